# Optimizing an MI355X kernel written in HIP

```python
import jax, jax.numpy as jnp
from jax import lax
import numpy as np

D_MODEL = 1024
BATCH = 2
SEQ = 8192
DEPTH = 2

CTX_LEN = 256
GRID_W = 64
HEAD_DIM = 64
EPS = 1e-6
FNET_GROUPS = 4
FNET_GROUP_DIM = 64
FNET_W = FNET_GROUPS * FNET_GROUP_DIM
RET_HEADS = 4
RET_W = RET_HEADS * HEAD_DIM
RET_CHUNK = 128
ATT_Q_HEADS = 8
ATT_KV_HEADS = 2
ATT_GROUP = ATT_Q_HEADS // ATT_KV_HEADS
ATT_QW = ATT_Q_HEADS * HEAD_DIM
ATT_KVW = ATT_KV_HEADS * HEAD_DIM
ATT_BLOCK = 128
ROPE_THETA = 10000.0
CONV_W = 256
CONV_K = 31
N_BRANCH = 4
IN_SIZES = (FNET_W, RET_W, RET_W, RET_W, RET_W, ATT_QW, ATT_KVW, ATT_KVW, 2 * CONV_W, N_BRANCH * D_MODEL)
IN_COLS = FNET_W + 4 * RET_W + ATT_QW + 2 * ATT_KVW + 2 * CONV_W + N_BRANCH * D_MODEL
FFN_DIM = 2816
N_EXPERTS = 8
TOP_K = 2
MOE_BLOCK = 128
N_DENSE = (DEPTH + 1) // 2
N_MOE = DEPTH // 2

kernel_name = "hybrid_fnet_retention_gqa_conformer_moe_dit"


def rms_norm(x, g):
    xf = x.astype(jnp.float32)
    y = xf * lax.rsqrt(jnp.mean(xf * xf, axis=-1, keepdims=True) + EPS)
    return (y * g.astype(jnp.float32)).astype(x.dtype)


def layer_norm(x, g, b):
    xf = x.astype(jnp.float32)
    mu = jnp.mean(xf, axis=-1, keepdims=True)
    var = jnp.mean(jnp.square(xf - mu), axis=-1, keepdims=True)
    y = (xf - mu) * lax.rsqrt(var + EPS) * g.astype(jnp.float32) + b.astype(jnp.float32)
    return y.astype(x.dtype)


def modulate(h, shift, scale):
    return h * (1.0 + scale) + shift


def rope_tables(rows):
    row = jnp.broadcast_to(jnp.arange(rows)[:, None], (rows, GRID_W)).reshape(-1).astype(jnp.float32)
    col = jnp.broadcast_to(jnp.arange(GRID_W)[None, :], (rows, GRID_W)).reshape(-1).astype(jnp.float32)
    n_axis = HEAD_DIM // 4
    inv = ROPE_THETA ** (-jnp.arange(n_axis, dtype=jnp.float32) / n_axis)
    ang = jnp.concatenate([row[:, None] * inv, col[:, None] * inv], axis=-1)
    return jnp.cos(ang), jnp.sin(ang)


def apply_rope(x, cos, sin):
    xf = x.astype(jnp.float32)
    x1, x2 = xf[..., :HEAD_DIM // 2], xf[..., HEAD_DIM // 2:]
    c, s = cos[None, :, None, :], sin[None, :, None, :]
    return jnp.concatenate([x1 * c - x2 * s, x1 * s + x2 * c], axis=-1).astype(x.dtype)


def fourier_mix(u):
    b, l, _ = u.shape
    ug = u.astype(jnp.float32).reshape(b, l, FNET_GROUPS, FNET_GROUP_DIM)
    y = jnp.fft.fft2(ug, axes=(1, 3), norm="ortho").real
    return y.reshape(b, l, FNET_W).astype(u.dtype)


def retention_scan(q, k, v, log_gamma, state0):
    b, l, h, d = q.shape
    n = l // RET_CHUNK
    pos = jnp.arange(RET_CHUNK, dtype=jnp.float32)
    diff = pos[:, None] - pos[None, :]
    decay = jnp.where(diff[None] >= 0.0,
                      jnp.exp(jnp.maximum(diff, 0.0)[None] * log_gamma[:, None, None]), 0.0)
    xi = jnp.exp((pos[:, None] + 1.0) * log_gamma[None, :])
    zeta = jnp.exp((RET_CHUNK - 1.0 - pos[:, None]) * log_gamma[None, :])
    g_chunk = jnp.exp(RET_CHUNK * log_gamma)

    def chunks(t):
        return t.reshape(b, n, RET_CHUNK, h, d).transpose(1, 0, 2, 3, 4)

    def step(state, qkv):
        qc, kc, vc = qkv
        att = jnp.einsum('bihd,bjhd->bhij', qc, kc) * decay
        o = (jnp.einsum('bhij,bjhe->bihe', att, vc)
             + jnp.einsum('bihd,bhde->bihe', qc, state) * xi[None, :, :, None])
        state = (state * g_chunk[None, :, None, None]
                 + jnp.einsum('bjhd,bjhe->bhde', kc * zeta[None, :, :, None], vc))
        return state, o

    state, o = lax.scan(step, state0, (chunks(q), chunks(k), chunks(v)))
    return o.transpose(1, 0, 2, 3, 4).reshape(b, l, h, d), state


def bidir_retention(q_c, k_c, v_c, q_l, k_l, v_l, lg_f, lg_b):
    b = q_l.shape[0]
    zero = jnp.zeros((b, RET_HEADS, HEAD_DIM, HEAD_DIM), jnp.float32)

    def flip(t):
        return t[:, ::-1]

    oc_f, sc_f = retention_scan(q_c, k_c, v_c, lg_f, zero)
    ol_f, _ = retention_scan(q_l, k_l, v_l, lg_f, sc_f)
    oc_b, sc_b = retention_scan(flip(q_c), flip(k_c), flip(v_c), lg_b, zero)
    ol_b, _ = retention_scan(flip(q_l), flip(k_l), flip(v_l), lg_b, sc_b)
    return oc_f + flip(oc_b), ol_f + flip(ol_b)


def retention_out(o, gate, g, w):
    b, l = o.shape[:2]
    y = rms_norm(o, g.reshape(RET_HEADS, HEAD_DIM)).reshape(b, l, RET_W).astype(gate.dtype)
    return (y * jax.nn.silu(gate)) @ w


def gqa_attend(q, k, v):
    b, lq = q.shape[:2]
    qg = q.reshape(b, lq, ATT_KV_HEADS, ATT_GROUP, HEAD_DIM)
    s = jnp.einsum('bqkgd,bskd->bkgqs', qg, k, preferred_element_type=jnp.float32) * (HEAD_DIM ** -0.5)
    p = jax.nn.softmax(s, axis=-1).astype(v.dtype)
    return jnp.einsum('bkgqs,bskd->bqkgd', p, v).reshape(b, lq, ATT_QW)


def latent_attention(q, k_all, v_all):
    b, s = q.shape[:2]
    nb = s // ATT_BLOCK
    qb = q.reshape(b, nb, ATT_BLOCK, ATT_Q_HEADS, HEAD_DIM).transpose(1, 0, 2, 3, 4)
    o = lax.map(lambda qblk: gqa_attend(qblk, k_all, v_all), qb)
    return o.transpose(1, 0, 2, 3).reshape(b, s, ATT_QW)


def conformer_conv(u, dw_w, dw_b, ln_g, ln_b, w_out):
    a, gt = jnp.split(u, 2, axis=-1)
    y = a * jax.nn.sigmoid(gt)
    y = lax.conv_general_dilated(y, dw_w[:, None, :], window_strides=(1,),
                                 padding=[(CONV_K // 2, CONV_K // 2)],
                                 dimension_numbers=('NWC', 'WIO', 'NWC'),
                                 feature_group_count=CONV_W) + dw_b
    return jax.nn.silu(layer_norm(y, ln_g, ln_b)) @ w_out


def merge_branches(branches, gate_pre, w_out):
    b, l, _ = gate_pre.shape
    g = jax.nn.sigmoid(gate_pre).reshape(b, l, N_BRANCH, D_MODEL)
    y0, y1, y2, y3 = branches
    merged = g[:, :, 0] * y0 + g[:, :, 1] * y1 + g[:, :, 2] * y2 + g[:, :, 3] * y3
    return merged @ w_out


def token_mixers(h_l, h_c, cos, sin, w_in, fnet_w, dec_f, dec_b, ret_g, ret_w,
                 qn_g, kn_g, att_w, dw_w, dw_b, cln_g, cln_b, conv_out, w_out, with_ctx):
    b, n_lat, _ = h_l.shape
    n_ctx = h_c.shape[1]
    splits = [int(s) for s in np.cumsum(IN_SIZES)[:-1]]
    fn_l, rq_l, rk_l, rv_l, rg_l, aq_l, ak_l, av_l, cv_l, gt_l = jnp.split(h_l @ w_in, splits, axis=-1)
    fn_c, rq_c, rk_c, rv_c, rg_c, aq_c, ak_c, av_c, cv_c, gt_c = jnp.split(h_c @ w_in, splits, axis=-1)

    def rheads(t, n):
        return t.reshape(b, n, RET_HEADS, HEAD_DIM).astype(jnp.float32)

    k_scale = HEAD_DIM ** -0.5
    lg_f, lg_b = jax.nn.log_sigmoid(dec_f.astype(jnp.float32)), jax.nn.log_sigmoid(dec_b.astype(jnp.float32))
    ro_c, ro_l = bidir_retention(
        rheads(rq_c, n_ctx), rheads(rk_c, n_ctx) * k_scale, rheads(rv_c, n_ctx),
        apply_rope(rheads(rq_l, n_lat), cos, sin), apply_rope(rheads(rk_l, n_lat), cos, sin) * k_scale,
        rheads(rv_l, n_lat), lg_f, lg_b)
    y_ret_l = retention_out(ro_l, rg_l, ret_g, ret_w)

    def aheads(t, n, hh):
        return t.reshape(b, n, hh, HEAD_DIM)

    q_l = apply_rope(rms_norm(aheads(aq_l, n_lat, ATT_Q_HEADS), qn_g), cos, sin)
    k_l = apply_rope(rms_norm(aheads(ak_l, n_lat, ATT_KV_HEADS), kn_g), cos, sin)
    k_c = rms_norm(aheads(ak_c, n_ctx, ATT_KV_HEADS), kn_g)
    v_l, v_c = aheads(av_l, n_lat, ATT_KV_HEADS), aheads(av_c, n_ctx, ATT_KV_HEADS)
    k_all = jnp.concatenate([k_c, k_l], axis=1)
    v_all = jnp.concatenate([v_c, v_l], axis=1)
    y_att_l = latent_attention(q_l, k_all, v_all) @ att_w

    y_fn_l = fourier_mix(fn_l) @ fnet_w
    y_cv_l = conformer_conv(cv_l, dw_w, dw_b, cln_g, cln_b, conv_out)
    out_l = merge_branches((y_fn_l, y_ret_l, y_att_l, y_cv_l), gt_l, w_out)

    if not with_ctx:
        return out_l, None

    q_c = rms_norm(aheads(aq_c, n_ctx, ATT_Q_HEADS), qn_g)
    y_att_c = gqa_attend(q_c, k_c, v_c) @ att_w
    y_ret_c = retention_out(ro_c, rg_c, ret_g, ret_w)
    y_fn_c = fourier_mix(fn_c) @ fnet_w
    y_cv_c = conformer_conv(cv_c, dw_w, dw_b, cln_g, cln_b, conv_out)
    out_c = merge_branches((y_fn_c, y_ret_c, y_att_c, y_cv_c), gt_c, w_out)
    return out_l, out_c


def swiglu(x, wg, wu, wd):
    return (jax.nn.silu(x @ wg) * (x @ wu)) @ wd


def moe_swiglu(x, router_w, wg, wu, wd):
    b, l, d = x.shape
    xt = x.reshape(-1, d)
    n_tok = xt.shape[0]
    logits = jnp.dot(xt, router_w, preferred_element_type=jnp.float32)
    top_v, top_e = lax.top_k(logits, TOP_K)
    top_w = jax.nn.softmax(top_v, axis=-1)
    e = top_e.reshape(-1)
    tok = jnp.repeat(jnp.arange(n_tok, dtype=jnp.int32), TOP_K)
    w = top_w.reshape(-1)
    n_assign = e.shape[0]
    order = jnp.argsort(e)
    e_s, tok_s, w_s = e[order], tok[order], w[order]
    counts = jnp.bincount(e, length=N_EXPERTS)
    start = jnp.cumsum(counts) - counts
    padded = (counts + MOE_BLOCK - 1) // MOE_BLOCK * MOE_BLOCK
    pad_end = jnp.cumsum(padded)
    pad_start = pad_end - padded
    dest = pad_start[e_s] + jnp.arange(n_assign) - start[e_s]
    n_blocks = -(-n_assign // MOE_BLOCK) + N_EXPERTS
    n_rows = n_blocks * MOE_BLOCK
    buf_tok = jnp.full((n_rows,), n_tok, jnp.int32).at[dest].set(tok_s)
    buf_w = jnp.zeros((n_rows,), jnp.float32).at[dest].set(w_s)
    blk_e = jnp.minimum(jnp.searchsorted(pad_end, jnp.arange(n_blocks) * MOE_BLOCK, side='right'),
                        N_EXPERTS - 1)
    x_pad = jnp.concatenate([xt, jnp.zeros((1, d), xt.dtype)], axis=0)
    xb = x_pad[buf_tok].reshape(n_blocks, MOE_BLOCK, d)

    def expert_block(args):
        xblk, ei = args
        return swiglu(xblk, wg[ei], wu[ei], wd[ei])

    yb = lax.map(expert_block, (xb, blk_e)).reshape(n_rows, d)
    y = jnp.zeros((n_tok + 1, d), jnp.float32).at[buf_tok].add(yb.astype(jnp.float32) * buf_w[:, None])
    return y[:n_tok].astype(x.dtype).reshape(b, l, d)


def setup_inputs(seed: int = 0) -> dict:
    key = jax.random.key(seed)
    keys = iter(jax.random.split(key, 40))
    f32 = jnp.float32

    def nrm(shape, scale):
        return jax.random.normal(next(keys), shape, f32) * scale

    def gain(shape):
        return 1.0 + nrm(shape, 0.02)

    gamma_logit = jnp.log(2.0 ** (5.0 + jnp.arange(RET_HEADS, dtype=f32)) - 1.0)
    return {
        "x": nrm((BATCH, SEQ, D_MODEL), 1.0),
        "c": nrm((BATCH, D_MODEL), 1.0),
        "ctx": nrm((BATCH, CTX_LEN, D_MODEL), 1.0),
        "c_ctx": nrm((D_MODEL,), 1.0),
        "ada_w": nrm((DEPTH, D_MODEL, 6 * D_MODEL), 0.5 * D_MODEL ** -0.5),
        "ada_b": nrm((DEPTH, 6 * D_MODEL), 0.02),
        "norm1_g": gain((DEPTH, D_MODEL)),
        "norm2_g": gain((DEPTH, D_MODEL)),
        "w_in": nrm((DEPTH, D_MODEL, IN_COLS), D_MODEL ** -0.5),
        "fnet_w": nrm((DEPTH, FNET_W, D_MODEL), FNET_W ** -0.5),
        "ret_decay_fwd": gamma_logit[None, :] + nrm((DEPTH, RET_HEADS), 0.05),
        "ret_decay_bwd": gamma_logit[None, :] + nrm((DEPTH, RET_HEADS), 0.05),
        "ret_norm_g": gain((DEPTH, RET_W)),
        "ret_w": nrm((DEPTH, RET_W, D_MODEL), RET_W ** -0.5),
        "attn_qn_g": gain((DEPTH, HEAD_DIM)),
        "attn_kn_g": gain((DEPTH, HEAD_DIM)),
        "attn_w": nrm((DEPTH, ATT_QW, D_MODEL), ATT_QW ** -0.5),
        "conv_dw_w": nrm((DEPTH, CONV_K, CONV_W), CONV_K ** -0.5),
        "conv_dw_b": nrm((DEPTH, CONV_W), 0.02),
        "conv_ln_g": gain((DEPTH, CONV_W)),
        "conv_ln_b": nrm((DEPTH, CONV_W), 0.02),
        "conv_w_out": nrm((DEPTH, CONV_W, D_MODEL), CONV_W ** -0.5),
        "w_out": nrm((DEPTH, D_MODEL, D_MODEL), D_MODEL ** -0.5),
        "ffn_w_gate": nrm((N_DENSE, D_MODEL, FFN_DIM), D_MODEL ** -0.5),
        "ffn_w_up": nrm((N_DENSE, D_MODEL, FFN_DIM), D_MODEL ** -0.5),
        "ffn_w_down": nrm((N_DENSE, FFN_DIM, D_MODEL), FFN_DIM ** -0.5),
        "router_w": nrm((N_MOE, D_MODEL, N_EXPERTS), D_MODEL ** -0.5),
        "moe_w_gate": nrm((N_MOE, N_EXPERTS, D_MODEL, FFN_DIM), D_MODEL ** -0.5),
        "moe_w_up": nrm((N_MOE, N_EXPERTS, D_MODEL, FFN_DIM), D_MODEL ** -0.5),
        "moe_w_down": nrm((N_MOE, N_EXPERTS, FFN_DIM, D_MODEL), FFN_DIM ** -0.5),
    }


def reference(x, c, ctx, c_ctx, ada_w, ada_b, norm1_g, norm2_g, w_in, fnet_w, ret_decay_fwd, ret_decay_bwd,
              ret_norm_g, ret_w, attn_qn_g, attn_kn_g, attn_w, conv_dw_w, conv_dw_b, conv_ln_g, conv_ln_b,
              conv_w_out, w_out, ffn_w_gate, ffn_w_up, ffn_w_down, router_w, moe_w_gate, moe_w_up, moe_w_down):
    n_lat = x.shape[1]
    rows = n_lat // GRID_W
    cos, sin = rope_tables(rows)
    n_ctx = ctx.shape[1]
    silu_c = jax.nn.silu(c)
    silu_cc = jax.nn.silu(c_ctx)
    h_lat, h_ctx = x, ctx
    for i in range(DEPTH):
        with_ctx = i < DEPTH - 1
        mod_l = jnp.split((silu_c @ ada_w[i] + ada_b[i])[:, None, :], 6, axis=-1)
        mod_c = jnp.split((silu_cc @ ada_w[i] + ada_b[i])[None, None, :], 6, axis=-1)
        a_l = modulate(rms_norm(h_lat, norm1_g[i]), mod_l[0], mod_l[1])
        a_c = modulate(rms_norm(h_ctx, norm1_g[i]), mod_c[0], mod_c[1])
        m_l, m_c = token_mixers(a_l, a_c, cos, sin, w_in[i], fnet_w[i], ret_decay_fwd[i], ret_decay_bwd[i],
                                ret_norm_g[i], ret_w[i], attn_qn_g[i], attn_kn_g[i], attn_w[i],
                                conv_dw_w[i], conv_dw_b[i], conv_ln_g[i], conv_ln_b[i], conv_w_out[i],
                                w_out[i], with_ctx)
        h_lat = h_lat + mod_l[2] * m_l
        j = i // 2
        if i % 2 == 0:
            ffn = lambda t, j=j: swiglu(t, ffn_w_gate[j], ffn_w_up[j], ffn_w_down[j])
        else:
            ffn = lambda t, j=j: moe_swiglu(t, router_w[j], moe_w_gate[j], moe_w_up[j], moe_w_down[j])
        f_l = modulate(rms_norm(h_lat, norm2_g[i]), mod_l[3], mod_l[4])
        if with_ctx:
            h_ctx = h_ctx + mod_c[2] * m_c
            f_c = modulate(rms_norm(h_ctx, norm2_g[i]), mod_c[3], mod_c[4])
            y = ffn(jnp.concatenate([f_c, f_l], axis=1))
            h_ctx = h_ctx + mod_c[5] * y[:, :n_ctx]
            h_lat = h_lat + mod_l[5] * y[:, n_ctx:]
        else:
            h_lat = h_lat + mod_l[5] * ffn(f_l)
    return h_lat
```

```cpp
#include <hip/hip_runtime.h>
#include <hip/hip_cooperative_groups.h>
#include <cstdio>
#include <cstdint>
namespace cg = cooperative_groups;

#ifndef MK_SINGLE
#define MK_SINGLE 0
#endif

typedef unsigned short bf16;
typedef float f32x4 __attribute__((ext_vector_type(4)));
typedef unsigned u32x4 __attribute__((ext_vector_type(4)));
typedef unsigned u32x2 __attribute__((ext_vector_type(2)));
#define LAS __attribute__((address_space(3)))

constexpr int D = 1024, NB = 2, SEQ = 8192, CTX = 256, NLAT = NB * SEQ, NCTX = NB * CTX, MROWS = NLAT + NCTX;
constexpr int INC = 6656, FFN = 2816, NEXP = 8, KEYS = CTX + SEQ;
constexpr int NCHUNK = 66;
constexpr float EPS = 1e-6f;
constexpr float QSCALE = 0.125f * 1.4426950408889634f;
constexpr int MOE_ROWS = 34816;
constexpr int NTHREADS = 512;

constexpr size_t MiB = 1u << 20;
constexpr size_t WS_CTL = 0, CTL_BYTES = 1 * MiB;
constexpr size_t WS_MODS = 1 * MiB;
constexpr size_t WS_ROPE = 2 * MiB;
constexpr size_t WS_F1 = 4 * MiB;
constexpr size_t WS_F2 = WS_F1 + 131072;
constexpr size_t WS_FC = WS_F2 + 131072;
constexpr size_t WS_ROUTE = 5 * MiB;
constexpr size_t WS_HCTX = 6 * MiB;
constexpr size_t WS_WIN = 8 * MiB;
constexpr size_t WS_WB = 34 * MiB;
constexpr size_t WS_WOUT = 40 * MiB;
constexpr size_t WS_FFN1 = 44 * MiB;
constexpr size_t WS_FFN2 = 55 * MiB;
constexpr size_t WS_A = 61 * MiB;
constexpr size_t WS_X = 94 * MiB;
constexpr size_t WS_Y = 144 * MiB;
constexpr size_t WS_RETQ = WS_Y;
constexpr size_t WS_RETK = WS_RETQ + (size_t)MROWS * 256 * 2;
constexpr size_t WS_RETV = WS_RETK + (size_t)MROWS * 256 * 2;
constexpr size_t WS_RETG = WS_RETV + (size_t)MROWS * 256 * 2;
constexpr size_t WS_ATTQ = WS_Y + 33 * MiB;
constexpr size_t WS_ATTK = WS_Y + 50 * MiB;
constexpr size_t WS_ATTV = WS_Y + 55 * MiB;
constexpr size_t WS_CONV = WS_Y + 60 * MiB;
constexpr size_t WS_UT = WS_Y + 77 * MiB;
constexpr size_t WS_UTC = WS_Y + 93 * MiB;
constexpr size_t WS_Z = WS_Y + 94 * MiB;
constexpr size_t WS_RETS = WS_Y + 126 * MiB;
constexpr size_t WS_MERGED = WS_Y + 143 * MiB;
constexpr size_t WS_G = 320 * MiB;
constexpr size_t WS_MOE1 = WS_G;
constexpr size_t WS_MOE2 = WS_G + (size_t)NEXP * 5632 * 1024 * 2;
constexpr size_t WS_HMID = WS_Y;
constexpr size_t WS_HMOE = 61 * MiB;
constexpr size_t WS_FS = 252 * MiB;
constexpr size_t WS_END = 452 * MiB;
static_assert(WS_MERGED + (size_t)MROWS * 1024 * 2 <= WS_G, "map");
static_assert(WS_HMOE + (size_t)MOE_ROWS * FFN * 2 <= WS_FS && WS_FS + (size_t)MOE_ROWS * 1024 * 2 <= WS_G, "map moe");
static_assert(WS_MOE2 + (size_t)NEXP * 1024 * FFN * 2 <= WS_END, "map moe w");
constexpr int CW_CNT = 64;
constexpr int CW_CUR = 128;
constexpr int CW_BAR = 4096;

struct P {
    const float* in[30];
    float* out;
    unsigned char* ws;
};

__device__ __forceinline__ float bf2f(bf16 v) { return __uint_as_float((unsigned)v << 16); }
__device__ __forceinline__ bf16 f2bf(float f) { unsigned u = __float_as_uint(f); return (bf16)((u + 0x7fffu + ((u >> 16) & 1u)) >> 16); }
__device__ __forceinline__ unsigned pk2(float lo, float hi) { return (unsigned)f2bf(lo) | ((unsigned)f2bf(hi) << 16); }
__device__ __forceinline__ float sigmoidf_(float x) { return 1.f / (1.f + __expf(-x)); }
__device__ __forceinline__ float siluf_(float x) { return x / (1.f + __expf(-x)); }
__device__ __forceinline__ float wave_sum(float v) {
#pragma unroll
    for (int o = 1; o < 64; o <<= 1) v += __shfl_xor(v, o);
    return v;
}
__device__ __forceinline__ int row_mi(int r) { return r < NLAT ? (r >> 13) : 2; }
__device__ __forceinline__ float* hrow(const P& p, int r) { return r < NLAT ? p.out + (size_t)r * D : (float*)(p.ws + WS_HCTX) + (size_t)(r - NLAT) * D; }
__device__ __forceinline__ const float* mods(const P& p, int layer, int mi, int chunk) { return (const float*)(p.ws + WS_MODS) + ((size_t)(layer * 3 + mi) * 6 + chunk) * D; }

__device__ __forceinline__ int rowmap(int mode, int n) { return mode == 0 ? n : (8 * (n >> 2) + (n & 3) + (mode == 2 ? 4 : 0)); }
__device__ __forceinline__ void conv_tile(LAS float* scr, const float* src, int ldn, int k0, int n0, bf16* dst, int ldd, int koff, int mode) {
    const int tid = threadIdx.x;
    __syncthreads();
#pragma unroll
    for (int i = 0; i < 8; ++i) { const int e = tid + i * NTHREADS, kk = e >> 6, nn = e & 63; scr[kk * 65 + nn] = src[(size_t)(k0 + kk) * ldn + n0 + nn]; }
    __syncthreads();
    const int nn = tid >> 3, kc = (tid & 7) * 8;
    u32x4 o; o.x = pk2(scr[(kc + 0) * 65 + nn], scr[(kc + 1) * 65 + nn]); o.y = pk2(scr[(kc + 2) * 65 + nn], scr[(kc + 3) * 65 + nn]);
    o.z = pk2(scr[(kc + 4) * 65 + nn], scr[(kc + 5) * 65 + nn]); o.w = pk2(scr[(kc + 6) * 65 + nn], scr[(kc + 7) * 65 + nn]);
    *(u32x4*)(dst + (size_t)rowmap(mode, n0 + nn) * ldd + koff + k0 + kc) = o;
}
struct CJob { const float* src; int K, N; bf16* dst; int ldd, koff, mode; };
__device__ __forceinline__ CJob get_job(const P& p, int j) {
    CJob c;
    if (j < 10) { const int l = j / 5, t = j % 5; bf16* wb = (bf16*)(p.ws + WS_WB) + (size_t)l * 1024 * 1536;
        if (t == 0) c = CJob{p.in[8] + (size_t)l * D * INC, D, INC, (bf16*)(p.ws + WS_WIN) + (size_t)l * INC * D, D, 0, 0};
        else if (t == 1) c = CJob{p.in[13] + (size_t)l * 256 * D, 256, D, wb, 1536, 512, 0};
        else if (t == 2) c = CJob{p.in[16] + (size_t)l * 512 * D, 512, D, wb, 1536, 768, 0};
        else if (t == 3) c = CJob{p.in[21] + (size_t)l * 256 * D, 256, D, wb, 1536, 1280, 0};
        else c = CJob{p.in[22] + (size_t)l * D * D, D, D, (bf16*)(p.ws + WS_WOUT) + (size_t)l * D * D, D, 0, 0}; }
    else if (j == 10) c = CJob{p.in[23], D, FFN, (bf16*)(p.ws + WS_FFN1), D, 0, 1};
    else if (j == 11) c = CJob{p.in[24], D, FFN, (bf16*)(p.ws + WS_FFN1), D, 0, 2};
    else c = CJob{p.in[25], FFN, D, (bf16*)(p.ws + WS_FFN2), FFN, 0, 0};
    return c;
}
__device__ __forceinline__ CJob get_moe_job(const P& p, int j) {
    const int e = j / 3, t = j % 3; CJob c;
    if (t == 0) c = CJob{p.in[27] + (size_t)e * D * FFN, D, FFN, (bf16*)(p.ws + WS_MOE1) + (size_t)e * 5632 * D, D, 0, 1};
    else if (t == 1) c = CJob{p.in[28] + (size_t)e * D * FFN, D, FFN, (bf16*)(p.ws + WS_MOE1) + (size_t)e * 5632 * D, D, 0, 2};
    else c = CJob{p.in[29] + (size_t)e * FFN * D, FFN, D, (bf16*)(p.ws + WS_MOE2) + (size_t)e * D * FFN, FFN, 0, 0};
    return c;
}
template <bool MOE> __device__ __forceinline__ void run_conv_jobs(const P& p, LAS float* scr, int njobs, int bid, int nb) {
    int base = 0;
    for (int j = 0; j < njobs; ++j) {
        const CJob jb = MOE ? get_moe_job(p, j) : get_job(p, j); const int nn = jb.N / 64, cnt = (jb.K / 64) * nn;
        const int first = ((bid - base) % nb + nb) % nb;
        for (int i = first; i < cnt; i += nb) conv_tile(scr, jb.src, jb.N, (i / nn) * 64, (i % nn) * 64, jb.dst, jb.ldd, jb.koff, jb.mode);
        base += cnt;
    }
}
__device__ __forceinline__ void ph_prologue(const P& p, LAS unsigned char* lds) {
    const int tid = threadIdx.x, bid = blockIdx.x, nb = gridDim.x;
    const int gt = bid * NTHREADS + tid, ngt = nb * NTHREADS;
    LAS float* scr = (LAS float*)lds;
    run_conv_jobs<false>(p, scr, 13, bid, nb);
    __syncthreads();
    {
        const float s = 1.0f / sqrtf(64.f * 8192.f);
        for (int e = gt; e < 2 * 512 * 1024; e += ngt) {
            const int n = e & 1023, kk = (e >> 10) & 511, l = e >> 19;
            const int part = kk >> 8, g = (kk >> 6) & 3, c = kk & 63;
            const float* W = p.in[9] + (size_t)l * 256 * D + (size_t)(g * 64) * D + n;
            float acc = 0.f;
            for (int c2 = 0; c2 < 64; ++c2) { const int m = (c * c2) & 63; const float t = part == 0 ? cospif(m * (2.f / 64.f)) : -sinpif(m * (2.f / 64.f)); acc += t * W[(size_t)c2 * D]; }
            ((bf16*)(p.ws + WS_WB))[(size_t)l * 1024 * 1536 + (size_t)n * 1536 + kk] = f2bf(acc * s);
        }
    }
    {
        float* rc = (float*)(p.ws + WS_ROPE); float* rs = rc + SEQ * 32;
        for (int e = gt; e < SEQ * 32; e += ngt) {
            const int s = e >> 5, i = e & 31; const float inv = powf(10000.f, -(float)(i & 15) / 16.f);
            const float pos = (float)(i < 16 ? (s >> 6) : (s & 63)); const float ang = pos * inv;
            rc[e] = cosf(ang); rs[e] = sinf(ang);
        }
    }
    {
        bf16* F1 = (bf16*)(p.ws + WS_F1); bf16* F2 = (bf16*)(p.ws + WS_F2); bf16* FC = (bf16*)(p.ws + WS_FC);
        for (int e = gt; e < 256 * 256; e += ngt) {
            const int rho = e >> 8, n1 = e & 255; float v = 0.f;
            if (n1 < 128) { const int k1 = (rho >> 5) * 16 + (rho & 15), c = (rho >> 4) & 1, m = (k1 * n1) & 127; v = c == 0 ? cospif(m * (2.f / 128.f)) : -sinpif(m * (2.f / 128.f)); }
            F1[e] = f2bf(v);
            float w = 0.f;
            if (rho < 128 && n1 < 128) { const int c2 = rho >> 6, k2 = rho & 63, c = n1 >> 6, n2 = n1 & 63, m = (k2 * n2) & 63; const float cs = cospif(m * (2.f / 64.f)), sn = sinpif(m * (2.f / 64.f));
                w = c2 == 0 ? (c == 0 ? cs : sn) : (c == 0 ? sn : -cs); }
            F2[e] = f2bf(w);
        }
        const float sc = sqrtf(32.f);
        for (int e = gt; e < 512 * 256; e += ngt) { const int rho = e >> 8, n = e & 255, c2 = rho >> 8, k = rho & 255, m = (k * n) & 255; FC[e] = f2bf(sc * (c2 == 0 ? cospif(m * (2.f / 256.f)) : sinpif(m * (2.f / 256.f)))); }
    }
    {
        u32x4* ut = (u32x4*)(p.ws + WS_UT); const u32x4 z = {0u, 0u, 0u, 0u};
        for (int e = gt; e < 2 * 256 * 64 * 16; e += ngt) { const int row = e >> 4, q = e & 15; ut[(size_t)row * 32 + 16 + q] = z; }
        u32x4* zz = (u32x4*)(p.ws + WS_Z);
        for (int e = gt; e < 2 * 32768 * 16; e += ngt) { const int row = e >> 4, q = e & 15; zz[(size_t)row * 32 + 16 + q] = z; }
    }
    {
        LAS float* sv = (LAS float*)lds;
        LAS float* red = sv + 3 * 1024;
        __syncthreads();
        for (int e = tid; e < 3 * 1024; e += NTHREADS) { const int j = e >> 10, k = e & 1023; const float v = j < 2 ? p.in[1][j * D + k] : p.in[3][k]; sv[e] = siluf_(v); }
        __syncthreads();
        const int kq = tid >> 6, cl = tid & 63;
        for (int it = bid; it < 2 * 96; it += nb) {
            const int l = it / 96, n = (it % 96) * 64 + cl;
            const float* W = p.in[4] + (size_t)l * D * 6144 + n;
            float a0 = 0.f, a1 = 0.f, a2 = 0.f;
            for (int k = kq; k < D; k += 8) { const float w = W[(size_t)k * 6144]; a0 += sv[k] * w; a1 += sv[1024 + k] * w; a2 += sv[2048 + k] * w; }
            red[(kq * 3 + 0) * 64 + cl] = a0; red[(kq * 3 + 1) * 64 + cl] = a1; red[(kq * 3 + 2) * 64 + cl] = a2;
            __syncthreads();
            if (tid < 192) { const int j = tid >> 6; float s = 0.f;
#pragma unroll
                for (int q = 0; q < 8; ++q) s += red[(q * 3 + j) * 64 + cl];
                ((float*)(p.ws + WS_MODS))[(size_t)(l * 3 + j) * 6144 + n] = s + p.in[5][l * 6144 + n]; }
            __syncthreads();
        }
    }
}
__device__ __forceinline__ void ph_moe_convert(const P& p, LAS unsigned char* lds) {
    LAS float* scr = (LAS float*)lds;
    const int bid = blockIdx.x, nb = gridDim.x;
    run_conv_jobs<true>(p, scr, 24, bid, nb);
    __syncthreads();
}

__device__ __forceinline__ void ph_norm(const P& p, int layer, int which, bool first, bool route, int nrows) {
    const int lane = threadIdx.x & 63, gw = blockIdx.x * 8 + (threadIdx.x >> 6), ngw = gridDim.x * 8;
    const float* gain = p.in[which == 0 ? 6 : 7] + layer * D;
    bf16* A = (bf16*)(p.ws + WS_A);
    if (route) {
        int* slot_tok = (int*)(p.ws + WS_ROUTE) + 16384 * 6;
        for (int e = blockIdx.x * NTHREADS + threadIdx.x; e < MOE_ROWS; e += gridDim.x * NTHREADS) slot_tok[e] = -1;
    }
    for (int r = gw; r < nrows; r += ngw) {
        const int mi = row_mi(r);
        const float* src = first ? (r < NLAT ? p.in[0] + (size_t)r * D : p.in[2] + (size_t)(r - NLAT) * D) : hrow(p, r);
        const float* shift = mods(p, layer, mi, which == 0 ? 0 : 3); const float* scale = mods(p, layer, mi, which == 0 ? 1 : 4);
        f32x4 v[4]; float ss = 0.f;
#pragma unroll
        for (int j = 0; j < 4; ++j) { v[j] = *(const f32x4*)(src + 4 * lane + 256 * j); ss += v[j].x * v[j].x + v[j].y * v[j].y + v[j].z * v[j].z + v[j].w * v[j].w; }
        if (first) { float* h = hrow(p, r);
#pragma unroll
            for (int j = 0; j < 4; ++j) *(f32x4*)(h + 4 * lane + 256 * j) = v[j]; }
        const float rstd = rsqrtf(wave_sum(ss) * (1.f / D) + EPS);
        float lg[8];
#pragma unroll
        for (int e = 0; e < 8; ++e) lg[e] = 0.f;
#pragma unroll
        for (int j = 0; j < 4; ++j) {
            const int c = 4 * lane + 256 * j;
            const f32x4 g = *(const f32x4*)(gain + c), sc = *(const f32x4*)(scale + c), sh = *(const f32x4*)(shift + c);
            f32x4 y = v[j] * rstd * g * (sc + 1.f) + sh;
            u32x2 o; o.x = pk2(y.x, y.y); o.y = pk2(y.z, y.w);
            *(u32x2*)(A + (size_t)r * D + c) = o;
            if (route) {
                const float* rw = p.in[26] + (size_t)c * 8;
#pragma unroll
                for (int q = 0; q < 4; ++q) { const f32x4 w0 = *(const f32x4*)(rw + q * 8), w1 = *(const f32x4*)(rw + q * 8 + 4); const float yy = y[q];
                    lg[0] += yy * w0.x; lg[1] += yy * w0.y; lg[2] += yy * w0.z; lg[3] += yy * w0.w; lg[4] += yy * w1.x; lg[5] += yy * w1.y; lg[6] += yy * w1.z; lg[7] += yy * w1.w; }
            }
        }
        if (route) {
#pragma unroll
            for (int e = 0; e < 8; ++e) lg[e] = wave_sum(lg[e]);
            if (lane == 0) {
                int e0 = 0; float v0 = lg[0];
#pragma unroll
                for (int e = 1; e < 8; ++e) if (lg[e] > v0) { v0 = lg[e]; e0 = e; }
                int e1 = -1; float v1 = -INFINITY;
#pragma unroll
                for (int e = 0; e < 8; ++e) if (e != e0 && lg[e] > v1) { v1 = lg[e]; e1 = e; }
                const float w0 = 1.f / (1.f + expf(v1 - v0));
                int* tok_e = (int*)(p.ws + WS_ROUTE); float* tok_w = (float*)(p.ws + WS_ROUTE) + 16384 * 2;
                tok_e[r * 2] = e0; tok_e[r * 2 + 1] = e1; tok_w[r * 2] = w0; tok_w[r * 2 + 1] = 1.f - w0;
                unsigned* ctl = (unsigned*)(p.ws + WS_CTL);
                atomicAdd(ctl + CW_CNT + e0, 1u); atomicAdd(ctl + CW_CNT + e1, 1u);
            }
        }
    }
}

__device__ __forceinline__ void gemm_tile_naive(LAS float* As, LAS float* Bs, const bf16* A, int lda, const bf16* Bt, int ldb, int K, float (&acc)[4][4]) {
    const int tid = threadIdx.x, ty = tid >> 4, tx = tid & 15;
#pragma unroll
    for (int i = 0; i < 4; ++i)
#pragma unroll
        for (int j = 0; j < 4; ++j) acc[i][j] = 0.f;
    const int lr = tid >> 2, lk = (tid & 3) * 8;
#pragma unroll 1
    for (int k0 = 0; k0 < K; k0 += 32) {
        __syncthreads();
        { const u32x4 a = *(const u32x4*)(A + (size_t)lr * lda + k0 + lk);
          const unsigned w[4] = {a.x, a.y, a.z, a.w};
#pragma unroll
          for (int q = 0; q < 4; ++q) { As[(lk + 2 * q) * 132 + lr] = __uint_as_float(w[q] << 16); As[(lk + 2 * q + 1) * 132 + lr] = __uint_as_float(w[q] & 0xffff0000u); } }
        if (tid < 256) { const u32x4 b = *(const u32x4*)(Bt + (size_t)lr * ldb + k0 + lk);
          const unsigned w[4] = {b.x, b.y, b.z, b.w};
#pragma unroll
          for (int q = 0; q < 4; ++q) { Bs[(lk + 2 * q) * 68 + lr] = __uint_as_float(w[q] << 16); Bs[(lk + 2 * q + 1) * 68 + lr] = __uint_as_float(w[q] & 0xffff0000u); } }
        __syncthreads();
#pragma unroll 8
        for (int k = 0; k < 32; ++k) {
            const f32x4 a = *(const LAS f32x4*)(As + k * 132 + ty * 4), b = *(const LAS f32x4*)(Bs + k * 68 + tx * 4);
#pragma unroll
            for (int i = 0; i < 4; ++i)
#pragma unroll
                for (int j = 0; j < 4; ++j) acc[i][j] += a[i] * b[j];
        }
    }
}
#define GEMM_LDS_AS(lds) ((LAS float*)(lds))
#define GEMM_LDS_BS(lds) ((LAS float*)(lds) + 32 * 132)

__device__ __forceinline__ void ph_win(const P& p, LAS unsigned char* lds, int layer) {
    const int tid = threadIdx.x, ty = tid >> 4, tx = tid & 15;
    const bf16* A = (const bf16*)(p.ws + WS_A); const bf16* Bt = (const bf16*)(p.ws + WS_WIN) + (size_t)layer * INC * D;
    const float* rc = (const float*)(p.ws + WS_ROPE); const float* rs = rc + SEQ * 32;
    const int ntm = MROWS / 128, ntn = INC / 64;
    for (int it = blockIdx.x; it < ntm * ntn; it += gridDim.x) {
        const int tm = it / ntn, tn = it % ntn, r0 = tm * 128, n0 = tn * 64;
        float acc[4][4];
        gemm_tile_naive(GEMM_LDS_AS(lds), GEMM_LDS_BS(lds), A + (size_t)r0 * D, D, Bt + (size_t)n0 * D, D, D, acc);
        const int c0 = n0 + tx * 4;
#pragma unroll
        for (int i = 0; i < 4; ++i) {
            const int r = r0 + ty * 4 + i; const bool lat = r < NLAT;
            const int b = lat ? (r >> 13) : ((r - NLAT) >> 8), s = lat ? (r & 8191) : ((r - NLAT) & 255);
            float v[4] = {acc[i][0], acc[i][1], acc[i][2], acc[i][3]};
            if (n0 < 256) {
                if (lat) { bf16* ut = (bf16*)(p.ws + WS_UT);
#pragma unroll
                    for (int j = 0; j < 4; ++j) ut[((size_t)(b * 256 + c0 + j) * 64 + (s & 63)) * 256 + (s >> 6)] = f2bf(v[j]); }
                else { bf16* utc = (bf16*)(p.ws + WS_UTC);
#pragma unroll
                    for (int j = 0; j < 4; ++j) utc[(size_t)(b * 256 + c0 + j) * 256 + s] = f2bf(v[j]); }
            } else if (n0 < 1280) {
                const int sec = (n0 - 256) >> 8, cc = (c0 - 256) & 255, d = cc & 63;
                if (sec < 2) {
                    float pr[4];
#pragma unroll
                    for (int j = 0; j < 4; ++j) pr[j] = __shfl_xor(v[j], 8);
                    if (lat) {
#pragma unroll
                        for (int j = 0; j < 4; ++j) { const int ii = (d + j) & 31; const float cs = rc[s * 32 + ii], sn = rs[s * 32 + ii]; v[j] = d < 32 ? v[j] * cs - pr[j] * sn : pr[j] * sn + v[j] * cs; }
                    }
                    if (sec == 1) {
#pragma unroll
                        for (int j = 0; j < 4; ++j) v[j] *= 0.125f; }
                }
                bf16* dst = (bf16*)(p.ws + WS_RETQ) + (size_t)sec * MROWS * 256 + (size_t)r * 256 + cc;
                u32x2 o; o.x = pk2(v[0], v[1]); o.y = pk2(v[2], v[3]); *(u32x2*)dst = o;
            } else if (n0 < 1920) {
                const bool isq = n0 < 1792; const int cc = isq ? c0 - 1280 : c0 - 1792, d = cc & 63;
                float ss = v[0] * v[0] + v[1] * v[1] + v[2] * v[2] + v[3] * v[3];
                ss += __shfl_xor(ss, 1); ss += __shfl_xor(ss, 2); ss += __shfl_xor(ss, 4); ss += __shfl_xor(ss, 8);
                const float rstd = rsqrtf(ss * (1.f / 64.f) + EPS);
                const float* g = p.in[isq ? 14 : 15] + layer * 64 + d;
#pragma unroll
                for (int j = 0; j < 4; ++j) v[j] = v[j] * rstd * g[j];
                float pr[4];
#pragma unroll
                for (int j = 0; j < 4; ++j) pr[j] = __shfl_xor(v[j], 8);
                if (lat) {
#pragma unroll
                    for (int j = 0; j < 4; ++j) { const int ii = (d + j) & 31; const float cs = rc[s * 32 + ii], sn = rs[s * 32 + ii]; v[j] = d < 32 ? v[j] * cs - pr[j] * sn : pr[j] * sn + v[j] * cs; }
                }
                if (isq) { u32x2 o; o.x = pk2(v[0] * QSCALE, v[1] * QSCALE); o.y = pk2(v[2] * QSCALE, v[3] * QSCALE); *(u32x2*)((bf16*)(p.ws + WS_ATTQ) + (size_t)r * 512 + cc) = o; }
                else { const int key = lat ? CTX + s : s; u32x2 o; o.x = pk2(v[0], v[1]); o.y = pk2(v[2], v[3]); *(u32x2*)((bf16*)(p.ws + WS_ATTK) + ((size_t)b * KEYS + key) * 128 + cc) = o; }
            } else if (n0 < 2048) {
                const int key = lat ? CTX + s : s; u32x2 o; o.x = pk2(v[0], v[1]); o.y = pk2(v[2], v[3]);
                *(u32x2*)((bf16*)(p.ws + WS_ATTV) + ((size_t)b * KEYS + key) * 128 + (c0 - 1920)) = o;
            } else if (n0 < 2560) {
                u32x2 o; o.x = pk2(v[0], v[1]); o.y = pk2(v[2], v[3]); *(u32x2*)((bf16*)(p.ws + WS_CONV) + (size_t)r * 512 + (c0 - 2048)) = o;
            } else {
                u32x2 o; o.x = pk2(sigmoidf_(v[0]), sigmoidf_(v[1])); o.y = pk2(sigmoidf_(v[2]), sigmoidf_(v[3]));
                *(u32x2*)((bf16*)(p.ws + WS_G) + (size_t)r * 4096 + (c0 - 2560)) = o;
            }
        }
    }
    __syncthreads();
}

__device__ __forceinline__ void conv_item(const P& p, LAS unsigned char* lds, int layer, int seqid, int t0) {
    const int tid = threadIdx.x; LAS float* y = (LAS float*)lds;
    const int L = seqid < 2 ? SEQ : CTX; const int rbase = seqid < 2 ? seqid * SEQ : NLAT + (seqid - 2) * CTX;
    const bf16* cv = (const bf16*)(p.ws + WS_CONV);
    __syncthreads();
    for (int e = tid; e < 94 * 256; e += NTHREADS) { const int tt = e >> 8, ch = e & 255, t = t0 - 15 + tt; float val = 0.f;
        if (t >= 0 && t < L) { const bf16* rowp = cv + (size_t)(rbase + t) * 512; val = bf2f(rowp[ch]) * sigmoidf_(bf2f(rowp[256 + ch])); }
        y[e] = val; }
    __syncthreads();
    if (tid < 256) {
        const int ch = tid;
        float w[31];
#pragma unroll
        for (int k = 0; k < 31; ++k) w[k] = p.in[17][(size_t)layer * 31 * 256 + k * 256 + ch];
        const float bias = p.in[18][layer * 256 + ch];
#pragma unroll 1
        for (int t = 0; t < 64; ++t) { float a = bias;
#pragma unroll
            for (int k = 0; k < 31; ++k) a += y[(t + k) * 256 + ch] * w[k];
            y[t * 256 + ch] = a; }
    }
    __syncthreads();
    const int wv = tid >> 6, lane = tid & 63;
    const f32x4 g = *(const f32x4*)(p.in[19] + layer * 256 + lane * 4), bb = *(const f32x4*)(p.in[20] + layer * 256 + lane * 4);
    for (int q = 0; q < 8; ++q) { const int t = wv * 8 + q;
        const f32x4 v = *(const LAS f32x4*)(y + t * 256 + lane * 4);
        const float mu = wave_sum(v.x + v.y + v.z + v.w) * (1.f / 256.f);
        const f32x4 dv = v - mu; const float var = wave_sum(dv.x * dv.x + dv.y * dv.y + dv.z * dv.z + dv.w * dv.w) * (1.f / 256.f);
        const float rstd = rsqrtf(var + EPS);
        f32x4 z = dv * rstd * g + bb;
        u32x2 ov; ov.x = pk2(siluf_(z.x), siluf_(z.y)); ov.y = pk2(siluf_(z.z), siluf_(z.w));
        *(u32x2*)((bf16*)(p.ws + WS_X) + (size_t)(rbase + t0 + t) * 1536 + 1280 + lane * 4) = ov; }
}

__device__ __forceinline__ void fft1_item(const P& p, LAS unsigned char* lds, int it) {
    const int tid = threadIdx.x; LAS float* u = (LAS float*)lds;
    LAS float* tc = u + 512; LAS float* tsn = tc + 128;
    const int b = it >> 12, ch = (it >> 4) & 255, n2g = it & 15;
    const bf16* ut = (const bf16*)(p.ws + WS_UT) + ((size_t)(b * 256 + ch) * 64 + n2g * 4) * 256;
    __syncthreads();
    { const int q = tid >> 7, n1 = tid & 127; u[tid] = bf2f(ut[q * 256 + n1]); if (tid < 128) { tc[tid] = cospif(tid * (2.f / 128.f)); tsn[tid] = sinpif(tid * (2.f / 128.f)); } }
    __syncthreads();
    const int k1 = tid & 127, q = tid >> 7, n2 = n2g * 4 + q;
    float yr = 0.f, yi = 0.f;
#pragma unroll 4
    for (int n1 = 0; n1 < 128; ++n1) { const int m = (k1 * n1) & 127; const float x = u[q * 128 + n1]; yr += tc[m] * x; yi -= tsn[m] * x; }
    const int mt = k1 * n2;
    const float ct = cospif(mt * (2.f / 8192.f)), st = sinpif(mt * (2.f / 8192.f));
    const float zr = yr * ct + yi * st, zi = yi * ct - yr * st;
    bf16* z = (bf16*)(p.ws + WS_Z) + ((size_t)b * 32768 + k1 * 256 + ch) * 256;
    z[n2] = f2bf(zr); z[64 + n2] = f2bf(zi);
}
__device__ __forceinline__ void fft3_item(const P& p, LAS unsigned char* lds, int it) {
    const int tid = threadIdx.x; LAS float* zz = (LAS float*)lds;
    LAS float* tc = zz + 1024; LAS float* tsn = tc + 64;
    const int b = it >> 12, k1 = (it >> 5) & 127, chg = it & 31;
    const bf16* z = (const bf16*)(p.ws + WS_Z) + ((size_t)b * 32768 + k1 * 256 + chg * 8) * 256;
    __syncthreads();
    for (int e = tid; e < 1024; e += NTHREADS) zz[e] = bf2f(z[(e >> 7) * 256 + (e & 127)]);
    if (tid < 64) { tc[tid] = cospif(tid * (2.f / 64.f)); tsn[tid] = sinpif(tid * (2.f / 64.f)); }
    __syncthreads();
    const int k2 = tid & 63, cl = tid >> 6;
    float r1 = 0.f, r2 = 0.f;
#pragma unroll 4
    for (int n2 = 0; n2 < 64; ++n2) { const int m = (k2 * n2) & 63; const float zr = zz[cl * 128 + n2], zi = zz[cl * 128 + 64 + n2]; r1 += tc[m] * zr + tsn[m] * zi; r2 += tsn[m] * zr - tc[m] * zi; }
    bf16* x = (bf16*)(p.ws + WS_X) + (size_t)(b * SEQ + k1 + 128 * k2) * 1536 + chg * 8 + cl;
    x[0] = f2bf(r1); x[256] = f2bf(r2);
}
__device__ __forceinline__ void fftc_item(const P& p, LAS unsigned char* lds, int it) {
    const int tid = threadIdx.x; LAS float* u = (LAS float*)lds; LAS float* tc = u + 256; LAS float* tsn = tc + 256;
    const int b = it >> 8, ch = it & 255;
    const bf16* utc = (const bf16*)(p.ws + WS_UTC) + (size_t)(b * 256 + ch) * 256;
    __syncthreads();
    if (tid < 256) { u[tid] = bf2f(utc[tid]); tc[tid] = cospif(tid * (2.f / 256.f)); tsn[tid] = sinpif(tid * (2.f / 256.f)); }
    __syncthreads();
    const int k = tid & 255, c2 = tid >> 8; float a = 0.f;
#pragma unroll 4
    for (int n = 0; n < 256; ++n) { const int m = (k * n) & 255; a += (c2 == 0 ? tc[m] : tsn[m]) * u[n]; }
    ((bf16*)(p.ws + WS_X))[(size_t)(NLAT + b * CTX + k) * 1536 + c2 * 256 + ch] = f2bf(a * sqrtf(32.f));
}

__device__ __forceinline__ int chunk_row0(int b, int n) { return n < 2 ? NLAT + b * CTX + n * 128 : b * SEQ + (n - 2) * 128; }
__device__ __forceinline__ float log_sigmoid(float x) { return x >= 0.f ? -log1pf(expf(-x)) : x - log1pf(expf(x)); }
__device__ __forceinline__ void ret_kv_item(const P& p, LAS unsigned char* lds, int layer, int it) {
    const int tid = threadIdx.x; const int h = it & 3, n = (it >> 2) % NCHUNK, b = (it >> 2) / NCHUNK;
    LAS float* Ks = (LAS float*)lds; LAS float* Vs = Ks + 128 * 64; LAS float* zf = Vs + 128 * 64; LAS float* zb = zf + 128;
    const int r0 = chunk_row0(b, n);
    const bf16* K = (const bf16*)(p.ws + WS_RETK) + (size_t)r0 * 256 + h * 64; const bf16* V = (const bf16*)(p.ws + WS_RETV) + (size_t)r0 * 256 + h * 64;
    const float lgf = log_sigmoid(p.in[10][layer * 4 + h]), lgb = log_sigmoid(p.in[11][layer * 4 + h]);
    __syncthreads();
    for (int e = tid; e < 128 * 64; e += NTHREADS) { const int j = e >> 6, d = e & 63; Ks[e] = bf2f(K[(size_t)j * 256 + d]); Vs[e] = bf2f(V[(size_t)j * 256 + d]); }
    if (tid < 128) { zf[tid] = expf((127.f - tid) * lgf); zb[tid] = expf((float)tid * lgb); }
    __syncthreads();
    const int d = tid >> 3, e0 = (tid & 7) * 8;
    float af[8], ab[8];
#pragma unroll
    for (int e = 0; e < 8; ++e) { af[e] = 0.f; ab[e] = 0.f; }
#pragma unroll 4
    for (int j = 0; j < 128; ++j) { const float k = Ks[j * 64 + d], kf = k * zf[j], kb = k * zb[j];
#pragma unroll
        for (int e = 0; e < 8; ++e) { const float v = Vs[j * 64 + e0 + e]; af[e] += kf * v; ab[e] += kb * v; } }
    float* S = (float*)(p.ws + WS_RETS);
    float* sf = S + ((size_t)((0 * 2 + b) * NCHUNK + n) * 4 + h) * 4096 + d * 64 + e0; float* sb = S + ((size_t)((1 * 2 + b) * NCHUNK + n) * 4 + h) * 4096 + d * 64 + e0;
#pragma unroll
    for (int e = 0; e < 8; ++e) { sf[e] = af[e]; sb[e] = ab[e]; }
}
__device__ __forceinline__ void ret_scan_item(const P& p, int layer, int it) {
    const int e = it * NTHREADS + threadIdx.x;
    const int de = e & 4095, h = (e >> 12) & 3, b = (e >> 14) & 1, dir = e >> 15;
    const float lg = log_sigmoid(p.in[dir == 0 ? 10 : 11][layer * 4 + h]); const float g = expf(128.f * lg);
    float* S = (float*)(p.ws + WS_RETS) + (size_t)((dir * 2 + b) * NCHUNK) * 4 * 4096 + (size_t)h * 4096 + de;
    float st = 0.f;
    for (int i = 0; i < NCHUNK; ++i) {
        int n;
        if (dir == 0) n = i; else n = i < 2 ? 1 - i : NCHUNK + 1 - i;
        float* q = S + (size_t)n * 4 * 4096; const float kv = *q; *q = st; st = st * g + kv;
    }
}
__device__ __forceinline__ void ret_out_item(const P& p, LAS unsigned char* lds, int layer, int it) {
    const int tid = threadIdx.x; const int h = it & 3, n = (it >> 2) % NCHUNK, b = (it >> 2) / NCHUNK;
    LAS float* Qs = (LAS float*)lds; LAS float* Ks = Qs + 8192; LAS float* Vs = Ks + 8192; LAS float* Sf = Vs + 8192; LAS float* Sb = Sf + 4096;
    LAS float* At = Sb + 4096; LAS float* pf = At + 32 * 128; LAS float* pb = pf + 132;
    const int r0 = chunk_row0(b, n);
    const bf16* Q = (const bf16*)(p.ws + WS_RETQ) + (size_t)r0 * 256 + h * 64; const bf16* K = (const bf16*)(p.ws + WS_RETK) + (size_t)r0 * 256 + h * 64;
    const bf16* V = (const bf16*)(p.ws + WS_RETV) + (size_t)r0 * 256 + h * 64; const bf16* G = (const bf16*)(p.ws + WS_RETG) + (size_t)r0 * 256 + h * 64;
    const float lgf = log_sigmoid(p.in[10][layer * 4 + h]), lgb = log_sigmoid(p.in[11][layer * 4 + h]);
    const float* S = (const float*)(p.ws + WS_RETS);
    const float* sfp = S + ((size_t)((0 * 2 + b) * NCHUNK + n) * 4 + h) * 4096; const float* sbp = S + ((size_t)((1 * 2 + b) * NCHUNK + n) * 4 + h) * 4096;
    __syncthreads();
    for (int e = tid; e < 8192; e += NTHREADS) { const int j = e >> 6, d = e & 63; Qs[e] = bf2f(Q[(size_t)j * 256 + d]); Ks[e] = bf2f(K[(size_t)j * 256 + d]); Vs[e] = bf2f(V[(size_t)j * 256 + d]); }
    for (int e = tid; e < 4096; e += NTHREADS) { Sf[e] = sfp[e]; Sb[e] = sbp[e]; }
    if (tid <= 128) { pf[tid] = expf((float)tid * lgf); pb[tid] = expf((float)tid * lgb); }
    __syncthreads();
    const float* rg = p.in[12] + layer * 256 + h * 64;
    for (int pass = 0; pass < 4; ++pass) {
        { const int il = tid >> 4, i = pass * 32 + il, j0 = (tid & 15) * 8;
#pragma unroll
          for (int jj = 0; jj < 8; ++jj) { const int j = j0 + jj; float s = 0.f;
#pragma unroll 8
              for (int d = 0; d < 64; ++d) s += Qs[i * 64 + d] * Ks[j * 64 + d];
              const float dm = i > j ? pf[i - j] : (i < j ? pb[j - i] : 2.f);
              At[il * 128 + j] = s * dm; } }
        __syncthreads();
        { const int il = tid >> 4, i = pass * 32 + il, e0 = (tid & 15) * 4;
          float o[4] = {0.f, 0.f, 0.f, 0.f};
#pragma unroll 4
          for (int j = 0; j < 128; ++j) { const float a = At[il * 128 + j];
#pragma unroll
              for (int e = 0; e < 4; ++e) o[e] += a * Vs[j * 64 + e0 + e]; }
          const float xf = pf[i + 1], xb = pb[128 - i];
#pragma unroll 4
          for (int d = 0; d < 64; ++d) { const float q = Qs[i * 64 + d], qf = q * xf, qb = q * xb;
#pragma unroll
              for (int e = 0; e < 4; ++e) o[e] += qf * Sf[d * 64 + e0 + e] + qb * Sb[d * 64 + e0 + e]; }
          float ss = o[0] * o[0] + o[1] * o[1] + o[2] * o[2] + o[3] * o[3];
          ss += __shfl_xor(ss, 1); ss += __shfl_xor(ss, 2); ss += __shfl_xor(ss, 4); ss += __shfl_xor(ss, 8);
          const float rstd = rsqrtf(ss * (1.f / 64.f) + EPS);
          float y[4];
#pragma unroll
          for (int e = 0; e < 4; ++e) { const float gt = bf2f(G[(size_t)i * 256 + e0 + e]); y[e] = o[e] * rstd * rg[e0 + e] * siluf_(gt); }
          u32x2 ov; ov.x = pk2(y[0], y[1]); ov.y = pk2(y[2], y[3]);
          *(u32x2*)((bf16*)(p.ws + WS_X) + (size_t)(r0 + i) * 1536 + 512 + h * 64 + e0) = ov; }
        __syncthreads();
    }
}

__device__ __forceinline__ void attn_item(const P& p, LAS unsigned char* lds, int b, int kvh, int row0  , int nkeys) {
    const int tid = threadIdx.x, g = tid >> 7, qi = tid & 127;
    LAS float* Ks = (LAS float*)lds; LAS float* Vs = Ks + 64 * 64;
    const bf16* Q = (const bf16*)(p.ws + WS_ATTQ) + (size_t)(row0 + qi) * 512 + (kvh * 4 + g) * 64;
    const bf16* K = (const bf16*)(p.ws + WS_ATTK) + (size_t)b * KEYS * 128 + kvh * 64; const bf16* V = (const bf16*)(p.ws + WS_ATTV) + (size_t)b * KEYS * 128 + kvh * 64;
    unsigned qp[32]; float o[64];
#pragma unroll
    for (int d = 0; d < 32; ++d) qp[d] = *(const unsigned*)(Q + 2 * d);
#pragma unroll
    for (int d = 0; d < 64; ++d) o[d] = 0.f;
    float m = -INFINITY, l = 0.f;
    for (int k0 = 0; k0 < nkeys; k0 += 64) {
        __syncthreads();
        for (int e = tid; e < 64 * 32; e += NTHREADS) { const int j = e >> 5, d2 = (e & 31) * 2; const unsigned kw = *(const unsigned*)(K + (size_t)(k0 + j) * 128 + d2), vw = *(const unsigned*)(V + (size_t)(k0 + j) * 128 + d2);
            Ks[j * 64 + d2] = __uint_as_float(kw << 16); Ks[j * 64 + d2 + 1] = __uint_as_float(kw & 0xffff0000u); Vs[j * 64 + d2] = __uint_as_float(vw << 16); Vs[j * 64 + d2 + 1] = __uint_as_float(vw & 0xffff0000u); }
        __syncthreads();
#pragma unroll 2
        for (int j = 0; j < 64; ++j) {
            float a = 0.f;
#pragma unroll
            for (int d = 0; d < 64; d += 4) { const f32x4 kk = *(const LAS f32x4*)(Ks + j * 64 + d);
                a += __uint_as_float(qp[d >> 1] << 16) * kk.x + __uint_as_float(qp[d >> 1] & 0xffff0000u) * kk.y + __uint_as_float(qp[(d >> 1) + 1] << 16) * kk.z + __uint_as_float(qp[(d >> 1) + 1] & 0xffff0000u) * kk.w; }
            if (a > m) { const float alpha = exp2f(m - a); m = a; l *= alpha;
#pragma unroll
                for (int d = 0; d < 64; ++d) o[d] *= alpha; }
            const float pj = exp2f(a - m); l += pj;
#pragma unroll
            for (int d = 0; d < 64; d += 4) { const f32x4 vv = *(const LAS f32x4*)(Vs + j * 64 + d); o[d] += pj * vv.x; o[d + 1] += pj * vv.y; o[d + 2] += pj * vv.z; o[d + 3] += pj * vv.w; }
        }
    }
    const float rl = 1.f / l;
    bf16* X = (bf16*)(p.ws + WS_X) + (size_t)(row0 + qi) * 1536 + 768 + (kvh * 4 + g) * 64;
#pragma unroll
    for (int d = 0; d < 64; d += 2) *(unsigned*)(X + d) = pk2(o[d] * rl, o[d + 1] * rl);
}

__device__ __forceinline__ void ph_mix1(const P& p, LAS unsigned char* lds, int layer) {
    const int nconv = layer == 0 ? 264 : 256, nfc = layer == 0 ? 512 : 0;
    const int n0 = nconv, n1 = n0 + NB * NCHUNK * 4, n2 = n1 + 8192, n3 = n2 + nfc;
    for (int it = blockIdx.x; it < n3; it += gridDim.x) {
        if (it < n0) { if (it < 256) conv_item(p, lds, layer, it >> 7, (it & 127) * 64); else conv_item(p, lds, layer, 2 + ((it - 256) >> 2), ((it - 256) & 3) * 64); }
        else if (it < n1) ret_kv_item(p, lds, layer, it - n0);
        else if (it < n2) fft1_item(p, lds, it - n1);
        else fftc_item(p, lds, it - n2);
    }
    __syncthreads();
}
__device__ __forceinline__ void ph_mix2(const P& p, LAS unsigned char* lds, int layer) {
    const int natt = 256 + (layer == 0 ? 8 : 0);
    const int n0 = natt, n1 = n0 + 128, n2 = n1 + 8192;
    for (int it = blockIdx.x; it < n2; it += gridDim.x) {
        if (it < 256) { const int b = it >> 7, kvh = (it >> 6) & 1, qt = it & 63; attn_item(p, lds, b, kvh, b * SEQ + qt * 128, KEYS); }
        else if (it < n0) { const int j = it - 256, b = j >> 2, kvh = (j >> 1) & 1, qt = j & 1; attn_item(p, lds, b, kvh, NLAT + b * CTX + qt * 128, CTX); }
        else if (it < n1) ret_scan_item(p, layer, it - n0);
        else fft3_item(p, lds, it - n1);
    }
    __syncthreads();
}
__device__ __forceinline__ void ph_mix3(const P& p, LAS unsigned char* lds, int layer) {
    for (int it = blockIdx.x; it < NB * NCHUNK * 4; it += gridDim.x) {
        const int n = (it >> 2) % NCHUNK; if (layer == 1 && n < 2) continue;
        ret_out_item(p, lds, layer, it);
    }
    __syncthreads();
}

__device__ __forceinline__ void ph_merge(const P& p, LAS unsigned char* lds, int layer, int nrows) {
    const int tid = threadIdx.x, ty = tid >> 4, tx = tid & 15;
    const bf16* X = (const bf16*)(p.ws + WS_X); const bf16* WB = (const bf16*)(p.ws + WS_WB) + (size_t)layer * 1024 * 1536;
    const bf16* G = (const bf16*)(p.ws + WS_G); bf16* Mg = (bf16*)(p.ws + WS_MERGED);
    const int ntn = 1024 / 64, ntm = nrows / 128;
    for (int it = blockIdx.x; it < ntm * ntn; it += gridDim.x) {
        const int r0 = (it / ntn) * 128, n0 = (it % ntn) * 64;
        float tot[4][4];
#pragma unroll
        for (int i = 0; i < 4; ++i)
#pragma unroll
            for (int j = 0; j < 4; ++j) tot[i][j] = 0.f;
#pragma unroll 1
        for (int br = 0; br < 4; ++br) {
            const int koff = br == 0 ? 0 : (br == 1 ? 512 : (br == 2 ? 768 : 1280)), klen = (br & 1) ? 256 : 512;
            float acc[4][4];
            gemm_tile_naive(GEMM_LDS_AS(lds), GEMM_LDS_BS(lds), X + (size_t)r0 * 1536 + koff, 1536, WB + (size_t)n0 * 1536 + koff, 1536, klen, acc);
#pragma unroll
            for (int i = 0; i < 4; ++i) { const int r = r0 + ty * 4 + i; const u32x2 gw = *(const u32x2*)(G + (size_t)r * 4096 + br * 1024 + n0 + tx * 4);
                tot[i][0] += acc[i][0] * __uint_as_float(gw.x << 16); tot[i][1] += acc[i][1] * __uint_as_float(gw.x & 0xffff0000u);
                tot[i][2] += acc[i][2] * __uint_as_float(gw.y << 16); tot[i][3] += acc[i][3] * __uint_as_float(gw.y & 0xffff0000u); }
        }
#pragma unroll
        for (int i = 0; i < 4; ++i) { u32x2 o; o.x = pk2(tot[i][0], tot[i][1]); o.y = pk2(tot[i][2], tot[i][3]); *(u32x2*)(Mg + (size_t)(r0 + ty * 4 + i) * 1024 + n0 + tx * 4) = o; }
    }
    __syncthreads();
}
__device__ __forceinline__ void ph_gemm_resid(const P& p, LAS unsigned char* lds, int layer, const bf16* A, int lda, const bf16* Bt, int K, int chunk, int nrows) {
    const int tid = threadIdx.x, ty = tid >> 4, tx = tid & 15;
    const int ntn = 1024 / 64, ntm = nrows / 128;
    for (int it = blockIdx.x; it < ntm * ntn; it += gridDim.x) {
        const int r0 = (it / ntn) * 128, n0 = (it % ntn) * 64;
        float acc[4][4];
        gemm_tile_naive(GEMM_LDS_AS(lds), GEMM_LDS_BS(lds), A + (size_t)r0 * lda, lda, Bt + (size_t)n0 * K, K, K, acc);
#pragma unroll
        for (int i = 0; i < 4; ++i) { const int r = r0 + ty * 4 + i, c = n0 + tx * 4; float* h = hrow(p, r) + c; const f32x4 g = *(const f32x4*)(mods(p, layer, row_mi(r), chunk) + c);
            f32x4 hv = *(f32x4*)h; hv.x += g.x * acc[i][0]; hv.y += g.y * acc[i][1]; hv.z += g.z * acc[i][2]; hv.w += g.w * acc[i][3]; *(f32x4*)h = hv; }
    }
    __syncthreads();
}
__device__ __forceinline__ void ph_gemm_swiglu(const P& p, LAS unsigned char* lds, const bf16* A, const bf16* Bt, bf16* Hm, int nrows, const int* tile_e  ) {
    const int tid = threadIdx.x, ty = tid >> 4, tx = tid & 15;
    const int ntn = 5632 / 64, ntm = nrows / 128;
    for (int it = blockIdx.x; it < ntm * ntn; it += gridDim.x) {
        const int r0 = (it / ntn) * 128, n0 = (it % ntn) * 64;
        const bf16* B = Bt + (tile_e ? (size_t)tile_e[r0 >> 8] * 5632 * D : 0);
        float acc[4][4];
        gemm_tile_naive(GEMM_LDS_AS(lds), GEMM_LDS_BS(lds), A + (size_t)r0 * D, D, B + (size_t)n0 * D, D, D, acc);
#pragma unroll
        for (int i = 0; i < 4; ++i) {
            float up[4];
#pragma unroll
            for (int j = 0; j < 4; ++j) up[j] = __shfl_xor(acc[i][j], 1);
            if ((tx & 1) == 0) { const int r = r0 + ty * 4 + i, j0 = (n0 + tx * 4) >> 1;
                u32x2 o; o.x = pk2(siluf_(acc[i][0]) * up[0], siluf_(acc[i][1]) * up[1]); o.y = pk2(siluf_(acc[i][2]) * up[2], siluf_(acc[i][3]) * up[3]);
                *(u32x2*)(Hm + (size_t)r * FFN + j0) = o; }
        }
    }
    __syncthreads();
}
__device__ __forceinline__ int moe_tiles(const P& p, LAS int* tile_e) {
    const unsigned* ctl = (const unsigned*)(p.ws + WS_CTL); int t = 0;
    for (int e = 0; e < NEXP; ++e) { const int c = (int)ctl[CW_CNT + e], nt = (c + 255) >> 8; for (int q = 0; q < nt; ++q) { if (threadIdx.x == 0) tile_e[t + q] = e; } t += nt; }
    __syncthreads();
    return t;
}
__device__ __forceinline__ void ph_assign(const P& p) {
    const unsigned* ctlr = (const unsigned*)(p.ws + WS_CTL); unsigned* ctl = (unsigned*)(p.ws + WS_CTL);
    int pstart[NEXP]; int t = 0;
#pragma unroll
    for (int e = 0; e < NEXP; ++e) { pstart[e] = t * 256; t += ((int)ctlr[CW_CNT + e] + 255) >> 8; }
    const int* tok_e = (const int*)(p.ws + WS_ROUTE); int* tok_slot = (int*)(p.ws + WS_ROUTE) + 16384 * 4; int* slot_tok = (int*)(p.ws + WS_ROUTE) + 16384 * 6;
    for (int a = blockIdx.x * NTHREADS + threadIdx.x; a < NLAT * 2; a += gridDim.x * NTHREADS) {
        const int e = tok_e[a]; int ps = 0;
#pragma unroll
        for (int q = 0; q < NEXP; ++q) if (q == e) ps = pstart[q];
        const int slot = ps + (int)atomicAdd(ctl + CW_CUR + e, 1u);
        tok_slot[a] = slot; slot_tok[slot] = a >> 1;
    }
}
__device__ __forceinline__ void ph_gather(const P& p) {
    const int lane = threadIdx.x & 63, gw = blockIdx.x * 8 + (threadIdx.x >> 6), ngw = gridDim.x * 8;
    const int* slot_tok = (const int*)(p.ws + WS_ROUTE) + 16384 * 6; const bf16* A = (const bf16*)(p.ws + WS_A); bf16* FS = (bf16*)(p.ws + WS_FS);
    for (int s = gw; s < MOE_ROWS; s += ngw) { const int tok = slot_tok[s];
#pragma unroll
        for (int q = 0; q < 2; ++q) { u32x4 v = {0u, 0u, 0u, 0u}; if (tok >= 0) v = *(const u32x4*)(A + (size_t)tok * D + (q * 64 + lane) * 8); *(u32x4*)(FS + (size_t)s * D + (q * 64 + lane) * 8) = v; } }
}
__device__ __forceinline__ void ph_moe2(const P& p, LAS unsigned char* lds) {
    const int tid = threadIdx.x, ty = tid >> 4, tx = tid & 15;
    LAS int* tile_e = (LAS int*)(lds + 32768); const int nt = moe_tiles(p, tile_e);
    const bf16* A = (const bf16*)(p.ws + WS_HMOE); bf16* Y = (bf16*)(p.ws + WS_FS);
    const int ntn = 1024 / 64, ntm = nt * 2;
    for (int it = blockIdx.x; it < ntm * ntn; it += gridDim.x) {
        const int r0 = (it / ntn) * 128, n0 = (it % ntn) * 64;
        const bf16* B = (const bf16*)(p.ws + WS_MOE2) + (size_t)tile_e[r0 >> 8] * D * FFN;
        float acc[4][4];
        gemm_tile_naive(GEMM_LDS_AS(lds), GEMM_LDS_BS(lds), A + (size_t)r0 * FFN, FFN, B + (size_t)n0 * FFN, FFN, FFN, acc);
#pragma unroll
        for (int i = 0; i < 4; ++i) { u32x2 o; o.x = pk2(acc[i][0], acc[i][1]); o.y = pk2(acc[i][2], acc[i][3]); *(u32x2*)(Y + (size_t)(r0 + ty * 4 + i) * D + n0 + tx * 4) = o; }
    }
    __syncthreads();
}
__device__ __forceinline__ void ph_combine(const P& p, int layer) {
    const int lane = threadIdx.x & 63, gw = blockIdx.x * 8 + (threadIdx.x >> 6), ngw = gridDim.x * 8;
    const float* tok_w = (const float*)(p.ws + WS_ROUTE) + 16384 * 2; const int* tok_slot = (const int*)(p.ws + WS_ROUTE) + 16384 * 4; const bf16* Y = (const bf16*)(p.ws + WS_FS);
    for (int r = gw; r < NLAT; r += ngw) {
        const int s0 = tok_slot[r * 2], s1 = tok_slot[r * 2 + 1]; const float w0 = tok_w[r * 2], w1 = tok_w[r * 2 + 1];
        const float* g = mods(p, layer, row_mi(r), 5); float* h = p.out + (size_t)r * D;
#pragma unroll
        for (int j = 0; j < 4; ++j) { const int c = 4 * lane + 256 * j;
            const u32x2 a = *(const u32x2*)(Y + (size_t)s0 * D + c), bq = *(const u32x2*)(Y + (size_t)s1 * D + c); const f32x4 gg = *(const f32x4*)(g + c); f32x4 hv = *(f32x4*)(h + c);
            hv.x += gg.x * (w0 * __uint_as_float(a.x << 16) + w1 * __uint_as_float(bq.x << 16)); hv.y += gg.y * (w0 * __uint_as_float(a.x & 0xffff0000u) + w1 * __uint_as_float(bq.x & 0xffff0000u));
            hv.z += gg.z * (w0 * __uint_as_float(a.y << 16) + w1 * __uint_as_float(bq.y << 16)); hv.w += gg.w * (w0 * __uint_as_float(a.y & 0xffff0000u) + w1 * __uint_as_float(bq.y & 0xffff0000u));
            *(f32x4*)(h + c) = hv; }
    }
}

__device__ __forceinline__ void grid_barrier(unsigned* bar, unsigned& epoch) {
    asm volatile("s_waitcnt vmcnt(0)" ::: "memory");
    __syncthreads();
    if (threadIdx.x == 0) {
        __builtin_amdgcn_fence(__ATOMIC_RELEASE, "agent");
        asm volatile("s_waitcnt vmcnt(0)" ::: "memory");
        ++epoch;
        const unsigned target = epoch * gridDim.x;
        __hip_atomic_fetch_add(bar, 1u, __ATOMIC_RELAXED, __HIP_MEMORY_SCOPE_AGENT);
        unsigned spins = 0;
        while (__hip_atomic_load(bar, __ATOMIC_RELAXED, __HIP_MEMORY_SCOPE_AGENT) < target) { __builtin_amdgcn_s_sleep(2); if (++spins > (1u << 26)) break; }
        __builtin_amdgcn_fence(__ATOMIC_ACQUIRE, "agent");
        asm volatile("s_waitcnt vmcnt(0)" ::: "memory");
    } else ++epoch;
    __syncthreads();
}

constexpr int NPHASE = 24;
constexpr int LDS_BYTES = 150 * 1024;
__global__ void __launch_bounds__(NTHREADS, 2) mk(P p, int lo, int hi) {
    extern __shared__ __attribute__((aligned(16))) unsigned char lds_raw[];
    LAS unsigned char* lds = (LAS unsigned char*)lds_raw;
    unsigned* bar = (unsigned*)(p.ws + WS_CTL) + CW_BAR; unsigned epoch = 0;
#define PH(k, body) do { if (lo <= (k) && (k) < hi) { if ((k) > lo) grid_barrier(bar, epoch); body; } } while (0)
#define LAYER_PHASES(L, base) \
    PH(base + 0, ph_win(p, lds, L)); \
    PH(base + 1, ph_mix1(p, lds, L)); \
    PH(base + 2, ph_mix2(p, lds, L)); \
    PH(base + 3, ph_mix3(p, lds, L)); \
    PH(base + 4, ph_merge(p, lds, L, L == 0 ? MROWS : NLAT)); \
    PH(base + 5, ph_gemm_resid(p, lds, L, (const bf16*)(p.ws + WS_MERGED), 1024, (const bf16*)(p.ws + WS_WOUT) + (size_t)L * D * D, D, 2, L == 0 ? MROWS : NLAT));
    PH(0, ph_prologue(p, lds));
    PH(1, ph_norm(p, 0, 0, true, false, MROWS));
    LAYER_PHASES(0, 2)
    PH(8, ph_norm(p, 0, 1, false, false, MROWS));
    PH(9, ph_gemm_swiglu(p, lds, (const bf16*)(p.ws + WS_A), (const bf16*)(p.ws + WS_FFN1), (bf16*)(p.ws + WS_HMID), MROWS, nullptr));
    PH(10, ph_gemm_resid(p, lds, 0, (const bf16*)(p.ws + WS_HMID), FFN, (const bf16*)(p.ws + WS_FFN2), FFN, 5, MROWS));
    PH(11, ph_norm(p, 1, 0, false, false, MROWS));
    LAYER_PHASES(1, 12)
    PH(18, { ph_norm(p, 1, 1, false, true, NLAT); ph_moe_convert(p, lds); });
    PH(19, ph_assign(p));
    PH(20, ph_gather(p));
    PH(21, { LAS int* tile_e = (LAS int*)(lds + 32768); const int nt = moe_tiles(p, tile_e);
             ph_gemm_swiglu(p, lds, (const bf16*)(p.ws + WS_FS), (const bf16*)(p.ws + WS_MOE1), (bf16*)(p.ws + WS_HMOE), nt * 256, (const int*)tile_e); });
    PH(22, ph_moe2(p, lds));
    PH(23, ph_combine(p, 1));
#undef PH
#undef LAYER_PHASES
}

extern "C" void kernel_launch(void* const* d_in, const int* in_sizes, int n_in, void* d_out, int out_size, void* d_ws, size_t ws_size, hipStream_t stream) {
    static int grid = 0;
    if (grid == 0) {
        if (n_in != 30 || out_size != NLAT * D || ws_size < WS_END) { fprintf(stderr, "kernel_launch: unexpected shapes (n_in %d out %d ws %zu)\n", n_in, out_size, ws_size); grid = -1; return; }
        int dev = 0, cus = 0, per_cu = 0;
        hipGetDevice(&dev); hipDeviceGetAttribute(&cus, hipDeviceAttributeMultiprocessorCount, dev);
        hipFuncSetAttribute((const void*)mk, hipFuncAttributeMaxDynamicSharedMemorySize, LDS_BYTES);
        hipOccupancyMaxActiveBlocksPerMultiprocessor(&per_cu, (const void*)mk, NTHREADS, LDS_BYTES);
        if (per_cu < 1) { fprintf(stderr, "kernel_launch: occupancy query says %d blocks per CU\n", per_cu); grid = -1; return; }
        grid = cus;
    }
    if (grid < 0) return;
    hipMemsetAsync((char*)d_ws + WS_CTL, 0, CTL_BYTES, stream);
    P p{};
    for (int i = 0; i < 30; ++i) p.in[i] = (const float*)d_in[i];
    p.out = (float*)d_out; p.ws = (unsigned char*)d_ws;
#if MK_SINGLE
    int lo = 0, hi = NPHASE; void* args[] = {&p, &lo, &hi};
    hipLaunchCooperativeKernel((const void*)mk, dim3(grid), dim3(NTHREADS), args, LDS_BYTES, stream);
#else
    for (int ph = 0; ph < NPHASE; ++ph) hipLaunchKernelGGL(mk, dim3(grid), dim3(NTHREADS), LDS_BYTES, stream, p, ph, ph + 1);
#endif
}
```

```cpp
#include <hip/hip_runtime.h>
#include <hip/hip_cooperative_groups.h>
#include <cstdio>
#include <cstdint>
namespace cg = cooperative_groups;

#ifndef MK_SINGLE
#define MK_SINGLE 1
#endif

typedef unsigned short bf16;
typedef float f32x4 __attribute__((ext_vector_type(4)));
typedef unsigned u32x4 __attribute__((ext_vector_type(4)));
typedef unsigned u32x2 __attribute__((ext_vector_type(2)));
#define LAS __attribute__((address_space(3)))

constexpr int D = 1024, NB = 2, SEQ = 8192, CTX = 256, NLAT = NB * SEQ, NCTX = NB * CTX, MROWS = NLAT + NCTX;
constexpr int INC = 6656, FFN = 2816, NEXP = 8, KEYS = CTX + SEQ;
constexpr int NCHUNK = 66;
constexpr float EPS = 1e-6f;
constexpr float QSCALE = 0.125f * 1.4426950408889634f;
constexpr int MOE_ROWS = 34816;
constexpr int NTHREADS = 512;

constexpr size_t MiB = 1u << 20;
constexpr size_t WS_CTL = 0, CTL_BYTES = 1 * MiB;
constexpr size_t WS_MODS = 1 * MiB;
constexpr size_t WS_ROPE = 2 * MiB;
constexpr size_t WS_F1 = 4 * MiB;
constexpr size_t WS_F2 = WS_F1 + 131072;
constexpr size_t WS_FC = WS_F2 + 131072;
constexpr size_t WS_TW = WS_FC + 262144;
constexpr size_t WS_ROUTE = 5 * MiB;
constexpr size_t WS_HCTX = 6 * MiB;
constexpr size_t WS_WIN = 8 * MiB;
constexpr size_t WS_WB = 34 * MiB;
constexpr size_t WS_WOUT = 40 * MiB;
constexpr size_t WS_FFN1 = 44 * MiB;
constexpr size_t WS_FFN2 = 55 * MiB;
constexpr size_t WS_A = 61 * MiB;
constexpr size_t WS_X = 94 * MiB;
constexpr size_t WS_Y = 144 * MiB;
constexpr size_t WS_RETQ = WS_Y;
constexpr size_t WS_RETK = WS_RETQ + (size_t)MROWS * 256 * 2;
constexpr size_t WS_RETV = WS_RETK + (size_t)MROWS * 256 * 2;
constexpr size_t WS_RETG = WS_RETV + (size_t)MROWS * 256 * 2;
constexpr size_t WS_ATTQ = WS_Y + 33 * MiB;
constexpr size_t WS_ATTK = WS_Y + 50 * MiB;
constexpr size_t WS_ATTV = WS_Y + 55 * MiB;
constexpr size_t WS_CONV = WS_Y + 60 * MiB;
constexpr size_t WS_UT = WS_Y + 77 * MiB;
constexpr size_t WS_UTC = WS_Y + 93 * MiB;
constexpr size_t WS_Z = WS_Y + 94 * MiB;
constexpr size_t WS_RETS = WS_Y + 126 * MiB;
constexpr size_t WS_MERGED = WS_Y + 143 * MiB;
constexpr size_t WS_G = 320 * MiB;
constexpr size_t WS_MOE1 = WS_G;
constexpr size_t WS_MOE2 = WS_G + (size_t)NEXP * 5632 * 1024 * 2;
constexpr size_t WS_HMID = WS_Y;
constexpr size_t WS_HMOE = 61 * MiB;
constexpr size_t WS_FS = 252 * MiB;
constexpr size_t WS_RETS2 = 452 * MiB;
constexpr size_t WS_Y2 = 160 * MiB;
constexpr size_t WS_END = 469 * MiB;
static_assert(WS_MERGED + (size_t)MROWS * 1024 * 2 <= WS_G, "map");
static_assert(WS_HMOE + (size_t)MOE_ROWS * FFN * 2 <= WS_FS && WS_FS + (size_t)MOE_ROWS * 1024 * 2 <= WS_G, "map moe");
static_assert(WS_MOE2 + (size_t)NEXP * 1024 * FFN * 2 <= WS_END, "map moe w");
constexpr int CW_CNT = 64;
constexpr int CW_CUR = 128;
constexpr int CW_BAR = 4096;

struct P {
    const float* in[30];
    float* out;
    unsigned char* ws;
};

__device__ __forceinline__ float bf2f(bf16 v) { return __uint_as_float((unsigned)v << 16); }
__device__ __forceinline__ bf16 f2bf(float f) { unsigned u = __float_as_uint(f); return (bf16)((u + 0x7fffu + ((u >> 16) & 1u)) >> 16); }
__device__ __forceinline__ unsigned pk2(float lo, float hi) { return (unsigned)f2bf(lo) | ((unsigned)f2bf(hi) << 16); }
__device__ __forceinline__ float sigmoidf_(float x) { return 1.f / (1.f + __expf(-x)); }
__device__ __forceinline__ float siluf_(float x) { return x / (1.f + __expf(-x)); }
__device__ __forceinline__ float sigmoid_fast(float x) { return __builtin_amdgcn_rcpf(1.f + __builtin_amdgcn_exp2f(-1.4426950408889634f * x)); }
__device__ __forceinline__ float silu_fast(float x) { return x * __builtin_amdgcn_rcpf(1.f + __builtin_amdgcn_exp2f(-1.4426950408889634f * x)); }
__device__ __forceinline__ float wave_sum(float v) {
#pragma unroll
    for (int o = 1; o < 64; o <<= 1) v += __shfl_xor(v, o);
    return v;
}
__device__ __forceinline__ int row_mi(int r) { return r < NLAT ? (r >> 13) : 2; }
__device__ __forceinline__ float* hrow(const P& p, int r) { return r < NLAT ? p.out + (size_t)r * D : (float*)(p.ws + WS_HCTX) + (size_t)(r - NLAT) * D; }
__device__ __forceinline__ const float* mods(const P& p, int layer, int mi, int chunk) { return (const float*)(p.ws + WS_MODS) + ((size_t)(layer * 3 + mi) * 6 + chunk) * D; }

__device__ __forceinline__ int rowmap(int mode, int n) {
    if (mode == 0) return n;
    if (mode == 1 || mode == 2) return 8 * (n >> 2) + (n & 3) + (mode == 2 ? 4 : 0);
    const int tile = n >> 8, l = n & 255, head = l >> 6, d = l & 63;
    const bool ropet = tile == 1 || tile == 2 || tile == 5 || tile == 6 || (tile == 7 && head < 2);
    if (ropet) { const int i = d & 31, nn = d >> 5; return tile * 256 + 128 * (i >> 4) + 32 * head + 8 * ((i >> 2) & 3) + 4 * nn + (i & 3); }
    if (tile == 7) return tile * 256 + 128 * (d >> 5) + 32 * head + 8 * ((d >> 3) & 3) + (d & 7);
    return n;
}
__device__ __forceinline__ void conv_tile(LAS float* scr, const float* src, int ldn, int k0, int n0, bf16* dst, int ldd, int koff, int mode) {
    const int tid = threadIdx.x;
    __syncthreads();
#pragma unroll
    for (int i = 0; i < 8; ++i) { const int e = tid + i * NTHREADS, kk = e >> 6, nn = e & 63; scr[kk * 65 + nn] = src[(size_t)(k0 + kk) * ldn + n0 + nn]; }
    __syncthreads();
    const int nn = tid >> 3, kc = (tid & 7) * 8;
    u32x4 o; o.x = pk2(scr[(kc + 0) * 65 + nn], scr[(kc + 1) * 65 + nn]); o.y = pk2(scr[(kc + 2) * 65 + nn], scr[(kc + 3) * 65 + nn]);
    o.z = pk2(scr[(kc + 4) * 65 + nn], scr[(kc + 5) * 65 + nn]); o.w = pk2(scr[(kc + 6) * 65 + nn], scr[(kc + 7) * 65 + nn]);
    *(u32x4*)(dst + (size_t)rowmap(mode, n0 + nn) * ldd + koff + k0 + kc) = o;
}
constexpr float F8_WSCALE = 32.f;
__device__ __forceinline__ unsigned pk4_fp8(float a, float b, float c, float d) { int w = 0; w = __builtin_amdgcn_cvt_pk_fp8_f32(a, b, w, false); w = __builtin_amdgcn_cvt_pk_fp8_f32(c, d, w, true); return (unsigned)w; }
__device__ __forceinline__ void conv_tile2_f8(LAS float* scr, const float* src, int ldn, unsigned char* dst8, int ldd, int mode, int k0a, int n0a, int k0b, int n0b, bool two) {
    const int tid = threadIdx.x;
    f32x4 va[2], vb[2];
#pragma unroll
    for (int i = 0; i < 2; ++i) { const int e = tid + i * NTHREADS, kk = e >> 4, n4 = (e & 15) * 4;
        va[i] = *(const f32x4*)(src + (size_t)(k0a + kk) * ldn + n0a + n4);
        if (two) vb[i] = *(const f32x4*)(src + (size_t)(k0b + kk) * ldn + n0b + n4); }
    __syncthreads();
#pragma unroll
    for (int i = 0; i < 2; ++i) { const int e = tid + i * NTHREADS, kk = e >> 4, n4 = (e & 15) * 4;
#pragma unroll
        for (int q = 0; q < 4; ++q) { scr[kk * 65 + n4 + q] = va[i][q]; if (two) scr[64 * 65 + kk * 65 + n4 + q] = vb[i][q]; } }
    __syncthreads();
    const int nn = tid >> 3, kc = (tid & 7) * 8;
#pragma unroll
    for (int t = 0; t < 2; ++t) { if (t == 1 && !two) break; const LAS float* sp = scr + t * 64 * 65; const int k0 = t ? k0b : k0a, n0 = t ? n0b : n0a;
        u32x2 o; o.x = pk4_fp8(sp[(kc + 0) * 65 + nn] * F8_WSCALE, sp[(kc + 1) * 65 + nn] * F8_WSCALE, sp[(kc + 2) * 65 + nn] * F8_WSCALE, sp[(kc + 3) * 65 + nn] * F8_WSCALE);
        o.y = pk4_fp8(sp[(kc + 4) * 65 + nn] * F8_WSCALE, sp[(kc + 5) * 65 + nn] * F8_WSCALE, sp[(kc + 6) * 65 + nn] * F8_WSCALE, sp[(kc + 7) * 65 + nn] * F8_WSCALE);
        *(u32x2*)(dst8 + (size_t)rowmap(mode, n0 + nn) * ldd + k0 + kc) = o; }
}
__device__ __forceinline__ void conv_tile128_f8(LAS float* scr, const float* src, int ldn, unsigned char* dst8, int ldd, int mode, int k0, int n0) {
    const int tid = threadIdx.x;
    f32x4 v[8];
#pragma unroll
    for (int i = 0; i < 8; ++i) { const int e = tid + i * NTHREADS, kk = e >> 5, n4 = (e & 31) * 4; v[i] = *(const f32x4*)(src + (size_t)(k0 + kk) * ldn + n0 + n4); }
    __syncthreads();
#pragma unroll
    for (int i = 0; i < 8; ++i) { const int e = tid + i * NTHREADS, kk = e >> 5, n4 = (e & 31) * 4;
#pragma unroll
        for (int q = 0; q < 4; ++q) scr[kk * 129 + n4 + q] = v[i][q]; }
    __syncthreads();
    const int nn = tid >> 2, kc = (tid & 3) * 32;
    u32x4 o[2];
#pragma unroll
    for (int h = 0; h < 2; ++h) { const LAS float* sp = scr + (kc + h * 16) * 129 + nn;
        o[h].x = pk4_fp8(sp[0] * F8_WSCALE, sp[129] * F8_WSCALE, sp[2 * 129] * F8_WSCALE, sp[3 * 129] * F8_WSCALE);
        o[h].y = pk4_fp8(sp[4 * 129] * F8_WSCALE, sp[5 * 129] * F8_WSCALE, sp[6 * 129] * F8_WSCALE, sp[7 * 129] * F8_WSCALE);
        o[h].z = pk4_fp8(sp[8 * 129] * F8_WSCALE, sp[9 * 129] * F8_WSCALE, sp[10 * 129] * F8_WSCALE, sp[11 * 129] * F8_WSCALE);
        o[h].w = pk4_fp8(sp[12 * 129] * F8_WSCALE, sp[13 * 129] * F8_WSCALE, sp[14 * 129] * F8_WSCALE, sp[15 * 129] * F8_WSCALE); }
    unsigned char* d = dst8 + (size_t)rowmap(mode, n0 + nn) * ldd + k0 + kc;
    *(u32x4*)d = o[0]; *(u32x4*)(d + 16) = o[1];
}
struct CJob { const float* src; int K, N; bf16* dst; int ldd, koff, mode; };
__device__ __forceinline__ CJob get_job(const P& p, int j) {
    CJob c;
    if (j < 10) { const int l = j / 5, t = j % 5; bf16* wb = (bf16*)(p.ws + WS_WB) + (size_t)l * 1024 * 1536;
        if (t == 0) c = CJob{p.in[8] + (size_t)l * D * INC, D, INC, (bf16*)(p.ws + WS_WIN) + (size_t)l * INC * D, D, 0, 3};
        else if (t == 1) c = CJob{p.in[13] + (size_t)l * 256 * D, 256, D, wb, 1536, 512, 0};
        else if (t == 2) c = CJob{p.in[16] + (size_t)l * 512 * D, 512, D, wb, 1536, 768, 0};
        else if (t == 3) c = CJob{p.in[21] + (size_t)l * 256 * D, 256, D, wb, 1536, 1280, 0};
        else c = CJob{p.in[22] + (size_t)l * D * D, D, D, (bf16*)(p.ws + WS_WOUT) + (size_t)l * D * D, D, 0, 0}; }
    else if (j == 10) c = CJob{p.in[23], D, FFN, (bf16*)(p.ws + WS_FFN1), D, 0, 1};
    else if (j == 11) c = CJob{p.in[24], D, FFN, (bf16*)(p.ws + WS_FFN1), D, 0, 2};
    else c = CJob{p.in[25], FFN, D, (bf16*)(p.ws + WS_FFN2), FFN, 0, 0};
    return c;
}
__device__ __forceinline__ CJob get_moe_job(const P& p, int j) {
    const int e = j / 3, t = j % 3; CJob c;
    const float* sg = p.in[27]; const float* su = p.in[28]; const float* sd = p.in[29];
    asm volatile("" : "+s"(sg), "+s"(su), "+s"(sd));
    if (t == 0) c = CJob{sg + (size_t)e * D * FFN, D, FFN, (bf16*)(p.ws + WS_MOE1 + (size_t)e * 5632 * D), D, 0, 1};
    else if (t == 1) c = CJob{su + (size_t)e * D * FFN, D, FFN, (bf16*)(p.ws + WS_MOE1 + (size_t)e * 5632 * D), D, 0, 2};
    else c = CJob{sd + (size_t)e * FFN * D, FFN, D, (bf16*)(p.ws + WS_MOE2 + (size_t)e * D * FFN), FFN, 0, 0};
    return c;
}
template <bool MOE> __device__ __forceinline__ void run_conv_jobs(const P& p, LAS float* scr, int njobs, int bid, int nb) {
    int base = 0, base2 = 0;
    for (int j = 0; j < njobs; ++j) {
        const CJob jb = MOE ? get_moe_job(p, j) : get_job(p, j); const int nn = jb.N / 64, cnt = (jb.K / 64) * nn;
        const int first = ((bid - base) % nb + nb) % nb;
        if (MOE) { const int nn2 = jb.N / 128, cnt2 = (jb.K / 128) * nn2; const int first2 = ((bid - base2) % nb + nb) % nb;
            for (int i = first2; i < cnt2; i += nb) conv_tile128_f8(scr, jb.src, jb.N, (unsigned char*)jb.dst, jb.ldd, jb.mode, (i / nn2) * 128, (i % nn2) * 128);
            base2 += cnt2; }
        else for (int i = first; i < cnt; i += nb) conv_tile(scr, jb.src, jb.N, (i / nn) * 64, (i % nn) * 64, jb.dst, jb.ldd, jb.koff, jb.mode);
        base += cnt;
    }
}
__device__ __forceinline__ void ph_prologue(const P& p, LAS unsigned char* lds) {
    const int tid = threadIdx.x, bid = blockIdx.x, nb = gridDim.x;
    const int gt = bid * NTHREADS + tid, ngt = nb * NTHREADS;
    LAS float* scr = (LAS float*)lds;
    run_conv_jobs<false>(p, scr, 13, bid, nb);
    __syncthreads();
    {
        LAS float* tc = (LAS float*)lds; LAS float* tsn = tc + 64;
        __syncthreads();
        if (tid < 64) { tc[tid] = cospif(tid * (2.f / 64.f)); tsn[tid] = sinpif(tid * (2.f / 64.f)); }
        __syncthreads();
        const float s = 1.0f / sqrtf(64.f * 8192.f);
        for (int e = gt; e < 2 * 512 * 1024; e += ngt) {
            const int n = e & 1023, kk = (e >> 10) & 511, l = e >> 19;
            const int part = kk >> 8, g = (kk >> 6) & 3, c = kk & 63;
            const float* W = p.in[9] + (size_t)l * 256 * D + (size_t)(g * 64) * D + n;
            float acc = 0.f;
#pragma unroll 8
            for (int c2 = 0; c2 < 64; ++c2) { const int m = (c * c2) & 63; const float t = part == 0 ? tc[m] : -tsn[m]; acc += t * W[(size_t)c2 * D]; }
            ((bf16*)(p.ws + WS_WB))[(size_t)l * 1024 * 1536 + (size_t)n * 1536 + kk] = f2bf(acc * s);
        }
        __syncthreads();
    }
    {
        float* rc = (float*)(p.ws + WS_ROPE); float* rs = rc + SEQ * 32;
        for (int e = gt; e < SEQ * 32; e += ngt) {
            const int s = e >> 5, i = e & 31; const float inv = powf(10000.f, -(float)(i & 15) / 16.f);
            const float pos = (float)(i < 16 ? (s >> 6) : (s & 63)); const float ang = pos * inv;
            rc[e] = cosf(ang); rs[e] = sinf(ang);
        }
    }
    {
        bf16* F1 = (bf16*)(p.ws + WS_F1); bf16* F2 = (bf16*)(p.ws + WS_F2); bf16* FC = (bf16*)(p.ws + WS_FC);
        for (int e = gt; e < 256 * 256; e += ngt) {
            const int rho = e >> 8, n1 = e & 255; float v = 0.f;
            if (n1 < 128) { const int k1 = (rho >> 5) * 16 + (rho & 15), c = (rho >> 4) & 1, m = (k1 * n1) & 127; v = c == 0 ? cospif(m * (2.f / 128.f)) : -sinpif(m * (2.f / 128.f)); }
            F1[e] = f2bf(v);
            float w = 0.f;
            if (rho < 128 && n1 < 128) { const int c2 = rho >> 6, k2 = rho & 63, c = n1 >> 6, n2 = n1 & 63, m = (k2 * n2) & 63; const float cs = cospif(m * (2.f / 64.f)), sn = sinpif(m * (2.f / 64.f));
                w = c2 == 0 ? (c == 0 ? cs : sn) : (c == 0 ? sn : -cs); }
            F2[e] = f2bf(w);
        }
        float* TW = (float*)(p.ws + WS_TW);
        for (int e = gt; e < 128 * 64; e += ngt) { const int k1 = e >> 6, n2 = e & 63; TW[2 * e] = cospif((k1 * n2) * (2.f / 8192.f)); TW[2 * e + 1] = sinpif((k1 * n2) * (2.f / 8192.f)); }
        const float sc = sqrtf(32.f);
        for (int e = gt; e < 512 * 256; e += ngt) { const int rho = e >> 8, n = e & 255, c2 = rho >> 8, k = rho & 255, m = (k * n) & 255; FC[e] = f2bf(sc * (c2 == 0 ? cospif(m * (2.f / 256.f)) : sinpif(m * (2.f / 256.f)))); }
    }
    {
        u32x4* ut = (u32x4*)(p.ws + WS_UT); const u32x4 z = {0u, 0u, 0u, 0u};
        for (int e = gt; e < 2 * 256 * 64 * 16; e += ngt) { const int row = e >> 4, q = e & 15; ut[(size_t)row * 32 + 16 + q] = z; }
        u32x4* zz = (u32x4*)(p.ws + WS_Z);
        for (int e = gt; e < 2 * 32768 * 16; e += ngt) { const int row = e >> 4, q = e & 15; zz[(size_t)row * 32 + 16 + q] = z; }
    }
    {
        LAS float* sv = (LAS float*)lds;
        LAS float* red = sv + 3 * 1024;
        __syncthreads();
        for (int e = tid; e < 3 * 1024; e += NTHREADS) { const int j = e >> 10, k = e & 1023; const float v = j < 2 ? p.in[1][j * D + k] : p.in[3][k]; sv[e] = siluf_(v); }
        __syncthreads();
        const int kq = tid >> 6, cl = tid & 63;
        for (int it = bid; it < 2 * 96; it += nb) {
            const int l = it / 96, n = (it % 96) * 64 + cl;
            const float* W = p.in[4] + (size_t)l * D * 6144 + n;
            float a0 = 0.f, a1 = 0.f, a2 = 0.f;
#pragma unroll 16
            for (int k = kq; k < D; k += 8) { const float w = W[(size_t)k * 6144]; a0 += sv[k] * w; a1 += sv[1024 + k] * w; a2 += sv[2048 + k] * w; }
            red[(kq * 3 + 0) * 64 + cl] = a0; red[(kq * 3 + 1) * 64 + cl] = a1; red[(kq * 3 + 2) * 64 + cl] = a2;
            __syncthreads();
            if (tid < 192) { const int j = tid >> 6; float s = 0.f;
#pragma unroll
                for (int q = 0; q < 8; ++q) s += red[(q * 3 + j) * 64 + cl];
                ((float*)(p.ws + WS_MODS))[(size_t)(l * 3 + j) * 6144 + n] = s + p.in[5][l * 6144 + n]; }
            __syncthreads();
        }
    }
}
__device__ __forceinline__ void ph_moe_convert(const P& p, LAS unsigned char* lds) {
    LAS float* scr = (LAS float*)lds;
    const int bid = blockIdx.x, nb = gridDim.x;
    run_conv_jobs<true>(p, scr, 24, bid, nb);
    __syncthreads();
}

__device__ __forceinline__ void ph_norm(const P& p, LAS unsigned char* lds, int layer, int which, bool first, bool route, int nrows) {
    LAS unsigned* cnt_lds = (LAS unsigned*)lds;
    if (route) { __syncthreads(); if (threadIdx.x < NEXP) cnt_lds[threadIdx.x] = 0u; __syncthreads(); }
    const int lane = threadIdx.x & 63, gw = blockIdx.x * 8 + (threadIdx.x >> 6), ngw = gridDim.x * 8;
    const float* gain = p.in[which == 0 ? 6 : 7] + layer * D;
    bf16* A = (bf16*)(p.ws + WS_A);
    for (int r = gw; r < nrows; r += ngw) {
        const int mi = row_mi(r);
        const float* src = first ? (r < NLAT ? p.in[0] + (size_t)r * D : p.in[2] + (size_t)(r - NLAT) * D) : hrow(p, r);
        const float* shift = mods(p, layer, mi, which == 0 ? 0 : 3); const float* scale = mods(p, layer, mi, which == 0 ? 1 : 4);
        f32x4 v[4]; float ss = 0.f;
#pragma unroll
        for (int j = 0; j < 4; ++j) { v[j] = *(const f32x4*)(src + 4 * lane + 256 * j); ss += v[j].x * v[j].x + v[j].y * v[j].y + v[j].z * v[j].z + v[j].w * v[j].w; }
        if (first) { float* h = hrow(p, r);
#pragma unroll
            for (int j = 0; j < 4; ++j) *(f32x4*)(h + 4 * lane + 256 * j) = v[j]; }
        const float rstd = rsqrtf(wave_sum(ss) * (1.f / D) + EPS);
        float lg[8];
#pragma unroll
        for (int e = 0; e < 8; ++e) lg[e] = 0.f;
#pragma unroll
        for (int j = 0; j < 4; ++j) {
            const int c = 4 * lane + 256 * j;
            const f32x4 g = *(const f32x4*)(gain + c), sc = *(const f32x4*)(scale + c), sh = *(const f32x4*)(shift + c);
            f32x4 y = v[j] * rstd * g * (sc + 1.f) + sh;
            u32x2 o; o.x = pk2(y.x, y.y); o.y = pk2(y.z, y.w);
            *(u32x2*)(A + (size_t)r * D + c) = o;
            if (route) {
                const float* rw = p.in[26] + (size_t)c * 8;
#pragma unroll
                for (int q = 0; q < 4; ++q) { const f32x4 w0 = *(const f32x4*)(rw + q * 8), w1 = *(const f32x4*)(rw + q * 8 + 4); const float yy = y[q];
                    lg[0] += yy * w0.x; lg[1] += yy * w0.y; lg[2] += yy * w0.z; lg[3] += yy * w0.w; lg[4] += yy * w1.x; lg[5] += yy * w1.y; lg[6] += yy * w1.z; lg[7] += yy * w1.w; }
            }
        }
        if (route) {
#pragma unroll
            for (int e = 0; e < 8; ++e) lg[e] = wave_sum(lg[e]);
            if (lane == 0) {
                int e0 = 0; float v0 = lg[0];
#pragma unroll
                for (int e = 1; e < 8; ++e) if (lg[e] > v0) { v0 = lg[e]; e0 = e; }
                int e1 = -1; float v1 = -INFINITY;
#pragma unroll
                for (int e = 0; e < 8; ++e) if (e != e0 && lg[e] > v1) { v1 = lg[e]; e1 = e; }
                const float w0 = 1.f / (1.f + expf(v1 - v0));
                int* tok_e = (int*)(p.ws + WS_ROUTE); float* tok_w = (float*)(p.ws + WS_ROUTE) + 16384 * 2;
                tok_e[r * 2] = e0; tok_e[r * 2 + 1] = e1; tok_w[r * 2] = w0; tok_w[r * 2 + 1] = 1.f - w0;
                __hip_atomic_fetch_add(cnt_lds + e0, 1u, __ATOMIC_RELAXED, __HIP_MEMORY_SCOPE_WORKGROUP); __hip_atomic_fetch_add(cnt_lds + e1, 1u, __ATOMIC_RELAXED, __HIP_MEMORY_SCOPE_WORKGROUP);
            }
        }
    }
    if (route) { __syncthreads(); if (threadIdx.x < NEXP) ((unsigned*)(p.ws + WS_ROUTE) + 16384 * 6)[blockIdx.x * NEXP + threadIdx.x] = cnt_lds[threadIdx.x]; __syncthreads(); }
}

namespace fg {
typedef short bf16x8 __attribute__((ext_vector_type(8)));
constexpr int BM = 256, BK = 64, HALF = 128, HTB = HALF * BK * 2, STAGE_BYTES = 8 * HTB, NXCD = 8, WGM = 8;
__device__ __forceinline__ int lds_byte(int r, int c) { const int st = (r >> 4) * 2 + (c >> 5), rr = r & 15, cc = c & 31, ob = rr * 64 + cc * 2; return st * 1024 + (ob ^ (((ob >> 9) & 1) << 5)); }
__device__ __forceinline__ void stage_rc(int b, int& R, int& C) { const int st = b / 1024, sb = b % 1024, swz = sb ^ (((sb >> 9) & 1) << 5); R = (st >> 1) * 16 + swz / 64; C = (st & 1) * 32 + (swz % 64) / 2; }
__device__ __forceinline__ int perm32(int rho) { const int n = rho >> 4, i = rho & 15; return 8 * (i >> 2) + 4 * n + (i & 3); }
struct Unit { int pm, pn; const char* A; const char* B; int nt, aux; };
__device__ __forceinline__ bool tile_order(int i, int nM, int nN, int G, int c, int& pm, int& pn) {
    const int nwg = nM * nN; const long L = (long)i * G + c; if (L >= nwg) return false;
    int wgid = (int)L; { const int q = nwg / NXCD, r = nwg % NXCD, xcd = wgid % NXCD, off = wgid / NXCD; wgid = (xcd < r ? xcd * (q + 1) : r * (q + 1) + (xcd - r) * q) + off; }
    const int nig = WGM * nN, gid = wgid / nig, fm = gid * WGM, gsz = (nM - fm) < WGM ? (nM - fm) : WGM;
    pm = fm + ((wgid % nig) % gsz); pn = (wgid % nig) / gsz; return true;
}
struct PlainSched {
    const char* Abase; const char* Bbase; int lda, ldb, nM, nN, G, c, nt;
    __device__ __forceinline__ int arow(int R) const { return R; }
    __device__ __forceinline__ int ahalf() const { return HALF; }
    __device__ __forceinline__ bool next(int i, Unit& u) const { if (!tile_order(i, nM, nN, G, c, u.pm, u.pn)) return false;
        u.A = Abase + (size_t)u.pm * BM * lda * 2; u.B = Bbase + (size_t)u.pn * BM * ldb * 2; u.nt = nt; u.aux = 0; return true; }
};
struct ExpertSched {
    const char* Abase; const char* Bbase; int lda, ldb, nM, nN, G, c, nt; const LAS int* tile_e; size_t estride;
    __device__ __forceinline__ int arow(int R) const { return R; }
    __device__ __forceinline__ int ahalf() const { return HALF; }
    __device__ __forceinline__ bool next(int i, Unit& u) const { if (!tile_order(i, nM, nN, G, c, u.pm, u.pn)) return false;
        u.A = Abase + (size_t)u.pm * BM * lda * 2; u.B = Bbase + (size_t)tile_e[u.pm] * estride + (size_t)u.pn * BM * ldb * 2; u.nt = nt; u.aux = 0; return true; }
};
struct WinSched {
    const char* Abase; const char* Bbase; int G, c, mode;
    __device__ __forceinline__ int arow(int R) const { return mode == 0 ? 256 * (R & 15) + 64 * ((R >> 4) & 3) + (R >> 6) : R; }
    __device__ __forceinline__ int ahalf() const { return mode == 0 ? 4096 : HALF; }
    __device__ __forceinline__ bool next(int i, Unit& u) const { if (!tile_order(i, mode == 0 ? 64 : 2, INC / 256, G, c, u.pm, u.pn)) return false;
        const size_t row0 = mode == 0 ? (size_t)((u.pm >> 5) * SEQ + 2 * (u.pm & 31)) : (size_t)(NLAT + u.pm * CTX);
        u.A = Abase + row0 * D * 2; u.B = Bbase + (size_t)u.pn * BM * D * 2; u.nt = D / 64; u.aux = mode; return true; }
};
struct MergeSched {
    const char* Xbase; const char* Wbase; int nM, G, c;
    __device__ __forceinline__ int arow(int R) const { return R; }
    __device__ __forceinline__ int ahalf() const { return HALF; }
    __device__ __forceinline__ bool next(int i, Unit& u) const { if (!tile_order(i >> 2, nM, 4, G, c, u.pm, u.pn)) return false;
        const int br = i & 3, koff = br == 0 ? 0 : (br == 1 ? 512 : (br == 2 ? 768 : 1280));
        u.A = Xbase + ((size_t)u.pm * BM * 1536 + koff) * 2; u.B = Wbase + ((size_t)u.pn * BM * 1536 + koff) * 2; u.nt = (br & 1) ? 4 : 8; u.aux = br; return true; }
};
typedef f32x4 Acc[2][2][4][2];
typedef int i32x4 __attribute__((ext_vector_type(4))); typedef int i32x8 __attribute__((ext_vector_type(8)));
__device__ __forceinline__ i32x8 ld32(const LAS unsigned char* p) { const i32x4 a = *(const LAS i32x4*)p, b = *(const LAS i32x4*)(p + 16); return __builtin_shufflevector(a, b, 0, 1, 2, 3, 4, 5, 6, 7); }
template <class Epi, class Sched, bool F8 = false>
__device__ __forceinline__ void gemm_phase(LAS unsigned char* lds, int lda, int ldb, const Sched& S, const Epi& E) {
    int tid_ = threadIdx.x; asm volatile("" : "+v"(tid_));
    const int tid = tid_, wid = __builtin_amdgcn_readfirstlane(tid >> 6), lane = tid & 63, wr = wid >> 2, wc = wid & 3, fr = lane & 15, fq = lane >> 4;
    unsigned voffA[2], voffB[2];
#pragma unroll
    for (int i = 0; i < 2; ++i) { int R, C; stage_rc(tid * 16 + i * 8192, R, C); const int Rb = Epi::PERM ? ((R & ~31) + perm32(R & 31)) : R;
        voffA[i] = (unsigned)(S.arow(R) * lda + C) * 2u; voffB[i] = (unsigned)(Rb * ldb + C) * 2u; }
    const size_t kstep = (size_t)(BK * 2);
    const size_t hstepA = (size_t)S.ahalf() * lda * 2, hstepB = (size_t)HALF * ldb * 2;
    const unsigned ldsw = (unsigned)wid * 1024u;
    const int aoff = lds_byte(wr * 64 + fr, F8 ? fq * 16 : fq * 8), boff = lds_byte(wc * 32 + fr, F8 ? fq * 16 : fq * 8);
#define FG_SA(b, h) (((b) * 2 + (h)) * HTB)
#define FG_SB(b, h) ((4 + (b) * 2 + (h)) * HTB)
#define FG_STAGE(bufoff, gbase, voff) do { _Pragma("unroll") for (int _i = 0; _i < 2; ++_i) \
        __builtin_amdgcn_global_load_lds((const unsigned*)((const char*)(gbase) + (voff)[_i]), (LAS unsigned*)(lds + (bufoff) + ldsw + _i * 8192), 16, 0, 0); } while (0)
#define FG_LDA(dst, b, h) do { if constexpr (F8) { _Pragma("unroll") for (int m = 0; m < 4; ++m) dst##8[m] = ld32(lds + FG_SA(b, h) + aoff + m * 2048); } \
        else { _Pragma("unroll") for (int m = 0; m < 4; ++m) _Pragma("unroll") for (int k = 0; k < 2; ++k) dst[m][k] = *(const LAS bf16x8*)(lds + FG_SA(b, h) + aoff + m * 2048 + k * 1024); } } while (0)
#define FG_LDB(dst, b, h) do { if constexpr (F8) { _Pragma("unroll") for (int n = 0; n < 2; ++n) dst##8[n] = ld32(lds + FG_SB(b, h) + boff + n * 2048); } \
        else { _Pragma("unroll") for (int n = 0; n < 2; ++n) _Pragma("unroll") for (int k = 0; k < 2; ++k) dst[n][k] = *(const LAS bf16x8*)(lds + FG_SB(b, h) + boff + n * 2048 + k * 1024); } } while (0)
#define FG_MMA(ai, bj, At, Bt) do { __builtin_amdgcn_s_setprio(1); _Pragma("unroll") for (int m = 0; m < 4; ++m) _Pragma("unroll") for (int n = 0; n < 2; ++n) { \
        if constexpr (F8) asm volatile("v_mfma_scale_f32_16x16x128_f8f6f4 %0, %1, %2, %0, %3, %4 op_sel_hi:[0,0,0]" : "+v"(acc[ai][bj][m][n]) : "v"(Bt##8[n]), "v"(At##8[m]), "v"(scw), "v"(sca)); \
        else { _Pragma("unroll") for (int k = 0; k < 2; ++k) acc[ai][bj][m][n] = __builtin_amdgcn_mfma_f32_16x16x32_bf16(Bt[n][k], At[m][k], acc[ai][bj][m][n], 0, 0, 0); } } \
        __builtin_amdgcn_s_setprio(0); } while (0)
#define FG_WAIT_V(n) asm volatile("s_waitcnt vmcnt(" #n ")" ::: "memory")
#define FG_WAIT_L(n) asm volatile("s_waitcnt lgkmcnt(" #n ")" ::: "memory")
#define FG_BAR __builtin_amdgcn_s_barrier()
#define FG_SCHED __builtin_amdgcn_sched_barrier(0)
    Unit cur, nxt; int ui = 0;
    if (!S.next(0, cur)) return;
    Acc acc;
#pragma unroll
    for (int a = 0; a < 2; ++a)
#pragma unroll
        for (int b = 0; b < 2; ++b)
#pragma unroll
            for (int m = 0; m < 4; ++m)
#pragma unroll
                for (int n = 0; n < 2; ++n) acc[a][b][m][n] = (f32x4){0.f, 0.f, 0.f, 0.f};
    bf16x8 At[4][2], B0[2][2], B1[2][2]; i32x8 At8[4], B08[2], B18[2];
    const int scw = 0x7a7a7a7a, sca = 0x7f7f7f7f;
    const char* cA = cur.A; const char* cB = cur.B;
    FG_STAGE(FG_SB(0, 0), cB, voffB); FG_STAGE(FG_SB(0, 1), cB + hstepB, voffB); FG_STAGE(FG_SA(0, 0), cA, voffA); FG_STAGE(FG_SA(0, 1), cA + hstepA, voffA);
    if (wr == 1) FG_BAR;
    FG_WAIT_V(2); FG_BAR;
    FG_STAGE(FG_SB(1, 0), cB + kstep, voffB); FG_STAGE(FG_SA(1, 0), cA + kstep, voffA); FG_STAGE(FG_SB(1, 1), cB + hstepB + kstep, voffB);
    FG_WAIT_V(6); FG_BAR;
    for (;;) {
        const bool has_next = S.next(ui + 1, nxt);
        const char* nA = has_next ? nxt.A : cA; const char* nB = has_next ? nxt.B : cB;
        const int nt = cur.nt;
#pragma unroll 1
        for (int t = 0; t < nt; t += 2) {
            const bool last = (t == nt - 2);
            const char* a1 = cA + (size_t)(t + 1) * kstep;
            const char* a2 = last ? nA : cA + (size_t)(t + 2) * kstep; const char* b2 = last ? nB : cB + (size_t)(t + 2) * kstep;
            const char* a3 = a2 + kstep; const char* b3 = b2 + kstep;
            FG_LDB(B0, 0, 0); FG_LDB(B1, 0, 1); FG_SCHED; FG_LDA(At, 0, 0); FG_STAGE(FG_SA(1, 1), a1 + hstepA, voffA);
            FG_WAIT_V(8); FG_WAIT_L(0); FG_BAR; FG_MMA(0, 0, At, B0); FG_MMA(0, 1, At, B1); FG_BAR; FG_SCHED;
            FG_LDA(At, 0, 1); FG_STAGE(FG_SB(0, 0), b2, voffB); FG_STAGE(FG_SB(0, 1), b2 + hstepB, voffB); FG_STAGE(FG_SA(0, 0), a2, voffA);
            FG_WAIT_V(8); FG_WAIT_L(0); FG_BAR; FG_MMA(1, 0, At, B0); FG_MMA(1, 1, At, B1); FG_BAR; FG_SCHED;
            FG_LDB(B0, 1, 0); FG_LDB(B1, 1, 1); FG_SCHED; FG_LDA(At, 1, 0); FG_STAGE(FG_SA(0, 1), a2 + hstepA, voffA);
            FG_WAIT_V(8); FG_WAIT_L(0); FG_BAR; FG_MMA(0, 0, At, B0); FG_MMA(0, 1, At, B1); FG_BAR; FG_SCHED;
            FG_LDA(At, 1, 1); FG_STAGE(FG_SB(1, 0), b3, voffB); FG_STAGE(FG_SB(1, 1), b3 + hstepB, voffB); FG_STAGE(FG_SA(1, 0), a3, voffA);
            FG_WAIT_V(8); FG_WAIT_L(0); FG_BAR; FG_MMA(1, 0, At, B0); FG_MMA(1, 1, At, B1); FG_BAR; FG_SCHED;
        }
        if (wr == 0) FG_BAR;
        E(acc, cur, wr, wc, fr, fq);
        if (!has_next) break;
#pragma unroll
        for (int a = 0; a < 2; ++a)
#pragma unroll
            for (int b = 0; b < 2; ++b)
#pragma unroll
                for (int m = 0; m < 4; ++m)
#pragma unroll
                    for (int n = 0; n < 2; ++n) acc[a][b][m][n] = (f32x4){0.f, 0.f, 0.f, 0.f};
        cur = nxt; cA = nA; cB = nB; ++ui;
        if (wr == 1) FG_BAR;
    }
    FG_WAIT_V(0);
    FG_BAR;
#undef FG_SA
#undef FG_SB
#undef FG_STAGE
#undef FG_LDA
#undef FG_LDB
#undef FG_MMA
#undef FG_WAIT_V
#undef FG_WAIT_L
#undef FG_BAR
#undef FG_SCHED
}
__device__ __forceinline__ unsigned cvt_pk(float lo, float hi) { unsigned r; asm volatile("v_cvt_pk_bf16_f32 %0, %1, %2" : "=v"(r) : "v"(lo), "v"(hi)); return r; }
__device__ __forceinline__ u32x4 pack8(const f32x4 a, const f32x4 b) { u32x4 w; w.x = cvt_pk(a[0], a[1]); w.y = cvt_pk(a[2], a[3]); w.z = cvt_pk(b[0], b[1]); w.w = cvt_pk(b[2], b[3]); return w; }
__device__ __forceinline__ f32x4 unpk_lo(unsigned x, unsigned y) { return (f32x4){__uint_as_float(x << 16), __uint_as_float(x & 0xffff0000u), __uint_as_float(y << 16), __uint_as_float(y & 0xffff0000u)}; }

struct EpiWin {
    static constexpr bool PERM = true;
    unsigned char* ws; const float* qg; const float* kg;
    __device__ __forceinline__ void operator()(const Acc& acc, const Unit& u, int wr, int wc, int fr_, int fq_) const {
        int fr = fr_, fq = fq_; asm volatile("" : "+v"(fr), "+v"(fq));
        const int tile = u.pn; const bool LAT = u.aux == 0;
        if (tile == 0) {
            if (LAT) {
                const int b = u.pm >> 5, n2 = 2 * (u.pm & 31) + wr;
#pragma unroll
                for (int ai = 0; ai < 2; ++ai)
#pragma unroll
                    for (int bj = 0; bj < 2; ++bj) {
#pragma unroll
                        for (int n = 0; n < 2; ++n)
#pragma unroll
                            for (int e = 0; e < 4; ++e) { const int ch = bj * HALF + wc * 32 + 8 * fq + 4 * n + e;
                                u32x2 o; o.x = cvt_pk(acc[ai][bj][0][n][e], acc[ai][bj][1][n][e]); o.y = cvt_pk(acc[ai][bj][2][n][e], acc[ai][bj][3][n][e]);
                                *(u32x2*)((bf16*)(ws + WS_UT) + ((size_t)(b * 256 + ch) * 64 + n2) * 256 + 64 * ai + 4 * fr) = o; }
                        asm volatile("" ::: "memory"); }
            } else {
#pragma unroll
                for (int ai = 0; ai < 2; ++ai)
#pragma unroll
                    for (int m = 0; m < 4; ++m) { const int sx = ai * HALF + wr * 64 + m * 16 + fr;
#pragma unroll
                        for (int bj = 0; bj < 2; ++bj)
#pragma unroll
                            for (int n = 0; n < 2; ++n)
#pragma unroll
                                for (int e = 0; e < 4; ++e) { const int ch = bj * HALF + wc * 32 + 8 * fq + 4 * n + e;
                                    ((bf16*)(ws + WS_UTC))[(size_t)(u.pm * 256 + ch) * 256 + sx] = f2bf(acc[ai][bj][m][n][e]); }
                        asm volatile("" ::: "memory"); }
            }
            return;
        }
        const bool ropek = tile == 1 || tile == 2 || tile == 5 || tile == 6 || (tile == 7 && wc < 2);
        const bool keyrow = tile == 7;
        size_t boff; int pitch, col0;
        if (tile <= 4) { boff = WS_RETQ + (size_t)(tile - 1) * MROWS * 256 * 2; pitch = 256; col0 = ropek ? wc * 64 : wc * 32; }
        else if (tile <= 6) { boff = WS_ATTQ; pitch = 512; col0 = (tile - 5) * 256 + wc * 64; }
        else if (tile == 7) { boff = wc < 2 ? WS_ATTK : WS_ATTV; pitch = 128; col0 = (wc & 1) * 64; }
        else if (tile < 10) { boff = WS_CONV; pitch = 512; col0 = (tile - 8) * 256 + wc * 32; }
        else { boff = WS_G; pitch = 4096; col0 = (tile - 10) * 256 + wc * 32; }
        const bool head = ropek || tile == 7;
        bf16* const dbase = (bf16*)(ws + boff);
        const bool norm = tile >= 5 && ropek;
        const float* gp = tile == 7 ? kg : qg;
        const float osc = tile == 2 ? 0.125f : (tile == 5 || tile == 6 ? QSCALE : 1.f);
        const float* rc = (const float*)(ws + WS_ROPE);
#pragma unroll
        for (int ai = 0; ai < 2; ++ai) {
            f32x4 rcs[4][2], rsn[4][2];
            if (ropek && LAT) {
#pragma unroll
                for (int m = 0; m < 4; ++m)
#pragma unroll
                    for (int bj = 0; bj < 2; ++bj) { const int sx = 4096 * ai + 256 * fr + 64 * m + 2 * (u.pm & 31) + wr, i0 = 16 * bj + 4 * fq;
                        rcs[m][bj] = *(const f32x4*)(rc + sx * 32 + i0); rsn[m][bj] = *(const f32x4*)(rc + SEQ * 32 + sx * 32 + i0); } }
#pragma unroll
            for (int m = 0; m < 4; ++m) {
                const int b = LAT ? (u.pm >> 5) : u.pm, s = LAT ? (4096 * ai + 256 * fr + 64 * m + 2 * (u.pm & 31) + wr) : (ai * HALF + wr * 64 + m * 16 + fr);
                const int rr = keyrow ? b * KEYS + (LAT ? CTX + s : s) : (LAT ? b * SEQ + s : NLAT + b * CTX + s);
                bf16* const drow = dbase + ((size_t)rr * pitch + col0 + 8 * fq);
                if (ropek) {
                    float rstd = 1.f;
                    if (norm) { float ss = 0.f;
#pragma unroll
                        for (int bj = 0; bj < 2; ++bj)
#pragma unroll
                            for (int n = 0; n < 2; ++n) { const f32x4 x = acc[ai][bj][m][n]; ss += (x[0] * x[0] + x[1] * x[1]) + (x[2] * x[2] + x[3] * x[3]); }
                        ss += __shfl_xor(ss, 16); ss += __shfl_xor(ss, 32);
                        rstd = rsqrtf(ss * (1.f / 64.f) + EPS); }
#pragma unroll
                    for (int bj = 0; bj < 2; ++bj) {
                        const int i0 = 16 * bj + 4 * fq;
                        f32x4 x1 = acc[ai][bj][m][0], x2 = acc[ai][bj][m][1];
                        if (norm) { const f32x4 g1 = *(const f32x4*)(gp + i0), g2 = *(const f32x4*)(gp + 32 + i0); x1 = x1 * rstd * g1; x2 = x2 * rstd * g2; }
                        f32x4 o1 = x1, o2 = x2;
                        if (LAT) { const f32x4 cs = rcs[m][bj], sn = rsn[m][bj]; o1 = x1 * cs - x2 * sn; o2 = x1 * sn + x2 * cs; }
                        *(u32x4*)(drow + 32 * bj) = pack8(o1 * osc, o2 * osc);
                    }
                } else {
#pragma unroll
                    for (int bj = 0; bj < 2; ++bj) {
                        f32x4 a0 = acc[ai][bj][m][0], a1 = acc[ai][bj][m][1];
                        if (tile >= 10) {
#pragma unroll
                            for (int e = 0; e < 4; ++e) { a0[e] = sigmoid_fast(a0[e]); a1[e] = sigmoid_fast(a1[e]); } }
                        *(u32x4*)(drow + (head ? 32 : HALF) * bj) = pack8(a0, a1);
                    }
                }
            }
        }
    }
};
struct EpiMerge {
    static constexpr bool PERM = true;
    const bf16* G; bf16* Mg;
    __device__ __forceinline__ void operator()(const Acc& acc, const Unit& u, int wr, int wc, int fr_, int fq_) const {
        int fr = fr_, fq = fq_; asm volatile("" : "+v"(fr), "+v"(fq));
        const int br = u.aux;
#pragma unroll
        for (int ai = 0; ai < 2; ++ai) {
            u32x4 g[4][2], old[4][2];
#pragma unroll
            for (int m = 0; m < 4; ++m)
#pragma unroll
                for (int bj = 0; bj < 2; ++bj) { const int r = u.pm * BM + ai * HALF + wr * 64 + m * 16 + fr, c = u.pn * BM + bj * HALF + wc * 32 + 8 * fq;
                    g[m][bj] = *(const u32x4*)(G + (size_t)r * 4096 + br * 1024 + c);
                    if (br > 0) old[m][bj] = *(const u32x4*)(Mg + (size_t)r * 1024 + c); }
#pragma unroll
            for (int m = 0; m < 4; ++m)
#pragma unroll
                for (int bj = 0; bj < 2; ++bj) { const int r = u.pm * BM + ai * HALF + wr * 64 + m * 16 + fr, c = u.pn * BM + bj * HALF + wc * 32 + 8 * fq;
                    f32x4 o0 = acc[ai][bj][m][0] * unpk_lo(g[m][bj].x, g[m][bj].y), o1 = acc[ai][bj][m][1] * unpk_lo(g[m][bj].z, g[m][bj].w);
                    if (br > 0) { o0 = o0 + unpk_lo(old[m][bj].x, old[m][bj].y); o1 = o1 + unpk_lo(old[m][bj].z, old[m][bj].w); }
                    *(u32x4*)(Mg + (size_t)r * 1024 + c) = pack8(o0, o1); }
        }
    }
};
struct EpiResid {
    static constexpr bool PERM = false;
    float* out; float* hctx; const float* modbase; int chunk;
    __device__ __forceinline__ void operator()(const Acc& acc, const Unit& u, int wr, int wc, int fr_, int fq_) const {
        int fr = fr_, fq = fq_; asm volatile("" : "+v"(fr), "+v"(fq));
        const int rt = u.pm * BM;
        const float* g = modbase + ((size_t)row_mi(rt) * 6 + chunk) * D;
        f32x4 gg[2][2];
#pragma unroll
        for (int bj = 0; bj < 2; ++bj)
#pragma unroll
            for (int n = 0; n < 2; ++n) gg[bj][n] = *(const f32x4*)(g + u.pn * BM + bj * HALF + wc * 32 + 16 * n + 4 * fq);
#pragma unroll
        for (int ai = 0; ai < 2; ++ai) {
            f32x4 hv[4][2][2];
#pragma unroll
            for (int m = 0; m < 4; ++m) { const int r = rt + ai * HALF + wr * 64 + m * 16 + fr; const float* h = r < NLAT ? out + (size_t)r * D : hctx + (size_t)(r - NLAT) * D;
#pragma unroll
                for (int bj = 0; bj < 2; ++bj)
#pragma unroll
                    for (int n = 0; n < 2; ++n) hv[m][bj][n] = *(const f32x4*)(h + u.pn * BM + bj * HALF + wc * 32 + 16 * n + 4 * fq); }
#pragma unroll
            for (int m = 0; m < 4; ++m) { const int r = rt + ai * HALF + wr * 64 + m * 16 + fr; float* h = r < NLAT ? out + (size_t)r * D : hctx + (size_t)(r - NLAT) * D;
#pragma unroll
                for (int bj = 0; bj < 2; ++bj)
#pragma unroll
                    for (int n = 0; n < 2; ++n) *(f32x4*)(h + u.pn * BM + bj * HALF + wc * 32 + 16 * n + 4 * fq) = hv[m][bj][n] + gg[bj][n] * acc[ai][bj][m][n]; }
        }
    }
};
struct EpiSwiglu {
    static constexpr bool PERM = true;
    bf16* Hm;
    __device__ __forceinline__ void operator()(const Acc& acc, const Unit& u, int wr, int wc, int fr, int fq) const {
#pragma unroll
        for (int ai = 0; ai < 2; ++ai)
#pragma unroll
            for (int m = 0; m < 4; ++m) { const int r = u.pm * BM + ai * HALF + wr * 64 + m * 16 + fr;
#pragma unroll
                for (int bj = 0; bj < 2; ++bj) { const int c = u.pn * BM + bj * HALF + wc * 32 + 8 * fq; const f32x4 g = acc[ai][bj][m][0], up = acc[ai][bj][m][1];
                    u32x2 o; o.x = cvt_pk(silu_fast(g[0]) * up[0], silu_fast(g[1]) * up[1]); o.y = cvt_pk(silu_fast(g[2]) * up[2], silu_fast(g[3]) * up[3]);
                    *(u32x2*)(Hm + (size_t)r * FFN + (c >> 1)) = o; } }
    }
};
struct EpiSwiglu8 {
    static constexpr bool PERM = true;
    unsigned char* Hm;
    __device__ __forceinline__ void operator()(const Acc& acc, const Unit& u, int wr, int wc, int fr_, int fq_) const {
        int fr = fr_, fq = fq_; asm volatile("" : "+v"(fr), "+v"(fq));
#pragma unroll
        for (int ai = 0; ai < 2; ++ai)
#pragma unroll
            for (int m = 0; m < 4; ++m) { const int r = u.pm * BM + ai * HALF + wr * 64 + m * 16 + fr;
#pragma unroll
                for (int bj = 0; bj < 2; ++bj) { const int c = u.pn * BM + bj * HALF + wc * 32 + 8 * fq; const f32x4 g = acc[ai][bj][m][0], up = acc[ai][bj][m][1];
                    *(unsigned*)(Hm + (size_t)r * FFN + (c >> 1)) = pk4_fp8(silu_fast(g[0]) * up[0], silu_fast(g[1]) * up[1], silu_fast(g[2]) * up[2], silu_fast(g[3]) * up[3]); } }
    }
};
struct EpiStore {
    static constexpr bool PERM = true;
    bf16* O; int ldc;
    __device__ __forceinline__ void operator()(const Acc& acc, const Unit& u, int wr, int wc, int fr_, int fq_) const {
        int fr = fr_, fq = fq_; asm volatile("" : "+v"(fr), "+v"(fq));
#pragma unroll
        for (int ai = 0; ai < 2; ++ai)
#pragma unroll
            for (int m = 0; m < 4; ++m) { const int r = u.pm * BM + ai * HALF + wr * 64 + m * 16 + fr;
#pragma unroll
                for (int bj = 0; bj < 2; ++bj) { const int c = u.pn * BM + bj * HALF + wc * 32 + 8 * fq; *(u32x4*)(O + (size_t)r * ldc + c) = pack8(acc[ai][bj][m][0], acc[ai][bj][m][1]); } }
    }
};
struct EpiFft1 {
    static constexpr bool PERM = true;
    unsigned char* ws;
    __device__ __forceinline__ void operator()(const Acc& acc, const Unit& u, int wr, int wc, int fr, int fq) const {
        const float* TW = (const float*)(ws + WS_TW); bf16* Z = (bf16*)(ws + WS_Z);
#pragma unroll
        for (int ai = 0; ai < 2; ++ai)
#pragma unroll
            for (int mm = 0; mm < 2; ++mm) { const int k1 = (4 * ai + 2 * wr + mm) * 16 + fr;
#pragma unroll
                for (int bj = 0; bj < 2; ++bj) { const int c = u.pn * BM + bj * HALF + wc * 32 + 8 * fq, n2 = c & 63, ch = (c >> 6) & 255, b = c >> 14;
                    f32x4 zr[2], zi[2];
#pragma unroll
                    for (int n = 0; n < 2; ++n) { const f32x4 yr = acc[ai][bj][2 * mm][n], yi = acc[ai][bj][2 * mm + 1][n];
                        const f32x4 t0 = *(const f32x4*)(TW + (size_t)(k1 * 64 + n2 + 4 * n) * 2), t1 = *(const f32x4*)(TW + (size_t)(k1 * 64 + n2 + 4 * n) * 2 + 4);
                        const f32x4 ct = {t0[0], t0[2], t1[0], t1[2]}, st = {t0[1], t0[3], t1[1], t1[3]};
                        zr[n] = yr * ct + yi * st; zi[n] = yi * ct - yr * st; }
                    bf16* dst = Z + ((size_t)b * 32768 + k1 * 256 + ch) * 256 + n2;
                    *(u32x4*)dst = pack8(zr[0], zr[1]); *(u32x4*)(dst + 64) = pack8(zi[0], zi[1]);
                    asm volatile("" ::: "memory"); } }
    }
};
struct EpiFft3 {
    static constexpr bool PERM = true;
    unsigned char* ws;
    __device__ __forceinline__ void operator()(const Acc& acc, const Unit& u, int wr, int wc, int fr, int fq) const {
        bf16* X = (bf16*)(ws + WS_X);
#pragma unroll
        for (int m = 0; m < 4; ++m) { const int k2 = 16 * m + fr;
#pragma unroll
            for (int bj = 0; bj < 2; ++bj) { const int c = u.pn * BM + bj * HALF + wc * 32 + 8 * fq, ch = c & 255, k1 = (c >> 8) & 127, b = c >> 15;
                *(u32x4*)(X + (size_t)(b * SEQ + k1 + 128 * k2) * 1536 + wr * 256 + ch) = pack8(acc[0][bj][m][0], acc[0][bj][m][1]); } }
    }
};
struct EpiFftC {
    static constexpr bool PERM = true;
    unsigned char* ws;
    __device__ __forceinline__ void operator()(const Acc& acc, const Unit& u, int wr, int wc, int fr, int fq) const {
        bf16* X = (bf16*)(ws + WS_X);
#pragma unroll
        for (int ai = 0; ai < 2; ++ai)
#pragma unroll
            for (int m = 0; m < 4; ++m) { const int k = ai * HALF + wr * 64 + m * 16 + fr;
#pragma unroll
                for (int bj = 0; bj < 2; ++bj) { const int ch = bj * HALF + wc * 32 + 8 * fq;
                    *(u32x4*)(X + (size_t)(NLAT + u.pn * CTX + k) * 1536 + u.pm * 256 + ch) = pack8(acc[ai][bj][m][0], acc[ai][bj][m][1]); } }
    }
};
}

__device__ __forceinline__ void ph_win(const P& p, LAS unsigned char* lds, int layer) {
    const char* W = (const char*)(p.ws + WS_WIN) + (size_t)layer * INC * D * 2;
#pragma unroll 1
    for (int mode = 0; mode < 2; ++mode) {
        fg::WinSched S{(const char*)(p.ws + WS_A), W, (int)gridDim.x, (int)((blockIdx.x + mode * 128) % gridDim.x), mode};
        fg::EpiWin E{p.ws, p.in[14] + layer * 64, p.in[15] + layer * 64};
        fg::gemm_phase(lds, D, D, S, E);
    }
}

__device__ __forceinline__ void conv_item(const P& p, LAS unsigned char* lds, int layer, int seqid, int t0) {
    const int tid = threadIdx.x; LAS float* y = (LAS float*)lds;
    const int L = seqid < 2 ? SEQ : CTX; const int rbase = seqid < 2 ? seqid * SEQ : NLAT + (seqid - 2) * CTX;
    const bf16* cv = (const bf16*)(p.ws + WS_CONV);
    __syncthreads();
    for (int e = tid; e < 94 * 32; e += NTHREADS) { const int tt = e >> 5, c8 = (e & 31) * 8, t = t0 - 15 + tt;
        f32x4 lo = {0.f, 0.f, 0.f, 0.f}, hi = lo;
        if (t >= 0 && t < L) { const bf16* rowp = cv + (size_t)(rbase + t) * 512 + c8; const u32x4 a = *(const u32x4*)rowp, g = *(const u32x4*)(rowp + 256);
            lo = (f32x4){__uint_as_float(a.x << 16) * sigmoidf_(__uint_as_float(g.x << 16)), __uint_as_float(a.x & 0xffff0000u) * sigmoidf_(__uint_as_float(g.x & 0xffff0000u)),
                         __uint_as_float(a.y << 16) * sigmoidf_(__uint_as_float(g.y << 16)), __uint_as_float(a.y & 0xffff0000u) * sigmoidf_(__uint_as_float(g.y & 0xffff0000u))};
            hi = (f32x4){__uint_as_float(a.z << 16) * sigmoidf_(__uint_as_float(g.z << 16)), __uint_as_float(a.z & 0xffff0000u) * sigmoidf_(__uint_as_float(g.z & 0xffff0000u)),
                         __uint_as_float(a.w << 16) * sigmoidf_(__uint_as_float(g.w << 16)), __uint_as_float(a.w & 0xffff0000u) * sigmoidf_(__uint_as_float(g.w & 0xffff0000u))}; }
        *(LAS f32x4*)(y + tt * 256 + c8) = lo; *(LAS f32x4*)(y + tt * 256 + c8 + 4) = hi; }
    __syncthreads();
    {
        const int ch = tid & 255, half = tid >> 8;
        float w[31];
#pragma unroll
        for (int k = 0; k < 31; ++k) w[k] = p.in[17][(size_t)layer * 31 * 256 + k * 256 + ch];
        const float bias = p.in[18][layer * 256 + ch];
        float o[4][8];
#pragma unroll
        for (int u = 0; u < 4; ++u) { const int tb = (half * 4 + u) * 8;
            float in[38];
#pragma unroll
            for (int q = 0; q < 38; ++q) in[q] = y[(tb + q) * 256 + ch];
#pragma unroll
            for (int q = 0; q < 8; ++q) { float a = bias;
#pragma unroll
                for (int k = 0; k < 31; ++k) a += in[q + k] * w[k];
                o[u][q] = a; } }
        __syncthreads();
#pragma unroll
        for (int u = 0; u < 4; ++u)
#pragma unroll
            for (int q = 0; q < 8; ++q) y[((half * 4 + u) * 8 + q) * 256 + ch] = o[u][q];
    }
    __syncthreads();
    const int wv = tid >> 6, lane = tid & 63;
    const f32x4 g = *(const f32x4*)(p.in[19] + layer * 256 + lane * 4), bb = *(const f32x4*)(p.in[20] + layer * 256 + lane * 4);
    for (int q = 0; q < 8; ++q) { const int t = wv * 8 + q;
        const f32x4 v = *(const LAS f32x4*)(y + t * 256 + lane * 4);
        const float mu = wave_sum(v.x + v.y + v.z + v.w) * (1.f / 256.f);
        const f32x4 dv = v - mu; const float var = wave_sum(dv.x * dv.x + dv.y * dv.y + dv.z * dv.z + dv.w * dv.w) * (1.f / 256.f);
        const float rstd = rsqrtf(var + EPS);
        f32x4 z = dv * rstd * g + bb;
        u32x2 ov; ov.x = pk2(siluf_(z.x), siluf_(z.y)); ov.y = pk2(siluf_(z.z), siluf_(z.w));
        *(u32x2*)((bf16*)(p.ws + WS_X) + (size_t)(rbase + t0 + t) * 1536 + 1280 + lane * 4) = ov; }
}

__device__ __forceinline__ int chunk_row0(int b, int n) { return n < 2 ? NLAT + b * CTX + n * 128 : b * SEQ + (n - 2) * 128; }
__device__ __forceinline__ float log_sigmoid(float x) { return x >= 0.f ? -log1pf(expf(-x)) : x - log1pf(expf(x)); }
namespace rt {
typedef short bf16x8 __attribute__((ext_vector_type(8)));
constexpr int PQ = 72, PJ = 136;
__device__ __forceinline__ f32x4 mma(bf16x8 a, bf16x8 b, f32x4 c) { return __builtin_amdgcn_mfma_f32_16x16x32_bf16(a, b, c, 0, 0, 0); }
__device__ __forceinline__ bf16x8 frag(const LAS bf16* base, int row, int pitch, int k0, int lane) { return *(const LAS bf16x8*)(base + (row + (lane & 15)) * pitch + k0 + 8 * (lane >> 4)); }
}
__device__ __forceinline__ void ret_kv_item(const P& p, LAS unsigned char* lds, int layer, int it) {
    using namespace rt;
    const int tid = threadIdx.x, lane = tid & 63, w = tid >> 6; const int h = it & 3, n = (it >> 2) % NCHUNK, b = (it >> 2) / NCHUNK;
    LAS bf16* KTf = (LAS bf16*)lds; LAS bf16* KTb = KTf + 64 * PJ; LAS bf16* VT = KTb + 64 * PJ;
    const int r0 = chunk_row0(b, n);
    const float lgf = log_sigmoid(p.in[10][layer * 4 + h]), lgb = log_sigmoid(p.in[11][layer * 4 + h]);
    __syncthreads();
    { const int j = tid & 127, dq = (tid >> 7) * 16;
      const bf16* K = (const bf16*)(p.ws + WS_RETK) + (size_t)(r0 + j) * 256 + h * 64 + dq; const bf16* V = (const bf16*)(p.ws + WS_RETV) + (size_t)(r0 + j) * 256 + h * 64 + dq;
      const float zf = expf((127.f - j) * lgf), zb = expf((float)j * lgb);
#pragma unroll
      for (int q8 = 0; q8 < 2; ++q8) { const u32x4 kw = *(const u32x4*)(K + q8 * 8), vw = *(const u32x4*)(V + q8 * 8);
          const unsigned kk[4] = {kw.x, kw.y, kw.z, kw.w}, vv[4] = {vw.x, vw.y, vw.z, vw.w};
#pragma unroll
          for (int q = 0; q < 4; ++q) { const int d = dq + q8 * 8 + 2 * q; const float k0 = __uint_as_float(kk[q] << 16), k1 = __uint_as_float(kk[q] & 0xffff0000u);
              KTf[d * PJ + j] = f2bf(k0 * zf); KTf[(d + 1) * PJ + j] = f2bf(k1 * zf); KTb[d * PJ + j] = f2bf(k0 * zb); KTb[(d + 1) * PJ + j] = f2bf(k1 * zb);
              VT[d * PJ + j] = (bf16)(vv[q] & 0xffffu); VT[(d + 1) * PJ + j] = (bf16)(vv[q] >> 16); } } }
    __syncthreads();
    const int fb = w >> 2, dt = w & 3; const LAS bf16* Am = fb == 0 ? KTf : KTb;
    f32x4 acc[4];
#pragma unroll
    for (int et = 0; et < 4; ++et) acc[et] = (f32x4){0.f, 0.f, 0.f, 0.f};
#pragma unroll
    for (int ks = 0; ks < 4; ++ks) { const bf16x8 af = frag(Am, dt * 16, PJ, ks * 32, lane);
#pragma unroll
        for (int et = 0; et < 4; ++et) acc[et] = mma(af, frag(VT, et * 16, PJ, ks * 32, lane), acc[et]); }
    float* S = (float*)(p.ws + WS_RETS) + ((size_t)((fb * 2 + b) * NCHUNK + n) * 4 + h) * 4096;
#pragma unroll
    for (int et = 0; et < 4; ++et)
#pragma unroll
        for (int r = 0; r < 4; ++r) S[(dt * 16 + 4 * (lane >> 4) + r) * 64 + et * 16 + (lane & 15)] = acc[et][r];
}
__device__ __forceinline__ void ret_scan_item(const P& p, int layer, int it) {
    const int e = it * NTHREADS + threadIdx.x;
    const int de = e & 4095, h = (e >> 12) & 3, b = (e >> 14) & 1, dir = e >> 15;
    const float lg = log_sigmoid(p.in[dir == 0 ? 10 : 11][layer * 4 + h]); const float g = expf(128.f * lg);
    float* S = (float*)(p.ws + WS_RETS) + (size_t)((dir * 2 + b) * NCHUNK) * 4 * 4096 + (size_t)h * 4096 + de;
    float kv[NCHUNK];
#pragma unroll
    for (int n = 0; n < NCHUNK; ++n) kv[n] = S[(size_t)n * 4 * 4096];
    float st = 0.f;
    if (dir == 0) {
#pragma unroll
        for (int n = 0; n < NCHUNK; ++n) { const float t = kv[n]; kv[n] = st; st = st * g + t; }
    } else {
#pragma unroll
        for (int i = 0; i < NCHUNK; ++i) { const int n = i < 2 ? 1 - i : NCHUNK + 1 - i; const float t = kv[n]; kv[n] = st; st = st * g + t; }
    }
    float* S2 = (float*)(p.ws + WS_RETS2) + (size_t)((dir * 2 + b) * NCHUNK) * 4 * 4096 + (size_t)h * 4096 + de;
#pragma unroll
    for (int n = 0; n < NCHUNK; ++n) S2[(size_t)n * 4 * 4096] = kv[n];
}
__device__ __forceinline__ void ret_out_item(const P& p, LAS unsigned char* lds, int layer, int it) {
    using namespace rt;
    const int tid = threadIdx.x, lane = tid & 63, w = tid >> 6; const int h = it & 3, n = (it >> 2) % NCHUNK, b = (it >> 2) / NCHUNK;
    LAS bf16* Qs = (LAS bf16*)lds; LAS bf16* Ks = Qs + 128 * PQ; LAS bf16* VT = Ks + 128 * PQ; LAS bf16* Ps = VT + 64 * PJ; LAS bf16* SfT = Ps + 128 * PJ; LAS bf16* SbT = SfT + 64 * PQ;
    LAS float* pf = (LAS float*)(SbT + 64 * PQ); LAS float* pb = pf + 132;
    const int r0 = chunk_row0(b, n);
    const float lgf = log_sigmoid(p.in[10][layer * 4 + h]), lgb = log_sigmoid(p.in[11][layer * 4 + h]);
    const float* S = (const float*)(p.ws + WS_RETS2);
    const float* sfp = S + ((size_t)((0 * 2 + b) * NCHUNK + n) * 4 + h) * 4096; const float* sbp = S + ((size_t)((1 * 2 + b) * NCHUNK + n) * 4 + h) * 4096;
    __syncthreads();
    { const int j = tid >> 2, dq = (tid & 3) * 16;
      const bf16* Q = (const bf16*)(p.ws + WS_RETQ) + (size_t)(r0 + j) * 256 + h * 64 + dq; const bf16* K = (const bf16*)(p.ws + WS_RETK) + (size_t)(r0 + j) * 256 + h * 64 + dq;
      *(LAS u32x4*)(Qs + j * PQ + dq) = *(const u32x4*)Q; *(LAS u32x4*)(Qs + j * PQ + dq + 8) = *(const u32x4*)(Q + 8);
      *(LAS u32x4*)(Ks + j * PQ + dq) = *(const u32x4*)K; *(LAS u32x4*)(Ks + j * PQ + dq + 8) = *(const u32x4*)(K + 8); }
    { const int j = tid & 127, dq = (tid >> 7) * 16;
      const bf16* V = (const bf16*)(p.ws + WS_RETV) + (size_t)(r0 + j) * 256 + h * 64 + dq;
#pragma unroll
      for (int q8 = 0; q8 < 2; ++q8) { const u32x4 vw = *(const u32x4*)(V + q8 * 8); const unsigned vv[4] = {vw.x, vw.y, vw.z, vw.w};
#pragma unroll
          for (int q = 0; q < 4; ++q) { const int d = dq + q8 * 8 + 2 * q; VT[d * PJ + j] = (bf16)(vv[q] & 0xffffu); VT[(d + 1) * PJ + j] = (bf16)(vv[q] >> 16); } } }
    { const int d = tid & 63, e0 = (tid >> 6) * 8;
#pragma unroll
      for (int q4 = 0; q4 < 2; ++q4) { const f32x4 a = *(const f32x4*)(sfp + d * 64 + e0 + q4 * 4), c = *(const f32x4*)(sbp + d * 64 + e0 + q4 * 4);
#pragma unroll
          for (int q = 0; q < 4; ++q) { SfT[(e0 + q4 * 4 + q) * PQ + d] = f2bf(a[q]); SbT[(e0 + q4 * 4 + q) * PQ + d] = f2bf(c[q]); } } }
    if (tid <= 128) { pf[tid] = expf((float)tid * lgf); pb[tid] = expf((float)tid * lgb); }
    __syncthreads();
    { const bf16x8 a0 = frag(Qs, 16 * w, PQ, 0, lane), a1 = frag(Qs, 16 * w, PQ, 32, lane);
#pragma unroll
      for (int jt = 0; jt < 8; ++jt) { f32x4 c = (f32x4){0.f, 0.f, 0.f, 0.f};
          c = mma(a0, frag(Ks, jt * 16, PQ, 0, lane), c); c = mma(a1, frag(Ks, jt * 16, PQ, 32, lane), c);
          const int j = jt * 16 + (lane & 15);
#pragma unroll
          for (int r = 0; r < 4; ++r) { const int i = 16 * w + 4 * (lane >> 4) + r; const float dm = i > j ? pf[i - j] : (i < j ? pb[j - i] : 2.f); Ps[i * PJ + j] = f2bf(c[r] * dm); } } }
    __syncthreads();
    f32x4 aP[4], aF[4], aB[4];
#pragma unroll
    for (int et = 0; et < 4; ++et) { aP[et] = (f32x4){0.f, 0.f, 0.f, 0.f}; aF[et] = aP[et]; aB[et] = aP[et]; }
#pragma unroll
    for (int ks = 0; ks < 4; ++ks) { const bf16x8 af = frag(Ps, 16 * w, PJ, ks * 32, lane);
#pragma unroll
        for (int et = 0; et < 4; ++et) aP[et] = mma(af, frag(VT, et * 16, PJ, ks * 32, lane), aP[et]); }
#pragma unroll
    for (int ks = 0; ks < 2; ++ks) { const bf16x8 af = frag(Qs, 16 * w, PQ, ks * 32, lane);
#pragma unroll
        for (int et = 0; et < 4; ++et) { aF[et] = mma(af, frag(SfT, et * 16, PQ, ks * 32, lane), aF[et]); aB[et] = mma(af, frag(SbT, et * 16, PQ, ks * 32, lane), aB[et]); } }
    const float* rg = p.in[12] + layer * 256 + h * 64;
    const bf16* G = (const bf16*)(p.ws + WS_RETG) + (size_t)r0 * 256 + h * 64; bf16* X = (bf16*)(p.ws + WS_X) + (size_t)r0 * 1536 + 512 + h * 64;
    float gt[4][4];
#pragma unroll
    for (int r = 0; r < 4; ++r)
#pragma unroll
        for (int et = 0; et < 4; ++et) gt[r][et] = bf2f(G[(size_t)(16 * w + 4 * (lane >> 4) + r) * 256 + et * 16 + (lane & 15)]);
#pragma unroll
    for (int r = 0; r < 4; ++r) { const int i = 16 * w + 4 * (lane >> 4) + r; const float xf = pf[i + 1], xb = pb[128 - i];
        float o[4]; float ss = 0.f;
#pragma unroll
        for (int et = 0; et < 4; ++et) { o[et] = aP[et][r] + xf * aF[et][r] + xb * aB[et][r]; ss += o[et] * o[et]; }
        ss += __shfl_xor(ss, 1); ss += __shfl_xor(ss, 2); ss += __shfl_xor(ss, 4); ss += __shfl_xor(ss, 8);
        const float rstd = rsqrtf(ss * (1.f / 64.f) + EPS);
#pragma unroll
        for (int et = 0; et < 4; ++et) { const int e = et * 16 + (lane & 15); Ps[i * PJ + e] = f2bf(o[et] * rstd * rg[e] * siluf_(gt[r][et])); } }
    asm volatile("s_waitcnt lgkmcnt(0)" ::: "memory");
#pragma unroll
    for (int q = 0; q < 2; ++q) { const int c = lane + 64 * q, i = 16 * w + (c >> 3), e8 = (c & 7) * 8;
        *(u32x4*)(X + (size_t)i * 1536 + e8) = *(const LAS u32x4*)(Ps + i * PJ + e8); }
    __syncthreads();
}

#include <hip/hip_bf16.h>
#include <cmath>
namespace attn_body {
using bf16=__hip_bfloat16;
using bf16x8=__attribute__((ext_vector_type(8)))short;
using s16x4=__attribute__((ext_vector_type(4)))short;
using f32x16=__attribute__((ext_vector_type(16)))float;
using u32x4=__attribute__((ext_vector_type(4)))unsigned;
constexpr int D=64, QP=512, KP=128, OP=1536;
constexpr int NW=8,QBLK=32,QB=QBLK*NW,KVBLK=64;
__device__ __forceinline__ int crow(int r,int hi){return (r&3)+8*(r>>2)+4*hi;}
#define SBAR() __builtin_amdgcn_sched_barrier(0)
__device__ __forceinline__ void cmask(f32x16&p0,f32x16&p1,int jb,int qrel,int hi){
  const float NEG=-INFINITY; int kb=64*jb+4*hi;
  #pragma unroll
  for(int r=0;r<16;++r){int kv=kb+(r&3)+8*(r>>2); if(kv>qrel)p0[r]=NEG; if(kv+32>qrel)p1[r]=NEG;}
}

constexpr int NSLOT=3, SLOTB=8192;
constexpr int LDS_K=0, LDS_V=NSLOT*SLOTB, LDS_WS=2*NSLOT*SLOTB, LDS_OST=LDS_WS+NW*64*4, LDS_BYTES=LDS_OST+NW*4096;
constexpr float C2=0.125f*1.4426950408889634f;
__device__ __forceinline__ void glds16(const void*gsrc,unsigned lds_dst){unsigned keep;
  asm volatile("s_mov_b32 %0, m0\n\ts_mov_b32 m0, %2\n\ts_nop 0\n\tglobal_load_lds_dwordx4 %1, off\n\ts_mov_b32 m0, %0":"=&s"(keep):"v"(gsrc),"s"(lds_dst):"memory");}
__device__ __forceinline__ float max3f(float a,float b,float c){float r;asm("v_max3_f32 %0, %1, %2, %3":"=v"(r):"v"(a),"v"(b),"v"(c));return r;}
__device__ __forceinline__ float max2f(float a,float b){float r;asm("v_max_f32_e32 %0, %1, %2":"=v"(r):"v"(a),"v"(b));return r;}
__device__ __forceinline__ float fadd_s(float a,float b){float r;asm("v_add_f32_e32 %0, %1, %2":"=v"(r):"v"(a),"v"(b));return r;}
__device__ __forceinline__ float fsub_s(float a,float b){float r;asm("v_sub_f32_e32 %0, %1, %2":"=v"(r):"v"(a),"v"(b));return r;}
typedef float f32x2_t __attribute__((ext_vector_type(2))); typedef __bf16 bf16x2_t __attribute__((ext_vector_type(2)));
__device__ __forceinline__ unsigned cvtpk_s(float lo,float hi){f32x2_t v={lo,hi};bf16x2_t b=__builtin_convertvector(v,bf16x2_t);return __builtin_bit_cast(unsigned,b);}
#define WAIT_BAR(N) asm volatile("s_waitcnt vmcnt(" #N ") lgkmcnt(0)\n\ts_barrier":::"memory")

__device__ __forceinline__ void qkt(f32x16&p0,f32x16&p1,const char*Kslot,const bf16x8*qr,const f32x16&negm,int r32,int hi){
  const char*kb=Kslot+hi*1024+r32*16;
  #pragma unroll
  for(int d0=0;d0<4;++d0){
    const bf16x8 b0=*reinterpret_cast<const bf16x8*>(kb+d0*2048);
    const bf16x8 b1=*reinterpret_cast<const bf16x8*>(kb+d0*2048+512);
    if(d0==0){p0=__builtin_amdgcn_mfma_f32_32x32x16_bf16(b0,qr[0],negm,0,0,0);p1=__builtin_amdgcn_mfma_f32_32x32x16_bf16(b1,qr[0],negm,0,0,0);}
    else{p0=__builtin_amdgcn_mfma_f32_32x32x16_bf16(b0,qr[d0],p0,0,0,0);p1=__builtin_amdgcn_mfma_f32_32x32x16_bf16(b1,qr[d0],p1,0,0,0);}}
}
typedef __attribute__((address_space(3))) const char* lds_cptr;
typedef short v4i16_t __attribute__((ext_vector_type(4)));
__device__ __forceinline__ void kload8(bf16x8*kf,lds_cptr kp){
  kf[0]=*(const __attribute__((address_space(3))) bf16x8*)(kp);      kf[1]=*(const __attribute__((address_space(3))) bf16x8*)(kp+512);
  kf[2]=*(const __attribute__((address_space(3))) bf16x8*)(kp+2048); kf[3]=*(const __attribute__((address_space(3))) bf16x8*)(kp+2560);
  kf[4]=*(const __attribute__((address_space(3))) bf16x8*)(kp+4096); kf[5]=*(const __attribute__((address_space(3))) bf16x8*)(kp+4608);
  kf[6]=*(const __attribute__((address_space(3))) bf16x8*)(kp+6144); kf[7]=*(const __attribute__((address_space(3))) bf16x8*)(kp+6656);
}
__device__ __forceinline__ void kload2(bf16x8*kf,lds_cptr kp,int j){ kf[2*j]=*(const __attribute__((address_space(3))) bf16x8*)(kp+j*2048); kf[2*j+1]=*(const __attribute__((address_space(3))) bf16x8*)(kp+j*2048+512); }
__device__ __forceinline__ s16x4 vtr(lds_cptr p){ return __builtin_bit_cast(s16x4,__builtin_amdgcn_ds_read_tr16_b64_v4i16((__attribute__((address_space(3))) v4i16_t*)p)); }
__device__ __forceinline__ float rowmax(const f32x16&p0,const f32x16&p1){
  float a=max3f(p0[0],p0[1],p1[0]),b=max3f(p0[2],p0[3],p1[1]);a=max3f(a,p1[2],p1[3]);
  #pragma unroll
  for(int r=4;r<16;r+=4){a=max3f(a,p0[r],p0[r+1]);b=max3f(b,p0[r+2],p0[r+3]);a=max3f(a,p1[r],p1[r+1]);b=max3f(b,p1[r+2],p1[r+3]);}
  const float m=max2f(a,b);
  auto rr=__builtin_amdgcn_permlane32_swap(__float_as_uint(m),__float_as_uint(m),false,false);
  return max2f(__uint_as_float(rr[0]),__uint_as_float(rr[1]));
}
__device__ __forceinline__ void pv(f32x16*o,int vb,bf16x8 pa0,bf16x8 pa1,bf16x8 pa2,bf16x8 pa3){
  #pragma unroll
  for(int d0=0;d0<2;++d0){s16x4 lo[4],hi[4];
    #pragma unroll
    for(int ks=0;ks<4;++ks){
      asm volatile("ds_read_b64_tr_b16 %0,%1 offset:%c2":"=&v"(lo[ks]):"v"(vb),"i"(d0*4096+ks*1024):"memory");
      asm volatile("ds_read_b64_tr_b16 %0,%1 offset:%c2":"=&v"(hi[ks]):"v"(vb),"i"(d0*4096+ks*1024+512):"memory");}
    asm volatile("s_waitcnt lgkmcnt(0)":::"memory");SBAR();
    #define PK(k) (bf16x8){lo[k][0],lo[k][1],lo[k][2],lo[k][3],hi[k][0],hi[k][1],hi[k][2],hi[k][3]}
    o[d0]=__builtin_amdgcn_mfma_f32_32x32x16_bf16(pa0,PK(0),o[d0],0,0,0);
    o[d0]=__builtin_amdgcn_mfma_f32_32x32x16_bf16(pa1,PK(1),o[d0],0,0,0);
    o[d0]=__builtin_amdgcn_mfma_f32_32x32x16_bf16(pa2,PK(2),o[d0],0,0,0);
    o[d0]=__builtin_amdgcn_mfma_f32_32x32x16_bf16(pa3,PK(3),o[d0],0,0,0);
    #undef PK
  }
}

#ifndef ATTN_STORE16
#define ATTN_STORE16(p,v) (*(u32x4*)(p)=(v))
#endif
template<int THRL> __device__ __forceinline__ void attn_unit(const bf16*Q0,const bf16*__restrict__ Kh,const bf16*__restrict__ Vh,bf16*O0,const int NT,char*shm){
  const int tid=threadIdx.x,lane=tid&63,r32=lane&31,hi=lane>>5; const int wid=__builtin_amdgcn_readfirstlane(tid>>6);
  const bf16*Qw=Q0+(long)(wid*QBLK)*QP;
  const unsigned lds0=(unsigned)(uintptr_t)shm;
  float*wsf=(float*)(shm+LDS_WS)+wid*64;
  const bf16*ksrc=Kh+(long)lane*KP+wid*8;
  const bf16*vsrc=Vh+(long)(16*(wid&3)+(lane>>2))*KP+(wid>>2)*32+(lane&3)*8;
  const unsigned kdst=lds0+LDS_K+wid*1024, vdst=lds0+LDS_V+wid*1024;
  #define DMA_K(t,slot) glds16(ksrc+(long)(t)*KVBLK*KP,(unsigned)__builtin_amdgcn_readfirstlane(kdst+(slot)))
  #define DMA_V(t,slot) glds16(vsrc+(long)(t)*KVBLK*KP,(unsigned)__builtin_amdgcn_readfirstlane(vdst+(slot)))
  const int vb0=(int)(lds0+LDS_V)+((lane>>4)&1)*32+(lane&3)*8+(4*hi+((lane&15)>>2))*64;
  const char*Kbase=shm+LDS_K; bf16x8 kf[8];
  const lds_cptr shm3=(lds_cptr)shm; const lds_cptr kp0=shm3+LDS_K+hi*1024+r32*16; const lds_cptr vp0=shm3+LDS_V+((lane>>4)&1)*32+(lane&3)*8+(4*hi+((lane&15)>>2))*64;
  DMA_K(0,0);DMA_V(0,0);DMA_K(1,SLOTB);
  bf16x8 qr[4];
  #pragma unroll
  for(int d0=0;d0<4;++d0)qr[d0]=*reinterpret_cast<const bf16x8*>(&Qw[(long)r32*QP+d0*16+hi*8]);
  float mhat=0.f,l_reg=0.f;f32x16 o[2];o[0]=f32x16{};o[1]=f32x16{};f32x16 negm=f32x16{};asm volatile("":"+v"(negm));
  #define CMASK(P0,P1,t) do{}while(0)
  bool resc=false;
  #define START(P0,P1) do{ const float rm=rowmax(P0,P1); resc=false; \
    { const float dl=rm; mhat=fadd_s(mhat,dl); \
      _Pragma("unroll") for(int r=0;r<16;++r){P0[r]=fsub_s(P0[r],dl);P1[r]=fsub_s(P1[r],dl);} \
      _Pragma("unroll") for(int r=0;r<16;++r)negm[r]=-mhat; asm volatile("":"+v"(negm)); } \
    _Pragma("unroll") for(int r=0;r<16;++r)P0[r]=__builtin_amdgcn_exp2f(P0[r]); }while(0)
  #define RESC() do{ if(resc){ asm volatile("s_waitcnt lgkmcnt(0)":::"memory"); \
      _Pragma("unroll") for(int d_=0;d_<2;++d_) _Pragma("unroll") for(int r=0;r<16;++r)o[d_][r]*=wsf[crow(r,hi)]; } }while(0)
  f32x16 pA0,pA1,pB0,pB1;
  int sl_prev=0,sl_cur=0,sl_next=SLOTB;
  #define ROT() do{sl_prev=sl_cur;sl_cur=sl_next;sl_next=(sl_next==(NSLOT-1)*SLOTB)?0:sl_next+SLOTB;}while(0)
  DMA_K(2,2*SLOTB);
  WAIT_BAR(3);
  qkt(pA0,pA1,Kbase,qr,negm,r32,hi);asm volatile("s_nop 15\n\ts_nop 7":"+v"(pA0),"+v"(pA1));CMASK(pA0,pA1,0);
  START(pA0,pA1);
  _Pragma("unroll") for(int r=0;r<16;++r)pA1[r]=__builtin_amdgcn_exp2f(pA1[r]);
  WAIT_BAR(0);
  DMA_K(3,0);DMA_V(1,SLOTB);
  ROT();
  kload8(kf,kp0+sl_cur);
  WAIT_BAR(2);
  s16x4 vlo[8],vhi[8]; u32x4 pw0,pw1,pw2,pw3;
  #define PKW(P,B) cvtpk_s(P[B],P[B+1])
  #define PAF(k) __builtin_bit_cast(bf16x8,pw##k)
  #define VFR(i) (bf16x8){vlo[i][0],vlo[i][1],vlo[i][2],vlo[i][3],vhi[i][0],vhi[i][1],vhi[i][2],vhi[i][3]}
  #define PIN(x) asm volatile("":"+v"(x))
  #define MX3(a,b,c) __builtin_fmaxf(__builtin_fmaxf((a),(b)),(c))
  #define GAPA(MF,A0,A1,A2,A3,W0,W1,PW) do{ MF; sacc+=A0; sacc+=A1; sacc+=A2; sacc+=A3; PIN(sacc); W0; W1; PIN(PW); SBAR(); }while(0)
  #define EX(v) __builtin_amdgcn_exp2f(v)
  #define GAPB(MF,X,B) do{ MF; X[B]=EX(X[B]); X[B+1]=EX(X[B+1]); X[B+2]=EX(X[B+2]); X[B+3]=EX(X[B+3]); PIN(X); SBAR(); }while(0)
  #define VRD(i) do{ vlo[i]=vtr(vp_+(((i)>>2)*4096+((i)&3)*1024)); vhi[i]=vtr(vp_+(((i)>>2)*4096+((i)&3)*1024+512)); }while(0)
  #define KRD(G,j) do{ if(G){ kload2(kf,kp0+sl_next,j); SBAR(); } }while(0)
  #define STEP(C0,C1,P0,P1,t,GK,GV,GL) do{ SBAR(); \
    const lds_cptr vp_=vp0+sl_prev; \
    VRD(0); SBAR(); float sacc=(P0[0]+P0[1]); \
    GAPA(C0=__builtin_amdgcn_mfma_f32_32x32x16_bf16(kf[0],qr[0],negm,0,0,0), P0[2],P0[3],P0[4],P0[5],     pw0[0]=PKW(P0,0), pw0[1]=PKW(P0,2), pw0); \
    VRD(4); SBAR(); GAPA(C1=__builtin_amdgcn_mfma_f32_32x32x16_bf16(kf[1],qr[0],negm,0,0,0), P0[6],P0[7],P0[8],P0[9],     pw0[2]=PKW(P0,4), pw0[3]=PKW(P0,6), pw0); \
    VRD(1); SBAR(); GAPA(C0=__builtin_amdgcn_mfma_f32_32x32x16_bf16(kf[2],qr[1],C0,0,0,0),   P0[10],P0[11],P0[12],P0[13], pw1[0]=PKW(P0,8), pw1[1]=PKW(P0,10), pw1); \
    VRD(5); SBAR(); GAPA(C1=__builtin_amdgcn_mfma_f32_32x32x16_bf16(kf[3],qr[1],C1,0,0,0),   P0[14],P0[15],P1[0],P1[1],   pw1[2]=PKW(P0,12),pw1[3]=PKW(P0,14), pw1); \
    VRD(2); SBAR(); GAPA(C0=__builtin_amdgcn_mfma_f32_32x32x16_bf16(kf[4],qr[2],C0,0,0,0),   P1[2],P1[3],P1[4],P1[5],     pw2[0]=PKW(P1,0), pw2[1]=PKW(P1,2), pw2); \
    VRD(6); SBAR(); GAPA(C1=__builtin_amdgcn_mfma_f32_32x32x16_bf16(kf[5],qr[2],C1,0,0,0),   P1[6],P1[7],P1[8],P1[9],     pw2[2]=PKW(P1,4), pw2[3]=PKW(P1,6), pw2); \
    VRD(3); SBAR(); GAPA(C0=__builtin_amdgcn_mfma_f32_32x32x16_bf16(kf[6],qr[3],C0,0,0,0),   P1[10],P1[11],P1[12],P1[13], pw3[0]=PKW(P1,8), pw3[1]=PKW(P1,10), pw3); \
    VRD(7); SBAR(); GAPA(C1=__builtin_amdgcn_mfma_f32_32x32x16_bf16(kf[7],qr[3],C1,0,0,0),   P1[14],P1[15],0.f,0.f,       pw3[2]=PKW(P1,12),pw3[3]=PKW(P1,14), pw3); \
    l_reg+=sacc; \
    if(GK){DMA_K((t)+3,sl_cur);} if(GV){DMA_V((t)+1,sl_next);} \
    CMASK(C0,C1,t); \
    { float a=MX3(C0[0],C0[1],C1[0]),b=MX3(C0[2],C0[3],C1[1]); a=MX3(a,C1[2],C1[3]); \
      _Pragma("unroll") for(int r=4;r<16;r+=4){a=MX3(a,C0[r],C0[r+1]);b=MX3(b,C0[r+2],C0[r+3]);a=MX3(a,C1[r],C1[r+1]);b=MX3(b,C1[r+2],C1[r+3]);} \
      float rm=__builtin_fmaxf(a,b); { auto rr=__builtin_amdgcn_permlane32_swap(__float_as_uint(rm),__float_as_uint(rm),false,false); rm=__builtin_fmaxf(__uint_as_float(rr[0]),__uint_as_float(rr[1])); } \
      resc=false; \
      if(__builtin_expect(__any(rm>(float)THRL),0)){ const float dl=__builtin_fmaxf(rm,0.f); mhat+=dl; \
        _Pragma("unroll") for(int r=0;r<16;++r){C0[r]-=dl;C1[r]-=dl;} \
        _Pragma("unroll") for(int r=0;r<16;++r)negm[r]=-mhat; asm volatile("":"+v"(negm)); \
        const float f=__builtin_amdgcn_exp2f(-dl); l_reg*=f; if(hi==0)wsf[r32]=f; resc=true; } } \
    SBAR(); \
    GAPB(o[0]=__builtin_amdgcn_mfma_f32_32x32x16_bf16(PAF(0),VFR(0),o[0],0,0,0), C0,0); \
    GAPB(o[1]=__builtin_amdgcn_mfma_f32_32x32x16_bf16(PAF(0),VFR(4),o[1],0,0,0), C0,4); \
    KRD(GL,0); GAPB(o[0]=__builtin_amdgcn_mfma_f32_32x32x16_bf16(PAF(1),VFR(1),o[0],0,0,0), C0,8); \
    KRD(GL,1); GAPB(o[1]=__builtin_amdgcn_mfma_f32_32x32x16_bf16(PAF(1),VFR(5),o[1],0,0,0), C0,12); \
    KRD(GL,2); GAPB(o[0]=__builtin_amdgcn_mfma_f32_32x32x16_bf16(PAF(2),VFR(2),o[0],0,0,0), C1,0); \
    KRD(GL,3); GAPB(o[1]=__builtin_amdgcn_mfma_f32_32x32x16_bf16(PAF(2),VFR(6),o[1],0,0,0), C1,4); \
    GAPB(o[0]=__builtin_amdgcn_mfma_f32_32x32x16_bf16(PAF(3),VFR(3),o[0],0,0,0), C1,8); \
    GAPB(o[1]=__builtin_amdgcn_mfma_f32_32x32x16_bf16(PAF(3),VFR(7),o[1],0,0,0), C1,12); \
    }while(0)
  int t=1;
  #undef CMASK
  #define CMASK(P0,P1,t) do{}while(0)
  for(;t+5<NT;t+=2){
    STEP(pB0,pB1,pA0,pA1,t,true,true,true);     WAIT_BAR(2); RESC(); ROT();
    STEP(pA0,pA1,pB0,pB1,t+1,true,true,true);   WAIT_BAR(2); RESC(); ROT();
  }
  #undef CMASK
  #define CMASK(P0,P1,t) do{}while(0)
  #define ENDW(tt) do{ if((tt)+3<NT){WAIT_BAR(2);} else if((tt)+2<NT){WAIT_BAR(1);} else {WAIT_BAR(0);} }while(0)
  for(;t+1<NT;t+=2){
    STEP(pB0,pB1,pA0,pA1,t,(t+3<NT),(t+1<NT),(t+1<NT));       ENDW(t);   RESC(); ROT();
    STEP(pA0,pA1,pB0,pB1,t+1,(t+4<NT),(t+2<NT),(t+2<NT));     ENDW(t+1); RESC(); ROT();
  }
  STEP(pB0,pB1,pA0,pA1,NT-1,false,false,false); RESC();
  { float sacc=pB0[0]+pB0[1]; _Pragma("unroll") for(int r=2;r<16;++r)sacc+=pB0[r]; _Pragma("unroll") for(int r=0;r<16;++r)sacc+=pB1[r]; l_reg+=sacc;
    pw0=(u32x4){PKW(pB0,0),PKW(pB0,2),PKW(pB0,4),PKW(pB0,6)};pw1=(u32x4){PKW(pB0,8),PKW(pB0,10),PKW(pB0,12),PKW(pB0,14)};pw2=(u32x4){PKW(pB1,0),PKW(pB1,2),PKW(pB1,4),PKW(pB1,6)};pw3=(u32x4){PKW(pB1,8),PKW(pB1,10),PKW(pB1,12),PKW(pB1,14)};
    SBAR(); pv(o,vb0+sl_cur,PAF(0),PAF(1),PAF(2),PAF(3)); }
  #undef PKW
  #undef PAF
  #undef VFR
  #undef PIN
  #undef MX3
  #undef GAPA
  #undef GAPB
  #undef EX
  #undef VRD
  #undef KRD
  #undef STEP
  #undef ENDW
  {auto rr=__builtin_amdgcn_permlane32_swap(__float_as_uint(l_reg),__float_as_uint(l_reg),false,false);l_reg=__uint_as_float(rr[0])+__uint_as_float(rr[1]);}
  if(hi==0)wsf[32+r32]=l_reg;asm volatile("s_waitcnt lgkmcnt(0)":::"memory");
  float rli[16];
  #pragma unroll
  for(int r=0;r<16;++r)rli[r]=__builtin_amdgcn_rcpf(wsf[32+crow(r,hi)]);
  bf16*Ow=O0+(long)(wid*QBLK)*OP;
  { bf16*stg=(bf16*)(shm+LDS_OST)+wid*2048;
    #pragma unroll
    for(int r=0;r<16;++r){const int orow=crow(r,hi);
      #pragma unroll
      for(int d0=0;d0<2;++d0)stg[orow*64+d0*32+r32]=__float2bfloat16(o[d0][r]*rli[r]);}
    asm volatile("s_waitcnt lgkmcnt(0)":::"memory");
    #pragma unroll
    for(int i=0;i<4;++i){const int row=i*8+(lane>>3),ch=lane&7; const u32x4 v=*(const u32x4*)(stg+row*64+ch*8); ATTN_STORE16(Ow+(long)row*OP+ch*8,v);} }
  asm volatile("s_waitcnt lgkmcnt(0)\n\ts_barrier":::"memory");
  #undef DMA_K
  #undef DMA_V
  #undef CMASK
  #undef START
  #undef RESC
  #undef ROT
}
constexpr int ATTN_LDS_BYTES=LDS_BYTES;
#undef SBAR
#undef WAIT_BAR
}

__device__ __forceinline__ void attn_phase_run(const P& p, unsigned char* lds_generic, int layer) {
    typedef attn_body::bf16 abf;
    const int G = gridDim.x, bx = blockIdx.x, vcu = (G % 8 == 0) ? (bx % 8) * (G / 8) + bx / 8 : bx;
    const abf* Q = (const abf*)(p.ws + WS_ATTQ); const abf* K = (const abf*)(p.ws + WS_ATTK); const abf* V = (const abf*)(p.ws + WS_ATTV); abf* X = (abf*)(p.ws + WS_X);
    if (G == 256) {
        const int x = vcu >> 5, qb = vcu & 31, b = x >> 2, kvh = (x >> 1) & 1;
#pragma unroll 1
        for (int i = 0; i < 2; ++i) { const int h = kvh * 4 + 2 * (x & 1) + i; const long r0 = (long)b * SEQ + qb * 256;
            attn_body::attn_unit<8>(Q + r0 * 512 + h * 64, K + (long)b * KEYS * 128 + kvh * 64, V + (long)b * KEYS * 128 + kvh * 64, X + r0 * 1536 + 768 + h * 64, KEYS / 64, (char*)lds_generic); }
    } else {
#pragma unroll 1
        for (int u = vcu; u < 512; u += G) { const int qb = u & 31, h = (u >> 5) & 7, b = u >> 8, kvh = h >> 2; const long r0 = (long)b * SEQ + qb * 256;
            attn_body::attn_unit<8>(Q + r0 * 512 + h * 64, K + (long)b * KEYS * 128 + kvh * 64, V + (long)b * KEYS * 128 + kvh * 64, X + r0 * 1536 + 768 + h * 64, KEYS / 64, (char*)lds_generic); }
    }
    if (layer == 0) {
#pragma unroll 1
        for (int u = vcu; u < 16; u += G) { const int b = u >> 3, h = u & 7, kvh = h >> 2; const long r0 = NLAT + (long)b * CTX;
            attn_body::attn_unit<8>(Q + r0 * 512 + h * 64, K + (long)b * KEYS * 128 + kvh * 64, V + (long)b * KEYS * 128 + kvh * 64, X + r0 * 1536 + 768 + h * 64, CTX / 64, (char*)lds_generic); }
    }
}

__device__ __forceinline__ void ph_fft1(const P& p, LAS unsigned char* lds, int layer) {
    { fg::PlainSched S{(const char*)(p.ws + WS_F1), (const char*)(p.ws + WS_UT), 256, 256, 1, 128, (int)gridDim.x, (int)blockIdx.x, 4};
      fg::EpiFft1 E{p.ws}; fg::gemm_phase(lds, 256, 256, S, E); }
    if (layer == 0) { fg::PlainSched S{(const char*)(p.ws + WS_FC), (const char*)(p.ws + WS_UTC), 256, 256, 2, 2, (int)gridDim.x, (int)((blockIdx.x + 128) % gridDim.x), 4};
      fg::EpiFftC E{p.ws}; fg::gemm_phase(lds, 256, 256, S, E); }
}
__device__ __forceinline__ void ph_fft3(const P& p, LAS unsigned char* lds) {
    fg::PlainSched S{(const char*)(p.ws + WS_F2), (const char*)(p.ws + WS_Z), 256, 256, 1, 256, (int)gridDim.x, (int)blockIdx.x, 4};
    fg::EpiFft3 E{p.ws}; fg::gemm_phase(lds, 256, 256, S, E);
}
__device__ __forceinline__ void ph_mix1(const P& p, LAS unsigned char* lds, int layer) {
    ph_fft1(p, lds, layer);
    const int nconv = layer == 0 ? 264 : 256;
    const int n0 = nconv, n1 = n0 + NB * NCHUNK * 4;
    for (int it = gridDim.x - 1 - blockIdx.x; it < n1; it += gridDim.x) {
        if (it < n0) { if (it < 256) conv_item(p, lds, layer, it >> 7, (it & 127) * 64); else conv_item(p, lds, layer, 2 + ((it - 256) >> 2), ((it - 256) & 3) * 64); }
        else ret_kv_item(p, lds, layer, it - n0);
    }
    __syncthreads();
}
__device__ __forceinline__ void ph_mix2(const P& p, LAS unsigned char* lds, unsigned char* lds_generic, int layer) {
    for (int it = blockIdx.x; it < 128; it += gridDim.x) ret_scan_item(p, layer, it);
    __syncthreads();
    ph_fft3(p, lds);
    attn_phase_run(p, lds_generic, layer);
    __syncthreads();
}
__device__ __forceinline__ void ph_mix3(const P& p, LAS unsigned char* lds, int layer) {
    for (int it = blockIdx.x; it < NB * NCHUNK * 4; it += gridDim.x) {
        const int n = (it >> 2) % NCHUNK; if (layer == 1 && n < 2) continue;
        ret_out_item(p, lds, layer, it);
    }
    __syncthreads();
}

namespace sk {
typedef short bf16x8 __attribute__((ext_vector_type(8)));
__device__ __forceinline__ void tile64(LAS unsigned char* lds, const bf16* A, int lda, const bf16* Bt, int ldb, int K, float (&out)[8]) {
    const int tid = threadIdx.x, lane = tid & 63, w = tid >> 6, kc = K >> 3;
    const bf16* ap = A + (size_t)(lane & 15) * lda + w * kc + 8 * (lane >> 4); const bf16* bp = Bt + (size_t)(lane & 15) * ldb + w * kc + 8 * (lane >> 4);
    f32x4 acc[4][4];
#pragma unroll
    for (int i = 0; i < 4; ++i)
#pragma unroll
        for (int j = 0; j < 4; ++j) acc[i][j] = (f32x4){0.f, 0.f, 0.f, 0.f};
#pragma unroll 2
    for (int k0 = 0; k0 < kc; k0 += 32) {
        bf16x8 af[4], bfr[4];
#pragma unroll
        for (int i = 0; i < 4; ++i) { af[i] = *(const bf16x8*)(ap + (size_t)(16 * i) * lda + k0); bfr[i] = *(const bf16x8*)(bp + (size_t)(16 * i) * ldb + k0); }
#pragma unroll
        for (int i = 0; i < 4; ++i)
#pragma unroll
            for (int j = 0; j < 4; ++j) acc[i][j] = __builtin_amdgcn_mfma_f32_16x16x32_bf16(af[i], bfr[j], acc[i][j], 0, 0, 0);
    }
    LAS float* part = (LAS float*)lds;
    __syncthreads();
#pragma unroll
    for (int i = 0; i < 4; ++i)
#pragma unroll
        for (int j = 0; j < 4; ++j)
#pragma unroll
            for (int r = 0; r < 4; ++r) part[((w * 16 + i * 4 + j) * 4 + r) * 64 + lane] = acc[i][j][r];
    __syncthreads();
#pragma unroll
    for (int q = 0; q < 8; ++q) { float sacc = 0.f;
#pragma unroll
        for (int ww = 0; ww < 8; ++ww) sacc += part[ww * 4096 + tid + 512 * q];
        out[q] = sacc; }
}
__device__ __forceinline__ void tile64_f8(LAS unsigned char* lds, const unsigned char* A, int lda, const unsigned char* Bt, int ldb, int K, float (&out)[8]) {
    const int tid = threadIdx.x, lane = tid & 63, w = tid >> 6;
    const unsigned char* ap = A + (size_t)(lane & 15) * lda + 32 * (lane >> 4); const unsigned char* bp = Bt + (size_t)(lane & 15) * ldb + 32 * (lane >> 4);
    f32x4 acc[4][4];
#pragma unroll
    for (int i = 0; i < 4; ++i)
#pragma unroll
        for (int j = 0; j < 4; ++j) acc[i][j] = (f32x4){0.f, 0.f, 0.f, 0.f};
    for (int ks = w; ks * 128 < K; ks += 8) {
        fg::i32x8 af[4], bfr[4];
#pragma unroll
        for (int i = 0; i < 4; ++i) { af[i] = *(const fg::i32x8*)(ap + (size_t)(16 * i) * lda + ks * 128); bfr[i] = *(const fg::i32x8*)(bp + (size_t)(16 * i) * ldb + ks * 128); }
#pragma unroll
        for (int i = 0; i < 4; ++i)
#pragma unroll
            for (int j = 0; j < 4; ++j) acc[i][j] = __builtin_amdgcn_mfma_scale_f32_16x16x128_f8f6f4(af[i], bfr[j], acc[i][j], 0, 0, 0, 0x7f7f7f7f, 0, 0x7a7a7a7a);
    }
    LAS float* part = (LAS float*)lds;
    __syncthreads();
#pragma unroll
    for (int i = 0; i < 4; ++i)
#pragma unroll
        for (int j = 0; j < 4; ++j)
#pragma unroll
            for (int r = 0; r < 4; ++r) part[((w * 16 + i * 4 + j) * 4 + r) * 64 + lane] = acc[i][j][r];
    __syncthreads();
#pragma unroll
    for (int q = 0; q < 8; ++q) { float sacc = 0.f;
#pragma unroll
        for (int ww = 0; ww < 8; ++ww) sacc += part[ww * 4096 + tid + 512 * q];
        out[q] = sacc; }
}
__device__ __forceinline__ void elem_rc(int tid, int q, int& row, int& col) { const int e = tid + 512 * q, t16 = e >> 8, reg = (e >> 6) & 3, lane = e & 63; row = 16 * (t16 >> 2) + 4 * (lane >> 4) + reg; col = 16 * (t16 & 3) + (lane & 15); }
}
__device__ __forceinline__ void mini_merge_ctx(const P& p, LAS unsigned char* lds, int layer) {
    const bf16* X = (const bf16*)(p.ws + WS_X); const bf16* WB = (const bf16*)(p.ws + WS_WB) + (size_t)layer * 1024 * 1536; const bf16* G = (const bf16*)(p.ws + WS_G); bf16* Mg = (bf16*)(p.ws + WS_MERGED);
    for (int it = gridDim.x - 1 - blockIdx.x; it < (NCTX / 64) * 16; it += gridDim.x) { const int r0 = NLAT + (it >> 4) * 64, c0 = (it & 15) * 64;
        float tot[8];
#pragma unroll
        for (int q = 0; q < 8; ++q) tot[q] = 0.f;
#pragma unroll 1
        for (int br = 0; br < 4; ++br) { const int koff = br == 0 ? 0 : (br == 1 ? 512 : (br == 2 ? 768 : 1280)), klen = (br & 1) ? 256 : 512;
            float o[8]; sk::tile64(lds, X + (size_t)r0 * 1536 + koff, 1536, WB + (size_t)c0 * 1536 + koff, 1536, klen, o);
#pragma unroll
            for (int q = 0; q < 8; ++q) { int rr, cc; sk::elem_rc(threadIdx.x, q, rr, cc); tot[q] += o[q] * bf2f(G[(size_t)(r0 + rr) * 4096 + br * 1024 + c0 + cc]); } }
#pragma unroll
        for (int q = 0; q < 8; ++q) { int rr, cc; sk::elem_rc(threadIdx.x, q, rr, cc); Mg[(size_t)(r0 + rr) * 1024 + c0 + cc] = f2bf(tot[q]); } }
    __syncthreads();
}
__device__ __forceinline__ void mini_resid_ctx(const P& p, LAS unsigned char* lds, int layer, const bf16* A, int lda, const bf16* Bt, int K, int chunk) {
    const float* g = mods(p, layer, 2, chunk); float* hc = (float*)(p.ws + WS_HCTX);
    for (int it = gridDim.x - 1 - blockIdx.x; it < (NCTX / 64) * 16; it += gridDim.x) { const int rl = (it >> 4) * 64, c0 = (it & 15) * 64;
        float o[8]; sk::tile64(lds, A + (size_t)(NLAT + rl) * lda, lda, Bt + (size_t)c0 * K, K, K, o);
#pragma unroll
        for (int q = 0; q < 8; ++q) { int rr, cc; sk::elem_rc(threadIdx.x, q, rr, cc); float* h = hc + (size_t)(rl + rr) * D + c0 + cc; *h = *h + g[c0 + cc] * o[q]; } }
    __syncthreads();
}
__device__ __forceinline__ void ph_merge(const P& p, LAS unsigned char* lds, int layer, int nrows) {
    fg::MergeSched S{(const char*)(p.ws + WS_X), (const char*)(p.ws + WS_WB) + (size_t)layer * 1024 * 1536 * 2, nrows / 256, (int)gridDim.x, (int)blockIdx.x};
    fg::EpiMerge E{(const bf16*)(p.ws + WS_G), (bf16*)(p.ws + WS_MERGED)};
    fg::gemm_phase(lds, 1536, 1536, S, E);
}
__device__ __forceinline__ void ph_gemm_resid(const P& p, LAS unsigned char* lds, int layer, const bf16* A, int lda, const bf16* Bt, int K, int chunk, int nrows) {
    fg::PlainSched S{(const char*)A, (const char*)Bt, lda, K, nrows / 256, 4, (int)gridDim.x, (int)blockIdx.x, K / 64};
    fg::EpiResid E{p.out, (float*)(p.ws + WS_HCTX), (const float*)(p.ws + WS_MODS) + (size_t)layer * 3 * 6144, chunk};
    fg::gemm_phase(lds, lda, K, S, E);
}
__device__ __forceinline__ void ph_ffn1(const P& p, LAS unsigned char* lds) {
    fg::PlainSched S{(const char*)(p.ws + WS_A), (const char*)(p.ws + WS_FFN1), D, D, MROWS / 256, 22, (int)gridDim.x, (int)blockIdx.x, D / 64};
    fg::EpiSwiglu E{(bf16*)(p.ws + WS_HMID)};
    fg::gemm_phase(lds, D, D, S, E);
}
__device__ __forceinline__ int moe_tiles(const P& p, LAS int* tile_e) {
    const unsigned* ctl = (const unsigned*)(p.ws + WS_CTL); int t = 0;
    for (int e = 0; e < NEXP; ++e) { const int c = (int)ctl[CW_CNT + e], nt = (c + 255) >> 8; for (int q = 0; q < nt; ++q) { if (threadIdx.x == 0) tile_e[t + q] = e; } t += nt; }
    __syncthreads();
    return t;
}
__device__ __forceinline__ void ph_assign_gather(const P& p, LAS unsigned char* lds) {
    const int tid = threadIdx.x, bid = blockIdx.x, G = gridDim.x;
    LAS int* sbase = (LAS int*)lds;
    LAS int* stot = sbase + 8;
    LAS int* spst = stot + 8;
    LAS int* sexp = spst + 16;
    LAS int* sslot = sexp + 128;
    const unsigned* cntb = (const unsigned*)(p.ws + WS_ROUTE) + 16384 * 6;
    const int* tok_e = (const int*)(p.ws + WS_ROUTE); int* tok_slot = (int*)(p.ws + WS_ROUTE) + 16384 * 4;
    __syncthreads();
    { const int e = tid >> 6, l = tid & 63; int tot = 0, below = 0;
      for (int b = l; b < G; b += 64) { const int c = (int)cntb[b * NEXP + e]; tot += c; if (b < bid) below += c; }
#pragma unroll
      for (int o = 1; o < 64; o <<= 1) { tot += __shfl_xor(tot, o); below += __shfl_xor(below, o); }
      if (l == 0) { sbase[e] = below; stot[e] = tot; } }
    if (tid < 128) { const int li = tid >> 1, w = li & 7, k = li >> 3, tok = (bid * 8 + w) + k * (G * 8); sexp[tid] = tok < NLAT ? tok_e[tok * 2 + (tid & 1)] : -1; }
    __syncthreads();
    if (tid == 0) { int t = 0; for (int e = 0; e < NEXP; ++e) { spst[e] = t * 256; t += (stot[e] + 255) >> 8; } spst[NEXP] = t * 256;
        if (bid == 0) { unsigned* ctl = (unsigned*)(p.ws + WS_CTL); for (int e = 0; e < NEXP; ++e) ctl[CW_CNT + e] = (unsigned)stot[e]; } }
    __syncthreads();
    if (tid < 128) { const int e = sexp[tid]; int slot = -1;
        if (e >= 0) { int rank = 0; for (int a = 0; a < tid; ++a) rank += (sexp[a] == e) ? 1 : 0; slot = spst[e] + sbase[e] + rank;
            const int li = tid >> 1, w = li & 7, k = li >> 3, tok = (bid * 8 + w) + k * (G * 8); tok_slot[tok * 2 + (tid & 1)] = slot; }
        sslot[tid] = slot; }
    __syncthreads();
    const int lane = tid & 63, wv = tid >> 6; const bf16* A = (const bf16*)(p.ws + WS_A); unsigned char* FS8 = p.ws + WS_FS;
    for (int a = wv; a < 128; a += 8) { const int slot = sslot[a]; if (slot < 0) continue; const int li = a >> 1, w = li & 7, k = li >> 3, tok = (bid * 8 + w) + k * (G * 8);
        { const u32x4 v0 = *(const u32x4*)(A + (size_t)tok * D + lane * 16), v1 = *(const u32x4*)(A + (size_t)tok * D + lane * 16 + 8);
          const f32x4 a = fg::unpk_lo(v0.x, v0.y), b = fg::unpk_lo(v0.z, v0.w), c = fg::unpk_lo(v1.x, v1.y), d = fg::unpk_lo(v1.z, v1.w);
          u32x4 o; o.x = pk4_fp8(a[0], a[1], a[2], a[3]); o.y = pk4_fp8(b[0], b[1], b[2], b[3]); o.z = pk4_fp8(c[0], c[1], c[2], c[3]); o.w = pk4_fp8(d[0], d[1], d[2], d[3]);
          *(u32x4*)(FS8 + (size_t)slot * D + lane * 16) = o; } }
    { int idx = 0;
      for (int e = 0; e < NEXP; ++e) { const int lo_ = spst[e] + stot[e], hi_ = spst[e + 1];
          for (int r = lo_ + ((bid * 8 + wv - idx) % (G * 8) + (G * 8)) % (G * 8); r < hi_; r += G * 8) {
              *(u32x4*)(FS8 + (size_t)r * D + lane * 16) = (u32x4){0u, 0u, 0u, 0u}; }
          idx += hi_ - lo_; } }
    __syncthreads();
}
__device__ __forceinline__ void ph_moe1(const P& p, LAS unsigned char* lds) {
    LAS int* tile_e = (LAS int*)(lds + fg::STAGE_BYTES); const int nt = moe_tiles(p, tile_e);
    fg::ExpertSched S{(const char*)(p.ws + WS_FS), (const char*)(p.ws + WS_MOE1), D / 2, D / 2, nt, 22, (int)gridDim.x, (int)blockIdx.x, D / 128, tile_e, (size_t)5632 * D};
    fg::EpiSwiglu8 E{p.ws + WS_HMOE};
    fg::gemm_phase<fg::EpiSwiglu8, fg::ExpertSched, true>(lds, D / 2, D / 2, S, E);
}
__device__ __forceinline__ void ph_moe2(const P& p, LAS unsigned char* lds) {
    LAS int* tile_e = (LAS int*)(lds + fg::STAGE_BYTES); const int nt = moe_tiles(p, tile_e);
    const int nbig = nt < 128 ? nt : 128;
    fg::ExpertSched S{(const char*)(p.ws + WS_HMOE), (const char*)(p.ws + WS_MOE2), FFN / 2, FFN / 2, nbig, 4, (int)gridDim.x, (int)blockIdx.x, FFN / 128, tile_e, (size_t)D * FFN};
    fg::EpiStore E{(bf16*)(p.ws + WS_Y2), D};
    fg::gemm_phase<fg::EpiStore, fg::ExpertSched, true>(lds, FFN / 2, FFN / 2, S, E);
    const unsigned char* A = p.ws + WS_HMOE; bf16* Y = (bf16*)(p.ws + WS_Y2);
    for (int it = blockIdx.x; it < (nt - nbig) * 64; it += gridDim.x) {
        const int rt = nbig + (it >> 6), r0 = rt * 256 + ((it >> 4) & 3) * 64, c0 = (it & 15) * 64;
        const unsigned char* B = p.ws + WS_MOE2 + (size_t)tile_e[rt] * D * FFN;
        float o[8]; sk::tile64_f8(lds, A + (size_t)r0 * FFN, FFN, B + (size_t)c0 * FFN, FFN, FFN, o);
#pragma unroll
        for (int q = 0; q < 8; ++q) { int rr, cc; sk::elem_rc(threadIdx.x, q, rr, cc); Y[(size_t)(r0 + rr) * D + c0 + cc] = f2bf(o[q]); } }
    __syncthreads();
}
__device__ __forceinline__ void ph_combine(const P& p, int layer) {
    const int lane = threadIdx.x & 63, gw = blockIdx.x * 8 + (threadIdx.x >> 6), ngw = gridDim.x * 8;
    const float* tok_w = (const float*)(p.ws + WS_ROUTE) + 16384 * 2; const int* tok_slot = (const int*)(p.ws + WS_ROUTE) + 16384 * 4; const bf16* Y = (const bf16*)(p.ws + WS_Y2);
    for (int r = gw; r < NLAT; r += ngw) {
        const int s0 = tok_slot[r * 2], s1 = tok_slot[r * 2 + 1]; const float w0 = tok_w[r * 2], w1 = tok_w[r * 2 + 1];
        const float* g = mods(p, layer, row_mi(r), 5); float* h = p.out + (size_t)r * D;
#pragma unroll
        for (int j = 0; j < 4; ++j) { const int c = 4 * lane + 256 * j;
            const u32x2 a = *(const u32x2*)(Y + (size_t)s0 * D + c), bq = *(const u32x2*)(Y + (size_t)s1 * D + c); const f32x4 gg = *(const f32x4*)(g + c); f32x4 hv = *(f32x4*)(h + c);
            hv.x += gg.x * (w0 * __uint_as_float(a.x << 16) + w1 * __uint_as_float(bq.x << 16)); hv.y += gg.y * (w0 * __uint_as_float(a.x & 0xffff0000u) + w1 * __uint_as_float(bq.x & 0xffff0000u));
            hv.z += gg.z * (w0 * __uint_as_float(a.y << 16) + w1 * __uint_as_float(bq.y << 16)); hv.w += gg.w * (w0 * __uint_as_float(a.y & 0xffff0000u) + w1 * __uint_as_float(bq.y & 0xffff0000u));
            *(f32x4*)(h + c) = hv; }
    }
}

#define XB_TMO      128
#define XB_XCNT(j)  (256  + 64 * (j))
#define XB_XSUB(j)  (1280 + 64 * (j))
#define XB_XGEN(j)  (2304 + 64 * (j))
#define XB_TOP      3328
#define XB_TOPGEN   3392
#define XCD_BAR_WORDS 3456
#define XB_SPIN_CAP (1u << 22)
__device__ __forceinline__ unsigned xb_ld(unsigned* p)              { return __hip_atomic_load(p, __ATOMIC_RELAXED, __HIP_MEMORY_SCOPE_AGENT); }
__device__ __forceinline__ unsigned xb_add(unsigned* p, unsigned v) { return __hip_atomic_fetch_add(p, v, __ATOMIC_RELAXED, __HIP_MEMORY_SCOPE_AGENT); }
__device__ __forceinline__ unsigned xb_xcc_id() { return (unsigned)__builtin_amdgcn_s_getreg((3 << 11) | 20) & 0xFu; }
#define XB_SPIN(cond, bar) do { unsigned _sp = 0; while (cond) { __builtin_amdgcn_s_sleep(1); \
    if ((++_sp & 255u) == 0u) { if (xb_ld(&(bar)[XB_TMO])) break; if (_sp > XB_SPIN_CAP) { atomicAdd(&(bar)[XB_TMO], 1u); break; } } } } while (0)
struct XcdBarrier { unsigned* bar; unsigned x; volatile LAS unsigned* st; };
__device__ __forceinline__ XcdBarrier xcd_barrier_post(unsigned* bar, volatile LAS unsigned* st) {
    XcdBarrier b; b.bar = bar; b.x = xb_xcc_id(); b.st = st;
    if (threadIdx.x == 0) (void)xb_add(&bar[XB_XCNT(b.x)], 1u);
    return b;
}
__device__ __forceinline__ void xcd_barrier_complete(unsigned* bar, unsigned x, unsigned& nloc, unsigned& nx) {
    const unsigned G = gridDim.x * gridDim.y * gridDim.z;
    unsigned sum, cnt, mine, sp = 0u;
    for (;;) {
        sum = 0u; cnt = 0u; mine = 0u;
#pragma unroll
        for (unsigned j = 0; j < 16; ++j) { const unsigned c = xb_ld(&bar[XB_XCNT(j)]); sum += c; cnt += (c > 0u) ? 1u : 0u; mine = (j == x) ? c : mine; }
        if (sum == G) break;
        __builtin_amdgcn_s_sleep(1);
        if ((++sp & 255u) == 0u) { if (xb_ld(&bar[XB_TMO])) break; if (sp > XB_SPIN_CAP) { atomicAdd(&bar[XB_TMO], 1u); break; } }
    }
    nloc = mine > 0u ? mine : 1u; nx = cnt > 0u ? cnt : 1u;
}
__device__ __forceinline__ void xcd_barrier(const XcdBarrier& b) {
    asm volatile("s_waitcnt vmcnt(0)" ::: "memory");
    __syncthreads();
    if (threadIdx.x == 0) {
        unsigned* bar = b.bar;
        __builtin_amdgcn_s_waitcnt(0);
        unsigned nloc = b.st[0], nx = b.st[1];
        if (nloc == 0u) { xcd_barrier_complete(bar, b.x, nloc, nx); b.st[0] = nloc; b.st[1] = nx; }
        const unsigned old = xb_add(&bar[XB_XSUB(b.x)], 1u);
        const unsigned gen = old / nloc;
        if (old + 1u == (gen + 1u) * nloc) {
            __builtin_amdgcn_fence(__ATOMIC_RELEASE, "agent");
            asm volatile("s_waitcnt vmcnt(0)" ::: "memory");
            const unsigned og = xb_add(&bar[XB_TOP], 1u);
            const unsigned tg = og / nx;
            if (og + 1u == (tg + 1u) * nx) xb_add(&bar[XB_TOPGEN], 1u);
            else XB_SPIN(xb_ld(&bar[XB_TOPGEN]) == tg, bar);
            __builtin_amdgcn_fence(__ATOMIC_ACQUIRE, "agent");
            xb_add(&bar[XB_XGEN(b.x)], 1u);
            asm volatile("s_waitcnt vmcnt(0)" ::: "memory");
        } else {
            XB_SPIN(xb_ld(&bar[XB_XGEN(b.x)]) == gen, bar);
            __builtin_amdgcn_fence(__ATOMIC_ACQUIRE, "agent");
            asm volatile("s_waitcnt vmcnt(0)" ::: "memory");
        }
    }
    __syncthreads();
}

constexpr int NPHASE = 23;
constexpr int LDS_BYTES = 150 * 1024;
__global__ void __launch_bounds__(NTHREADS, 2) mk(P p, int lo, int hi) {
    extern __shared__ __attribute__((aligned(16))) unsigned char lds_raw[];
    LAS unsigned char* lds = (LAS unsigned char*)lds_raw;
    volatile LAS unsigned* misc = (volatile LAS unsigned*)(lds + LDS_BYTES - 64);
    if (threadIdx.x < 16) misc[threadIdx.x] = 0u;
    __syncthreads();
    XcdBarrier bar; bar.bar = (unsigned*)(p.ws + WS_CTL) + CW_BAR; bar.x = 0; bar.st = misc;
    if (hi - lo > 1) bar = xcd_barrier_post((unsigned*)(p.ws + WS_CTL) + CW_BAR, misc);
#ifndef PROBE_MASK
#define PROBE_MASK 0u
#endif
#define PH(k, body) do { if (lo <= (k) && (k) < hi) { if ((k) > lo) { if (MK_SINGLE && (k) == 1) cg::this_grid().sync(); else xcd_barrier(bar); } body; \
    if ((PROBE_MASK >> (k)) & 1u) { xcd_barrier(bar); body; } } } while (0)
#define LAYER_PHASES(L, base) \
    PH(base + 0, ph_win(p, lds, L)); \
    PH(base + 1, ph_mix1(p, lds, L)); \
    PH(base + 2, ph_mix2(p, lds, lds_raw, L)); \
    PH(base + 3, ph_mix3(p, lds, L)); \
    PH(base + 4, { ph_merge(p, lds, L, NLAT); if (L == 0) mini_merge_ctx(p, lds, L); }); \
    PH(base + 5, { ph_gemm_resid(p, lds, L, (const bf16*)(p.ws + WS_MERGED), 1024, (const bf16*)(p.ws + WS_WOUT) + (size_t)L * D * D, D, 2, NLAT); if (L == 0) mini_resid_ctx(p, lds, L, (const bf16*)(p.ws + WS_MERGED), 1024, (const bf16*)(p.ws + WS_WOUT), D, 2); });
    PH(0, ph_prologue(p, lds));
    PH(1, ph_norm(p, lds, 0, 0, true, false, MROWS));
    LAYER_PHASES(0, 2)
    PH(8, ph_norm(p, lds, 0, 1, false, false, MROWS));
    PH(9, ph_ffn1(p, lds));
    PH(10, { ph_gemm_resid(p, lds, 0, (const bf16*)(p.ws + WS_HMID), FFN, (const bf16*)(p.ws + WS_FFN2), FFN, 5, NLAT); mini_resid_ctx(p, lds, 0, (const bf16*)(p.ws + WS_HMID), FFN, (const bf16*)(p.ws + WS_FFN2), FFN, 5); });
    PH(11, ph_norm(p, lds, 1, 0, false, false, MROWS));
    LAYER_PHASES(1, 12)
    PH(18, ph_norm(p, lds, 1, 1, false, true, NLAT));
    PH(19, { ph_assign_gather(p, lds); ph_moe_convert(p, lds); });
    PH(20, ph_moe1(p, lds));
    PH(21, ph_moe2(p, lds));
    PH(22, ph_combine(p, 1));
#undef PH
#undef LAYER_PHASES
}

extern "C" void kernel_launch(void* const* d_in, const int* in_sizes, int n_in, void* d_out, int out_size, void* d_ws, size_t ws_size, hipStream_t stream) {
    static int grid = 0;
    if (grid == 0) {
        if (n_in != 30 || out_size != NLAT * D || ws_size < WS_END) { fprintf(stderr, "kernel_launch: unexpected shapes (n_in %d out %d ws %zu)\n", n_in, out_size, ws_size); grid = -1; return; }
        int dev = 0, cus = 0, per_cu = 0;
        hipGetDevice(&dev); hipDeviceGetAttribute(&cus, hipDeviceAttributeMultiprocessorCount, dev);
        hipFuncSetAttribute((const void*)mk, hipFuncAttributeMaxDynamicSharedMemorySize, LDS_BYTES);
        hipOccupancyMaxActiveBlocksPerMultiprocessor(&per_cu, (const void*)mk, NTHREADS, LDS_BYTES);
        if (per_cu < 1) { fprintf(stderr, "kernel_launch: occupancy query says %d blocks per CU\n", per_cu); grid = -1; return; }
        grid = cus;
    }
    if (grid < 0) return;
    hipMemsetAsync((char*)d_ws + WS_CTL, 0, CTL_BYTES, stream);
    P p{};
    for (int i = 0; i < 30; ++i) p.in[i] = (const float*)d_in[i];
    p.out = (float*)d_out; p.ws = (unsigned char*)d_ws;
#if MK_SINGLE
    int lo = 0, hi = NPHASE; void* args[] = {&p, &lo, &hi};
    hipLaunchCooperativeKernel((const void*)mk, dim3(grid), dim3(NTHREADS), args, LDS_BYTES, stream);
#else
    for (int ph = 0; ph < NPHASE; ++ph) hipLaunchKernelGGL(mk, dim3(grid), dim3(NTHREADS), LDS_BYTES, stream, p, ph, ph + 1);
#endif
}
```

```cpp
#include <hip/hip_runtime.h>
#include <hip/hip_cooperative_groups.h>
#include <cstdio>
#include <cstdint>
namespace cg = cooperative_groups;

#ifndef MK_SINGLE
#define MK_SINGLE 1
#endif

typedef unsigned short bf16;
typedef float f32x4 __attribute__((ext_vector_type(4)));
typedef unsigned u32x4 __attribute__((ext_vector_type(4)));
typedef unsigned u32x2 __attribute__((ext_vector_type(2)));
#define LAS __attribute__((address_space(3)))

constexpr int D = 1024, NB = 2, SEQ = 8192, CTX = 256, NLAT = NB * SEQ, NCTX = NB * CTX, MROWS = NLAT + NCTX;
constexpr int INC = 6656, FFN = 2816, NEXP = 8, KEYS = CTX + SEQ;
constexpr int NCHUNK = 66;
constexpr float EPS = 1e-6f;
constexpr float QSCALE = 0.125f * 1.4426950408889634f;
constexpr int MOE_ROWS = 34816;
constexpr int NTHREADS = 512;

constexpr size_t MiB = 1u << 20;
constexpr size_t WS_CTL = 0, CTL_BYTES = 1 * MiB;
constexpr size_t WS_MODS = 1 * MiB;
constexpr size_t WS_ROPE = 2 * MiB;
constexpr size_t WS_F1 = 4 * MiB;
constexpr size_t WS_F2 = WS_F1 + 131072;
constexpr size_t WS_FC = WS_F2 + 131072;
constexpr size_t WS_TW = WS_FC + 262144;
constexpr size_t WS_ROUTE = 5 * MiB;
constexpr size_t WS_HCTX = 6 * MiB;
constexpr size_t WS_WIN = 8 * MiB;
constexpr size_t WS_WB = 34 * MiB;
constexpr size_t WS_WOUT = 40 * MiB;
constexpr size_t WS_FFN1 = 44 * MiB;
constexpr size_t WS_FFN2 = 55 * MiB;
constexpr size_t WS_A = 61 * MiB;
constexpr size_t WS_X = 94 * MiB;
constexpr size_t WS_Y = 144 * MiB;
constexpr size_t WS_RETQ = WS_Y;
constexpr size_t WS_RETK = WS_RETQ + (size_t)MROWS * 256 * 2;
constexpr size_t WS_RETV = WS_RETK + (size_t)MROWS * 256 * 2;
constexpr size_t WS_RETG = WS_RETV + (size_t)MROWS * 256 * 2;
constexpr size_t WS_ATTQ = WS_Y + 33 * MiB;
constexpr size_t WS_ATTK = WS_Y + 50 * MiB;
constexpr size_t WS_ATTV = WS_Y + 55 * MiB;
constexpr size_t WS_CONV = WS_Y + 60 * MiB;
constexpr size_t WS_UT = WS_Y + 77 * MiB;
constexpr size_t WS_UTC = WS_Y + 93 * MiB;
constexpr size_t WS_Z = WS_Y + 94 * MiB;
constexpr size_t WS_RETS = WS_Y + 126 * MiB;
constexpr size_t WS_MERGED = WS_Y + 143 * MiB;
constexpr size_t WS_G = 320 * MiB;
constexpr size_t WS_MOE1 = WS_G;
constexpr size_t WS_MOE2 = WS_G + (size_t)NEXP * 5632 * 1024 * 2;
constexpr size_t WS_HMID = WS_Y;
constexpr size_t WS_HMOE = 61 * MiB;
constexpr size_t WS_FS = 252 * MiB;
constexpr size_t WS_RETS2 = 452 * MiB;
constexpr size_t WS_Y2 = 160 * MiB;
constexpr size_t WS_END = 469 * MiB;
static_assert(WS_MERGED + (size_t)MROWS * 1024 * 2 <= WS_G, "map");
static_assert(WS_HMOE + (size_t)MOE_ROWS * FFN * 2 <= WS_FS && WS_FS + (size_t)MOE_ROWS * 1024 * 2 <= WS_G, "map moe");
static_assert(WS_MOE2 + (size_t)NEXP * 1024 * FFN * 2 <= WS_END, "map moe w");
constexpr int CW_CNT = 64;
constexpr int CW_CUR = 128;
constexpr int CW_BAR = 4096;
constexpr int CW_TMO = CW_BAR + 128;
constexpr int CW_PCNT = 8192;
constexpr int CW_CCNT = 8192 + 4 * 64 * 16;
constexpr size_t CTL_XBUF = 128 * 1024;

struct P {
    const float* in[30];
    float* out;
    unsigned char* ws;
};

__device__ __forceinline__ float bf2f(bf16 v) { return __uint_as_float((unsigned)v << 16); }
__device__ __forceinline__ bf16 f2bf(float f) { unsigned u = __float_as_uint(f); return (bf16)((u + 0x7fffu + ((u >> 16) & 1u)) >> 16); }
__device__ __forceinline__ unsigned pk2(float lo, float hi) { return (unsigned)f2bf(lo) | ((unsigned)f2bf(hi) << 16); }
__device__ __forceinline__ float sigmoidf_(float x) { return 1.f / (1.f + __expf(-x)); }
__device__ __forceinline__ float siluf_(float x) { return x / (1.f + __expf(-x)); }
__device__ __forceinline__ float sigmoid_fast(float x) { return __builtin_amdgcn_rcpf(1.f + __builtin_amdgcn_exp2f(-1.4426950408889634f * x)); }
__device__ __forceinline__ float silu_fast(float x) { return x * __builtin_amdgcn_rcpf(1.f + __builtin_amdgcn_exp2f(-1.4426950408889634f * x)); }
__device__ __forceinline__ float wave_sum(float v) {
#pragma unroll
    for (int o = 1; o < 64; o <<= 1) v += __shfl_xor(v, o);
    return v;
}
__device__ __forceinline__ int row_mi(int r) { return r < NLAT ? (r >> 13) : 2; }
__device__ __forceinline__ float* hrow(const P& p, int r) { return r < NLAT ? p.out + (size_t)r * D : (float*)(p.ws + WS_HCTX) + (size_t)(r - NLAT) * D; }
__device__ __forceinline__ const float* mods(const P& p, int layer, int mi, int chunk) { return (const float*)(p.ws + WS_MODS) + ((size_t)(layer * 3 + mi) * 6 + chunk) * D; }

__device__ __forceinline__ int rowmap(int mode, int n) {
    if (mode == 0) return n;
    if (mode == 1 || mode == 2) return 8 * (n >> 2) + (n & 3) + (mode == 2 ? 4 : 0);
    const int tile = n >> 8, l = n & 255, head = l >> 6, d = l & 63;
    const bool ropet = tile == 1 || tile == 2 || tile == 5 || tile == 6 || (tile == 7 && head < 2);
    if (ropet) { const int i = d & 31, nn = d >> 5; return tile * 256 + 128 * (i >> 4) + 32 * head + 8 * ((i >> 2) & 3) + 4 * nn + (i & 3); }
    if (tile == 7) return tile * 256 + 128 * (d >> 5) + 32 * head + 8 * ((d >> 3) & 3) + (d & 7);
    return n;
}
__device__ __forceinline__ void conv_tile(LAS float* scr, const float* src, int ldn, int k0, int n0, bf16* dst, int ldd, int koff, int mode) {
    const int tid = threadIdx.x;
    __syncthreads();
#pragma unroll
    for (int i = 0; i < 8; ++i) { const int e = tid + i * NTHREADS, kk = e >> 6, nn = e & 63; scr[kk * 65 + nn] = src[(size_t)(k0 + kk) * ldn + n0 + nn]; }
    __syncthreads();
    const int nn = tid >> 3, kc = (tid & 7) * 8;
    u32x4 o; o.x = pk2(scr[(kc + 0) * 65 + nn], scr[(kc + 1) * 65 + nn]); o.y = pk2(scr[(kc + 2) * 65 + nn], scr[(kc + 3) * 65 + nn]);
    o.z = pk2(scr[(kc + 4) * 65 + nn], scr[(kc + 5) * 65 + nn]); o.w = pk2(scr[(kc + 6) * 65 + nn], scr[(kc + 7) * 65 + nn]);
    *(u32x4*)(dst + (size_t)rowmap(mode, n0 + nn) * ldd + koff + k0 + kc) = o;
}
constexpr float F8_WSCALE = 32.f;
__device__ __forceinline__ unsigned pk4_fp8(float a, float b, float c, float d) { int w = 0; w = __builtin_amdgcn_cvt_pk_fp8_f32(a, b, w, false); w = __builtin_amdgcn_cvt_pk_fp8_f32(c, d, w, true); return (unsigned)w; }
__device__ __forceinline__ void conv_tile2_f8(LAS float* scr, const float* src, int ldn, unsigned char* dst8, int ldd, int mode, int k0a, int n0a, int k0b, int n0b, bool two) {
    const int tid = threadIdx.x;
    f32x4 va[2], vb[2];
#pragma unroll
    for (int i = 0; i < 2; ++i) { const int e = tid + i * NTHREADS, kk = e >> 4, n4 = (e & 15) * 4;
        va[i] = *(const f32x4*)(src + (size_t)(k0a + kk) * ldn + n0a + n4);
        if (two) vb[i] = *(const f32x4*)(src + (size_t)(k0b + kk) * ldn + n0b + n4); }
    __syncthreads();
#pragma unroll
    for (int i = 0; i < 2; ++i) { const int e = tid + i * NTHREADS, kk = e >> 4, n4 = (e & 15) * 4;
#pragma unroll
        for (int q = 0; q < 4; ++q) { scr[kk * 65 + n4 + q] = va[i][q]; if (two) scr[64 * 65 + kk * 65 + n4 + q] = vb[i][q]; } }
    __syncthreads();
    const int nn = tid >> 3, kc = (tid & 7) * 8;
#pragma unroll
    for (int t = 0; t < 2; ++t) { if (t == 1 && !two) break; const LAS float* sp = scr + t * 64 * 65; const int k0 = t ? k0b : k0a, n0 = t ? n0b : n0a;
        u32x2 o; o.x = pk4_fp8(sp[(kc + 0) * 65 + nn] * F8_WSCALE, sp[(kc + 1) * 65 + nn] * F8_WSCALE, sp[(kc + 2) * 65 + nn] * F8_WSCALE, sp[(kc + 3) * 65 + nn] * F8_WSCALE);
        o.y = pk4_fp8(sp[(kc + 4) * 65 + nn] * F8_WSCALE, sp[(kc + 5) * 65 + nn] * F8_WSCALE, sp[(kc + 6) * 65 + nn] * F8_WSCALE, sp[(kc + 7) * 65 + nn] * F8_WSCALE);
        *(u32x2*)(dst8 + (size_t)rowmap(mode, n0 + nn) * ldd + k0 + kc) = o; }
}
__device__ __forceinline__ void conv_tile128_f8(LAS float* scr, const float* src, int ldn, unsigned char* dst8, int ldd, int mode, int k0, int n0) {
    const int tid = threadIdx.x;
    f32x4 v[8];
#pragma unroll
    for (int i = 0; i < 8; ++i) { const int e = tid + i * NTHREADS, kk = e >> 5, n4 = (e & 31) * 4; v[i] = *(const f32x4*)(src + (size_t)(k0 + kk) * ldn + n0 + n4); }
    __syncthreads();
#pragma unroll
    for (int i = 0; i < 8; ++i) { const int e = tid + i * NTHREADS, kk = e >> 5, n4 = (e & 31) * 4;
#pragma unroll
        for (int q = 0; q < 4; ++q) scr[kk * 129 + n4 + q] = v[i][q]; }
    __syncthreads();
    const int nn = tid >> 2, kc = (tid & 3) * 32;
    u32x4 o[2];
#pragma unroll
    for (int h = 0; h < 2; ++h) { const LAS float* sp = scr + (kc + h * 16) * 129 + nn;
        o[h].x = pk4_fp8(sp[0] * F8_WSCALE, sp[129] * F8_WSCALE, sp[2 * 129] * F8_WSCALE, sp[3 * 129] * F8_WSCALE);
        o[h].y = pk4_fp8(sp[4 * 129] * F8_WSCALE, sp[5 * 129] * F8_WSCALE, sp[6 * 129] * F8_WSCALE, sp[7 * 129] * F8_WSCALE);
        o[h].z = pk4_fp8(sp[8 * 129] * F8_WSCALE, sp[9 * 129] * F8_WSCALE, sp[10 * 129] * F8_WSCALE, sp[11 * 129] * F8_WSCALE);
        o[h].w = pk4_fp8(sp[12 * 129] * F8_WSCALE, sp[13 * 129] * F8_WSCALE, sp[14 * 129] * F8_WSCALE, sp[15 * 129] * F8_WSCALE); }
    unsigned char* d = dst8 + (size_t)rowmap(mode, n0 + nn) * ldd + k0 + kc;
    *(u32x4*)d = o[0]; *(u32x4*)(d + 16) = o[1];
}
struct CJob { const float* src; int K, N; bf16* dst; int ldd, koff, mode; };
__device__ __forceinline__ CJob get_job(const P& p, int j) {
    CJob c;
    if (j < 10) { const int l = j / 5, t = j % 5; bf16* wb = (bf16*)(p.ws + WS_WB) + (size_t)l * 1024 * 1536;
        if (t == 0) c = CJob{p.in[8] + (size_t)l * D * INC, D, INC, (bf16*)(p.ws + WS_WIN) + (size_t)l * INC * D, D, 0, 3};
        else if (t == 1) c = CJob{p.in[13] + (size_t)l * 256 * D, 256, D, wb, 1536, 512, 0};
        else if (t == 2) c = CJob{p.in[16] + (size_t)l * 512 * D, 512, D, wb, 1536, 768, 0};
        else if (t == 3) c = CJob{p.in[21] + (size_t)l * 256 * D, 256, D, wb, 1536, 1280, 0};
        else c = CJob{p.in[22] + (size_t)l * D * D, D, D, (bf16*)(p.ws + WS_WOUT) + (size_t)l * D * D, D, 0, 0}; }
    else if (j == 10) c = CJob{p.in[23], D, FFN, (bf16*)(p.ws + WS_FFN1), D, 0, 1};
    else if (j == 11) c = CJob{p.in[24], D, FFN, (bf16*)(p.ws + WS_FFN1), D, 0, 2};
    else c = CJob{p.in[25], FFN, D, (bf16*)(p.ws + WS_FFN2), FFN, 0, 0};
    return c;
}
__device__ __forceinline__ CJob get_moe_job(const P& p, int j) {
    const int e = j / 3, t = j % 3; CJob c;
    const float* sg = p.in[27]; const float* su = p.in[28]; const float* sd = p.in[29];
    asm volatile("" : "+s"(sg), "+s"(su), "+s"(sd));
    if (t == 0) c = CJob{sg + (size_t)e * D * FFN, D, FFN, (bf16*)(p.ws + WS_MOE1 + (size_t)e * 5632 * D), D, 0, 1};
    else if (t == 1) c = CJob{su + (size_t)e * D * FFN, D, FFN, (bf16*)(p.ws + WS_MOE1 + (size_t)e * 5632 * D), D, 0, 2};
    else c = CJob{sd + (size_t)e * FFN * D, FFN, D, (bf16*)(p.ws + WS_MOE2 + (size_t)e * D * FFN), FFN, 0, 0};
    return c;
}
template <bool MOE> __device__ __forceinline__ void run_conv_jobs(const P& p, LAS float* scr, int njobs, int bid, int nb) {
    int base = 0, base2 = 0;
    for (int j = 0; j < njobs; ++j) {
        const CJob jb = MOE ? get_moe_job(p, j) : get_job(p, j); const int nn = jb.N / 64, cnt = (jb.K / 64) * nn;
        const int first = ((bid - base) % nb + nb) % nb;
        if (MOE) { const int nn2 = jb.N / 128, cnt2 = (jb.K / 128) * nn2; const int first2 = ((bid - base2) % nb + nb) % nb;
            for (int i = first2; i < cnt2; i += nb) conv_tile128_f8(scr, jb.src, jb.N, (unsigned char*)jb.dst, jb.ldd, jb.mode, (i / nn2) * 128, (i % nn2) * 128);
            base2 += cnt2; }
        else for (int i = first; i < cnt; i += nb) conv_tile(scr, jb.src, jb.N, (i / nn) * 64, (i % nn) * 64, jb.dst, jb.ldd, jb.koff, jb.mode);
        base += cnt;
    }
}
__device__ __forceinline__ void ph_prologue(const P& p, LAS unsigned char* lds) {
    const int tid = threadIdx.x, bid = blockIdx.x, nb = gridDim.x;
    const int gt = bid * NTHREADS + tid, ngt = nb * NTHREADS;
    LAS float* scr = (LAS float*)lds;
    run_conv_jobs<false>(p, scr, 13, bid, nb);
    __syncthreads();
    {
        LAS float* tc = (LAS float*)lds; LAS float* tsn = tc + 64;
        __syncthreads();
        if (tid < 64) { tc[tid] = cospif(tid * (2.f / 64.f)); tsn[tid] = sinpif(tid * (2.f / 64.f)); }
        __syncthreads();
        const float s = 1.0f / sqrtf(64.f * 8192.f);
        for (int e = gt; e < 2 * 512 * 1024; e += ngt) {
            const int n = e & 1023, kk = (e >> 10) & 511, l = e >> 19;
            const int part = kk >> 8, g = (kk >> 6) & 3, c = kk & 63;
            const float* W = p.in[9] + (size_t)l * 256 * D + (size_t)(g * 64) * D + n;
            float acc = 0.f;
#pragma unroll 8
            for (int c2 = 0; c2 < 64; ++c2) { const int m = (c * c2) & 63; const float t = part == 0 ? tc[m] : -tsn[m]; acc += t * W[(size_t)c2 * D]; }
            ((bf16*)(p.ws + WS_WB))[(size_t)l * 1024 * 1536 + (size_t)n * 1536 + kk] = f2bf(acc * s);
        }
        __syncthreads();
    }
    {
        float* rc = (float*)(p.ws + WS_ROPE); float* rs = rc + SEQ * 32;
        for (int e = gt; e < SEQ * 32; e += ngt) {
            const int s = e >> 5, i = e & 31; const float inv = powf(10000.f, -(float)(i & 15) / 16.f);
            const float pos = (float)(i < 16 ? (s >> 6) : (s & 63)); const float ang = pos * inv;
            rc[e] = cosf(ang); rs[e] = sinf(ang);
        }
    }
    {
        bf16* F1 = (bf16*)(p.ws + WS_F1); bf16* F2 = (bf16*)(p.ws + WS_F2); bf16* FC = (bf16*)(p.ws + WS_FC);
        for (int e = gt; e < 256 * 256; e += ngt) {
            const int rho = e >> 8, n1 = e & 255; float v = 0.f;
            if (n1 < 128) { const int k1 = (rho >> 5) * 16 + (rho & 15), c = (rho >> 4) & 1, m = (k1 * n1) & 127; v = c == 0 ? cospif(m * (2.f / 128.f)) : -sinpif(m * (2.f / 128.f)); }
            F1[e] = f2bf(v);
            float w = 0.f;
            if (rho < 128 && n1 < 128) { const int c2 = rho >> 6, k2 = rho & 63, c = n1 >> 6, n2 = n1 & 63, m = (k2 * n2) & 63; const float cs = cospif(m * (2.f / 64.f)), sn = sinpif(m * (2.f / 64.f));
                w = c2 == 0 ? (c == 0 ? cs : sn) : (c == 0 ? sn : -cs); }
            F2[e] = f2bf(w);
        }
        float* TW = (float*)(p.ws + WS_TW);
        for (int e = gt; e < 128 * 64; e += ngt) { const int k1 = e >> 6, n2 = e & 63; TW[2 * e] = cospif((k1 * n2) * (2.f / 8192.f)); TW[2 * e + 1] = sinpif((k1 * n2) * (2.f / 8192.f)); }
        const float sc = sqrtf(32.f);
        for (int e = gt; e < 512 * 256; e += ngt) { const int rho = e >> 8, n = e & 255, c2 = rho >> 8, k = rho & 255, m = (k * n) & 255; FC[e] = f2bf(sc * (c2 == 0 ? cospif(m * (2.f / 256.f)) : sinpif(m * (2.f / 256.f)))); }
    }
    {
        u32x4* ut = (u32x4*)(p.ws + WS_UT); const u32x4 z = {0u, 0u, 0u, 0u};
        for (int e = gt; e < 2 * 256 * 64 * 16; e += ngt) { const int row = e >> 4, q = e & 15; ut[(size_t)row * 32 + 16 + q] = z; }
        u32x4* zz = (u32x4*)(p.ws + WS_Z);
        for (int e = gt; e < 2 * 32768 * 16; e += ngt) { const int row = e >> 4, q = e & 15; zz[(size_t)row * 32 + 16 + q] = z; }
    }
    {
        LAS float* sv = (LAS float*)lds;
        LAS float* red = sv + 3 * 1024;
        __syncthreads();
        for (int e = tid; e < 3 * 1024; e += NTHREADS) { const int j = e >> 10, k = e & 1023; const float v = j < 2 ? p.in[1][j * D + k] : p.in[3][k]; sv[e] = siluf_(v); }
        __syncthreads();
        const int kq = tid >> 6, cl = tid & 63;
        for (int it = bid; it < 2 * 96; it += nb) {
            const int l = it / 96, n = (it % 96) * 64 + cl;
            const float* W = p.in[4] + (size_t)l * D * 6144 + n;
            float a0 = 0.f, a1 = 0.f, a2 = 0.f;
#pragma unroll 16
            for (int k = kq; k < D; k += 8) { const float w = W[(size_t)k * 6144]; a0 += sv[k] * w; a1 += sv[1024 + k] * w; a2 += sv[2048 + k] * w; }
            red[(kq * 3 + 0) * 64 + cl] = a0; red[(kq * 3 + 1) * 64 + cl] = a1; red[(kq * 3 + 2) * 64 + cl] = a2;
            __syncthreads();
            if (tid < 192) { const int j = tid >> 6; float s = 0.f;
#pragma unroll
                for (int q = 0; q < 8; ++q) s += red[(q * 3 + j) * 64 + cl];
                ((float*)(p.ws + WS_MODS))[(size_t)(l * 3 + j) * 6144 + n] = s + p.in[5][l * 6144 + n]; }
            __syncthreads();
        }
    }
}
__device__ __forceinline__ void ph_moe_convert(const P& p, LAS unsigned char* lds) {
    LAS float* scr = (LAS float*)lds;
    const int bid = blockIdx.x, nb = gridDim.x;
    run_conv_jobs<true>(p, scr, 24, bid, nb);
    __syncthreads();
}

__device__ __forceinline__ void ph_norm(const P& p, LAS unsigned char* lds, int layer, int which, bool first, bool route, int nrows) {
    LAS unsigned* cnt_lds = (LAS unsigned*)lds;
    if (route) { __syncthreads(); if (threadIdx.x < NEXP) cnt_lds[threadIdx.x] = 0u; __syncthreads(); }
    const int lane = threadIdx.x & 63, gw = blockIdx.x * 8 + (threadIdx.x >> 6), ngw = gridDim.x * 8;
    const float* gain = p.in[which == 0 ? 6 : 7] + layer * D;
    bf16* A = (bf16*)(p.ws + WS_A);
    for (int r = gw; r < nrows; r += ngw) {
        const int mi = row_mi(r);
        const float* src = first ? (r < NLAT ? p.in[0] + (size_t)r * D : p.in[2] + (size_t)(r - NLAT) * D) : hrow(p, r);
        const float* shift = mods(p, layer, mi, which == 0 ? 0 : 3); const float* scale = mods(p, layer, mi, which == 0 ? 1 : 4);
        f32x4 v[4]; float ss = 0.f;
#pragma unroll
        for (int j = 0; j < 4; ++j) { v[j] = *(const f32x4*)(src + 4 * lane + 256 * j); ss += v[j].x * v[j].x + v[j].y * v[j].y + v[j].z * v[j].z + v[j].w * v[j].w; }
        if (first) { float* h = hrow(p, r);
#pragma unroll
            for (int j = 0; j < 4; ++j) *(f32x4*)(h + 4 * lane + 256 * j) = v[j]; }
        const float rstd = rsqrtf(wave_sum(ss) * (1.f / D) + EPS);
        float lg[8];
#pragma unroll
        for (int e = 0; e < 8; ++e) lg[e] = 0.f;
#pragma unroll
        for (int j = 0; j < 4; ++j) {
            const int c = 4 * lane + 256 * j;
            const f32x4 g = *(const f32x4*)(gain + c), sc = *(const f32x4*)(scale + c), sh = *(const f32x4*)(shift + c);
            f32x4 y = v[j] * rstd * g * (sc + 1.f) + sh;
            u32x2 o; o.x = pk2(y.x, y.y); o.y = pk2(y.z, y.w);
            *(u32x2*)(A + (size_t)r * D + c) = o;
            if (route) {
                const float* rw = p.in[26] + (size_t)c * 8;
#pragma unroll
                for (int q = 0; q < 4; ++q) { const f32x4 w0 = *(const f32x4*)(rw + q * 8), w1 = *(const f32x4*)(rw + q * 8 + 4); const float yy = y[q];
                    lg[0] += yy * w0.x; lg[1] += yy * w0.y; lg[2] += yy * w0.z; lg[3] += yy * w0.w; lg[4] += yy * w1.x; lg[5] += yy * w1.y; lg[6] += yy * w1.z; lg[7] += yy * w1.w; }
            }
        }
        if (route) {
#pragma unroll
            for (int e = 0; e < 8; ++e) lg[e] = wave_sum(lg[e]);
            if (lane == 0) {
                int e0 = 0; float v0 = lg[0];
#pragma unroll
                for (int e = 1; e < 8; ++e) if (lg[e] > v0) { v0 = lg[e]; e0 = e; }
                int e1 = -1; float v1 = -INFINITY;
#pragma unroll
                for (int e = 0; e < 8; ++e) if (e != e0 && lg[e] > v1) { v1 = lg[e]; e1 = e; }
                const float w0 = 1.f / (1.f + expf(v1 - v0));
                int* tok_e = (int*)(p.ws + WS_ROUTE); float* tok_w = (float*)(p.ws + WS_ROUTE) + 16384 * 2;
                tok_e[r * 2] = e0; tok_e[r * 2 + 1] = e1; tok_w[r * 2] = w0; tok_w[r * 2 + 1] = 1.f - w0;
                __hip_atomic_fetch_add(cnt_lds + e0, 1u, __ATOMIC_RELAXED, __HIP_MEMORY_SCOPE_WORKGROUP); __hip_atomic_fetch_add(cnt_lds + e1, 1u, __ATOMIC_RELAXED, __HIP_MEMORY_SCOPE_WORKGROUP);
            }
        }
    }
    if (route) { __syncthreads(); if (threadIdx.x < NEXP) ((unsigned*)(p.ws + WS_ROUTE) + 16384 * 6)[blockIdx.x * NEXP + threadIdx.x] = cnt_lds[threadIdx.x]; __syncthreads(); }
}

__device__ __forceinline__ void norm_row(const P& p, int layer, int which, int r, int lane) {
    const float* gain = p.in[which == 0 ? 6 : 7] + layer * D; bf16* A = (bf16*)(p.ws + WS_A);
    const int mi = row_mi(r); const float* src = hrow(p, r);
    const float* shift = mods(p, layer, mi, which == 0 ? 0 : 3); const float* scale = mods(p, layer, mi, which == 0 ? 1 : 4);
    f32x4 v[4]; float ss = 0.f;
#pragma unroll
    for (int j = 0; j < 4; ++j) { v[j] = *(const f32x4*)(src + 4 * lane + 256 * j); ss += v[j].x * v[j].x + v[j].y * v[j].y + v[j].z * v[j].z + v[j].w * v[j].w; }
    const float rstd = rsqrtf(wave_sum(ss) * (1.f / D) + EPS);
#pragma unroll
    for (int j = 0; j < 4; ++j) { const int c = 4 * lane + 256 * j;
        const f32x4 g = *(const f32x4*)(gain + c), sc = *(const f32x4*)(scale + c), sh = *(const f32x4*)(shift + c);
        const f32x4 y = v[j] * rstd * g * (sc + 1.f) + sh;
        u32x2 o; o.x = pk2(y.x, y.y); o.y = pk2(y.z, y.w);
        *(u32x2*)(A + (size_t)r * D + c) = o; }
}

namespace fg {
typedef short bf16x8 __attribute__((ext_vector_type(8)));
constexpr int BM = 256, BK = 64, HALF = 128, HTB = HALF * BK * 2, STAGE_BYTES = 8 * HTB, NXCD = 8, WGM = 8;
__device__ __forceinline__ int lds_byte(int r, int c) { const int st = (r >> 4) * 2 + (c >> 5), rr = r & 15, cc = c & 31, ob = rr * 64 + cc * 2; return st * 1024 + (ob ^ (((ob >> 9) & 1) << 5)); }
__device__ __forceinline__ void stage_rc(int b, int& R, int& C) { const int st = b / 1024, sb = b % 1024, swz = sb ^ (((sb >> 9) & 1) << 5); R = (st >> 1) * 16 + swz / 64; C = (st & 1) * 32 + (swz % 64) / 2; }
__device__ __forceinline__ int perm32(int rho) { const int n = rho >> 4, i = rho & 15; return 8 * (i >> 2) + 4 * n + (i & 3); }
struct Unit { int pm, pn; const char* A; const char* B; int nt, aux; };
__device__ __forceinline__ bool tile_order(int i, int nM, int nN, int G, int c, int& pm, int& pn) {
    const int nwg = nM * nN; const long L = (long)i * G + c; if (L >= nwg) return false;
    int wgid = (int)L; { const int q = nwg / NXCD, r = nwg % NXCD, xcd = wgid % NXCD, off = wgid / NXCD; wgid = (xcd < r ? xcd * (q + 1) : r * (q + 1) + (xcd - r) * q) + off; }
    const int nig = WGM * nN, gid = wgid / nig, fm = gid * WGM, gsz = (nM - fm) < WGM ? (nM - fm) : WGM;
    pm = fm + ((wgid % nig) % gsz); pn = (wgid % nig) / gsz; return true;
}
struct PlainSched {
    const char* Abase; const char* Bbase; int lda, ldb, nM, nN, G, c, nt;
    __device__ __forceinline__ int arow(int R) const { return R; }
    __device__ __forceinline__ int ahalf() const { return HALF; }
    __device__ __forceinline__ bool next(int i, Unit& u) const { if (!tile_order(i, nM, nN, G, c, u.pm, u.pn)) return false;
        u.A = Abase + (size_t)u.pm * BM * lda * 2; u.B = Bbase + (size_t)u.pn * BM * ldb * 2; u.nt = nt; u.aux = 0; return true; }
};
struct ExpertSched {
    const char* Abase; const char* Bbase; int lda, ldb, nM, nN, G, c, nt; const LAS int* tile_e; size_t estride;
    __device__ __forceinline__ int arow(int R) const { return R; }
    __device__ __forceinline__ int ahalf() const { return HALF; }
    __device__ __forceinline__ bool next(int i, Unit& u) const { if (!tile_order(i, nM, nN, G, c, u.pm, u.pn)) return false;
        u.A = Abase + (size_t)u.pm * BM * lda * 2; u.B = Bbase + (size_t)tile_e[u.pm] * estride + (size_t)u.pn * BM * ldb * 2; u.nt = nt; u.aux = 0; return true; }
};
struct WinSched {
    const char* Abase; const char* Bbase; int G, c, mode;
    __device__ __forceinline__ int arow(int R) const { return mode == 0 ? 256 * (R & 15) + 64 * ((R >> 4) & 3) + (R >> 6) : R; }
    __device__ __forceinline__ int ahalf() const { return mode == 0 ? 4096 : HALF; }
    __device__ __forceinline__ bool next(int i, Unit& u) const { if (!tile_order(i, mode == 0 ? 64 : 2, INC / 256, G, c, u.pm, u.pn)) return false;
        const size_t row0 = mode == 0 ? (size_t)((u.pm >> 5) * SEQ + 2 * (u.pm & 31)) : (size_t)(NLAT + u.pm * CTX);
        u.A = Abase + row0 * D * 2; u.B = Bbase + (size_t)u.pn * BM * D * 2; u.nt = D / 64; u.aux = mode; return true; }
};
struct MergeSched {
    const char* Xbase; const char* Wbase; int nM, G, c;
    __device__ __forceinline__ int arow(int R) const { return R; }
    __device__ __forceinline__ int ahalf() const { return HALF; }
    __device__ __forceinline__ bool next(int i, Unit& u) const { if (!tile_order(i >> 2, nM, 4, G, c, u.pm, u.pn)) return false;
        const int br = i & 3, koff = br == 0 ? 0 : (br == 1 ? 512 : (br == 2 ? 768 : 1280));
        u.A = Xbase + ((size_t)u.pm * BM * 1536 + koff) * 2; u.B = Wbase + ((size_t)u.pn * BM * 1536 + koff) * 2; u.nt = (br & 1) ? 4 : 8; u.aux = br; return true; }
};
typedef f32x4 Acc[2][2][4][2];
typedef int i32x4 __attribute__((ext_vector_type(4))); typedef int i32x8 __attribute__((ext_vector_type(8)));
__device__ __forceinline__ i32x8 ld32(const LAS unsigned char* p) { const i32x4 a = *(const LAS i32x4*)p, b = *(const LAS i32x4*)(p + 16); return __builtin_shufflevector(a, b, 0, 1, 2, 3, 4, 5, 6, 7); }
template <class Epi, class Sched, bool F8 = false>
__device__ __forceinline__ void gemm_phase(LAS unsigned char* lds, int lda, int ldb, const Sched& S, const Epi& E) {
    int tid_ = threadIdx.x; asm volatile("" : "+v"(tid_));
    const int tid = tid_, wid = __builtin_amdgcn_readfirstlane(tid >> 6), lane = tid & 63, wr = wid >> 2, wc = wid & 3, fr = lane & 15, fq = lane >> 4;
    unsigned voffA[2], voffB[2];
#pragma unroll
    for (int i = 0; i < 2; ++i) { int R, C; stage_rc(tid * 16 + i * 8192, R, C); const int Rb = Epi::PERM ? ((R & ~31) + perm32(R & 31)) : R;
        voffA[i] = (unsigned)(S.arow(R) * lda + C) * 2u; voffB[i] = (unsigned)(Rb * ldb + C) * 2u; }
    const size_t kstep = (size_t)(BK * 2);
    const size_t hstepA = (size_t)S.ahalf() * lda * 2, hstepB = (size_t)HALF * ldb * 2;
    const unsigned ldsw = (unsigned)wid * 1024u;
    const int aoff = lds_byte(wr * 64 + fr, F8 ? fq * 16 : fq * 8), boff = lds_byte(wc * 32 + fr, F8 ? fq * 16 : fq * 8);
#define FG_SA(b, h) (((b) * 2 + (h)) * HTB)
#define FG_SB(b, h) ((4 + (b) * 2 + (h)) * HTB)
#define FG_STAGE(bufoff, gbase, voff) do { _Pragma("unroll") for (int _i = 0; _i < 2; ++_i) \
        __builtin_amdgcn_global_load_lds((const unsigned*)((const char*)(gbase) + (voff)[_i]), (LAS unsigned*)(lds + (bufoff) + ldsw + _i * 8192), 16, 0, 0); } while (0)
#define FG_LDA(dst, b, h) do { if constexpr (F8) { _Pragma("unroll") for (int m = 0; m < 4; ++m) dst##8[m] = ld32(lds + FG_SA(b, h) + aoff + m * 2048); } \
        else { _Pragma("unroll") for (int m = 0; m < 4; ++m) _Pragma("unroll") for (int k = 0; k < 2; ++k) dst[m][k] = *(const LAS bf16x8*)(lds + FG_SA(b, h) + aoff + m * 2048 + k * 1024); } } while (0)
#define FG_LDB(dst, b, h) do { if constexpr (F8) { _Pragma("unroll") for (int n = 0; n < 2; ++n) dst##8[n] = ld32(lds + FG_SB(b, h) + boff + n * 2048); } \
        else { _Pragma("unroll") for (int n = 0; n < 2; ++n) _Pragma("unroll") for (int k = 0; k < 2; ++k) dst[n][k] = *(const LAS bf16x8*)(lds + FG_SB(b, h) + boff + n * 2048 + k * 1024); } } while (0)
#define FG_MMA(ai, bj, At, Bt) do { __builtin_amdgcn_s_setprio(1); _Pragma("unroll") for (int m = 0; m < 4; ++m) _Pragma("unroll") for (int n = 0; n < 2; ++n) { \
        if constexpr (F8) asm volatile("v_mfma_scale_f32_16x16x128_f8f6f4 %0, %1, %2, %0, %3, %4 op_sel_hi:[0,0,0]" : "+v"(acc[ai][bj][m][n]) : "v"(Bt##8[n]), "v"(At##8[m]), "v"(scw), "v"(sca)); \
        else { _Pragma("unroll") for (int k = 0; k < 2; ++k) acc[ai][bj][m][n] = __builtin_amdgcn_mfma_f32_16x16x32_bf16(Bt[n][k], At[m][k], acc[ai][bj][m][n], 0, 0, 0); } } \
        __builtin_amdgcn_s_setprio(0); } while (0)
#define FG_WAIT_V(n) asm volatile("s_waitcnt vmcnt(" #n ")" ::: "memory")
#define FG_WAIT_L(n) asm volatile("s_waitcnt lgkmcnt(" #n ")" ::: "memory")
#define FG_BAR __builtin_amdgcn_s_barrier()
#define FG_SCHED __builtin_amdgcn_sched_barrier(0)
    Unit cur, nxt; int ui = 0;
    if (!S.next(0, cur)) return;
    Acc acc;
#pragma unroll
    for (int a = 0; a < 2; ++a)
#pragma unroll
        for (int b = 0; b < 2; ++b)
#pragma unroll
            for (int m = 0; m < 4; ++m)
#pragma unroll
                for (int n = 0; n < 2; ++n) acc[a][b][m][n] = (f32x4){0.f, 0.f, 0.f, 0.f};
    bf16x8 At[4][2], B0[2][2], B1[2][2]; i32x8 At8[4], B08[2], B18[2];
    const int scw = 0x7a7a7a7a, sca = 0x7f7f7f7f;
    const char* cA = cur.A; const char* cB = cur.B;
    FG_STAGE(FG_SB(0, 0), cB, voffB); FG_STAGE(FG_SB(0, 1), cB + hstepB, voffB); FG_STAGE(FG_SA(0, 0), cA, voffA); FG_STAGE(FG_SA(0, 1), cA + hstepA, voffA);
    if (wr == 1) FG_BAR;
    FG_WAIT_V(2); FG_BAR;
    FG_STAGE(FG_SB(1, 0), cB + kstep, voffB); FG_STAGE(FG_SA(1, 0), cA + kstep, voffA); FG_STAGE(FG_SB(1, 1), cB + hstepB + kstep, voffB);
    FG_WAIT_V(6); FG_BAR;
    for (;;) {
        const bool has_next = S.next(ui + 1, nxt);
        const char* nA = has_next ? nxt.A : cA; const char* nB = has_next ? nxt.B : cB;
        const int nt = cur.nt;
#pragma unroll 1
        for (int t = 0; t < nt; t += 2) {
            const bool last = (t == nt - 2);
            const char* a1 = cA + (size_t)(t + 1) * kstep;
            const char* a2 = last ? nA : cA + (size_t)(t + 2) * kstep; const char* b2 = last ? nB : cB + (size_t)(t + 2) * kstep;
            const char* a3 = a2 + kstep; const char* b3 = b2 + kstep;
            FG_LDB(B0, 0, 0); FG_LDB(B1, 0, 1); FG_SCHED; FG_LDA(At, 0, 0); FG_STAGE(FG_SA(1, 1), a1 + hstepA, voffA);
            FG_WAIT_V(8); FG_WAIT_L(0); FG_BAR; FG_MMA(0, 0, At, B0); FG_MMA(0, 1, At, B1); FG_BAR; FG_SCHED;
            FG_LDA(At, 0, 1); FG_STAGE(FG_SB(0, 0), b2, voffB); FG_STAGE(FG_SB(0, 1), b2 + hstepB, voffB); FG_STAGE(FG_SA(0, 0), a2, voffA);
            FG_WAIT_V(8); FG_WAIT_L(0); FG_BAR; FG_MMA(1, 0, At, B0); FG_MMA(1, 1, At, B1); FG_BAR; FG_SCHED;
            FG_LDB(B0, 1, 0); FG_LDB(B1, 1, 1); FG_SCHED; FG_LDA(At, 1, 0); FG_STAGE(FG_SA(0, 1), a2 + hstepA, voffA);
            FG_WAIT_V(8); FG_WAIT_L(0); FG_BAR; FG_MMA(0, 0, At, B0); FG_MMA(0, 1, At, B1); FG_BAR; FG_SCHED;
            FG_LDA(At, 1, 1); FG_STAGE(FG_SB(1, 0), b3, voffB); FG_STAGE(FG_SB(1, 1), b3 + hstepB, voffB); FG_STAGE(FG_SA(1, 0), a3, voffA);
            FG_WAIT_V(8); FG_WAIT_L(0); FG_BAR; FG_MMA(1, 0, At, B0); FG_MMA(1, 1, At, B1); FG_BAR; FG_SCHED;
        }
        if (wr == 0) FG_BAR;
        E(acc, cur, wr, wc, fr, fq);
        if (!has_next) break;
#pragma unroll
        for (int a = 0; a < 2; ++a)
#pragma unroll
            for (int b = 0; b < 2; ++b)
#pragma unroll
                for (int m = 0; m < 4; ++m)
#pragma unroll
                    for (int n = 0; n < 2; ++n) acc[a][b][m][n] = (f32x4){0.f, 0.f, 0.f, 0.f};
        cur = nxt; cA = nA; cB = nB; ++ui;
        if (wr == 1) FG_BAR;
    }
    FG_WAIT_V(0);
    FG_BAR;
#undef FG_SA
#undef FG_SB
#undef FG_STAGE
#undef FG_LDA
#undef FG_LDB
#undef FG_MMA
#undef FG_WAIT_V
#undef FG_WAIT_L
#undef FG_BAR
#undef FG_SCHED
}
__device__ __forceinline__ unsigned cvt_pk(float lo, float hi) { unsigned r; asm volatile("v_cvt_pk_bf16_f32 %0, %1, %2" : "=v"(r) : "v"(lo), "v"(hi)); return r; }
__device__ __forceinline__ u32x4 pack8(const f32x4 a, const f32x4 b) { u32x4 w; w.x = cvt_pk(a[0], a[1]); w.y = cvt_pk(a[2], a[3]); w.z = cvt_pk(b[0], b[1]); w.w = cvt_pk(b[2], b[3]); return w; }
__device__ __forceinline__ f32x4 unpk_lo(unsigned x, unsigned y) { return (f32x4){__uint_as_float(x << 16), __uint_as_float(x & 0xffff0000u), __uint_as_float(y << 16), __uint_as_float(y & 0xffff0000u)}; }

struct EpiWin {
    static constexpr bool PERM = true;
    unsigned char* ws; const float* qg; const float* kg;
    __device__ __forceinline__ void operator()(const Acc& acc, const Unit& u, int wr, int wc, int fr_, int fq_) const {
        int fr = fr_, fq = fq_; asm volatile("" : "+v"(fr), "+v"(fq));
        const int tile = u.pn; const bool LAT = u.aux == 0;
        if (tile == 0) {
            if (LAT) {
                const int b = u.pm >> 5, n2 = 2 * (u.pm & 31) + wr;
#pragma unroll
                for (int ai = 0; ai < 2; ++ai)
#pragma unroll
                    for (int bj = 0; bj < 2; ++bj) {
#pragma unroll
                        for (int n = 0; n < 2; ++n)
#pragma unroll
                            for (int e = 0; e < 4; ++e) { const int ch = bj * HALF + wc * 32 + 8 * fq + 4 * n + e;
                                u32x2 o; o.x = cvt_pk(acc[ai][bj][0][n][e], acc[ai][bj][1][n][e]); o.y = cvt_pk(acc[ai][bj][2][n][e], acc[ai][bj][3][n][e]);
                                *(u32x2*)((bf16*)(ws + WS_UT) + ((size_t)(b * 256 + ch) * 64 + n2) * 256 + 64 * ai + 4 * fr) = o; }
                        asm volatile("" ::: "memory"); }
            } else {
#pragma unroll
                for (int ai = 0; ai < 2; ++ai)
#pragma unroll
                    for (int m = 0; m < 4; ++m) { const int sx = ai * HALF + wr * 64 + m * 16 + fr;
#pragma unroll
                        for (int bj = 0; bj < 2; ++bj)
#pragma unroll
                            for (int n = 0; n < 2; ++n)
#pragma unroll
                                for (int e = 0; e < 4; ++e) { const int ch = bj * HALF + wc * 32 + 8 * fq + 4 * n + e;
                                    ((bf16*)(ws + WS_UTC))[(size_t)(u.pm * 256 + ch) * 256 + sx] = f2bf(acc[ai][bj][m][n][e]); }
                        asm volatile("" ::: "memory"); }
            }
            return;
        }
        const bool ropek = tile == 1 || tile == 2 || tile == 5 || tile == 6 || (tile == 7 && wc < 2);
        const bool keyrow = tile == 7;
        size_t boff; int pitch, col0;
        if (tile <= 4) { boff = WS_RETQ + (size_t)(tile - 1) * MROWS * 256 * 2; pitch = 256; col0 = ropek ? wc * 64 : wc * 32; }
        else if (tile <= 6) { boff = WS_ATTQ; pitch = 512; col0 = (tile - 5) * 256 + wc * 64; }
        else if (tile == 7) { boff = wc < 2 ? WS_ATTK : WS_ATTV; pitch = 128; col0 = (wc & 1) * 64; }
        else if (tile < 10) { boff = WS_CONV; pitch = 512; col0 = (tile - 8) * 256 + wc * 32; }
        else { boff = WS_G; pitch = 4096; col0 = (tile - 10) * 256 + wc * 32; }
        const bool head = ropek || tile == 7;
        bf16* const dbase = (bf16*)(ws + boff);
        const bool norm = tile >= 5 && ropek;
        const float* gp = tile == 7 ? kg : qg;
        const float osc = tile == 2 ? 0.125f : (tile == 5 || tile == 6 ? QSCALE : 1.f);
        const float* rc = (const float*)(ws + WS_ROPE);
#pragma unroll
        for (int ai = 0; ai < 2; ++ai) {
            f32x4 rcs[4][2], rsn[4][2];
            if (ropek && LAT) {
#pragma unroll
                for (int m = 0; m < 4; ++m)
#pragma unroll
                    for (int bj = 0; bj < 2; ++bj) { const int sx = 4096 * ai + 256 * fr + 64 * m + 2 * (u.pm & 31) + wr, i0 = 16 * bj + 4 * fq;
                        rcs[m][bj] = *(const f32x4*)(rc + sx * 32 + i0); rsn[m][bj] = *(const f32x4*)(rc + SEQ * 32 + sx * 32 + i0); } }
#pragma unroll
            for (int m = 0; m < 4; ++m) {
                const int b = LAT ? (u.pm >> 5) : u.pm, s = LAT ? (4096 * ai + 256 * fr + 64 * m + 2 * (u.pm & 31) + wr) : (ai * HALF + wr * 64 + m * 16 + fr);
                const int rr = keyrow ? b * KEYS + (LAT ? CTX + s : s) : (LAT ? b * SEQ + s : NLAT + b * CTX + s);
                bf16* const drow = dbase + ((size_t)rr * pitch + col0 + 8 * fq);
                if (ropek) {
                    float rstd = 1.f;
                    if (norm) { float ss = 0.f;
#pragma unroll
                        for (int bj = 0; bj < 2; ++bj)
#pragma unroll
                            for (int n = 0; n < 2; ++n) { const f32x4 x = acc[ai][bj][m][n]; ss += (x[0] * x[0] + x[1] * x[1]) + (x[2] * x[2] + x[3] * x[3]); }
                        ss += __shfl_xor(ss, 16); ss += __shfl_xor(ss, 32);
                        rstd = rsqrtf(ss * (1.f / 64.f) + EPS); }
#pragma unroll
                    for (int bj = 0; bj < 2; ++bj) {
                        const int i0 = 16 * bj + 4 * fq;
                        f32x4 x1 = acc[ai][bj][m][0], x2 = acc[ai][bj][m][1];
                        if (norm) { const f32x4 g1 = *(const f32x4*)(gp + i0), g2 = *(const f32x4*)(gp + 32 + i0); x1 = x1 * rstd * g1; x2 = x2 * rstd * g2; }
                        f32x4 o1 = x1, o2 = x2;
                        if (LAT) { const f32x4 cs = rcs[m][bj], sn = rsn[m][bj]; o1 = x1 * cs - x2 * sn; o2 = x1 * sn + x2 * cs; }
                        *(u32x4*)(drow + 32 * bj) = pack8(o1 * osc, o2 * osc);
                    }
                } else {
#pragma unroll
                    for (int bj = 0; bj < 2; ++bj) {
                        f32x4 a0 = acc[ai][bj][m][0], a1 = acc[ai][bj][m][1];
                        if (tile >= 10) {
#pragma unroll
                            for (int e = 0; e < 4; ++e) { a0[e] = sigmoid_fast(a0[e]); a1[e] = sigmoid_fast(a1[e]); } }
                        *(u32x4*)(drow + (head ? 32 : HALF) * bj) = pack8(a0, a1);
                    }
                }
            }
        }
    }
};
struct EpiMerge {
    static constexpr bool PERM = true;
    const bf16* G; bf16* Mg;
    __device__ __forceinline__ void operator()(const Acc& acc, const Unit& u, int wr, int wc, int fr_, int fq_) const {
        int fr = fr_, fq = fq_; asm volatile("" : "+v"(fr), "+v"(fq));
        const int br = u.aux;
#pragma unroll
        for (int ai = 0; ai < 2; ++ai) {
            u32x4 g[4][2], old[4][2];
#pragma unroll
            for (int m = 0; m < 4; ++m)
#pragma unroll
                for (int bj = 0; bj < 2; ++bj) { const int r = u.pm * BM + ai * HALF + wr * 64 + m * 16 + fr, c = u.pn * BM + bj * HALF + wc * 32 + 8 * fq;
                    g[m][bj] = *(const u32x4*)(G + (size_t)r * 4096 + br * 1024 + c);
                    if (br > 0) old[m][bj] = *(const u32x4*)(Mg + (size_t)r * 1024 + c); }
#pragma unroll
            for (int m = 0; m < 4; ++m)
#pragma unroll
                for (int bj = 0; bj < 2; ++bj) { const int r = u.pm * BM + ai * HALF + wr * 64 + m * 16 + fr, c = u.pn * BM + bj * HALF + wc * 32 + 8 * fq;
                    f32x4 o0 = acc[ai][bj][m][0] * unpk_lo(g[m][bj].x, g[m][bj].y), o1 = acc[ai][bj][m][1] * unpk_lo(g[m][bj].z, g[m][bj].w);
                    if (br > 0) { o0 = o0 + unpk_lo(old[m][bj].x, old[m][bj].y); o1 = o1 + unpk_lo(old[m][bj].z, old[m][bj].w); }
                    *(u32x4*)(Mg + (size_t)r * 1024 + c) = pack8(o0, o1); }
        }
    }
};
struct EpiResid {
    static constexpr bool PERM = false;
    float* out; float* hctx; const float* modbase; int chunk;
    __device__ __forceinline__ void operator()(const Acc& acc, const Unit& u, int wr, int wc, int fr_, int fq_) const {
        int fr = fr_, fq = fq_; asm volatile("" : "+v"(fr), "+v"(fq));
        const int rt = u.pm * BM;
        const float* g = modbase + ((size_t)row_mi(rt) * 6 + chunk) * D;
        f32x4 gg[2][2];
#pragma unroll
        for (int bj = 0; bj < 2; ++bj)
#pragma unroll
            for (int n = 0; n < 2; ++n) gg[bj][n] = *(const f32x4*)(g + u.pn * BM + bj * HALF + wc * 32 + 16 * n + 4 * fq);
#pragma unroll
        for (int ai = 0; ai < 2; ++ai) {
            f32x4 hv[4][2][2];
#pragma unroll
            for (int m = 0; m < 4; ++m) { const int r = rt + ai * HALF + wr * 64 + m * 16 + fr; const float* h = r < NLAT ? out + (size_t)r * D : hctx + (size_t)(r - NLAT) * D;
#pragma unroll
                for (int bj = 0; bj < 2; ++bj)
#pragma unroll
                    for (int n = 0; n < 2; ++n) hv[m][bj][n] = *(const f32x4*)(h + u.pn * BM + bj * HALF + wc * 32 + 16 * n + 4 * fq); }
#pragma unroll
            for (int m = 0; m < 4; ++m) { const int r = rt + ai * HALF + wr * 64 + m * 16 + fr; float* h = r < NLAT ? out + (size_t)r * D : hctx + (size_t)(r - NLAT) * D;
#pragma unroll
                for (int bj = 0; bj < 2; ++bj)
#pragma unroll
                    for (int n = 0; n < 2; ++n) *(f32x4*)(h + u.pn * BM + bj * HALF + wc * 32 + 16 * n + 4 * fq) = hv[m][bj][n] + gg[bj][n] * acc[ai][bj][m][n]; }
        }
    }
};
struct EpiResidNorm {
    static constexpr bool PERM = false;
    float* out; const float* modbase; int chunk;
    const float* gain; const float* nmods; int csh, csc; bf16* A;
    float* xbuf; unsigned* cnt; unsigned* tmo; LAS unsigned char* lds;
    __device__ __forceinline__ void operator()(Acc& acc, const Unit& u, int wr, int wc, int fr_, int fq_) const {
        int fr = fr_, fq = fq_; asm volatile("" : "+v"(fr), "+v"(fq));
        const int wid = __builtin_amdgcn_readfirstlane((int)threadIdx.x >> 6), lane = threadIdx.x & 63;
        const int rt = u.pm * BM, mi = row_mi(rt);
        LAS float* Pt = (LAS float*)(lds + STAGE_BYTES);
        LAS float* St = (LAS float*)(lds + STAGE_BYTES + 4096);
        LAS unsigned* flag = (LAS unsigned*)(lds + STAGE_BYTES + 5120);
        { const float* g = modbase + ((size_t)mi * 6 + chunk) * D;
          f32x4 gg[2][2];
#pragma unroll
          for (int bj = 0; bj < 2; ++bj)
#pragma unroll
              for (int n = 0; n < 2; ++n) gg[bj][n] = *(const f32x4*)(g + u.pn * BM + bj * HALF + wc * 32 + 16 * n + 4 * fq);
#pragma unroll
          for (int am = 0; am < 4; ++am) { const int ai = am >> 1, m0 = (am & 1) * 2;
              f32x4 hv[2][2][2];
#pragma unroll
              for (int mm = 0; mm < 2; ++mm) { const float* h = out + (size_t)(rt + ai * HALF + wr * 64 + (m0 + mm) * 16 + fr) * D;
#pragma unroll
                  for (int bj = 0; bj < 2; ++bj)
#pragma unroll
                      for (int n = 0; n < 2; ++n) hv[mm][bj][n] = *(const f32x4*)(h + u.pn * BM + bj * HALF + wc * 32 + 16 * n + 4 * fq); }
#pragma unroll
              for (int mm = 0; mm < 2; ++mm) { const int m = m0 + mm; float* h = out + (size_t)(rt + ai * HALF + wr * 64 + m * 16 + fr) * D; float ss = 0.f;
#pragma unroll
                  for (int bj = 0; bj < 2; ++bj)
#pragma unroll
                      for (int n = 0; n < 2; ++n) { const f32x4 x = hv[mm][bj][n] + gg[bj][n] * acc[ai][bj][m][n]; acc[ai][bj][m][n] = x;
                          *(f32x4*)(h + u.pn * BM + bj * HALF + wc * 32 + 16 * n + 4 * fq) = x; ss += (x[0] * x[0] + x[1] * x[1]) + (x[2] * x[2] + x[3] * x[3]); }
                  ss += __shfl_xor(ss, 16); ss += __shfl_xor(ss, 32);
                  if (fq == 0) Pt[(ai * HALF + wr * 64 + m * 16 + fr) * 4 + wc] = ss; }
              asm volatile("" ::: "memory");
          } }
        asm volatile("s_waitcnt lgkmcnt(0)" ::: "memory"); __builtin_amdgcn_s_barrier(); asm volatile("" ::: "memory");
        const int row = wid * 32 + (lane & 31);
        if (lane < 32) { const f32x4 q = *(const LAS f32x4*)(Pt + row * 4);
            __hip_atomic_store(xbuf + ((size_t)(rt + row) * 4 + u.pn), (q[0] + q[1]) + (q[2] + q[3]), __ATOMIC_RELAXED, __HIP_MEMORY_SCOPE_AGENT); }
        asm volatile("s_waitcnt vmcnt(0)" ::: "memory");
        if (lane == 0) __hip_atomic_fetch_add(cnt + 16 * u.pm, 1u, __ATOMIC_RELAXED, __HIP_MEMORY_SCOPE_AGENT);
        if (wid == 0) { unsigned sp = 0u, dead = 0u;
            while ((unsigned)__builtin_amdgcn_readfirstlane(__hip_atomic_load(cnt + 16 * u.pm, __ATOMIC_RELAXED, __HIP_MEMORY_SCOPE_AGENT)) < 32u) {
                __builtin_amdgcn_s_sleep(1);
                if ((++sp & 255u) == 0u) { if (__hip_atomic_load(tmo, __ATOMIC_RELAXED, __HIP_MEMORY_SCOPE_AGENT)) { dead = 1u; break; } if (sp > (1u << 22)) { if (lane == 0) atomicAdd(tmo, 1u); dead = 1u; break; } } }
            __builtin_amdgcn_fence(__ATOMIC_ACQUIRE, "agent");
            if (lane == 0) flag[0] = dead; }
        asm volatile("s_waitcnt vmcnt(0) lgkmcnt(0)" ::: "memory"); __builtin_amdgcn_s_barrier(); asm volatile("" ::: "memory");
        if (lane < 32) { const float* sl = xbuf + (size_t)(rt + row) * 4; float t = 0.f;
#pragma unroll
            for (int q = 0; q < 4; ++q) t += __hip_atomic_load(sl + q, __ATOMIC_RELAXED, __HIP_MEMORY_SCOPE_AGENT);
            St[row] = rsqrtf(t * (1.f / D) + EPS); }
        asm volatile("s_waitcnt lgkmcnt(0)" ::: "memory"); __builtin_amdgcn_s_barrier(); asm volatile("" ::: "memory");
        const float* shp = nmods + ((size_t)mi * 6 + csh) * D; const float* scp = nmods + ((size_t)mi * 6 + csc) * D;
        float rs[2][4];
#pragma unroll
        for (int ai = 0; ai < 2; ++ai)
#pragma unroll
            for (int m = 0; m < 4; ++m) rs[ai][m] = St[ai * HALF + wr * 64 + m * 16 + fr];
#pragma unroll
        for (int bj = 0; bj < 2; ++bj)
#pragma unroll
            for (int n = 0; n < 2; ++n) { const int c = u.pn * BM + bj * HALF + wc * 32 + 16 * n + 4 * fq;
                const f32x4 g4 = *(const f32x4*)(gain + c), sc4 = *(const f32x4*)(scp + c) + 1.f, sh4 = *(const f32x4*)(shp + c);
#pragma unroll
                for (int ai = 0; ai < 2; ++ai)
#pragma unroll
                    for (int m = 0; m < 4; ++m) { const f32x4 y = acc[ai][bj][m][n] * rs[ai][m] * g4 * sc4 + sh4;
                        u32x2 o; o.x = cvt_pk(y[0], y[1]); o.y = cvt_pk(y[2], y[3]);
                        *(u32x2*)(A + (size_t)(rt + ai * HALF + wr * 64 + m * 16 + fr) * D + c) = o; } }
    }
};
struct EpiSwiglu {
    static constexpr bool PERM = true;
    bf16* Hm;
    __device__ __forceinline__ void operator()(const Acc& acc, const Unit& u, int wr, int wc, int fr, int fq) const {
#pragma unroll
        for (int ai = 0; ai < 2; ++ai)
#pragma unroll
            for (int m = 0; m < 4; ++m) { const int r = u.pm * BM + ai * HALF + wr * 64 + m * 16 + fr;
#pragma unroll
                for (int bj = 0; bj < 2; ++bj) { const int c = u.pn * BM + bj * HALF + wc * 32 + 8 * fq; const f32x4 g = acc[ai][bj][m][0], up = acc[ai][bj][m][1];
                    u32x2 o; o.x = cvt_pk(silu_fast(g[0]) * up[0], silu_fast(g[1]) * up[1]); o.y = cvt_pk(silu_fast(g[2]) * up[2], silu_fast(g[3]) * up[3]);
                    *(u32x2*)(Hm + (size_t)r * FFN + (c >> 1)) = o; } }
    }
};
struct EpiSwiglu8 {
    static constexpr bool PERM = true;
    unsigned char* Hm;
    __device__ __forceinline__ void operator()(const Acc& acc, const Unit& u, int wr, int wc, int fr_, int fq_) const {
        int fr = fr_, fq = fq_; asm volatile("" : "+v"(fr), "+v"(fq));
#pragma unroll
        for (int ai = 0; ai < 2; ++ai)
#pragma unroll
            for (int m = 0; m < 4; ++m) { const int r = u.pm * BM + ai * HALF + wr * 64 + m * 16 + fr;
#pragma unroll
                for (int bj = 0; bj < 2; ++bj) { const int c = u.pn * BM + bj * HALF + wc * 32 + 8 * fq; const f32x4 g = acc[ai][bj][m][0], up = acc[ai][bj][m][1];
                    *(unsigned*)(Hm + (size_t)r * FFN + (c >> 1)) = pk4_fp8(silu_fast(g[0]) * up[0], silu_fast(g[1]) * up[1], silu_fast(g[2]) * up[2], silu_fast(g[3]) * up[3]); } }
    }
};
struct EpiStore {
    static constexpr bool PERM = true;
    bf16* O; int ldc;
    __device__ __forceinline__ void operator()(const Acc& acc, const Unit& u, int wr, int wc, int fr_, int fq_) const {
        int fr = fr_, fq = fq_; asm volatile("" : "+v"(fr), "+v"(fq));
#pragma unroll
        for (int ai = 0; ai < 2; ++ai)
#pragma unroll
            for (int m = 0; m < 4; ++m) { const int r = u.pm * BM + ai * HALF + wr * 64 + m * 16 + fr;
#pragma unroll
                for (int bj = 0; bj < 2; ++bj) { const int c = u.pn * BM + bj * HALF + wc * 32 + 8 * fq; *(u32x4*)(O + (size_t)r * ldc + c) = pack8(acc[ai][bj][m][0], acc[ai][bj][m][1]); } }
    }
};
struct EpiFft1 {
    static constexpr bool PERM = true;
    unsigned char* ws;
    __device__ __forceinline__ void operator()(const Acc& acc, const Unit& u, int wr, int wc, int fr, int fq) const {
        const float* TW = (const float*)(ws + WS_TW); bf16* Z = (bf16*)(ws + WS_Z);
#pragma unroll
        for (int ai = 0; ai < 2; ++ai)
#pragma unroll
            for (int mm = 0; mm < 2; ++mm) { const int k1 = (4 * ai + 2 * wr + mm) * 16 + fr;
#pragma unroll
                for (int bj = 0; bj < 2; ++bj) { const int c = u.pn * BM + bj * HALF + wc * 32 + 8 * fq, n2 = c & 63, ch = (c >> 6) & 255, b = c >> 14;
                    f32x4 zr[2], zi[2];
#pragma unroll
                    for (int n = 0; n < 2; ++n) { const f32x4 yr = acc[ai][bj][2 * mm][n], yi = acc[ai][bj][2 * mm + 1][n];
                        const f32x4 t0 = *(const f32x4*)(TW + (size_t)(k1 * 64 + n2 + 4 * n) * 2), t1 = *(const f32x4*)(TW + (size_t)(k1 * 64 + n2 + 4 * n) * 2 + 4);
                        const f32x4 ct = {t0[0], t0[2], t1[0], t1[2]}, st = {t0[1], t0[3], t1[1], t1[3]};
                        zr[n] = yr * ct + yi * st; zi[n] = yi * ct - yr * st; }
                    bf16* dst = Z + ((size_t)b * 32768 + k1 * 256 + ch) * 256 + n2;
                    *(u32x4*)dst = pack8(zr[0], zr[1]); *(u32x4*)(dst + 64) = pack8(zi[0], zi[1]);
                    asm volatile("" ::: "memory"); } }
    }
};
struct EpiFft3 {
    static constexpr bool PERM = true;
    unsigned char* ws;
    __device__ __forceinline__ void operator()(const Acc& acc, const Unit& u, int wr, int wc, int fr, int fq) const {
        bf16* X = (bf16*)(ws + WS_X);
#pragma unroll
        for (int m = 0; m < 4; ++m) { const int k2 = 16 * m + fr;
#pragma unroll
            for (int bj = 0; bj < 2; ++bj) { const int c = u.pn * BM + bj * HALF + wc * 32 + 8 * fq, ch = c & 255, k1 = (c >> 8) & 127, b = c >> 15;
                *(u32x4*)(X + (size_t)(b * SEQ + k1 + 128 * k2) * 1536 + wr * 256 + ch) = pack8(acc[0][bj][m][0], acc[0][bj][m][1]); } }
    }
};
struct EpiFftC {
    static constexpr bool PERM = true;
    unsigned char* ws;
    __device__ __forceinline__ void operator()(const Acc& acc, const Unit& u, int wr, int wc, int fr, int fq) const {
        bf16* X = (bf16*)(ws + WS_X);
#pragma unroll
        for (int ai = 0; ai < 2; ++ai)
#pragma unroll
            for (int m = 0; m < 4; ++m) { const int k = ai * HALF + wr * 64 + m * 16 + fr;
#pragma unroll
                for (int bj = 0; bj < 2; ++bj) { const int ch = bj * HALF + wc * 32 + 8 * fq;
                    *(u32x4*)(X + (size_t)(NLAT + u.pn * CTX + k) * 1536 + u.pm * 256 + ch) = pack8(acc[ai][bj][m][0], acc[ai][bj][m][1]); } }
    }
};
}

__device__ __forceinline__ void ph_win(const P& p, LAS unsigned char* lds, int layer) {
    const char* W = (const char*)(p.ws + WS_WIN) + (size_t)layer * INC * D * 2;
#pragma unroll 1
    for (int mode = 0; mode < 2; ++mode) {
        fg::WinSched S{(const char*)(p.ws + WS_A), W, (int)gridDim.x, (int)((blockIdx.x + mode * 128) % gridDim.x), mode};
        fg::EpiWin E{p.ws, p.in[14] + layer * 64, p.in[15] + layer * 64};
        fg::gemm_phase(lds, D, D, S, E);
    }
}

__device__ __forceinline__ void conv_item(const P& p, LAS unsigned char* lds, int layer, int seqid, int t0) {
    const int tid = threadIdx.x; LAS float* y = (LAS float*)lds;
    const int L = seqid < 2 ? SEQ : CTX; const int rbase = seqid < 2 ? seqid * SEQ : NLAT + (seqid - 2) * CTX;
    const bf16* cv = (const bf16*)(p.ws + WS_CONV);
    __syncthreads();
    for (int e = tid; e < 94 * 32; e += NTHREADS) { const int tt = e >> 5, c8 = (e & 31) * 8, t = t0 - 15 + tt;
        f32x4 lo = {0.f, 0.f, 0.f, 0.f}, hi = lo;
        if (t >= 0 && t < L) { const bf16* rowp = cv + (size_t)(rbase + t) * 512 + c8; const u32x4 a = *(const u32x4*)rowp, g = *(const u32x4*)(rowp + 256);
            lo = (f32x4){__uint_as_float(a.x << 16) * sigmoidf_(__uint_as_float(g.x << 16)), __uint_as_float(a.x & 0xffff0000u) * sigmoidf_(__uint_as_float(g.x & 0xffff0000u)),
                         __uint_as_float(a.y << 16) * sigmoidf_(__uint_as_float(g.y << 16)), __uint_as_float(a.y & 0xffff0000u) * sigmoidf_(__uint_as_float(g.y & 0xffff0000u))};
            hi = (f32x4){__uint_as_float(a.z << 16) * sigmoidf_(__uint_as_float(g.z << 16)), __uint_as_float(a.z & 0xffff0000u) * sigmoidf_(__uint_as_float(g.z & 0xffff0000u)),
                         __uint_as_float(a.w << 16) * sigmoidf_(__uint_as_float(g.w << 16)), __uint_as_float(a.w & 0xffff0000u) * sigmoidf_(__uint_as_float(g.w & 0xffff0000u))}; }
        *(LAS f32x4*)(y + tt * 256 + c8) = lo; *(LAS f32x4*)(y + tt * 256 + c8 + 4) = hi; }
    __syncthreads();
    {
        const int ch = tid & 255, half = tid >> 8;
        float w[31];
#pragma unroll
        for (int k = 0; k < 31; ++k) w[k] = p.in[17][(size_t)layer * 31 * 256 + k * 256 + ch];
        const float bias = p.in[18][layer * 256 + ch];
        float o[4][8];
#pragma unroll
        for (int u = 0; u < 4; ++u) { const int tb = (half * 4 + u) * 8;
            float in[38];
#pragma unroll
            for (int q = 0; q < 38; ++q) in[q] = y[(tb + q) * 256 + ch];
#pragma unroll
            for (int q = 0; q < 8; ++q) { float a = bias;
#pragma unroll
                for (int k = 0; k < 31; ++k) a += in[q + k] * w[k];
                o[u][q] = a; } }
        __syncthreads();
#pragma unroll
        for (int u = 0; u < 4; ++u)
#pragma unroll
            for (int q = 0; q < 8; ++q) y[((half * 4 + u) * 8 + q) * 256 + ch] = o[u][q];
    }
    __syncthreads();
    const int wv = tid >> 6, lane = tid & 63;
    const f32x4 g = *(const f32x4*)(p.in[19] + layer * 256 + lane * 4), bb = *(const f32x4*)(p.in[20] + layer * 256 + lane * 4);
    for (int q = 0; q < 8; ++q) { const int t = wv * 8 + q;
        const f32x4 v = *(const LAS f32x4*)(y + t * 256 + lane * 4);
        const float mu = wave_sum(v.x + v.y + v.z + v.w) * (1.f / 256.f);
        const f32x4 dv = v - mu; const float var = wave_sum(dv.x * dv.x + dv.y * dv.y + dv.z * dv.z + dv.w * dv.w) * (1.f / 256.f);
        const float rstd = rsqrtf(var + EPS);
        f32x4 z = dv * rstd * g + bb;
        u32x2 ov; ov.x = pk2(siluf_(z.x), siluf_(z.y)); ov.y = pk2(siluf_(z.z), siluf_(z.w));
        *(u32x2*)((bf16*)(p.ws + WS_X) + (size_t)(rbase + t0 + t) * 1536 + 1280 + lane * 4) = ov; }
}

__device__ __forceinline__ int chunk_row0(int b, int n) { return n < 2 ? NLAT + b * CTX + n * 128 : b * SEQ + (n - 2) * 128; }
__device__ __forceinline__ float log_sigmoid(float x) { return x >= 0.f ? -log1pf(expf(-x)) : x - log1pf(expf(x)); }
namespace rt {
typedef short bf16x8 __attribute__((ext_vector_type(8)));
constexpr int PQ = 72, PJ = 136;
__device__ __forceinline__ f32x4 mma(bf16x8 a, bf16x8 b, f32x4 c) { return __builtin_amdgcn_mfma_f32_16x16x32_bf16(a, b, c, 0, 0, 0); }
__device__ __forceinline__ bf16x8 frag(const LAS bf16* base, int row, int pitch, int k0, int lane) { return *(const LAS bf16x8*)(base + (row + (lane & 15)) * pitch + k0 + 8 * (lane >> 4)); }
}
__device__ __forceinline__ void ret_kv_item(const P& p, LAS unsigned char* lds, int layer, int it) {
    using namespace rt;
    const int tid = threadIdx.x, lane = tid & 63, w = tid >> 6; const int h = it & 3, n = (it >> 2) % NCHUNK, b = (it >> 2) / NCHUNK;
    LAS bf16* KTf = (LAS bf16*)lds; LAS bf16* KTb = KTf + 64 * PJ; LAS bf16* VT = KTb + 64 * PJ;
    const int r0 = chunk_row0(b, n);
    const float lgf = log_sigmoid(p.in[10][layer * 4 + h]), lgb = log_sigmoid(p.in[11][layer * 4 + h]);
    __syncthreads();
    { const int j = tid & 127, dq = (tid >> 7) * 16;
      const bf16* K = (const bf16*)(p.ws + WS_RETK) + (size_t)(r0 + j) * 256 + h * 64 + dq; const bf16* V = (const bf16*)(p.ws + WS_RETV) + (size_t)(r0 + j) * 256 + h * 64 + dq;
      const float zf = expf((127.f - j) * lgf), zb = expf((float)j * lgb);
#pragma unroll
      for (int q8 = 0; q8 < 2; ++q8) { const u32x4 kw = *(const u32x4*)(K + q8 * 8), vw = *(const u32x4*)(V + q8 * 8);
          const unsigned kk[4] = {kw.x, kw.y, kw.z, kw.w}, vv[4] = {vw.x, vw.y, vw.z, vw.w};
#pragma unroll
          for (int q = 0; q < 4; ++q) { const int d = dq + q8 * 8 + 2 * q; const float k0 = __uint_as_float(kk[q] << 16), k1 = __uint_as_float(kk[q] & 0xffff0000u);
              KTf[d * PJ + j] = f2bf(k0 * zf); KTf[(d + 1) * PJ + j] = f2bf(k1 * zf); KTb[d * PJ + j] = f2bf(k0 * zb); KTb[(d + 1) * PJ + j] = f2bf(k1 * zb);
              VT[d * PJ + j] = (bf16)(vv[q] & 0xffffu); VT[(d + 1) * PJ + j] = (bf16)(vv[q] >> 16); } } }
    __syncthreads();
    const int fb = w >> 2, dt = w & 3; const LAS bf16* Am = fb == 0 ? KTf : KTb;
    f32x4 acc[4];
#pragma unroll
    for (int et = 0; et < 4; ++et) acc[et] = (f32x4){0.f, 0.f, 0.f, 0.f};
#pragma unroll
    for (int ks = 0; ks < 4; ++ks) { const bf16x8 af = frag(Am, dt * 16, PJ, ks * 32, lane);
#pragma unroll
        for (int et = 0; et < 4; ++et) acc[et] = mma(af, frag(VT, et * 16, PJ, ks * 32, lane), acc[et]); }
    float* S = (float*)(p.ws + WS_RETS) + ((size_t)((fb * 2 + b) * NCHUNK + n) * 4 + h) * 4096;
#pragma unroll
    for (int et = 0; et < 4; ++et)
#pragma unroll
        for (int r = 0; r < 4; ++r) S[(dt * 16 + 4 * (lane >> 4) + r) * 64 + et * 16 + (lane & 15)] = acc[et][r];
}
__device__ __forceinline__ void ret_scan_item(const P& p, int layer, int it) {
    const int e = it * NTHREADS + threadIdx.x;
    const int de = e & 4095, h = (e >> 12) & 3, b = (e >> 14) & 1, dir = e >> 15;
    const float lg = log_sigmoid(p.in[dir == 0 ? 10 : 11][layer * 4 + h]); const float g = expf(128.f * lg);
    float* S = (float*)(p.ws + WS_RETS) + (size_t)((dir * 2 + b) * NCHUNK) * 4 * 4096 + (size_t)h * 4096 + de;
    float kv[NCHUNK];
#pragma unroll
    for (int n = 0; n < NCHUNK; ++n) kv[n] = S[(size_t)n * 4 * 4096];
    float st = 0.f;
    if (dir == 0) {
#pragma unroll
        for (int n = 0; n < NCHUNK; ++n) { const float t = kv[n]; kv[n] = st; st = st * g + t; }
    } else {
#pragma unroll
        for (int i = 0; i < NCHUNK; ++i) { const int n = i < 2 ? 1 - i : NCHUNK + 1 - i; const float t = kv[n]; kv[n] = st; st = st * g + t; }
    }
    float* S2 = (float*)(p.ws + WS_RETS2) + (size_t)((dir * 2 + b) * NCHUNK) * 4 * 4096 + (size_t)h * 4096 + de;
#pragma unroll
    for (int n = 0; n < NCHUNK; ++n) S2[(size_t)n * 4 * 4096] = kv[n];
}
__device__ __forceinline__ void ret_out_item(const P& p, LAS unsigned char* lds, int layer, int it) {
    using namespace rt;
    const int tid = threadIdx.x, lane = tid & 63, w = tid >> 6; const int h = it & 3, n = (it >> 2) % NCHUNK, b = (it >> 2) / NCHUNK;
    LAS bf16* Qs = (LAS bf16*)lds; LAS bf16* Ks = Qs + 128 * PQ; LAS bf16* VT = Ks + 128 * PQ; LAS bf16* Ps = VT + 64 * PJ; LAS bf16* SfT = Ps + 128 * PJ; LAS bf16* SbT = SfT + 64 * PQ;
    LAS float* pf = (LAS float*)(SbT + 64 * PQ); LAS float* pb = pf + 132;
    const int r0 = chunk_row0(b, n);
    const float lgf = log_sigmoid(p.in[10][layer * 4 + h]), lgb = log_sigmoid(p.in[11][layer * 4 + h]);
    const float* S = (const float*)(p.ws + WS_RETS2);
    const float* sfp = S + ((size_t)((0 * 2 + b) * NCHUNK + n) * 4 + h) * 4096; const float* sbp = S + ((size_t)((1 * 2 + b) * NCHUNK + n) * 4 + h) * 4096;
    __syncthreads();
    { const int j = tid >> 2, dq = (tid & 3) * 16;
      const bf16* Q = (const bf16*)(p.ws + WS_RETQ) + (size_t)(r0 + j) * 256 + h * 64 + dq; const bf16* K = (const bf16*)(p.ws + WS_RETK) + (size_t)(r0 + j) * 256 + h * 64 + dq;
      *(LAS u32x4*)(Qs + j * PQ + dq) = *(const u32x4*)Q; *(LAS u32x4*)(Qs + j * PQ + dq + 8) = *(const u32x4*)(Q + 8);
      *(LAS u32x4*)(Ks + j * PQ + dq) = *(const u32x4*)K; *(LAS u32x4*)(Ks + j * PQ + dq + 8) = *(const u32x4*)(K + 8); }
    { const int j = tid & 127, dq = (tid >> 7) * 16;
      const bf16* V = (const bf16*)(p.ws + WS_RETV) + (size_t)(r0 + j) * 256 + h * 64 + dq;
#pragma unroll
      for (int q8 = 0; q8 < 2; ++q8) { const u32x4 vw = *(const u32x4*)(V + q8 * 8); const unsigned vv[4] = {vw.x, vw.y, vw.z, vw.w};
#pragma unroll
          for (int q = 0; q < 4; ++q) { const int d = dq + q8 * 8 + 2 * q; VT[d * PJ + j] = (bf16)(vv[q] & 0xffffu); VT[(d + 1) * PJ + j] = (bf16)(vv[q] >> 16); } } }
    { const int d = tid & 63, e0 = (tid >> 6) * 8;
#pragma unroll
      for (int q4 = 0; q4 < 2; ++q4) { const f32x4 a = *(const f32x4*)(sfp + d * 64 + e0 + q4 * 4), c = *(const f32x4*)(sbp + d * 64 + e0 + q4 * 4);
#pragma unroll
          for (int q = 0; q < 4; ++q) { SfT[(e0 + q4 * 4 + q) * PQ + d] = f2bf(a[q]); SbT[(e0 + q4 * 4 + q) * PQ + d] = f2bf(c[q]); } } }
    if (tid <= 128) { pf[tid] = expf((float)tid * lgf); pb[tid] = expf((float)tid * lgb); }
    __syncthreads();
    { const bf16x8 a0 = frag(Qs, 16 * w, PQ, 0, lane), a1 = frag(Qs, 16 * w, PQ, 32, lane);
#pragma unroll
      for (int jt = 0; jt < 8; ++jt) { f32x4 c = (f32x4){0.f, 0.f, 0.f, 0.f};
          c = mma(a0, frag(Ks, jt * 16, PQ, 0, lane), c); c = mma(a1, frag(Ks, jt * 16, PQ, 32, lane), c);
          const int j = jt * 16 + (lane & 15);
#pragma unroll
          for (int r = 0; r < 4; ++r) { const int i = 16 * w + 4 * (lane >> 4) + r; const float dm = i > j ? pf[i - j] : (i < j ? pb[j - i] : 2.f); Ps[i * PJ + j] = f2bf(c[r] * dm); } } }
    __syncthreads();
    f32x4 aP[4], aF[4], aB[4];
#pragma unroll
    for (int et = 0; et < 4; ++et) { aP[et] = (f32x4){0.f, 0.f, 0.f, 0.f}; aF[et] = aP[et]; aB[et] = aP[et]; }
#pragma unroll
    for (int ks = 0; ks < 4; ++ks) { const bf16x8 af = frag(Ps, 16 * w, PJ, ks * 32, lane);
#pragma unroll
        for (int et = 0; et < 4; ++et) aP[et] = mma(af, frag(VT, et * 16, PJ, ks * 32, lane), aP[et]); }
#pragma unroll
    for (int ks = 0; ks < 2; ++ks) { const bf16x8 af = frag(Qs, 16 * w, PQ, ks * 32, lane);
#pragma unroll
        for (int et = 0; et < 4; ++et) { aF[et] = mma(af, frag(SfT, et * 16, PQ, ks * 32, lane), aF[et]); aB[et] = mma(af, frag(SbT, et * 16, PQ, ks * 32, lane), aB[et]); } }
    const float* rg = p.in[12] + layer * 256 + h * 64;
    const bf16* G = (const bf16*)(p.ws + WS_RETG) + (size_t)r0 * 256 + h * 64; bf16* X = (bf16*)(p.ws + WS_X) + (size_t)r0 * 1536 + 512 + h * 64;
    float gt[4][4];
#pragma unroll
    for (int r = 0; r < 4; ++r)
#pragma unroll
        for (int et = 0; et < 4; ++et) gt[r][et] = bf2f(G[(size_t)(16 * w + 4 * (lane >> 4) + r) * 256 + et * 16 + (lane & 15)]);
#pragma unroll
    for (int r = 0; r < 4; ++r) { const int i = 16 * w + 4 * (lane >> 4) + r; const float xf = pf[i + 1], xb = pb[128 - i];
        float o[4]; float ss = 0.f;
#pragma unroll
        for (int et = 0; et < 4; ++et) { o[et] = aP[et][r] + xf * aF[et][r] + xb * aB[et][r]; ss += o[et] * o[et]; }
        ss += __shfl_xor(ss, 1); ss += __shfl_xor(ss, 2); ss += __shfl_xor(ss, 4); ss += __shfl_xor(ss, 8);
        const float rstd = rsqrtf(ss * (1.f / 64.f) + EPS);
#pragma unroll
        for (int et = 0; et < 4; ++et) { const int e = et * 16 + (lane & 15); Ps[i * PJ + e] = f2bf(o[et] * rstd * rg[e] * siluf_(gt[r][et])); } }
    asm volatile("s_waitcnt lgkmcnt(0)" ::: "memory");
#pragma unroll
    for (int q = 0; q < 2; ++q) { const int c = lane + 64 * q, i = 16 * w + (c >> 3), e8 = (c & 7) * 8;
        *(u32x4*)(X + (size_t)i * 1536 + e8) = *(const LAS u32x4*)(Ps + i * PJ + e8); }
    __syncthreads();
}

#include <hip/hip_bf16.h>
#include <cmath>
namespace attn_body {
using bf16=__hip_bfloat16;
using bf16x8=__attribute__((ext_vector_type(8)))short;
using s16x4=__attribute__((ext_vector_type(4)))short;
using f32x16=__attribute__((ext_vector_type(16)))float;
using u32x4=__attribute__((ext_vector_type(4)))unsigned;
constexpr int D=64, QP=512, KP=128, OP=1536;
constexpr int NW=8,QBLK=32,QB=QBLK*NW,KVBLK=64;
__device__ __forceinline__ int crow(int r,int hi){return (r&3)+8*(r>>2)+4*hi;}
#define SBAR() __builtin_amdgcn_sched_barrier(0)
__device__ __forceinline__ void cmask(f32x16&p0,f32x16&p1,int jb,int qrel,int hi){
  const float NEG=-INFINITY; int kb=64*jb+4*hi;
  #pragma unroll
  for(int r=0;r<16;++r){int kv=kb+(r&3)+8*(r>>2); if(kv>qrel)p0[r]=NEG; if(kv+32>qrel)p1[r]=NEG;}
}

constexpr int NSLOT=3, SLOTB=8192;
constexpr int LDS_K=0, LDS_V=NSLOT*SLOTB, LDS_WS=2*NSLOT*SLOTB, LDS_OST=LDS_WS+NW*64*4, LDS_BYTES=LDS_OST+NW*4096;
constexpr float C2=0.125f*1.4426950408889634f;
__device__ __forceinline__ void glds16(const void*gsrc,unsigned lds_dst){unsigned keep;
  asm volatile("s_mov_b32 %0, m0\n\ts_mov_b32 m0, %2\n\ts_nop 0\n\tglobal_load_lds_dwordx4 %1, off\n\ts_mov_b32 m0, %0":"=&s"(keep):"v"(gsrc),"s"(lds_dst):"memory");}
__device__ __forceinline__ float max3f(float a,float b,float c){float r;asm("v_max3_f32 %0, %1, %2, %3":"=v"(r):"v"(a),"v"(b),"v"(c));return r;}
__device__ __forceinline__ float max2f(float a,float b){float r;asm("v_max_f32_e32 %0, %1, %2":"=v"(r):"v"(a),"v"(b));return r;}
__device__ __forceinline__ float fadd_s(float a,float b){float r;asm("v_add_f32_e32 %0, %1, %2":"=v"(r):"v"(a),"v"(b));return r;}
__device__ __forceinline__ float fsub_s(float a,float b){float r;asm("v_sub_f32_e32 %0, %1, %2":"=v"(r):"v"(a),"v"(b));return r;}
typedef float f32x2_t __attribute__((ext_vector_type(2))); typedef __bf16 bf16x2_t __attribute__((ext_vector_type(2)));
__device__ __forceinline__ unsigned cvtpk_s(float lo,float hi){f32x2_t v={lo,hi};bf16x2_t b=__builtin_convertvector(v,bf16x2_t);return __builtin_bit_cast(unsigned,b);}
#define WAIT_BAR(N) asm volatile("s_waitcnt vmcnt(" #N ") lgkmcnt(0)\n\ts_barrier":::"memory")

__device__ __forceinline__ void qkt(f32x16&p0,f32x16&p1,const char*Kslot,const bf16x8*qr,const f32x16&negm,int r32,int hi){
  const char*kb=Kslot+hi*1024+r32*16;
  #pragma unroll
  for(int d0=0;d0<4;++d0){
    const bf16x8 b0=*reinterpret_cast<const bf16x8*>(kb+d0*2048);
    const bf16x8 b1=*reinterpret_cast<const bf16x8*>(kb+d0*2048+512);
    if(d0==0){p0=__builtin_amdgcn_mfma_f32_32x32x16_bf16(b0,qr[0],negm,0,0,0);p1=__builtin_amdgcn_mfma_f32_32x32x16_bf16(b1,qr[0],negm,0,0,0);}
    else{p0=__builtin_amdgcn_mfma_f32_32x32x16_bf16(b0,qr[d0],p0,0,0,0);p1=__builtin_amdgcn_mfma_f32_32x32x16_bf16(b1,qr[d0],p1,0,0,0);}}
}
typedef __attribute__((address_space(3))) const char* lds_cptr;
typedef short v4i16_t __attribute__((ext_vector_type(4)));
__device__ __forceinline__ void kload8(bf16x8*kf,lds_cptr kp){
  kf[0]=*(const __attribute__((address_space(3))) bf16x8*)(kp);      kf[1]=*(const __attribute__((address_space(3))) bf16x8*)(kp+512);
  kf[2]=*(const __attribute__((address_space(3))) bf16x8*)(kp+2048); kf[3]=*(const __attribute__((address_space(3))) bf16x8*)(kp+2560);
  kf[4]=*(const __attribute__((address_space(3))) bf16x8*)(kp+4096); kf[5]=*(const __attribute__((address_space(3))) bf16x8*)(kp+4608);
  kf[6]=*(const __attribute__((address_space(3))) bf16x8*)(kp+6144); kf[7]=*(const __attribute__((address_space(3))) bf16x8*)(kp+6656);
}
__device__ __forceinline__ void kload2(bf16x8*kf,lds_cptr kp,int j){ kf[2*j]=*(const __attribute__((address_space(3))) bf16x8*)(kp+j*2048); kf[2*j+1]=*(const __attribute__((address_space(3))) bf16x8*)(kp+j*2048+512); }
__device__ __forceinline__ s16x4 vtr(lds_cptr p){ return __builtin_bit_cast(s16x4,__builtin_amdgcn_ds_read_tr16_b64_v4i16((__attribute__((address_space(3))) v4i16_t*)p)); }
__device__ __forceinline__ float rowmax(const f32x16&p0,const f32x16&p1){
  float a=max3f(p0[0],p0[1],p1[0]),b=max3f(p0[2],p0[3],p1[1]);a=max3f(a,p1[2],p1[3]);
  #pragma unroll
  for(int r=4;r<16;r+=4){a=max3f(a,p0[r],p0[r+1]);b=max3f(b,p0[r+2],p0[r+3]);a=max3f(a,p1[r],p1[r+1]);b=max3f(b,p1[r+2],p1[r+3]);}
  const float m=max2f(a,b);
  auto rr=__builtin_amdgcn_permlane32_swap(__float_as_uint(m),__float_as_uint(m),false,false);
  return max2f(__uint_as_float(rr[0]),__uint_as_float(rr[1]));
}
__device__ __forceinline__ void pv(f32x16*o,int vb,bf16x8 pa0,bf16x8 pa1,bf16x8 pa2,bf16x8 pa3){
  #pragma unroll
  for(int d0=0;d0<2;++d0){s16x4 lo[4],hi[4];
    #pragma unroll
    for(int ks=0;ks<4;++ks){
      asm volatile("ds_read_b64_tr_b16 %0,%1 offset:%c2":"=&v"(lo[ks]):"v"(vb),"i"(d0*4096+ks*1024):"memory");
      asm volatile("ds_read_b64_tr_b16 %0,%1 offset:%c2":"=&v"(hi[ks]):"v"(vb),"i"(d0*4096+ks*1024+512):"memory");}
    asm volatile("s_waitcnt lgkmcnt(0)":::"memory");SBAR();
    #define PK(k) (bf16x8){lo[k][0],lo[k][1],lo[k][2],lo[k][3],hi[k][0],hi[k][1],hi[k][2],hi[k][3]}
    o[d0]=__builtin_amdgcn_mfma_f32_32x32x16_bf16(pa0,PK(0),o[d0],0,0,0);
    o[d0]=__builtin_amdgcn_mfma_f32_32x32x16_bf16(pa1,PK(1),o[d0],0,0,0);
    o[d0]=__builtin_amdgcn_mfma_f32_32x32x16_bf16(pa2,PK(2),o[d0],0,0,0);
    o[d0]=__builtin_amdgcn_mfma_f32_32x32x16_bf16(pa3,PK(3),o[d0],0,0,0);
    #undef PK
  }
}

#ifndef ATTN_STORE16
#define ATTN_STORE16(p,v) (*(u32x4*)(p)=(v))
#endif
template<int THRL> __device__ __forceinline__ void attn_unit(const bf16*Q0,const bf16*__restrict__ Kh,const bf16*__restrict__ Vh,bf16*O0,const int NT,char*shm){
  const int tid=threadIdx.x,lane=tid&63,r32=lane&31,hi=lane>>5; const int wid=__builtin_amdgcn_readfirstlane(tid>>6);
  const bf16*Qw=Q0+(long)(wid*QBLK)*QP;
  const unsigned lds0=(unsigned)(uintptr_t)shm;
  float*wsf=(float*)(shm+LDS_WS)+wid*64;
  const bf16*ksrc=Kh+(long)lane*KP+wid*8;
  const bf16*vsrc=Vh+(long)(16*(wid&3)+(lane>>2))*KP+(wid>>2)*32+(lane&3)*8;
  const unsigned kdst=lds0+LDS_K+wid*1024, vdst=lds0+LDS_V+wid*1024;
  #define DMA_K(t,slot) glds16(ksrc+(long)(t)*KVBLK*KP,(unsigned)__builtin_amdgcn_readfirstlane(kdst+(slot)))
  #define DMA_V(t,slot) glds16(vsrc+(long)(t)*KVBLK*KP,(unsigned)__builtin_amdgcn_readfirstlane(vdst+(slot)))
  const int vb0=(int)(lds0+LDS_V)+((lane>>4)&1)*32+(lane&3)*8+(4*hi+((lane&15)>>2))*64;
  const char*Kbase=shm+LDS_K; bf16x8 kf[8];
  const lds_cptr shm3=(lds_cptr)shm; const lds_cptr kp0=shm3+LDS_K+hi*1024+r32*16; const lds_cptr vp0=shm3+LDS_V+((lane>>4)&1)*32+(lane&3)*8+(4*hi+((lane&15)>>2))*64;
  DMA_K(0,0);DMA_V(0,0);DMA_K(1,SLOTB);
  bf16x8 qr[4];
  #pragma unroll
  for(int d0=0;d0<4;++d0)qr[d0]=*reinterpret_cast<const bf16x8*>(&Qw[(long)r32*QP+d0*16+hi*8]);
  float mhat=0.f,l_reg=0.f;f32x16 o[2];o[0]=f32x16{};o[1]=f32x16{};f32x16 negm=f32x16{};asm volatile("":"+v"(negm));
  #define CMASK(P0,P1,t) do{}while(0)
  bool resc=false;
  #define START(P0,P1) do{ const float rm=rowmax(P0,P1); resc=false; \
    { const float dl=rm; mhat=fadd_s(mhat,dl); \
      _Pragma("unroll") for(int r=0;r<16;++r){P0[r]=fsub_s(P0[r],dl);P1[r]=fsub_s(P1[r],dl);} \
      _Pragma("unroll") for(int r=0;r<16;++r)negm[r]=-mhat; asm volatile("":"+v"(negm)); } \
    _Pragma("unroll") for(int r=0;r<16;++r)P0[r]=__builtin_amdgcn_exp2f(P0[r]); }while(0)
  #define RESC() do{ if(resc){ asm volatile("s_waitcnt lgkmcnt(0)":::"memory"); \
      _Pragma("unroll") for(int d_=0;d_<2;++d_) _Pragma("unroll") for(int r=0;r<16;++r)o[d_][r]*=wsf[crow(r,hi)]; } }while(0)
  f32x16 pA0,pA1,pB0,pB1;
  int sl_prev=0,sl_cur=0,sl_next=SLOTB;
  #define ROT() do{sl_prev=sl_cur;sl_cur=sl_next;sl_next=(sl_next==(NSLOT-1)*SLOTB)?0:sl_next+SLOTB;}while(0)
  DMA_K(2,2*SLOTB);
  WAIT_BAR(3);
  qkt(pA0,pA1,Kbase,qr,negm,r32,hi);asm volatile("s_nop 15\n\ts_nop 7":"+v"(pA0),"+v"(pA1));CMASK(pA0,pA1,0);
  START(pA0,pA1);
  _Pragma("unroll") for(int r=0;r<16;++r)pA1[r]=__builtin_amdgcn_exp2f(pA1[r]);
  WAIT_BAR(0);
  DMA_K(3,0);DMA_V(1,SLOTB);
  ROT();
  kload8(kf,kp0+sl_cur);
  WAIT_BAR(2);
  s16x4 vlo[8],vhi[8]; u32x4 pw0,pw1,pw2,pw3;
  #define PKW(P,B) cvtpk_s(P[B],P[B+1])
  #define PAF(k) __builtin_bit_cast(bf16x8,pw##k)
  #define VFR(i) (bf16x8){vlo[i][0],vlo[i][1],vlo[i][2],vlo[i][3],vhi[i][0],vhi[i][1],vhi[i][2],vhi[i][3]}
  #define PIN(x) asm volatile("":"+v"(x))
  #define MX3(a,b,c) __builtin_fmaxf(__builtin_fmaxf((a),(b)),(c))
  #define GAPA(MF,A0,A1,A2,A3,W0,W1,PW) do{ MF; sacc+=A0; sacc+=A1; sacc+=A2; sacc+=A3; PIN(sacc); W0; W1; PIN(PW); SBAR(); }while(0)
  #define EX(v) __builtin_amdgcn_exp2f(v)
  #define GAPB(MF,X,B) do{ MF; X[B]=EX(X[B]); X[B+1]=EX(X[B+1]); X[B+2]=EX(X[B+2]); X[B+3]=EX(X[B+3]); PIN(X); SBAR(); }while(0)
  #define VRD(i) do{ vlo[i]=vtr(vp_+(((i)>>2)*4096+((i)&3)*1024)); vhi[i]=vtr(vp_+(((i)>>2)*4096+((i)&3)*1024+512)); }while(0)
  #define KRD(G,j) do{ if(G){ kload2(kf,kp0+sl_next,j); SBAR(); } }while(0)
  #define STEP(C0,C1,P0,P1,t,GK,GV,GL) do{ SBAR(); \
    const lds_cptr vp_=vp0+sl_prev; \
    VRD(0); SBAR(); float sacc=(P0[0]+P0[1]); \
    GAPA(C0=__builtin_amdgcn_mfma_f32_32x32x16_bf16(kf[0],qr[0],negm,0,0,0), P0[2],P0[3],P0[4],P0[5],     pw0[0]=PKW(P0,0), pw0[1]=PKW(P0,2), pw0); \
    VRD(4); SBAR(); GAPA(C1=__builtin_amdgcn_mfma_f32_32x32x16_bf16(kf[1],qr[0],negm,0,0,0), P0[6],P0[7],P0[8],P0[9],     pw0[2]=PKW(P0,4), pw0[3]=PKW(P0,6), pw0); \
    VRD(1); SBAR(); GAPA(C0=__builtin_amdgcn_mfma_f32_32x32x16_bf16(kf[2],qr[1],C0,0,0,0),   P0[10],P0[11],P0[12],P0[13], pw1[0]=PKW(P0,8), pw1[1]=PKW(P0,10), pw1); \
    VRD(5); SBAR(); GAPA(C1=__builtin_amdgcn_mfma_f32_32x32x16_bf16(kf[3],qr[1],C1,0,0,0),   P0[14],P0[15],P1[0],P1[1],   pw1[2]=PKW(P0,12),pw1[3]=PKW(P0,14), pw1); \
    VRD(2); SBAR(); GAPA(C0=__builtin_amdgcn_mfma_f32_32x32x16_bf16(kf[4],qr[2],C0,0,0,0),   P1[2],P1[3],P1[4],P1[5],     pw2[0]=PKW(P1,0), pw2[1]=PKW(P1,2), pw2); \
    VRD(6); SBAR(); GAPA(C1=__builtin_amdgcn_mfma_f32_32x32x16_bf16(kf[5],qr[2],C1,0,0,0),   P1[6],P1[7],P1[8],P1[9],     pw2[2]=PKW(P1,4), pw2[3]=PKW(P1,6), pw2); \
    VRD(3); SBAR(); GAPA(C0=__builtin_amdgcn_mfma_f32_32x32x16_bf16(kf[6],qr[3],C0,0,0,0),   P1[10],P1[11],P1[12],P1[13], pw3[0]=PKW(P1,8), pw3[1]=PKW(P1,10), pw3); \
    VRD(7); SBAR(); GAPA(C1=__builtin_amdgcn_mfma_f32_32x32x16_bf16(kf[7],qr[3],C1,0,0,0),   P1[14],P1[15],0.f,0.f,       pw3[2]=PKW(P1,12),pw3[3]=PKW(P1,14), pw3); \
    l_reg+=sacc; \
    if(GK){DMA_K((t)+3,sl_cur);} if(GV){DMA_V((t)+1,sl_next);} \
    CMASK(C0,C1,t); \
    { float a=MX3(C0[0],C0[1],C1[0]),b=MX3(C0[2],C0[3],C1[1]); a=MX3(a,C1[2],C1[3]); \
      _Pragma("unroll") for(int r=4;r<16;r+=4){a=MX3(a,C0[r],C0[r+1]);b=MX3(b,C0[r+2],C0[r+3]);a=MX3(a,C1[r],C1[r+1]);b=MX3(b,C1[r+2],C1[r+3]);} \
      float rm=__builtin_fmaxf(a,b); { auto rr=__builtin_amdgcn_permlane32_swap(__float_as_uint(rm),__float_as_uint(rm),false,false); rm=__builtin_fmaxf(__uint_as_float(rr[0]),__uint_as_float(rr[1])); } \
      resc=false; \
      if(__builtin_expect(__any(rm>(float)THRL),0)){ const float dl=__builtin_fmaxf(rm,0.f); mhat+=dl; \
        _Pragma("unroll") for(int r=0;r<16;++r){C0[r]-=dl;C1[r]-=dl;} \
        _Pragma("unroll") for(int r=0;r<16;++r)negm[r]=-mhat; asm volatile("":"+v"(negm)); \
        const float f=__builtin_amdgcn_exp2f(-dl); l_reg*=f; if(hi==0)wsf[r32]=f; resc=true; } } \
    SBAR(); \
    GAPB(o[0]=__builtin_amdgcn_mfma_f32_32x32x16_bf16(PAF(0),VFR(0),o[0],0,0,0), C0,0); \
    GAPB(o[1]=__builtin_amdgcn_mfma_f32_32x32x16_bf16(PAF(0),VFR(4),o[1],0,0,0), C0,4); \
    KRD(GL,0); GAPB(o[0]=__builtin_amdgcn_mfma_f32_32x32x16_bf16(PAF(1),VFR(1),o[0],0,0,0), C0,8); \
    KRD(GL,1); GAPB(o[1]=__builtin_amdgcn_mfma_f32_32x32x16_bf16(PAF(1),VFR(5),o[1],0,0,0), C0,12); \
    KRD(GL,2); GAPB(o[0]=__builtin_amdgcn_mfma_f32_32x32x16_bf16(PAF(2),VFR(2),o[0],0,0,0), C1,0); \
    KRD(GL,3); GAPB(o[1]=__builtin_amdgcn_mfma_f32_32x32x16_bf16(PAF(2),VFR(6),o[1],0,0,0), C1,4); \
    GAPB(o[0]=__builtin_amdgcn_mfma_f32_32x32x16_bf16(PAF(3),VFR(3),o[0],0,0,0), C1,8); \
    GAPB(o[1]=__builtin_amdgcn_mfma_f32_32x32x16_bf16(PAF(3),VFR(7),o[1],0,0,0), C1,12); \
    }while(0)
  int t=1;
  #undef CMASK
  #define CMASK(P0,P1,t) do{}while(0)
  for(;t+5<NT;t+=2){
    STEP(pB0,pB1,pA0,pA1,t,true,true,true);     WAIT_BAR(2); RESC(); ROT();
    STEP(pA0,pA1,pB0,pB1,t+1,true,true,true);   WAIT_BAR(2); RESC(); ROT();
  }
  #undef CMASK
  #define CMASK(P0,P1,t) do{}while(0)
  #define ENDW(tt) do{ if((tt)+3<NT){WAIT_BAR(2);} else if((tt)+2<NT){WAIT_BAR(1);} else {WAIT_BAR(0);} }while(0)
  for(;t+1<NT;t+=2){
    STEP(pB0,pB1,pA0,pA1,t,(t+3<NT),(t+1<NT),(t+1<NT));       ENDW(t);   RESC(); ROT();
    STEP(pA0,pA1,pB0,pB1,t+1,(t+4<NT),(t+2<NT),(t+2<NT));     ENDW(t+1); RESC(); ROT();
  }
  STEP(pB0,pB1,pA0,pA1,NT-1,false,false,false); RESC();
  { float sacc=pB0[0]+pB0[1]; _Pragma("unroll") for(int r=2;r<16;++r)sacc+=pB0[r]; _Pragma("unroll") for(int r=0;r<16;++r)sacc+=pB1[r]; l_reg+=sacc;
    pw0=(u32x4){PKW(pB0,0),PKW(pB0,2),PKW(pB0,4),PKW(pB0,6)};pw1=(u32x4){PKW(pB0,8),PKW(pB0,10),PKW(pB0,12),PKW(pB0,14)};pw2=(u32x4){PKW(pB1,0),PKW(pB1,2),PKW(pB1,4),PKW(pB1,6)};pw3=(u32x4){PKW(pB1,8),PKW(pB1,10),PKW(pB1,12),PKW(pB1,14)};
    SBAR(); pv(o,vb0+sl_cur,PAF(0),PAF(1),PAF(2),PAF(3)); }
  #undef PKW
  #undef PAF
  #undef VFR
  #undef PIN
  #undef MX3
  #undef GAPA
  #undef GAPB
  #undef EX
  #undef VRD
  #undef KRD
  #undef STEP
  #undef ENDW
  {auto rr=__builtin_amdgcn_permlane32_swap(__float_as_uint(l_reg),__float_as_uint(l_reg),false,false);l_reg=__uint_as_float(rr[0])+__uint_as_float(rr[1]);}
  if(hi==0)wsf[32+r32]=l_reg;asm volatile("s_waitcnt lgkmcnt(0)":::"memory");
  float rli[16];
  #pragma unroll
  for(int r=0;r<16;++r)rli[r]=__builtin_amdgcn_rcpf(wsf[32+crow(r,hi)]);
  bf16*Ow=O0+(long)(wid*QBLK)*OP;
  { bf16*stg=(bf16*)(shm+LDS_OST)+wid*2048;
    #pragma unroll
    for(int r=0;r<16;++r){const int orow=crow(r,hi);
      #pragma unroll
      for(int d0=0;d0<2;++d0)stg[orow*64+d0*32+r32]=__float2bfloat16(o[d0][r]*rli[r]);}
    asm volatile("s_waitcnt lgkmcnt(0)":::"memory");
    #pragma unroll
    for(int i=0;i<4;++i){const int row=i*8+(lane>>3),ch=lane&7; const u32x4 v=*(const u32x4*)(stg+row*64+ch*8); ATTN_STORE16(Ow+(long)row*OP+ch*8,v);} }
  asm volatile("s_waitcnt lgkmcnt(0)\n\ts_barrier":::"memory");
  #undef DMA_K
  #undef DMA_V
  #undef CMASK
  #undef START
  #undef RESC
  #undef ROT
}
constexpr int ATTN_LDS_BYTES=LDS_BYTES;
#undef SBAR
#undef WAIT_BAR
}

__device__ __forceinline__ void attn_phase_run(const P& p, unsigned char* lds_generic, int layer) {
    typedef attn_body::bf16 abf;
    const int G = gridDim.x, bx = blockIdx.x, vcu = (G % 8 == 0) ? (bx % 8) * (G / 8) + bx / 8 : bx;
    const abf* Q = (const abf*)(p.ws + WS_ATTQ); const abf* K = (const abf*)(p.ws + WS_ATTK); const abf* V = (const abf*)(p.ws + WS_ATTV); abf* X = (abf*)(p.ws + WS_X);
    if (G == 256) {
        const int x = vcu >> 5, qb = vcu & 31, b = x >> 2, kvh = (x >> 1) & 1;
#pragma unroll 1
        for (int i = 0; i < 2; ++i) { const int h = kvh * 4 + 2 * (x & 1) + i; const long r0 = (long)b * SEQ + qb * 256;
            attn_body::attn_unit<8>(Q + r0 * 512 + h * 64, K + (long)b * KEYS * 128 + kvh * 64, V + (long)b * KEYS * 128 + kvh * 64, X + r0 * 1536 + 768 + h * 64, KEYS / 64, (char*)lds_generic); }
    } else {
#pragma unroll 1
        for (int u = vcu; u < 512; u += G) { const int qb = u & 31, h = (u >> 5) & 7, b = u >> 8, kvh = h >> 2; const long r0 = (long)b * SEQ + qb * 256;
            attn_body::attn_unit<8>(Q + r0 * 512 + h * 64, K + (long)b * KEYS * 128 + kvh * 64, V + (long)b * KEYS * 128 + kvh * 64, X + r0 * 1536 + 768 + h * 64, KEYS / 64, (char*)lds_generic); }
    }
    if (layer == 0) {
#pragma unroll 1
        for (int u = vcu; u < 16; u += G) { const int b = u >> 3, h = u & 7, kvh = h >> 2; const long r0 = NLAT + (long)b * CTX;
            attn_body::attn_unit<8>(Q + r0 * 512 + h * 64, K + (long)b * KEYS * 128 + kvh * 64, V + (long)b * KEYS * 128 + kvh * 64, X + r0 * 1536 + 768 + h * 64, CTX / 64, (char*)lds_generic); }
    }
}

__device__ __forceinline__ void ph_fft1(const P& p, LAS unsigned char* lds, int layer) {
    { fg::PlainSched S{(const char*)(p.ws + WS_F1), (const char*)(p.ws + WS_UT), 256, 256, 1, 128, (int)gridDim.x, (int)blockIdx.x, 4};
      fg::EpiFft1 E{p.ws}; fg::gemm_phase(lds, 256, 256, S, E); }
    if (layer == 0) { fg::PlainSched S{(const char*)(p.ws + WS_FC), (const char*)(p.ws + WS_UTC), 256, 256, 2, 2, (int)gridDim.x, (int)((blockIdx.x + 128) % gridDim.x), 4};
      fg::EpiFftC E{p.ws}; fg::gemm_phase(lds, 256, 256, S, E); }
}
__device__ __forceinline__ void ph_fft3(const P& p, LAS unsigned char* lds) {
    fg::PlainSched S{(const char*)(p.ws + WS_F2), (const char*)(p.ws + WS_Z), 256, 256, 1, 256, (int)gridDim.x, (int)blockIdx.x, 4};
    fg::EpiFft3 E{p.ws}; fg::gemm_phase(lds, 256, 256, S, E);
}
__device__ __forceinline__ void ph_mix1(const P& p, LAS unsigned char* lds, int layer) {
    ph_fft1(p, lds, layer);
    const int nconv = layer == 0 ? 264 : 256;
    const int n0 = nconv, n1 = n0 + NB * NCHUNK * 4;
    for (int it = gridDim.x - 1 - blockIdx.x; it < n1; it += gridDim.x) {
        if (it < n0) { if (it < 256) conv_item(p, lds, layer, it >> 7, (it & 127) * 64); else conv_item(p, lds, layer, 2 + ((it - 256) >> 2), ((it - 256) & 3) * 64); }
        else ret_kv_item(p, lds, layer, it - n0);
    }
    __syncthreads();
}
__device__ __forceinline__ void ph_mix2(const P& p, LAS unsigned char* lds, unsigned char* lds_generic, int layer) {
    for (int it = blockIdx.x; it < 128; it += gridDim.x) ret_scan_item(p, layer, it);
    __syncthreads();
    ph_fft3(p, lds);
    attn_phase_run(p, lds_generic, layer);
    __syncthreads();
}
__device__ __forceinline__ void ph_mix3(const P& p, LAS unsigned char* lds, int layer) {
    for (int it = blockIdx.x; it < NB * NCHUNK * 4; it += gridDim.x) {
        const int n = (it >> 2) % NCHUNK; if (layer == 1 && n < 2) continue;
        ret_out_item(p, lds, layer, it);
    }
    __syncthreads();
}

namespace sk {
typedef short bf16x8 __attribute__((ext_vector_type(8)));
__device__ __forceinline__ void tile64(LAS unsigned char* lds, const bf16* A, int lda, const bf16* Bt, int ldb, int K, float (&out)[8]) {
    const int tid = threadIdx.x, lane = tid & 63, w = tid >> 6, kc = K >> 3;
    const bf16* ap = A + (size_t)(lane & 15) * lda + w * kc + 8 * (lane >> 4); const bf16* bp = Bt + (size_t)(lane & 15) * ldb + w * kc + 8 * (lane >> 4);
    f32x4 acc[4][4];
#pragma unroll
    for (int i = 0; i < 4; ++i)
#pragma unroll
        for (int j = 0; j < 4; ++j) acc[i][j] = (f32x4){0.f, 0.f, 0.f, 0.f};
#pragma unroll 2
    for (int k0 = 0; k0 < kc; k0 += 32) {
        bf16x8 af[4], bfr[4];
#pragma unroll
        for (int i = 0; i < 4; ++i) { af[i] = *(const bf16x8*)(ap + (size_t)(16 * i) * lda + k0); bfr[i] = *(const bf16x8*)(bp + (size_t)(16 * i) * ldb + k0); }
#pragma unroll
        for (int i = 0; i < 4; ++i)
#pragma unroll
            for (int j = 0; j < 4; ++j) acc[i][j] = __builtin_amdgcn_mfma_f32_16x16x32_bf16(af[i], bfr[j], acc[i][j], 0, 0, 0);
    }
    LAS float* part = (LAS float*)lds;
    __syncthreads();
#pragma unroll
    for (int i = 0; i < 4; ++i)
#pragma unroll
        for (int j = 0; j < 4; ++j)
#pragma unroll
            for (int r = 0; r < 4; ++r) part[((w * 16 + i * 4 + j) * 4 + r) * 64 + lane] = acc[i][j][r];
    __syncthreads();
#pragma unroll
    for (int q = 0; q < 8; ++q) { float sacc = 0.f;
#pragma unroll
        for (int ww = 0; ww < 8; ++ww) sacc += part[ww * 4096 + tid + 512 * q];
        out[q] = sacc; }
}
__device__ __forceinline__ void tile64_f8(LAS unsigned char* lds, const unsigned char* A, int lda, const unsigned char* Bt, int ldb, int K, float (&out)[8]) {
    const int tid = threadIdx.x, lane = tid & 63, w = tid >> 6;
    const unsigned char* ap = A + (size_t)(lane & 15) * lda + 32 * (lane >> 4); const unsigned char* bp = Bt + (size_t)(lane & 15) * ldb + 32 * (lane >> 4);
    f32x4 acc[4][4];
#pragma unroll
    for (int i = 0; i < 4; ++i)
#pragma unroll
        for (int j = 0; j < 4; ++j) acc[i][j] = (f32x4){0.f, 0.f, 0.f, 0.f};
    for (int ks = w; ks * 128 < K; ks += 8) {
        fg::i32x8 af[4], bfr[4];
#pragma unroll
        for (int i = 0; i < 4; ++i) { af[i] = *(const fg::i32x8*)(ap + (size_t)(16 * i) * lda + ks * 128); bfr[i] = *(const fg::i32x8*)(bp + (size_t)(16 * i) * ldb + ks * 128); }
#pragma unroll
        for (int i = 0; i < 4; ++i)
#pragma unroll
            for (int j = 0; j < 4; ++j) acc[i][j] = __builtin_amdgcn_mfma_scale_f32_16x16x128_f8f6f4(af[i], bfr[j], acc[i][j], 0, 0, 0, 0x7f7f7f7f, 0, 0x7a7a7a7a);
    }
    LAS float* part = (LAS float*)lds;
    __syncthreads();
#pragma unroll
    for (int i = 0; i < 4; ++i)
#pragma unroll
        for (int j = 0; j < 4; ++j)
#pragma unroll
            for (int r = 0; r < 4; ++r) part[((w * 16 + i * 4 + j) * 4 + r) * 64 + lane] = acc[i][j][r];
    __syncthreads();
#pragma unroll
    for (int q = 0; q < 8; ++q) { float sacc = 0.f;
#pragma unroll
        for (int ww = 0; ww < 8; ++ww) sacc += part[ww * 4096 + tid + 512 * q];
        out[q] = sacc; }
}
__device__ __forceinline__ void elem_rc(int tid, int q, int& row, int& col) { const int e = tid + 512 * q, t16 = e >> 8, reg = (e >> 6) & 3, lane = e & 63; row = 16 * (t16 >> 2) + 4 * (lane >> 4) + reg; col = 16 * (t16 & 3) + (lane & 15); }
}
__device__ __forceinline__ void mini_merge_ctx(const P& p, LAS unsigned char* lds, int layer) {
    const bf16* X = (const bf16*)(p.ws + WS_X); const bf16* WB = (const bf16*)(p.ws + WS_WB) + (size_t)layer * 1024 * 1536; const bf16* G = (const bf16*)(p.ws + WS_G); bf16* Mg = (bf16*)(p.ws + WS_MERGED);
    for (int it = gridDim.x - 1 - blockIdx.x; it < (NCTX / 64) * 16; it += gridDim.x) { const int r0 = NLAT + (it >> 4) * 64, c0 = (it & 15) * 64;
        float tot[8];
#pragma unroll
        for (int q = 0; q < 8; ++q) tot[q] = 0.f;
#pragma unroll 1
        for (int br = 0; br < 4; ++br) { const int koff = br == 0 ? 0 : (br == 1 ? 512 : (br == 2 ? 768 : 1280)), klen = (br & 1) ? 256 : 512;
            float o[8]; sk::tile64(lds, X + (size_t)r0 * 1536 + koff, 1536, WB + (size_t)c0 * 1536 + koff, 1536, klen, o);
#pragma unroll
            for (int q = 0; q < 8; ++q) { int rr, cc; sk::elem_rc(threadIdx.x, q, rr, cc); tot[q] += o[q] * bf2f(G[(size_t)(r0 + rr) * 4096 + br * 1024 + c0 + cc]); } }
#pragma unroll
        for (int q = 0; q < 8; ++q) { int rr, cc; sk::elem_rc(threadIdx.x, q, rr, cc); Mg[(size_t)(r0 + rr) * 1024 + c0 + cc] = f2bf(tot[q]); } }
    __syncthreads();
}
__device__ __forceinline__ void mini_resid_ctx(const P& p, LAS unsigned char* lds, int layer, const bf16* A, int lda, const bf16* Bt, int K, int chunk, int xnorm = -1, int nlayer = 0, int nwhich = 0) {
    const float* g = mods(p, layer, 2, chunk); float* hc = (float*)(p.ws + WS_HCTX);
    for (int it = gridDim.x - 1 - blockIdx.x; it < (NCTX / 64) * 16; it += gridDim.x) { const int rl = (it >> 4) * 64, c0 = (it & 15) * 64;
        float o[8]; sk::tile64(lds, A + (size_t)(NLAT + rl) * lda, lda, Bt + (size_t)c0 * K, K, K, o);
        if (xnorm < 0) {
#pragma unroll
            for (int q = 0; q < 8; ++q) { int rr, cc; sk::elem_rc(threadIdx.x, q, rr, cc); float* h = hc + (size_t)(rl + rr) * D + c0 + cc; *h = *h + g[c0 + cc] * o[q]; }
        } else {
#pragma unroll
            for (int q = 0; q < 8; ++q) { int rr, cc; sk::elem_rc(threadIdx.x, q, rr, cc); float* h = hc + (size_t)(rl + rr) * D + c0 + cc;
                __hip_atomic_store(h, *h + g[c0 + cc] * o[q], __ATOMIC_RELAXED, __HIP_MEMORY_SCOPE_AGENT); }
            LAS unsigned* fl = (LAS unsigned*)(lds + fg::STAGE_BYTES + 8192);
            asm volatile("s_waitcnt vmcnt(0)" ::: "memory"); __syncthreads();
            if (threadIdx.x == 0) { unsigned* c = (unsigned*)(p.ws + WS_CTL) + CW_CCNT + (8 * xnorm + (it >> 4)) * 16;
                fl[0] = __hip_atomic_fetch_add(c, 1u, __ATOMIC_RELAXED, __HIP_MEMORY_SCOPE_AGENT) == 15u ? 1u : 0u; }
            __syncthreads();
            if (fl[0]) { __builtin_amdgcn_fence(__ATOMIC_ACQUIRE, "agent");
                const int w = threadIdx.x >> 6, lane = threadIdx.x & 63;
#pragma unroll 1
                for (int j = 0; j < 8; ++j) norm_row(p, nlayer, nwhich, NLAT + rl + w * 8 + j, lane); }
            __syncthreads();
        } }
    __syncthreads();
}
__device__ __forceinline__ void ph_merge(const P& p, LAS unsigned char* lds, int layer, int nrows) {
    fg::MergeSched S{(const char*)(p.ws + WS_X), (const char*)(p.ws + WS_WB) + (size_t)layer * 1024 * 1536 * 2, nrows / 256, (int)gridDim.x, (int)blockIdx.x};
    fg::EpiMerge E{(const bf16*)(p.ws + WS_G), (bf16*)(p.ws + WS_MERGED)};
    fg::gemm_phase(lds, 1536, 1536, S, E);
}
__device__ __forceinline__ void ph_gemm_resid(const P& p, LAS unsigned char* lds, int layer, const bf16* A, int lda, const bf16* Bt, int K, int chunk, int nrows) {
    fg::PlainSched S{(const char*)A, (const char*)Bt, lda, K, nrows / 256, 4, (int)gridDim.x, (int)blockIdx.x, K / 64};
    fg::EpiResid E{p.out, (float*)(p.ws + WS_HCTX), (const float*)(p.ws + WS_MODS) + (size_t)layer * 3 * 6144, chunk};
    fg::gemm_phase(lds, lda, K, S, E);
}
__device__ __forceinline__ void ph_gemm_resid_norm(const P& p, LAS unsigned char* lds, int layer, const bf16* A, int lda, const bf16* Bt, int K, int chunk, int x, int nlayer, int nwhich) {
    fg::PlainSched S{(const char*)A, (const char*)Bt, lda, K, NLAT / 256, 4, (int)gridDim.x, (int)blockIdx.x, K / 64};
    unsigned* ctl = (unsigned*)(p.ws + WS_CTL);
    fg::EpiResidNorm E{p.out, (const float*)(p.ws + WS_MODS) + (size_t)layer * 3 * 6144, chunk,
        p.in[nwhich == 0 ? 6 : 7] + nlayer * D, (const float*)(p.ws + WS_MODS) + (size_t)nlayer * 3 * 6144, nwhich == 0 ? 0 : 3, nwhich == 0 ? 1 : 4, (bf16*)(p.ws + WS_A),
        (float*)(p.ws + WS_CTL + CTL_XBUF) + (size_t)x * 65536, ctl + CW_PCNT + 64 * 16 * x, ctl + CW_TMO, lds};
    fg::gemm_phase(lds, lda, K, S, E);
}
__device__ __forceinline__ void ph_ffn1(const P& p, LAS unsigned char* lds) {
    fg::PlainSched S{(const char*)(p.ws + WS_A), (const char*)(p.ws + WS_FFN1), D, D, MROWS / 256, 22, (int)gridDim.x, (int)blockIdx.x, D / 64};
    fg::EpiSwiglu E{(bf16*)(p.ws + WS_HMID)};
    fg::gemm_phase(lds, D, D, S, E);
}
__device__ __forceinline__ int moe_tiles(const P& p, LAS int* tile_e) {
    const unsigned* ctl = (const unsigned*)(p.ws + WS_CTL); int t = 0;
    for (int e = 0; e < NEXP; ++e) { const int c = (int)ctl[CW_CNT + e], nt = (c + 255) >> 8; for (int q = 0; q < nt; ++q) { if (threadIdx.x == 0) tile_e[t + q] = e; } t += nt; }
    __syncthreads();
    return t;
}
__device__ __forceinline__ void ph_assign_gather(const P& p, LAS unsigned char* lds) {
    const int tid = threadIdx.x, bid = blockIdx.x, G = gridDim.x;
    LAS int* sbase = (LAS int*)lds;
    LAS int* stot = sbase + 8;
    LAS int* spst = stot + 8;
    LAS int* sexp = spst + 16;
    LAS int* sslot = sexp + 128;
    const unsigned* cntb = (const unsigned*)(p.ws + WS_ROUTE) + 16384 * 6;
    const int* tok_e = (const int*)(p.ws + WS_ROUTE); int* tok_slot = (int*)(p.ws + WS_ROUTE) + 16384 * 4;
    __syncthreads();
    { const int e = tid >> 6, l = tid & 63; int tot = 0, below = 0;
      for (int b = l; b < G; b += 64) { const int c = (int)cntb[b * NEXP + e]; tot += c; if (b < bid) below += c; }
#pragma unroll
      for (int o = 1; o < 64; o <<= 1) { tot += __shfl_xor(tot, o); below += __shfl_xor(below, o); }
      if (l == 0) { sbase[e] = below; stot[e] = tot; } }
    if (tid < 128) { const int li = tid >> 1, w = li & 7, k = li >> 3, tok = (bid * 8 + w) + k * (G * 8); sexp[tid] = tok < NLAT ? tok_e[tok * 2 + (tid & 1)] : -1; }
    __syncthreads();
    if (tid == 0) { int t = 0; for (int e = 0; e < NEXP; ++e) { spst[e] = t * 256; t += (stot[e] + 255) >> 8; } spst[NEXP] = t * 256;
        if (bid == 0) { unsigned* ctl = (unsigned*)(p.ws + WS_CTL); for (int e = 0; e < NEXP; ++e) ctl[CW_CNT + e] = (unsigned)stot[e]; } }
    __syncthreads();
    if (tid < 128) { const int e = sexp[tid]; int slot = -1;
        if (e >= 0) { int rank = 0; for (int a = 0; a < tid; ++a) rank += (sexp[a] == e) ? 1 : 0; slot = spst[e] + sbase[e] + rank;
            const int li = tid >> 1, w = li & 7, k = li >> 3, tok = (bid * 8 + w) + k * (G * 8); tok_slot[tok * 2 + (tid & 1)] = slot; }
        sslot[tid] = slot; }
    __syncthreads();
    const int lane = tid & 63, wv = tid >> 6; const bf16* A = (const bf16*)(p.ws + WS_A); unsigned char* FS8 = p.ws + WS_FS;
    for (int a = wv; a < 128; a += 8) { const int slot = sslot[a]; if (slot < 0) continue; const int li = a >> 1, w = li & 7, k = li >> 3, tok = (bid * 8 + w) + k * (G * 8);
        { const u32x4 v0 = *(const u32x4*)(A + (size_t)tok * D + lane * 16), v1 = *(const u32x4*)(A + (size_t)tok * D + lane * 16 + 8);
          const f32x4 a = fg::unpk_lo(v0.x, v0.y), b = fg::unpk_lo(v0.z, v0.w), c = fg::unpk_lo(v1.x, v1.y), d = fg::unpk_lo(v1.z, v1.w);
          u32x4 o; o.x = pk4_fp8(a[0], a[1], a[2], a[3]); o.y = pk4_fp8(b[0], b[1], b[2], b[3]); o.z = pk4_fp8(c[0], c[1], c[2], c[3]); o.w = pk4_fp8(d[0], d[1], d[2], d[3]);
          *(u32x4*)(FS8 + (size_t)slot * D + lane * 16) = o; } }
    { int idx = 0;
      for (int e = 0; e < NEXP; ++e) { const int lo_ = spst[e] + stot[e], hi_ = spst[e + 1];
          for (int r = lo_ + ((bid * 8 + wv - idx) % (G * 8) + (G * 8)) % (G * 8); r < hi_; r += G * 8) {
              *(u32x4*)(FS8 + (size_t)r * D + lane * 16) = (u32x4){0u, 0u, 0u, 0u}; }
          idx += hi_ - lo_; } }
    __syncthreads();
}
__device__ __forceinline__ void ph_moe1(const P& p, LAS unsigned char* lds) {
    LAS int* tile_e = (LAS int*)(lds + fg::STAGE_BYTES); const int nt = moe_tiles(p, tile_e);
    fg::ExpertSched S{(const char*)(p.ws + WS_FS), (const char*)(p.ws + WS_MOE1), D / 2, D / 2, nt, 22, (int)gridDim.x, (int)blockIdx.x, D / 128, tile_e, (size_t)5632 * D};
    fg::EpiSwiglu8 E{p.ws + WS_HMOE};
    fg::gemm_phase<fg::EpiSwiglu8, fg::ExpertSched, true>(lds, D / 2, D / 2, S, E);
}
__device__ __forceinline__ void ph_moe2(const P& p, LAS unsigned char* lds) {
    LAS int* tile_e = (LAS int*)(lds + fg::STAGE_BYTES); const int nt = moe_tiles(p, tile_e);
    const int nbig = nt < 128 ? nt : 128;
    fg::ExpertSched S{(const char*)(p.ws + WS_HMOE), (const char*)(p.ws + WS_MOE2), FFN / 2, FFN / 2, nbig, 4, (int)gridDim.x, (int)blockIdx.x, FFN / 128, tile_e, (size_t)D * FFN};
    fg::EpiStore E{(bf16*)(p.ws + WS_Y2), D};
    fg::gemm_phase<fg::EpiStore, fg::ExpertSched, true>(lds, FFN / 2, FFN / 2, S, E);
    const unsigned char* A = p.ws + WS_HMOE; bf16* Y = (bf16*)(p.ws + WS_Y2);
    for (int it = blockIdx.x; it < (nt - nbig) * 64; it += gridDim.x) {
        const int rt = nbig + (it >> 6), r0 = rt * 256 + ((it >> 4) & 3) * 64, c0 = (it & 15) * 64;
        const unsigned char* B = p.ws + WS_MOE2 + (size_t)tile_e[rt] * D * FFN;
        float o[8]; sk::tile64_f8(lds, A + (size_t)r0 * FFN, FFN, B + (size_t)c0 * FFN, FFN, FFN, o);
#pragma unroll
        for (int q = 0; q < 8; ++q) { int rr, cc; sk::elem_rc(threadIdx.x, q, rr, cc); Y[(size_t)(r0 + rr) * D + c0 + cc] = f2bf(o[q]); } }
    __syncthreads();
}
__device__ __forceinline__ void ph_combine(const P& p, int layer) {
    const int lane = threadIdx.x & 63, gw = blockIdx.x * 8 + (threadIdx.x >> 6), ngw = gridDim.x * 8;
    const float* tok_w = (const float*)(p.ws + WS_ROUTE) + 16384 * 2; const int* tok_slot = (const int*)(p.ws + WS_ROUTE) + 16384 * 4; const bf16* Y = (const bf16*)(p.ws + WS_Y2);
    for (int r = gw; r < NLAT; r += ngw) {
        const int s0 = tok_slot[r * 2], s1 = tok_slot[r * 2 + 1]; const float w0 = tok_w[r * 2], w1 = tok_w[r * 2 + 1];
        const float* g = mods(p, layer, row_mi(r), 5); float* h = p.out + (size_t)r * D;
#pragma unroll
        for (int j = 0; j < 4; ++j) { const int c = 4 * lane + 256 * j;
            const u32x2 a = *(const u32x2*)(Y + (size_t)s0 * D + c), bq = *(const u32x2*)(Y + (size_t)s1 * D + c); const f32x4 gg = *(const f32x4*)(g + c); f32x4 hv = *(f32x4*)(h + c);
            hv.x += gg.x * (w0 * __uint_as_float(a.x << 16) + w1 * __uint_as_float(bq.x << 16)); hv.y += gg.y * (w0 * __uint_as_float(a.x & 0xffff0000u) + w1 * __uint_as_float(bq.x & 0xffff0000u));
            hv.z += gg.z * (w0 * __uint_as_float(a.y << 16) + w1 * __uint_as_float(bq.y << 16)); hv.w += gg.w * (w0 * __uint_as_float(a.y & 0xffff0000u) + w1 * __uint_as_float(bq.y & 0xffff0000u));
            *(f32x4*)(h + c) = hv; }
    }
}

#define XB_TMO      128
static_assert(CW_TMO == CW_BAR + XB_TMO, "tmo word");
#define XB_XCNT(j)  (256  + 64 * (j))
#define XB_XSUB(j)  (1280 + 64 * (j))
#define XB_XGEN(j)  (2304 + 64 * (j))
#define XB_TOP      3328
#define XB_TOPGEN   3392
#define XCD_BAR_WORDS 3456
#define XB_SPIN_CAP (1u << 22)
__device__ __forceinline__ unsigned xb_ld(unsigned* p)              { return __hip_atomic_load(p, __ATOMIC_RELAXED, __HIP_MEMORY_SCOPE_AGENT); }
__device__ __forceinline__ unsigned xb_add(unsigned* p, unsigned v) { return __hip_atomic_fetch_add(p, v, __ATOMIC_RELAXED, __HIP_MEMORY_SCOPE_AGENT); }
__device__ __forceinline__ unsigned xb_xcc_id() { return (unsigned)__builtin_amdgcn_s_getreg((3 << 11) | 20) & 0xFu; }
#define XB_SPIN(cond, bar) do { unsigned _sp = 0; while (cond) { __builtin_amdgcn_s_sleep(1); \
    if ((++_sp & 255u) == 0u) { if (xb_ld(&(bar)[XB_TMO])) break; if (_sp > XB_SPIN_CAP) { atomicAdd(&(bar)[XB_TMO], 1u); break; } } } } while (0)
struct XcdBarrier { unsigned* bar; unsigned x; volatile LAS unsigned* st; };
__device__ __forceinline__ XcdBarrier xcd_barrier_post(unsigned* bar, volatile LAS unsigned* st) {
    XcdBarrier b; b.bar = bar; b.x = xb_xcc_id(); b.st = st;
    if (threadIdx.x == 0) (void)xb_add(&bar[XB_XCNT(b.x)], 1u);
    return b;
}
__device__ __forceinline__ void xcd_barrier_complete(unsigned* bar, unsigned x, unsigned& nloc, unsigned& nx) {
    const unsigned G = gridDim.x * gridDim.y * gridDim.z;
    unsigned sum, cnt, mine, sp = 0u;
    for (;;) {
        sum = 0u; cnt = 0u; mine = 0u;
#pragma unroll
        for (unsigned j = 0; j < 16; ++j) { const unsigned c = xb_ld(&bar[XB_XCNT(j)]); sum += c; cnt += (c > 0u) ? 1u : 0u; mine = (j == x) ? c : mine; }
        if (sum == G) break;
        __builtin_amdgcn_s_sleep(1);
        if ((++sp & 255u) == 0u) { if (xb_ld(&bar[XB_TMO])) break; if (sp > XB_SPIN_CAP) { atomicAdd(&bar[XB_TMO], 1u); break; } }
    }
    nloc = mine > 0u ? mine : 1u; nx = cnt > 0u ? cnt : 1u;
}
__device__ __forceinline__ void xcd_barrier(const XcdBarrier& b) {
    asm volatile("s_waitcnt vmcnt(0)" ::: "memory");
    __syncthreads();
    if (threadIdx.x == 0) {
        unsigned* bar = b.bar;
        __builtin_amdgcn_s_waitcnt(0);
        unsigned nloc = b.st[0], nx = b.st[1];
        if (nloc == 0u) { xcd_barrier_complete(bar, b.x, nloc, nx); b.st[0] = nloc; b.st[1] = nx; }
        const unsigned old = xb_add(&bar[XB_XSUB(b.x)], 1u);
        const unsigned gen = old / nloc;
        if (old + 1u == (gen + 1u) * nloc) {
            __builtin_amdgcn_fence(__ATOMIC_RELEASE, "agent");
            asm volatile("s_waitcnt vmcnt(0)" ::: "memory");
            const unsigned og = xb_add(&bar[XB_TOP], 1u);
            const unsigned tg = og / nx;
            if (og + 1u == (tg + 1u) * nx) xb_add(&bar[XB_TOPGEN], 1u);
            else XB_SPIN(xb_ld(&bar[XB_TOPGEN]) == tg, bar);
            __builtin_amdgcn_fence(__ATOMIC_ACQUIRE, "agent");
            xb_add(&bar[XB_XGEN(b.x)], 1u);
            asm volatile("s_waitcnt vmcnt(0)" ::: "memory");
        } else {
            XB_SPIN(xb_ld(&bar[XB_XGEN(b.x)]) == gen, bar);
            __builtin_amdgcn_fence(__ATOMIC_ACQUIRE, "agent");
            asm volatile("s_waitcnt vmcnt(0)" ::: "memory");
        }
    }
    __syncthreads();
}

constexpr int NPHASE = 23;
constexpr int LDS_BYTES = 150 * 1024;
__global__ void __launch_bounds__(NTHREADS, 2) mk(P p, int lo, int hi, int fuse) {
    extern __shared__ __attribute__((aligned(16))) unsigned char lds_raw[];
    LAS unsigned char* lds = (LAS unsigned char*)lds_raw;
    volatile LAS unsigned* misc = (volatile LAS unsigned*)(lds + LDS_BYTES - 64);
    if (threadIdx.x < 16) misc[threadIdx.x] = 0u;
    __syncthreads();
    XcdBarrier bar; bar.bar = (unsigned*)(p.ws + WS_CTL) + CW_BAR; bar.x = 0; bar.st = misc;
    if (hi - lo > 1) bar = xcd_barrier_post((unsigned*)(p.ws + WS_CTL) + CW_BAR, misc);
#ifndef PROBE_MASK
#define PROBE_MASK 0u
#endif
#define PH(k, body) do { if (lo <= (k) && (k) < hi) { if ((k) > lo) { if (MK_SINGLE && (k) == 1) cg::this_grid().sync(); else xcd_barrier(bar); } body; \
    if ((PROBE_MASK >> (k)) & 1u) { xcd_barrier(bar); body; } } } while (0)
#define LAYER_PHASES(L, base) \
    PH(base + 0, ph_win(p, lds, L)); \
    PH(base + 1, ph_mix1(p, lds, L)); \
    PH(base + 2, ph_mix2(p, lds, lds_raw, L)); \
    PH(base + 3, ph_mix3(p, lds, L)); \
    PH(base + 4, { ph_merge(p, lds, L, NLAT); if (L == 0) mini_merge_ctx(p, lds, L); }); \
    PH(base + 5, { if (L == 0 && fuse) { ph_gemm_resid_norm(p, lds, 0, (const bf16*)(p.ws + WS_MERGED), 1024, (const bf16*)(p.ws + WS_WOUT), D, 2, 0, 0, 1); mini_resid_ctx(p, lds, 0, (const bf16*)(p.ws + WS_MERGED), 1024, (const bf16*)(p.ws + WS_WOUT), D, 2, 0, 0, 1); } \
        else { ph_gemm_resid(p, lds, L, (const bf16*)(p.ws + WS_MERGED), 1024, (const bf16*)(p.ws + WS_WOUT) + (size_t)L * D * D, D, 2, NLAT); if (L == 0) mini_resid_ctx(p, lds, L, (const bf16*)(p.ws + WS_MERGED), 1024, (const bf16*)(p.ws + WS_WOUT), D, 2); } });
    PH(0, ph_prologue(p, lds));
    PH(1, ph_norm(p, lds, 0, 0, true, false, MROWS));
    LAYER_PHASES(0, 2)
    if (!fuse) PH(8, ph_norm(p, lds, 0, 1, false, false, MROWS));
    PH(9, ph_ffn1(p, lds));
    PH(10, { if (fuse) { ph_gemm_resid_norm(p, lds, 0, (const bf16*)(p.ws + WS_HMID), FFN, (const bf16*)(p.ws + WS_FFN2), FFN, 5, 1, 1, 0); mini_resid_ctx(p, lds, 0, (const bf16*)(p.ws + WS_HMID), FFN, (const bf16*)(p.ws + WS_FFN2), FFN, 5, 1, 1, 0); }
        else { ph_gemm_resid(p, lds, 0, (const bf16*)(p.ws + WS_HMID), FFN, (const bf16*)(p.ws + WS_FFN2), FFN, 5, NLAT); mini_resid_ctx(p, lds, 0, (const bf16*)(p.ws + WS_HMID), FFN, (const bf16*)(p.ws + WS_FFN2), FFN, 5); } });
    if (!fuse) PH(11, ph_norm(p, lds, 1, 0, false, false, MROWS));
    LAYER_PHASES(1, 12)
    PH(18, ph_norm(p, lds, 1, 1, false, true, NLAT));
    PH(19, { ph_assign_gather(p, lds); ph_moe_convert(p, lds); });
    PH(20, ph_moe1(p, lds));
    PH(21, ph_moe2(p, lds));
    PH(22, ph_combine(p, 1));
#undef PH
#undef LAYER_PHASES
}

extern "C" void kernel_launch(void* const* d_in, const int* in_sizes, int n_in, void* d_out, int out_size, void* d_ws, size_t ws_size, hipStream_t stream) {
    static int grid = 0;
    if (grid == 0) {
        if (n_in != 30 || out_size != NLAT * D || ws_size < WS_END) { fprintf(stderr, "kernel_launch: unexpected shapes (n_in %d out %d ws %zu)\n", n_in, out_size, ws_size); grid = -1; return; }
        int dev = 0, cus = 0, per_cu = 0;
        hipGetDevice(&dev); hipDeviceGetAttribute(&cus, hipDeviceAttributeMultiprocessorCount, dev);
        hipFuncSetAttribute((const void*)mk, hipFuncAttributeMaxDynamicSharedMemorySize, LDS_BYTES);
        hipOccupancyMaxActiveBlocksPerMultiprocessor(&per_cu, (const void*)mk, NTHREADS, LDS_BYTES);
        if (per_cu < 1) { fprintf(stderr, "kernel_launch: occupancy query says %d blocks per CU\n", per_cu); grid = -1; return; }
        grid = cus;
    }
    if (grid < 0) return;
    hipMemsetAsync((char*)d_ws + WS_CTL, 0, CTL_BYTES, stream);
    P p{};
    for (int i = 0; i < 30; ++i) p.in[i] = (const float*)d_in[i];
    p.out = (float*)d_out; p.ws = (unsigned char*)d_ws;
#if MK_SINGLE
    int lo = 0, hi = NPHASE, fuse = grid == 256 ? 1 : 0; void* args[] = {&p, &lo, &hi, &fuse};
    hipLaunchCooperativeKernel((const void*)mk, dim3(grid), dim3(NTHREADS), args, LDS_BYTES, stream);
#else
    for (int ph = 0; ph < NPHASE; ++ph) hipLaunchKernelGGL(mk, dim3(grid), dim3(NTHREADS), LDS_BYTES, stream, p, ph, ph + 1, 0);
#endif
}
```

```cpp
#include <hip/hip_runtime.h>
#include <hip/hip_cooperative_groups.h>
#include <cstdio>
#include <cstdint>
namespace cg = cooperative_groups;

#ifndef MK_SINGLE
#define MK_SINGLE 1
#endif

typedef unsigned short bf16;
typedef float f32x4 __attribute__((ext_vector_type(4)));
typedef unsigned u32x4 __attribute__((ext_vector_type(4)));
typedef unsigned u32x2 __attribute__((ext_vector_type(2)));
#define LAS __attribute__((address_space(3)))

constexpr int D = 1024, NB = 2, SEQ = 8192, CTX = 256, NLAT = NB * SEQ, NCTX = NB * CTX, MROWS = NLAT + NCTX;
constexpr int INC = 6656, FFN = 2816, NEXP = 8, KEYS = CTX + SEQ;
constexpr int NCHUNK = 66;
constexpr float EPS = 1e-6f;
constexpr float QSCALE = 0.125f * 1.4426950408889634f;
constexpr int MOE_ROWS = 34816;
constexpr int NTHREADS = 512;

constexpr size_t MiB = 1u << 20;
constexpr size_t WS_CTL = 0, CTL_BYTES = 1 * MiB;
constexpr size_t WS_MODS = 1 * MiB;
constexpr size_t WS_ROPE = 2 * MiB;
constexpr size_t WS_F1 = 4 * MiB;
constexpr size_t WS_F2 = WS_F1 + 131072;
constexpr size_t WS_FC = WS_F2 + 131072;
constexpr size_t WS_TW = WS_FC + 262144;
constexpr size_t WS_ROUTE = 5 * MiB;
constexpr size_t WS_HCTX = 6 * MiB;
constexpr size_t WS_WIN = 8 * MiB;
constexpr size_t WS_WB = 34 * MiB;
constexpr size_t WS_WOUT = 40 * MiB;
constexpr size_t WS_FFN1 = 44 * MiB;
constexpr size_t WS_FFN2 = 55 * MiB;
constexpr size_t WS_A = 61 * MiB;
constexpr size_t WS_X = 94 * MiB;
constexpr size_t WS_Y = 144 * MiB;
constexpr size_t WS_RETQ = WS_Y;
constexpr size_t WS_RETK = WS_RETQ + (size_t)MROWS * 256 * 2;
constexpr size_t WS_RETV = WS_RETK + (size_t)MROWS * 256 * 2;
constexpr size_t WS_RETG = WS_RETV + (size_t)MROWS * 256 * 2;
constexpr size_t WS_ATTQ = WS_Y + 33 * MiB;
constexpr size_t WS_ATTK = WS_Y + 50 * MiB;
constexpr size_t WS_ATTV = WS_Y + 55 * MiB;
constexpr size_t WS_CONV = WS_Y + 60 * MiB;
constexpr size_t WS_UT = WS_Y + 77 * MiB;
constexpr size_t WS_UTC = WS_Y + 93 * MiB;
constexpr size_t WS_Z = WS_Y + 94 * MiB;
constexpr size_t WS_RETS = WS_Y + 126 * MiB;
constexpr size_t WS_MERGED = WS_Y + 143 * MiB;
constexpr size_t WS_G = 320 * MiB;
constexpr size_t WS_MOE1 = WS_G;
constexpr size_t WS_MOE2 = WS_G + (size_t)NEXP * 5632 * 1024 * 2;
constexpr size_t WS_HMID = WS_Y;
constexpr size_t WS_HMOE = 61 * MiB;
constexpr size_t WS_FS = 252 * MiB;
constexpr size_t WS_A8 = 386 * MiB;
constexpr size_t WS_WIN8 = 430 * MiB;
constexpr size_t WS_RETS2 = 452 * MiB;
constexpr size_t WS_Y2 = 160 * MiB;
constexpr size_t WS_END = 469 * MiB;
static_assert(WS_MERGED + (size_t)MROWS * 1024 * 2 <= WS_G, "map");
static_assert(WS_HMOE + (size_t)MOE_ROWS * FFN * 2 <= WS_FS && WS_FS + (size_t)MOE_ROWS * 1024 * 2 <= WS_G, "map moe");
static_assert(WS_MOE2 + (size_t)NEXP * 1024 * FFN * 2 <= WS_END, "map moe w");
static_assert(WS_G + (size_t)MROWS * 4096 <= WS_A8 && WS_A8 + (size_t)NLAT * 1024 <= WS_MOE2 && WS_MOE2 + (size_t)NEXP * 1024 * FFN <= WS_WIN8 && WS_WIN8 + (size_t)2 * 4096 * 1024 <= WS_RETS2, "map fp8 w_in");
constexpr int CW_CNT = 64;
constexpr int CW_CUR = 128;
constexpr int CW_BAR = 4096;
constexpr int CW_TMO = CW_BAR + 128;
constexpr int CW_PCNT = 8192;
constexpr int CW_CCNT = 8192 + 4 * 64 * 16;
constexpr size_t CTL_XBUF = 128 * 1024;

struct P {
    const float* in[30];
    float* out;
    unsigned char* ws;
};

__device__ __forceinline__ float bf2f(bf16 v) { return __uint_as_float((unsigned)v << 16); }
__device__ __forceinline__ bf16 f2bf(float f) { unsigned u = __float_as_uint(f); return (bf16)((u + 0x7fffu + ((u >> 16) & 1u)) >> 16); }
__device__ __forceinline__ unsigned pk2(float lo, float hi) { return (unsigned)f2bf(lo) | ((unsigned)f2bf(hi) << 16); }
__device__ __forceinline__ float sigmoidf_(float x) { return 1.f / (1.f + __expf(-x)); }
__device__ __forceinline__ float siluf_(float x) { return x / (1.f + __expf(-x)); }
__device__ __forceinline__ float sigmoid_fast(float x) { return __builtin_amdgcn_rcpf(1.f + __builtin_amdgcn_exp2f(-1.4426950408889634f * x)); }
__device__ __forceinline__ float silu_fast(float x) { return x * __builtin_amdgcn_rcpf(1.f + __builtin_amdgcn_exp2f(-1.4426950408889634f * x)); }
__device__ __forceinline__ float wave_sum(float v) {
#pragma unroll
    for (int o = 1; o < 64; o <<= 1) v += __shfl_xor(v, o);
    return v;
}
__device__ __forceinline__ int row_mi(int r) { return r < NLAT ? (r >> 13) : 2; }
__device__ __forceinline__ float* hrow(const P& p, int r) { return r < NLAT ? p.out + (size_t)r * D : (float*)(p.ws + WS_HCTX) + (size_t)(r - NLAT) * D; }
__device__ __forceinline__ const float* mods(const P& p, int layer, int mi, int chunk) { return (const float*)(p.ws + WS_MODS) + ((size_t)(layer * 3 + mi) * 6 + chunk) * D; }

__device__ __forceinline__ int rowmap(int mode, int n) {
    if (mode == 0) return n;
    if (mode == 1 || mode == 2) return 8 * (n >> 2) + (n & 3) + (mode == 2 ? 4 : 0);
    const int tile = n >> 8, l = n & 255, head = l >> 6, d = l & 63;
    const bool ropet = tile == 1 || tile == 2 || tile == 5 || tile == 6 || (tile == 7 && head < 2);
    if (ropet) { const int i = d & 31, nn = d >> 5; return tile * 256 + 128 * (i >> 4) + 32 * head + 8 * ((i >> 2) & 3) + 4 * nn + (i & 3); }
    if (tile == 7) return tile * 256 + 128 * (d >> 5) + 32 * head + 8 * ((d >> 3) & 3) + (d & 7);
    return n;
}
__device__ __forceinline__ void conv_tile(LAS float* scr, const float* src, int ldn, int k0, int n0, bf16* dst, int ldd, int koff, int mode) {
    const int tid = threadIdx.x;
    __syncthreads();
#pragma unroll
    for (int i = 0; i < 8; ++i) { const int e = tid + i * NTHREADS, kk = e >> 6, nn = e & 63; scr[kk * 65 + nn] = src[(size_t)(k0 + kk) * ldn + n0 + nn]; }
    __syncthreads();
    const int nn = tid >> 3, kc = (tid & 7) * 8;
    u32x4 o; o.x = pk2(scr[(kc + 0) * 65 + nn], scr[(kc + 1) * 65 + nn]); o.y = pk2(scr[(kc + 2) * 65 + nn], scr[(kc + 3) * 65 + nn]);
    o.z = pk2(scr[(kc + 4) * 65 + nn], scr[(kc + 5) * 65 + nn]); o.w = pk2(scr[(kc + 6) * 65 + nn], scr[(kc + 7) * 65 + nn]);
    *(u32x4*)(dst + (size_t)rowmap(mode, n0 + nn) * ldd + koff + k0 + kc) = o;
}
constexpr float F8_WSCALE = 32.f;
__device__ __forceinline__ unsigned pk4_fp8(float a, float b, float c, float d) { int w = 0; w = __builtin_amdgcn_cvt_pk_fp8_f32(a, b, w, false); w = __builtin_amdgcn_cvt_pk_fp8_f32(c, d, w, true); return (unsigned)w; }
__device__ __forceinline__ void conv_tile2_f8(LAS float* scr, const float* src, int ldn, unsigned char* dst8, int ldd, int mode, int k0a, int n0a, int k0b, int n0b, bool two) {
    const int tid = threadIdx.x;
    f32x4 va[2], vb[2];
#pragma unroll
    for (int i = 0; i < 2; ++i) { const int e = tid + i * NTHREADS, kk = e >> 4, n4 = (e & 15) * 4;
        va[i] = *(const f32x4*)(src + (size_t)(k0a + kk) * ldn + n0a + n4);
        if (two) vb[i] = *(const f32x4*)(src + (size_t)(k0b + kk) * ldn + n0b + n4); }
    __syncthreads();
#pragma unroll
    for (int i = 0; i < 2; ++i) { const int e = tid + i * NTHREADS, kk = e >> 4, n4 = (e & 15) * 4;
#pragma unroll
        for (int q = 0; q < 4; ++q) { scr[kk * 65 + n4 + q] = va[i][q]; if (two) scr[64 * 65 + kk * 65 + n4 + q] = vb[i][q]; } }
    __syncthreads();
    const int nn = tid >> 3, kc = (tid & 7) * 8;
#pragma unroll
    for (int t = 0; t < 2; ++t) { if (t == 1 && !two) break; const LAS float* sp = scr + t * 64 * 65; const int k0 = t ? k0b : k0a, n0 = t ? n0b : n0a;
        u32x2 o; o.x = pk4_fp8(sp[(kc + 0) * 65 + nn] * F8_WSCALE, sp[(kc + 1) * 65 + nn] * F8_WSCALE, sp[(kc + 2) * 65 + nn] * F8_WSCALE, sp[(kc + 3) * 65 + nn] * F8_WSCALE);
        o.y = pk4_fp8(sp[(kc + 4) * 65 + nn] * F8_WSCALE, sp[(kc + 5) * 65 + nn] * F8_WSCALE, sp[(kc + 6) * 65 + nn] * F8_WSCALE, sp[(kc + 7) * 65 + nn] * F8_WSCALE);
        *(u32x2*)(dst8 + (size_t)rowmap(mode, n0 + nn) * ldd + k0 + kc) = o; }
}
__device__ __forceinline__ void conv_tile128_f8(LAS float* scr, const float* src, int ldn, unsigned char* dst8, int ldd, int mode, int k0, int n0) {
    const int tid = threadIdx.x;
    f32x4 v[8];
#pragma unroll
    for (int i = 0; i < 8; ++i) { const int e = tid + i * NTHREADS, kk = e >> 5, n4 = (e & 31) * 4; v[i] = *(const f32x4*)(src + (size_t)(k0 + kk) * ldn + n0 + n4); }
    __syncthreads();
#pragma unroll
    for (int i = 0; i < 8; ++i) { const int e = tid + i * NTHREADS, kk = e >> 5, n4 = (e & 31) * 4;
#pragma unroll
        for (int q = 0; q < 4; ++q) scr[kk * 129 + n4 + q] = v[i][q]; }
    __syncthreads();
    const int nn = tid >> 2, kc = (tid & 3) * 32;
    u32x4 o[2];
#pragma unroll
    for (int h = 0; h < 2; ++h) { const LAS float* sp = scr + (kc + h * 16) * 129 + nn;
        o[h].x = pk4_fp8(sp[0] * F8_WSCALE, sp[129] * F8_WSCALE, sp[2 * 129] * F8_WSCALE, sp[3 * 129] * F8_WSCALE);
        o[h].y = pk4_fp8(sp[4 * 129] * F8_WSCALE, sp[5 * 129] * F8_WSCALE, sp[6 * 129] * F8_WSCALE, sp[7 * 129] * F8_WSCALE);
        o[h].z = pk4_fp8(sp[8 * 129] * F8_WSCALE, sp[9 * 129] * F8_WSCALE, sp[10 * 129] * F8_WSCALE, sp[11 * 129] * F8_WSCALE);
        o[h].w = pk4_fp8(sp[12 * 129] * F8_WSCALE, sp[13 * 129] * F8_WSCALE, sp[14 * 129] * F8_WSCALE, sp[15 * 129] * F8_WSCALE); }
    unsigned char* d = dst8 + (size_t)rowmap(mode, n0 + nn) * ldd + k0 + kc;
    *(u32x4*)d = o[0]; *(u32x4*)(d + 16) = o[1];
}
struct CJob { const float* src; int K, N; bf16* dst; int ldd, koff, mode, ldn; };
__device__ __forceinline__ CJob get_job(const P& p, int j) {
    CJob c;
    if (j < 10) { const int l = j / 5, t = j % 5; bf16* wb = (bf16*)(p.ws + WS_WB) + (size_t)l * 1024 * 1536;
        if (t == 0) c = CJob{p.in[8] + (size_t)l * D * INC, D, l == 0 ? INC : 2560, (bf16*)(p.ws + WS_WIN) + (size_t)l * INC * D, D, 0, 3, INC};
        else if (t == 1) c = CJob{p.in[13] + (size_t)l * 256 * D, 256, D, wb, 1536, 512, 0};
        else if (t == 2) c = CJob{p.in[16] + (size_t)l * 512 * D, 512, D, wb, 1536, 768, 0};
        else if (t == 3) c = CJob{p.in[21] + (size_t)l * 256 * D, 256, D, wb, 1536, 1280, 0};
        else c = CJob{p.in[22] + (size_t)l * D * D, D, D, (bf16*)(p.ws + WS_WOUT) + (size_t)l * D * D, D, 0, 0}; }
    else if (j == 10) c = CJob{p.in[23], D, FFN, (bf16*)(p.ws + WS_FFN1), D, 0, 1};
    else if (j == 11) c = CJob{p.in[24], D, FFN, (bf16*)(p.ws + WS_FFN1), D, 0, 2};
    else c = CJob{p.in[25], FFN, D, (bf16*)(p.ws + WS_FFN2), FFN, 0, 0};
    return c;
}
__device__ __forceinline__ CJob get_moe_job(const P& p, int j) {
    const int e = j / 3, t = j % 3; CJob c;
    const float* sg = p.in[27]; const float* su = p.in[28]; const float* sd = p.in[29];
    asm volatile("" : "+s"(sg), "+s"(su), "+s"(sd));
    if (t == 0) c = CJob{sg + (size_t)e * D * FFN, D, FFN, (bf16*)(p.ws + WS_MOE1 + (size_t)e * 5632 * D), D, 0, 1};
    else if (t == 1) c = CJob{su + (size_t)e * D * FFN, D, FFN, (bf16*)(p.ws + WS_MOE1 + (size_t)e * 5632 * D), D, 0, 2};
    else c = CJob{sd + (size_t)e * FFN * D, FFN, D, (bf16*)(p.ws + WS_MOE2 + (size_t)e * D * FFN), FFN, 0, 0};
    return c;
}
template <bool MOE> __device__ __forceinline__ void run_conv_jobs(const P& p, LAS float* scr, int njobs, int bid, int nb) {
    int base = 0, base2 = 0;
    for (int j = 0; j < njobs; ++j) {
        const CJob jb = MOE ? get_moe_job(p, j) : get_job(p, j); const int nn = jb.N / 64, cnt = (jb.K / 64) * nn, ldn = jb.ldn ? jb.ldn : jb.N;
        const int first = ((bid - base) % nb + nb) % nb;
        if (MOE) { const int nn2 = jb.N / 128, cnt2 = (jb.K / 128) * nn2; const int first2 = ((bid - base2) % nb + nb) % nb;
            for (int i = first2; i < cnt2; i += nb) conv_tile128_f8(scr, jb.src, jb.N, (unsigned char*)jb.dst, jb.ldd, jb.mode, (i / nn2) * 128, (i % nn2) * 128);
            base2 += cnt2; }
        else for (int i = first; i < cnt; i += nb) conv_tile(scr, jb.src, ldn, (i / nn) * 64, (i % nn) * 64, jb.dst, jb.ldd, jb.koff, jb.mode);
        base += cnt;
    }
}
__device__ __forceinline__ void ph_prologue(const P& p, LAS unsigned char* lds) {
    const int tid = threadIdx.x, bid = blockIdx.x, nb = gridDim.x;
    const int gt = bid * NTHREADS + tid, ngt = nb * NTHREADS;
    LAS float* scr = (LAS float*)lds;
    run_conv_jobs<false>(p, scr, 13, bid, nb);
    __syncthreads();
    for (int i = bid; i < 512; i += nb) { const int l = i >> 8, t = i & 255;
        conv_tile128_f8(scr, p.in[8] + (size_t)l * D * INC + 2560, INC, p.ws + WS_WIN8 + (size_t)l * 4096 * 1024, 1024, 0, (t >> 5) * 128, (t & 31) * 128); }
    __syncthreads();
    {
        LAS float* tc = (LAS float*)lds; LAS float* tsn = tc + 64;
        __syncthreads();
        if (tid < 64) { tc[tid] = cospif(tid * (2.f / 64.f)); tsn[tid] = sinpif(tid * (2.f / 64.f)); }
        __syncthreads();
        const float s = 1.0f / sqrtf(64.f * 8192.f);
        for (int e = gt; e < 2 * 512 * 1024; e += ngt) {
            const int n = e & 1023, kk = (e >> 10) & 511, l = e >> 19;
            const int part = kk >> 8, g = (kk >> 6) & 3, c = kk & 63;
            const float* W = p.in[9] + (size_t)l * 256 * D + (size_t)(g * 64) * D + n;
            float acc = 0.f;
#pragma unroll 8
            for (int c2 = 0; c2 < 64; ++c2) { const int m = (c * c2) & 63; const float t = part == 0 ? tc[m] : -tsn[m]; acc += t * W[(size_t)c2 * D]; }
            ((bf16*)(p.ws + WS_WB))[(size_t)l * 1024 * 1536 + (size_t)n * 1536 + kk] = f2bf(acc * s);
        }
        __syncthreads();
    }
    {
        float* rc = (float*)(p.ws + WS_ROPE); float* rs = rc + SEQ * 32;
        for (int e = gt; e < SEQ * 32; e += ngt) {
            const int s = e >> 5, i = e & 31; const float inv = powf(10000.f, -(float)(i & 15) / 16.f);
            const float pos = (float)(i < 16 ? (s >> 6) : (s & 63)); const float ang = pos * inv;
            rc[e] = cosf(ang); rs[e] = sinf(ang);
        }
    }
    {
        bf16* F1 = (bf16*)(p.ws + WS_F1); bf16* F2 = (bf16*)(p.ws + WS_F2); bf16* FC = (bf16*)(p.ws + WS_FC);
        for (int e = gt; e < 256 * 256; e += ngt) {
            const int rho = e >> 8, n1 = e & 255; float v = 0.f;
            if (n1 < 128) { const int k1 = (rho >> 5) * 16 + (rho & 15), c = (rho >> 4) & 1, m = (k1 * n1) & 127; v = c == 0 ? cospif(m * (2.f / 128.f)) : -sinpif(m * (2.f / 128.f)); }
            F1[e] = f2bf(v);
            float w = 0.f;
            if (rho < 128 && n1 < 128) { const int c2 = rho >> 6, k2 = rho & 63, c = n1 >> 6, n2 = n1 & 63, m = (k2 * n2) & 63; const float cs = cospif(m * (2.f / 64.f)), sn = sinpif(m * (2.f / 64.f));
                w = c2 == 0 ? (c == 0 ? cs : sn) : (c == 0 ? sn : -cs); }
            F2[e] = f2bf(w);
        }
        float* TW = (float*)(p.ws + WS_TW);
        for (int e = gt; e < 128 * 64; e += ngt) { const int k1 = e >> 6, n2 = e & 63; TW[2 * e] = cospif((k1 * n2) * (2.f / 8192.f)); TW[2 * e + 1] = sinpif((k1 * n2) * (2.f / 8192.f)); }
        const float sc = sqrtf(32.f);
        for (int e = gt; e < 512 * 256; e += ngt) { const int rho = e >> 8, n = e & 255, c2 = rho >> 8, k = rho & 255, m = (k * n) & 255; FC[e] = f2bf(sc * (c2 == 0 ? cospif(m * (2.f / 256.f)) : sinpif(m * (2.f / 256.f)))); }
    }
    {
        LAS float* sv = (LAS float*)lds;
        LAS float* red = sv + 3 * 1024;
        __syncthreads();
        for (int e = tid; e < 3 * 1024; e += NTHREADS) { const int j = e >> 10, k = e & 1023; const float v = j < 2 ? p.in[1][j * D + k] : p.in[3][k]; sv[e] = siluf_(v); }
        __syncthreads();
        const int kq = tid >> 6, cl = tid & 63;
        for (int it = bid; it < 2 * 96; it += nb) {
            const int l = it / 96, n = (it % 96) * 64 + cl;
            const float* W = p.in[4] + (size_t)l * D * 6144 + n;
            float a0 = 0.f, a1 = 0.f, a2 = 0.f;
#pragma unroll 16
            for (int k = kq; k < D; k += 8) { const float w = W[(size_t)k * 6144]; a0 += sv[k] * w; a1 += sv[1024 + k] * w; a2 += sv[2048 + k] * w; }
            red[(kq * 3 + 0) * 64 + cl] = a0; red[(kq * 3 + 1) * 64 + cl] = a1; red[(kq * 3 + 2) * 64 + cl] = a2;
            __syncthreads();
            if (tid < 192) { const int j = tid >> 6; float s = 0.f;
#pragma unroll
                for (int q = 0; q < 8; ++q) s += red[(q * 3 + j) * 64 + cl];
                ((float*)(p.ws + WS_MODS))[(size_t)(l * 3 + j) * 6144 + n] = s + p.in[5][l * 6144 + n]; }
            __syncthreads();
        }
    }
}
__device__ __forceinline__ void ph_moe_convert(const P& p, LAS unsigned char* lds) {
    LAS float* scr = (LAS float*)lds;
    const int bid = blockIdx.x, nb = gridDim.x;
    run_conv_jobs<true>(p, scr, 24, bid, nb);
    __syncthreads();
}

__device__ __forceinline__ void ph_norm(const P& p, LAS unsigned char* lds, int layer, int which, bool first, bool route, int nrows, bool copy = true) {
    LAS unsigned* cnt_lds = (LAS unsigned*)lds;
    if (route) { __syncthreads(); if (threadIdx.x < NEXP) cnt_lds[threadIdx.x] = 0u; __syncthreads(); }
    const int lane = threadIdx.x & 63, gw = blockIdx.x * 8 + (threadIdx.x >> 6), ngw = gridDim.x * 8;
    const float* gain = p.in[which == 0 ? 6 : 7] + layer * D;
    bf16* A = (bf16*)(p.ws + WS_A);
    for (int r = gw; r < nrows; r += ngw) {
        const int mi = row_mi(r);
        const float* src = first ? (r < NLAT ? p.in[0] + (size_t)r * D : p.in[2] + (size_t)(r - NLAT) * D) : hrow(p, r);
        const float* shift = mods(p, layer, mi, which == 0 ? 0 : 3); const float* scale = mods(p, layer, mi, which == 0 ? 1 : 4);
        f32x4 v[4]; float ss = 0.f;
#pragma unroll
        for (int j = 0; j < 4; ++j) { v[j] = *(const f32x4*)(src + 4 * lane + 256 * j); ss += v[j].x * v[j].x + v[j].y * v[j].y + v[j].z * v[j].z + v[j].w * v[j].w; }
        if (first && copy) { float* h = hrow(p, r);
#pragma unroll
            for (int j = 0; j < 4; ++j) *(f32x4*)(h + 4 * lane + 256 * j) = v[j]; }
        const float rstd = rsqrtf(wave_sum(ss) * (1.f / D) + EPS);
        float lg[8];
#pragma unroll
        for (int e = 0; e < 8; ++e) lg[e] = 0.f;
#pragma unroll
        for (int j = 0; j < 4; ++j) {
            const int c = 4 * lane + 256 * j;
            const f32x4 g = *(const f32x4*)(gain + c), sc = *(const f32x4*)(scale + c), sh = *(const f32x4*)(shift + c);
            f32x4 y = v[j] * rstd * g * (sc + 1.f) + sh;
            u32x2 o; o.x = pk2(y.x, y.y); o.y = pk2(y.z, y.w);
            if (!route) *(u32x2*)(A + (size_t)r * D + c) = o;
            if ((which == 0 || route) && r < NLAT) *(unsigned*)(p.ws + WS_A8 + (size_t)r * D + c) = pk4_fp8(y.x, y.y, y.z, y.w);
            if (route) {
                const float* rw = p.in[26] + (size_t)c * 8;
#pragma unroll
                for (int q = 0; q < 4; ++q) { const f32x4 w0 = *(const f32x4*)(rw + q * 8), w1 = *(const f32x4*)(rw + q * 8 + 4); const float yy = y[q];
                    lg[0] += yy * w0.x; lg[1] += yy * w0.y; lg[2] += yy * w0.z; lg[3] += yy * w0.w; lg[4] += yy * w1.x; lg[5] += yy * w1.y; lg[6] += yy * w1.z; lg[7] += yy * w1.w; }
            }
        }
        if (route) {
#pragma unroll
            for (int e = 0; e < 8; ++e) lg[e] = wave_sum(lg[e]);
            if (lane == 0) {
                int e0 = 0; float v0 = lg[0];
#pragma unroll
                for (int e = 1; e < 8; ++e) if (lg[e] > v0) { v0 = lg[e]; e0 = e; }
                int e1 = -1; float v1 = -INFINITY;
#pragma unroll
                for (int e = 0; e < 8; ++e) if (e != e0 && lg[e] > v1) { v1 = lg[e]; e1 = e; }
                const float w0 = 1.f / (1.f + expf(v1 - v0));
                int* tok_e = (int*)(p.ws + WS_ROUTE); float* tok_w = (float*)(p.ws + WS_ROUTE) + 16384 * 2;
                tok_e[r * 2] = e0; tok_e[r * 2 + 1] = e1; tok_w[r * 2] = w0; tok_w[r * 2 + 1] = 1.f - w0;
                __hip_atomic_fetch_add(cnt_lds + e0, 1u, __ATOMIC_RELAXED, __HIP_MEMORY_SCOPE_WORKGROUP); __hip_atomic_fetch_add(cnt_lds + e1, 1u, __ATOMIC_RELAXED, __HIP_MEMORY_SCOPE_WORKGROUP);
            }
        }
    }
    if (route) { __syncthreads(); if (threadIdx.x < NEXP) ((unsigned*)(p.ws + WS_ROUTE) + 16384 * 6)[blockIdx.x * NEXP + threadIdx.x] = cnt_lds[threadIdx.x]; __syncthreads(); }
}

__device__ __forceinline__ void norm_row(const P& p, int layer, int which, int r, int lane) {
    const float* gain = p.in[which == 0 ? 6 : 7] + layer * D; bf16* A = (bf16*)(p.ws + WS_A);
    const int mi = row_mi(r); const float* src = hrow(p, r);
    const float* shift = mods(p, layer, mi, which == 0 ? 0 : 3); const float* scale = mods(p, layer, mi, which == 0 ? 1 : 4);
    f32x4 v[4]; float ss = 0.f;
#pragma unroll
    for (int j = 0; j < 4; ++j) { v[j] = *(const f32x4*)(src + 4 * lane + 256 * j); ss += v[j].x * v[j].x + v[j].y * v[j].y + v[j].z * v[j].z + v[j].w * v[j].w; }
    const float rstd = rsqrtf(wave_sum(ss) * (1.f / D) + EPS);
#pragma unroll
    for (int j = 0; j < 4; ++j) { const int c = 4 * lane + 256 * j;
        const f32x4 g = *(const f32x4*)(gain + c), sc = *(const f32x4*)(scale + c), sh = *(const f32x4*)(shift + c);
        const f32x4 y = v[j] * rstd * g * (sc + 1.f) + sh;
        u32x2 o; o.x = pk2(y.x, y.y); o.y = pk2(y.z, y.w);
        *(u32x2*)(A + (size_t)r * D + c) = o; }
}

namespace fg {
typedef short bf16x8 __attribute__((ext_vector_type(8)));
constexpr int BM = 256, BK = 64, HALF = 128, HTB = HALF * BK * 2, STAGE_BYTES = 8 * HTB, NXCD = 8, WGM = 8;
__device__ __forceinline__ int lds_byte(int r, int c) { const int st = (r >> 4) * 2 + (c >> 5), rr = r & 15, cc = c & 31, ob = rr * 64 + cc * 2; return st * 1024 + (ob ^ (((ob >> 9) & 1) << 5)); }
__device__ __forceinline__ void stage_rc(int b, int& R, int& C) { const int st = b / 1024, sb = b % 1024, swz = sb ^ (((sb >> 9) & 1) << 5); R = (st >> 1) * 16 + swz / 64; C = (st & 1) * 32 + (swz % 64) / 2; }
__device__ __forceinline__ int perm32(int rho) { const int n = rho >> 4, i = rho & 15; return 8 * (i >> 2) + 4 * n + (i & 3); }
struct Unit { int pm, pn; const char* A; const char* B; int nt, aux; };
__device__ __forceinline__ bool tile_order(int i, int nM, int nN, int G, int c, int& pm, int& pn) {
    const int nwg = nM * nN; const long L = (long)i * G + c; if (L >= nwg) return false;
    int wgid = (int)L; { const int q = nwg / NXCD, r = nwg % NXCD, xcd = wgid % NXCD, off = wgid / NXCD; wgid = (xcd < r ? xcd * (q + 1) : r * (q + 1) + (xcd - r) * q) + off; }
    const int nig = WGM * nN, gid = wgid / nig, fm = gid * WGM, gsz = (nM - fm) < WGM ? (nM - fm) : WGM;
    pm = fm + ((wgid % nig) % gsz); pn = (wgid % nig) / gsz; return true;
}
struct PlainSched {
    const char* Abase; const char* Bbase; int lda, ldb, nM, nN, G, c, nt;
    __device__ __forceinline__ int arow(int R) const { return R; }
    __device__ __forceinline__ int ahalf() const { return HALF; }
    __device__ __forceinline__ bool next(int i, Unit& u) const { if (!tile_order(i, nM, nN, G, c, u.pm, u.pn)) return false;
        u.A = Abase + (size_t)u.pm * BM * lda * 2; u.B = Bbase + (size_t)u.pn * BM * ldb * 2; u.nt = nt; u.aux = 0; return true; }
};
struct ExpertSched {
    const char* Abase; const char* Bbase; int lda, ldb, nM, nN, G, c, nt; const LAS int* tile_e; size_t estride;
    __device__ __forceinline__ int arow(int R) const { return R; }
    __device__ __forceinline__ int ahalf() const { return HALF; }
    __device__ __forceinline__ bool next(int i, Unit& u) const { if (!tile_order(i, nM, nN, G, c, u.pm, u.pn)) return false;
        u.A = Abase + (size_t)u.pm * BM * lda * 2; u.B = Bbase + (size_t)tile_e[u.pm] * estride + (size_t)u.pn * BM * ldb * 2; u.nt = nt; u.aux = 0; return true; }
};
struct WinSched {
    const char* Abase; const char* Bbase; int G, c, mode, nN;
    __device__ __forceinline__ int arow(int R) const { return mode == 0 ? 256 * (R & 15) + 64 * ((R >> 4) & 3) + (R >> 6) : R; }
    __device__ __forceinline__ int ahalf() const { return mode == 0 ? 4096 : HALF; }
    __device__ __forceinline__ bool next(int i, Unit& u) const { if (!tile_order(i, mode == 0 ? 64 : 2, nN, G, c, u.pm, u.pn)) return false;
        const size_t row0 = mode == 0 ? (size_t)((u.pm >> 5) * SEQ + 2 * (u.pm & 31)) : (size_t)(NLAT + u.pm * CTX);
        u.A = Abase + row0 * D * 2; u.B = Bbase + (size_t)u.pn * BM * D * 2; u.nt = D / 64; u.aux = mode; return true; }
};
struct MergeSched {
    const char* Xbase; const char* Wbase; int nM, G, c;
    __device__ __forceinline__ int arow(int R) const { return R; }
    __device__ __forceinline__ int ahalf() const { return HALF; }
    __device__ __forceinline__ bool next(int i, Unit& u) const { if (!tile_order(i >> 2, nM, 4, G, c, u.pm, u.pn)) return false;
        const int br = i & 3, koff = br == 0 ? 0 : (br == 1 ? 512 : (br == 2 ? 768 : 1280));
        u.A = Xbase + ((size_t)u.pm * BM * 1536 + koff) * 2; u.B = Wbase + ((size_t)u.pn * BM * 1536 + koff) * 2; u.nt = (br & 1) ? 4 : 8; u.aux = br; return true; }
};
template <class E, class = void> struct is_chain { static constexpr bool v = false; };
template <class E> struct is_chain<E, decltype((void)E::CHAIN)> { static constexpr bool v = E::CHAIN; };
typedef f32x4 Acc[2][2][4][2];
typedef int i32x4 __attribute__((ext_vector_type(4))); typedef int i32x8 __attribute__((ext_vector_type(8)));
__device__ __forceinline__ i32x8 ld32(const LAS unsigned char* p) { const i32x4 a = *(const LAS i32x4*)p, b = *(const LAS i32x4*)(p + 16); return __builtin_shufflevector(a, b, 0, 1, 2, 3, 4, 5, 6, 7); }
template <class Epi, class Sched, bool F8 = false>
__device__ __forceinline__ void gemm_phase(LAS unsigned char* lds, int lda, int ldb, const Sched& S, const Epi& E) {
    int tid_ = threadIdx.x; asm volatile("" : "+v"(tid_));
    const int tid = tid_, wid = __builtin_amdgcn_readfirstlane(tid >> 6), lane = tid & 63, wr = wid >> 2, wc = wid & 3, fr = lane & 15, fq = lane >> 4;
    unsigned voffA[2], voffB[2];
#pragma unroll
    for (int i = 0; i < 2; ++i) { int R, C; stage_rc(tid * 16 + i * 8192, R, C); const int Rb = Epi::PERM ? ((R & ~31) + perm32(R & 31)) : R;
        voffA[i] = (unsigned)(S.arow(R) * lda + C) * 2u; voffB[i] = (unsigned)(Rb * ldb + C) * 2u; }
    const size_t kstep = (size_t)(BK * 2);
    const size_t hstepA = (size_t)S.ahalf() * lda * 2, hstepB = (size_t)HALF * ldb * 2;
    const unsigned ldsw = (unsigned)wid * 1024u;
    const int aoff = lds_byte(wr * 64 + fr, F8 ? fq * 16 : fq * 8), boff = lds_byte(wc * 32 + fr, F8 ? fq * 16 : fq * 8);
#define FG_SA(b, h) (((b) * 2 + (h)) * HTB)
#define FG_SB(b, h) ((4 + (b) * 2 + (h)) * HTB)
#define FG_STAGE(bufoff, gbase, voff) do { _Pragma("unroll") for (int _i = 0; _i < 2; ++_i) \
        __builtin_amdgcn_global_load_lds((const unsigned*)((const char*)(gbase) + (voff)[_i]), (LAS unsigned*)(lds + (bufoff) + ldsw + _i * 8192), 16, 0, 0); } while (0)
#define FG_LDA(dst, b, h) do { if constexpr (F8) { _Pragma("unroll") for (int m = 0; m < 4; ++m) dst##8[m] = ld32(lds + FG_SA(b, h) + aoff + m * 2048); } \
        else { _Pragma("unroll") for (int m = 0; m < 4; ++m) _Pragma("unroll") for (int k = 0; k < 2; ++k) dst[m][k] = *(const LAS bf16x8*)(lds + FG_SA(b, h) + aoff + m * 2048 + k * 1024); } } while (0)
#define FG_LDB(dst, b, h) do { if constexpr (F8) { _Pragma("unroll") for (int n = 0; n < 2; ++n) dst##8[n] = ld32(lds + FG_SB(b, h) + boff + n * 2048); } \
        else { _Pragma("unroll") for (int n = 0; n < 2; ++n) _Pragma("unroll") for (int k = 0; k < 2; ++k) dst[n][k] = *(const LAS bf16x8*)(lds + FG_SB(b, h) + boff + n * 2048 + k * 1024); } } while (0)
#define FG_MMA(ai, bj, At, Bt) do { __builtin_amdgcn_s_setprio(1); _Pragma("unroll") for (int m = 0; m < 4; ++m) _Pragma("unroll") for (int n = 0; n < 2; ++n) { \
        if constexpr (F8) asm volatile("v_mfma_scale_f32_16x16x128_f8f6f4 %0, %1, %2, %0, %3, %4 op_sel_hi:[0,0,0]" : "+v"(acc[ai][bj][m][n]) : "v"(Bt##8[n]), "v"(At##8[m]), "v"(scw), "v"(sca)); \
        else { _Pragma("unroll") for (int k = 0; k < 2; ++k) acc[ai][bj][m][n] = __builtin_amdgcn_mfma_f32_16x16x32_bf16(Bt[n][k], At[m][k], acc[ai][bj][m][n], 0, 0, 0); } } \
        __builtin_amdgcn_s_setprio(0); } while (0)
#define FG_WAIT_V(n) asm volatile("s_waitcnt vmcnt(" #n ")" ::: "memory")
#define FG_WAIT_L(n) asm volatile("s_waitcnt lgkmcnt(" #n ")" ::: "memory")
#define FG_BAR __builtin_amdgcn_s_barrier()
#define FG_SCHED __builtin_amdgcn_sched_barrier(0)
    Unit cur, nxt; int ui = 0;
    if (!S.next(0, cur)) return;
    Acc acc;
#pragma unroll
    for (int a = 0; a < 2; ++a)
#pragma unroll
        for (int b = 0; b < 2; ++b)
#pragma unroll
            for (int m = 0; m < 4; ++m)
#pragma unroll
                for (int n = 0; n < 2; ++n) acc[a][b][m][n] = (f32x4){0.f, 0.f, 0.f, 0.f};
    bf16x8 At[4][2], B0[2][2], B1[2][2]; i32x8 At8[4], B08[2], B18[2];
    const int scw = 0x7a7a7a7a, sca = 0x7f7f7f7f;
    const char* cA = cur.A; const char* cB = cur.B;
    FG_STAGE(FG_SB(0, 0), cB, voffB); FG_STAGE(FG_SB(0, 1), cB + hstepB, voffB); FG_STAGE(FG_SA(0, 0), cA, voffA); FG_STAGE(FG_SA(0, 1), cA + hstepA, voffA);
    if (wr == 1) FG_BAR;
    FG_WAIT_V(2); FG_BAR;
    FG_STAGE(FG_SB(1, 0), cB + kstep, voffB); FG_STAGE(FG_SA(1, 0), cA + kstep, voffA); FG_STAGE(FG_SB(1, 1), cB + hstepB + kstep, voffB);
    FG_WAIT_V(6); FG_BAR;
    for (;;) {
        const bool has_next = S.next(ui + 1, nxt);
        const char* nA = has_next ? nxt.A : cA; const char* nB = has_next ? nxt.B : cB;
        const int nt = cur.nt;
#pragma unroll 1
        for (int t = 0; t < nt; t += 2) {
            const bool last = (t == nt - 2);
            const char* a1 = cA + (size_t)(t + 1) * kstep;
            const char* a2 = last ? nA : cA + (size_t)(t + 2) * kstep; const char* b2 = last ? nB : cB + (size_t)(t + 2) * kstep;
            const char* a3 = a2 + kstep; const char* b3 = b2 + kstep;
            FG_LDB(B0, 0, 0); FG_LDB(B1, 0, 1); FG_SCHED; FG_LDA(At, 0, 0); FG_STAGE(FG_SA(1, 1), a1 + hstepA, voffA);
            FG_WAIT_V(8); FG_WAIT_L(0); FG_BAR; FG_MMA(0, 0, At, B0); FG_MMA(0, 1, At, B1); FG_BAR; FG_SCHED;
            FG_LDA(At, 0, 1); FG_STAGE(FG_SB(0, 0), b2, voffB); FG_STAGE(FG_SB(0, 1), b2 + hstepB, voffB); FG_STAGE(FG_SA(0, 0), a2, voffA);
            FG_WAIT_V(8); FG_WAIT_L(0); FG_BAR; FG_MMA(1, 0, At, B0); FG_MMA(1, 1, At, B1); FG_BAR; FG_SCHED;
            FG_LDB(B0, 1, 0); FG_LDB(B1, 1, 1); FG_SCHED; FG_LDA(At, 1, 0); FG_STAGE(FG_SA(0, 1), a2 + hstepA, voffA);
            FG_WAIT_V(8); FG_WAIT_L(0); FG_BAR; FG_MMA(0, 0, At, B0); FG_MMA(0, 1, At, B1); FG_BAR; FG_SCHED;
            FG_LDA(At, 1, 1); FG_STAGE(FG_SB(1, 0), b3, voffB); FG_STAGE(FG_SB(1, 1), b3 + hstepB, voffB); FG_STAGE(FG_SA(1, 0), a3, voffA);
            FG_WAIT_V(8); FG_WAIT_L(0); FG_BAR; FG_MMA(1, 0, At, B0); FG_MMA(1, 1, At, B1); FG_BAR; FG_SCHED;
        }
        if (wr == 0) FG_BAR;
        E(acc, cur, wr, wc, fr, fq);
        if (!has_next) break;
        if (!(is_chain<Epi>::v && cur.aux != 3)) {
#pragma unroll
        for (int a = 0; a < 2; ++a)
#pragma unroll
            for (int b = 0; b < 2; ++b)
#pragma unroll
                for (int m = 0; m < 4; ++m)
#pragma unroll
                    for (int n = 0; n < 2; ++n) acc[a][b][m][n] = (f32x4){0.f, 0.f, 0.f, 0.f};
        }
        cur = nxt; cA = nA; cB = nB; ++ui;
        if (wr == 1) FG_BAR;
    }
    FG_WAIT_V(0);
    FG_BAR;
#undef FG_SA
#undef FG_SB
#undef FG_STAGE
#undef FG_LDA
#undef FG_LDB
#undef FG_MMA
#undef FG_WAIT_V
#undef FG_WAIT_L
#undef FG_BAR
#undef FG_SCHED
}
__device__ __forceinline__ unsigned cvt_pk(float lo, float hi) { unsigned r; asm volatile("v_cvt_pk_bf16_f32 %0, %1, %2" : "=v"(r) : "v"(lo), "v"(hi)); return r; }
__device__ __forceinline__ u32x4 pack8(const f32x4 a, const f32x4 b) { u32x4 w; w.x = cvt_pk(a[0], a[1]); w.y = cvt_pk(a[2], a[3]); w.z = cvt_pk(b[0], b[1]); w.w = cvt_pk(b[2], b[3]); return w; }
__device__ __forceinline__ f32x4 unpk_u8(unsigned x) { const float k = 1.f / 255.f; return (f32x4){(float)(x & 0xffu) * k, (float)((x >> 8) & 0xffu) * k, (float)((x >> 16) & 0xffu) * k, (float)(x >> 24) * k}; }
__device__ __forceinline__ f32x4 unpk_u8r(unsigned x) { return (f32x4){(float)(x & 0xffu), (float)((x >> 8) & 0xffu), (float)((x >> 16) & 0xffu), (float)(x >> 24)}; }
__device__ __forceinline__ f32x4 unpk_lo(unsigned x, unsigned y) { return (f32x4){__uint_as_float(x << 16), __uint_as_float(x & 0xffff0000u), __uint_as_float(y << 16), __uint_as_float(y & 0xffff0000u)}; }

struct EpiWin {
    static constexpr bool PERM = true;
    unsigned char* ws; const float* qg; const float* kg;
    __device__ __forceinline__ void operator()(const Acc& acc, const Unit& u, int wr, int wc, int fr_, int fq_) const {
        int fr = fr_, fq = fq_; asm volatile("" : "+v"(fr), "+v"(fq));
        const int tile = u.pn; const bool LAT = u.aux == 0;
        if (tile == 0) {
            if (LAT) {
                const int b = u.pm >> 5, n2 = 2 * (u.pm & 31) + wr;
#pragma unroll
                for (int ai = 0; ai < 2; ++ai)
#pragma unroll
                    for (int bj = 0; bj < 2; ++bj) {
#pragma unroll
                        for (int n = 0; n < 2; ++n)
#pragma unroll
                            for (int e = 0; e < 4; ++e) { const int ch = bj * HALF + wc * 32 + 8 * fq + 4 * n + e;
                                u32x2 o; o.x = cvt_pk(acc[ai][bj][0][n][e], acc[ai][bj][1][n][e]); o.y = cvt_pk(acc[ai][bj][2][n][e], acc[ai][bj][3][n][e]);
                                *(u32x2*)((bf16*)(ws + WS_UT) + ((size_t)(b * 256 + ch) * 64 + n2) * 256 + 64 * ai + 4 * fr) = o; }
                        asm volatile("" ::: "memory"); }
            } else {
#pragma unroll
                for (int ai = 0; ai < 2; ++ai)
#pragma unroll
                    for (int m = 0; m < 4; ++m) { const int sx = ai * HALF + wr * 64 + m * 16 + fr;
#pragma unroll
                        for (int bj = 0; bj < 2; ++bj)
#pragma unroll
                            for (int n = 0; n < 2; ++n)
#pragma unroll
                                for (int e = 0; e < 4; ++e) { const int ch = bj * HALF + wc * 32 + 8 * fq + 4 * n + e;
                                    ((bf16*)(ws + WS_UTC))[(size_t)(u.pm * 256 + ch) * 256 + sx] = f2bf(acc[ai][bj][m][n][e]); }
                        asm volatile("" ::: "memory"); }
            }
            return;
        }
        const bool ropek = tile == 1 || tile == 2 || tile == 5 || tile == 6 || (tile == 7 && wc < 2);
        const bool keyrow = tile == 7;
        size_t boff; int pitch, col0;
        if (tile <= 4) { boff = WS_RETQ + (size_t)(tile - 1) * MROWS * 256 * 2; pitch = 256; col0 = ropek ? wc * 64 : wc * 32; }
        else if (tile <= 6) { boff = WS_ATTQ; pitch = 512; col0 = (tile - 5) * 256 + wc * 64; }
        else if (tile == 7) { boff = wc < 2 ? WS_ATTK : WS_ATTV; pitch = 128; col0 = (wc & 1) * 64; }
        else if (tile < 10) { boff = WS_CONV; pitch = 512; col0 = (tile - 8) * 256 + wc * 32; }
        else { boff = WS_G; pitch = 4096; col0 = (tile - 10) * 256 + wc * 32; }
        const bool head = ropek || tile == 7;
        bf16* const dbase = (bf16*)(ws + boff);
        const bool norm = tile >= 5 && ropek;
        const float* gp = tile == 7 ? kg : qg;
        const float osc = tile == 2 ? 0.125f : (tile == 5 || tile == 6 ? QSCALE : 1.f);
        const float* rc = (const float*)(ws + WS_ROPE);
#pragma unroll
        for (int ai = 0; ai < 2; ++ai) {
            f32x4 rcs[4][2], rsn[4][2];
            if (ropek && LAT) {
#pragma unroll
                for (int m = 0; m < 4; ++m)
#pragma unroll
                    for (int bj = 0; bj < 2; ++bj) { const int sx = 4096 * ai + 256 * fr + 64 * m + 2 * (u.pm & 31) + wr, i0 = 16 * bj + 4 * fq;
                        rcs[m][bj] = *(const f32x4*)(rc + sx * 32 + i0); rsn[m][bj] = *(const f32x4*)(rc + SEQ * 32 + sx * 32 + i0); } }
#pragma unroll
            for (int m = 0; m < 4; ++m) {
                const int b = LAT ? (u.pm >> 5) : u.pm, s = LAT ? (4096 * ai + 256 * fr + 64 * m + 2 * (u.pm & 31) + wr) : (ai * HALF + wr * 64 + m * 16 + fr);
                const int rr = keyrow ? b * KEYS + (LAT ? CTX + s : s) : (LAT ? b * SEQ + s : NLAT + b * CTX + s);
                bf16* const drow = dbase + ((size_t)rr * pitch + col0 + 8 * fq);
                if (ropek) {
                    float rstd = 1.f;
                    if (norm) { float ss = 0.f;
#pragma unroll
                        for (int bj = 0; bj < 2; ++bj)
#pragma unroll
                            for (int n = 0; n < 2; ++n) { const f32x4 x = acc[ai][bj][m][n]; ss += (x[0] * x[0] + x[1] * x[1]) + (x[2] * x[2] + x[3] * x[3]); }
                        ss += __shfl_xor(ss, 16); ss += __shfl_xor(ss, 32);
                        rstd = rsqrtf(ss * (1.f / 64.f) + EPS); }
#pragma unroll
                    for (int bj = 0; bj < 2; ++bj) {
                        const int i0 = 16 * bj + 4 * fq;
                        f32x4 x1 = acc[ai][bj][m][0], x2 = acc[ai][bj][m][1];
                        if (norm) { const f32x4 g1 = *(const f32x4*)(gp + i0), g2 = *(const f32x4*)(gp + 32 + i0); x1 = x1 * rstd * g1; x2 = x2 * rstd * g2; }
                        f32x4 o1 = x1, o2 = x2;
                        if (LAT) { const f32x4 cs = rcs[m][bj], sn = rsn[m][bj]; o1 = x1 * cs - x2 * sn; o2 = x1 * sn + x2 * cs; }
                        *(u32x4*)(drow + 32 * bj) = pack8(o1 * osc, o2 * osc);
                    }
                } else {
#pragma unroll
                    for (int bj = 0; bj < 2; ++bj) {
                        f32x4 a0 = acc[ai][bj][m][0], a1 = acc[ai][bj][m][1];
                        if (tile >= 10) {
                            u32x2 o; o.x = 0u; o.y = 0u;
#pragma unroll
                            for (int e = 0; e < 4; ++e) { o.x = __builtin_amdgcn_cvt_pk_u8_f32(__builtin_fmaxf(__builtin_floorf(sigmoid_fast(a0[e]) * 255.f + 0.5f), 1.f), e, o.x);
                                o.y = __builtin_amdgcn_cvt_pk_u8_f32(__builtin_fmaxf(__builtin_floorf(sigmoid_fast(a1[e]) * 255.f + 0.5f), 1.f), e, o.y); }
                            *(u32x2*)(ws + WS_G + (size_t)rr * 4096 + (tile - 10) * 256 + wc * 32 + 8 * fq + HALF * bj) = o;
                        } else *(u32x4*)(drow + (head ? 32 : HALF) * bj) = pack8(a0, a1);
                    }
                }
            }
        }
    }
};
struct EpiGate8 {
    static constexpr bool PERM = true;
    unsigned char* G;
    __device__ __forceinline__ void operator()(const Acc& acc, const Unit& u, int wr, int wc, int fr_, int fq_) const {
        int fr = fr_, fq = fq_; asm volatile("" : "+v"(fr), "+v"(fq));
#pragma unroll
        for (int ai = 0; ai < 2; ++ai)
#pragma unroll
            for (int m = 0; m < 4; ++m) { const int r = u.pm * BM + ai * HALF + wr * 64 + m * 16 + fr;
#pragma unroll
                for (int bj = 0; bj < 2; ++bj) { const f32x4 a0 = acc[ai][bj][m][0], a1 = acc[ai][bj][m][1]; u32x2 o; o.x = 0u; o.y = 0u;
#pragma unroll
                    for (int e = 0; e < 4; ++e) { o.x = __builtin_amdgcn_cvt_pk_u8_f32(__builtin_fmaxf(__builtin_floorf(sigmoid_fast(a0[e]) * 255.f + 0.5f), 1.f), e, o.x);
                        o.y = __builtin_amdgcn_cvt_pk_u8_f32(__builtin_fmaxf(__builtin_floorf(sigmoid_fast(a1[e]) * 255.f + 0.5f), 1.f), e, o.y); }
                    *(u32x2*)(G + (size_t)r * 4096 + u.pn * BM + bj * HALF + wc * 32 + 8 * fq) = o; } }
    }
};
struct EpiMerge {
    static constexpr bool PERM = true, CHAIN = true;
    const unsigned char* G; bf16* Mg;
    __device__ __forceinline__ void operator()(Acc& acc, const Unit& u, int wr, int wc, int fr_, int fq_) const {
        int fr = fr_, fq = fq_; asm volatile("" : "+v"(fr), "+v"(fq));
        const int br = u.aux; const bool lastb = br == 3;
#pragma unroll
        for (int ai = 0; ai < 2; ++ai) {
            u32x2 g[4][2], gn[4][2];
#pragma unroll
            for (int m = 0; m < 4; ++m)
#pragma unroll
                for (int bj = 0; bj < 2; ++bj) { const int r = u.pm * BM + ai * HALF + wr * 64 + m * 16 + fr, c = u.pn * BM + bj * HALF + wc * 32 + 8 * fq;
                    g[m][bj] = *(const u32x2*)(G + (size_t)r * 4096 + br * 1024 + c);
                    if (!lastb) gn[m][bj] = *(const u32x2*)(G + (size_t)r * 4096 + (br + 1) * 1024 + c); }
#pragma unroll
            for (int m = 0; m < 4; ++m)
#pragma unroll
                for (int bj = 0; bj < 2; ++bj) {
                    if (!lastb) {
                        const f32x4 n0 = unpk_u8r(g[m][bj].x), n1 = unpk_u8r(g[m][bj].y), d0 = unpk_u8r(gn[m][bj].x), d1 = unpk_u8r(gn[m][bj].y);
#pragma unroll
                        for (int e = 0; e < 4; ++e) { acc[ai][bj][m][0][e] *= n0[e] * __builtin_amdgcn_rcpf(d0[e]); acc[ai][bj][m][1][e] *= n1[e] * __builtin_amdgcn_rcpf(d1[e]); }
                    } else { const int r = u.pm * BM + ai * HALF + wr * 64 + m * 16 + fr, c = u.pn * BM + bj * HALF + wc * 32 + 8 * fq;
                        *(u32x4*)(Mg + (size_t)r * 1024 + c) = pack8(acc[ai][bj][m][0] * unpk_u8(g[m][bj].x), acc[ai][bj][m][1] * unpk_u8(g[m][bj].y)); } }
        }
    }
};
struct EpiResid {
    static constexpr bool PERM = false;
    float* out; float* hctx; const float* modbase; int chunk;
    __device__ __forceinline__ void operator()(const Acc& acc, const Unit& u, int wr, int wc, int fr_, int fq_) const {
        int fr = fr_, fq = fq_; asm volatile("" : "+v"(fr), "+v"(fq));
        const int rt = u.pm * BM;
        const float* g = modbase + ((size_t)row_mi(rt) * 6 + chunk) * D;
        f32x4 gg[2][2];
#pragma unroll
        for (int bj = 0; bj < 2; ++bj)
#pragma unroll
            for (int n = 0; n < 2; ++n) gg[bj][n] = *(const f32x4*)(g + u.pn * BM + bj * HALF + wc * 32 + 16 * n + 4 * fq);
#pragma unroll
        for (int ai = 0; ai < 2; ++ai) {
            f32x4 hv[4][2][2];
#pragma unroll
            for (int m = 0; m < 4; ++m) { const int r = rt + ai * HALF + wr * 64 + m * 16 + fr; const float* h = r < NLAT ? out + (size_t)r * D : hctx + (size_t)(r - NLAT) * D;
#pragma unroll
                for (int bj = 0; bj < 2; ++bj)
#pragma unroll
                    for (int n = 0; n < 2; ++n) hv[m][bj][n] = *(const f32x4*)(h + u.pn * BM + bj * HALF + wc * 32 + 16 * n + 4 * fq); }
#pragma unroll
            for (int m = 0; m < 4; ++m) { const int r = rt + ai * HALF + wr * 64 + m * 16 + fr; float* h = r < NLAT ? out + (size_t)r * D : hctx + (size_t)(r - NLAT) * D;
#pragma unroll
                for (int bj = 0; bj < 2; ++bj)
#pragma unroll
                    for (int n = 0; n < 2; ++n) *(f32x4*)(h + u.pn * BM + bj * HALF + wc * 32 + 16 * n + 4 * fq) = hv[m][bj][n] + gg[bj][n] * acc[ai][bj][m][n]; }
        }
    }
};
struct EpiResidNorm {
    static constexpr bool PERM = false;
    const float* hin; float* out; const float* modbase; int chunk;
    const float* gain; const float* nmods; int csh, csc; bf16* A; unsigned char* A8;
    float* xbuf; unsigned* cnt; unsigned* tmo; LAS unsigned char* lds;
    __device__ __forceinline__ void operator()(Acc& acc, const Unit& u, int wr, int wc, int fr_, int fq_) const {
        int fr = fr_, fq = fq_; asm volatile("" : "+v"(fr), "+v"(fq));
        const int wid = __builtin_amdgcn_readfirstlane((int)threadIdx.x >> 6), lane = threadIdx.x & 63;
        const int rt = u.pm * BM, mi = row_mi(rt);
        LAS float* Pt = (LAS float*)(lds + STAGE_BYTES);
        LAS float* St = (LAS float*)(lds + STAGE_BYTES + 4096);
        LAS unsigned* flag = (LAS unsigned*)(lds + STAGE_BYTES + 5120);
        { const float* g = modbase + ((size_t)mi * 6 + chunk) * D;
          f32x4 gg[2][2];
#pragma unroll
          for (int bj = 0; bj < 2; ++bj)
#pragma unroll
              for (int n = 0; n < 2; ++n) gg[bj][n] = *(const f32x4*)(g + u.pn * BM + bj * HALF + wc * 32 + 16 * n + 4 * fq);
#pragma unroll
          for (int am = 0; am < 4; ++am) { const int ai = am >> 1, m0 = (am & 1) * 2;
              f32x4 hv[2][2][2];
#pragma unroll
              for (int mm = 0; mm < 2; ++mm) { const float* h = hin + (size_t)(rt + ai * HALF + wr * 64 + (m0 + mm) * 16 + fr) * D;
#pragma unroll
                  for (int bj = 0; bj < 2; ++bj)
#pragma unroll
                      for (int n = 0; n < 2; ++n) hv[mm][bj][n] = *(const f32x4*)(h + u.pn * BM + bj * HALF + wc * 32 + 16 * n + 4 * fq); }
#pragma unroll
              for (int mm = 0; mm < 2; ++mm) { const int m = m0 + mm; float* h = out + (size_t)(rt + ai * HALF + wr * 64 + m * 16 + fr) * D; float ss = 0.f;
#pragma unroll
                  for (int bj = 0; bj < 2; ++bj)
#pragma unroll
                      for (int n = 0; n < 2; ++n) { const f32x4 x = hv[mm][bj][n] + gg[bj][n] * acc[ai][bj][m][n]; acc[ai][bj][m][n] = x;
                          *(f32x4*)(h + u.pn * BM + bj * HALF + wc * 32 + 16 * n + 4 * fq) = x; ss += (x[0] * x[0] + x[1] * x[1]) + (x[2] * x[2] + x[3] * x[3]); }
                  ss += __shfl_xor(ss, 16); ss += __shfl_xor(ss, 32);
                  if (fq == 0) Pt[(ai * HALF + wr * 64 + m * 16 + fr) * 4 + wc] = ss; }
              asm volatile("" ::: "memory");
          } }
        asm volatile("s_waitcnt lgkmcnt(0)" ::: "memory"); __builtin_amdgcn_s_barrier(); asm volatile("" ::: "memory");
        const int row = wid * 32 + (lane & 31);
        if (lane < 32) { const f32x4 q = *(const LAS f32x4*)(Pt + row * 4);
            __hip_atomic_store(xbuf + ((size_t)(rt + row) * 4 + u.pn), (q[0] + q[1]) + (q[2] + q[3]), __ATOMIC_RELAXED, __HIP_MEMORY_SCOPE_AGENT); }
        asm volatile("s_waitcnt vmcnt(0)" ::: "memory");
        if (lane == 0) __hip_atomic_fetch_add(cnt + 16 * u.pm, 1u, __ATOMIC_RELAXED, __HIP_MEMORY_SCOPE_AGENT);
        if (wid == 0) { unsigned sp = 0u, dead = 0u;
            while ((unsigned)__builtin_amdgcn_readfirstlane(__hip_atomic_load(cnt + 16 * u.pm, __ATOMIC_RELAXED, __HIP_MEMORY_SCOPE_AGENT)) < 32u) {
                __builtin_amdgcn_s_sleep(1);
                if ((++sp & 255u) == 0u) { if (__hip_atomic_load(tmo, __ATOMIC_RELAXED, __HIP_MEMORY_SCOPE_AGENT)) { dead = 1u; break; } if (sp > (1u << 22)) { if (lane == 0) atomicAdd(tmo, 1u); dead = 1u; break; } } }
            __builtin_amdgcn_fence(__ATOMIC_ACQUIRE, "agent");
            if (lane == 0) flag[0] = dead; }
        asm volatile("s_waitcnt vmcnt(0) lgkmcnt(0)" ::: "memory"); __builtin_amdgcn_s_barrier(); asm volatile("" ::: "memory");
        if (lane < 32) { const float* sl = xbuf + (size_t)(rt + row) * 4; float t = 0.f;
#pragma unroll
            for (int q = 0; q < 4; ++q) t += __hip_atomic_load(sl + q, __ATOMIC_RELAXED, __HIP_MEMORY_SCOPE_AGENT);
            St[row] = rsqrtf(t * (1.f / D) + EPS); }
        asm volatile("s_waitcnt lgkmcnt(0)" ::: "memory"); __builtin_amdgcn_s_barrier(); asm volatile("" ::: "memory");
        const float* shp = nmods + ((size_t)mi * 6 + csh) * D; const float* scp = nmods + ((size_t)mi * 6 + csc) * D;
        float rs[2][4];
#pragma unroll
        for (int ai = 0; ai < 2; ++ai)
#pragma unroll
            for (int m = 0; m < 4; ++m) rs[ai][m] = St[ai * HALF + wr * 64 + m * 16 + fr];
#pragma unroll
        for (int bj = 0; bj < 2; ++bj)
#pragma unroll
            for (int n = 0; n < 2; ++n) { const int c = u.pn * BM + bj * HALF + wc * 32 + 16 * n + 4 * fq;
                const f32x4 g4 = *(const f32x4*)(gain + c), sc4 = *(const f32x4*)(scp + c) + 1.f, sh4 = *(const f32x4*)(shp + c);
#pragma unroll
                for (int ai = 0; ai < 2; ++ai)
#pragma unroll
                    for (int m = 0; m < 4; ++m) { const f32x4 y = acc[ai][bj][m][n] * rs[ai][m] * g4 * sc4 + sh4;
                        u32x2 o; o.x = cvt_pk(y[0], y[1]); o.y = cvt_pk(y[2], y[3]);
                        *(u32x2*)(A + (size_t)(rt + ai * HALF + wr * 64 + m * 16 + fr) * D + c) = o;
                        if (A8) *(unsigned*)(A8 + (size_t)(rt + ai * HALF + wr * 64 + m * 16 + fr) * D + c) = pk4_fp8(y[0], y[1], y[2], y[3]); } }
    }
};
struct EpiSwiglu {
    static constexpr bool PERM = true;
    bf16* Hm;
    __device__ __forceinline__ void operator()(const Acc& acc, const Unit& u, int wr, int wc, int fr, int fq) const {
#pragma unroll
        for (int ai = 0; ai < 2; ++ai)
#pragma unroll
            for (int m = 0; m < 4; ++m) { const int r = u.pm * BM + ai * HALF + wr * 64 + m * 16 + fr;
#pragma unroll
                for (int bj = 0; bj < 2; ++bj) { const int c = u.pn * BM + bj * HALF + wc * 32 + 8 * fq; const f32x4 g = acc[ai][bj][m][0], up = acc[ai][bj][m][1];
                    u32x2 o; o.x = cvt_pk(silu_fast(g[0]) * up[0], silu_fast(g[1]) * up[1]); o.y = cvt_pk(silu_fast(g[2]) * up[2], silu_fast(g[3]) * up[3]);
                    *(u32x2*)(Hm + (size_t)r * FFN + (c >> 1)) = o; } }
    }
};
struct EpiSwiglu8 {
    static constexpr bool PERM = true;
    unsigned char* Hm;
    __device__ __forceinline__ void operator()(const Acc& acc, const Unit& u, int wr, int wc, int fr_, int fq_) const {
        int fr = fr_, fq = fq_; asm volatile("" : "+v"(fr), "+v"(fq));
#pragma unroll
        for (int ai = 0; ai < 2; ++ai)
#pragma unroll
            for (int m = 0; m < 4; ++m) { const int r = u.pm * BM + ai * HALF + wr * 64 + m * 16 + fr;
#pragma unroll
                for (int bj = 0; bj < 2; ++bj) { const int c = u.pn * BM + bj * HALF + wc * 32 + 8 * fq; const f32x4 g = acc[ai][bj][m][0], up = acc[ai][bj][m][1];
                    *(unsigned*)(Hm + (size_t)r * FFN + (c >> 1)) = pk4_fp8(silu_fast(g[0]) * up[0], silu_fast(g[1]) * up[1], silu_fast(g[2]) * up[2], silu_fast(g[3]) * up[3]); } }
    }
};
struct EpiStore {
    static constexpr bool PERM = true;
    bf16* O; int ldc;
    __device__ __forceinline__ void operator()(const Acc& acc, const Unit& u, int wr, int wc, int fr_, int fq_) const {
        int fr = fr_, fq = fq_; asm volatile("" : "+v"(fr), "+v"(fq));
#pragma unroll
        for (int ai = 0; ai < 2; ++ai)
#pragma unroll
            for (int m = 0; m < 4; ++m) { const int r = u.pm * BM + ai * HALF + wr * 64 + m * 16 + fr;
#pragma unroll
                for (int bj = 0; bj < 2; ++bj) { const int c = u.pn * BM + bj * HALF + wc * 32 + 8 * fq; *(u32x4*)(O + (size_t)r * ldc + c) = pack8(acc[ai][bj][m][0], acc[ai][bj][m][1]); } }
    }
};
struct EpiFft1 {
    static constexpr bool PERM = true;
    unsigned char* ws;
    __device__ __forceinline__ void operator()(const Acc& acc, const Unit& u, int wr, int wc, int fr, int fq) const {
        const float* TW = (const float*)(ws + WS_TW); bf16* Z = (bf16*)(ws + WS_Z);
#pragma unroll
        for (int ai = 0; ai < 2; ++ai)
#pragma unroll
            for (int mm = 0; mm < 2; ++mm) { const int k1 = (4 * ai + 2 * wr + mm) * 16 + fr;
#pragma unroll
                for (int bj = 0; bj < 2; ++bj) { const int c = u.pn * BM + bj * HALF + wc * 32 + 8 * fq, n2 = c & 63, ch = (c >> 6) & 255, b = c >> 14;
                    f32x4 zr[2], zi[2];
#pragma unroll
                    for (int n = 0; n < 2; ++n) { const f32x4 yr = acc[ai][bj][2 * mm][n], yi = acc[ai][bj][2 * mm + 1][n];
                        const f32x4 t0 = *(const f32x4*)(TW + (size_t)(k1 * 64 + n2 + 4 * n) * 2), t1 = *(const f32x4*)(TW + (size_t)(k1 * 64 + n2 + 4 * n) * 2 + 4);
                        const f32x4 ct = {t0[0], t0[2], t1[0], t1[2]}, st = {t0[1], t0[3], t1[1], t1[3]};
                        zr[n] = yr * ct + yi * st; zi[n] = yi * ct - yr * st; }
                    bf16* dst = Z + ((size_t)b * 32768 + k1 * 256 + ch) * 256 + n2;
                    *(u32x4*)dst = pack8(zr[0], zr[1]); *(u32x4*)(dst + 64) = pack8(zi[0], zi[1]);
                    asm volatile("" ::: "memory"); } }
    }
};
struct EpiFft3 {
    static constexpr bool PERM = true;
    unsigned char* ws;
    __device__ __forceinline__ void operator()(const Acc& acc, const Unit& u, int wr, int wc, int fr, int fq) const {
        bf16* X = (bf16*)(ws + WS_X);
#pragma unroll
        for (int m = 0; m < 4; ++m) { const int k2 = 16 * m + fr;
#pragma unroll
            for (int bj = 0; bj < 2; ++bj) { const int c = u.pn * BM + bj * HALF + wc * 32 + 8 * fq, ch = c & 255, k1 = (c >> 8) & 127, b = c >> 15;
                *(u32x4*)(X + (size_t)(b * SEQ + k1 + 128 * k2) * 1536 + wr * 256 + ch) = pack8(acc[0][bj][m][0], acc[0][bj][m][1]); } }
    }
};
struct EpiFftC {
    static constexpr bool PERM = true;
    unsigned char* ws;
    __device__ __forceinline__ void operator()(const Acc& acc, const Unit& u, int wr, int wc, int fr, int fq) const {
        bf16* X = (bf16*)(ws + WS_X);
#pragma unroll
        for (int ai = 0; ai < 2; ++ai)
#pragma unroll
            for (int m = 0; m < 4; ++m) { const int k = ai * HALF + wr * 64 + m * 16 + fr;
#pragma unroll
                for (int bj = 0; bj < 2; ++bj) { const int ch = bj * HALF + wc * 32 + 8 * fq;
                    *(u32x4*)(X + (size_t)(NLAT + u.pn * CTX + k) * 1536 + u.pm * 256 + ch) = pack8(acc[ai][bj][m][0], acc[ai][bj][m][1]); } }
    }
};
}

__device__ __forceinline__ void ph_win(const P& p, LAS unsigned char* lds, int layer) {
    const char* W = (const char*)(p.ws + WS_WIN) + (size_t)layer * INC * D * 2;
#pragma unroll 1
    for (int mode = 0; mode < 2; ++mode) {
        fg::WinSched S{(const char*)(p.ws + WS_A), W, (int)gridDim.x, (int)((blockIdx.x + mode * 128) % gridDim.x), mode, mode == 0 ? 10 : (layer == 0 ? 26 : 10)};
        fg::EpiWin E{p.ws, p.in[14] + layer * 64, p.in[15] + layer * 64};
        fg::gemm_phase(lds, D, D, S, E);
    }
    {
        fg::PlainSched S{(const char*)(p.ws + WS_A8), (const char*)(p.ws + WS_WIN8) + (size_t)layer * 4096 * 1024, D / 2, D / 2, NLAT / 256, 16, (int)gridDim.x, (int)blockIdx.x, D / 128};
        fg::EpiGate8 E{p.ws + WS_G};
        fg::gemm_phase<fg::EpiGate8, fg::PlainSched, true>(lds, D / 2, D / 2, S, E);
    }
}

__device__ __forceinline__ void conv_item(const P& p, LAS unsigned char* lds, int layer, int seqid, int t0) {
    const int tid = threadIdx.x; LAS float* y = (LAS float*)lds;
    const int L = seqid < 2 ? SEQ : CTX; const int rbase = seqid < 2 ? seqid * SEQ : NLAT + (seqid - 2) * CTX;
    const bf16* cv = (const bf16*)(p.ws + WS_CONV);
    __syncthreads();
    u32x4 pa[6], pg[6];
#pragma unroll
    for (int i = 0; i < 6; ++i) { const int e = tid + i * NTHREADS, tt = e >> 5, c8 = (e & 31) * 8, t = t0 - 15 + tt;
        if (e < 94 * 32 && t >= 0 && t < L) { const bf16* rowp = cv + (size_t)(rbase + t) * 512 + c8; pa[i] = *(const u32x4*)rowp; pg[i] = *(const u32x4*)(rowp + 256); } }
#pragma unroll
    for (int i = 0; i < 6; ++i) { const int e = tid + i * NTHREADS; if (e >= 94 * 32) break; const int tt = e >> 5, c8 = (e & 31) * 8, t = t0 - 15 + tt;
        f32x4 lo = {0.f, 0.f, 0.f, 0.f}, hi = lo;
        if (t >= 0 && t < L) { const u32x4 a = pa[i], g = pg[i];
            lo = (f32x4){__uint_as_float(a.x << 16) * sigmoidf_(__uint_as_float(g.x << 16)), __uint_as_float(a.x & 0xffff0000u) * sigmoidf_(__uint_as_float(g.x & 0xffff0000u)),
                         __uint_as_float(a.y << 16) * sigmoidf_(__uint_as_float(g.y << 16)), __uint_as_float(a.y & 0xffff0000u) * sigmoidf_(__uint_as_float(g.y & 0xffff0000u))};
            hi = (f32x4){__uint_as_float(a.z << 16) * sigmoidf_(__uint_as_float(g.z << 16)), __uint_as_float(a.z & 0xffff0000u) * sigmoidf_(__uint_as_float(g.z & 0xffff0000u)),
                         __uint_as_float(a.w << 16) * sigmoidf_(__uint_as_float(g.w << 16)), __uint_as_float(a.w & 0xffff0000u) * sigmoidf_(__uint_as_float(g.w & 0xffff0000u))}; }
        *(LAS f32x4*)(y + tt * 256 + c8) = lo; *(LAS f32x4*)(y + tt * 256 + c8 + 4) = hi; }
    __syncthreads();
    {
        const int ch = tid & 255, half = tid >> 8;
        float w[31];
#pragma unroll
        for (int k = 0; k < 31; ++k) w[k] = p.in[17][(size_t)layer * 31 * 256 + k * 256 + ch];
        const float bias = p.in[18][layer * 256 + ch];
        float o[4][8];
#pragma unroll
        for (int u = 0; u < 4; ++u) { const int tb = (half * 4 + u) * 8;
            float in[38];
#pragma unroll
            for (int q = 0; q < 38; ++q) in[q] = y[(tb + q) * 256 + ch];
#pragma unroll
            for (int q = 0; q < 8; ++q) { float a = bias;
#pragma unroll
                for (int k = 0; k < 31; ++k) a += in[q + k] * w[k];
                o[u][q] = a; } }
        __syncthreads();
#pragma unroll
        for (int u = 0; u < 4; ++u)
#pragma unroll
            for (int q = 0; q < 8; ++q) y[((half * 4 + u) * 8 + q) * 256 + ch] = o[u][q];
    }
    __syncthreads();
    const int wv = tid >> 6, lane = tid & 63;
    const f32x4 g = *(const f32x4*)(p.in[19] + layer * 256 + lane * 4), bb = *(const f32x4*)(p.in[20] + layer * 256 + lane * 4);
    for (int q = 0; q < 8; ++q) { const int t = wv * 8 + q;
        const f32x4 v = *(const LAS f32x4*)(y + t * 256 + lane * 4);
        const float mu = wave_sum(v.x + v.y + v.z + v.w) * (1.f / 256.f);
        const f32x4 dv = v - mu; const float var = wave_sum(dv.x * dv.x + dv.y * dv.y + dv.z * dv.z + dv.w * dv.w) * (1.f / 256.f);
        const float rstd = rsqrtf(var + EPS);
        f32x4 z = dv * rstd * g + bb;
        u32x2 ov; ov.x = pk2(siluf_(z.x), siluf_(z.y)); ov.y = pk2(siluf_(z.z), siluf_(z.w));
        *(u32x2*)((bf16*)(p.ws + WS_X) + (size_t)(rbase + t0 + t) * 1536 + 1280 + lane * 4) = ov; }
}

__device__ __forceinline__ int chunk_row0(int b, int n) { return n < 2 ? NLAT + b * CTX + n * 128 : b * SEQ + (n - 2) * 128; }
__device__ __forceinline__ float log_sigmoid(float x) { return x >= 0.f ? -log1pf(expf(-x)) : x - log1pf(expf(x)); }
namespace rt {
typedef short bf16x8 __attribute__((ext_vector_type(8)));
constexpr int PQ = 72, PJ = 136;
__device__ __forceinline__ f32x4 mma(bf16x8 a, bf16x8 b, f32x4 c) { return __builtin_amdgcn_mfma_f32_16x16x32_bf16(a, b, c, 0, 0, 0); }
__device__ __forceinline__ bf16x8 frag(const LAS bf16* base, int row, int pitch, int k0, int lane) { return *(const LAS bf16x8*)(base + (row + (lane & 15)) * pitch + k0 + 8 * (lane >> 4)); }
}
__device__ __forceinline__ void ret_kv_item(const P& p, LAS unsigned char* lds, int layer, int it) {
    using namespace rt;
    const int tid = threadIdx.x, lane = tid & 63, w = tid >> 6; const int h = it & 3, n = (it >> 2) % NCHUNK, b = (it >> 2) / NCHUNK;
    LAS bf16* KTf = (LAS bf16*)lds; LAS bf16* KTb = KTf + 64 * PJ; LAS bf16* VT = KTb + 64 * PJ;
    const int r0 = chunk_row0(b, n);
    const float lgf = log_sigmoid(p.in[10][layer * 4 + h]), lgb = log_sigmoid(p.in[11][layer * 4 + h]);
    __syncthreads();
    { const int j = tid & 127, dq = (tid >> 7) * 16;
      const bf16* K = (const bf16*)(p.ws + WS_RETK) + (size_t)(r0 + j) * 256 + h * 64 + dq; const bf16* V = (const bf16*)(p.ws + WS_RETV) + (size_t)(r0 + j) * 256 + h * 64 + dq;
      const float zf = expf((127.f - j) * lgf), zb = expf((float)j * lgb);
#pragma unroll
      for (int q8 = 0; q8 < 2; ++q8) { const u32x4 kw = *(const u32x4*)(K + q8 * 8), vw = *(const u32x4*)(V + q8 * 8);
          const unsigned kk[4] = {kw.x, kw.y, kw.z, kw.w}, vv[4] = {vw.x, vw.y, vw.z, vw.w};
#pragma unroll
          for (int q = 0; q < 4; ++q) { const int d = dq + q8 * 8 + 2 * q; const float k0 = __uint_as_float(kk[q] << 16), k1 = __uint_as_float(kk[q] & 0xffff0000u);
              KTf[d * PJ + j] = f2bf(k0 * zf); KTf[(d + 1) * PJ + j] = f2bf(k1 * zf); KTb[d * PJ + j] = f2bf(k0 * zb); KTb[(d + 1) * PJ + j] = f2bf(k1 * zb);
              VT[d * PJ + j] = (bf16)(vv[q] & 0xffffu); VT[(d + 1) * PJ + j] = (bf16)(vv[q] >> 16); } } }
    __syncthreads();
    const int fb = w >> 2, dt = w & 3; const LAS bf16* Am = fb == 0 ? KTf : KTb;
    f32x4 acc[4];
#pragma unroll
    for (int et = 0; et < 4; ++et) acc[et] = (f32x4){0.f, 0.f, 0.f, 0.f};
#pragma unroll
    for (int ks = 0; ks < 4; ++ks) { const bf16x8 af = frag(Am, dt * 16, PJ, ks * 32, lane);
#pragma unroll
        for (int et = 0; et < 4; ++et) acc[et] = mma(af, frag(VT, et * 16, PJ, ks * 32, lane), acc[et]); }
    float* S = (float*)(p.ws + WS_RETS) + ((size_t)((fb * 2 + b) * NCHUNK + n) * 4 + h) * 4096;
#pragma unroll
    for (int et = 0; et < 4; ++et)
#pragma unroll
        for (int r = 0; r < 4; ++r) S[(dt * 16 + 4 * (lane >> 4) + r) * 64 + et * 16 + (lane & 15)] = acc[et][r];
}
__device__ __forceinline__ void ret_scan_item(const P& p, int layer, int it) {
    const int e = it * NTHREADS + threadIdx.x;
    const int de = e & 4095, h = (e >> 12) & 3, b = (e >> 14) & 1, dir = e >> 15;
    const float lg = log_sigmoid(p.in[dir == 0 ? 10 : 11][layer * 4 + h]); const float g = expf(128.f * lg);
    float* S = (float*)(p.ws + WS_RETS) + (size_t)((dir * 2 + b) * NCHUNK) * 4 * 4096 + (size_t)h * 4096 + de;
    float kv[NCHUNK];
#pragma unroll
    for (int n = 0; n < NCHUNK; ++n) kv[n] = S[(size_t)n * 4 * 4096];
    float st = 0.f;
    if (dir == 0) {
#pragma unroll
        for (int n = 0; n < NCHUNK; ++n) { const float t = kv[n]; kv[n] = st; st = st * g + t; }
    } else {
#pragma unroll
        for (int i = 0; i < NCHUNK; ++i) { const int n = i < 2 ? 1 - i : NCHUNK + 1 - i; const float t = kv[n]; kv[n] = st; st = st * g + t; }
    }
    float* S2 = (float*)(p.ws + WS_RETS2) + (size_t)((dir * 2 + b) * NCHUNK) * 4 * 4096 + (size_t)h * 4096 + de;
#pragma unroll
    for (int n = 0; n < NCHUNK; ++n) S2[(size_t)n * 4 * 4096] = kv[n];
}
__device__ __forceinline__ void ret_out_item(const P& p, LAS unsigned char* lds, int layer, int it) {
    using namespace rt;
    const int tid = threadIdx.x, lane = tid & 63, w = tid >> 6; const int h = it & 3, n = (it >> 2) % NCHUNK, b = (it >> 2) / NCHUNK;
    LAS bf16* Qs = (LAS bf16*)lds; LAS bf16* Ks = Qs + 128 * PQ; LAS bf16* VT = Ks + 128 * PQ; LAS bf16* Ps = VT + 64 * PJ; LAS bf16* SfT = Ps + 128 * PJ; LAS bf16* SbT = SfT + 64 * PQ;
    LAS float* pf = (LAS float*)(SbT + 64 * PQ); LAS float* pb = pf + 132;
    const int r0 = chunk_row0(b, n);
    const float lgf = log_sigmoid(p.in[10][layer * 4 + h]), lgb = log_sigmoid(p.in[11][layer * 4 + h]);
    const float* S = (const float*)(p.ws + WS_RETS2);
    const float* sfp = S + ((size_t)((0 * 2 + b) * NCHUNK + n) * 4 + h) * 4096; const float* sbp = S + ((size_t)((1 * 2 + b) * NCHUNK + n) * 4 + h) * 4096;
    __syncthreads();
    { const int j = tid >> 2, dq = (tid & 3) * 16;
      const bf16* Q = (const bf16*)(p.ws + WS_RETQ) + (size_t)(r0 + j) * 256 + h * 64 + dq; const bf16* K = (const bf16*)(p.ws + WS_RETK) + (size_t)(r0 + j) * 256 + h * 64 + dq;
      *(LAS u32x4*)(Qs + j * PQ + dq) = *(const u32x4*)Q; *(LAS u32x4*)(Qs + j * PQ + dq + 8) = *(const u32x4*)(Q + 8);
      *(LAS u32x4*)(Ks + j * PQ + dq) = *(const u32x4*)K; *(LAS u32x4*)(Ks + j * PQ + dq + 8) = *(const u32x4*)(K + 8); }
    { const int j = tid & 127, dq = (tid >> 7) * 16;
      const bf16* V = (const bf16*)(p.ws + WS_RETV) + (size_t)(r0 + j) * 256 + h * 64 + dq;
#pragma unroll
      for (int q8 = 0; q8 < 2; ++q8) { const u32x4 vw = *(const u32x4*)(V + q8 * 8); const unsigned vv[4] = {vw.x, vw.y, vw.z, vw.w};
#pragma unroll
          for (int q = 0; q < 4; ++q) { const int d = dq + q8 * 8 + 2 * q; VT[d * PJ + j] = (bf16)(vv[q] & 0xffffu); VT[(d + 1) * PJ + j] = (bf16)(vv[q] >> 16); } } }
    { const int d = tid & 63, e0 = (tid >> 6) * 8;
#pragma unroll
      for (int q4 = 0; q4 < 2; ++q4) { const f32x4 a = *(const f32x4*)(sfp + d * 64 + e0 + q4 * 4), c = *(const f32x4*)(sbp + d * 64 + e0 + q4 * 4);
#pragma unroll
          for (int q = 0; q < 4; ++q) { SfT[(e0 + q4 * 4 + q) * PQ + d] = f2bf(a[q]); SbT[(e0 + q4 * 4 + q) * PQ + d] = f2bf(c[q]); } } }
    if (tid <= 128) { pf[tid] = expf((float)tid * lgf); pb[tid] = expf((float)tid * lgb); }
    __syncthreads();
    { const bf16x8 a0 = frag(Qs, 16 * w, PQ, 0, lane), a1 = frag(Qs, 16 * w, PQ, 32, lane);
#pragma unroll
      for (int jt = 0; jt < 8; ++jt) { f32x4 c = (f32x4){0.f, 0.f, 0.f, 0.f};
          c = mma(a0, frag(Ks, jt * 16, PQ, 0, lane), c); c = mma(a1, frag(Ks, jt * 16, PQ, 32, lane), c);
          const int j = jt * 16 + (lane & 15);
#pragma unroll
          for (int r = 0; r < 4; ++r) { const int i = 16 * w + 4 * (lane >> 4) + r; const float dm = i > j ? pf[i - j] : (i < j ? pb[j - i] : 2.f); Ps[i * PJ + j] = f2bf(c[r] * dm); } } }
    __syncthreads();
    f32x4 aP[4], aF[4], aB[4];
#pragma unroll
    for (int et = 0; et < 4; ++et) { aP[et] = (f32x4){0.f, 0.f, 0.f, 0.f}; aF[et] = aP[et]; aB[et] = aP[et]; }
#pragma unroll
    for (int ks = 0; ks < 4; ++ks) { const bf16x8 af = frag(Ps, 16 * w, PJ, ks * 32, lane);
#pragma unroll
        for (int et = 0; et < 4; ++et) aP[et] = mma(af, frag(VT, et * 16, PJ, ks * 32, lane), aP[et]); }
#pragma unroll
    for (int ks = 0; ks < 2; ++ks) { const bf16x8 af = frag(Qs, 16 * w, PQ, ks * 32, lane);
#pragma unroll
        for (int et = 0; et < 4; ++et) { aF[et] = mma(af, frag(SfT, et * 16, PQ, ks * 32, lane), aF[et]); aB[et] = mma(af, frag(SbT, et * 16, PQ, ks * 32, lane), aB[et]); } }
    const float* rg = p.in[12] + layer * 256 + h * 64;
    const bf16* G = (const bf16*)(p.ws + WS_RETG) + (size_t)r0 * 256 + h * 64; bf16* X = (bf16*)(p.ws + WS_X) + (size_t)r0 * 1536 + 512 + h * 64;
    float gt[4][4];
#pragma unroll
    for (int r = 0; r < 4; ++r)
#pragma unroll
        for (int et = 0; et < 4; ++et) gt[r][et] = bf2f(G[(size_t)(16 * w + 4 * (lane >> 4) + r) * 256 + et * 16 + (lane & 15)]);
#pragma unroll
    for (int r = 0; r < 4; ++r) { const int i = 16 * w + 4 * (lane >> 4) + r; const float xf = pf[i + 1], xb = pb[128 - i];
        float o[4]; float ss = 0.f;
#pragma unroll
        for (int et = 0; et < 4; ++et) { o[et] = aP[et][r] + xf * aF[et][r] + xb * aB[et][r]; ss += o[et] * o[et]; }
        ss += __shfl_xor(ss, 1); ss += __shfl_xor(ss, 2); ss += __shfl_xor(ss, 4); ss += __shfl_xor(ss, 8);
        const float rstd = rsqrtf(ss * (1.f / 64.f) + EPS);
#pragma unroll
        for (int et = 0; et < 4; ++et) { const int e = et * 16 + (lane & 15); Ps[i * PJ + e] = f2bf(o[et] * rstd * rg[e] * siluf_(gt[r][et])); } }
    asm volatile("s_waitcnt lgkmcnt(0)" ::: "memory");
#pragma unroll
    for (int q = 0; q < 2; ++q) { const int c = lane + 64 * q, i = 16 * w + (c >> 3), e8 = (c & 7) * 8;
        *(u32x4*)(X + (size_t)i * 1536 + e8) = *(const LAS u32x4*)(Ps + i * PJ + e8); }
    __syncthreads();
}

#include <hip/hip_bf16.h>
#include <cmath>
namespace attn_body {
using bf16=__hip_bfloat16;
using bf16x8=__attribute__((ext_vector_type(8)))short;
using s16x4=__attribute__((ext_vector_type(4)))short;
using f32x16=__attribute__((ext_vector_type(16)))float;
using u32x4=__attribute__((ext_vector_type(4)))unsigned;
constexpr int D=64, QP=512, KP=128, OP=1536;
constexpr int NW=8,QBLK=32,QB=QBLK*NW,KVBLK=64;
__device__ __forceinline__ int crow(int r,int hi){return (r&3)+8*(r>>2)+4*hi;}
#define SBAR() __builtin_amdgcn_sched_barrier(0)
__device__ __forceinline__ void cmask(f32x16&p0,f32x16&p1,int jb,int qrel,int hi){
  const float NEG=-INFINITY; int kb=64*jb+4*hi;
  #pragma unroll
  for(int r=0;r<16;++r){int kv=kb+(r&3)+8*(r>>2); if(kv>qrel)p0[r]=NEG; if(kv+32>qrel)p1[r]=NEG;}
}

constexpr int NSLOT=3, SLOTB=8192;
constexpr int LDS_K=0, LDS_V=NSLOT*SLOTB, LDS_WS=2*NSLOT*SLOTB, LDS_OST=LDS_WS+NW*64*4, LDS_BYTES=LDS_OST+NW*4096;
constexpr float C2=0.125f*1.4426950408889634f;
__device__ __forceinline__ void glds16(const void*gsrc,unsigned lds_dst){unsigned keep;
  asm volatile("s_mov_b32 %0, m0\n\ts_mov_b32 m0, %2\n\ts_nop 0\n\tglobal_load_lds_dwordx4 %1, off\n\ts_mov_b32 m0, %0":"=&s"(keep):"v"(gsrc),"s"(lds_dst):"memory");}
__device__ __forceinline__ float max3f(float a,float b,float c){float r;asm("v_max3_f32 %0, %1, %2, %3":"=v"(r):"v"(a),"v"(b),"v"(c));return r;}
__device__ __forceinline__ float max2f(float a,float b){float r;asm("v_max_f32_e32 %0, %1, %2":"=v"(r):"v"(a),"v"(b));return r;}
__device__ __forceinline__ float fadd_s(float a,float b){float r;asm("v_add_f32_e32 %0, %1, %2":"=v"(r):"v"(a),"v"(b));return r;}
__device__ __forceinline__ float fsub_s(float a,float b){float r;asm("v_sub_f32_e32 %0, %1, %2":"=v"(r):"v"(a),"v"(b));return r;}
typedef float f32x2_t __attribute__((ext_vector_type(2))); typedef __bf16 bf16x2_t __attribute__((ext_vector_type(2)));
__device__ __forceinline__ unsigned cvtpk_s(float lo,float hi){f32x2_t v={lo,hi};bf16x2_t b=__builtin_convertvector(v,bf16x2_t);return __builtin_bit_cast(unsigned,b);}
#define WAIT_BAR(N) asm volatile("s_waitcnt vmcnt(" #N ") lgkmcnt(0)\n\ts_barrier":::"memory")

__device__ __forceinline__ void qkt(f32x16&p0,f32x16&p1,const char*Kslot,const bf16x8*qr,const f32x16&negm,int r32,int hi){
  const char*kb=Kslot+hi*1024+r32*16;
  #pragma unroll
  for(int d0=0;d0<4;++d0){
    const bf16x8 b0=*reinterpret_cast<const bf16x8*>(kb+d0*2048);
    const bf16x8 b1=*reinterpret_cast<const bf16x8*>(kb+d0*2048+512);
    if(d0==0){p0=__builtin_amdgcn_mfma_f32_32x32x16_bf16(b0,qr[0],negm,0,0,0);p1=__builtin_amdgcn_mfma_f32_32x32x16_bf16(b1,qr[0],negm,0,0,0);}
    else{p0=__builtin_amdgcn_mfma_f32_32x32x16_bf16(b0,qr[d0],p0,0,0,0);p1=__builtin_amdgcn_mfma_f32_32x32x16_bf16(b1,qr[d0],p1,0,0,0);}}
}
typedef __attribute__((address_space(3))) const char* lds_cptr;
typedef short v4i16_t __attribute__((ext_vector_type(4)));
__device__ __forceinline__ void kload8(bf16x8*kf,lds_cptr kp){
  kf[0]=*(const __attribute__((address_space(3))) bf16x8*)(kp);      kf[1]=*(const __attribute__((address_space(3))) bf16x8*)(kp+512);
  kf[2]=*(const __attribute__((address_space(3))) bf16x8*)(kp+2048); kf[3]=*(const __attribute__((address_space(3))) bf16x8*)(kp+2560);
  kf[4]=*(const __attribute__((address_space(3))) bf16x8*)(kp+4096); kf[5]=*(const __attribute__((address_space(3))) bf16x8*)(kp+4608);
  kf[6]=*(const __attribute__((address_space(3))) bf16x8*)(kp+6144); kf[7]=*(const __attribute__((address_space(3))) bf16x8*)(kp+6656);
}
__device__ __forceinline__ void kload2(bf16x8*kf,lds_cptr kp,int j){ kf[2*j]=*(const __attribute__((address_space(3))) bf16x8*)(kp+j*2048); kf[2*j+1]=*(const __attribute__((address_space(3))) bf16x8*)(kp+j*2048+512); }
__device__ __forceinline__ s16x4 vtr(lds_cptr p){ return __builtin_bit_cast(s16x4,__builtin_amdgcn_ds_read_tr16_b64_v4i16((__attribute__((address_space(3))) v4i16_t*)p)); }
__device__ __forceinline__ float rowmax(const f32x16&p0,const f32x16&p1){
  float a=max3f(p0[0],p0[1],p1[0]),b=max3f(p0[2],p0[3],p1[1]);a=max3f(a,p1[2],p1[3]);
  #pragma unroll
  for(int r=4;r<16;r+=4){a=max3f(a,p0[r],p0[r+1]);b=max3f(b,p0[r+2],p0[r+3]);a=max3f(a,p1[r],p1[r+1]);b=max3f(b,p1[r+2],p1[r+3]);}
  const float m=max2f(a,b);
  auto rr=__builtin_amdgcn_permlane32_swap(__float_as_uint(m),__float_as_uint(m),false,false);
  return max2f(__uint_as_float(rr[0]),__uint_as_float(rr[1]));
}
__device__ __forceinline__ void pv(f32x16*o,int vb,bf16x8 pa0,bf16x8 pa1,bf16x8 pa2,bf16x8 pa3){
  #pragma unroll
  for(int d0=0;d0<2;++d0){s16x4 lo[4],hi[4];
    #pragma unroll
    for(int ks=0;ks<4;++ks){
      asm volatile("ds_read_b64_tr_b16 %0,%1 offset:%c2":"=&v"(lo[ks]):"v"(vb),"i"(d0*4096+ks*1024):"memory");
      asm volatile("ds_read_b64_tr_b16 %0,%1 offset:%c2":"=&v"(hi[ks]):"v"(vb),"i"(d0*4096+ks*1024+512):"memory");}
    asm volatile("s_waitcnt lgkmcnt(0)":::"memory");SBAR();
    #define PK(k) (bf16x8){lo[k][0],lo[k][1],lo[k][2],lo[k][3],hi[k][0],hi[k][1],hi[k][2],hi[k][3]}
    o[d0]=__builtin_amdgcn_mfma_f32_32x32x16_bf16(pa0,PK(0),o[d0],0,0,0);
    o[d0]=__builtin_amdgcn_mfma_f32_32x32x16_bf16(pa1,PK(1),o[d0],0,0,0);
    o[d0]=__builtin_amdgcn_mfma_f32_32x32x16_bf16(pa2,PK(2),o[d0],0,0,0);
    o[d0]=__builtin_amdgcn_mfma_f32_32x32x16_bf16(pa3,PK(3),o[d0],0,0,0);
    #undef PK
  }
}

#ifndef ATTN_STORE16
#define ATTN_STORE16(p,v) (*(u32x4*)(p)=(v))
#endif
template<int THRL> __device__ __forceinline__ void attn_unit(const bf16*Q0,const bf16*__restrict__ Kh,const bf16*__restrict__ Vh,bf16*O0,const int NT,char*shm){
  const int tid=threadIdx.x,lane=tid&63,r32=lane&31,hi=lane>>5; const int wid=__builtin_amdgcn_readfirstlane(tid>>6);
  const bf16*Qw=Q0+(long)(wid*QBLK)*QP;
  const unsigned lds0=(unsigned)(uintptr_t)shm;
  float*wsf=(float*)(shm+LDS_WS)+wid*64;
  const bf16*ksrc=Kh+(long)lane*KP+wid*8;
  const bf16*vsrc=Vh+(long)(16*(wid&3)+(lane>>2))*KP+(wid>>2)*32+(lane&3)*8;
  const unsigned kdst=lds0+LDS_K+wid*1024, vdst=lds0+LDS_V+wid*1024;
  #define DMA_K(t,slot) glds16(ksrc+(long)(t)*KVBLK*KP,(unsigned)__builtin_amdgcn_readfirstlane(kdst+(slot)))
  #define DMA_V(t,slot) glds16(vsrc+(long)(t)*KVBLK*KP,(unsigned)__builtin_amdgcn_readfirstlane(vdst+(slot)))
  const int vb0=(int)(lds0+LDS_V)+((lane>>4)&1)*32+(lane&3)*8+(4*hi+((lane&15)>>2))*64;
  const char*Kbase=shm+LDS_K; bf16x8 kf[8];
  const lds_cptr shm3=(lds_cptr)shm; const lds_cptr kp0=shm3+LDS_K+hi*1024+r32*16; const lds_cptr vp0=shm3+LDS_V+((lane>>4)&1)*32+(lane&3)*8+(4*hi+((lane&15)>>2))*64;
  DMA_K(0,0);DMA_V(0,0);DMA_K(1,SLOTB);
  bf16x8 qr[4];
  #pragma unroll
  for(int d0=0;d0<4;++d0)qr[d0]=*reinterpret_cast<const bf16x8*>(&Qw[(long)r32*QP+d0*16+hi*8]);
  float mhat=0.f,l_reg=0.f;f32x16 o[2];o[0]=f32x16{};o[1]=f32x16{};f32x16 negm=f32x16{};asm volatile("":"+v"(negm));
  #define CMASK(P0,P1,t) do{}while(0)
  bool resc=false;
  #define START(P0,P1) do{ const float rm=rowmax(P0,P1); resc=false; \
    { const float dl=rm; mhat=fadd_s(mhat,dl); \
      _Pragma("unroll") for(int r=0;r<16;++r){P0[r]=fsub_s(P0[r],dl);P1[r]=fsub_s(P1[r],dl);} \
      _Pragma("unroll") for(int r=0;r<16;++r)negm[r]=-mhat; asm volatile("":"+v"(negm)); } \
    _Pragma("unroll") for(int r=0;r<16;++r)P0[r]=__builtin_amdgcn_exp2f(P0[r]); }while(0)
  #define RESC() do{ if(resc){ asm volatile("s_waitcnt lgkmcnt(0)":::"memory"); \
      _Pragma("unroll") for(int d_=0;d_<2;++d_) _Pragma("unroll") for(int r=0;r<16;++r)o[d_][r]*=wsf[crow(r,hi)]; } }while(0)
  f32x16 pA0,pA1,pB0,pB1;
  int sl_prev=0,sl_cur=0,sl_next=SLOTB;
  #define ROT() do{sl_prev=sl_cur;sl_cur=sl_next;sl_next=(sl_next==(NSLOT-1)*SLOTB)?0:sl_next+SLOTB;}while(0)
  DMA_K(2,2*SLOTB);
  WAIT_BAR(3);
  qkt(pA0,pA1,Kbase,qr,negm,r32,hi);asm volatile("s_nop 15\n\ts_nop 7":"+v"(pA0),"+v"(pA1));CMASK(pA0,pA1,0);
  START(pA0,pA1);
  _Pragma("unroll") for(int r=0;r<16;++r)pA1[r]=__builtin_amdgcn_exp2f(pA1[r]);
  WAIT_BAR(0);
  DMA_K(3,0);DMA_V(1,SLOTB);
  ROT();
  kload8(kf,kp0+sl_cur);
  WAIT_BAR(2);
  s16x4 vlo[8],vhi[8]; u32x4 pw0,pw1,pw2,pw3;
  #define PKW(P,B) cvtpk_s(P[B],P[B+1])
  #define PAF(k) __builtin_bit_cast(bf16x8,pw##k)
  #define VFR(i) (bf16x8){vlo[i][0],vlo[i][1],vlo[i][2],vlo[i][3],vhi[i][0],vhi[i][1],vhi[i][2],vhi[i][3]}
  #define PIN(x) asm volatile("":"+v"(x))
  #define MX3(a,b,c) __builtin_fmaxf(__builtin_fmaxf((a),(b)),(c))
  #define GAPA(MF,A0,A1,A2,A3,W0,W1,PW) do{ MF; sacc+=A0; sacc+=A1; sacc+=A2; sacc+=A3; PIN(sacc); W0; W1; PIN(PW); SBAR(); }while(0)
  #define EX(v) __builtin_amdgcn_exp2f(v)
  #define GAPB(MF,X,B) do{ MF; X[B]=EX(X[B]); X[B+1]=EX(X[B+1]); X[B+2]=EX(X[B+2]); X[B+3]=EX(X[B+3]); PIN(X); SBAR(); }while(0)
  #define VRD(i) do{ vlo[i]=vtr(vp_+(((i)>>2)*4096+((i)&3)*1024)); vhi[i]=vtr(vp_+(((i)>>2)*4096+((i)&3)*1024+512)); }while(0)
  #define KRD(G,j) do{ if(G){ kload2(kf,kp0+sl_next,j); SBAR(); } }while(0)
  #define STEP(C0,C1,P0,P1,t,GK,GV,GL) do{ SBAR(); \
    const lds_cptr vp_=vp0+sl_prev; \
    VRD(0); SBAR(); float sacc=(P0[0]+P0[1]); \
    GAPA(C0=__builtin_amdgcn_mfma_f32_32x32x16_bf16(kf[0],qr[0],negm,0,0,0), P0[2],P0[3],P0[4],P0[5],     pw0[0]=PKW(P0,0), pw0[1]=PKW(P0,2), pw0); \
    VRD(4); SBAR(); GAPA(C1=__builtin_amdgcn_mfma_f32_32x32x16_bf16(kf[1],qr[0],negm,0,0,0), P0[6],P0[7],P0[8],P0[9],     pw0[2]=PKW(P0,4), pw0[3]=PKW(P0,6), pw0); \
    VRD(1); SBAR(); GAPA(C0=__builtin_amdgcn_mfma_f32_32x32x16_bf16(kf[2],qr[1],C0,0,0,0),   P0[10],P0[11],P0[12],P0[13], pw1[0]=PKW(P0,8), pw1[1]=PKW(P0,10), pw1); \
    VRD(5); SBAR(); GAPA(C1=__builtin_amdgcn_mfma_f32_32x32x16_bf16(kf[3],qr[1],C1,0,0,0),   P0[14],P0[15],P1[0],P1[1],   pw1[2]=PKW(P0,12),pw1[3]=PKW(P0,14), pw1); \
    VRD(2); SBAR(); GAPA(C0=__builtin_amdgcn_mfma_f32_32x32x16_bf16(kf[4],qr[2],C0,0,0,0),   P1[2],P1[3],P1[4],P1[5],     pw2[0]=PKW(P1,0), pw2[1]=PKW(P1,2), pw2); \
    VRD(6); SBAR(); GAPA(C1=__builtin_amdgcn_mfma_f32_32x32x16_bf16(kf[5],qr[2],C1,0,0,0),   P1[6],P1[7],P1[8],P1[9],     pw2[2]=PKW(P1,4), pw2[3]=PKW(P1,6), pw2); \
    VRD(3); SBAR(); GAPA(C0=__builtin_amdgcn_mfma_f32_32x32x16_bf16(kf[6],qr[3],C0,0,0,0),   P1[10],P1[11],P1[12],P1[13], pw3[0]=PKW(P1,8), pw3[1]=PKW(P1,10), pw3); \
    VRD(7); SBAR(); GAPA(C1=__builtin_amdgcn_mfma_f32_32x32x16_bf16(kf[7],qr[3],C1,0,0,0),   P1[14],P1[15],0.f,0.f,       pw3[2]=PKW(P1,12),pw3[3]=PKW(P1,14), pw3); \
    l_reg+=sacc; \
    if(GK){DMA_K((t)+3,sl_cur);} if(GV){DMA_V((t)+1,sl_next);} \
    CMASK(C0,C1,t); \
    { float a=MX3(C0[0],C0[1],C1[0]),b=MX3(C0[2],C0[3],C1[1]); a=MX3(a,C1[2],C1[3]); \
      _Pragma("unroll") for(int r=4;r<16;r+=4){a=MX3(a,C0[r],C0[r+1]);b=MX3(b,C0[r+2],C0[r+3]);a=MX3(a,C1[r],C1[r+1]);b=MX3(b,C1[r+2],C1[r+3]);} \
      float rm=__builtin_fmaxf(a,b); { auto rr=__builtin_amdgcn_permlane32_swap(__float_as_uint(rm),__float_as_uint(rm),false,false); rm=__builtin_fmaxf(__uint_as_float(rr[0]),__uint_as_float(rr[1])); } \
      resc=false; \
      if(__builtin_expect(__any(rm>(float)THRL),0)){ const float dl=__builtin_fmaxf(rm,0.f); mhat+=dl; \
        _Pragma("unroll") for(int r=0;r<16;++r){C0[r]-=dl;C1[r]-=dl;} \
        _Pragma("unroll") for(int r=0;r<16;++r)negm[r]=-mhat; asm volatile("":"+v"(negm)); \
        const float f=__builtin_amdgcn_exp2f(-dl); l_reg*=f; if(hi==0)wsf[r32]=f; resc=true; } } \
    SBAR(); \
    GAPB(o[0]=__builtin_amdgcn_mfma_f32_32x32x16_bf16(PAF(0),VFR(0),o[0],0,0,0), C0,0); \
    GAPB(o[1]=__builtin_amdgcn_mfma_f32_32x32x16_bf16(PAF(0),VFR(4),o[1],0,0,0), C0,4); \
    KRD(GL,0); GAPB(o[0]=__builtin_amdgcn_mfma_f32_32x32x16_bf16(PAF(1),VFR(1),o[0],0,0,0), C0,8); \
    KRD(GL,1); GAPB(o[1]=__builtin_amdgcn_mfma_f32_32x32x16_bf16(PAF(1),VFR(5),o[1],0,0,0), C0,12); \
    KRD(GL,2); GAPB(o[0]=__builtin_amdgcn_mfma_f32_32x32x16_bf16(PAF(2),VFR(2),o[0],0,0,0), C1,0); \
    KRD(GL,3); GAPB(o[1]=__builtin_amdgcn_mfma_f32_32x32x16_bf16(PAF(2),VFR(6),o[1],0,0,0), C1,4); \
    GAPB(o[0]=__builtin_amdgcn_mfma_f32_32x32x16_bf16(PAF(3),VFR(3),o[0],0,0,0), C1,8); \
    GAPB(o[1]=__builtin_amdgcn_mfma_f32_32x32x16_bf16(PAF(3),VFR(7),o[1],0,0,0), C1,12); \
    }while(0)
  int t=1;
  #undef CMASK
  #define CMASK(P0,P1,t) do{}while(0)
  for(;t+5<NT;t+=2){
    STEP(pB0,pB1,pA0,pA1,t,true,true,true);     WAIT_BAR(2); RESC(); ROT();
    STEP(pA0,pA1,pB0,pB1,t+1,true,true,true);   WAIT_BAR(2); RESC(); ROT();
  }
  #undef CMASK
  #define CMASK(P0,P1,t) do{}while(0)
  #define ENDW(tt) do{ if((tt)+3<NT){WAIT_BAR(2);} else if((tt)+2<NT){WAIT_BAR(1);} else {WAIT_BAR(0);} }while(0)
  for(;t+1<NT;t+=2){
    STEP(pB0,pB1,pA0,pA1,t,(t+3<NT),(t+1<NT),(t+1<NT));       ENDW(t);   RESC(); ROT();
    STEP(pA0,pA1,pB0,pB1,t+1,(t+4<NT),(t+2<NT),(t+2<NT));     ENDW(t+1); RESC(); ROT();
  }
  STEP(pB0,pB1,pA0,pA1,NT-1,false,false,false); RESC();
  { float sacc=pB0[0]+pB0[1]; _Pragma("unroll") for(int r=2;r<16;++r)sacc+=pB0[r]; _Pragma("unroll") for(int r=0;r<16;++r)sacc+=pB1[r]; l_reg+=sacc;
    pw0=(u32x4){PKW(pB0,0),PKW(pB0,2),PKW(pB0,4),PKW(pB0,6)};pw1=(u32x4){PKW(pB0,8),PKW(pB0,10),PKW(pB0,12),PKW(pB0,14)};pw2=(u32x4){PKW(pB1,0),PKW(pB1,2),PKW(pB1,4),PKW(pB1,6)};pw3=(u32x4){PKW(pB1,8),PKW(pB1,10),PKW(pB1,12),PKW(pB1,14)};
    SBAR(); pv(o,vb0+sl_cur,PAF(0),PAF(1),PAF(2),PAF(3)); }
  #undef PKW
  #undef PAF
  #undef VFR
  #undef PIN
  #undef MX3
  #undef GAPA
  #undef GAPB
  #undef EX
  #undef VRD
  #undef KRD
  #undef STEP
  #undef ENDW
  {auto rr=__builtin_amdgcn_permlane32_swap(__float_as_uint(l_reg),__float_as_uint(l_reg),false,false);l_reg=__uint_as_float(rr[0])+__uint_as_float(rr[1]);}
  if(hi==0)wsf[32+r32]=l_reg;asm volatile("s_waitcnt lgkmcnt(0)":::"memory");
  float rli[16];
  #pragma unroll
  for(int r=0;r<16;++r)rli[r]=__builtin_amdgcn_rcpf(wsf[32+crow(r,hi)]);
  bf16*Ow=O0+(long)(wid*QBLK)*OP;
  { bf16*stg=(bf16*)(shm+LDS_OST)+wid*2048;
    #pragma unroll
    for(int r=0;r<16;++r){const int orow=crow(r,hi);
      #pragma unroll
      for(int d0=0;d0<2;++d0)stg[orow*64+d0*32+r32]=__float2bfloat16(o[d0][r]*rli[r]);}
    asm volatile("s_waitcnt lgkmcnt(0)":::"memory");
    #pragma unroll
    for(int i=0;i<4;++i){const int row=i*8+(lane>>3),ch=lane&7; const u32x4 v=*(const u32x4*)(stg+row*64+ch*8); ATTN_STORE16(Ow+(long)row*OP+ch*8,v);} }
  asm volatile("s_waitcnt lgkmcnt(0)\n\ts_barrier":::"memory");
  #undef DMA_K
  #undef DMA_V
  #undef CMASK
  #undef START
  #undef RESC
  #undef ROT
}
constexpr int ATTN_LDS_BYTES=LDS_BYTES;
#undef SBAR
#undef WAIT_BAR
}

__device__ __forceinline__ void attn_phase_run(const P& p, unsigned char* lds_generic, int layer) {
    typedef attn_body::bf16 abf;
    const int G = gridDim.x, bx = blockIdx.x, vcu = (G % 8 == 0) ? (bx % 8) * (G / 8) + bx / 8 : bx;
    const abf* Q = (const abf*)(p.ws + WS_ATTQ); const abf* K = (const abf*)(p.ws + WS_ATTK); const abf* V = (const abf*)(p.ws + WS_ATTV); abf* X = (abf*)(p.ws + WS_X);
    if (G == 256) {
        const int x = vcu >> 5, qb = vcu & 31, b = x >> 2, kvh = (x >> 1) & 1;
#pragma unroll 1
        for (int i = 0; i < 2; ++i) { const int h = kvh * 4 + 2 * (x & 1) + i; const long r0 = (long)b * SEQ + qb * 256;
            attn_body::attn_unit<8>(Q + r0 * 512 + h * 64, K + (long)b * KEYS * 128 + kvh * 64, V + (long)b * KEYS * 128 + kvh * 64, X + r0 * 1536 + 768 + h * 64, KEYS / 64, (char*)lds_generic); }
    } else {
#pragma unroll 1
        for (int u = vcu; u < 512; u += G) { const int qb = u & 31, h = (u >> 5) & 7, b = u >> 8, kvh = h >> 2; const long r0 = (long)b * SEQ + qb * 256;
            attn_body::attn_unit<8>(Q + r0 * 512 + h * 64, K + (long)b * KEYS * 128 + kvh * 64, V + (long)b * KEYS * 128 + kvh * 64, X + r0 * 1536 + 768 + h * 64, KEYS / 64, (char*)lds_generic); }
    }
    if (layer == 0) {
#pragma unroll 1
        for (int u = vcu; u < 16; u += G) { const int b = u >> 3, h = u & 7, kvh = h >> 2; const long r0 = NLAT + (long)b * CTX;
            attn_body::attn_unit<8>(Q + r0 * 512 + h * 64, K + (long)b * KEYS * 128 + kvh * 64, V + (long)b * KEYS * 128 + kvh * 64, X + r0 * 1536 + 768 + h * 64, CTX / 64, (char*)lds_generic); }
    }
}

__device__ __forceinline__ void ph_fft1(const P& p, LAS unsigned char* lds, int layer) {
    int nt2 = 2; asm volatile("" : "+s"(nt2));
    { fg::PlainSched S{(const char*)(p.ws + WS_F1), (const char*)(p.ws + WS_UT), 256, 256, 1, 128, (int)gridDim.x, (int)blockIdx.x, nt2};
      fg::EpiFft1 E{p.ws}; fg::gemm_phase(lds, 256, 256, S, E); }
    if (layer == 0) { fg::PlainSched S{(const char*)(p.ws + WS_FC), (const char*)(p.ws + WS_UTC), 256, 256, 2, 2, (int)gridDim.x, (int)((blockIdx.x + 128) % gridDim.x), 4};
      fg::EpiFftC E{p.ws}; fg::gemm_phase(lds, 256, 256, S, E); }
}
__device__ __forceinline__ void ph_fft3(const P& p, LAS unsigned char* lds) {
    int nt2 = 2; asm volatile("" : "+s"(nt2));
    fg::PlainSched S{(const char*)(p.ws + WS_F2), (const char*)(p.ws + WS_Z), 256, 256, 1, 256, (int)gridDim.x, (int)blockIdx.x, nt2};
    fg::EpiFft3 E{p.ws}; fg::gemm_phase(lds, 256, 256, S, E);
}
__device__ __forceinline__ void ph_mix1(const P& p, LAS unsigned char* lds, int layer) {
    ph_fft1(p, lds, layer);
    const int nconv = layer == 0 ? 264 : 256;
    const int n0 = nconv, n1 = n0 + NB * NCHUNK * 4;
    for (int it = gridDim.x - 1 - blockIdx.x; it < n1; it += gridDim.x) {
        if (it < n0) { if (it < 256) conv_item(p, lds, layer, it >> 7, (it & 127) * 64); else conv_item(p, lds, layer, 2 + ((it - 256) >> 2), ((it - 256) & 3) * 64); }
        else ret_kv_item(p, lds, layer, it - n0);
    }
    __syncthreads();
}
__device__ __forceinline__ void ph_mix2(const P& p, LAS unsigned char* lds, unsigned char* lds_generic, int layer) {
    for (int it = blockIdx.x; it < 128; it += gridDim.x) ret_scan_item(p, layer, it);
    __syncthreads();
    ph_fft3(p, lds);
    attn_phase_run(p, lds_generic, layer);
    __syncthreads();
}
__device__ __forceinline__ void ph_mix3(const P& p, LAS unsigned char* lds, int layer, bool ctxlater) {
    for (int it = blockIdx.x; it < NB * NCHUNK * 4; it += gridDim.x) {
        const int n = (it >> 2) % NCHUNK; if ((layer == 1 || ctxlater) && n < 2) continue;
        ret_out_item(p, lds, layer, it);
    }
    __syncthreads();
}
__device__ __forceinline__ void ctx_ret_items(const P& p, LAS unsigned char* lds) {
    const int u = blockIdx.x;
    if (u < 16) { const int b = u >> 3, n = (u >> 2) & 1, h = u & 3;
        ret_out_item(p, lds, 0, (b * NCHUNK + n) * 4 + h);
        asm volatile("s_waitcnt vmcnt(0)" ::: "memory"); __syncthreads();
        if (threadIdx.x == 0) { __builtin_amdgcn_fence(__ATOMIC_RELEASE, "agent");
            __hip_atomic_fetch_add((unsigned*)(p.ws + WS_CTL) + CW_CCNT + (8 * 3) * 16, 1u, __ATOMIC_RELAXED, __HIP_MEMORY_SCOPE_AGENT); }
        __syncthreads(); }
}
__device__ __forceinline__ void ctx_ret_wait(const P& p) {
    if (threadIdx.x == 0) { unsigned* c = (unsigned*)(p.ws + WS_CTL) + CW_CCNT + (8 * 3) * 16; unsigned* tmo = (unsigned*)(p.ws + WS_CTL) + CW_TMO; unsigned sp = 0u;
        while (__hip_atomic_load(c, __ATOMIC_RELAXED, __HIP_MEMORY_SCOPE_AGENT) < 16u) { __builtin_amdgcn_s_sleep(1);
            if ((++sp & 255u) == 0u) { if (__hip_atomic_load(tmo, __ATOMIC_RELAXED, __HIP_MEMORY_SCOPE_AGENT)) break; if (sp > (1u << 22)) { atomicAdd(tmo, 1u); break; } } }
        __builtin_amdgcn_fence(__ATOMIC_ACQUIRE, "agent"); }
    __syncthreads();
}

namespace sk {
typedef short bf16x8 __attribute__((ext_vector_type(8)));
__device__ __forceinline__ void tile64(LAS unsigned char* lds, const bf16* A, int lda, const bf16* Bt, int ldb, int K, float (&out)[8]) {
    const int tid = threadIdx.x, lane = tid & 63, w = tid >> 6, kc = K >> 3;
    const bf16* ap = A + (size_t)(lane & 15) * lda + w * kc + 8 * (lane >> 4); const bf16* bp = Bt + (size_t)(lane & 15) * ldb + w * kc + 8 * (lane >> 4);
    f32x4 acc[4][4];
#pragma unroll
    for (int i = 0; i < 4; ++i)
#pragma unroll
        for (int j = 0; j < 4; ++j) acc[i][j] = (f32x4){0.f, 0.f, 0.f, 0.f};
#pragma unroll 2
    for (int k0 = 0; k0 < kc; k0 += 32) {
        bf16x8 af[4], bfr[4];
#pragma unroll
        for (int i = 0; i < 4; ++i) { af[i] = *(const bf16x8*)(ap + (size_t)(16 * i) * lda + k0); bfr[i] = *(const bf16x8*)(bp + (size_t)(16 * i) * ldb + k0); }
#pragma unroll
        for (int i = 0; i < 4; ++i)
#pragma unroll
            for (int j = 0; j < 4; ++j) acc[i][j] = __builtin_amdgcn_mfma_f32_16x16x32_bf16(af[i], bfr[j], acc[i][j], 0, 0, 0);
    }
    LAS float* part = (LAS float*)lds;
    __syncthreads();
#pragma unroll
    for (int i = 0; i < 4; ++i)
#pragma unroll
        for (int j = 0; j < 4; ++j)
#pragma unroll
            for (int r = 0; r < 4; ++r) part[((w * 16 + i * 4 + j) * 4 + r) * 64 + lane] = acc[i][j][r];
    __syncthreads();
#pragma unroll
    for (int q = 0; q < 8; ++q) { float sacc = 0.f;
#pragma unroll
        for (int ww = 0; ww < 8; ++ww) sacc += part[ww * 4096 + tid + 512 * q];
        out[q] = sacc; }
}
__device__ __forceinline__ void tile64_f8(LAS unsigned char* lds, const unsigned char* A, int lda, const unsigned char* Bt, int ldb, int K, float (&out)[8]) {
    const int tid = threadIdx.x, lane = tid & 63, w = tid >> 6;
    const unsigned char* ap = A + (size_t)(lane & 15) * lda + 32 * (lane >> 4); const unsigned char* bp = Bt + (size_t)(lane & 15) * ldb + 32 * (lane >> 4);
    f32x4 acc[4][4];
#pragma unroll
    for (int i = 0; i < 4; ++i)
#pragma unroll
        for (int j = 0; j < 4; ++j) acc[i][j] = (f32x4){0.f, 0.f, 0.f, 0.f};
    for (int ks = w; ks * 128 < K; ks += 8) {
        fg::i32x8 af[4], bfr[4];
#pragma unroll
        for (int i = 0; i < 4; ++i) { af[i] = *(const fg::i32x8*)(ap + (size_t)(16 * i) * lda + ks * 128); bfr[i] = *(const fg::i32x8*)(bp + (size_t)(16 * i) * ldb + ks * 128); }
#pragma unroll
        for (int i = 0; i < 4; ++i)
#pragma unroll
            for (int j = 0; j < 4; ++j) acc[i][j] = __builtin_amdgcn_mfma_scale_f32_16x16x128_f8f6f4(af[i], bfr[j], acc[i][j], 0, 0, 0, 0x7f7f7f7f, 0, 0x7a7a7a7a);
    }
    LAS float* part = (LAS float*)lds;
    __syncthreads();
#pragma unroll
    for (int i = 0; i < 4; ++i)
#pragma unroll
        for (int j = 0; j < 4; ++j)
#pragma unroll
            for (int r = 0; r < 4; ++r) part[((w * 16 + i * 4 + j) * 4 + r) * 64 + lane] = acc[i][j][r];
    __syncthreads();
#pragma unroll
    for (int q = 0; q < 8; ++q) { float sacc = 0.f;
#pragma unroll
        for (int ww = 0; ww < 8; ++ww) sacc += part[ww * 4096 + tid + 512 * q];
        out[q] = sacc; }
}
__device__ __forceinline__ void elem_rc(int tid, int q, int& row, int& col) { const int e = tid + 512 * q, t16 = e >> 8, reg = (e >> 6) & 3, lane = e & 63; row = 16 * (t16 >> 2) + 4 * (lane >> 4) + reg; col = 16 * (t16 & 3) + (lane & 15); }
}
__device__ __forceinline__ void mini_merge_ctx(const P& p, LAS unsigned char* lds, int layer) {
    const bf16* X = (const bf16*)(p.ws + WS_X); const bf16* WB = (const bf16*)(p.ws + WS_WB) + (size_t)layer * 1024 * 1536; const unsigned char* G = (const unsigned char*)(p.ws + WS_G); bf16* Mg = (bf16*)(p.ws + WS_MERGED);
    for (int it = gridDim.x - 1 - blockIdx.x; it < (NCTX / 64) * 16; it += gridDim.x) { const int r0 = NLAT + (it >> 4) * 64, c0 = (it & 15) * 64;
        float tot[8];
#pragma unroll
        for (int q = 0; q < 8; ++q) tot[q] = 0.f;
#pragma unroll 1
        for (int br = 0; br < 4; ++br) { const int koff = br == 0 ? 0 : (br == 1 ? 512 : (br == 2 ? 768 : 1280)), klen = (br & 1) ? 256 : 512;
            float o[8]; sk::tile64(lds, X + (size_t)r0 * 1536 + koff, 1536, WB + (size_t)c0 * 1536 + koff, 1536, klen, o);
#pragma unroll
            for (int q = 0; q < 8; ++q) { int rr, cc; sk::elem_rc(threadIdx.x, q, rr, cc); tot[q] += o[q] * ((float)G[(size_t)(r0 + rr) * 4096 + br * 1024 + c0 + cc] * (1.f / 255.f)); } }
#pragma unroll
        for (int q = 0; q < 8; ++q) { int rr, cc; sk::elem_rc(threadIdx.x, q, rr, cc); Mg[(size_t)(r0 + rr) * 1024 + c0 + cc] = f2bf(tot[q]); } }
    __syncthreads();
}
__device__ __forceinline__ void mini_resid_ctx(const P& p, LAS unsigned char* lds, int layer, const bf16* A, int lda, const bf16* Bt, int K, int chunk, int xnorm = -1, int nlayer = 0, int nwhich = 0, const float* hsrc = nullptr) {
    const float* g = mods(p, layer, 2, chunk); float* hc = (float*)(p.ws + WS_HCTX); if (hsrc == nullptr) hsrc = hc;
    for (int it = gridDim.x - 1 - blockIdx.x; it < (NCTX / 64) * 16; it += gridDim.x) { const int rl = (it >> 4) * 64, c0 = (it & 15) * 64;
        float o[8]; sk::tile64(lds, A + (size_t)(NLAT + rl) * lda, lda, Bt + (size_t)c0 * K, K, K, o);
        if (xnorm < 0) {
#pragma unroll
            for (int q = 0; q < 8; ++q) { int rr, cc; sk::elem_rc(threadIdx.x, q, rr, cc); float* h = hc + (size_t)(rl + rr) * D + c0 + cc; *h = *h + g[c0 + cc] * o[q]; }
        } else {
#pragma unroll
            for (int q = 0; q < 8; ++q) { int rr, cc; sk::elem_rc(threadIdx.x, q, rr, cc); float* h = hc + (size_t)(rl + rr) * D + c0 + cc;
                __hip_atomic_store(h, hsrc[(size_t)(rl + rr) * D + c0 + cc] + g[c0 + cc] * o[q], __ATOMIC_RELAXED, __HIP_MEMORY_SCOPE_AGENT); }
            asm volatile("s_waitcnt vmcnt(0)" ::: "memory"); __syncthreads();
            if (threadIdx.x == 0) { unsigned* c = (unsigned*)(p.ws + WS_CTL) + CW_CCNT + (8 * xnorm + (it >> 4)) * 16; unsigned* tmo = (unsigned*)(p.ws + WS_CTL) + CW_TMO;
                __hip_atomic_fetch_add(c, 1u, __ATOMIC_RELAXED, __HIP_MEMORY_SCOPE_AGENT);
                unsigned sp = 0u;
                while (__hip_atomic_load(c, __ATOMIC_RELAXED, __HIP_MEMORY_SCOPE_AGENT) < 16u) { __builtin_amdgcn_s_sleep(1);
                    if ((++sp & 255u) == 0u) { if (__hip_atomic_load(tmo, __ATOMIC_RELAXED, __HIP_MEMORY_SCOPE_AGENT)) break; if (sp > (1u << 22)) { atomicAdd(tmo, 1u); break; } } }
                __builtin_amdgcn_fence(__ATOMIC_ACQUIRE, "agent"); }
            __syncthreads();
            { const int w = threadIdx.x >> 6, lane = threadIdx.x & 63;
              if (w < 4) { __builtin_amdgcn_fence(__ATOMIC_ACQUIRE, "agent"); norm_row(p, nlayer, nwhich, NLAT + rl + (it & 15) * 4 + w, lane); } }
            __syncthreads();
        } }
    __syncthreads();
}
__device__ __forceinline__ void ph_merge(const P& p, LAS unsigned char* lds, int layer, int nrows) {
    fg::MergeSched S{(const char*)(p.ws + WS_X), (const char*)(p.ws + WS_WB) + (size_t)layer * 1024 * 1536 * 2, nrows / 256, (int)gridDim.x, (int)blockIdx.x};
    fg::EpiMerge E{(const unsigned char*)(p.ws + WS_G), (bf16*)(p.ws + WS_MERGED)};
    fg::gemm_phase(lds, 1536, 1536, S, E);
}
__device__ __forceinline__ void ph_gemm_resid(const P& p, LAS unsigned char* lds, int layer, const bf16* A, int lda, const bf16* Bt, int K, int chunk, int nrows) {
    fg::PlainSched S{(const char*)A, (const char*)Bt, lda, K, nrows / 256, 4, (int)gridDim.x, (int)blockIdx.x, K / 64};
    fg::EpiResid E{p.out, (float*)(p.ws + WS_HCTX), (const float*)(p.ws + WS_MODS) + (size_t)layer * 3 * 6144, chunk};
    fg::gemm_phase(lds, lda, K, S, E);
}
__device__ __forceinline__ void ph_gemm_resid_norm(const P& p, LAS unsigned char* lds, int layer, const bf16* A, int lda, const bf16* Bt, int K, int chunk, int x, int nlayer, int nwhich, const float* hin) {
    fg::PlainSched S{(const char*)A, (const char*)Bt, lda, K, NLAT / 256, 4, (int)gridDim.x, (int)blockIdx.x, K / 64};
    unsigned* ctl = (unsigned*)(p.ws + WS_CTL);
    fg::EpiResidNorm E{hin, p.out, (const float*)(p.ws + WS_MODS) + (size_t)layer * 3 * 6144, chunk,
        p.in[nwhich == 0 ? 6 : 7] + nlayer * D, (const float*)(p.ws + WS_MODS) + (size_t)nlayer * 3 * 6144, nwhich == 0 ? 0 : 3, nwhich == 0 ? 1 : 4, (bf16*)(p.ws + WS_A), nwhich == 0 ? p.ws + WS_A8 : (unsigned char*)nullptr,
        (float*)(p.ws + WS_CTL + CTL_XBUF) + (size_t)x * 65536, ctl + CW_PCNT + 64 * 16 * x, ctl + CW_TMO, lds};
    fg::gemm_phase(lds, lda, K, S, E);
}
__device__ __forceinline__ void ph_ffn1(const P& p, LAS unsigned char* lds) {
    fg::PlainSched S{(const char*)(p.ws + WS_A), (const char*)(p.ws + WS_FFN1), D, D, MROWS / 256, 22, (int)gridDim.x, (int)blockIdx.x, D / 64};
    fg::EpiSwiglu E{(bf16*)(p.ws + WS_HMID)};
    fg::gemm_phase(lds, D, D, S, E);
}
__device__ __forceinline__ int moe_tiles(const P& p, LAS int* tile_e) {
    const unsigned* ctl = (const unsigned*)(p.ws + WS_CTL); int t = 0;
    for (int e = 0; e < NEXP; ++e) { const int c = (int)ctl[CW_CNT + e], nt = (c + 255) >> 8; for (int q = 0; q < nt; ++q) { if (threadIdx.x == 0) tile_e[t + q] = e; } t += nt; }
    __syncthreads();
    return t;
}
__device__ __forceinline__ void ph_assign_gather(const P& p, LAS unsigned char* lds) {
    const int tid = threadIdx.x, bid = blockIdx.x, G = gridDim.x;
    LAS int* sbase = (LAS int*)lds;
    LAS int* stot = sbase + 8;
    LAS int* spst = stot + 8;
    LAS int* sexp = spst + 16;
    LAS int* sslot = sexp + 128;
    const unsigned* cntb = (const unsigned*)(p.ws + WS_ROUTE) + 16384 * 6;
    const int* tok_e = (const int*)(p.ws + WS_ROUTE); int* tok_slot = (int*)(p.ws + WS_ROUTE) + 16384 * 4;
    __syncthreads();
    { const int e = tid >> 6, l = tid & 63; int tot = 0, below = 0;
      for (int b = l; b < G; b += 64) { const int c = (int)cntb[b * NEXP + e]; tot += c; if (b < bid) below += c; }
#pragma unroll
      for (int o = 1; o < 64; o <<= 1) { tot += __shfl_xor(tot, o); below += __shfl_xor(below, o); }
      if (l == 0) { sbase[e] = below; stot[e] = tot; } }
    if (tid < 128) { const int li = tid >> 1, w = li & 7, k = li >> 3, tok = (bid * 8 + w) + k * (G * 8); sexp[tid] = tok < NLAT ? tok_e[tok * 2 + (tid & 1)] : -1; }
    __syncthreads();
    if (tid == 0) { int t = 0; for (int e = 0; e < NEXP; ++e) { spst[e] = t * 256; t += (stot[e] + 255) >> 8; } spst[NEXP] = t * 256;
        if (bid == 0) { unsigned* ctl = (unsigned*)(p.ws + WS_CTL); for (int e = 0; e < NEXP; ++e) ctl[CW_CNT + e] = (unsigned)stot[e]; } }
    __syncthreads();
    if (tid < 128) { const int e = sexp[tid]; int slot = -1;
        if (e >= 0) { int rank = 0; for (int a = 0; a < tid; ++a) rank += (sexp[a] == e) ? 1 : 0; slot = spst[e] + sbase[e] + rank;
            const int li = tid >> 1, w = li & 7, k = li >> 3, tok = (bid * 8 + w) + k * (G * 8); tok_slot[tok * 2 + (tid & 1)] = slot; }
        sslot[tid] = slot; }
    __syncthreads();
    const int lane = tid & 63, wv = tid >> 6; const unsigned char* A8 = p.ws + WS_A8; unsigned char* FS8 = p.ws + WS_FS;
    for (int a = wv; a < 128; a += 8) { const int slot = sslot[a]; if (slot < 0) continue; const int li = a >> 1, w = li & 7, k = li >> 3, tok = (bid * 8 + w) + k * (G * 8);
        *(u32x4*)(FS8 + (size_t)slot * D + lane * 16) = *(const u32x4*)(A8 + (size_t)tok * D + lane * 16); }
    { int idx = 0;
      for (int e = 0; e < NEXP; ++e) { const int lo_ = spst[e] + stot[e], hi_ = spst[e + 1];
          for (int r = lo_ + ((bid * 8 + wv - idx) % (G * 8) + (G * 8)) % (G * 8); r < hi_; r += G * 8) {
              *(u32x4*)(FS8 + (size_t)r * D + lane * 16) = (u32x4){0u, 0u, 0u, 0u}; }
          idx += hi_ - lo_; } }
    __syncthreads();
}
__device__ __forceinline__ void ph_moe1(const P& p, LAS unsigned char* lds) {
    LAS int* tile_e = (LAS int*)(lds + fg::STAGE_BYTES); const int nt = moe_tiles(p, tile_e);
    fg::ExpertSched S{(const char*)(p.ws + WS_FS), (const char*)(p.ws + WS_MOE1), D / 2, D / 2, nt, 22, (int)gridDim.x, (int)blockIdx.x, D / 128, tile_e, (size_t)5632 * D};
    fg::EpiSwiglu8 E{p.ws + WS_HMOE};
    fg::gemm_phase<fg::EpiSwiglu8, fg::ExpertSched, true>(lds, D / 2, D / 2, S, E);
}
__device__ __forceinline__ void ph_moe2(const P& p, LAS unsigned char* lds) {
    LAS int* tile_e = (LAS int*)(lds + fg::STAGE_BYTES); const int nt = moe_tiles(p, tile_e);
    const int nbig = nt < 128 ? nt : 128;
    fg::ExpertSched S{(const char*)(p.ws + WS_HMOE), (const char*)(p.ws + WS_MOE2), FFN / 2, FFN / 2, nbig, 4, (int)gridDim.x, (int)blockIdx.x, FFN / 128, tile_e, (size_t)D * FFN};
    fg::EpiStore E{(bf16*)(p.ws + WS_Y2), D};
    fg::gemm_phase<fg::EpiStore, fg::ExpertSched, true>(lds, FFN / 2, FFN / 2, S, E);
    const unsigned char* A = p.ws + WS_HMOE; bf16* Y = (bf16*)(p.ws + WS_Y2);
    for (int it = blockIdx.x; it < (nt - nbig) * 64; it += gridDim.x) {
        const int rt = nbig + (it >> 6), r0 = rt * 256 + ((it >> 4) & 3) * 64, c0 = (it & 15) * 64;
        const unsigned char* B = p.ws + WS_MOE2 + (size_t)tile_e[rt] * D * FFN;
        float o[8]; sk::tile64_f8(lds, A + (size_t)r0 * FFN, FFN, B + (size_t)c0 * FFN, FFN, FFN, o);
#pragma unroll
        for (int q = 0; q < 8; ++q) { int rr, cc; sk::elem_rc(threadIdx.x, q, rr, cc); Y[(size_t)(r0 + rr) * D + c0 + cc] = f2bf(o[q]); } }
    __syncthreads();
}
__device__ __forceinline__ void ph_combine(const P& p, int layer) {
    const int lane = threadIdx.x & 63, gw = blockIdx.x * 8 + (threadIdx.x >> 6), ngw = gridDim.x * 8;
    const float* tok_w = (const float*)(p.ws + WS_ROUTE) + 16384 * 2; const int* tok_slot = (const int*)(p.ws + WS_ROUTE) + 16384 * 4; const bf16* Y = (const bf16*)(p.ws + WS_Y2);
    for (int r = gw; r < NLAT; r += ngw) {
        const int s0 = tok_slot[r * 2], s1 = tok_slot[r * 2 + 1]; const float w0 = tok_w[r * 2], w1 = tok_w[r * 2 + 1];
        const float* g = mods(p, layer, row_mi(r), 5); float* h = p.out + (size_t)r * D;
#pragma unroll
        for (int j = 0; j < 4; ++j) { const int c = 4 * lane + 256 * j;
            const u32x2 a = *(const u32x2*)(Y + (size_t)s0 * D + c), bq = *(const u32x2*)(Y + (size_t)s1 * D + c); const f32x4 gg = *(const f32x4*)(g + c); f32x4 hv = *(f32x4*)(h + c);
            hv.x += gg.x * (w0 * __uint_as_float(a.x << 16) + w1 * __uint_as_float(bq.x << 16)); hv.y += gg.y * (w0 * __uint_as_float(a.x & 0xffff0000u) + w1 * __uint_as_float(bq.x & 0xffff0000u));
            hv.z += gg.z * (w0 * __uint_as_float(a.y << 16) + w1 * __uint_as_float(bq.y << 16)); hv.w += gg.w * (w0 * __uint_as_float(a.y & 0xffff0000u) + w1 * __uint_as_float(bq.y & 0xffff0000u));
            *(f32x4*)(h + c) = hv; }
    }
}

#define XB_TMO      128
static_assert(CW_TMO == CW_BAR + XB_TMO, "tmo word");
#define XB_XCNT(j)  (256  + 64 * (j))
#define XB_XSUB(j)  (1280 + 64 * (j))
#define XB_XGEN(j)  (2304 + 64 * (j))
#define XB_TOP      3328
#define XB_TOPGEN   3392
#define XCD_BAR_WORDS 3456
#define XB_SPIN_CAP (1u << 22)
__device__ __forceinline__ unsigned xb_ld(unsigned* p)              { return __hip_atomic_load(p, __ATOMIC_RELAXED, __HIP_MEMORY_SCOPE_AGENT); }
__device__ __forceinline__ unsigned xb_add(unsigned* p, unsigned v) { return __hip_atomic_fetch_add(p, v, __ATOMIC_RELAXED, __HIP_MEMORY_SCOPE_AGENT); }
__device__ __forceinline__ unsigned xb_xcc_id() { return (unsigned)__builtin_amdgcn_s_getreg((3 << 11) | 20) & 0xFu; }
#define XB_SPIN(cond, bar) do { unsigned _sp = 0; while (cond) { __builtin_amdgcn_s_sleep(1); \
    if ((++_sp & 255u) == 0u) { if (xb_ld(&(bar)[XB_TMO])) break; if (_sp > XB_SPIN_CAP) { atomicAdd(&(bar)[XB_TMO], 1u); break; } } } } while (0)
struct XcdBarrier { unsigned* bar; unsigned x; volatile LAS unsigned* st; };
__device__ __forceinline__ XcdBarrier xcd_barrier_post(unsigned* bar, volatile LAS unsigned* st) {
    XcdBarrier b; b.bar = bar; b.x = xb_xcc_id(); b.st = st;
    if (threadIdx.x == 0) (void)xb_add(&bar[XB_XCNT(b.x)], 1u);
    return b;
}
__device__ __forceinline__ void xcd_barrier_complete(unsigned* bar, unsigned x, unsigned& nloc, unsigned& nx) {
    const unsigned G = gridDim.x * gridDim.y * gridDim.z;
    unsigned sum, cnt, mine, sp = 0u;
    for (;;) {
        sum = 0u; cnt = 0u; mine = 0u;
#pragma unroll
        for (unsigned j = 0; j < 16; ++j) { const unsigned c = xb_ld(&bar[XB_XCNT(j)]); sum += c; cnt += (c > 0u) ? 1u : 0u; mine = (j == x) ? c : mine; }
        if (sum == G) break;
        __builtin_amdgcn_s_sleep(1);
        if ((++sp & 255u) == 0u) { if (xb_ld(&bar[XB_TMO])) break; if (sp > XB_SPIN_CAP) { atomicAdd(&bar[XB_TMO], 1u); break; } }
    }
    nloc = mine > 0u ? mine : 1u; nx = cnt > 0u ? cnt : 1u;
}
__device__ __forceinline__ void xcd_barrier(const XcdBarrier& b) {
    asm volatile("s_waitcnt vmcnt(0)" ::: "memory");
    __syncthreads();
    if (threadIdx.x == 0) {
        unsigned* bar = b.bar;
        __builtin_amdgcn_s_waitcnt(0);
        unsigned nloc = b.st[0], nx = b.st[1];
        if (nloc == 0u) { xcd_barrier_complete(bar, b.x, nloc, nx); b.st[0] = nloc; b.st[1] = nx; }
        const unsigned old = xb_add(&bar[XB_XSUB(b.x)], 1u);
        const unsigned gen = old / nloc;
        if (old + 1u == (gen + 1u) * nloc) {
            __builtin_amdgcn_fence(__ATOMIC_RELEASE, "agent");
            asm volatile("s_waitcnt vmcnt(0)" ::: "memory");
            const unsigned og = xb_add(&bar[XB_TOP], 1u);
            const unsigned tg = og / nx;
            if (og + 1u == (tg + 1u) * nx) xb_add(&bar[XB_TOPGEN], 1u);
            else XB_SPIN(xb_ld(&bar[XB_TOPGEN]) == tg, bar);
            __builtin_amdgcn_fence(__ATOMIC_ACQUIRE, "agent");
            xb_add(&bar[XB_XGEN(b.x)], 1u);
            asm volatile("s_waitcnt vmcnt(0)" ::: "memory");
        } else {
            XB_SPIN(xb_ld(&bar[XB_XGEN(b.x)]) == gen, bar);
            __builtin_amdgcn_fence(__ATOMIC_ACQUIRE, "agent");
            asm volatile("s_waitcnt vmcnt(0)" ::: "memory");
        }
    }
    __syncthreads();
}

constexpr int NPHASE = 23;
constexpr int LDS_BYTES = 150 * 1024;
__global__ void __launch_bounds__(NTHREADS, 2) mk(P p, int lo, int hi, int fuse) {
    extern __shared__ __attribute__((aligned(16))) unsigned char lds_raw[];
    LAS unsigned char* lds = (LAS unsigned char*)lds_raw;
    volatile LAS unsigned* misc = (volatile LAS unsigned*)(lds + LDS_BYTES - 64);
    if (threadIdx.x < 16) misc[threadIdx.x] = 0u;
    __syncthreads();
    XcdBarrier bar; bar.bar = (unsigned*)(p.ws + WS_CTL) + CW_BAR; bar.x = 0; bar.st = misc;
    if (hi - lo > 1) bar = xcd_barrier_post((unsigned*)(p.ws + WS_CTL) + CW_BAR, misc);
#if MK_SINGLE
    cg::this_grid().sync();
#endif
#ifndef PROBE_MASK
#define PROBE_MASK 0u
#endif
#ifndef AMP_A
#define AMP_A (-1)
#define AMP_B (-1)
#define AMP_MUL 15
#endif
#define AMP(k) do { if ((k) == AMP_A && blockIdx.x == 0 && threadIdx.x == 0) { const unsigned long long t = __builtin_amdgcn_s_memrealtime(); misc[8] = (unsigned)t; } \
    if ((k) == AMP_B && blockIdx.x == 0 && threadIdx.x == 0) { const unsigned t1 = (unsigned)__builtin_amdgcn_s_memrealtime(), dt = (t1 - misc[8]) * AMP_MUL; while ((unsigned)__builtin_amdgcn_s_memrealtime() - t1 < dt) __builtin_amdgcn_s_sleep(8); } } while (0)
#define PH(k, body) do { if (lo <= (k) && (k) < hi) { if ((k) > lo) { xcd_barrier(bar); } AMP(k); body; \
    if ((PROBE_MASK >> (k)) & 1u) { xcd_barrier(bar); body; } } } while (0)
#define LAYER_PHASES(L, base) \
    PH(base + 0, ph_win(p, lds, L)); \
    PH(base + 1, ph_mix1(p, lds, L)); \
    PH(base + 2, ph_mix2(p, lds, lds_raw, L)); \
    PH(base + 3, ph_mix3(p, lds, L, fuse != 0)); \
    PH(base + 4, { if (L == 0 && fuse) ctx_ret_items(p, lds); ph_merge(p, lds, L, NLAT); if (L == 0) { if (fuse && (int)(gridDim.x - 1 - blockIdx.x) < (NCTX / 64) * 16) ctx_ret_wait(p); mini_merge_ctx(p, lds, L); } }); \
    PH(base + 5, { if (L == 0 && fuse) { ph_gemm_resid_norm(p, lds, 0, (const bf16*)(p.ws + WS_MERGED), 1024, (const bf16*)(p.ws + WS_WOUT), D, 2, 0, 0, 1, p.in[0]); mini_resid_ctx(p, lds, 0, (const bf16*)(p.ws + WS_MERGED), 1024, (const bf16*)(p.ws + WS_WOUT), D, 2, 0, 0, 1, p.in[2]); } \
        else { ph_gemm_resid(p, lds, L, (const bf16*)(p.ws + WS_MERGED), 1024, (const bf16*)(p.ws + WS_WOUT) + (size_t)L * D * D, D, 2, NLAT); if (L == 0) mini_resid_ctx(p, lds, L, (const bf16*)(p.ws + WS_MERGED), 1024, (const bf16*)(p.ws + WS_WOUT), D, 2); } });
    PH(0, ph_prologue(p, lds));
    PH(1, ph_norm(p, lds, 0, 0, true, false, MROWS, !fuse));
    LAYER_PHASES(0, 2)
    if (!fuse) PH(8, ph_norm(p, lds, 0, 1, false, false, MROWS));
    PH(9, ph_ffn1(p, lds));
    PH(10, { if (fuse) { ph_gemm_resid_norm(p, lds, 0, (const bf16*)(p.ws + WS_HMID), FFN, (const bf16*)(p.ws + WS_FFN2), FFN, 5, 1, 1, 0, p.out); mini_resid_ctx(p, lds, 0, (const bf16*)(p.ws + WS_HMID), FFN, (const bf16*)(p.ws + WS_FFN2), FFN, 5, 1, 1, 0); }
        else { ph_gemm_resid(p, lds, 0, (const bf16*)(p.ws + WS_HMID), FFN, (const bf16*)(p.ws + WS_FFN2), FFN, 5, NLAT); mini_resid_ctx(p, lds, 0, (const bf16*)(p.ws + WS_HMID), FFN, (const bf16*)(p.ws + WS_FFN2), FFN, 5); } });
    if (!fuse) PH(11, ph_norm(p, lds, 1, 0, false, false, MROWS));
    LAYER_PHASES(1, 12)
    PH(18, ph_norm(p, lds, 1, 1, false, true, NLAT));
    PH(19, { ph_assign_gather(p, lds); ph_moe_convert(p, lds); });
    PH(20, ph_moe1(p, lds));
    PH(21, ph_moe2(p, lds));
    PH(22, ph_combine(p, 1));
#undef PH
#undef LAYER_PHASES
}

extern "C" void kernel_launch(void* const* d_in, const int* in_sizes, int n_in, void* d_out, int out_size, void* d_ws, size_t ws_size, hipStream_t stream) {
    static int grid = 0;
    if (grid == 0) {
        if (n_in != 30 || out_size != NLAT * D || ws_size < WS_END) { fprintf(stderr, "kernel_launch: unexpected shapes (n_in %d out %d ws %zu)\n", n_in, out_size, ws_size); grid = -1; return; }
        int dev = 0, cus = 0, per_cu = 0;
        hipGetDevice(&dev); hipDeviceGetAttribute(&cus, hipDeviceAttributeMultiprocessorCount, dev);
        hipFuncSetAttribute((const void*)mk, hipFuncAttributeMaxDynamicSharedMemorySize, LDS_BYTES);
        hipOccupancyMaxActiveBlocksPerMultiprocessor(&per_cu, (const void*)mk, NTHREADS, LDS_BYTES);
        if (per_cu < 1) { fprintf(stderr, "kernel_launch: occupancy query says %d blocks per CU\n", per_cu); grid = -1; return; }
        grid = cus;
    }
    if (grid < 0) return;
    hipMemsetAsync((char*)d_ws + WS_CTL, 0, CTL_BYTES, stream);
    P p{};
    for (int i = 0; i < 30; ++i) p.in[i] = (const float*)d_in[i];
    p.out = (float*)d_out; p.ws = (unsigned char*)d_ws;
#if MK_SINGLE
    int lo = 0, hi = NPHASE, fuse = grid == 256 ? 1 : 0; void* args[] = {&p, &lo, &hi, &fuse};
    hipLaunchCooperativeKernel((const void*)mk, dim3(grid), dim3(NTHREADS), args, LDS_BYTES, stream);
#else
    for (int ph = 0; ph < NPHASE; ++ph) hipLaunchKernelGGL(mk, dim3(grid), dim3(NTHREADS), LDS_BYTES, stream, p, ph, ph + 1, 0);
#endif
}
```

```cpp
#include <hip/hip_runtime.h>
#include <hip/hip_cooperative_groups.h>
#include <cstdio>
#include <cstdint>
namespace cg = cooperative_groups;

#ifndef MK_SINGLE
#define MK_SINGLE 1
#endif

typedef unsigned short bf16;
typedef float f32x4 __attribute__((ext_vector_type(4)));
typedef unsigned u32x4 __attribute__((ext_vector_type(4)));
typedef unsigned u32x2 __attribute__((ext_vector_type(2)));
#define LAS __attribute__((address_space(3)))

constexpr int D = 1024, NB = 2, SEQ = 8192, CTX = 256, NLAT = NB * SEQ, NCTX = NB * CTX, MROWS = NLAT + NCTX;
constexpr int INC = 6656, FFN = 2816, NEXP = 8, KEYS = CTX + SEQ;
constexpr int NCHUNK = 66;
constexpr float EPS = 1e-6f;
constexpr float QSCALE = 0.125f * 1.4426950408889634f;
constexpr int MOE_ROWS = 34816;
constexpr int NTHREADS = 512;

constexpr size_t MiB = 1u << 20;
constexpr size_t WS_CTL = 0, CTL_BYTES = 1 * MiB;
constexpr size_t WS_MODS = 1 * MiB;
constexpr size_t WS_ROPE = 2 * MiB;
constexpr size_t WS_F1 = 4 * MiB;
constexpr size_t WS_F2 = WS_F1 + 131072;
constexpr size_t WS_FC = WS_F2 + 131072;
constexpr size_t WS_TW = WS_FC + 262144;
constexpr size_t WS_ROUTE = 5 * MiB;
constexpr size_t WS_HCTX = 6 * MiB;
constexpr size_t WS_WIN = 8 * MiB;
constexpr size_t WS_WB = 34 * MiB;
constexpr size_t WS_WOUT = 40 * MiB;
constexpr size_t WS_FFN1 = 44 * MiB;
constexpr size_t WS_FFN2 = 55 * MiB;
constexpr size_t WS_A = 61 * MiB;
constexpr size_t WS_X = 94 * MiB;
constexpr size_t WS_Y = 144 * MiB;
constexpr size_t WS_RETQ = WS_Y;
constexpr size_t WS_RETK = WS_RETQ + (size_t)MROWS * 256 * 2;
constexpr size_t WS_RETV = WS_RETK + (size_t)MROWS * 256 * 2;
constexpr size_t WS_RETG = WS_RETV + (size_t)MROWS * 256 * 2;
constexpr size_t WS_ATTQ = WS_Y + 33 * MiB;
constexpr size_t WS_ATTK = WS_Y + 50 * MiB;
constexpr size_t WS_ATTV = WS_Y + 55 * MiB;
constexpr size_t WS_CONV = WS_Y + 60 * MiB;
constexpr size_t WS_UT = WS_Y + 77 * MiB;
constexpr size_t WS_UTC = WS_Y + 93 * MiB;
constexpr size_t WS_Z = WS_Y + 94 * MiB;
constexpr size_t WS_RETS = WS_Y + 126 * MiB;
constexpr size_t WS_MERGED = WS_Y + 143 * MiB;
constexpr size_t WS_G = 320 * MiB;
constexpr size_t WS_MOE1 = WS_G;
constexpr size_t WS_MOE2 = WS_G + (size_t)NEXP * 5632 * 1024 * 2;
constexpr size_t WS_HMID = WS_Y;
constexpr size_t WS_HMOE = 61 * MiB;
constexpr size_t WS_FS = 252 * MiB;
constexpr size_t WS_A8 = 386 * MiB;
constexpr size_t WS_WIN8 = 430 * MiB;
constexpr size_t WS_RETS2 = 452 * MiB;
constexpr size_t WS_Y2 = 160 * MiB;
constexpr size_t WS_END = 469 * MiB;
static_assert(WS_MERGED + (size_t)MROWS * 1024 * 2 <= WS_G, "map");
static_assert(WS_HMOE + (size_t)MOE_ROWS * FFN * 2 <= WS_FS && WS_FS + (size_t)MOE_ROWS * 1024 * 2 <= WS_G, "map moe");
static_assert(WS_MOE2 + (size_t)NEXP * 1024 * FFN * 2 <= WS_END, "map moe w");
static_assert(WS_G + (size_t)MROWS * 4096 <= WS_A8 && WS_A8 + (size_t)NLAT * 1024 <= WS_MOE2 && WS_MOE2 + (size_t)NEXP * 1024 * FFN <= WS_WIN8 && WS_WIN8 + (size_t)2 * 4096 * 1024 <= WS_RETS2, "map fp8 w_in");
constexpr int CW_CNT = 64;
constexpr int CW_CUR = 128;
constexpr int CW_BAR = 4096;
constexpr int CW_TMO = CW_BAR + 128;
constexpr int CW_PCNT = 8192;
constexpr int CW_CCNT = 8192 + 4 * 64 * 16;
constexpr size_t CTL_XBUF = 128 * 1024;

struct P {
    const float* in[30];
    float* out;
    unsigned char* ws;
};

__device__ __forceinline__ float bf2f(bf16 v) { return __uint_as_float((unsigned)v << 16); }
__device__ __forceinline__ bf16 f2bf(float f) { unsigned u = __float_as_uint(f); return (bf16)((u + 0x7fffu + ((u >> 16) & 1u)) >> 16); }
__device__ __forceinline__ unsigned pk2(float lo, float hi) { return (unsigned)f2bf(lo) | ((unsigned)f2bf(hi) << 16); }
__device__ __forceinline__ float sigmoidf_(float x) { return 1.f / (1.f + __expf(-x)); }
__device__ __forceinline__ float siluf_(float x) { return x / (1.f + __expf(-x)); }
__device__ __forceinline__ float sigmoid_fast(float x) { return __builtin_amdgcn_rcpf(1.f + __builtin_amdgcn_exp2f(-1.4426950408889634f * x)); }
__device__ __forceinline__ float silu_fast(float x) { return x * __builtin_amdgcn_rcpf(1.f + __builtin_amdgcn_exp2f(-1.4426950408889634f * x)); }
__device__ __forceinline__ float wave_sum(float v) {
#pragma unroll
    for (int o = 1; o < 64; o <<= 1) v += __shfl_xor(v, o);
    return v;
}
__device__ __forceinline__ int row_mi(int r) { return r < NLAT ? (r >> 13) : 2; }
__device__ __forceinline__ float* hrow(const P& p, int r) { return r < NLAT ? p.out + (size_t)r * D : (float*)(p.ws + WS_HCTX) + (size_t)(r - NLAT) * D; }
__device__ __forceinline__ const float* mods(const P& p, int layer, int mi, int chunk) { return (const float*)(p.ws + WS_MODS) + ((size_t)(layer * 3 + mi) * 6 + chunk) * D; }

__device__ __forceinline__ int rowmap(int mode, int n) {
    if (mode == 0) return n;
    if (mode == 1 || mode == 2) return 8 * (n >> 2) + (n & 3) + (mode == 2 ? 4 : 0);
    const int tile = n >> 8, l = n & 255, head = l >> 6, d = l & 63;
    const bool ropet = tile == 1 || tile == 2 || tile == 5 || tile == 6 || (tile == 7 && head < 2);
    if (ropet) { const int i = d & 31, nn = d >> 5; return tile * 256 + 128 * (i >> 4) + 32 * head + 8 * ((i >> 2) & 3) + 4 * nn + (i & 3); }
    if (tile == 7) return tile * 256 + 128 * (d >> 5) + 32 * head + 8 * ((d >> 3) & 3) + (d & 7);
    return n;
}
__device__ __forceinline__ void conv_tile(LAS float* scr, const float* src, int ldn, int k0, int n0, bf16* dst, int ldd, int koff, int mode) {
    const int tid = threadIdx.x;
    __syncthreads();
#pragma unroll
    for (int i = 0; i < 8; ++i) { const int e = tid + i * NTHREADS, kk = e >> 6, nn = e & 63; scr[kk * 65 + nn] = src[(size_t)(k0 + kk) * ldn + n0 + nn]; }
    __syncthreads();
    const int nn = tid >> 3, kc = (tid & 7) * 8;
    u32x4 o; o.x = pk2(scr[(kc + 0) * 65 + nn], scr[(kc + 1) * 65 + nn]); o.y = pk2(scr[(kc + 2) * 65 + nn], scr[(kc + 3) * 65 + nn]);
    o.z = pk2(scr[(kc + 4) * 65 + nn], scr[(kc + 5) * 65 + nn]); o.w = pk2(scr[(kc + 6) * 65 + nn], scr[(kc + 7) * 65 + nn]);
    *(u32x4*)(dst + (size_t)rowmap(mode, n0 + nn) * ldd + koff + k0 + kc) = o;
}
constexpr float F8_WSCALE = 32.f;
__device__ __forceinline__ unsigned pk4_fp8(float a, float b, float c, float d) { int w = 0; w = __builtin_amdgcn_cvt_pk_fp8_f32(a, b, w, false); w = __builtin_amdgcn_cvt_pk_fp8_f32(c, d, w, true); return (unsigned)w; }
__device__ __forceinline__ void conv_tile2_f8(LAS float* scr, const float* src, int ldn, unsigned char* dst8, int ldd, int mode, int k0a, int n0a, int k0b, int n0b, bool two) {
    const int tid = threadIdx.x;
    f32x4 va[2], vb[2];
#pragma unroll
    for (int i = 0; i < 2; ++i) { const int e = tid + i * NTHREADS, kk = e >> 4, n4 = (e & 15) * 4;
        va[i] = *(const f32x4*)(src + (size_t)(k0a + kk) * ldn + n0a + n4);
        if (two) vb[i] = *(const f32x4*)(src + (size_t)(k0b + kk) * ldn + n0b + n4); }
    __syncthreads();
#pragma unroll
    for (int i = 0; i < 2; ++i) { const int e = tid + i * NTHREADS, kk = e >> 4, n4 = (e & 15) * 4;
#pragma unroll
        for (int q = 0; q < 4; ++q) { scr[kk * 65 + n4 + q] = va[i][q]; if (two) scr[64 * 65 + kk * 65 + n4 + q] = vb[i][q]; } }
    __syncthreads();
    const int nn = tid >> 3, kc = (tid & 7) * 8;
#pragma unroll
    for (int t = 0; t < 2; ++t) { if (t == 1 && !two) break; const LAS float* sp = scr + t * 64 * 65; const int k0 = t ? k0b : k0a, n0 = t ? n0b : n0a;
        u32x2 o; o.x = pk4_fp8(sp[(kc + 0) * 65 + nn] * F8_WSCALE, sp[(kc + 1) * 65 + nn] * F8_WSCALE, sp[(kc + 2) * 65 + nn] * F8_WSCALE, sp[(kc + 3) * 65 + nn] * F8_WSCALE);
        o.y = pk4_fp8(sp[(kc + 4) * 65 + nn] * F8_WSCALE, sp[(kc + 5) * 65 + nn] * F8_WSCALE, sp[(kc + 6) * 65 + nn] * F8_WSCALE, sp[(kc + 7) * 65 + nn] * F8_WSCALE);
        *(u32x2*)(dst8 + (size_t)rowmap(mode, n0 + nn) * ldd + k0 + kc) = o; }
}
__device__ __forceinline__ void conv_tile128_f8(LAS float* scr, const float* src, int ldn, unsigned char* dst8, int ldd, int mode, int k0, int n0) {
    const int tid = threadIdx.x;
    f32x4 v[8];
#pragma unroll
    for (int i = 0; i < 8; ++i) { const int e = tid + i * NTHREADS, kk = e >> 5, n4 = (e & 31) * 4; v[i] = *(const f32x4*)(src + (size_t)(k0 + kk) * ldn + n0 + n4); }
    __syncthreads();
#pragma unroll
    for (int i = 0; i < 8; ++i) { const int e = tid + i * NTHREADS, kk = e >> 5, n4 = (e & 31) * 4;
#pragma unroll
        for (int q = 0; q < 4; ++q) scr[kk * 129 + n4 + q] = v[i][q]; }
    __syncthreads();
    const int nn = tid >> 2, kc = (tid & 3) * 32;
    u32x4 o[2];
#pragma unroll
    for (int h = 0; h < 2; ++h) { const LAS float* sp = scr + (kc + h * 16) * 129 + nn;
        o[h].x = pk4_fp8(sp[0] * F8_WSCALE, sp[129] * F8_WSCALE, sp[2 * 129] * F8_WSCALE, sp[3 * 129] * F8_WSCALE);
        o[h].y = pk4_fp8(sp[4 * 129] * F8_WSCALE, sp[5 * 129] * F8_WSCALE, sp[6 * 129] * F8_WSCALE, sp[7 * 129] * F8_WSCALE);
        o[h].z = pk4_fp8(sp[8 * 129] * F8_WSCALE, sp[9 * 129] * F8_WSCALE, sp[10 * 129] * F8_WSCALE, sp[11 * 129] * F8_WSCALE);
        o[h].w = pk4_fp8(sp[12 * 129] * F8_WSCALE, sp[13 * 129] * F8_WSCALE, sp[14 * 129] * F8_WSCALE, sp[15 * 129] * F8_WSCALE); }
    unsigned char* d = dst8 + (size_t)rowmap(mode, n0 + nn) * ldd + k0 + kc;
    *(u32x4*)d = o[0]; *(u32x4*)(d + 16) = o[1];
}
struct CJob { const float* src; int K, N; bf16* dst; int ldd, koff, mode, ldn; };
__device__ __forceinline__ CJob get_job(const P& p, int j) {
    CJob c;
    if (j < 10) { const int l = j / 5, t = j % 5; bf16* wb = (bf16*)(p.ws + WS_WB) + (size_t)l * 1024 * 1536;
        if (t == 0) c = CJob{p.in[8] + (size_t)l * D * INC, D, l == 0 ? INC : 2560, (bf16*)(p.ws + WS_WIN) + (size_t)l * INC * D, D, 0, 3, INC};
        else if (t == 1) c = CJob{p.in[13] + (size_t)l * 256 * D, 256, D, wb, 1536, 512, 0};
        else if (t == 2) c = CJob{p.in[16] + (size_t)l * 512 * D, 512, D, wb, 1536, 768, 0};
        else if (t == 3) c = CJob{p.in[21] + (size_t)l * 256 * D, 256, D, wb, 1536, 1280, 0};
        else c = CJob{p.in[22] + (size_t)l * D * D, D, D, (bf16*)(p.ws + WS_WOUT) + (size_t)l * D * D, D, 0, 0}; }
    else if (j == 10) c = CJob{p.in[23], D, FFN, (bf16*)(p.ws + WS_FFN1), D, 0, 1};
    else if (j == 11) c = CJob{p.in[24], D, FFN, (bf16*)(p.ws + WS_FFN1), D, 0, 2};
    else c = CJob{p.in[25], FFN, D, (bf16*)(p.ws + WS_FFN2), FFN, 0, 0};
    return c;
}
__device__ __forceinline__ CJob get_moe_job(const P& p, int j) {
    const int e = j / 3, t = j % 3; CJob c;
    const float* sg = p.in[27]; const float* su = p.in[28]; const float* sd = p.in[29];
    asm volatile("" : "+s"(sg), "+s"(su), "+s"(sd));
    if (t == 0) c = CJob{sg + (size_t)e * D * FFN, D, FFN, (bf16*)(p.ws + WS_MOE1 + (size_t)e * 5632 * D), D, 0, 1};
    else if (t == 1) c = CJob{su + (size_t)e * D * FFN, D, FFN, (bf16*)(p.ws + WS_MOE1 + (size_t)e * 5632 * D), D, 0, 2};
    else c = CJob{sd + (size_t)e * FFN * D, FFN, D, (bf16*)(p.ws + WS_MOE2 + (size_t)e * D * FFN), FFN, 0, 0};
    return c;
}
template <bool MOE> __device__ __forceinline__ void run_conv_jobs(const P& p, LAS float* scr, int njobs, int bid, int nb) {
    int base = 0, base2 = 0;
    for (int j = 0; j < njobs; ++j) {
        const CJob jb = MOE ? get_moe_job(p, j) : get_job(p, j); const int nn = jb.N / 64, cnt = (jb.K / 64) * nn, ldn = jb.ldn ? jb.ldn : jb.N;
        const int first = ((bid - base) % nb + nb) % nb;
        if (MOE) { const int nn2 = jb.N / 128, cnt2 = (jb.K / 128) * nn2; const int first2 = ((bid - base2) % nb + nb) % nb;
            for (int i = first2; i < cnt2; i += nb) conv_tile128_f8(scr, jb.src, jb.N, (unsigned char*)jb.dst, jb.ldd, jb.mode, (i / nn2) * 128, (i % nn2) * 128);
            base2 += cnt2; }
        else for (int i = first; i < cnt; i += nb) conv_tile(scr, jb.src, ldn, (i / nn) * 64, (i % nn) * 64, jb.dst, jb.ldd, jb.koff, jb.mode);
        base += cnt;
    }
}
__device__ __forceinline__ void ph_prologue(const P& p, LAS unsigned char* lds) {
    const int tid = threadIdx.x, bid = blockIdx.x, nb = gridDim.x;
    const int gt = bid * NTHREADS + tid, ngt = nb * NTHREADS;
    LAS float* scr = (LAS float*)lds;
    run_conv_jobs<false>(p, scr, 13, bid, nb);
    __syncthreads();
    for (int i = bid; i < 512; i += nb) { const int l = i >> 8, t = i & 255;
        conv_tile128_f8(scr, p.in[8] + (size_t)l * D * INC + 2560, INC, p.ws + WS_WIN8 + (size_t)l * 4096 * 1024, 1024, 0, (t >> 5) * 128, (t & 31) * 128); }
    __syncthreads();
    {
        LAS float* tc = (LAS float*)lds; LAS float* tsn = tc + 64;
        __syncthreads();
        if (tid < 64) { tc[tid] = cospif(tid * (2.f / 64.f)); tsn[tid] = sinpif(tid * (2.f / 64.f)); }
        __syncthreads();
        const float s = 1.0f / sqrtf(64.f * 8192.f);
        for (int e = gt; e < 2 * 512 * 1024; e += ngt) {
            const int n = e & 1023, kk = (e >> 10) & 511, l = e >> 19;
            const int part = kk >> 8, g = (kk >> 6) & 3, c = kk & 63;
            const float* W = p.in[9] + (size_t)l * 256 * D + (size_t)(g * 64) * D + n;
            float acc = 0.f;
#pragma unroll 8
            for (int c2 = 0; c2 < 64; ++c2) { const int m = (c * c2) & 63; const float t = part == 0 ? tc[m] : -tsn[m]; acc += t * W[(size_t)c2 * D]; }
            ((bf16*)(p.ws + WS_WB))[(size_t)l * 1024 * 1536 + (size_t)n * 1536 + kk] = f2bf(acc * s);
        }
        __syncthreads();
    }
    {
        float* rc = (float*)(p.ws + WS_ROPE); float* rs = rc + SEQ * 32;
        for (int e = gt; e < SEQ * 32; e += ngt) {
            const int s = e >> 5, i = e & 31; const float inv = powf(10000.f, -(float)(i & 15) / 16.f);
            const float pos = (float)(i < 16 ? (s >> 6) : (s & 63)); const float ang = pos * inv;
            rc[e] = cosf(ang); rs[e] = sinf(ang);
        }
    }
    {
        bf16* F1 = (bf16*)(p.ws + WS_F1); bf16* F2 = (bf16*)(p.ws + WS_F2); bf16* FC = (bf16*)(p.ws + WS_FC);
        for (int e = gt; e < 256 * 256; e += ngt) {
            const int rho = e >> 8, n1 = e & 255; float v = 0.f;
            if (n1 < 128) { const int k1 = (rho >> 5) * 16 + (rho & 15), c = (rho >> 4) & 1, m = (k1 * n1) & 127; v = c == 0 ? cospif(m * (2.f / 128.f)) : -sinpif(m * (2.f / 128.f)); }
            F1[e] = f2bf(v);
            float w = 0.f;
            if (rho < 128 && n1 < 128) { const int c2 = rho >> 6, k2 = rho & 63, c = n1 >> 6, n2 = n1 & 63, m = (k2 * n2) & 63; const float cs = cospif(m * (2.f / 64.f)), sn = sinpif(m * (2.f / 64.f));
                w = c2 == 0 ? (c == 0 ? cs : sn) : (c == 0 ? sn : -cs); }
            F2[e] = f2bf(w);
        }
        float* TW = (float*)(p.ws + WS_TW);
        for (int e = gt; e < 128 * 64; e += ngt) { const int k1 = e >> 6, n2 = e & 63; TW[2 * e] = cospif((k1 * n2) * (2.f / 8192.f)); TW[2 * e + 1] = sinpif((k1 * n2) * (2.f / 8192.f)); }
        const float sc = sqrtf(32.f);
        for (int e = gt; e < 512 * 256; e += ngt) { const int rho = e >> 8, n = e & 255, c2 = rho >> 8, k = rho & 255, m = (k * n) & 255; FC[e] = f2bf(sc * (c2 == 0 ? cospif(m * (2.f / 256.f)) : sinpif(m * (2.f / 256.f)))); }
    }
    {
        LAS float* sv = (LAS float*)lds;
        LAS float* red = sv + 3 * 1024;
        __syncthreads();
        for (int e = tid; e < 3 * 1024; e += NTHREADS) { const int j = e >> 10, k = e & 1023; const float v = j < 2 ? p.in[1][j * D + k] : p.in[3][k]; sv[e] = siluf_(v); }
        __syncthreads();
        const int kq = tid >> 6, cl = tid & 63;
        for (int it = bid; it < 2 * 96; it += nb) {
            const int l = it / 96, n = (it % 96) * 64 + cl;
            const float* W = p.in[4] + (size_t)l * D * 6144 + n;
            float a0 = 0.f, a1 = 0.f, a2 = 0.f;
#pragma unroll 16
            for (int k = kq; k < D; k += 8) { const float w = W[(size_t)k * 6144]; a0 += sv[k] * w; a1 += sv[1024 + k] * w; a2 += sv[2048 + k] * w; }
            red[(kq * 3 + 0) * 64 + cl] = a0; red[(kq * 3 + 1) * 64 + cl] = a1; red[(kq * 3 + 2) * 64 + cl] = a2;
            __syncthreads();
            if (tid < 192) { const int j = tid >> 6; float s = 0.f;
#pragma unroll
                for (int q = 0; q < 8; ++q) s += red[(q * 3 + j) * 64 + cl];
                ((float*)(p.ws + WS_MODS))[(size_t)(l * 3 + j) * 6144 + n] = s + p.in[5][l * 6144 + n]; }
            __syncthreads();
        }
    }
}
__device__ __forceinline__ void ph_moe_convert(const P& p, LAS unsigned char* lds) {
    LAS float* scr = (LAS float*)lds;
    const int bid = blockIdx.x, nb = gridDim.x;
    run_conv_jobs<true>(p, scr, 24, bid, nb);
    __syncthreads();
}

__device__ __forceinline__ void ph_norm(const P& p, LAS unsigned char* lds, int layer, int which, bool first, bool route, int nrows, bool copy = true) {
    LAS unsigned* cnt_lds = (LAS unsigned*)lds;
    if (route) { __syncthreads(); if (threadIdx.x < NEXP) cnt_lds[threadIdx.x] = 0u; __syncthreads(); }
    const int lane = threadIdx.x & 63, gw = blockIdx.x * 8 + (threadIdx.x >> 6), ngw = gridDim.x * 8;
    const float* gain = p.in[which == 0 ? 6 : 7] + layer * D;
    bf16* A = (bf16*)(p.ws + WS_A);
    for (int r = gw; r < nrows; r += ngw) {
        const int mi = row_mi(r);
        const float* src = first ? (r < NLAT ? p.in[0] + (size_t)r * D : p.in[2] + (size_t)(r - NLAT) * D) : hrow(p, r);
        const float* shift = mods(p, layer, mi, which == 0 ? 0 : 3); const float* scale = mods(p, layer, mi, which == 0 ? 1 : 4);
        f32x4 v[4]; float ss = 0.f;
#pragma unroll
        for (int j = 0; j < 4; ++j) { v[j] = *(const f32x4*)(src + 4 * lane + 256 * j); ss += v[j].x * v[j].x + v[j].y * v[j].y + v[j].z * v[j].z + v[j].w * v[j].w; }
        if (first && copy) { float* h = hrow(p, r);
#pragma unroll
            for (int j = 0; j < 4; ++j) *(f32x4*)(h + 4 * lane + 256 * j) = v[j]; }
        const float rstd = rsqrtf(wave_sum(ss) * (1.f / D) + EPS);
        float lg[8];
#pragma unroll
        for (int e = 0; e < 8; ++e) lg[e] = 0.f;
#pragma unroll
        for (int j = 0; j < 4; ++j) {
            const int c = 4 * lane + 256 * j;
            const f32x4 g = *(const f32x4*)(gain + c), sc = *(const f32x4*)(scale + c), sh = *(const f32x4*)(shift + c);
            f32x4 y = v[j] * rstd * g * (sc + 1.f) + sh;
            u32x2 o; o.x = pk2(y.x, y.y); o.y = pk2(y.z, y.w);
            if (!route) *(u32x2*)(A + (size_t)r * D + c) = o;
            if ((which == 0 || route) && r < NLAT) *(unsigned*)(p.ws + WS_A8 + (size_t)r * D + c) = pk4_fp8(y.x, y.y, y.z, y.w);
            if (route) {
                const float* rw = p.in[26] + (size_t)c * 8;
#pragma unroll
                for (int q = 0; q < 4; ++q) { const f32x4 w0 = *(const f32x4*)(rw + q * 8), w1 = *(const f32x4*)(rw + q * 8 + 4); const float yy = y[q];
                    lg[0] += yy * w0.x; lg[1] += yy * w0.y; lg[2] += yy * w0.z; lg[3] += yy * w0.w; lg[4] += yy * w1.x; lg[5] += yy * w1.y; lg[6] += yy * w1.z; lg[7] += yy * w1.w; }
            }
        }
        if (route) {
#pragma unroll
            for (int e = 0; e < 8; ++e) lg[e] = wave_sum(lg[e]);
            if (lane == 0) {
                int e0 = 0; float v0 = lg[0];
#pragma unroll
                for (int e = 1; e < 8; ++e) if (lg[e] > v0) { v0 = lg[e]; e0 = e; }
                int e1 = -1; float v1 = -INFINITY;
#pragma unroll
                for (int e = 0; e < 8; ++e) if (e != e0 && lg[e] > v1) { v1 = lg[e]; e1 = e; }
                const float w0 = 1.f / (1.f + expf(v1 - v0));
                int* tok_e = (int*)(p.ws + WS_ROUTE); float* tok_w = (float*)(p.ws + WS_ROUTE) + 16384 * 2;
                tok_e[r * 2] = e0; tok_e[r * 2 + 1] = e1; tok_w[r * 2] = w0; tok_w[r * 2 + 1] = 1.f - w0;
                __hip_atomic_fetch_add(cnt_lds + e0, 1u, __ATOMIC_RELAXED, __HIP_MEMORY_SCOPE_WORKGROUP); __hip_atomic_fetch_add(cnt_lds + e1, 1u, __ATOMIC_RELAXED, __HIP_MEMORY_SCOPE_WORKGROUP);
            }
        }
    }
    if (route) { __syncthreads(); if (threadIdx.x < NEXP) ((unsigned*)(p.ws + WS_ROUTE) + 16384 * 6)[blockIdx.x * NEXP + threadIdx.x] = cnt_lds[threadIdx.x]; __syncthreads(); }
}

__device__ __forceinline__ void norm_row(const P& p, int layer, int which, int r, int lane) {
    const float* gain = p.in[which == 0 ? 6 : 7] + layer * D; bf16* A = (bf16*)(p.ws + WS_A);
    const int mi = row_mi(r); const float* src = hrow(p, r);
    const float* shift = mods(p, layer, mi, which == 0 ? 0 : 3); const float* scale = mods(p, layer, mi, which == 0 ? 1 : 4);
    f32x4 v[4]; float ss = 0.f;
#pragma unroll
    for (int j = 0; j < 4; ++j) { v[j] = *(const f32x4*)(src + 4 * lane + 256 * j); ss += v[j].x * v[j].x + v[j].y * v[j].y + v[j].z * v[j].z + v[j].w * v[j].w; }
    const float rstd = rsqrtf(wave_sum(ss) * (1.f / D) + EPS);
#pragma unroll
    for (int j = 0; j < 4; ++j) { const int c = 4 * lane + 256 * j;
        const f32x4 g = *(const f32x4*)(gain + c), sc = *(const f32x4*)(scale + c), sh = *(const f32x4*)(shift + c);
        const f32x4 y = v[j] * rstd * g * (sc + 1.f) + sh;
        u32x2 o; o.x = pk2(y.x, y.y); o.y = pk2(y.z, y.w);
        *(u32x2*)(A + (size_t)r * D + c) = o; }
}

namespace fg {
typedef short bf16x8 __attribute__((ext_vector_type(8)));
constexpr int BM = 256, BK = 64, HALF = 128, HTB = HALF * BK * 2, STAGE_BYTES = 8 * HTB, NXCD = 8, WGM = 8;
__device__ __forceinline__ int lds_byte(int r, int c) { const int st = (r >> 4) * 2 + (c >> 5), rr = r & 15, cc = c & 31, ob = rr * 64 + cc * 2; return st * 1024 + (ob ^ (((ob >> 9) & 1) << 5)); }
__device__ __forceinline__ void stage_rc(int b, int& R, int& C) { const int st = b / 1024, sb = b % 1024, swz = sb ^ (((sb >> 9) & 1) << 5); R = (st >> 1) * 16 + swz / 64; C = (st & 1) * 32 + (swz % 64) / 2; }
__device__ __forceinline__ int perm32(int rho) { const int n = rho >> 4, i = rho & 15; return 8 * (i >> 2) + 4 * n + (i & 3); }
struct Unit { int pm, pn; const char* A; const char* B; int nt, aux; };
__device__ __forceinline__ bool tile_order(int i, int nM, int nN, int G, int c, int& pm, int& pn) {
    const int nwg = nM * nN; const long L = (long)i * G + c; if (L >= nwg) return false;
    int wgid = (int)L; { const int q = nwg / NXCD, r = nwg % NXCD, xcd = wgid % NXCD, off = wgid / NXCD; wgid = (xcd < r ? xcd * (q + 1) : r * (q + 1) + (xcd - r) * q) + off; }
    const int nig = WGM * nN, gid = wgid / nig, fm = gid * WGM, gsz = (nM - fm) < WGM ? (nM - fm) : WGM;
    pm = fm + ((wgid % nig) % gsz); pn = (wgid % nig) / gsz; return true;
}
struct PlainSched {
    const char* Abase; const char* Bbase; int lda, ldb, nM, nN, G, c, nt;
    __device__ __forceinline__ int arow(int R) const { return R; }
    __device__ __forceinline__ int ahalf() const { return HALF; }
    __device__ __forceinline__ bool next(int i, Unit& u) const { if (!tile_order(i, nM, nN, G, c, u.pm, u.pn)) return false;
        u.A = Abase + (size_t)u.pm * BM * lda * 2; u.B = Bbase + (size_t)u.pn * BM * ldb * 2; u.nt = nt; u.aux = 0; return true; }
};
struct ExpertSched {
    const char* Abase; const char* Bbase; int lda, ldb, nM, nN, G, c, nt; const LAS int* tile_e; size_t estride;
    __device__ __forceinline__ int arow(int R) const { return R; }
    __device__ __forceinline__ int ahalf() const { return HALF; }
    __device__ __forceinline__ bool next(int i, Unit& u) const { if (!tile_order(i, nM, nN, G, c, u.pm, u.pn)) return false;
        u.A = Abase + (size_t)u.pm * BM * lda * 2; u.B = Bbase + (size_t)tile_e[u.pm] * estride + (size_t)u.pn * BM * ldb * 2; u.nt = nt; u.aux = 0; return true; }
};
struct WinSched {
    const char* Abase; const char* Bbase; int G, c, mode, nN;
    __device__ __forceinline__ int arow(int R) const { return mode == 0 ? 256 * (R & 15) + 64 * ((R >> 4) & 3) + (R >> 6) : R; }
    __device__ __forceinline__ int ahalf() const { return mode == 0 ? 4096 : HALF; }
    __device__ __forceinline__ bool next(int i, Unit& u) const { if (!tile_order(i, mode == 0 ? 64 : 2, nN, G, c, u.pm, u.pn)) return false;
        const size_t row0 = mode == 0 ? (size_t)((u.pm >> 5) * SEQ + 2 * (u.pm & 31)) : (size_t)(NLAT + u.pm * CTX);
        u.A = Abase + row0 * D * 2; u.B = Bbase + (size_t)u.pn * BM * D * 2; u.nt = D / 64; u.aux = mode; return true; }
};
struct MergeSched {
    const char* Xbase; const char* Wbase; int nM, G, c;
    __device__ __forceinline__ int arow(int R) const { return R; }
    __device__ __forceinline__ int ahalf() const { return HALF; }
    __device__ __forceinline__ bool next(int i, Unit& u) const { if (!tile_order(i >> 2, nM, 4, G, c, u.pm, u.pn)) return false;
        const int br = i & 3, koff = br == 0 ? 0 : (br == 1 ? 512 : (br == 2 ? 768 : 1280));
        u.A = Xbase + ((size_t)u.pm * BM * 1536 + koff) * 2; u.B = Wbase + ((size_t)u.pn * BM * 1536 + koff) * 2; u.nt = (br & 1) ? 4 : 8; u.aux = br; return true; }
};
template <class E, class = void> struct is_chain { static constexpr bool v = false; };
template <class E> struct is_chain<E, decltype((void)E::CHAIN)> { static constexpr bool v = E::CHAIN; };
typedef f32x4 Acc[2][2][4][2];
typedef int i32x4 __attribute__((ext_vector_type(4))); typedef int i32x8 __attribute__((ext_vector_type(8)));
__device__ __forceinline__ i32x8 ld32(const LAS unsigned char* p) { const i32x4 a = *(const LAS i32x4*)p, b = *(const LAS i32x4*)(p + 16); return __builtin_shufflevector(a, b, 0, 1, 2, 3, 4, 5, 6, 7); }
template <class Epi, class Sched, bool F8 = false>
__device__ __forceinline__ void gemm_phase(LAS unsigned char* lds, int lda, int ldb, const Sched& S, const Epi& E) {
    int tid_ = threadIdx.x; asm volatile("" : "+v"(tid_));
    const int tid = tid_, wid = __builtin_amdgcn_readfirstlane(tid >> 6), lane = tid & 63, wr = wid >> 2, wc = wid & 3, fr = lane & 15, fq = lane >> 4;
    unsigned voffA[2], voffB[2];
#pragma unroll
    for (int i = 0; i < 2; ++i) { int R, C; stage_rc(tid * 16 + i * 8192, R, C); const int Rb = Epi::PERM ? ((R & ~31) + perm32(R & 31)) : R;
        voffA[i] = (unsigned)(S.arow(R) * lda + C) * 2u; voffB[i] = (unsigned)(Rb * ldb + C) * 2u; }
    const size_t kstep = (size_t)(BK * 2);
    const size_t hstepA = (size_t)S.ahalf() * lda * 2, hstepB = (size_t)HALF * ldb * 2;
    const unsigned ldsw = (unsigned)wid * 1024u;
    const int aoff = lds_byte(wr * 64 + fr, F8 ? fq * 16 : fq * 8), boff = lds_byte(wc * 32 + fr, F8 ? fq * 16 : fq * 8);
#define FG_SA(b, h) (((b) * 2 + (h)) * HTB)
#define FG_SB(b, h) ((4 + (b) * 2 + (h)) * HTB)
#define FG_STAGE(bufoff, gbase, voff) do { _Pragma("unroll") for (int _i = 0; _i < 2; ++_i) \
        __builtin_amdgcn_global_load_lds((const unsigned*)((const char*)(gbase) + (voff)[_i]), (LAS unsigned*)(lds + (bufoff) + ldsw + _i * 8192), 16, 0, 0); } while (0)
#define FG_LDA(dst, b, h) do { if constexpr (F8) { _Pragma("unroll") for (int m = 0; m < 4; ++m) dst##8[m] = ld32(lds + FG_SA(b, h) + aoff + m * 2048); } \
        else { _Pragma("unroll") for (int m = 0; m < 4; ++m) _Pragma("unroll") for (int k = 0; k < 2; ++k) dst[m][k] = *(const LAS bf16x8*)(lds + FG_SA(b, h) + aoff + m * 2048 + k * 1024); } } while (0)
#define FG_LDB(dst, b, h) do { if constexpr (F8) { _Pragma("unroll") for (int n = 0; n < 2; ++n) dst##8[n] = ld32(lds + FG_SB(b, h) + boff + n * 2048); } \
        else { _Pragma("unroll") for (int n = 0; n < 2; ++n) _Pragma("unroll") for (int k = 0; k < 2; ++k) dst[n][k] = *(const LAS bf16x8*)(lds + FG_SB(b, h) + boff + n * 2048 + k * 1024); } } while (0)
#define FG_MMA(ai, bj, At, Bt) do { __builtin_amdgcn_s_setprio(1); _Pragma("unroll") for (int m = 0; m < 4; ++m) _Pragma("unroll") for (int n = 0; n < 2; ++n) { \
        if constexpr (F8) asm volatile("v_mfma_scale_f32_16x16x128_f8f6f4 %0, %1, %2, %0, %3, %4 op_sel_hi:[0,0,0]" : "+v"(acc[ai][bj][m][n]) : "v"(Bt##8[n]), "v"(At##8[m]), "v"(scw), "v"(sca)); \
        else { _Pragma("unroll") for (int k = 0; k < 2; ++k) acc[ai][bj][m][n] = __builtin_amdgcn_mfma_f32_16x16x32_bf16(Bt[n][k], At[m][k], acc[ai][bj][m][n], 0, 0, 0); } } \
        __builtin_amdgcn_s_setprio(0); } while (0)
#define FG_WAIT_V(n) asm volatile("s_waitcnt vmcnt(" #n ")" ::: "memory")
#define FG_WAIT_L(n) asm volatile("s_waitcnt lgkmcnt(" #n ")" ::: "memory")
#define FG_BAR __builtin_amdgcn_s_barrier()
#define FG_SCHED __builtin_amdgcn_sched_barrier(0)
    Unit cur, nxt; int ui = 0;
    if (!S.next(0, cur)) return;
    Acc acc;
#pragma unroll
    for (int a = 0; a < 2; ++a)
#pragma unroll
        for (int b = 0; b < 2; ++b)
#pragma unroll
            for (int m = 0; m < 4; ++m)
#pragma unroll
                for (int n = 0; n < 2; ++n) acc[a][b][m][n] = (f32x4){0.f, 0.f, 0.f, 0.f};
    bf16x8 At[4][2], B0[2][2], B1[2][2]; i32x8 At8[4], B08[2], B18[2];
    const int scw = 0x7a7a7a7a, sca = 0x7f7f7f7f;
    const char* cA = cur.A; const char* cB = cur.B;
    FG_STAGE(FG_SB(0, 0), cB, voffB); FG_STAGE(FG_SB(0, 1), cB + hstepB, voffB); FG_STAGE(FG_SA(0, 0), cA, voffA); FG_STAGE(FG_SA(0, 1), cA + hstepA, voffA);
    if (wr == 1) FG_BAR;
    FG_WAIT_V(2); FG_BAR;
    FG_STAGE(FG_SB(1, 0), cB + kstep, voffB); FG_STAGE(FG_SA(1, 0), cA + kstep, voffA); FG_STAGE(FG_SB(1, 1), cB + hstepB + kstep, voffB);
    FG_WAIT_V(6); FG_BAR;
    for (;;) {
        const bool has_next = S.next(ui + 1, nxt);
        const char* nA = has_next ? nxt.A : cA; const char* nB = has_next ? nxt.B : cB;
        const int nt = cur.nt;
#pragma unroll 1
        for (int t = 0; t < nt; t += 2) {
            const bool last = (t == nt - 2);
            const char* a1 = cA + (size_t)(t + 1) * kstep;
            const char* a2 = last ? nA : cA + (size_t)(t + 2) * kstep; const char* b2 = last ? nB : cB + (size_t)(t + 2) * kstep;
            const char* a3 = a2 + kstep; const char* b3 = b2 + kstep;
            FG_LDB(B0, 0, 0); FG_LDB(B1, 0, 1); FG_SCHED; FG_LDA(At, 0, 0); FG_STAGE(FG_SA(1, 1), a1 + hstepA, voffA);
            FG_WAIT_V(8); FG_WAIT_L(0); FG_BAR; FG_MMA(0, 0, At, B0); FG_MMA(0, 1, At, B1); FG_BAR; FG_SCHED;
            FG_LDA(At, 0, 1); FG_STAGE(FG_SB(0, 0), b2, voffB); FG_STAGE(FG_SB(0, 1), b2 + hstepB, voffB); FG_STAGE(FG_SA(0, 0), a2, voffA);
            FG_WAIT_V(8); FG_WAIT_L(0); FG_BAR; FG_MMA(1, 0, At, B0); FG_MMA(1, 1, At, B1); FG_BAR; FG_SCHED;
            FG_LDB(B0, 1, 0); FG_LDB(B1, 1, 1); FG_SCHED; FG_LDA(At, 1, 0); FG_STAGE(FG_SA(0, 1), a2 + hstepA, voffA);
            FG_WAIT_V(8); FG_WAIT_L(0); FG_BAR; FG_MMA(0, 0, At, B0); FG_MMA(0, 1, At, B1); FG_BAR; FG_SCHED;
            FG_LDA(At, 1, 1); FG_STAGE(FG_SB(1, 0), b3, voffB); FG_STAGE(FG_SB(1, 1), b3 + hstepB, voffB); FG_STAGE(FG_SA(1, 0), a3, voffA);
            FG_WAIT_V(8); FG_WAIT_L(0); FG_BAR; FG_MMA(1, 0, At, B0); FG_MMA(1, 1, At, B1); FG_BAR; FG_SCHED;
        }
        if (wr == 0) FG_BAR;
        E(acc, cur, wr, wc, fr, fq);
        if (!has_next) break;
        if (!(is_chain<Epi>::v && cur.aux != 3)) {
#pragma unroll
        for (int a = 0; a < 2; ++a)
#pragma unroll
            for (int b = 0; b < 2; ++b)
#pragma unroll
                for (int m = 0; m < 4; ++m)
#pragma unroll
                    for (int n = 0; n < 2; ++n) acc[a][b][m][n] = (f32x4){0.f, 0.f, 0.f, 0.f};
        }
        cur = nxt; cA = nA; cB = nB; ++ui;
        if (wr == 1) FG_BAR;
    }
    FG_WAIT_V(0);
    FG_BAR;
#undef FG_SA
#undef FG_SB
#undef FG_STAGE
#undef FG_LDA
#undef FG_LDB
#undef FG_MMA
#undef FG_WAIT_V
#undef FG_WAIT_L
#undef FG_BAR
#undef FG_SCHED
}
__device__ __forceinline__ unsigned cvt_pk(float lo, float hi) { unsigned r; asm volatile("v_cvt_pk_bf16_f32 %0, %1, %2" : "=v"(r) : "v"(lo), "v"(hi)); return r; }
__device__ __forceinline__ u32x4 pack8(const f32x4 a, const f32x4 b) { u32x4 w; w.x = cvt_pk(a[0], a[1]); w.y = cvt_pk(a[2], a[3]); w.z = cvt_pk(b[0], b[1]); w.w = cvt_pk(b[2], b[3]); return w; }
__device__ __forceinline__ f32x4 unpk_u8(unsigned x) { const float k = 1.f / 255.f; return (f32x4){(float)(x & 0xffu) * k, (float)((x >> 8) & 0xffu) * k, (float)((x >> 16) & 0xffu) * k, (float)(x >> 24) * k}; }
__device__ __forceinline__ f32x4 unpk_u8r(unsigned x) { return (f32x4){(float)(x & 0xffu), (float)((x >> 8) & 0xffu), (float)((x >> 16) & 0xffu), (float)(x >> 24)}; }
__device__ __forceinline__ f32x4 unpk_lo(unsigned x, unsigned y) { return (f32x4){__uint_as_float(x << 16), __uint_as_float(x & 0xffff0000u), __uint_as_float(y << 16), __uint_as_float(y & 0xffff0000u)}; }

struct EpiWin {
    static constexpr bool PERM = true;
    unsigned char* ws; const float* qg; const float* kg;
    __device__ __forceinline__ void operator()(const Acc& acc, const Unit& u, int wr, int wc, int fr_, int fq_) const {
        int fr = fr_, fq = fq_; asm volatile("" : "+v"(fr), "+v"(fq));
        const int tile = u.pn; const bool LAT = u.aux == 0;
        if (tile == 0) {
            if (LAT) {
                const int b = u.pm >> 5, n2 = 2 * (u.pm & 31) + wr;
#pragma unroll
                for (int ai = 0; ai < 2; ++ai)
#pragma unroll
                    for (int bj = 0; bj < 2; ++bj) {
#pragma unroll
                        for (int n = 0; n < 2; ++n)
#pragma unroll
                            for (int e = 0; e < 4; ++e) { const int ch = bj * HALF + wc * 32 + 8 * fq + 4 * n + e;
                                u32x2 o; o.x = cvt_pk(acc[ai][bj][0][n][e], acc[ai][bj][1][n][e]); o.y = cvt_pk(acc[ai][bj][2][n][e], acc[ai][bj][3][n][e]);
                                *(u32x2*)((bf16*)(ws + WS_UT) + ((size_t)(b * 256 + ch) * 64 + n2) * 256 + 64 * ai + 4 * fr) = o; }
                        asm volatile("" ::: "memory"); }
            } else {
#pragma unroll
                for (int ai = 0; ai < 2; ++ai)
#pragma unroll
                    for (int m = 0; m < 4; ++m) { const int sx = ai * HALF + wr * 64 + m * 16 + fr;
#pragma unroll
                        for (int bj = 0; bj < 2; ++bj)
#pragma unroll
                            for (int n = 0; n < 2; ++n)
#pragma unroll
                                for (int e = 0; e < 4; ++e) { const int ch = bj * HALF + wc * 32 + 8 * fq + 4 * n + e;
                                    ((bf16*)(ws + WS_UTC))[(size_t)(u.pm * 256 + ch) * 256 + sx] = f2bf(acc[ai][bj][m][n][e]); }
                        asm volatile("" ::: "memory"); }
            }
            return;
        }
        const bool ropek = tile == 1 || tile == 2 || tile == 5 || tile == 6 || (tile == 7 && wc < 2);
        const bool keyrow = tile == 7;
        size_t boff; int pitch, col0;
        if (tile <= 4) { boff = WS_RETQ + (size_t)(tile - 1) * MROWS * 256 * 2; pitch = 256; col0 = ropek ? wc * 64 : wc * 32; }
        else if (tile <= 6) { boff = WS_ATTQ; pitch = 512; col0 = (tile - 5) * 256 + wc * 64; }
        else if (tile == 7) { boff = wc < 2 ? WS_ATTK : WS_ATTV; pitch = 128; col0 = (wc & 1) * 64; }
        else if (tile < 10) { boff = WS_CONV; pitch = 512; col0 = (tile - 8) * 256 + wc * 32; }
        else { boff = WS_G; pitch = 4096; col0 = (tile - 10) * 256 + wc * 32; }
        const bool head = ropek || tile == 7;
        bf16* const dbase = (bf16*)(ws + boff);
        const bool norm = tile >= 5 && ropek;
        const float* gp = tile == 7 ? kg : qg;
        const float osc = tile == 2 ? 0.125f : (tile == 5 || tile == 6 ? QSCALE : 1.f);
        const float* rc = (const float*)(ws + WS_ROPE);
#pragma unroll
        for (int ai = 0; ai < 2; ++ai) {
            f32x4 rcs[4][2], rsn[4][2];
            if (ropek && LAT) {
#pragma unroll
                for (int m = 0; m < 4; ++m)
#pragma unroll
                    for (int bj = 0; bj < 2; ++bj) { const int sx = 4096 * ai + 256 * fr + 64 * m + 2 * (u.pm & 31) + wr, i0 = 16 * bj + 4 * fq;
                        rcs[m][bj] = *(const f32x4*)(rc + sx * 32 + i0); rsn[m][bj] = *(const f32x4*)(rc + SEQ * 32 + sx * 32 + i0); } }
#pragma unroll
            for (int m = 0; m < 4; ++m) {
                const int b = LAT ? (u.pm >> 5) : u.pm, s = LAT ? (4096 * ai + 256 * fr + 64 * m + 2 * (u.pm & 31) + wr) : (ai * HALF + wr * 64 + m * 16 + fr);
                const int rr = keyrow ? b * KEYS + (LAT ? CTX + s : s) : (LAT ? b * SEQ + s : NLAT + b * CTX + s);
                bf16* const drow = dbase + ((size_t)rr * pitch + col0 + 8 * fq);
                if (ropek) {
                    float rstd = 1.f;
                    if (norm) { float ss = 0.f;
#pragma unroll
                        for (int bj = 0; bj < 2; ++bj)
#pragma unroll
                            for (int n = 0; n < 2; ++n) { const f32x4 x = acc[ai][bj][m][n]; ss += (x[0] * x[0] + x[1] * x[1]) + (x[2] * x[2] + x[3] * x[3]); }
                        ss += __shfl_xor(ss, 16); ss += __shfl_xor(ss, 32);
                        rstd = rsqrtf(ss * (1.f / 64.f) + EPS); }
#pragma unroll
                    for (int bj = 0; bj < 2; ++bj) {
                        const int i0 = 16 * bj + 4 * fq;
                        f32x4 x1 = acc[ai][bj][m][0], x2 = acc[ai][bj][m][1];
                        if (norm) { const f32x4 g1 = *(const f32x4*)(gp + i0), g2 = *(const f32x4*)(gp + 32 + i0); x1 = x1 * rstd * g1; x2 = x2 * rstd * g2; }
                        f32x4 o1 = x1, o2 = x2;
                        if (LAT) { const f32x4 cs = rcs[m][bj], sn = rsn[m][bj]; o1 = x1 * cs - x2 * sn; o2 = x1 * sn + x2 * cs; }
                        *(u32x4*)(drow + 32 * bj) = pack8(o1 * osc, o2 * osc);
                    }
                } else {
#pragma unroll
                    for (int bj = 0; bj < 2; ++bj) {
                        f32x4 a0 = acc[ai][bj][m][0], a1 = acc[ai][bj][m][1];
                        if (tile >= 10) {
                            u32x2 o; o.x = 0u; o.y = 0u;
#pragma unroll
                            for (int e = 0; e < 4; ++e) { o.x = __builtin_amdgcn_cvt_pk_u8_f32(__builtin_fmaxf(__builtin_floorf(sigmoid_fast(a0[e]) * 255.f + 0.5f), 1.f), e, o.x);
                                o.y = __builtin_amdgcn_cvt_pk_u8_f32(__builtin_fmaxf(__builtin_floorf(sigmoid_fast(a1[e]) * 255.f + 0.5f), 1.f), e, o.y); }
                            *(u32x2*)(ws + WS_G + (size_t)rr * 4096 + (tile - 10) * 256 + wc * 32 + 8 * fq + HALF * bj) = o;
                        } else *(u32x4*)(drow + (head ? 32 : HALF) * bj) = pack8(a0, a1);
                    }
                }
            }
        }
    }
};
struct EpiGate8 {
    static constexpr bool PERM = true;
    unsigned char* G;
    __device__ __forceinline__ void operator()(const Acc& acc, const Unit& u, int wr, int wc, int fr_, int fq_) const {
        int fr = fr_, fq = fq_; asm volatile("" : "+v"(fr), "+v"(fq));
#pragma unroll
        for (int ai = 0; ai < 2; ++ai)
#pragma unroll
            for (int m = 0; m < 4; ++m) { const int r = u.pm * BM + ai * HALF + wr * 64 + m * 16 + fr;
#pragma unroll
                for (int bj = 0; bj < 2; ++bj) { const f32x4 a0 = acc[ai][bj][m][0], a1 = acc[ai][bj][m][1]; u32x2 o; o.x = 0u; o.y = 0u;
#pragma unroll
                    for (int e = 0; e < 4; ++e) { o.x = __builtin_amdgcn_cvt_pk_u8_f32(__builtin_fmaxf(__builtin_floorf(sigmoid_fast(a0[e]) * 255.f + 0.5f), 1.f), e, o.x);
                        o.y = __builtin_amdgcn_cvt_pk_u8_f32(__builtin_fmaxf(__builtin_floorf(sigmoid_fast(a1[e]) * 255.f + 0.5f), 1.f), e, o.y); }
                    *(u32x2*)(G + (size_t)r * 4096 + u.pn * BM + bj * HALF + wc * 32 + 8 * fq) = o; } }
    }
};
struct EpiMerge {
    static constexpr bool PERM = true, CHAIN = true;
    const unsigned char* G; bf16* Mg;
    __device__ __forceinline__ void operator()(Acc& acc, const Unit& u, int wr, int wc, int fr_, int fq_) const {
        int fr = fr_, fq = fq_; asm volatile("" : "+v"(fr), "+v"(fq));
        const int br = u.aux; const bool lastb = br == 3;
#pragma unroll
        for (int ai = 0; ai < 2; ++ai) {
            u32x2 g[4][2], gn[4][2];
#pragma unroll
            for (int m = 0; m < 4; ++m)
#pragma unroll
                for (int bj = 0; bj < 2; ++bj) { const int r = u.pm * BM + ai * HALF + wr * 64 + m * 16 + fr, c = u.pn * BM + bj * HALF + wc * 32 + 8 * fq;
                    g[m][bj] = *(const u32x2*)(G + (size_t)r * 4096 + br * 1024 + c);
                    if (!lastb) gn[m][bj] = *(const u32x2*)(G + (size_t)r * 4096 + (br + 1) * 1024 + c); }
#pragma unroll
            for (int m = 0; m < 4; ++m)
#pragma unroll
                for (int bj = 0; bj < 2; ++bj) {
                    if (!lastb) {
                        const f32x4 n0 = unpk_u8r(g[m][bj].x), n1 = unpk_u8r(g[m][bj].y), d0 = unpk_u8r(gn[m][bj].x), d1 = unpk_u8r(gn[m][bj].y);
#pragma unroll
                        for (int e = 0; e < 4; ++e) { acc[ai][bj][m][0][e] *= n0[e] * __builtin_amdgcn_rcpf(d0[e]); acc[ai][bj][m][1][e] *= n1[e] * __builtin_amdgcn_rcpf(d1[e]); }
                    } else { const int r = u.pm * BM + ai * HALF + wr * 64 + m * 16 + fr, c = u.pn * BM + bj * HALF + wc * 32 + 8 * fq;
                        *(u32x4*)(Mg + (size_t)r * 1024 + c) = pack8(acc[ai][bj][m][0] * unpk_u8(g[m][bj].x), acc[ai][bj][m][1] * unpk_u8(g[m][bj].y)); } }
        }
    }
};
struct EpiResid {
    static constexpr bool PERM = false;
    float* out; float* hctx; const float* modbase; int chunk;
    __device__ __forceinline__ void operator()(const Acc& acc, const Unit& u, int wr, int wc, int fr_, int fq_) const {
        int fr = fr_, fq = fq_; asm volatile("" : "+v"(fr), "+v"(fq));
        const int rt = u.pm * BM;
        const float* g = modbase + ((size_t)row_mi(rt) * 6 + chunk) * D;
        f32x4 gg[2][2];
#pragma unroll
        for (int bj = 0; bj < 2; ++bj)
#pragma unroll
            for (int n = 0; n < 2; ++n) gg[bj][n] = *(const f32x4*)(g + u.pn * BM + bj * HALF + wc * 32 + 16 * n + 4 * fq);
#pragma unroll
        for (int ai = 0; ai < 2; ++ai) {
            f32x4 hv[4][2][2];
#pragma unroll
            for (int m = 0; m < 4; ++m) { const int r = rt + ai * HALF + wr * 64 + m * 16 + fr; const float* h = r < NLAT ? out + (size_t)r * D : hctx + (size_t)(r - NLAT) * D;
#pragma unroll
                for (int bj = 0; bj < 2; ++bj)
#pragma unroll
                    for (int n = 0; n < 2; ++n) hv[m][bj][n] = *(const f32x4*)(h + u.pn * BM + bj * HALF + wc * 32 + 16 * n + 4 * fq); }
#pragma unroll
            for (int m = 0; m < 4; ++m) { const int r = rt + ai * HALF + wr * 64 + m * 16 + fr; float* h = r < NLAT ? out + (size_t)r * D : hctx + (size_t)(r - NLAT) * D;
#pragma unroll
                for (int bj = 0; bj < 2; ++bj)
#pragma unroll
                    for (int n = 0; n < 2; ++n) *(f32x4*)(h + u.pn * BM + bj * HALF + wc * 32 + 16 * n + 4 * fq) = hv[m][bj][n] + gg[bj][n] * acc[ai][bj][m][n]; }
        }
    }
};
struct EpiResidNorm {
    static constexpr bool PERM = false;
    const float* hin; float* out; const float* modbase; int chunk;
    const float* gain; const float* nmods; int csh, csc; bf16* A; unsigned char* A8;
    float* xbuf; unsigned* cnt; unsigned* tmo; LAS unsigned char* lds;
    __device__ __forceinline__ void operator()(Acc& acc, const Unit& u, int wr, int wc, int fr_, int fq_) const {
        int fr = fr_, fq = fq_; asm volatile("" : "+v"(fr), "+v"(fq));
        const int wid = __builtin_amdgcn_readfirstlane((int)threadIdx.x >> 6), lane = threadIdx.x & 63;
        const int rt = u.pm * BM, mi = row_mi(rt);
        LAS float* Pt = (LAS float*)(lds + STAGE_BYTES);
        LAS float* St = (LAS float*)(lds + STAGE_BYTES + 4096);
        LAS unsigned* flag = (LAS unsigned*)(lds + STAGE_BYTES + 5120);
        { const float* g = modbase + ((size_t)mi * 6 + chunk) * D;
          f32x4 gg[2][2];
#pragma unroll
          for (int bj = 0; bj < 2; ++bj)
#pragma unroll
              for (int n = 0; n < 2; ++n) gg[bj][n] = *(const f32x4*)(g + u.pn * BM + bj * HALF + wc * 32 + 16 * n + 4 * fq);
#pragma unroll
          for (int am = 0; am < 4; ++am) { const int ai = am >> 1, m0 = (am & 1) * 2;
              f32x4 hv[2][2][2];
#pragma unroll
              for (int mm = 0; mm < 2; ++mm) { const float* h = hin + (size_t)(rt + ai * HALF + wr * 64 + (m0 + mm) * 16 + fr) * D;
#pragma unroll
                  for (int bj = 0; bj < 2; ++bj)
#pragma unroll
                      for (int n = 0; n < 2; ++n) hv[mm][bj][n] = *(const f32x4*)(h + u.pn * BM + bj * HALF + wc * 32 + 16 * n + 4 * fq); }
#pragma unroll
              for (int mm = 0; mm < 2; ++mm) { const int m = m0 + mm; float* h = out + (size_t)(rt + ai * HALF + wr * 64 + m * 16 + fr) * D; float ss = 0.f;
#pragma unroll
                  for (int bj = 0; bj < 2; ++bj)
#pragma unroll
                      for (int n = 0; n < 2; ++n) { const f32x4 x = hv[mm][bj][n] + gg[bj][n] * acc[ai][bj][m][n]; acc[ai][bj][m][n] = x;
                          *(f32x4*)(h + u.pn * BM + bj * HALF + wc * 32 + 16 * n + 4 * fq) = x; ss += (x[0] * x[0] + x[1] * x[1]) + (x[2] * x[2] + x[3] * x[3]); }
                  ss += __shfl_xor(ss, 16); ss += __shfl_xor(ss, 32);
                  if (fq == 0) Pt[(ai * HALF + wr * 64 + m * 16 + fr) * 4 + wc] = ss; }
              asm volatile("" ::: "memory");
          } }
        asm volatile("s_waitcnt lgkmcnt(0)" ::: "memory"); __builtin_amdgcn_s_barrier(); asm volatile("" ::: "memory");
        const int row = wid * 32 + (lane & 31);
        if (lane < 32) { const f32x4 q = *(const LAS f32x4*)(Pt + row * 4);
            __hip_atomic_store(xbuf + ((size_t)(rt + row) * 4 + u.pn), (q[0] + q[1]) + (q[2] + q[3]), __ATOMIC_RELAXED, __HIP_MEMORY_SCOPE_AGENT); }
        asm volatile("s_waitcnt vmcnt(0)" ::: "memory");
        if (lane == 0) __hip_atomic_fetch_add(cnt + 16 * u.pm, 1u, __ATOMIC_RELAXED, __HIP_MEMORY_SCOPE_AGENT);
        if (wid == 0) { unsigned sp = 0u, dead = 0u;
            while ((unsigned)__builtin_amdgcn_readfirstlane(__hip_atomic_load(cnt + 16 * u.pm, __ATOMIC_RELAXED, __HIP_MEMORY_SCOPE_AGENT)) < 32u) {
                __builtin_amdgcn_s_sleep(1);
                if ((++sp & 255u) == 0u) { if (__hip_atomic_load(tmo, __ATOMIC_RELAXED, __HIP_MEMORY_SCOPE_AGENT)) { dead = 1u; break; } if (sp > (1u << 22)) { if (lane == 0) atomicAdd(tmo, 1u); dead = 1u; break; } } }
            __builtin_amdgcn_fence(__ATOMIC_ACQUIRE, "agent");
            if (lane == 0) flag[0] = dead; }
        asm volatile("s_waitcnt vmcnt(0) lgkmcnt(0)" ::: "memory"); __builtin_amdgcn_s_barrier(); asm volatile("" ::: "memory");
        if (lane < 32) { const float* sl = xbuf + (size_t)(rt + row) * 4; float t = 0.f;
#pragma unroll
            for (int q = 0; q < 4; ++q) t += __hip_atomic_load(sl + q, __ATOMIC_RELAXED, __HIP_MEMORY_SCOPE_AGENT);
            St[row] = rsqrtf(t * (1.f / D) + EPS); }
        asm volatile("s_waitcnt lgkmcnt(0)" ::: "memory"); __builtin_amdgcn_s_barrier(); asm volatile("" ::: "memory");
        const float* shp = nmods + ((size_t)mi * 6 + csh) * D; const float* scp = nmods + ((size_t)mi * 6 + csc) * D;
        float rs[2][4];
#pragma unroll
        for (int ai = 0; ai < 2; ++ai)
#pragma unroll
            for (int m = 0; m < 4; ++m) rs[ai][m] = St[ai * HALF + wr * 64 + m * 16 + fr];
#pragma unroll
        for (int bj = 0; bj < 2; ++bj)
#pragma unroll
            for (int n = 0; n < 2; ++n) { const int c = u.pn * BM + bj * HALF + wc * 32 + 16 * n + 4 * fq;
                const f32x4 g4 = *(const f32x4*)(gain + c), sc4 = *(const f32x4*)(scp + c) + 1.f, sh4 = *(const f32x4*)(shp + c);
#pragma unroll
                for (int ai = 0; ai < 2; ++ai)
#pragma unroll
                    for (int m = 0; m < 4; ++m) { const f32x4 y = acc[ai][bj][m][n] * rs[ai][m] * g4 * sc4 + sh4;
                        u32x2 o; o.x = cvt_pk(y[0], y[1]); o.y = cvt_pk(y[2], y[3]);
                        *(u32x2*)(A + (size_t)(rt + ai * HALF + wr * 64 + m * 16 + fr) * D + c) = o;
                        if (A8) *(unsigned*)(A8 + (size_t)(rt + ai * HALF + wr * 64 + m * 16 + fr) * D + c) = pk4_fp8(y[0], y[1], y[2], y[3]); } }
    }
};
struct EpiSwiglu {
    static constexpr bool PERM = true;
    bf16* Hm;
    __device__ __forceinline__ void operator()(const Acc& acc, const Unit& u, int wr, int wc, int fr, int fq) const {
#pragma unroll
        for (int ai = 0; ai < 2; ++ai)
#pragma unroll
            for (int m = 0; m < 4; ++m) { const int r = u.pm * BM + ai * HALF + wr * 64 + m * 16 + fr;
#pragma unroll
                for (int bj = 0; bj < 2; ++bj) { const int c = u.pn * BM + bj * HALF + wc * 32 + 8 * fq; const f32x4 g = acc[ai][bj][m][0], up = acc[ai][bj][m][1];
                    u32x2 o; o.x = cvt_pk(silu_fast(g[0]) * up[0], silu_fast(g[1]) * up[1]); o.y = cvt_pk(silu_fast(g[2]) * up[2], silu_fast(g[3]) * up[3]);
                    *(u32x2*)(Hm + (size_t)r * FFN + (c >> 1)) = o; } }
    }
};
struct EpiSwiglu8 {
    static constexpr bool PERM = true;
    unsigned char* Hm;
    __device__ __forceinline__ void operator()(const Acc& acc, const Unit& u, int wr, int wc, int fr_, int fq_) const {
        int fr = fr_, fq = fq_; asm volatile("" : "+v"(fr), "+v"(fq));
#pragma unroll
        for (int ai = 0; ai < 2; ++ai)
#pragma unroll
            for (int m = 0; m < 4; ++m) { const int r = u.pm * BM + ai * HALF + wr * 64 + m * 16 + fr;
#pragma unroll
                for (int bj = 0; bj < 2; ++bj) { const int c = u.pn * BM + bj * HALF + wc * 32 + 8 * fq; const f32x4 g = acc[ai][bj][m][0], up = acc[ai][bj][m][1];
                    *(unsigned*)(Hm + (size_t)r * FFN + (c >> 1)) = pk4_fp8(silu_fast(g[0]) * up[0], silu_fast(g[1]) * up[1], silu_fast(g[2]) * up[2], silu_fast(g[3]) * up[3]); } }
    }
};
struct EpiStore {
    static constexpr bool PERM = true;
    bf16* O; int ldc;
    __device__ __forceinline__ void operator()(const Acc& acc, const Unit& u, int wr, int wc, int fr_, int fq_) const {
        int fr = fr_, fq = fq_; asm volatile("" : "+v"(fr), "+v"(fq));
#pragma unroll
        for (int ai = 0; ai < 2; ++ai)
#pragma unroll
            for (int m = 0; m < 4; ++m) { const int r = u.pm * BM + ai * HALF + wr * 64 + m * 16 + fr;
#pragma unroll
                for (int bj = 0; bj < 2; ++bj) { const int c = u.pn * BM + bj * HALF + wc * 32 + 8 * fq; *(u32x4*)(O + (size_t)r * ldc + c) = pack8(acc[ai][bj][m][0], acc[ai][bj][m][1]); } }
    }
};
struct EpiFft1 {
    static constexpr bool PERM = true;
    unsigned char* ws;
    __device__ __forceinline__ void operator()(const Acc& acc, const Unit& u, int wr, int wc, int fr, int fq) const {
        const float* TW = (const float*)(ws + WS_TW); bf16* Z = (bf16*)(ws + WS_Z);
#pragma unroll
        for (int ai = 0; ai < 2; ++ai)
#pragma unroll
            for (int mm = 0; mm < 2; ++mm) { const int k1 = (4 * ai + 2 * wr + mm) * 16 + fr;
#pragma unroll
                for (int bj = 0; bj < 2; ++bj) { const int c = u.pn * BM + bj * HALF + wc * 32 + 8 * fq, n2 = c & 63, ch = (c >> 6) & 255, b = c >> 14;
                    f32x4 zr[2], zi[2];
#pragma unroll
                    for (int n = 0; n < 2; ++n) { const f32x4 yr = acc[ai][bj][2 * mm][n], yi = acc[ai][bj][2 * mm + 1][n];
                        const f32x4 t0 = *(const f32x4*)(TW + (size_t)(k1 * 64 + n2 + 4 * n) * 2), t1 = *(const f32x4*)(TW + (size_t)(k1 * 64 + n2 + 4 * n) * 2 + 4);
                        const f32x4 ct = {t0[0], t0[2], t1[0], t1[2]}, st = {t0[1], t0[3], t1[1], t1[3]};
                        zr[n] = yr * ct + yi * st; zi[n] = yi * ct - yr * st; }
                    bf16* dst = Z + ((size_t)b * 32768 + k1 * 256 + ch) * 256 + n2;
                    *(u32x4*)dst = pack8(zr[0], zr[1]); *(u32x4*)(dst + 64) = pack8(zi[0], zi[1]);
                    asm volatile("" ::: "memory"); } }
    }
};
struct EpiFft3 {
    static constexpr bool PERM = true;
    unsigned char* ws;
    __device__ __forceinline__ void operator()(const Acc& acc, const Unit& u, int wr, int wc, int fr, int fq) const {
        bf16* X = (bf16*)(ws + WS_X);
#pragma unroll
        for (int m = 0; m < 4; ++m) { const int k2 = 16 * m + fr;
#pragma unroll
            for (int bj = 0; bj < 2; ++bj) { const int c = u.pn * BM + bj * HALF + wc * 32 + 8 * fq, ch = c & 255, k1 = (c >> 8) & 127, b = c >> 15;
                *(u32x4*)(X + (size_t)(b * SEQ + k1 + 128 * k2) * 1536 + wr * 256 + ch) = pack8(acc[0][bj][m][0], acc[0][bj][m][1]); } }
    }
};
struct EpiFftC {
    static constexpr bool PERM = true;
    unsigned char* ws;
    __device__ __forceinline__ void operator()(const Acc& acc, const Unit& u, int wr, int wc, int fr, int fq) const {
        bf16* X = (bf16*)(ws + WS_X);
#pragma unroll
        for (int ai = 0; ai < 2; ++ai)
#pragma unroll
            for (int m = 0; m < 4; ++m) { const int k = ai * HALF + wr * 64 + m * 16 + fr;
#pragma unroll
                for (int bj = 0; bj < 2; ++bj) { const int ch = bj * HALF + wc * 32 + 8 * fq;
                    *(u32x4*)(X + (size_t)(NLAT + u.pn * CTX + k) * 1536 + u.pm * 256 + ch) = pack8(acc[ai][bj][m][0], acc[ai][bj][m][1]); } }
    }
};
}

__device__ __forceinline__ void ph_win(const P& p, LAS unsigned char* lds, int layer) {
    const char* W = (const char*)(p.ws + WS_WIN) + (size_t)layer * INC * D * 2;
#pragma unroll 1
    for (int mode = 0; mode < 2; ++mode) {
        fg::WinSched S{(const char*)(p.ws + WS_A), W, (int)gridDim.x, (int)((blockIdx.x + mode * 128) % gridDim.x), mode, mode == 0 ? 10 : (layer == 0 ? 26 : 10)};
        fg::EpiWin E{p.ws, p.in[14] + layer * 64, p.in[15] + layer * 64};
        fg::gemm_phase(lds, D, D, S, E);
    }
    {
        fg::PlainSched S{(const char*)(p.ws + WS_A8), (const char*)(p.ws + WS_WIN8) + (size_t)layer * 4096 * 1024, D / 2, D / 2, NLAT / 256, 16, (int)gridDim.x, (int)blockIdx.x, D / 128};
        fg::EpiGate8 E{p.ws + WS_G};
        fg::gemm_phase<fg::EpiGate8, fg::PlainSched, true>(lds, D / 2, D / 2, S, E);
    }
}

__device__ __forceinline__ void conv_item(const P& p, LAS unsigned char* lds, int layer, int seqid, int t0) {
    const int tid = threadIdx.x; LAS float* y = (LAS float*)lds;
    const int L = seqid < 2 ? SEQ : CTX; const int rbase = seqid < 2 ? seqid * SEQ : NLAT + (seqid - 2) * CTX;
    const bf16* cv = (const bf16*)(p.ws + WS_CONV);
    __syncthreads();
    u32x4 pa[6], pg[6];
#pragma unroll
    for (int i = 0; i < 6; ++i) { const int e = tid + i * NTHREADS, tt = e >> 5, c8 = (e & 31) * 8, t = t0 - 15 + tt;
        if (e < 94 * 32 && t >= 0 && t < L) { const bf16* rowp = cv + (size_t)(rbase + t) * 512 + c8; pa[i] = *(const u32x4*)rowp; pg[i] = *(const u32x4*)(rowp + 256); } }
#pragma unroll
    for (int i = 0; i < 6; ++i) { const int e = tid + i * NTHREADS; if (e >= 94 * 32) break; const int tt = e >> 5, c8 = (e & 31) * 8, t = t0 - 15 + tt;
        f32x4 lo = {0.f, 0.f, 0.f, 0.f}, hi = lo;
        if (t >= 0 && t < L) { const u32x4 a = pa[i], g = pg[i];
            lo = (f32x4){__uint_as_float(a.x << 16) * sigmoidf_(__uint_as_float(g.x << 16)), __uint_as_float(a.x & 0xffff0000u) * sigmoidf_(__uint_as_float(g.x & 0xffff0000u)),
                         __uint_as_float(a.y << 16) * sigmoidf_(__uint_as_float(g.y << 16)), __uint_as_float(a.y & 0xffff0000u) * sigmoidf_(__uint_as_float(g.y & 0xffff0000u))};
            hi = (f32x4){__uint_as_float(a.z << 16) * sigmoidf_(__uint_as_float(g.z << 16)), __uint_as_float(a.z & 0xffff0000u) * sigmoidf_(__uint_as_float(g.z & 0xffff0000u)),
                         __uint_as_float(a.w << 16) * sigmoidf_(__uint_as_float(g.w << 16)), __uint_as_float(a.w & 0xffff0000u) * sigmoidf_(__uint_as_float(g.w & 0xffff0000u))}; }
        *(LAS f32x4*)(y + tt * 256 + c8) = lo; *(LAS f32x4*)(y + tt * 256 + c8 + 4) = hi; }
    __syncthreads();
    {
        const int ch = tid & 255, half = tid >> 8;
        float w[31];
#pragma unroll
        for (int k = 0; k < 31; ++k) w[k] = p.in[17][(size_t)layer * 31 * 256 + k * 256 + ch];
        const float bias = p.in[18][layer * 256 + ch];
        float o[4][8];
#pragma unroll
        for (int u = 0; u < 4; ++u) { const int tb = (half * 4 + u) * 8;
            float in[38];
#pragma unroll
            for (int q = 0; q < 38; ++q) in[q] = y[(tb + q) * 256 + ch];
#pragma unroll
            for (int q = 0; q < 8; ++q) { float a = bias;
#pragma unroll
                for (int k = 0; k < 31; ++k) a += in[q + k] * w[k];
                o[u][q] = a; } }
        __syncthreads();
#pragma unroll
        for (int u = 0; u < 4; ++u)
#pragma unroll
            for (int q = 0; q < 8; ++q) y[((half * 4 + u) * 8 + q) * 256 + ch] = o[u][q];
    }
    __syncthreads();
    const int wv = tid >> 6, lane = tid & 63;
    const f32x4 g = *(const f32x4*)(p.in[19] + layer * 256 + lane * 4), bb = *(const f32x4*)(p.in[20] + layer * 256 + lane * 4);
    for (int q = 0; q < 8; ++q) { const int t = wv * 8 + q;
        const f32x4 v = *(const LAS f32x4*)(y + t * 256 + lane * 4);
        const float mu = wave_sum(v.x + v.y + v.z + v.w) * (1.f / 256.f);
        const f32x4 dv = v - mu; const float var = wave_sum(dv.x * dv.x + dv.y * dv.y + dv.z * dv.z + dv.w * dv.w) * (1.f / 256.f);
        const float rstd = rsqrtf(var + EPS);
        f32x4 z = dv * rstd * g + bb;
        u32x2 ov; ov.x = pk2(siluf_(z.x), siluf_(z.y)); ov.y = pk2(siluf_(z.z), siluf_(z.w));
        *(u32x2*)((bf16*)(p.ws + WS_X) + (size_t)(rbase + t0 + t) * 1536 + 1280 + lane * 4) = ov; }
}

__device__ __forceinline__ int chunk_row0(int b, int n) { return n < 2 ? NLAT + b * CTX + n * 128 : b * SEQ + (n - 2) * 128; }
__device__ __forceinline__ float log_sigmoid(float x) { return x >= 0.f ? -log1pf(expf(-x)) : x - log1pf(expf(x)); }
namespace rt {
typedef short bf16x8 __attribute__((ext_vector_type(8)));
constexpr int PQ = 72, PJ = 136;
__device__ __forceinline__ f32x4 mma(bf16x8 a, bf16x8 b, f32x4 c) { return __builtin_amdgcn_mfma_f32_16x16x32_bf16(a, b, c, 0, 0, 0); }
__device__ __forceinline__ bf16x8 frag(const LAS bf16* base, int row, int pitch, int k0, int lane) { return *(const LAS bf16x8*)(base + (row + (lane & 15)) * pitch + k0 + 8 * (lane >> 4)); }
}
__device__ __forceinline__ void ret_kv_item(const P& p, LAS unsigned char* lds, int layer, int it) {
    using namespace rt;
    const int tid = threadIdx.x, lane = tid & 63, w = tid >> 6; const int h = it & 3, n = (it >> 2) % NCHUNK, b = (it >> 2) / NCHUNK;
    LAS bf16* KTf = (LAS bf16*)lds; LAS bf16* KTb = KTf + 64 * PJ; LAS bf16* VT = KTb + 64 * PJ;
    const int r0 = chunk_row0(b, n);
    const float lgf = log_sigmoid(p.in[10][layer * 4 + h]), lgb = log_sigmoid(p.in[11][layer * 4 + h]);
    __syncthreads();
    { const int j = tid & 127, dq = (tid >> 7) * 16;
      const bf16* K = (const bf16*)(p.ws + WS_RETK) + (size_t)(r0 + j) * 256 + h * 64 + dq; const bf16* V = (const bf16*)(p.ws + WS_RETV) + (size_t)(r0 + j) * 256 + h * 64 + dq;
      const float zf = expf((127.f - j) * lgf), zb = expf((float)j * lgb);
#pragma unroll
      for (int q8 = 0; q8 < 2; ++q8) { const u32x4 kw = *(const u32x4*)(K + q8 * 8), vw = *(const u32x4*)(V + q8 * 8);
          const unsigned kk[4] = {kw.x, kw.y, kw.z, kw.w}, vv[4] = {vw.x, vw.y, vw.z, vw.w};
#pragma unroll
          for (int q = 0; q < 4; ++q) { const int d = dq + q8 * 8 + 2 * q; const float k0 = __uint_as_float(kk[q] << 16), k1 = __uint_as_float(kk[q] & 0xffff0000u);
              KTf[d * PJ + j] = f2bf(k0 * zf); KTf[(d + 1) * PJ + j] = f2bf(k1 * zf); KTb[d * PJ + j] = f2bf(k0 * zb); KTb[(d + 1) * PJ + j] = f2bf(k1 * zb);
              VT[d * PJ + j] = (bf16)(vv[q] & 0xffffu); VT[(d + 1) * PJ + j] = (bf16)(vv[q] >> 16); } } }
    __syncthreads();
    const int fb = w >> 2, dt = w & 3; const LAS bf16* Am = fb == 0 ? KTf : KTb;
    f32x4 acc[4];
#pragma unroll
    for (int et = 0; et < 4; ++et) acc[et] = (f32x4){0.f, 0.f, 0.f, 0.f};
#pragma unroll
    for (int ks = 0; ks < 4; ++ks) { const bf16x8 af = frag(Am, dt * 16, PJ, ks * 32, lane);
#pragma unroll
        for (int et = 0; et < 4; ++et) acc[et] = mma(af, frag(VT, et * 16, PJ, ks * 32, lane), acc[et]); }
    float* S = (float*)(p.ws + WS_RETS) + ((size_t)((fb * 2 + b) * NCHUNK + n) * 4 + h) * 4096;
#pragma unroll
    for (int et = 0; et < 4; ++et)
#pragma unroll
        for (int r = 0; r < 4; ++r) S[(dt * 16 + 4 * (lane >> 4) + r) * 64 + et * 16 + (lane & 15)] = acc[et][r];
}
__device__ __forceinline__ void ret_scan_item(const P& p, int layer, int it) {
    const int e = it * NTHREADS + threadIdx.x;
    const int de = e & 4095, h = (e >> 12) & 3, b = (e >> 14) & 1, dir = e >> 15;
    const float lg = log_sigmoid(p.in[dir == 0 ? 10 : 11][layer * 4 + h]); const float g = expf(128.f * lg);
    float* S = (float*)(p.ws + WS_RETS) + (size_t)((dir * 2 + b) * NCHUNK) * 4 * 4096 + (size_t)h * 4096 + de;
    float kv[NCHUNK];
#pragma unroll
    for (int n = 0; n < NCHUNK; ++n) kv[n] = S[(size_t)n * 4 * 4096];
    float st = 0.f;
    if (dir == 0) {
#pragma unroll
        for (int n = 0; n < NCHUNK; ++n) { const float t = kv[n]; kv[n] = st; st = st * g + t; }
    } else {
#pragma unroll
        for (int i = 0; i < NCHUNK; ++i) { const int n = i < 2 ? 1 - i : NCHUNK + 1 - i; const float t = kv[n]; kv[n] = st; st = st * g + t; }
    }
    float* S2 = (float*)(p.ws + WS_RETS2) + (size_t)((dir * 2 + b) * NCHUNK) * 4 * 4096 + (size_t)h * 4096 + de;
#pragma unroll
    for (int n = 0; n < NCHUNK; ++n) S2[(size_t)n * 4 * 4096] = kv[n];
}
__device__ __forceinline__ void ret_out_item(const P& p, LAS unsigned char* lds, int layer, int it) {
    using namespace rt;
    const int tid = threadIdx.x, lane = tid & 63, w = tid >> 6; const int h = it & 3, n = (it >> 2) % NCHUNK, b = (it >> 2) / NCHUNK;
    LAS bf16* Qs = (LAS bf16*)lds; LAS bf16* Ks = Qs + 128 * PQ; LAS bf16* VT = Ks + 128 * PQ; LAS bf16* Ps = VT + 64 * PJ; LAS bf16* SfT = Ps + 128 * PJ; LAS bf16* SbT = SfT + 64 * PQ;
    LAS float* pf = (LAS float*)(SbT + 64 * PQ); LAS float* pb = pf + 132;
    const int r0 = chunk_row0(b, n);
    const float lgf = log_sigmoid(p.in[10][layer * 4 + h]), lgb = log_sigmoid(p.in[11][layer * 4 + h]);
    const float* S = (const float*)(p.ws + WS_RETS2);
    const float* sfp = S + ((size_t)((0 * 2 + b) * NCHUNK + n) * 4 + h) * 4096; const float* sbp = S + ((size_t)((1 * 2 + b) * NCHUNK + n) * 4 + h) * 4096;
    __syncthreads();
    { const int j = tid >> 2, dq = (tid & 3) * 16;
      const bf16* Q = (const bf16*)(p.ws + WS_RETQ) + (size_t)(r0 + j) * 256 + h * 64 + dq; const bf16* K = (const bf16*)(p.ws + WS_RETK) + (size_t)(r0 + j) * 256 + h * 64 + dq;
      *(LAS u32x4*)(Qs + j * PQ + dq) = *(const u32x4*)Q; *(LAS u32x4*)(Qs + j * PQ + dq + 8) = *(const u32x4*)(Q + 8);
      *(LAS u32x4*)(Ks + j * PQ + dq) = *(const u32x4*)K; *(LAS u32x4*)(Ks + j * PQ + dq + 8) = *(const u32x4*)(K + 8); }
    { const int j = tid & 127, dq = (tid >> 7) * 16;
      const bf16* V = (const bf16*)(p.ws + WS_RETV) + (size_t)(r0 + j) * 256 + h * 64 + dq;
#pragma unroll
      for (int q8 = 0; q8 < 2; ++q8) { const u32x4 vw = *(const u32x4*)(V + q8 * 8); const unsigned vv[4] = {vw.x, vw.y, vw.z, vw.w};
#pragma unroll
          for (int q = 0; q < 4; ++q) { const int d = dq + q8 * 8 + 2 * q; VT[d * PJ + j] = (bf16)(vv[q] & 0xffffu); VT[(d + 1) * PJ + j] = (bf16)(vv[q] >> 16); } } }
    { const int d = tid & 63, e0 = (tid >> 6) * 8;
#pragma unroll
      for (int q4 = 0; q4 < 2; ++q4) { const f32x4 a = *(const f32x4*)(sfp + d * 64 + e0 + q4 * 4), c = *(const f32x4*)(sbp + d * 64 + e0 + q4 * 4);
#pragma unroll
          for (int q = 0; q < 4; ++q) { SfT[(e0 + q4 * 4 + q) * PQ + d] = f2bf(a[q]); SbT[(e0 + q4 * 4 + q) * PQ + d] = f2bf(c[q]); } } }
    if (tid <= 128) { pf[tid] = expf((float)tid * lgf); pb[tid] = expf((float)tid * lgb); }
    __syncthreads();
    { const bf16x8 a0 = frag(Qs, 16 * w, PQ, 0, lane), a1 = frag(Qs, 16 * w, PQ, 32, lane);
#pragma unroll
      for (int jt = 0; jt < 8; ++jt) { f32x4 c = (f32x4){0.f, 0.f, 0.f, 0.f};
          c = mma(a0, frag(Ks, jt * 16, PQ, 0, lane), c); c = mma(a1, frag(Ks, jt * 16, PQ, 32, lane), c);
          const int j = jt * 16 + (lane & 15);
#pragma unroll
          for (int r = 0; r < 4; ++r) { const int i = 16 * w + 4 * (lane >> 4) + r; const float dm = i > j ? pf[i - j] : (i < j ? pb[j - i] : 2.f); Ps[i * PJ + j] = f2bf(c[r] * dm); } } }
    __syncthreads();
    f32x4 aP[4], aF[4], aB[4];
#pragma unroll
    for (int et = 0; et < 4; ++et) { aP[et] = (f32x4){0.f, 0.f, 0.f, 0.f}; aF[et] = aP[et]; aB[et] = aP[et]; }
#pragma unroll
    for (int ks = 0; ks < 4; ++ks) { const bf16x8 af = frag(Ps, 16 * w, PJ, ks * 32, lane);
#pragma unroll
        for (int et = 0; et < 4; ++et) aP[et] = mma(af, frag(VT, et * 16, PJ, ks * 32, lane), aP[et]); }
#pragma unroll
    for (int ks = 0; ks < 2; ++ks) { const bf16x8 af = frag(Qs, 16 * w, PQ, ks * 32, lane);
#pragma unroll
        for (int et = 0; et < 4; ++et) { aF[et] = mma(af, frag(SfT, et * 16, PQ, ks * 32, lane), aF[et]); aB[et] = mma(af, frag(SbT, et * 16, PQ, ks * 32, lane), aB[et]); } }
    const float* rg = p.in[12] + layer * 256 + h * 64;
    const bf16* G = (const bf16*)(p.ws + WS_RETG) + (size_t)r0 * 256 + h * 64; bf16* X = (bf16*)(p.ws + WS_X) + (size_t)r0 * 1536 + 512 + h * 64;
    float gt[4][4];
#pragma unroll
    for (int r = 0; r < 4; ++r)
#pragma unroll
        for (int et = 0; et < 4; ++et) gt[r][et] = bf2f(G[(size_t)(16 * w + 4 * (lane >> 4) + r) * 256 + et * 16 + (lane & 15)]);
#pragma unroll
    for (int r = 0; r < 4; ++r) { const int i = 16 * w + 4 * (lane >> 4) + r; const float xf = pf[i + 1], xb = pb[128 - i];
        float o[4]; float ss = 0.f;
#pragma unroll
        for (int et = 0; et < 4; ++et) { o[et] = aP[et][r] + xf * aF[et][r] + xb * aB[et][r]; ss += o[et] * o[et]; }
        ss += __shfl_xor(ss, 1); ss += __shfl_xor(ss, 2); ss += __shfl_xor(ss, 4); ss += __shfl_xor(ss, 8);
        const float rstd = rsqrtf(ss * (1.f / 64.f) + EPS);
#pragma unroll
        for (int et = 0; et < 4; ++et) { const int e = et * 16 + (lane & 15); Ps[i * PJ + e] = f2bf(o[et] * rstd * rg[e] * siluf_(gt[r][et])); } }
    asm volatile("s_waitcnt lgkmcnt(0)" ::: "memory");
#pragma unroll
    for (int q = 0; q < 2; ++q) { const int c = lane + 64 * q, i = 16 * w + (c >> 3), e8 = (c & 7) * 8;
        *(u32x4*)(X + (size_t)i * 1536 + e8) = *(const LAS u32x4*)(Ps + i * PJ + e8); }
    __syncthreads();
}

#include <hip/hip_bf16.h>
#include <cmath>
namespace attn_body {
using bf16=__hip_bfloat16;
using bf16x8=__attribute__((ext_vector_type(8)))short;
using s16x4=__attribute__((ext_vector_type(4)))short;
using f32x16=__attribute__((ext_vector_type(16)))float;
using u32x4=__attribute__((ext_vector_type(4)))unsigned;
constexpr int D=64, QP=512, KP=128, OP=1536;
constexpr int NW=8,QBLK=32,QB=QBLK*NW,KVBLK=64;
__device__ __forceinline__ int crow(int r,int hi){return (r&3)+8*(r>>2)+4*hi;}
#define SBAR() __builtin_amdgcn_sched_barrier(0)
__device__ __forceinline__ void cmask(f32x16&p0,f32x16&p1,int jb,int qrel,int hi){
  const float NEG=-INFINITY; int kb=64*jb+4*hi;
  #pragma unroll
  for(int r=0;r<16;++r){int kv=kb+(r&3)+8*(r>>2); if(kv>qrel)p0[r]=NEG; if(kv+32>qrel)p1[r]=NEG;}
}

constexpr int NSLOT=3, SLOTB=8192;
constexpr int LDS_K=0, LDS_V=NSLOT*SLOTB, LDS_WS=2*NSLOT*SLOTB, LDS_OST=LDS_WS+NW*64*4, LDS_BYTES=LDS_OST+NW*4096;
constexpr float C2=0.125f*1.4426950408889634f;
__device__ __forceinline__ void glds16(const void*gsrc,unsigned lds_dst){unsigned keep;
  asm volatile("s_mov_b32 %0, m0\n\ts_mov_b32 m0, %2\n\ts_nop 0\n\tglobal_load_lds_dwordx4 %1, off\n\ts_mov_b32 m0, %0":"=&s"(keep):"v"(gsrc),"s"(lds_dst):"memory");}
__device__ __forceinline__ float max3f(float a,float b,float c){float r;asm("v_max3_f32 %0, %1, %2, %3":"=v"(r):"v"(a),"v"(b),"v"(c));return r;}
__device__ __forceinline__ float max2f(float a,float b){float r;asm("v_max_f32_e32 %0, %1, %2":"=v"(r):"v"(a),"v"(b));return r;}
__device__ __forceinline__ float fadd_s(float a,float b){float r;asm("v_add_f32_e32 %0, %1, %2":"=v"(r):"v"(a),"v"(b));return r;}
__device__ __forceinline__ float fsub_s(float a,float b){float r;asm("v_sub_f32_e32 %0, %1, %2":"=v"(r):"v"(a),"v"(b));return r;}
typedef float f32x2_t __attribute__((ext_vector_type(2))); typedef __bf16 bf16x2_t __attribute__((ext_vector_type(2)));
__device__ __forceinline__ unsigned cvtpk_s(float lo,float hi){f32x2_t v={lo,hi};bf16x2_t b=__builtin_convertvector(v,bf16x2_t);return __builtin_bit_cast(unsigned,b);}
#define WAIT_BAR(N) asm volatile("s_waitcnt vmcnt(" #N ") lgkmcnt(0)\n\ts_barrier":::"memory")

__device__ __forceinline__ void qkt(f32x16&p0,f32x16&p1,const char*Kslot,const bf16x8*qr,const f32x16&negm,int r32,int hi){
  const char*kb=Kslot+hi*1024+r32*16;
  #pragma unroll
  for(int d0=0;d0<4;++d0){
    const bf16x8 b0=*reinterpret_cast<const bf16x8*>(kb+d0*2048);
    const bf16x8 b1=*reinterpret_cast<const bf16x8*>(kb+d0*2048+512);
    if(d0==0){p0=__builtin_amdgcn_mfma_f32_32x32x16_bf16(b0,qr[0],negm,0,0,0);p1=__builtin_amdgcn_mfma_f32_32x32x16_bf16(b1,qr[0],negm,0,0,0);}
    else{p0=__builtin_amdgcn_mfma_f32_32x32x16_bf16(b0,qr[d0],p0,0,0,0);p1=__builtin_amdgcn_mfma_f32_32x32x16_bf16(b1,qr[d0],p1,0,0,0);}}
}
typedef __attribute__((address_space(3))) const char* lds_cptr;
typedef short v4i16_t __attribute__((ext_vector_type(4)));
__device__ __forceinline__ void kload8(bf16x8*kf,lds_cptr kp){
  kf[0]=*(const __attribute__((address_space(3))) bf16x8*)(kp);      kf[1]=*(const __attribute__((address_space(3))) bf16x8*)(kp+512);
  kf[2]=*(const __attribute__((address_space(3))) bf16x8*)(kp+2048); kf[3]=*(const __attribute__((address_space(3))) bf16x8*)(kp+2560);
  kf[4]=*(const __attribute__((address_space(3))) bf16x8*)(kp+4096); kf[5]=*(const __attribute__((address_space(3))) bf16x8*)(kp+4608);
  kf[6]=*(const __attribute__((address_space(3))) bf16x8*)(kp+6144); kf[7]=*(const __attribute__((address_space(3))) bf16x8*)(kp+6656);
}
__device__ __forceinline__ void kload2(bf16x8*kf,lds_cptr kp,int j){ kf[2*j]=*(const __attribute__((address_space(3))) bf16x8*)(kp+j*2048); kf[2*j+1]=*(const __attribute__((address_space(3))) bf16x8*)(kp+j*2048+512); }
__device__ __forceinline__ s16x4 vtr(lds_cptr p){ return __builtin_bit_cast(s16x4,__builtin_amdgcn_ds_read_tr16_b64_v4i16((__attribute__((address_space(3))) v4i16_t*)p)); }
__device__ __forceinline__ float rowmax(const f32x16&p0,const f32x16&p1){
  float a=max3f(p0[0],p0[1],p1[0]),b=max3f(p0[2],p0[3],p1[1]);a=max3f(a,p1[2],p1[3]);
  #pragma unroll
  for(int r=4;r<16;r+=4){a=max3f(a,p0[r],p0[r+1]);b=max3f(b,p0[r+2],p0[r+3]);a=max3f(a,p1[r],p1[r+1]);b=max3f(b,p1[r+2],p1[r+3]);}
  const float m=max2f(a,b);
  auto rr=__builtin_amdgcn_permlane32_swap(__float_as_uint(m),__float_as_uint(m),false,false);
  return max2f(__uint_as_float(rr[0]),__uint_as_float(rr[1]));
}
__device__ __forceinline__ void pv(f32x16*o,int vb,bf16x8 pa0,bf16x8 pa1,bf16x8 pa2,bf16x8 pa3){
  #pragma unroll
  for(int d0=0;d0<2;++d0){s16x4 lo[4],hi[4];
    #pragma unroll
    for(int ks=0;ks<4;++ks){
      asm volatile("ds_read_b64_tr_b16 %0,%1 offset:%c2":"=&v"(lo[ks]):"v"(vb),"i"(d0*4096+ks*1024):"memory");
      asm volatile("ds_read_b64_tr_b16 %0,%1 offset:%c2":"=&v"(hi[ks]):"v"(vb),"i"(d0*4096+ks*1024+512):"memory");}
    asm volatile("s_waitcnt lgkmcnt(0)":::"memory");SBAR();
    #define PK(k) (bf16x8){lo[k][0],lo[k][1],lo[k][2],lo[k][3],hi[k][0],hi[k][1],hi[k][2],hi[k][3]}
    o[d0]=__builtin_amdgcn_mfma_f32_32x32x16_bf16(pa0,PK(0),o[d0],0,0,0);
    o[d0]=__builtin_amdgcn_mfma_f32_32x32x16_bf16(pa1,PK(1),o[d0],0,0,0);
    o[d0]=__builtin_amdgcn_mfma_f32_32x32x16_bf16(pa2,PK(2),o[d0],0,0,0);
    o[d0]=__builtin_amdgcn_mfma_f32_32x32x16_bf16(pa3,PK(3),o[d0],0,0,0);
    #undef PK
  }
}

#ifndef ATTN_STORE16
#define ATTN_STORE16(p,v) (*(u32x4*)(p)=(v))
#endif
template<int THRL> __device__ __forceinline__ void attn_unit(const bf16*Q0,const bf16*__restrict__ Kh,const bf16*__restrict__ Vh,bf16*O0,const int NT,char*shm){
  const int tid=threadIdx.x,lane=tid&63,r32=lane&31,hi=lane>>5; const int wid=__builtin_amdgcn_readfirstlane(tid>>6);
  const bf16*Qw=Q0+(long)(wid*QBLK)*QP;
  const unsigned lds0=(unsigned)(uintptr_t)shm;
  float*wsf=(float*)(shm+LDS_WS)+wid*64;
  const bf16*ksrc=Kh+(long)lane*KP+wid*8;
  const bf16*vsrc=Vh+(long)(16*(wid&3)+(lane>>2))*KP+(wid>>2)*32+(lane&3)*8;
  const unsigned kdst=lds0+LDS_K+wid*1024, vdst=lds0+LDS_V+wid*1024;
  #define DMA_K(t,slot) glds16(ksrc+(long)(t)*KVBLK*KP,(unsigned)__builtin_amdgcn_readfirstlane(kdst+(slot)))
  #define DMA_V(t,slot) glds16(vsrc+(long)(t)*KVBLK*KP,(unsigned)__builtin_amdgcn_readfirstlane(vdst+(slot)))
  const int vb0=(int)(lds0+LDS_V)+((lane>>4)&1)*32+(lane&3)*8+(4*hi+((lane&15)>>2))*64;
  const char*Kbase=shm+LDS_K; bf16x8 kf[8];
  const lds_cptr shm3=(lds_cptr)shm; const lds_cptr kp0=shm3+LDS_K+hi*1024+r32*16; const lds_cptr vp0=shm3+LDS_V+((lane>>4)&1)*32+(lane&3)*8+(4*hi+((lane&15)>>2))*64;
  DMA_K(0,0);DMA_V(0,0);DMA_K(1,SLOTB);
  bf16x8 qr[4];
  #pragma unroll
  for(int d0=0;d0<4;++d0)qr[d0]=*reinterpret_cast<const bf16x8*>(&Qw[(long)r32*QP+d0*16+hi*8]);
  float mhat=0.f,l_reg=0.f;f32x16 o[2];o[0]=f32x16{};o[1]=f32x16{};f32x16 negm=f32x16{};asm volatile("":"+v"(negm));
  #define CMASK(P0,P1,t) do{}while(0)
  bool resc=false;
  #define START(P0,P1) do{ const float rm=rowmax(P0,P1); resc=false; \
    { const float dl=rm; mhat=fadd_s(mhat,dl); \
      _Pragma("unroll") for(int r=0;r<16;++r){P0[r]=fsub_s(P0[r],dl);P1[r]=fsub_s(P1[r],dl);} \
      _Pragma("unroll") for(int r=0;r<16;++r)negm[r]=-mhat; asm volatile("":"+v"(negm)); } \
    _Pragma("unroll") for(int r=0;r<16;++r)P0[r]=__builtin_amdgcn_exp2f(P0[r]); }while(0)
  #define RESC() do{ if(resc){ asm volatile("s_waitcnt lgkmcnt(0)":::"memory"); \
      _Pragma("unroll") for(int d_=0;d_<2;++d_) _Pragma("unroll") for(int r=0;r<16;++r)o[d_][r]*=wsf[crow(r,hi)]; } }while(0)
  f32x16 pA0,pA1,pB0,pB1;
  int sl_prev=0,sl_cur=0,sl_next=SLOTB;
  #define ROT() do{sl_prev=sl_cur;sl_cur=sl_next;sl_next=(sl_next==(NSLOT-1)*SLOTB)?0:sl_next+SLOTB;}while(0)
  DMA_K(2,2*SLOTB);
  WAIT_BAR(3);
  qkt(pA0,pA1,Kbase,qr,negm,r32,hi);asm volatile("s_nop 15\n\ts_nop 7":"+v"(pA0),"+v"(pA1));CMASK(pA0,pA1,0);
  START(pA0,pA1);
  _Pragma("unroll") for(int r=0;r<16;++r)pA1[r]=__builtin_amdgcn_exp2f(pA1[r]);
  WAIT_BAR(0);
  DMA_K(3,0);DMA_V(1,SLOTB);
  ROT();
  kload8(kf,kp0+sl_cur);
  WAIT_BAR(2);
  s16x4 vlo[8],vhi[8]; u32x4 pw0,pw1,pw2,pw3;
  #define PKW(P,B) cvtpk_s(P[B],P[B+1])
  #define PAF(k) __builtin_bit_cast(bf16x8,pw##k)
  #define VFR(i) (bf16x8){vlo[i][0],vlo[i][1],vlo[i][2],vlo[i][3],vhi[i][0],vhi[i][1],vhi[i][2],vhi[i][3]}
  #define PIN(x) asm volatile("":"+v"(x))
  #define MX3(a,b,c) __builtin_fmaxf(__builtin_fmaxf((a),(b)),(c))
  #define GAPA(MF,A0,A1,A2,A3,W0,W1,PW) do{ MF; sacc+=A0; sacc+=A1; sacc+=A2; sacc+=A3; PIN(sacc); W0; W1; PIN(PW); SBAR(); }while(0)
  #define EX(v) __builtin_amdgcn_exp2f(v)
  #define GAPB(MF,X,B) do{ MF; X[B]=EX(X[B]); X[B+1]=EX(X[B+1]); X[B+2]=EX(X[B+2]); X[B+3]=EX(X[B+3]); PIN(X); SBAR(); }while(0)
  #define VRD(i) do{ vlo[i]=vtr(vp_+(((i)>>2)*4096+((i)&3)*1024)); vhi[i]=vtr(vp_+(((i)>>2)*4096+((i)&3)*1024+512)); }while(0)
  #define KRD(G,j) do{ if(G){ kload2(kf,kp0+sl_next,j); SBAR(); } }while(0)
  #define STEP(C0,C1,P0,P1,t,GK,GV,GL) do{ SBAR(); \
    const lds_cptr vp_=vp0+sl_prev; \
    VRD(0); SBAR(); float sacc=(P0[0]+P0[1]); \
    GAPA(C0=__builtin_amdgcn_mfma_f32_32x32x16_bf16(kf[0],qr[0],negm,0,0,0), P0[2],P0[3],P0[4],P0[5],     pw0[0]=PKW(P0,0), pw0[1]=PKW(P0,2), pw0); \
    VRD(4); SBAR(); GAPA(C1=__builtin_amdgcn_mfma_f32_32x32x16_bf16(kf[1],qr[0],negm,0,0,0), P0[6],P0[7],P0[8],P0[9],     pw0[2]=PKW(P0,4), pw0[3]=PKW(P0,6), pw0); \
    VRD(1); SBAR(); GAPA(C0=__builtin_amdgcn_mfma_f32_32x32x16_bf16(kf[2],qr[1],C0,0,0,0),   P0[10],P0[11],P0[12],P0[13], pw1[0]=PKW(P0,8), pw1[1]=PKW(P0,10), pw1); \
    VRD(5); SBAR(); GAPA(C1=__builtin_amdgcn_mfma_f32_32x32x16_bf16(kf[3],qr[1],C1,0,0,0),   P0[14],P0[15],P1[0],P1[1],   pw1[2]=PKW(P0,12),pw1[3]=PKW(P0,14), pw1); \
    VRD(2); SBAR(); GAPA(C0=__builtin_amdgcn_mfma_f32_32x32x16_bf16(kf[4],qr[2],C0,0,0,0),   P1[2],P1[3],P1[4],P1[5],     pw2[0]=PKW(P1,0), pw2[1]=PKW(P1,2), pw2); \
    VRD(6); SBAR(); GAPA(C1=__builtin_amdgcn_mfma_f32_32x32x16_bf16(kf[5],qr[2],C1,0,0,0),   P1[6],P1[7],P1[8],P1[9],     pw2[2]=PKW(P1,4), pw2[3]=PKW(P1,6), pw2); \
    VRD(3); SBAR(); GAPA(C0=__builtin_amdgcn_mfma_f32_32x32x16_bf16(kf[6],qr[3],C0,0,0,0),   P1[10],P1[11],P1[12],P1[13], pw3[0]=PKW(P1,8), pw3[1]=PKW(P1,10), pw3); \
    VRD(7); SBAR(); GAPA(C1=__builtin_amdgcn_mfma_f32_32x32x16_bf16(kf[7],qr[3],C1,0,0,0),   P1[14],P1[15],0.f,0.f,       pw3[2]=PKW(P1,12),pw3[3]=PKW(P1,14), pw3); \
    l_reg+=sacc; \
    if(GK){DMA_K((t)+3,sl_cur);} if(GV){DMA_V((t)+1,sl_next);} \
    CMASK(C0,C1,t); \
    { float a=MX3(C0[0],C0[1],C1[0]),b=MX3(C0[2],C0[3],C1[1]); a=MX3(a,C1[2],C1[3]); \
      _Pragma("unroll") for(int r=4;r<16;r+=4){a=MX3(a,C0[r],C0[r+1]);b=MX3(b,C0[r+2],C0[r+3]);a=MX3(a,C1[r],C1[r+1]);b=MX3(b,C1[r+2],C1[r+3]);} \
      float rm=__builtin_fmaxf(a,b); { auto rr=__builtin_amdgcn_permlane32_swap(__float_as_uint(rm),__float_as_uint(rm),false,false); rm=__builtin_fmaxf(__uint_as_float(rr[0]),__uint_as_float(rr[1])); } \
      resc=false; \
      if(__builtin_expect(__any(rm>(float)THRL),0)){ const float dl=__builtin_fmaxf(rm,0.f); mhat+=dl; \
        _Pragma("unroll") for(int r=0;r<16;++r){C0[r]-=dl;C1[r]-=dl;} \
        _Pragma("unroll") for(int r=0;r<16;++r)negm[r]=-mhat; asm volatile("":"+v"(negm)); \
        const float f=__builtin_amdgcn_exp2f(-dl); l_reg*=f; if(hi==0)wsf[r32]=f; resc=true; } } \
    SBAR(); \
    GAPB(o[0]=__builtin_amdgcn_mfma_f32_32x32x16_bf16(PAF(0),VFR(0),o[0],0,0,0), C0,0); \
    GAPB(o[1]=__builtin_amdgcn_mfma_f32_32x32x16_bf16(PAF(0),VFR(4),o[1],0,0,0), C0,4); \
    KRD(GL,0); GAPB(o[0]=__builtin_amdgcn_mfma_f32_32x32x16_bf16(PAF(1),VFR(1),o[0],0,0,0), C0,8); \
    KRD(GL,1); GAPB(o[1]=__builtin_amdgcn_mfma_f32_32x32x16_bf16(PAF(1),VFR(5),o[1],0,0,0), C0,12); \
    KRD(GL,2); GAPB(o[0]=__builtin_amdgcn_mfma_f32_32x32x16_bf16(PAF(2),VFR(2),o[0],0,0,0), C1,0); \
    KRD(GL,3); GAPB(o[1]=__builtin_amdgcn_mfma_f32_32x32x16_bf16(PAF(2),VFR(6),o[1],0,0,0), C1,4); \
    GAPB(o[0]=__builtin_amdgcn_mfma_f32_32x32x16_bf16(PAF(3),VFR(3),o[0],0,0,0), C1,8); \
    GAPB(o[1]=__builtin_amdgcn_mfma_f32_32x32x16_bf16(PAF(3),VFR(7),o[1],0,0,0), C1,12); \
    }while(0)
  int t=1;
  #undef CMASK
  #define CMASK(P0,P1,t) do{}while(0)
  for(;t+5<NT;t+=2){
    STEP(pB0,pB1,pA0,pA1,t,true,true,true);     WAIT_BAR(2); RESC(); ROT();
    STEP(pA0,pA1,pB0,pB1,t+1,true,true,true);   WAIT_BAR(2); RESC(); ROT();
  }
  #undef CMASK
  #define CMASK(P0,P1,t) do{}while(0)
  #define ENDW(tt) do{ if((tt)+3<NT){WAIT_BAR(2);} else if((tt)+2<NT){WAIT_BAR(1);} else {WAIT_BAR(0);} }while(0)
  for(;t+1<NT;t+=2){
    STEP(pB0,pB1,pA0,pA1,t,(t+3<NT),(t+1<NT),(t+1<NT));       ENDW(t);   RESC(); ROT();
    STEP(pA0,pA1,pB0,pB1,t+1,(t+4<NT),(t+2<NT),(t+2<NT));     ENDW(t+1); RESC(); ROT();
  }
  STEP(pB0,pB1,pA0,pA1,NT-1,false,false,false); RESC();
  { float sacc=pB0[0]+pB0[1]; _Pragma("unroll") for(int r=2;r<16;++r)sacc+=pB0[r]; _Pragma("unroll") for(int r=0;r<16;++r)sacc+=pB1[r]; l_reg+=sacc;
    pw0=(u32x4){PKW(pB0,0),PKW(pB0,2),PKW(pB0,4),PKW(pB0,6)};pw1=(u32x4){PKW(pB0,8),PKW(pB0,10),PKW(pB0,12),PKW(pB0,14)};pw2=(u32x4){PKW(pB1,0),PKW(pB1,2),PKW(pB1,4),PKW(pB1,6)};pw3=(u32x4){PKW(pB1,8),PKW(pB1,10),PKW(pB1,12),PKW(pB1,14)};
    SBAR(); pv(o,vb0+sl_cur,PAF(0),PAF(1),PAF(2),PAF(3)); }
  #undef PKW
  #undef PAF
  #undef VFR
  #undef PIN
  #undef MX3
  #undef GAPA
  #undef GAPB
  #undef EX
  #undef VRD
  #undef KRD
  #undef STEP
  #undef ENDW
  {auto rr=__builtin_amdgcn_permlane32_swap(__float_as_uint(l_reg),__float_as_uint(l_reg),false,false);l_reg=__uint_as_float(rr[0])+__uint_as_float(rr[1]);}
  if(hi==0)wsf[32+r32]=l_reg;asm volatile("s_waitcnt lgkmcnt(0)":::"memory");
  float rli[16];
  #pragma unroll
  for(int r=0;r<16;++r)rli[r]=__builtin_amdgcn_rcpf(wsf[32+crow(r,hi)]);
  bf16*Ow=O0+(long)(wid*QBLK)*OP;
  { bf16*stg=(bf16*)(shm+LDS_OST)+wid*2048;
    #pragma unroll
    for(int r=0;r<16;++r){const int orow=crow(r,hi);
      #pragma unroll
      for(int d0=0;d0<2;++d0)stg[orow*64+d0*32+r32]=__float2bfloat16(o[d0][r]*rli[r]);}
    asm volatile("s_waitcnt lgkmcnt(0)":::"memory");
    #pragma unroll
    for(int i=0;i<4;++i){const int row=i*8+(lane>>3),ch=lane&7; const u32x4 v=*(const u32x4*)(stg+row*64+ch*8); ATTN_STORE16(Ow+(long)row*OP+ch*8,v);} }
  asm volatile("s_waitcnt lgkmcnt(0)\n\ts_barrier":::"memory");
  #undef DMA_K
  #undef DMA_V
  #undef CMASK
  #undef START
  #undef RESC
  #undef ROT
}
constexpr int ATTN_LDS_BYTES=LDS_BYTES;
#undef SBAR
#undef WAIT_BAR
}

__device__ __forceinline__ void attn_phase_run(const P& p, unsigned char* lds_generic, int layer) {
    typedef attn_body::bf16 abf;
    const int G = gridDim.x, bx = blockIdx.x, vcu = (G % 8 == 0) ? (bx % 8) * (G / 8) + bx / 8 : bx;
    const abf* Q = (const abf*)(p.ws + WS_ATTQ); const abf* K = (const abf*)(p.ws + WS_ATTK); const abf* V = (const abf*)(p.ws + WS_ATTV); abf* X = (abf*)(p.ws + WS_X);
    if (G == 256) {
        const int x = vcu >> 5, qb = vcu & 31, b = x >> 2, kvh = (x >> 1) & 1;
#pragma unroll 1
        for (int i = 0; i < 2; ++i) { const int h = kvh * 4 + 2 * (x & 1) + i; const long r0 = (long)b * SEQ + qb * 256;
            attn_body::attn_unit<8>(Q + r0 * 512 + h * 64, K + (long)b * KEYS * 128 + kvh * 64, V + (long)b * KEYS * 128 + kvh * 64, X + r0 * 1536 + 768 + h * 64, KEYS / 64, (char*)lds_generic); }
    } else {
#pragma unroll 1
        for (int u = vcu; u < 512; u += G) { const int qb = u & 31, h = (u >> 5) & 7, b = u >> 8, kvh = h >> 2; const long r0 = (long)b * SEQ + qb * 256;
            attn_body::attn_unit<8>(Q + r0 * 512 + h * 64, K + (long)b * KEYS * 128 + kvh * 64, V + (long)b * KEYS * 128 + kvh * 64, X + r0 * 1536 + 768 + h * 64, KEYS / 64, (char*)lds_generic); }
    }
    if (layer == 0) {
#pragma unroll 1
        for (int u = vcu; u < 16; u += G) { const int b = u >> 3, h = u & 7, kvh = h >> 2; const long r0 = NLAT + (long)b * CTX;
            attn_body::attn_unit<8>(Q + r0 * 512 + h * 64, K + (long)b * KEYS * 128 + kvh * 64, V + (long)b * KEYS * 128 + kvh * 64, X + r0 * 1536 + 768 + h * 64, CTX / 64, (char*)lds_generic); }
    }
}

__device__ __forceinline__ void ph_fft1(const P& p, LAS unsigned char* lds, int layer) {
    int nt2 = 2; asm volatile("" : "+s"(nt2));
    { fg::PlainSched S{(const char*)(p.ws + WS_F1), (const char*)(p.ws + WS_UT), 256, 256, 1, 128, (int)gridDim.x, (int)blockIdx.x, nt2};
      fg::EpiFft1 E{p.ws}; fg::gemm_phase(lds, 256, 256, S, E); }
    if (layer == 0) { fg::PlainSched S{(const char*)(p.ws + WS_FC), (const char*)(p.ws + WS_UTC), 256, 256, 2, 2, (int)gridDim.x, (int)((blockIdx.x + 128) % gridDim.x), 4};
      fg::EpiFftC E{p.ws}; fg::gemm_phase(lds, 256, 256, S, E); }
}
__device__ __forceinline__ void ph_fft3(const P& p, LAS unsigned char* lds) {
    int nt2 = 2; asm volatile("" : "+s"(nt2));
    fg::PlainSched S{(const char*)(p.ws + WS_F2), (const char*)(p.ws + WS_Z), 256, 256, 1, 256, (int)gridDim.x, (int)blockIdx.x, nt2};
    fg::EpiFft3 E{p.ws}; fg::gemm_phase(lds, 256, 256, S, E);
}
__device__ __forceinline__ void ph_mix1(const P& p, LAS unsigned char* lds, int layer) {
    ph_fft1(p, lds, layer);
    const int nconv = layer == 0 ? 264 : 256;
    const int n0 = nconv, n1 = n0 + NB * NCHUNK * 4;
    for (int it = gridDim.x - 1 - blockIdx.x; it < n1; it += gridDim.x) {
        if (it < n0) { if (it < 256) conv_item(p, lds, layer, it >> 7, (it & 127) * 64); else conv_item(p, lds, layer, 2 + ((it - 256) >> 2), ((it - 256) & 3) * 64); }
        else ret_kv_item(p, lds, layer, it - n0);
    }
    __syncthreads();
}
__device__ __forceinline__ void ph_mix2(const P& p, LAS unsigned char* lds, unsigned char* lds_generic, int layer) {
    for (int it = blockIdx.x; it < 128; it += gridDim.x) ret_scan_item(p, layer, it);
    __syncthreads();
    ph_fft3(p, lds);
    attn_phase_run(p, lds_generic, layer);
    __syncthreads();
}
__device__ __forceinline__ void ph_mix3(const P& p, LAS unsigned char* lds, int layer, bool ctxlater) {
    for (int it = blockIdx.x; it < NB * NCHUNK * 4; it += gridDim.x) {
        const int n = (it >> 2) % NCHUNK; if ((layer == 1 || ctxlater) && n < 2) continue;
        ret_out_item(p, lds, layer, it);
    }
    __syncthreads();
}
__device__ __forceinline__ void ctx_ret_items(const P& p, LAS unsigned char* lds) {
    const int u = blockIdx.x;
    if (u < 16) { const int b = u >> 3, n = (u >> 2) & 1, h = u & 3;
        ret_out_item(p, lds, 0, (b * NCHUNK + n) * 4 + h);
        asm volatile("s_waitcnt vmcnt(0)" ::: "memory"); __syncthreads();
        if (threadIdx.x == 0) { __builtin_amdgcn_fence(__ATOMIC_RELEASE, "agent");
            __hip_atomic_fetch_add((unsigned*)(p.ws + WS_CTL) + CW_CCNT + (8 * 3) * 16, 1u, __ATOMIC_RELAXED, __HIP_MEMORY_SCOPE_AGENT); }
        __syncthreads(); }
}
__device__ __forceinline__ void ctx_ret_wait(const P& p) {
    if (threadIdx.x == 0) { unsigned* c = (unsigned*)(p.ws + WS_CTL) + CW_CCNT + (8 * 3) * 16; unsigned* tmo = (unsigned*)(p.ws + WS_CTL) + CW_TMO; unsigned sp = 0u;
        while (__hip_atomic_load(c, __ATOMIC_RELAXED, __HIP_MEMORY_SCOPE_AGENT) < 16u) { __builtin_amdgcn_s_sleep(1);
            if ((++sp & 255u) == 0u) { if (__hip_atomic_load(tmo, __ATOMIC_RELAXED, __HIP_MEMORY_SCOPE_AGENT)) break; if (sp > (1u << 22)) { atomicAdd(tmo, 1u); break; } } }
        __builtin_amdgcn_fence(__ATOMIC_ACQUIRE, "agent"); }
    __syncthreads();
}

namespace sk {
typedef short bf16x8 __attribute__((ext_vector_type(8)));
__device__ __forceinline__ void tile64(LAS unsigned char* lds, const bf16* A, int lda, const bf16* Bt, int ldb, int K, float (&out)[8]) {
    const int tid = threadIdx.x, lane = tid & 63, w = tid >> 6, kc = K >> 3;
    const bf16* ap = A + (size_t)(lane & 15) * lda + w * kc + 8 * (lane >> 4); const bf16* bp = Bt + (size_t)(lane & 15) * ldb + w * kc + 8 * (lane >> 4);
    f32x4 acc[4][4];
#pragma unroll
    for (int i = 0; i < 4; ++i)
#pragma unroll
        for (int j = 0; j < 4; ++j) acc[i][j] = (f32x4){0.f, 0.f, 0.f, 0.f};
#pragma unroll 2
    for (int k0 = 0; k0 < kc; k0 += 32) {
        bf16x8 af[4], bfr[4];
#pragma unroll
        for (int i = 0; i < 4; ++i) { af[i] = *(const bf16x8*)(ap + (size_t)(16 * i) * lda + k0); bfr[i] = *(const bf16x8*)(bp + (size_t)(16 * i) * ldb + k0); }
#pragma unroll
        for (int i = 0; i < 4; ++i)
#pragma unroll
            for (int j = 0; j < 4; ++j) acc[i][j] = __builtin_amdgcn_mfma_f32_16x16x32_bf16(af[i], bfr[j], acc[i][j], 0, 0, 0);
    }
    LAS float* part = (LAS float*)lds;
    __syncthreads();
#pragma unroll
    for (int i = 0; i < 4; ++i)
#pragma unroll
        for (int j = 0; j < 4; ++j)
#pragma unroll
            for (int r = 0; r < 4; ++r) part[((w * 16 + i * 4 + j) * 4 + r) * 64 + lane] = acc[i][j][r];
    __syncthreads();
#pragma unroll
    for (int q = 0; q < 8; ++q) { float sacc = 0.f;
#pragma unroll
        for (int ww = 0; ww < 8; ++ww) sacc += part[ww * 4096 + tid + 512 * q];
        out[q] = sacc; }
}
__device__ __forceinline__ void tile64_f8(LAS unsigned char* lds, const unsigned char* A, int lda, const unsigned char* Bt, int ldb, int K, float (&out)[8]) {
    const int tid = threadIdx.x, lane = tid & 63, w = tid >> 6;
    const unsigned char* ap = A + (size_t)(lane & 15) * lda + 32 * (lane >> 4); const unsigned char* bp = Bt + (size_t)(lane & 15) * ldb + 32 * (lane >> 4);
    f32x4 acc[4][4];
#pragma unroll
    for (int i = 0; i < 4; ++i)
#pragma unroll
        for (int j = 0; j < 4; ++j) acc[i][j] = (f32x4){0.f, 0.f, 0.f, 0.f};
    for (int ks = w; ks * 128 < K; ks += 8) {
        fg::i32x8 af[4], bfr[4];
#pragma unroll
        for (int i = 0; i < 4; ++i) { af[i] = *(const fg::i32x8*)(ap + (size_t)(16 * i) * lda + ks * 128); bfr[i] = *(const fg::i32x8*)(bp + (size_t)(16 * i) * ldb + ks * 128); }
#pragma unroll
        for (int i = 0; i < 4; ++i)
#pragma unroll
            for (int j = 0; j < 4; ++j) acc[i][j] = __builtin_amdgcn_mfma_scale_f32_16x16x128_f8f6f4(af[i], bfr[j], acc[i][j], 0, 0, 0, 0x7f7f7f7f, 0, 0x7a7a7a7a);
    }
    LAS float* part = (LAS float*)lds;
    __syncthreads();
#pragma unroll
    for (int i = 0; i < 4; ++i)
#pragma unroll
        for (int j = 0; j < 4; ++j)
#pragma unroll
            for (int r = 0; r < 4; ++r) part[((w * 16 + i * 4 + j) * 4 + r) * 64 + lane] = acc[i][j][r];
    __syncthreads();
#pragma unroll
    for (int q = 0; q < 8; ++q) { float sacc = 0.f;
#pragma unroll
        for (int ww = 0; ww < 8; ++ww) sacc += part[ww * 4096 + tid + 512 * q];
        out[q] = sacc; }
}
__device__ __forceinline__ void elem_rc(int tid, int q, int& row, int& col) { const int e = tid + 512 * q, t16 = e >> 8, reg = (e >> 6) & 3, lane = e & 63; row = 16 * (t16 >> 2) + 4 * (lane >> 4) + reg; col = 16 * (t16 & 3) + (lane & 15); }
}
__device__ __forceinline__ void mini_merge_ctx(const P& p, LAS unsigned char* lds, int layer) {
    const bf16* X = (const bf16*)(p.ws + WS_X); const bf16* WB = (const bf16*)(p.ws + WS_WB) + (size_t)layer * 1024 * 1536; const unsigned char* G = (const unsigned char*)(p.ws + WS_G); bf16* Mg = (bf16*)(p.ws + WS_MERGED);
    for (int it = gridDim.x - 1 - blockIdx.x; it < (NCTX / 64) * 16; it += gridDim.x) { const int r0 = NLAT + (it >> 4) * 64, c0 = (it & 15) * 64;
        float tot[8];
#pragma unroll
        for (int q = 0; q < 8; ++q) tot[q] = 0.f;
#pragma unroll 1
        for (int br = 0; br < 4; ++br) { const int koff = br == 0 ? 0 : (br == 1 ? 512 : (br == 2 ? 768 : 1280)), klen = (br & 1) ? 256 : 512;
            float o[8]; sk::tile64(lds, X + (size_t)r0 * 1536 + koff, 1536, WB + (size_t)c0 * 1536 + koff, 1536, klen, o);
#pragma unroll
            for (int q = 0; q < 8; ++q) { int rr, cc; sk::elem_rc(threadIdx.x, q, rr, cc); tot[q] += o[q] * ((float)G[(size_t)(r0 + rr) * 4096 + br * 1024 + c0 + cc] * (1.f / 255.f)); } }
#pragma unroll
        for (int q = 0; q < 8; ++q) { int rr, cc; sk::elem_rc(threadIdx.x, q, rr, cc); Mg[(size_t)(r0 + rr) * 1024 + c0 + cc] = f2bf(tot[q]); } }
    __syncthreads();
}
__device__ __forceinline__ void mini_resid_ctx(const P& p, LAS unsigned char* lds, int layer, const bf16* A, int lda, const bf16* Bt, int K, int chunk, int xnorm = -1, int nlayer = 0, int nwhich = 0, const float* hsrc = nullptr) {
    const float* g = mods(p, layer, 2, chunk); float* hc = (float*)(p.ws + WS_HCTX); if (hsrc == nullptr) hsrc = hc;
    for (int it = gridDim.x - 1 - blockIdx.x; it < (NCTX / 64) * 16; it += gridDim.x) { const int rl = (it >> 4) * 64, c0 = (it & 15) * 64;
        float o[8]; sk::tile64(lds, A + (size_t)(NLAT + rl) * lda, lda, Bt + (size_t)c0 * K, K, K, o);
        if (xnorm < 0) {
#pragma unroll
            for (int q = 0; q < 8; ++q) { int rr, cc; sk::elem_rc(threadIdx.x, q, rr, cc); float* h = hc + (size_t)(rl + rr) * D + c0 + cc; *h = *h + g[c0 + cc] * o[q]; }
        } else {
#pragma unroll
            for (int q = 0; q < 8; ++q) { int rr, cc; sk::elem_rc(threadIdx.x, q, rr, cc); float* h = hc + (size_t)(rl + rr) * D + c0 + cc;
                __hip_atomic_store(h, hsrc[(size_t)(rl + rr) * D + c0 + cc] + g[c0 + cc] * o[q], __ATOMIC_RELAXED, __HIP_MEMORY_SCOPE_AGENT); }
            asm volatile("s_waitcnt vmcnt(0)" ::: "memory"); __syncthreads();
            if (threadIdx.x == 0) { unsigned* c = (unsigned*)(p.ws + WS_CTL) + CW_CCNT + (8 * xnorm + (it >> 4)) * 16; unsigned* tmo = (unsigned*)(p.ws + WS_CTL) + CW_TMO;
                __hip_atomic_fetch_add(c, 1u, __ATOMIC_RELAXED, __HIP_MEMORY_SCOPE_AGENT);
                unsigned sp = 0u;
                while (__hip_atomic_load(c, __ATOMIC_RELAXED, __HIP_MEMORY_SCOPE_AGENT) < 16u) { __builtin_amdgcn_s_sleep(1);
                    if ((++sp & 255u) == 0u) { if (__hip_atomic_load(tmo, __ATOMIC_RELAXED, __HIP_MEMORY_SCOPE_AGENT)) break; if (sp > (1u << 22)) { atomicAdd(tmo, 1u); break; } } }
                __builtin_amdgcn_fence(__ATOMIC_ACQUIRE, "agent"); }
            __syncthreads();
            { const int w = threadIdx.x >> 6, lane = threadIdx.x & 63;
              if (w < 4) { __builtin_amdgcn_fence(__ATOMIC_ACQUIRE, "agent"); norm_row(p, nlayer, nwhich, NLAT + rl + (it & 15) * 4 + w, lane); } }
            __syncthreads();
        } }
    __syncthreads();
}
__device__ __forceinline__ void ph_merge(const P& p, LAS unsigned char* lds, int layer, int nrows) {
    fg::MergeSched S{(const char*)(p.ws + WS_X), (const char*)(p.ws + WS_WB) + (size_t)layer * 1024 * 1536 * 2, nrows / 256, (int)gridDim.x, (int)blockIdx.x};
    fg::EpiMerge E{(const unsigned char*)(p.ws + WS_G), (bf16*)(p.ws + WS_MERGED)};
    fg::gemm_phase(lds, 1536, 1536, S, E);
}
__device__ __forceinline__ void ph_gemm_resid(const P& p, LAS unsigned char* lds, int layer, const bf16* A, int lda, const bf16* Bt, int K, int chunk, int nrows) {
    fg::PlainSched S{(const char*)A, (const char*)Bt, lda, K, nrows / 256, 4, (int)gridDim.x, (int)blockIdx.x, K / 64};
    fg::EpiResid E{p.out, (float*)(p.ws + WS_HCTX), (const float*)(p.ws + WS_MODS) + (size_t)layer * 3 * 6144, chunk};
    fg::gemm_phase(lds, lda, K, S, E);
}
__device__ __forceinline__ void ph_gemm_resid_norm(const P& p, LAS unsigned char* lds, int layer, const bf16* A, int lda, const bf16* Bt, int K, int chunk, int x, int nlayer, int nwhich, const float* hin) {
    fg::PlainSched S{(const char*)A, (const char*)Bt, lda, K, NLAT / 256, 4, (int)gridDim.x, (int)blockIdx.x, K / 64};
    unsigned* ctl = (unsigned*)(p.ws + WS_CTL);
    fg::EpiResidNorm E{hin, p.out, (const float*)(p.ws + WS_MODS) + (size_t)layer * 3 * 6144, chunk,
        p.in[nwhich == 0 ? 6 : 7] + nlayer * D, (const float*)(p.ws + WS_MODS) + (size_t)nlayer * 3 * 6144, nwhich == 0 ? 0 : 3, nwhich == 0 ? 1 : 4, (bf16*)(p.ws + WS_A), nwhich == 0 ? p.ws + WS_A8 : (unsigned char*)nullptr,
        (float*)(p.ws + WS_CTL + CTL_XBUF) + (size_t)x * 65536, ctl + CW_PCNT + 64 * 16 * x, ctl + CW_TMO, lds};
    fg::gemm_phase(lds, lda, K, S, E);
}
__device__ __forceinline__ void ph_ffn1(const P& p, LAS unsigned char* lds) {
    fg::PlainSched S{(const char*)(p.ws + WS_A), (const char*)(p.ws + WS_FFN1), D, D, MROWS / 256, 22, (int)gridDim.x, (int)blockIdx.x, D / 64};
    fg::EpiSwiglu E{(bf16*)(p.ws + WS_HMID)};
    fg::gemm_phase(lds, D, D, S, E);
}
__device__ __forceinline__ int moe_tiles(const P& p, LAS int* tile_e) {
    const unsigned* ctl = (const unsigned*)(p.ws + WS_CTL); int t = 0;
    for (int e = 0; e < NEXP; ++e) { const int c = (int)ctl[CW_CNT + e], nt = (c + 255) >> 8; for (int q = 0; q < nt; ++q) { if (threadIdx.x == 0) tile_e[t + q] = e; } t += nt; }
    __syncthreads();
    return t;
}
__device__ __forceinline__ void ph_assign_gather(const P& p, LAS unsigned char* lds) {
    const int tid = threadIdx.x, bid = blockIdx.x, G = gridDim.x;
    LAS int* sbase = (LAS int*)lds;
    LAS int* stot = sbase + 8;
    LAS int* spst = stot + 8;
    LAS int* sexp = spst + 16;
    LAS int* sslot = sexp + 128;
    const unsigned* cntb = (const unsigned*)(p.ws + WS_ROUTE) + 16384 * 6;
    const int* tok_e = (const int*)(p.ws + WS_ROUTE); int* tok_slot = (int*)(p.ws + WS_ROUTE) + 16384 * 4;
    __syncthreads();
    { const int e = tid >> 6, l = tid & 63; int tot = 0, below = 0;
      for (int b = l; b < G; b += 64) { const int c = (int)cntb[b * NEXP + e]; tot += c; if (b < bid) below += c; }
#pragma unroll
      for (int o = 1; o < 64; o <<= 1) { tot += __shfl_xor(tot, o); below += __shfl_xor(below, o); }
      if (l == 0) { sbase[e] = below; stot[e] = tot; } }
    if (tid < 128) { const int li = tid >> 1, w = li & 7, k = li >> 3, tok = (bid * 8 + w) + k * (G * 8); sexp[tid] = tok < NLAT ? tok_e[tok * 2 + (tid & 1)] : -1; }
    __syncthreads();
    if (tid == 0) { int t = 0; for (int e = 0; e < NEXP; ++e) { spst[e] = t * 256; t += (stot[e] + 255) >> 8; } spst[NEXP] = t * 256;
        if (bid == 0) { unsigned* ctl = (unsigned*)(p.ws + WS_CTL); for (int e = 0; e < NEXP; ++e) ctl[CW_CNT + e] = (unsigned)stot[e]; } }
    __syncthreads();
    if (tid < 128) { const int e = sexp[tid]; int slot = -1;
        if (e >= 0) { int rank = 0; for (int a = 0; a < tid; ++a) rank += (sexp[a] == e) ? 1 : 0; slot = spst[e] + sbase[e] + rank;
            const int li = tid >> 1, w = li & 7, k = li >> 3, tok = (bid * 8 + w) + k * (G * 8); tok_slot[tok * 2 + (tid & 1)] = slot; }
        sslot[tid] = slot; }
    __syncthreads();
    const int lane = tid & 63, wv = tid >> 6; const unsigned char* A8 = p.ws + WS_A8; unsigned char* FS8 = p.ws + WS_FS;
    for (int a = wv; a < 128; a += 8) { const int slot = sslot[a]; if (slot < 0) continue; const int li = a >> 1, w = li & 7, k = li >> 3, tok = (bid * 8 + w) + k * (G * 8);
        *(u32x4*)(FS8 + (size_t)slot * D + lane * 16) = *(const u32x4*)(A8 + (size_t)tok * D + lane * 16); }
    { int idx = 0;
      for (int e = 0; e < NEXP; ++e) { const int lo_ = spst[e] + stot[e], hi_ = spst[e + 1];
          for (int r = lo_ + ((bid * 8 + wv - idx) % (G * 8) + (G * 8)) % (G * 8); r < hi_; r += G * 8) {
              *(u32x4*)(FS8 + (size_t)r * D + lane * 16) = (u32x4){0u, 0u, 0u, 0u}; }
          idx += hi_ - lo_; } }
    __syncthreads();
}
__device__ __forceinline__ void ph_moe1(const P& p, LAS unsigned char* lds) {
    LAS int* tile_e = (LAS int*)(lds + fg::STAGE_BYTES); const int nt = moe_tiles(p, tile_e);
    fg::ExpertSched S{(const char*)(p.ws + WS_FS), (const char*)(p.ws + WS_MOE1), D / 2, D / 2, nt, 22, (int)gridDim.x, (int)blockIdx.x, D / 128, tile_e, (size_t)5632 * D};
    fg::EpiSwiglu8 E{p.ws + WS_HMOE};
    fg::gemm_phase<fg::EpiSwiglu8, fg::ExpertSched, true>(lds, D / 2, D / 2, S, E);
}
__device__ __forceinline__ void ph_moe2(const P& p, LAS unsigned char* lds) {
    LAS int* tile_e = (LAS int*)(lds + fg::STAGE_BYTES); const int nt = moe_tiles(p, tile_e);
    const int nbig = nt < 128 ? nt : 128;
    fg::ExpertSched S{(const char*)(p.ws + WS_HMOE), (const char*)(p.ws + WS_MOE2), FFN / 2, FFN / 2, nbig, 4, (int)gridDim.x, (int)blockIdx.x, FFN / 128, tile_e, (size_t)D * FFN};
    fg::EpiStore E{(bf16*)(p.ws + WS_Y2), D};
    fg::gemm_phase<fg::EpiStore, fg::ExpertSched, true>(lds, FFN / 2, FFN / 2, S, E);
    const unsigned char* A = p.ws + WS_HMOE; bf16* Y = (bf16*)(p.ws + WS_Y2);
    for (int it = blockIdx.x; it < (nt - nbig) * 64; it += gridDim.x) {
        const int rt = nbig + (it >> 6), r0 = rt * 256 + ((it >> 4) & 3) * 64, c0 = (it & 15) * 64;
        const unsigned char* B = p.ws + WS_MOE2 + (size_t)tile_e[rt] * D * FFN;
        float o[8]; sk::tile64_f8(lds, A + (size_t)r0 * FFN, FFN, B + (size_t)c0 * FFN, FFN, FFN, o);
#pragma unroll
        for (int q = 0; q < 8; ++q) { int rr, cc; sk::elem_rc(threadIdx.x, q, rr, cc); Y[(size_t)(r0 + rr) * D + c0 + cc] = f2bf(o[q]); } }
    __syncthreads();
}
__device__ __forceinline__ void ph_combine(const P& p, int layer) {
    const int lane = threadIdx.x & 63, gw = blockIdx.x * 8 + (threadIdx.x >> 6), ngw = gridDim.x * 8;
    const float* tok_w = (const float*)(p.ws + WS_ROUTE) + 16384 * 2; const int* tok_slot = (const int*)(p.ws + WS_ROUTE) + 16384 * 4; const bf16* Y = (const bf16*)(p.ws + WS_Y2);
    for (int r = gw; r < NLAT; r += ngw) {
        const int s0 = tok_slot[r * 2], s1 = tok_slot[r * 2 + 1]; const float w0 = tok_w[r * 2], w1 = tok_w[r * 2 + 1];
        const float* g = mods(p, layer, row_mi(r), 5); float* h = p.out + (size_t)r * D;
#pragma unroll
        for (int j = 0; j < 4; ++j) { const int c = 4 * lane + 256 * j;
            const u32x2 a = *(const u32x2*)(Y + (size_t)s0 * D + c), bq = *(const u32x2*)(Y + (size_t)s1 * D + c); const f32x4 gg = *(const f32x4*)(g + c); f32x4 hv = *(f32x4*)(h + c);
            hv.x += gg.x * (w0 * __uint_as_float(a.x << 16) + w1 * __uint_as_float(bq.x << 16)); hv.y += gg.y * (w0 * __uint_as_float(a.x & 0xffff0000u) + w1 * __uint_as_float(bq.x & 0xffff0000u));
            hv.z += gg.z * (w0 * __uint_as_float(a.y << 16) + w1 * __uint_as_float(bq.y << 16)); hv.w += gg.w * (w0 * __uint_as_float(a.y & 0xffff0000u) + w1 * __uint_as_float(bq.y & 0xffff0000u));
            *(f32x4*)(h + c) = hv; }
    }
}

#define XB_TMO      128
static_assert(CW_TMO == CW_BAR + XB_TMO, "tmo word");
#define XB_XCNT(j)  (256  + 64 * (j))
#define XB_XSUB(j)  (1280 + 64 * (j))
#define XB_XGEN(j)  (2304 + 64 * (j))
#define XB_TOP      3328
#define XB_TOPGEN   3392
#define XCD_BAR_WORDS 3456
#define XB_SPIN_CAP (1u << 22)
__device__ __forceinline__ unsigned xb_ld(unsigned* p)              { return __hip_atomic_load(p, __ATOMIC_RELAXED, __HIP_MEMORY_SCOPE_AGENT); }
__device__ __forceinline__ unsigned xb_add(unsigned* p, unsigned v) { return __hip_atomic_fetch_add(p, v, __ATOMIC_RELAXED, __HIP_MEMORY_SCOPE_AGENT); }
__device__ __forceinline__ unsigned xb_xcc_id() { return (unsigned)__builtin_amdgcn_s_getreg((3 << 11) | 20) & 0xFu; }
#define XB_SPIN(cond, bar) do { unsigned _sp = 0; while (cond) { __builtin_amdgcn_s_sleep(1); \
    if ((++_sp & 255u) == 0u) { if (xb_ld(&(bar)[XB_TMO])) break; if (_sp > XB_SPIN_CAP) { atomicAdd(&(bar)[XB_TMO], 1u); break; } } } } while (0)
struct XcdBarrier { unsigned* bar; unsigned x; volatile LAS unsigned* st; };
__device__ __forceinline__ XcdBarrier xcd_barrier_post(unsigned* bar, volatile LAS unsigned* st) {
    XcdBarrier b; b.bar = bar; b.x = xb_xcc_id(); b.st = st;
    if (threadIdx.x == 0) (void)xb_add(&bar[XB_XCNT(b.x)], 1u);
    return b;
}
__device__ __forceinline__ void xcd_barrier_complete(unsigned* bar, unsigned x, unsigned& nloc, unsigned& nx) {
    const unsigned G = gridDim.x * gridDim.y * gridDim.z;
    unsigned sum, cnt, mine, sp = 0u;
    for (;;) {
        sum = 0u; cnt = 0u; mine = 0u;
#pragma unroll
        for (unsigned j = 0; j < 16; ++j) { const unsigned c = xb_ld(&bar[XB_XCNT(j)]); sum += c; cnt += (c > 0u) ? 1u : 0u; mine = (j == x) ? c : mine; }
        if (sum == G) break;
        __builtin_amdgcn_s_sleep(1);
        if ((++sp & 255u) == 0u) { if (xb_ld(&bar[XB_TMO])) break; if (sp > XB_SPIN_CAP) { atomicAdd(&bar[XB_TMO], 1u); break; } }
    }
    nloc = mine > 0u ? mine : 1u; nx = cnt > 0u ? cnt : 1u;
}
__device__ __forceinline__ void xcd_barrier(const XcdBarrier& b) {
    asm volatile("s_waitcnt vmcnt(0)" ::: "memory");
    __syncthreads();
    if (threadIdx.x == 0) {
        unsigned* bar = b.bar;
        __builtin_amdgcn_s_waitcnt(0);
        unsigned nloc = b.st[0], nx = b.st[1];
        if (nloc == 0u) { xcd_barrier_complete(bar, b.x, nloc, nx); b.st[0] = nloc; b.st[1] = nx; }
        const unsigned old = xb_add(&bar[XB_XSUB(b.x)], 1u);
        const unsigned gen = old / nloc;
        if (old + 1u == (gen + 1u) * nloc) {
            __builtin_amdgcn_fence(__ATOMIC_RELEASE, "agent");
            asm volatile("s_waitcnt vmcnt(0)" ::: "memory");
            const unsigned og = xb_add(&bar[XB_TOP], 1u);
            const unsigned tg = og / nx;
            if (og + 1u == (tg + 1u) * nx) xb_add(&bar[XB_TOPGEN], 1u);
            else XB_SPIN(xb_ld(&bar[XB_TOPGEN]) == tg, bar);
            __builtin_amdgcn_fence(__ATOMIC_ACQUIRE, "agent");
            xb_add(&bar[XB_XGEN(b.x)], 1u);
            asm volatile("s_waitcnt vmcnt(0)" ::: "memory");
        } else {
            XB_SPIN(xb_ld(&bar[XB_XGEN(b.x)]) == gen, bar);
            asm volatile("buffer_inv sc0" ::: "memory");
            asm volatile("s_waitcnt vmcnt(0)" ::: "memory");
        }
    }
    __syncthreads();
}

constexpr int NPHASE = 23;
constexpr int LDS_BYTES = 150 * 1024;
__global__ void __launch_bounds__(NTHREADS, 2) mk(P p, int lo, int hi, int fuse) {
    extern __shared__ __attribute__((aligned(16))) unsigned char lds_raw[];
    LAS unsigned char* lds = (LAS unsigned char*)lds_raw;
    volatile LAS unsigned* misc = (volatile LAS unsigned*)(lds + LDS_BYTES - 64);
    if (threadIdx.x < 16) misc[threadIdx.x] = 0u;
    __syncthreads();
    XcdBarrier bar; bar.bar = (unsigned*)(p.ws + WS_CTL) + CW_BAR; bar.x = 0; bar.st = misc;
    if (hi - lo > 1) bar = xcd_barrier_post((unsigned*)(p.ws + WS_CTL) + CW_BAR, misc);
#if MK_SINGLE
    cg::this_grid().sync();
#endif
#ifndef PROBE_MASK
#define PROBE_MASK 0u
#endif
#ifndef AMP_A
#define AMP_A (-1)
#define AMP_B (-1)
#define AMP_MUL 15
#endif
#define AMP(k) do { if ((k) == AMP_A && blockIdx.x == 0 && threadIdx.x == 0) { const unsigned long long t = __builtin_amdgcn_s_memrealtime(); misc[8] = (unsigned)t; } \
    if ((k) == AMP_B && blockIdx.x == 0 && threadIdx.x == 0) { const unsigned t1 = (unsigned)__builtin_amdgcn_s_memrealtime(), dt = (t1 - misc[8]) * AMP_MUL; while ((unsigned)__builtin_amdgcn_s_memrealtime() - t1 < dt) __builtin_amdgcn_s_sleep(8); } } while (0)
#define PH(k, body) do { if (lo <= (k) && (k) < hi) { if ((k) > lo) { xcd_barrier(bar); } AMP(k); body; \
    if ((PROBE_MASK >> (k)) & 1u) { xcd_barrier(bar); body; } } } while (0)
#define LAYER_PHASES(L, base) \
    PH(base + 0, ph_win(p, lds, L)); \
    PH(base + 1, ph_mix1(p, lds, L)); \
    PH(base + 2, ph_mix2(p, lds, lds_raw, L)); \
    PH(base + 3, ph_mix3(p, lds, L, fuse != 0)); \
    PH(base + 4, { if (L == 0 && fuse) ctx_ret_items(p, lds); ph_merge(p, lds, L, NLAT); if (L == 0) { if (fuse && (int)(gridDim.x - 1 - blockIdx.x) < (NCTX / 64) * 16) ctx_ret_wait(p); mini_merge_ctx(p, lds, L); } }); \
    PH(base + 5, { if (L == 0 && fuse) { ph_gemm_resid_norm(p, lds, 0, (const bf16*)(p.ws + WS_MERGED), 1024, (const bf16*)(p.ws + WS_WOUT), D, 2, 0, 0, 1, p.in[0]); mini_resid_ctx(p, lds, 0, (const bf16*)(p.ws + WS_MERGED), 1024, (const bf16*)(p.ws + WS_WOUT), D, 2, 0, 0, 1, p.in[2]); } \
        else { ph_gemm_resid(p, lds, L, (const bf16*)(p.ws + WS_MERGED), 1024, (const bf16*)(p.ws + WS_WOUT) + (size_t)L * D * D, D, 2, NLAT); if (L == 0) mini_resid_ctx(p, lds, L, (const bf16*)(p.ws + WS_MERGED), 1024, (const bf16*)(p.ws + WS_WOUT), D, 2); } });
    PH(0, ph_prologue(p, lds));
    PH(1, ph_norm(p, lds, 0, 0, true, false, MROWS, !fuse));
    LAYER_PHASES(0, 2)
    if (!fuse) PH(8, ph_norm(p, lds, 0, 1, false, false, MROWS));
    PH(9, ph_ffn1(p, lds));
    PH(10, { if (fuse) { ph_gemm_resid_norm(p, lds, 0, (const bf16*)(p.ws + WS_HMID), FFN, (const bf16*)(p.ws + WS_FFN2), FFN, 5, 1, 1, 0, p.out); mini_resid_ctx(p, lds, 0, (const bf16*)(p.ws + WS_HMID), FFN, (const bf16*)(p.ws + WS_FFN2), FFN, 5, 1, 1, 0); }
        else { ph_gemm_resid(p, lds, 0, (const bf16*)(p.ws + WS_HMID), FFN, (const bf16*)(p.ws + WS_FFN2), FFN, 5, NLAT); mini_resid_ctx(p, lds, 0, (const bf16*)(p.ws + WS_HMID), FFN, (const bf16*)(p.ws + WS_FFN2), FFN, 5); } });
    if (!fuse) PH(11, ph_norm(p, lds, 1, 0, false, false, MROWS));
    LAYER_PHASES(1, 12)
    PH(18, ph_norm(p, lds, 1, 1, false, true, NLAT));
    PH(19, { ph_assign_gather(p, lds); ph_moe_convert(p, lds); });
    PH(20, ph_moe1(p, lds));
    PH(21, ph_moe2(p, lds));
    PH(22, ph_combine(p, 1));
#undef PH
#undef LAYER_PHASES
}

extern "C" void kernel_launch(void* const* d_in, const int* in_sizes, int n_in, void* d_out, int out_size, void* d_ws, size_t ws_size, hipStream_t stream) {
    static int grid = 0;
    if (grid == 0) {
        if (n_in != 30 || out_size != NLAT * D || ws_size < WS_END) { fprintf(stderr, "kernel_launch: unexpected shapes (n_in %d out %d ws %zu)\n", n_in, out_size, ws_size); grid = -1; return; }
        int dev = 0, cus = 0, per_cu = 0;
        hipGetDevice(&dev); hipDeviceGetAttribute(&cus, hipDeviceAttributeMultiprocessorCount, dev);
        hipFuncSetAttribute((const void*)mk, hipFuncAttributeMaxDynamicSharedMemorySize, LDS_BYTES);
        hipOccupancyMaxActiveBlocksPerMultiprocessor(&per_cu, (const void*)mk, NTHREADS, LDS_BYTES);
        if (per_cu < 1) { fprintf(stderr, "kernel_launch: occupancy query says %d blocks per CU\n", per_cu); grid = -1; return; }
        grid = cus;
    }
    if (grid < 0) return;
    hipMemsetAsync((char*)d_ws + WS_CTL, 0, CTL_BYTES, stream);
    P p{};
    for (int i = 0; i < 30; ++i) p.in[i] = (const float*)d_in[i];
    p.out = (float*)d_out; p.ws = (unsigned char*)d_ws;
#if MK_SINGLE
    int lo = 0, hi = NPHASE, fuse = grid == 256 ? 1 : 0; void* args[] = {&p, &lo, &hi, &fuse};
    hipLaunchCooperativeKernel((const void*)mk, dim3(grid), dim3(NTHREADS), args, LDS_BYTES, stream);
#else
    for (int ph = 0; ph < NPHASE; ++ph) hipLaunchKernelGGL(mk, dim3(grid), dim3(NTHREADS), LDS_BYTES, stream, p, ph, ph + 1, 0);
#endif
}
```

```cpp
#include <hip/hip_runtime.h>
#include <hip/hip_cooperative_groups.h>
#include <cstdio>
#include <cstdint>
namespace cg = cooperative_groups;

#ifndef MK_SINGLE
#define MK_SINGLE 1
#endif

typedef unsigned short bf16;
typedef float f32x4 __attribute__((ext_vector_type(4)));
typedef unsigned u32x4 __attribute__((ext_vector_type(4)));
typedef unsigned u32x2 __attribute__((ext_vector_type(2)));
#define LAS __attribute__((address_space(3)))

constexpr int D = 1024, NB = 2, SEQ = 8192, CTX = 256, NLAT = NB * SEQ, NCTX = NB * CTX, MROWS = NLAT + NCTX;
constexpr int INC = 6656, FFN = 2816, NEXP = 8, KEYS = CTX + SEQ;
constexpr int NCHUNK = 66;
constexpr float EPS = 1e-6f;
constexpr float QSCALE = 0.125f * 1.4426950408889634f;
constexpr int MOE_ROWS = 34816;
constexpr int NTHREADS = 512;

constexpr size_t MiB = 1u << 20;
constexpr size_t WS_CTL = 0, CTL_BYTES = 1 * MiB;
constexpr size_t WS_MODS = 1 * MiB;
constexpr size_t WS_ROPE = 2 * MiB;
constexpr size_t WS_F1 = 4 * MiB;
constexpr size_t WS_F2 = WS_F1 + 131072;
constexpr size_t WS_FC = WS_F2 + 131072;
constexpr size_t WS_TW = WS_FC + 262144;
constexpr size_t WS_ROUTE = 5 * MiB;
constexpr size_t WS_HCTX = 6 * MiB;
constexpr size_t WS_WIN = 8 * MiB;
constexpr size_t WS_WB = 34 * MiB;
constexpr size_t WS_WOUT = 40 * MiB;
constexpr size_t WS_FFN1 = 44 * MiB;
constexpr size_t WS_FFN2 = 55 * MiB;
constexpr size_t WS_A = 61 * MiB;
constexpr size_t WS_X = 94 * MiB;
constexpr size_t WS_Y = 144 * MiB;
constexpr size_t WS_RETQ = WS_Y;
constexpr size_t WS_RETK = WS_RETQ + (size_t)MROWS * 256 * 2;
constexpr size_t WS_RETV = WS_RETK + (size_t)MROWS * 256 * 2;
constexpr size_t WS_RETG = WS_RETV + (size_t)MROWS * 256 * 2;
constexpr size_t WS_ATTQ = WS_Y + 33 * MiB;
constexpr size_t WS_ATTK = WS_Y + 50 * MiB;
constexpr size_t WS_ATTV = WS_Y + 55 * MiB;
constexpr size_t WS_CONV = WS_Y + 60 * MiB;
constexpr size_t WS_UT = WS_Y + 77 * MiB;
constexpr size_t WS_UTC = WS_Y + 93 * MiB;
constexpr size_t WS_Z = WS_Y + 94 * MiB;
constexpr size_t WS_RETS = WS_Y + 126 * MiB;
constexpr size_t WS_MERGED = WS_Y + 143 * MiB;
constexpr size_t WS_G = 320 * MiB;
constexpr size_t WS_MOE1 = WS_G;
constexpr size_t WS_MOE2 = WS_G + (size_t)NEXP * 5632 * 1024 * 2;
constexpr size_t WS_HMID = WS_Y;
constexpr size_t WS_HMOE = 61 * MiB;
constexpr size_t WS_FS = 252 * MiB;
constexpr size_t WS_A8 = 386 * MiB;
constexpr size_t WS_WIN8 = 430 * MiB;
constexpr size_t WS_RETS2 = 452 * MiB;
constexpr size_t WS_Y2 = 160 * MiB;
constexpr size_t WS_END = 469 * MiB;
static_assert(WS_MERGED + (size_t)MROWS * 1024 * 2 <= WS_G, "map");
static_assert(WS_HMOE + (size_t)MOE_ROWS * FFN * 2 <= WS_FS && WS_FS + (size_t)MOE_ROWS * 1024 * 2 <= WS_G, "map moe");
static_assert(WS_MOE2 + (size_t)NEXP * 1024 * FFN * 2 <= WS_END, "map moe w");
static_assert(WS_G + (size_t)MROWS * 4096 <= WS_A8 && WS_A8 + (size_t)NLAT * 1024 <= WS_MOE2 && WS_MOE2 + (size_t)NEXP * 1024 * FFN <= WS_WIN8 && WS_WIN8 + (size_t)2 * 4096 * 1024 <= WS_RETS2, "map fp8 w_in");
constexpr int CW_CNT = 64;
constexpr int CW_CUR = 128;
constexpr int CW_BAR = 4096;
constexpr int CW_TMO = CW_BAR + 128;
constexpr int CW_PCNT = 8192;
constexpr int CW_CCNT = 8192 + 4 * 64 * 16;
constexpr size_t CTL_XBUF = 128 * 1024;

struct P {
    const float* in[30];
    float* out;
    unsigned char* ws;
};

__device__ __forceinline__ float bf2f(bf16 v) { return __uint_as_float((unsigned)v << 16); }
__device__ __forceinline__ bf16 f2bf(float f) { unsigned u = __float_as_uint(f); return (bf16)((u + 0x7fffu + ((u >> 16) & 1u)) >> 16); }
__device__ __forceinline__ unsigned pk2(float lo, float hi) { return (unsigned)f2bf(lo) | ((unsigned)f2bf(hi) << 16); }
__device__ __forceinline__ float sigmoidf_(float x) { return 1.f / (1.f + __expf(-x)); }
__device__ __forceinline__ float siluf_(float x) { return x / (1.f + __expf(-x)); }
__device__ __forceinline__ float sigmoid_fast(float x) { return __builtin_amdgcn_rcpf(1.f + __builtin_amdgcn_exp2f(-1.4426950408889634f * x)); }
__device__ __forceinline__ float silu_fast(float x) { return x * __builtin_amdgcn_rcpf(1.f + __builtin_amdgcn_exp2f(-1.4426950408889634f * x)); }
__device__ __forceinline__ float wave_sum(float v) {
#pragma unroll
    for (int o = 1; o < 64; o <<= 1) v += __shfl_xor(v, o);
    return v;
}
__device__ __forceinline__ int row_mi(int r) { return r < NLAT ? (r >> 13) : 2; }
__device__ __forceinline__ float* hrow(const P& p, int r) { return r < NLAT ? p.out + (size_t)r * D : (float*)(p.ws + WS_HCTX) + (size_t)(r - NLAT) * D; }
__device__ __forceinline__ const float* mods(const P& p, int layer, int mi, int chunk) { return (const float*)(p.ws + WS_MODS) + ((size_t)(layer * 3 + mi) * 6 + chunk) * D; }

__device__ __forceinline__ int rowmap(int mode, int n) {
    if (mode == 0) return n;
    if (mode == 1 || mode == 2) return 8 * (n >> 2) + (n & 3) + (mode == 2 ? 4 : 0);
    const int tile = n >> 8, l = n & 255, head = l >> 6, d = l & 63;
    const bool ropet = tile == 1 || tile == 2 || tile == 5 || tile == 6 || (tile == 7 && head < 2);
    if (ropet) { const int i = d & 31, nn = d >> 5; return tile * 256 + 128 * (i >> 4) + 32 * head + 8 * ((i >> 2) & 3) + 4 * nn + (i & 3); }
    if (tile == 7) return tile * 256 + 128 * (d >> 5) + 32 * head + 8 * ((d >> 3) & 3) + (d & 7);
    return n;
}
__device__ __forceinline__ void conv_tile(LAS float* scr, const float* src, int ldn, int k0, int n0, bf16* dst, int ldd, int koff, int mode) {
    const int tid = threadIdx.x;
    __syncthreads();
#pragma unroll
    for (int i = 0; i < 8; ++i) { const int e = tid + i * NTHREADS, kk = e >> 6, nn = e & 63; scr[kk * 65 + nn] = src[(size_t)(k0 + kk) * ldn + n0 + nn]; }
    __syncthreads();
    const int nn = tid >> 3, kc = (tid & 7) * 8;
    u32x4 o; o.x = pk2(scr[(kc + 0) * 65 + nn], scr[(kc + 1) * 65 + nn]); o.y = pk2(scr[(kc + 2) * 65 + nn], scr[(kc + 3) * 65 + nn]);
    o.z = pk2(scr[(kc + 4) * 65 + nn], scr[(kc + 5) * 65 + nn]); o.w = pk2(scr[(kc + 6) * 65 + nn], scr[(kc + 7) * 65 + nn]);
    *(u32x4*)(dst + (size_t)rowmap(mode, n0 + nn) * ldd + koff + k0 + kc) = o;
}
constexpr float F8_WSCALE = 32.f;
__device__ __forceinline__ unsigned pk4_fp8(float a, float b, float c, float d) { int w = 0; w = __builtin_amdgcn_cvt_pk_fp8_f32(a, b, w, false); w = __builtin_amdgcn_cvt_pk_fp8_f32(c, d, w, true); return (unsigned)w; }
__device__ __forceinline__ void conv_tile2_f8(LAS float* scr, const float* src, int ldn, unsigned char* dst8, int ldd, int mode, int k0a, int n0a, int k0b, int n0b, bool two) {
    const int tid = threadIdx.x;
    f32x4 va[2], vb[2];
#pragma unroll
    for (int i = 0; i < 2; ++i) { const int e = tid + i * NTHREADS, kk = e >> 4, n4 = (e & 15) * 4;
        va[i] = *(const f32x4*)(src + (size_t)(k0a + kk) * ldn + n0a + n4);
        if (two) vb[i] = *(const f32x4*)(src + (size_t)(k0b + kk) * ldn + n0b + n4); }
    __syncthreads();
#pragma unroll
    for (int i = 0; i < 2; ++i) { const int e = tid + i * NTHREADS, kk = e >> 4, n4 = (e & 15) * 4;
#pragma unroll
        for (int q = 0; q < 4; ++q) { scr[kk * 65 + n4 + q] = va[i][q]; if (two) scr[64 * 65 + kk * 65 + n4 + q] = vb[i][q]; } }
    __syncthreads();
    const int nn = tid >> 3, kc = (tid & 7) * 8;
#pragma unroll
    for (int t = 0; t < 2; ++t) { if (t == 1 && !two) break; const LAS float* sp = scr + t * 64 * 65; const int k0 = t ? k0b : k0a, n0 = t ? n0b : n0a;
        u32x2 o; o.x = pk4_fp8(sp[(kc + 0) * 65 + nn] * F8_WSCALE, sp[(kc + 1) * 65 + nn] * F8_WSCALE, sp[(kc + 2) * 65 + nn] * F8_WSCALE, sp[(kc + 3) * 65 + nn] * F8_WSCALE);
        o.y = pk4_fp8(sp[(kc + 4) * 65 + nn] * F8_WSCALE, sp[(kc + 5) * 65 + nn] * F8_WSCALE, sp[(kc + 6) * 65 + nn] * F8_WSCALE, sp[(kc + 7) * 65 + nn] * F8_WSCALE);
        *(u32x2*)(dst8 + (size_t)rowmap(mode, n0 + nn) * ldd + k0 + kc) = o; }
}
__device__ __forceinline__ void conv_tile128_f8(LAS float* scr, const float* src, int ldn, unsigned char* dst8, int ldd, int mode, int k0, int n0) {
    const int tid = threadIdx.x;
    f32x4 v[8];
#pragma unroll
    for (int i = 0; i < 8; ++i) { const int e = tid + i * NTHREADS, kk = e >> 5, n4 = (e & 31) * 4; v[i] = *(const f32x4*)(src + (size_t)(k0 + kk) * ldn + n0 + n4); }
    __syncthreads();
#pragma unroll
    for (int i = 0; i < 8; ++i) { const int e = tid + i * NTHREADS, kk = e >> 5, n4 = (e & 31) * 4;
#pragma unroll
        for (int q = 0; q < 4; ++q) scr[kk * 129 + n4 + q] = v[i][q]; }
    __syncthreads();
    const int nn = tid >> 2, kc = (tid & 3) * 32;
    u32x4 o[2];
#pragma unroll
    for (int h = 0; h < 2; ++h) { const LAS float* sp = scr + (kc + h * 16) * 129 + nn;
        o[h].x = pk4_fp8(sp[0] * F8_WSCALE, sp[129] * F8_WSCALE, sp[2 * 129] * F8_WSCALE, sp[3 * 129] * F8_WSCALE);
        o[h].y = pk4_fp8(sp[4 * 129] * F8_WSCALE, sp[5 * 129] * F8_WSCALE, sp[6 * 129] * F8_WSCALE, sp[7 * 129] * F8_WSCALE);
        o[h].z = pk4_fp8(sp[8 * 129] * F8_WSCALE, sp[9 * 129] * F8_WSCALE, sp[10 * 129] * F8_WSCALE, sp[11 * 129] * F8_WSCALE);
        o[h].w = pk4_fp8(sp[12 * 129] * F8_WSCALE, sp[13 * 129] * F8_WSCALE, sp[14 * 129] * F8_WSCALE, sp[15 * 129] * F8_WSCALE); }
    unsigned char* d = dst8 + (size_t)rowmap(mode, n0 + nn) * ldd + k0 + kc;
    *(u32x4*)d = o[0]; *(u32x4*)(d + 16) = o[1];
}
struct CJob { const float* src; int K, N; bf16* dst; int ldd, koff, mode, ldn; };
__device__ __forceinline__ CJob get_job(const P& p, int j) {
    CJob c;
    if (j < 10) { const int l = j / 5, t = j % 5; bf16* wb = (bf16*)(p.ws + WS_WB) + (size_t)l * 1024 * 1536;
        if (t == 0) c = CJob{p.in[8] + (size_t)l * D * INC, D, l == 0 ? INC : 2560, (bf16*)(p.ws + WS_WIN) + (size_t)l * INC * D, D, 0, 3, INC};
        else if (t == 1) c = CJob{p.in[13] + (size_t)l * 256 * D, 256, D, wb, 1536, 512, 0};
        else if (t == 2) c = CJob{p.in[16] + (size_t)l * 512 * D, 512, D, wb, 1536, 768, 0};
        else if (t == 3) c = CJob{p.in[21] + (size_t)l * 256 * D, 256, D, wb, 1536, 1280, 0};
        else c = CJob{p.in[22] + (size_t)l * D * D, D, D, (bf16*)(p.ws + WS_WOUT) + (size_t)l * D * D, D, 0, 0}; }
    else if (j == 10) c = CJob{p.in[23], D, FFN, (bf16*)(p.ws + WS_FFN1), D, 0, 1};
    else if (j == 11) c = CJob{p.in[24], D, FFN, (bf16*)(p.ws + WS_FFN1), D, 0, 2};
    else c = CJob{p.in[25], FFN, D, (bf16*)(p.ws + WS_FFN2), FFN, 0, 0};
    return c;
}
__device__ __forceinline__ CJob get_moe_job(const P& p, int j) {
    const int e = j / 3, t = j % 3; CJob c;
    const float* sg = p.in[27]; const float* su = p.in[28]; const float* sd = p.in[29];
    asm volatile("" : "+s"(sg), "+s"(su), "+s"(sd));
    if (t == 0) c = CJob{sg + (size_t)e * D * FFN, D, FFN, (bf16*)(p.ws + WS_MOE1 + (size_t)e * 5632 * D), D, 0, 1};
    else if (t == 1) c = CJob{su + (size_t)e * D * FFN, D, FFN, (bf16*)(p.ws + WS_MOE1 + (size_t)e * 5632 * D), D, 0, 2};
    else c = CJob{sd + (size_t)e * FFN * D, FFN, D, (bf16*)(p.ws + WS_MOE2 + (size_t)e * D * FFN), FFN, 0, 0};
    return c;
}
template <bool MOE> __device__ __forceinline__ void run_conv_jobs(const P& p, LAS float* scr, int njobs, int bid, int nb) {
    int base = 0, base2 = 0;
    for (int j = 0; j < njobs; ++j) {
        const CJob jb = MOE ? get_moe_job(p, j) : get_job(p, j); const int nn = jb.N / 64, cnt = (jb.K / 64) * nn, ldn = jb.ldn ? jb.ldn : jb.N;
        const int first = ((bid - base) % nb + nb) % nb;
        if (MOE) { const int nn2 = jb.N / 128, cnt2 = (jb.K / 128) * nn2; const int first2 = ((bid - base2) % nb + nb) % nb;
            for (int i = first2; i < cnt2; i += nb) conv_tile128_f8(scr, jb.src, jb.N, (unsigned char*)jb.dst, jb.ldd, jb.mode, (i / nn2) * 128, (i % nn2) * 128);
            base2 += cnt2; }
        else for (int i = first; i < cnt; i += nb) conv_tile(scr, jb.src, ldn, (i / nn) * 64, (i % nn) * 64, jb.dst, jb.ldd, jb.koff, jb.mode);
        base += cnt;
    }
}
__device__ __forceinline__ void ph_prologue(const P& p, LAS unsigned char* lds) {
    const int tid = threadIdx.x, bid = blockIdx.x, nb = gridDim.x;
    const int gt = bid * NTHREADS + tid, ngt = nb * NTHREADS;
    LAS float* scr = (LAS float*)lds;
    run_conv_jobs<false>(p, scr, 13, bid, nb);
    __syncthreads();
    for (int i = bid; i < 512; i += nb) { const int l = i >> 8, t = i & 255;
        conv_tile128_f8(scr, p.in[8] + (size_t)l * D * INC + 2560, INC, p.ws + WS_WIN8 + (size_t)l * 4096 * 1024, 1024, 0, (t >> 5) * 128, (t & 31) * 128); }
    __syncthreads();
    {
        LAS float* tc = (LAS float*)lds; LAS float* tsn = tc + 64;
        __syncthreads();
        if (tid < 64) { tc[tid] = cospif(tid * (2.f / 64.f)); tsn[tid] = sinpif(tid * (2.f / 64.f)); }
        __syncthreads();
        const float s = 1.0f / sqrtf(64.f * 8192.f);
        for (int e = gt; e < 2 * 512 * 1024; e += ngt) {
            const int n = e & 1023, kk = (e >> 10) & 511, l = e >> 19;
            const int part = kk >> 8, g = (kk >> 6) & 3, c = kk & 63;
            const float* W = p.in[9] + (size_t)l * 256 * D + (size_t)(g * 64) * D + n;
            float acc = 0.f;
#pragma unroll 8
            for (int c2 = 0; c2 < 64; ++c2) { const int m = (c * c2) & 63; const float t = part == 0 ? tc[m] : -tsn[m]; acc += t * W[(size_t)c2 * D]; }
            ((bf16*)(p.ws + WS_WB))[(size_t)l * 1024 * 1536 + (size_t)n * 1536 + kk] = f2bf(acc * s);
        }
        __syncthreads();
    }
    {
        float* rc = (float*)(p.ws + WS_ROPE); float* rs = rc + SEQ * 32;
        for (int e = gt; e < SEQ * 32; e += ngt) {
            const int s = e >> 5, i = e & 31; const float inv = powf(10000.f, -(float)(i & 15) / 16.f);
            const float pos = (float)(i < 16 ? (s >> 6) : (s & 63)); const float ang = pos * inv;
            rc[e] = cosf(ang); rs[e] = sinf(ang);
        }
    }
    {
        bf16* F1 = (bf16*)(p.ws + WS_F1); bf16* F2 = (bf16*)(p.ws + WS_F2); bf16* FC = (bf16*)(p.ws + WS_FC);
        for (int e = gt; e < 256 * 256; e += ngt) {
            const int rho = e >> 8, n1 = e & 255; float v = 0.f;
            if (n1 < 128) { const int k1 = (rho >> 5) * 16 + (rho & 15), c = (rho >> 4) & 1, m = (k1 * n1) & 127; v = c == 0 ? cospif(m * (2.f / 128.f)) : -sinpif(m * (2.f / 128.f)); }
            F1[e] = f2bf(v);
            float w = 0.f;
            if (rho < 128 && n1 < 128) { const int c2 = rho >> 6, k2 = rho & 63, c = n1 >> 6, n2 = n1 & 63, m = (k2 * n2) & 63; const float cs = cospif(m * (2.f / 64.f)), sn = sinpif(m * (2.f / 64.f));
                w = c2 == 0 ? (c == 0 ? cs : sn) : (c == 0 ? sn : -cs); }
            F2[e] = f2bf(w);
        }
        float* TW = (float*)(p.ws + WS_TW);
        for (int e = gt; e < 128 * 64; e += ngt) { const int k1 = e >> 6, n2 = e & 63; TW[2 * e] = cospif((k1 * n2) * (2.f / 8192.f)); TW[2 * e + 1] = sinpif((k1 * n2) * (2.f / 8192.f)); }
        const float sc = sqrtf(32.f);
        for (int e = gt; e < 512 * 256; e += ngt) { const int rho = e >> 8, n = e & 255, c2 = rho >> 8, k = rho & 255, m = (k * n) & 255; FC[e] = f2bf(sc * (c2 == 0 ? cospif(m * (2.f / 256.f)) : sinpif(m * (2.f / 256.f)))); }
    }
    {
        LAS float* sv = (LAS float*)lds;
        LAS float* red = sv + 3 * 1024;
        __syncthreads();
        for (int e = tid; e < 3 * 1024; e += NTHREADS) { const int j = e >> 10, k = e & 1023; const float v = j < 2 ? p.in[1][j * D + k] : p.in[3][k]; sv[e] = siluf_(v); }
        __syncthreads();
        const int kq = tid >> 6, cl = tid & 63;
        for (int it = bid; it < 2 * 96; it += nb) {
            const int l = it / 96, n = (it % 96) * 64 + cl;
            const float* W = p.in[4] + (size_t)l * D * 6144 + n;
            float a0 = 0.f, a1 = 0.f, a2 = 0.f;
#pragma unroll 16
            for (int k = kq; k < D; k += 8) { const float w = W[(size_t)k * 6144]; a0 += sv[k] * w; a1 += sv[1024 + k] * w; a2 += sv[2048 + k] * w; }
            red[(kq * 3 + 0) * 64 + cl] = a0; red[(kq * 3 + 1) * 64 + cl] = a1; red[(kq * 3 + 2) * 64 + cl] = a2;
            __syncthreads();
            if (tid < 192) { const int j = tid >> 6; float s = 0.f;
#pragma unroll
                for (int q = 0; q < 8; ++q) s += red[(q * 3 + j) * 64 + cl];
                ((float*)(p.ws + WS_MODS))[(size_t)(l * 3 + j) * 6144 + n] = s + p.in[5][l * 6144 + n]; }
            __syncthreads();
        }
    }
}
__device__ __forceinline__ void ph_moe_convert(const P& p, LAS unsigned char* lds) {
    LAS float* scr = (LAS float*)lds;
    const int bid = blockIdx.x, nb = gridDim.x;
    run_conv_jobs<true>(p, scr, 24, bid, nb);
    __syncthreads();
}

__device__ __forceinline__ void ph_norm(const P& p, LAS unsigned char* lds, int layer, int which, bool first, bool route, int nrows, bool copy = true) {
    LAS unsigned* cnt_lds = (LAS unsigned*)lds;
    if (route) { __syncthreads(); if (threadIdx.x < NEXP) cnt_lds[threadIdx.x] = 0u; __syncthreads(); }
    const int lane = threadIdx.x & 63, gw = blockIdx.x * 8 + (threadIdx.x >> 6), ngw = gridDim.x * 8;
    const float* gain = p.in[which == 0 ? 6 : 7] + layer * D;
    bf16* A = (bf16*)(p.ws + WS_A);
    for (int r = gw; r < nrows; r += ngw) {
        const int mi = row_mi(r);
        const float* src = first ? (r < NLAT ? p.in[0] + (size_t)r * D : p.in[2] + (size_t)(r - NLAT) * D) : hrow(p, r);
        const float* shift = mods(p, layer, mi, which == 0 ? 0 : 3); const float* scale = mods(p, layer, mi, which == 0 ? 1 : 4);
        f32x4 v[4]; float ss = 0.f;
#pragma unroll
        for (int j = 0; j < 4; ++j) { v[j] = *(const f32x4*)(src + 4 * lane + 256 * j); ss += v[j].x * v[j].x + v[j].y * v[j].y + v[j].z * v[j].z + v[j].w * v[j].w; }
        if (first && copy) { float* h = hrow(p, r);
#pragma unroll
            for (int j = 0; j < 4; ++j) *(f32x4*)(h + 4 * lane + 256 * j) = v[j]; }
        const float rstd = rsqrtf(wave_sum(ss) * (1.f / D) + EPS);
        float lg[8];
#pragma unroll
        for (int e = 0; e < 8; ++e) lg[e] = 0.f;
#pragma unroll
        for (int j = 0; j < 4; ++j) {
            const int c = 4 * lane + 256 * j;
            const f32x4 g = *(const f32x4*)(gain + c), sc = *(const f32x4*)(scale + c), sh = *(const f32x4*)(shift + c);
            f32x4 y = v[j] * rstd * g * (sc + 1.f) + sh;
            u32x2 o; o.x = pk2(y.x, y.y); o.y = pk2(y.z, y.w);
            if (!route) *(u32x2*)(A + (size_t)r * D + c) = o;
            if ((which == 0 || route) && r < NLAT) *(unsigned*)(p.ws + WS_A8 + (size_t)r * D + c) = pk4_fp8(y.x, y.y, y.z, y.w);
            if (route) {
                const float* rw = p.in[26] + (size_t)c * 8;
#pragma unroll
                for (int q = 0; q < 4; ++q) { const f32x4 w0 = *(const f32x4*)(rw + q * 8), w1 = *(const f32x4*)(rw + q * 8 + 4); const float yy = y[q];
                    lg[0] += yy * w0.x; lg[1] += yy * w0.y; lg[2] += yy * w0.z; lg[3] += yy * w0.w; lg[4] += yy * w1.x; lg[5] += yy * w1.y; lg[6] += yy * w1.z; lg[7] += yy * w1.w; }
            }
        }
        if (route) {
#pragma unroll
            for (int e = 0; e < 8; ++e) lg[e] = wave_sum(lg[e]);
            if (lane == 0) {
                int e0 = 0; float v0 = lg[0];
#pragma unroll
                for (int e = 1; e < 8; ++e) if (lg[e] > v0) { v0 = lg[e]; e0 = e; }
                int e1 = -1; float v1 = -INFINITY;
#pragma unroll
                for (int e = 0; e < 8; ++e) if (e != e0 && lg[e] > v1) { v1 = lg[e]; e1 = e; }
                const float w0 = 1.f / (1.f + expf(v1 - v0));
                int* tok_e = (int*)(p.ws + WS_ROUTE); float* tok_w = (float*)(p.ws + WS_ROUTE) + 16384 * 2;
                tok_e[r * 2] = e0; tok_e[r * 2 + 1] = e1; tok_w[r * 2] = w0; tok_w[r * 2 + 1] = 1.f - w0;
                __hip_atomic_fetch_add(cnt_lds + e0, 1u, __ATOMIC_RELAXED, __HIP_MEMORY_SCOPE_WORKGROUP); __hip_atomic_fetch_add(cnt_lds + e1, 1u, __ATOMIC_RELAXED, __HIP_MEMORY_SCOPE_WORKGROUP);
            }
        }
    }
    if (route) { __syncthreads(); if (threadIdx.x < NEXP) ((unsigned*)(p.ws + WS_ROUTE) + 16384 * 6)[blockIdx.x * NEXP + threadIdx.x] = cnt_lds[threadIdx.x]; __syncthreads(); }
}

__device__ __forceinline__ void norm_row(const P& p, int layer, int which, int r, int lane) {
    const float* gain = p.in[which == 0 ? 6 : 7] + layer * D; bf16* A = (bf16*)(p.ws + WS_A);
    const int mi = row_mi(r); const float* src = hrow(p, r);
    const float* shift = mods(p, layer, mi, which == 0 ? 0 : 3); const float* scale = mods(p, layer, mi, which == 0 ? 1 : 4);
    f32x4 v[4]; float ss = 0.f;
#pragma unroll
    for (int j = 0; j < 4; ++j) { v[j] = *(const f32x4*)(src + 4 * lane + 256 * j); ss += v[j].x * v[j].x + v[j].y * v[j].y + v[j].z * v[j].z + v[j].w * v[j].w; }
    const float rstd = rsqrtf(wave_sum(ss) * (1.f / D) + EPS);
#pragma unroll
    for (int j = 0; j < 4; ++j) { const int c = 4 * lane + 256 * j;
        const f32x4 g = *(const f32x4*)(gain + c), sc = *(const f32x4*)(scale + c), sh = *(const f32x4*)(shift + c);
        const f32x4 y = v[j] * rstd * g * (sc + 1.f) + sh;
        u32x2 o; o.x = pk2(y.x, y.y); o.y = pk2(y.z, y.w);
        *(u32x2*)(A + (size_t)r * D + c) = o; }
}

namespace fg {
typedef short bf16x8 __attribute__((ext_vector_type(8)));
constexpr int BM = 256, BK = 64, HALF = 128, HTB = HALF * BK * 2, STAGE_BYTES = 8 * HTB, NXCD = 8, WGM = 8;
__device__ __forceinline__ int lds_byte(int r, int c) { const int st = (r >> 4) * 2 + (c >> 5), rr = r & 15, cc = c & 31, ob = rr * 64 + cc * 2; return st * 1024 + (ob ^ (((ob >> 9) & 1) << 5)); }
__device__ __forceinline__ void stage_rc(int b, int& R, int& C) { const int st = b / 1024, sb = b % 1024, swz = sb ^ (((sb >> 9) & 1) << 5); R = (st >> 1) * 16 + swz / 64; C = (st & 1) * 32 + (swz % 64) / 2; }
__device__ __forceinline__ int perm32(int rho) { const int n = rho >> 4, i = rho & 15; return 8 * (i >> 2) + 4 * n + (i & 3); }
struct Unit { int pm, pn; const char* A; const char* B; int nt, aux; };
__device__ __forceinline__ bool tile_order(int i, int nM, int nN, int G, int c, int& pm, int& pn) {
    const int nwg = nM * nN; const long L = (long)i * G + c; if (L >= nwg) return false;
    int wgid = (int)L; { const int q = nwg / NXCD, r = nwg % NXCD, xcd = wgid % NXCD, off = wgid / NXCD; wgid = (xcd < r ? xcd * (q + 1) : r * (q + 1) + (xcd - r) * q) + off; }
    const int nig = WGM * nN, gid = wgid / nig, fm = gid * WGM, gsz = (nM - fm) < WGM ? (nM - fm) : WGM;
    pm = fm + ((wgid % nig) % gsz); pn = (wgid % nig) / gsz; return true;
}
struct PlainSched {
    const char* Abase; const char* Bbase; int lda, ldb, nM, nN, G, c, nt;
    __device__ __forceinline__ int arow(int R) const { return R; }
    __device__ __forceinline__ int ahalf() const { return HALF; }
    __device__ __forceinline__ bool next(int i, Unit& u) const { if (!tile_order(i, nM, nN, G, c, u.pm, u.pn)) return false;
        u.A = Abase + (size_t)u.pm * BM * lda * 2; u.B = Bbase + (size_t)u.pn * BM * ldb * 2; u.nt = nt; u.aux = 0; return true; }
};
struct ExpertSched {
    const char* Abase; const char* Bbase; int lda, ldb, nM, nN, G, c, nt; const LAS int* tile_e; size_t estride;
    __device__ __forceinline__ int arow(int R) const { return R; }
    __device__ __forceinline__ int ahalf() const { return HALF; }
    __device__ __forceinline__ bool next(int i, Unit& u) const { if (!tile_order(i, nM, nN, G, c, u.pm, u.pn)) return false;
        u.A = Abase + (size_t)u.pm * BM * lda * 2; u.B = Bbase + (size_t)tile_e[u.pm] * estride + (size_t)u.pn * BM * ldb * 2; u.nt = nt; u.aux = 0; return true; }
};
struct WinSched {
    const char* Abase; const char* Bbase; int G, c, mode, nN;
    __device__ __forceinline__ int arow(int R) const { return mode == 0 ? 256 * (R & 15) + 64 * ((R >> 4) & 3) + (R >> 6) : R; }
    __device__ __forceinline__ int ahalf() const { return mode == 0 ? 4096 : HALF; }
    __device__ __forceinline__ bool next(int i, Unit& u) const { if (!tile_order(i, mode == 0 ? 64 : 2, nN, G, c, u.pm, u.pn)) return false;
        const size_t row0 = mode == 0 ? (size_t)((u.pm >> 5) * SEQ + 2 * (u.pm & 31)) : (size_t)(NLAT + u.pm * CTX);
        u.A = Abase + row0 * D * 2; u.B = Bbase + (size_t)u.pn * BM * D * 2; u.nt = D / 64; u.aux = mode; return true; }
};
struct MergeSched {
    const char* Xbase; const char* Wbase; int nM, G, c;
    __device__ __forceinline__ int arow(int R) const { return R; }
    __device__ __forceinline__ int ahalf() const { return HALF; }
    __device__ __forceinline__ bool next(int i, Unit& u) const { if (!tile_order(i >> 2, nM, 4, G, c, u.pm, u.pn)) return false;
        const int br = i & 3, koff = br == 0 ? 0 : (br == 1 ? 512 : (br == 2 ? 768 : 1280));
        u.A = Xbase + ((size_t)u.pm * BM * 1536 + koff) * 2; u.B = Wbase + ((size_t)u.pn * BM * 1536 + koff) * 2; u.nt = (br & 1) ? 4 : 8; u.aux = br; return true; }
};
template <class E, class = void> struct is_chain { static constexpr bool v = false; };
template <class E> struct is_chain<E, decltype((void)E::CHAIN)> { static constexpr bool v = E::CHAIN; };
typedef f32x4 Acc[2][2][4][2];
typedef int i32x4 __attribute__((ext_vector_type(4))); typedef int i32x8 __attribute__((ext_vector_type(8)));
__device__ __forceinline__ i32x8 ld32(const LAS unsigned char* p) { const i32x4 a = *(const LAS i32x4*)p, b = *(const LAS i32x4*)(p + 16); return __builtin_shufflevector(a, b, 0, 1, 2, 3, 4, 5, 6, 7); }
template <class Epi, class Sched, bool F8 = false>
__device__ __forceinline__ void gemm_phase(LAS unsigned char* lds, int lda, int ldb, const Sched& S, const Epi& E) {
    int tid_ = threadIdx.x; asm volatile("" : "+v"(tid_));
    const int tid = tid_, wid = __builtin_amdgcn_readfirstlane(tid >> 6), lane = tid & 63, wr = wid >> 2, wc = wid & 3, fr = lane & 15, fq = lane >> 4;
    unsigned voffA[2], voffB[2];
#pragma unroll
    for (int i = 0; i < 2; ++i) { int R, C; stage_rc(tid * 16 + i * 8192, R, C); const int Rb = Epi::PERM ? ((R & ~31) + perm32(R & 31)) : R;
        voffA[i] = (unsigned)(S.arow(R) * lda + C) * 2u; voffB[i] = (unsigned)(Rb * ldb + C) * 2u; }
    const size_t kstep = (size_t)(BK * 2);
    const size_t hstepA = (size_t)S.ahalf() * lda * 2, hstepB = (size_t)HALF * ldb * 2;
    const unsigned ldsw = (unsigned)wid * 1024u;
    const int aoff = lds_byte(wr * 64 + fr, F8 ? fq * 16 : fq * 8), boff = lds_byte(wc * 32 + fr, F8 ? fq * 16 : fq * 8);
#define FG_SA(b, h) (((b) * 2 + (h)) * HTB)
#define FG_SB(b, h) ((4 + (b) * 2 + (h)) * HTB)
#define FG_STAGE(bufoff, gbase, voff) do { _Pragma("unroll") for (int _i = 0; _i < 2; ++_i) \
        __builtin_amdgcn_global_load_lds((const unsigned*)((const char*)(gbase) + (voff)[_i]), (LAS unsigned*)(lds + (bufoff) + ldsw + _i * 8192), 16, 0, 0); } while (0)
#define FG_LDA(dst, b, h) do { if constexpr (F8) { _Pragma("unroll") for (int m = 0; m < 4; ++m) dst##8[m] = ld32(lds + FG_SA(b, h) + aoff + m * 2048); } \
        else { _Pragma("unroll") for (int m = 0; m < 4; ++m) _Pragma("unroll") for (int k = 0; k < 2; ++k) dst[m][k] = *(const LAS bf16x8*)(lds + FG_SA(b, h) + aoff + m * 2048 + k * 1024); } } while (0)
#define FG_LDB(dst, b, h) do { if constexpr (F8) { _Pragma("unroll") for (int n = 0; n < 2; ++n) dst##8[n] = ld32(lds + FG_SB(b, h) + boff + n * 2048); } \
        else { _Pragma("unroll") for (int n = 0; n < 2; ++n) _Pragma("unroll") for (int k = 0; k < 2; ++k) dst[n][k] = *(const LAS bf16x8*)(lds + FG_SB(b, h) + boff + n * 2048 + k * 1024); } } while (0)
#define FG_MMA(ai, bj, At, Bt) do { __builtin_amdgcn_s_setprio(1); _Pragma("unroll") for (int m = 0; m < 4; ++m) _Pragma("unroll") for (int n = 0; n < 2; ++n) { \
        if constexpr (F8) asm volatile("v_mfma_scale_f32_16x16x128_f8f6f4 %0, %1, %2, %0, %3, %4 op_sel_hi:[0,0,0]" : "+v"(acc[ai][bj][m][n]) : "v"(Bt##8[n]), "v"(At##8[m]), "v"(scw), "v"(sca)); \
        else { _Pragma("unroll") for (int k = 0; k < 2; ++k) acc[ai][bj][m][n] = __builtin_amdgcn_mfma_f32_16x16x32_bf16(Bt[n][k], At[m][k], acc[ai][bj][m][n], 0, 0, 0); } } \
        __builtin_amdgcn_s_setprio(0); } while (0)
#define FG_WAIT_V(n) asm volatile("s_waitcnt vmcnt(" #n ")" ::: "memory")
#define FG_WAIT_L(n) asm volatile("s_waitcnt lgkmcnt(" #n ")" ::: "memory")
#define FG_BAR __builtin_amdgcn_s_barrier()
#define FG_SCHED __builtin_amdgcn_sched_barrier(0)
    Unit cur, nxt; int ui = 0;
    if (!S.next(0, cur)) return;
    Acc acc;
#pragma unroll
    for (int a = 0; a < 2; ++a)
#pragma unroll
        for (int b = 0; b < 2; ++b)
#pragma unroll
            for (int m = 0; m < 4; ++m)
#pragma unroll
                for (int n = 0; n < 2; ++n) acc[a][b][m][n] = (f32x4){0.f, 0.f, 0.f, 0.f};
    bf16x8 At[4][2], B0[2][2], B1[2][2]; i32x8 At8[4], B08[2], B18[2];
    const int scw = 0x7a7a7a7a, sca = 0x7f7f7f7f;
    const char* cA = cur.A; const char* cB = cur.B;
    FG_STAGE(FG_SB(0, 0), cB, voffB); FG_STAGE(FG_SB(0, 1), cB + hstepB, voffB); FG_STAGE(FG_SA(0, 0), cA, voffA); FG_STAGE(FG_SA(0, 1), cA + hstepA, voffA);
    if (wr == 1) FG_BAR;
    FG_WAIT_V(2); FG_BAR;
    FG_STAGE(FG_SB(1, 0), cB + kstep, voffB); FG_STAGE(FG_SA(1, 0), cA + kstep, voffA); FG_STAGE(FG_SB(1, 1), cB + hstepB + kstep, voffB);
    FG_WAIT_V(6); FG_BAR;
    for (;;) {
        const bool has_next = S.next(ui + 1, nxt);
        const char* nA = has_next ? nxt.A : cA; const char* nB = has_next ? nxt.B : cB;
        const int nt = cur.nt;
#pragma unroll 1
        for (int t = 0; t < nt; t += 2) {
            const bool last = (t == nt - 2);
            const char* a1 = cA + (size_t)(t + 1) * kstep;
            const char* a2 = last ? nA : cA + (size_t)(t + 2) * kstep; const char* b2 = last ? nB : cB + (size_t)(t + 2) * kstep;
            const char* a3 = a2 + kstep; const char* b3 = b2 + kstep;
            FG_LDB(B0, 0, 0); FG_LDB(B1, 0, 1); FG_SCHED; FG_LDA(At, 0, 0); FG_STAGE(FG_SA(1, 1), a1 + hstepA, voffA);
            FG_WAIT_V(8); FG_WAIT_L(0); FG_BAR; FG_MMA(0, 0, At, B0); FG_MMA(0, 1, At, B1); FG_BAR; FG_SCHED;
            FG_LDA(At, 0, 1); FG_STAGE(FG_SB(0, 0), b2, voffB); FG_STAGE(FG_SB(0, 1), b2 + hstepB, voffB); FG_STAGE(FG_SA(0, 0), a2, voffA);
            FG_WAIT_V(8); FG_WAIT_L(0); FG_BAR; FG_MMA(1, 0, At, B0); FG_MMA(1, 1, At, B1); FG_BAR; FG_SCHED;
            FG_LDB(B0, 1, 0); FG_LDB(B1, 1, 1); FG_SCHED; FG_LDA(At, 1, 0); FG_STAGE(FG_SA(0, 1), a2 + hstepA, voffA);
            FG_WAIT_V(8); FG_WAIT_L(0); FG_BAR; FG_MMA(0, 0, At, B0); FG_MMA(0, 1, At, B1); FG_BAR; FG_SCHED;
            FG_LDA(At, 1, 1); FG_STAGE(FG_SB(1, 0), b3, voffB); FG_STAGE(FG_SB(1, 1), b3 + hstepB, voffB); FG_STAGE(FG_SA(1, 0), a3, voffA);
            FG_WAIT_V(8); FG_WAIT_L(0); FG_BAR; FG_MMA(1, 0, At, B0); FG_MMA(1, 1, At, B1); FG_BAR; FG_SCHED;
        }
        if (wr == 0) FG_BAR;
        E(acc, cur, wr, wc, fr, fq);
        if (!has_next) break;
        if (!(is_chain<Epi>::v && cur.aux != 3)) {
#pragma unroll
        for (int a = 0; a < 2; ++a)
#pragma unroll
            for (int b = 0; b < 2; ++b)
#pragma unroll
                for (int m = 0; m < 4; ++m)
#pragma unroll
                    for (int n = 0; n < 2; ++n) acc[a][b][m][n] = (f32x4){0.f, 0.f, 0.f, 0.f};
        }
        cur = nxt; cA = nA; cB = nB; ++ui;
        if (wr == 1) FG_BAR;
    }
    FG_WAIT_V(0);
    FG_BAR;
#undef FG_SA
#undef FG_SB
#undef FG_STAGE
#undef FG_LDA
#undef FG_LDB
#undef FG_MMA
#undef FG_WAIT_V
#undef FG_WAIT_L
#undef FG_BAR
#undef FG_SCHED
}
__device__ __forceinline__ unsigned cvt_pk(float lo, float hi) { unsigned r; asm volatile("v_cvt_pk_bf16_f32 %0, %1, %2" : "=v"(r) : "v"(lo), "v"(hi)); return r; }
__device__ __forceinline__ u32x4 pack8(const f32x4 a, const f32x4 b) { u32x4 w; w.x = cvt_pk(a[0], a[1]); w.y = cvt_pk(a[2], a[3]); w.z = cvt_pk(b[0], b[1]); w.w = cvt_pk(b[2], b[3]); return w; }
__device__ __forceinline__ f32x4 unpk_u8(unsigned x) { const float k = 1.f / 255.f; return (f32x4){(float)(x & 0xffu) * k, (float)((x >> 8) & 0xffu) * k, (float)((x >> 16) & 0xffu) * k, (float)(x >> 24) * k}; }
__device__ __forceinline__ f32x4 unpk_u8r(unsigned x) { return (f32x4){(float)(x & 0xffu), (float)((x >> 8) & 0xffu), (float)((x >> 16) & 0xffu), (float)(x >> 24)}; }
__device__ __forceinline__ f32x4 unpk_lo(unsigned x, unsigned y) { return (f32x4){__uint_as_float(x << 16), __uint_as_float(x & 0xffff0000u), __uint_as_float(y << 16), __uint_as_float(y & 0xffff0000u)}; }

struct EpiWin {
    static constexpr bool PERM = true;
    unsigned char* ws; const float* qg; const float* kg;
    __device__ __forceinline__ void operator()(const Acc& acc, const Unit& u, int wr, int wc, int fr_, int fq_) const {
        int fr = fr_, fq = fq_; asm volatile("" : "+v"(fr), "+v"(fq));
        const int tile = u.pn; const bool LAT = u.aux == 0;
        if (tile == 0) {
            if (LAT) {
                const int b = u.pm >> 5, n2 = 2 * (u.pm & 31) + wr;
#pragma unroll
                for (int ai = 0; ai < 2; ++ai)
#pragma unroll
                    for (int bj = 0; bj < 2; ++bj) {
#pragma unroll
                        for (int n = 0; n < 2; ++n)
#pragma unroll
                            for (int e = 0; e < 4; ++e) { const int ch = bj * HALF + wc * 32 + 8 * fq + 4 * n + e;
                                u32x2 o; o.x = cvt_pk(acc[ai][bj][0][n][e], acc[ai][bj][1][n][e]); o.y = cvt_pk(acc[ai][bj][2][n][e], acc[ai][bj][3][n][e]);
                                *(u32x2*)((bf16*)(ws + WS_UT) + ((size_t)(b * 256 + ch) * 64 + n2) * 256 + 64 * ai + 4 * fr) = o; }
                        asm volatile("" ::: "memory"); }
            } else {
#pragma unroll
                for (int ai = 0; ai < 2; ++ai)
#pragma unroll
                    for (int m = 0; m < 4; ++m) { const int sx = ai * HALF + wr * 64 + m * 16 + fr;
#pragma unroll
                        for (int bj = 0; bj < 2; ++bj)
#pragma unroll
                            for (int n = 0; n < 2; ++n)
#pragma unroll
                                for (int e = 0; e < 4; ++e) { const int ch = bj * HALF + wc * 32 + 8 * fq + 4 * n + e;
                                    ((bf16*)(ws + WS_UTC))[(size_t)(u.pm * 256 + ch) * 256 + sx] = f2bf(acc[ai][bj][m][n][e]); }
                        asm volatile("" ::: "memory"); }
            }
            return;
        }
        const bool ropek = tile == 1 || tile == 2 || tile == 5 || tile == 6 || (tile == 7 && wc < 2);
        const bool keyrow = tile == 7;
        size_t boff; int pitch, col0;
        if (tile <= 4) { boff = WS_RETQ + (size_t)(tile - 1) * MROWS * 256 * 2; pitch = 256; col0 = ropek ? wc * 64 : wc * 32; }
        else if (tile <= 6) { boff = WS_ATTQ; pitch = 512; col0 = (tile - 5) * 256 + wc * 64; }
        else if (tile == 7) { boff = wc < 2 ? WS_ATTK : WS_ATTV; pitch = 128; col0 = (wc & 1) * 64; }
        else if (tile < 10) { boff = WS_CONV; pitch = 512; col0 = (tile - 8) * 256 + wc * 32; }
        else { boff = WS_G; pitch = 4096; col0 = (tile - 10) * 256 + wc * 32; }
        const bool head = ropek || tile == 7;
        bf16* const dbase = (bf16*)(ws + boff);
        const bool norm = tile >= 5 && ropek;
        const float* gp = tile == 7 ? kg : qg;
        const float osc = tile == 2 ? 0.125f : (tile == 5 || tile == 6 ? QSCALE : 1.f);
        const float* rc = (const float*)(ws + WS_ROPE);
#pragma unroll
        for (int ai = 0; ai < 2; ++ai) {
            f32x4 rcs[4][2], rsn[4][2];
            if (ropek && LAT) {
#pragma unroll
                for (int m = 0; m < 4; ++m)
#pragma unroll
                    for (int bj = 0; bj < 2; ++bj) { const int sx = 4096 * ai + 256 * fr + 64 * m + 2 * (u.pm & 31) + wr, i0 = 16 * bj + 4 * fq;
                        rcs[m][bj] = *(const f32x4*)(rc + sx * 32 + i0); rsn[m][bj] = *(const f32x4*)(rc + SEQ * 32 + sx * 32 + i0); } }
#pragma unroll
            for (int m = 0; m < 4; ++m) {
                const int b = LAT ? (u.pm >> 5) : u.pm, s = LAT ? (4096 * ai + 256 * fr + 64 * m + 2 * (u.pm & 31) + wr) : (ai * HALF + wr * 64 + m * 16 + fr);
                const int rr = keyrow ? b * KEYS + (LAT ? CTX + s : s) : (LAT ? b * SEQ + s : NLAT + b * CTX + s);
                bf16* const drow = dbase + ((size_t)rr * pitch + col0 + 8 * fq);
                if (ropek) {
                    float rstd = 1.f;
                    if (norm) { float ss = 0.f;
#pragma unroll
                        for (int bj = 0; bj < 2; ++bj)
#pragma unroll
                            for (int n = 0; n < 2; ++n) { const f32x4 x = acc[ai][bj][m][n]; ss += (x[0] * x[0] + x[1] * x[1]) + (x[2] * x[2] + x[3] * x[3]); }
                        ss += __shfl_xor(ss, 16); ss += __shfl_xor(ss, 32);
                        rstd = rsqrtf(ss * (1.f / 64.f) + EPS); }
#pragma unroll
                    for (int bj = 0; bj < 2; ++bj) {
                        const int i0 = 16 * bj + 4 * fq;
                        f32x4 x1 = acc[ai][bj][m][0], x2 = acc[ai][bj][m][1];
                        if (norm) { const f32x4 g1 = *(const f32x4*)(gp + i0), g2 = *(const f32x4*)(gp + 32 + i0); x1 = x1 * rstd * g1; x2 = x2 * rstd * g2; }
                        f32x4 o1 = x1, o2 = x2;
                        if (LAT) { const f32x4 cs = rcs[m][bj], sn = rsn[m][bj]; o1 = x1 * cs - x2 * sn; o2 = x1 * sn + x2 * cs; }
                        *(u32x4*)(drow + 32 * bj) = pack8(o1 * osc, o2 * osc);
                    }
                } else {
#pragma unroll
                    for (int bj = 0; bj < 2; ++bj) {
                        f32x4 a0 = acc[ai][bj][m][0], a1 = acc[ai][bj][m][1];
                        if (tile >= 10) {
                            u32x2 o; o.x = 0u; o.y = 0u;
#pragma unroll
                            for (int e = 0; e < 4; ++e) { o.x = __builtin_amdgcn_cvt_pk_u8_f32(__builtin_fmaxf(__builtin_floorf(sigmoid_fast(a0[e]) * 255.f + 0.5f), 1.f), e, o.x);
                                o.y = __builtin_amdgcn_cvt_pk_u8_f32(__builtin_fmaxf(__builtin_floorf(sigmoid_fast(a1[e]) * 255.f + 0.5f), 1.f), e, o.y); }
                            *(u32x2*)(ws + WS_G + (size_t)rr * 4096 + (tile - 10) * 256 + wc * 32 + 8 * fq + HALF * bj) = o;
                        } else *(u32x4*)(drow + (head ? 32 : HALF) * bj) = pack8(a0, a1);
                    }
                }
            }
        }
    }
};
struct EpiGate8 {
    static constexpr bool PERM = true;
    unsigned char* G;
    __device__ __forceinline__ void operator()(const Acc& acc, const Unit& u, int wr, int wc, int fr_, int fq_) const {
        int fr = fr_, fq = fq_; asm volatile("" : "+v"(fr), "+v"(fq));
#pragma unroll
        for (int ai = 0; ai < 2; ++ai)
#pragma unroll
            for (int m = 0; m < 4; ++m) { const int r = u.pm * BM + ai * HALF + wr * 64 + m * 16 + fr;
#pragma unroll
                for (int bj = 0; bj < 2; ++bj) { const f32x4 a0 = acc[ai][bj][m][0], a1 = acc[ai][bj][m][1]; u32x2 o; o.x = 0u; o.y = 0u;
#pragma unroll
                    for (int e = 0; e < 4; ++e) { o.x = __builtin_amdgcn_cvt_pk_u8_f32(__builtin_fmaxf(__builtin_floorf(sigmoid_fast(a0[e]) * 255.f + 0.5f), 1.f), e, o.x);
                        o.y = __builtin_amdgcn_cvt_pk_u8_f32(__builtin_fmaxf(__builtin_floorf(sigmoid_fast(a1[e]) * 255.f + 0.5f), 1.f), e, o.y); }
                    *(u32x2*)(G + (size_t)r * 4096 + u.pn * BM + bj * HALF + wc * 32 + 8 * fq) = o; } }
    }
};
struct EpiMerge {
    static constexpr bool PERM = true, CHAIN = true;
    const unsigned char* G; bf16* Mg;
    __device__ __forceinline__ void operator()(Acc& acc, const Unit& u, int wr, int wc, int fr_, int fq_) const {
        int fr = fr_, fq = fq_; asm volatile("" : "+v"(fr), "+v"(fq));
        const int br = u.aux; const bool lastb = br == 3;
#pragma unroll
        for (int ai = 0; ai < 2; ++ai) {
            u32x2 g[4][2], gn[4][2];
#pragma unroll
            for (int m = 0; m < 4; ++m)
#pragma unroll
                for (int bj = 0; bj < 2; ++bj) { const int r = u.pm * BM + ai * HALF + wr * 64 + m * 16 + fr, c = u.pn * BM + bj * HALF + wc * 32 + 8 * fq;
                    g[m][bj] = *(const u32x2*)(G + (size_t)r * 4096 + br * 1024 + c);
                    if (!lastb) gn[m][bj] = *(const u32x2*)(G + (size_t)r * 4096 + (br + 1) * 1024 + c); }
#pragma unroll
            for (int m = 0; m < 4; ++m)
#pragma unroll
                for (int bj = 0; bj < 2; ++bj) {
                    if (!lastb) {
                        const f32x4 n0 = unpk_u8r(g[m][bj].x), n1 = unpk_u8r(g[m][bj].y), d0 = unpk_u8r(gn[m][bj].x), d1 = unpk_u8r(gn[m][bj].y);
#pragma unroll
                        for (int e = 0; e < 4; ++e) { acc[ai][bj][m][0][e] *= n0[e] * __builtin_amdgcn_rcpf(d0[e]); acc[ai][bj][m][1][e] *= n1[e] * __builtin_amdgcn_rcpf(d1[e]); }
                    } else { const int r = u.pm * BM + ai * HALF + wr * 64 + m * 16 + fr, c = u.pn * BM + bj * HALF + wc * 32 + 8 * fq;
                        *(u32x4*)(Mg + (size_t)r * 1024 + c) = pack8(acc[ai][bj][m][0] * unpk_u8(g[m][bj].x), acc[ai][bj][m][1] * unpk_u8(g[m][bj].y)); } }
        }
    }
};
struct EpiResid {
    static constexpr bool PERM = false;
    float* out; float* hctx; const float* modbase; int chunk;
    __device__ __forceinline__ void operator()(const Acc& acc, const Unit& u, int wr, int wc, int fr_, int fq_) const {
        int fr = fr_, fq = fq_; asm volatile("" : "+v"(fr), "+v"(fq));
        const int rt = u.pm * BM;
        const float* g = modbase + ((size_t)row_mi(rt) * 6 + chunk) * D;
        f32x4 gg[2][2];
#pragma unroll
        for (int bj = 0; bj < 2; ++bj)
#pragma unroll
            for (int n = 0; n < 2; ++n) gg[bj][n] = *(const f32x4*)(g + u.pn * BM + bj * HALF + wc * 32 + 16 * n + 4 * fq);
#pragma unroll
        for (int ai = 0; ai < 2; ++ai) {
            f32x4 hv[4][2][2];
#pragma unroll
            for (int m = 0; m < 4; ++m) { const int r = rt + ai * HALF + wr * 64 + m * 16 + fr; const float* h = r < NLAT ? out + (size_t)r * D : hctx + (size_t)(r - NLAT) * D;
#pragma unroll
                for (int bj = 0; bj < 2; ++bj)
#pragma unroll
                    for (int n = 0; n < 2; ++n) hv[m][bj][n] = *(const f32x4*)(h + u.pn * BM + bj * HALF + wc * 32 + 16 * n + 4 * fq); }
#pragma unroll
            for (int m = 0; m < 4; ++m) { const int r = rt + ai * HALF + wr * 64 + m * 16 + fr; float* h = r < NLAT ? out + (size_t)r * D : hctx + (size_t)(r - NLAT) * D;
#pragma unroll
                for (int bj = 0; bj < 2; ++bj)
#pragma unroll
                    for (int n = 0; n < 2; ++n) *(f32x4*)(h + u.pn * BM + bj * HALF + wc * 32 + 16 * n + 4 * fq) = hv[m][bj][n] + gg[bj][n] * acc[ai][bj][m][n]; }
        }
    }
};
struct EpiResidNorm {
    static constexpr bool PERM = false;
    const float* hin; float* out; const float* modbase; int chunk;
    const float* gain; const float* nmods; int csh, csc; bf16* A; unsigned char* A8;
    float* xbuf; unsigned* cnt; unsigned* tmo; LAS unsigned char* lds;
    __device__ __forceinline__ void operator()(Acc& acc, const Unit& u, int wr, int wc, int fr_, int fq_) const {
        int fr = fr_, fq = fq_; asm volatile("" : "+v"(fr), "+v"(fq));
        const int wid = __builtin_amdgcn_readfirstlane((int)threadIdx.x >> 6), lane = threadIdx.x & 63;
        const int rt = u.pm * BM, mi = row_mi(rt);
        LAS float* Pt = (LAS float*)(lds + STAGE_BYTES);
        LAS float* St = (LAS float*)(lds + STAGE_BYTES + 4096);
        LAS unsigned* flag = (LAS unsigned*)(lds + STAGE_BYTES + 5120);
        { const float* g = modbase + ((size_t)mi * 6 + chunk) * D;
          f32x4 gg[2][2];
#pragma unroll
          for (int bj = 0; bj < 2; ++bj)
#pragma unroll
              for (int n = 0; n < 2; ++n) gg[bj][n] = *(const f32x4*)(g + u.pn * BM + bj * HALF + wc * 32 + 16 * n + 4 * fq);
#pragma unroll
          for (int am = 0; am < 4; ++am) { const int ai = am >> 1, m0 = (am & 1) * 2;
              f32x4 hv[2][2][2];
#pragma unroll
              for (int mm = 0; mm < 2; ++mm) { const float* h = hin + (size_t)(rt + ai * HALF + wr * 64 + (m0 + mm) * 16 + fr) * D;
#pragma unroll
                  for (int bj = 0; bj < 2; ++bj)
#pragma unroll
                      for (int n = 0; n < 2; ++n) hv[mm][bj][n] = *(const f32x4*)(h + u.pn * BM + bj * HALF + wc * 32 + 16 * n + 4 * fq); }
#pragma unroll
              for (int mm = 0; mm < 2; ++mm) { const int m = m0 + mm; float* h = out + (size_t)(rt + ai * HALF + wr * 64 + m * 16 + fr) * D; float ss = 0.f;
#pragma unroll
                  for (int bj = 0; bj < 2; ++bj)
#pragma unroll
                      for (int n = 0; n < 2; ++n) { const f32x4 x = hv[mm][bj][n] + gg[bj][n] * acc[ai][bj][m][n]; acc[ai][bj][m][n] = x;
                          *(f32x4*)(h + u.pn * BM + bj * HALF + wc * 32 + 16 * n + 4 * fq) = x; ss += (x[0] * x[0] + x[1] * x[1]) + (x[2] * x[2] + x[3] * x[3]); }
                  ss += __shfl_xor(ss, 16); ss += __shfl_xor(ss, 32);
                  if (fq == 0) Pt[(ai * HALF + wr * 64 + m * 16 + fr) * 4 + wc] = ss; }
              asm volatile("" ::: "memory");
          } }
        asm volatile("s_waitcnt lgkmcnt(0)" ::: "memory"); __builtin_amdgcn_s_barrier(); asm volatile("" ::: "memory");
        const int row = wid * 32 + (lane & 31);
        if (lane < 32) { const f32x4 q = *(const LAS f32x4*)(Pt + row * 4);
            __hip_atomic_store(xbuf + ((size_t)(rt + row) * 4 + u.pn), (q[0] + q[1]) + (q[2] + q[3]), __ATOMIC_RELAXED, __HIP_MEMORY_SCOPE_AGENT); }
        asm volatile("s_waitcnt vmcnt(0)" ::: "memory");
        if (lane == 0) __hip_atomic_fetch_add(cnt + 16 * u.pm, 1u, __ATOMIC_RELAXED, __HIP_MEMORY_SCOPE_AGENT);
        if (wid == 0) { unsigned sp = 0u, dead = 0u;
            while ((unsigned)__builtin_amdgcn_readfirstlane(__hip_atomic_load(cnt + 16 * u.pm, __ATOMIC_RELAXED, __HIP_MEMORY_SCOPE_AGENT)) < 32u) {
                __builtin_amdgcn_s_sleep(1);
                if ((++sp & 255u) == 0u) { if (__hip_atomic_load(tmo, __ATOMIC_RELAXED, __HIP_MEMORY_SCOPE_AGENT)) { dead = 1u; break; } if (sp > (1u << 22)) { if (lane == 0) atomicAdd(tmo, 1u); dead = 1u; break; } } }
            __builtin_amdgcn_fence(__ATOMIC_ACQUIRE, "agent");
            if (lane == 0) flag[0] = dead; }
        asm volatile("s_waitcnt vmcnt(0) lgkmcnt(0)" ::: "memory"); __builtin_amdgcn_s_barrier(); asm volatile("" ::: "memory");
        if (lane < 32) { const float* sl = xbuf + (size_t)(rt + row) * 4; float t = 0.f;
#pragma unroll
            for (int q = 0; q < 4; ++q) t += __hip_atomic_load(sl + q, __ATOMIC_RELAXED, __HIP_MEMORY_SCOPE_AGENT);
            St[row] = rsqrtf(t * (1.f / D) + EPS); }
        asm volatile("s_waitcnt lgkmcnt(0)" ::: "memory"); __builtin_amdgcn_s_barrier(); asm volatile("" ::: "memory");
        const float* shp = nmods + ((size_t)mi * 6 + csh) * D; const float* scp = nmods + ((size_t)mi * 6 + csc) * D;
        float rs[2][4];
#pragma unroll
        for (int ai = 0; ai < 2; ++ai)
#pragma unroll
            for (int m = 0; m < 4; ++m) rs[ai][m] = St[ai * HALF + wr * 64 + m * 16 + fr];
#pragma unroll
        for (int bj = 0; bj < 2; ++bj)
#pragma unroll
            for (int n = 0; n < 2; ++n) { const int c = u.pn * BM + bj * HALF + wc * 32 + 16 * n + 4 * fq;
                const f32x4 g4 = *(const f32x4*)(gain + c), sc4 = *(const f32x4*)(scp + c) + 1.f, sh4 = *(const f32x4*)(shp + c);
#pragma unroll
                for (int ai = 0; ai < 2; ++ai)
#pragma unroll
                    for (int m = 0; m < 4; ++m) { const f32x4 y = acc[ai][bj][m][n] * rs[ai][m] * g4 * sc4 + sh4;
                        u32x2 o; o.x = cvt_pk(y[0], y[1]); o.y = cvt_pk(y[2], y[3]);
                        *(u32x2*)(A + (size_t)(rt + ai * HALF + wr * 64 + m * 16 + fr) * D + c) = o;
                        if (A8) *(unsigned*)(A8 + (size_t)(rt + ai * HALF + wr * 64 + m * 16 + fr) * D + c) = pk4_fp8(y[0], y[1], y[2], y[3]); } }
    }
};
struct EpiSwiglu {
    static constexpr bool PERM = true;
    bf16* Hm;
    __device__ __forceinline__ void operator()(const Acc& acc, const Unit& u, int wr, int wc, int fr, int fq) const {
#pragma unroll
        for (int ai = 0; ai < 2; ++ai)
#pragma unroll
            for (int m = 0; m < 4; ++m) { const int r = u.pm * BM + ai * HALF + wr * 64 + m * 16 + fr;
#pragma unroll
                for (int bj = 0; bj < 2; ++bj) { const int c = u.pn * BM + bj * HALF + wc * 32 + 8 * fq; const f32x4 g = acc[ai][bj][m][0], up = acc[ai][bj][m][1];
                    u32x2 o; o.x = cvt_pk(silu_fast(g[0]) * up[0], silu_fast(g[1]) * up[1]); o.y = cvt_pk(silu_fast(g[2]) * up[2], silu_fast(g[3]) * up[3]);
                    *(u32x2*)(Hm + (size_t)r * FFN + (c >> 1)) = o; } }
    }
};
struct EpiSwiglu8 {
    static constexpr bool PERM = true;
    unsigned char* Hm;
    __device__ __forceinline__ void operator()(const Acc& acc, const Unit& u, int wr, int wc, int fr_, int fq_) const {
        int fr = fr_, fq = fq_; asm volatile("" : "+v"(fr), "+v"(fq));
#pragma unroll
        for (int ai = 0; ai < 2; ++ai)
#pragma unroll
            for (int m = 0; m < 4; ++m) { const int r = u.pm * BM + ai * HALF + wr * 64 + m * 16 + fr;
#pragma unroll
                for (int bj = 0; bj < 2; ++bj) { const int c = u.pn * BM + bj * HALF + wc * 32 + 8 * fq; const f32x4 g = acc[ai][bj][m][0], up = acc[ai][bj][m][1];
                    *(unsigned*)(Hm + (size_t)r * FFN + (c >> 1)) = pk4_fp8(silu_fast(g[0]) * up[0], silu_fast(g[1]) * up[1], silu_fast(g[2]) * up[2], silu_fast(g[3]) * up[3]); } }
    }
};
struct EpiStore {
    static constexpr bool PERM = true;
    bf16* O; int ldc;
    __device__ __forceinline__ void operator()(const Acc& acc, const Unit& u, int wr, int wc, int fr_, int fq_) const {
        int fr = fr_, fq = fq_; asm volatile("" : "+v"(fr), "+v"(fq));
#pragma unroll
        for (int ai = 0; ai < 2; ++ai)
#pragma unroll
            for (int m = 0; m < 4; ++m) { const int r = u.pm * BM + ai * HALF + wr * 64 + m * 16 + fr;
#pragma unroll
                for (int bj = 0; bj < 2; ++bj) { const int c = u.pn * BM + bj * HALF + wc * 32 + 8 * fq; *(u32x4*)(O + (size_t)r * ldc + c) = pack8(acc[ai][bj][m][0], acc[ai][bj][m][1]); } }
    }
};
struct EpiFft1 {
    static constexpr bool PERM = true;
    unsigned char* ws;
    __device__ __forceinline__ void operator()(const Acc& acc, const Unit& u, int wr, int wc, int fr, int fq) const {
        const float* TW = (const float*)(ws + WS_TW); bf16* Z = (bf16*)(ws + WS_Z);
#pragma unroll
        for (int ai = 0; ai < 2; ++ai)
#pragma unroll
            for (int mm = 0; mm < 2; ++mm) { const int k1 = (4 * ai + 2 * wr + mm) * 16 + fr;
#pragma unroll
                for (int bj = 0; bj < 2; ++bj) { const int c = u.pn * BM + bj * HALF + wc * 32 + 8 * fq, n2 = c & 63, ch = (c >> 6) & 255, b = c >> 14;
                    f32x4 zr[2], zi[2];
#pragma unroll
                    for (int n = 0; n < 2; ++n) { const f32x4 yr = acc[ai][bj][2 * mm][n], yi = acc[ai][bj][2 * mm + 1][n];
                        const f32x4 t0 = *(const f32x4*)(TW + (size_t)(k1 * 64 + n2 + 4 * n) * 2), t1 = *(const f32x4*)(TW + (size_t)(k1 * 64 + n2 + 4 * n) * 2 + 4);
                        const f32x4 ct = {t0[0], t0[2], t1[0], t1[2]}, st = {t0[1], t0[3], t1[1], t1[3]};
                        zr[n] = yr * ct + yi * st; zi[n] = yi * ct - yr * st; }
                    bf16* dst = Z + ((size_t)b * 32768 + k1 * 256 + ch) * 256 + n2;
                    *(u32x4*)dst = pack8(zr[0], zr[1]); *(u32x4*)(dst + 64) = pack8(zi[0], zi[1]);
                    asm volatile("" ::: "memory"); } }
    }
};
struct EpiFft3 {
    static constexpr bool PERM = true;
    unsigned char* ws;
    __device__ __forceinline__ void operator()(const Acc& acc, const Unit& u, int wr, int wc, int fr, int fq) const {
        bf16* X = (bf16*)(ws + WS_X);
#pragma unroll
        for (int m = 0; m < 4; ++m) { const int k2 = 16 * m + fr;
#pragma unroll
            for (int bj = 0; bj < 2; ++bj) { const int c = u.pn * BM + bj * HALF + wc * 32 + 8 * fq, ch = c & 255, k1 = (c >> 8) & 127, b = c >> 15;
                *(u32x4*)(X + (size_t)(b * SEQ + k1 + 128 * k2) * 1536 + wr * 256 + ch) = pack8(acc[0][bj][m][0], acc[0][bj][m][1]); } }
    }
};
struct EpiFftC {
    static constexpr bool PERM = true;
    unsigned char* ws;
    __device__ __forceinline__ void operator()(const Acc& acc, const Unit& u, int wr, int wc, int fr, int fq) const {
        bf16* X = (bf16*)(ws + WS_X);
#pragma unroll
        for (int ai = 0; ai < 2; ++ai)
#pragma unroll
            for (int m = 0; m < 4; ++m) { const int k = ai * HALF + wr * 64 + m * 16 + fr;
#pragma unroll
                for (int bj = 0; bj < 2; ++bj) { const int ch = bj * HALF + wc * 32 + 8 * fq;
                    *(u32x4*)(X + (size_t)(NLAT + u.pn * CTX + k) * 1536 + u.pm * 256 + ch) = pack8(acc[ai][bj][m][0], acc[ai][bj][m][1]); } }
    }
};
}

__device__ __forceinline__ void ph_win(const P& p, LAS unsigned char* lds, int layer) {
    const char* W = (const char*)(p.ws + WS_WIN) + (size_t)layer * INC * D * 2;
#pragma unroll 1
    for (int mode = 0; mode < 2; ++mode) {
        fg::WinSched S{(const char*)(p.ws + WS_A), W, (int)gridDim.x, (int)((blockIdx.x + mode * 128) % gridDim.x), mode, mode == 0 ? 10 : (layer == 0 ? 26 : 10)};
        fg::EpiWin E{p.ws, p.in[14] + layer * 64, p.in[15] + layer * 64};
        fg::gemm_phase(lds, D, D, S, E);
    }
    {
        fg::PlainSched S{(const char*)(p.ws + WS_A8), (const char*)(p.ws + WS_WIN8) + (size_t)layer * 4096 * 1024, D / 2, D / 2, NLAT / 256, 16, (int)gridDim.x, (int)blockIdx.x, D / 128};
        fg::EpiGate8 E{p.ws + WS_G};
        fg::gemm_phase<fg::EpiGate8, fg::PlainSched, true>(lds, D / 2, D / 2, S, E);
    }
}

__device__ __forceinline__ void conv_item(const P& p, LAS unsigned char* lds, int layer, int seqid, int t0) {
    const int tid = threadIdx.x; LAS float* y = (LAS float*)lds;
    const int L = seqid < 2 ? SEQ : CTX; const int rbase = seqid < 2 ? seqid * SEQ : NLAT + (seqid - 2) * CTX;
    const bf16* cv = (const bf16*)(p.ws + WS_CONV);
    __syncthreads();
    u32x4 pa[6], pg[6];
#pragma unroll
    for (int i = 0; i < 6; ++i) { const int e = tid + i * NTHREADS, tt = e >> 5, c8 = (e & 31) * 8, t = t0 - 15 + tt;
        if (e < 94 * 32 && t >= 0 && t < L) { const bf16* rowp = cv + (size_t)(rbase + t) * 512 + c8; pa[i] = *(const u32x4*)rowp; pg[i] = *(const u32x4*)(rowp + 256); } }
#pragma unroll
    for (int i = 0; i < 6; ++i) { const int e = tid + i * NTHREADS; if (e >= 94 * 32) break; const int tt = e >> 5, c8 = (e & 31) * 8, t = t0 - 15 + tt;
        f32x4 lo = {0.f, 0.f, 0.f, 0.f}, hi = lo;
        if (t >= 0 && t < L) { const u32x4 a = pa[i], g = pg[i];
            lo = (f32x4){__uint_as_float(a.x << 16) * sigmoidf_(__uint_as_float(g.x << 16)), __uint_as_float(a.x & 0xffff0000u) * sigmoidf_(__uint_as_float(g.x & 0xffff0000u)),
                         __uint_as_float(a.y << 16) * sigmoidf_(__uint_as_float(g.y << 16)), __uint_as_float(a.y & 0xffff0000u) * sigmoidf_(__uint_as_float(g.y & 0xffff0000u))};
            hi = (f32x4){__uint_as_float(a.z << 16) * sigmoidf_(__uint_as_float(g.z << 16)), __uint_as_float(a.z & 0xffff0000u) * sigmoidf_(__uint_as_float(g.z & 0xffff0000u)),
                         __uint_as_float(a.w << 16) * sigmoidf_(__uint_as_float(g.w << 16)), __uint_as_float(a.w & 0xffff0000u) * sigmoidf_(__uint_as_float(g.w & 0xffff0000u))}; }
        *(LAS f32x4*)(y + tt * 256 + c8) = lo; *(LAS f32x4*)(y + tt * 256 + c8 + 4) = hi; }
    __syncthreads();
    {
        const int ch = tid & 255, half = tid >> 8;
        float w[31];
#pragma unroll
        for (int k = 0; k < 31; ++k) w[k] = p.in[17][(size_t)layer * 31 * 256 + k * 256 + ch];
        const float bias = p.in[18][layer * 256 + ch];
        float o[4][8];
#pragma unroll
        for (int u = 0; u < 4; ++u) { const int tb = (half * 4 + u) * 8;
            float in[38];
#pragma unroll
            for (int q = 0; q < 38; ++q) in[q] = y[(tb + q) * 256 + ch];
#pragma unroll
            for (int q = 0; q < 8; ++q) { float a = bias;
#pragma unroll
                for (int k = 0; k < 31; ++k) a += in[q + k] * w[k];
                o[u][q] = a; } }
        __syncthreads();
#pragma unroll
        for (int u = 0; u < 4; ++u)
#pragma unroll
            for (int q = 0; q < 8; ++q) y[((half * 4 + u) * 8 + q) * 256 + ch] = o[u][q];
    }
    __syncthreads();
    const int wv = tid >> 6, lane = tid & 63;
    const f32x4 g = *(const f32x4*)(p.in[19] + layer * 256 + lane * 4), bb = *(const f32x4*)(p.in[20] + layer * 256 + lane * 4);
    for (int q = 0; q < 8; ++q) { const int t = wv * 8 + q;
        const f32x4 v = *(const LAS f32x4*)(y + t * 256 + lane * 4);
        const float mu = wave_sum(v.x + v.y + v.z + v.w) * (1.f / 256.f);
        const f32x4 dv = v - mu; const float var = wave_sum(dv.x * dv.x + dv.y * dv.y + dv.z * dv.z + dv.w * dv.w) * (1.f / 256.f);
        const float rstd = rsqrtf(var + EPS);
        f32x4 z = dv * rstd * g + bb;
        u32x2 ov; ov.x = pk2(siluf_(z.x), siluf_(z.y)); ov.y = pk2(siluf_(z.z), siluf_(z.w));
        *(u32x2*)((bf16*)(p.ws + WS_X) + (size_t)(rbase + t0 + t) * 1536 + 1280 + lane * 4) = ov; }
}

__device__ __forceinline__ int chunk_row0(int b, int n) { return n < 2 ? NLAT + b * CTX + n * 128 : b * SEQ + (n - 2) * 128; }
__device__ __forceinline__ float log_sigmoid(float x) { return x >= 0.f ? -log1pf(expf(-x)) : x - log1pf(expf(x)); }
namespace rt {
typedef short bf16x8 __attribute__((ext_vector_type(8)));
constexpr int PQ = 72, PJ = 136;
__device__ __forceinline__ f32x4 mma(bf16x8 a, bf16x8 b, f32x4 c) { return __builtin_amdgcn_mfma_f32_16x16x32_bf16(a, b, c, 0, 0, 0); }
__device__ __forceinline__ bf16x8 frag(const LAS bf16* base, int row, int pitch, int k0, int lane) { return *(const LAS bf16x8*)(base + (row + (lane & 15)) * pitch + k0 + 8 * (lane >> 4)); }
}
__device__ __forceinline__ void ret_kv_item(const P& p, LAS unsigned char* lds, int layer, int it) {
    using namespace rt;
    const int tid = threadIdx.x, lane = tid & 63, w = tid >> 6; const int h = it & 3, n = (it >> 2) % NCHUNK, b = (it >> 2) / NCHUNK;
    LAS bf16* KTf = (LAS bf16*)lds; LAS bf16* KTb = KTf + 64 * PJ; LAS bf16* VT = KTb + 64 * PJ;
    const int r0 = chunk_row0(b, n);
    const float lgf = log_sigmoid(p.in[10][layer * 4 + h]), lgb = log_sigmoid(p.in[11][layer * 4 + h]);
    __syncthreads();
    { const int j = tid & 127, dq = (tid >> 7) * 16;
      const bf16* K = (const bf16*)(p.ws + WS_RETK) + (size_t)(r0 + j) * 256 + h * 64 + dq; const bf16* V = (const bf16*)(p.ws + WS_RETV) + (size_t)(r0 + j) * 256 + h * 64 + dq;
      const float zf = expf((127.f - j) * lgf), zb = expf((float)j * lgb);
#pragma unroll
      for (int q8 = 0; q8 < 2; ++q8) { const u32x4 kw = *(const u32x4*)(K + q8 * 8), vw = *(const u32x4*)(V + q8 * 8);
          const unsigned kk[4] = {kw.x, kw.y, kw.z, kw.w}, vv[4] = {vw.x, vw.y, vw.z, vw.w};
#pragma unroll
          for (int q = 0; q < 4; ++q) { const int d = dq + q8 * 8 + 2 * q; const float k0 = __uint_as_float(kk[q] << 16), k1 = __uint_as_float(kk[q] & 0xffff0000u);
              KTf[d * PJ + j] = f2bf(k0 * zf); KTf[(d + 1) * PJ + j] = f2bf(k1 * zf); KTb[d * PJ + j] = f2bf(k0 * zb); KTb[(d + 1) * PJ + j] = f2bf(k1 * zb);
              VT[d * PJ + j] = (bf16)(vv[q] & 0xffffu); VT[(d + 1) * PJ + j] = (bf16)(vv[q] >> 16); } } }
    __syncthreads();
    const int fb = w >> 2, dt = w & 3; const LAS bf16* Am = fb == 0 ? KTf : KTb;
    f32x4 acc[4];
#pragma unroll
    for (int et = 0; et < 4; ++et) acc[et] = (f32x4){0.f, 0.f, 0.f, 0.f};
#pragma unroll
    for (int ks = 0; ks < 4; ++ks) { const bf16x8 af = frag(Am, dt * 16, PJ, ks * 32, lane);
#pragma unroll
        for (int et = 0; et < 4; ++et) acc[et] = mma(af, frag(VT, et * 16, PJ, ks * 32, lane), acc[et]); }
    float* S = (float*)(p.ws + WS_RETS) + ((size_t)((fb * 2 + b) * NCHUNK + n) * 4 + h) * 4096;
#pragma unroll
    for (int et = 0; et < 4; ++et)
#pragma unroll
        for (int r = 0; r < 4; ++r) S[(dt * 16 + 4 * (lane >> 4) + r) * 64 + et * 16 + (lane & 15)] = acc[et][r];
}
__device__ __forceinline__ void ret_scan_item(const P& p, int layer, int it) {
    const int e = it * NTHREADS + threadIdx.x;
    const int de = e & 4095, h = (e >> 12) & 3, b = (e >> 14) & 1, dir = e >> 15;
    const float lg = log_sigmoid(p.in[dir == 0 ? 10 : 11][layer * 4 + h]); const float g = expf(128.f * lg);
    float* S = (float*)(p.ws + WS_RETS) + (size_t)((dir * 2 + b) * NCHUNK) * 4 * 4096 + (size_t)h * 4096 + de;
    float kv[NCHUNK];
#pragma unroll
    for (int n = 0; n < NCHUNK; ++n) kv[n] = S[(size_t)n * 4 * 4096];
    float st = 0.f;
    if (dir == 0) {
#pragma unroll
        for (int n = 0; n < NCHUNK; ++n) { const float t = kv[n]; kv[n] = st; st = st * g + t; }
    } else {
#pragma unroll
        for (int i = 0; i < NCHUNK; ++i) { const int n = i < 2 ? 1 - i : NCHUNK + 1 - i; const float t = kv[n]; kv[n] = st; st = st * g + t; }
    }
    float* S2 = (float*)(p.ws + WS_RETS2) + (size_t)((dir * 2 + b) * NCHUNK) * 4 * 4096 + (size_t)h * 4096 + de;
#pragma unroll
    for (int n = 0; n < NCHUNK; ++n) S2[(size_t)n * 4 * 4096] = kv[n];
}
__device__ __forceinline__ void ret_out_item(const P& p, LAS unsigned char* lds, int layer, int it) {
    using namespace rt;
    const int tid = threadIdx.x, lane = tid & 63, w = tid >> 6; const int h = it & 3, n = (it >> 2) % NCHUNK, b = (it >> 2) / NCHUNK;
    LAS bf16* Qs = (LAS bf16*)lds; LAS bf16* Ks = Qs + 128 * PQ; LAS bf16* VT = Ks + 128 * PQ; LAS bf16* Ps = VT + 64 * PJ; LAS bf16* SfT = Ps + 128 * PJ; LAS bf16* SbT = SfT + 64 * PQ;
    LAS float* pf = (LAS float*)(SbT + 64 * PQ); LAS float* pb = pf + 132;
    const int r0 = chunk_row0(b, n);
    const float lgf = log_sigmoid(p.in[10][layer * 4 + h]), lgb = log_sigmoid(p.in[11][layer * 4 + h]);
    const float* S = (const float*)(p.ws + WS_RETS2);
    const float* sfp = S + ((size_t)((0 * 2 + b) * NCHUNK + n) * 4 + h) * 4096; const float* sbp = S + ((size_t)((1 * 2 + b) * NCHUNK + n) * 4 + h) * 4096;
    __syncthreads();
    { const int j = tid >> 2, dq = (tid & 3) * 16;
      const bf16* Q = (const bf16*)(p.ws + WS_RETQ) + (size_t)(r0 + j) * 256 + h * 64 + dq; const bf16* K = (const bf16*)(p.ws + WS_RETK) + (size_t)(r0 + j) * 256 + h * 64 + dq;
      *(LAS u32x4*)(Qs + j * PQ + dq) = *(const u32x4*)Q; *(LAS u32x4*)(Qs + j * PQ + dq + 8) = *(const u32x4*)(Q + 8);
      *(LAS u32x4*)(Ks + j * PQ + dq) = *(const u32x4*)K; *(LAS u32x4*)(Ks + j * PQ + dq + 8) = *(const u32x4*)(K + 8); }
    { const int j = tid & 127, dq = (tid >> 7) * 16;
      const bf16* V = (const bf16*)(p.ws + WS_RETV) + (size_t)(r0 + j) * 256 + h * 64 + dq;
#pragma unroll
      for (int q8 = 0; q8 < 2; ++q8) { const u32x4 vw = *(const u32x4*)(V + q8 * 8); const unsigned vv[4] = {vw.x, vw.y, vw.z, vw.w};
#pragma unroll
          for (int q = 0; q < 4; ++q) { const int d = dq + q8 * 8 + 2 * q; VT[d * PJ + j] = (bf16)(vv[q] & 0xffffu); VT[(d + 1) * PJ + j] = (bf16)(vv[q] >> 16); } } }
    { const int d = tid & 63, e0 = (tid >> 6) * 8;
#pragma unroll
      for (int q4 = 0; q4 < 2; ++q4) { const f32x4 a = *(const f32x4*)(sfp + d * 64 + e0 + q4 * 4), c = *(const f32x4*)(sbp + d * 64 + e0 + q4 * 4);
#pragma unroll
          for (int q = 0; q < 4; ++q) { SfT[(e0 + q4 * 4 + q) * PQ + d] = f2bf(a[q]); SbT[(e0 + q4 * 4 + q) * PQ + d] = f2bf(c[q]); } } }
    if (tid <= 128) { pf[tid] = expf((float)tid * lgf); pb[tid] = expf((float)tid * lgb); }
    __syncthreads();
    { const bf16x8 a0 = frag(Qs, 16 * w, PQ, 0, lane), a1 = frag(Qs, 16 * w, PQ, 32, lane);
#pragma unroll
      for (int jt = 0; jt < 8; ++jt) { f32x4 c = (f32x4){0.f, 0.f, 0.f, 0.f};
          c = mma(a0, frag(Ks, jt * 16, PQ, 0, lane), c); c = mma(a1, frag(Ks, jt * 16, PQ, 32, lane), c);
          const int j = jt * 16 + (lane & 15);
#pragma unroll
          for (int r = 0; r < 4; ++r) { const int i = 16 * w + 4 * (lane >> 4) + r; const float dm = i > j ? pf[i - j] : (i < j ? pb[j - i] : 2.f); Ps[i * PJ + j] = f2bf(c[r] * dm); } } }
    __syncthreads();
    f32x4 aP[4], aF[4], aB[4];
#pragma unroll
    for (int et = 0; et < 4; ++et) { aP[et] = (f32x4){0.f, 0.f, 0.f, 0.f}; aF[et] = aP[et]; aB[et] = aP[et]; }
#pragma unroll
    for (int ks = 0; ks < 4; ++ks) { const bf16x8 af = frag(Ps, 16 * w, PJ, ks * 32, lane);
#pragma unroll
        for (int et = 0; et < 4; ++et) aP[et] = mma(af, frag(VT, et * 16, PJ, ks * 32, lane), aP[et]); }
#pragma unroll
    for (int ks = 0; ks < 2; ++ks) { const bf16x8 af = frag(Qs, 16 * w, PQ, ks * 32, lane);
#pragma unroll
        for (int et = 0; et < 4; ++et) { aF[et] = mma(af, frag(SfT, et * 16, PQ, ks * 32, lane), aF[et]); aB[et] = mma(af, frag(SbT, et * 16, PQ, ks * 32, lane), aB[et]); } }
    const float* rg = p.in[12] + layer * 256 + h * 64;
    const bf16* G = (const bf16*)(p.ws + WS_RETG) + (size_t)r0 * 256 + h * 64; bf16* X = (bf16*)(p.ws + WS_X) + (size_t)r0 * 1536 + 512 + h * 64;
    float gt[4][4];
#pragma unroll
    for (int r = 0; r < 4; ++r)
#pragma unroll
        for (int et = 0; et < 4; ++et) gt[r][et] = bf2f(G[(size_t)(16 * w + 4 * (lane >> 4) + r) * 256 + et * 16 + (lane & 15)]);
#pragma unroll
    for (int r = 0; r < 4; ++r) { const int i = 16 * w + 4 * (lane >> 4) + r; const float xf = pf[i + 1], xb = pb[128 - i];
        float o[4]; float ss = 0.f;
#pragma unroll
        for (int et = 0; et < 4; ++et) { o[et] = aP[et][r] + xf * aF[et][r] + xb * aB[et][r]; ss += o[et] * o[et]; }
        ss += __shfl_xor(ss, 1); ss += __shfl_xor(ss, 2); ss += __shfl_xor(ss, 4); ss += __shfl_xor(ss, 8);
        const float rstd = rsqrtf(ss * (1.f / 64.f) + EPS);
#pragma unroll
        for (int et = 0; et < 4; ++et) { const int e = et * 16 + (lane & 15); Ps[i * PJ + e] = f2bf(o[et] * rstd * rg[e] * siluf_(gt[r][et])); } }
    asm volatile("s_waitcnt lgkmcnt(0)" ::: "memory");
#pragma unroll
    for (int q = 0; q < 2; ++q) { const int c = lane + 64 * q, i = 16 * w + (c >> 3), e8 = (c & 7) * 8;
        *(u32x4*)(X + (size_t)i * 1536 + e8) = *(const LAS u32x4*)(Ps + i * PJ + e8); }
    __syncthreads();
}

#include <hip/hip_bf16.h>
#include <cmath>
namespace attn_body {
using bf16=__hip_bfloat16;
using bf16x8=__attribute__((ext_vector_type(8)))short;
using s16x4=__attribute__((ext_vector_type(4)))short;
using f32x16=__attribute__((ext_vector_type(16)))float;
using u32x4=__attribute__((ext_vector_type(4)))unsigned;
constexpr int D=64, QP=512, KP=128, OP=1536;
constexpr int NW=8,QBLK=32,QB=QBLK*NW,KVBLK=64;
__device__ __forceinline__ int crow(int r,int hi){return (r&3)+8*(r>>2)+4*hi;}
#define SBAR() __builtin_amdgcn_sched_barrier(0)
__device__ __forceinline__ void cmask(f32x16&p0,f32x16&p1,int jb,int qrel,int hi){
  const float NEG=-INFINITY; int kb=64*jb+4*hi;
  #pragma unroll
  for(int r=0;r<16;++r){int kv=kb+(r&3)+8*(r>>2); if(kv>qrel)p0[r]=NEG; if(kv+32>qrel)p1[r]=NEG;}
}

constexpr int NSLOT=3, SLOTB=8192;
constexpr int LDS_K=0, LDS_V=NSLOT*SLOTB, LDS_WS=2*NSLOT*SLOTB, LDS_OST=LDS_WS+NW*64*4, LDS_BYTES=LDS_OST+NW*4096;
constexpr float C2=0.125f*1.4426950408889634f;
__device__ __forceinline__ void glds16(const void*gsrc,unsigned lds_dst){unsigned keep;
  asm volatile("s_mov_b32 %0, m0\n\ts_mov_b32 m0, %2\n\ts_nop 0\n\tglobal_load_lds_dwordx4 %1, off\n\ts_mov_b32 m0, %0":"=&s"(keep):"v"(gsrc),"s"(lds_dst):"memory");}
__device__ __forceinline__ float max3f(float a,float b,float c){float r;asm("v_max3_f32 %0, %1, %2, %3":"=v"(r):"v"(a),"v"(b),"v"(c));return r;}
__device__ __forceinline__ float max2f(float a,float b){float r;asm("v_max_f32_e32 %0, %1, %2":"=v"(r):"v"(a),"v"(b));return r;}
__device__ __forceinline__ float fadd_s(float a,float b){float r;asm("v_add_f32_e32 %0, %1, %2":"=v"(r):"v"(a),"v"(b));return r;}
__device__ __forceinline__ float fsub_s(float a,float b){float r;asm("v_sub_f32_e32 %0, %1, %2":"=v"(r):"v"(a),"v"(b));return r;}
typedef float f32x2_t __attribute__((ext_vector_type(2))); typedef __bf16 bf16x2_t __attribute__((ext_vector_type(2)));
__device__ __forceinline__ unsigned cvtpk_s(float lo,float hi){f32x2_t v={lo,hi};bf16x2_t b=__builtin_convertvector(v,bf16x2_t);return __builtin_bit_cast(unsigned,b);}
#define WAIT_BAR(N) asm volatile("s_waitcnt vmcnt(" #N ") lgkmcnt(0)\n\ts_barrier":::"memory")

__device__ __forceinline__ void qkt(f32x16&p0,f32x16&p1,const char*Kslot,const bf16x8*qr,const f32x16&negm,int r32,int hi){
  const char*kb=Kslot+hi*1024+r32*16;
  #pragma unroll
  for(int d0=0;d0<4;++d0){
    const bf16x8 b0=*reinterpret_cast<const bf16x8*>(kb+d0*2048);
    const bf16x8 b1=*reinterpret_cast<const bf16x8*>(kb+d0*2048+512);
    if(d0==0){p0=__builtin_amdgcn_mfma_f32_32x32x16_bf16(b0,qr[0],negm,0,0,0);p1=__builtin_amdgcn_mfma_f32_32x32x16_bf16(b1,qr[0],negm,0,0,0);}
    else{p0=__builtin_amdgcn_mfma_f32_32x32x16_bf16(b0,qr[d0],p0,0,0,0);p1=__builtin_amdgcn_mfma_f32_32x32x16_bf16(b1,qr[d0],p1,0,0,0);}}
}
typedef __attribute__((address_space(3))) const char* lds_cptr;
typedef short v4i16_t __attribute__((ext_vector_type(4)));
__device__ __forceinline__ void kload8(bf16x8*kf,lds_cptr kp){
  kf[0]=*(const __attribute__((address_space(3))) bf16x8*)(kp);      kf[1]=*(const __attribute__((address_space(3))) bf16x8*)(kp+512);
  kf[2]=*(const __attribute__((address_space(3))) bf16x8*)(kp+2048); kf[3]=*(const __attribute__((address_space(3))) bf16x8*)(kp+2560);
  kf[4]=*(const __attribute__((address_space(3))) bf16x8*)(kp+4096); kf[5]=*(const __attribute__((address_space(3))) bf16x8*)(kp+4608);
  kf[6]=*(const __attribute__((address_space(3))) bf16x8*)(kp+6144); kf[7]=*(const __attribute__((address_space(3))) bf16x8*)(kp+6656);
}
__device__ __forceinline__ void kload2(bf16x8*kf,lds_cptr kp,int j){ kf[2*j]=*(const __attribute__((address_space(3))) bf16x8*)(kp+j*2048); kf[2*j+1]=*(const __attribute__((address_space(3))) bf16x8*)(kp+j*2048+512); }
__device__ __forceinline__ s16x4 vtr(lds_cptr p){ return __builtin_bit_cast(s16x4,__builtin_amdgcn_ds_read_tr16_b64_v4i16((__attribute__((address_space(3))) v4i16_t*)p)); }
__device__ __forceinline__ float rowmax(const f32x16&p0,const f32x16&p1){
  float a=max3f(p0[0],p0[1],p1[0]),b=max3f(p0[2],p0[3],p1[1]);a=max3f(a,p1[2],p1[3]);
  #pragma unroll
  for(int r=4;r<16;r+=4){a=max3f(a,p0[r],p0[r+1]);b=max3f(b,p0[r+2],p0[r+3]);a=max3f(a,p1[r],p1[r+1]);b=max3f(b,p1[r+2],p1[r+3]);}
  const float m=max2f(a,b);
  auto rr=__builtin_amdgcn_permlane32_swap(__float_as_uint(m),__float_as_uint(m),false,false);
  return max2f(__uint_as_float(rr[0]),__uint_as_float(rr[1]));
}
__device__ __forceinline__ void pv(f32x16*o,int vb,bf16x8 pa0,bf16x8 pa1,bf16x8 pa2,bf16x8 pa3){
  #pragma unroll
  for(int d0=0;d0<2;++d0){s16x4 lo[4],hi[4];
    #pragma unroll
    for(int ks=0;ks<4;++ks){
      asm volatile("ds_read_b64_tr_b16 %0,%1 offset:%c2":"=&v"(lo[ks]):"v"(vb),"i"(d0*4096+ks*1024):"memory");
      asm volatile("ds_read_b64_tr_b16 %0,%1 offset:%c2":"=&v"(hi[ks]):"v"(vb),"i"(d0*4096+ks*1024+512):"memory");}
    asm volatile("s_waitcnt lgkmcnt(0)":::"memory");SBAR();
    #define PK(k) (bf16x8){lo[k][0],lo[k][1],lo[k][2],lo[k][3],hi[k][0],hi[k][1],hi[k][2],hi[k][3]}
    o[d0]=__builtin_amdgcn_mfma_f32_32x32x16_bf16(pa0,PK(0),o[d0],0,0,0);
    o[d0]=__builtin_amdgcn_mfma_f32_32x32x16_bf16(pa1,PK(1),o[d0],0,0,0);
    o[d0]=__builtin_amdgcn_mfma_f32_32x32x16_bf16(pa2,PK(2),o[d0],0,0,0);
    o[d0]=__builtin_amdgcn_mfma_f32_32x32x16_bf16(pa3,PK(3),o[d0],0,0,0);
    #undef PK
  }
}

#ifndef ATTN_STORE16
#define ATTN_STORE16(p,v) (*(u32x4*)(p)=(v))
#endif
template<int THRL> __device__ __forceinline__ void attn_unit(const bf16*Q0,const bf16*__restrict__ Kh,const bf16*__restrict__ Vh,bf16*O0,const int NT,char*shm){
  const int tid=threadIdx.x,lane=tid&63,r32=lane&31,hi=lane>>5; const int wid=__builtin_amdgcn_readfirstlane(tid>>6);
  const bf16*Qw=Q0+(long)(wid*QBLK)*QP;
  const unsigned lds0=(unsigned)(uintptr_t)shm;
  float*wsf=(float*)(shm+LDS_WS)+wid*64;
  const bf16*ksrc=Kh+(long)lane*KP+wid*8;
  const bf16*vsrc=Vh+(long)(16*(wid&3)+(lane>>2))*KP+(wid>>2)*32+(lane&3)*8;
  const unsigned kdst=lds0+LDS_K+wid*1024, vdst=lds0+LDS_V+wid*1024;
  #define DMA_K(t,slot) glds16(ksrc+(long)(t)*KVBLK*KP,(unsigned)__builtin_amdgcn_readfirstlane(kdst+(slot)))
  #define DMA_V(t,slot) glds16(vsrc+(long)(t)*KVBLK*KP,(unsigned)__builtin_amdgcn_readfirstlane(vdst+(slot)))
  const int vb0=(int)(lds0+LDS_V)+((lane>>4)&1)*32+(lane&3)*8+(4*hi+((lane&15)>>2))*64;
  const char*Kbase=shm+LDS_K; bf16x8 kf[8];
  const lds_cptr shm3=(lds_cptr)shm; const lds_cptr kp0=shm3+LDS_K+hi*1024+r32*16; const lds_cptr vp0=shm3+LDS_V+((lane>>4)&1)*32+(lane&3)*8+(4*hi+((lane&15)>>2))*64;
  DMA_K(0,0);DMA_V(0,0);DMA_K(1,SLOTB);
  bf16x8 qr[4];
  #pragma unroll
  for(int d0=0;d0<4;++d0)qr[d0]=*reinterpret_cast<const bf16x8*>(&Qw[(long)r32*QP+d0*16+hi*8]);
  float mhat=0.f,l_reg=0.f;f32x16 o[2];o[0]=f32x16{};o[1]=f32x16{};f32x16 negm=f32x16{};asm volatile("":"+v"(negm));
  #define CMASK(P0,P1,t) do{}while(0)
  bool resc=false;
  #define START(P0,P1) do{ const float rm=rowmax(P0,P1); resc=false; \
    { const float dl=rm; mhat=fadd_s(mhat,dl); \
      _Pragma("unroll") for(int r=0;r<16;++r){P0[r]=fsub_s(P0[r],dl);P1[r]=fsub_s(P1[r],dl);} \
      _Pragma("unroll") for(int r=0;r<16;++r)negm[r]=-mhat; asm volatile("":"+v"(negm)); } \
    _Pragma("unroll") for(int r=0;r<16;++r)P0[r]=__builtin_amdgcn_exp2f(P0[r]); }while(0)
  #define RESC() do{ if(resc){ asm volatile("s_waitcnt lgkmcnt(0)":::"memory"); \
      _Pragma("unroll") for(int d_=0;d_<2;++d_) _Pragma("unroll") for(int r=0;r<16;++r)o[d_][r]*=wsf[crow(r,hi)]; } }while(0)
  f32x16 pA0,pA1,pB0,pB1;
  int sl_prev=0,sl_cur=0,sl_next=SLOTB;
  #define ROT() do{sl_prev=sl_cur;sl_cur=sl_next;sl_next=(sl_next==(NSLOT-1)*SLOTB)?0:sl_next+SLOTB;}while(0)
  DMA_K(2,2*SLOTB);
  WAIT_BAR(3);
  qkt(pA0,pA1,Kbase,qr,negm,r32,hi);asm volatile("s_nop 15\n\ts_nop 7":"+v"(pA0),"+v"(pA1));CMASK(pA0,pA1,0);
  START(pA0,pA1);
  _Pragma("unroll") for(int r=0;r<16;++r)pA1[r]=__builtin_amdgcn_exp2f(pA1[r]);
  WAIT_BAR(0);
  DMA_K(3,0);DMA_V(1,SLOTB);
  ROT();
  kload8(kf,kp0+sl_cur);
  WAIT_BAR(2);
  s16x4 vlo[8],vhi[8]; u32x4 pw0,pw1,pw2,pw3;
  #define PKW(P,B) cvtpk_s(P[B],P[B+1])
  #define PAF(k) __builtin_bit_cast(bf16x8,pw##k)
  #define VFR(i) (bf16x8){vlo[i][0],vlo[i][1],vlo[i][2],vlo[i][3],vhi[i][0],vhi[i][1],vhi[i][2],vhi[i][3]}
  #define PIN(x) asm volatile("":"+v"(x))
  #define MX3(a,b,c) __builtin_fmaxf(__builtin_fmaxf((a),(b)),(c))
  #define GAPA(MF,A0,A1,A2,A3,W0,W1,PW) do{ MF; sacc+=A0; sacc+=A1; sacc+=A2; sacc+=A3; PIN(sacc); W0; W1; PIN(PW); SBAR(); }while(0)
  #define EX(v) __builtin_amdgcn_exp2f(v)
  #define GAPB(MF,X,B) do{ MF; X[B]=EX(X[B]); X[B+1]=EX(X[B+1]); X[B+2]=EX(X[B+2]); X[B+3]=EX(X[B+3]); PIN(X); SBAR(); }while(0)
  #define VRD(i) do{ vlo[i]=vtr(vp_+(((i)>>2)*4096+((i)&3)*1024)); vhi[i]=vtr(vp_+(((i)>>2)*4096+((i)&3)*1024+512)); }while(0)
  #define KRD(G,j) do{ if(G){ kload2(kf,kp0+sl_next,j); SBAR(); } }while(0)
  #define STEP(C0,C1,P0,P1,t,GK,GV,GL) do{ SBAR(); \
    const lds_cptr vp_=vp0+sl_prev; \
    VRD(0); SBAR(); float sacc=(P0[0]+P0[1]); \
    GAPA(C0=__builtin_amdgcn_mfma_f32_32x32x16_bf16(kf[0],qr[0],negm,0,0,0), P0[2],P0[3],P0[4],P0[5],     pw0[0]=PKW(P0,0), pw0[1]=PKW(P0,2), pw0); \
    VRD(4); SBAR(); GAPA(C1=__builtin_amdgcn_mfma_f32_32x32x16_bf16(kf[1],qr[0],negm,0,0,0), P0[6],P0[7],P0[8],P0[9],     pw0[2]=PKW(P0,4), pw0[3]=PKW(P0,6), pw0); \
    VRD(1); SBAR(); GAPA(C0=__builtin_amdgcn_mfma_f32_32x32x16_bf16(kf[2],qr[1],C0,0,0,0),   P0[10],P0[11],P0[12],P0[13], pw1[0]=PKW(P0,8), pw1[1]=PKW(P0,10), pw1); \
    VRD(5); SBAR(); GAPA(C1=__builtin_amdgcn_mfma_f32_32x32x16_bf16(kf[3],qr[1],C1,0,0,0),   P0[14],P0[15],P1[0],P1[1],   pw1[2]=PKW(P0,12),pw1[3]=PKW(P0,14), pw1); \
    VRD(2); SBAR(); GAPA(C0=__builtin_amdgcn_mfma_f32_32x32x16_bf16(kf[4],qr[2],C0,0,0,0),   P1[2],P1[3],P1[4],P1[5],     pw2[0]=PKW(P1,0), pw2[1]=PKW(P1,2), pw2); \
    VRD(6); SBAR(); GAPA(C1=__builtin_amdgcn_mfma_f32_32x32x16_bf16(kf[5],qr[2],C1,0,0,0),   P1[6],P1[7],P1[8],P1[9],     pw2[2]=PKW(P1,4), pw2[3]=PKW(P1,6), pw2); \
    VRD(3); SBAR(); GAPA(C0=__builtin_amdgcn_mfma_f32_32x32x16_bf16(kf[6],qr[3],C0,0,0,0),   P1[10],P1[11],P1[12],P1[13], pw3[0]=PKW(P1,8), pw3[1]=PKW(P1,10), pw3); \
    VRD(7); SBAR(); GAPA(C1=__builtin_amdgcn_mfma_f32_32x32x16_bf16(kf[7],qr[3],C1,0,0,0),   P1[14],P1[15],0.f,0.f,       pw3[2]=PKW(P1,12),pw3[3]=PKW(P1,14), pw3); \
    l_reg+=sacc; \
    if(GK){DMA_K((t)+3,sl_cur);} if(GV){DMA_V((t)+1,sl_next);} \
    CMASK(C0,C1,t); \
    { float a=MX3(C0[0],C0[1],C1[0]),b=MX3(C0[2],C0[3],C1[1]); a=MX3(a,C1[2],C1[3]); \
      _Pragma("unroll") for(int r=4;r<16;r+=4){a=MX3(a,C0[r],C0[r+1]);b=MX3(b,C0[r+2],C0[r+3]);a=MX3(a,C1[r],C1[r+1]);b=MX3(b,C1[r+2],C1[r+3]);} \
      float rm=__builtin_fmaxf(a,b); { auto rr=__builtin_amdgcn_permlane32_swap(__float_as_uint(rm),__float_as_uint(rm),false,false); rm=__builtin_fmaxf(__uint_as_float(rr[0]),__uint_as_float(rr[1])); } \
      resc=false; \
      if(__builtin_expect(__any(rm>(float)THRL),0)){ const float dl=__builtin_fmaxf(rm,0.f); mhat+=dl; \
        _Pragma("unroll") for(int r=0;r<16;++r){C0[r]-=dl;C1[r]-=dl;} \
        _Pragma("unroll") for(int r=0;r<16;++r)negm[r]=-mhat; asm volatile("":"+v"(negm)); \
        const float f=__builtin_amdgcn_exp2f(-dl); l_reg*=f; if(hi==0)wsf[r32]=f; resc=true; } } \
    SBAR(); \
    GAPB(o[0]=__builtin_amdgcn_mfma_f32_32x32x16_bf16(PAF(0),VFR(0),o[0],0,0,0), C0,0); \
    GAPB(o[1]=__builtin_amdgcn_mfma_f32_32x32x16_bf16(PAF(0),VFR(4),o[1],0,0,0), C0,4); \
    KRD(GL,0); GAPB(o[0]=__builtin_amdgcn_mfma_f32_32x32x16_bf16(PAF(1),VFR(1),o[0],0,0,0), C0,8); \
    KRD(GL,1); GAPB(o[1]=__builtin_amdgcn_mfma_f32_32x32x16_bf16(PAF(1),VFR(5),o[1],0,0,0), C0,12); \
    KRD(GL,2); GAPB(o[0]=__builtin_amdgcn_mfma_f32_32x32x16_bf16(PAF(2),VFR(2),o[0],0,0,0), C1,0); \
    KRD(GL,3); GAPB(o[1]=__builtin_amdgcn_mfma_f32_32x32x16_bf16(PAF(2),VFR(6),o[1],0,0,0), C1,4); \
    GAPB(o[0]=__builtin_amdgcn_mfma_f32_32x32x16_bf16(PAF(3),VFR(3),o[0],0,0,0), C1,8); \
    GAPB(o[1]=__builtin_amdgcn_mfma_f32_32x32x16_bf16(PAF(3),VFR(7),o[1],0,0,0), C1,12); \
    }while(0)
  int t=1;
  #undef CMASK
  #define CMASK(P0,P1,t) do{}while(0)
  for(;t+5<NT;t+=2){
    STEP(pB0,pB1,pA0,pA1,t,true,true,true);     WAIT_BAR(2); RESC(); ROT();
    STEP(pA0,pA1,pB0,pB1,t+1,true,true,true);   WAIT_BAR(2); RESC(); ROT();
  }
  #undef CMASK
  #define CMASK(P0,P1,t) do{}while(0)
  #define ENDW(tt) do{ if((tt)+3<NT){WAIT_BAR(2);} else if((tt)+2<NT){WAIT_BAR(1);} else {WAIT_BAR(0);} }while(0)
  for(;t+1<NT;t+=2){
    STEP(pB0,pB1,pA0,pA1,t,(t+3<NT),(t+1<NT),(t+1<NT));       ENDW(t);   RESC(); ROT();
    STEP(pA0,pA1,pB0,pB1,t+1,(t+4<NT),(t+2<NT),(t+2<NT));     ENDW(t+1); RESC(); ROT();
  }
  STEP(pB0,pB1,pA0,pA1,NT-1,false,false,false); RESC();
  { float sacc=pB0[0]+pB0[1]; _Pragma("unroll") for(int r=2;r<16;++r)sacc+=pB0[r]; _Pragma("unroll") for(int r=0;r<16;++r)sacc+=pB1[r]; l_reg+=sacc;
    pw0=(u32x4){PKW(pB0,0),PKW(pB0,2),PKW(pB0,4),PKW(pB0,6)};pw1=(u32x4){PKW(pB0,8),PKW(pB0,10),PKW(pB0,12),PKW(pB0,14)};pw2=(u32x4){PKW(pB1,0),PKW(pB1,2),PKW(pB1,4),PKW(pB1,6)};pw3=(u32x4){PKW(pB1,8),PKW(pB1,10),PKW(pB1,12),PKW(pB1,14)};
    SBAR(); pv(o,vb0+sl_cur,PAF(0),PAF(1),PAF(2),PAF(3)); }
  #undef PKW
  #undef PAF
  #undef VFR
  #undef PIN
  #undef MX3
  #undef GAPA
  #undef GAPB
  #undef EX
  #undef VRD
  #undef KRD
  #undef STEP
  #undef ENDW
  {auto rr=__builtin_amdgcn_permlane32_swap(__float_as_uint(l_reg),__float_as_uint(l_reg),false,false);l_reg=__uint_as_float(rr[0])+__uint_as_float(rr[1]);}
  if(hi==0)wsf[32+r32]=l_reg;asm volatile("s_waitcnt lgkmcnt(0)":::"memory");
  float rli[16];
  #pragma unroll
  for(int r=0;r<16;++r)rli[r]=__builtin_amdgcn_rcpf(wsf[32+crow(r,hi)]);
  bf16*Ow=O0+(long)(wid*QBLK)*OP;
  { bf16*stg=(bf16*)(shm+LDS_OST)+wid*2048;
    #pragma unroll
    for(int r=0;r<16;++r){const int orow=crow(r,hi);
      #pragma unroll
      for(int d0=0;d0<2;++d0)stg[orow*64+d0*32+r32]=__float2bfloat16(o[d0][r]*rli[r]);}
    asm volatile("s_waitcnt lgkmcnt(0)":::"memory");
    #pragma unroll
    for(int i=0;i<4;++i){const int row=i*8+(lane>>3),ch=lane&7; const u32x4 v=*(const u32x4*)(stg+row*64+ch*8); ATTN_STORE16(Ow+(long)row*OP+ch*8,v);} }
  asm volatile("s_waitcnt lgkmcnt(0)\n\ts_barrier":::"memory");
  #undef DMA_K
  #undef DMA_V
  #undef CMASK
  #undef START
  #undef RESC
  #undef ROT
}
constexpr int ATTN_LDS_BYTES=LDS_BYTES;
#undef SBAR
#undef WAIT_BAR
}

__device__ __forceinline__ void attn_phase_run(const P& p, unsigned char* lds_generic, int layer) {
    typedef attn_body::bf16 abf;
    const int G = gridDim.x, bx = blockIdx.x, vcu = (G % 8 == 0) ? (bx % 8) * (G / 8) + bx / 8 : bx;
    const abf* Q = (const abf*)(p.ws + WS_ATTQ); const abf* K = (const abf*)(p.ws + WS_ATTK); const abf* V = (const abf*)(p.ws + WS_ATTV); abf* X = (abf*)(p.ws + WS_X);
    if (G == 256) {
        const int x = vcu >> 5, qb = vcu & 31, b = x >> 2, kvh = (x >> 1) & 1;
#pragma unroll 1
        for (int i = 0; i < 2; ++i) { const int h = kvh * 4 + 2 * (x & 1) + i; const long r0 = (long)b * SEQ + qb * 256;
            attn_body::attn_unit<8>(Q + r0 * 512 + h * 64, K + (long)b * KEYS * 128 + kvh * 64, V + (long)b * KEYS * 128 + kvh * 64, X + r0 * 1536 + 768 + h * 64, KEYS / 64, (char*)lds_generic); }
    } else {
#pragma unroll 1
        for (int u = vcu; u < 512; u += G) { const int qb = u & 31, h = (u >> 5) & 7, b = u >> 8, kvh = h >> 2; const long r0 = (long)b * SEQ + qb * 256;
            attn_body::attn_unit<8>(Q + r0 * 512 + h * 64, K + (long)b * KEYS * 128 + kvh * 64, V + (long)b * KEYS * 128 + kvh * 64, X + r0 * 1536 + 768 + h * 64, KEYS / 64, (char*)lds_generic); }
    }
    if (layer == 0) {
#pragma unroll 1
        for (int u = vcu; u < 16; u += G) { const int b = u >> 3, h = u & 7, kvh = h >> 2; const long r0 = NLAT + (long)b * CTX;
            attn_body::attn_unit<8>(Q + r0 * 512 + h * 64, K + (long)b * KEYS * 128 + kvh * 64, V + (long)b * KEYS * 128 + kvh * 64, X + r0 * 1536 + 768 + h * 64, CTX / 64, (char*)lds_generic); }
    }
}

__device__ __forceinline__ void ph_fft1(const P& p, LAS unsigned char* lds, int layer) {
    int nt2 = 2; asm volatile("" : "+s"(nt2));
    { fg::PlainSched S{(const char*)(p.ws + WS_F1), (const char*)(p.ws + WS_UT), 256, 256, 1, 128, (int)gridDim.x, (int)blockIdx.x, nt2};
      fg::EpiFft1 E{p.ws}; fg::gemm_phase(lds, 256, 256, S, E); }
    if (layer == 0) { fg::PlainSched S{(const char*)(p.ws + WS_FC), (const char*)(p.ws + WS_UTC), 256, 256, 2, 2, (int)gridDim.x, (int)((blockIdx.x + 128) % gridDim.x), 4};
      fg::EpiFftC E{p.ws}; fg::gemm_phase(lds, 256, 256, S, E); }
}
__device__ __forceinline__ void ph_fft3(const P& p, LAS unsigned char* lds) {
    int nt2 = 2; asm volatile("" : "+s"(nt2));
    fg::PlainSched S{(const char*)(p.ws + WS_F2), (const char*)(p.ws + WS_Z), 256, 256, 1, 256, (int)gridDim.x, (int)blockIdx.x, nt2};
    fg::EpiFft3 E{p.ws}; fg::gemm_phase(lds, 256, 256, S, E);
}
__device__ __forceinline__ void ph_mix1(const P& p, LAS unsigned char* lds, int layer) {
    ph_fft1(p, lds, layer);
    const int nconv = layer == 0 ? 264 : 256;
    const int n0 = nconv, n1 = n0 + NB * NCHUNK * 4;
    for (int it = gridDim.x - 1 - blockIdx.x; it < n1; it += gridDim.x) {
        if (it < n0) { if (it < 256) conv_item(p, lds, layer, it >> 7, (it & 127) * 64); else conv_item(p, lds, layer, 2 + ((it - 256) >> 2), ((it - 256) & 3) * 64); }
        else ret_kv_item(p, lds, layer, it - n0);
    }
    __syncthreads();
}
__device__ __forceinline__ void ph_mix2(const P& p, LAS unsigned char* lds, unsigned char* lds_generic, int layer) {
    for (int it = blockIdx.x; it < 128; it += gridDim.x) ret_scan_item(p, layer, it);
    __syncthreads();
    ph_fft3(p, lds);
    attn_phase_run(p, lds_generic, layer);
    __syncthreads();
}
__device__ __forceinline__ void ph_mix3(const P& p, LAS unsigned char* lds, int layer, bool ctxlater) {
    for (int it = blockIdx.x; it < NB * NCHUNK * 4; it += gridDim.x) {
        const int n = (it >> 2) % NCHUNK; if ((layer == 1 || ctxlater) && n < 2) continue;
        ret_out_item(p, lds, layer, it);
    }
    __syncthreads();
}
__device__ __forceinline__ void ctx_ret_items(const P& p, LAS unsigned char* lds) {
    const int u = blockIdx.x;
    if (u < 16) { const int b = u >> 3, n = (u >> 2) & 1, h = u & 3;
        ret_out_item(p, lds, 0, (b * NCHUNK + n) * 4 + h);
        asm volatile("s_waitcnt vmcnt(0)" ::: "memory"); __syncthreads();
        if (threadIdx.x == 0) { __builtin_amdgcn_fence(__ATOMIC_RELEASE, "agent");
            __hip_atomic_fetch_add((unsigned*)(p.ws + WS_CTL) + CW_CCNT + (8 * 3) * 16, 1u, __ATOMIC_RELAXED, __HIP_MEMORY_SCOPE_AGENT); }
        __syncthreads(); }
}
__device__ __forceinline__ void ctx_ret_wait(const P& p) {
    if (threadIdx.x == 0) { unsigned* c = (unsigned*)(p.ws + WS_CTL) + CW_CCNT + (8 * 3) * 16; unsigned* tmo = (unsigned*)(p.ws + WS_CTL) + CW_TMO; unsigned sp = 0u;
        while (__hip_atomic_load(c, __ATOMIC_RELAXED, __HIP_MEMORY_SCOPE_AGENT) < 16u) { __builtin_amdgcn_s_sleep(1);
            if ((++sp & 255u) == 0u) { if (__hip_atomic_load(tmo, __ATOMIC_RELAXED, __HIP_MEMORY_SCOPE_AGENT)) break; if (sp > (1u << 22)) { atomicAdd(tmo, 1u); break; } } }
        __builtin_amdgcn_fence(__ATOMIC_ACQUIRE, "agent"); }
    __syncthreads();
}

namespace sk {
typedef short bf16x8 __attribute__((ext_vector_type(8)));
__device__ __forceinline__ void tile64(LAS unsigned char* lds, const bf16* A, int lda, const bf16* Bt, int ldb, int K, float (&out)[8]) {
    const int tid = threadIdx.x, lane = tid & 63, w = tid >> 6, kc = K >> 3;
    const bf16* ap = A + (size_t)(lane & 15) * lda + w * kc + 8 * (lane >> 4); const bf16* bp = Bt + (size_t)(lane & 15) * ldb + w * kc + 8 * (lane >> 4);
    f32x4 acc[4][4];
#pragma unroll
    for (int i = 0; i < 4; ++i)
#pragma unroll
        for (int j = 0; j < 4; ++j) acc[i][j] = (f32x4){0.f, 0.f, 0.f, 0.f};
#pragma unroll 2
    for (int k0 = 0; k0 < kc; k0 += 32) {
        bf16x8 af[4], bfr[4];
#pragma unroll
        for (int i = 0; i < 4; ++i) { af[i] = *(const bf16x8*)(ap + (size_t)(16 * i) * lda + k0); bfr[i] = *(const bf16x8*)(bp + (size_t)(16 * i) * ldb + k0); }
#pragma unroll
        for (int i = 0; i < 4; ++i)
#pragma unroll
            for (int j = 0; j < 4; ++j) acc[i][j] = __builtin_amdgcn_mfma_f32_16x16x32_bf16(af[i], bfr[j], acc[i][j], 0, 0, 0);
    }
    LAS float* part = (LAS float*)lds;
    __syncthreads();
#pragma unroll
    for (int i = 0; i < 4; ++i)
#pragma unroll
        for (int j = 0; j < 4; ++j)
#pragma unroll
            for (int r = 0; r < 4; ++r) part[((w * 16 + i * 4 + j) * 4 + r) * 64 + lane] = acc[i][j][r];
    __syncthreads();
#pragma unroll
    for (int q = 0; q < 8; ++q) { float sacc = 0.f;
#pragma unroll
        for (int ww = 0; ww < 8; ++ww) sacc += part[ww * 4096 + tid + 512 * q];
        out[q] = sacc; }
}
__device__ __forceinline__ void tile64_f8(LAS unsigned char* lds, const unsigned char* A, int lda, const unsigned char* Bt, int ldb, int K, float (&out)[8]) {
    const int tid = threadIdx.x, lane = tid & 63, w = tid >> 6;
    const unsigned char* ap = A + (size_t)(lane & 15) * lda + 32 * (lane >> 4); const unsigned char* bp = Bt + (size_t)(lane & 15) * ldb + 32 * (lane >> 4);
    f32x4 acc[4][4];
#pragma unroll
    for (int i = 0; i < 4; ++i)
#pragma unroll
        for (int j = 0; j < 4; ++j) acc[i][j] = (f32x4){0.f, 0.f, 0.f, 0.f};
    for (int ks = w; ks * 128 < K; ks += 8) {
        fg::i32x8 af[4], bfr[4];
#pragma unroll
        for (int i = 0; i < 4; ++i) { af[i] = *(const fg::i32x8*)(ap + (size_t)(16 * i) * lda + ks * 128); bfr[i] = *(const fg::i32x8*)(bp + (size_t)(16 * i) * ldb + ks * 128); }
#pragma unroll
        for (int i = 0; i < 4; ++i)
#pragma unroll
            for (int j = 0; j < 4; ++j) acc[i][j] = __builtin_amdgcn_mfma_scale_f32_16x16x128_f8f6f4(af[i], bfr[j], acc[i][j], 0, 0, 0, 0x7f7f7f7f, 0, 0x7a7a7a7a);
    }
    LAS float* part = (LAS float*)lds;
    __syncthreads();
#pragma unroll
    for (int i = 0; i < 4; ++i)
#pragma unroll
        for (int j = 0; j < 4; ++j)
#pragma unroll
            for (int r = 0; r < 4; ++r) part[((w * 16 + i * 4 + j) * 4 + r) * 64 + lane] = acc[i][j][r];
    __syncthreads();
#pragma unroll
    for (int q = 0; q < 8; ++q) { float sacc = 0.f;
#pragma unroll
        for (int ww = 0; ww < 8; ++ww) sacc += part[ww * 4096 + tid + 512 * q];
        out[q] = sacc; }
}
__device__ __forceinline__ void elem_rc(int tid, int q, int& row, int& col) { const int e = tid + 512 * q, t16 = e >> 8, reg = (e >> 6) & 3, lane = e & 63; row = 16 * (t16 >> 2) + 4 * (lane >> 4) + reg; col = 16 * (t16 & 3) + (lane & 15); }
}
__device__ __forceinline__ void mini_merge_ctx(const P& p, LAS unsigned char* lds, int layer) {
    const bf16* X = (const bf16*)(p.ws + WS_X); const bf16* WB = (const bf16*)(p.ws + WS_WB) + (size_t)layer * 1024 * 1536; const unsigned char* G = (const unsigned char*)(p.ws + WS_G); bf16* Mg = (bf16*)(p.ws + WS_MERGED);
    for (int it = gridDim.x - 1 - blockIdx.x; it < (NCTX / 64) * 16; it += gridDim.x) { const int r0 = NLAT + (it >> 4) * 64, c0 = (it & 15) * 64;
        float tot[8];
#pragma unroll
        for (int q = 0; q < 8; ++q) tot[q] = 0.f;
#pragma unroll 1
        for (int br = 0; br < 4; ++br) { const int koff = br == 0 ? 0 : (br == 1 ? 512 : (br == 2 ? 768 : 1280)), klen = (br & 1) ? 256 : 512;
            float o[8]; sk::tile64(lds, X + (size_t)r0 * 1536 + koff, 1536, WB + (size_t)c0 * 1536 + koff, 1536, klen, o);
#pragma unroll
            for (int q = 0; q < 8; ++q) { int rr, cc; sk::elem_rc(threadIdx.x, q, rr, cc); tot[q] += o[q] * ((float)G[(size_t)(r0 + rr) * 4096 + br * 1024 + c0 + cc] * (1.f / 255.f)); } }
#pragma unroll
        for (int q = 0; q < 8; ++q) { int rr, cc; sk::elem_rc(threadIdx.x, q, rr, cc); Mg[(size_t)(r0 + rr) * 1024 + c0 + cc] = f2bf(tot[q]); } }
    __syncthreads();
}
__device__ __forceinline__ void mini_resid_ctx(const P& p, LAS unsigned char* lds, int layer, const bf16* A, int lda, const bf16* Bt, int K, int chunk, int xnorm = -1, int nlayer = 0, int nwhich = 0, const float* hsrc = nullptr) {
    const float* g = mods(p, layer, 2, chunk); float* hc = (float*)(p.ws + WS_HCTX); if (hsrc == nullptr) hsrc = hc;
    for (int it = gridDim.x - 1 - blockIdx.x; it < (NCTX / 64) * 16; it += gridDim.x) { const int rl = (it >> 4) * 64, c0 = (it & 15) * 64;
        float o[8]; sk::tile64(lds, A + (size_t)(NLAT + rl) * lda, lda, Bt + (size_t)c0 * K, K, K, o);
        if (xnorm < 0) {
#pragma unroll
            for (int q = 0; q < 8; ++q) { int rr, cc; sk::elem_rc(threadIdx.x, q, rr, cc); float* h = hc + (size_t)(rl + rr) * D + c0 + cc; *h = *h + g[c0 + cc] * o[q]; }
        } else {
#pragma unroll
            for (int q = 0; q < 8; ++q) { int rr, cc; sk::elem_rc(threadIdx.x, q, rr, cc); float* h = hc + (size_t)(rl + rr) * D + c0 + cc;
                __hip_atomic_store(h, hsrc[(size_t)(rl + rr) * D + c0 + cc] + g[c0 + cc] * o[q], __ATOMIC_RELAXED, __HIP_MEMORY_SCOPE_AGENT); }
            asm volatile("s_waitcnt vmcnt(0)" ::: "memory"); __syncthreads();
            if (threadIdx.x == 0) { unsigned* c = (unsigned*)(p.ws + WS_CTL) + CW_CCNT + (8 * xnorm + (it >> 4)) * 16; unsigned* tmo = (unsigned*)(p.ws + WS_CTL) + CW_TMO;
                __hip_atomic_fetch_add(c, 1u, __ATOMIC_RELAXED, __HIP_MEMORY_SCOPE_AGENT);
                unsigned sp = 0u;
                while (__hip_atomic_load(c, __ATOMIC_RELAXED, __HIP_MEMORY_SCOPE_AGENT) < 16u) { __builtin_amdgcn_s_sleep(1);
                    if ((++sp & 255u) == 0u) { if (__hip_atomic_load(tmo, __ATOMIC_RELAXED, __HIP_MEMORY_SCOPE_AGENT)) break; if (sp > (1u << 22)) { atomicAdd(tmo, 1u); break; } } }
                __builtin_amdgcn_fence(__ATOMIC_ACQUIRE, "agent"); }
            __syncthreads();
            { const int w = threadIdx.x >> 6, lane = threadIdx.x & 63;
              if (w < 4) norm_row(p, nlayer, nwhich, NLAT + rl + (it & 15) * 4 + w, lane); }
            __syncthreads();
        } }
    __syncthreads();
}
__device__ __forceinline__ void ph_merge(const P& p, LAS unsigned char* lds, int layer, int nrows) {
    fg::MergeSched S{(const char*)(p.ws + WS_X), (const char*)(p.ws + WS_WB) + (size_t)layer * 1024 * 1536 * 2, nrows / 256, (int)gridDim.x, (int)blockIdx.x};
    fg::EpiMerge E{(const unsigned char*)(p.ws + WS_G), (bf16*)(p.ws + WS_MERGED)};
    fg::gemm_phase(lds, 1536, 1536, S, E);
}
__device__ __forceinline__ void ph_gemm_resid(const P& p, LAS unsigned char* lds, int layer, const bf16* A, int lda, const bf16* Bt, int K, int chunk, int nrows) {
    fg::PlainSched S{(const char*)A, (const char*)Bt, lda, K, nrows / 256, 4, (int)gridDim.x, (int)blockIdx.x, K / 64};
    fg::EpiResid E{p.out, (float*)(p.ws + WS_HCTX), (const float*)(p.ws + WS_MODS) + (size_t)layer * 3 * 6144, chunk};
    fg::gemm_phase(lds, lda, K, S, E);
}
__device__ __forceinline__ void ph_gemm_resid_norm(const P& p, LAS unsigned char* lds, int layer, const bf16* A, int lda, const bf16* Bt, int K, int chunk, int x, int nlayer, int nwhich, const float* hin) {
    fg::PlainSched S{(const char*)A, (const char*)Bt, lda, K, NLAT / 256, 4, (int)gridDim.x, (int)blockIdx.x, K / 64};
    unsigned* ctl = (unsigned*)(p.ws + WS_CTL);
    fg::EpiResidNorm E{hin, p.out, (const float*)(p.ws + WS_MODS) + (size_t)layer * 3 * 6144, chunk,
        p.in[nwhich == 0 ? 6 : 7] + nlayer * D, (const float*)(p.ws + WS_MODS) + (size_t)nlayer * 3 * 6144, nwhich == 0 ? 0 : 3, nwhich == 0 ? 1 : 4, (bf16*)(p.ws + WS_A), nwhich == 0 ? p.ws + WS_A8 : (unsigned char*)nullptr,
        (float*)(p.ws + WS_CTL + CTL_XBUF) + (size_t)x * 65536, ctl + CW_PCNT + 64 * 16 * x, ctl + CW_TMO, lds};
    fg::gemm_phase(lds, lda, K, S, E);
}
__device__ __forceinline__ void ph_ffn1(const P& p, LAS unsigned char* lds) {
    fg::PlainSched S{(const char*)(p.ws + WS_A), (const char*)(p.ws + WS_FFN1), D, D, MROWS / 256, 22, (int)gridDim.x, (int)blockIdx.x, D / 64};
    fg::EpiSwiglu E{(bf16*)(p.ws + WS_HMID)};
    fg::gemm_phase(lds, D, D, S, E);
}
__device__ __forceinline__ int moe_tiles(const P& p, LAS int* tile_e) {
    const unsigned* ctl = (const unsigned*)(p.ws + WS_CTL); int t = 0;
    for (int e = 0; e < NEXP; ++e) { const int c = (int)ctl[CW_CNT + e], nt = (c + 255) >> 8; for (int q = 0; q < nt; ++q) { if (threadIdx.x == 0) tile_e[t + q] = e; } t += nt; }
    __syncthreads();
    return t;
}
__device__ __forceinline__ void ph_assign_gather(const P& p, LAS unsigned char* lds) {
    const int tid = threadIdx.x, bid = blockIdx.x, G = gridDim.x;
    LAS int* sbase = (LAS int*)lds;
    LAS int* stot = sbase + 8;
    LAS int* spst = stot + 8;
    LAS int* sexp = spst + 16;
    LAS int* sslot = sexp + 128;
    const unsigned* cntb = (const unsigned*)(p.ws + WS_ROUTE) + 16384 * 6;
    const int* tok_e = (const int*)(p.ws + WS_ROUTE); int* tok_slot = (int*)(p.ws + WS_ROUTE) + 16384 * 4;
    __syncthreads();
    { const int e = tid >> 6, l = tid & 63; int tot = 0, below = 0;
      for (int b = l; b < G; b += 64) { const int c = (int)cntb[b * NEXP + e]; tot += c; if (b < bid) below += c; }
#pragma unroll
      for (int o = 1; o < 64; o <<= 1) { tot += __shfl_xor(tot, o); below += __shfl_xor(below, o); }
      if (l == 0) { sbase[e] = below; stot[e] = tot; } }
    if (tid < 128) { const int li = tid >> 1, w = li & 7, k = li >> 3, tok = (bid * 8 + w) + k * (G * 8); sexp[tid] = tok < NLAT ? tok_e[tok * 2 + (tid & 1)] : -1; }
    __syncthreads();
    if (tid == 0) { int t = 0; for (int e = 0; e < NEXP; ++e) { spst[e] = t * 256; t += (stot[e] + 255) >> 8; } spst[NEXP] = t * 256;
        if (bid == 0) { unsigned* ctl = (unsigned*)(p.ws + WS_CTL); for (int e = 0; e < NEXP; ++e) ctl[CW_CNT + e] = (unsigned)stot[e]; } }
    __syncthreads();
    if (tid < 128) { const int e = sexp[tid]; int slot = -1;
        if (e >= 0) { int rank = 0; for (int a = 0; a < tid; ++a) rank += (sexp[a] == e) ? 1 : 0; slot = spst[e] + sbase[e] + rank;
            const int li = tid >> 1, w = li & 7, k = li >> 3, tok = (bid * 8 + w) + k * (G * 8); tok_slot[tok * 2 + (tid & 1)] = slot; }
        sslot[tid] = slot; }
    __syncthreads();
    const int lane = tid & 63, wv = tid >> 6; const unsigned char* A8 = p.ws + WS_A8; unsigned char* FS8 = p.ws + WS_FS;
    for (int a = wv; a < 128; a += 8) { const int slot = sslot[a]; if (slot < 0) continue; const int li = a >> 1, w = li & 7, k = li >> 3, tok = (bid * 8 + w) + k * (G * 8);
        *(u32x4*)(FS8 + (size_t)slot * D + lane * 16) = *(const u32x4*)(A8 + (size_t)tok * D + lane * 16); }
    { int idx = 0;
      for (int e = 0; e < NEXP; ++e) { const int lo_ = spst[e] + stot[e], hi_ = spst[e + 1];
          for (int r = lo_ + ((bid * 8 + wv - idx) % (G * 8) + (G * 8)) % (G * 8); r < hi_; r += G * 8) {
              *(u32x4*)(FS8 + (size_t)r * D + lane * 16) = (u32x4){0u, 0u, 0u, 0u}; }
          idx += hi_ - lo_; } }
    __syncthreads();
}
__device__ __forceinline__ void ph_moe1(const P& p, LAS unsigned char* lds) {
    LAS int* tile_e = (LAS int*)(lds + fg::STAGE_BYTES); const int nt = moe_tiles(p, tile_e);
    fg::ExpertSched S{(const char*)(p.ws + WS_FS), (const char*)(p.ws + WS_MOE1), D / 2, D / 2, nt, 22, (int)gridDim.x, (int)blockIdx.x, D / 128, tile_e, (size_t)5632 * D};
    fg::EpiSwiglu8 E{p.ws + WS_HMOE};
    fg::gemm_phase<fg::EpiSwiglu8, fg::ExpertSched, true>(lds, D / 2, D / 2, S, E);
}
__device__ __forceinline__ void ph_moe2(const P& p, LAS unsigned char* lds) {
    LAS int* tile_e = (LAS int*)(lds + fg::STAGE_BYTES); const int nt = moe_tiles(p, tile_e);
    const int nbig = nt < 128 ? nt : 128;
    fg::ExpertSched S{(const char*)(p.ws + WS_HMOE), (const char*)(p.ws + WS_MOE2), FFN / 2, FFN / 2, nbig, 4, (int)gridDim.x, (int)blockIdx.x, FFN / 128, tile_e, (size_t)D * FFN};
    fg::EpiStore E{(bf16*)(p.ws + WS_Y2), D};
    fg::gemm_phase<fg::EpiStore, fg::ExpertSched, true>(lds, FFN / 2, FFN / 2, S, E);
    const unsigned char* A = p.ws + WS_HMOE; bf16* Y = (bf16*)(p.ws + WS_Y2);
    for (int it = blockIdx.x; it < (nt - nbig) * 64; it += gridDim.x) {
        const int rt = nbig + (it >> 6), r0 = rt * 256 + ((it >> 4) & 3) * 64, c0 = (it & 15) * 64;
        const unsigned char* B = p.ws + WS_MOE2 + (size_t)tile_e[rt] * D * FFN;
        float o[8]; sk::tile64_f8(lds, A + (size_t)r0 * FFN, FFN, B + (size_t)c0 * FFN, FFN, FFN, o);
#pragma unroll
        for (int q = 0; q < 8; ++q) { int rr, cc; sk::elem_rc(threadIdx.x, q, rr, cc); Y[(size_t)(r0 + rr) * D + c0 + cc] = f2bf(o[q]); } }
    __syncthreads();
}
__device__ __forceinline__ void ph_combine(const P& p, int layer) {
    const int lane = threadIdx.x & 63, gw = blockIdx.x * 8 + (threadIdx.x >> 6), ngw = gridDim.x * 8;
    const float* tok_w = (const float*)(p.ws + WS_ROUTE) + 16384 * 2; const int* tok_slot = (const int*)(p.ws + WS_ROUTE) + 16384 * 4; const bf16* Y = (const bf16*)(p.ws + WS_Y2);
    for (int r = gw; r < NLAT; r += ngw) {
        const int s0 = tok_slot[r * 2], s1 = tok_slot[r * 2 + 1]; const float w0 = tok_w[r * 2], w1 = tok_w[r * 2 + 1];
        const float* g = mods(p, layer, row_mi(r), 5); float* h = p.out + (size_t)r * D;
#pragma unroll
        for (int j = 0; j < 4; ++j) { const int c = 4 * lane + 256 * j;
            const u32x2 a = *(const u32x2*)(Y + (size_t)s0 * D + c), bq = *(const u32x2*)(Y + (size_t)s1 * D + c); const f32x4 gg = *(const f32x4*)(g + c); f32x4 hv = *(f32x4*)(h + c);
            hv.x += gg.x * (w0 * __uint_as_float(a.x << 16) + w1 * __uint_as_float(bq.x << 16)); hv.y += gg.y * (w0 * __uint_as_float(a.x & 0xffff0000u) + w1 * __uint_as_float(bq.x & 0xffff0000u));
            hv.z += gg.z * (w0 * __uint_as_float(a.y << 16) + w1 * __uint_as_float(bq.y << 16)); hv.w += gg.w * (w0 * __uint_as_float(a.y & 0xffff0000u) + w1 * __uint_as_float(bq.y & 0xffff0000u));
            *(f32x4*)(h + c) = hv; }
    }
}

#define XB_TMO      128
static_assert(CW_TMO == CW_BAR + XB_TMO, "tmo word");
#define XB_XCNT(j)  (256  + 64 * (j))
#define XB_XSUB(j)  (1280 + 64 * (j))
#define XB_XGEN(j)  (2304 + 64 * (j))
#define XB_TOP      3328
#define XB_TOPGEN   3392
#define XCD_BAR_WORDS 3456
#define XB_SPIN_CAP (1u << 22)
__device__ __forceinline__ unsigned xb_ld(unsigned* p)              { return __hip_atomic_load(p, __ATOMIC_RELAXED, __HIP_MEMORY_SCOPE_AGENT); }
__device__ __forceinline__ unsigned xb_add(unsigned* p, unsigned v) { return __hip_atomic_fetch_add(p, v, __ATOMIC_RELAXED, __HIP_MEMORY_SCOPE_AGENT); }
__device__ __forceinline__ unsigned xb_xcc_id() { return (unsigned)__builtin_amdgcn_s_getreg((3 << 11) | 20) & 0xFu; }
#define XB_SPIN(cond, bar) do { unsigned _sp = 0; while (cond) { __builtin_amdgcn_s_sleep(1); \
    if ((++_sp & 255u) == 0u) { if (xb_ld(&(bar)[XB_TMO])) break; if (_sp > XB_SPIN_CAP) { atomicAdd(&(bar)[XB_TMO], 1u); break; } } } } while (0)
struct XcdBarrier { unsigned* bar; unsigned x; volatile LAS unsigned* st; };
__device__ __forceinline__ XcdBarrier xcd_barrier_post(unsigned* bar, volatile LAS unsigned* st) {
    XcdBarrier b; b.bar = bar; b.x = xb_xcc_id(); b.st = st;
    if (threadIdx.x == 0) (void)xb_add(&bar[XB_XCNT(b.x)], 1u);
    return b;
}
__device__ __forceinline__ void xcd_barrier_complete(unsigned* bar, unsigned x, unsigned& nloc, unsigned& nx) {
    const unsigned G = gridDim.x * gridDim.y * gridDim.z;
    unsigned sum, cnt, mine, sp = 0u;
    for (;;) {
        sum = 0u; cnt = 0u; mine = 0u;
#pragma unroll
        for (unsigned j = 0; j < 16; ++j) { const unsigned c = xb_ld(&bar[XB_XCNT(j)]); sum += c; cnt += (c > 0u) ? 1u : 0u; mine = (j == x) ? c : mine; }
        if (sum == G) break;
        __builtin_amdgcn_s_sleep(1);
        if ((++sp & 255u) == 0u) { if (xb_ld(&bar[XB_TMO])) break; if (sp > XB_SPIN_CAP) { atomicAdd(&bar[XB_TMO], 1u); break; } }
    }
    nloc = mine > 0u ? mine : 1u; nx = cnt > 0u ? cnt : 1u;
}
__device__ __forceinline__ void xcd_barrier(const XcdBarrier& b) {
    asm volatile("s_waitcnt vmcnt(0)" ::: "memory");
    __syncthreads();
    if (threadIdx.x == 0) {
        unsigned* bar = b.bar;
        __builtin_amdgcn_s_waitcnt(0);
        unsigned nloc = b.st[0], nx = b.st[1];
        if (nloc == 0u) { xcd_barrier_complete(bar, b.x, nloc, nx); b.st[0] = nloc; b.st[1] = nx; }
        const unsigned old = xb_add(&bar[XB_XSUB(b.x)], 1u);
        const unsigned gen = old / nloc;
        if (old + 1u == (gen + 1u) * nloc) {
            __builtin_amdgcn_fence(__ATOMIC_RELEASE, "agent");
            asm volatile("s_waitcnt vmcnt(0)" ::: "memory");
            const unsigned og = xb_add(&bar[XB_TOP], 1u);
            const unsigned tg = og / nx;
            if (og + 1u == (tg + 1u) * nx) xb_add(&bar[XB_TOPGEN], 1u);
            else XB_SPIN(xb_ld(&bar[XB_TOPGEN]) == tg, bar);
            __builtin_amdgcn_fence(__ATOMIC_ACQUIRE, "agent");
            xb_add(&bar[XB_XGEN(b.x)], 1u);
            asm volatile("s_waitcnt vmcnt(0)" ::: "memory");
        } else {
            XB_SPIN(xb_ld(&bar[XB_XGEN(b.x)]) == gen, bar);
            asm volatile("buffer_inv sc0" ::: "memory");
            asm volatile("s_waitcnt vmcnt(0)" ::: "memory");
        }
    }
    __syncthreads();
}

constexpr int NPHASE = 23;
constexpr int LDS_BYTES = 150 * 1024;
__global__ void __launch_bounds__(NTHREADS, 2) mk(P p, int lo, int hi, int fuse) {
    extern __shared__ __attribute__((aligned(16))) unsigned char lds_raw[];
    LAS unsigned char* lds = (LAS unsigned char*)lds_raw;
    volatile LAS unsigned* misc = (volatile LAS unsigned*)(lds + LDS_BYTES - 64);
    if (threadIdx.x < 16) misc[threadIdx.x] = 0u;
    __syncthreads();
    XcdBarrier bar; bar.bar = (unsigned*)(p.ws + WS_CTL) + CW_BAR; bar.x = 0; bar.st = misc;
    if (hi - lo > 1) bar = xcd_barrier_post((unsigned*)(p.ws + WS_CTL) + CW_BAR, misc);
#if MK_SINGLE
    cg::this_grid().sync();
#endif
#ifndef PROBE_MASK
#define PROBE_MASK 0u
#endif
#ifndef AMP_A
#define AMP_A (-1)
#define AMP_B (-1)
#define AMP_MUL 15
#endif
#define AMP(k) do { if ((k) == AMP_A && blockIdx.x == 0 && threadIdx.x == 0) { const unsigned long long t = __builtin_amdgcn_s_memrealtime(); misc[8] = (unsigned)t; } \
    if ((k) == AMP_B && blockIdx.x == 0 && threadIdx.x == 0) { const unsigned t1 = (unsigned)__builtin_amdgcn_s_memrealtime(), dt = (t1 - misc[8]) * AMP_MUL; while ((unsigned)__builtin_amdgcn_s_memrealtime() - t1 < dt) __builtin_amdgcn_s_sleep(8); } } while (0)
#define PH(k, body) do { if (lo <= (k) && (k) < hi) { if ((k) > lo) { xcd_barrier(bar); } AMP(k); body; \
    if ((PROBE_MASK >> (k)) & 1u) { xcd_barrier(bar); body; } } } while (0)
#define LAYER_PHASES(L, base) \
    PH(base + 0, ph_win(p, lds, L)); \
    PH(base + 1, ph_mix1(p, lds, L)); \
    PH(base + 2, ph_mix2(p, lds, lds_raw, L)); \
    PH(base + 3, ph_mix3(p, lds, L, fuse != 0)); \
    PH(base + 4, { if (L == 0 && fuse) ctx_ret_items(p, lds); ph_merge(p, lds, L, NLAT); if (L == 0) { if (fuse && (int)(gridDim.x - 1 - blockIdx.x) < (NCTX / 64) * 16) ctx_ret_wait(p); mini_merge_ctx(p, lds, L); } }); \
    PH(base + 5, { if (L == 0 && fuse) { ph_gemm_resid_norm(p, lds, 0, (const bf16*)(p.ws + WS_MERGED), 1024, (const bf16*)(p.ws + WS_WOUT), D, 2, 0, 0, 1, p.in[0]); mini_resid_ctx(p, lds, 0, (const bf16*)(p.ws + WS_MERGED), 1024, (const bf16*)(p.ws + WS_WOUT), D, 2, 0, 0, 1, p.in[2]); } \
        else { ph_gemm_resid(p, lds, L, (const bf16*)(p.ws + WS_MERGED), 1024, (const bf16*)(p.ws + WS_WOUT) + (size_t)L * D * D, D, 2, NLAT); if (L == 0) mini_resid_ctx(p, lds, L, (const bf16*)(p.ws + WS_MERGED), 1024, (const bf16*)(p.ws + WS_WOUT), D, 2); } });
    PH(0, ph_prologue(p, lds));
    PH(1, ph_norm(p, lds, 0, 0, true, false, MROWS, !fuse));
    LAYER_PHASES(0, 2)
    if (!fuse) PH(8, ph_norm(p, lds, 0, 1, false, false, MROWS));
    PH(9, ph_ffn1(p, lds));
    PH(10, { if (fuse) { ph_gemm_resid_norm(p, lds, 0, (const bf16*)(p.ws + WS_HMID), FFN, (const bf16*)(p.ws + WS_FFN2), FFN, 5, 1, 1, 0, p.out); mini_resid_ctx(p, lds, 0, (const bf16*)(p.ws + WS_HMID), FFN, (const bf16*)(p.ws + WS_FFN2), FFN, 5, 1, 1, 0); }
        else { ph_gemm_resid(p, lds, 0, (const bf16*)(p.ws + WS_HMID), FFN, (const bf16*)(p.ws + WS_FFN2), FFN, 5, NLAT); mini_resid_ctx(p, lds, 0, (const bf16*)(p.ws + WS_HMID), FFN, (const bf16*)(p.ws + WS_FFN2), FFN, 5); } });
    if (!fuse) PH(11, ph_norm(p, lds, 1, 0, false, false, MROWS));
    LAYER_PHASES(1, 12)
    PH(18, ph_norm(p, lds, 1, 1, false, true, NLAT));
    PH(19, { ph_assign_gather(p, lds); ph_moe_convert(p, lds); });
    PH(20, ph_moe1(p, lds));
    PH(21, ph_moe2(p, lds));
    PH(22, ph_combine(p, 1));
#undef PH
#undef LAYER_PHASES
}

extern "C" void kernel_launch(void* const* d_in, const int* in_sizes, int n_in, void* d_out, int out_size, void* d_ws, size_t ws_size, hipStream_t stream) {
    static int grid = 0;
    if (grid == 0) {
        if (n_in != 30 || out_size != NLAT * D || ws_size < WS_END) { fprintf(stderr, "kernel_launch: unexpected shapes (n_in %d out %d ws %zu)\n", n_in, out_size, ws_size); grid = -1; return; }
        int dev = 0, cus = 0, per_cu = 0;
        hipGetDevice(&dev); hipDeviceGetAttribute(&cus, hipDeviceAttributeMultiprocessorCount, dev);
        hipFuncSetAttribute((const void*)mk, hipFuncAttributeMaxDynamicSharedMemorySize, LDS_BYTES);
        hipOccupancyMaxActiveBlocksPerMultiprocessor(&per_cu, (const void*)mk, NTHREADS, LDS_BYTES);
        if (per_cu < 1) { fprintf(stderr, "kernel_launch: occupancy query says %d blocks per CU\n", per_cu); grid = -1; return; }
        grid = cus;
    }
    if (grid < 0) return;
    hipMemsetAsync((char*)d_ws + WS_CTL, 0, CTL_BYTES, stream);
    P p{};
    for (int i = 0; i < 30; ++i) p.in[i] = (const float*)d_in[i];
    p.out = (float*)d_out; p.ws = (unsigned char*)d_ws;
#if MK_SINGLE
    int lo = 0, hi = NPHASE, fuse = grid == 256 ? 1 : 0; void* args[] = {&p, &lo, &hi, &fuse};
    hipLaunchCooperativeKernel((const void*)mk, dim3(grid), dim3(NTHREADS), args, LDS_BYTES, stream);
#else
    for (int ph = 0; ph < NPHASE; ++ph) hipLaunchKernelGGL(mk, dim3(grid), dim3(NTHREADS), LDS_BYTES, stream, p, ph, ph + 1, 0);
#endif
}
```

```cpp
#include <hip/hip_runtime.h>
#include <hip/hip_cooperative_groups.h>
#include <cstdio>
#include <cstdint>
namespace cg = cooperative_groups;

#ifndef MK_SINGLE
#define MK_SINGLE 1
#endif

typedef unsigned short bf16;
typedef float f32x4 __attribute__((ext_vector_type(4)));
typedef unsigned u32x4 __attribute__((ext_vector_type(4)));
typedef unsigned u32x2 __attribute__((ext_vector_type(2)));
#define LAS __attribute__((address_space(3)))

constexpr int D = 1024, NB = 2, SEQ = 8192, CTX = 256, NLAT = NB * SEQ, NCTX = NB * CTX, MROWS = NLAT + NCTX;
constexpr int INC = 6656, FFN = 2816, NEXP = 8, KEYS = CTX + SEQ;
constexpr int NCHUNK = 66;
constexpr float EPS = 1e-6f;
constexpr float QSCALE = 0.125f * 1.4426950408889634f;
constexpr int MOE_ROWS = 34816;
constexpr int NTHREADS = 512;

constexpr size_t MiB = 1u << 20;
constexpr size_t WS_CTL = 0, CTL_BYTES = 1 * MiB;
constexpr size_t WS_MODS = 1 * MiB;
constexpr size_t WS_ROPE = 2 * MiB;
constexpr size_t WS_F1 = 4 * MiB;
constexpr size_t WS_F2 = WS_F1 + 131072;
constexpr size_t WS_FC = WS_F2 + 131072;
constexpr size_t WS_TW = WS_FC + 262144;
constexpr size_t WS_ROUTE = 5 * MiB;
constexpr size_t WS_HCTX = 6 * MiB;
constexpr size_t WS_WIN = 8 * MiB;
constexpr size_t WS_WB = 34 * MiB;
constexpr size_t WS_WOUT = 40 * MiB;
constexpr size_t WS_FFN1 = 44 * MiB;
constexpr size_t WS_FFN2 = 55 * MiB;
constexpr size_t WS_A = 61 * MiB;
constexpr size_t WS_X = 94 * MiB;
constexpr size_t WS_Y = 144 * MiB;
constexpr size_t WS_RETQ = WS_Y;
constexpr size_t WS_RETK = WS_RETQ + (size_t)MROWS * 256 * 2;
constexpr size_t WS_RETV = WS_RETK + (size_t)MROWS * 256 * 2;
constexpr size_t WS_RETG = WS_RETV + (size_t)MROWS * 256 * 2;
constexpr size_t WS_ATTQ = WS_Y + 33 * MiB;
constexpr size_t WS_ATTK = WS_Y + 50 * MiB;
constexpr size_t WS_ATTV = WS_Y + 55 * MiB;
constexpr size_t WS_CONV = WS_Y + 60 * MiB;
constexpr size_t WS_UT = WS_Y + 77 * MiB;
constexpr size_t WS_UTC = WS_Y + 93 * MiB;
constexpr size_t WS_Z = WS_Y + 94 * MiB;
constexpr size_t WS_RETS = WS_Y + 126 * MiB;
constexpr size_t WS_MERGED = WS_Y + 143 * MiB;
constexpr size_t WS_G = 320 * MiB;
constexpr size_t WS_MOE1 = WS_G;
constexpr size_t WS_MOE2 = WS_G + (size_t)NEXP * 5632 * 1024 * 2;
constexpr size_t WS_HMID = WS_Y;
constexpr size_t WS_HMOE = 61 * MiB;
constexpr size_t WS_FS = 252 * MiB;
constexpr size_t WS_A8 = 386 * MiB;
constexpr size_t WS_WIN8 = 430 * MiB;
constexpr size_t WS_RETS2 = 452 * MiB;
constexpr size_t WS_Y2 = 160 * MiB;
constexpr size_t WS_END = 469 * MiB;
static_assert(WS_MERGED + (size_t)MROWS * 1024 * 2 <= WS_G, "map");
static_assert(WS_HMOE + (size_t)MOE_ROWS * FFN * 2 <= WS_FS && WS_FS + (size_t)MOE_ROWS * 1024 * 2 <= WS_G, "map moe");
static_assert(WS_MOE2 + (size_t)NEXP * 1024 * FFN * 2 <= WS_END, "map moe w");
static_assert(WS_G + (size_t)MROWS * 4096 <= WS_A8 && WS_A8 + (size_t)NLAT * 1024 <= WS_MOE2 && WS_MOE2 + (size_t)NEXP * 1024 * FFN <= WS_WIN8 && WS_WIN8 + (size_t)2 * 4096 * 1024 <= WS_RETS2, "map fp8 w_in");
constexpr int CW_CNT = 64;
constexpr int CW_CUR = 128;
constexpr int CW_BAR = 4096;
constexpr int CW_TMO = CW_BAR + 128;
constexpr int CW_PCNT = 8192;
constexpr int CW_CCNT = 8192 + 4 * 64 * 16;
constexpr size_t CTL_XBUF = 128 * 1024;

struct P {
    const float* in[30];
    float* out;
    unsigned char* ws;
};

__device__ __forceinline__ float bf2f(bf16 v) { return __uint_as_float((unsigned)v << 16); }
__device__ __forceinline__ bf16 f2bf(float f) { unsigned u = __float_as_uint(f); return (bf16)((u + 0x7fffu + ((u >> 16) & 1u)) >> 16); }
__device__ __forceinline__ unsigned pk2(float lo, float hi) { return (unsigned)f2bf(lo) | ((unsigned)f2bf(hi) << 16); }
__device__ __forceinline__ float sigmoidf_(float x) { return 1.f / (1.f + __expf(-x)); }
__device__ __forceinline__ float siluf_(float x) { return x / (1.f + __expf(-x)); }
__device__ __forceinline__ float sigmoid_fast(float x) { return __builtin_amdgcn_rcpf(1.f + __builtin_amdgcn_exp2f(-1.4426950408889634f * x)); }
__device__ __forceinline__ float silu_fast(float x) { return x * __builtin_amdgcn_rcpf(1.f + __builtin_amdgcn_exp2f(-1.4426950408889634f * x)); }
__device__ __forceinline__ float wave_sum(float v) {
#pragma unroll
    for (int o = 1; o < 64; o <<= 1) v += __shfl_xor(v, o);
    return v;
}
__device__ __forceinline__ int row_mi(int r) { return r < NLAT ? (r >> 13) : 2; }
__device__ __forceinline__ float* hrow(const P& p, int r) { return r < NLAT ? p.out + (size_t)r * D : (float*)(p.ws + WS_HCTX) + (size_t)(r - NLAT) * D; }
__device__ __forceinline__ const float* mods(const P& p, int layer, int mi, int chunk) { return (const float*)(p.ws + WS_MODS) + ((size_t)(layer * 3 + mi) * 6 + chunk) * D; }

__device__ __forceinline__ int rowmap(int mode, int n) {
    if (mode == 0) return n;
    if (mode == 1 || mode == 2) return 8 * (n >> 2) + (n & 3) + (mode == 2 ? 4 : 0);
    const int tile = n >> 8, l = n & 255, head = l >> 6, d = l & 63;
    const bool ropet = tile == 1 || tile == 2 || tile == 5 || tile == 6 || (tile == 7 && head < 2);
    if (ropet) { const int i = d & 31, nn = d >> 5; return tile * 256 + 128 * (i >> 4) + 32 * head + 8 * ((i >> 2) & 3) + 4 * nn + (i & 3); }
    if (tile == 7) return tile * 256 + 128 * (d >> 5) + 32 * head + 8 * ((d >> 3) & 3) + (d & 7);
    return n;
}
__device__ __forceinline__ void conv_tile(LAS float* scr, const float* src, int ldn, int k0, int n0, bf16* dst, int ldd, int koff, int mode) {
    const int tid = threadIdx.x;
    __syncthreads();
#pragma unroll
    for (int i = 0; i < 8; ++i) { const int e = tid + i * NTHREADS, kk = e >> 6, nn = e & 63; scr[kk * 65 + nn] = src[(size_t)(k0 + kk) * ldn + n0 + nn]; }
    __syncthreads();
    const int nn = tid >> 3, kc = (tid & 7) * 8;
    u32x4 o; o.x = pk2(scr[(kc + 0) * 65 + nn], scr[(kc + 1) * 65 + nn]); o.y = pk2(scr[(kc + 2) * 65 + nn], scr[(kc + 3) * 65 + nn]);
    o.z = pk2(scr[(kc + 4) * 65 + nn], scr[(kc + 5) * 65 + nn]); o.w = pk2(scr[(kc + 6) * 65 + nn], scr[(kc + 7) * 65 + nn]);
    *(u32x4*)(dst + (size_t)rowmap(mode, n0 + nn) * ldd + koff + k0 + kc) = o;
}
constexpr float F8_WSCALE = 32.f;
__device__ __forceinline__ unsigned pk4_fp8(float a, float b, float c, float d) { int w = 0; w = __builtin_amdgcn_cvt_pk_fp8_f32(a, b, w, false); w = __builtin_amdgcn_cvt_pk_fp8_f32(c, d, w, true); return (unsigned)w; }
__device__ __forceinline__ void conv_tile2_f8(LAS float* scr, const float* src, int ldn, unsigned char* dst8, int ldd, int mode, int k0a, int n0a, int k0b, int n0b, bool two) {
    const int tid = threadIdx.x;
    f32x4 va[2], vb[2];
#pragma unroll
    for (int i = 0; i < 2; ++i) { const int e = tid + i * NTHREADS, kk = e >> 4, n4 = (e & 15) * 4;
        va[i] = *(const f32x4*)(src + (size_t)(k0a + kk) * ldn + n0a + n4);
        if (two) vb[i] = *(const f32x4*)(src + (size_t)(k0b + kk) * ldn + n0b + n4); }
    __syncthreads();
#pragma unroll
    for (int i = 0; i < 2; ++i) { const int e = tid + i * NTHREADS, kk = e >> 4, n4 = (e & 15) * 4;
#pragma unroll
        for (int q = 0; q < 4; ++q) { scr[kk * 65 + n4 + q] = va[i][q]; if (two) scr[64 * 65 + kk * 65 + n4 + q] = vb[i][q]; } }
    __syncthreads();
    const int nn = tid >> 3, kc = (tid & 7) * 8;
#pragma unroll
    for (int t = 0; t < 2; ++t) { if (t == 1 && !two) break; const LAS float* sp = scr + t * 64 * 65; const int k0 = t ? k0b : k0a, n0 = t ? n0b : n0a;
        u32x2 o; o.x = pk4_fp8(sp[(kc + 0) * 65 + nn] * F8_WSCALE, sp[(kc + 1) * 65 + nn] * F8_WSCALE, sp[(kc + 2) * 65 + nn] * F8_WSCALE, sp[(kc + 3) * 65 + nn] * F8_WSCALE);
        o.y = pk4_fp8(sp[(kc + 4) * 65 + nn] * F8_WSCALE, sp[(kc + 5) * 65 + nn] * F8_WSCALE, sp[(kc + 6) * 65 + nn] * F8_WSCALE, sp[(kc + 7) * 65 + nn] * F8_WSCALE);
        *(u32x2*)(dst8 + (size_t)rowmap(mode, n0 + nn) * ldd + k0 + kc) = o; }
}
__device__ __forceinline__ void conv_tile128_f8(LAS float* scr, const float* src, int ldn, unsigned char* dst8, int ldd, int mode, int k0, int n0) {
    const int tid = threadIdx.x;
    f32x4 v[8];
#pragma unroll
    for (int i = 0; i < 8; ++i) { const int e = tid + i * NTHREADS, kk = e >> 5, n4 = (e & 31) * 4; v[i] = *(const f32x4*)(src + (size_t)(k0 + kk) * ldn + n0 + n4); }
    __syncthreads();
#pragma unroll
    for (int i = 0; i < 8; ++i) { const int e = tid + i * NTHREADS, kk = e >> 5, n4 = (e & 31) * 4;
#pragma unroll
        for (int q = 0; q < 4; ++q) scr[kk * 129 + n4 + q] = v[i][q]; }
    __syncthreads();
    const int nn = tid >> 2, kc = (tid & 3) * 32;
    u32x4 o[2];
#pragma unroll
    for (int h = 0; h < 2; ++h) { const LAS float* sp = scr + (kc + h * 16) * 129 + nn;
        o[h].x = pk4_fp8(sp[0] * F8_WSCALE, sp[129] * F8_WSCALE, sp[2 * 129] * F8_WSCALE, sp[3 * 129] * F8_WSCALE);
        o[h].y = pk4_fp8(sp[4 * 129] * F8_WSCALE, sp[5 * 129] * F8_WSCALE, sp[6 * 129] * F8_WSCALE, sp[7 * 129] * F8_WSCALE);
        o[h].z = pk4_fp8(sp[8 * 129] * F8_WSCALE, sp[9 * 129] * F8_WSCALE, sp[10 * 129] * F8_WSCALE, sp[11 * 129] * F8_WSCALE);
        o[h].w = pk4_fp8(sp[12 * 129] * F8_WSCALE, sp[13 * 129] * F8_WSCALE, sp[14 * 129] * F8_WSCALE, sp[15 * 129] * F8_WSCALE); }
    unsigned char* d = dst8 + (size_t)rowmap(mode, n0 + nn) * ldd + k0 + kc;
    *(u32x4*)d = o[0]; *(u32x4*)(d + 16) = o[1];
}
struct CJob { const float* src; int K, N; bf16* dst; int ldd, koff, mode, ldn; };
__device__ __forceinline__ CJob get_job(const P& p, int j) {
    CJob c;
    if (j < 10) { const int l = j / 5, t = j % 5; bf16* wb = (bf16*)(p.ws + WS_WB) + (size_t)l * 1024 * 1536;
        if (t == 0) c = CJob{p.in[8] + (size_t)l * D * INC, D, l == 0 ? INC : 2560, (bf16*)(p.ws + WS_WIN) + (size_t)l * INC * D, D, 0, 3, INC};
        else if (t == 1) c = CJob{p.in[13] + (size_t)l * 256 * D, 256, D, wb, 1536, 512, 0};
        else if (t == 2) c = CJob{p.in[16] + (size_t)l * 512 * D, 512, D, wb, 1536, 768, 0};
        else if (t == 3) c = CJob{p.in[21] + (size_t)l * 256 * D, 256, D, wb, 1536, 1280, 0};
        else c = CJob{p.in[22] + (size_t)l * D * D, D, D, (bf16*)(p.ws + WS_WOUT) + (size_t)l * D * D, D, 0, 0}; }
    else if (j == 10) c = CJob{p.in[23], D, FFN, (bf16*)(p.ws + WS_FFN1), D, 0, 1};
    else if (j == 11) c = CJob{p.in[24], D, FFN, (bf16*)(p.ws + WS_FFN1), D, 0, 2};
    else c = CJob{p.in[25], FFN, D, (bf16*)(p.ws + WS_FFN2), FFN, 0, 0};
    return c;
}
__device__ __forceinline__ CJob get_moe_job(const P& p, int j) {
    const int e = j / 3, t = j % 3; CJob c;
    const float* sg = p.in[27]; const float* su = p.in[28]; const float* sd = p.in[29];
    asm volatile("" : "+s"(sg), "+s"(su), "+s"(sd));
    if (t == 0) c = CJob{sg + (size_t)e * D * FFN, D, FFN, (bf16*)(p.ws + WS_MOE1 + (size_t)e * 5632 * D), D, 0, 1};
    else if (t == 1) c = CJob{su + (size_t)e * D * FFN, D, FFN, (bf16*)(p.ws + WS_MOE1 + (size_t)e * 5632 * D), D, 0, 2};
    else c = CJob{sd + (size_t)e * FFN * D, FFN, D, (bf16*)(p.ws + WS_MOE2 + (size_t)e * D * FFN), FFN, 0, 0};
    return c;
}
template <bool MOE> __device__ __forceinline__ void run_conv_jobs(const P& p, LAS float* scr, int njobs, int bid, int nb) {
    int base = 0, base2 = 0;
    for (int j = 0; j < njobs; ++j) {
        const CJob jb = MOE ? get_moe_job(p, j) : get_job(p, j); const int nn = jb.N / 64, cnt = (jb.K / 64) * nn, ldn = jb.ldn ? jb.ldn : jb.N;
        const int first = ((bid - base) % nb + nb) % nb;
        if (MOE) { const int nn2 = jb.N / 128, cnt2 = (jb.K / 128) * nn2; const int first2 = ((bid - base2) % nb + nb) % nb;
            for (int i = first2; i < cnt2; i += nb) conv_tile128_f8(scr, jb.src, jb.N, (unsigned char*)jb.dst, jb.ldd, jb.mode, (i / nn2) * 128, (i % nn2) * 128);
            base2 += cnt2; }
        else for (int i = first; i < cnt; i += nb) conv_tile(scr, jb.src, ldn, (i / nn) * 64, (i % nn) * 64, jb.dst, jb.ldd, jb.koff, jb.mode);
        base += cnt;
    }
}
__device__ __forceinline__ void ph_prologue(const P& p, LAS unsigned char* lds) {
    const int tid = threadIdx.x, bid = blockIdx.x, nb = gridDim.x;
    const int gt = bid * NTHREADS + tid, ngt = nb * NTHREADS;
    LAS float* scr = (LAS float*)lds;
    run_conv_jobs<false>(p, scr, 13, bid, nb);
    __syncthreads();
    for (int i = bid; i < 512; i += nb) { const int l = i >> 8, t = i & 255;
        conv_tile128_f8(scr, p.in[8] + (size_t)l * D * INC + 2560, INC, p.ws + WS_WIN8 + (size_t)l * 4096 * 1024, 1024, 0, (t >> 5) * 128, (t & 31) * 128); }
    __syncthreads();
    {
        LAS float* tc = (LAS float*)lds; LAS float* tsn = tc + 64;
        __syncthreads();
        if (tid < 64) { tc[tid] = cospif(tid * (2.f / 64.f)); tsn[tid] = sinpif(tid * (2.f / 64.f)); }
        __syncthreads();
        const float s = 1.0f / sqrtf(64.f * 8192.f);
        for (int e = gt; e < 2 * 512 * 1024; e += ngt) {
            const int n = e & 1023, kk = (e >> 10) & 511, l = e >> 19;
            const int part = kk >> 8, g = (kk >> 6) & 3, c = kk & 63;
            const float* W = p.in[9] + (size_t)l * 256 * D + (size_t)(g * 64) * D + n;
            float acc = 0.f;
#pragma unroll 8
            for (int c2 = 0; c2 < 64; ++c2) { const int m = (c * c2) & 63; const float t = part == 0 ? tc[m] : -tsn[m]; acc += t * W[(size_t)c2 * D]; }
            ((bf16*)(p.ws + WS_WB))[(size_t)l * 1024 * 1536 + (size_t)n * 1536 + kk] = f2bf(acc * s);
        }
        __syncthreads();
    }
    {
        float* rc = (float*)(p.ws + WS_ROPE); float* rs = rc + SEQ * 32;
        for (int e = gt; e < SEQ * 32; e += ngt) {
            const int s = e >> 5, i = e & 31; const float inv = powf(10000.f, -(float)(i & 15) / 16.f);
            const float pos = (float)(i < 16 ? (s >> 6) : (s & 63)); const float ang = pos * inv;
            rc[e] = cosf(ang); rs[e] = sinf(ang);
        }
    }
    {
        bf16* F1 = (bf16*)(p.ws + WS_F1); bf16* F2 = (bf16*)(p.ws + WS_F2); bf16* FC = (bf16*)(p.ws + WS_FC);
        for (int e = gt; e < 256 * 256; e += ngt) {
            const int rho = e >> 8, n1 = e & 255; float v = 0.f;
            if (n1 < 128) { const int k1 = (rho >> 5) * 16 + (rho & 15), c = (rho >> 4) & 1, m = (k1 * n1) & 127; v = c == 0 ? cospif(m * (2.f / 128.f)) : -sinpif(m * (2.f / 128.f)); }
            F1[e] = f2bf(v);
            float w = 0.f;
            if (rho < 128 && n1 < 128) { const int c2 = rho >> 6, k2 = rho & 63, c = n1 >> 6, n2 = n1 & 63, m = (k2 * n2) & 63; const float cs = cospif(m * (2.f / 64.f)), sn = sinpif(m * (2.f / 64.f));
                w = c2 == 0 ? (c == 0 ? cs : sn) : (c == 0 ? sn : -cs); }
            F2[e] = f2bf(w);
        }
        float* TW = (float*)(p.ws + WS_TW);
        for (int e = gt; e < 128 * 64; e += ngt) { const int k1 = e >> 6, n2 = e & 63; TW[2 * e] = cospif((k1 * n2) * (2.f / 8192.f)); TW[2 * e + 1] = sinpif((k1 * n2) * (2.f / 8192.f)); }
        const float sc = sqrtf(32.f);
        for (int e = gt; e < 512 * 256; e += ngt) { const int rho = e >> 8, n = e & 255, c2 = rho >> 8, k = rho & 255, m = (k * n) & 255; FC[e] = f2bf(sc * (c2 == 0 ? cospif(m * (2.f / 256.f)) : sinpif(m * (2.f / 256.f)))); }
    }
    {
        LAS float* sv = (LAS float*)lds;
        LAS float* red = sv + 3 * 1024;
        __syncthreads();
        for (int e = tid; e < 3 * 1024; e += NTHREADS) { const int j = e >> 10, k = e & 1023; const float v = j < 2 ? p.in[1][j * D + k] : p.in[3][k]; sv[e] = siluf_(v); }
        __syncthreads();
        const int kq = tid >> 6, cl = tid & 63;
        for (int it = bid; it < 2 * 96; it += nb) {
            const int l = it / 96, n = (it % 96) * 64 + cl;
            const float* W = p.in[4] + (size_t)l * D * 6144 + n;
            float a0 = 0.f, a1 = 0.f, a2 = 0.f;
#pragma unroll 16
            for (int k = kq; k < D; k += 8) { const float w = W[(size_t)k * 6144]; a0 += sv[k] * w; a1 += sv[1024 + k] * w; a2 += sv[2048 + k] * w; }
            red[(kq * 3 + 0) * 64 + cl] = a0; red[(kq * 3 + 1) * 64 + cl] = a1; red[(kq * 3 + 2) * 64 + cl] = a2;
            __syncthreads();
            if (tid < 192) { const int j = tid >> 6; float s = 0.f;
#pragma unroll
                for (int q = 0; q < 8; ++q) s += red[(q * 3 + j) * 64 + cl];
                ((float*)(p.ws + WS_MODS))[(size_t)(l * 3 + j) * 6144 + n] = s + p.in[5][l * 6144 + n]; }
            __syncthreads();
        }
    }
}
__device__ __forceinline__ void ph_moe_convert(const P& p, LAS unsigned char* lds) {
    LAS float* scr = (LAS float*)lds;
    const int bid = blockIdx.x, nb = gridDim.x;
    run_conv_jobs<true>(p, scr, 24, bid, nb);
    __syncthreads();
}

__device__ __forceinline__ void ph_norm(const P& p, LAS unsigned char* lds, int layer, int which, bool first, bool route, int nrows, bool copy = true) {
    LAS unsigned* cnt_lds = (LAS unsigned*)lds;
    if (route) { __syncthreads(); if (threadIdx.x < NEXP) cnt_lds[threadIdx.x] = 0u; __syncthreads(); }
    const int lane = threadIdx.x & 63, gw = blockIdx.x * 8 + (threadIdx.x >> 6), ngw = gridDim.x * 8;
    const float* gain = p.in[which == 0 ? 6 : 7] + layer * D;
    bf16* A = (bf16*)(p.ws + WS_A);
    for (int r = gw; r < nrows; r += ngw) {
        const int mi = row_mi(r);
        const float* src = first ? (r < NLAT ? p.in[0] + (size_t)r * D : p.in[2] + (size_t)(r - NLAT) * D) : hrow(p, r);
        const float* shift = mods(p, layer, mi, which == 0 ? 0 : 3); const float* scale = mods(p, layer, mi, which == 0 ? 1 : 4);
        f32x4 v[4]; float ss = 0.f;
#pragma unroll
        for (int j = 0; j < 4; ++j) { v[j] = *(const f32x4*)(src + 4 * lane + 256 * j); ss += v[j].x * v[j].x + v[j].y * v[j].y + v[j].z * v[j].z + v[j].w * v[j].w; }
        if (first && copy) { float* h = hrow(p, r);
#pragma unroll
            for (int j = 0; j < 4; ++j) *(f32x4*)(h + 4 * lane + 256 * j) = v[j]; }
        const float rstd = rsqrtf(wave_sum(ss) * (1.f / D) + EPS);
        float lg[8];
#pragma unroll
        for (int e = 0; e < 8; ++e) lg[e] = 0.f;
#pragma unroll
        for (int j = 0; j < 4; ++j) {
            const int c = 4 * lane + 256 * j;
            const f32x4 g = *(const f32x4*)(gain + c), sc = *(const f32x4*)(scale + c), sh = *(const f32x4*)(shift + c);
            f32x4 y = v[j] * rstd * g * (sc + 1.f) + sh;
            u32x2 o; o.x = pk2(y.x, y.y); o.y = pk2(y.z, y.w);
            if (!route) *(u32x2*)(A + (size_t)r * D + c) = o;
            if ((which == 0 || route) && r < NLAT) *(unsigned*)(p.ws + WS_A8 + (size_t)r * D + c) = pk4_fp8(y.x, y.y, y.z, y.w);
            if (route) {
                const float* rw = p.in[26] + (size_t)c * 8;
#pragma unroll
                for (int q = 0; q < 4; ++q) { const f32x4 w0 = *(const f32x4*)(rw + q * 8), w1 = *(const f32x4*)(rw + q * 8 + 4); const float yy = y[q];
                    lg[0] += yy * w0.x; lg[1] += yy * w0.y; lg[2] += yy * w0.z; lg[3] += yy * w0.w; lg[4] += yy * w1.x; lg[5] += yy * w1.y; lg[6] += yy * w1.z; lg[7] += yy * w1.w; }
            }
        }
        if (route) {
#pragma unroll
            for (int e = 0; e < 8; ++e) lg[e] = wave_sum(lg[e]);
            if (lane == 0) {
                int e0 = 0; float v0 = lg[0];
#pragma unroll
                for (int e = 1; e < 8; ++e) if (lg[e] > v0) { v0 = lg[e]; e0 = e; }
                int e1 = -1; float v1 = -INFINITY;
#pragma unroll
                for (int e = 0; e < 8; ++e) if (e != e0 && lg[e] > v1) { v1 = lg[e]; e1 = e; }
                const float w0 = 1.f / (1.f + expf(v1 - v0));
                int* tok_e = (int*)(p.ws + WS_ROUTE); float* tok_w = (float*)(p.ws + WS_ROUTE) + 16384 * 2;
                tok_e[r * 2] = e0; tok_e[r * 2 + 1] = e1; tok_w[r * 2] = w0; tok_w[r * 2 + 1] = 1.f - w0;
                __hip_atomic_fetch_add(cnt_lds + e0, 1u, __ATOMIC_RELAXED, __HIP_MEMORY_SCOPE_WORKGROUP); __hip_atomic_fetch_add(cnt_lds + e1, 1u, __ATOMIC_RELAXED, __HIP_MEMORY_SCOPE_WORKGROUP);
            }
        }
    }
    if (route) { __syncthreads(); if (threadIdx.x < NEXP) ((unsigned*)(p.ws + WS_ROUTE) + 16384 * 6)[blockIdx.x * NEXP + threadIdx.x] = cnt_lds[threadIdx.x]; __syncthreads(); }
}

__device__ __forceinline__ void norm_row(const P& p, int layer, int which, int r, int lane) {
    const float* gain = p.in[which == 0 ? 6 : 7] + layer * D; bf16* A = (bf16*)(p.ws + WS_A);
    const int mi = row_mi(r); const float* src = hrow(p, r);
    const float* shift = mods(p, layer, mi, which == 0 ? 0 : 3); const float* scale = mods(p, layer, mi, which == 0 ? 1 : 4);
    f32x4 v[4]; float ss = 0.f;
#pragma unroll
    for (int j = 0; j < 4; ++j) { v[j] = *(const f32x4*)(src + 4 * lane + 256 * j); ss += v[j].x * v[j].x + v[j].y * v[j].y + v[j].z * v[j].z + v[j].w * v[j].w; }
    const float rstd = rsqrtf(wave_sum(ss) * (1.f / D) + EPS);
#pragma unroll
    for (int j = 0; j < 4; ++j) { const int c = 4 * lane + 256 * j;
        const f32x4 g = *(const f32x4*)(gain + c), sc = *(const f32x4*)(scale + c), sh = *(const f32x4*)(shift + c);
        const f32x4 y = v[j] * rstd * g * (sc + 1.f) + sh;
        u32x2 o; o.x = pk2(y.x, y.y); o.y = pk2(y.z, y.w);
        *(u32x2*)(A + (size_t)r * D + c) = o; }
}

namespace fg {
typedef short bf16x8 __attribute__((ext_vector_type(8)));
constexpr int BM = 256, BK = 64, HALF = 128, HTB = HALF * BK * 2, STAGE_BYTES = 8 * HTB, NXCD = 8, WGM = 8;
__device__ __forceinline__ int lds_byte(int r, int c) { const int st = (r >> 4) * 2 + (c >> 5), rr = r & 15, cc = c & 31, ob = rr * 64 + cc * 2; return st * 1024 + (ob ^ (((ob >> 9) & 1) << 5)); }
__device__ __forceinline__ void stage_rc(int b, int& R, int& C) { const int st = b / 1024, sb = b % 1024, swz = sb ^ (((sb >> 9) & 1) << 5); R = (st >> 1) * 16 + swz / 64; C = (st & 1) * 32 + (swz % 64) / 2; }
__device__ __forceinline__ int perm32(int rho) { const int n = rho >> 4, i = rho & 15; return 8 * (i >> 2) + 4 * n + (i & 3); }
struct Unit { int pm, pn; const char* A; const char* B; int nt, aux; };
__device__ __forceinline__ bool tile_order(int i, int nM, int nN, int G, int c, int& pm, int& pn) {
    const int nwg = nM * nN; const long L = (long)i * G + c; if (L >= nwg) return false;
    int wgid = (int)L; { const int q = nwg / NXCD, r = nwg % NXCD, xcd = wgid % NXCD, off = wgid / NXCD; wgid = (xcd < r ? xcd * (q + 1) : r * (q + 1) + (xcd - r) * q) + off; }
    const int nig = WGM * nN, gid = wgid / nig, fm = gid * WGM, gsz = (nM - fm) < WGM ? (nM - fm) : WGM;
    pm = fm + ((wgid % nig) % gsz); pn = (wgid % nig) / gsz; return true;
}
struct PlainSched {
    const char* Abase; const char* Bbase; int lda, ldb, nM, nN, G, c, nt;
    __device__ __forceinline__ int arow(int R) const { return R; }
    __device__ __forceinline__ int ahalf() const { return HALF; }
    __device__ __forceinline__ bool next(int i, Unit& u) const { if (!tile_order(i, nM, nN, G, c, u.pm, u.pn)) return false;
        u.A = Abase + (size_t)u.pm * BM * lda * 2; u.B = Bbase + (size_t)u.pn * BM * ldb * 2; u.nt = nt; u.aux = 0; return true; }
};
struct ExpertSched {
    const char* Abase; const char* Bbase; int lda, ldb, nM, nN, G, c, nt; const LAS int* tile_e; size_t estride;
    __device__ __forceinline__ int arow(int R) const { return R; }
    __device__ __forceinline__ int ahalf() const { return HALF; }
    __device__ __forceinline__ bool next(int i, Unit& u) const { if (!tile_order(i, nM, nN, G, c, u.pm, u.pn)) return false;
        u.A = Abase + (size_t)u.pm * BM * lda * 2; u.B = Bbase + (size_t)tile_e[u.pm] * estride + (size_t)u.pn * BM * ldb * 2; u.nt = nt; u.aux = 0; return true; }
};
struct WinSched {
    const char* Abase; const char* Bbase; int G, c, mode, nN;
    __device__ __forceinline__ int arow(int R) const { return mode == 0 ? 256 * (R & 15) + 64 * ((R >> 4) & 3) + (R >> 6) : R; }
    __device__ __forceinline__ int ahalf() const { return mode == 0 ? 4096 : HALF; }
    __device__ __forceinline__ bool next(int i, Unit& u) const { if (!tile_order(i, mode == 0 ? 64 : 2, nN, G, c, u.pm, u.pn)) return false;
        const size_t row0 = mode == 0 ? (size_t)((u.pm >> 5) * SEQ + 2 * (u.pm & 31)) : (size_t)(NLAT + u.pm * CTX);
        u.A = Abase + row0 * D * 2; u.B = Bbase + (size_t)u.pn * BM * D * 2; u.nt = D / 64; u.aux = mode; return true; }
};
struct MergeSched {
    const char* Xbase; const char* Wbase; int nM, G, c;
    __device__ __forceinline__ int arow(int R) const { return R; }
    __device__ __forceinline__ int ahalf() const { return HALF; }
    __device__ __forceinline__ bool next(int i, Unit& u) const { if (!tile_order(i >> 2, nM, 4, G, c, u.pm, u.pn)) return false;
        const int br = i & 3, koff = br == 0 ? 0 : (br == 1 ? 512 : (br == 2 ? 768 : 1280));
        u.A = Xbase + ((size_t)u.pm * BM * 1536 + koff) * 2; u.B = Wbase + ((size_t)u.pn * BM * 1536 + koff) * 2; u.nt = (br & 1) ? 4 : 8; u.aux = br; return true; }
};
template <class E, class = void> struct is_chain { static constexpr bool v = false; };
template <class E> struct is_chain<E, decltype((void)E::CHAIN)> { static constexpr bool v = E::CHAIN; };
typedef f32x4 Acc[2][2][4][2];
typedef int i32x4 __attribute__((ext_vector_type(4))); typedef int i32x8 __attribute__((ext_vector_type(8)));
__device__ __forceinline__ i32x8 ld32(const LAS unsigned char* p) { const i32x4 a = *(const LAS i32x4*)p, b = *(const LAS i32x4*)(p + 16); return __builtin_shufflevector(a, b, 0, 1, 2, 3, 4, 5, 6, 7); }
template <class Epi, class Sched, bool F8 = false>
__device__ __forceinline__ void gemm_phase(LAS unsigned char* lds, int lda, int ldb, const Sched& S, const Epi& E) {
    int tid_ = threadIdx.x; asm volatile("" : "+v"(tid_));
    const int tid = tid_, wid = __builtin_amdgcn_readfirstlane(tid >> 6), lane = tid & 63, wr = wid >> 2, wc = wid & 3, fr = lane & 15, fq = lane >> 4;
    unsigned voffA[2], voffB[2];
#pragma unroll
    for (int i = 0; i < 2; ++i) { int R, C; stage_rc(tid * 16 + i * 8192, R, C); const int Rb = Epi::PERM ? ((R & ~31) + perm32(R & 31)) : R;
        voffA[i] = (unsigned)(S.arow(R) * lda + C) * 2u; voffB[i] = (unsigned)(Rb * ldb + C) * 2u; }
    const size_t kstep = (size_t)(BK * 2);
    const size_t hstepA = (size_t)S.ahalf() * lda * 2, hstepB = (size_t)HALF * ldb * 2;
    const unsigned ldsw = (unsigned)wid * 1024u;
    const int aoff = lds_byte(wr * 64 + fr, F8 ? fq * 16 : fq * 8), boff = lds_byte(wc * 32 + fr, F8 ? fq * 16 : fq * 8);
#define FG_SA(b, h) (((b) * 2 + (h)) * HTB)
#define FG_SB(b, h) ((4 + (b) * 2 + (h)) * HTB)
#define FG_STAGE(bufoff, gbase, voff) do { _Pragma("unroll") for (int _i = 0; _i < 2; ++_i) \
        __builtin_amdgcn_global_load_lds((const unsigned*)((const char*)(gbase) + (voff)[_i]), (LAS unsigned*)(lds + (bufoff) + ldsw + _i * 8192), 16, 0, 0); } while (0)
#define FG_LDA(dst, b, h) do { if constexpr (F8) { _Pragma("unroll") for (int m = 0; m < 4; ++m) dst##8[m] = ld32(lds + FG_SA(b, h) + aoff + m * 2048); } \
        else { _Pragma("unroll") for (int m = 0; m < 4; ++m) _Pragma("unroll") for (int k = 0; k < 2; ++k) dst[m][k] = *(const LAS bf16x8*)(lds + FG_SA(b, h) + aoff + m * 2048 + k * 1024); } } while (0)
#define FG_LDB(dst, b, h) do { if constexpr (F8) { _Pragma("unroll") for (int n = 0; n < 2; ++n) dst##8[n] = ld32(lds + FG_SB(b, h) + boff + n * 2048); } \
        else { _Pragma("unroll") for (int n = 0; n < 2; ++n) _Pragma("unroll") for (int k = 0; k < 2; ++k) dst[n][k] = *(const LAS bf16x8*)(lds + FG_SB(b, h) + boff + n * 2048 + k * 1024); } } while (0)
#define FG_MMA(ai, bj, At, Bt) do { __builtin_amdgcn_s_setprio(1); _Pragma("unroll") for (int m = 0; m < 4; ++m) _Pragma("unroll") for (int n = 0; n < 2; ++n) { \
        if constexpr (F8) asm volatile("v_mfma_scale_f32_16x16x128_f8f6f4 %0, %1, %2, %0, %3, %4 op_sel_hi:[0,0,0]" : "+v"(acc[ai][bj][m][n]) : "v"(Bt##8[n]), "v"(At##8[m]), "v"(scw), "v"(sca)); \
        else { _Pragma("unroll") for (int k = 0; k < 2; ++k) acc[ai][bj][m][n] = __builtin_amdgcn_mfma_f32_16x16x32_bf16(Bt[n][k], At[m][k], acc[ai][bj][m][n], 0, 0, 0); } } \
        __builtin_amdgcn_s_setprio(0); } while (0)
#define FG_WAIT_V(n) asm volatile("s_waitcnt vmcnt(" #n ")" ::: "memory")
#define FG_WAIT_L(n) asm volatile("s_waitcnt lgkmcnt(" #n ")" ::: "memory")
#define FG_BAR __builtin_amdgcn_s_barrier()
#define FG_SCHED __builtin_amdgcn_sched_barrier(0)
    Unit cur, nxt; int ui = 0;
    if (!S.next(0, cur)) return;
    Acc acc;
#pragma unroll
    for (int a = 0; a < 2; ++a)
#pragma unroll
        for (int b = 0; b < 2; ++b)
#pragma unroll
            for (int m = 0; m < 4; ++m)
#pragma unroll
                for (int n = 0; n < 2; ++n) acc[a][b][m][n] = (f32x4){0.f, 0.f, 0.f, 0.f};
    bf16x8 At[4][2], B0[2][2], B1[2][2]; i32x8 At8[4], B08[2], B18[2];
    const int scw = 0x7a7a7a7a, sca = 0x7f7f7f7f;
    const char* cA = cur.A; const char* cB = cur.B;
    FG_STAGE(FG_SB(0, 0), cB, voffB); FG_STAGE(FG_SB(0, 1), cB + hstepB, voffB); FG_STAGE(FG_SA(0, 0), cA, voffA); FG_STAGE(FG_SA(0, 1), cA + hstepA, voffA);
    if (wr == 1) FG_BAR;
    FG_WAIT_V(2); FG_BAR;
    FG_STAGE(FG_SB(1, 0), cB + kstep, voffB); FG_STAGE(FG_SA(1, 0), cA + kstep, voffA); FG_STAGE(FG_SB(1, 1), cB + hstepB + kstep, voffB);
    FG_WAIT_V(6); FG_BAR;
    for (;;) {
        const bool has_next = S.next(ui + 1, nxt);
        const char* nA = has_next ? nxt.A : cA; const char* nB = has_next ? nxt.B : cB;
        const int nt = cur.nt;
#pragma unroll 1
        for (int t = 0; t < nt; t += 2) {
            const bool last = (t == nt - 2);
            const char* a1 = cA + (size_t)(t + 1) * kstep;
            const char* a2 = last ? nA : cA + (size_t)(t + 2) * kstep; const char* b2 = last ? nB : cB + (size_t)(t + 2) * kstep;
            const char* a3 = a2 + kstep; const char* b3 = b2 + kstep;
            FG_LDB(B0, 0, 0); FG_LDB(B1, 0, 1); FG_SCHED; FG_LDA(At, 0, 0); FG_STAGE(FG_SA(1, 1), a1 + hstepA, voffA);
            FG_WAIT_V(8); FG_WAIT_L(0); FG_BAR; FG_MMA(0, 0, At, B0); FG_MMA(0, 1, At, B1); FG_BAR; FG_SCHED;
            FG_LDA(At, 0, 1); FG_STAGE(FG_SB(0, 0), b2, voffB); FG_STAGE(FG_SB(0, 1), b2 + hstepB, voffB); FG_STAGE(FG_SA(0, 0), a2, voffA);
            FG_WAIT_V(8); FG_WAIT_L(0); FG_BAR; FG_MMA(1, 0, At, B0); FG_MMA(1, 1, At, B1); FG_BAR; FG_SCHED;
            FG_LDB(B0, 1, 0); FG_LDB(B1, 1, 1); FG_SCHED; FG_LDA(At, 1, 0); FG_STAGE(FG_SA(0, 1), a2 + hstepA, voffA);
            FG_WAIT_V(8); FG_WAIT_L(0); FG_BAR; FG_MMA(0, 0, At, B0); FG_MMA(0, 1, At, B1); FG_BAR; FG_SCHED;
            FG_LDA(At, 1, 1); FG_STAGE(FG_SB(1, 0), b3, voffB); FG_STAGE(FG_SB(1, 1), b3 + hstepB, voffB); FG_STAGE(FG_SA(1, 0), a3, voffA);
            FG_WAIT_V(8); FG_WAIT_L(0); FG_BAR; FG_MMA(1, 0, At, B0); FG_MMA(1, 1, At, B1); FG_BAR; FG_SCHED;
        }
        if (wr == 0) FG_BAR;
        E(acc, cur, wr, wc, fr, fq);
        if (!has_next) break;
        if (!(is_chain<Epi>::v && cur.aux != 3)) {
#pragma unroll
        for (int a = 0; a < 2; ++a)
#pragma unroll
            for (int b = 0; b < 2; ++b)
#pragma unroll
                for (int m = 0; m < 4; ++m)
#pragma unroll
                    for (int n = 0; n < 2; ++n) acc[a][b][m][n] = (f32x4){0.f, 0.f, 0.f, 0.f};
        }
        cur = nxt; cA = nA; cB = nB; ++ui;
        if (wr == 1) FG_BAR;
    }
    FG_WAIT_V(0);
    FG_BAR;
#undef FG_SA
#undef FG_SB
#undef FG_STAGE
#undef FG_LDA
#undef FG_LDB
#undef FG_MMA
#undef FG_WAIT_V
#undef FG_WAIT_L
#undef FG_BAR
#undef FG_SCHED
}
__device__ __forceinline__ unsigned cvt_pk(float lo, float hi) { unsigned r; asm volatile("v_cvt_pk_bf16_f32 %0, %1, %2" : "=v"(r) : "v"(lo), "v"(hi)); return r; }
__device__ __forceinline__ u32x4 pack8(const f32x4 a, const f32x4 b) { u32x4 w; w.x = cvt_pk(a[0], a[1]); w.y = cvt_pk(a[2], a[3]); w.z = cvt_pk(b[0], b[1]); w.w = cvt_pk(b[2], b[3]); return w; }
__device__ __forceinline__ f32x4 unpk_u8(unsigned x) { const float k = 1.f / 255.f; return (f32x4){(float)(x & 0xffu) * k, (float)((x >> 8) & 0xffu) * k, (float)((x >> 16) & 0xffu) * k, (float)(x >> 24) * k}; }
__device__ __forceinline__ f32x4 unpk_u8r(unsigned x) { return (f32x4){(float)(x & 0xffu), (float)((x >> 8) & 0xffu), (float)((x >> 16) & 0xffu), (float)(x >> 24)}; }
__device__ __forceinline__ f32x4 unpk_lo(unsigned x, unsigned y) { return (f32x4){__uint_as_float(x << 16), __uint_as_float(x & 0xffff0000u), __uint_as_float(y << 16), __uint_as_float(y & 0xffff0000u)}; }

struct EpiWin {
    static constexpr bool PERM = true;
    unsigned char* ws; const float* qg; const float* kg;
    __device__ __forceinline__ void operator()(const Acc& acc, const Unit& u, int wr, int wc, int fr_, int fq_) const {
        int fr = fr_, fq = fq_; asm volatile("" : "+v"(fr), "+v"(fq));
        const int tile = u.pn; const bool LAT = u.aux == 0;
        if (tile == 0) {
            if (LAT) {
                const int b = u.pm >> 5, n2 = 2 * (u.pm & 31) + wr;
#pragma unroll
                for (int ai = 0; ai < 2; ++ai)
#pragma unroll
                    for (int bj = 0; bj < 2; ++bj) {
#pragma unroll
                        for (int n = 0; n < 2; ++n)
#pragma unroll
                            for (int e = 0; e < 4; ++e) { const int ch = bj * HALF + wc * 32 + 8 * fq + 4 * n + e;
                                u32x2 o; o.x = cvt_pk(acc[ai][bj][0][n][e], acc[ai][bj][1][n][e]); o.y = cvt_pk(acc[ai][bj][2][n][e], acc[ai][bj][3][n][e]);
                                *(u32x2*)((bf16*)(ws + WS_UT) + ((size_t)(b * 256 + ch) * 64 + n2) * 256 + 64 * ai + 4 * fr) = o; }
                        asm volatile("" ::: "memory"); }
            } else {
#pragma unroll
                for (int ai = 0; ai < 2; ++ai)
#pragma unroll
                    for (int m = 0; m < 4; ++m) { const int sx = ai * HALF + wr * 64 + m * 16 + fr;
#pragma unroll
                        for (int bj = 0; bj < 2; ++bj)
#pragma unroll
                            for (int n = 0; n < 2; ++n)
#pragma unroll
                                for (int e = 0; e < 4; ++e) { const int ch = bj * HALF + wc * 32 + 8 * fq + 4 * n + e;
                                    ((bf16*)(ws + WS_UTC))[(size_t)(u.pm * 256 + ch) * 256 + sx] = f2bf(acc[ai][bj][m][n][e]); }
                        asm volatile("" ::: "memory"); }
            }
            return;
        }
        const bool ropek = tile == 1 || tile == 2 || tile == 5 || tile == 6 || (tile == 7 && wc < 2);
        const bool keyrow = tile == 7;
        size_t boff; int pitch, col0;
        if (tile <= 4) { boff = WS_RETQ + (size_t)(tile - 1) * MROWS * 256 * 2; pitch = 256; col0 = ropek ? wc * 64 : wc * 32; }
        else if (tile <= 6) { boff = WS_ATTQ; pitch = 512; col0 = (tile - 5) * 256 + wc * 64; }
        else if (tile == 7) { boff = wc < 2 ? WS_ATTK : WS_ATTV; pitch = 128; col0 = (wc & 1) * 64; }
        else if (tile < 10) { boff = WS_CONV; pitch = 512; col0 = (tile - 8) * 256 + wc * 32; }
        else { boff = WS_G; pitch = 4096; col0 = (tile - 10) * 256 + wc * 32; }
        const bool head = ropek || tile == 7;
        bf16* const dbase = (bf16*)(ws + boff);
        const bool norm = tile >= 5 && ropek;
        const float* gp = tile == 7 ? kg : qg;
        const float osc = tile == 2 ? 0.125f : (tile == 5 || tile == 6 ? QSCALE : 1.f);
        const float* rc = (const float*)(ws + WS_ROPE);
#pragma unroll
        for (int ai = 0; ai < 2; ++ai) {
            f32x4 rcs[4][2], rsn[4][2];
            if (ropek && LAT) {
#pragma unroll
                for (int m = 0; m < 4; ++m)
#pragma unroll
                    for (int bj = 0; bj < 2; ++bj) { const int sx = 4096 * ai + 256 * fr + 64 * m + 2 * (u.pm & 31) + wr, i0 = 16 * bj + 4 * fq;
                        rcs[m][bj] = *(const f32x4*)(rc + sx * 32 + i0); rsn[m][bj] = *(const f32x4*)(rc + SEQ * 32 + sx * 32 + i0); } }
#pragma unroll
            for (int m = 0; m < 4; ++m) {
                const int b = LAT ? (u.pm >> 5) : u.pm, s = LAT ? (4096 * ai + 256 * fr + 64 * m + 2 * (u.pm & 31) + wr) : (ai * HALF + wr * 64 + m * 16 + fr);
                const int rr = keyrow ? b * KEYS + (LAT ? CTX + s : s) : (LAT ? b * SEQ + s : NLAT + b * CTX + s);
                bf16* const drow = dbase + ((size_t)rr * pitch + col0 + 8 * fq);
                if (ropek) {
                    float rstd = 1.f;
                    if (norm) { float ss = 0.f;
#pragma unroll
                        for (int bj = 0; bj < 2; ++bj)
#pragma unroll
                            for (int n = 0; n < 2; ++n) { const f32x4 x = acc[ai][bj][m][n]; ss += (x[0] * x[0] + x[1] * x[1]) + (x[2] * x[2] + x[3] * x[3]); }
                        ss += __shfl_xor(ss, 16); ss += __shfl_xor(ss, 32);
                        rstd = rsqrtf(ss * (1.f / 64.f) + EPS); }
#pragma unroll
                    for (int bj = 0; bj < 2; ++bj) {
                        const int i0 = 16 * bj + 4 * fq;
                        f32x4 x1 = acc[ai][bj][m][0], x2 = acc[ai][bj][m][1];
                        if (norm) { const f32x4 g1 = *(const f32x4*)(gp + i0), g2 = *(const f32x4*)(gp + 32 + i0); x1 = x1 * rstd * g1; x2 = x2 * rstd * g2; }
                        f32x4 o1 = x1, o2 = x2;
                        if (LAT) { const f32x4 cs = rcs[m][bj], sn = rsn[m][bj]; o1 = x1 * cs - x2 * sn; o2 = x1 * sn + x2 * cs; }
                        *(u32x4*)(drow + 32 * bj) = pack8(o1 * osc, o2 * osc);
                    }
                } else {
#pragma unroll
                    for (int bj = 0; bj < 2; ++bj) {
                        f32x4 a0 = acc[ai][bj][m][0], a1 = acc[ai][bj][m][1];
                        if (tile >= 10) {
                            u32x2 o; o.x = 0u; o.y = 0u;
#pragma unroll
                            for (int e = 0; e < 4; ++e) { o.x = __builtin_amdgcn_cvt_pk_u8_f32(__builtin_fmaxf(__builtin_floorf(sigmoid_fast(a0[e]) * 255.f + 0.5f), 1.f), e, o.x);
                                o.y = __builtin_amdgcn_cvt_pk_u8_f32(__builtin_fmaxf(__builtin_floorf(sigmoid_fast(a1[e]) * 255.f + 0.5f), 1.f), e, o.y); }
                            *(u32x2*)(ws + WS_G + (size_t)rr * 4096 + (tile - 10) * 256 + wc * 32 + 8 * fq + HALF * bj) = o;
                        } else *(u32x4*)(drow + (head ? 32 : HALF) * bj) = pack8(a0, a1);
                    }
                }
            }
        }
    }
};
struct EpiGate8 {
    static constexpr bool PERM = true;
    unsigned char* G;
    __device__ __forceinline__ void operator()(const Acc& acc, const Unit& u, int wr, int wc, int fr_, int fq_) const {
        int fr = fr_, fq = fq_; asm volatile("" : "+v"(fr), "+v"(fq));
#pragma unroll
        for (int ai = 0; ai < 2; ++ai)
#pragma unroll
            for (int m = 0; m < 4; ++m) { const int r = u.pm * BM + ai * HALF + wr * 64 + m * 16 + fr;
#pragma unroll
                for (int bj = 0; bj < 2; ++bj) { const f32x4 a0 = acc[ai][bj][m][0], a1 = acc[ai][bj][m][1]; u32x2 o; o.x = 0u; o.y = 0u;
#pragma unroll
                    for (int e = 0; e < 4; ++e) { o.x = __builtin_amdgcn_cvt_pk_u8_f32(__builtin_fmaxf(__builtin_floorf(sigmoid_fast(a0[e]) * 255.f + 0.5f), 1.f), e, o.x);
                        o.y = __builtin_amdgcn_cvt_pk_u8_f32(__builtin_fmaxf(__builtin_floorf(sigmoid_fast(a1[e]) * 255.f + 0.5f), 1.f), e, o.y); }
                    *(u32x2*)(G + (size_t)r * 4096 + u.pn * BM + bj * HALF + wc * 32 + 8 * fq) = o; } }
    }
};
struct EpiMerge {
    static constexpr bool PERM = true, CHAIN = true;
    const unsigned char* G; bf16* Mg;
    __device__ __forceinline__ void operator()(Acc& acc, const Unit& u, int wr, int wc, int fr_, int fq_) const {
        int fr = fr_, fq = fq_; asm volatile("" : "+v"(fr), "+v"(fq));
        const int br = u.aux; const bool lastb = br == 3;
#pragma unroll
        for (int ai = 0; ai < 2; ++ai) {
            u32x2 g[4][2], gn[4][2];
#pragma unroll
            for (int m = 0; m < 4; ++m)
#pragma unroll
                for (int bj = 0; bj < 2; ++bj) { const int r = u.pm * BM + ai * HALF + wr * 64 + m * 16 + fr, c = u.pn * BM + bj * HALF + wc * 32 + 8 * fq;
                    g[m][bj] = *(const u32x2*)(G + (size_t)r * 4096 + br * 1024 + c);
                    if (!lastb) gn[m][bj] = *(const u32x2*)(G + (size_t)r * 4096 + (br + 1) * 1024 + c); }
#pragma unroll
            for (int m = 0; m < 4; ++m)
#pragma unroll
                for (int bj = 0; bj < 2; ++bj) {
                    if (!lastb) {
                        const f32x4 n0 = unpk_u8r(g[m][bj].x), n1 = unpk_u8r(g[m][bj].y), d0 = unpk_u8r(gn[m][bj].x), d1 = unpk_u8r(gn[m][bj].y);
#pragma unroll
                        for (int e = 0; e < 4; ++e) { acc[ai][bj][m][0][e] *= n0[e] * __builtin_amdgcn_rcpf(d0[e]); acc[ai][bj][m][1][e] *= n1[e] * __builtin_amdgcn_rcpf(d1[e]); }
                    } else { const int r = u.pm * BM + ai * HALF + wr * 64 + m * 16 + fr, c = u.pn * BM + bj * HALF + wc * 32 + 8 * fq;
                        *(u32x4*)(Mg + (size_t)r * 1024 + c) = pack8(acc[ai][bj][m][0] * unpk_u8(g[m][bj].x), acc[ai][bj][m][1] * unpk_u8(g[m][bj].y)); } }
        }
    }
};
struct EpiResid {
    static constexpr bool PERM = false;
    float* out; float* hctx; const float* modbase; int chunk;
    __device__ __forceinline__ void operator()(const Acc& acc, const Unit& u, int wr, int wc, int fr_, int fq_) const {
        int fr = fr_, fq = fq_; asm volatile("" : "+v"(fr), "+v"(fq));
        const int rt = u.pm * BM;
        const float* g = modbase + ((size_t)row_mi(rt) * 6 + chunk) * D;
        f32x4 gg[2][2];
#pragma unroll
        for (int bj = 0; bj < 2; ++bj)
#pragma unroll
            for (int n = 0; n < 2; ++n) gg[bj][n] = *(const f32x4*)(g + u.pn * BM + bj * HALF + wc * 32 + 16 * n + 4 * fq);
#pragma unroll
        for (int ai = 0; ai < 2; ++ai) {
            f32x4 hv[4][2][2];
#pragma unroll
            for (int m = 0; m < 4; ++m) { const int r = rt + ai * HALF + wr * 64 + m * 16 + fr; const float* h = r < NLAT ? out + (size_t)r * D : hctx + (size_t)(r - NLAT) * D;
#pragma unroll
                for (int bj = 0; bj < 2; ++bj)
#pragma unroll
                    for (int n = 0; n < 2; ++n) hv[m][bj][n] = *(const f32x4*)(h + u.pn * BM + bj * HALF + wc * 32 + 16 * n + 4 * fq); }
#pragma unroll
            for (int m = 0; m < 4; ++m) { const int r = rt + ai * HALF + wr * 64 + m * 16 + fr; float* h = r < NLAT ? out + (size_t)r * D : hctx + (size_t)(r - NLAT) * D;
#pragma unroll
                for (int bj = 0; bj < 2; ++bj)
#pragma unroll
                    for (int n = 0; n < 2; ++n) *(f32x4*)(h + u.pn * BM + bj * HALF + wc * 32 + 16 * n + 4 * fq) = hv[m][bj][n] + gg[bj][n] * acc[ai][bj][m][n]; }
        }
    }
};
struct EpiResidNorm {
    static constexpr bool PERM = false;
    const float* hin; float* out; const float* modbase; int chunk;
    const float* gain; const float* nmods; int csh, csc; bf16* A; unsigned char* A8;
    float* xbuf; unsigned* cnt; unsigned* tmo; LAS unsigned char* lds;
    __device__ __forceinline__ void operator()(Acc& acc, const Unit& u, int wr, int wc, int fr_, int fq_) const {
        int fr = fr_, fq = fq_; asm volatile("" : "+v"(fr), "+v"(fq));
        const int wid = __builtin_amdgcn_readfirstlane((int)threadIdx.x >> 6), lane = threadIdx.x & 63;
        const int rt = u.pm * BM, mi = row_mi(rt);
        LAS float* Pt = (LAS float*)(lds + STAGE_BYTES);
        LAS float* St = (LAS float*)(lds + STAGE_BYTES + 4096);
        LAS unsigned* flag = (LAS unsigned*)(lds + STAGE_BYTES + 5120);
        { const float* g = modbase + ((size_t)mi * 6 + chunk) * D;
          f32x4 gg[2][2];
#pragma unroll
          for (int bj = 0; bj < 2; ++bj)
#pragma unroll
              for (int n = 0; n < 2; ++n) gg[bj][n] = *(const f32x4*)(g + u.pn * BM + bj * HALF + wc * 32 + 16 * n + 4 * fq);
#pragma unroll
          for (int am = 0; am < 4; ++am) { const int ai = am >> 1, m0 = (am & 1) * 2;
              f32x4 hv[2][2][2];
#pragma unroll
              for (int mm = 0; mm < 2; ++mm) { const float* h = hin + (size_t)(rt + ai * HALF + wr * 64 + (m0 + mm) * 16 + fr) * D;
#pragma unroll
                  for (int bj = 0; bj < 2; ++bj)
#pragma unroll
                      for (int n = 0; n < 2; ++n) hv[mm][bj][n] = *(const f32x4*)(h + u.pn * BM + bj * HALF + wc * 32 + 16 * n + 4 * fq); }
#pragma unroll
              for (int mm = 0; mm < 2; ++mm) { const int m = m0 + mm; float* h = out + (size_t)(rt + ai * HALF + wr * 64 + m * 16 + fr) * D; float ss = 0.f;
#pragma unroll
                  for (int bj = 0; bj < 2; ++bj)
#pragma unroll
                      for (int n = 0; n < 2; ++n) { const f32x4 x = hv[mm][bj][n] + gg[bj][n] * acc[ai][bj][m][n]; acc[ai][bj][m][n] = x;
                          *(f32x4*)(h + u.pn * BM + bj * HALF + wc * 32 + 16 * n + 4 * fq) = x; ss += (x[0] * x[0] + x[1] * x[1]) + (x[2] * x[2] + x[3] * x[3]); }
                  ss += __shfl_xor(ss, 16); ss += __shfl_xor(ss, 32);
                  if (fq == 0) Pt[(ai * HALF + wr * 64 + m * 16 + fr) * 4 + wc] = ss; }
              asm volatile("" ::: "memory");
          } }
        asm volatile("s_waitcnt lgkmcnt(0)" ::: "memory"); __builtin_amdgcn_s_barrier(); asm volatile("" ::: "memory");
        const int row = wid * 32 + (lane & 31);
        if (lane < 32) { const f32x4 q = *(const LAS f32x4*)(Pt + row * 4);
            __hip_atomic_store(xbuf + ((size_t)(rt + row) * 4 + u.pn), (q[0] + q[1]) + (q[2] + q[3]), __ATOMIC_RELAXED, __HIP_MEMORY_SCOPE_AGENT); }
        asm volatile("s_waitcnt vmcnt(0)" ::: "memory");
        if (lane == 0) __hip_atomic_fetch_add(cnt + 16 * u.pm, 1u, __ATOMIC_RELAXED, __HIP_MEMORY_SCOPE_AGENT);
        if (wid == 0) { unsigned sp = 0u, dead = 0u;
            while ((unsigned)__builtin_amdgcn_readfirstlane(__hip_atomic_load(cnt + 16 * u.pm, __ATOMIC_RELAXED, __HIP_MEMORY_SCOPE_AGENT)) < 32u) {
                __builtin_amdgcn_s_sleep(1);
                if ((++sp & 255u) == 0u) { if (__hip_atomic_load(tmo, __ATOMIC_RELAXED, __HIP_MEMORY_SCOPE_AGENT)) { dead = 1u; break; } if (sp > (1u << 22)) { if (lane == 0) atomicAdd(tmo, 1u); dead = 1u; break; } } }
            __builtin_amdgcn_fence(__ATOMIC_ACQUIRE, "agent");
            if (lane == 0) flag[0] = dead; }
        asm volatile("s_waitcnt vmcnt(0) lgkmcnt(0)" ::: "memory"); __builtin_amdgcn_s_barrier(); asm volatile("" ::: "memory");
        if (lane < 32) { const float* sl = xbuf + (size_t)(rt + row) * 4; float t = 0.f;
#pragma unroll
            for (int q = 0; q < 4; ++q) t += __hip_atomic_load(sl + q, __ATOMIC_RELAXED, __HIP_MEMORY_SCOPE_AGENT);
            St[row] = rsqrtf(t * (1.f / D) + EPS); }
        asm volatile("s_waitcnt lgkmcnt(0)" ::: "memory"); __builtin_amdgcn_s_barrier(); asm volatile("" ::: "memory");
        const float* shp = nmods + ((size_t)mi * 6 + csh) * D; const float* scp = nmods + ((size_t)mi * 6 + csc) * D;
        float rs[2][4];
#pragma unroll
        for (int ai = 0; ai < 2; ++ai)
#pragma unroll
            for (int m = 0; m < 4; ++m) rs[ai][m] = St[ai * HALF + wr * 64 + m * 16 + fr];
#pragma unroll
        for (int bj = 0; bj < 2; ++bj)
#pragma unroll
            for (int n = 0; n < 2; ++n) { const int c = u.pn * BM + bj * HALF + wc * 32 + 16 * n + 4 * fq;
                const f32x4 g4 = *(const f32x4*)(gain + c), sc4 = *(const f32x4*)(scp + c) + 1.f, sh4 = *(const f32x4*)(shp + c);
#pragma unroll
                for (int ai = 0; ai < 2; ++ai)
#pragma unroll
                    for (int m = 0; m < 4; ++m) { const f32x4 y = acc[ai][bj][m][n] * rs[ai][m] * g4 * sc4 + sh4;
                        u32x2 o; o.x = cvt_pk(y[0], y[1]); o.y = cvt_pk(y[2], y[3]);
                        *(u32x2*)(A + (size_t)(rt + ai * HALF + wr * 64 + m * 16 + fr) * D + c) = o;
                        if (A8) *(unsigned*)(A8 + (size_t)(rt + ai * HALF + wr * 64 + m * 16 + fr) * D + c) = pk4_fp8(y[0], y[1], y[2], y[3]); } }
    }
};
struct EpiSwiglu {
    static constexpr bool PERM = true;
    bf16* Hm;
    __device__ __forceinline__ void operator()(const Acc& acc, const Unit& u, int wr, int wc, int fr, int fq) const {
#pragma unroll
        for (int ai = 0; ai < 2; ++ai)
#pragma unroll
            for (int m = 0; m < 4; ++m) { const int r = u.pm * BM + ai * HALF + wr * 64 + m * 16 + fr;
#pragma unroll
                for (int bj = 0; bj < 2; ++bj) { const int c = u.pn * BM + bj * HALF + wc * 32 + 8 * fq; const f32x4 g = acc[ai][bj][m][0], up = acc[ai][bj][m][1];
                    u32x2 o; o.x = cvt_pk(silu_fast(g[0]) * up[0], silu_fast(g[1]) * up[1]); o.y = cvt_pk(silu_fast(g[2]) * up[2], silu_fast(g[3]) * up[3]);
                    *(u32x2*)(Hm + (size_t)r * FFN + (c >> 1)) = o; } }
    }
};
struct EpiSwiglu8 {
    static constexpr bool PERM = true;
    unsigned char* Hm;
    __device__ __forceinline__ void operator()(const Acc& acc, const Unit& u, int wr, int wc, int fr_, int fq_) const {
        int fr = fr_, fq = fq_; asm volatile("" : "+v"(fr), "+v"(fq));
#pragma unroll
        for (int ai = 0; ai < 2; ++ai)
#pragma unroll
            for (int m = 0; m < 4; ++m) { const int r = u.pm * BM + ai * HALF + wr * 64 + m * 16 + fr;
#pragma unroll
                for (int bj = 0; bj < 2; ++bj) { const int c = u.pn * BM + bj * HALF + wc * 32 + 8 * fq; const f32x4 g = acc[ai][bj][m][0], up = acc[ai][bj][m][1];
                    *(unsigned*)(Hm + (size_t)r * FFN + (c >> 1)) = pk4_fp8(silu_fast(g[0]) * up[0], silu_fast(g[1]) * up[1], silu_fast(g[2]) * up[2], silu_fast(g[3]) * up[3]); } }
    }
};
struct EpiStore {
    static constexpr bool PERM = true;
    bf16* O; int ldc;
    __device__ __forceinline__ void operator()(const Acc& acc, const Unit& u, int wr, int wc, int fr_, int fq_) const {
        int fr = fr_, fq = fq_; asm volatile("" : "+v"(fr), "+v"(fq));
#pragma unroll
        for (int ai = 0; ai < 2; ++ai)
#pragma unroll
            for (int m = 0; m < 4; ++m) { const int r = u.pm * BM + ai * HALF + wr * 64 + m * 16 + fr;
#pragma unroll
                for (int bj = 0; bj < 2; ++bj) { const int c = u.pn * BM + bj * HALF + wc * 32 + 8 * fq; *(u32x4*)(O + (size_t)r * ldc + c) = pack8(acc[ai][bj][m][0], acc[ai][bj][m][1]); } }
    }
};
struct EpiFft1 {
    static constexpr bool PERM = true;
    unsigned char* ws;
    __device__ __forceinline__ void operator()(const Acc& acc, const Unit& u, int wr, int wc, int fr, int fq) const {
        const float* TW = (const float*)(ws + WS_TW); bf16* Z = (bf16*)(ws + WS_Z);
#pragma unroll
        for (int ai = 0; ai < 2; ++ai)
#pragma unroll
            for (int mm = 0; mm < 2; ++mm) { const int k1 = (4 * ai + 2 * wr + mm) * 16 + fr;
#pragma unroll
                for (int bj = 0; bj < 2; ++bj) { const int c = u.pn * BM + bj * HALF + wc * 32 + 8 * fq, n2 = c & 63, ch = (c >> 6) & 255, b = c >> 14;
                    f32x4 zr[2], zi[2];
#pragma unroll
                    for (int n = 0; n < 2; ++n) { const f32x4 yr = acc[ai][bj][2 * mm][n], yi = acc[ai][bj][2 * mm + 1][n];
                        const f32x4 t0 = *(const f32x4*)(TW + (size_t)(k1 * 64 + n2 + 4 * n) * 2), t1 = *(const f32x4*)(TW + (size_t)(k1 * 64 + n2 + 4 * n) * 2 + 4);
                        const f32x4 ct = {t0[0], t0[2], t1[0], t1[2]}, st = {t0[1], t0[3], t1[1], t1[3]};
                        zr[n] = yr * ct + yi * st; zi[n] = yi * ct - yr * st; }
                    bf16* dst = Z + ((size_t)b * 32768 + k1 * 256 + ch) * 256 + n2;
                    *(u32x4*)dst = pack8(zr[0], zr[1]); *(u32x4*)(dst + 64) = pack8(zi[0], zi[1]);
                    asm volatile("" ::: "memory"); } }
    }
};
struct EpiFft3 {
    static constexpr bool PERM = true;
    unsigned char* ws;
    __device__ __forceinline__ void operator()(const Acc& acc, const Unit& u, int wr, int wc, int fr, int fq) const {
        bf16* X = (bf16*)(ws + WS_X);
#pragma unroll
        for (int m = 0; m < 4; ++m) { const int k2 = 16 * m + fr;
#pragma unroll
            for (int bj = 0; bj < 2; ++bj) { const int c = u.pn * BM + bj * HALF + wc * 32 + 8 * fq, ch = c & 255, k1 = (c >> 8) & 127, b = c >> 15;
                *(u32x4*)(X + (size_t)(b * SEQ + k1 + 128 * k2) * 1536 + wr * 256 + ch) = pack8(acc[0][bj][m][0], acc[0][bj][m][1]); } }
    }
};
struct EpiFftC {
    static constexpr bool PERM = true;
    unsigned char* ws;
    __device__ __forceinline__ void operator()(const Acc& acc, const Unit& u, int wr, int wc, int fr, int fq) const {
        bf16* X = (bf16*)(ws + WS_X);
#pragma unroll
        for (int ai = 0; ai < 2; ++ai)
#pragma unroll
            for (int m = 0; m < 4; ++m) { const int k = ai * HALF + wr * 64 + m * 16 + fr;
#pragma unroll
                for (int bj = 0; bj < 2; ++bj) { const int ch = bj * HALF + wc * 32 + 8 * fq;
                    *(u32x4*)(X + (size_t)(NLAT + u.pn * CTX + k) * 1536 + u.pm * 256 + ch) = pack8(acc[ai][bj][m][0], acc[ai][bj][m][1]); } }
    }
};
}

__device__ __forceinline__ void ph_win(const P& p, LAS unsigned char* lds, int layer) {
    const char* W = (const char*)(p.ws + WS_WIN) + (size_t)layer * INC * D * 2;
#pragma unroll 1
    for (int mode = 0; mode < 2; ++mode) {
        fg::WinSched S{(const char*)(p.ws + WS_A), W, (int)gridDim.x, (int)((blockIdx.x + mode * 128) % gridDim.x), mode, mode == 0 ? 10 : (layer == 0 ? 26 : 10)};
        fg::EpiWin E{p.ws, p.in[14] + layer * 64, p.in[15] + layer * 64};
        fg::gemm_phase(lds, D, D, S, E);
    }
    {
        fg::PlainSched S{(const char*)(p.ws + WS_A8), (const char*)(p.ws + WS_WIN8) + (size_t)layer * 4096 * 1024, D / 2, D / 2, NLAT / 256, 16, (int)gridDim.x, (int)blockIdx.x, D / 128};
        fg::EpiGate8 E{p.ws + WS_G};
        fg::gemm_phase<fg::EpiGate8, fg::PlainSched, true>(lds, D / 2, D / 2, S, E);
    }
}

__device__ __forceinline__ void conv_item(const P& p, LAS unsigned char* lds, int layer, int seqid, int t0) {
    const int tid = threadIdx.x; LAS float* y = (LAS float*)lds;
    const int L = seqid < 2 ? SEQ : CTX; const int rbase = seqid < 2 ? seqid * SEQ : NLAT + (seqid - 2) * CTX;
    const bf16* cv = (const bf16*)(p.ws + WS_CONV);
    __syncthreads();
    u32x4 pa[6], pg[6];
#pragma unroll
    for (int i = 0; i < 6; ++i) { const int e = tid + i * NTHREADS, tt = e >> 5, c8 = (e & 31) * 8, t = t0 - 15 + tt;
        if (e < 94 * 32 && t >= 0 && t < L) { const bf16* rowp = cv + (size_t)(rbase + t) * 512 + c8; pa[i] = *(const u32x4*)rowp; pg[i] = *(const u32x4*)(rowp + 256); } }
#pragma unroll
    for (int i = 0; i < 6; ++i) { const int e = tid + i * NTHREADS; if (e >= 94 * 32) break; const int tt = e >> 5, c8 = (e & 31) * 8, t = t0 - 15 + tt;
        f32x4 lo = {0.f, 0.f, 0.f, 0.f}, hi = lo;
        if (t >= 0 && t < L) { const u32x4 a = pa[i], g = pg[i];
            lo = (f32x4){__uint_as_float(a.x << 16) * sigmoidf_(__uint_as_float(g.x << 16)), __uint_as_float(a.x & 0xffff0000u) * sigmoidf_(__uint_as_float(g.x & 0xffff0000u)),
                         __uint_as_float(a.y << 16) * sigmoidf_(__uint_as_float(g.y << 16)), __uint_as_float(a.y & 0xffff0000u) * sigmoidf_(__uint_as_float(g.y & 0xffff0000u))};
            hi = (f32x4){__uint_as_float(a.z << 16) * sigmoidf_(__uint_as_float(g.z << 16)), __uint_as_float(a.z & 0xffff0000u) * sigmoidf_(__uint_as_float(g.z & 0xffff0000u)),
                         __uint_as_float(a.w << 16) * sigmoidf_(__uint_as_float(g.w << 16)), __uint_as_float(a.w & 0xffff0000u) * sigmoidf_(__uint_as_float(g.w & 0xffff0000u))}; }
        *(LAS f32x4*)(y + tt * 256 + c8) = lo; *(LAS f32x4*)(y + tt * 256 + c8 + 4) = hi; }
    __syncthreads();
    {
        const int ch = tid & 255, half = tid >> 8;
        float w[31];
#pragma unroll
        for (int k = 0; k < 31; ++k) w[k] = p.in[17][(size_t)layer * 31 * 256 + k * 256 + ch];
        const float bias = p.in[18][layer * 256 + ch];
        float o[4][8];
#pragma unroll
        for (int u = 0; u < 4; ++u) { const int tb = (half * 4 + u) * 8;
            float in[38];
#pragma unroll
            for (int q = 0; q < 38; ++q) in[q] = y[(tb + q) * 256 + ch];
#pragma unroll
            for (int q = 0; q < 8; ++q) { float a = bias;
#pragma unroll
                for (int k = 0; k < 31; ++k) a += in[q + k] * w[k];
                o[u][q] = a; } }
        __syncthreads();
#pragma unroll
        for (int u = 0; u < 4; ++u)
#pragma unroll
            for (int q = 0; q < 8; ++q) y[((half * 4 + u) * 8 + q) * 256 + ch] = o[u][q];
    }
    __syncthreads();
    const int wv = tid >> 6, lane = tid & 63;
    const f32x4 g = *(const f32x4*)(p.in[19] + layer * 256 + lane * 4), bb = *(const f32x4*)(p.in[20] + layer * 256 + lane * 4);
    for (int q = 0; q < 8; ++q) { const int t = wv * 8 + q;
        const f32x4 v = *(const LAS f32x4*)(y + t * 256 + lane * 4);
        const float mu = wave_sum(v.x + v.y + v.z + v.w) * (1.f / 256.f);
        const f32x4 dv = v - mu; const float var = wave_sum(dv.x * dv.x + dv.y * dv.y + dv.z * dv.z + dv.w * dv.w) * (1.f / 256.f);
        const float rstd = rsqrtf(var + EPS);
        f32x4 z = dv * rstd * g + bb;
        u32x2 ov; ov.x = pk2(siluf_(z.x), siluf_(z.y)); ov.y = pk2(siluf_(z.z), siluf_(z.w));
        *(u32x2*)((bf16*)(p.ws + WS_X) + (size_t)(rbase + t0 + t) * 1536 + 1280 + lane * 4) = ov; }
}

__device__ __forceinline__ int chunk_row0(int b, int n) { return n < 2 ? NLAT + b * CTX + n * 128 : b * SEQ + (n - 2) * 128; }
__device__ __forceinline__ float log_sigmoid(float x) { return x >= 0.f ? -log1pf(expf(-x)) : x - log1pf(expf(x)); }
namespace rt {
typedef short bf16x8 __attribute__((ext_vector_type(8)));
constexpr int PQ = 72, PJ = 136;
__device__ __forceinline__ f32x4 mma(bf16x8 a, bf16x8 b, f32x4 c) { return __builtin_amdgcn_mfma_f32_16x16x32_bf16(a, b, c, 0, 0, 0); }
__device__ __forceinline__ bf16x8 frag(const LAS bf16* base, int row, int pitch, int k0, int lane) { return *(const LAS bf16x8*)(base + (row + (lane & 15)) * pitch + k0 + 8 * (lane >> 4)); }
}
__device__ __forceinline__ void ret_kv_item(const P& p, LAS unsigned char* lds, int layer, int it) {
    using namespace rt;
    const int tid = threadIdx.x, lane = tid & 63, w = tid >> 6; const int h = it & 3, n = (it >> 2) % NCHUNK, b = (it >> 2) / NCHUNK;
    LAS bf16* KTf = (LAS bf16*)lds; LAS bf16* KTb = KTf + 64 * PJ; LAS bf16* VT = KTb + 64 * PJ;
    const int r0 = chunk_row0(b, n);
    const float lgf = log_sigmoid(p.in[10][layer * 4 + h]), lgb = log_sigmoid(p.in[11][layer * 4 + h]);
    __syncthreads();
    { const int j = tid & 127, dq = (tid >> 7) * 16;
      const bf16* K = (const bf16*)(p.ws + WS_RETK) + (size_t)(r0 + j) * 256 + h * 64 + dq; const bf16* V = (const bf16*)(p.ws + WS_RETV) + (size_t)(r0 + j) * 256 + h * 64 + dq;
      const float zf = expf((127.f - j) * lgf), zb = expf((float)j * lgb);
#pragma unroll
      for (int q8 = 0; q8 < 2; ++q8) { const u32x4 kw = *(const u32x4*)(K + q8 * 8), vw = *(const u32x4*)(V + q8 * 8);
          const unsigned kk[4] = {kw.x, kw.y, kw.z, kw.w}, vv[4] = {vw.x, vw.y, vw.z, vw.w};
#pragma unroll
          for (int q = 0; q < 4; ++q) { const int d = dq + q8 * 8 + 2 * q; const float k0 = __uint_as_float(kk[q] << 16), k1 = __uint_as_float(kk[q] & 0xffff0000u);
              KTf[d * PJ + j] = f2bf(k0 * zf); KTf[(d + 1) * PJ + j] = f2bf(k1 * zf); KTb[d * PJ + j] = f2bf(k0 * zb); KTb[(d + 1) * PJ + j] = f2bf(k1 * zb);
              VT[d * PJ + j] = (bf16)(vv[q] & 0xffffu); VT[(d + 1) * PJ + j] = (bf16)(vv[q] >> 16); } } }
    __syncthreads();
    const int fb = w >> 2, dt = w & 3; const LAS bf16* Am = fb == 0 ? KTf : KTb;
    f32x4 acc[4];
#pragma unroll
    for (int et = 0; et < 4; ++et) acc[et] = (f32x4){0.f, 0.f, 0.f, 0.f};
#pragma unroll
    for (int ks = 0; ks < 4; ++ks) { const bf16x8 af = frag(Am, dt * 16, PJ, ks * 32, lane);
#pragma unroll
        for (int et = 0; et < 4; ++et) acc[et] = mma(af, frag(VT, et * 16, PJ, ks * 32, lane), acc[et]); }
    float* S = (float*)(p.ws + WS_RETS) + ((size_t)((fb * 2 + b) * NCHUNK + n) * 4 + h) * 4096;
#pragma unroll
    for (int et = 0; et < 4; ++et)
#pragma unroll
        for (int r = 0; r < 4; ++r) S[(dt * 16 + 4 * (lane >> 4) + r) * 64 + et * 16 + (lane & 15)] = acc[et][r];
}
__device__ __forceinline__ void ret_scan_item(const P& p, int layer, int it) {
    const int e = it * NTHREADS + threadIdx.x;
    const int de = e & 4095, h = (e >> 12) & 3, b = (e >> 14) & 1, dir = e >> 15;
    const float lg = log_sigmoid(p.in[dir == 0 ? 10 : 11][layer * 4 + h]); const float g = expf(128.f * lg);
    float* S = (float*)(p.ws + WS_RETS) + (size_t)((dir * 2 + b) * NCHUNK) * 4 * 4096 + (size_t)h * 4096 + de;
    float kv[NCHUNK];
#pragma unroll
    for (int n = 0; n < NCHUNK; ++n) kv[n] = S[(size_t)n * 4 * 4096];
    float st = 0.f;
    if (dir == 0) {
#pragma unroll
        for (int n = 0; n < NCHUNK; ++n) { const float t = kv[n]; kv[n] = st; st = st * g + t; }
    } else {
#pragma unroll
        for (int i = 0; i < NCHUNK; ++i) { const int n = i < 2 ? 1 - i : NCHUNK + 1 - i; const float t = kv[n]; kv[n] = st; st = st * g + t; }
    }
    float* S2 = (float*)(p.ws + WS_RETS2) + (size_t)((dir * 2 + b) * NCHUNK) * 4 * 4096 + (size_t)h * 4096 + de;
#pragma unroll
    for (int n = 0; n < NCHUNK; ++n) S2[(size_t)n * 4 * 4096] = kv[n];
}
__device__ __forceinline__ void ret_out_item(const P& p, LAS unsigned char* lds, int layer, int it) {
    using namespace rt;
    const int tid = threadIdx.x, lane = tid & 63, w = tid >> 6; const int h = it & 3, n = (it >> 2) % NCHUNK, b = (it >> 2) / NCHUNK;
    LAS bf16* Qs = (LAS bf16*)lds; LAS bf16* Ks = Qs + 128 * PQ; LAS bf16* VT = Ks + 128 * PQ; LAS bf16* Ps = VT + 64 * PJ; LAS bf16* SfT = Ps + 128 * PJ; LAS bf16* SbT = SfT + 64 * PQ;
    LAS float* pf = (LAS float*)(SbT + 64 * PQ); LAS float* pb = pf + 132;
    const int r0 = chunk_row0(b, n);
    const float lgf = log_sigmoid(p.in[10][layer * 4 + h]), lgb = log_sigmoid(p.in[11][layer * 4 + h]);
    const float* S = (const float*)(p.ws + WS_RETS2);
    const float* sfp = S + ((size_t)((0 * 2 + b) * NCHUNK + n) * 4 + h) * 4096; const float* sbp = S + ((size_t)((1 * 2 + b) * NCHUNK + n) * 4 + h) * 4096;
    __syncthreads();
    { const int j = tid >> 2, dq = (tid & 3) * 16;
      const bf16* Q = (const bf16*)(p.ws + WS_RETQ) + (size_t)(r0 + j) * 256 + h * 64 + dq; const bf16* K = (const bf16*)(p.ws + WS_RETK) + (size_t)(r0 + j) * 256 + h * 64 + dq;
      *(LAS u32x4*)(Qs + j * PQ + dq) = *(const u32x4*)Q; *(LAS u32x4*)(Qs + j * PQ + dq + 8) = *(const u32x4*)(Q + 8);
      *(LAS u32x4*)(Ks + j * PQ + dq) = *(const u32x4*)K; *(LAS u32x4*)(Ks + j * PQ + dq + 8) = *(const u32x4*)(K + 8); }
    { const int j = tid & 127, dq = (tid >> 7) * 16;
      const bf16* V = (const bf16*)(p.ws + WS_RETV) + (size_t)(r0 + j) * 256 + h * 64 + dq;
#pragma unroll
      for (int q8 = 0; q8 < 2; ++q8) { const u32x4 vw = *(const u32x4*)(V + q8 * 8); const unsigned vv[4] = {vw.x, vw.y, vw.z, vw.w};
#pragma unroll
          for (int q = 0; q < 4; ++q) { const int d = dq + q8 * 8 + 2 * q; VT[d * PJ + j] = (bf16)(vv[q] & 0xffffu); VT[(d + 1) * PJ + j] = (bf16)(vv[q] >> 16); } } }
    { const int d = tid & 63, e0 = (tid >> 6) * 8;
#pragma unroll
      for (int q4 = 0; q4 < 2; ++q4) { const f32x4 a = *(const f32x4*)(sfp + d * 64 + e0 + q4 * 4), c = *(const f32x4*)(sbp + d * 64 + e0 + q4 * 4);
#pragma unroll
          for (int q = 0; q < 4; ++q) { SfT[(e0 + q4 * 4 + q) * PQ + d] = f2bf(a[q]); SbT[(e0 + q4 * 4 + q) * PQ + d] = f2bf(c[q]); } } }
    if (tid <= 128) { pf[tid] = expf((float)tid * lgf); pb[tid] = expf((float)tid * lgb); }
    __syncthreads();
    { const bf16x8 a0 = frag(Qs, 16 * w, PQ, 0, lane), a1 = frag(Qs, 16 * w, PQ, 32, lane);
#pragma unroll
      for (int jt = 0; jt < 8; ++jt) { f32x4 c = (f32x4){0.f, 0.f, 0.f, 0.f};
          c = mma(a0, frag(Ks, jt * 16, PQ, 0, lane), c); c = mma(a1, frag(Ks, jt * 16, PQ, 32, lane), c);
          const int j = jt * 16 + (lane & 15);
#pragma unroll
          for (int r = 0; r < 4; ++r) { const int i = 16 * w + 4 * (lane >> 4) + r; const float dm = i > j ? pf[i - j] : (i < j ? pb[j - i] : 2.f); Ps[i * PJ + j] = f2bf(c[r] * dm); } } }
    __syncthreads();
    f32x4 aP[4], aF[4], aB[4];
#pragma unroll
    for (int et = 0; et < 4; ++et) { aP[et] = (f32x4){0.f, 0.f, 0.f, 0.f}; aF[et] = aP[et]; aB[et] = aP[et]; }
#pragma unroll
    for (int ks = 0; ks < 4; ++ks) { const bf16x8 af = frag(Ps, 16 * w, PJ, ks * 32, lane);
#pragma unroll
        for (int et = 0; et < 4; ++et) aP[et] = mma(af, frag(VT, et * 16, PJ, ks * 32, lane), aP[et]); }
#pragma unroll
    for (int ks = 0; ks < 2; ++ks) { const bf16x8 af = frag(Qs, 16 * w, PQ, ks * 32, lane);
#pragma unroll
        for (int et = 0; et < 4; ++et) { aF[et] = mma(af, frag(SfT, et * 16, PQ, ks * 32, lane), aF[et]); aB[et] = mma(af, frag(SbT, et * 16, PQ, ks * 32, lane), aB[et]); } }
    const float* rg = p.in[12] + layer * 256 + h * 64;
    const bf16* G = (const bf16*)(p.ws + WS_RETG) + (size_t)r0 * 256 + h * 64; bf16* X = (bf16*)(p.ws + WS_X) + (size_t)r0 * 1536 + 512 + h * 64;
    float gt[4][4];
#pragma unroll
    for (int r = 0; r < 4; ++r)
#pragma unroll
        for (int et = 0; et < 4; ++et) gt[r][et] = bf2f(G[(size_t)(16 * w + 4 * (lane >> 4) + r) * 256 + et * 16 + (lane & 15)]);
#pragma unroll
    for (int r = 0; r < 4; ++r) { const int i = 16 * w + 4 * (lane >> 4) + r; const float xf = pf[i + 1], xb = pb[128 - i];
        float o[4]; float ss = 0.f;
#pragma unroll
        for (int et = 0; et < 4; ++et) { o[et] = aP[et][r] + xf * aF[et][r] + xb * aB[et][r]; ss += o[et] * o[et]; }
        ss += __shfl_xor(ss, 1); ss += __shfl_xor(ss, 2); ss += __shfl_xor(ss, 4); ss += __shfl_xor(ss, 8);
        const float rstd = rsqrtf(ss * (1.f / 64.f) + EPS);
#pragma unroll
        for (int et = 0; et < 4; ++et) { const int e = et * 16 + (lane & 15); Ps[i * PJ + e] = f2bf(o[et] * rstd * rg[e] * siluf_(gt[r][et])); } }
    asm volatile("s_waitcnt lgkmcnt(0)" ::: "memory");
#pragma unroll
    for (int q = 0; q < 2; ++q) { const int c = lane + 64 * q, i = 16 * w + (c >> 3), e8 = (c & 7) * 8;
        *(u32x4*)(X + (size_t)i * 1536 + e8) = *(const LAS u32x4*)(Ps + i * PJ + e8); }
    __syncthreads();
}

#include <hip/hip_bf16.h>
#include <cmath>
namespace attn_body {
using bf16=__hip_bfloat16;
using bf16x8=__attribute__((ext_vector_type(8)))short;
using s16x4=__attribute__((ext_vector_type(4)))short;
using f32x16=__attribute__((ext_vector_type(16)))float;
using u32x4=__attribute__((ext_vector_type(4)))unsigned;
constexpr int D=64, QP=512, KP=128, OP=1536;
constexpr int NW=8,QBLK=32,QB=QBLK*NW,KVBLK=64;
__device__ __forceinline__ int crow(int r,int hi){return (r&3)+8*(r>>2)+4*hi;}
#define SBAR() __builtin_amdgcn_sched_barrier(0)
__device__ __forceinline__ void cmask(f32x16&p0,f32x16&p1,int jb,int qrel,int hi){
  const float NEG=-INFINITY; int kb=64*jb+4*hi;
  #pragma unroll
  for(int r=0;r<16;++r){int kv=kb+(r&3)+8*(r>>2); if(kv>qrel)p0[r]=NEG; if(kv+32>qrel)p1[r]=NEG;}
}

constexpr int NSLOT=3, SLOTB=8192;
constexpr int LDS_K=0, LDS_V=NSLOT*SLOTB, LDS_WS=2*NSLOT*SLOTB, LDS_OST=LDS_WS+NW*64*4, LDS_BYTES=LDS_OST+NW*4096;
constexpr float C2=0.125f*1.4426950408889634f;
__device__ __forceinline__ void glds16(const void*gsrc,unsigned lds_dst){unsigned keep;
  asm volatile("s_mov_b32 %0, m0\n\ts_mov_b32 m0, %2\n\ts_nop 0\n\tglobal_load_lds_dwordx4 %1, off\n\ts_mov_b32 m0, %0":"=&s"(keep):"v"(gsrc),"s"(lds_dst):"memory");}
__device__ __forceinline__ float max3f(float a,float b,float c){float r;asm("v_max3_f32 %0, %1, %2, %3":"=v"(r):"v"(a),"v"(b),"v"(c));return r;}
__device__ __forceinline__ float max2f(float a,float b){float r;asm("v_max_f32_e32 %0, %1, %2":"=v"(r):"v"(a),"v"(b));return r;}
__device__ __forceinline__ float fadd_s(float a,float b){float r;asm("v_add_f32_e32 %0, %1, %2":"=v"(r):"v"(a),"v"(b));return r;}
__device__ __forceinline__ float fsub_s(float a,float b){float r;asm("v_sub_f32_e32 %0, %1, %2":"=v"(r):"v"(a),"v"(b));return r;}
typedef float f32x2_t __attribute__((ext_vector_type(2))); typedef __bf16 bf16x2_t __attribute__((ext_vector_type(2)));
__device__ __forceinline__ unsigned cvtpk_s(float lo,float hi){f32x2_t v={lo,hi};bf16x2_t b=__builtin_convertvector(v,bf16x2_t);return __builtin_bit_cast(unsigned,b);}
#define WAIT_BAR(N) asm volatile("s_waitcnt vmcnt(" #N ") lgkmcnt(0)\n\ts_barrier":::"memory")

__device__ __forceinline__ void qkt(f32x16&p0,f32x16&p1,const char*Kslot,const bf16x8*qr,const f32x16&negm,int r32,int hi){
  const char*kb=Kslot+hi*1024+r32*16;
  #pragma unroll
  for(int d0=0;d0<4;++d0){
    const bf16x8 b0=*reinterpret_cast<const bf16x8*>(kb+d0*2048);
    const bf16x8 b1=*reinterpret_cast<const bf16x8*>(kb+d0*2048+512);
    if(d0==0){p0=__builtin_amdgcn_mfma_f32_32x32x16_bf16(b0,qr[0],negm,0,0,0);p1=__builtin_amdgcn_mfma_f32_32x32x16_bf16(b1,qr[0],negm,0,0,0);}
    else{p0=__builtin_amdgcn_mfma_f32_32x32x16_bf16(b0,qr[d0],p0,0,0,0);p1=__builtin_amdgcn_mfma_f32_32x32x16_bf16(b1,qr[d0],p1,0,0,0);}}
}
typedef __attribute__((address_space(3))) const char* lds_cptr;
typedef short v4i16_t __attribute__((ext_vector_type(4)));
__device__ __forceinline__ void kload8(bf16x8*kf,lds_cptr kp){
  kf[0]=*(const __attribute__((address_space(3))) bf16x8*)(kp);      kf[1]=*(const __attribute__((address_space(3))) bf16x8*)(kp+512);
  kf[2]=*(const __attribute__((address_space(3))) bf16x8*)(kp+2048); kf[3]=*(const __attribute__((address_space(3))) bf16x8*)(kp+2560);
  kf[4]=*(const __attribute__((address_space(3))) bf16x8*)(kp+4096); kf[5]=*(const __attribute__((address_space(3))) bf16x8*)(kp+4608);
  kf[6]=*(const __attribute__((address_space(3))) bf16x8*)(kp+6144); kf[7]=*(const __attribute__((address_space(3))) bf16x8*)(kp+6656);
}
__device__ __forceinline__ void kload2(bf16x8*kf,lds_cptr kp,int j){ kf[2*j]=*(const __attribute__((address_space(3))) bf16x8*)(kp+j*2048); kf[2*j+1]=*(const __attribute__((address_space(3))) bf16x8*)(kp+j*2048+512); }
__device__ __forceinline__ s16x4 vtr(lds_cptr p){ return __builtin_bit_cast(s16x4,__builtin_amdgcn_ds_read_tr16_b64_v4i16((__attribute__((address_space(3))) v4i16_t*)p)); }
__device__ __forceinline__ float rowmax(const f32x16&p0,const f32x16&p1){
  float a=max3f(p0[0],p0[1],p1[0]),b=max3f(p0[2],p0[3],p1[1]);a=max3f(a,p1[2],p1[3]);
  #pragma unroll
  for(int r=4;r<16;r+=4){a=max3f(a,p0[r],p0[r+1]);b=max3f(b,p0[r+2],p0[r+3]);a=max3f(a,p1[r],p1[r+1]);b=max3f(b,p1[r+2],p1[r+3]);}
  const float m=max2f(a,b);
  auto rr=__builtin_amdgcn_permlane32_swap(__float_as_uint(m),__float_as_uint(m),false,false);
  return max2f(__uint_as_float(rr[0]),__uint_as_float(rr[1]));
}
__device__ __forceinline__ void pv(f32x16*o,int vb,bf16x8 pa0,bf16x8 pa1,bf16x8 pa2,bf16x8 pa3){
  #pragma unroll
  for(int d0=0;d0<2;++d0){s16x4 lo[4],hi[4];
    #pragma unroll
    for(int ks=0;ks<4;++ks){
      asm volatile("ds_read_b64_tr_b16 %0,%1 offset:%c2":"=&v"(lo[ks]):"v"(vb),"i"(d0*4096+ks*1024):"memory");
      asm volatile("ds_read_b64_tr_b16 %0,%1 offset:%c2":"=&v"(hi[ks]):"v"(vb),"i"(d0*4096+ks*1024+512):"memory");}
    asm volatile("s_waitcnt lgkmcnt(0)":::"memory");SBAR();
    #define PK(k) (bf16x8){lo[k][0],lo[k][1],lo[k][2],lo[k][3],hi[k][0],hi[k][1],hi[k][2],hi[k][3]}
    o[d0]=__builtin_amdgcn_mfma_f32_32x32x16_bf16(pa0,PK(0),o[d0],0,0,0);
    o[d0]=__builtin_amdgcn_mfma_f32_32x32x16_bf16(pa1,PK(1),o[d0],0,0,0);
    o[d0]=__builtin_amdgcn_mfma_f32_32x32x16_bf16(pa2,PK(2),o[d0],0,0,0);
    o[d0]=__builtin_amdgcn_mfma_f32_32x32x16_bf16(pa3,PK(3),o[d0],0,0,0);
    #undef PK
  }
}

#ifndef ATTN_STORE16
#define ATTN_STORE16(p,v) (*(u32x4*)(p)=(v))
#endif
template<int THRL> __device__ __forceinline__ void attn_unit(const bf16*Q0,const bf16*__restrict__ Kh,const bf16*__restrict__ Vh,bf16*O0,const int NT,char*shm){
  const int tid=threadIdx.x,lane=tid&63,r32=lane&31,hi=lane>>5; const int wid=__builtin_amdgcn_readfirstlane(tid>>6);
  const bf16*Qw=Q0+(long)(wid*QBLK)*QP;
  const unsigned lds0=(unsigned)(uintptr_t)shm;
  float*wsf=(float*)(shm+LDS_WS)+wid*64;
  const bf16*ksrc=Kh+(long)lane*KP+wid*8;
  const bf16*vsrc=Vh+(long)(16*(wid&3)+(lane>>2))*KP+(wid>>2)*32+(lane&3)*8;
  const unsigned kdst=lds0+LDS_K+wid*1024, vdst=lds0+LDS_V+wid*1024;
  #define DMA_K(t,slot) glds16(ksrc+(long)(t)*KVBLK*KP,(unsigned)__builtin_amdgcn_readfirstlane(kdst+(slot)))
  #define DMA_V(t,slot) glds16(vsrc+(long)(t)*KVBLK*KP,(unsigned)__builtin_amdgcn_readfirstlane(vdst+(slot)))
  const int vb0=(int)(lds0+LDS_V)+((lane>>4)&1)*32+(lane&3)*8+(4*hi+((lane&15)>>2))*64;
  const char*Kbase=shm+LDS_K; bf16x8 kf[8];
  const lds_cptr shm3=(lds_cptr)shm; const lds_cptr kp0=shm3+LDS_K+hi*1024+r32*16; const lds_cptr vp0=shm3+LDS_V+((lane>>4)&1)*32+(lane&3)*8+(4*hi+((lane&15)>>2))*64;
  DMA_K(0,0);DMA_V(0,0);DMA_K(1,SLOTB);
  bf16x8 qr[4];
  #pragma unroll
  for(int d0=0;d0<4;++d0)qr[d0]=*reinterpret_cast<const bf16x8*>(&Qw[(long)r32*QP+d0*16+hi*8]);
  float mhat=0.f,l_reg=0.f;f32x16 o[2];o[0]=f32x16{};o[1]=f32x16{};f32x16 negm=f32x16{};asm volatile("":"+v"(negm));
  #define CMASK(P0,P1,t) do{}while(0)
  bool resc=false;
  #define START(P0,P1) do{ const float rm=rowmax(P0,P1); resc=false; \
    { const float dl=rm; mhat=fadd_s(mhat,dl); \
      _Pragma("unroll") for(int r=0;r<16;++r){P0[r]=fsub_s(P0[r],dl);P1[r]=fsub_s(P1[r],dl);} \
      _Pragma("unroll") for(int r=0;r<16;++r)negm[r]=-mhat; asm volatile("":"+v"(negm)); } \
    _Pragma("unroll") for(int r=0;r<16;++r)P0[r]=__builtin_amdgcn_exp2f(P0[r]); }while(0)
  #define RESC() do{ if(resc){ asm volatile("s_waitcnt lgkmcnt(0)":::"memory"); \
      _Pragma("unroll") for(int d_=0;d_<2;++d_) _Pragma("unroll") for(int r=0;r<16;++r)o[d_][r]*=wsf[crow(r,hi)]; } }while(0)
  f32x16 pA0,pA1,pB0,pB1;
  int sl_prev=0,sl_cur=0,sl_next=SLOTB;
  #define ROT() do{sl_prev=sl_cur;sl_cur=sl_next;sl_next=(sl_next==(NSLOT-1)*SLOTB)?0:sl_next+SLOTB;}while(0)
  DMA_K(2,2*SLOTB);
  WAIT_BAR(3);
  qkt(pA0,pA1,Kbase,qr,negm,r32,hi);asm volatile("s_nop 15\n\ts_nop 7":"+v"(pA0),"+v"(pA1));CMASK(pA0,pA1,0);
  START(pA0,pA1);
  _Pragma("unroll") for(int r=0;r<16;++r)pA1[r]=__builtin_amdgcn_exp2f(pA1[r]);
  WAIT_BAR(0);
  DMA_K(3,0);DMA_V(1,SLOTB);
  ROT();
  kload8(kf,kp0+sl_cur);
  WAIT_BAR(2);
  s16x4 vlo[8],vhi[8]; u32x4 pw0,pw1,pw2,pw3;
  #define PKW(P,B) cvtpk_s(P[B],P[B+1])
  #define PAF(k) __builtin_bit_cast(bf16x8,pw##k)
  #define VFR(i) (bf16x8){vlo[i][0],vlo[i][1],vlo[i][2],vlo[i][3],vhi[i][0],vhi[i][1],vhi[i][2],vhi[i][3]}
  #define PIN(x) asm volatile("":"+v"(x))
  #define MX3(a,b,c) __builtin_fmaxf(__builtin_fmaxf((a),(b)),(c))
  #define GAPA(MF,A0,A1,A2,A3,W0,W1,PW) do{ MF; sacc+=A0; sacc+=A1; sacc+=A2; sacc+=A3; PIN(sacc); W0; W1; PIN(PW); SBAR(); }while(0)
  #define EX(v) __builtin_amdgcn_exp2f(v)
  #define GAPB(MF,X,B) do{ MF; X[B]=EX(X[B]); X[B+1]=EX(X[B+1]); X[B+2]=EX(X[B+2]); X[B+3]=EX(X[B+3]); PIN(X); SBAR(); }while(0)
  #define VRD(i) do{ vlo[i]=vtr(vp_+(((i)>>2)*4096+((i)&3)*1024)); vhi[i]=vtr(vp_+(((i)>>2)*4096+((i)&3)*1024+512)); }while(0)
  #define KRD(G,j) do{ if(G){ kload2(kf,kp0+sl_next,j); SBAR(); } }while(0)
  #define STEP(C0,C1,P0,P1,t,GK,GV,GL) do{ SBAR(); \
    const lds_cptr vp_=vp0+sl_prev; \
    VRD(0); SBAR(); float sacc=(P0[0]+P0[1]); \
    GAPA(C0=__builtin_amdgcn_mfma_f32_32x32x16_bf16(kf[0],qr[0],negm,0,0,0), P0[2],P0[3],P0[4],P0[5],     pw0[0]=PKW(P0,0), pw0[1]=PKW(P0,2), pw0); \
    VRD(4); SBAR(); GAPA(C1=__builtin_amdgcn_mfma_f32_32x32x16_bf16(kf[1],qr[0],negm,0,0,0), P0[6],P0[7],P0[8],P0[9],     pw0[2]=PKW(P0,4), pw0[3]=PKW(P0,6), pw0); \
    VRD(1); SBAR(); GAPA(C0=__builtin_amdgcn_mfma_f32_32x32x16_bf16(kf[2],qr[1],C0,0,0,0),   P0[10],P0[11],P0[12],P0[13], pw1[0]=PKW(P0,8), pw1[1]=PKW(P0,10), pw1); \
    VRD(5); SBAR(); GAPA(C1=__builtin_amdgcn_mfma_f32_32x32x16_bf16(kf[3],qr[1],C1,0,0,0),   P0[14],P0[15],P1[0],P1[1],   pw1[2]=PKW(P0,12),pw1[3]=PKW(P0,14), pw1); \
    VRD(2); SBAR(); GAPA(C0=__builtin_amdgcn_mfma_f32_32x32x16_bf16(kf[4],qr[2],C0,0,0,0),   P1[2],P1[3],P1[4],P1[5],     pw2[0]=PKW(P1,0), pw2[1]=PKW(P1,2), pw2); \
    VRD(6); SBAR(); GAPA(C1=__builtin_amdgcn_mfma_f32_32x32x16_bf16(kf[5],qr[2],C1,0,0,0),   P1[6],P1[7],P1[8],P1[9],     pw2[2]=PKW(P1,4), pw2[3]=PKW(P1,6), pw2); \
    VRD(3); SBAR(); GAPA(C0=__builtin_amdgcn_mfma_f32_32x32x16_bf16(kf[6],qr[3],C0,0,0,0),   P1[10],P1[11],P1[12],P1[13], pw3[0]=PKW(P1,8), pw3[1]=PKW(P1,10), pw3); \
    VRD(7); SBAR(); GAPA(C1=__builtin_amdgcn_mfma_f32_32x32x16_bf16(kf[7],qr[3],C1,0,0,0),   P1[14],P1[15],0.f,0.f,       pw3[2]=PKW(P1,12),pw3[3]=PKW(P1,14), pw3); \
    l_reg+=sacc; \
    if(GK){DMA_K((t)+3,sl_cur);} if(GV){DMA_V((t)+1,sl_next);} \
    CMASK(C0,C1,t); \
    { float a=MX3(C0[0],C0[1],C1[0]),b=MX3(C0[2],C0[3],C1[1]); a=MX3(a,C1[2],C1[3]); \
      _Pragma("unroll") for(int r=4;r<16;r+=4){a=MX3(a,C0[r],C0[r+1]);b=MX3(b,C0[r+2],C0[r+3]);a=MX3(a,C1[r],C1[r+1]);b=MX3(b,C1[r+2],C1[r+3]);} \
      float rm=__builtin_fmaxf(a,b); { auto rr=__builtin_amdgcn_permlane32_swap(__float_as_uint(rm),__float_as_uint(rm),false,false); rm=__builtin_fmaxf(__uint_as_float(rr[0]),__uint_as_float(rr[1])); } \
      resc=false; \
      if(__builtin_expect(__any(rm>(float)THRL),0)){ const float dl=__builtin_fmaxf(rm,0.f); mhat+=dl; \
        _Pragma("unroll") for(int r=0;r<16;++r){C0[r]-=dl;C1[r]-=dl;} \
        _Pragma("unroll") for(int r=0;r<16;++r)negm[r]=-mhat; asm volatile("":"+v"(negm)); \
        const float f=__builtin_amdgcn_exp2f(-dl); l_reg*=f; if(hi==0)wsf[r32]=f; resc=true; } } \
    SBAR(); \
    GAPB(o[0]=__builtin_amdgcn_mfma_f32_32x32x16_bf16(PAF(0),VFR(0),o[0],0,0,0), C0,0); \
    GAPB(o[1]=__builtin_amdgcn_mfma_f32_32x32x16_bf16(PAF(0),VFR(4),o[1],0,0,0), C0,4); \
    KRD(GL,0); GAPB(o[0]=__builtin_amdgcn_mfma_f32_32x32x16_bf16(PAF(1),VFR(1),o[0],0,0,0), C0,8); \
    KRD(GL,1); GAPB(o[1]=__builtin_amdgcn_mfma_f32_32x32x16_bf16(PAF(1),VFR(5),o[1],0,0,0), C0,12); \
    KRD(GL,2); GAPB(o[0]=__builtin_amdgcn_mfma_f32_32x32x16_bf16(PAF(2),VFR(2),o[0],0,0,0), C1,0); \
    KRD(GL,3); GAPB(o[1]=__builtin_amdgcn_mfma_f32_32x32x16_bf16(PAF(2),VFR(6),o[1],0,0,0), C1,4); \
    GAPB(o[0]=__builtin_amdgcn_mfma_f32_32x32x16_bf16(PAF(3),VFR(3),o[0],0,0,0), C1,8); \
    GAPB(o[1]=__builtin_amdgcn_mfma_f32_32x32x16_bf16(PAF(3),VFR(7),o[1],0,0,0), C1,12); \
    }while(0)
  int t=1;
  #undef CMASK
  #define CMASK(P0,P1,t) do{}while(0)
  for(;t+5<NT;t+=2){
    STEP(pB0,pB1,pA0,pA1,t,true,true,true);     WAIT_BAR(2); RESC(); ROT();
    STEP(pA0,pA1,pB0,pB1,t+1,true,true,true);   WAIT_BAR(2); RESC(); ROT();
  }
  #undef CMASK
  #define CMASK(P0,P1,t) do{}while(0)
  #define ENDW(tt) do{ if((tt)+3<NT){WAIT_BAR(2);} else if((tt)+2<NT){WAIT_BAR(1);} else {WAIT_BAR(0);} }while(0)
  for(;t+1<NT;t+=2){
    STEP(pB0,pB1,pA0,pA1,t,(t+3<NT),(t+1<NT),(t+1<NT));       ENDW(t);   RESC(); ROT();
    STEP(pA0,pA1,pB0,pB1,t+1,(t+4<NT),(t+2<NT),(t+2<NT));     ENDW(t+1); RESC(); ROT();
  }
  STEP(pB0,pB1,pA0,pA1,NT-1,false,false,false); RESC();
  { float sacc=pB0[0]+pB0[1]; _Pragma("unroll") for(int r=2;r<16;++r)sacc+=pB0[r]; _Pragma("unroll") for(int r=0;r<16;++r)sacc+=pB1[r]; l_reg+=sacc;
    pw0=(u32x4){PKW(pB0,0),PKW(pB0,2),PKW(pB0,4),PKW(pB0,6)};pw1=(u32x4){PKW(pB0,8),PKW(pB0,10),PKW(pB0,12),PKW(pB0,14)};pw2=(u32x4){PKW(pB1,0),PKW(pB1,2),PKW(pB1,4),PKW(pB1,6)};pw3=(u32x4){PKW(pB1,8),PKW(pB1,10),PKW(pB1,12),PKW(pB1,14)};
    SBAR(); pv(o,vb0+sl_cur,PAF(0),PAF(1),PAF(2),PAF(3)); }
  #undef PKW
  #undef PAF
  #undef VFR
  #undef PIN
  #undef MX3
  #undef GAPA
  #undef GAPB
  #undef EX
  #undef VRD
  #undef KRD
  #undef STEP
  #undef ENDW
  {auto rr=__builtin_amdgcn_permlane32_swap(__float_as_uint(l_reg),__float_as_uint(l_reg),false,false);l_reg=__uint_as_float(rr[0])+__uint_as_float(rr[1]);}
  if(hi==0)wsf[32+r32]=l_reg;asm volatile("s_waitcnt lgkmcnt(0)":::"memory");
  float rli[16];
  #pragma unroll
  for(int r=0;r<16;++r)rli[r]=__builtin_amdgcn_rcpf(wsf[32+crow(r,hi)]);
  bf16*Ow=O0+(long)(wid*QBLK)*OP;
  { bf16*stg=(bf16*)(shm+LDS_OST)+wid*2048;
    #pragma unroll
    for(int r=0;r<16;++r){const int orow=crow(r,hi);
      #pragma unroll
      for(int d0=0;d0<2;++d0)stg[orow*64+d0*32+r32]=__float2bfloat16(o[d0][r]*rli[r]);}
    asm volatile("s_waitcnt lgkmcnt(0)":::"memory");
    #pragma unroll
    for(int i=0;i<4;++i){const int row=i*8+(lane>>3),ch=lane&7; const u32x4 v=*(const u32x4*)(stg+row*64+ch*8); ATTN_STORE16(Ow+(long)row*OP+ch*8,v);} }
  asm volatile("s_waitcnt lgkmcnt(0)\n\ts_barrier":::"memory");
  #undef DMA_K
  #undef DMA_V
  #undef CMASK
  #undef START
  #undef RESC
  #undef ROT
}
constexpr int ATTN_LDS_BYTES=LDS_BYTES;
#undef SBAR
#undef WAIT_BAR
}

__device__ __forceinline__ void attn_phase_run(const P& p, unsigned char* lds_generic, int layer) {
    typedef attn_body::bf16 abf;
    const int G = gridDim.x, bx = blockIdx.x, vcu = (G % 8 == 0) ? (bx % 8) * (G / 8) + bx / 8 : bx;
    const abf* Q = (const abf*)(p.ws + WS_ATTQ); const abf* K = (const abf*)(p.ws + WS_ATTK); const abf* V = (const abf*)(p.ws + WS_ATTV); abf* X = (abf*)(p.ws + WS_X);
    if (G == 256) {
        const int x = vcu >> 5, qb = vcu & 31, b = x >> 2, kvh = (x >> 1) & 1;
#pragma unroll 1
        for (int i = 0; i < 2; ++i) { const int h = kvh * 4 + 2 * (x & 1) + i; const long r0 = (long)b * SEQ + qb * 256;
            attn_body::attn_unit<8>(Q + r0 * 512 + h * 64, K + (long)b * KEYS * 128 + kvh * 64, V + (long)b * KEYS * 128 + kvh * 64, X + r0 * 1536 + 768 + h * 64, KEYS / 64, (char*)lds_generic); }
    } else {
#pragma unroll 1
        for (int u = vcu; u < 512; u += G) { const int qb = u & 31, h = (u >> 5) & 7, b = u >> 8, kvh = h >> 2; const long r0 = (long)b * SEQ + qb * 256;
            attn_body::attn_unit<8>(Q + r0 * 512 + h * 64, K + (long)b * KEYS * 128 + kvh * 64, V + (long)b * KEYS * 128 + kvh * 64, X + r0 * 1536 + 768 + h * 64, KEYS / 64, (char*)lds_generic); }
    }
    if (layer == 0) {
#pragma unroll 1
        for (int u = vcu; u < 16; u += G) { const int b = u >> 3, h = u & 7, kvh = h >> 2; const long r0 = NLAT + (long)b * CTX;
            attn_body::attn_unit<8>(Q + r0 * 512 + h * 64, K + (long)b * KEYS * 128 + kvh * 64, V + (long)b * KEYS * 128 + kvh * 64, X + r0 * 1536 + 768 + h * 64, CTX / 64, (char*)lds_generic); }
    }
}

__device__ __forceinline__ void ph_fft1(const P& p, LAS unsigned char* lds, int layer) {
    int nt2 = 2; asm volatile("" : "+s"(nt2));
    { fg::PlainSched S{(const char*)(p.ws + WS_F1), (const char*)(p.ws + WS_UT), 256, 256, 1, 128, (int)gridDim.x, (int)blockIdx.x, nt2};
      fg::EpiFft1 E{p.ws}; fg::gemm_phase(lds, 256, 256, S, E); }
    if (layer == 0) { fg::PlainSched S{(const char*)(p.ws + WS_FC), (const char*)(p.ws + WS_UTC), 256, 256, 2, 2, (int)gridDim.x, (int)((blockIdx.x + 128) % gridDim.x), 4};
      fg::EpiFftC E{p.ws}; fg::gemm_phase(lds, 256, 256, S, E); }
}
__device__ __forceinline__ void ph_fft3(const P& p, LAS unsigned char* lds) {
    int nt2 = 2; asm volatile("" : "+s"(nt2));
    fg::PlainSched S{(const char*)(p.ws + WS_F2), (const char*)(p.ws + WS_Z), 256, 256, 1, 256, (int)gridDim.x, (int)blockIdx.x, nt2};
    fg::EpiFft3 E{p.ws}; fg::gemm_phase(lds, 256, 256, S, E);
}
__device__ __forceinline__ void ph_mix1(const P& p, LAS unsigned char* lds, int layer) {
    ph_fft1(p, lds, layer);
    const int nconv = layer == 0 ? 264 : 256;
    const int n0 = nconv, n1 = n0 + NB * NCHUNK * 4;
    for (int it = gridDim.x - 1 - blockIdx.x; it < n1; it += gridDim.x) {
        if (it < n0) { if (it < 256) conv_item(p, lds, layer, it >> 7, (it & 127) * 64); else conv_item(p, lds, layer, 2 + ((it - 256) >> 2), ((it - 256) & 3) * 64); }
        else ret_kv_item(p, lds, layer, it - n0);
    }
    __syncthreads();
}
__device__ __forceinline__ void ph_mix2(const P& p, LAS unsigned char* lds, unsigned char* lds_generic, int layer) {
    for (int it = blockIdx.x; it < 128; it += gridDim.x) ret_scan_item(p, layer, it);
    __syncthreads();
    ph_fft3(p, lds);
    attn_phase_run(p, lds_generic, layer);
    __syncthreads();
}
__device__ __forceinline__ void ph_mix3(const P& p, LAS unsigned char* lds, int layer, bool ctxlater) {
    for (int it = blockIdx.x; it < NB * NCHUNK * 4; it += gridDim.x) {
        const int n = (it >> 2) % NCHUNK; if ((layer == 1 || ctxlater) && n < 2) continue;
        ret_out_item(p, lds, layer, it);
    }
    __syncthreads();
}
__device__ __forceinline__ void ctx_ret_items(const P& p, LAS unsigned char* lds) {
    const int u = blockIdx.x;
    if (u < 16) { const int b = u >> 3, n = (u >> 2) & 1, h = u & 3;
        ret_out_item(p, lds, 0, (b * NCHUNK + n) * 4 + h);
        asm volatile("s_waitcnt vmcnt(0)" ::: "memory"); __syncthreads();
        if (threadIdx.x == 0) { __builtin_amdgcn_fence(__ATOMIC_RELEASE, "agent");
            __hip_atomic_fetch_add((unsigned*)(p.ws + WS_CTL) + CW_CCNT + (8 * 3) * 16, 1u, __ATOMIC_RELAXED, __HIP_MEMORY_SCOPE_AGENT); }
        __syncthreads(); }
}
__device__ __forceinline__ void ctx_ret_wait(const P& p) {
    if (threadIdx.x == 0) { unsigned* c = (unsigned*)(p.ws + WS_CTL) + CW_CCNT + (8 * 3) * 16; unsigned* tmo = (unsigned*)(p.ws + WS_CTL) + CW_TMO; unsigned sp = 0u;
        while (__hip_atomic_load(c, __ATOMIC_RELAXED, __HIP_MEMORY_SCOPE_AGENT) < 16u) { __builtin_amdgcn_s_sleep(1);
            if ((++sp & 255u) == 0u) { if (__hip_atomic_load(tmo, __ATOMIC_RELAXED, __HIP_MEMORY_SCOPE_AGENT)) break; if (sp > (1u << 22)) { atomicAdd(tmo, 1u); break; } } }
        __builtin_amdgcn_fence(__ATOMIC_ACQUIRE, "agent"); }
    __syncthreads();
}

namespace sk {
typedef short bf16x8 __attribute__((ext_vector_type(8)));
__device__ __forceinline__ void tile64(LAS unsigned char* lds, const bf16* A, int lda, const bf16* Bt, int ldb, int K, float (&out)[8]) {
    const int tid = threadIdx.x, lane = tid & 63, w = tid >> 6, kc = K >> 3;
    const bf16* ap = A + (size_t)(lane & 15) * lda + w * kc + 8 * (lane >> 4); const bf16* bp = Bt + (size_t)(lane & 15) * ldb + w * kc + 8 * (lane >> 4);
    f32x4 acc[4][4];
#pragma unroll
    for (int i = 0; i < 4; ++i)
#pragma unroll
        for (int j = 0; j < 4; ++j) acc[i][j] = (f32x4){0.f, 0.f, 0.f, 0.f};
#pragma unroll 2
    for (int k0 = 0; k0 < kc; k0 += 32) {
        bf16x8 af[4], bfr[4];
#pragma unroll
        for (int i = 0; i < 4; ++i) { af[i] = *(const bf16x8*)(ap + (size_t)(16 * i) * lda + k0); bfr[i] = *(const bf16x8*)(bp + (size_t)(16 * i) * ldb + k0); }
#pragma unroll
        for (int i = 0; i < 4; ++i)
#pragma unroll
            for (int j = 0; j < 4; ++j) acc[i][j] = __builtin_amdgcn_mfma_f32_16x16x32_bf16(af[i], bfr[j], acc[i][j], 0, 0, 0);
    }
    LAS float* part = (LAS float*)lds;
    __syncthreads();
#pragma unroll
    for (int i = 0; i < 4; ++i)
#pragma unroll
        for (int j = 0; j < 4; ++j)
#pragma unroll
            for (int r = 0; r < 4; ++r) part[((w * 16 + i * 4 + j) * 4 + r) * 64 + lane] = acc[i][j][r];
    __syncthreads();
#pragma unroll
    for (int q = 0; q < 8; ++q) { float sacc = 0.f;
#pragma unroll
        for (int ww = 0; ww < 8; ++ww) sacc += part[ww * 4096 + tid + 512 * q];
        out[q] = sacc; }
}
__device__ __forceinline__ void tile64_f8(LAS unsigned char* lds, const unsigned char* A, int lda, const unsigned char* Bt, int ldb, int K, float (&out)[8]) {
    const int tid = threadIdx.x, lane = tid & 63, w = tid >> 6;
    const unsigned char* ap = A + (size_t)(lane & 15) * lda + 32 * (lane >> 4); const unsigned char* bp = Bt + (size_t)(lane & 15) * ldb + 32 * (lane >> 4);
    f32x4 acc[4][4];
#pragma unroll
    for (int i = 0; i < 4; ++i)
#pragma unroll
        for (int j = 0; j < 4; ++j) acc[i][j] = (f32x4){0.f, 0.f, 0.f, 0.f};
    for (int ks = w; ks * 128 < K; ks += 8) {
        fg::i32x8 af[4], bfr[4];
#pragma unroll
        for (int i = 0; i < 4; ++i) { af[i] = *(const fg::i32x8*)(ap + (size_t)(16 * i) * lda + ks * 128); bfr[i] = *(const fg::i32x8*)(bp + (size_t)(16 * i) * ldb + ks * 128); }
#pragma unroll
        for (int i = 0; i < 4; ++i)
#pragma unroll
            for (int j = 0; j < 4; ++j) acc[i][j] = __builtin_amdgcn_mfma_scale_f32_16x16x128_f8f6f4(af[i], bfr[j], acc[i][j], 0, 0, 0, 0x7f7f7f7f, 0, 0x7a7a7a7a);
    }
    LAS float* part = (LAS float*)lds;
    __syncthreads();
#pragma unroll
    for (int i = 0; i < 4; ++i)
#pragma unroll
        for (int j = 0; j < 4; ++j)
#pragma unroll
            for (int r = 0; r < 4; ++r) part[((w * 16 + i * 4 + j) * 4 + r) * 64 + lane] = acc[i][j][r];
    __syncthreads();
#pragma unroll
    for (int q = 0; q < 8; ++q) { float sacc = 0.f;
#pragma unroll
        for (int ww = 0; ww < 8; ++ww) sacc += part[ww * 4096 + tid + 512 * q];
        out[q] = sacc; }
}
__device__ __forceinline__ void elem_rc(int tid, int q, int& row, int& col) { const int e = tid + 512 * q, t16 = e >> 8, reg = (e >> 6) & 3, lane = e & 63; row = 16 * (t16 >> 2) + 4 * (lane >> 4) + reg; col = 16 * (t16 & 3) + (lane & 15); }
}
__device__ __forceinline__ void mini_merge_ctx(const P& p, LAS unsigned char* lds, int layer) {
    const bf16* X = (const bf16*)(p.ws + WS_X); const bf16* WB = (const bf16*)(p.ws + WS_WB) + (size_t)layer * 1024 * 1536; const unsigned char* G = (const unsigned char*)(p.ws + WS_G); bf16* Mg = (bf16*)(p.ws + WS_MERGED);
    for (int it = gridDim.x - 1 - blockIdx.x; it < (NCTX / 64) * 16; it += gridDim.x) { const int r0 = NLAT + (it >> 4) * 64, c0 = (it & 15) * 64;
        float tot[8];
#pragma unroll
        for (int q = 0; q < 8; ++q) tot[q] = 0.f;
#pragma unroll 1
        for (int br = 0; br < 4; ++br) { const int koff = br == 0 ? 0 : (br == 1 ? 512 : (br == 2 ? 768 : 1280)), klen = (br & 1) ? 256 : 512;
            float o[8]; sk::tile64(lds, X + (size_t)r0 * 1536 + koff, 1536, WB + (size_t)c0 * 1536 + koff, 1536, klen, o);
#pragma unroll
            for (int q = 0; q < 8; ++q) { int rr, cc; sk::elem_rc(threadIdx.x, q, rr, cc); tot[q] += o[q] * ((float)G[(size_t)(r0 + rr) * 4096 + br * 1024 + c0 + cc] * (1.f / 255.f)); } }
#pragma unroll
        for (int q = 0; q < 8; ++q) { int rr, cc; sk::elem_rc(threadIdx.x, q, rr, cc); Mg[(size_t)(r0 + rr) * 1024 + c0 + cc] = f2bf(tot[q]); } }
    __syncthreads();
}
__device__ __forceinline__ void mini_resid_ctx(const P& p, LAS unsigned char* lds, int layer, const bf16* A, int lda, const bf16* Bt, int K, int chunk, int xnorm = -1, int nlayer = 0, int nwhich = 0, const float* hsrc = nullptr) {
    const float* g = mods(p, layer, 2, chunk); float* hc = (float*)(p.ws + WS_HCTX); if (hsrc == nullptr) hsrc = hc;
    for (int it = gridDim.x - 1 - blockIdx.x; it < (NCTX / 64) * 16; it += gridDim.x) { const int rl = (it >> 4) * 64, c0 = (it & 15) * 64;
        float o[8]; sk::tile64(lds, A + (size_t)(NLAT + rl) * lda, lda, Bt + (size_t)c0 * K, K, K, o);
        if (xnorm < 0) {
#pragma unroll
            for (int q = 0; q < 8; ++q) { int rr, cc; sk::elem_rc(threadIdx.x, q, rr, cc); float* h = hc + (size_t)(rl + rr) * D + c0 + cc; *h = *h + g[c0 + cc] * o[q]; }
        } else {
#pragma unroll
            for (int q = 0; q < 8; ++q) { int rr, cc; sk::elem_rc(threadIdx.x, q, rr, cc); float* h = hc + (size_t)(rl + rr) * D + c0 + cc;
                __hip_atomic_store(h, hsrc[(size_t)(rl + rr) * D + c0 + cc] + g[c0 + cc] * o[q], __ATOMIC_RELAXED, __HIP_MEMORY_SCOPE_AGENT); }
            asm volatile("s_waitcnt vmcnt(0)" ::: "memory"); __syncthreads();
            if (threadIdx.x == 0) { unsigned* c = (unsigned*)(p.ws + WS_CTL) + CW_CCNT + (8 * xnorm + (it >> 4)) * 16; unsigned* tmo = (unsigned*)(p.ws + WS_CTL) + CW_TMO;
                __hip_atomic_fetch_add(c, 1u, __ATOMIC_RELAXED, __HIP_MEMORY_SCOPE_AGENT);
                unsigned sp = 0u;
                while (__hip_atomic_load(c, __ATOMIC_RELAXED, __HIP_MEMORY_SCOPE_AGENT) < 16u) { __builtin_amdgcn_s_sleep(1);
                    if ((++sp & 255u) == 0u) { if (__hip_atomic_load(tmo, __ATOMIC_RELAXED, __HIP_MEMORY_SCOPE_AGENT)) break; if (sp > (1u << 22)) { atomicAdd(tmo, 1u); break; } } }
                __builtin_amdgcn_fence(__ATOMIC_ACQUIRE, "agent"); }
            __syncthreads();
            { const int w = threadIdx.x >> 6, lane = threadIdx.x & 63;
              if (w < 4) norm_row(p, nlayer, nwhich, NLAT + rl + (it & 15) * 4 + w, lane); }
            __syncthreads();
        } }
    __syncthreads();
}
__device__ __forceinline__ void ph_merge(const P& p, LAS unsigned char* lds, int layer, int nrows) {
    fg::MergeSched S{(const char*)(p.ws + WS_X), (const char*)(p.ws + WS_WB) + (size_t)layer * 1024 * 1536 * 2, nrows / 256, (int)gridDim.x, (int)blockIdx.x};
    fg::EpiMerge E{(const unsigned char*)(p.ws + WS_G), (bf16*)(p.ws + WS_MERGED)};
    fg::gemm_phase(lds, 1536, 1536, S, E);
}
__device__ __forceinline__ void ph_gemm_resid(const P& p, LAS unsigned char* lds, int layer, const bf16* A, int lda, const bf16* Bt, int K, int chunk, int nrows) {
    fg::PlainSched S{(const char*)A, (const char*)Bt, lda, K, nrows / 256, 4, (int)gridDim.x, (int)blockIdx.x, K / 64};
    fg::EpiResid E{p.out, (float*)(p.ws + WS_HCTX), (const float*)(p.ws + WS_MODS) + (size_t)layer * 3 * 6144, chunk};
    fg::gemm_phase(lds, lda, K, S, E);
}
__device__ __forceinline__ void ph_gemm_resid_norm(const P& p, LAS unsigned char* lds, int layer, const bf16* A, int lda, const bf16* Bt, int K, int chunk, int x, int nlayer, int nwhich, const float* hin) {
    fg::PlainSched S{(const char*)A, (const char*)Bt, lda, K, NLAT / 256, 4, (int)gridDim.x, (int)blockIdx.x, K / 64};
    unsigned* ctl = (unsigned*)(p.ws + WS_CTL);
    fg::EpiResidNorm E{hin, p.out, (const float*)(p.ws + WS_MODS) + (size_t)layer * 3 * 6144, chunk,
        p.in[nwhich == 0 ? 6 : 7] + nlayer * D, (const float*)(p.ws + WS_MODS) + (size_t)nlayer * 3 * 6144, nwhich == 0 ? 0 : 3, nwhich == 0 ? 1 : 4, (bf16*)(p.ws + WS_A), nwhich == 0 ? p.ws + WS_A8 : (unsigned char*)nullptr,
        (float*)(p.ws + WS_CTL + CTL_XBUF) + (size_t)x * 65536, ctl + CW_PCNT + 64 * 16 * x, ctl + CW_TMO, lds};
    fg::gemm_phase(lds, lda, K, S, E);
}
__device__ __forceinline__ void ph_ffn1(const P& p, LAS unsigned char* lds) {
    fg::PlainSched S{(const char*)(p.ws + WS_A), (const char*)(p.ws + WS_FFN1), D, D, MROWS / 256, 22, (int)gridDim.x, (int)blockIdx.x, D / 64};
    fg::EpiSwiglu E{(bf16*)(p.ws + WS_HMID)};
    fg::gemm_phase(lds, D, D, S, E);
}
__device__ __forceinline__ int moe_tiles(const P& p, LAS int* tile_e) {
    const unsigned* ctl = (const unsigned*)(p.ws + WS_CTL); int t = 0;
    for (int e = 0; e < NEXP; ++e) { const int c = (int)ctl[CW_CNT + e], nt = (c + 255) >> 8; for (int q = 0; q < nt; ++q) { if (threadIdx.x == 0) tile_e[t + q] = e; } t += nt; }
    __syncthreads();
    return t;
}
__device__ __forceinline__ void ph_assign_gather(const P& p, LAS unsigned char* lds) {
    const int tid = threadIdx.x, bid = blockIdx.x, G = gridDim.x;
    LAS int* sbase = (LAS int*)lds;
    LAS int* stot = sbase + 8;
    LAS int* spst = stot + 8;
    LAS int* sexp = spst + 16;
    LAS int* sslot = sexp + 128;
    const unsigned* cntb = (const unsigned*)(p.ws + WS_ROUTE) + 16384 * 6;
    const int* tok_e = (const int*)(p.ws + WS_ROUTE); int* tok_slot = (int*)(p.ws + WS_ROUTE) + 16384 * 4;
    __syncthreads();
    { const int e = tid >> 6, l = tid & 63; int tot = 0, below = 0;
      for (int b = l; b < G; b += 64) { const int c = (int)cntb[b * NEXP + e]; tot += c; if (b < bid) below += c; }
#pragma unroll
      for (int o = 1; o < 64; o <<= 1) { tot += __shfl_xor(tot, o); below += __shfl_xor(below, o); }
      if (l == 0) { sbase[e] = below; stot[e] = tot; } }
    if (tid < 128) { const int li = tid >> 1, w = li & 7, k = li >> 3, tok = (bid * 8 + w) + k * (G * 8); sexp[tid] = tok < NLAT ? tok_e[tok * 2 + (tid & 1)] : -1; }
    __syncthreads();
    if (tid == 0) { int t = 0; for (int e = 0; e < NEXP; ++e) { spst[e] = t * 256; t += (stot[e] + 255) >> 8; } spst[NEXP] = t * 256;
        if (bid == 0) { unsigned* ctl = (unsigned*)(p.ws + WS_CTL); for (int e = 0; e < NEXP; ++e) ctl[CW_CNT + e] = (unsigned)stot[e]; } }
    __syncthreads();
    if (tid < 128) { const int e = sexp[tid]; int slot = -1;
        if (e >= 0) { int rank = 0; for (int a = 0; a < tid; ++a) rank += (sexp[a] == e) ? 1 : 0; slot = spst[e] + sbase[e] + rank;
            const int li = tid >> 1, w = li & 7, k = li >> 3, tok = (bid * 8 + w) + k * (G * 8); tok_slot[tok * 2 + (tid & 1)] = slot; }
        sslot[tid] = slot; }
    __syncthreads();
    const int lane = tid & 63, wv = tid >> 6; const unsigned char* A8 = p.ws + WS_A8; unsigned char* FS8 = p.ws + WS_FS;
    for (int a = wv; a < 128; a += 8) { const int slot = sslot[a]; if (slot < 0) continue; const int li = a >> 1, w = li & 7, k = li >> 3, tok = (bid * 8 + w) + k * (G * 8);
        *(u32x4*)(FS8 + (size_t)slot * D + lane * 16) = *(const u32x4*)(A8 + (size_t)tok * D + lane * 16); }
    { int idx = 0;
      for (int e = 0; e < NEXP; ++e) { const int lo_ = spst[e] + stot[e], hi_ = spst[e + 1];
          for (int r = lo_ + ((bid * 8 + wv - idx) % (G * 8) + (G * 8)) % (G * 8); r < hi_; r += G * 8) {
              *(u32x4*)(FS8 + (size_t)r * D + lane * 16) = (u32x4){0u, 0u, 0u, 0u}; }
          idx += hi_ - lo_; } }
    __syncthreads();
}
__device__ __forceinline__ void ph_moe1(const P& p, LAS unsigned char* lds) {
    LAS int* tile_e = (LAS int*)(lds + fg::STAGE_BYTES); const int nt = moe_tiles(p, tile_e);
    fg::ExpertSched S{(const char*)(p.ws + WS_FS), (const char*)(p.ws + WS_MOE1), D / 2, D / 2, nt, 22, (int)gridDim.x, (int)blockIdx.x, D / 128, tile_e, (size_t)5632 * D};
    fg::EpiSwiglu8 E{p.ws + WS_HMOE};
    fg::gemm_phase<fg::EpiSwiglu8, fg::ExpertSched, true>(lds, D / 2, D / 2, S, E);
}
__device__ __forceinline__ void ph_moe2(const P& p, LAS unsigned char* lds) {
    LAS int* tile_e = (LAS int*)(lds + fg::STAGE_BYTES); const int nt = moe_tiles(p, tile_e);
    const int nbig = nt < 128 ? nt : 128;
    fg::ExpertSched S{(const char*)(p.ws + WS_HMOE), (const char*)(p.ws + WS_MOE2), FFN / 2, FFN / 2, nbig, 4, (int)gridDim.x, (int)blockIdx.x, FFN / 128, tile_e, (size_t)D * FFN};
    fg::EpiStore E{(bf16*)(p.ws + WS_Y2), D};
    fg::gemm_phase<fg::EpiStore, fg::ExpertSched, true>(lds, FFN / 2, FFN / 2, S, E);
    const unsigned char* A = p.ws + WS_HMOE; bf16* Y = (bf16*)(p.ws + WS_Y2);
    for (int it = blockIdx.x; it < (nt - nbig) * 64; it += gridDim.x) {
        const int rt = nbig + (it >> 6), r0 = rt * 256 + ((it >> 4) & 3) * 64, c0 = (it & 15) * 64;
        const unsigned char* B = p.ws + WS_MOE2 + (size_t)tile_e[rt] * D * FFN;
        float o[8]; sk::tile64_f8(lds, A + (size_t)r0 * FFN, FFN, B + (size_t)c0 * FFN, FFN, FFN, o);
#pragma unroll
        for (int q = 0; q < 8; ++q) { int rr, cc; sk::elem_rc(threadIdx.x, q, rr, cc); Y[(size_t)(r0 + rr) * D + c0 + cc] = f2bf(o[q]); } }
    __syncthreads();
}
__device__ __forceinline__ void ph_combine(const P& p, int layer) {
    const int lane = threadIdx.x & 63, gw = blockIdx.x * 8 + (threadIdx.x >> 6), ngw = gridDim.x * 8;
    const float* tok_w = (const float*)(p.ws + WS_ROUTE) + 16384 * 2; const int* tok_slot = (const int*)(p.ws + WS_ROUTE) + 16384 * 4; const bf16* Y = (const bf16*)(p.ws + WS_Y2);
    for (int r = gw; r < NLAT; r += ngw) {
        const int s0 = tok_slot[r * 2], s1 = tok_slot[r * 2 + 1]; const float w0 = tok_w[r * 2], w1 = tok_w[r * 2 + 1];
        const float* g = mods(p, layer, row_mi(r), 5); float* h = p.out + (size_t)r * D;
#pragma unroll
        for (int j = 0; j < 4; ++j) { const int c = 4 * lane + 256 * j;
            const u32x2 a = *(const u32x2*)(Y + (size_t)s0 * D + c), bq = *(const u32x2*)(Y + (size_t)s1 * D + c); const f32x4 gg = *(const f32x4*)(g + c); f32x4 hv = *(f32x4*)(h + c);
            hv.x += gg.x * (w0 * __uint_as_float(a.x << 16) + w1 * __uint_as_float(bq.x << 16)); hv.y += gg.y * (w0 * __uint_as_float(a.x & 0xffff0000u) + w1 * __uint_as_float(bq.x & 0xffff0000u));
            hv.z += gg.z * (w0 * __uint_as_float(a.y << 16) + w1 * __uint_as_float(bq.y << 16)); hv.w += gg.w * (w0 * __uint_as_float(a.y & 0xffff0000u) + w1 * __uint_as_float(bq.y & 0xffff0000u));
            *(f32x4*)(h + c) = hv; }
    }
}

#define XB_TMO      128
static_assert(CW_TMO == CW_BAR + XB_TMO, "tmo word");
static_assert(CW_CCNT + 4 * 8 * 16 <= 16384, "all zero-initialised control words lie in the first 64 KiB");
#define XB_XCNT(j)  (256  + 64 * (j))
#define XB_XSUB(j)  (1280 + 64 * (j))
#define XB_XGEN(j)  (2304 + 64 * (j))
#define XB_TOP      3328
#define XB_TOPGEN   3392
#define XCD_BAR_WORDS 3456
#define XB_SPIN_CAP (1u << 22)
__device__ __forceinline__ unsigned xb_ld(unsigned* p)              { return __hip_atomic_load(p, __ATOMIC_RELAXED, __HIP_MEMORY_SCOPE_AGENT); }
__device__ __forceinline__ unsigned xb_add(unsigned* p, unsigned v) { return __hip_atomic_fetch_add(p, v, __ATOMIC_RELAXED, __HIP_MEMORY_SCOPE_AGENT); }
__device__ __forceinline__ unsigned xb_xcc_id() { return (unsigned)__builtin_amdgcn_s_getreg((3 << 11) | 20) & 0xFu; }
#define XB_SPIN(cond, bar) do { unsigned _sp = 0; while (cond) { __builtin_amdgcn_s_sleep(1); \
    if ((++_sp & 255u) == 0u) { if (xb_ld(&(bar)[XB_TMO])) break; if (_sp > XB_SPIN_CAP) { atomicAdd(&(bar)[XB_TMO], 1u); break; } } } } while (0)
struct XcdBarrier { unsigned* bar; unsigned x; volatile LAS unsigned* st; };
__device__ __forceinline__ XcdBarrier xcd_barrier_post(unsigned* bar, volatile LAS unsigned* st) {
    XcdBarrier b; b.bar = bar; b.x = xb_xcc_id(); b.st = st;
    if (threadIdx.x == 0) (void)xb_add(&bar[XB_XCNT(b.x)], 1u);
    return b;
}
__device__ __forceinline__ void xcd_barrier_complete(unsigned* bar, unsigned x, unsigned& nloc, unsigned& nx) {
    const unsigned G = gridDim.x * gridDim.y * gridDim.z;
    unsigned sum, cnt, mine, sp = 0u;
    for (;;) {
        sum = 0u; cnt = 0u; mine = 0u;
#pragma unroll
        for (unsigned j = 0; j < 16; ++j) { const unsigned c = xb_ld(&bar[XB_XCNT(j)]); sum += c; cnt += (c > 0u) ? 1u : 0u; mine = (j == x) ? c : mine; }
        if (sum == G) break;
        __builtin_amdgcn_s_sleep(1);
        if ((++sp & 255u) == 0u) { if (xb_ld(&bar[XB_TMO])) break; if (sp > XB_SPIN_CAP) { atomicAdd(&bar[XB_TMO], 1u); break; } }
    }
    nloc = mine > 0u ? mine : 1u; nx = cnt > 0u ? cnt : 1u;
}
__device__ __forceinline__ void xcd_barrier(const XcdBarrier& b) {
    asm volatile("s_waitcnt vmcnt(0)" ::: "memory");
    __syncthreads();
    if (threadIdx.x == 0) {
        unsigned* bar = b.bar;
        __builtin_amdgcn_s_waitcnt(0);
        unsigned nloc = b.st[0], nx = b.st[1];
        if (nloc == 0u) { xcd_barrier_complete(bar, b.x, nloc, nx); b.st[0] = nloc; b.st[1] = nx; }
        const unsigned old = xb_add(&bar[XB_XSUB(b.x)], 1u);
        const unsigned gen = old / nloc;
        if (old + 1u == (gen + 1u) * nloc) {
            __builtin_amdgcn_fence(__ATOMIC_RELEASE, "agent");
            asm volatile("s_waitcnt vmcnt(0)" ::: "memory");
            const unsigned og = xb_add(&bar[XB_TOP], 1u);
            const unsigned tg = og / nx;
            if (og + 1u == (tg + 1u) * nx) xb_add(&bar[XB_TOPGEN], 1u);
            else XB_SPIN(xb_ld(&bar[XB_TOPGEN]) == tg, bar);
            __builtin_amdgcn_fence(__ATOMIC_ACQUIRE, "agent");
            xb_add(&bar[XB_XGEN(b.x)], 1u);
            asm volatile("s_waitcnt vmcnt(0)" ::: "memory");
        } else {
            XB_SPIN(xb_ld(&bar[XB_XGEN(b.x)]) == gen, bar);
            asm volatile("buffer_inv sc0" ::: "memory");
            asm volatile("s_waitcnt vmcnt(0)" ::: "memory");
        }
    }
    __syncthreads();
}

constexpr int NPHASE = 23;
constexpr int LDS_BYTES = 150 * 1024;
__global__ void __launch_bounds__(NTHREADS, 2) mk(P p, int lo, int hi, int fuse) {
    extern __shared__ __attribute__((aligned(16))) unsigned char lds_raw[];
    LAS unsigned char* lds = (LAS unsigned char*)lds_raw;
    volatile LAS unsigned* misc = (volatile LAS unsigned*)(lds + LDS_BYTES - 64);
    if (threadIdx.x < 16) misc[threadIdx.x] = 0u;
    __syncthreads();
    XcdBarrier bar; bar.bar = (unsigned*)(p.ws + WS_CTL) + CW_BAR; bar.x = 0; bar.st = misc;
    if (hi - lo > 1) bar = xcd_barrier_post((unsigned*)(p.ws + WS_CTL) + CW_BAR, misc);
#if MK_SINGLE
    cg::this_grid().sync();
#endif
#ifndef PROBE_MASK
#define PROBE_MASK 0u
#endif
#ifndef AMP_A
#define AMP_A (-1)
#define AMP_B (-1)
#define AMP_MUL 15
#endif
#define AMP(k) do { if ((k) == AMP_A && blockIdx.x == 0 && threadIdx.x == 0) { const unsigned long long t = __builtin_amdgcn_s_memrealtime(); misc[8] = (unsigned)t; } \
    if ((k) == AMP_B && blockIdx.x == 0 && threadIdx.x == 0) { const unsigned t1 = (unsigned)__builtin_amdgcn_s_memrealtime(), dt = (t1 - misc[8]) * AMP_MUL; while ((unsigned)__builtin_amdgcn_s_memrealtime() - t1 < dt) __builtin_amdgcn_s_sleep(8); } } while (0)
#define PH(k, body) do { if (lo <= (k) && (k) < hi) { if ((k) > lo) { xcd_barrier(bar); } AMP(k); body; \
    if ((PROBE_MASK >> (k)) & 1u) { xcd_barrier(bar); body; } } } while (0)
#define LAYER_PHASES(L, base) \
    PH(base + 0, ph_win(p, lds, L)); \
    PH(base + 1, ph_mix1(p, lds, L)); \
    PH(base + 2, ph_mix2(p, lds, lds_raw, L)); \
    PH(base + 3, ph_mix3(p, lds, L, fuse != 0)); \
    PH(base + 4, { if (L == 0 && fuse) ctx_ret_items(p, lds); ph_merge(p, lds, L, NLAT); if (L == 0) { if (fuse && (int)(gridDim.x - 1 - blockIdx.x) < (NCTX / 64) * 16) ctx_ret_wait(p); mini_merge_ctx(p, lds, L); } }); \
    PH(base + 5, { if (L == 0 && fuse) { ph_gemm_resid_norm(p, lds, 0, (const bf16*)(p.ws + WS_MERGED), 1024, (const bf16*)(p.ws + WS_WOUT), D, 2, 0, 0, 1, p.in[0]); mini_resid_ctx(p, lds, 0, (const bf16*)(p.ws + WS_MERGED), 1024, (const bf16*)(p.ws + WS_WOUT), D, 2, 0, 0, 1, p.in[2]); } \
        else { ph_gemm_resid(p, lds, L, (const bf16*)(p.ws + WS_MERGED), 1024, (const bf16*)(p.ws + WS_WOUT) + (size_t)L * D * D, D, 2, NLAT); if (L == 0) mini_resid_ctx(p, lds, L, (const bf16*)(p.ws + WS_MERGED), 1024, (const bf16*)(p.ws + WS_WOUT), D, 2); } });
    PH(0, ph_prologue(p, lds));
    PH(1, ph_norm(p, lds, 0, 0, true, false, MROWS, !fuse));
    LAYER_PHASES(0, 2)
    if (!fuse) PH(8, ph_norm(p, lds, 0, 1, false, false, MROWS));
    PH(9, ph_ffn1(p, lds));
    PH(10, { if (fuse) { ph_gemm_resid_norm(p, lds, 0, (const bf16*)(p.ws + WS_HMID), FFN, (const bf16*)(p.ws + WS_FFN2), FFN, 5, 1, 1, 0, p.out); mini_resid_ctx(p, lds, 0, (const bf16*)(p.ws + WS_HMID), FFN, (const bf16*)(p.ws + WS_FFN2), FFN, 5, 1, 1, 0); }
        else { ph_gemm_resid(p, lds, 0, (const bf16*)(p.ws + WS_HMID), FFN, (const bf16*)(p.ws + WS_FFN2), FFN, 5, NLAT); mini_resid_ctx(p, lds, 0, (const bf16*)(p.ws + WS_HMID), FFN, (const bf16*)(p.ws + WS_FFN2), FFN, 5); } });
    if (!fuse) PH(11, ph_norm(p, lds, 1, 0, false, false, MROWS));
    LAYER_PHASES(1, 12)
    PH(18, ph_norm(p, lds, 1, 1, false, true, NLAT));
    PH(19, { ph_assign_gather(p, lds); ph_moe_convert(p, lds); });
    PH(20, ph_moe1(p, lds));
    PH(21, ph_moe2(p, lds));
    PH(22, ph_combine(p, 1));
#undef PH
#undef LAYER_PHASES
}

extern "C" void kernel_launch(void* const* d_in, const int* in_sizes, int n_in, void* d_out, int out_size, void* d_ws, size_t ws_size, hipStream_t stream) {
    static int grid = 0;
    if (grid == 0) {
        if (n_in != 30 || out_size != NLAT * D || ws_size < WS_END) { fprintf(stderr, "kernel_launch: unexpected shapes (n_in %d out %d ws %zu)\n", n_in, out_size, ws_size); grid = -1; return; }
        int dev = 0, cus = 0, per_cu = 0;
        hipGetDevice(&dev); hipDeviceGetAttribute(&cus, hipDeviceAttributeMultiprocessorCount, dev);
        hipFuncSetAttribute((const void*)mk, hipFuncAttributeMaxDynamicSharedMemorySize, LDS_BYTES);
        hipOccupancyMaxActiveBlocksPerMultiprocessor(&per_cu, (const void*)mk, NTHREADS, LDS_BYTES);
        if (per_cu < 1) { fprintf(stderr, "kernel_launch: occupancy query says %d blocks per CU\n", per_cu); grid = -1; return; }
        grid = cus;
    }
    if (grid < 0) return;
    hipMemsetAsync((char*)d_ws + WS_CTL, 0, 64 * 1024, stream);
    P p{};
    for (int i = 0; i < 30; ++i) p.in[i] = (const float*)d_in[i];
    p.out = (float*)d_out; p.ws = (unsigned char*)d_ws;
#if MK_SINGLE
    int lo = 0, hi = NPHASE, fuse = grid == 256 ? 1 : 0; void* args[] = {&p, &lo, &hi, &fuse};
    hipLaunchCooperativeKernel((const void*)mk, dim3(grid), dim3(NTHREADS), args, LDS_BYTES, stream);
#else
    for (int ph = 0; ph < NPHASE; ++ph) hipLaunchKernelGGL(mk, dim3(grid), dim3(NTHREADS), LDS_BYTES, stream, p, ph, ph + 1, 0);
#endif
}
```

```cpp
#include <hip/hip_runtime.h>
#include <hip/hip_cooperative_groups.h>
#include <cstdio>
#include <cstdint>
namespace cg = cooperative_groups;

#ifndef MK_SINGLE
#define MK_SINGLE 1
#endif

typedef unsigned short bf16;
typedef float f32x4 __attribute__((ext_vector_type(4)));
typedef unsigned u32x4 __attribute__((ext_vector_type(4)));
typedef unsigned u32x2 __attribute__((ext_vector_type(2)));
#define LAS __attribute__((address_space(3)))

constexpr int D = 1024, NB = 2, SEQ = 8192, CTX = 256, NLAT = NB * SEQ, NCTX = NB * CTX, MROWS = NLAT + NCTX;
constexpr int INC = 6656, FFN = 2816, NEXP = 8, KEYS = CTX + SEQ;
constexpr int NCHUNK = 66;
constexpr float EPS = 1e-6f;
constexpr float QSCALE = 0.125f * 1.4426950408889634f;
constexpr int MOE_ROWS = 34816;
constexpr int NTHREADS = 512;

constexpr size_t MiB = 1u << 20;
constexpr size_t WS_CTL = 0, CTL_BYTES = 1 * MiB;
constexpr size_t WS_MODS = 1 * MiB;
constexpr size_t WS_ROPE = 2 * MiB;
constexpr size_t WS_F1 = 4 * MiB;
constexpr size_t WS_F2 = WS_F1 + 131072;
constexpr size_t WS_FC = WS_F2 + 131072;
constexpr size_t WS_TW = WS_FC + 262144;
constexpr size_t WS_ROUTE = 5 * MiB;
constexpr size_t WS_HCTX = 6 * MiB;
constexpr size_t WS_WIN = 8 * MiB;
constexpr size_t WS_WB = 34 * MiB;
constexpr size_t WS_WOUT = 40 * MiB;
constexpr size_t WS_FFN1 = 44 * MiB;
constexpr size_t WS_FFN2 = 55 * MiB;
constexpr size_t WS_A = 61 * MiB;
constexpr size_t WS_X = 94 * MiB;
constexpr size_t WS_Y = 144 * MiB;
constexpr size_t WS_RETQ = WS_Y;
constexpr size_t WS_RETK = WS_RETQ + (size_t)MROWS * 256 * 2;
constexpr size_t WS_RETV = WS_RETK + (size_t)MROWS * 256 * 2;
constexpr size_t WS_RETG = WS_RETV + (size_t)MROWS * 256 * 2;
constexpr size_t WS_ATTQ = WS_Y + 33 * MiB;
constexpr size_t WS_ATTK = WS_Y + 50 * MiB;
constexpr size_t WS_ATTV = WS_Y + 55 * MiB;
constexpr size_t WS_CONV = WS_Y + 60 * MiB;
constexpr size_t WS_UT = WS_Y + 77 * MiB;
constexpr size_t WS_UTC = WS_Y + 93 * MiB;
constexpr size_t WS_Z = WS_Y + 94 * MiB;
constexpr size_t WS_RETS = WS_Y + 126 * MiB;
constexpr size_t WS_MERGED = WS_Y + 143 * MiB;
constexpr size_t WS_G = 320 * MiB;
constexpr size_t WS_MOE1 = WS_G;
constexpr size_t WS_MOE2 = WS_G + (size_t)NEXP * 5632 * 1024 * 2;
constexpr size_t WS_HMID = WS_Y;
constexpr size_t WS_HMOE = 61 * MiB;
constexpr size_t WS_FS = 252 * MiB;
constexpr size_t WS_A8 = 386 * MiB;
constexpr size_t WS_WIN8 = 430 * MiB;
constexpr size_t WS_RETS2 = 452 * MiB;
constexpr size_t WS_Y2 = 160 * MiB;
constexpr size_t WS_END = 469 * MiB;
static_assert(WS_MERGED + (size_t)MROWS * 1024 * 2 <= WS_G, "map");
static_assert(WS_HMOE + (size_t)MOE_ROWS * FFN * 2 <= WS_FS && WS_FS + (size_t)MOE_ROWS * 1024 * 2 <= WS_G, "map moe");
static_assert(WS_MOE2 + (size_t)NEXP * 1024 * FFN * 2 <= WS_END, "map moe w");
static_assert(WS_G + (size_t)MROWS * 4096 <= WS_A8 && WS_A8 + (size_t)NLAT * 1024 <= WS_MOE2 && WS_MOE2 + (size_t)NEXP * 1024 * FFN <= WS_WIN8 && WS_WIN8 + (size_t)2 * 4096 * 1024 <= WS_RETS2, "map fp8 w_in");
constexpr int CW_CNT = 64;
constexpr int CW_CUR = 128;
constexpr int CW_BAR = 4096;
constexpr int CW_TMO = CW_BAR + 128;
constexpr int CW_PCNT = 8192;
constexpr int CW_CCNT = 8192 + 4 * 64 * 16;
constexpr size_t CTL_XBUF = 128 * 1024;

struct P {
    const float* in[30];
    float* out;
    unsigned char* ws;
};

__device__ __forceinline__ float bf2f(bf16 v) { return __uint_as_float((unsigned)v << 16); }
__device__ __forceinline__ bf16 f2bf(float f) { unsigned u = __float_as_uint(f); return (bf16)((u + 0x7fffu + ((u >> 16) & 1u)) >> 16); }
__device__ __forceinline__ unsigned pk2(float lo, float hi) { return (unsigned)f2bf(lo) | ((unsigned)f2bf(hi) << 16); }
__device__ __forceinline__ float sigmoidf_(float x) { return 1.f / (1.f + __expf(-x)); }
__device__ __forceinline__ float siluf_(float x) { return x / (1.f + __expf(-x)); }
__device__ __forceinline__ float sigmoid_fast(float x) { return __builtin_amdgcn_rcpf(1.f + __builtin_amdgcn_exp2f(-1.4426950408889634f * x)); }
__device__ __forceinline__ float silu_fast(float x) { return x * __builtin_amdgcn_rcpf(1.f + __builtin_amdgcn_exp2f(-1.4426950408889634f * x)); }
__device__ __forceinline__ float wave_sum(float v) {
#pragma unroll
    for (int o = 1; o < 64; o <<= 1) v += __shfl_xor(v, o);
    return v;
}
__device__ __forceinline__ int row_mi(int r) { return r < NLAT ? (r >> 13) : 2; }
__device__ __forceinline__ float* hrow(const P& p, int r) { return r < NLAT ? p.out + (size_t)r * D : (float*)(p.ws + WS_HCTX) + (size_t)(r - NLAT) * D; }
__device__ __forceinline__ const float* mods(const P& p, int layer, int mi, int chunk) { return (const float*)(p.ws + WS_MODS) + ((size_t)(layer * 3 + mi) * 6 + chunk) * D; }

__device__ __forceinline__ int rowmap(int mode, int n) {
    if (mode == 0) return n;
    if (mode == 1 || mode == 2) return 8 * (n >> 2) + (n & 3) + (mode == 2 ? 4 : 0);
    const int tile = n >> 8, l = n & 255, head = l >> 6, d = l & 63;
    const bool ropet = tile == 1 || tile == 2 || tile == 5 || tile == 6 || (tile == 7 && head < 2);
    if (ropet) { const int i = d & 31, nn = d >> 5; return tile * 256 + 128 * (i >> 4) + 32 * head + 8 * ((i >> 2) & 3) + 4 * nn + (i & 3); }
    if (tile == 7) return tile * 256 + 128 * (d >> 5) + 32 * head + 8 * ((d >> 3) & 3) + (d & 7);
    return n;
}
__device__ __forceinline__ void conv_tile(LAS float* scr, const float* src, int ldn, int k0, int n0, bf16* dst, int ldd, int koff, int mode) {
    const int tid = threadIdx.x;
    __syncthreads();
#pragma unroll
    for (int i = 0; i < 8; ++i) { const int e = tid + i * NTHREADS, kk = e >> 6, nn = e & 63; scr[kk * 65 + nn] = src[(size_t)(k0 + kk) * ldn + n0 + nn]; }
    __syncthreads();
    const int nn = tid >> 3, kc = (tid & 7) * 8;
    u32x4 o; o.x = pk2(scr[(kc + 0) * 65 + nn], scr[(kc + 1) * 65 + nn]); o.y = pk2(scr[(kc + 2) * 65 + nn], scr[(kc + 3) * 65 + nn]);
    o.z = pk2(scr[(kc + 4) * 65 + nn], scr[(kc + 5) * 65 + nn]); o.w = pk2(scr[(kc + 6) * 65 + nn], scr[(kc + 7) * 65 + nn]);
    *(u32x4*)(dst + (size_t)rowmap(mode, n0 + nn) * ldd + koff + k0 + kc) = o;
}
constexpr float F8_WSCALE = 32.f;
__device__ __forceinline__ unsigned pk4_fp8(float a, float b, float c, float d) { int w = 0; w = __builtin_amdgcn_cvt_pk_fp8_f32(a, b, w, false); w = __builtin_amdgcn_cvt_pk_fp8_f32(c, d, w, true); return (unsigned)w; }
__device__ __forceinline__ void conv_tile2_f8(LAS float* scr, const float* src, int ldn, unsigned char* dst8, int ldd, int mode, int k0a, int n0a, int k0b, int n0b, bool two) {
    const int tid = threadIdx.x;
    f32x4 va[2], vb[2];
#pragma unroll
    for (int i = 0; i < 2; ++i) { const int e = tid + i * NTHREADS, kk = e >> 4, n4 = (e & 15) * 4;
        va[i] = *(const f32x4*)(src + (size_t)(k0a + kk) * ldn + n0a + n4);
        if (two) vb[i] = *(const f32x4*)(src + (size_t)(k0b + kk) * ldn + n0b + n4); }
    __syncthreads();
#pragma unroll
    for (int i = 0; i < 2; ++i) { const int e = tid + i * NTHREADS, kk = e >> 4, n4 = (e & 15) * 4;
#pragma unroll
        for (int q = 0; q < 4; ++q) { scr[kk * 65 + n4 + q] = va[i][q]; if (two) scr[64 * 65 + kk * 65 + n4 + q] = vb[i][q]; } }
    __syncthreads();
    const int nn = tid >> 3, kc = (tid & 7) * 8;
#pragma unroll
    for (int t = 0; t < 2; ++t) { if (t == 1 && !two) break; const LAS float* sp = scr + t * 64 * 65; const int k0 = t ? k0b : k0a, n0 = t ? n0b : n0a;
        u32x2 o; o.x = pk4_fp8(sp[(kc + 0) * 65 + nn] * F8_WSCALE, sp[(kc + 1) * 65 + nn] * F8_WSCALE, sp[(kc + 2) * 65 + nn] * F8_WSCALE, sp[(kc + 3) * 65 + nn] * F8_WSCALE);
        o.y = pk4_fp8(sp[(kc + 4) * 65 + nn] * F8_WSCALE, sp[(kc + 5) * 65 + nn] * F8_WSCALE, sp[(kc + 6) * 65 + nn] * F8_WSCALE, sp[(kc + 7) * 65 + nn] * F8_WSCALE);
        *(u32x2*)(dst8 + (size_t)rowmap(mode, n0 + nn) * ldd + k0 + kc) = o; }
}
__device__ __forceinline__ void conv_tile128_f8(LAS float* scr, const float* src, int ldn, unsigned char* dst8, int ldd, int mode, int k0, int n0) {
    const int tid = threadIdx.x;
    f32x4 v[8];
#pragma unroll
    for (int i = 0; i < 8; ++i) { const int e = tid + i * NTHREADS, kk = e >> 5, n4 = (e & 31) * 4; v[i] = *(const f32x4*)(src + (size_t)(k0 + kk) * ldn + n0 + n4); }
    __syncthreads();
#pragma unroll
    for (int i = 0; i < 8; ++i) { const int e = tid + i * NTHREADS, kk = e >> 5, n4 = (e & 31) * 4;
#pragma unroll
        for (int q = 0; q < 4; ++q) scr[kk * 129 + n4 + q] = v[i][q]; }
    __syncthreads();
    const int nn = tid >> 2, kc = (tid & 3) * 32;
    u32x4 o[2];
#pragma unroll
    for (int h = 0; h < 2; ++h) { const LAS float* sp = scr + (kc + h * 16) * 129 + nn;
        o[h].x = pk4_fp8(sp[0] * F8_WSCALE, sp[129] * F8_WSCALE, sp[2 * 129] * F8_WSCALE, sp[3 * 129] * F8_WSCALE);
        o[h].y = pk4_fp8(sp[4 * 129] * F8_WSCALE, sp[5 * 129] * F8_WSCALE, sp[6 * 129] * F8_WSCALE, sp[7 * 129] * F8_WSCALE);
        o[h].z = pk4_fp8(sp[8 * 129] * F8_WSCALE, sp[9 * 129] * F8_WSCALE, sp[10 * 129] * F8_WSCALE, sp[11 * 129] * F8_WSCALE);
        o[h].w = pk4_fp8(sp[12 * 129] * F8_WSCALE, sp[13 * 129] * F8_WSCALE, sp[14 * 129] * F8_WSCALE, sp[15 * 129] * F8_WSCALE); }
    unsigned char* d = dst8 + (size_t)rowmap(mode, n0 + nn) * ldd + k0 + kc;
    *(u32x4*)d = o[0]; *(u32x4*)(d + 16) = o[1];
}
struct CJob { const float* src; int K, N; bf16* dst; int ldd, koff, mode, ldn; };
__device__ __forceinline__ CJob get_job(const P& p, int j) {
    CJob c;
    if (j < 10) { const int l = j / 5, t = j % 5; bf16* wb = (bf16*)(p.ws + WS_WB) + (size_t)l * 1024 * 1536;
        if (t == 0) c = CJob{p.in[8] + (size_t)l * D * INC, D, l == 0 ? INC : 2560, (bf16*)(p.ws + WS_WIN) + (size_t)l * INC * D, D, 0, 3, INC};
        else if (t == 1) c = CJob{p.in[13] + (size_t)l * 256 * D, 256, D, wb, 1536, 512, 0};
        else if (t == 2) c = CJob{p.in[16] + (size_t)l * 512 * D, 512, D, wb, 1536, 768, 0};
        else if (t == 3) c = CJob{p.in[21] + (size_t)l * 256 * D, 256, D, wb, 1536, 1280, 0};
        else c = CJob{p.in[22] + (size_t)l * D * D, D, D, (bf16*)(p.ws + WS_WOUT) + (size_t)l * D * D, D, 0, 0}; }
    else if (j == 10) c = CJob{p.in[23], D, FFN, (bf16*)(p.ws + WS_FFN1), D, 0, 1};
    else if (j == 11) c = CJob{p.in[24], D, FFN, (bf16*)(p.ws + WS_FFN1), D, 0, 2};
    else c = CJob{p.in[25], FFN, D, (bf16*)(p.ws + WS_FFN2), FFN, 0, 0};
    return c;
}
__device__ __forceinline__ CJob get_moe_job(const P& p, int j) {
    const int e = j / 3, t = j % 3; CJob c;
    const float* sg = p.in[27]; const float* su = p.in[28]; const float* sd = p.in[29];
    asm volatile("" : "+s"(sg), "+s"(su), "+s"(sd));
    if (t == 0) c = CJob{sg + (size_t)e * D * FFN, D, FFN, (bf16*)(p.ws + WS_MOE1 + (size_t)e * 5632 * D), D, 0, 1};
    else if (t == 1) c = CJob{su + (size_t)e * D * FFN, D, FFN, (bf16*)(p.ws + WS_MOE1 + (size_t)e * 5632 * D), D, 0, 2};
    else c = CJob{sd + (size_t)e * FFN * D, FFN, D, (bf16*)(p.ws + WS_MOE2 + (size_t)e * D * FFN), FFN, 0, 0};
    return c;
}
template <bool MOE> __device__ __forceinline__ void run_conv_jobs(const P& p, LAS float* scr, int njobs, int bid, int nb) {
    int base = 0, base2 = 0;
    for (int j = 0; j < njobs; ++j) {
        const CJob jb = MOE ? get_moe_job(p, j) : get_job(p, j); const int nn = jb.N / 64, cnt = (jb.K / 64) * nn, ldn = jb.ldn ? jb.ldn : jb.N;
        const int first = ((bid - base) % nb + nb) % nb;
        if (MOE) { const int nn2 = jb.N / 128, cnt2 = (jb.K / 128) * nn2; const int first2 = ((bid - base2) % nb + nb) % nb;
            for (int i = first2; i < cnt2; i += nb) conv_tile128_f8(scr, jb.src, jb.N, (unsigned char*)jb.dst, jb.ldd, jb.mode, (i / nn2) * 128, (i % nn2) * 128);
            base2 += cnt2; }
        else for (int i = first; i < cnt; i += nb) conv_tile(scr, jb.src, ldn, (i / nn) * 64, (i % nn) * 64, jb.dst, jb.ldd, jb.koff, jb.mode);
        base += cnt;
    }
}
__device__ __forceinline__ void ph_prologue(const P& p, LAS unsigned char* lds) {
    const int tid = threadIdx.x, bid = blockIdx.x, nb = gridDim.x;
    const int gt = bid * NTHREADS + tid, ngt = nb * NTHREADS;
    LAS float* scr = (LAS float*)lds;
    run_conv_jobs<false>(p, scr, 13, bid, nb);
    __syncthreads();
    for (int i = bid; i < 512; i += nb) { const int l = i >> 8, t = i & 255;
        conv_tile128_f8(scr, p.in[8] + (size_t)l * D * INC + 2560, INC, p.ws + WS_WIN8 + (size_t)l * 4096 * 1024, 1024, 0, (t >> 5) * 128, (t & 31) * 128); }
    __syncthreads();
    {
        LAS float* tc = (LAS float*)lds; LAS float* tsn = tc + 64;
        __syncthreads();
        if (tid < 64) { tc[tid] = cospif(tid * (2.f / 64.f)); tsn[tid] = sinpif(tid * (2.f / 64.f)); }
        __syncthreads();
        const float s = 1.0f / sqrtf(64.f * 8192.f);
        for (int e = gt; e < 2 * 512 * 1024; e += ngt) {
            const int n = e & 1023, kk = (e >> 10) & 511, l = e >> 19;
            const int part = kk >> 8, g = (kk >> 6) & 3, c = kk & 63;
            const float* W = p.in[9] + (size_t)l * 256 * D + (size_t)(g * 64) * D + n;
            float acc = 0.f;
#pragma unroll
            for (int c2 = 0; c2 < 64; ++c2) { const int m = (c * c2) & 63; const float t = part == 0 ? tc[m] : -tsn[m]; acc += t * W[(size_t)c2 * D]; }
            ((bf16*)(p.ws + WS_WB))[(size_t)l * 1024 * 1536 + (size_t)n * 1536 + kk] = f2bf(acc * s);
        }
        __syncthreads();
    }
    {
        float* rc = (float*)(p.ws + WS_ROPE); float* rs = rc + SEQ * 32;
        for (int e = gt; e < SEQ * 32; e += ngt) {
            const int s = e >> 5, i = e & 31; const float inv = powf(10000.f, -(float)(i & 15) / 16.f);
            const float pos = (float)(i < 16 ? (s >> 6) : (s & 63)); const float ang = pos * inv;
            rc[e] = cosf(ang); rs[e] = sinf(ang);
        }
    }
    {
        bf16* F1 = (bf16*)(p.ws + WS_F1); bf16* F2 = (bf16*)(p.ws + WS_F2); bf16* FC = (bf16*)(p.ws + WS_FC);
        for (int e = gt; e < 256 * 256; e += ngt) {
            const int rho = e >> 8, n1 = e & 255; float v = 0.f;
            if (n1 < 128) { const int k1 = (rho >> 5) * 16 + (rho & 15), c = (rho >> 4) & 1, m = (k1 * n1) & 127; v = c == 0 ? cospif(m * (2.f / 128.f)) : -sinpif(m * (2.f / 128.f)); }
            F1[e] = f2bf(v);
            float w = 0.f;
            if (rho < 128 && n1 < 128) { const int c2 = rho >> 6, k2 = rho & 63, c = n1 >> 6, n2 = n1 & 63, m = (k2 * n2) & 63; const float cs = cospif(m * (2.f / 64.f)), sn = sinpif(m * (2.f / 64.f));
                w = c2 == 0 ? (c == 0 ? cs : sn) : (c == 0 ? sn : -cs); }
            F2[e] = f2bf(w);
        }
        float* TW = (float*)(p.ws + WS_TW);
        for (int e = gt; e < 128 * 64; e += ngt) { const int k1 = e >> 6, n2 = e & 63; TW[2 * e] = cospif((k1 * n2) * (2.f / 8192.f)); TW[2 * e + 1] = sinpif((k1 * n2) * (2.f / 8192.f)); }
        const float sc = sqrtf(32.f);
        for (int e = gt; e < 512 * 256; e += ngt) { const int rho = e >> 8, n = e & 255, c2 = rho >> 8, k = rho & 255, m = (k * n) & 255; FC[e] = f2bf(sc * (c2 == 0 ? cospif(m * (2.f / 256.f)) : sinpif(m * (2.f / 256.f)))); }
    }
    {
        LAS float* sv = (LAS float*)lds;
        LAS float* red = sv + 3 * 1024;
        __syncthreads();
        for (int e = tid; e < 3 * 1024; e += NTHREADS) { const int j = e >> 10, k = e & 1023; const float v = j < 2 ? p.in[1][j * D + k] : p.in[3][k]; sv[e] = siluf_(v); }
        __syncthreads();
        const int kq = tid >> 6, cl = tid & 63;
        for (int it = bid; it < 2 * 96; it += nb) {
            const int l = it / 96, n = (it % 96) * 64 + cl;
            const float* W = p.in[4] + (size_t)l * D * 6144 + n;
            float a0 = 0.f, a1 = 0.f, a2 = 0.f;
#pragma unroll 32
            for (int k = kq; k < D; k += 8) { const float w = W[(size_t)k * 6144]; a0 += sv[k] * w; a1 += sv[1024 + k] * w; a2 += sv[2048 + k] * w; }
            red[(kq * 3 + 0) * 64 + cl] = a0; red[(kq * 3 + 1) * 64 + cl] = a1; red[(kq * 3 + 2) * 64 + cl] = a2;
            __syncthreads();
            if (tid < 192) { const int j = tid >> 6; float s = 0.f;
#pragma unroll
                for (int q = 0; q < 8; ++q) s += red[(q * 3 + j) * 64 + cl];
                ((float*)(p.ws + WS_MODS))[(size_t)(l * 3 + j) * 6144 + n] = s + p.in[5][l * 6144 + n]; }
            __syncthreads();
        }
    }
}
__device__ __forceinline__ void ph_moe_convert(const P& p, LAS unsigned char* lds) {
    LAS float* scr = (LAS float*)lds;
    const int bid = blockIdx.x, nb = gridDim.x;
    run_conv_jobs<true>(p, scr, 24, bid, nb);
    __syncthreads();
}

__device__ __forceinline__ void ph_norm(const P& p, LAS unsigned char* lds, int layer, int which, bool first, bool route, int nrows, bool copy = true) {
    LAS unsigned* cnt_lds = (LAS unsigned*)lds;
    if (route) { __syncthreads(); if (threadIdx.x < NEXP) cnt_lds[threadIdx.x] = 0u; __syncthreads(); }
    const int lane = threadIdx.x & 63, gw = blockIdx.x * 8 + (threadIdx.x >> 6), ngw = gridDim.x * 8;
    const float* gain = p.in[which == 0 ? 6 : 7] + layer * D;
    bf16* A = (bf16*)(p.ws + WS_A);
    for (int r = gw; r < nrows; r += ngw) {
        const int mi = row_mi(r);
        const float* src = first ? (r < NLAT ? p.in[0] + (size_t)r * D : p.in[2] + (size_t)(r - NLAT) * D) : hrow(p, r);
        const float* shift = mods(p, layer, mi, which == 0 ? 0 : 3); const float* scale = mods(p, layer, mi, which == 0 ? 1 : 4);
        f32x4 v[4]; float ss = 0.f;
#pragma unroll
        for (int j = 0; j < 4; ++j) { v[j] = *(const f32x4*)(src + 4 * lane + 256 * j); ss += v[j].x * v[j].x + v[j].y * v[j].y + v[j].z * v[j].z + v[j].w * v[j].w; }
        if (first && copy) { float* h = hrow(p, r);
#pragma unroll
            for (int j = 0; j < 4; ++j) *(f32x4*)(h + 4 * lane + 256 * j) = v[j]; }
        const float rstd = rsqrtf(wave_sum(ss) * (1.f / D) + EPS);
        float lg[8];
#pragma unroll
        for (int e = 0; e < 8; ++e) lg[e] = 0.f;
#pragma unroll
        for (int j = 0; j < 4; ++j) {
            const int c = 4 * lane + 256 * j;
            const f32x4 g = *(const f32x4*)(gain + c), sc = *(const f32x4*)(scale + c), sh = *(const f32x4*)(shift + c);
            f32x4 y = v[j] * rstd * g * (sc + 1.f) + sh;
            u32x2 o; o.x = pk2(y.x, y.y); o.y = pk2(y.z, y.w);
            if (!route) *(u32x2*)(A + (size_t)r * D + c) = o;
            if ((which == 0 || route) && r < NLAT) *(unsigned*)(p.ws + WS_A8 + (size_t)r * D + c) = pk4_fp8(y.x, y.y, y.z, y.w);
            if (route) {
                const float* rw = p.in[26] + (size_t)c * 8;
#pragma unroll
                for (int q = 0; q < 4; ++q) { const f32x4 w0 = *(const f32x4*)(rw + q * 8), w1 = *(const f32x4*)(rw + q * 8 + 4); const float yy = y[q];
                    lg[0] += yy * w0.x; lg[1] += yy * w0.y; lg[2] += yy * w0.z; lg[3] += yy * w0.w; lg[4] += yy * w1.x; lg[5] += yy * w1.y; lg[6] += yy * w1.z; lg[7] += yy * w1.w; }
            }
        }
        if (route) {
#pragma unroll
            for (int e = 0; e < 8; ++e) lg[e] = wave_sum(lg[e]);
            if (lane == 0) {
                int e0 = 0; float v0 = lg[0];
#pragma unroll
                for (int e = 1; e < 8; ++e) if (lg[e] > v0) { v0 = lg[e]; e0 = e; }
                int e1 = -1; float v1 = -INFINITY;
#pragma unroll
                for (int e = 0; e < 8; ++e) if (e != e0 && lg[e] > v1) { v1 = lg[e]; e1 = e; }
                const float w0 = 1.f / (1.f + expf(v1 - v0));
                int* tok_e = (int*)(p.ws + WS_ROUTE); float* tok_w = (float*)(p.ws + WS_ROUTE) + 16384 * 2;
                tok_e[r * 2] = e0; tok_e[r * 2 + 1] = e1; tok_w[r * 2] = w0; tok_w[r * 2 + 1] = 1.f - w0;
                __hip_atomic_fetch_add(cnt_lds + e0, 1u, __ATOMIC_RELAXED, __HIP_MEMORY_SCOPE_WORKGROUP); __hip_atomic_fetch_add(cnt_lds + e1, 1u, __ATOMIC_RELAXED, __HIP_MEMORY_SCOPE_WORKGROUP);
            }
        }
    }
    if (route) { __syncthreads(); if (threadIdx.x < NEXP) ((unsigned*)(p.ws + WS_ROUTE) + 16384 * 6)[blockIdx.x * NEXP + threadIdx.x] = cnt_lds[threadIdx.x]; __syncthreads(); }
}

__device__ __forceinline__ void norm_row(const P& p, int layer, int which, int r, int lane) {
    const float* gain = p.in[which == 0 ? 6 : 7] + layer * D; bf16* A = (bf16*)(p.ws + WS_A);
    const int mi = row_mi(r); const float* src = hrow(p, r);
    const float* shift = mods(p, layer, mi, which == 0 ? 0 : 3); const float* scale = mods(p, layer, mi, which == 0 ? 1 : 4);
    f32x4 v[4]; float ss = 0.f;
#pragma unroll
    for (int j = 0; j < 4; ++j) { v[j] = *(const f32x4*)(src + 4 * lane + 256 * j); ss += v[j].x * v[j].x + v[j].y * v[j].y + v[j].z * v[j].z + v[j].w * v[j].w; }
    const float rstd = rsqrtf(wave_sum(ss) * (1.f / D) + EPS);
#pragma unroll
    for (int j = 0; j < 4; ++j) { const int c = 4 * lane + 256 * j;
        const f32x4 g = *(const f32x4*)(gain + c), sc = *(const f32x4*)(scale + c), sh = *(const f32x4*)(shift + c);
        const f32x4 y = v[j] * rstd * g * (sc + 1.f) + sh;
        u32x2 o; o.x = pk2(y.x, y.y); o.y = pk2(y.z, y.w);
        *(u32x2*)(A + (size_t)r * D + c) = o; }
}

namespace fg {
typedef short bf16x8 __attribute__((ext_vector_type(8)));
constexpr int BM = 256, BK = 64, HALF = 128, HTB = HALF * BK * 2, STAGE_BYTES = 8 * HTB, NXCD = 8, WGM = 8;
__device__ __forceinline__ int lds_byte(int r, int c) { const int st = (r >> 4) * 2 + (c >> 5), rr = r & 15, cc = c & 31, ob = rr * 64 + cc * 2; return st * 1024 + (ob ^ (((ob >> 9) & 1) << 5)); }
__device__ __forceinline__ void stage_rc(int b, int& R, int& C) { const int st = b / 1024, sb = b % 1024, swz = sb ^ (((sb >> 9) & 1) << 5); R = (st >> 1) * 16 + swz / 64; C = (st & 1) * 32 + (swz % 64) / 2; }
__device__ __forceinline__ int perm32(int rho) { const int n = rho >> 4, i = rho & 15; return 8 * (i >> 2) + 4 * n + (i & 3); }
struct Unit { int pm, pn; const char* A; const char* B; int nt, aux; };
__device__ __forceinline__ bool tile_order(int i, int nM, int nN, int G, int c, int& pm, int& pn) {
    const int nwg = nM * nN; const long L = (long)i * G + c; if (L >= nwg) return false;
    int wgid = (int)L; { const int q = nwg / NXCD, r = nwg % NXCD, xcd = wgid % NXCD, off = wgid / NXCD; wgid = (xcd < r ? xcd * (q + 1) : r * (q + 1) + (xcd - r) * q) + off; }
    const int nig = WGM * nN, gid = wgid / nig, fm = gid * WGM, gsz = (nM - fm) < WGM ? (nM - fm) : WGM;
    pm = fm + ((wgid % nig) % gsz); pn = (wgid % nig) / gsz; return true;
}
struct PlainSched {
    const char* Abase; const char* Bbase; int lda, ldb, nM, nN, G, c, nt;
    __device__ __forceinline__ int arow(int R) const { return R; }
    __device__ __forceinline__ int ahalf() const { return HALF; }
    __device__ __forceinline__ bool next(int i, Unit& u) const { if (!tile_order(i, nM, nN, G, c, u.pm, u.pn)) return false;
        u.A = Abase + (size_t)u.pm * BM * lda * 2; u.B = Bbase + (size_t)u.pn * BM * ldb * 2; u.nt = nt; u.aux = 0; return true; }
};
struct ExpertSched {
    const char* Abase; const char* Bbase; int lda, ldb, nM, nN, G, c, nt; const LAS int* tile_e; size_t estride;
    __device__ __forceinline__ int arow(int R) const { return R; }
    __device__ __forceinline__ int ahalf() const { return HALF; }
    __device__ __forceinline__ bool next(int i, Unit& u) const { if (!tile_order(i, nM, nN, G, c, u.pm, u.pn)) return false;
        u.A = Abase + (size_t)u.pm * BM * lda * 2; u.B = Bbase + (size_t)tile_e[u.pm] * estride + (size_t)u.pn * BM * ldb * 2; u.nt = nt; u.aux = 0; return true; }
};
struct WinSched {
    const char* Abase; const char* Bbase; int G, c, mode, nN;
    __device__ __forceinline__ int arow(int R) const { return mode == 0 ? 256 * (R & 15) + 64 * ((R >> 4) & 3) + (R >> 6) : R; }
    __device__ __forceinline__ int ahalf() const { return mode == 0 ? 4096 : HALF; }
    __device__ __forceinline__ bool next(int i, Unit& u) const { if (!tile_order(i, mode == 0 ? 64 : 2, nN, G, c, u.pm, u.pn)) return false;
        const size_t row0 = mode == 0 ? (size_t)((u.pm >> 5) * SEQ + 2 * (u.pm & 31)) : (size_t)(NLAT + u.pm * CTX);
        u.A = Abase + row0 * D * 2; u.B = Bbase + (size_t)u.pn * BM * D * 2; u.nt = D / 64; u.aux = mode; return true; }
};
struct MergeSched {
    const char* Xbase; const char* Wbase; int nM, G, c;
    __device__ __forceinline__ int arow(int R) const { return R; }
    __device__ __forceinline__ int ahalf() const { return HALF; }
    __device__ __forceinline__ bool next(int i, Unit& u) const { if (!tile_order(i >> 2, nM, 4, G, c, u.pm, u.pn)) return false;
        const int br = i & 3, koff = br == 0 ? 0 : (br == 1 ? 512 : (br == 2 ? 768 : 1280));
        u.A = Xbase + ((size_t)u.pm * BM * 1536 + koff) * 2; u.B = Wbase + ((size_t)u.pn * BM * 1536 + koff) * 2; u.nt = (br & 1) ? 4 : 8; u.aux = br; return true; }
};
template <class E, class = void> struct is_chain { static constexpr bool v = false; };
template <class E> struct is_chain<E, decltype((void)E::CHAIN)> { static constexpr bool v = E::CHAIN; };
typedef f32x4 Acc[2][2][4][2];
typedef int i32x4 __attribute__((ext_vector_type(4))); typedef int i32x8 __attribute__((ext_vector_type(8)));
__device__ __forceinline__ i32x8 ld32(const LAS unsigned char* p) { const i32x4 a = *(const LAS i32x4*)p, b = *(const LAS i32x4*)(p + 16); return __builtin_shufflevector(a, b, 0, 1, 2, 3, 4, 5, 6, 7); }
template <class Epi, class Sched, bool F8 = false>
__device__ __forceinline__ void gemm_phase(LAS unsigned char* lds, int lda, int ldb, const Sched& S, const Epi& E) {
    int tid_ = threadIdx.x; asm volatile("" : "+v"(tid_));
    const int tid = tid_, wid = __builtin_amdgcn_readfirstlane(tid >> 6), lane = tid & 63, wr = wid >> 2, wc = wid & 3, fr = lane & 15, fq = lane >> 4;
    unsigned voffA[2], voffB[2];
#pragma unroll
    for (int i = 0; i < 2; ++i) { int R, C; stage_rc(tid * 16 + i * 8192, R, C); const int Rb = Epi::PERM ? ((R & ~31) + perm32(R & 31)) : R;
        voffA[i] = (unsigned)(S.arow(R) * lda + C) * 2u; voffB[i] = (unsigned)(Rb * ldb + C) * 2u; }
    const size_t kstep = (size_t)(BK * 2);
    const size_t hstepA = (size_t)S.ahalf() * lda * 2, hstepB = (size_t)HALF * ldb * 2;
    const unsigned ldsw = (unsigned)wid * 1024u;
    const int aoff = lds_byte(wr * 64 + fr, F8 ? fq * 16 : fq * 8), boff = lds_byte(wc * 32 + fr, F8 ? fq * 16 : fq * 8);
#define FG_SA(b, h) (((b) * 2 + (h)) * HTB)
#define FG_SB(b, h) ((4 + (b) * 2 + (h)) * HTB)
#define FG_STAGE(bufoff, gbase, voff) do { _Pragma("unroll") for (int _i = 0; _i < 2; ++_i) \
        __builtin_amdgcn_global_load_lds((const unsigned*)((const char*)(gbase) + (voff)[_i]), (LAS unsigned*)(lds + (bufoff) + ldsw + _i * 8192), 16, 0, 0); } while (0)
#define FG_LDA(dst, b, h) do { if constexpr (F8) { _Pragma("unroll") for (int m = 0; m < 4; ++m) dst##8[m] = ld32(lds + FG_SA(b, h) + aoff + m * 2048); } \
        else { _Pragma("unroll") for (int m = 0; m < 4; ++m) _Pragma("unroll") for (int k = 0; k < 2; ++k) dst[m][k] = *(const LAS bf16x8*)(lds + FG_SA(b, h) + aoff + m * 2048 + k * 1024); } } while (0)
#define FG_LDB(dst, b, h) do { if constexpr (F8) { _Pragma("unroll") for (int n = 0; n < 2; ++n) dst##8[n] = ld32(lds + FG_SB(b, h) + boff + n * 2048); } \
        else { _Pragma("unroll") for (int n = 0; n < 2; ++n) _Pragma("unroll") for (int k = 0; k < 2; ++k) dst[n][k] = *(const LAS bf16x8*)(lds + FG_SB(b, h) + boff + n * 2048 + k * 1024); } } while (0)
#define FG_MMA(ai, bj, At, Bt) do { __builtin_amdgcn_s_setprio(1); _Pragma("unroll") for (int m = 0; m < 4; ++m) _Pragma("unroll") for (int n = 0; n < 2; ++n) { \
        if constexpr (F8) asm volatile("v_mfma_scale_f32_16x16x128_f8f6f4 %0, %1, %2, %0, %3, %4 op_sel_hi:[0,0,0]" : "+v"(acc[ai][bj][m][n]) : "v"(Bt##8[n]), "v"(At##8[m]), "v"(scw), "v"(sca)); \
        else { _Pragma("unroll") for (int k = 0; k < 2; ++k) acc[ai][bj][m][n] = __builtin_amdgcn_mfma_f32_16x16x32_bf16(Bt[n][k], At[m][k], acc[ai][bj][m][n], 0, 0, 0); } } \
        __builtin_amdgcn_s_setprio(0); } while (0)
#define FG_WAIT_V(n) asm volatile("s_waitcnt vmcnt(" #n ")" ::: "memory")
#define FG_WAIT_L(n) asm volatile("s_waitcnt lgkmcnt(" #n ")" ::: "memory")
#define FG_BAR __builtin_amdgcn_s_barrier()
#define FG_SCHED __builtin_amdgcn_sched_barrier(0)
    Unit cur, nxt; int ui = 0;
    if (!S.next(0, cur)) return;
    Acc acc;
#pragma unroll
    for (int a = 0; a < 2; ++a)
#pragma unroll
        for (int b = 0; b < 2; ++b)
#pragma unroll
            for (int m = 0; m < 4; ++m)
#pragma unroll
                for (int n = 0; n < 2; ++n) acc[a][b][m][n] = (f32x4){0.f, 0.f, 0.f, 0.f};
    bf16x8 At[4][2], B0[2][2], B1[2][2]; i32x8 At8[4], B08[2], B18[2];
    const int scw = 0x7a7a7a7a, sca = 0x7f7f7f7f;
    const char* cA = cur.A; const char* cB = cur.B;
    FG_STAGE(FG_SB(0, 0), cB, voffB); FG_STAGE(FG_SB(0, 1), cB + hstepB, voffB); FG_STAGE(FG_SA(0, 0), cA, voffA); FG_STAGE(FG_SA(0, 1), cA + hstepA, voffA);
    if (wr == 1) FG_BAR;
    FG_WAIT_V(2); FG_BAR;
    FG_STAGE(FG_SB(1, 0), cB + kstep, voffB); FG_STAGE(FG_SA(1, 0), cA + kstep, voffA); FG_STAGE(FG_SB(1, 1), cB + hstepB + kstep, voffB);
    FG_WAIT_V(6); FG_BAR;
    for (;;) {
        const bool has_next = S.next(ui + 1, nxt);
        const char* nA = has_next ? nxt.A : cA; const char* nB = has_next ? nxt.B : cB;
        const int nt = cur.nt;
#pragma unroll 1
        for (int t = 0; t < nt; t += 2) {
            const bool last = (t == nt - 2);
            const char* a1 = cA + (size_t)(t + 1) * kstep;
            const char* a2 = last ? nA : cA + (size_t)(t + 2) * kstep; const char* b2 = last ? nB : cB + (size_t)(t + 2) * kstep;
            const char* a3 = a2 + kstep; const char* b3 = b2 + kstep;
            FG_LDB(B0, 0, 0); FG_LDB(B1, 0, 1); FG_SCHED; FG_LDA(At, 0, 0); FG_STAGE(FG_SA(1, 1), a1 + hstepA, voffA);
            FG_WAIT_V(8); FG_WAIT_L(0); FG_BAR; FG_MMA(0, 0, At, B0); FG_MMA(0, 1, At, B1); FG_BAR; FG_SCHED;
            FG_LDA(At, 0, 1); FG_STAGE(FG_SB(0, 0), b2, voffB); FG_STAGE(FG_SB(0, 1), b2 + hstepB, voffB); FG_STAGE(FG_SA(0, 0), a2, voffA);
            FG_WAIT_V(8); FG_WAIT_L(0); FG_BAR; FG_MMA(1, 0, At, B0); FG_MMA(1, 1, At, B1); FG_BAR; FG_SCHED;
            FG_LDB(B0, 1, 0); FG_LDB(B1, 1, 1); FG_SCHED; FG_LDA(At, 1, 0); FG_STAGE(FG_SA(0, 1), a2 + hstepA, voffA);
            FG_WAIT_V(8); FG_WAIT_L(0); FG_BAR; FG_MMA(0, 0, At, B0); FG_MMA(0, 1, At, B1); FG_BAR; FG_SCHED;
            FG_LDA(At, 1, 1); FG_STAGE(FG_SB(1, 0), b3, voffB); FG_STAGE(FG_SB(1, 1), b3 + hstepB, voffB); FG_STAGE(FG_SA(1, 0), a3, voffA);
            FG_WAIT_V(8); FG_WAIT_L(0); FG_BAR; FG_MMA(1, 0, At, B0); FG_MMA(1, 1, At, B1); FG_BAR; FG_SCHED;
        }
        if (wr == 0) FG_BAR;
        E(acc, cur, wr, wc, fr, fq);
        if (!has_next) break;
        if (!(is_chain<Epi>::v && cur.aux != 3)) {
#pragma unroll
        for (int a = 0; a < 2; ++a)
#pragma unroll
            for (int b = 0; b < 2; ++b)
#pragma unroll
                for (int m = 0; m < 4; ++m)
#pragma unroll
                    for (int n = 0; n < 2; ++n) acc[a][b][m][n] = (f32x4){0.f, 0.f, 0.f, 0.f};
        }
        cur = nxt; cA = nA; cB = nB; ++ui;
        if (wr == 1) FG_BAR;
    }
    FG_WAIT_V(0);
    FG_BAR;
#undef FG_SA
#undef FG_SB
#undef FG_STAGE
#undef FG_LDA
#undef FG_LDB
#undef FG_MMA
#undef FG_WAIT_V
#undef FG_WAIT_L
#undef FG_BAR
#undef FG_SCHED
}
__device__ __forceinline__ unsigned cvt_pk(float lo, float hi) { unsigned r; asm volatile("v_cvt_pk_bf16_f32 %0, %1, %2" : "=v"(r) : "v"(lo), "v"(hi)); return r; }
__device__ __forceinline__ u32x4 pack8(const f32x4 a, const f32x4 b) { u32x4 w; w.x = cvt_pk(a[0], a[1]); w.y = cvt_pk(a[2], a[3]); w.z = cvt_pk(b[0], b[1]); w.w = cvt_pk(b[2], b[3]); return w; }
__device__ __forceinline__ f32x4 unpk_u8(unsigned x) { const float k = 1.f / 255.f; return (f32x4){(float)(x & 0xffu) * k, (float)((x >> 8) & 0xffu) * k, (float)((x >> 16) & 0xffu) * k, (float)(x >> 24) * k}; }
__device__ __forceinline__ f32x4 unpk_u8r(unsigned x) { return (f32x4){(float)(x & 0xffu), (float)((x >> 8) & 0xffu), (float)((x >> 16) & 0xffu), (float)(x >> 24)}; }
__device__ __forceinline__ f32x4 unpk_lo(unsigned x, unsigned y) { return (f32x4){__uint_as_float(x << 16), __uint_as_float(x & 0xffff0000u), __uint_as_float(y << 16), __uint_as_float(y & 0xffff0000u)}; }

struct EpiWin {
    static constexpr bool PERM = true;
    unsigned char* ws; const float* qg; const float* kg;
    __device__ __forceinline__ void operator()(const Acc& acc, const Unit& u, int wr, int wc, int fr_, int fq_) const {
        int fr = fr_, fq = fq_; asm volatile("" : "+v"(fr), "+v"(fq));
        const int tile = u.pn; const bool LAT = u.aux == 0;
        if (tile == 0) {
            if (LAT) {
                const int b = u.pm >> 5, n2 = 2 * (u.pm & 31) + wr;
#pragma unroll
                for (int ai = 0; ai < 2; ++ai)
#pragma unroll
                    for (int bj = 0; bj < 2; ++bj) {
#pragma unroll
                        for (int n = 0; n < 2; ++n)
#pragma unroll
                            for (int e = 0; e < 4; ++e) { const int ch = bj * HALF + wc * 32 + 8 * fq + 4 * n + e;
                                u32x2 o; o.x = cvt_pk(acc[ai][bj][0][n][e], acc[ai][bj][1][n][e]); o.y = cvt_pk(acc[ai][bj][2][n][e], acc[ai][bj][3][n][e]);
                                *(u32x2*)((bf16*)(ws + WS_UT) + ((size_t)(b * 256 + ch) * 64 + n2) * 256 + 64 * ai + 4 * fr) = o; }
                        asm volatile("" ::: "memory"); }
            } else {
#pragma unroll
                for (int ai = 0; ai < 2; ++ai)
#pragma unroll
                    for (int m = 0; m < 4; ++m) { const int sx = ai * HALF + wr * 64 + m * 16 + fr;
#pragma unroll
                        for (int bj = 0; bj < 2; ++bj)
#pragma unroll
                            for (int n = 0; n < 2; ++n)
#pragma unroll
                                for (int e = 0; e < 4; ++e) { const int ch = bj * HALF + wc * 32 + 8 * fq + 4 * n + e;
                                    ((bf16*)(ws + WS_UTC))[(size_t)(u.pm * 256 + ch) * 256 + sx] = f2bf(acc[ai][bj][m][n][e]); }
                        asm volatile("" ::: "memory"); }
            }
            return;
        }
        const bool ropek = tile == 1 || tile == 2 || tile == 5 || tile == 6 || (tile == 7 && wc < 2);
        const bool keyrow = tile == 7;
        size_t boff; int pitch, col0;
        if (tile <= 4) { boff = WS_RETQ + (size_t)(tile - 1) * MROWS * 256 * 2; pitch = 256; col0 = ropek ? wc * 64 : wc * 32; }
        else if (tile <= 6) { boff = WS_ATTQ; pitch = 512; col0 = (tile - 5) * 256 + wc * 64; }
        else if (tile == 7) { boff = wc < 2 ? WS_ATTK : WS_ATTV; pitch = 128; col0 = (wc & 1) * 64; }
        else if (tile < 10) { boff = WS_CONV; pitch = 512; col0 = (tile - 8) * 256 + wc * 32; }
        else { boff = WS_G; pitch = 4096; col0 = (tile - 10) * 256 + wc * 32; }
        const bool head = ropek || tile == 7;
        bf16* const dbase = (bf16*)(ws + boff);
        const bool norm = tile >= 5 && ropek;
        const float* gp = tile == 7 ? kg : qg;
        const float osc = tile == 2 ? 0.125f : (tile == 5 || tile == 6 ? QSCALE : 1.f);
        const float* rc = (const float*)(ws + WS_ROPE);
#pragma unroll
        for (int ai = 0; ai < 2; ++ai) {
            f32x4 rcs[4][2], rsn[4][2];
            if (ropek && LAT) {
#pragma unroll
                for (int m = 0; m < 4; ++m)
#pragma unroll
                    for (int bj = 0; bj < 2; ++bj) { const int sx = 4096 * ai + 256 * fr + 64 * m + 2 * (u.pm & 31) + wr, i0 = 16 * bj + 4 * fq;
                        rcs[m][bj] = *(const f32x4*)(rc + sx * 32 + i0); rsn[m][bj] = *(const f32x4*)(rc + SEQ * 32 + sx * 32 + i0); } }
#pragma unroll
            for (int m = 0; m < 4; ++m) {
                const int b = LAT ? (u.pm >> 5) : u.pm, s = LAT ? (4096 * ai + 256 * fr + 64 * m + 2 * (u.pm & 31) + wr) : (ai * HALF + wr * 64 + m * 16 + fr);
                const int rr = keyrow ? b * KEYS + (LAT ? CTX + s : s) : (LAT ? b * SEQ + s : NLAT + b * CTX + s);
                bf16* const drow = dbase + ((size_t)rr * pitch + col0 + 8 * fq);
                if (ropek) {
                    float rstd = 1.f;
                    if (norm) { float ss = 0.f;
#pragma unroll
                        for (int bj = 0; bj < 2; ++bj)
#pragma unroll
                            for (int n = 0; n < 2; ++n) { const f32x4 x = acc[ai][bj][m][n]; ss += (x[0] * x[0] + x[1] * x[1]) + (x[2] * x[2] + x[3] * x[3]); }
                        ss += __shfl_xor(ss, 16); ss += __shfl_xor(ss, 32);
                        rstd = rsqrtf(ss * (1.f / 64.f) + EPS); }
#pragma unroll
                    for (int bj = 0; bj < 2; ++bj) {
                        const int i0 = 16 * bj + 4 * fq;
                        f32x4 x1 = acc[ai][bj][m][0], x2 = acc[ai][bj][m][1];
                        if (norm) { const f32x4 g1 = *(const f32x4*)(gp + i0), g2 = *(const f32x4*)(gp + 32 + i0); x1 = x1 * rstd * g1; x2 = x2 * rstd * g2; }
                        f32x4 o1 = x1, o2 = x2;
                        if (LAT) { const f32x4 cs = rcs[m][bj], sn = rsn[m][bj]; o1 = x1 * cs - x2 * sn; o2 = x1 * sn + x2 * cs; }
                        *(u32x4*)(drow + 32 * bj) = pack8(o1 * osc, o2 * osc);
                    }
                } else {
#pragma unroll
                    for (int bj = 0; bj < 2; ++bj) {
                        f32x4 a0 = acc[ai][bj][m][0], a1 = acc[ai][bj][m][1];
                        if (tile >= 10) {
                            u32x2 o; o.x = 0u; o.y = 0u;
#pragma unroll
                            for (int e = 0; e < 4; ++e) { o.x = __builtin_amdgcn_cvt_pk_u8_f32(__builtin_fmaxf(__builtin_floorf(sigmoid_fast(a0[e]) * 255.f + 0.5f), 1.f), e, o.x);
                                o.y = __builtin_amdgcn_cvt_pk_u8_f32(__builtin_fmaxf(__builtin_floorf(sigmoid_fast(a1[e]) * 255.f + 0.5f), 1.f), e, o.y); }
                            *(u32x2*)(ws + WS_G + (size_t)rr * 4096 + (tile - 10) * 256 + wc * 32 + 8 * fq + HALF * bj) = o;
                        } else *(u32x4*)(drow + (head ? 32 : HALF) * bj) = pack8(a0, a1);
                    }
                }
            }
        }
    }
};
struct EpiGate8 {
    static constexpr bool PERM = true;
    unsigned char* G;
    __device__ __forceinline__ void operator()(const Acc& acc, const Unit& u, int wr, int wc, int fr_, int fq_) const {
        int fr = fr_, fq = fq_; asm volatile("" : "+v"(fr), "+v"(fq));
#pragma unroll
        for (int ai = 0; ai < 2; ++ai)
#pragma unroll
            for (int m = 0; m < 4; ++m) { const int r = u.pm * BM + ai * HALF + wr * 64 + m * 16 + fr;
#pragma unroll
                for (int bj = 0; bj < 2; ++bj) { const f32x4 a0 = acc[ai][bj][m][0], a1 = acc[ai][bj][m][1]; u32x2 o; o.x = 0u; o.y = 0u;
#pragma unroll
                    for (int e = 0; e < 4; ++e) { o.x = __builtin_amdgcn_cvt_pk_u8_f32(__builtin_fmaxf(__builtin_floorf(sigmoid_fast(a0[e]) * 255.f + 0.5f), 1.f), e, o.x);
                        o.y = __builtin_amdgcn_cvt_pk_u8_f32(__builtin_fmaxf(__builtin_floorf(sigmoid_fast(a1[e]) * 255.f + 0.5f), 1.f), e, o.y); }
                    *(u32x2*)(G + (size_t)r * 4096 + u.pn * BM + bj * HALF + wc * 32 + 8 * fq) = o; } }
    }
};
struct EpiMerge {
    static constexpr bool PERM = true, CHAIN = true;
    const unsigned char* G; bf16* Mg;
    __device__ __forceinline__ void operator()(Acc& acc, const Unit& u, int wr, int wc, int fr_, int fq_) const {
        int fr = fr_, fq = fq_; asm volatile("" : "+v"(fr), "+v"(fq));
        const int br = u.aux; const bool lastb = br == 3;
#pragma unroll
        for (int ai = 0; ai < 2; ++ai) {
            u32x2 g[4][2], gn[4][2];
#pragma unroll
            for (int m = 0; m < 4; ++m)
#pragma unroll
                for (int bj = 0; bj < 2; ++bj) { const int r = u.pm * BM + ai * HALF + wr * 64 + m * 16 + fr, c = u.pn * BM + bj * HALF + wc * 32 + 8 * fq;
                    g[m][bj] = *(const u32x2*)(G + (size_t)r * 4096 + br * 1024 + c);
                    if (!lastb) gn[m][bj] = *(const u32x2*)(G + (size_t)r * 4096 + (br + 1) * 1024 + c); }
#pragma unroll
            for (int m = 0; m < 4; ++m)
#pragma unroll
                for (int bj = 0; bj < 2; ++bj) {
                    if (!lastb) {
                        const f32x4 n0 = unpk_u8r(g[m][bj].x), n1 = unpk_u8r(g[m][bj].y), d0 = unpk_u8r(gn[m][bj].x), d1 = unpk_u8r(gn[m][bj].y);
#pragma unroll
                        for (int e = 0; e < 4; ++e) { acc[ai][bj][m][0][e] *= n0[e] * __builtin_amdgcn_rcpf(d0[e]); acc[ai][bj][m][1][e] *= n1[e] * __builtin_amdgcn_rcpf(d1[e]); }
                    } else { const int r = u.pm * BM + ai * HALF + wr * 64 + m * 16 + fr, c = u.pn * BM + bj * HALF + wc * 32 + 8 * fq;
                        *(u32x4*)(Mg + (size_t)r * 1024 + c) = pack8(acc[ai][bj][m][0] * unpk_u8(g[m][bj].x), acc[ai][bj][m][1] * unpk_u8(g[m][bj].y)); } }
        }
    }
};
struct EpiResid {
    static constexpr bool PERM = false;
    float* out; float* hctx; const float* modbase; int chunk;
    __device__ __forceinline__ void operator()(const Acc& acc, const Unit& u, int wr, int wc, int fr_, int fq_) const {
        int fr = fr_, fq = fq_; asm volatile("" : "+v"(fr), "+v"(fq));
        const int rt = u.pm * BM;
        const float* g = modbase + ((size_t)row_mi(rt) * 6 + chunk) * D;
        f32x4 gg[2][2];
#pragma unroll
        for (int bj = 0; bj < 2; ++bj)
#pragma unroll
            for (int n = 0; n < 2; ++n) gg[bj][n] = *(const f32x4*)(g + u.pn * BM + bj * HALF + wc * 32 + 16 * n + 4 * fq);
#pragma unroll
        for (int ai = 0; ai < 2; ++ai) {
            f32x4 hv[4][2][2];
#pragma unroll
            for (int m = 0; m < 4; ++m) { const int r = rt + ai * HALF + wr * 64 + m * 16 + fr; const float* h = r < NLAT ? out + (size_t)r * D : hctx + (size_t)(r - NLAT) * D;
#pragma unroll
                for (int bj = 0; bj < 2; ++bj)
#pragma unroll
                    for (int n = 0; n < 2; ++n) hv[m][bj][n] = *(const f32x4*)(h + u.pn * BM + bj * HALF + wc * 32 + 16 * n + 4 * fq); }
#pragma unroll
            for (int m = 0; m < 4; ++m) { const int r = rt + ai * HALF + wr * 64 + m * 16 + fr; float* h = r < NLAT ? out + (size_t)r * D : hctx + (size_t)(r - NLAT) * D;
#pragma unroll
                for (int bj = 0; bj < 2; ++bj)
#pragma unroll
                    for (int n = 0; n < 2; ++n) *(f32x4*)(h + u.pn * BM + bj * HALF + wc * 32 + 16 * n + 4 * fq) = hv[m][bj][n] + gg[bj][n] * acc[ai][bj][m][n]; }
        }
    }
};
struct EpiResidNorm {
    static constexpr bool PERM = false;
    const float* hin; float* out; const float* modbase; int chunk;
    const float* gain; const float* nmods; int csh, csc; bf16* A; unsigned char* A8;
    float* xbuf; unsigned* cnt; unsigned* tmo; LAS unsigned char* lds;
    __device__ __forceinline__ void operator()(Acc& acc, const Unit& u, int wr, int wc, int fr_, int fq_) const {
        int fr = fr_, fq = fq_; asm volatile("" : "+v"(fr), "+v"(fq));
        const int wid = __builtin_amdgcn_readfirstlane((int)threadIdx.x >> 6), lane = threadIdx.x & 63;
        const int rt = u.pm * BM, mi = row_mi(rt);
        LAS float* Pt = (LAS float*)(lds + STAGE_BYTES);
        LAS float* St = (LAS float*)(lds + STAGE_BYTES + 4096);
        LAS unsigned* flag = (LAS unsigned*)(lds + STAGE_BYTES + 5120);
        { const float* g = modbase + ((size_t)mi * 6 + chunk) * D;
          f32x4 gg[2][2];
#pragma unroll
          for (int bj = 0; bj < 2; ++bj)
#pragma unroll
              for (int n = 0; n < 2; ++n) gg[bj][n] = *(const f32x4*)(g + u.pn * BM + bj * HALF + wc * 32 + 16 * n + 4 * fq);
#pragma unroll
          for (int am = 0; am < 4; ++am) { const int ai = am >> 1, m0 = (am & 1) * 2;
              f32x4 hv[2][2][2];
#pragma unroll
              for (int mm = 0; mm < 2; ++mm) { const float* h = hin + (size_t)(rt + ai * HALF + wr * 64 + (m0 + mm) * 16 + fr) * D;
#pragma unroll
                  for (int bj = 0; bj < 2; ++bj)
#pragma unroll
                      for (int n = 0; n < 2; ++n) hv[mm][bj][n] = *(const f32x4*)(h + u.pn * BM + bj * HALF + wc * 32 + 16 * n + 4 * fq); }
#pragma unroll
              for (int mm = 0; mm < 2; ++mm) { const int m = m0 + mm; float* h = out + (size_t)(rt + ai * HALF + wr * 64 + m * 16 + fr) * D; float ss = 0.f;
#pragma unroll
                  for (int bj = 0; bj < 2; ++bj)
#pragma unroll
                      for (int n = 0; n < 2; ++n) { const f32x4 x = hv[mm][bj][n] + gg[bj][n] * acc[ai][bj][m][n]; acc[ai][bj][m][n] = x;
                          *(f32x4*)(h + u.pn * BM + bj * HALF + wc * 32 + 16 * n + 4 * fq) = x; ss += (x[0] * x[0] + x[1] * x[1]) + (x[2] * x[2] + x[3] * x[3]); }
                  ss += __shfl_xor(ss, 16); ss += __shfl_xor(ss, 32);
                  if (fq == 0) Pt[(ai * HALF + wr * 64 + m * 16 + fr) * 4 + wc] = ss; }
              asm volatile("" ::: "memory");
          } }
        asm volatile("s_waitcnt lgkmcnt(0)" ::: "memory"); __builtin_amdgcn_s_barrier(); asm volatile("" ::: "memory");
        const int row = wid * 32 + (lane & 31);
        if (lane < 32) { const f32x4 q = *(const LAS f32x4*)(Pt + row * 4);
            __hip_atomic_store(xbuf + ((size_t)(rt + row) * 4 + u.pn), (q[0] + q[1]) + (q[2] + q[3]), __ATOMIC_RELAXED, __HIP_MEMORY_SCOPE_AGENT); }
        asm volatile("s_waitcnt vmcnt(0)" ::: "memory");
        if (lane == 0) __hip_atomic_fetch_add(cnt + 16 * u.pm, 1u, __ATOMIC_RELAXED, __HIP_MEMORY_SCOPE_AGENT);
        if (wid == 0) { unsigned sp = 0u, dead = 0u;
            while ((unsigned)__builtin_amdgcn_readfirstlane(__hip_atomic_load(cnt + 16 * u.pm, __ATOMIC_RELAXED, __HIP_MEMORY_SCOPE_AGENT)) < 32u) {
                __builtin_amdgcn_s_sleep(1);
                if ((++sp & 255u) == 0u) { if (__hip_atomic_load(tmo, __ATOMIC_RELAXED, __HIP_MEMORY_SCOPE_AGENT)) { dead = 1u; break; } if (sp > (1u << 22)) { if (lane == 0) atomicAdd(tmo, 1u); dead = 1u; break; } } }
            __builtin_amdgcn_fence(__ATOMIC_ACQUIRE, "agent");
            if (lane == 0) flag[0] = dead; }
        asm volatile("s_waitcnt vmcnt(0) lgkmcnt(0)" ::: "memory"); __builtin_amdgcn_s_barrier(); asm volatile("" ::: "memory");
        if (lane < 32) { const float* sl = xbuf + (size_t)(rt + row) * 4; float t = 0.f;
#pragma unroll
            for (int q = 0; q < 4; ++q) t += __hip_atomic_load(sl + q, __ATOMIC_RELAXED, __HIP_MEMORY_SCOPE_AGENT);
            St[row] = rsqrtf(t * (1.f / D) + EPS); }
        asm volatile("s_waitcnt lgkmcnt(0)" ::: "memory"); __builtin_amdgcn_s_barrier(); asm volatile("" ::: "memory");
        const float* shp = nmods + ((size_t)mi * 6 + csh) * D; const float* scp = nmods + ((size_t)mi * 6 + csc) * D;
        float rs[2][4];
#pragma unroll
        for (int ai = 0; ai < 2; ++ai)
#pragma unroll
            for (int m = 0; m < 4; ++m) rs[ai][m] = St[ai * HALF + wr * 64 + m * 16 + fr];
#pragma unroll
        for (int bj = 0; bj < 2; ++bj)
#pragma unroll
            for (int n = 0; n < 2; ++n) { const int c = u.pn * BM + bj * HALF + wc * 32 + 16 * n + 4 * fq;
                const f32x4 g4 = *(const f32x4*)(gain + c), sc4 = *(const f32x4*)(scp + c) + 1.f, sh4 = *(const f32x4*)(shp + c);
#pragma unroll
                for (int ai = 0; ai < 2; ++ai)
#pragma unroll
                    for (int m = 0; m < 4; ++m) { const f32x4 y = acc[ai][bj][m][n] * rs[ai][m] * g4 * sc4 + sh4;
                        u32x2 o; o.x = cvt_pk(y[0], y[1]); o.y = cvt_pk(y[2], y[3]);
                        *(u32x2*)(A + (size_t)(rt + ai * HALF + wr * 64 + m * 16 + fr) * D + c) = o;
                        if (A8) *(unsigned*)(A8 + (size_t)(rt + ai * HALF + wr * 64 + m * 16 + fr) * D + c) = pk4_fp8(y[0], y[1], y[2], y[3]); } }
    }
};
struct EpiSwiglu {
    static constexpr bool PERM = true;
    bf16* Hm;
    __device__ __forceinline__ void operator()(const Acc& acc, const Unit& u, int wr, int wc, int fr, int fq) const {
#pragma unroll
        for (int ai = 0; ai < 2; ++ai)
#pragma unroll
            for (int m = 0; m < 4; ++m) { const int r = u.pm * BM + ai * HALF + wr * 64 + m * 16 + fr;
#pragma unroll
                for (int bj = 0; bj < 2; ++bj) { const int c = u.pn * BM + bj * HALF + wc * 32 + 8 * fq; const f32x4 g = acc[ai][bj][m][0], up = acc[ai][bj][m][1];
                    u32x2 o; o.x = cvt_pk(silu_fast(g[0]) * up[0], silu_fast(g[1]) * up[1]); o.y = cvt_pk(silu_fast(g[2]) * up[2], silu_fast(g[3]) * up[3]);
                    *(u32x2*)(Hm + (size_t)r * FFN + (c >> 1)) = o; } }
    }
};
struct EpiSwiglu8 {
    static constexpr bool PERM = true;
    unsigned char* Hm;
    __device__ __forceinline__ void operator()(const Acc& acc, const Unit& u, int wr, int wc, int fr_, int fq_) const {
        int fr = fr_, fq = fq_; asm volatile("" : "+v"(fr), "+v"(fq));
#pragma unroll
        for (int ai = 0; ai < 2; ++ai)
#pragma unroll
            for (int m = 0; m < 4; ++m) { const int r = u.pm * BM + ai * HALF + wr * 64 + m * 16 + fr;
#pragma unroll
                for (int bj = 0; bj < 2; ++bj) { const int c = u.pn * BM + bj * HALF + wc * 32 + 8 * fq; const f32x4 g = acc[ai][bj][m][0], up = acc[ai][bj][m][1];
                    *(unsigned*)(Hm + (size_t)r * FFN + (c >> 1)) = pk4_fp8(silu_fast(g[0]) * up[0], silu_fast(g[1]) * up[1], silu_fast(g[2]) * up[2], silu_fast(g[3]) * up[3]); } }
    }
};
struct EpiStore {
    static constexpr bool PERM = true;
    bf16* O; int ldc;
    __device__ __forceinline__ void operator()(const Acc& acc, const Unit& u, int wr, int wc, int fr_, int fq_) const {
        int fr = fr_, fq = fq_; asm volatile("" : "+v"(fr), "+v"(fq));
#pragma unroll
        for (int ai = 0; ai < 2; ++ai)
#pragma unroll
            for (int m = 0; m < 4; ++m) { const int r = u.pm * BM + ai * HALF + wr * 64 + m * 16 + fr;
#pragma unroll
                for (int bj = 0; bj < 2; ++bj) { const int c = u.pn * BM + bj * HALF + wc * 32 + 8 * fq; *(u32x4*)(O + (size_t)r * ldc + c) = pack8(acc[ai][bj][m][0], acc[ai][bj][m][1]); } }
    }
};
struct EpiFft1 {
    static constexpr bool PERM = true;
    unsigned char* ws;
    __device__ __forceinline__ void operator()(const Acc& acc, const Unit& u, int wr, int wc, int fr, int fq) const {
        const float* TW = (const float*)(ws + WS_TW); bf16* Z = (bf16*)(ws + WS_Z);
#pragma unroll
        for (int ai = 0; ai < 2; ++ai)
#pragma unroll
            for (int mm = 0; mm < 2; ++mm) { const int k1 = (4 * ai + 2 * wr + mm) * 16 + fr;
#pragma unroll
                for (int bj = 0; bj < 2; ++bj) { const int c = u.pn * BM + bj * HALF + wc * 32 + 8 * fq, n2 = c & 63, ch = (c >> 6) & 255, b = c >> 14;
                    f32x4 zr[2], zi[2];
#pragma unroll
                    for (int n = 0; n < 2; ++n) { const f32x4 yr = acc[ai][bj][2 * mm][n], yi = acc[ai][bj][2 * mm + 1][n];
                        const f32x4 t0 = *(const f32x4*)(TW + (size_t)(k1 * 64 + n2 + 4 * n) * 2), t1 = *(const f32x4*)(TW + (size_t)(k1 * 64 + n2 + 4 * n) * 2 + 4);
                        const f32x4 ct = {t0[0], t0[2], t1[0], t1[2]}, st = {t0[1], t0[3], t1[1], t1[3]};
                        zr[n] = yr * ct + yi * st; zi[n] = yi * ct - yr * st; }
                    bf16* dst = Z + ((size_t)b * 32768 + k1 * 256 + ch) * 256 + n2;
                    *(u32x4*)dst = pack8(zr[0], zr[1]); *(u32x4*)(dst + 64) = pack8(zi[0], zi[1]);
                    asm volatile("" ::: "memory"); } }
    }
};
struct EpiFft3 {
    static constexpr bool PERM = true;
    unsigned char* ws;
    __device__ __forceinline__ void operator()(const Acc& acc, const Unit& u, int wr, int wc, int fr, int fq) const {
        bf16* X = (bf16*)(ws + WS_X);
#pragma unroll
        for (int m = 0; m < 4; ++m) { const int k2 = 16 * m + fr;
#pragma unroll
            for (int bj = 0; bj < 2; ++bj) { const int c = u.pn * BM + bj * HALF + wc * 32 + 8 * fq, ch = c & 255, k1 = (c >> 8) & 127, b = c >> 15;
                *(u32x4*)(X + (size_t)(b * SEQ + k1 + 128 * k2) * 1536 + wr * 256 + ch) = pack8(acc[0][bj][m][0], acc[0][bj][m][1]); } }
    }
};
struct EpiFftC {
    static constexpr bool PERM = true;
    unsigned char* ws;
    __device__ __forceinline__ void operator()(const Acc& acc, const Unit& u, int wr, int wc, int fr, int fq) const {
        bf16* X = (bf16*)(ws + WS_X);
#pragma unroll
        for (int ai = 0; ai < 2; ++ai)
#pragma unroll
            for (int m = 0; m < 4; ++m) { const int k = ai * HALF + wr * 64 + m * 16 + fr;
#pragma unroll
                for (int bj = 0; bj < 2; ++bj) { const int ch = bj * HALF + wc * 32 + 8 * fq;
                    *(u32x4*)(X + (size_t)(NLAT + u.pn * CTX + k) * 1536 + u.pm * 256 + ch) = pack8(acc[ai][bj][m][0], acc[ai][bj][m][1]); } }
    }
};
}

__device__ __forceinline__ void ph_win(const P& p, LAS unsigned char* lds, int layer) {
    const char* W = (const char*)(p.ws + WS_WIN) + (size_t)layer * INC * D * 2;
#pragma unroll 1
    for (int mode = 0; mode < 2; ++mode) {
        fg::WinSched S{(const char*)(p.ws + WS_A), W, (int)gridDim.x, (int)((blockIdx.x + mode * 128) % gridDim.x), mode, mode == 0 ? 10 : (layer == 0 ? 26 : 10)};
        fg::EpiWin E{p.ws, p.in[14] + layer * 64, p.in[15] + layer * 64};
        fg::gemm_phase(lds, D, D, S, E);
    }
    {
        fg::PlainSched S{(const char*)(p.ws + WS_A8), (const char*)(p.ws + WS_WIN8) + (size_t)layer * 4096 * 1024, D / 2, D / 2, NLAT / 256, 16, (int)gridDim.x, (int)blockIdx.x, D / 128};
        fg::EpiGate8 E{p.ws + WS_G};
        fg::gemm_phase<fg::EpiGate8, fg::PlainSched, true>(lds, D / 2, D / 2, S, E);
    }
}

__device__ __forceinline__ void conv_item(const P& p, LAS unsigned char* lds, int layer, int seqid, int t0) {
    const int tid = threadIdx.x; LAS float* y = (LAS float*)lds;
    const int L = seqid < 2 ? SEQ : CTX; const int rbase = seqid < 2 ? seqid * SEQ : NLAT + (seqid - 2) * CTX;
    const bf16* cv = (const bf16*)(p.ws + WS_CONV);
    __syncthreads();
    u32x4 pa[6], pg[6];
#pragma unroll
    for (int i = 0; i < 6; ++i) { const int e = tid + i * NTHREADS, tt = e >> 5, c8 = (e & 31) * 8, t = t0 - 15 + tt;
        if (e < 94 * 32 && t >= 0 && t < L) { const bf16* rowp = cv + (size_t)(rbase + t) * 512 + c8; pa[i] = *(const u32x4*)rowp; pg[i] = *(const u32x4*)(rowp + 256); } }
#pragma unroll
    for (int i = 0; i < 6; ++i) { const int e = tid + i * NTHREADS; if (e >= 94 * 32) break; const int tt = e >> 5, c8 = (e & 31) * 8, t = t0 - 15 + tt;
        f32x4 lo = {0.f, 0.f, 0.f, 0.f}, hi = lo;
        if (t >= 0 && t < L) { const u32x4 a = pa[i], g = pg[i];
            lo = (f32x4){__uint_as_float(a.x << 16) * sigmoidf_(__uint_as_float(g.x << 16)), __uint_as_float(a.x & 0xffff0000u) * sigmoidf_(__uint_as_float(g.x & 0xffff0000u)),
                         __uint_as_float(a.y << 16) * sigmoidf_(__uint_as_float(g.y << 16)), __uint_as_float(a.y & 0xffff0000u) * sigmoidf_(__uint_as_float(g.y & 0xffff0000u))};
            hi = (f32x4){__uint_as_float(a.z << 16) * sigmoidf_(__uint_as_float(g.z << 16)), __uint_as_float(a.z & 0xffff0000u) * sigmoidf_(__uint_as_float(g.z & 0xffff0000u)),
                         __uint_as_float(a.w << 16) * sigmoidf_(__uint_as_float(g.w << 16)), __uint_as_float(a.w & 0xffff0000u) * sigmoidf_(__uint_as_float(g.w & 0xffff0000u))}; }
        *(LAS f32x4*)(y + tt * 256 + c8) = lo; *(LAS f32x4*)(y + tt * 256 + c8 + 4) = hi; }
    __syncthreads();
    {
        const int ch = tid & 255, half = tid >> 8;
        float w[31];
#pragma unroll
        for (int k = 0; k < 31; ++k) w[k] = p.in[17][(size_t)layer * 31 * 256 + k * 256 + ch];
        const float bias = p.in[18][layer * 256 + ch];
        float o[4][8];
#pragma unroll
        for (int u = 0; u < 4; ++u) { const int tb = (half * 4 + u) * 8;
            float in[38];
#pragma unroll
            for (int q = 0; q < 38; ++q) in[q] = y[(tb + q) * 256 + ch];
#pragma unroll
            for (int q = 0; q < 8; ++q) { float a = bias;
#pragma unroll
                for (int k = 0; k < 31; ++k) a += in[q + k] * w[k];
                o[u][q] = a; } }
        __syncthreads();
#pragma unroll
        for (int u = 0; u < 4; ++u)
#pragma unroll
            for (int q = 0; q < 8; ++q) y[((half * 4 + u) * 8 + q) * 256 + ch] = o[u][q];
    }
    __syncthreads();
    const int wv = tid >> 6, lane = tid & 63;
    const f32x4 g = *(const f32x4*)(p.in[19] + layer * 256 + lane * 4), bb = *(const f32x4*)(p.in[20] + layer * 256 + lane * 4);
    for (int q = 0; q < 8; ++q) { const int t = wv * 8 + q;
        const f32x4 v = *(const LAS f32x4*)(y + t * 256 + lane * 4);
        const float mu = wave_sum(v.x + v.y + v.z + v.w) * (1.f / 256.f);
        const f32x4 dv = v - mu; const float var = wave_sum(dv.x * dv.x + dv.y * dv.y + dv.z * dv.z + dv.w * dv.w) * (1.f / 256.f);
        const float rstd = rsqrtf(var + EPS);
        f32x4 z = dv * rstd * g + bb;
        u32x2 ov; ov.x = pk2(siluf_(z.x), siluf_(z.y)); ov.y = pk2(siluf_(z.z), siluf_(z.w));
        *(u32x2*)((bf16*)(p.ws + WS_X) + (size_t)(rbase + t0 + t) * 1536 + 1280 + lane * 4) = ov; }
}

__device__ __forceinline__ int chunk_row0(int b, int n) { return n < 2 ? NLAT + b * CTX + n * 128 : b * SEQ + (n - 2) * 128; }
__device__ __forceinline__ float log_sigmoid(float x) { return x >= 0.f ? -log1pf(expf(-x)) : x - log1pf(expf(x)); }
namespace rt {
typedef short bf16x8 __attribute__((ext_vector_type(8)));
constexpr int PQ = 72, PJ = 136;
__device__ __forceinline__ f32x4 mma(bf16x8 a, bf16x8 b, f32x4 c) { return __builtin_amdgcn_mfma_f32_16x16x32_bf16(a, b, c, 0, 0, 0); }
__device__ __forceinline__ bf16x8 frag(const LAS bf16* base, int row, int pitch, int k0, int lane) { return *(const LAS bf16x8*)(base + (row + (lane & 15)) * pitch + k0 + 8 * (lane >> 4)); }
}
__device__ __forceinline__ void ret_kv_item(const P& p, LAS unsigned char* lds, int layer, int it) {
    using namespace rt;
    const int tid = threadIdx.x, lane = tid & 63, w = tid >> 6; const int h = it & 3, n = (it >> 2) % NCHUNK, b = (it >> 2) / NCHUNK;
    LAS bf16* KTf = (LAS bf16*)lds; LAS bf16* KTb = KTf + 64 * PJ; LAS bf16* VT = KTb + 64 * PJ;
    const int r0 = chunk_row0(b, n);
    const float lgf = log_sigmoid(p.in[10][layer * 4 + h]), lgb = log_sigmoid(p.in[11][layer * 4 + h]);
    __syncthreads();
    { const int j = tid & 127, dq = (tid >> 7) * 16;
      const bf16* K = (const bf16*)(p.ws + WS_RETK) + (size_t)(r0 + j) * 256 + h * 64 + dq; const bf16* V = (const bf16*)(p.ws + WS_RETV) + (size_t)(r0 + j) * 256 + h * 64 + dq;
      const float zf = expf((127.f - j) * lgf), zb = expf((float)j * lgb);
#pragma unroll
      for (int q8 = 0; q8 < 2; ++q8) { const u32x4 kw = *(const u32x4*)(K + q8 * 8), vw = *(const u32x4*)(V + q8 * 8);
          const unsigned kk[4] = {kw.x, kw.y, kw.z, kw.w}, vv[4] = {vw.x, vw.y, vw.z, vw.w};
#pragma unroll
          for (int q = 0; q < 4; ++q) { const int d = dq + q8 * 8 + 2 * q; const float k0 = __uint_as_float(kk[q] << 16), k1 = __uint_as_float(kk[q] & 0xffff0000u);
              KTf[d * PJ + j] = f2bf(k0 * zf); KTf[(d + 1) * PJ + j] = f2bf(k1 * zf); KTb[d * PJ + j] = f2bf(k0 * zb); KTb[(d + 1) * PJ + j] = f2bf(k1 * zb);
              VT[d * PJ + j] = (bf16)(vv[q] & 0xffffu); VT[(d + 1) * PJ + j] = (bf16)(vv[q] >> 16); } } }
    __syncthreads();
    const int fb = w >> 2, dt = w & 3; const LAS bf16* Am = fb == 0 ? KTf : KTb;
    f32x4 acc[4];
#pragma unroll
    for (int et = 0; et < 4; ++et) acc[et] = (f32x4){0.f, 0.f, 0.f, 0.f};
#pragma unroll
    for (int ks = 0; ks < 4; ++ks) { const bf16x8 af = frag(Am, dt * 16, PJ, ks * 32, lane);
#pragma unroll
        for (int et = 0; et < 4; ++et) acc[et] = mma(af, frag(VT, et * 16, PJ, ks * 32, lane), acc[et]); }
    float* S = (float*)(p.ws + WS_RETS) + ((size_t)((fb * 2 + b) * NCHUNK + n) * 4 + h) * 4096;
#pragma unroll
    for (int et = 0; et < 4; ++et)
#pragma unroll
        for (int r = 0; r < 4; ++r) S[(dt * 16 + 4 * (lane >> 4) + r) * 64 + et * 16 + (lane & 15)] = acc[et][r];
}
__device__ __forceinline__ void ret_scan_item(const P& p, int layer, int it) {
    const int e = it * NTHREADS + threadIdx.x;
    const int de = e & 4095, h = (e >> 12) & 3, b = (e >> 14) & 1, dir = e >> 15;
    const float lg = log_sigmoid(p.in[dir == 0 ? 10 : 11][layer * 4 + h]); const float g = expf(128.f * lg);
    float* S = (float*)(p.ws + WS_RETS) + (size_t)((dir * 2 + b) * NCHUNK) * 4 * 4096 + (size_t)h * 4096 + de;
    float kv[NCHUNK];
#pragma unroll
    for (int n = 0; n < NCHUNK; ++n) kv[n] = S[(size_t)n * 4 * 4096];
    float st = 0.f;
    if (dir == 0) {
#pragma unroll
        for (int n = 0; n < NCHUNK; ++n) { const float t = kv[n]; kv[n] = st; st = st * g + t; }
    } else {
#pragma unroll
        for (int i = 0; i < NCHUNK; ++i) { const int n = i < 2 ? 1 - i : NCHUNK + 1 - i; const float t = kv[n]; kv[n] = st; st = st * g + t; }
    }
    float* S2 = (float*)(p.ws + WS_RETS2) + (size_t)((dir * 2 + b) * NCHUNK) * 4 * 4096 + (size_t)h * 4096 + de;
#pragma unroll
    for (int n = 0; n < NCHUNK; ++n) S2[(size_t)n * 4 * 4096] = kv[n];
}
__device__ __forceinline__ void ret_out_item(const P& p, LAS unsigned char* lds, int layer, int it) {
    using namespace rt;
    const int tid = threadIdx.x, lane = tid & 63, w = tid >> 6; const int h = it & 3, n = (it >> 2) % NCHUNK, b = (it >> 2) / NCHUNK;
    LAS bf16* Qs = (LAS bf16*)lds; LAS bf16* Ks = Qs + 128 * PQ; LAS bf16* VT = Ks + 128 * PQ; LAS bf16* Ps = VT + 64 * PJ; LAS bf16* SfT = Ps + 128 * PJ; LAS bf16* SbT = SfT + 64 * PQ;
    LAS float* pf = (LAS float*)(SbT + 64 * PQ); LAS float* pb = pf + 132;
    const int r0 = chunk_row0(b, n);
    const float lgf = log_sigmoid(p.in[10][layer * 4 + h]), lgb = log_sigmoid(p.in[11][layer * 4 + h]);
    const float* S = (const float*)(p.ws + WS_RETS2);
    const float* sfp = S + ((size_t)((0 * 2 + b) * NCHUNK + n) * 4 + h) * 4096; const float* sbp = S + ((size_t)((1 * 2 + b) * NCHUNK + n) * 4 + h) * 4096;
    __syncthreads();
    { const int j = tid >> 2, dq = (tid & 3) * 16;
      const bf16* Q = (const bf16*)(p.ws + WS_RETQ) + (size_t)(r0 + j) * 256 + h * 64 + dq; const bf16* K = (const bf16*)(p.ws + WS_RETK) + (size_t)(r0 + j) * 256 + h * 64 + dq;
      *(LAS u32x4*)(Qs + j * PQ + dq) = *(const u32x4*)Q; *(LAS u32x4*)(Qs + j * PQ + dq + 8) = *(const u32x4*)(Q + 8);
      *(LAS u32x4*)(Ks + j * PQ + dq) = *(const u32x4*)K; *(LAS u32x4*)(Ks + j * PQ + dq + 8) = *(const u32x4*)(K + 8); }
    { const int j = tid & 127, dq = (tid >> 7) * 16;
      const bf16* V = (const bf16*)(p.ws + WS_RETV) + (size_t)(r0 + j) * 256 + h * 64 + dq;
#pragma unroll
      for (int q8 = 0; q8 < 2; ++q8) { const u32x4 vw = *(const u32x4*)(V + q8 * 8); const unsigned vv[4] = {vw.x, vw.y, vw.z, vw.w};
#pragma unroll
          for (int q = 0; q < 4; ++q) { const int d = dq + q8 * 8 + 2 * q; VT[d * PJ + j] = (bf16)(vv[q] & 0xffffu); VT[(d + 1) * PJ + j] = (bf16)(vv[q] >> 16); } } }
    { const int d = tid & 63, e0 = (tid >> 6) * 8;
#pragma unroll
      for (int q4 = 0; q4 < 2; ++q4) { const f32x4 a = *(const f32x4*)(sfp + d * 64 + e0 + q4 * 4), c = *(const f32x4*)(sbp + d * 64 + e0 + q4 * 4);
#pragma unroll
          for (int q = 0; q < 4; ++q) { SfT[(e0 + q4 * 4 + q) * PQ + d] = f2bf(a[q]); SbT[(e0 + q4 * 4 + q) * PQ + d] = f2bf(c[q]); } } }
    if (tid <= 128) { pf[tid] = expf((float)tid * lgf); pb[tid] = expf((float)tid * lgb); }
    __syncthreads();
    { const bf16x8 a0 = frag(Qs, 16 * w, PQ, 0, lane), a1 = frag(Qs, 16 * w, PQ, 32, lane);
#pragma unroll
      for (int jt = 0; jt < 8; ++jt) { f32x4 c = (f32x4){0.f, 0.f, 0.f, 0.f};
          c = mma(a0, frag(Ks, jt * 16, PQ, 0, lane), c); c = mma(a1, frag(Ks, jt * 16, PQ, 32, lane), c);
          const int j = jt * 16 + (lane & 15);
#pragma unroll
          for (int r = 0; r < 4; ++r) { const int i = 16 * w + 4 * (lane >> 4) + r; const float dm = i > j ? pf[i - j] : (i < j ? pb[j - i] : 2.f); Ps[i * PJ + j] = f2bf(c[r] * dm); } } }
    __syncthreads();
    f32x4 aP[4], aF[4], aB[4];
#pragma unroll
    for (int et = 0; et < 4; ++et) { aP[et] = (f32x4){0.f, 0.f, 0.f, 0.f}; aF[et] = aP[et]; aB[et] = aP[et]; }
#pragma unroll
    for (int ks = 0; ks < 4; ++ks) { const bf16x8 af = frag(Ps, 16 * w, PJ, ks * 32, lane);
#pragma unroll
        for (int et = 0; et < 4; ++et) aP[et] = mma(af, frag(VT, et * 16, PJ, ks * 32, lane), aP[et]); }
#pragma unroll
    for (int ks = 0; ks < 2; ++ks) { const bf16x8 af = frag(Qs, 16 * w, PQ, ks * 32, lane);
#pragma unroll
        for (int et = 0; et < 4; ++et) { aF[et] = mma(af, frag(SfT, et * 16, PQ, ks * 32, lane), aF[et]); aB[et] = mma(af, frag(SbT, et * 16, PQ, ks * 32, lane), aB[et]); } }
    const float* rg = p.in[12] + layer * 256 + h * 64;
    const bf16* G = (const bf16*)(p.ws + WS_RETG) + (size_t)r0 * 256 + h * 64; bf16* X = (bf16*)(p.ws + WS_X) + (size_t)r0 * 1536 + 512 + h * 64;
    float gt[4][4];
#pragma unroll
    for (int r = 0; r < 4; ++r)
#pragma unroll
        for (int et = 0; et < 4; ++et) gt[r][et] = bf2f(G[(size_t)(16 * w + 4 * (lane >> 4) + r) * 256 + et * 16 + (lane & 15)]);
#pragma unroll
    for (int r = 0; r < 4; ++r) { const int i = 16 * w + 4 * (lane >> 4) + r; const float xf = pf[i + 1], xb = pb[128 - i];
        float o[4]; float ss = 0.f;
#pragma unroll
        for (int et = 0; et < 4; ++et) { o[et] = aP[et][r] + xf * aF[et][r] + xb * aB[et][r]; ss += o[et] * o[et]; }
        ss += __shfl_xor(ss, 1); ss += __shfl_xor(ss, 2); ss += __shfl_xor(ss, 4); ss += __shfl_xor(ss, 8);
        const float rstd = rsqrtf(ss * (1.f / 64.f) + EPS);
#pragma unroll
        for (int et = 0; et < 4; ++et) { const int e = et * 16 + (lane & 15); Ps[i * PJ + e] = f2bf(o[et] * rstd * rg[e] * siluf_(gt[r][et])); } }
    asm volatile("s_waitcnt lgkmcnt(0)" ::: "memory");
#pragma unroll
    for (int q = 0; q < 2; ++q) { const int c = lane + 64 * q, i = 16 * w + (c >> 3), e8 = (c & 7) * 8;
        *(u32x4*)(X + (size_t)i * 1536 + e8) = *(const LAS u32x4*)(Ps + i * PJ + e8); }
    __syncthreads();
}

#include <hip/hip_bf16.h>
#include <cmath>
namespace attn_body {
using bf16=__hip_bfloat16;
using bf16x8=__attribute__((ext_vector_type(8)))short;
using s16x4=__attribute__((ext_vector_type(4)))short;
using f32x16=__attribute__((ext_vector_type(16)))float;
using u32x4=__attribute__((ext_vector_type(4)))unsigned;
constexpr int D=64, QP=512, KP=128, OP=1536;
constexpr int NW=8,QBLK=32,QB=QBLK*NW,KVBLK=64;
__device__ __forceinline__ int crow(int r,int hi){return (r&3)+8*(r>>2)+4*hi;}
#define SBAR() __builtin_amdgcn_sched_barrier(0)
__device__ __forceinline__ void cmask(f32x16&p0,f32x16&p1,int jb,int qrel,int hi){
  const float NEG=-INFINITY; int kb=64*jb+4*hi;
  #pragma unroll
  for(int r=0;r<16;++r){int kv=kb+(r&3)+8*(r>>2); if(kv>qrel)p0[r]=NEG; if(kv+32>qrel)p1[r]=NEG;}
}

constexpr int NSLOT=3, SLOTB=8192;
constexpr int LDS_K=0, LDS_V=NSLOT*SLOTB, LDS_WS=2*NSLOT*SLOTB, LDS_OST=LDS_WS+NW*64*4, LDS_BYTES=LDS_OST+NW*4096;
constexpr float C2=0.125f*1.4426950408889634f;
__device__ __forceinline__ void glds16(const void*gsrc,unsigned lds_dst){unsigned keep;
  asm volatile("s_mov_b32 %0, m0\n\ts_mov_b32 m0, %2\n\ts_nop 0\n\tglobal_load_lds_dwordx4 %1, off\n\ts_mov_b32 m0, %0":"=&s"(keep):"v"(gsrc),"s"(lds_dst):"memory");}
__device__ __forceinline__ float max3f(float a,float b,float c){float r;asm("v_max3_f32 %0, %1, %2, %3":"=v"(r):"v"(a),"v"(b),"v"(c));return r;}
__device__ __forceinline__ float max2f(float a,float b){float r;asm("v_max_f32_e32 %0, %1, %2":"=v"(r):"v"(a),"v"(b));return r;}
__device__ __forceinline__ float fadd_s(float a,float b){float r;asm("v_add_f32_e32 %0, %1, %2":"=v"(r):"v"(a),"v"(b));return r;}
__device__ __forceinline__ float fsub_s(float a,float b){float r;asm("v_sub_f32_e32 %0, %1, %2":"=v"(r):"v"(a),"v"(b));return r;}
typedef float f32x2_t __attribute__((ext_vector_type(2))); typedef __bf16 bf16x2_t __attribute__((ext_vector_type(2)));
__device__ __forceinline__ unsigned cvtpk_s(float lo,float hi){f32x2_t v={lo,hi};bf16x2_t b=__builtin_convertvector(v,bf16x2_t);return __builtin_bit_cast(unsigned,b);}
#define WAIT_BAR(N) asm volatile("s_waitcnt vmcnt(" #N ") lgkmcnt(0)\n\ts_barrier":::"memory")

__device__ __forceinline__ void qkt(f32x16&p0,f32x16&p1,const char*Kslot,const bf16x8*qr,const f32x16&negm,int r32,int hi){
  const char*kb=Kslot+hi*1024+r32*16;
  #pragma unroll
  for(int d0=0;d0<4;++d0){
    const bf16x8 b0=*reinterpret_cast<const bf16x8*>(kb+d0*2048);
    const bf16x8 b1=*reinterpret_cast<const bf16x8*>(kb+d0*2048+512);
    if(d0==0){p0=__builtin_amdgcn_mfma_f32_32x32x16_bf16(b0,qr[0],negm,0,0,0);p1=__builtin_amdgcn_mfma_f32_32x32x16_bf16(b1,qr[0],negm,0,0,0);}
    else{p0=__builtin_amdgcn_mfma_f32_32x32x16_bf16(b0,qr[d0],p0,0,0,0);p1=__builtin_amdgcn_mfma_f32_32x32x16_bf16(b1,qr[d0],p1,0,0,0);}}
}
typedef __attribute__((address_space(3))) const char* lds_cptr;
typedef short v4i16_t __attribute__((ext_vector_type(4)));
__device__ __forceinline__ void kload8(bf16x8*kf,lds_cptr kp){
  kf[0]=*(const __attribute__((address_space(3))) bf16x8*)(kp);      kf[1]=*(const __attribute__((address_space(3))) bf16x8*)(kp+512);
  kf[2]=*(const __attribute__((address_space(3))) bf16x8*)(kp+2048); kf[3]=*(const __attribute__((address_space(3))) bf16x8*)(kp+2560);
  kf[4]=*(const __attribute__((address_space(3))) bf16x8*)(kp+4096); kf[5]=*(const __attribute__((address_space(3))) bf16x8*)(kp+4608);
  kf[6]=*(const __attribute__((address_space(3))) bf16x8*)(kp+6144); kf[7]=*(const __attribute__((address_space(3))) bf16x8*)(kp+6656);
}
__device__ __forceinline__ void kload2(bf16x8*kf,lds_cptr kp,int j){ kf[2*j]=*(const __attribute__((address_space(3))) bf16x8*)(kp+j*2048); kf[2*j+1]=*(const __attribute__((address_space(3))) bf16x8*)(kp+j*2048+512); }
__device__ __forceinline__ s16x4 vtr(lds_cptr p){ return __builtin_bit_cast(s16x4,__builtin_amdgcn_ds_read_tr16_b64_v4i16((__attribute__((address_space(3))) v4i16_t*)p)); }
__device__ __forceinline__ float rowmax(const f32x16&p0,const f32x16&p1){
  float a=max3f(p0[0],p0[1],p1[0]),b=max3f(p0[2],p0[3],p1[1]);a=max3f(a,p1[2],p1[3]);
  #pragma unroll
  for(int r=4;r<16;r+=4){a=max3f(a,p0[r],p0[r+1]);b=max3f(b,p0[r+2],p0[r+3]);a=max3f(a,p1[r],p1[r+1]);b=max3f(b,p1[r+2],p1[r+3]);}
  const float m=max2f(a,b);
  auto rr=__builtin_amdgcn_permlane32_swap(__float_as_uint(m),__float_as_uint(m),false,false);
  return max2f(__uint_as_float(rr[0]),__uint_as_float(rr[1]));
}
__device__ __forceinline__ void pv(f32x16*o,int vb,bf16x8 pa0,bf16x8 pa1,bf16x8 pa2,bf16x8 pa3){
  #pragma unroll
  for(int d0=0;d0<2;++d0){s16x4 lo[4],hi[4];
    #pragma unroll
    for(int ks=0;ks<4;++ks){
      asm volatile("ds_read_b64_tr_b16 %0,%1 offset:%c2":"=&v"(lo[ks]):"v"(vb),"i"(d0*4096+ks*1024):"memory");
      asm volatile("ds_read_b64_tr_b16 %0,%1 offset:%c2":"=&v"(hi[ks]):"v"(vb),"i"(d0*4096+ks*1024+512):"memory");}
    asm volatile("s_waitcnt lgkmcnt(0)":::"memory");SBAR();
    #define PK(k) (bf16x8){lo[k][0],lo[k][1],lo[k][2],lo[k][3],hi[k][0],hi[k][1],hi[k][2],hi[k][3]}
    o[d0]=__builtin_amdgcn_mfma_f32_32x32x16_bf16(pa0,PK(0),o[d0],0,0,0);
    o[d0]=__builtin_amdgcn_mfma_f32_32x32x16_bf16(pa1,PK(1),o[d0],0,0,0);
    o[d0]=__builtin_amdgcn_mfma_f32_32x32x16_bf16(pa2,PK(2),o[d0],0,0,0);
    o[d0]=__builtin_amdgcn_mfma_f32_32x32x16_bf16(pa3,PK(3),o[d0],0,0,0);
    #undef PK
  }
}

#ifndef ATTN_STORE16
#define ATTN_STORE16(p,v) (*(u32x4*)(p)=(v))
#endif
template<int THRL> __device__ __forceinline__ void attn_unit(const bf16*Q0,const bf16*__restrict__ Kh,const bf16*__restrict__ Vh,bf16*O0,const int NT,char*shm){
  const int tid=threadIdx.x,lane=tid&63,r32=lane&31,hi=lane>>5; const int wid=__builtin_amdgcn_readfirstlane(tid>>6);
  const bf16*Qw=Q0+(long)(wid*QBLK)*QP;
  const unsigned lds0=(unsigned)(uintptr_t)shm;
  float*wsf=(float*)(shm+LDS_WS)+wid*64;
  const bf16*ksrc=Kh+(long)lane*KP+wid*8;
  const bf16*vsrc=Vh+(long)(16*(wid&3)+(lane>>2))*KP+(wid>>2)*32+(lane&3)*8;
  const unsigned kdst=lds0+LDS_K+wid*1024, vdst=lds0+LDS_V+wid*1024;
  #define DMA_K(t,slot) glds16(ksrc+(long)(t)*KVBLK*KP,(unsigned)__builtin_amdgcn_readfirstlane(kdst+(slot)))
  #define DMA_V(t,slot) glds16(vsrc+(long)(t)*KVBLK*KP,(unsigned)__builtin_amdgcn_readfirstlane(vdst+(slot)))
  const int vb0=(int)(lds0+LDS_V)+((lane>>4)&1)*32+(lane&3)*8+(4*hi+((lane&15)>>2))*64;
  const char*Kbase=shm+LDS_K; bf16x8 kf[8];
  const lds_cptr shm3=(lds_cptr)shm; const lds_cptr kp0=shm3+LDS_K+hi*1024+r32*16; const lds_cptr vp0=shm3+LDS_V+((lane>>4)&1)*32+(lane&3)*8+(4*hi+((lane&15)>>2))*64;
  DMA_K(0,0);DMA_V(0,0);DMA_K(1,SLOTB);
  bf16x8 qr[4];
  #pragma unroll
  for(int d0=0;d0<4;++d0)qr[d0]=*reinterpret_cast<const bf16x8*>(&Qw[(long)r32*QP+d0*16+hi*8]);
  float mhat=0.f,l_reg=0.f;f32x16 o[2];o[0]=f32x16{};o[1]=f32x16{};f32x16 negm=f32x16{};asm volatile("":"+v"(negm));
  #define CMASK(P0,P1,t) do{}while(0)
  bool resc=false;
  #define START(P0,P1) do{ const float rm=rowmax(P0,P1); resc=false; \
    { const float dl=rm; mhat=fadd_s(mhat,dl); \
      _Pragma("unroll") for(int r=0;r<16;++r){P0[r]=fsub_s(P0[r],dl);P1[r]=fsub_s(P1[r],dl);} \
      _Pragma("unroll") for(int r=0;r<16;++r)negm[r]=-mhat; asm volatile("":"+v"(negm)); } \
    _Pragma("unroll") for(int r=0;r<16;++r)P0[r]=__builtin_amdgcn_exp2f(P0[r]); }while(0)
  #define RESC() do{ if(resc){ asm volatile("s_waitcnt lgkmcnt(0)":::"memory"); \
      _Pragma("unroll") for(int d_=0;d_<2;++d_) _Pragma("unroll") for(int r=0;r<16;++r)o[d_][r]*=wsf[crow(r,hi)]; } }while(0)
  f32x16 pA0,pA1,pB0,pB1;
  int sl_prev=0,sl_cur=0,sl_next=SLOTB;
  #define ROT() do{sl_prev=sl_cur;sl_cur=sl_next;sl_next=(sl_next==(NSLOT-1)*SLOTB)?0:sl_next+SLOTB;}while(0)
  DMA_K(2,2*SLOTB);
  WAIT_BAR(3);
  qkt(pA0,pA1,Kbase,qr,negm,r32,hi);asm volatile("s_nop 15\n\ts_nop 7":"+v"(pA0),"+v"(pA1));CMASK(pA0,pA1,0);
  START(pA0,pA1);
  _Pragma("unroll") for(int r=0;r<16;++r)pA1[r]=__builtin_amdgcn_exp2f(pA1[r]);
  WAIT_BAR(0);
  DMA_K(3,0);DMA_V(1,SLOTB);
  ROT();
  kload8(kf,kp0+sl_cur);
  WAIT_BAR(2);
  s16x4 vlo[8],vhi[8]; u32x4 pw0,pw1,pw2,pw3;
  #define PKW(P,B) cvtpk_s(P[B],P[B+1])
  #define PAF(k) __builtin_bit_cast(bf16x8,pw##k)
  #define VFR(i) (bf16x8){vlo[i][0],vlo[i][1],vlo[i][2],vlo[i][3],vhi[i][0],vhi[i][1],vhi[i][2],vhi[i][3]}
  #define PIN(x) asm volatile("":"+v"(x))
  #define MX3(a,b,c) __builtin_fmaxf(__builtin_fmaxf((a),(b)),(c))
  #define GAPA(MF,A0,A1,A2,A3,W0,W1,PW) do{ MF; sacc+=A0; sacc+=A1; sacc+=A2; sacc+=A3; PIN(sacc); W0; W1; PIN(PW); SBAR(); }while(0)
  #define EX(v) __builtin_amdgcn_exp2f(v)
  #define GAPB(MF,X,B) do{ MF; X[B]=EX(X[B]); X[B+1]=EX(X[B+1]); X[B+2]=EX(X[B+2]); X[B+3]=EX(X[B+3]); PIN(X); SBAR(); }while(0)
  #define VRD(i) do{ vlo[i]=vtr(vp_+(((i)>>2)*4096+((i)&3)*1024)); vhi[i]=vtr(vp_+(((i)>>2)*4096+((i)&3)*1024+512)); }while(0)
  #define KRD(G,j) do{ if(G){ kload2(kf,kp0+sl_next,j); SBAR(); } }while(0)
  #define STEP(C0,C1,P0,P1,t,GK,GV,GL) do{ SBAR(); \
    const lds_cptr vp_=vp0+sl_prev; \
    VRD(0); SBAR(); float sacc=(P0[0]+P0[1]); \
    GAPA(C0=__builtin_amdgcn_mfma_f32_32x32x16_bf16(kf[0],qr[0],negm,0,0,0), P0[2],P0[3],P0[4],P0[5],     pw0[0]=PKW(P0,0), pw0[1]=PKW(P0,2), pw0); \
    VRD(4); SBAR(); GAPA(C1=__builtin_amdgcn_mfma_f32_32x32x16_bf16(kf[1],qr[0],negm,0,0,0), P0[6],P0[7],P0[8],P0[9],     pw0[2]=PKW(P0,4), pw0[3]=PKW(P0,6), pw0); \
    VRD(1); SBAR(); GAPA(C0=__builtin_amdgcn_mfma_f32_32x32x16_bf16(kf[2],qr[1],C0,0,0,0),   P0[10],P0[11],P0[12],P0[13], pw1[0]=PKW(P0,8), pw1[1]=PKW(P0,10), pw1); \
    VRD(5); SBAR(); GAPA(C1=__builtin_amdgcn_mfma_f32_32x32x16_bf16(kf[3],qr[1],C1,0,0,0),   P0[14],P0[15],P1[0],P1[1],   pw1[2]=PKW(P0,12),pw1[3]=PKW(P0,14), pw1); \
    VRD(2); SBAR(); GAPA(C0=__builtin_amdgcn_mfma_f32_32x32x16_bf16(kf[4],qr[2],C0,0,0,0),   P1[2],P1[3],P1[4],P1[5],     pw2[0]=PKW(P1,0), pw2[1]=PKW(P1,2), pw2); \
    VRD(6); SBAR(); GAPA(C1=__builtin_amdgcn_mfma_f32_32x32x16_bf16(kf[5],qr[2],C1,0,0,0),   P1[6],P1[7],P1[8],P1[9],     pw2[2]=PKW(P1,4), pw2[3]=PKW(P1,6), pw2); \
    VRD(3); SBAR(); GAPA(C0=__builtin_amdgcn_mfma_f32_32x32x16_bf16(kf[6],qr[3],C0,0,0,0),   P1[10],P1[11],P1[12],P1[13], pw3[0]=PKW(P1,8), pw3[1]=PKW(P1,10), pw3); \
    VRD(7); SBAR(); GAPA(C1=__builtin_amdgcn_mfma_f32_32x32x16_bf16(kf[7],qr[3],C1,0,0,0),   P1[14],P1[15],0.f,0.f,       pw3[2]=PKW(P1,12),pw3[3]=PKW(P1,14), pw3); \
    l_reg+=sacc; \
    if(GK){DMA_K((t)+3,sl_cur);} if(GV){DMA_V((t)+1,sl_next);} \
    CMASK(C0,C1,t); \
    { float a=MX3(C0[0],C0[1],C1[0]),b=MX3(C0[2],C0[3],C1[1]); a=MX3(a,C1[2],C1[3]); \
      _Pragma("unroll") for(int r=4;r<16;r+=4){a=MX3(a,C0[r],C0[r+1]);b=MX3(b,C0[r+2],C0[r+3]);a=MX3(a,C1[r],C1[r+1]);b=MX3(b,C1[r+2],C1[r+3]);} \
      float rm=__builtin_fmaxf(a,b); { auto rr=__builtin_amdgcn_permlane32_swap(__float_as_uint(rm),__float_as_uint(rm),false,false); rm=__builtin_fmaxf(__uint_as_float(rr[0]),__uint_as_float(rr[1])); } \
      resc=false; \
      if(__builtin_expect(__any(rm>(float)THRL),0)){ const float dl=__builtin_fmaxf(rm,0.f); mhat+=dl; \
        _Pragma("unroll") for(int r=0;r<16;++r){C0[r]-=dl;C1[r]-=dl;} \
        _Pragma("unroll") for(int r=0;r<16;++r)negm[r]=-mhat; asm volatile("":"+v"(negm)); \
        const float f=__builtin_amdgcn_exp2f(-dl); l_reg*=f; if(hi==0)wsf[r32]=f; resc=true; } } \
    SBAR(); \
    GAPB(o[0]=__builtin_amdgcn_mfma_f32_32x32x16_bf16(PAF(0),VFR(0),o[0],0,0,0), C0,0); \
    GAPB(o[1]=__builtin_amdgcn_mfma_f32_32x32x16_bf16(PAF(0),VFR(4),o[1],0,0,0), C0,4); \
    KRD(GL,0); GAPB(o[0]=__builtin_amdgcn_mfma_f32_32x32x16_bf16(PAF(1),VFR(1),o[0],0,0,0), C0,8); \
    KRD(GL,1); GAPB(o[1]=__builtin_amdgcn_mfma_f32_32x32x16_bf16(PAF(1),VFR(5),o[1],0,0,0), C0,12); \
    KRD(GL,2); GAPB(o[0]=__builtin_amdgcn_mfma_f32_32x32x16_bf16(PAF(2),VFR(2),o[0],0,0,0), C1,0); \
    KRD(GL,3); GAPB(o[1]=__builtin_amdgcn_mfma_f32_32x32x16_bf16(PAF(2),VFR(6),o[1],0,0,0), C1,4); \
    GAPB(o[0]=__builtin_amdgcn_mfma_f32_32x32x16_bf16(PAF(3),VFR(3),o[0],0,0,0), C1,8); \
    GAPB(o[1]=__builtin_amdgcn_mfma_f32_32x32x16_bf16(PAF(3),VFR(7),o[1],0,0,0), C1,12); \
    }while(0)
  int t=1;
  #undef CMASK
  #define CMASK(P0,P1,t) do{}while(0)
  for(;t+5<NT;t+=2){
    STEP(pB0,pB1,pA0,pA1,t,true,true,true);     WAIT_BAR(2); RESC(); ROT();
    STEP(pA0,pA1,pB0,pB1,t+1,true,true,true);   WAIT_BAR(2); RESC(); ROT();
  }
  #undef CMASK
  #define CMASK(P0,P1,t) do{}while(0)
  #define ENDW(tt) do{ if((tt)+3<NT){WAIT_BAR(2);} else if((tt)+2<NT){WAIT_BAR(1);} else {WAIT_BAR(0);} }while(0)
  for(;t+1<NT;t+=2){
    STEP(pB0,pB1,pA0,pA1,t,(t+3<NT),(t+1<NT),(t+1<NT));       ENDW(t);   RESC(); ROT();
    STEP(pA0,pA1,pB0,pB1,t+1,(t+4<NT),(t+2<NT),(t+2<NT));     ENDW(t+1); RESC(); ROT();
  }
  STEP(pB0,pB1,pA0,pA1,NT-1,false,false,false); RESC();
  { float sacc=pB0[0]+pB0[1]; _Pragma("unroll") for(int r=2;r<16;++r)sacc+=pB0[r]; _Pragma("unroll") for(int r=0;r<16;++r)sacc+=pB1[r]; l_reg+=sacc;
    pw0=(u32x4){PKW(pB0,0),PKW(pB0,2),PKW(pB0,4),PKW(pB0,6)};pw1=(u32x4){PKW(pB0,8),PKW(pB0,10),PKW(pB0,12),PKW(pB0,14)};pw2=(u32x4){PKW(pB1,0),PKW(pB1,2),PKW(pB1,4),PKW(pB1,6)};pw3=(u32x4){PKW(pB1,8),PKW(pB1,10),PKW(pB1,12),PKW(pB1,14)};
    SBAR(); pv(o,vb0+sl_cur,PAF(0),PAF(1),PAF(2),PAF(3)); }
  #undef PKW
  #undef PAF
  #undef VFR
  #undef PIN
  #undef MX3
  #undef GAPA
  #undef GAPB
  #undef EX
  #undef VRD
  #undef KRD
  #undef STEP
  #undef ENDW
  {auto rr=__builtin_amdgcn_permlane32_swap(__float_as_uint(l_reg),__float_as_uint(l_reg),false,false);l_reg=__uint_as_float(rr[0])+__uint_as_float(rr[1]);}
  if(hi==0)wsf[32+r32]=l_reg;asm volatile("s_waitcnt lgkmcnt(0)":::"memory");
  float rli[16];
  #pragma unroll
  for(int r=0;r<16;++r)rli[r]=__builtin_amdgcn_rcpf(wsf[32+crow(r,hi)]);
  bf16*Ow=O0+(long)(wid*QBLK)*OP;
  { bf16*stg=(bf16*)(shm+LDS_OST)+wid*2048;
    #pragma unroll
    for(int r=0;r<16;++r){const int orow=crow(r,hi);
      #pragma unroll
      for(int d0=0;d0<2;++d0)stg[orow*64+d0*32+r32]=__float2bfloat16(o[d0][r]*rli[r]);}
    asm volatile("s_waitcnt lgkmcnt(0)":::"memory");
    #pragma unroll
    for(int i=0;i<4;++i){const int row=i*8+(lane>>3),ch=lane&7; const u32x4 v=*(const u32x4*)(stg+row*64+ch*8); ATTN_STORE16(Ow+(long)row*OP+ch*8,v);} }
  asm volatile("s_waitcnt lgkmcnt(0)\n\ts_barrier":::"memory");
  #undef DMA_K
  #undef DMA_V
  #undef CMASK
  #undef START
  #undef RESC
  #undef ROT
}
constexpr int ATTN_LDS_BYTES=LDS_BYTES;
#undef SBAR
#undef WAIT_BAR
}

__device__ __forceinline__ void attn_phase_run(const P& p, unsigned char* lds_generic, int layer) {
    typedef attn_body::bf16 abf;
    const int G = gridDim.x, bx = blockIdx.x, vcu = (G % 8 == 0) ? (bx % 8) * (G / 8) + bx / 8 : bx;
    const abf* Q = (const abf*)(p.ws + WS_ATTQ); const abf* K = (const abf*)(p.ws + WS_ATTK); const abf* V = (const abf*)(p.ws + WS_ATTV); abf* X = (abf*)(p.ws + WS_X);
    if (G == 256) {
        const int x = vcu >> 5, qb = vcu & 31, b = x >> 2, kvh = (x >> 1) & 1;
#pragma unroll 1
        for (int i = 0; i < 2; ++i) { const int h = kvh * 4 + 2 * (x & 1) + i; const long r0 = (long)b * SEQ + qb * 256;
            attn_body::attn_unit<8>(Q + r0 * 512 + h * 64, K + (long)b * KEYS * 128 + kvh * 64, V + (long)b * KEYS * 128 + kvh * 64, X + r0 * 1536 + 768 + h * 64, KEYS / 64, (char*)lds_generic); }
    } else {
#pragma unroll 1
        for (int u = vcu; u < 512; u += G) { const int qb = u & 31, h = (u >> 5) & 7, b = u >> 8, kvh = h >> 2; const long r0 = (long)b * SEQ + qb * 256;
            attn_body::attn_unit<8>(Q + r0 * 512 + h * 64, K + (long)b * KEYS * 128 + kvh * 64, V + (long)b * KEYS * 128 + kvh * 64, X + r0 * 1536 + 768 + h * 64, KEYS / 64, (char*)lds_generic); }
    }
    if (layer == 0) {
#pragma unroll 1
        for (int u = vcu; u < 16; u += G) { const int b = u >> 3, h = u & 7, kvh = h >> 2; const long r0 = NLAT + (long)b * CTX;
            attn_body::attn_unit<8>(Q + r0 * 512 + h * 64, K + (long)b * KEYS * 128 + kvh * 64, V + (long)b * KEYS * 128 + kvh * 64, X + r0 * 1536 + 768 + h * 64, CTX / 64, (char*)lds_generic); }
    }
}

__device__ __forceinline__ void ph_fft1(const P& p, LAS unsigned char* lds, int layer) {
    int nt2 = 2; asm volatile("" : "+s"(nt2));
    { fg::PlainSched S{(const char*)(p.ws + WS_F1), (const char*)(p.ws + WS_UT), 256, 256, 1, 128, (int)gridDim.x, (int)blockIdx.x, nt2};
      fg::EpiFft1 E{p.ws}; fg::gemm_phase(lds, 256, 256, S, E); }
    if (layer == 0) { fg::PlainSched S{(const char*)(p.ws + WS_FC), (const char*)(p.ws + WS_UTC), 256, 256, 2, 2, (int)gridDim.x, (int)((blockIdx.x + 128) % gridDim.x), 4};
      fg::EpiFftC E{p.ws}; fg::gemm_phase(lds, 256, 256, S, E); }
}
__device__ __forceinline__ void ph_fft3(const P& p, LAS unsigned char* lds) {
    int nt2 = 2; asm volatile("" : "+s"(nt2));
    fg::PlainSched S{(const char*)(p.ws + WS_F2), (const char*)(p.ws + WS_Z), 256, 256, 1, 256, (int)gridDim.x, (int)blockIdx.x, nt2};
    fg::EpiFft3 E{p.ws}; fg::gemm_phase(lds, 256, 256, S, E);
}
__device__ __forceinline__ void ph_mix1(const P& p, LAS unsigned char* lds, int layer) {
    ph_fft1(p, lds, layer);
    const int nconv = layer == 0 ? 264 : 256;
    const int n0 = nconv, n1 = n0 + NB * NCHUNK * 4;
    for (int it = gridDim.x - 1 - blockIdx.x; it < n1; it += gridDim.x) {
        if (it < n0) { if (it < 256) conv_item(p, lds, layer, it >> 7, (it & 127) * 64); else conv_item(p, lds, layer, 2 + ((it - 256) >> 2), ((it - 256) & 3) * 64); }
        else ret_kv_item(p, lds, layer, it - n0);
    }
    __syncthreads();
}
__device__ __forceinline__ void ph_mix2(const P& p, LAS unsigned char* lds, unsigned char* lds_generic, int layer) {
    for (int it = blockIdx.x; it < 128; it += gridDim.x) ret_scan_item(p, layer, it);
    __syncthreads();
    ph_fft3(p, lds);
    attn_phase_run(p, lds_generic, layer);
    __syncthreads();
}
__device__ __forceinline__ void ph_mix3(const P& p, LAS unsigned char* lds, int layer, bool ctxlater) {
    for (int it = blockIdx.x; it < NB * NCHUNK * 4; it += gridDim.x) {
        const int n = (it >> 2) % NCHUNK; if ((layer == 1 || ctxlater) && n < 2) continue;
        ret_out_item(p, lds, layer, it);
    }
    __syncthreads();
}
__device__ __forceinline__ void ctx_ret_items(const P& p, LAS unsigned char* lds) {
    const int u = blockIdx.x;
    if (u < 16) { const int b = u >> 3, n = (u >> 2) & 1, h = u & 3;
        ret_out_item(p, lds, 0, (b * NCHUNK + n) * 4 + h);
        asm volatile("s_waitcnt vmcnt(0)" ::: "memory"); __syncthreads();
        if (threadIdx.x == 0) { __builtin_amdgcn_fence(__ATOMIC_RELEASE, "agent");
            __hip_atomic_fetch_add((unsigned*)(p.ws + WS_CTL) + CW_CCNT + (8 * 3) * 16, 1u, __ATOMIC_RELAXED, __HIP_MEMORY_SCOPE_AGENT); }
        __syncthreads(); }
}
__device__ __forceinline__ void ctx_ret_wait(const P& p) {
    if (threadIdx.x == 0) { unsigned* c = (unsigned*)(p.ws + WS_CTL) + CW_CCNT + (8 * 3) * 16; unsigned* tmo = (unsigned*)(p.ws + WS_CTL) + CW_TMO; unsigned sp = 0u;
        while (__hip_atomic_load(c, __ATOMIC_RELAXED, __HIP_MEMORY_SCOPE_AGENT) < 16u) { __builtin_amdgcn_s_sleep(1);
            if ((++sp & 255u) == 0u) { if (__hip_atomic_load(tmo, __ATOMIC_RELAXED, __HIP_MEMORY_SCOPE_AGENT)) break; if (sp > (1u << 22)) { atomicAdd(tmo, 1u); break; } } }
        __builtin_amdgcn_fence(__ATOMIC_ACQUIRE, "agent"); }
    __syncthreads();
}

namespace sk {
typedef short bf16x8 __attribute__((ext_vector_type(8)));
__device__ __forceinline__ void tile64(LAS unsigned char* lds, const bf16* A, int lda, const bf16* Bt, int ldb, int K, float (&out)[8]) {
    const int tid = threadIdx.x, lane = tid & 63, w = tid >> 6, kc = K >> 3;
    const bf16* ap = A + (size_t)(lane & 15) * lda + w * kc + 8 * (lane >> 4); const bf16* bp = Bt + (size_t)(lane & 15) * ldb + w * kc + 8 * (lane >> 4);
    f32x4 acc[4][4];
#pragma unroll
    for (int i = 0; i < 4; ++i)
#pragma unroll
        for (int j = 0; j < 4; ++j) acc[i][j] = (f32x4){0.f, 0.f, 0.f, 0.f};
#pragma unroll 2
    for (int k0 = 0; k0 < kc; k0 += 32) {
        bf16x8 af[4], bfr[4];
#pragma unroll
        for (int i = 0; i < 4; ++i) { af[i] = *(const bf16x8*)(ap + (size_t)(16 * i) * lda + k0); bfr[i] = *(const bf16x8*)(bp + (size_t)(16 * i) * ldb + k0); }
#pragma unroll
        for (int i = 0; i < 4; ++i)
#pragma unroll
            for (int j = 0; j < 4; ++j) acc[i][j] = __builtin_amdgcn_mfma_f32_16x16x32_bf16(af[i], bfr[j], acc[i][j], 0, 0, 0);
    }
    LAS float* part = (LAS float*)lds;
    __syncthreads();
#pragma unroll
    for (int i = 0; i < 4; ++i)
#pragma unroll
        for (int j = 0; j < 4; ++j)
#pragma unroll
            for (int r = 0; r < 4; ++r) part[((w * 16 + i * 4 + j) * 4 + r) * 64 + lane] = acc[i][j][r];
    __syncthreads();
#pragma unroll
    for (int q = 0; q < 8; ++q) { float sacc = 0.f;
#pragma unroll
        for (int ww = 0; ww < 8; ++ww) sacc += part[ww * 4096 + tid + 512 * q];
        out[q] = sacc; }
}
__device__ __forceinline__ void tile64_f8(LAS unsigned char* lds, const unsigned char* A, int lda, const unsigned char* Bt, int ldb, int K, float (&out)[8]) {
    const int tid = threadIdx.x, lane = tid & 63, w = tid >> 6;
    const unsigned char* ap = A + (size_t)(lane & 15) * lda + 32 * (lane >> 4); const unsigned char* bp = Bt + (size_t)(lane & 15) * ldb + 32 * (lane >> 4);
    f32x4 acc[4][4];
#pragma unroll
    for (int i = 0; i < 4; ++i)
#pragma unroll
        for (int j = 0; j < 4; ++j) acc[i][j] = (f32x4){0.f, 0.f, 0.f, 0.f};
    for (int ks = w; ks * 128 < K; ks += 8) {
        fg::i32x8 af[4], bfr[4];
#pragma unroll
        for (int i = 0; i < 4; ++i) { af[i] = *(const fg::i32x8*)(ap + (size_t)(16 * i) * lda + ks * 128); bfr[i] = *(const fg::i32x8*)(bp + (size_t)(16 * i) * ldb + ks * 128); }
#pragma unroll
        for (int i = 0; i < 4; ++i)
#pragma unroll
            for (int j = 0; j < 4; ++j) acc[i][j] = __builtin_amdgcn_mfma_scale_f32_16x16x128_f8f6f4(af[i], bfr[j], acc[i][j], 0, 0, 0, 0x7f7f7f7f, 0, 0x7a7a7a7a);
    }
    LAS float* part = (LAS float*)lds;
    __syncthreads();
#pragma unroll
    for (int i = 0; i < 4; ++i)
#pragma unroll
        for (int j = 0; j < 4; ++j)
#pragma unroll
            for (int r = 0; r < 4; ++r) part[((w * 16 + i * 4 + j) * 4 + r) * 64 + lane] = acc[i][j][r];
    __syncthreads();
#pragma unroll
    for (int q = 0; q < 8; ++q) { float sacc = 0.f;
#pragma unroll
        for (int ww = 0; ww < 8; ++ww) sacc += part[ww * 4096 + tid + 512 * q];
        out[q] = sacc; }
}
__device__ __forceinline__ void elem_rc(int tid, int q, int& row, int& col) { const int e = tid + 512 * q, t16 = e >> 8, reg = (e >> 6) & 3, lane = e & 63; row = 16 * (t16 >> 2) + 4 * (lane >> 4) + reg; col = 16 * (t16 & 3) + (lane & 15); }
}
__device__ __forceinline__ void mini_merge_ctx(const P& p, LAS unsigned char* lds, int layer) {
    const bf16* X = (const bf16*)(p.ws + WS_X); const bf16* WB = (const bf16*)(p.ws + WS_WB) + (size_t)layer * 1024 * 1536; const unsigned char* G = (const unsigned char*)(p.ws + WS_G); bf16* Mg = (bf16*)(p.ws + WS_MERGED);
    for (int it = gridDim.x - 1 - blockIdx.x; it < (NCTX / 64) * 16; it += gridDim.x) { const int r0 = NLAT + (it >> 4) * 64, c0 = (it & 15) * 64;
        float tot[8];
#pragma unroll
        for (int q = 0; q < 8; ++q) tot[q] = 0.f;
#pragma unroll 1
        for (int br = 0; br < 4; ++br) { const int koff = br == 0 ? 0 : (br == 1 ? 512 : (br == 2 ? 768 : 1280)), klen = (br & 1) ? 256 : 512;
            float o[8]; sk::tile64(lds, X + (size_t)r0 * 1536 + koff, 1536, WB + (size_t)c0 * 1536 + koff, 1536, klen, o);
#pragma unroll
            for (int q = 0; q < 8; ++q) { int rr, cc; sk::elem_rc(threadIdx.x, q, rr, cc); tot[q] += o[q] * ((float)G[(size_t)(r0 + rr) * 4096 + br * 1024 + c0 + cc] * (1.f / 255.f)); } }
#pragma unroll
        for (int q = 0; q < 8; ++q) { int rr, cc; sk::elem_rc(threadIdx.x, q, rr, cc); Mg[(size_t)(r0 + rr) * 1024 + c0 + cc] = f2bf(tot[q]); } }
    __syncthreads();
}
__device__ __forceinline__ void mini_resid_ctx(const P& p, LAS unsigned char* lds, int layer, const bf16* A, int lda, const bf16* Bt, int K, int chunk, int xnorm = -1, int nlayer = 0, int nwhich = 0, const float* hsrc = nullptr) {
    const float* g = mods(p, layer, 2, chunk); float* hc = (float*)(p.ws + WS_HCTX); if (hsrc == nullptr) hsrc = hc;
    for (int it = gridDim.x - 1 - blockIdx.x; it < (NCTX / 64) * 16; it += gridDim.x) { const int rl = (it >> 4) * 64, c0 = (it & 15) * 64;
        float o[8]; sk::tile64(lds, A + (size_t)(NLAT + rl) * lda, lda, Bt + (size_t)c0 * K, K, K, o);
        if (xnorm < 0) {
#pragma unroll
            for (int q = 0; q < 8; ++q) { int rr, cc; sk::elem_rc(threadIdx.x, q, rr, cc); float* h = hc + (size_t)(rl + rr) * D + c0 + cc; *h = *h + g[c0 + cc] * o[q]; }
        } else {
#pragma unroll
            for (int q = 0; q < 8; ++q) { int rr, cc; sk::elem_rc(threadIdx.x, q, rr, cc); float* h = hc + (size_t)(rl + rr) * D + c0 + cc;
                __hip_atomic_store(h, hsrc[(size_t)(rl + rr) * D + c0 + cc] + g[c0 + cc] * o[q], __ATOMIC_RELAXED, __HIP_MEMORY_SCOPE_AGENT); }
            asm volatile("s_waitcnt vmcnt(0)" ::: "memory"); __syncthreads();
            if (threadIdx.x == 0) { unsigned* c = (unsigned*)(p.ws + WS_CTL) + CW_CCNT + (8 * xnorm + (it >> 4)) * 16; unsigned* tmo = (unsigned*)(p.ws + WS_CTL) + CW_TMO;
                __hip_atomic_fetch_add(c, 1u, __ATOMIC_RELAXED, __HIP_MEMORY_SCOPE_AGENT);
                unsigned sp = 0u;
                while (__hip_atomic_load(c, __ATOMIC_RELAXED, __HIP_MEMORY_SCOPE_AGENT) < 16u) { __builtin_amdgcn_s_sleep(1);
                    if ((++sp & 255u) == 0u) { if (__hip_atomic_load(tmo, __ATOMIC_RELAXED, __HIP_MEMORY_SCOPE_AGENT)) break; if (sp > (1u << 22)) { atomicAdd(tmo, 1u); break; } } }
                __builtin_amdgcn_fence(__ATOMIC_ACQUIRE, "agent"); }
            __syncthreads();
            { const int w = threadIdx.x >> 6, lane = threadIdx.x & 63;
              if (w < 4) norm_row(p, nlayer, nwhich, NLAT + rl + (it & 15) * 4 + w, lane); }
            __syncthreads();
        } }
    __syncthreads();
}
__device__ __forceinline__ void ph_merge(const P& p, LAS unsigned char* lds, int layer, int nrows) {
    fg::MergeSched S{(const char*)(p.ws + WS_X), (const char*)(p.ws + WS_WB) + (size_t)layer * 1024 * 1536 * 2, nrows / 256, (int)gridDim.x, (int)blockIdx.x};
    fg::EpiMerge E{(const unsigned char*)(p.ws + WS_G), (bf16*)(p.ws + WS_MERGED)};
    fg::gemm_phase(lds, 1536, 1536, S, E);
}
__device__ __forceinline__ void ph_gemm_resid(const P& p, LAS unsigned char* lds, int layer, const bf16* A, int lda, const bf16* Bt, int K, int chunk, int nrows) {
    fg::PlainSched S{(const char*)A, (const char*)Bt, lda, K, nrows / 256, 4, (int)gridDim.x, (int)blockIdx.x, K / 64};
    fg::EpiResid E{p.out, (float*)(p.ws + WS_HCTX), (const float*)(p.ws + WS_MODS) + (size_t)layer * 3 * 6144, chunk};
    fg::gemm_phase(lds, lda, K, S, E);
}
__device__ __forceinline__ void ph_gemm_resid_norm(const P& p, LAS unsigned char* lds, int layer, const bf16* A, int lda, const bf16* Bt, int K, int chunk, int x, int nlayer, int nwhich, const float* hin) {
    fg::PlainSched S{(const char*)A, (const char*)Bt, lda, K, NLAT / 256, 4, (int)gridDim.x, (int)blockIdx.x, K / 64};
    unsigned* ctl = (unsigned*)(p.ws + WS_CTL);
    fg::EpiResidNorm E{hin, p.out, (const float*)(p.ws + WS_MODS) + (size_t)layer * 3 * 6144, chunk,
        p.in[nwhich == 0 ? 6 : 7] + nlayer * D, (const float*)(p.ws + WS_MODS) + (size_t)nlayer * 3 * 6144, nwhich == 0 ? 0 : 3, nwhich == 0 ? 1 : 4, (bf16*)(p.ws + WS_A), nwhich == 0 ? p.ws + WS_A8 : (unsigned char*)nullptr,
        (float*)(p.ws + WS_CTL + CTL_XBUF) + (size_t)x * 65536, ctl + CW_PCNT + 64 * 16 * x, ctl + CW_TMO, lds};
    fg::gemm_phase(lds, lda, K, S, E);
}
__device__ __forceinline__ void ph_ffn1(const P& p, LAS unsigned char* lds) {
    fg::PlainSched S{(const char*)(p.ws + WS_A), (const char*)(p.ws + WS_FFN1), D, D, MROWS / 256, 22, (int)gridDim.x, (int)blockIdx.x, D / 64};
    fg::EpiSwiglu E{(bf16*)(p.ws + WS_HMID)};
    fg::gemm_phase(lds, D, D, S, E);
}
__device__ __forceinline__ int moe_tiles(const P& p, LAS int* tile_e) {
    const unsigned* ctl = (const unsigned*)(p.ws + WS_CTL); int t = 0;
    for (int e = 0; e < NEXP; ++e) { const int c = (int)ctl[CW_CNT + e], nt = (c + 255) >> 8; for (int q = 0; q < nt; ++q) { if (threadIdx.x == 0) tile_e[t + q] = e; } t += nt; }
    __syncthreads();
    return t;
}
__device__ __forceinline__ void ph_assign_gather(const P& p, LAS unsigned char* lds) {
    const int tid = threadIdx.x, bid = blockIdx.x, G = gridDim.x;
    LAS int* sbase = (LAS int*)lds;
    LAS int* stot = sbase + 8;
    LAS int* spst = stot + 8;
    LAS int* sexp = spst + 16;
    LAS int* sslot = sexp + 128;
    const unsigned* cntb = (const unsigned*)(p.ws + WS_ROUTE) + 16384 * 6;
    const int* tok_e = (const int*)(p.ws + WS_ROUTE); int* tok_slot = (int*)(p.ws + WS_ROUTE) + 16384 * 4;
    __syncthreads();
    { const int e = tid >> 6, l = tid & 63; int tot = 0, below = 0;
      for (int b = l; b < G; b += 64) { const int c = (int)cntb[b * NEXP + e]; tot += c; if (b < bid) below += c; }
#pragma unroll
      for (int o = 1; o < 64; o <<= 1) { tot += __shfl_xor(tot, o); below += __shfl_xor(below, o); }
      if (l == 0) { sbase[e] = below; stot[e] = tot; } }
    if (tid < 128) { const int li = tid >> 1, w = li & 7, k = li >> 3, tok = (bid * 8 + w) + k * (G * 8); sexp[tid] = tok < NLAT ? tok_e[tok * 2 + (tid & 1)] : -1; }
    __syncthreads();
    if (tid == 0) { int t = 0; for (int e = 0; e < NEXP; ++e) { spst[e] = t * 256; t += (stot[e] + 255) >> 8; } spst[NEXP] = t * 256;
        if (bid == 0) { unsigned* ctl = (unsigned*)(p.ws + WS_CTL); for (int e = 0; e < NEXP; ++e) ctl[CW_CNT + e] = (unsigned)stot[e]; } }
    __syncthreads();
    if (tid < 128) { const int e = sexp[tid]; int slot = -1;
        if (e >= 0) { int rank = 0; for (int a = 0; a < tid; ++a) rank += (sexp[a] == e) ? 1 : 0; slot = spst[e] + sbase[e] + rank;
            const int li = tid >> 1, w = li & 7, k = li >> 3, tok = (bid * 8 + w) + k * (G * 8); tok_slot[tok * 2 + (tid & 1)] = slot; }
        sslot[tid] = slot; }
    __syncthreads();
    const int lane = tid & 63, wv = tid >> 6; const unsigned char* A8 = p.ws + WS_A8; unsigned char* FS8 = p.ws + WS_FS;
    for (int a = wv; a < 128; a += 8) { const int slot = sslot[a]; if (slot < 0) continue; const int li = a >> 1, w = li & 7, k = li >> 3, tok = (bid * 8 + w) + k * (G * 8);
        *(u32x4*)(FS8 + (size_t)slot * D + lane * 16) = *(const u32x4*)(A8 + (size_t)tok * D + lane * 16); }
    { int idx = 0;
      for (int e = 0; e < NEXP; ++e) { const int lo_ = spst[e] + stot[e], hi_ = spst[e + 1];
          for (int r = lo_ + ((bid * 8 + wv - idx) % (G * 8) + (G * 8)) % (G * 8); r < hi_; r += G * 8) {
              *(u32x4*)(FS8 + (size_t)r * D + lane * 16) = (u32x4){0u, 0u, 0u, 0u}; }
          idx += hi_ - lo_; } }
    __syncthreads();
}
__device__ __forceinline__ void ph_moe1(const P& p, LAS unsigned char* lds) {
    LAS int* tile_e = (LAS int*)(lds + fg::STAGE_BYTES); const int nt = moe_tiles(p, tile_e);
    fg::ExpertSched S{(const char*)(p.ws + WS_FS), (const char*)(p.ws + WS_MOE1), D / 2, D / 2, nt, 22, (int)gridDim.x, (int)blockIdx.x, D / 128, tile_e, (size_t)5632 * D};
    fg::EpiSwiglu8 E{p.ws + WS_HMOE};
    fg::gemm_phase<fg::EpiSwiglu8, fg::ExpertSched, true>(lds, D / 2, D / 2, S, E);
}
__device__ __forceinline__ void ph_moe2(const P& p, LAS unsigned char* lds) {
    LAS int* tile_e = (LAS int*)(lds + fg::STAGE_BYTES); const int nt = moe_tiles(p, tile_e);
    const int nbig = nt < 128 ? nt : 128;
    fg::ExpertSched S{(const char*)(p.ws + WS_HMOE), (const char*)(p.ws + WS_MOE2), FFN / 2, FFN / 2, nbig, 4, (int)gridDim.x, (int)blockIdx.x, FFN / 128, tile_e, (size_t)D * FFN};
    fg::EpiStore E{(bf16*)(p.ws + WS_Y2), D};
    fg::gemm_phase<fg::EpiStore, fg::ExpertSched, true>(lds, FFN / 2, FFN / 2, S, E);
    const unsigned char* A = p.ws + WS_HMOE; bf16* Y = (bf16*)(p.ws + WS_Y2);
    for (int it = blockIdx.x; it < (nt - nbig) * 64; it += gridDim.x) {
        const int rt = nbig + (it >> 6), r0 = rt * 256 + ((it >> 4) & 3) * 64, c0 = (it & 15) * 64;
        const unsigned char* B = p.ws + WS_MOE2 + (size_t)tile_e[rt] * D * FFN;
        float o[8]; sk::tile64_f8(lds, A + (size_t)r0 * FFN, FFN, B + (size_t)c0 * FFN, FFN, FFN, o);
#pragma unroll
        for (int q = 0; q < 8; ++q) { int rr, cc; sk::elem_rc(threadIdx.x, q, rr, cc); Y[(size_t)(r0 + rr) * D + c0 + cc] = f2bf(o[q]); } }
    __syncthreads();
}
__device__ __forceinline__ void ph_combine(const P& p, int layer) {
    const int lane = threadIdx.x & 63, gw = blockIdx.x * 8 + (threadIdx.x >> 6), ngw = gridDim.x * 8;
    const float* tok_w = (const float*)(p.ws + WS_ROUTE) + 16384 * 2; const int* tok_slot = (const int*)(p.ws + WS_ROUTE) + 16384 * 4; const bf16* Y = (const bf16*)(p.ws + WS_Y2);
    for (int r = gw; r < NLAT; r += ngw) {
        const int s0 = tok_slot[r * 2], s1 = tok_slot[r * 2 + 1]; const float w0 = tok_w[r * 2], w1 = tok_w[r * 2 + 1];
        const float* g = mods(p, layer, row_mi(r), 5); float* h = p.out + (size_t)r * D;
#pragma unroll
        for (int j = 0; j < 4; ++j) { const int c = 4 * lane + 256 * j;
            const u32x2 a = *(const u32x2*)(Y + (size_t)s0 * D + c), bq = *(const u32x2*)(Y + (size_t)s1 * D + c); const f32x4 gg = *(const f32x4*)(g + c); f32x4 hv = *(f32x4*)(h + c);
            hv.x += gg.x * (w0 * __uint_as_float(a.x << 16) + w1 * __uint_as_float(bq.x << 16)); hv.y += gg.y * (w0 * __uint_as_float(a.x & 0xffff0000u) + w1 * __uint_as_float(bq.x & 0xffff0000u));
            hv.z += gg.z * (w0 * __uint_as_float(a.y << 16) + w1 * __uint_as_float(bq.y << 16)); hv.w += gg.w * (w0 * __uint_as_float(a.y & 0xffff0000u) + w1 * __uint_as_float(bq.y & 0xffff0000u));
            *(f32x4*)(h + c) = hv; }
    }
}

#define XB_TMO      128
static_assert(CW_TMO == CW_BAR + XB_TMO, "tmo word");
static_assert(CW_CCNT + 4 * 8 * 16 <= 16384, "all zero-initialised control words lie in the first 64 KiB");
#define XB_XCNT(j)  (256  + 64 * (j))
#define XB_XSUB(j)  (1280 + 64 * (j))
#define XB_XGEN(j)  (2304 + 64 * (j))
#define XB_TOP      3328
#define XB_TOPGEN   3392
#define XCD_BAR_WORDS 3456
#define XB_SPIN_CAP (1u << 22)
__device__ __forceinline__ unsigned xb_ld(unsigned* p)              { return __hip_atomic_load(p, __ATOMIC_RELAXED, __HIP_MEMORY_SCOPE_AGENT); }
__device__ __forceinline__ unsigned xb_add(unsigned* p, unsigned v) { return __hip_atomic_fetch_add(p, v, __ATOMIC_RELAXED, __HIP_MEMORY_SCOPE_AGENT); }
__device__ __forceinline__ unsigned xb_xcc_id() { return (unsigned)__builtin_amdgcn_s_getreg((3 << 11) | 20) & 0xFu; }
#define XB_SPIN(cond, bar) do { unsigned _sp = 0; while (cond) { __builtin_amdgcn_s_sleep(1); \
    if ((++_sp & 255u) == 0u) { if (xb_ld(&(bar)[XB_TMO])) break; if (_sp > XB_SPIN_CAP) { atomicAdd(&(bar)[XB_TMO], 1u); break; } } } } while (0)
struct XcdBarrier { unsigned* bar; unsigned x; volatile LAS unsigned* st; };
__device__ __forceinline__ XcdBarrier xcd_barrier_post(unsigned* bar, volatile LAS unsigned* st) {
    XcdBarrier b; b.bar = bar; b.x = xb_xcc_id(); b.st = st;
    if (threadIdx.x == 0) (void)xb_add(&bar[XB_XCNT(b.x)], 1u);
    return b;
}
__device__ __forceinline__ void xcd_barrier_complete(unsigned* bar, unsigned x, unsigned& nloc, unsigned& nx) {
    const unsigned G = gridDim.x * gridDim.y * gridDim.z;
    unsigned sum, cnt, mine, sp = 0u;
    for (;;) {
        sum = 0u; cnt = 0u; mine = 0u;
#pragma unroll
        for (unsigned j = 0; j < 16; ++j) { const unsigned c = xb_ld(&bar[XB_XCNT(j)]); sum += c; cnt += (c > 0u) ? 1u : 0u; mine = (j == x) ? c : mine; }
        if (sum == G) break;
        __builtin_amdgcn_s_sleep(1);
        if ((++sp & 255u) == 0u) { if (xb_ld(&bar[XB_TMO])) break; if (sp > XB_SPIN_CAP) { atomicAdd(&bar[XB_TMO], 1u); break; } }
    }
    nloc = mine > 0u ? mine : 1u; nx = cnt > 0u ? cnt : 1u;
}
__device__ __forceinline__ void xcd_barrier(const XcdBarrier& b) {
    asm volatile("s_waitcnt vmcnt(0)" ::: "memory");
    __syncthreads();
    if (threadIdx.x == 0) {
        unsigned* bar = b.bar;
        __builtin_amdgcn_s_waitcnt(0);
        unsigned nloc = b.st[0], nx = b.st[1];
        if (nloc == 0u) { xcd_barrier_complete(bar, b.x, nloc, nx); b.st[0] = nloc; b.st[1] = nx; }
        const unsigned old = xb_add(&bar[XB_XSUB(b.x)], 1u);
        const unsigned gen = old / nloc;
        if (old + 1u == (gen + 1u) * nloc) {
            __builtin_amdgcn_fence(__ATOMIC_RELEASE, "agent");
            asm volatile("s_waitcnt vmcnt(0)" ::: "memory");
            const unsigned og = xb_add(&bar[XB_TOP], 1u);
            const unsigned tg = og / nx;
            if (og + 1u == (tg + 1u) * nx) xb_add(&bar[XB_TOPGEN], 1u);
            else XB_SPIN(xb_ld(&bar[XB_TOPGEN]) == tg, bar);
            __builtin_amdgcn_fence(__ATOMIC_ACQUIRE, "agent");
            xb_add(&bar[XB_XGEN(b.x)], 1u);
            asm volatile("s_waitcnt vmcnt(0)" ::: "memory");
        } else {
            XB_SPIN(xb_ld(&bar[XB_XGEN(b.x)]) == gen, bar);
            asm volatile("buffer_inv sc0" ::: "memory");
            asm volatile("s_waitcnt vmcnt(0)" ::: "memory");
        }
    }
    __syncthreads();
}

constexpr int NPHASE = 23;
constexpr int LDS_BYTES = 150 * 1024;
__global__ void __launch_bounds__(NTHREADS, 2) mk(P p, int lo, int hi, int fuse) {
    extern __shared__ __attribute__((aligned(16))) unsigned char lds_raw[];
    LAS unsigned char* lds = (LAS unsigned char*)lds_raw;
    volatile LAS unsigned* misc = (volatile LAS unsigned*)(lds + LDS_BYTES - 64);
    if (threadIdx.x < 16) misc[threadIdx.x] = 0u;
    __syncthreads();
    XcdBarrier bar; bar.bar = (unsigned*)(p.ws + WS_CTL) + CW_BAR; bar.x = 0; bar.st = misc;
    if (hi - lo > 1) bar = xcd_barrier_post((unsigned*)(p.ws + WS_CTL) + CW_BAR, misc);
#if MK_SINGLE
    cg::this_grid().sync();
#endif
#ifndef PROBE_MASK
#define PROBE_MASK 0u
#endif
#ifndef AMP_A
#define AMP_A (-1)
#define AMP_B (-1)
#define AMP_MUL 15
#endif
#define AMP(k) do { if ((k) == AMP_A && blockIdx.x == 0 && threadIdx.x == 0) { const unsigned long long t = __builtin_amdgcn_s_memrealtime(); misc[8] = (unsigned)t; } \
    if ((k) == AMP_B && blockIdx.x == 0 && threadIdx.x == 0) { const unsigned t1 = (unsigned)__builtin_amdgcn_s_memrealtime(), dt = (t1 - misc[8]) * AMP_MUL; while ((unsigned)__builtin_amdgcn_s_memrealtime() - t1 < dt) __builtin_amdgcn_s_sleep(8); } } while (0)
#define PH(k, body) do { if (lo <= (k) && (k) < hi) { if ((k) > lo) { xcd_barrier(bar); } AMP(k); body; \
    if ((PROBE_MASK >> (k)) & 1u) { xcd_barrier(bar); body; } } } while (0)
#define LAYER_PHASES(L, base) \
    PH(base + 0, ph_win(p, lds, L)); \
    PH(base + 1, ph_mix1(p, lds, L)); \
    PH(base + 2, ph_mix2(p, lds, lds_raw, L)); \
    PH(base + 3, ph_mix3(p, lds, L, fuse != 0)); \
    PH(base + 4, { if (L == 0 && fuse) ctx_ret_items(p, lds); ph_merge(p, lds, L, NLAT); if (L == 0) { if (fuse && (int)(gridDim.x - 1 - blockIdx.x) < (NCTX / 64) * 16) ctx_ret_wait(p); mini_merge_ctx(p, lds, L); } }); \
    PH(base + 5, { if (L == 0 && fuse) { ph_gemm_resid_norm(p, lds, 0, (const bf16*)(p.ws + WS_MERGED), 1024, (const bf16*)(p.ws + WS_WOUT), D, 2, 0, 0, 1, p.in[0]); mini_resid_ctx(p, lds, 0, (const bf16*)(p.ws + WS_MERGED), 1024, (const bf16*)(p.ws + WS_WOUT), D, 2, 0, 0, 1, p.in[2]); } \
        else { ph_gemm_resid(p, lds, L, (const bf16*)(p.ws + WS_MERGED), 1024, (const bf16*)(p.ws + WS_WOUT) + (size_t)L * D * D, D, 2, NLAT); if (L == 0) mini_resid_ctx(p, lds, L, (const bf16*)(p.ws + WS_MERGED), 1024, (const bf16*)(p.ws + WS_WOUT), D, 2); } });
    PH(0, ph_prologue(p, lds));
    PH(1, ph_norm(p, lds, 0, 0, true, false, MROWS, !fuse));
    LAYER_PHASES(0, 2)
    if (!fuse) PH(8, ph_norm(p, lds, 0, 1, false, false, MROWS));
    PH(9, ph_ffn1(p, lds));
    PH(10, { if (fuse) { ph_gemm_resid_norm(p, lds, 0, (const bf16*)(p.ws + WS_HMID), FFN, (const bf16*)(p.ws + WS_FFN2), FFN, 5, 1, 1, 0, p.out); mini_resid_ctx(p, lds, 0, (const bf16*)(p.ws + WS_HMID), FFN, (const bf16*)(p.ws + WS_FFN2), FFN, 5, 1, 1, 0); }
        else { ph_gemm_resid(p, lds, 0, (const bf16*)(p.ws + WS_HMID), FFN, (const bf16*)(p.ws + WS_FFN2), FFN, 5, NLAT); mini_resid_ctx(p, lds, 0, (const bf16*)(p.ws + WS_HMID), FFN, (const bf16*)(p.ws + WS_FFN2), FFN, 5); } });
    if (!fuse) PH(11, ph_norm(p, lds, 1, 0, false, false, MROWS));
    LAYER_PHASES(1, 12)
    PH(18, ph_norm(p, lds, 1, 1, false, true, NLAT));
    PH(19, { ph_assign_gather(p, lds); ph_moe_convert(p, lds); });
    PH(20, ph_moe1(p, lds));
    PH(21, ph_moe2(p, lds));
    PH(22, ph_combine(p, 1));
#undef PH
#undef LAYER_PHASES
}

extern "C" void kernel_launch(void* const* d_in, const int* in_sizes, int n_in, void* d_out, int out_size, void* d_ws, size_t ws_size, hipStream_t stream) {
    static int grid = 0;
    if (grid == 0) {
        if (n_in != 30 || out_size != NLAT * D || ws_size < WS_END) { fprintf(stderr, "kernel_launch: unexpected shapes (n_in %d out %d ws %zu)\n", n_in, out_size, ws_size); grid = -1; return; }
        int dev = 0, cus = 0, per_cu = 0;
        hipGetDevice(&dev); hipDeviceGetAttribute(&cus, hipDeviceAttributeMultiprocessorCount, dev);
        hipFuncSetAttribute((const void*)mk, hipFuncAttributeMaxDynamicSharedMemorySize, LDS_BYTES);
        hipOccupancyMaxActiveBlocksPerMultiprocessor(&per_cu, (const void*)mk, NTHREADS, LDS_BYTES);
        if (per_cu < 1) { fprintf(stderr, "kernel_launch: occupancy query says %d blocks per CU\n", per_cu); grid = -1; return; }
        grid = cus;
    }
    if (grid < 0) return;
    hipMemsetAsync((char*)d_ws + WS_CTL, 0, 64 * 1024, stream);
    P p{};
    for (int i = 0; i < 30; ++i) p.in[i] = (const float*)d_in[i];
    p.out = (float*)d_out; p.ws = (unsigned char*)d_ws;
#if MK_SINGLE
    int lo = 0, hi = NPHASE, fuse = grid == 256 ? 1 : 0; void* args[] = {&p, &lo, &hi, &fuse};
    hipLaunchCooperativeKernel((const void*)mk, dim3(grid), dim3(NTHREADS), args, LDS_BYTES, stream);
#else
    for (int ph = 0; ph < NPHASE; ++ph) hipLaunchKernelGGL(mk, dim3(grid), dim3(NTHREADS), LDS_BYTES, stream, p, ph, ph + 1, 0);
#endif
}
```

```cpp
#include <hip/hip_runtime.h>
#include <hip/hip_cooperative_groups.h>
#include <cstdio>
#include <cstdint>
namespace cg = cooperative_groups;

#ifndef MK_SINGLE
#define MK_SINGLE 1
#endif

typedef unsigned short bf16;
typedef float f32x4 __attribute__((ext_vector_type(4)));
typedef unsigned u32x4 __attribute__((ext_vector_type(4)));
typedef unsigned u32x2 __attribute__((ext_vector_type(2)));
#define LAS __attribute__((address_space(3)))

constexpr int D = 1024, NB = 2, SEQ = 8192, CTX = 256, NLAT = NB * SEQ, NCTX = NB * CTX, MROWS = NLAT + NCTX;
constexpr int INC = 6656, FFN = 2816, NEXP = 8, KEYS = CTX + SEQ;
constexpr int NCHUNK = 66;
constexpr float EPS = 1e-6f;
constexpr float QSCALE = 0.125f * 1.4426950408889634f;
constexpr int MOE_ROWS = 34816;
constexpr int NTHREADS = 512;

constexpr size_t MiB = 1u << 20;
constexpr size_t WS_CTL = 0, CTL_BYTES = 1 * MiB;
constexpr size_t WS_MODS = 1 * MiB;
constexpr size_t WS_ROPE = 2 * MiB;
constexpr size_t WS_F1 = 4 * MiB;
constexpr size_t WS_F2 = WS_F1 + 131072;
constexpr size_t WS_FC = WS_F2 + 131072;
constexpr size_t WS_TW = WS_FC + 262144;
constexpr size_t WS_ROUTE = 5 * MiB;
constexpr size_t WS_HCTX = 6 * MiB;
constexpr size_t WS_WIN = 8 * MiB;
constexpr size_t WS_WB = 34 * MiB;
constexpr size_t WS_WOUT = 40 * MiB;
constexpr size_t WS_FFN1 = 44 * MiB;
constexpr size_t WS_FFN2 = 55 * MiB;
constexpr size_t WS_A = 61 * MiB;
constexpr size_t WS_X = 94 * MiB;
constexpr size_t WS_Y = 144 * MiB;
constexpr size_t WS_RETQ = WS_Y;
constexpr size_t WS_RETK = WS_RETQ + (size_t)MROWS * 256 * 2;
constexpr size_t WS_RETV = WS_RETK + (size_t)MROWS * 256 * 2;
constexpr size_t WS_RETG = WS_RETV + (size_t)MROWS * 256 * 2;
constexpr size_t WS_ATTQ = WS_Y + 33 * MiB;
constexpr size_t WS_ATTK = WS_Y + 50 * MiB;
constexpr size_t WS_ATTV = WS_Y + 55 * MiB;
constexpr size_t WS_CONV = WS_Y + 60 * MiB;
constexpr size_t WS_UT = WS_Y + 77 * MiB;
constexpr size_t WS_UTC = WS_Y + 93 * MiB;
constexpr size_t WS_Z = WS_Y + 94 * MiB;
constexpr size_t WS_RETS = WS_Y + 126 * MiB;
constexpr size_t WS_MERGED = WS_Y + 143 * MiB;
constexpr size_t WS_G = 320 * MiB;
constexpr size_t WS_MOE1 = WS_G;
constexpr size_t WS_MOE2 = WS_G + (size_t)NEXP * 5632 * 1024 * 2;
constexpr size_t WS_HMID = WS_Y;
constexpr size_t WS_HMOE = 61 * MiB;
constexpr size_t WS_FS = 252 * MiB;
constexpr size_t WS_A8 = 386 * MiB;
constexpr size_t WS_WIN8 = 430 * MiB;
constexpr size_t WS_RETS2 = 452 * MiB;
constexpr size_t WS_Y2 = 160 * MiB;
constexpr size_t WS_END = 469 * MiB;
static_assert(WS_MERGED + (size_t)MROWS * 1024 * 2 <= WS_G, "map");
static_assert(WS_HMOE + (size_t)MOE_ROWS * FFN * 2 <= WS_FS && WS_FS + (size_t)MOE_ROWS * 1024 * 2 <= WS_G, "map moe");
static_assert(WS_MOE2 + (size_t)NEXP * 1024 * FFN * 2 <= WS_END, "map moe w");
static_assert(WS_G + (size_t)MROWS * 4096 <= WS_A8 && WS_A8 + (size_t)NLAT * 1024 <= WS_MOE2 && WS_MOE2 + (size_t)NEXP * 1024 * FFN <= WS_WIN8 && WS_WIN8 + (size_t)2 * 4096 * 1024 <= WS_RETS2, "map fp8 w_in");
constexpr int CW_CNT = 64;
constexpr int CW_CUR = 128;
constexpr int CW_BAR = 4096;
constexpr int CW_TMO = CW_BAR + 128;
constexpr int CW_PCNT = 8192;
constexpr int CW_CCNT = 8192 + 4 * 64 * 16;
constexpr size_t CTL_XBUF = 128 * 1024;

struct P {
    const float* in[30];
    float* out;
    unsigned char* ws;
};

__device__ __forceinline__ float bf2f(bf16 v) { return __uint_as_float((unsigned)v << 16); }
__device__ __forceinline__ bf16 f2bf(float f) { unsigned u = __float_as_uint(f); return (bf16)((u + 0x7fffu + ((u >> 16) & 1u)) >> 16); }
__device__ __forceinline__ unsigned pk2(float lo, float hi) { return (unsigned)f2bf(lo) | ((unsigned)f2bf(hi) << 16); }
__device__ __forceinline__ float sigmoidf_(float x) { return 1.f / (1.f + __expf(-x)); }
__device__ __forceinline__ float siluf_(float x) { return x / (1.f + __expf(-x)); }
__device__ __forceinline__ float sigmoid_fast(float x) { return __builtin_amdgcn_rcpf(1.f + __builtin_amdgcn_exp2f(-1.4426950408889634f * x)); }
__device__ __forceinline__ float silu_fast(float x) { return x * __builtin_amdgcn_rcpf(1.f + __builtin_amdgcn_exp2f(-1.4426950408889634f * x)); }
__device__ __forceinline__ float wave_sum(float v) {
#pragma unroll
    for (int o = 1; o < 64; o <<= 1) v += __shfl_xor(v, o);
    return v;
}
__device__ __forceinline__ int row_mi(int r) { return r < NLAT ? (r >> 13) : 2; }
__device__ __forceinline__ float* hrow(const P& p, int r) { return r < NLAT ? p.out + (size_t)r * D : (float*)(p.ws + WS_HCTX) + (size_t)(r - NLAT) * D; }
__device__ __forceinline__ const float* mods(const P& p, int layer, int mi, int chunk) { return (const float*)(p.ws + WS_MODS) + ((size_t)(layer * 3 + mi) * 6 + chunk) * D; }

__device__ __forceinline__ int rowmap(int mode, int n) {
    if (mode == 0) return n;
    if (mode == 1 || mode == 2) return 8 * (n >> 2) + (n & 3) + (mode == 2 ? 4 : 0);
    const int tile = n >> 8, l = n & 255, head = l >> 6, d = l & 63;
    const bool ropet = tile == 1 || tile == 2 || tile == 5 || tile == 6 || (tile == 7 && head < 2);
    if (ropet) { const int i = d & 31, nn = d >> 5; return tile * 256 + 128 * (i >> 4) + 32 * head + 8 * ((i >> 2) & 3) + 4 * nn + (i & 3); }
    if (tile == 7) return tile * 256 + 128 * (d >> 5) + 32 * head + 8 * ((d >> 3) & 3) + (d & 7);
    return n;
}
__device__ __forceinline__ void conv_tile(LAS float* scr, const float* src, int ldn, int k0, int n0, bf16* dst, int ldd, int koff, int mode) {
    const int tid = threadIdx.x;
    __syncthreads();
#pragma unroll
    for (int i = 0; i < 8; ++i) { const int e = tid + i * NTHREADS, kk = e >> 6, nn = e & 63; scr[kk * 65 + nn] = src[(size_t)(k0 + kk) * ldn + n0 + nn]; }
    __syncthreads();
    const int nn = tid >> 3, kc = (tid & 7) * 8;
    u32x4 o; o.x = pk2(scr[(kc + 0) * 65 + nn], scr[(kc + 1) * 65 + nn]); o.y = pk2(scr[(kc + 2) * 65 + nn], scr[(kc + 3) * 65 + nn]);
    o.z = pk2(scr[(kc + 4) * 65 + nn], scr[(kc + 5) * 65 + nn]); o.w = pk2(scr[(kc + 6) * 65 + nn], scr[(kc + 7) * 65 + nn]);
    *(u32x4*)(dst + (size_t)rowmap(mode, n0 + nn) * ldd + koff + k0 + kc) = o;
}
constexpr float F8_WSCALE = 32.f;
__device__ __forceinline__ unsigned pk4_fp8(float a, float b, float c, float d) { int w = 0; w = __builtin_amdgcn_cvt_pk_fp8_f32(a, b, w, false); w = __builtin_amdgcn_cvt_pk_fp8_f32(c, d, w, true); return (unsigned)w; }
__device__ __forceinline__ void conv_tile2_f8(LAS float* scr, const float* src, int ldn, unsigned char* dst8, int ldd, int mode, int k0a, int n0a, int k0b, int n0b, bool two) {
    const int tid = threadIdx.x;
    f32x4 va[2], vb[2];
#pragma unroll
    for (int i = 0; i < 2; ++i) { const int e = tid + i * NTHREADS, kk = e >> 4, n4 = (e & 15) * 4;
        va[i] = *(const f32x4*)(src + (size_t)(k0a + kk) * ldn + n0a + n4);
        if (two) vb[i] = *(const f32x4*)(src + (size_t)(k0b + kk) * ldn + n0b + n4); }
    __syncthreads();
#pragma unroll
    for (int i = 0; i < 2; ++i) { const int e = tid + i * NTHREADS, kk = e >> 4, n4 = (e & 15) * 4;
#pragma unroll
        for (int q = 0; q < 4; ++q) { scr[kk * 65 + n4 + q] = va[i][q]; if (two) scr[64 * 65 + kk * 65 + n4 + q] = vb[i][q]; } }
    __syncthreads();
    const int nn = tid >> 3, kc = (tid & 7) * 8;
#pragma unroll
    for (int t = 0; t < 2; ++t) { if (t == 1 && !two) break; const LAS float* sp = scr + t * 64 * 65; const int k0 = t ? k0b : k0a, n0 = t ? n0b : n0a;
        u32x2 o; o.x = pk4_fp8(sp[(kc + 0) * 65 + nn] * F8_WSCALE, sp[(kc + 1) * 65 + nn] * F8_WSCALE, sp[(kc + 2) * 65 + nn] * F8_WSCALE, sp[(kc + 3) * 65 + nn] * F8_WSCALE);
        o.y = pk4_fp8(sp[(kc + 4) * 65 + nn] * F8_WSCALE, sp[(kc + 5) * 65 + nn] * F8_WSCALE, sp[(kc + 6) * 65 + nn] * F8_WSCALE, sp[(kc + 7) * 65 + nn] * F8_WSCALE);
        *(u32x2*)(dst8 + (size_t)rowmap(mode, n0 + nn) * ldd + k0 + kc) = o; }
}
__device__ __forceinline__ void conv_tile128_f8(LAS float* scr, const float* src, int ldn, unsigned char* dst8, int ldd, int mode, int k0, int n0) {
    const int tid = threadIdx.x;
    f32x4 v[8];
#pragma unroll
    for (int i = 0; i < 8; ++i) { const int e = tid + i * NTHREADS, kk = e >> 5, n4 = (e & 31) * 4; v[i] = *(const f32x4*)(src + (size_t)(k0 + kk) * ldn + n0 + n4); }
    __syncthreads();
#pragma unroll
    for (int i = 0; i < 8; ++i) { const int e = tid + i * NTHREADS, kk = e >> 5, n4 = (e & 31) * 4;
#pragma unroll
        for (int q = 0; q < 4; ++q) scr[kk * 129 + n4 + q] = v[i][q]; }
    __syncthreads();
    const int nn = tid >> 2, kc = (tid & 3) * 32;
    u32x4 o[2];
#pragma unroll
    for (int h = 0; h < 2; ++h) { const LAS float* sp = scr + (kc + h * 16) * 129 + nn;
        o[h].x = pk4_fp8(sp[0] * F8_WSCALE, sp[129] * F8_WSCALE, sp[2 * 129] * F8_WSCALE, sp[3 * 129] * F8_WSCALE);
        o[h].y = pk4_fp8(sp[4 * 129] * F8_WSCALE, sp[5 * 129] * F8_WSCALE, sp[6 * 129] * F8_WSCALE, sp[7 * 129] * F8_WSCALE);
        o[h].z = pk4_fp8(sp[8 * 129] * F8_WSCALE, sp[9 * 129] * F8_WSCALE, sp[10 * 129] * F8_WSCALE, sp[11 * 129] * F8_WSCALE);
        o[h].w = pk4_fp8(sp[12 * 129] * F8_WSCALE, sp[13 * 129] * F8_WSCALE, sp[14 * 129] * F8_WSCALE, sp[15 * 129] * F8_WSCALE); }
    unsigned char* d = dst8 + (size_t)rowmap(mode, n0 + nn) * ldd + k0 + kc;
    *(u32x4*)d = o[0]; *(u32x4*)(d + 16) = o[1];
}
__device__ __forceinline__ void conv_tile4(LAS float* scr, const float* src, int ldn, int nn, int cnt, int i, int st, bf16* dst, int ldd, int koff, int mode) {
    const int tid = threadIdx.x, kk = tid >> 4, n4 = (tid & 15) * 4;
    f32x4 v[4][2];
#pragma unroll
    for (int t = 0; t < 4; ++t) { const int it = i + t * st; if (it < cnt) { const int k0 = (it / nn) * 64, n0 = (it % nn) * 64;
#pragma unroll
        for (int h = 0; h < 2; ++h) v[t][h] = *(const f32x4*)(src + (size_t)(k0 + kk + 32 * h) * ldn + n0 + n4); } }
    __syncthreads();
#pragma unroll
    for (int t = 0; t < 4; ++t) if (i + t * st < cnt) {
#pragma unroll
        for (int h = 0; h < 2; ++h)
#pragma unroll
            for (int q = 0; q < 4; ++q) scr[t * 64 * 65 + (kk + 32 * h) * 65 + n4 + q] = v[t][h][q]; }
    __syncthreads();
    const int nr = tid >> 3, kc = (tid & 7) * 8;
#pragma unroll
    for (int t = 0; t < 4; ++t) { const int it = i + t * st; if (it < cnt) { const int k0 = (it / nn) * 64, n0 = (it % nn) * 64; const LAS float* sp = scr + t * 64 * 65;
        u32x4 o; o.x = pk2(sp[(kc + 0) * 65 + nr], sp[(kc + 1) * 65 + nr]); o.y = pk2(sp[(kc + 2) * 65 + nr], sp[(kc + 3) * 65 + nr]);
        o.z = pk2(sp[(kc + 4) * 65 + nr], sp[(kc + 5) * 65 + nr]); o.w = pk2(sp[(kc + 6) * 65 + nr], sp[(kc + 7) * 65 + nr]);
        *(u32x4*)(dst + (size_t)rowmap(mode, n0 + nr) * ldd + koff + k0 + kc) = o; } }
}
struct CJob { const float* src; int K, N; bf16* dst; int ldd, koff, mode, ldn; };
__device__ __forceinline__ CJob get_job(const P& p, int j) {
    CJob c;
    if (j < 10) { const int l = j / 5, t = j % 5; bf16* wb = (bf16*)(p.ws + WS_WB) + (size_t)l * 1024 * 1536;
        if (t == 0) c = CJob{p.in[8] + (size_t)l * D * INC, D, l == 0 ? INC : 2560, (bf16*)(p.ws + WS_WIN) + (size_t)l * INC * D, D, 0, 3, INC};
        else if (t == 1) c = CJob{p.in[13] + (size_t)l * 256 * D, 256, D, wb, 1536, 512, 0};
        else if (t == 2) c = CJob{p.in[16] + (size_t)l * 512 * D, 512, D, wb, 1536, 768, 0};
        else if (t == 3) c = CJob{p.in[21] + (size_t)l * 256 * D, 256, D, wb, 1536, 1280, 0};
        else c = CJob{p.in[22] + (size_t)l * D * D, D, D, (bf16*)(p.ws + WS_WOUT) + (size_t)l * D * D, D, 0, 0}; }
    else if (j == 10) c = CJob{p.in[23], D, FFN, (bf16*)(p.ws + WS_FFN1), D, 0, 1};
    else if (j == 11) c = CJob{p.in[24], D, FFN, (bf16*)(p.ws + WS_FFN1), D, 0, 2};
    else c = CJob{p.in[25], FFN, D, (bf16*)(p.ws + WS_FFN2), FFN, 0, 0};
    return c;
}
__device__ __forceinline__ CJob get_moe_job(const P& p, int j) {
    const int e = j / 3, t = j % 3; CJob c;
    const float* sg = p.in[27]; const float* su = p.in[28]; const float* sd = p.in[29];
    asm volatile("" : "+s"(sg), "+s"(su), "+s"(sd));
    if (t == 0) c = CJob{sg + (size_t)e * D * FFN, D, FFN, (bf16*)(p.ws + WS_MOE1 + (size_t)e * 5632 * D), D, 0, 1};
    else if (t == 1) c = CJob{su + (size_t)e * D * FFN, D, FFN, (bf16*)(p.ws + WS_MOE1 + (size_t)e * 5632 * D), D, 0, 2};
    else c = CJob{sd + (size_t)e * FFN * D, FFN, D, (bf16*)(p.ws + WS_MOE2 + (size_t)e * D * FFN), FFN, 0, 0};
    return c;
}
template <bool MOE> __device__ __forceinline__ void run_conv_jobs(const P& p, LAS float* scr, int njobs, int bid, int nb) {
    int base = 0, base2 = 0;
    for (int j = 0; j < njobs; ++j) {
        const CJob jb = MOE ? get_moe_job(p, j) : get_job(p, j); const int nn = jb.N / 64, cnt = (jb.K / 64) * nn, ldn = jb.ldn ? jb.ldn : jb.N;
        const int first = ((bid - base) % nb + nb) % nb;
        if (MOE) { const int nn2 = jb.N / 128, cnt2 = (jb.K / 128) * nn2; const int first2 = ((bid - base2) % nb + nb) % nb;
            for (int i = first2; i < cnt2; i += nb) conv_tile128_f8(scr, jb.src, jb.N, (unsigned char*)jb.dst, jb.ldd, jb.mode, (i / nn2) * 128, (i % nn2) * 128);
            base2 += cnt2; }
        else for (int i = first; i < cnt; i += 4 * nb) conv_tile4(scr, jb.src, ldn, nn, cnt, i, nb, jb.dst, jb.ldd, jb.koff, jb.mode);
        base += cnt;
    }
}
__device__ __forceinline__ void ph_prologue(const P& p, LAS unsigned char* lds) {
    const int tid = threadIdx.x, bid = blockIdx.x, nb = gridDim.x;
    const int gt = bid * NTHREADS + tid, ngt = nb * NTHREADS;
    LAS float* scr = (LAS float*)lds;
    run_conv_jobs<false>(p, scr, 13, bid, nb);
    __syncthreads();
    for (int i = bid; i < 512; i += nb) { const int l = i >> 8, t = i & 255;
        conv_tile128_f8(scr, p.in[8] + (size_t)l * D * INC + 2560, INC, p.ws + WS_WIN8 + (size_t)l * 4096 * 1024, 1024, 0, (t >> 5) * 128, (t & 31) * 128); }
    __syncthreads();
    {
        LAS float* tc = (LAS float*)lds; LAS float* tsn = tc + 64;
        __syncthreads();
        if (tid < 64) { tc[tid] = cospif(tid * (2.f / 64.f)); tsn[tid] = sinpif(tid * (2.f / 64.f)); }
        __syncthreads();
        const float s = 1.0f / sqrtf(64.f * 8192.f);
        for (int e = gt; e < 2 * 512 * 1024; e += ngt) {
            const int n = e & 1023, kk = (e >> 10) & 511, l = e >> 19;
            const int part = kk >> 8, g = (kk >> 6) & 3, c = kk & 63;
            const float* W = p.in[9] + (size_t)l * 256 * D + (size_t)(g * 64) * D + n;
            float acc = 0.f;
#pragma unroll
            for (int c2 = 0; c2 < 64; ++c2) { const int m = (c * c2) & 63; const float t = part == 0 ? tc[m] : -tsn[m]; acc += t * W[(size_t)c2 * D]; }
            ((bf16*)(p.ws + WS_WB))[(size_t)l * 1024 * 1536 + (size_t)n * 1536 + kk] = f2bf(acc * s);
        }
        __syncthreads();
    }
    {
        float* rc = (float*)(p.ws + WS_ROPE); float* rs = rc + SEQ * 32;
        for (int e = gt; e < SEQ * 32; e += ngt) {
            const int s = e >> 5, i = e & 31; const float inv = powf(10000.f, -(float)(i & 15) / 16.f);
            const float pos = (float)(i < 16 ? (s >> 6) : (s & 63)); const float ang = pos * inv;
            rc[e] = cosf(ang); rs[e] = sinf(ang);
        }
    }
    {
        bf16* F1 = (bf16*)(p.ws + WS_F1); bf16* F2 = (bf16*)(p.ws + WS_F2); bf16* FC = (bf16*)(p.ws + WS_FC);
        for (int e = gt; e < 256 * 256; e += ngt) {
            const int rho = e >> 8, n1 = e & 255; float v = 0.f;
            if (n1 < 128) { const int k1 = (rho >> 5) * 16 + (rho & 15), c = (rho >> 4) & 1, m = (k1 * n1) & 127; v = c == 0 ? cospif(m * (2.f / 128.f)) : -sinpif(m * (2.f / 128.f)); }
            F1[e] = f2bf(v);
            float w = 0.f;
            if (rho < 128 && n1 < 128) { const int c2 = rho >> 6, k2 = rho & 63, c = n1 >> 6, n2 = n1 & 63, m = (k2 * n2) & 63; const float cs = cospif(m * (2.f / 64.f)), sn = sinpif(m * (2.f / 64.f));
                w = c2 == 0 ? (c == 0 ? cs : sn) : (c == 0 ? sn : -cs); }
            F2[e] = f2bf(w);
        }
        float* TW = (float*)(p.ws + WS_TW);
        for (int e = gt; e < 128 * 64; e += ngt) { const int k1 = e >> 6, n2 = e & 63; TW[2 * e] = cospif((k1 * n2) * (2.f / 8192.f)); TW[2 * e + 1] = sinpif((k1 * n2) * (2.f / 8192.f)); }
        const float sc = sqrtf(32.f);
        for (int e = gt; e < 512 * 256; e += ngt) { const int rho = e >> 8, n = e & 255, c2 = rho >> 8, k = rho & 255, m = (k * n) & 255; FC[e] = f2bf(sc * (c2 == 0 ? cospif(m * (2.f / 256.f)) : sinpif(m * (2.f / 256.f)))); }
    }
    {
        LAS float* sv = (LAS float*)lds;
        LAS float* red = sv + 3 * 1024;
        __syncthreads();
        for (int e = tid; e < 3 * 1024; e += NTHREADS) { const int j = e >> 10, k = e & 1023; const float v = j < 2 ? p.in[1][j * D + k] : p.in[3][k]; sv[e] = siluf_(v); }
        __syncthreads();
        const int kq = tid >> 6, cl = tid & 63;
        for (int it = bid; it < 2 * 96; it += nb) {
            const int l = it / 96, n = (it % 96) * 64 + cl;
            const float* W = p.in[4] + (size_t)l * D * 6144 + n;
            float a0 = 0.f, a1 = 0.f, a2 = 0.f;
#pragma unroll 32
            for (int k = kq; k < D; k += 8) { const float w = W[(size_t)k * 6144]; a0 += sv[k] * w; a1 += sv[1024 + k] * w; a2 += sv[2048 + k] * w; }
            red[(kq * 3 + 0) * 64 + cl] = a0; red[(kq * 3 + 1) * 64 + cl] = a1; red[(kq * 3 + 2) * 64 + cl] = a2;
            __syncthreads();
            if (tid < 192) { const int j = tid >> 6; float s = 0.f;
#pragma unroll
                for (int q = 0; q < 8; ++q) s += red[(q * 3 + j) * 64 + cl];
                ((float*)(p.ws + WS_MODS))[(size_t)(l * 3 + j) * 6144 + n] = s + p.in[5][l * 6144 + n]; }
            __syncthreads();
        }
    }
}
__device__ __forceinline__ void ph_moe_convert(const P& p, LAS unsigned char* lds) {
    LAS float* scr = (LAS float*)lds;
    const int bid = blockIdx.x, nb = gridDim.x;
    run_conv_jobs<true>(p, scr, 24, bid, nb);
    __syncthreads();
}

__device__ __forceinline__ void ph_norm(const P& p, LAS unsigned char* lds, int layer, int which, bool first, bool route, int nrows, bool copy = true) {
    LAS unsigned* cnt_lds = (LAS unsigned*)lds;
    if (route) { __syncthreads(); if (threadIdx.x < NEXP) cnt_lds[threadIdx.x] = 0u; __syncthreads(); }
    const int lane = threadIdx.x & 63, gw = blockIdx.x * 8 + (threadIdx.x >> 6), ngw = gridDim.x * 8;
    const float* gain = p.in[which == 0 ? 6 : 7] + layer * D;
    bf16* A = (bf16*)(p.ws + WS_A);
    for (int r = gw; r < nrows; r += ngw) {
        const int mi = row_mi(r);
        const float* src = first ? (r < NLAT ? p.in[0] + (size_t)r * D : p.in[2] + (size_t)(r - NLAT) * D) : hrow(p, r);
        const float* shift = mods(p, layer, mi, which == 0 ? 0 : 3); const float* scale = mods(p, layer, mi, which == 0 ? 1 : 4);
        f32x4 v[4]; float ss = 0.f;
#pragma unroll
        for (int j = 0; j < 4; ++j) { v[j] = *(const f32x4*)(src + 4 * lane + 256 * j); ss += v[j].x * v[j].x + v[j].y * v[j].y + v[j].z * v[j].z + v[j].w * v[j].w; }
        if (first && copy) { float* h = hrow(p, r);
#pragma unroll
            for (int j = 0; j < 4; ++j) *(f32x4*)(h + 4 * lane + 256 * j) = v[j]; }
        const float rstd = rsqrtf(wave_sum(ss) * (1.f / D) + EPS);
        float lg[8];
#pragma unroll
        for (int e = 0; e < 8; ++e) lg[e] = 0.f;
#pragma unroll
        for (int j = 0; j < 4; ++j) {
            const int c = 4 * lane + 256 * j;
            const f32x4 g = *(const f32x4*)(gain + c), sc = *(const f32x4*)(scale + c), sh = *(const f32x4*)(shift + c);
            f32x4 y = v[j] * rstd * g * (sc + 1.f) + sh;
            u32x2 o; o.x = pk2(y.x, y.y); o.y = pk2(y.z, y.w);
            if (!route) *(u32x2*)(A + (size_t)r * D + c) = o;
            if ((which == 0 || route) && r < NLAT) *(unsigned*)(p.ws + WS_A8 + (size_t)r * D + c) = pk4_fp8(y.x, y.y, y.z, y.w);
            if (route) {
                const float* rw = p.in[26] + (size_t)c * 8;
#pragma unroll
                for (int q = 0; q < 4; ++q) { const f32x4 w0 = *(const f32x4*)(rw + q * 8), w1 = *(const f32x4*)(rw + q * 8 + 4); const float yy = y[q];
                    lg[0] += yy * w0.x; lg[1] += yy * w0.y; lg[2] += yy * w0.z; lg[3] += yy * w0.w; lg[4] += yy * w1.x; lg[5] += yy * w1.y; lg[6] += yy * w1.z; lg[7] += yy * w1.w; }
            }
        }
        if (route) {
#pragma unroll
            for (int e = 0; e < 8; ++e) lg[e] = wave_sum(lg[e]);
            if (lane == 0) {
                int e0 = 0; float v0 = lg[0];
#pragma unroll
                for (int e = 1; e < 8; ++e) if (lg[e] > v0) { v0 = lg[e]; e0 = e; }
                int e1 = -1; float v1 = -INFINITY;
#pragma unroll
                for (int e = 0; e < 8; ++e) if (e != e0 && lg[e] > v1) { v1 = lg[e]; e1 = e; }
                const float w0 = 1.f / (1.f + expf(v1 - v0));
                int* tok_e = (int*)(p.ws + WS_ROUTE); float* tok_w = (float*)(p.ws + WS_ROUTE) + 16384 * 2;
                tok_e[r * 2] = e0; tok_e[r * 2 + 1] = e1; tok_w[r * 2] = w0; tok_w[r * 2 + 1] = 1.f - w0;
                __hip_atomic_fetch_add(cnt_lds + e0, 1u, __ATOMIC_RELAXED, __HIP_MEMORY_SCOPE_WORKGROUP); __hip_atomic_fetch_add(cnt_lds + e1, 1u, __ATOMIC_RELAXED, __HIP_MEMORY_SCOPE_WORKGROUP);
            }
        }
    }
    if (route) { __syncthreads(); if (threadIdx.x < NEXP) ((unsigned*)(p.ws + WS_ROUTE) + 16384 * 6)[blockIdx.x * NEXP + threadIdx.x] = cnt_lds[threadIdx.x]; __syncthreads(); }
}

__device__ __forceinline__ void norm_row(const P& p, int layer, int which, int r, int lane) {
    const float* gain = p.in[which == 0 ? 6 : 7] + layer * D; bf16* A = (bf16*)(p.ws + WS_A);
    const int mi = row_mi(r); const float* src = hrow(p, r);
    const float* shift = mods(p, layer, mi, which == 0 ? 0 : 3); const float* scale = mods(p, layer, mi, which == 0 ? 1 : 4);
    f32x4 v[4]; float ss = 0.f;
#pragma unroll
    for (int j = 0; j < 4; ++j) { v[j] = *(const f32x4*)(src + 4 * lane + 256 * j); ss += v[j].x * v[j].x + v[j].y * v[j].y + v[j].z * v[j].z + v[j].w * v[j].w; }
    const float rstd = rsqrtf(wave_sum(ss) * (1.f / D) + EPS);
#pragma unroll
    for (int j = 0; j < 4; ++j) { const int c = 4 * lane + 256 * j;
        const f32x4 g = *(const f32x4*)(gain + c), sc = *(const f32x4*)(scale + c), sh = *(const f32x4*)(shift + c);
        const f32x4 y = v[j] * rstd * g * (sc + 1.f) + sh;
        u32x2 o; o.x = pk2(y.x, y.y); o.y = pk2(y.z, y.w);
        *(u32x2*)(A + (size_t)r * D + c) = o; }
}

namespace fg {
typedef short bf16x8 __attribute__((ext_vector_type(8)));
constexpr int BM = 256, BK = 64, HALF = 128, HTB = HALF * BK * 2, STAGE_BYTES = 8 * HTB, NXCD = 8, WGM = 8;
__device__ __forceinline__ int lds_byte(int r, int c) { const int st = (r >> 4) * 2 + (c >> 5), rr = r & 15, cc = c & 31, ob = rr * 64 + cc * 2; return st * 1024 + (ob ^ (((ob >> 9) & 1) << 5)); }
__device__ __forceinline__ void stage_rc(int b, int& R, int& C) { const int st = b / 1024, sb = b % 1024, swz = sb ^ (((sb >> 9) & 1) << 5); R = (st >> 1) * 16 + swz / 64; C = (st & 1) * 32 + (swz % 64) / 2; }
__device__ __forceinline__ int perm32(int rho) { const int n = rho >> 4, i = rho & 15; return 8 * (i >> 2) + 4 * n + (i & 3); }
struct Unit { int pm, pn; const char* A; const char* B; int nt, aux; };
__device__ __forceinline__ bool tile_order(int i, int nM, int nN, int G, int c, int& pm, int& pn) {
    const int nwg = nM * nN; const long L = (long)i * G + c; if (L >= nwg) return false;
    int wgid = (int)L; { const int q = nwg / NXCD, r = nwg % NXCD, xcd = wgid % NXCD, off = wgid / NXCD; wgid = (xcd < r ? xcd * (q + 1) : r * (q + 1) + (xcd - r) * q) + off; }
    const int nig = WGM * nN, gid = wgid / nig, fm = gid * WGM, gsz = (nM - fm) < WGM ? (nM - fm) : WGM;
    pm = fm + ((wgid % nig) % gsz); pn = (wgid % nig) / gsz; return true;
}
struct PlainSched {
    const char* Abase; const char* Bbase; int lda, ldb, nM, nN, G, c, nt;
    __device__ __forceinline__ int arow(int R) const { return R; }
    __device__ __forceinline__ int ahalf() const { return HALF; }
    __device__ __forceinline__ bool next(int i, Unit& u) const { if (!tile_order(i, nM, nN, G, c, u.pm, u.pn)) return false;
        u.A = Abase + (size_t)u.pm * BM * lda * 2; u.B = Bbase + (size_t)u.pn * BM * ldb * 2; u.nt = nt; u.aux = 0; return true; }
};
struct ExpertSched {
    const char* Abase; const char* Bbase; int lda, ldb, nM, nN, G, c, nt; const LAS int* tile_e; size_t estride;
    __device__ __forceinline__ int arow(int R) const { return R; }
    __device__ __forceinline__ int ahalf() const { return HALF; }
    __device__ __forceinline__ bool next(int i, Unit& u) const { if (!tile_order(i, nM, nN, G, c, u.pm, u.pn)) return false;
        u.A = Abase + (size_t)u.pm * BM * lda * 2; u.B = Bbase + (size_t)tile_e[u.pm] * estride + (size_t)u.pn * BM * ldb * 2; u.nt = nt; u.aux = 0; return true; }
};
struct WinSched {
    const char* Abase; const char* Bbase; int G, c, mode, nN;
    __device__ __forceinline__ int arow(int R) const { return mode == 0 ? 256 * (R & 15) + 64 * ((R >> 4) & 3) + (R >> 6) : R; }
    __device__ __forceinline__ int ahalf() const { return mode == 0 ? 4096 : HALF; }
    __device__ __forceinline__ bool next(int i, Unit& u) const { if (!tile_order(i, mode == 0 ? 64 : 2, nN, G, c, u.pm, u.pn)) return false;
        const size_t row0 = mode == 0 ? (size_t)((u.pm >> 5) * SEQ + 2 * (u.pm & 31)) : (size_t)(NLAT + u.pm * CTX);
        u.A = Abase + row0 * D * 2; u.B = Bbase + (size_t)u.pn * BM * D * 2; u.nt = D / 64; u.aux = mode; return true; }
};
struct MergeSched {
    const char* Xbase; const char* Wbase; int nM, G, c;
    __device__ __forceinline__ int arow(int R) const { return R; }
    __device__ __forceinline__ int ahalf() const { return HALF; }
    __device__ __forceinline__ bool next(int i, Unit& u) const { if (!tile_order(i >> 2, nM, 4, G, c, u.pm, u.pn)) return false;
        const int br = i & 3, koff = br == 0 ? 0 : (br == 1 ? 512 : (br == 2 ? 768 : 1280));
        u.A = Xbase + ((size_t)u.pm * BM * 1536 + koff) * 2; u.B = Wbase + ((size_t)u.pn * BM * 1536 + koff) * 2; u.nt = (br & 1) ? 4 : 8; u.aux = br; return true; }
};
template <class E, class = void> struct is_chain { static constexpr bool v = false; };
template <class E> struct is_chain<E, decltype((void)E::CHAIN)> { static constexpr bool v = E::CHAIN; };
typedef f32x4 Acc[2][2][4][2];
typedef int i32x4 __attribute__((ext_vector_type(4))); typedef int i32x8 __attribute__((ext_vector_type(8)));
__device__ __forceinline__ i32x8 ld32(const LAS unsigned char* p) { const i32x4 a = *(const LAS i32x4*)p, b = *(const LAS i32x4*)(p + 16); return __builtin_shufflevector(a, b, 0, 1, 2, 3, 4, 5, 6, 7); }
template <class Epi, class Sched, bool F8 = false>
__device__ __forceinline__ void gemm_phase(LAS unsigned char* lds, int lda, int ldb, const Sched& S, const Epi& E) {
    int tid_ = threadIdx.x; asm volatile("" : "+v"(tid_));
    const int tid = tid_, wid = __builtin_amdgcn_readfirstlane(tid >> 6), lane = tid & 63, wr = wid >> 2, wc = wid & 3, fr = lane & 15, fq = lane >> 4;
    unsigned voffA[2], voffB[2];
#pragma unroll
    for (int i = 0; i < 2; ++i) { int R, C; stage_rc(tid * 16 + i * 8192, R, C); const int Rb = Epi::PERM ? ((R & ~31) + perm32(R & 31)) : R;
        voffA[i] = (unsigned)(S.arow(R) * lda + C) * 2u; voffB[i] = (unsigned)(Rb * ldb + C) * 2u; }
    const size_t kstep = (size_t)(BK * 2);
    const size_t hstepA = (size_t)S.ahalf() * lda * 2, hstepB = (size_t)HALF * ldb * 2;
    const unsigned ldsw = (unsigned)wid * 1024u;
    const int aoff = lds_byte(wr * 64 + fr, F8 ? fq * 16 : fq * 8), boff = lds_byte(wc * 32 + fr, F8 ? fq * 16 : fq * 8);
#define FG_SA(b, h) (((b) * 2 + (h)) * HTB)
#define FG_SB(b, h) ((4 + (b) * 2 + (h)) * HTB)
#define FG_STAGE(bufoff, gbase, voff) do { _Pragma("unroll") for (int _i = 0; _i < 2; ++_i) \
        __builtin_amdgcn_global_load_lds((const unsigned*)((const char*)(gbase) + (voff)[_i]), (LAS unsigned*)(lds + (bufoff) + ldsw + _i * 8192), 16, 0, 0); } while (0)
#define FG_LDA(dst, b, h) do { if constexpr (F8) { _Pragma("unroll") for (int m = 0; m < 4; ++m) dst##8[m] = ld32(lds + FG_SA(b, h) + aoff + m * 2048); } \
        else { _Pragma("unroll") for (int m = 0; m < 4; ++m) _Pragma("unroll") for (int k = 0; k < 2; ++k) dst[m][k] = *(const LAS bf16x8*)(lds + FG_SA(b, h) + aoff + m * 2048 + k * 1024); } } while (0)
#define FG_LDB(dst, b, h) do { if constexpr (F8) { _Pragma("unroll") for (int n = 0; n < 2; ++n) dst##8[n] = ld32(lds + FG_SB(b, h) + boff + n * 2048); } \
        else { _Pragma("unroll") for (int n = 0; n < 2; ++n) _Pragma("unroll") for (int k = 0; k < 2; ++k) dst[n][k] = *(const LAS bf16x8*)(lds + FG_SB(b, h) + boff + n * 2048 + k * 1024); } } while (0)
#define FG_MMA(ai, bj, At, Bt) do { __builtin_amdgcn_s_setprio(1); _Pragma("unroll") for (int m = 0; m < 4; ++m) _Pragma("unroll") for (int n = 0; n < 2; ++n) { \
        if constexpr (F8) asm volatile("v_mfma_scale_f32_16x16x128_f8f6f4 %0, %1, %2, %0, %3, %4 op_sel_hi:[0,0,0]" : "+v"(acc[ai][bj][m][n]) : "v"(Bt##8[n]), "v"(At##8[m]), "v"(scw), "v"(sca)); \
        else { _Pragma("unroll") for (int k = 0; k < 2; ++k) acc[ai][bj][m][n] = __builtin_amdgcn_mfma_f32_16x16x32_bf16(Bt[n][k], At[m][k], acc[ai][bj][m][n], 0, 0, 0); } } \
        __builtin_amdgcn_s_setprio(0); } while (0)
#define FG_WAIT_V(n) asm volatile("s_waitcnt vmcnt(" #n ")" ::: "memory")
#define FG_WAIT_L(n) asm volatile("s_waitcnt lgkmcnt(" #n ")" ::: "memory")
#define FG_BAR __builtin_amdgcn_s_barrier()
#define FG_SCHED __builtin_amdgcn_sched_barrier(0)
    Unit cur, nxt; int ui = 0;
    if (!S.next(0, cur)) return;
    Acc acc;
#pragma unroll
    for (int a = 0; a < 2; ++a)
#pragma unroll
        for (int b = 0; b < 2; ++b)
#pragma unroll
            for (int m = 0; m < 4; ++m)
#pragma unroll
                for (int n = 0; n < 2; ++n) acc[a][b][m][n] = (f32x4){0.f, 0.f, 0.f, 0.f};
    bf16x8 At[4][2], B0[2][2], B1[2][2]; i32x8 At8[4], B08[2], B18[2];
    const int scw = 0x7a7a7a7a, sca = 0x7f7f7f7f;
    const char* cA = cur.A; const char* cB = cur.B;
    FG_STAGE(FG_SB(0, 0), cB, voffB); FG_STAGE(FG_SB(0, 1), cB + hstepB, voffB); FG_STAGE(FG_SA(0, 0), cA, voffA); FG_STAGE(FG_SA(0, 1), cA + hstepA, voffA);
    if (wr == 1) FG_BAR;
    FG_WAIT_V(2); FG_BAR;
    FG_STAGE(FG_SB(1, 0), cB + kstep, voffB); FG_STAGE(FG_SA(1, 0), cA + kstep, voffA); FG_STAGE(FG_SB(1, 1), cB + hstepB + kstep, voffB);
    FG_WAIT_V(6); FG_BAR;
    for (;;) {
        const bool has_next = S.next(ui + 1, nxt);
        const char* nA = has_next ? nxt.A : cA; const char* nB = has_next ? nxt.B : cB;
        const int nt = cur.nt;
#pragma unroll 1
        for (int t = 0; t < nt; t += 2) {
            const bool last = (t == nt - 2);
            const char* a1 = cA + (size_t)(t + 1) * kstep;
            const char* a2 = last ? nA : cA + (size_t)(t + 2) * kstep; const char* b2 = last ? nB : cB + (size_t)(t + 2) * kstep;
            const char* a3 = a2 + kstep; const char* b3 = b2 + kstep;
            FG_LDB(B0, 0, 0); FG_LDB(B1, 0, 1); FG_SCHED; FG_LDA(At, 0, 0); FG_STAGE(FG_SA(1, 1), a1 + hstepA, voffA);
            FG_WAIT_V(8); FG_WAIT_L(0); FG_BAR; FG_MMA(0, 0, At, B0); FG_MMA(0, 1, At, B1); FG_BAR; FG_SCHED;
            FG_LDA(At, 0, 1); FG_STAGE(FG_SB(0, 0), b2, voffB); FG_STAGE(FG_SB(0, 1), b2 + hstepB, voffB); FG_STAGE(FG_SA(0, 0), a2, voffA);
            FG_WAIT_V(8); FG_WAIT_L(0); FG_BAR; FG_MMA(1, 0, At, B0); FG_MMA(1, 1, At, B1); FG_BAR; FG_SCHED;
            FG_LDB(B0, 1, 0); FG_LDB(B1, 1, 1); FG_SCHED; FG_LDA(At, 1, 0); FG_STAGE(FG_SA(0, 1), a2 + hstepA, voffA);
            FG_WAIT_V(8); FG_WAIT_L(0); FG_BAR; FG_MMA(0, 0, At, B0); FG_MMA(0, 1, At, B1); FG_BAR; FG_SCHED;
            FG_LDA(At, 1, 1); FG_STAGE(FG_SB(1, 0), b3, voffB); FG_STAGE(FG_SB(1, 1), b3 + hstepB, voffB); FG_STAGE(FG_SA(1, 0), a3, voffA);
            FG_WAIT_V(8); FG_WAIT_L(0); FG_BAR; FG_MMA(1, 0, At, B0); FG_MMA(1, 1, At, B1); FG_BAR; FG_SCHED;
        }
        if (wr == 0) FG_BAR;
        E(acc, cur, wr, wc, fr, fq);
        if (!has_next) break;
        if (!(is_chain<Epi>::v && cur.aux != 3)) {
#pragma unroll
        for (int a = 0; a < 2; ++a)
#pragma unroll
            for (int b = 0; b < 2; ++b)
#pragma unroll
                for (int m = 0; m < 4; ++m)
#pragma unroll
                    for (int n = 0; n < 2; ++n) acc[a][b][m][n] = (f32x4){0.f, 0.f, 0.f, 0.f};
        }
        cur = nxt; cA = nA; cB = nB; ++ui;
        if (wr == 1) FG_BAR;
    }
    FG_WAIT_V(0);
    FG_BAR;
#undef FG_SA
#undef FG_SB
#undef FG_STAGE
#undef FG_LDA
#undef FG_LDB
#undef FG_MMA
#undef FG_WAIT_V
#undef FG_WAIT_L
#undef FG_BAR
#undef FG_SCHED
}
__device__ __forceinline__ unsigned cvt_pk(float lo, float hi) { unsigned r; asm volatile("v_cvt_pk_bf16_f32 %0, %1, %2" : "=v"(r) : "v"(lo), "v"(hi)); return r; }
__device__ __forceinline__ u32x4 pack8(const f32x4 a, const f32x4 b) { u32x4 w; w.x = cvt_pk(a[0], a[1]); w.y = cvt_pk(a[2], a[3]); w.z = cvt_pk(b[0], b[1]); w.w = cvt_pk(b[2], b[3]); return w; }
__device__ __forceinline__ f32x4 unpk_u8(unsigned x) { const float k = 1.f / 255.f; return (f32x4){(float)(x & 0xffu) * k, (float)((x >> 8) & 0xffu) * k, (float)((x >> 16) & 0xffu) * k, (float)(x >> 24) * k}; }
__device__ __forceinline__ f32x4 unpk_u8r(unsigned x) { return (f32x4){(float)(x & 0xffu), (float)((x >> 8) & 0xffu), (float)((x >> 16) & 0xffu), (float)(x >> 24)}; }
__device__ __forceinline__ f32x4 unpk_lo(unsigned x, unsigned y) { return (f32x4){__uint_as_float(x << 16), __uint_as_float(x & 0xffff0000u), __uint_as_float(y << 16), __uint_as_float(y & 0xffff0000u)}; }

struct EpiWin {
    static constexpr bool PERM = true;
    unsigned char* ws; const float* qg; const float* kg;
    __device__ __forceinline__ void operator()(const Acc& acc, const Unit& u, int wr, int wc, int fr_, int fq_) const {
        int fr = fr_, fq = fq_; asm volatile("" : "+v"(fr), "+v"(fq));
        const int tile = u.pn; const bool LAT = u.aux == 0;
        if (tile == 0) {
            if (LAT) {
                const int b = u.pm >> 5, n2 = 2 * (u.pm & 31) + wr;
#pragma unroll
                for (int ai = 0; ai < 2; ++ai)
#pragma unroll
                    for (int bj = 0; bj < 2; ++bj) {
#pragma unroll
                        for (int n = 0; n < 2; ++n)
#pragma unroll
                            for (int e = 0; e < 4; ++e) { const int ch = bj * HALF + wc * 32 + 8 * fq + 4 * n + e;
                                u32x2 o; o.x = cvt_pk(acc[ai][bj][0][n][e], acc[ai][bj][1][n][e]); o.y = cvt_pk(acc[ai][bj][2][n][e], acc[ai][bj][3][n][e]);
                                *(u32x2*)((bf16*)(ws + WS_UT) + ((size_t)(b * 256 + ch) * 64 + n2) * 256 + 64 * ai + 4 * fr) = o; }
                        asm volatile("" ::: "memory"); }
            } else {
#pragma unroll
                for (int ai = 0; ai < 2; ++ai)
#pragma unroll
                    for (int m = 0; m < 4; ++m) { const int sx = ai * HALF + wr * 64 + m * 16 + fr;
#pragma unroll
                        for (int bj = 0; bj < 2; ++bj)
#pragma unroll
                            for (int n = 0; n < 2; ++n)
#pragma unroll
                                for (int e = 0; e < 4; ++e) { const int ch = bj * HALF + wc * 32 + 8 * fq + 4 * n + e;
                                    ((bf16*)(ws + WS_UTC))[(size_t)(u.pm * 256 + ch) * 256 + sx] = f2bf(acc[ai][bj][m][n][e]); }
                        asm volatile("" ::: "memory"); }
            }
            return;
        }
        const bool ropek = tile == 1 || tile == 2 || tile == 5 || tile == 6 || (tile == 7 && wc < 2);
        const bool keyrow = tile == 7;
        size_t boff; int pitch, col0;
        if (tile <= 4) { boff = WS_RETQ + (size_t)(tile - 1) * MROWS * 256 * 2; pitch = 256; col0 = ropek ? wc * 64 : wc * 32; }
        else if (tile <= 6) { boff = WS_ATTQ; pitch = 512; col0 = (tile - 5) * 256 + wc * 64; }
        else if (tile == 7) { boff = wc < 2 ? WS_ATTK : WS_ATTV; pitch = 128; col0 = (wc & 1) * 64; }
        else if (tile < 10) { boff = WS_CONV; pitch = 512; col0 = (tile - 8) * 256 + wc * 32; }
        else { boff = WS_G; pitch = 4096; col0 = (tile - 10) * 256 + wc * 32; }
        const bool head = ropek || tile == 7;
        bf16* const dbase = (bf16*)(ws + boff);
        const bool norm = tile >= 5 && ropek;
        const float* gp = tile == 7 ? kg : qg;
        const float osc = tile == 2 ? 0.125f : (tile == 5 || tile == 6 ? QSCALE : 1.f);
        const float* rc = (const float*)(ws + WS_ROPE);
#pragma unroll
        for (int ai = 0; ai < 2; ++ai) {
            f32x4 rcs[4][2], rsn[4][2];
            if (ropek && LAT) {
#pragma unroll
                for (int m = 0; m < 4; ++m)
#pragma unroll
                    for (int bj = 0; bj < 2; ++bj) { const int sx = 4096 * ai + 256 * fr + 64 * m + 2 * (u.pm & 31) + wr, i0 = 16 * bj + 4 * fq;
                        rcs[m][bj] = *(const f32x4*)(rc + sx * 32 + i0); rsn[m][bj] = *(const f32x4*)(rc + SEQ * 32 + sx * 32 + i0); } }
#pragma unroll
            for (int m = 0; m < 4; ++m) {
                const int b = LAT ? (u.pm >> 5) : u.pm, s = LAT ? (4096 * ai + 256 * fr + 64 * m + 2 * (u.pm & 31) + wr) : (ai * HALF + wr * 64 + m * 16 + fr);
                const int rr = keyrow ? b * KEYS + (LAT ? CTX + s : s) : (LAT ? b * SEQ + s : NLAT + b * CTX + s);
                bf16* const drow = dbase + ((size_t)rr * pitch + col0 + 8 * fq);
                if (ropek) {
                    float rstd = 1.f;
                    if (norm) { float ss = 0.f;
#pragma unroll
                        for (int bj = 0; bj < 2; ++bj)
#pragma unroll
                            for (int n = 0; n < 2; ++n) { const f32x4 x = acc[ai][bj][m][n]; ss += (x[0] * x[0] + x[1] * x[1]) + (x[2] * x[2] + x[3] * x[3]); }
                        ss += __shfl_xor(ss, 16); ss += __shfl_xor(ss, 32);
                        rstd = rsqrtf(ss * (1.f / 64.f) + EPS); }
#pragma unroll
                    for (int bj = 0; bj < 2; ++bj) {
                        const int i0 = 16 * bj + 4 * fq;
                        f32x4 x1 = acc[ai][bj][m][0], x2 = acc[ai][bj][m][1];
                        if (norm) { const f32x4 g1 = *(const f32x4*)(gp + i0), g2 = *(const f32x4*)(gp + 32 + i0); x1 = x1 * rstd * g1; x2 = x2 * rstd * g2; }
                        f32x4 o1 = x1, o2 = x2;
                        if (LAT) { const f32x4 cs = rcs[m][bj], sn = rsn[m][bj]; o1 = x1 * cs - x2 * sn; o2 = x1 * sn + x2 * cs; }
                        *(u32x4*)(drow + 32 * bj) = pack8(o1 * osc, o2 * osc);
                    }
                } else {
#pragma unroll
                    for (int bj = 0; bj < 2; ++bj) {
                        f32x4 a0 = acc[ai][bj][m][0], a1 = acc[ai][bj][m][1];
                        if (tile >= 10) {
                            u32x2 o; o.x = 0u; o.y = 0u;
#pragma unroll
                            for (int e = 0; e < 4; ++e) { o.x = __builtin_amdgcn_cvt_pk_u8_f32(__builtin_fmaxf(__builtin_floorf(sigmoid_fast(a0[e]) * 255.f + 0.5f), 1.f), e, o.x);
                                o.y = __builtin_amdgcn_cvt_pk_u8_f32(__builtin_fmaxf(__builtin_floorf(sigmoid_fast(a1[e]) * 255.f + 0.5f), 1.f), e, o.y); }
                            *(u32x2*)(ws + WS_G + (size_t)rr * 4096 + (tile - 10) * 256 + wc * 32 + 8 * fq + HALF * bj) = o;
                        } else *(u32x4*)(drow + (head ? 32 : HALF) * bj) = pack8(a0, a1);
                    }
                }
            }
        }
    }
};
struct EpiGate8 {
    static constexpr bool PERM = true;
    unsigned char* G;
    __device__ __forceinline__ void operator()(const Acc& acc, const Unit& u, int wr, int wc, int fr_, int fq_) const {
        int fr = fr_, fq = fq_; asm volatile("" : "+v"(fr), "+v"(fq));
#pragma unroll
        for (int ai = 0; ai < 2; ++ai)
#pragma unroll
            for (int m = 0; m < 4; ++m) { const int r = u.pm * BM + ai * HALF + wr * 64 + m * 16 + fr;
#pragma unroll
                for (int bj = 0; bj < 2; ++bj) { const f32x4 a0 = acc[ai][bj][m][0], a1 = acc[ai][bj][m][1]; u32x2 o; o.x = 0u; o.y = 0u;
#pragma unroll
                    for (int e = 0; e < 4; ++e) { o.x = __builtin_amdgcn_cvt_pk_u8_f32(__builtin_fmaxf(__builtin_floorf(sigmoid_fast(a0[e]) * 255.f + 0.5f), 1.f), e, o.x);
                        o.y = __builtin_amdgcn_cvt_pk_u8_f32(__builtin_fmaxf(__builtin_floorf(sigmoid_fast(a1[e]) * 255.f + 0.5f), 1.f), e, o.y); }
                    *(u32x2*)(G + (size_t)r * 4096 + u.pn * BM + bj * HALF + wc * 32 + 8 * fq) = o; } }
    }
};
struct EpiMerge {
    static constexpr bool PERM = true, CHAIN = true;
    const unsigned char* G; bf16* Mg;
    __device__ __forceinline__ void operator()(Acc& acc, const Unit& u, int wr, int wc, int fr_, int fq_) const {
        int fr = fr_, fq = fq_; asm volatile("" : "+v"(fr), "+v"(fq));
        const int br = u.aux; const bool lastb = br == 3;
#pragma unroll
        for (int ai = 0; ai < 2; ++ai) {
            u32x2 g[4][2], gn[4][2];
#pragma unroll
            for (int m = 0; m < 4; ++m)
#pragma unroll
                for (int bj = 0; bj < 2; ++bj) { const int r = u.pm * BM + ai * HALF + wr * 64 + m * 16 + fr, c = u.pn * BM + bj * HALF + wc * 32 + 8 * fq;
                    g[m][bj] = *(const u32x2*)(G + (size_t)r * 4096 + br * 1024 + c);
                    if (!lastb) gn[m][bj] = *(const u32x2*)(G + (size_t)r * 4096 + (br + 1) * 1024 + c); }
#pragma unroll
            for (int m = 0; m < 4; ++m)
#pragma unroll
                for (int bj = 0; bj < 2; ++bj) {
                    if (!lastb) {
                        const f32x4 n0 = unpk_u8r(g[m][bj].x), n1 = unpk_u8r(g[m][bj].y), d0 = unpk_u8r(gn[m][bj].x), d1 = unpk_u8r(gn[m][bj].y);
#pragma unroll
                        for (int e = 0; e < 4; ++e) { acc[ai][bj][m][0][e] *= n0[e] * __builtin_amdgcn_rcpf(d0[e]); acc[ai][bj][m][1][e] *= n1[e] * __builtin_amdgcn_rcpf(d1[e]); }
                    } else { const int r = u.pm * BM + ai * HALF + wr * 64 + m * 16 + fr, c = u.pn * BM + bj * HALF + wc * 32 + 8 * fq;
                        *(u32x4*)(Mg + (size_t)r * 1024 + c) = pack8(acc[ai][bj][m][0] * unpk_u8(g[m][bj].x), acc[ai][bj][m][1] * unpk_u8(g[m][bj].y)); } }
        }
    }
};
struct EpiResid {
    static constexpr bool PERM = false;
    float* out; float* hctx; const float* modbase; int chunk;
    __device__ __forceinline__ void operator()(const Acc& acc, const Unit& u, int wr, int wc, int fr_, int fq_) const {
        int fr = fr_, fq = fq_; asm volatile("" : "+v"(fr), "+v"(fq));
        const int rt = u.pm * BM;
        const float* g = modbase + ((size_t)row_mi(rt) * 6 + chunk) * D;
        f32x4 gg[2][2];
#pragma unroll
        for (int bj = 0; bj < 2; ++bj)
#pragma unroll
            for (int n = 0; n < 2; ++n) gg[bj][n] = *(const f32x4*)(g + u.pn * BM + bj * HALF + wc * 32 + 16 * n + 4 * fq);
#pragma unroll
        for (int ai = 0; ai < 2; ++ai) {
            f32x4 hv[4][2][2];
#pragma unroll
            for (int m = 0; m < 4; ++m) { const int r = rt + ai * HALF + wr * 64 + m * 16 + fr; const float* h = r < NLAT ? out + (size_t)r * D : hctx + (size_t)(r - NLAT) * D;
#pragma unroll
                for (int bj = 0; bj < 2; ++bj)
#pragma unroll
                    for (int n = 0; n < 2; ++n) hv[m][bj][n] = *(const f32x4*)(h + u.pn * BM + bj * HALF + wc * 32 + 16 * n + 4 * fq); }
#pragma unroll
            for (int m = 0; m < 4; ++m) { const int r = rt + ai * HALF + wr * 64 + m * 16 + fr; float* h = r < NLAT ? out + (size_t)r * D : hctx + (size_t)(r - NLAT) * D;
#pragma unroll
                for (int bj = 0; bj < 2; ++bj)
#pragma unroll
                    for (int n = 0; n < 2; ++n) *(f32x4*)(h + u.pn * BM + bj * HALF + wc * 32 + 16 * n + 4 * fq) = hv[m][bj][n] + gg[bj][n] * acc[ai][bj][m][n]; }
        }
    }
};
struct EpiResidNorm {
    static constexpr bool PERM = false;
    const float* hin; float* out; const float* modbase; int chunk;
    const float* gain; const float* nmods; int csh, csc; bf16* A; unsigned char* A8;
    float* xbuf; unsigned* cnt; unsigned* tmo; LAS unsigned char* lds;
    __device__ __forceinline__ void operator()(Acc& acc, const Unit& u, int wr, int wc, int fr_, int fq_) const {
        int fr = fr_, fq = fq_; asm volatile("" : "+v"(fr), "+v"(fq));
        const int wid = __builtin_amdgcn_readfirstlane((int)threadIdx.x >> 6), lane = threadIdx.x & 63;
        const int rt = u.pm * BM, mi = row_mi(rt);
        LAS float* Pt = (LAS float*)(lds + STAGE_BYTES);
        LAS float* St = (LAS float*)(lds + STAGE_BYTES + 4096);
        LAS unsigned* flag = (LAS unsigned*)(lds + STAGE_BYTES + 5120);
        { const float* g = modbase + ((size_t)mi * 6 + chunk) * D;
          f32x4 gg[2][2];
#pragma unroll
          for (int bj = 0; bj < 2; ++bj)
#pragma unroll
              for (int n = 0; n < 2; ++n) gg[bj][n] = *(const f32x4*)(g + u.pn * BM + bj * HALF + wc * 32 + 16 * n + 4 * fq);
#pragma unroll
          for (int am = 0; am < 4; ++am) { const int ai = am >> 1, m0 = (am & 1) * 2;
              f32x4 hv[2][2][2];
#pragma unroll
              for (int mm = 0; mm < 2; ++mm) { const float* h = hin + (size_t)(rt + ai * HALF + wr * 64 + (m0 + mm) * 16 + fr) * D;
#pragma unroll
                  for (int bj = 0; bj < 2; ++bj)
#pragma unroll
                      for (int n = 0; n < 2; ++n) hv[mm][bj][n] = *(const f32x4*)(h + u.pn * BM + bj * HALF + wc * 32 + 16 * n + 4 * fq); }
#pragma unroll
              for (int mm = 0; mm < 2; ++mm) { const int m = m0 + mm; float* h = out + (size_t)(rt + ai * HALF + wr * 64 + m * 16 + fr) * D; float ss = 0.f;
#pragma unroll
                  for (int bj = 0; bj < 2; ++bj)
#pragma unroll
                      for (int n = 0; n < 2; ++n) { const f32x4 x = hv[mm][bj][n] + gg[bj][n] * acc[ai][bj][m][n]; acc[ai][bj][m][n] = x;
                          *(f32x4*)(h + u.pn * BM + bj * HALF + wc * 32 + 16 * n + 4 * fq) = x; ss += (x[0] * x[0] + x[1] * x[1]) + (x[2] * x[2] + x[3] * x[3]); }
                  ss += __shfl_xor(ss, 16); ss += __shfl_xor(ss, 32);
                  if (fq == 0) Pt[(ai * HALF + wr * 64 + m * 16 + fr) * 4 + wc] = ss; }
              asm volatile("" ::: "memory");
          } }
        asm volatile("s_waitcnt lgkmcnt(0)" ::: "memory"); __builtin_amdgcn_s_barrier(); asm volatile("" ::: "memory");
        const int row = wid * 32 + (lane & 31);
        if (lane < 32) { const f32x4 q = *(const LAS f32x4*)(Pt + row * 4);
            __hip_atomic_store(xbuf + ((size_t)(rt + row) * 4 + u.pn), (q[0] + q[1]) + (q[2] + q[3]), __ATOMIC_RELAXED, __HIP_MEMORY_SCOPE_AGENT); }
        asm volatile("s_waitcnt vmcnt(0)" ::: "memory");
        if (lane == 0) __hip_atomic_fetch_add(cnt + 16 * u.pm, 1u, __ATOMIC_RELAXED, __HIP_MEMORY_SCOPE_AGENT);
        if (wid == 0) { unsigned sp = 0u, dead = 0u;
            while ((unsigned)__builtin_amdgcn_readfirstlane(__hip_atomic_load(cnt + 16 * u.pm, __ATOMIC_RELAXED, __HIP_MEMORY_SCOPE_AGENT)) < 32u) {
                __builtin_amdgcn_s_sleep(1);
                if ((++sp & 255u) == 0u) { if (__hip_atomic_load(tmo, __ATOMIC_RELAXED, __HIP_MEMORY_SCOPE_AGENT)) { dead = 1u; break; } if (sp > (1u << 22)) { if (lane == 0) atomicAdd(tmo, 1u); dead = 1u; break; } } }
            __builtin_amdgcn_fence(__ATOMIC_ACQUIRE, "agent");
            if (lane == 0) flag[0] = dead; }
        asm volatile("s_waitcnt vmcnt(0) lgkmcnt(0)" ::: "memory"); __builtin_amdgcn_s_barrier(); asm volatile("" ::: "memory");
        if (lane < 32) { const float* sl = xbuf + (size_t)(rt + row) * 4; float t = 0.f;
#pragma unroll
            for (int q = 0; q < 4; ++q) t += __hip_atomic_load(sl + q, __ATOMIC_RELAXED, __HIP_MEMORY_SCOPE_AGENT);
            St[row] = rsqrtf(t * (1.f / D) + EPS); }
        asm volatile("s_waitcnt lgkmcnt(0)" ::: "memory"); __builtin_amdgcn_s_barrier(); asm volatile("" ::: "memory");
        const float* shp = nmods + ((size_t)mi * 6 + csh) * D; const float* scp = nmods + ((size_t)mi * 6 + csc) * D;
        float rs[2][4];
#pragma unroll
        for (int ai = 0; ai < 2; ++ai)
#pragma unroll
            for (int m = 0; m < 4; ++m) rs[ai][m] = St[ai * HALF + wr * 64 + m * 16 + fr];
#pragma unroll
        for (int bj = 0; bj < 2; ++bj)
#pragma unroll
            for (int n = 0; n < 2; ++n) { const int c = u.pn * BM + bj * HALF + wc * 32 + 16 * n + 4 * fq;
                const f32x4 g4 = *(const f32x4*)(gain + c), sc4 = *(const f32x4*)(scp + c) + 1.f, sh4 = *(const f32x4*)(shp + c);
#pragma unroll
                for (int ai = 0; ai < 2; ++ai)
#pragma unroll
                    for (int m = 0; m < 4; ++m) { const f32x4 y = acc[ai][bj][m][n] * rs[ai][m] * g4 * sc4 + sh4;
                        u32x2 o; o.x = cvt_pk(y[0], y[1]); o.y = cvt_pk(y[2], y[3]);
                        *(u32x2*)(A + (size_t)(rt + ai * HALF + wr * 64 + m * 16 + fr) * D + c) = o;
                        if (A8) *(unsigned*)(A8 + (size_t)(rt + ai * HALF + wr * 64 + m * 16 + fr) * D + c) = pk4_fp8(y[0], y[1], y[2], y[3]); } }
    }
};
struct EpiSwiglu {
    static constexpr bool PERM = true;
    bf16* Hm;
    __device__ __forceinline__ void operator()(const Acc& acc, const Unit& u, int wr, int wc, int fr, int fq) const {
#pragma unroll
        for (int ai = 0; ai < 2; ++ai)
#pragma unroll
            for (int m = 0; m < 4; ++m) { const int r = u.pm * BM + ai * HALF + wr * 64 + m * 16 + fr;
#pragma unroll
                for (int bj = 0; bj < 2; ++bj) { const int c = u.pn * BM + bj * HALF + wc * 32 + 8 * fq; const f32x4 g = acc[ai][bj][m][0], up = acc[ai][bj][m][1];
                    u32x2 o; o.x = cvt_pk(silu_fast(g[0]) * up[0], silu_fast(g[1]) * up[1]); o.y = cvt_pk(silu_fast(g[2]) * up[2], silu_fast(g[3]) * up[3]);
                    *(u32x2*)(Hm + (size_t)r * FFN + (c >> 1)) = o; } }
    }
};
struct EpiSwiglu8 {
    static constexpr bool PERM = true;
    unsigned char* Hm;
    __device__ __forceinline__ void operator()(const Acc& acc, const Unit& u, int wr, int wc, int fr_, int fq_) const {
        int fr = fr_, fq = fq_; asm volatile("" : "+v"(fr), "+v"(fq));
#pragma unroll
        for (int ai = 0; ai < 2; ++ai)
#pragma unroll
            for (int m = 0; m < 4; ++m) { const int r = u.pm * BM + ai * HALF + wr * 64 + m * 16 + fr;
#pragma unroll
                for (int bj = 0; bj < 2; ++bj) { const int c = u.pn * BM + bj * HALF + wc * 32 + 8 * fq; const f32x4 g = acc[ai][bj][m][0], up = acc[ai][bj][m][1];
                    *(unsigned*)(Hm + (size_t)r * FFN + (c >> 1)) = pk4_fp8(silu_fast(g[0]) * up[0], silu_fast(g[1]) * up[1], silu_fast(g[2]) * up[2], silu_fast(g[3]) * up[3]); } }
    }
};
struct EpiStore {
    static constexpr bool PERM = true;
    bf16* O; int ldc;
    __device__ __forceinline__ void operator()(const Acc& acc, const Unit& u, int wr, int wc, int fr_, int fq_) const {
        int fr = fr_, fq = fq_; asm volatile("" : "+v"(fr), "+v"(fq));
#pragma unroll
        for (int ai = 0; ai < 2; ++ai)
#pragma unroll
            for (int m = 0; m < 4; ++m) { const int r = u.pm * BM + ai * HALF + wr * 64 + m * 16 + fr;
#pragma unroll
                for (int bj = 0; bj < 2; ++bj) { const int c = u.pn * BM + bj * HALF + wc * 32 + 8 * fq; *(u32x4*)(O + (size_t)r * ldc + c) = pack8(acc[ai][bj][m][0], acc[ai][bj][m][1]); } }
    }
};
struct EpiFft1 {
    static constexpr bool PERM = true;
    unsigned char* ws;
    __device__ __forceinline__ void operator()(const Acc& acc, const Unit& u, int wr, int wc, int fr, int fq) const {
        const float* TW = (const float*)(ws + WS_TW); bf16* Z = (bf16*)(ws + WS_Z);
#pragma unroll
        for (int ai = 0; ai < 2; ++ai)
#pragma unroll
            for (int mm = 0; mm < 2; ++mm) { const int k1 = (4 * ai + 2 * wr + mm) * 16 + fr;
#pragma unroll
                for (int bj = 0; bj < 2; ++bj) { const int c = u.pn * BM + bj * HALF + wc * 32 + 8 * fq, n2 = c & 63, ch = (c >> 6) & 255, b = c >> 14;
                    f32x4 zr[2], zi[2];
#pragma unroll
                    for (int n = 0; n < 2; ++n) { const f32x4 yr = acc[ai][bj][2 * mm][n], yi = acc[ai][bj][2 * mm + 1][n];
                        const f32x4 t0 = *(const f32x4*)(TW + (size_t)(k1 * 64 + n2 + 4 * n) * 2), t1 = *(const f32x4*)(TW + (size_t)(k1 * 64 + n2 + 4 * n) * 2 + 4);
                        const f32x4 ct = {t0[0], t0[2], t1[0], t1[2]}, st = {t0[1], t0[3], t1[1], t1[3]};
                        zr[n] = yr * ct + yi * st; zi[n] = yi * ct - yr * st; }
                    bf16* dst = Z + ((size_t)b * 32768 + k1 * 256 + ch) * 256 + n2;
                    *(u32x4*)dst = pack8(zr[0], zr[1]); *(u32x4*)(dst + 64) = pack8(zi[0], zi[1]);
                    asm volatile("" ::: "memory"); } }
    }
};
struct EpiFft3 {
    static constexpr bool PERM = true;
    unsigned char* ws;
    __device__ __forceinline__ void operator()(const Acc& acc, const Unit& u, int wr, int wc, int fr, int fq) const {
        bf16* X = (bf16*)(ws + WS_X);
#pragma unroll
        for (int m = 0; m < 4; ++m) { const int k2 = 16 * m + fr;
#pragma unroll
            for (int bj = 0; bj < 2; ++bj) { const int c = u.pn * BM + bj * HALF + wc * 32 + 8 * fq, ch = c & 255, k1 = (c >> 8) & 127, b = c >> 15;
                *(u32x4*)(X + (size_t)(b * SEQ + k1 + 128 * k2) * 1536 + wr * 256 + ch) = pack8(acc[0][bj][m][0], acc[0][bj][m][1]); } }
    }
};
struct EpiFftC {
    static constexpr bool PERM = true;
    unsigned char* ws;
    __device__ __forceinline__ void operator()(const Acc& acc, const Unit& u, int wr, int wc, int fr, int fq) const {
        bf16* X = (bf16*)(ws + WS_X);
#pragma unroll
        for (int ai = 0; ai < 2; ++ai)
#pragma unroll
            for (int m = 0; m < 4; ++m) { const int k = ai * HALF + wr * 64 + m * 16 + fr;
#pragma unroll
                for (int bj = 0; bj < 2; ++bj) { const int ch = bj * HALF + wc * 32 + 8 * fq;
                    *(u32x4*)(X + (size_t)(NLAT + u.pn * CTX + k) * 1536 + u.pm * 256 + ch) = pack8(acc[ai][bj][m][0], acc[ai][bj][m][1]); } }
    }
};
}

__device__ __forceinline__ void ph_win(const P& p, LAS unsigned char* lds, int layer) {
    const char* W = (const char*)(p.ws + WS_WIN) + (size_t)layer * INC * D * 2;
#pragma unroll 1
    for (int mode = 0; mode < 2; ++mode) {
        fg::WinSched S{(const char*)(p.ws + WS_A), W, (int)gridDim.x, (int)((blockIdx.x + mode * 128) % gridDim.x), mode, mode == 0 ? 10 : (layer == 0 ? 26 : 10)};
        fg::EpiWin E{p.ws, p.in[14] + layer * 64, p.in[15] + layer * 64};
        fg::gemm_phase(lds, D, D, S, E);
    }
    {
        fg::PlainSched S{(const char*)(p.ws + WS_A8), (const char*)(p.ws + WS_WIN8) + (size_t)layer * 4096 * 1024, D / 2, D / 2, NLAT / 256, 16, (int)gridDim.x, (int)blockIdx.x, D / 128};
        fg::EpiGate8 E{p.ws + WS_G};
        fg::gemm_phase<fg::EpiGate8, fg::PlainSched, true>(lds, D / 2, D / 2, S, E);
    }
}

__device__ __forceinline__ void conv_item(const P& p, LAS unsigned char* lds, int layer, int seqid, int t0) {
    const int tid = threadIdx.x; LAS float* y = (LAS float*)lds;
    const int L = seqid < 2 ? SEQ : CTX; const int rbase = seqid < 2 ? seqid * SEQ : NLAT + (seqid - 2) * CTX;
    const bf16* cv = (const bf16*)(p.ws + WS_CONV);
    __syncthreads();
    u32x4 pa[6], pg[6];
#pragma unroll
    for (int i = 0; i < 6; ++i) { const int e = tid + i * NTHREADS, tt = e >> 5, c8 = (e & 31) * 8, t = t0 - 15 + tt;
        if (e < 94 * 32 && t >= 0 && t < L) { const bf16* rowp = cv + (size_t)(rbase + t) * 512 + c8; pa[i] = *(const u32x4*)rowp; pg[i] = *(const u32x4*)(rowp + 256); } }
#pragma unroll
    for (int i = 0; i < 6; ++i) { const int e = tid + i * NTHREADS; if (e >= 94 * 32) break; const int tt = e >> 5, c8 = (e & 31) * 8, t = t0 - 15 + tt;
        f32x4 lo = {0.f, 0.f, 0.f, 0.f}, hi = lo;
        if (t >= 0 && t < L) { const u32x4 a = pa[i], g = pg[i];
            lo = (f32x4){__uint_as_float(a.x << 16) * sigmoidf_(__uint_as_float(g.x << 16)), __uint_as_float(a.x & 0xffff0000u) * sigmoidf_(__uint_as_float(g.x & 0xffff0000u)),
                         __uint_as_float(a.y << 16) * sigmoidf_(__uint_as_float(g.y << 16)), __uint_as_float(a.y & 0xffff0000u) * sigmoidf_(__uint_as_float(g.y & 0xffff0000u))};
            hi = (f32x4){__uint_as_float(a.z << 16) * sigmoidf_(__uint_as_float(g.z << 16)), __uint_as_float(a.z & 0xffff0000u) * sigmoidf_(__uint_as_float(g.z & 0xffff0000u)),
                         __uint_as_float(a.w << 16) * sigmoidf_(__uint_as_float(g.w << 16)), __uint_as_float(a.w & 0xffff0000u) * sigmoidf_(__uint_as_float(g.w & 0xffff0000u))}; }
        *(LAS f32x4*)(y + tt * 256 + c8) = lo; *(LAS f32x4*)(y + tt * 256 + c8 + 4) = hi; }
    __syncthreads();
    {
        const int ch = tid & 255, half = tid >> 8;
        float w[31];
#pragma unroll
        for (int k = 0; k < 31; ++k) w[k] = p.in[17][(size_t)layer * 31 * 256 + k * 256 + ch];
        const float bias = p.in[18][layer * 256 + ch];
        float o[4][8];
#pragma unroll
        for (int u = 0; u < 4; ++u) { const int tb = (half * 4 + u) * 8;
            float in[38];
#pragma unroll
            for (int q = 0; q < 38; ++q) in[q] = y[(tb + q) * 256 + ch];
#pragma unroll
            for (int q = 0; q < 8; ++q) { float a = bias;
#pragma unroll
                for (int k = 0; k < 31; ++k) a += in[q + k] * w[k];
                o[u][q] = a; } }
        __syncthreads();
#pragma unroll
        for (int u = 0; u < 4; ++u)
#pragma unroll
            for (int q = 0; q < 8; ++q) y[((half * 4 + u) * 8 + q) * 256 + ch] = o[u][q];
    }
    __syncthreads();
    const int wv = tid >> 6, lane = tid & 63;
    const f32x4 g = *(const f32x4*)(p.in[19] + layer * 256 + lane * 4), bb = *(const f32x4*)(p.in[20] + layer * 256 + lane * 4);
    for (int q = 0; q < 8; ++q) { const int t = wv * 8 + q;
        const f32x4 v = *(const LAS f32x4*)(y + t * 256 + lane * 4);
        const float mu = wave_sum(v.x + v.y + v.z + v.w) * (1.f / 256.f);
        const f32x4 dv = v - mu; const float var = wave_sum(dv.x * dv.x + dv.y * dv.y + dv.z * dv.z + dv.w * dv.w) * (1.f / 256.f);
        const float rstd = rsqrtf(var + EPS);
        f32x4 z = dv * rstd * g + bb;
        u32x2 ov; ov.x = pk2(siluf_(z.x), siluf_(z.y)); ov.y = pk2(siluf_(z.z), siluf_(z.w));
        *(u32x2*)((bf16*)(p.ws + WS_X) + (size_t)(rbase + t0 + t) * 1536 + 1280 + lane * 4) = ov; }
}

__device__ __forceinline__ int chunk_row0(int b, int n) { return n < 2 ? NLAT + b * CTX + n * 128 : b * SEQ + (n - 2) * 128; }
__device__ __forceinline__ float log_sigmoid(float x) { return x >= 0.f ? -log1pf(expf(-x)) : x - log1pf(expf(x)); }
namespace rt {
typedef short bf16x8 __attribute__((ext_vector_type(8)));
constexpr int PQ = 72, PJ = 136;
__device__ __forceinline__ f32x4 mma(bf16x8 a, bf16x8 b, f32x4 c) { return __builtin_amdgcn_mfma_f32_16x16x32_bf16(a, b, c, 0, 0, 0); }
__device__ __forceinline__ bf16x8 frag(const LAS bf16* base, int row, int pitch, int k0, int lane) { return *(const LAS bf16x8*)(base + (row + (lane & 15)) * pitch + k0 + 8 * (lane >> 4)); }
}
__device__ __forceinline__ void ret_kv_item(const P& p, LAS unsigned char* lds, int layer, int it) {
    using namespace rt;
    const int tid = threadIdx.x, lane = tid & 63, w = tid >> 6; const int h = it & 3, n = (it >> 2) % NCHUNK, b = (it >> 2) / NCHUNK;
    LAS bf16* KTf = (LAS bf16*)lds; LAS bf16* KTb = KTf + 64 * PJ; LAS bf16* VT = KTb + 64 * PJ;
    const int r0 = chunk_row0(b, n);
    const float lgf = log_sigmoid(p.in[10][layer * 4 + h]), lgb = log_sigmoid(p.in[11][layer * 4 + h]);
    __syncthreads();
    { const int j = tid & 127, dq = (tid >> 7) * 16;
      const bf16* K = (const bf16*)(p.ws + WS_RETK) + (size_t)(r0 + j) * 256 + h * 64 + dq; const bf16* V = (const bf16*)(p.ws + WS_RETV) + (size_t)(r0 + j) * 256 + h * 64 + dq;
      const float zf = expf((127.f - j) * lgf), zb = expf((float)j * lgb);
#pragma unroll
      for (int q8 = 0; q8 < 2; ++q8) { const u32x4 kw = *(const u32x4*)(K + q8 * 8), vw = *(const u32x4*)(V + q8 * 8);
          const unsigned kk[4] = {kw.x, kw.y, kw.z, kw.w}, vv[4] = {vw.x, vw.y, vw.z, vw.w};
#pragma unroll
          for (int q = 0; q < 4; ++q) { const int d = dq + q8 * 8 + 2 * q; const float k0 = __uint_as_float(kk[q] << 16), k1 = __uint_as_float(kk[q] & 0xffff0000u);
              KTf[d * PJ + j] = f2bf(k0 * zf); KTf[(d + 1) * PJ + j] = f2bf(k1 * zf); KTb[d * PJ + j] = f2bf(k0 * zb); KTb[(d + 1) * PJ + j] = f2bf(k1 * zb);
              VT[d * PJ + j] = (bf16)(vv[q] & 0xffffu); VT[(d + 1) * PJ + j] = (bf16)(vv[q] >> 16); } } }
    __syncthreads();
    const int fb = w >> 2, dt = w & 3; const LAS bf16* Am = fb == 0 ? KTf : KTb;
    f32x4 acc[4];
#pragma unroll
    for (int et = 0; et < 4; ++et) acc[et] = (f32x4){0.f, 0.f, 0.f, 0.f};
#pragma unroll
    for (int ks = 0; ks < 4; ++ks) { const bf16x8 af = frag(Am, dt * 16, PJ, ks * 32, lane);
#pragma unroll
        for (int et = 0; et < 4; ++et) acc[et] = mma(af, frag(VT, et * 16, PJ, ks * 32, lane), acc[et]); }
    float* S = (float*)(p.ws + WS_RETS) + ((size_t)((fb * 2 + b) * NCHUNK + n) * 4 + h) * 4096;
#pragma unroll
    for (int et = 0; et < 4; ++et)
#pragma unroll
        for (int r = 0; r < 4; ++r) S[(dt * 16 + 4 * (lane >> 4) + r) * 64 + et * 16 + (lane & 15)] = acc[et][r];
}
__device__ __forceinline__ void ret_scan_item(const P& p, int layer, int it) {
    const int e = it * NTHREADS + threadIdx.x;
    const int de = e & 4095, h = (e >> 12) & 3, b = (e >> 14) & 1, dir = e >> 15;
    const float lg = log_sigmoid(p.in[dir == 0 ? 10 : 11][layer * 4 + h]); const float g = expf(128.f * lg);
    float* S = (float*)(p.ws + WS_RETS) + (size_t)((dir * 2 + b) * NCHUNK) * 4 * 4096 + (size_t)h * 4096 + de;
    float kv[NCHUNK];
#pragma unroll
    for (int n = 0; n < NCHUNK; ++n) kv[n] = S[(size_t)n * 4 * 4096];
    float st = 0.f;
    if (dir == 0) {
#pragma unroll
        for (int n = 0; n < NCHUNK; ++n) { const float t = kv[n]; kv[n] = st; st = st * g + t; }
    } else {
#pragma unroll
        for (int i = 0; i < NCHUNK; ++i) { const int n = i < 2 ? 1 - i : NCHUNK + 1 - i; const float t = kv[n]; kv[n] = st; st = st * g + t; }
    }
    float* S2 = (float*)(p.ws + WS_RETS2) + (size_t)((dir * 2 + b) * NCHUNK) * 4 * 4096 + (size_t)h * 4096 + de;
#pragma unroll
    for (int n = 0; n < NCHUNK; ++n) S2[(size_t)n * 4 * 4096] = kv[n];
}
__device__ __forceinline__ void ret_out_item(const P& p, LAS unsigned char* lds, int layer, int it) {
    using namespace rt;
    const int tid = threadIdx.x, lane = tid & 63, w = tid >> 6; const int h = it & 3, n = (it >> 2) % NCHUNK, b = (it >> 2) / NCHUNK;
    LAS bf16* Qs = (LAS bf16*)lds; LAS bf16* Ks = Qs + 128 * PQ; LAS bf16* VT = Ks + 128 * PQ; LAS bf16* Ps = VT + 64 * PJ; LAS bf16* SfT = Ps + 128 * PJ; LAS bf16* SbT = SfT + 64 * PQ;
    LAS float* pf = (LAS float*)(SbT + 64 * PQ); LAS float* pb = pf + 132;
    const int r0 = chunk_row0(b, n);
    const float lgf = log_sigmoid(p.in[10][layer * 4 + h]), lgb = log_sigmoid(p.in[11][layer * 4 + h]);
    const float* S = (const float*)(p.ws + WS_RETS2);
    const float* sfp = S + ((size_t)((0 * 2 + b) * NCHUNK + n) * 4 + h) * 4096; const float* sbp = S + ((size_t)((1 * 2 + b) * NCHUNK + n) * 4 + h) * 4096;
    __syncthreads();
    { const int j = tid >> 2, dq = (tid & 3) * 16;
      const bf16* Q = (const bf16*)(p.ws + WS_RETQ) + (size_t)(r0 + j) * 256 + h * 64 + dq; const bf16* K = (const bf16*)(p.ws + WS_RETK) + (size_t)(r0 + j) * 256 + h * 64 + dq;
      *(LAS u32x4*)(Qs + j * PQ + dq) = *(const u32x4*)Q; *(LAS u32x4*)(Qs + j * PQ + dq + 8) = *(const u32x4*)(Q + 8);
      *(LAS u32x4*)(Ks + j * PQ + dq) = *(const u32x4*)K; *(LAS u32x4*)(Ks + j * PQ + dq + 8) = *(const u32x4*)(K + 8); }
    { const int j = tid & 127, dq = (tid >> 7) * 16;
      const bf16* V = (const bf16*)(p.ws + WS_RETV) + (size_t)(r0 + j) * 256 + h * 64 + dq;
#pragma unroll
      for (int q8 = 0; q8 < 2; ++q8) { const u32x4 vw = *(const u32x4*)(V + q8 * 8); const unsigned vv[4] = {vw.x, vw.y, vw.z, vw.w};
#pragma unroll
          for (int q = 0; q < 4; ++q) { const int d = dq + q8 * 8 + 2 * q; VT[d * PJ + j] = (bf16)(vv[q] & 0xffffu); VT[(d + 1) * PJ + j] = (bf16)(vv[q] >> 16); } } }
    { const int d = tid & 63, e0 = (tid >> 6) * 8;
#pragma unroll
      for (int q4 = 0; q4 < 2; ++q4) { const f32x4 a = *(const f32x4*)(sfp + d * 64 + e0 + q4 * 4), c = *(const f32x4*)(sbp + d * 64 + e0 + q4 * 4);
#pragma unroll
          for (int q = 0; q < 4; ++q) { SfT[(e0 + q4 * 4 + q) * PQ + d] = f2bf(a[q]); SbT[(e0 + q4 * 4 + q) * PQ + d] = f2bf(c[q]); } } }
    if (tid <= 128) { pf[tid] = expf((float)tid * lgf); pb[tid] = expf((float)tid * lgb); }
    __syncthreads();
    { const bf16x8 a0 = frag(Qs, 16 * w, PQ, 0, lane), a1 = frag(Qs, 16 * w, PQ, 32, lane);
#pragma unroll
      for (int jt = 0; jt < 8; ++jt) { f32x4 c = (f32x4){0.f, 0.f, 0.f, 0.f};
          c = mma(a0, frag(Ks, jt * 16, PQ, 0, lane), c); c = mma(a1, frag(Ks, jt * 16, PQ, 32, lane), c);
          const int j = jt * 16 + (lane & 15);
#pragma unroll
          for (int r = 0; r < 4; ++r) { const int i = 16 * w + 4 * (lane >> 4) + r; const float dm = i > j ? pf[i - j] : (i < j ? pb[j - i] : 2.f); Ps[i * PJ + j] = f2bf(c[r] * dm); } } }
    __syncthreads();
    f32x4 aP[4], aF[4], aB[4];
#pragma unroll
    for (int et = 0; et < 4; ++et) { aP[et] = (f32x4){0.f, 0.f, 0.f, 0.f}; aF[et] = aP[et]; aB[et] = aP[et]; }
#pragma unroll
    for (int ks = 0; ks < 4; ++ks) { const bf16x8 af = frag(Ps, 16 * w, PJ, ks * 32, lane);
#pragma unroll
        for (int et = 0; et < 4; ++et) aP[et] = mma(af, frag(VT, et * 16, PJ, ks * 32, lane), aP[et]); }
#pragma unroll
    for (int ks = 0; ks < 2; ++ks) { const bf16x8 af = frag(Qs, 16 * w, PQ, ks * 32, lane);
#pragma unroll
        for (int et = 0; et < 4; ++et) { aF[et] = mma(af, frag(SfT, et * 16, PQ, ks * 32, lane), aF[et]); aB[et] = mma(af, frag(SbT, et * 16, PQ, ks * 32, lane), aB[et]); } }
    const float* rg = p.in[12] + layer * 256 + h * 64;
    const bf16* G = (const bf16*)(p.ws + WS_RETG) + (size_t)r0 * 256 + h * 64; bf16* X = (bf16*)(p.ws + WS_X) + (size_t)r0 * 1536 + 512 + h * 64;
    float gt[4][4];
#pragma unroll
    for (int r = 0; r < 4; ++r)
#pragma unroll
        for (int et = 0; et < 4; ++et) gt[r][et] = bf2f(G[(size_t)(16 * w + 4 * (lane >> 4) + r) * 256 + et * 16 + (lane & 15)]);
#pragma unroll
    for (int r = 0; r < 4; ++r) { const int i = 16 * w + 4 * (lane >> 4) + r; const float xf = pf[i + 1], xb = pb[128 - i];
        float o[4]; float ss = 0.f;
#pragma unroll
        for (int et = 0; et < 4; ++et) { o[et] = aP[et][r] + xf * aF[et][r] + xb * aB[et][r]; ss += o[et] * o[et]; }
        ss += __shfl_xor(ss, 1); ss += __shfl_xor(ss, 2); ss += __shfl_xor(ss, 4); ss += __shfl_xor(ss, 8);
        const float rstd = rsqrtf(ss * (1.f / 64.f) + EPS);
#pragma unroll
        for (int et = 0; et < 4; ++et) { const int e = et * 16 + (lane & 15); Ps[i * PJ + e] = f2bf(o[et] * rstd * rg[e] * siluf_(gt[r][et])); } }
    asm volatile("s_waitcnt lgkmcnt(0)" ::: "memory");
#pragma unroll
    for (int q = 0; q < 2; ++q) { const int c = lane + 64 * q, i = 16 * w + (c >> 3), e8 = (c & 7) * 8;
        *(u32x4*)(X + (size_t)i * 1536 + e8) = *(const LAS u32x4*)(Ps + i * PJ + e8); }
    __syncthreads();
}

#include <hip/hip_bf16.h>
#include <cmath>
namespace attn_body {
using bf16=__hip_bfloat16;
using bf16x8=__attribute__((ext_vector_type(8)))short;
using s16x4=__attribute__((ext_vector_type(4)))short;
using f32x16=__attribute__((ext_vector_type(16)))float;
using u32x4=__attribute__((ext_vector_type(4)))unsigned;
constexpr int D=64, QP=512, KP=128, OP=1536;
constexpr int NW=8,QBLK=32,QB=QBLK*NW,KVBLK=64;
__device__ __forceinline__ int crow(int r,int hi){return (r&3)+8*(r>>2)+4*hi;}
#define SBAR() __builtin_amdgcn_sched_barrier(0)
__device__ __forceinline__ void cmask(f32x16&p0,f32x16&p1,int jb,int qrel,int hi){
  const float NEG=-INFINITY; int kb=64*jb+4*hi;
  #pragma unroll
  for(int r=0;r<16;++r){int kv=kb+(r&3)+8*(r>>2); if(kv>qrel)p0[r]=NEG; if(kv+32>qrel)p1[r]=NEG;}
}

constexpr int NSLOT=3, SLOTB=8192;
constexpr int LDS_K=0, LDS_V=NSLOT*SLOTB, LDS_WS=2*NSLOT*SLOTB, LDS_OST=LDS_WS+NW*64*4, LDS_BYTES=LDS_OST+NW*4096;
constexpr float C2=0.125f*1.4426950408889634f;
__device__ __forceinline__ void glds16(const void*gsrc,unsigned lds_dst){unsigned keep;
  asm volatile("s_mov_b32 %0, m0\n\ts_mov_b32 m0, %2\n\ts_nop 0\n\tglobal_load_lds_dwordx4 %1, off\n\ts_mov_b32 m0, %0":"=&s"(keep):"v"(gsrc),"s"(lds_dst):"memory");}
__device__ __forceinline__ float max3f(float a,float b,float c){float r;asm("v_max3_f32 %0, %1, %2, %3":"=v"(r):"v"(a),"v"(b),"v"(c));return r;}
__device__ __forceinline__ float max2f(float a,float b){float r;asm("v_max_f32_e32 %0, %1, %2":"=v"(r):"v"(a),"v"(b));return r;}
__device__ __forceinline__ float fadd_s(float a,float b){float r;asm("v_add_f32_e32 %0, %1, %2":"=v"(r):"v"(a),"v"(b));return r;}
__device__ __forceinline__ float fsub_s(float a,float b){float r;asm("v_sub_f32_e32 %0, %1, %2":"=v"(r):"v"(a),"v"(b));return r;}
typedef float f32x2_t __attribute__((ext_vector_type(2))); typedef __bf16 bf16x2_t __attribute__((ext_vector_type(2)));
__device__ __forceinline__ unsigned cvtpk_s(float lo,float hi){f32x2_t v={lo,hi};bf16x2_t b=__builtin_convertvector(v,bf16x2_t);return __builtin_bit_cast(unsigned,b);}
#define WAIT_BAR(N) asm volatile("s_waitcnt vmcnt(" #N ") lgkmcnt(0)\n\ts_barrier":::"memory")

__device__ __forceinline__ void qkt(f32x16&p0,f32x16&p1,const char*Kslot,const bf16x8*qr,const f32x16&negm,int r32,int hi){
  const char*kb=Kslot+hi*1024+r32*16;
  #pragma unroll
  for(int d0=0;d0<4;++d0){
    const bf16x8 b0=*reinterpret_cast<const bf16x8*>(kb+d0*2048);
    const bf16x8 b1=*reinterpret_cast<const bf16x8*>(kb+d0*2048+512);
    if(d0==0){p0=__builtin_amdgcn_mfma_f32_32x32x16_bf16(b0,qr[0],negm,0,0,0);p1=__builtin_amdgcn_mfma_f32_32x32x16_bf16(b1,qr[0],negm,0,0,0);}
    else{p0=__builtin_amdgcn_mfma_f32_32x32x16_bf16(b0,qr[d0],p0,0,0,0);p1=__builtin_amdgcn_mfma_f32_32x32x16_bf16(b1,qr[d0],p1,0,0,0);}}
}
typedef __attribute__((address_space(3))) const char* lds_cptr;
typedef short v4i16_t __attribute__((ext_vector_type(4)));
__device__ __forceinline__ void kload8(bf16x8*kf,lds_cptr kp){
  kf[0]=*(const __attribute__((address_space(3))) bf16x8*)(kp);      kf[1]=*(const __attribute__((address_space(3))) bf16x8*)(kp+512);
  kf[2]=*(const __attribute__((address_space(3))) bf16x8*)(kp+2048); kf[3]=*(const __attribute__((address_space(3))) bf16x8*)(kp+2560);
  kf[4]=*(const __attribute__((address_space(3))) bf16x8*)(kp+4096); kf[5]=*(const __attribute__((address_space(3))) bf16x8*)(kp+4608);
  kf[6]=*(const __attribute__((address_space(3))) bf16x8*)(kp+6144); kf[7]=*(const __attribute__((address_space(3))) bf16x8*)(kp+6656);
}
__device__ __forceinline__ void kload2(bf16x8*kf,lds_cptr kp,int j){ kf[2*j]=*(const __attribute__((address_space(3))) bf16x8*)(kp+j*2048); kf[2*j+1]=*(const __attribute__((address_space(3))) bf16x8*)(kp+j*2048+512); }
__device__ __forceinline__ s16x4 vtr(lds_cptr p){ return __builtin_bit_cast(s16x4,__builtin_amdgcn_ds_read_tr16_b64_v4i16((__attribute__((address_space(3))) v4i16_t*)p)); }
__device__ __forceinline__ float rowmax(const f32x16&p0,const f32x16&p1){
  float a=max3f(p0[0],p0[1],p1[0]),b=max3f(p0[2],p0[3],p1[1]);a=max3f(a,p1[2],p1[3]);
  #pragma unroll
  for(int r=4;r<16;r+=4){a=max3f(a,p0[r],p0[r+1]);b=max3f(b,p0[r+2],p0[r+3]);a=max3f(a,p1[r],p1[r+1]);b=max3f(b,p1[r+2],p1[r+3]);}
  const float m=max2f(a,b);
  auto rr=__builtin_amdgcn_permlane32_swap(__float_as_uint(m),__float_as_uint(m),false,false);
  return max2f(__uint_as_float(rr[0]),__uint_as_float(rr[1]));
}
__device__ __forceinline__ void pv(f32x16*o,int vb,bf16x8 pa0,bf16x8 pa1,bf16x8 pa2,bf16x8 pa3){
  #pragma unroll
  for(int d0=0;d0<2;++d0){s16x4 lo[4],hi[4];
    #pragma unroll
    for(int ks=0;ks<4;++ks){
      asm volatile("ds_read_b64_tr_b16 %0,%1 offset:%c2":"=&v"(lo[ks]):"v"(vb),"i"(d0*4096+ks*1024):"memory");
      asm volatile("ds_read_b64_tr_b16 %0,%1 offset:%c2":"=&v"(hi[ks]):"v"(vb),"i"(d0*4096+ks*1024+512):"memory");}
    asm volatile("s_waitcnt lgkmcnt(0)":::"memory");SBAR();
    #define PK(k) (bf16x8){lo[k][0],lo[k][1],lo[k][2],lo[k][3],hi[k][0],hi[k][1],hi[k][2],hi[k][3]}
    o[d0]=__builtin_amdgcn_mfma_f32_32x32x16_bf16(pa0,PK(0),o[d0],0,0,0);
    o[d0]=__builtin_amdgcn_mfma_f32_32x32x16_bf16(pa1,PK(1),o[d0],0,0,0);
    o[d0]=__builtin_amdgcn_mfma_f32_32x32x16_bf16(pa2,PK(2),o[d0],0,0,0);
    o[d0]=__builtin_amdgcn_mfma_f32_32x32x16_bf16(pa3,PK(3),o[d0],0,0,0);
    #undef PK
  }
}

#ifndef ATTN_STORE16
#define ATTN_STORE16(p,v) (*(u32x4*)(p)=(v))
#endif
template<int THRL> __device__ __forceinline__ void attn_unit(const bf16*Q0,const bf16*__restrict__ Kh,const bf16*__restrict__ Vh,bf16*O0,const int NT,char*shm){
  const int tid=threadIdx.x,lane=tid&63,r32=lane&31,hi=lane>>5; const int wid=__builtin_amdgcn_readfirstlane(tid>>6);
  const bf16*Qw=Q0+(long)(wid*QBLK)*QP;
  const unsigned lds0=(unsigned)(uintptr_t)shm;
  float*wsf=(float*)(shm+LDS_WS)+wid*64;
  const bf16*ksrc=Kh+(long)lane*KP+wid*8;
  const bf16*vsrc=Vh+(long)(16*(wid&3)+(lane>>2))*KP+(wid>>2)*32+(lane&3)*8;
  const unsigned kdst=lds0+LDS_K+wid*1024, vdst=lds0+LDS_V+wid*1024;
  #define DMA_K(t,slot) glds16(ksrc+(long)(t)*KVBLK*KP,(unsigned)__builtin_amdgcn_readfirstlane(kdst+(slot)))
  #define DMA_V(t,slot) glds16(vsrc+(long)(t)*KVBLK*KP,(unsigned)__builtin_amdgcn_readfirstlane(vdst+(slot)))
  const int vb0=(int)(lds0+LDS_V)+((lane>>4)&1)*32+(lane&3)*8+(4*hi+((lane&15)>>2))*64;
  const char*Kbase=shm+LDS_K; bf16x8 kf[8];
  const lds_cptr shm3=(lds_cptr)shm; const lds_cptr kp0=shm3+LDS_K+hi*1024+r32*16; const lds_cptr vp0=shm3+LDS_V+((lane>>4)&1)*32+(lane&3)*8+(4*hi+((lane&15)>>2))*64;
  DMA_K(0,0);DMA_V(0,0);DMA_K(1,SLOTB);
  bf16x8 qr[4];
  #pragma unroll
  for(int d0=0;d0<4;++d0)qr[d0]=*reinterpret_cast<const bf16x8*>(&Qw[(long)r32*QP+d0*16+hi*8]);
  float mhat=0.f,l_reg=0.f;f32x16 o[2];o[0]=f32x16{};o[1]=f32x16{};f32x16 negm=f32x16{};asm volatile("":"+v"(negm));
  #define CMASK(P0,P1,t) do{}while(0)
  bool resc=false;
  #define START(P0,P1) do{ const float rm=rowmax(P0,P1); resc=false; \
    { const float dl=rm; mhat=fadd_s(mhat,dl); \
      _Pragma("unroll") for(int r=0;r<16;++r){P0[r]=fsub_s(P0[r],dl);P1[r]=fsub_s(P1[r],dl);} \
      _Pragma("unroll") for(int r=0;r<16;++r)negm[r]=-mhat; asm volatile("":"+v"(negm)); } \
    _Pragma("unroll") for(int r=0;r<16;++r)P0[r]=__builtin_amdgcn_exp2f(P0[r]); }while(0)
  #define RESC() do{ if(resc){ asm volatile("s_waitcnt lgkmcnt(0)":::"memory"); \
      _Pragma("unroll") for(int d_=0;d_<2;++d_) _Pragma("unroll") for(int r=0;r<16;++r)o[d_][r]*=wsf[crow(r,hi)]; } }while(0)
  f32x16 pA0,pA1,pB0,pB1;
  int sl_prev=0,sl_cur=0,sl_next=SLOTB;
  #define ROT() do{sl_prev=sl_cur;sl_cur=sl_next;sl_next=(sl_next==(NSLOT-1)*SLOTB)?0:sl_next+SLOTB;}while(0)
  DMA_K(2,2*SLOTB);
  WAIT_BAR(3);
  qkt(pA0,pA1,Kbase,qr,negm,r32,hi);asm volatile("s_nop 15\n\ts_nop 7":"+v"(pA0),"+v"(pA1));CMASK(pA0,pA1,0);
  START(pA0,pA1);
  _Pragma("unroll") for(int r=0;r<16;++r)pA1[r]=__builtin_amdgcn_exp2f(pA1[r]);
  WAIT_BAR(0);
  DMA_K(3,0);DMA_V(1,SLOTB);
  ROT();
  kload8(kf,kp0+sl_cur);
  WAIT_BAR(2);
  s16x4 vlo[8],vhi[8]; u32x4 pw0,pw1,pw2,pw3;
  #define PKW(P,B) cvtpk_s(P[B],P[B+1])
  #define PAF(k) __builtin_bit_cast(bf16x8,pw##k)
  #define VFR(i) (bf16x8){vlo[i][0],vlo[i][1],vlo[i][2],vlo[i][3],vhi[i][0],vhi[i][1],vhi[i][2],vhi[i][3]}
  #define PIN(x) asm volatile("":"+v"(x))
  #define MX3(a,b,c) __builtin_fmaxf(__builtin_fmaxf((a),(b)),(c))
  #define GAPA(MF,A0,A1,A2,A3,W0,W1,PW) do{ MF; sacc+=A0; sacc+=A1; sacc+=A2; sacc+=A3; PIN(sacc); W0; W1; PIN(PW); SBAR(); }while(0)
  #define EX(v) __builtin_amdgcn_exp2f(v)
  #define GAPB(MF,X,B) do{ MF; X[B]=EX(X[B]); X[B+1]=EX(X[B+1]); X[B+2]=EX(X[B+2]); X[B+3]=EX(X[B+3]); PIN(X); SBAR(); }while(0)
  #define VRD(i) do{ vlo[i]=vtr(vp_+(((i)>>2)*4096+((i)&3)*1024)); vhi[i]=vtr(vp_+(((i)>>2)*4096+((i)&3)*1024+512)); }while(0)
  #define KRD(G,j) do{ if(G){ kload2(kf,kp0+sl_next,j); SBAR(); } }while(0)
  #define STEP(C0,C1,P0,P1,t,GK,GV,GL) do{ SBAR(); \
    const lds_cptr vp_=vp0+sl_prev; \
    VRD(0); SBAR(); float sacc=(P0[0]+P0[1]); \
    GAPA(C0=__builtin_amdgcn_mfma_f32_32x32x16_bf16(kf[0],qr[0],negm,0,0,0), P0[2],P0[3],P0[4],P0[5],     pw0[0]=PKW(P0,0), pw0[1]=PKW(P0,2), pw0); \
    VRD(4); SBAR(); GAPA(C1=__builtin_amdgcn_mfma_f32_32x32x16_bf16(kf[1],qr[0],negm,0,0,0), P0[6],P0[7],P0[8],P0[9],     pw0[2]=PKW(P0,4), pw0[3]=PKW(P0,6), pw0); \
    VRD(1); SBAR(); GAPA(C0=__builtin_amdgcn_mfma_f32_32x32x16_bf16(kf[2],qr[1],C0,0,0,0),   P0[10],P0[11],P0[12],P0[13], pw1[0]=PKW(P0,8), pw1[1]=PKW(P0,10), pw1); \
    VRD(5); SBAR(); GAPA(C1=__builtin_amdgcn_mfma_f32_32x32x16_bf16(kf[3],qr[1],C1,0,0,0),   P0[14],P0[15],P1[0],P1[1],   pw1[2]=PKW(P0,12),pw1[3]=PKW(P0,14), pw1); \
    VRD(2); SBAR(); GAPA(C0=__builtin_amdgcn_mfma_f32_32x32x16_bf16(kf[4],qr[2],C0,0,0,0),   P1[2],P1[3],P1[4],P1[5],     pw2[0]=PKW(P1,0), pw2[1]=PKW(P1,2), pw2); \
    VRD(6); SBAR(); GAPA(C1=__builtin_amdgcn_mfma_f32_32x32x16_bf16(kf[5],qr[2],C1,0,0,0),   P1[6],P1[7],P1[8],P1[9],     pw2[2]=PKW(P1,4), pw2[3]=PKW(P1,6), pw2); \
    VRD(3); SBAR(); GAPA(C0=__builtin_amdgcn_mfma_f32_32x32x16_bf16(kf[6],qr[3],C0,0,0,0),   P1[10],P1[11],P1[12],P1[13], pw3[0]=PKW(P1,8), pw3[1]=PKW(P1,10), pw3); \
    VRD(7); SBAR(); GAPA(C1=__builtin_amdgcn_mfma_f32_32x32x16_bf16(kf[7],qr[3],C1,0,0,0),   P1[14],P1[15],0.f,0.f,       pw3[2]=PKW(P1,12),pw3[3]=PKW(P1,14), pw3); \
    l_reg+=sacc; \
    if(GK){DMA_K((t)+3,sl_cur);} if(GV){DMA_V((t)+1,sl_next);} \
    CMASK(C0,C1,t); \
    { float a=MX3(C0[0],C0[1],C1[0]),b=MX3(C0[2],C0[3],C1[1]); a=MX3(a,C1[2],C1[3]); \
      _Pragma("unroll") for(int r=4;r<16;r+=4){a=MX3(a,C0[r],C0[r+1]);b=MX3(b,C0[r+2],C0[r+3]);a=MX3(a,C1[r],C1[r+1]);b=MX3(b,C1[r+2],C1[r+3]);} \
      float rm=__builtin_fmaxf(a,b); { auto rr=__builtin_amdgcn_permlane32_swap(__float_as_uint(rm),__float_as_uint(rm),false,false); rm=__builtin_fmaxf(__uint_as_float(rr[0]),__uint_as_float(rr[1])); } \
      resc=false; \
      if(__builtin_expect(__any(rm>(float)THRL),0)){ const float dl=__builtin_fmaxf(rm,0.f); mhat+=dl; \
        _Pragma("unroll") for(int r=0;r<16;++r){C0[r]-=dl;C1[r]-=dl;} \
        _Pragma("unroll") for(int r=0;r<16;++r)negm[r]=-mhat; asm volatile("":"+v"(negm)); \
        const float f=__builtin_amdgcn_exp2f(-dl); l_reg*=f; if(hi==0)wsf[r32]=f; resc=true; } } \
    SBAR(); \
    GAPB(o[0]=__builtin_amdgcn_mfma_f32_32x32x16_bf16(PAF(0),VFR(0),o[0],0,0,0), C0,0); \
    GAPB(o[1]=__builtin_amdgcn_mfma_f32_32x32x16_bf16(PAF(0),VFR(4),o[1],0,0,0), C0,4); \
    KRD(GL,0); GAPB(o[0]=__builtin_amdgcn_mfma_f32_32x32x16_bf16(PAF(1),VFR(1),o[0],0,0,0), C0,8); \
    KRD(GL,1); GAPB(o[1]=__builtin_amdgcn_mfma_f32_32x32x16_bf16(PAF(1),VFR(5),o[1],0,0,0), C0,12); \
    KRD(GL,2); GAPB(o[0]=__builtin_amdgcn_mfma_f32_32x32x16_bf16(PAF(2),VFR(2),o[0],0,0,0), C1,0); \
    KRD(GL,3); GAPB(o[1]=__builtin_amdgcn_mfma_f32_32x32x16_bf16(PAF(2),VFR(6),o[1],0,0,0), C1,4); \
    GAPB(o[0]=__builtin_amdgcn_mfma_f32_32x32x16_bf16(PAF(3),VFR(3),o[0],0,0,0), C1,8); \
    GAPB(o[1]=__builtin_amdgcn_mfma_f32_32x32x16_bf16(PAF(3),VFR(7),o[1],0,0,0), C1,12); \
    }while(0)
  int t=1;
  #undef CMASK
  #define CMASK(P0,P1,t) do{}while(0)
  for(;t+5<NT;t+=2){
    STEP(pB0,pB1,pA0,pA1,t,true,true,true);     WAIT_BAR(2); RESC(); ROT();
    STEP(pA0,pA1,pB0,pB1,t+1,true,true,true);   WAIT_BAR(2); RESC(); ROT();
  }
  #undef CMASK
  #define CMASK(P0,P1,t) do{}while(0)
  #define ENDW(tt) do{ if((tt)+3<NT){WAIT_BAR(2);} else if((tt)+2<NT){WAIT_BAR(1);} else {WAIT_BAR(0);} }while(0)
  for(;t+1<NT;t+=2){
    STEP(pB0,pB1,pA0,pA1,t,(t+3<NT),(t+1<NT),(t+1<NT));       ENDW(t);   RESC(); ROT();
    STEP(pA0,pA1,pB0,pB1,t+1,(t+4<NT),(t+2<NT),(t+2<NT));     ENDW(t+1); RESC(); ROT();
  }
  STEP(pB0,pB1,pA0,pA1,NT-1,false,false,false); RESC();
  { float sacc=pB0[0]+pB0[1]; _Pragma("unroll") for(int r=2;r<16;++r)sacc+=pB0[r]; _Pragma("unroll") for(int r=0;r<16;++r)sacc+=pB1[r]; l_reg+=sacc;
    pw0=(u32x4){PKW(pB0,0),PKW(pB0,2),PKW(pB0,4),PKW(pB0,6)};pw1=(u32x4){PKW(pB0,8),PKW(pB0,10),PKW(pB0,12),PKW(pB0,14)};pw2=(u32x4){PKW(pB1,0),PKW(pB1,2),PKW(pB1,4),PKW(pB1,6)};pw3=(u32x4){PKW(pB1,8),PKW(pB1,10),PKW(pB1,12),PKW(pB1,14)};
    SBAR(); pv(o,vb0+sl_cur,PAF(0),PAF(1),PAF(2),PAF(3)); }
  #undef PKW
  #undef PAF
  #undef VFR
  #undef PIN
  #undef MX3
  #undef GAPA
  #undef GAPB
  #undef EX
  #undef VRD
  #undef KRD
  #undef STEP
  #undef ENDW
  {auto rr=__builtin_amdgcn_permlane32_swap(__float_as_uint(l_reg),__float_as_uint(l_reg),false,false);l_reg=__uint_as_float(rr[0])+__uint_as_float(rr[1]);}
  if(hi==0)wsf[32+r32]=l_reg;asm volatile("s_waitcnt lgkmcnt(0)":::"memory");
  float rli[16];
  #pragma unroll
  for(int r=0;r<16;++r)rli[r]=__builtin_amdgcn_rcpf(wsf[32+crow(r,hi)]);
  bf16*Ow=O0+(long)(wid*QBLK)*OP;
  { bf16*stg=(bf16*)(shm+LDS_OST)+wid*2048;
    #pragma unroll
    for(int r=0;r<16;++r){const int orow=crow(r,hi);
      #pragma unroll
      for(int d0=0;d0<2;++d0)stg[orow*64+d0*32+r32]=__float2bfloat16(o[d0][r]*rli[r]);}
    asm volatile("s_waitcnt lgkmcnt(0)":::"memory");
    #pragma unroll
    for(int i=0;i<4;++i){const int row=i*8+(lane>>3),ch=lane&7; const u32x4 v=*(const u32x4*)(stg+row*64+ch*8); ATTN_STORE16(Ow+(long)row*OP+ch*8,v);} }
  asm volatile("s_waitcnt lgkmcnt(0)\n\ts_barrier":::"memory");
  #undef DMA_K
  #undef DMA_V
  #undef CMASK
  #undef START
  #undef RESC
  #undef ROT
}
constexpr int ATTN_LDS_BYTES=LDS_BYTES;
#undef SBAR
#undef WAIT_BAR
}

__device__ __forceinline__ void attn_phase_run(const P& p, unsigned char* lds_generic, int layer) {
    typedef attn_body::bf16 abf;
    const int G = gridDim.x, bx = blockIdx.x, vcu = (G % 8 == 0) ? (bx % 8) * (G / 8) + bx / 8 : bx;
    const abf* Q = (const abf*)(p.ws + WS_ATTQ); const abf* K = (const abf*)(p.ws + WS_ATTK); const abf* V = (const abf*)(p.ws + WS_ATTV); abf* X = (abf*)(p.ws + WS_X);
    if (G == 256) {
        const int x = vcu >> 5, qb = vcu & 31, b = x >> 2, kvh = (x >> 1) & 1;
#pragma unroll 1
        for (int i = 0; i < 2; ++i) { const int h = kvh * 4 + 2 * (x & 1) + i; const long r0 = (long)b * SEQ + qb * 256;
            attn_body::attn_unit<8>(Q + r0 * 512 + h * 64, K + (long)b * KEYS * 128 + kvh * 64, V + (long)b * KEYS * 128 + kvh * 64, X + r0 * 1536 + 768 + h * 64, KEYS / 64, (char*)lds_generic); }
    } else {
#pragma unroll 1
        for (int u = vcu; u < 512; u += G) { const int qb = u & 31, h = (u >> 5) & 7, b = u >> 8, kvh = h >> 2; const long r0 = (long)b * SEQ + qb * 256;
            attn_body::attn_unit<8>(Q + r0 * 512 + h * 64, K + (long)b * KEYS * 128 + kvh * 64, V + (long)b * KEYS * 128 + kvh * 64, X + r0 * 1536 + 768 + h * 64, KEYS / 64, (char*)lds_generic); }
    }
    if (layer == 0) {
#pragma unroll 1
        for (int u = vcu; u < 16; u += G) { const int b = u >> 3, h = u & 7, kvh = h >> 2; const long r0 = NLAT + (long)b * CTX;
            attn_body::attn_unit<8>(Q + r0 * 512 + h * 64, K + (long)b * KEYS * 128 + kvh * 64, V + (long)b * KEYS * 128 + kvh * 64, X + r0 * 1536 + 768 + h * 64, CTX / 64, (char*)lds_generic); }
    }
}

__device__ __forceinline__ void ph_fft1(const P& p, LAS unsigned char* lds, int layer) {
    int nt2 = 2; asm volatile("" : "+s"(nt2));
    { fg::PlainSched S{(const char*)(p.ws + WS_F1), (const char*)(p.ws + WS_UT), 256, 256, 1, 128, (int)gridDim.x, (int)blockIdx.x, nt2};
      fg::EpiFft1 E{p.ws}; fg::gemm_phase(lds, 256, 256, S, E); }
    if (layer == 0) { fg::PlainSched S{(const char*)(p.ws + WS_FC), (const char*)(p.ws + WS_UTC), 256, 256, 2, 2, (int)gridDim.x, (int)((blockIdx.x + 128) % gridDim.x), 4};
      fg::EpiFftC E{p.ws}; fg::gemm_phase(lds, 256, 256, S, E); }
}
__device__ __forceinline__ void ph_fft3(const P& p, LAS unsigned char* lds) {
    int nt2 = 2; asm volatile("" : "+s"(nt2));
    fg::PlainSched S{(const char*)(p.ws + WS_F2), (const char*)(p.ws + WS_Z), 256, 256, 1, 256, (int)gridDim.x, (int)blockIdx.x, nt2};
    fg::EpiFft3 E{p.ws}; fg::gemm_phase(lds, 256, 256, S, E);
}
__device__ __forceinline__ void ph_mix1(const P& p, LAS unsigned char* lds, int layer) {
    ph_fft1(p, lds, layer);
    const int nconv = layer == 0 ? 264 : 256;
    const int n0 = nconv, n1 = n0 + NB * NCHUNK * 4;
    for (int it = gridDim.x - 1 - blockIdx.x; it < n1; it += gridDim.x) {
        if (it < n0) { if (it < 256) conv_item(p, lds, layer, it >> 7, (it & 127) * 64); else conv_item(p, lds, layer, 2 + ((it - 256) >> 2), ((it - 256) & 3) * 64); }
        else ret_kv_item(p, lds, layer, it - n0);
    }
    __syncthreads();
}
__device__ __forceinline__ void ph_mix2(const P& p, LAS unsigned char* lds, unsigned char* lds_generic, int layer) {
    for (int it = blockIdx.x; it < 128; it += gridDim.x) ret_scan_item(p, layer, it);
    __syncthreads();
    ph_fft3(p, lds);
    attn_phase_run(p, lds_generic, layer);
    __syncthreads();
}
__device__ __forceinline__ void ph_mix3(const P& p, LAS unsigned char* lds, int layer, bool ctxlater) {
    for (int it = blockIdx.x; it < NB * NCHUNK * 4; it += gridDim.x) {
        const int n = (it >> 2) % NCHUNK; if ((layer == 1 || ctxlater) && n < 2) continue;
        ret_out_item(p, lds, layer, it);
    }
    __syncthreads();
}
__device__ __forceinline__ void ctx_ret_items(const P& p, LAS unsigned char* lds) {
    const int u = blockIdx.x;
    if (u < 16) { const int b = u >> 3, n = (u >> 2) & 1, h = u & 3;
        ret_out_item(p, lds, 0, (b * NCHUNK + n) * 4 + h);
        asm volatile("s_waitcnt vmcnt(0)" ::: "memory"); __syncthreads();
        if (threadIdx.x == 0) { __builtin_amdgcn_fence(__ATOMIC_RELEASE, "agent");
            __hip_atomic_fetch_add((unsigned*)(p.ws + WS_CTL) + CW_CCNT + (8 * 3) * 16, 1u, __ATOMIC_RELAXED, __HIP_MEMORY_SCOPE_AGENT); }
        __syncthreads(); }
}
__device__ __forceinline__ void ctx_ret_wait(const P& p) {
    if (threadIdx.x == 0) { unsigned* c = (unsigned*)(p.ws + WS_CTL) + CW_CCNT + (8 * 3) * 16; unsigned* tmo = (unsigned*)(p.ws + WS_CTL) + CW_TMO; unsigned sp = 0u;
        while (__hip_atomic_load(c, __ATOMIC_RELAXED, __HIP_MEMORY_SCOPE_AGENT) < 16u) { __builtin_amdgcn_s_sleep(1);
            if ((++sp & 255u) == 0u) { if (__hip_atomic_load(tmo, __ATOMIC_RELAXED, __HIP_MEMORY_SCOPE_AGENT)) break; if (sp > (1u << 22)) { atomicAdd(tmo, 1u); break; } } }
        __builtin_amdgcn_fence(__ATOMIC_ACQUIRE, "agent"); }
    __syncthreads();
}

namespace sk {
typedef short bf16x8 __attribute__((ext_vector_type(8)));
__device__ __forceinline__ void tile64(LAS unsigned char* lds, const bf16* A, int lda, const bf16* Bt, int ldb, int K, float (&out)[8]) {
    const int tid = threadIdx.x, lane = tid & 63, w = tid >> 6, kc = K >> 3;
    const bf16* ap = A + (size_t)(lane & 15) * lda + w * kc + 8 * (lane >> 4); const bf16* bp = Bt + (size_t)(lane & 15) * ldb + w * kc + 8 * (lane >> 4);
    f32x4 acc[4][4];
#pragma unroll
    for (int i = 0; i < 4; ++i)
#pragma unroll
        for (int j = 0; j < 4; ++j) acc[i][j] = (f32x4){0.f, 0.f, 0.f, 0.f};
#pragma unroll 2
    for (int k0 = 0; k0 < kc; k0 += 32) {
        bf16x8 af[4], bfr[4];
#pragma unroll
        for (int i = 0; i < 4; ++i) { af[i] = *(const bf16x8*)(ap + (size_t)(16 * i) * lda + k0); bfr[i] = *(const bf16x8*)(bp + (size_t)(16 * i) * ldb + k0); }
#pragma unroll
        for (int i = 0; i < 4; ++i)
#pragma unroll
            for (int j = 0; j < 4; ++j) acc[i][j] = __builtin_amdgcn_mfma_f32_16x16x32_bf16(af[i], bfr[j], acc[i][j], 0, 0, 0);
    }
    LAS float* part = (LAS float*)lds;
    __syncthreads();
#pragma unroll
    for (int i = 0; i < 4; ++i)
#pragma unroll
        for (int j = 0; j < 4; ++j)
#pragma unroll
            for (int r = 0; r < 4; ++r) part[((w * 16 + i * 4 + j) * 4 + r) * 64 + lane] = acc[i][j][r];
    __syncthreads();
#pragma unroll
    for (int q = 0; q < 8; ++q) { float sacc = 0.f;
#pragma unroll
        for (int ww = 0; ww < 8; ++ww) sacc += part[ww * 4096 + tid + 512 * q];
        out[q] = sacc; }
}
__device__ __forceinline__ void tile64_f8(LAS unsigned char* lds, const unsigned char* A, int lda, const unsigned char* Bt, int ldb, int K, float (&out)[8]) {
    const int tid = threadIdx.x, lane = tid & 63, w = tid >> 6;
    const unsigned char* ap = A + (size_t)(lane & 15) * lda + 32 * (lane >> 4); const unsigned char* bp = Bt + (size_t)(lane & 15) * ldb + 32 * (lane >> 4);
    f32x4 acc[4][4];
#pragma unroll
    for (int i = 0; i < 4; ++i)
#pragma unroll
        for (int j = 0; j < 4; ++j) acc[i][j] = (f32x4){0.f, 0.f, 0.f, 0.f};
    for (int ks = w; ks * 128 < K; ks += 8) {
        fg::i32x8 af[4], bfr[4];
#pragma unroll
        for (int i = 0; i < 4; ++i) { af[i] = *(const fg::i32x8*)(ap + (size_t)(16 * i) * lda + ks * 128); bfr[i] = *(const fg::i32x8*)(bp + (size_t)(16 * i) * ldb + ks * 128); }
#pragma unroll
        for (int i = 0; i < 4; ++i)
#pragma unroll
            for (int j = 0; j < 4; ++j) acc[i][j] = __builtin_amdgcn_mfma_scale_f32_16x16x128_f8f6f4(af[i], bfr[j], acc[i][j], 0, 0, 0, 0x7f7f7f7f, 0, 0x7a7a7a7a);
    }
    LAS float* part = (LAS float*)lds;
    __syncthreads();
#pragma unroll
    for (int i = 0; i < 4; ++i)
#pragma unroll
        for (int j = 0; j < 4; ++j)
#pragma unroll
            for (int r = 0; r < 4; ++r) part[((w * 16 + i * 4 + j) * 4 + r) * 64 + lane] = acc[i][j][r];
    __syncthreads();
#pragma unroll
    for (int q = 0; q < 8; ++q) { float sacc = 0.f;
#pragma unroll
        for (int ww = 0; ww < 8; ++ww) sacc += part[ww * 4096 + tid + 512 * q];
        out[q] = sacc; }
}
__device__ __forceinline__ void elem_rc(int tid, int q, int& row, int& col) { const int e = tid + 512 * q, t16 = e >> 8, reg = (e >> 6) & 3, lane = e & 63; row = 16 * (t16 >> 2) + 4 * (lane >> 4) + reg; col = 16 * (t16 & 3) + (lane & 15); }
}
__device__ __forceinline__ void mini_merge_ctx(const P& p, LAS unsigned char* lds, int layer) {
    const bf16* X = (const bf16*)(p.ws + WS_X); const bf16* WB = (const bf16*)(p.ws + WS_WB) + (size_t)layer * 1024 * 1536; const unsigned char* G = (const unsigned char*)(p.ws + WS_G); bf16* Mg = (bf16*)(p.ws + WS_MERGED);
    for (int it = gridDim.x - 1 - blockIdx.x; it < (NCTX / 64) * 16; it += gridDim.x) { const int r0 = NLAT + (it >> 4) * 64, c0 = (it & 15) * 64;
        float tot[8];
#pragma unroll
        for (int q = 0; q < 8; ++q) tot[q] = 0.f;
#pragma unroll 1
        for (int br = 0; br < 4; ++br) { const int koff = br == 0 ? 0 : (br == 1 ? 512 : (br == 2 ? 768 : 1280)), klen = (br & 1) ? 256 : 512;
            float o[8]; sk::tile64(lds, X + (size_t)r0 * 1536 + koff, 1536, WB + (size_t)c0 * 1536 + koff, 1536, klen, o);
#pragma unroll
            for (int q = 0; q < 8; ++q) { int rr, cc; sk::elem_rc(threadIdx.x, q, rr, cc); tot[q] += o[q] * ((float)G[(size_t)(r0 + rr) * 4096 + br * 1024 + c0 + cc] * (1.f / 255.f)); } }
#pragma unroll
        for (int q = 0; q < 8; ++q) { int rr, cc; sk::elem_rc(threadIdx.x, q, rr, cc); Mg[(size_t)(r0 + rr) * 1024 + c0 + cc] = f2bf(tot[q]); } }
    __syncthreads();
}
__device__ __forceinline__ void mini_resid_ctx(const P& p, LAS unsigned char* lds, int layer, const bf16* A, int lda, const bf16* Bt, int K, int chunk, int xnorm = -1, int nlayer = 0, int nwhich = 0, const float* hsrc = nullptr) {
    const float* g = mods(p, layer, 2, chunk); float* hc = (float*)(p.ws + WS_HCTX); if (hsrc == nullptr) hsrc = hc;
    for (int it = gridDim.x - 1 - blockIdx.x; it < (NCTX / 64) * 16; it += gridDim.x) { const int rl = (it >> 4) * 64, c0 = (it & 15) * 64;
        float o[8]; sk::tile64(lds, A + (size_t)(NLAT + rl) * lda, lda, Bt + (size_t)c0 * K, K, K, o);
        if (xnorm < 0) {
#pragma unroll
            for (int q = 0; q < 8; ++q) { int rr, cc; sk::elem_rc(threadIdx.x, q, rr, cc); float* h = hc + (size_t)(rl + rr) * D + c0 + cc; *h = *h + g[c0 + cc] * o[q]; }
        } else {
#pragma unroll
            for (int q = 0; q < 8; ++q) { int rr, cc; sk::elem_rc(threadIdx.x, q, rr, cc); float* h = hc + (size_t)(rl + rr) * D + c0 + cc;
                __hip_atomic_store(h, hsrc[(size_t)(rl + rr) * D + c0 + cc] + g[c0 + cc] * o[q], __ATOMIC_RELAXED, __HIP_MEMORY_SCOPE_AGENT); }
            asm volatile("s_waitcnt vmcnt(0)" ::: "memory"); __syncthreads();
            if (threadIdx.x == 0) { unsigned* c = (unsigned*)(p.ws + WS_CTL) + CW_CCNT + (8 * xnorm + (it >> 4)) * 16; unsigned* tmo = (unsigned*)(p.ws + WS_CTL) + CW_TMO;
                __hip_atomic_fetch_add(c, 1u, __ATOMIC_RELAXED, __HIP_MEMORY_SCOPE_AGENT);
                unsigned sp = 0u;
                while (__hip_atomic_load(c, __ATOMIC_RELAXED, __HIP_MEMORY_SCOPE_AGENT) < 16u) { __builtin_amdgcn_s_sleep(1);
                    if ((++sp & 255u) == 0u) { if (__hip_atomic_load(tmo, __ATOMIC_RELAXED, __HIP_MEMORY_SCOPE_AGENT)) break; if (sp > (1u << 22)) { atomicAdd(tmo, 1u); break; } } }
                __builtin_amdgcn_fence(__ATOMIC_ACQUIRE, "agent"); }
            __syncthreads();
            { const int w = threadIdx.x >> 6, lane = threadIdx.x & 63;
              if (w < 4) norm_row(p, nlayer, nwhich, NLAT + rl + (it & 15) * 4 + w, lane); }
            __syncthreads();
        } }
    __syncthreads();
}
__device__ __forceinline__ void ph_merge(const P& p, LAS unsigned char* lds, int layer, int nrows) {
    fg::MergeSched S{(const char*)(p.ws + WS_X), (const char*)(p.ws + WS_WB) + (size_t)layer * 1024 * 1536 * 2, nrows / 256, (int)gridDim.x, (int)blockIdx.x};
    fg::EpiMerge E{(const unsigned char*)(p.ws + WS_G), (bf16*)(p.ws + WS_MERGED)};
    fg::gemm_phase(lds, 1536, 1536, S, E);
}
__device__ __forceinline__ void ph_gemm_resid(const P& p, LAS unsigned char* lds, int layer, const bf16* A, int lda, const bf16* Bt, int K, int chunk, int nrows) {
    fg::PlainSched S{(const char*)A, (const char*)Bt, lda, K, nrows / 256, 4, (int)gridDim.x, (int)blockIdx.x, K / 64};
    fg::EpiResid E{p.out, (float*)(p.ws + WS_HCTX), (const float*)(p.ws + WS_MODS) + (size_t)layer * 3 * 6144, chunk};
    fg::gemm_phase(lds, lda, K, S, E);
}
__device__ __forceinline__ void ph_gemm_resid_norm(const P& p, LAS unsigned char* lds, int layer, const bf16* A, int lda, const bf16* Bt, int K, int chunk, int x, int nlayer, int nwhich, const float* hin) {
    fg::PlainSched S{(const char*)A, (const char*)Bt, lda, K, NLAT / 256, 4, (int)gridDim.x, (int)blockIdx.x, K / 64};
    unsigned* ctl = (unsigned*)(p.ws + WS_CTL);
    fg::EpiResidNorm E{hin, p.out, (const float*)(p.ws + WS_MODS) + (size_t)layer * 3 * 6144, chunk,
        p.in[nwhich == 0 ? 6 : 7] + nlayer * D, (const float*)(p.ws + WS_MODS) + (size_t)nlayer * 3 * 6144, nwhich == 0 ? 0 : 3, nwhich == 0 ? 1 : 4, (bf16*)(p.ws + WS_A), nwhich == 0 ? p.ws + WS_A8 : (unsigned char*)nullptr,
        (float*)(p.ws + WS_CTL + CTL_XBUF) + (size_t)x * 65536, ctl + CW_PCNT + 64 * 16 * x, ctl + CW_TMO, lds};
    fg::gemm_phase(lds, lda, K, S, E);
}
__device__ __forceinline__ void ph_ffn1(const P& p, LAS unsigned char* lds) {
    fg::PlainSched S{(const char*)(p.ws + WS_A), (const char*)(p.ws + WS_FFN1), D, D, MROWS / 256, 22, (int)gridDim.x, (int)blockIdx.x, D / 64};
    fg::EpiSwiglu E{(bf16*)(p.ws + WS_HMID)};
    fg::gemm_phase(lds, D, D, S, E);
}
__device__ __forceinline__ int moe_tiles(const P& p, LAS int* tile_e) {
    const unsigned* ctl = (const unsigned*)(p.ws + WS_CTL); int t = 0;
    for (int e = 0; e < NEXP; ++e) { const int c = (int)ctl[CW_CNT + e], nt = (c + 255) >> 8; for (int q = 0; q < nt; ++q) { if (threadIdx.x == 0) tile_e[t + q] = e; } t += nt; }
    __syncthreads();
    return t;
}
__device__ __forceinline__ void ph_assign_gather(const P& p, LAS unsigned char* lds) {
    const int tid = threadIdx.x, bid = blockIdx.x, G = gridDim.x;
    LAS int* sbase = (LAS int*)lds;
    LAS int* stot = sbase + 8;
    LAS int* spst = stot + 8;
    LAS int* sexp = spst + 16;
    LAS int* sslot = sexp + 128;
    const unsigned* cntb = (const unsigned*)(p.ws + WS_ROUTE) + 16384 * 6;
    const int* tok_e = (const int*)(p.ws + WS_ROUTE); int* tok_slot = (int*)(p.ws + WS_ROUTE) + 16384 * 4;
    __syncthreads();
    { const int e = tid >> 6, l = tid & 63; int tot = 0, below = 0;
      for (int b = l; b < G; b += 64) { const int c = (int)cntb[b * NEXP + e]; tot += c; if (b < bid) below += c; }
#pragma unroll
      for (int o = 1; o < 64; o <<= 1) { tot += __shfl_xor(tot, o); below += __shfl_xor(below, o); }
      if (l == 0) { sbase[e] = below; stot[e] = tot; } }
    if (tid < 128) { const int li = tid >> 1, w = li & 7, k = li >> 3, tok = (bid * 8 + w) + k * (G * 8); sexp[tid] = tok < NLAT ? tok_e[tok * 2 + (tid & 1)] : -1; }
    __syncthreads();
    if (tid == 0) { int t = 0; for (int e = 0; e < NEXP; ++e) { spst[e] = t * 256; t += (stot[e] + 255) >> 8; } spst[NEXP] = t * 256;
        if (bid == 0) { unsigned* ctl = (unsigned*)(p.ws + WS_CTL); for (int e = 0; e < NEXP; ++e) ctl[CW_CNT + e] = (unsigned)stot[e]; } }
    __syncthreads();
    if (tid < 128) { const int e = sexp[tid]; int slot = -1;
        if (e >= 0) { int rank = 0; for (int a = 0; a < tid; ++a) rank += (sexp[a] == e) ? 1 : 0; slot = spst[e] + sbase[e] + rank;
            const int li = tid >> 1, w = li & 7, k = li >> 3, tok = (bid * 8 + w) + k * (G * 8); tok_slot[tok * 2 + (tid & 1)] = slot; }
        sslot[tid] = slot; }
    __syncthreads();
    const int lane = tid & 63, wv = tid >> 6; const unsigned char* A8 = p.ws + WS_A8; unsigned char* FS8 = p.ws + WS_FS;
    for (int a = wv; a < 128; a += 8) { const int slot = sslot[a]; if (slot < 0) continue; const int li = a >> 1, w = li & 7, k = li >> 3, tok = (bid * 8 + w) + k * (G * 8);
        *(u32x4*)(FS8 + (size_t)slot * D + lane * 16) = *(const u32x4*)(A8 + (size_t)tok * D + lane * 16); }
    { int idx = 0;
      for (int e = 0; e < NEXP; ++e) { const int lo_ = spst[e] + stot[e], hi_ = spst[e + 1];
          for (int r = lo_ + ((bid * 8 + wv - idx) % (G * 8) + (G * 8)) % (G * 8); r < hi_; r += G * 8) {
              *(u32x4*)(FS8 + (size_t)r * D + lane * 16) = (u32x4){0u, 0u, 0u, 0u}; }
          idx += hi_ - lo_; } }
    __syncthreads();
}
__device__ __forceinline__ void ph_moe1(const P& p, LAS unsigned char* lds) {
    LAS int* tile_e = (LAS int*)(lds + fg::STAGE_BYTES); const int nt = moe_tiles(p, tile_e);
    fg::ExpertSched S{(const char*)(p.ws + WS_FS), (const char*)(p.ws + WS_MOE1), D / 2, D / 2, nt, 22, (int)gridDim.x, (int)blockIdx.x, D / 128, tile_e, (size_t)5632 * D};
    fg::EpiSwiglu8 E{p.ws + WS_HMOE};
    fg::gemm_phase<fg::EpiSwiglu8, fg::ExpertSched, true>(lds, D / 2, D / 2, S, E);
}
__device__ __forceinline__ void ph_moe2(const P& p, LAS unsigned char* lds) {
    LAS int* tile_e = (LAS int*)(lds + fg::STAGE_BYTES); const int nt = moe_tiles(p, tile_e);
    const int nbig = nt < 128 ? nt : 128;
    fg::ExpertSched S{(const char*)(p.ws + WS_HMOE), (const char*)(p.ws + WS_MOE2), FFN / 2, FFN / 2, nbig, 4, (int)gridDim.x, (int)blockIdx.x, FFN / 128, tile_e, (size_t)D * FFN};
    fg::EpiStore E{(bf16*)(p.ws + WS_Y2), D};
    fg::gemm_phase<fg::EpiStore, fg::ExpertSched, true>(lds, FFN / 2, FFN / 2, S, E);
    const unsigned char* A = p.ws + WS_HMOE; bf16* Y = (bf16*)(p.ws + WS_Y2);
    for (int it = blockIdx.x; it < (nt - nbig) * 64; it += gridDim.x) {
        const int rt = nbig + (it >> 6), r0 = rt * 256 + ((it >> 4) & 3) * 64, c0 = (it & 15) * 64;
        const unsigned char* B = p.ws + WS_MOE2 + (size_t)tile_e[rt] * D * FFN;
        float o[8]; sk::tile64_f8(lds, A + (size_t)r0 * FFN, FFN, B + (size_t)c0 * FFN, FFN, FFN, o);
#pragma unroll
        for (int q = 0; q < 8; ++q) { int rr, cc; sk::elem_rc(threadIdx.x, q, rr, cc); Y[(size_t)(r0 + rr) * D + c0 + cc] = f2bf(o[q]); } }
    __syncthreads();
}
__device__ __forceinline__ void ph_combine(const P& p, int layer) {
    const int lane = threadIdx.x & 63, gw = blockIdx.x * 8 + (threadIdx.x >> 6), ngw = gridDim.x * 8;
    const float* tok_w = (const float*)(p.ws + WS_ROUTE) + 16384 * 2; const int* tok_slot = (const int*)(p.ws + WS_ROUTE) + 16384 * 4; const bf16* Y = (const bf16*)(p.ws + WS_Y2);
    for (int r = gw; r < NLAT; r += ngw) {
        const int s0 = tok_slot[r * 2], s1 = tok_slot[r * 2 + 1]; const float w0 = tok_w[r * 2], w1 = tok_w[r * 2 + 1];
        const float* g = mods(p, layer, row_mi(r), 5); float* h = p.out + (size_t)r * D;
#pragma unroll
        for (int j = 0; j < 4; ++j) { const int c = 4 * lane + 256 * j;
            const u32x2 a = *(const u32x2*)(Y + (size_t)s0 * D + c), bq = *(const u32x2*)(Y + (size_t)s1 * D + c); const f32x4 gg = *(const f32x4*)(g + c); f32x4 hv = *(f32x4*)(h + c);
            hv.x += gg.x * (w0 * __uint_as_float(a.x << 16) + w1 * __uint_as_float(bq.x << 16)); hv.y += gg.y * (w0 * __uint_as_float(a.x & 0xffff0000u) + w1 * __uint_as_float(bq.x & 0xffff0000u));
            hv.z += gg.z * (w0 * __uint_as_float(a.y << 16) + w1 * __uint_as_float(bq.y << 16)); hv.w += gg.w * (w0 * __uint_as_float(a.y & 0xffff0000u) + w1 * __uint_as_float(bq.y & 0xffff0000u));
            *(f32x4*)(h + c) = hv; }
    }
}

#define XB_TMO      128
static_assert(CW_TMO == CW_BAR + XB_TMO, "tmo word");
static_assert(CW_CCNT + 4 * 8 * 16 <= 16384, "all zero-initialised control words lie in the first 64 KiB");
#define XB_XCNT(j)  (256  + 64 * (j))
#define XB_XSUB(j)  (1280 + 64 * (j))
#define XB_XGEN(j)  (2304 + 64 * (j))
#define XB_TOP      3328
#define XB_TOPGEN   3392
#define XCD_BAR_WORDS 3456
#define XB_SPIN_CAP (1u << 22)
__device__ __forceinline__ unsigned xb_ld(unsigned* p)              { return __hip_atomic_load(p, __ATOMIC_RELAXED, __HIP_MEMORY_SCOPE_AGENT); }
__device__ __forceinline__ unsigned xb_add(unsigned* p, unsigned v) { return __hip_atomic_fetch_add(p, v, __ATOMIC_RELAXED, __HIP_MEMORY_SCOPE_AGENT); }
__device__ __forceinline__ unsigned xb_xcc_id() { return (unsigned)__builtin_amdgcn_s_getreg((3 << 11) | 20) & 0xFu; }
#define XB_SPIN(cond, bar) do { unsigned _sp = 0; while (cond) { __builtin_amdgcn_s_sleep(1); \
    if ((++_sp & 255u) == 0u) { if (xb_ld(&(bar)[XB_TMO])) break; if (_sp > XB_SPIN_CAP) { atomicAdd(&(bar)[XB_TMO], 1u); break; } } } } while (0)
struct XcdBarrier { unsigned* bar; unsigned x; volatile LAS unsigned* st; };
__device__ __forceinline__ XcdBarrier xcd_barrier_post(unsigned* bar, volatile LAS unsigned* st) {
    XcdBarrier b; b.bar = bar; b.x = xb_xcc_id(); b.st = st;
    if (threadIdx.x == 0) (void)xb_add(&bar[XB_XCNT(b.x)], 1u);
    return b;
}
__device__ __forceinline__ void xcd_barrier_complete(unsigned* bar, unsigned x, unsigned& nloc, unsigned& nx) {
    const unsigned G = gridDim.x * gridDim.y * gridDim.z;
    unsigned sum, cnt, mine, sp = 0u;
    for (;;) {
        sum = 0u; cnt = 0u; mine = 0u;
#pragma unroll
        for (unsigned j = 0; j < 16; ++j) { const unsigned c = xb_ld(&bar[XB_XCNT(j)]); sum += c; cnt += (c > 0u) ? 1u : 0u; mine = (j == x) ? c : mine; }
        if (sum == G) break;
        __builtin_amdgcn_s_sleep(1);
        if ((++sp & 255u) == 0u) { if (xb_ld(&bar[XB_TMO])) break; if (sp > XB_SPIN_CAP) { atomicAdd(&bar[XB_TMO], 1u); break; } }
    }
    nloc = mine > 0u ? mine : 1u; nx = cnt > 0u ? cnt : 1u;
}
__device__ __forceinline__ void xcd_barrier(const XcdBarrier& b) {
    asm volatile("s_waitcnt vmcnt(0)" ::: "memory");
    __syncthreads();
    if (threadIdx.x == 0) {
        unsigned* bar = b.bar;
        __builtin_amdgcn_s_waitcnt(0);
        unsigned nloc = b.st[0], nx = b.st[1];
        if (nloc == 0u) { xcd_barrier_complete(bar, b.x, nloc, nx); b.st[0] = nloc; b.st[1] = nx; }
        const unsigned old = xb_add(&bar[XB_XSUB(b.x)], 1u);
        const unsigned gen = old / nloc;
        if (old + 1u == (gen + 1u) * nloc) {
            __builtin_amdgcn_fence(__ATOMIC_RELEASE, "agent");
            asm volatile("s_waitcnt vmcnt(0)" ::: "memory");
            const unsigned og = xb_add(&bar[XB_TOP], 1u);
            const unsigned tg = og / nx;
            if (og + 1u == (tg + 1u) * nx) xb_add(&bar[XB_TOPGEN], 1u);
            else XB_SPIN(xb_ld(&bar[XB_TOPGEN]) == tg, bar);
            __builtin_amdgcn_fence(__ATOMIC_ACQUIRE, "agent");
            xb_add(&bar[XB_XGEN(b.x)], 1u);
            asm volatile("s_waitcnt vmcnt(0)" ::: "memory");
        } else {
            XB_SPIN(xb_ld(&bar[XB_XGEN(b.x)]) == gen, bar);
            asm volatile("buffer_inv sc0" ::: "memory");
            asm volatile("s_waitcnt vmcnt(0)" ::: "memory");
        }
    }
    __syncthreads();
}

constexpr int NPHASE = 23;
constexpr int LDS_BYTES = 150 * 1024;
__global__ void __launch_bounds__(NTHREADS, 2) mk(P p, int lo, int hi, int fuse) {
    extern __shared__ __attribute__((aligned(16))) unsigned char lds_raw[];
    LAS unsigned char* lds = (LAS unsigned char*)lds_raw;
    volatile LAS unsigned* misc = (volatile LAS unsigned*)(lds + LDS_BYTES - 64);
    if (threadIdx.x < 16) misc[threadIdx.x] = 0u;
    __syncthreads();
    XcdBarrier bar; bar.bar = (unsigned*)(p.ws + WS_CTL) + CW_BAR; bar.x = 0; bar.st = misc;
    if (hi - lo > 1) bar = xcd_barrier_post((unsigned*)(p.ws + WS_CTL) + CW_BAR, misc);
#if MK_SINGLE
    cg::this_grid().sync();
#endif
#ifndef PROBE_MASK
#define PROBE_MASK 0u
#endif
#ifndef AMP_A
#define AMP_A (-1)
#define AMP_B (-1)
#define AMP_MUL 15
#endif
#define AMP(k) do { if ((k) == AMP_A && blockIdx.x == 0 && threadIdx.x == 0) { const unsigned long long t = __builtin_amdgcn_s_memrealtime(); misc[8] = (unsigned)t; } \
    if ((k) == AMP_B && blockIdx.x == 0 && threadIdx.x == 0) { const unsigned t1 = (unsigned)__builtin_amdgcn_s_memrealtime(), dt = (t1 - misc[8]) * AMP_MUL; while ((unsigned)__builtin_amdgcn_s_memrealtime() - t1 < dt) __builtin_amdgcn_s_sleep(8); } } while (0)
#define PH(k, body) do { if (lo <= (k) && (k) < hi) { if ((k) > lo) { xcd_barrier(bar); } AMP(k); body; \
    if ((PROBE_MASK >> (k)) & 1u) { xcd_barrier(bar); body; } } } while (0)
#define LAYER_PHASES(L, base) \
    PH(base + 0, ph_win(p, lds, L)); \
    PH(base + 1, ph_mix1(p, lds, L)); \
    PH(base + 2, ph_mix2(p, lds, lds_raw, L)); \
    PH(base + 3, ph_mix3(p, lds, L, fuse != 0)); \
    PH(base + 4, { if (L == 0 && fuse) ctx_ret_items(p, lds); ph_merge(p, lds, L, NLAT); if (L == 0) { if (fuse && (int)(gridDim.x - 1 - blockIdx.x) < (NCTX / 64) * 16) ctx_ret_wait(p); mini_merge_ctx(p, lds, L); } }); \
    PH(base + 5, { if (L == 0 && fuse) { ph_gemm_resid_norm(p, lds, 0, (const bf16*)(p.ws + WS_MERGED), 1024, (const bf16*)(p.ws + WS_WOUT), D, 2, 0, 0, 1, p.in[0]); mini_resid_ctx(p, lds, 0, (const bf16*)(p.ws + WS_MERGED), 1024, (const bf16*)(p.ws + WS_WOUT), D, 2, 0, 0, 1, p.in[2]); } \
        else { ph_gemm_resid(p, lds, L, (const bf16*)(p.ws + WS_MERGED), 1024, (const bf16*)(p.ws + WS_WOUT) + (size_t)L * D * D, D, 2, NLAT); if (L == 0) mini_resid_ctx(p, lds, L, (const bf16*)(p.ws + WS_MERGED), 1024, (const bf16*)(p.ws + WS_WOUT), D, 2); } });
    PH(0, ph_prologue(p, lds));
    PH(1, ph_norm(p, lds, 0, 0, true, false, MROWS, !fuse));
    LAYER_PHASES(0, 2)
    if (!fuse) PH(8, ph_norm(p, lds, 0, 1, false, false, MROWS));
    PH(9, ph_ffn1(p, lds));
    PH(10, { if (fuse) { ph_gemm_resid_norm(p, lds, 0, (const bf16*)(p.ws + WS_HMID), FFN, (const bf16*)(p.ws + WS_FFN2), FFN, 5, 1, 1, 0, p.out); mini_resid_ctx(p, lds, 0, (const bf16*)(p.ws + WS_HMID), FFN, (const bf16*)(p.ws + WS_FFN2), FFN, 5, 1, 1, 0); }
        else { ph_gemm_resid(p, lds, 0, (const bf16*)(p.ws + WS_HMID), FFN, (const bf16*)(p.ws + WS_FFN2), FFN, 5, NLAT); mini_resid_ctx(p, lds, 0, (const bf16*)(p.ws + WS_HMID), FFN, (const bf16*)(p.ws + WS_FFN2), FFN, 5); } });
    if (!fuse) PH(11, ph_norm(p, lds, 1, 0, false, false, MROWS));
    LAYER_PHASES(1, 12)
    PH(18, ph_norm(p, lds, 1, 1, false, true, NLAT));
    PH(19, { ph_assign_gather(p, lds); ph_moe_convert(p, lds); });
    PH(20, ph_moe1(p, lds));
    PH(21, ph_moe2(p, lds));
    PH(22, ph_combine(p, 1));
#undef PH
#undef LAYER_PHASES
}

extern "C" void kernel_launch(void* const* d_in, const int* in_sizes, int n_in, void* d_out, int out_size, void* d_ws, size_t ws_size, hipStream_t stream) {
    static int grid = 0;
    if (grid == 0) {
        if (n_in != 30 || out_size != NLAT * D || ws_size < WS_END) { fprintf(stderr, "kernel_launch: unexpected shapes (n_in %d out %d ws %zu)\n", n_in, out_size, ws_size); grid = -1; return; }
        int dev = 0, cus = 0, per_cu = 0;
        hipGetDevice(&dev); hipDeviceGetAttribute(&cus, hipDeviceAttributeMultiprocessorCount, dev);
        hipFuncSetAttribute((const void*)mk, hipFuncAttributeMaxDynamicSharedMemorySize, LDS_BYTES);
        hipOccupancyMaxActiveBlocksPerMultiprocessor(&per_cu, (const void*)mk, NTHREADS, LDS_BYTES);
        if (per_cu < 1) { fprintf(stderr, "kernel_launch: occupancy query says %d blocks per CU\n", per_cu); grid = -1; return; }
        grid = cus;
    }
    if (grid < 0) return;
    hipMemsetAsync((char*)d_ws + WS_CTL, 0, 64 * 1024, stream);
    P p{};
    for (int i = 0; i < 30; ++i) p.in[i] = (const float*)d_in[i];
    p.out = (float*)d_out; p.ws = (unsigned char*)d_ws;
#if MK_SINGLE
    int lo = 0, hi = NPHASE, fuse = grid == 256 ? 1 : 0; void* args[] = {&p, &lo, &hi, &fuse};
    hipLaunchCooperativeKernel((const void*)mk, dim3(grid), dim3(NTHREADS), args, LDS_BYTES, stream);
#else
    for (int ph = 0; ph < NPHASE; ++ph) hipLaunchKernelGGL(mk, dim3(grid), dim3(NTHREADS), LDS_BYTES, stream, p, ph, ph + 1, 0);
#endif
}
```

```cpp
#include <hip/hip_runtime.h>
#include <hip/hip_cooperative_groups.h>
#include <cstdio>
#include <cstdint>
namespace cg = cooperative_groups;

#ifndef MK_SINGLE
#define MK_SINGLE 1
#endif

typedef unsigned short bf16;
typedef float f32x4 __attribute__((ext_vector_type(4)));
typedef unsigned u32x4 __attribute__((ext_vector_type(4)));
typedef unsigned u32x2 __attribute__((ext_vector_type(2)));
#define LAS __attribute__((address_space(3)))

constexpr int D = 1024, NB = 2, SEQ = 8192, CTX = 256, NLAT = NB * SEQ, NCTX = NB * CTX, MROWS = NLAT + NCTX;
constexpr int INC = 6656, FFN = 2816, NEXP = 8, KEYS = CTX + SEQ;
constexpr int NCHUNK = 66;
constexpr float EPS = 1e-6f;
constexpr float QSCALE = 0.125f * 1.4426950408889634f;
constexpr int MOE_ROWS = 34816;
constexpr int NTHREADS = 512;

constexpr size_t MiB = 1u << 20;
constexpr size_t WS_CTL = 0, CTL_BYTES = 1 * MiB;
constexpr size_t WS_MODS = 1 * MiB;
constexpr size_t WS_ROPE = 2 * MiB;
constexpr size_t WS_F1 = 4 * MiB;
constexpr size_t WS_F2 = WS_F1 + 131072;
constexpr size_t WS_FC = WS_F2 + 131072;
constexpr size_t WS_TW = WS_FC + 262144;
constexpr size_t WS_ROUTE = 5 * MiB;
constexpr size_t WS_HCTX = 6 * MiB;
constexpr size_t WS_WIN = 8 * MiB;
constexpr size_t WS_WB = 34 * MiB;
constexpr size_t WS_WOUT = 40 * MiB;
constexpr size_t WS_FFN1 = 44 * MiB;
constexpr size_t WS_FFN2 = 55 * MiB;
constexpr size_t WS_A = 61 * MiB;
constexpr size_t WS_X = 94 * MiB;
constexpr size_t WS_Y = 144 * MiB;
constexpr size_t WS_RETQ = WS_Y;
constexpr size_t WS_RETK = WS_RETQ + (size_t)MROWS * 256 * 2;
constexpr size_t WS_RETV = WS_RETK + (size_t)MROWS * 256 * 2;
constexpr size_t WS_RETG = WS_RETV + (size_t)MROWS * 256 * 2;
constexpr size_t WS_ATTQ = WS_Y + 33 * MiB;
constexpr size_t WS_ATTK = WS_Y + 50 * MiB;
constexpr size_t WS_ATTV = WS_Y + 55 * MiB;
constexpr size_t WS_CONV = WS_Y + 60 * MiB;
constexpr size_t WS_UT = WS_Y + 77 * MiB;
constexpr size_t WS_UTC = WS_Y + 93 * MiB;
constexpr size_t WS_Z = WS_Y + 94 * MiB;
constexpr size_t WS_RETS = WS_Y + 126 * MiB;
constexpr size_t WS_MERGED = WS_Y + 143 * MiB;
constexpr size_t WS_G = 320 * MiB;
constexpr size_t WS_MOE1 = WS_G;
constexpr size_t WS_MOE2 = WS_G + (size_t)NEXP * 5632 * 1024 * 2;
constexpr size_t WS_HMID = WS_Y;
constexpr size_t WS_HMOE = 61 * MiB;
constexpr size_t WS_FS = 252 * MiB;
constexpr size_t WS_A8 = 386 * MiB;
constexpr size_t WS_WIN8 = 430 * MiB;
constexpr size_t WS_RETS2 = 452 * MiB;
constexpr size_t WS_Y2 = 160 * MiB;
constexpr size_t WS_END = 469 * MiB;
static_assert(WS_MERGED + (size_t)MROWS * 1024 * 2 <= WS_G, "map");
static_assert(WS_HMOE + (size_t)MOE_ROWS * FFN * 2 <= WS_FS && WS_FS + (size_t)MOE_ROWS * 1024 * 2 <= WS_G, "map moe");
static_assert(WS_MOE2 + (size_t)NEXP * 1024 * FFN * 2 <= WS_END, "map moe w");
static_assert(WS_G + (size_t)MROWS * 4096 <= WS_A8 && WS_A8 + (size_t)NLAT * 1024 <= WS_MOE2 && WS_MOE2 + (size_t)NEXP * 1024 * FFN <= WS_WIN8 && WS_WIN8 + (size_t)2 * 4096 * 1024 <= WS_RETS2, "map fp8 w_in");
constexpr int CW_CNT = 64;
constexpr int CW_CUR = 128;
constexpr int CW_BAR = 4096;
constexpr int CW_TMO = CW_BAR + 128;
constexpr int CW_PCNT = 8192;
constexpr int CW_CCNT = 8192 + 4 * 64 * 16;
constexpr size_t CTL_XBUF = 128 * 1024;

struct P {
    const float* in[30];
    float* out;
    unsigned char* ws;
};

__device__ __forceinline__ float bf2f(bf16 v) { return __uint_as_float((unsigned)v << 16); }
__device__ __forceinline__ bf16 f2bf(float f) { unsigned u = __float_as_uint(f); return (bf16)((u + 0x7fffu + ((u >> 16) & 1u)) >> 16); }
__device__ __forceinline__ unsigned pk2(float lo, float hi) { return (unsigned)f2bf(lo) | ((unsigned)f2bf(hi) << 16); }
__device__ __forceinline__ float sigmoidf_(float x) { return 1.f / (1.f + __expf(-x)); }
__device__ __forceinline__ float siluf_(float x) { return x / (1.f + __expf(-x)); }
__device__ __forceinline__ float sigmoid_fast(float x) { return __builtin_amdgcn_rcpf(1.f + __builtin_amdgcn_exp2f(-1.4426950408889634f * x)); }
__device__ __forceinline__ float silu_fast(float x) { return x * __builtin_amdgcn_rcpf(1.f + __builtin_amdgcn_exp2f(-1.4426950408889634f * x)); }
__device__ __forceinline__ float wave_sum(float v) {
#pragma unroll
    for (int o = 1; o < 64; o <<= 1) v += __shfl_xor(v, o);
    return v;
}
__device__ __forceinline__ int row_mi(int r) { return r < NLAT ? (r >> 13) : 2; }
__device__ __forceinline__ float* hrow(const P& p, int r) { return r < NLAT ? p.out + (size_t)r * D : (float*)(p.ws + WS_HCTX) + (size_t)(r - NLAT) * D; }
__device__ __forceinline__ const float* mods(const P& p, int layer, int mi, int chunk) { return (const float*)(p.ws + WS_MODS) + ((size_t)(layer * 3 + mi) * 6 + chunk) * D; }

__device__ __forceinline__ int rowmap(int mode, int n) {
    if (mode == 0) return n;
    if (mode == 1 || mode == 2) return 8 * (n >> 2) + (n & 3) + (mode == 2 ? 4 : 0);
    const int tile = n >> 8, l = n & 255, head = l >> 6, d = l & 63;
    const bool ropet = tile == 1 || tile == 2 || tile == 5 || tile == 6 || (tile == 7 && head < 2);
    if (ropet) { const int i = d & 31, nn = d >> 5; return tile * 256 + 128 * (i >> 4) + 32 * head + 8 * ((i >> 2) & 3) + 4 * nn + (i & 3); }
    if (tile == 7) return tile * 256 + 128 * (d >> 5) + 32 * head + 8 * ((d >> 3) & 3) + (d & 7);
    return n;
}
__device__ __forceinline__ void conv_tile(LAS float* scr, const float* src, int ldn, int k0, int n0, bf16* dst, int ldd, int koff, int mode) {
    const int tid = threadIdx.x;
    __syncthreads();
#pragma unroll
    for (int i = 0; i < 8; ++i) { const int e = tid + i * NTHREADS, kk = e >> 6, nn = e & 63; scr[kk * 65 + nn] = src[(size_t)(k0 + kk) * ldn + n0 + nn]; }
    __syncthreads();
    const int nn = tid >> 3, kc = (tid & 7) * 8;
    u32x4 o; o.x = pk2(scr[(kc + 0) * 65 + nn], scr[(kc + 1) * 65 + nn]); o.y = pk2(scr[(kc + 2) * 65 + nn], scr[(kc + 3) * 65 + nn]);
    o.z = pk2(scr[(kc + 4) * 65 + nn], scr[(kc + 5) * 65 + nn]); o.w = pk2(scr[(kc + 6) * 65 + nn], scr[(kc + 7) * 65 + nn]);
    *(u32x4*)(dst + (size_t)rowmap(mode, n0 + nn) * ldd + koff + k0 + kc) = o;
}
constexpr float F8_WSCALE = 32.f;
__device__ __forceinline__ unsigned pk4_fp8(float a, float b, float c, float d) { int w = 0; w = __builtin_amdgcn_cvt_pk_fp8_f32(a, b, w, false); w = __builtin_amdgcn_cvt_pk_fp8_f32(c, d, w, true); return (unsigned)w; }
__device__ __forceinline__ void conv_tile2_f8(LAS float* scr, const float* src, int ldn, unsigned char* dst8, int ldd, int mode, int k0a, int n0a, int k0b, int n0b, bool two) {
    const int tid = threadIdx.x;
    f32x4 va[2], vb[2];
#pragma unroll
    for (int i = 0; i < 2; ++i) { const int e = tid + i * NTHREADS, kk = e >> 4, n4 = (e & 15) * 4;
        va[i] = *(const f32x4*)(src + (size_t)(k0a + kk) * ldn + n0a + n4);
        if (two) vb[i] = *(const f32x4*)(src + (size_t)(k0b + kk) * ldn + n0b + n4); }
    __syncthreads();
#pragma unroll
    for (int i = 0; i < 2; ++i) { const int e = tid + i * NTHREADS, kk = e >> 4, n4 = (e & 15) * 4;
#pragma unroll
        for (int q = 0; q < 4; ++q) { scr[kk * 65 + n4 + q] = va[i][q]; if (two) scr[64 * 65 + kk * 65 + n4 + q] = vb[i][q]; } }
    __syncthreads();
    const int nn = tid >> 3, kc = (tid & 7) * 8;
#pragma unroll
    for (int t = 0; t < 2; ++t) { if (t == 1 && !two) break; const LAS float* sp = scr + t * 64 * 65; const int k0 = t ? k0b : k0a, n0 = t ? n0b : n0a;
        u32x2 o; o.x = pk4_fp8(sp[(kc + 0) * 65 + nn] * F8_WSCALE, sp[(kc + 1) * 65 + nn] * F8_WSCALE, sp[(kc + 2) * 65 + nn] * F8_WSCALE, sp[(kc + 3) * 65 + nn] * F8_WSCALE);
        o.y = pk4_fp8(sp[(kc + 4) * 65 + nn] * F8_WSCALE, sp[(kc + 5) * 65 + nn] * F8_WSCALE, sp[(kc + 6) * 65 + nn] * F8_WSCALE, sp[(kc + 7) * 65 + nn] * F8_WSCALE);
        *(u32x2*)(dst8 + (size_t)rowmap(mode, n0 + nn) * ldd + k0 + kc) = o; }
}
__device__ __forceinline__ void conv_tile128_f8(LAS float* scr, const float* src, int ldn, unsigned char* dst8, int ldd, int mode, int k0, int n0) {
    const int tid = threadIdx.x;
    f32x4 v[8];
#pragma unroll
    for (int i = 0; i < 8; ++i) { const int e = tid + i * NTHREADS, kk = e >> 5, n4 = (e & 31) * 4; v[i] = *(const f32x4*)(src + (size_t)(k0 + kk) * ldn + n0 + n4); }
    __syncthreads();
#pragma unroll
    for (int i = 0; i < 8; ++i) { const int e = tid + i * NTHREADS, kk = e >> 5, n4 = (e & 31) * 4;
#pragma unroll
        for (int q = 0; q < 4; ++q) scr[kk * 129 + n4 + q] = v[i][q]; }
    __syncthreads();
    const int nn = tid >> 2, kc = (tid & 3) * 32;
    u32x4 o[2];
#pragma unroll
    for (int h = 0; h < 2; ++h) { const LAS float* sp = scr + (kc + h * 16) * 129 + nn;
        o[h].x = pk4_fp8(sp[0] * F8_WSCALE, sp[129] * F8_WSCALE, sp[2 * 129] * F8_WSCALE, sp[3 * 129] * F8_WSCALE);
        o[h].y = pk4_fp8(sp[4 * 129] * F8_WSCALE, sp[5 * 129] * F8_WSCALE, sp[6 * 129] * F8_WSCALE, sp[7 * 129] * F8_WSCALE);
        o[h].z = pk4_fp8(sp[8 * 129] * F8_WSCALE, sp[9 * 129] * F8_WSCALE, sp[10 * 129] * F8_WSCALE, sp[11 * 129] * F8_WSCALE);
        o[h].w = pk4_fp8(sp[12 * 129] * F8_WSCALE, sp[13 * 129] * F8_WSCALE, sp[14 * 129] * F8_WSCALE, sp[15 * 129] * F8_WSCALE); }
    unsigned char* d = dst8 + (size_t)rowmap(mode, n0 + nn) * ldd + k0 + kc;
    *(u32x4*)d = o[0]; *(u32x4*)(d + 16) = o[1];
}
__device__ __forceinline__ void conv_tile4(LAS float* scr, const float* src, int ldn, int nn, int cnt, int i, int st, bf16* dst, int ldd, int koff, int mode) {
    const int tid = threadIdx.x, kk = tid >> 4, n4 = (tid & 15) * 4;
    f32x4 v[4][2];
#pragma unroll
    for (int t = 0; t < 4; ++t) { const int it = i + t * st; if (it < cnt) { const int k0 = (it / nn) * 64, n0 = (it % nn) * 64;
#pragma unroll
        for (int h = 0; h < 2; ++h) v[t][h] = *(const f32x4*)(src + (size_t)(k0 + kk + 32 * h) * ldn + n0 + n4); } }
    __syncthreads();
#pragma unroll
    for (int t = 0; t < 4; ++t) if (i + t * st < cnt) {
#pragma unroll
        for (int h = 0; h < 2; ++h)
#pragma unroll
            for (int q = 0; q < 4; ++q) scr[t * 64 * 65 + (kk + 32 * h) * 65 + n4 + q] = v[t][h][q]; }
    __syncthreads();
    const int nr = tid >> 3, kc = (tid & 7) * 8;
#pragma unroll
    for (int t = 0; t < 4; ++t) { const int it = i + t * st; if (it < cnt) { const int k0 = (it / nn) * 64, n0 = (it % nn) * 64; const LAS float* sp = scr + t * 64 * 65;
        u32x4 o; o.x = pk2(sp[(kc + 0) * 65 + nr], sp[(kc + 1) * 65 + nr]); o.y = pk2(sp[(kc + 2) * 65 + nr], sp[(kc + 3) * 65 + nr]);
        o.z = pk2(sp[(kc + 4) * 65 + nr], sp[(kc + 5) * 65 + nr]); o.w = pk2(sp[(kc + 6) * 65 + nr], sp[(kc + 7) * 65 + nr]);
        *(u32x4*)(dst + (size_t)rowmap(mode, n0 + nr) * ldd + koff + k0 + kc) = o; } }
}
struct CJob { const float* src; int K, N; bf16* dst; int ldd, koff, mode, ldn; };
__device__ __forceinline__ CJob get_job(const P& p, int j) {
    CJob c;
    if (j < 10) { const int l = j / 5, t = j % 5; bf16* wb = (bf16*)(p.ws + WS_WB) + (size_t)l * 1024 * 1536;
        if (t == 0) c = CJob{p.in[8] + (size_t)l * D * INC, D, l == 0 ? INC : 2560, (bf16*)(p.ws + WS_WIN) + (size_t)l * INC * D, D, 0, 3, INC};
        else if (t == 1) c = CJob{p.in[13] + (size_t)l * 256 * D, 256, D, wb, 1536, 512, 0};
        else if (t == 2) c = CJob{p.in[16] + (size_t)l * 512 * D, 512, D, wb, 1536, 768, 0};
        else if (t == 3) c = CJob{p.in[21] + (size_t)l * 256 * D, 256, D, wb, 1536, 1280, 0};
        else c = CJob{p.in[22] + (size_t)l * D * D, D, D, (bf16*)(p.ws + WS_WOUT) + (size_t)l * D * D, D, 0, 0}; }
    else if (j == 10) c = CJob{p.in[23], D, FFN, (bf16*)(p.ws + WS_FFN1), D, 0, 1};
    else if (j == 11) c = CJob{p.in[24], D, FFN, (bf16*)(p.ws + WS_FFN1), D, 0, 2};
    else c = CJob{p.in[25], FFN, D, (bf16*)(p.ws + WS_FFN2), FFN, 0, 0};
    return c;
}
__device__ __forceinline__ CJob get_moe_job(const P& p, int j) {
    const int e = j / 3, t = j % 3; CJob c;
    const float* sg = p.in[27]; const float* su = p.in[28]; const float* sd = p.in[29];
    asm volatile("" : "+s"(sg), "+s"(su), "+s"(sd));
    if (t == 0) c = CJob{sg + (size_t)e * D * FFN, D, FFN, (bf16*)(p.ws + WS_MOE1 + (size_t)e * 5632 * D), D, 0, 1};
    else if (t == 1) c = CJob{su + (size_t)e * D * FFN, D, FFN, (bf16*)(p.ws + WS_MOE1 + (size_t)e * 5632 * D), D, 0, 2};
    else c = CJob{sd + (size_t)e * FFN * D, FFN, D, (bf16*)(p.ws + WS_MOE2 + (size_t)e * D * FFN), FFN, 0, 0};
    return c;
}
template <bool MOE> __device__ __forceinline__ void run_conv_jobs(const P& p, LAS float* scr, int njobs, int bid, int nb) {
    int base = 0, base2 = 0;
    for (int j = 0; j < njobs; ++j) {
        const CJob jb = MOE ? get_moe_job(p, j) : get_job(p, j); const int nn = jb.N / 64, cnt = (jb.K / 64) * nn, ldn = jb.ldn ? jb.ldn : jb.N;
        const int first = ((bid - base) % nb + nb) % nb;
        if (MOE) { const int nn2 = jb.N / 128, cnt2 = (jb.K / 128) * nn2; const int first2 = ((bid - base2) % nb + nb) % nb;
            for (int i = first2; i < cnt2; i += nb) conv_tile128_f8(scr, jb.src, jb.N, (unsigned char*)jb.dst, jb.ldd, jb.mode, (i / nn2) * 128, (i % nn2) * 128);
            base2 += cnt2; }
        else for (int i = first; i < cnt; i += 4 * nb) conv_tile4(scr, jb.src, ldn, nn, cnt, i, nb, jb.dst, jb.ldd, jb.koff, jb.mode);
        base += cnt;
    }
}
__device__ __forceinline__ void ph_prologue(const P& p, LAS unsigned char* lds) {
    const int tid = threadIdx.x, bid = blockIdx.x, nb = gridDim.x;
    const int gt = bid * NTHREADS + tid, ngt = nb * NTHREADS;
    LAS float* scr = (LAS float*)lds;
    run_conv_jobs<false>(p, scr, 13, bid, nb);
    __syncthreads();
    for (int i = bid; i < 512; i += nb) { const int l = i >> 8, t = i & 255;
        conv_tile128_f8(scr, p.in[8] + (size_t)l * D * INC + 2560, INC, p.ws + WS_WIN8 + (size_t)l * 4096 * 1024, 1024, 0, (t >> 5) * 128, (t & 31) * 128); }
    __syncthreads();
    {
        LAS float* tc = (LAS float*)lds; LAS float* tsn = tc + 64;
        __syncthreads();
        if (tid < 64) { tc[tid] = cospif(tid * (2.f / 64.f)); tsn[tid] = sinpif(tid * (2.f / 64.f)); }
        __syncthreads();
        const float s = 1.0f / sqrtf(64.f * 8192.f);
        for (int e = gt; e < 2 * 512 * 1024; e += ngt) {
            const int n = e & 1023, kk = (e >> 10) & 511, l = e >> 19;
            const int part = kk >> 8, g = (kk >> 6) & 3, c = kk & 63;
            const float* W = p.in[9] + (size_t)l * 256 * D + (size_t)(g * 64) * D + n;
            float acc = 0.f;
#pragma unroll
            for (int c2 = 0; c2 < 64; ++c2) { const int m = (c * c2) & 63; const float t = part == 0 ? tc[m] : -tsn[m]; acc += t * W[(size_t)c2 * D]; }
            ((bf16*)(p.ws + WS_WB))[(size_t)l * 1024 * 1536 + (size_t)n * 1536 + kk] = f2bf(acc * s);
        }
        __syncthreads();
    }
    {
        float* rc = (float*)(p.ws + WS_ROPE); float* rs = rc + SEQ * 32;
        for (int e = gt; e < SEQ * 32; e += ngt) {
            const int s = e >> 5, i = e & 31; const float inv = powf(10000.f, -(float)(i & 15) / 16.f);
            const float pos = (float)(i < 16 ? (s >> 6) : (s & 63)); const float ang = pos * inv;
            rc[e] = cosf(ang); rs[e] = sinf(ang);
        }
    }
    {
        bf16* F1 = (bf16*)(p.ws + WS_F1); bf16* F2 = (bf16*)(p.ws + WS_F2); bf16* FC = (bf16*)(p.ws + WS_FC);
        for (int e = gt; e < 256 * 256; e += ngt) {
            const int rho = e >> 8, n1 = e & 255; float v = 0.f;
            if (n1 < 128) { const int k1 = (rho >> 5) * 16 + (rho & 15), c = (rho >> 4) & 1, m = (k1 * n1) & 127; v = c == 0 ? cospif(m * (2.f / 128.f)) : -sinpif(m * (2.f / 128.f)); }
            F1[e] = f2bf(v);
            float w = 0.f;
            if (rho < 128 && n1 < 128) { const int c2 = rho >> 6, k2 = rho & 63, c = n1 >> 6, n2 = n1 & 63, m = (k2 * n2) & 63; const float cs = cospif(m * (2.f / 64.f)), sn = sinpif(m * (2.f / 64.f));
                w = c2 == 0 ? (c == 0 ? cs : sn) : (c == 0 ? sn : -cs); }
            F2[e] = f2bf(w);
        }
        float* TW = (float*)(p.ws + WS_TW);
        for (int e = gt; e < 128 * 64; e += ngt) { const int k1 = e >> 6, n2 = e & 63; TW[2 * e] = cospif((k1 * n2) * (2.f / 8192.f)); TW[2 * e + 1] = sinpif((k1 * n2) * (2.f / 8192.f)); }
        const float sc = sqrtf(32.f);
        for (int e = gt; e < 512 * 256; e += ngt) { const int rho = e >> 8, n = e & 255, c2 = rho >> 8, k = rho & 255, m = (k * n) & 255; FC[e] = f2bf(sc * (c2 == 0 ? cospif(m * (2.f / 256.f)) : sinpif(m * (2.f / 256.f)))); }
    }
    {
        LAS float* sv = (LAS float*)lds;
        LAS float* red = sv + 3 * 1024;
        __syncthreads();
        for (int e = tid; e < 3 * 1024; e += NTHREADS) { const int j = e >> 10, k = e & 1023; const float v = j < 2 ? p.in[1][j * D + k] : p.in[3][k]; sv[e] = siluf_(v); }
        __syncthreads();
        const int kq = tid >> 6, cl = tid & 63;
        for (int it = bid; it < 2 * 96; it += nb) {
            const int l = it / 96, n = (it % 96) * 64 + cl;
            const float* W = p.in[4] + (size_t)l * D * 6144 + n;
            float a0 = 0.f, a1 = 0.f, a2 = 0.f;
#pragma unroll 32
            for (int k = kq; k < D; k += 8) { const float w = W[(size_t)k * 6144]; a0 += sv[k] * w; a1 += sv[1024 + k] * w; a2 += sv[2048 + k] * w; }
            red[(kq * 3 + 0) * 64 + cl] = a0; red[(kq * 3 + 1) * 64 + cl] = a1; red[(kq * 3 + 2) * 64 + cl] = a2;
            __syncthreads();
            if (tid < 192) { const int j = tid >> 6; float s = 0.f;
#pragma unroll
                for (int q = 0; q < 8; ++q) s += red[(q * 3 + j) * 64 + cl];
                ((float*)(p.ws + WS_MODS))[(size_t)(l * 3 + j) * 6144 + n] = s + p.in[5][l * 6144 + n]; }
            __syncthreads();
        }
    }
}
__device__ __forceinline__ void ph_moe_convert(const P& p, LAS unsigned char* lds) {
    LAS float* scr = (LAS float*)lds;
    const int bid = blockIdx.x, nb = gridDim.x;
    run_conv_jobs<true>(p, scr, 24, bid, nb);
    __syncthreads();
}

__device__ __forceinline__ void ph_norm(const P& p, LAS unsigned char* lds, int layer, int which, bool first, bool route, int nrows, bool copy = true) {
    LAS unsigned* cnt_lds = (LAS unsigned*)lds;
    LAS float* Wl = (LAS float*)(lds + 1024);
    if (route) { __syncthreads(); if (threadIdx.x < NEXP) cnt_lds[threadIdx.x] = 0u;
        for (int i = threadIdx.x; i < D * NEXP; i += NTHREADS) Wl[(i & 7) * D + (i >> 3)] = p.in[26][i];
        __syncthreads(); }
    const int lane = threadIdx.x & 63, gw = blockIdx.x * 8 + (threadIdx.x >> 6), ngw = gridDim.x * 8;
    const float* gain = p.in[which == 0 ? 6 : 7] + layer * D;
    bf16* A = (bf16*)(p.ws + WS_A);
    for (int r = gw; r < nrows; r += ngw) {
        const int mi = row_mi(r);
        const float* src = first ? (r < NLAT ? p.in[0] + (size_t)r * D : p.in[2] + (size_t)(r - NLAT) * D) : hrow(p, r);
        const float* shift = mods(p, layer, mi, which == 0 ? 0 : 3); const float* scale = mods(p, layer, mi, which == 0 ? 1 : 4);
        f32x4 v[4]; float ss = 0.f;
#pragma unroll
        for (int j = 0; j < 4; ++j) { v[j] = *(const f32x4*)(src + 4 * lane + 256 * j); ss += v[j].x * v[j].x + v[j].y * v[j].y + v[j].z * v[j].z + v[j].w * v[j].w; }
        if (first && copy) { float* h = hrow(p, r);
#pragma unroll
            for (int j = 0; j < 4; ++j) *(f32x4*)(h + 4 * lane + 256 * j) = v[j]; }
        const float rstd = rsqrtf(wave_sum(ss) * (1.f / D) + EPS);
        float lg[8];
#pragma unroll
        for (int e = 0; e < 8; ++e) lg[e] = 0.f;
#pragma unroll
        for (int j = 0; j < 4; ++j) {
            const int c = 4 * lane + 256 * j;
            const f32x4 g = *(const f32x4*)(gain + c), sc = *(const f32x4*)(scale + c), sh = *(const f32x4*)(shift + c);
            f32x4 y = v[j] * rstd * g * (sc + 1.f) + sh;
            u32x2 o; o.x = pk2(y.x, y.y); o.y = pk2(y.z, y.w);
            if (!route) *(u32x2*)(A + (size_t)r * D + c) = o;
            if ((which == 0 || route) && r < NLAT) *(unsigned*)(p.ws + WS_A8 + (size_t)r * D + c) = pk4_fp8(y.x, y.y, y.z, y.w);
            if (route) {
#pragma unroll
                for (int e = 0; e < 8; ++e) { const f32x4 w = *(const LAS f32x4*)(Wl + e * D + c); lg[e] += (y[0] * w[0] + y[1] * w[1]) + (y[2] * w[2] + y[3] * w[3]); }
            }
        }
        if (route) {
#pragma unroll
            for (int e = 0; e < 8; ++e) lg[e] = wave_sum(lg[e]);
            if (lane == 0) {
                int e0 = 0; float v0 = lg[0];
#pragma unroll
                for (int e = 1; e < 8; ++e) if (lg[e] > v0) { v0 = lg[e]; e0 = e; }
                int e1 = -1; float v1 = -INFINITY;
#pragma unroll
                for (int e = 0; e < 8; ++e) if (e != e0 && lg[e] > v1) { v1 = lg[e]; e1 = e; }
                const float w0 = 1.f / (1.f + expf(v1 - v0));
                int* tok_e = (int*)(p.ws + WS_ROUTE); float* tok_w = (float*)(p.ws + WS_ROUTE) + 16384 * 2;
                tok_e[r * 2] = e0; tok_e[r * 2 + 1] = e1; tok_w[r * 2] = w0; tok_w[r * 2 + 1] = 1.f - w0;
                __hip_atomic_fetch_add(cnt_lds + e0, 1u, __ATOMIC_RELAXED, __HIP_MEMORY_SCOPE_WORKGROUP); __hip_atomic_fetch_add(cnt_lds + e1, 1u, __ATOMIC_RELAXED, __HIP_MEMORY_SCOPE_WORKGROUP);
            }
        }
    }
    if (route) { __syncthreads(); if (threadIdx.x < NEXP) ((unsigned*)(p.ws + WS_ROUTE) + 16384 * 6)[blockIdx.x * NEXP + threadIdx.x] = cnt_lds[threadIdx.x]; __syncthreads(); }
}

__device__ __forceinline__ void norm_row(const P& p, int layer, int which, int r, int lane) {
    const float* gain = p.in[which == 0 ? 6 : 7] + layer * D; bf16* A = (bf16*)(p.ws + WS_A);
    const int mi = row_mi(r); const float* src = hrow(p, r);
    const float* shift = mods(p, layer, mi, which == 0 ? 0 : 3); const float* scale = mods(p, layer, mi, which == 0 ? 1 : 4);
    f32x4 v[4]; float ss = 0.f;
#pragma unroll
    for (int j = 0; j < 4; ++j) { v[j] = *(const f32x4*)(src + 4 * lane + 256 * j); ss += v[j].x * v[j].x + v[j].y * v[j].y + v[j].z * v[j].z + v[j].w * v[j].w; }
    const float rstd = rsqrtf(wave_sum(ss) * (1.f / D) + EPS);
#pragma unroll
    for (int j = 0; j < 4; ++j) { const int c = 4 * lane + 256 * j;
        const f32x4 g = *(const f32x4*)(gain + c), sc = *(const f32x4*)(scale + c), sh = *(const f32x4*)(shift + c);
        const f32x4 y = v[j] * rstd * g * (sc + 1.f) + sh;
        u32x2 o; o.x = pk2(y.x, y.y); o.y = pk2(y.z, y.w);
        *(u32x2*)(A + (size_t)r * D + c) = o; }
}

namespace fg {
typedef short bf16x8 __attribute__((ext_vector_type(8)));
constexpr int BM = 256, BK = 64, HALF = 128, HTB = HALF * BK * 2, STAGE_BYTES = 8 * HTB, NXCD = 8, WGM = 8;
__device__ __forceinline__ int lds_byte(int r, int c) { const int st = (r >> 4) * 2 + (c >> 5), rr = r & 15, cc = c & 31, ob = rr * 64 + cc * 2; return st * 1024 + (ob ^ (((ob >> 9) & 1) << 5)); }
__device__ __forceinline__ void stage_rc(int b, int& R, int& C) { const int st = b / 1024, sb = b % 1024, swz = sb ^ (((sb >> 9) & 1) << 5); R = (st >> 1) * 16 + swz / 64; C = (st & 1) * 32 + (swz % 64) / 2; }
__device__ __forceinline__ int perm32(int rho) { const int n = rho >> 4, i = rho & 15; return 8 * (i >> 2) + 4 * n + (i & 3); }
struct Unit { int pm, pn; const char* A; const char* B; int nt, aux; };
__device__ __forceinline__ bool tile_order(int i, int nM, int nN, int G, int c, int& pm, int& pn) {
    const int nwg = nM * nN; const long L = (long)i * G + c; if (L >= nwg) return false;
    int wgid = (int)L; { const int q = nwg / NXCD, r = nwg % NXCD, xcd = wgid % NXCD, off = wgid / NXCD; wgid = (xcd < r ? xcd * (q + 1) : r * (q + 1) + (xcd - r) * q) + off; }
    const int nig = WGM * nN, gid = wgid / nig, fm = gid * WGM, gsz = (nM - fm) < WGM ? (nM - fm) : WGM;
    pm = fm + ((wgid % nig) % gsz); pn = (wgid % nig) / gsz; return true;
}
struct PlainSched {
    const char* Abase; const char* Bbase; int lda, ldb, nM, nN, G, c, nt;
    __device__ __forceinline__ int arow(int R) const { return R; }
    __device__ __forceinline__ int ahalf() const { return HALF; }
    __device__ __forceinline__ bool next(int i, Unit& u) const { if (!tile_order(i, nM, nN, G, c, u.pm, u.pn)) return false;
        u.A = Abase + (size_t)u.pm * BM * lda * 2; u.B = Bbase + (size_t)u.pn * BM * ldb * 2; u.nt = nt; u.aux = 0; return true; }
};
struct ExpertSched {
    const char* Abase; const char* Bbase; int lda, ldb, nM, nN, G, c, nt; const LAS int* tile_e; size_t estride;
    __device__ __forceinline__ int arow(int R) const { return R; }
    __device__ __forceinline__ int ahalf() const { return HALF; }
    __device__ __forceinline__ bool next(int i, Unit& u) const { if (!tile_order(i, nM, nN, G, c, u.pm, u.pn)) return false;
        u.A = Abase + (size_t)u.pm * BM * lda * 2; u.B = Bbase + (size_t)tile_e[u.pm] * estride + (size_t)u.pn * BM * ldb * 2; u.nt = nt; u.aux = 0; return true; }
};
struct WinSched {
    const char* Abase; const char* Bbase; int G, c, mode, nN;
    __device__ __forceinline__ int arow(int R) const { return mode == 0 ? 256 * (R & 15) + 64 * ((R >> 4) & 3) + (R >> 6) : R; }
    __device__ __forceinline__ int ahalf() const { return mode == 0 ? 4096 : HALF; }
    __device__ __forceinline__ bool next(int i, Unit& u) const { if (!tile_order(i, mode == 0 ? 64 : 2, nN, G, c, u.pm, u.pn)) return false;
        const size_t row0 = mode == 0 ? (size_t)((u.pm >> 5) * SEQ + 2 * (u.pm & 31)) : (size_t)(NLAT + u.pm * CTX);
        u.A = Abase + row0 * D * 2; u.B = Bbase + (size_t)u.pn * BM * D * 2; u.nt = D / 64; u.aux = mode; return true; }
};
struct MergeSched {
    const char* Xbase; const char* Wbase; int nM, G, c;
    __device__ __forceinline__ int arow(int R) const { return R; }
    __device__ __forceinline__ int ahalf() const { return HALF; }
    __device__ __forceinline__ bool next(int i, Unit& u) const { if (!tile_order(i >> 2, nM, 4, G, c, u.pm, u.pn)) return false;
        const int br = i & 3, koff = br == 0 ? 0 : (br == 1 ? 512 : (br == 2 ? 768 : 1280));
        u.A = Xbase + ((size_t)u.pm * BM * 1536 + koff) * 2; u.B = Wbase + ((size_t)u.pn * BM * 1536 + koff) * 2; u.nt = (br & 1) ? 4 : 8; u.aux = br; return true; }
};
template <class E, class = void> struct is_chain { static constexpr bool v = false; };
template <class E> struct is_chain<E, decltype((void)E::CHAIN)> { static constexpr bool v = E::CHAIN; };
typedef f32x4 Acc[2][2][4][2];
typedef int i32x4 __attribute__((ext_vector_type(4))); typedef int i32x8 __attribute__((ext_vector_type(8)));
__device__ __forceinline__ i32x8 ld32(const LAS unsigned char* p) { const i32x4 a = *(const LAS i32x4*)p, b = *(const LAS i32x4*)(p + 16); return __builtin_shufflevector(a, b, 0, 1, 2, 3, 4, 5, 6, 7); }
template <class Epi, class Sched, bool F8 = false>
__device__ __forceinline__ void gemm_phase(LAS unsigned char* lds, int lda, int ldb, const Sched& S, const Epi& E) {
    int tid_ = threadIdx.x; asm volatile("" : "+v"(tid_));
    const int tid = tid_, wid = __builtin_amdgcn_readfirstlane(tid >> 6), lane = tid & 63, wr = wid >> 2, wc = wid & 3, fr = lane & 15, fq = lane >> 4;
    unsigned voffA[2], voffB[2];
#pragma unroll
    for (int i = 0; i < 2; ++i) { int R, C; stage_rc(tid * 16 + i * 8192, R, C); const int Rb = Epi::PERM ? ((R & ~31) + perm32(R & 31)) : R;
        voffA[i] = (unsigned)(S.arow(R) * lda + C) * 2u; voffB[i] = (unsigned)(Rb * ldb + C) * 2u; }
    const size_t kstep = (size_t)(BK * 2);
    const size_t hstepA = (size_t)S.ahalf() * lda * 2, hstepB = (size_t)HALF * ldb * 2;
    const unsigned ldsw = (unsigned)wid * 1024u;
    const int aoff = lds_byte(wr * 64 + fr, F8 ? fq * 16 : fq * 8), boff = lds_byte(wc * 32 + fr, F8 ? fq * 16 : fq * 8);
#define FG_SA(b, h) (((b) * 2 + (h)) * HTB)
#define FG_SB(b, h) ((4 + (b) * 2 + (h)) * HTB)
#define FG_STAGE(bufoff, gbase, voff) do { _Pragma("unroll") for (int _i = 0; _i < 2; ++_i) \
        __builtin_amdgcn_global_load_lds((const unsigned*)((const char*)(gbase) + (voff)[_i]), (LAS unsigned*)(lds + (bufoff) + ldsw + _i * 8192), 16, 0, 0); } while (0)
#define FG_LDA(dst, b, h) do { if constexpr (F8) { _Pragma("unroll") for (int m = 0; m < 4; ++m) dst##8[m] = ld32(lds + FG_SA(b, h) + aoff + m * 2048); } \
        else { _Pragma("unroll") for (int m = 0; m < 4; ++m) _Pragma("unroll") for (int k = 0; k < 2; ++k) dst[m][k] = *(const LAS bf16x8*)(lds + FG_SA(b, h) + aoff + m * 2048 + k * 1024); } } while (0)
#define FG_LDB(dst, b, h) do { if constexpr (F8) { _Pragma("unroll") for (int n = 0; n < 2; ++n) dst##8[n] = ld32(lds + FG_SB(b, h) + boff + n * 2048); } \
        else { _Pragma("unroll") for (int n = 0; n < 2; ++n) _Pragma("unroll") for (int k = 0; k < 2; ++k) dst[n][k] = *(const LAS bf16x8*)(lds + FG_SB(b, h) + boff + n * 2048 + k * 1024); } } while (0)
#define FG_MMA(ai, bj, At, Bt) do { __builtin_amdgcn_s_setprio(1); _Pragma("unroll") for (int m = 0; m < 4; ++m) _Pragma("unroll") for (int n = 0; n < 2; ++n) { \
        if constexpr (F8) asm volatile("v_mfma_scale_f32_16x16x128_f8f6f4 %0, %1, %2, %0, %3, %4 op_sel_hi:[0,0,0]" : "+v"(acc[ai][bj][m][n]) : "v"(Bt##8[n]), "v"(At##8[m]), "v"(scw), "v"(sca)); \
        else { _Pragma("unroll") for (int k = 0; k < 2; ++k) acc[ai][bj][m][n] = __builtin_amdgcn_mfma_f32_16x16x32_bf16(Bt[n][k], At[m][k], acc[ai][bj][m][n], 0, 0, 0); } } \
        __builtin_amdgcn_s_setprio(0); } while (0)
#define FG_WAIT_V(n) asm volatile("s_waitcnt vmcnt(" #n ")" ::: "memory")
#define FG_WAIT_L(n) asm volatile("s_waitcnt lgkmcnt(" #n ")" ::: "memory")
#define FG_BAR __builtin_amdgcn_s_barrier()
#define FG_SCHED __builtin_amdgcn_sched_barrier(0)
    Unit cur, nxt; int ui = 0;
    if (!S.next(0, cur)) return;
    Acc acc;
#pragma unroll
    for (int a = 0; a < 2; ++a)
#pragma unroll
        for (int b = 0; b < 2; ++b)
#pragma unroll
            for (int m = 0; m < 4; ++m)
#pragma unroll
                for (int n = 0; n < 2; ++n) acc[a][b][m][n] = (f32x4){0.f, 0.f, 0.f, 0.f};
    bf16x8 At[4][2], B0[2][2], B1[2][2]; i32x8 At8[4], B08[2], B18[2];
    const int scw = 0x7a7a7a7a, sca = 0x7f7f7f7f;
    const char* cA = cur.A; const char* cB = cur.B;
    FG_STAGE(FG_SB(0, 0), cB, voffB); FG_STAGE(FG_SB(0, 1), cB + hstepB, voffB); FG_STAGE(FG_SA(0, 0), cA, voffA); FG_STAGE(FG_SA(0, 1), cA + hstepA, voffA);
    if (wr == 1) FG_BAR;
    FG_WAIT_V(2); FG_BAR;
    FG_STAGE(FG_SB(1, 0), cB + kstep, voffB); FG_STAGE(FG_SA(1, 0), cA + kstep, voffA); FG_STAGE(FG_SB(1, 1), cB + hstepB + kstep, voffB);
    FG_WAIT_V(6); FG_BAR;
    for (;;) {
        const bool has_next = S.next(ui + 1, nxt);
        const char* nA = has_next ? nxt.A : cA; const char* nB = has_next ? nxt.B : cB;
        const int nt = cur.nt;
#pragma unroll 1
        for (int t = 0; t < nt; t += 2) {
            const bool last = (t == nt - 2);
            const char* a1 = cA + (size_t)(t + 1) * kstep;
            const char* a2 = last ? nA : cA + (size_t)(t + 2) * kstep; const char* b2 = last ? nB : cB + (size_t)(t + 2) * kstep;
            const char* a3 = a2 + kstep; const char* b3 = b2 + kstep;
            FG_LDB(B0, 0, 0); FG_LDB(B1, 0, 1); FG_SCHED; FG_LDA(At, 0, 0); FG_STAGE(FG_SA(1, 1), a1 + hstepA, voffA);
            FG_WAIT_V(8); FG_WAIT_L(0); FG_BAR; FG_MMA(0, 0, At, B0); FG_MMA(0, 1, At, B1); FG_BAR; FG_SCHED;
            FG_LDA(At, 0, 1); FG_STAGE(FG_SB(0, 0), b2, voffB); FG_STAGE(FG_SB(0, 1), b2 + hstepB, voffB); FG_STAGE(FG_SA(0, 0), a2, voffA);
            FG_WAIT_V(8); FG_WAIT_L(0); FG_BAR; FG_MMA(1, 0, At, B0); FG_MMA(1, 1, At, B1); FG_BAR; FG_SCHED;
            FG_LDB(B0, 1, 0); FG_LDB(B1, 1, 1); FG_SCHED; FG_LDA(At, 1, 0); FG_STAGE(FG_SA(0, 1), a2 + hstepA, voffA);
            FG_WAIT_V(8); FG_WAIT_L(0); FG_BAR; FG_MMA(0, 0, At, B0); FG_MMA(0, 1, At, B1); FG_BAR; FG_SCHED;
            FG_LDA(At, 1, 1); FG_STAGE(FG_SB(1, 0), b3, voffB); FG_STAGE(FG_SB(1, 1), b3 + hstepB, voffB); FG_STAGE(FG_SA(1, 0), a3, voffA);
            FG_WAIT_V(8); FG_WAIT_L(0); FG_BAR; FG_MMA(1, 0, At, B0); FG_MMA(1, 1, At, B1); FG_BAR; FG_SCHED;
        }
        if (wr == 0) FG_BAR;
        E(acc, cur, wr, wc, fr, fq);
        if (!has_next) break;
        if (!(is_chain<Epi>::v && cur.aux != 3)) {
#pragma unroll
        for (int a = 0; a < 2; ++a)
#pragma unroll
            for (int b = 0; b < 2; ++b)
#pragma unroll
                for (int m = 0; m < 4; ++m)
#pragma unroll
                    for (int n = 0; n < 2; ++n) acc[a][b][m][n] = (f32x4){0.f, 0.f, 0.f, 0.f};
        }
        cur = nxt; cA = nA; cB = nB; ++ui;
        if (wr == 1) FG_BAR;
    }
    FG_WAIT_V(0);
    FG_BAR;
#undef FG_SA
#undef FG_SB
#undef FG_STAGE
#undef FG_LDA
#undef FG_LDB
#undef FG_MMA
#undef FG_WAIT_V
#undef FG_WAIT_L
#undef FG_BAR
#undef FG_SCHED
}
__device__ __forceinline__ unsigned cvt_pk(float lo, float hi) { unsigned r; asm volatile("v_cvt_pk_bf16_f32 %0, %1, %2" : "=v"(r) : "v"(lo), "v"(hi)); return r; }
__device__ __forceinline__ u32x4 pack8(const f32x4 a, const f32x4 b) { u32x4 w; w.x = cvt_pk(a[0], a[1]); w.y = cvt_pk(a[2], a[3]); w.z = cvt_pk(b[0], b[1]); w.w = cvt_pk(b[2], b[3]); return w; }
__device__ __forceinline__ f32x4 unpk_u8(unsigned x) { const float k = 1.f / 255.f; return (f32x4){(float)(x & 0xffu) * k, (float)((x >> 8) & 0xffu) * k, (float)((x >> 16) & 0xffu) * k, (float)(x >> 24) * k}; }
__device__ __forceinline__ f32x4 unpk_u8r(unsigned x) { return (f32x4){(float)(x & 0xffu), (float)((x >> 8) & 0xffu), (float)((x >> 16) & 0xffu), (float)(x >> 24)}; }
__device__ __forceinline__ f32x4 unpk_lo(unsigned x, unsigned y) { return (f32x4){__uint_as_float(x << 16), __uint_as_float(x & 0xffff0000u), __uint_as_float(y << 16), __uint_as_float(y & 0xffff0000u)}; }

struct EpiWin {
    static constexpr bool PERM = true;
    unsigned char* ws; const float* qg; const float* kg;
    __device__ __forceinline__ void operator()(const Acc& acc, const Unit& u, int wr, int wc, int fr_, int fq_) const {
        int fr = fr_, fq = fq_; asm volatile("" : "+v"(fr), "+v"(fq));
        const int tile = u.pn; const bool LAT = u.aux == 0;
        if (tile == 0) {
            if (LAT) {
                const int b = u.pm >> 5, n2 = 2 * (u.pm & 31) + wr;
#pragma unroll
                for (int ai = 0; ai < 2; ++ai)
#pragma unroll
                    for (int bj = 0; bj < 2; ++bj) {
#pragma unroll
                        for (int n = 0; n < 2; ++n)
#pragma unroll
                            for (int e = 0; e < 4; ++e) { const int ch = bj * HALF + wc * 32 + 8 * fq + 4 * n + e;
                                u32x2 o; o.x = cvt_pk(acc[ai][bj][0][n][e], acc[ai][bj][1][n][e]); o.y = cvt_pk(acc[ai][bj][2][n][e], acc[ai][bj][3][n][e]);
                                *(u32x2*)((bf16*)(ws + WS_UT) + ((size_t)(b * 256 + ch) * 64 + n2) * 256 + 64 * ai + 4 * fr) = o; }
                        asm volatile("" ::: "memory"); }
            } else {
#pragma unroll
                for (int ai = 0; ai < 2; ++ai)
#pragma unroll
                    for (int m = 0; m < 4; ++m) { const int sx = ai * HALF + wr * 64 + m * 16 + fr;
#pragma unroll
                        for (int bj = 0; bj < 2; ++bj)
#pragma unroll
                            for (int n = 0; n < 2; ++n)
#pragma unroll
                                for (int e = 0; e < 4; ++e) { const int ch = bj * HALF + wc * 32 + 8 * fq + 4 * n + e;
                                    ((bf16*)(ws + WS_UTC))[(size_t)(u.pm * 256 + ch) * 256 + sx] = f2bf(acc[ai][bj][m][n][e]); }
                        asm volatile("" ::: "memory"); }
            }
            return;
        }
        const bool ropek = tile == 1 || tile == 2 || tile == 5 || tile == 6 || (tile == 7 && wc < 2);
        const bool keyrow = tile == 7;
        size_t boff; int pitch, col0;
        if (tile <= 4) { boff = WS_RETQ + (size_t)(tile - 1) * MROWS * 256 * 2; pitch = 256; col0 = ropek ? wc * 64 : wc * 32; }
        else if (tile <= 6) { boff = WS_ATTQ; pitch = 512; col0 = (tile - 5) * 256 + wc * 64; }
        else if (tile == 7) { boff = wc < 2 ? WS_ATTK : WS_ATTV; pitch = 128; col0 = (wc & 1) * 64; }
        else if (tile < 10) { boff = WS_CONV; pitch = 512; col0 = (tile - 8) * 256 + wc * 32; }
        else { boff = WS_G; pitch = 4096; col0 = (tile - 10) * 256 + wc * 32; }
        const bool head = ropek || tile == 7;
        bf16* const dbase = (bf16*)(ws + boff);
        const bool norm = tile >= 5 && ropek;
        const float* gp = tile == 7 ? kg : qg;
        const float osc = tile == 2 ? 0.125f : (tile == 5 || tile == 6 ? QSCALE : 1.f);
        const float* rc = (const float*)(ws + WS_ROPE);
#pragma unroll
        for (int ai = 0; ai < 2; ++ai) {
            f32x4 rcs[4][2], rsn[4][2];
            if (ropek && LAT) {
#pragma unroll
                for (int m = 0; m < 4; ++m)
#pragma unroll
                    for (int bj = 0; bj < 2; ++bj) { const int sx = 4096 * ai + 256 * fr + 64 * m + 2 * (u.pm & 31) + wr, i0 = 16 * bj + 4 * fq;
                        rcs[m][bj] = *(const f32x4*)(rc + sx * 32 + i0); rsn[m][bj] = *(const f32x4*)(rc + SEQ * 32 + sx * 32 + i0); } }
#pragma unroll
            for (int m = 0; m < 4; ++m) {
                const int b = LAT ? (u.pm >> 5) : u.pm, s = LAT ? (4096 * ai + 256 * fr + 64 * m + 2 * (u.pm & 31) + wr) : (ai * HALF + wr * 64 + m * 16 + fr);
                const int rr = keyrow ? b * KEYS + (LAT ? CTX + s : s) : (LAT ? b * SEQ + s : NLAT + b * CTX + s);
                bf16* const drow = dbase + ((size_t)rr * pitch + col0 + 8 * fq);
                if (ropek) {
                    float rstd = 1.f;
                    if (norm) { float ss = 0.f;
#pragma unroll
                        for (int bj = 0; bj < 2; ++bj)
#pragma unroll
                            for (int n = 0; n < 2; ++n) { const f32x4 x = acc[ai][bj][m][n]; ss += (x[0] * x[0] + x[1] * x[1]) + (x[2] * x[2] + x[3] * x[3]); }
                        ss += __shfl_xor(ss, 16); ss += __shfl_xor(ss, 32);
                        rstd = rsqrtf(ss * (1.f / 64.f) + EPS); }
#pragma unroll
                    for (int bj = 0; bj < 2; ++bj) {
                        const int i0 = 16 * bj + 4 * fq;
                        f32x4 x1 = acc[ai][bj][m][0], x2 = acc[ai][bj][m][1];
                        if (norm) { const f32x4 g1 = *(const f32x4*)(gp + i0), g2 = *(const f32x4*)(gp + 32 + i0); x1 = x1 * rstd * g1; x2 = x2 * rstd * g2; }
                        f32x4 o1 = x1, o2 = x2;
                        if (LAT) { const f32x4 cs = rcs[m][bj], sn = rsn[m][bj]; o1 = x1 * cs - x2 * sn; o2 = x1 * sn + x2 * cs; }
                        *(u32x4*)(drow + 32 * bj) = pack8(o1 * osc, o2 * osc);
                    }
                } else {
#pragma unroll
                    for (int bj = 0; bj < 2; ++bj) {
                        f32x4 a0 = acc[ai][bj][m][0], a1 = acc[ai][bj][m][1];
                        if (tile >= 10) {
                            u32x2 o; o.x = 0u; o.y = 0u;
#pragma unroll
                            for (int e = 0; e < 4; ++e) { o.x = __builtin_amdgcn_cvt_pk_u8_f32(__builtin_fmaxf(__builtin_floorf(sigmoid_fast(a0[e]) * 255.f + 0.5f), 1.f), e, o.x);
                                o.y = __builtin_amdgcn_cvt_pk_u8_f32(__builtin_fmaxf(__builtin_floorf(sigmoid_fast(a1[e]) * 255.f + 0.5f), 1.f), e, o.y); }
                            *(u32x2*)(ws + WS_G + (size_t)rr * 4096 + (tile - 10) * 256 + wc * 32 + 8 * fq + HALF * bj) = o;
                        } else *(u32x4*)(drow + (head ? 32 : HALF) * bj) = pack8(a0, a1);
                    }
                }
            }
        }
    }
};
struct EpiGate8 {
    static constexpr bool PERM = true;
    unsigned char* G;
    __device__ __forceinline__ void operator()(const Acc& acc, const Unit& u, int wr, int wc, int fr_, int fq_) const {
        int fr = fr_, fq = fq_; asm volatile("" : "+v"(fr), "+v"(fq));
#pragma unroll
        for (int ai = 0; ai < 2; ++ai)
#pragma unroll
            for (int m = 0; m < 4; ++m) { const int r = u.pm * BM + ai * HALF + wr * 64 + m * 16 + fr;
#pragma unroll
                for (int bj = 0; bj < 2; ++bj) { const f32x4 a0 = acc[ai][bj][m][0], a1 = acc[ai][bj][m][1]; u32x2 o; o.x = 0u; o.y = 0u;
#pragma unroll
                    for (int e = 0; e < 4; ++e) { o.x = __builtin_amdgcn_cvt_pk_u8_f32(__builtin_fmaxf(__builtin_floorf(sigmoid_fast(a0[e]) * 255.f + 0.5f), 1.f), e, o.x);
                        o.y = __builtin_amdgcn_cvt_pk_u8_f32(__builtin_fmaxf(__builtin_floorf(sigmoid_fast(a1[e]) * 255.f + 0.5f), 1.f), e, o.y); }
                    *(u32x2*)(G + (size_t)r * 4096 + u.pn * BM + bj * HALF + wc * 32 + 8 * fq) = o; } }
    }
};
struct EpiMerge {
    static constexpr bool PERM = true, CHAIN = true;
    const unsigned char* G; bf16* Mg;
    __device__ __forceinline__ void operator()(Acc& acc, const Unit& u, int wr, int wc, int fr_, int fq_) const {
        int fr = fr_, fq = fq_; asm volatile("" : "+v"(fr), "+v"(fq));
        const int br = u.aux; const bool lastb = br == 3;
#pragma unroll
        for (int ai = 0; ai < 2; ++ai) {
            u32x2 g[4][2], gn[4][2];
#pragma unroll
            for (int m = 0; m < 4; ++m)
#pragma unroll
                for (int bj = 0; bj < 2; ++bj) { const int r = u.pm * BM + ai * HALF + wr * 64 + m * 16 + fr, c = u.pn * BM + bj * HALF + wc * 32 + 8 * fq;
                    g[m][bj] = *(const u32x2*)(G + (size_t)r * 4096 + br * 1024 + c);
                    if (!lastb) gn[m][bj] = *(const u32x2*)(G + (size_t)r * 4096 + (br + 1) * 1024 + c); }
#pragma unroll
            for (int m = 0; m < 4; ++m)
#pragma unroll
                for (int bj = 0; bj < 2; ++bj) {
                    if (!lastb) {
                        const f32x4 n0 = unpk_u8r(g[m][bj].x), n1 = unpk_u8r(g[m][bj].y), d0 = unpk_u8r(gn[m][bj].x), d1 = unpk_u8r(gn[m][bj].y);
#pragma unroll
                        for (int e = 0; e < 4; ++e) { acc[ai][bj][m][0][e] *= n0[e] * __builtin_amdgcn_rcpf(d0[e]); acc[ai][bj][m][1][e] *= n1[e] * __builtin_amdgcn_rcpf(d1[e]); }
                    } else { const int r = u.pm * BM + ai * HALF + wr * 64 + m * 16 + fr, c = u.pn * BM + bj * HALF + wc * 32 + 8 * fq;
                        *(u32x4*)(Mg + (size_t)r * 1024 + c) = pack8(acc[ai][bj][m][0] * unpk_u8(g[m][bj].x), acc[ai][bj][m][1] * unpk_u8(g[m][bj].y)); } }
        }
    }
};
struct EpiResid {
    static constexpr bool PERM = false;
    float* out; float* hctx; const float* modbase; int chunk;
    __device__ __forceinline__ void operator()(const Acc& acc, const Unit& u, int wr, int wc, int fr_, int fq_) const {
        int fr = fr_, fq = fq_; asm volatile("" : "+v"(fr), "+v"(fq));
        const int rt = u.pm * BM;
        const float* g = modbase + ((size_t)row_mi(rt) * 6 + chunk) * D;
        f32x4 gg[2][2];
#pragma unroll
        for (int bj = 0; bj < 2; ++bj)
#pragma unroll
            for (int n = 0; n < 2; ++n) gg[bj][n] = *(const f32x4*)(g + u.pn * BM + bj * HALF + wc * 32 + 16 * n + 4 * fq);
#pragma unroll
        for (int ai = 0; ai < 2; ++ai) {
            f32x4 hv[4][2][2];
#pragma unroll
            for (int m = 0; m < 4; ++m) { const int r = rt + ai * HALF + wr * 64 + m * 16 + fr; const float* h = r < NLAT ? out + (size_t)r * D : hctx + (size_t)(r - NLAT) * D;
#pragma unroll
                for (int bj = 0; bj < 2; ++bj)
#pragma unroll
                    for (int n = 0; n < 2; ++n) hv[m][bj][n] = *(const f32x4*)(h + u.pn * BM + bj * HALF + wc * 32 + 16 * n + 4 * fq); }
#pragma unroll
            for (int m = 0; m < 4; ++m) { const int r = rt + ai * HALF + wr * 64 + m * 16 + fr; float* h = r < NLAT ? out + (size_t)r * D : hctx + (size_t)(r - NLAT) * D;
#pragma unroll
                for (int bj = 0; bj < 2; ++bj)
#pragma unroll
                    for (int n = 0; n < 2; ++n) *(f32x4*)(h + u.pn * BM + bj * HALF + wc * 32 + 16 * n + 4 * fq) = hv[m][bj][n] + gg[bj][n] * acc[ai][bj][m][n]; }
        }
    }
};
struct EpiResidNorm {
    static constexpr bool PERM = false;
    const float* hin; float* out; const float* modbase; int chunk;
    const float* gain; const float* nmods; int csh, csc; bf16* A; unsigned char* A8;
    float* xbuf; unsigned* cnt; unsigned* tmo; LAS unsigned char* lds;
    __device__ __forceinline__ void operator()(Acc& acc, const Unit& u, int wr, int wc, int fr_, int fq_) const {
        int fr = fr_, fq = fq_; asm volatile("" : "+v"(fr), "+v"(fq));
        const int wid = __builtin_amdgcn_readfirstlane((int)threadIdx.x >> 6), lane = threadIdx.x & 63;
        const int rt = u.pm * BM, mi = row_mi(rt);
        LAS float* Pt = (LAS float*)(lds + STAGE_BYTES);
        LAS float* St = (LAS float*)(lds + STAGE_BYTES + 4096);
        LAS unsigned* flag = (LAS unsigned*)(lds + STAGE_BYTES + 5120);
        { const float* g = modbase + ((size_t)mi * 6 + chunk) * D;
          f32x4 gg[2][2];
#pragma unroll
          for (int bj = 0; bj < 2; ++bj)
#pragma unroll
              for (int n = 0; n < 2; ++n) gg[bj][n] = *(const f32x4*)(g + u.pn * BM + bj * HALF + wc * 32 + 16 * n + 4 * fq);
#pragma unroll
          for (int am = 0; am < 4; ++am) { const int ai = am >> 1, m0 = (am & 1) * 2;
              f32x4 hv[2][2][2];
#pragma unroll
              for (int mm = 0; mm < 2; ++mm) { const float* h = hin + (size_t)(rt + ai * HALF + wr * 64 + (m0 + mm) * 16 + fr) * D;
#pragma unroll
                  for (int bj = 0; bj < 2; ++bj)
#pragma unroll
                      for (int n = 0; n < 2; ++n) hv[mm][bj][n] = *(const f32x4*)(h + u.pn * BM + bj * HALF + wc * 32 + 16 * n + 4 * fq); }
#pragma unroll
              for (int mm = 0; mm < 2; ++mm) { const int m = m0 + mm; float* h = out + (size_t)(rt + ai * HALF + wr * 64 + m * 16 + fr) * D; float ss = 0.f;
#pragma unroll
                  for (int bj = 0; bj < 2; ++bj)
#pragma unroll
                      for (int n = 0; n < 2; ++n) { const f32x4 x = hv[mm][bj][n] + gg[bj][n] * acc[ai][bj][m][n]; acc[ai][bj][m][n] = x;
                          *(f32x4*)(h + u.pn * BM + bj * HALF + wc * 32 + 16 * n + 4 * fq) = x; ss += (x[0] * x[0] + x[1] * x[1]) + (x[2] * x[2] + x[3] * x[3]); }
                  ss += __shfl_xor(ss, 16); ss += __shfl_xor(ss, 32);
                  if (fq == 0) Pt[(ai * HALF + wr * 64 + m * 16 + fr) * 4 + wc] = ss; }
              asm volatile("" ::: "memory");
          } }
        asm volatile("s_waitcnt lgkmcnt(0)" ::: "memory"); __builtin_amdgcn_s_barrier(); asm volatile("" ::: "memory");
        const int row = wid * 32 + (lane & 31);
        if (lane < 32) { const f32x4 q = *(const LAS f32x4*)(Pt + row * 4);
            __hip_atomic_store(xbuf + ((size_t)(rt + row) * 4 + u.pn), (q[0] + q[1]) + (q[2] + q[3]), __ATOMIC_RELAXED, __HIP_MEMORY_SCOPE_AGENT); }
        asm volatile("s_waitcnt vmcnt(0)" ::: "memory");
        if (lane == 0) __hip_atomic_fetch_add(cnt + 16 * u.pm, 1u, __ATOMIC_RELAXED, __HIP_MEMORY_SCOPE_AGENT);
        if (wid == 0) { unsigned sp = 0u, dead = 0u;
            while ((unsigned)__builtin_amdgcn_readfirstlane(__hip_atomic_load(cnt + 16 * u.pm, __ATOMIC_RELAXED, __HIP_MEMORY_SCOPE_AGENT)) < 32u) {
                __builtin_amdgcn_s_sleep(1);
                if ((++sp & 255u) == 0u) { if (__hip_atomic_load(tmo, __ATOMIC_RELAXED, __HIP_MEMORY_SCOPE_AGENT)) { dead = 1u; break; } if (sp > (1u << 22)) { if (lane == 0) atomicAdd(tmo, 1u); dead = 1u; break; } } }
            __builtin_amdgcn_fence(__ATOMIC_ACQUIRE, "agent");
            if (lane == 0) flag[0] = dead; }
        asm volatile("s_waitcnt vmcnt(0) lgkmcnt(0)" ::: "memory"); __builtin_amdgcn_s_barrier(); asm volatile("" ::: "memory");
        if (lane < 32) { const float* sl = xbuf + (size_t)(rt + row) * 4; float t = 0.f;
#pragma unroll
            for (int q = 0; q < 4; ++q) t += __hip_atomic_load(sl + q, __ATOMIC_RELAXED, __HIP_MEMORY_SCOPE_AGENT);
            St[row] = rsqrtf(t * (1.f / D) + EPS); }
        asm volatile("s_waitcnt lgkmcnt(0)" ::: "memory"); __builtin_amdgcn_s_barrier(); asm volatile("" ::: "memory");
        const float* shp = nmods + ((size_t)mi * 6 + csh) * D; const float* scp = nmods + ((size_t)mi * 6 + csc) * D;
        float rs[2][4];
#pragma unroll
        for (int ai = 0; ai < 2; ++ai)
#pragma unroll
            for (int m = 0; m < 4; ++m) rs[ai][m] = St[ai * HALF + wr * 64 + m * 16 + fr];
#pragma unroll
        for (int bj = 0; bj < 2; ++bj)
#pragma unroll
            for (int n = 0; n < 2; ++n) { const int c = u.pn * BM + bj * HALF + wc * 32 + 16 * n + 4 * fq;
                const f32x4 g4 = *(const f32x4*)(gain + c), sc4 = *(const f32x4*)(scp + c) + 1.f, sh4 = *(const f32x4*)(shp + c);
#pragma unroll
                for (int ai = 0; ai < 2; ++ai)
#pragma unroll
                    for (int m = 0; m < 4; ++m) { const f32x4 y = acc[ai][bj][m][n] * rs[ai][m] * g4 * sc4 + sh4;
                        u32x2 o; o.x = cvt_pk(y[0], y[1]); o.y = cvt_pk(y[2], y[3]);
                        *(u32x2*)(A + (size_t)(rt + ai * HALF + wr * 64 + m * 16 + fr) * D + c) = o;
                        if (A8) *(unsigned*)(A8 + (size_t)(rt + ai * HALF + wr * 64 + m * 16 + fr) * D + c) = pk4_fp8(y[0], y[1], y[2], y[3]); } }
    }
};
struct EpiSwiglu {
    static constexpr bool PERM = true;
    bf16* Hm;
    __device__ __forceinline__ void operator()(const Acc& acc, const Unit& u, int wr, int wc, int fr, int fq) const {
#pragma unroll
        for (int ai = 0; ai < 2; ++ai)
#pragma unroll
            for (int m = 0; m < 4; ++m) { const int r = u.pm * BM + ai * HALF + wr * 64 + m * 16 + fr;
#pragma unroll
                for (int bj = 0; bj < 2; ++bj) { const int c = u.pn * BM + bj * HALF + wc * 32 + 8 * fq; const f32x4 g = acc[ai][bj][m][0], up = acc[ai][bj][m][1];
                    u32x2 o; o.x = cvt_pk(silu_fast(g[0]) * up[0], silu_fast(g[1]) * up[1]); o.y = cvt_pk(silu_fast(g[2]) * up[2], silu_fast(g[3]) * up[3]);
                    *(u32x2*)(Hm + (size_t)r * FFN + (c >> 1)) = o; } }
    }
};
struct EpiSwiglu8 {
    static constexpr bool PERM = true;
    unsigned char* Hm;
    __device__ __forceinline__ void operator()(const Acc& acc, const Unit& u, int wr, int wc, int fr_, int fq_) const {
        int fr = fr_, fq = fq_; asm volatile("" : "+v"(fr), "+v"(fq));
#pragma unroll
        for (int ai = 0; ai < 2; ++ai)
#pragma unroll
            for (int m = 0; m < 4; ++m) { const int r = u.pm * BM + ai * HALF + wr * 64 + m * 16 + fr;
#pragma unroll
                for (int bj = 0; bj < 2; ++bj) { const int c = u.pn * BM + bj * HALF + wc * 32 + 8 * fq; const f32x4 g = acc[ai][bj][m][0], up = acc[ai][bj][m][1];
                    *(unsigned*)(Hm + (size_t)r * FFN + (c >> 1)) = pk4_fp8(silu_fast(g[0]) * up[0], silu_fast(g[1]) * up[1], silu_fast(g[2]) * up[2], silu_fast(g[3]) * up[3]); } }
    }
};
struct EpiStore {
    static constexpr bool PERM = true;
    bf16* O; int ldc;
    __device__ __forceinline__ void operator()(const Acc& acc, const Unit& u, int wr, int wc, int fr_, int fq_) const {
        int fr = fr_, fq = fq_; asm volatile("" : "+v"(fr), "+v"(fq));
#pragma unroll
        for (int ai = 0; ai < 2; ++ai)
#pragma unroll
            for (int m = 0; m < 4; ++m) { const int r = u.pm * BM + ai * HALF + wr * 64 + m * 16 + fr;
#pragma unroll
                for (int bj = 0; bj < 2; ++bj) { const int c = u.pn * BM + bj * HALF + wc * 32 + 8 * fq; *(u32x4*)(O + (size_t)r * ldc + c) = pack8(acc[ai][bj][m][0], acc[ai][bj][m][1]); } }
    }
};
struct EpiFft1 {
    static constexpr bool PERM = true;
    unsigned char* ws;
    __device__ __forceinline__ void operator()(const Acc& acc, const Unit& u, int wr, int wc, int fr, int fq) const {
        const float* TW = (const float*)(ws + WS_TW); bf16* Z = (bf16*)(ws + WS_Z);
#pragma unroll
        for (int ai = 0; ai < 2; ++ai)
#pragma unroll
            for (int mm = 0; mm < 2; ++mm) { const int k1 = (4 * ai + 2 * wr + mm) * 16 + fr;
#pragma unroll
                for (int bj = 0; bj < 2; ++bj) { const int c = u.pn * BM + bj * HALF + wc * 32 + 8 * fq, n2 = c & 63, ch = (c >> 6) & 255, b = c >> 14;
                    f32x4 zr[2], zi[2];
#pragma unroll
                    for (int n = 0; n < 2; ++n) { const f32x4 yr = acc[ai][bj][2 * mm][n], yi = acc[ai][bj][2 * mm + 1][n];
                        const f32x4 t0 = *(const f32x4*)(TW + (size_t)(k1 * 64 + n2 + 4 * n) * 2), t1 = *(const f32x4*)(TW + (size_t)(k1 * 64 + n2 + 4 * n) * 2 + 4);
                        const f32x4 ct = {t0[0], t0[2], t1[0], t1[2]}, st = {t0[1], t0[3], t1[1], t1[3]};
                        zr[n] = yr * ct + yi * st; zi[n] = yi * ct - yr * st; }
                    bf16* dst = Z + ((size_t)b * 32768 + k1 * 256 + ch) * 256 + n2;
                    *(u32x4*)dst = pack8(zr[0], zr[1]); *(u32x4*)(dst + 64) = pack8(zi[0], zi[1]);
                    asm volatile("" ::: "memory"); } }
    }
};
struct EpiFft3 {
    static constexpr bool PERM = true;
    unsigned char* ws;
    __device__ __forceinline__ void operator()(const Acc& acc, const Unit& u, int wr, int wc, int fr, int fq) const {
        bf16* X = (bf16*)(ws + WS_X);
#pragma unroll
        for (int m = 0; m < 4; ++m) { const int k2 = 16 * m + fr;
#pragma unroll
            for (int bj = 0; bj < 2; ++bj) { const int c = u.pn * BM + bj * HALF + wc * 32 + 8 * fq, ch = c & 255, k1 = (c >> 8) & 127, b = c >> 15;
                *(u32x4*)(X + (size_t)(b * SEQ + k1 + 128 * k2) * 1536 + wr * 256 + ch) = pack8(acc[0][bj][m][0], acc[0][bj][m][1]); } }
    }
};
struct EpiFftC {
    static constexpr bool PERM = true;
    unsigned char* ws;
    __device__ __forceinline__ void operator()(const Acc& acc, const Unit& u, int wr, int wc, int fr, int fq) const {
        bf16* X = (bf16*)(ws + WS_X);
#pragma unroll
        for (int ai = 0; ai < 2; ++ai)
#pragma unroll
            for (int m = 0; m < 4; ++m) { const int k = ai * HALF + wr * 64 + m * 16 + fr;
#pragma unroll
                for (int bj = 0; bj < 2; ++bj) { const int ch = bj * HALF + wc * 32 + 8 * fq;
                    *(u32x4*)(X + (size_t)(NLAT + u.pn * CTX + k) * 1536 + u.pm * 256 + ch) = pack8(acc[ai][bj][m][0], acc[ai][bj][m][1]); } }
    }
};
}

__device__ __forceinline__ void ph_win(const P& p, LAS unsigned char* lds, int layer) {
    const char* W = (const char*)(p.ws + WS_WIN) + (size_t)layer * INC * D * 2;
#pragma unroll 1
    for (int mode = 0; mode < 2; ++mode) {
        fg::WinSched S{(const char*)(p.ws + WS_A), W, (int)gridDim.x, (int)((blockIdx.x + mode * 128) % gridDim.x), mode, mode == 0 ? 10 : (layer == 0 ? 26 : 10)};
        fg::EpiWin E{p.ws, p.in[14] + layer * 64, p.in[15] + layer * 64};
        fg::gemm_phase(lds, D, D, S, E);
    }
    {
        fg::PlainSched S{(const char*)(p.ws + WS_A8), (const char*)(p.ws + WS_WIN8) + (size_t)layer * 4096 * 1024, D / 2, D / 2, NLAT / 256, 16, (int)gridDim.x, (int)blockIdx.x, D / 128};
        fg::EpiGate8 E{p.ws + WS_G};
        fg::gemm_phase<fg::EpiGate8, fg::PlainSched, true>(lds, D / 2, D / 2, S, E);
    }
}

__device__ __forceinline__ void conv_item(const P& p, LAS unsigned char* lds, int layer, int seqid, int t0) {
    const int tid = threadIdx.x; LAS float* y = (LAS float*)lds;
    const int L = seqid < 2 ? SEQ : CTX; const int rbase = seqid < 2 ? seqid * SEQ : NLAT + (seqid - 2) * CTX;
    const bf16* cv = (const bf16*)(p.ws + WS_CONV);
    __syncthreads();
    u32x4 pa[6], pg[6];
#pragma unroll
    for (int i = 0; i < 6; ++i) { const int e = tid + i * NTHREADS, tt = e >> 5, c8 = (e & 31) * 8, t = t0 - 15 + tt;
        if (e < 94 * 32 && t >= 0 && t < L) { const bf16* rowp = cv + (size_t)(rbase + t) * 512 + c8; pa[i] = *(const u32x4*)rowp; pg[i] = *(const u32x4*)(rowp + 256); } }
#pragma unroll
    for (int i = 0; i < 6; ++i) { const int e = tid + i * NTHREADS; if (e >= 94 * 32) break; const int tt = e >> 5, c8 = (e & 31) * 8, t = t0 - 15 + tt;
        f32x4 lo = {0.f, 0.f, 0.f, 0.f}, hi = lo;
        if (t >= 0 && t < L) { const u32x4 a = pa[i], g = pg[i];
            lo = (f32x4){__uint_as_float(a.x << 16) * sigmoidf_(__uint_as_float(g.x << 16)), __uint_as_float(a.x & 0xffff0000u) * sigmoidf_(__uint_as_float(g.x & 0xffff0000u)),
                         __uint_as_float(a.y << 16) * sigmoidf_(__uint_as_float(g.y << 16)), __uint_as_float(a.y & 0xffff0000u) * sigmoidf_(__uint_as_float(g.y & 0xffff0000u))};
            hi = (f32x4){__uint_as_float(a.z << 16) * sigmoidf_(__uint_as_float(g.z << 16)), __uint_as_float(a.z & 0xffff0000u) * sigmoidf_(__uint_as_float(g.z & 0xffff0000u)),
                         __uint_as_float(a.w << 16) * sigmoidf_(__uint_as_float(g.w << 16)), __uint_as_float(a.w & 0xffff0000u) * sigmoidf_(__uint_as_float(g.w & 0xffff0000u))}; }
        *(LAS f32x4*)(y + tt * 256 + c8) = lo; *(LAS f32x4*)(y + tt * 256 + c8 + 4) = hi; }
    __syncthreads();
    {
        const int ch = tid & 255, half = tid >> 8;
        float w[31];
#pragma unroll
        for (int k = 0; k < 31; ++k) w[k] = p.in[17][(size_t)layer * 31 * 256 + k * 256 + ch];
        const float bias = p.in[18][layer * 256 + ch];
        float o[4][8];
#pragma unroll
        for (int u = 0; u < 4; ++u) { const int tb = (half * 4 + u) * 8;
            float in[38];
#pragma unroll
            for (int q = 0; q < 38; ++q) in[q] = y[(tb + q) * 256 + ch];
#pragma unroll
            for (int q = 0; q < 8; ++q) { float a = bias;
#pragma unroll
                for (int k = 0; k < 31; ++k) a += in[q + k] * w[k];
                o[u][q] = a; } }
        __syncthreads();
#pragma unroll
        for (int u = 0; u < 4; ++u)
#pragma unroll
            for (int q = 0; q < 8; ++q) y[((half * 4 + u) * 8 + q) * 256 + ch] = o[u][q];
    }
    __syncthreads();
    const int wv = tid >> 6, lane = tid & 63;
    const f32x4 g = *(const f32x4*)(p.in[19] + layer * 256 + lane * 4), bb = *(const f32x4*)(p.in[20] + layer * 256 + lane * 4);
    for (int q = 0; q < 8; ++q) { const int t = wv * 8 + q;
        const f32x4 v = *(const LAS f32x4*)(y + t * 256 + lane * 4);
        const float mu = wave_sum(v.x + v.y + v.z + v.w) * (1.f / 256.f);
        const f32x4 dv = v - mu; const float var = wave_sum(dv.x * dv.x + dv.y * dv.y + dv.z * dv.z + dv.w * dv.w) * (1.f / 256.f);
        const float rstd = rsqrtf(var + EPS);
        f32x4 z = dv * rstd * g + bb;
        u32x2 ov; ov.x = pk2(siluf_(z.x), siluf_(z.y)); ov.y = pk2(siluf_(z.z), siluf_(z.w));
        *(u32x2*)((bf16*)(p.ws + WS_X) + (size_t)(rbase + t0 + t) * 1536 + 1280 + lane * 4) = ov; }
}

__device__ __forceinline__ int chunk_row0(int b, int n) { return n < 2 ? NLAT + b * CTX + n * 128 : b * SEQ + (n - 2) * 128; }
__device__ __forceinline__ float log_sigmoid(float x) { return x >= 0.f ? -log1pf(expf(-x)) : x - log1pf(expf(x)); }
namespace rt {
typedef short bf16x8 __attribute__((ext_vector_type(8)));
constexpr int PQ = 72, PJ = 136;
__device__ __forceinline__ f32x4 mma(bf16x8 a, bf16x8 b, f32x4 c) { return __builtin_amdgcn_mfma_f32_16x16x32_bf16(a, b, c, 0, 0, 0); }
__device__ __forceinline__ bf16x8 frag(const LAS bf16* base, int row, int pitch, int k0, int lane) { return *(const LAS bf16x8*)(base + (row + (lane & 15)) * pitch + k0 + 8 * (lane >> 4)); }
}
__device__ __forceinline__ void ret_kv_item(const P& p, LAS unsigned char* lds, int layer, int it) {
    using namespace rt;
    const int tid = threadIdx.x, lane = tid & 63, w = tid >> 6; const int h = it & 3, n = (it >> 2) % NCHUNK, b = (it >> 2) / NCHUNK;
    LAS bf16* KTf = (LAS bf16*)lds; LAS bf16* KTb = KTf + 64 * PJ; LAS bf16* VT = KTb + 64 * PJ;
    const int r0 = chunk_row0(b, n);
    const float lgf = log_sigmoid(p.in[10][layer * 4 + h]), lgb = log_sigmoid(p.in[11][layer * 4 + h]);
    __syncthreads();
    { const int j = tid & 127, dq = (tid >> 7) * 16;
      const bf16* K = (const bf16*)(p.ws + WS_RETK) + (size_t)(r0 + j) * 256 + h * 64 + dq; const bf16* V = (const bf16*)(p.ws + WS_RETV) + (size_t)(r0 + j) * 256 + h * 64 + dq;
      const float zf = expf((127.f - j) * lgf), zb = expf((float)j * lgb);
#pragma unroll
      for (int q8 = 0; q8 < 2; ++q8) { const u32x4 kw = *(const u32x4*)(K + q8 * 8), vw = *(const u32x4*)(V + q8 * 8);
          const unsigned kk[4] = {kw.x, kw.y, kw.z, kw.w}, vv[4] = {vw.x, vw.y, vw.z, vw.w};
#pragma unroll
          for (int q = 0; q < 4; ++q) { const int d = dq + q8 * 8 + 2 * q; const float k0 = __uint_as_float(kk[q] << 16), k1 = __uint_as_float(kk[q] & 0xffff0000u);
              KTf[d * PJ + j] = f2bf(k0 * zf); KTf[(d + 1) * PJ + j] = f2bf(k1 * zf); KTb[d * PJ + j] = f2bf(k0 * zb); KTb[(d + 1) * PJ + j] = f2bf(k1 * zb);
              VT[d * PJ + j] = (bf16)(vv[q] & 0xffffu); VT[(d + 1) * PJ + j] = (bf16)(vv[q] >> 16); } } }
    __syncthreads();
    const int fb = w >> 2, dt = w & 3; const LAS bf16* Am = fb == 0 ? KTf : KTb;
    f32x4 acc[4];
#pragma unroll
    for (int et = 0; et < 4; ++et) acc[et] = (f32x4){0.f, 0.f, 0.f, 0.f};
#pragma unroll
    for (int ks = 0; ks < 4; ++ks) { const bf16x8 af = frag(Am, dt * 16, PJ, ks * 32, lane);
#pragma unroll
        for (int et = 0; et < 4; ++et) acc[et] = mma(af, frag(VT, et * 16, PJ, ks * 32, lane), acc[et]); }
    float* S = (float*)(p.ws + WS_RETS) + ((size_t)((fb * 2 + b) * NCHUNK + n) * 4 + h) * 4096;
#pragma unroll
    for (int et = 0; et < 4; ++et)
#pragma unroll
        for (int r = 0; r < 4; ++r) S[(dt * 16 + 4 * (lane >> 4) + r) * 64 + et * 16 + (lane & 15)] = acc[et][r];
}
__device__ __forceinline__ void ret_scan_item(const P& p, int layer, int it) {
    const int e = it * NTHREADS + threadIdx.x;
    const int de = e & 4095, h = (e >> 12) & 3, b = (e >> 14) & 1, dir = e >> 15;
    const float lg = log_sigmoid(p.in[dir == 0 ? 10 : 11][layer * 4 + h]); const float g = expf(128.f * lg);
    float* S = (float*)(p.ws + WS_RETS) + (size_t)((dir * 2 + b) * NCHUNK) * 4 * 4096 + (size_t)h * 4096 + de;
    float kv[NCHUNK];
#pragma unroll
    for (int n = 0; n < NCHUNK; ++n) kv[n] = S[(size_t)n * 4 * 4096];
    float st = 0.f;
    if (dir == 0) {
#pragma unroll
        for (int n = 0; n < NCHUNK; ++n) { const float t = kv[n]; kv[n] = st; st = st * g + t; }
    } else {
#pragma unroll
        for (int i = 0; i < NCHUNK; ++i) { const int n = i < 2 ? 1 - i : NCHUNK + 1 - i; const float t = kv[n]; kv[n] = st; st = st * g + t; }
    }
    float* S2 = (float*)(p.ws + WS_RETS2) + (size_t)((dir * 2 + b) * NCHUNK) * 4 * 4096 + (size_t)h * 4096 + de;
#pragma unroll
    for (int n = 0; n < NCHUNK; ++n) S2[(size_t)n * 4 * 4096] = kv[n];
}
__device__ __forceinline__ void ret_out_item(const P& p, LAS unsigned char* lds, int layer, int it) {
    using namespace rt;
    const int tid = threadIdx.x, lane = tid & 63, w = tid >> 6; const int h = it & 3, n = (it >> 2) % NCHUNK, b = (it >> 2) / NCHUNK;
    LAS bf16* Qs = (LAS bf16*)lds; LAS bf16* Ks = Qs + 128 * PQ; LAS bf16* VT = Ks + 128 * PQ; LAS bf16* Ps = VT + 64 * PJ; LAS bf16* SfT = Ps + 128 * PJ; LAS bf16* SbT = SfT + 64 * PQ;
    LAS float* pf = (LAS float*)(SbT + 64 * PQ); LAS float* pb = pf + 132;
    const int r0 = chunk_row0(b, n);
    const float lgf = log_sigmoid(p.in[10][layer * 4 + h]), lgb = log_sigmoid(p.in[11][layer * 4 + h]);
    const float* S = (const float*)(p.ws + WS_RETS2);
    const float* sfp = S + ((size_t)((0 * 2 + b) * NCHUNK + n) * 4 + h) * 4096; const float* sbp = S + ((size_t)((1 * 2 + b) * NCHUNK + n) * 4 + h) * 4096;
    __syncthreads();
    { const int j = tid >> 2, dq = (tid & 3) * 16;
      const bf16* Q = (const bf16*)(p.ws + WS_RETQ) + (size_t)(r0 + j) * 256 + h * 64 + dq; const bf16* K = (const bf16*)(p.ws + WS_RETK) + (size_t)(r0 + j) * 256 + h * 64 + dq;
      *(LAS u32x4*)(Qs + j * PQ + dq) = *(const u32x4*)Q; *(LAS u32x4*)(Qs + j * PQ + dq + 8) = *(const u32x4*)(Q + 8);
      *(LAS u32x4*)(Ks + j * PQ + dq) = *(const u32x4*)K; *(LAS u32x4*)(Ks + j * PQ + dq + 8) = *(const u32x4*)(K + 8); }
    { const int j = tid & 127, dq = (tid >> 7) * 16;
      const bf16* V = (const bf16*)(p.ws + WS_RETV) + (size_t)(r0 + j) * 256 + h * 64 + dq;
#pragma unroll
      for (int q8 = 0; q8 < 2; ++q8) { const u32x4 vw = *(const u32x4*)(V + q8 * 8); const unsigned vv[4] = {vw.x, vw.y, vw.z, vw.w};
#pragma unroll
          for (int q = 0; q < 4; ++q) { const int d = dq + q8 * 8 + 2 * q; VT[d * PJ + j] = (bf16)(vv[q] & 0xffffu); VT[(d + 1) * PJ + j] = (bf16)(vv[q] >> 16); } } }
    { const int d = tid & 63, e0 = (tid >> 6) * 8;
#pragma unroll
      for (int q4 = 0; q4 < 2; ++q4) { const f32x4 a = *(const f32x4*)(sfp + d * 64 + e0 + q4 * 4), c = *(const f32x4*)(sbp + d * 64 + e0 + q4 * 4);
#pragma unroll
          for (int q = 0; q < 4; ++q) { SfT[(e0 + q4 * 4 + q) * PQ + d] = f2bf(a[q]); SbT[(e0 + q4 * 4 + q) * PQ + d] = f2bf(c[q]); } } }
    if (tid <= 128) { pf[tid] = expf((float)tid * lgf); pb[tid] = expf((float)tid * lgb); }
    __syncthreads();
    { const bf16x8 a0 = frag(Qs, 16 * w, PQ, 0, lane), a1 = frag(Qs, 16 * w, PQ, 32, lane);
#pragma unroll
      for (int jt = 0; jt < 8; ++jt) { f32x4 c = (f32x4){0.f, 0.f, 0.f, 0.f};
          c = mma(a0, frag(Ks, jt * 16, PQ, 0, lane), c); c = mma(a1, frag(Ks, jt * 16, PQ, 32, lane), c);
          const int j = jt * 16 + (lane & 15);
#pragma unroll
          for (int r = 0; r < 4; ++r) { const int i = 16 * w + 4 * (lane >> 4) + r; const float dm = i > j ? pf[i - j] : (i < j ? pb[j - i] : 2.f); Ps[i * PJ + j] = f2bf(c[r] * dm); } } }
    __syncthreads();
    f32x4 aP[4], aF[4], aB[4];
#pragma unroll
    for (int et = 0; et < 4; ++et) { aP[et] = (f32x4){0.f, 0.f, 0.f, 0.f}; aF[et] = aP[et]; aB[et] = aP[et]; }
#pragma unroll
    for (int ks = 0; ks < 4; ++ks) { const bf16x8 af = frag(Ps, 16 * w, PJ, ks * 32, lane);
#pragma unroll
        for (int et = 0; et < 4; ++et) aP[et] = mma(af, frag(VT, et * 16, PJ, ks * 32, lane), aP[et]); }
#pragma unroll
    for (int ks = 0; ks < 2; ++ks) { const bf16x8 af = frag(Qs, 16 * w, PQ, ks * 32, lane);
#pragma unroll
        for (int et = 0; et < 4; ++et) { aF[et] = mma(af, frag(SfT, et * 16, PQ, ks * 32, lane), aF[et]); aB[et] = mma(af, frag(SbT, et * 16, PQ, ks * 32, lane), aB[et]); } }
    const float* rg = p.in[12] + layer * 256 + h * 64;
    const bf16* G = (const bf16*)(p.ws + WS_RETG) + (size_t)r0 * 256 + h * 64; bf16* X = (bf16*)(p.ws + WS_X) + (size_t)r0 * 1536 + 512 + h * 64;
    float gt[4][4];
#pragma unroll
    for (int r = 0; r < 4; ++r)
#pragma unroll
        for (int et = 0; et < 4; ++et) gt[r][et] = bf2f(G[(size_t)(16 * w + 4 * (lane >> 4) + r) * 256 + et * 16 + (lane & 15)]);
#pragma unroll
    for (int r = 0; r < 4; ++r) { const int i = 16 * w + 4 * (lane >> 4) + r; const float xf = pf[i + 1], xb = pb[128 - i];
        float o[4]; float ss = 0.f;
#pragma unroll
        for (int et = 0; et < 4; ++et) { o[et] = aP[et][r] + xf * aF[et][r] + xb * aB[et][r]; ss += o[et] * o[et]; }
        ss += __shfl_xor(ss, 1); ss += __shfl_xor(ss, 2); ss += __shfl_xor(ss, 4); ss += __shfl_xor(ss, 8);
        const float rstd = rsqrtf(ss * (1.f / 64.f) + EPS);
#pragma unroll
        for (int et = 0; et < 4; ++et) { const int e = et * 16 + (lane & 15); Ps[i * PJ + e] = f2bf(o[et] * rstd * rg[e] * siluf_(gt[r][et])); } }
    asm volatile("s_waitcnt lgkmcnt(0)" ::: "memory");
#pragma unroll
    for (int q = 0; q < 2; ++q) { const int c = lane + 64 * q, i = 16 * w + (c >> 3), e8 = (c & 7) * 8;
        *(u32x4*)(X + (size_t)i * 1536 + e8) = *(const LAS u32x4*)(Ps + i * PJ + e8); }
    __syncthreads();
}

#include <hip/hip_bf16.h>
#include <cmath>
namespace attn_body {
using bf16=__hip_bfloat16;
using bf16x8=__attribute__((ext_vector_type(8)))short;
using s16x4=__attribute__((ext_vector_type(4)))short;
using f32x16=__attribute__((ext_vector_type(16)))float;
using u32x4=__attribute__((ext_vector_type(4)))unsigned;
constexpr int D=64, QP=512, KP=128, OP=1536;
constexpr int NW=8,QBLK=32,QB=QBLK*NW,KVBLK=64;
__device__ __forceinline__ int crow(int r,int hi){return (r&3)+8*(r>>2)+4*hi;}
#define SBAR() __builtin_amdgcn_sched_barrier(0)
__device__ __forceinline__ void cmask(f32x16&p0,f32x16&p1,int jb,int qrel,int hi){
  const float NEG=-INFINITY; int kb=64*jb+4*hi;
  #pragma unroll
  for(int r=0;r<16;++r){int kv=kb+(r&3)+8*(r>>2); if(kv>qrel)p0[r]=NEG; if(kv+32>qrel)p1[r]=NEG;}
}

constexpr int NSLOT=3, SLOTB=8192;
constexpr int LDS_K=0, LDS_V=NSLOT*SLOTB, LDS_WS=2*NSLOT*SLOTB, LDS_OST=LDS_WS+NW*64*4, LDS_BYTES=LDS_OST+NW*4096;
constexpr float C2=0.125f*1.4426950408889634f;
__device__ __forceinline__ void glds16(const void*gsrc,unsigned lds_dst){unsigned keep;
  asm volatile("s_mov_b32 %0, m0\n\ts_mov_b32 m0, %2\n\ts_nop 0\n\tglobal_load_lds_dwordx4 %1, off\n\ts_mov_b32 m0, %0":"=&s"(keep):"v"(gsrc),"s"(lds_dst):"memory");}
__device__ __forceinline__ float max3f(float a,float b,float c){float r;asm("v_max3_f32 %0, %1, %2, %3":"=v"(r):"v"(a),"v"(b),"v"(c));return r;}
__device__ __forceinline__ float max2f(float a,float b){float r;asm("v_max_f32_e32 %0, %1, %2":"=v"(r):"v"(a),"v"(b));return r;}
__device__ __forceinline__ float fadd_s(float a,float b){float r;asm("v_add_f32_e32 %0, %1, %2":"=v"(r):"v"(a),"v"(b));return r;}
__device__ __forceinline__ float fsub_s(float a,float b){float r;asm("v_sub_f32_e32 %0, %1, %2":"=v"(r):"v"(a),"v"(b));return r;}
typedef float f32x2_t __attribute__((ext_vector_type(2))); typedef __bf16 bf16x2_t __attribute__((ext_vector_type(2)));
__device__ __forceinline__ unsigned cvtpk_s(float lo,float hi){f32x2_t v={lo,hi};bf16x2_t b=__builtin_convertvector(v,bf16x2_t);return __builtin_bit_cast(unsigned,b);}
#define WAIT_BAR(N) asm volatile("s_waitcnt vmcnt(" #N ") lgkmcnt(0)\n\ts_barrier":::"memory")

__device__ __forceinline__ void qkt(f32x16&p0,f32x16&p1,const char*Kslot,const bf16x8*qr,const f32x16&negm,int r32,int hi){
  const char*kb=Kslot+hi*1024+r32*16;
  #pragma unroll
  for(int d0=0;d0<4;++d0){
    const bf16x8 b0=*reinterpret_cast<const bf16x8*>(kb+d0*2048);
    const bf16x8 b1=*reinterpret_cast<const bf16x8*>(kb+d0*2048+512);
    if(d0==0){p0=__builtin_amdgcn_mfma_f32_32x32x16_bf16(b0,qr[0],negm,0,0,0);p1=__builtin_amdgcn_mfma_f32_32x32x16_bf16(b1,qr[0],negm,0,0,0);}
    else{p0=__builtin_amdgcn_mfma_f32_32x32x16_bf16(b0,qr[d0],p0,0,0,0);p1=__builtin_amdgcn_mfma_f32_32x32x16_bf16(b1,qr[d0],p1,0,0,0);}}
}
typedef __attribute__((address_space(3))) const char* lds_cptr;
typedef short v4i16_t __attribute__((ext_vector_type(4)));
__device__ __forceinline__ void kload8(bf16x8*kf,lds_cptr kp){
  kf[0]=*(const __attribute__((address_space(3))) bf16x8*)(kp);      kf[1]=*(const __attribute__((address_space(3))) bf16x8*)(kp+512);
  kf[2]=*(const __attribute__((address_space(3))) bf16x8*)(kp+2048); kf[3]=*(const __attribute__((address_space(3))) bf16x8*)(kp+2560);
  kf[4]=*(const __attribute__((address_space(3))) bf16x8*)(kp+4096); kf[5]=*(const __attribute__((address_space(3))) bf16x8*)(kp+4608);
  kf[6]=*(const __attribute__((address_space(3))) bf16x8*)(kp+6144); kf[7]=*(const __attribute__((address_space(3))) bf16x8*)(kp+6656);
}
__device__ __forceinline__ void kload2(bf16x8*kf,lds_cptr kp,int j){ kf[2*j]=*(const __attribute__((address_space(3))) bf16x8*)(kp+j*2048); kf[2*j+1]=*(const __attribute__((address_space(3))) bf16x8*)(kp+j*2048+512); }
__device__ __forceinline__ s16x4 vtr(lds_cptr p){ return __builtin_bit_cast(s16x4,__builtin_amdgcn_ds_read_tr16_b64_v4i16((__attribute__((address_space(3))) v4i16_t*)p)); }
__device__ __forceinline__ float rowmax(const f32x16&p0,const f32x16&p1){
  float a=max3f(p0[0],p0[1],p1[0]),b=max3f(p0[2],p0[3],p1[1]);a=max3f(a,p1[2],p1[3]);
  #pragma unroll
  for(int r=4;r<16;r+=4){a=max3f(a,p0[r],p0[r+1]);b=max3f(b,p0[r+2],p0[r+3]);a=max3f(a,p1[r],p1[r+1]);b=max3f(b,p1[r+2],p1[r+3]);}
  const float m=max2f(a,b);
  auto rr=__builtin_amdgcn_permlane32_swap(__float_as_uint(m),__float_as_uint(m),false,false);
  return max2f(__uint_as_float(rr[0]),__uint_as_float(rr[1]));
}
__device__ __forceinline__ void pv(f32x16*o,int vb,bf16x8 pa0,bf16x8 pa1,bf16x8 pa2,bf16x8 pa3){
  #pragma unroll
  for(int d0=0;d0<2;++d0){s16x4 lo[4],hi[4];
    #pragma unroll
    for(int ks=0;ks<4;++ks){
      asm volatile("ds_read_b64_tr_b16 %0,%1 offset:%c2":"=&v"(lo[ks]):"v"(vb),"i"(d0*4096+ks*1024):"memory");
      asm volatile("ds_read_b64_tr_b16 %0,%1 offset:%c2":"=&v"(hi[ks]):"v"(vb),"i"(d0*4096+ks*1024+512):"memory");}
    asm volatile("s_waitcnt lgkmcnt(0)":::"memory");SBAR();
    #define PK(k) (bf16x8){lo[k][0],lo[k][1],lo[k][2],lo[k][3],hi[k][0],hi[k][1],hi[k][2],hi[k][3]}
    o[d0]=__builtin_amdgcn_mfma_f32_32x32x16_bf16(pa0,PK(0),o[d0],0,0,0);
    o[d0]=__builtin_amdgcn_mfma_f32_32x32x16_bf16(pa1,PK(1),o[d0],0,0,0);
    o[d0]=__builtin_amdgcn_mfma_f32_32x32x16_bf16(pa2,PK(2),o[d0],0,0,0);
    o[d0]=__builtin_amdgcn_mfma_f32_32x32x16_bf16(pa3,PK(3),o[d0],0,0,0);
    #undef PK
  }
}

#ifndef ATTN_STORE16
#define ATTN_STORE16(p,v) (*(u32x4*)(p)=(v))
#endif
template<int THRL> __device__ __forceinline__ void attn_unit(const bf16*Q0,const bf16*__restrict__ Kh,const bf16*__restrict__ Vh,bf16*O0,const int NT,char*shm){
  const int tid=threadIdx.x,lane=tid&63,r32=lane&31,hi=lane>>5; const int wid=__builtin_amdgcn_readfirstlane(tid>>6);
  const bf16*Qw=Q0+(long)(wid*QBLK)*QP;
  const unsigned lds0=(unsigned)(uintptr_t)shm;
  float*wsf=(float*)(shm+LDS_WS)+wid*64;
  const bf16*ksrc=Kh+(long)lane*KP+wid*8;
  const bf16*vsrc=Vh+(long)(16*(wid&3)+(lane>>2))*KP+(wid>>2)*32+(lane&3)*8;
  const unsigned kdst=lds0+LDS_K+wid*1024, vdst=lds0+LDS_V+wid*1024;
  #define DMA_K(t,slot) glds16(ksrc+(long)(t)*KVBLK*KP,(unsigned)__builtin_amdgcn_readfirstlane(kdst+(slot)))
  #define DMA_V(t,slot) glds16(vsrc+(long)(t)*KVBLK*KP,(unsigned)__builtin_amdgcn_readfirstlane(vdst+(slot)))
  const int vb0=(int)(lds0+LDS_V)+((lane>>4)&1)*32+(lane&3)*8+(4*hi+((lane&15)>>2))*64;
  const char*Kbase=shm+LDS_K; bf16x8 kf[8];
  const lds_cptr shm3=(lds_cptr)shm; const lds_cptr kp0=shm3+LDS_K+hi*1024+r32*16; const lds_cptr vp0=shm3+LDS_V+((lane>>4)&1)*32+(lane&3)*8+(4*hi+((lane&15)>>2))*64;
  DMA_K(0,0);DMA_V(0,0);DMA_K(1,SLOTB);
  bf16x8 qr[4];
  #pragma unroll
  for(int d0=0;d0<4;++d0)qr[d0]=*reinterpret_cast<const bf16x8*>(&Qw[(long)r32*QP+d0*16+hi*8]);
  float mhat=0.f,l_reg=0.f;f32x16 o[2];o[0]=f32x16{};o[1]=f32x16{};f32x16 negm=f32x16{};asm volatile("":"+v"(negm));
  #define CMASK(P0,P1,t) do{}while(0)
  bool resc=false;
  #define START(P0,P1) do{ const float rm=rowmax(P0,P1); resc=false; \
    { const float dl=rm; mhat=fadd_s(mhat,dl); \
      _Pragma("unroll") for(int r=0;r<16;++r){P0[r]=fsub_s(P0[r],dl);P1[r]=fsub_s(P1[r],dl);} \
      _Pragma("unroll") for(int r=0;r<16;++r)negm[r]=-mhat; asm volatile("":"+v"(negm)); } \
    _Pragma("unroll") for(int r=0;r<16;++r)P0[r]=__builtin_amdgcn_exp2f(P0[r]); }while(0)
  #define RESC() do{ if(resc){ asm volatile("s_waitcnt lgkmcnt(0)":::"memory"); \
      _Pragma("unroll") for(int d_=0;d_<2;++d_) _Pragma("unroll") for(int r=0;r<16;++r)o[d_][r]*=wsf[crow(r,hi)]; } }while(0)
  f32x16 pA0,pA1,pB0,pB1;
  int sl_prev=0,sl_cur=0,sl_next=SLOTB;
  #define ROT() do{sl_prev=sl_cur;sl_cur=sl_next;sl_next=(sl_next==(NSLOT-1)*SLOTB)?0:sl_next+SLOTB;}while(0)
  DMA_K(2,2*SLOTB);
  WAIT_BAR(3);
  qkt(pA0,pA1,Kbase,qr,negm,r32,hi);asm volatile("s_nop 15\n\ts_nop 7":"+v"(pA0),"+v"(pA1));CMASK(pA0,pA1,0);
  START(pA0,pA1);
  _Pragma("unroll") for(int r=0;r<16;++r)pA1[r]=__builtin_amdgcn_exp2f(pA1[r]);
  WAIT_BAR(0);
  DMA_K(3,0);DMA_V(1,SLOTB);
  ROT();
  kload8(kf,kp0+sl_cur);
  WAIT_BAR(2);
  s16x4 vlo[8],vhi[8]; u32x4 pw0,pw1,pw2,pw3;
  #define PKW(P,B) cvtpk_s(P[B],P[B+1])
  #define PAF(k) __builtin_bit_cast(bf16x8,pw##k)
  #define VFR(i) (bf16x8){vlo[i][0],vlo[i][1],vlo[i][2],vlo[i][3],vhi[i][0],vhi[i][1],vhi[i][2],vhi[i][3]}
  #define PIN(x) asm volatile("":"+v"(x))
  #define MX3(a,b,c) __builtin_fmaxf(__builtin_fmaxf((a),(b)),(c))
  #define GAPA(MF,A0,A1,A2,A3,W0,W1,PW) do{ MF; sacc+=A0; sacc+=A1; sacc+=A2; sacc+=A3; PIN(sacc); W0; W1; PIN(PW); SBAR(); }while(0)
  #define EX(v) __builtin_amdgcn_exp2f(v)
  #define GAPB(MF,X,B) do{ MF; X[B]=EX(X[B]); X[B+1]=EX(X[B+1]); X[B+2]=EX(X[B+2]); X[B+3]=EX(X[B+3]); PIN(X); SBAR(); }while(0)
  #define VRD(i) do{ vlo[i]=vtr(vp_+(((i)>>2)*4096+((i)&3)*1024)); vhi[i]=vtr(vp_+(((i)>>2)*4096+((i)&3)*1024+512)); }while(0)
  #define KRD(G,j) do{ if(G){ kload2(kf,kp0+sl_next,j); SBAR(); } }while(0)
  #define STEP(C0,C1,P0,P1,t,GK,GV,GL) do{ SBAR(); \
    const lds_cptr vp_=vp0+sl_prev; \
    VRD(0); SBAR(); float sacc=(P0[0]+P0[1]); \
    GAPA(C0=__builtin_amdgcn_mfma_f32_32x32x16_bf16(kf[0],qr[0],negm,0,0,0), P0[2],P0[3],P0[4],P0[5],     pw0[0]=PKW(P0,0), pw0[1]=PKW(P0,2), pw0); \
    VRD(4); SBAR(); GAPA(C1=__builtin_amdgcn_mfma_f32_32x32x16_bf16(kf[1],qr[0],negm,0,0,0), P0[6],P0[7],P0[8],P0[9],     pw0[2]=PKW(P0,4), pw0[3]=PKW(P0,6), pw0); \
    VRD(1); SBAR(); GAPA(C0=__builtin_amdgcn_mfma_f32_32x32x16_bf16(kf[2],qr[1],C0,0,0,0),   P0[10],P0[11],P0[12],P0[13], pw1[0]=PKW(P0,8), pw1[1]=PKW(P0,10), pw1); \
    VRD(5); SBAR(); GAPA(C1=__builtin_amdgcn_mfma_f32_32x32x16_bf16(kf[3],qr[1],C1,0,0,0),   P0[14],P0[15],P1[0],P1[1],   pw1[2]=PKW(P0,12),pw1[3]=PKW(P0,14), pw1); \
    VRD(2); SBAR(); GAPA(C0=__builtin_amdgcn_mfma_f32_32x32x16_bf16(kf[4],qr[2],C0,0,0,0),   P1[2],P1[3],P1[4],P1[5],     pw2[0]=PKW(P1,0), pw2[1]=PKW(P1,2), pw2); \
    VRD(6); SBAR(); GAPA(C1=__builtin_amdgcn_mfma_f32_32x32x16_bf16(kf[5],qr[2],C1,0,0,0),   P1[6],P1[7],P1[8],P1[9],     pw2[2]=PKW(P1,4), pw2[3]=PKW(P1,6), pw2); \
    VRD(3); SBAR(); GAPA(C0=__builtin_amdgcn_mfma_f32_32x32x16_bf16(kf[6],qr[3],C0,0,0,0),   P1[10],P1[11],P1[12],P1[13], pw3[0]=PKW(P1,8), pw3[1]=PKW(P1,10), pw3); \
    VRD(7); SBAR(); GAPA(C1=__builtin_amdgcn_mfma_f32_32x32x16_bf16(kf[7],qr[3],C1,0,0,0),   P1[14],P1[15],0.f,0.f,       pw3[2]=PKW(P1,12),pw3[3]=PKW(P1,14), pw3); \
    l_reg+=sacc; \
    if(GK){DMA_K((t)+3,sl_cur);} if(GV){DMA_V((t)+1,sl_next);} \
    CMASK(C0,C1,t); \
    { float a=MX3(C0[0],C0[1],C1[0]),b=MX3(C0[2],C0[3],C1[1]); a=MX3(a,C1[2],C1[3]); \
      _Pragma("unroll") for(int r=4;r<16;r+=4){a=MX3(a,C0[r],C0[r+1]);b=MX3(b,C0[r+2],C0[r+3]);a=MX3(a,C1[r],C1[r+1]);b=MX3(b,C1[r+2],C1[r+3]);} \
      float rm=__builtin_fmaxf(a,b); { auto rr=__builtin_amdgcn_permlane32_swap(__float_as_uint(rm),__float_as_uint(rm),false,false); rm=__builtin_fmaxf(__uint_as_float(rr[0]),__uint_as_float(rr[1])); } \
      resc=false; \
      if(__builtin_expect(__any(rm>(float)THRL),0)){ const float dl=__builtin_fmaxf(rm,0.f); mhat+=dl; \
        _Pragma("unroll") for(int r=0;r<16;++r){C0[r]-=dl;C1[r]-=dl;} \
        _Pragma("unroll") for(int r=0;r<16;++r)negm[r]=-mhat; asm volatile("":"+v"(negm)); \
        const float f=__builtin_amdgcn_exp2f(-dl); l_reg*=f; if(hi==0)wsf[r32]=f; resc=true; } } \
    SBAR(); \
    GAPB(o[0]=__builtin_amdgcn_mfma_f32_32x32x16_bf16(PAF(0),VFR(0),o[0],0,0,0), C0,0); \
    GAPB(o[1]=__builtin_amdgcn_mfma_f32_32x32x16_bf16(PAF(0),VFR(4),o[1],0,0,0), C0,4); \
    KRD(GL,0); GAPB(o[0]=__builtin_amdgcn_mfma_f32_32x32x16_bf16(PAF(1),VFR(1),o[0],0,0,0), C0,8); \
    KRD(GL,1); GAPB(o[1]=__builtin_amdgcn_mfma_f32_32x32x16_bf16(PAF(1),VFR(5),o[1],0,0,0), C0,12); \
    KRD(GL,2); GAPB(o[0]=__builtin_amdgcn_mfma_f32_32x32x16_bf16(PAF(2),VFR(2),o[0],0,0,0), C1,0); \
    KRD(GL,3); GAPB(o[1]=__builtin_amdgcn_mfma_f32_32x32x16_bf16(PAF(2),VFR(6),o[1],0,0,0), C1,4); \
    GAPB(o[0]=__builtin_amdgcn_mfma_f32_32x32x16_bf16(PAF(3),VFR(3),o[0],0,0,0), C1,8); \
    GAPB(o[1]=__builtin_amdgcn_mfma_f32_32x32x16_bf16(PAF(3),VFR(7),o[1],0,0,0), C1,12); \
    }while(0)
  int t=1;
  #undef CMASK
  #define CMASK(P0,P1,t) do{}while(0)
  for(;t+5<NT;t+=2){
    STEP(pB0,pB1,pA0,pA1,t,true,true,true);     WAIT_BAR(2); RESC(); ROT();
    STEP(pA0,pA1,pB0,pB1,t+1,true,true,true);   WAIT_BAR(2); RESC(); ROT();
  }
  #undef CMASK
  #define CMASK(P0,P1,t) do{}while(0)
  #define ENDW(tt) do{ if((tt)+3<NT){WAIT_BAR(2);} else if((tt)+2<NT){WAIT_BAR(1);} else {WAIT_BAR(0);} }while(0)
  for(;t+1<NT;t+=2){
    STEP(pB0,pB1,pA0,pA1,t,(t+3<NT),(t+1<NT),(t+1<NT));       ENDW(t);   RESC(); ROT();
    STEP(pA0,pA1,pB0,pB1,t+1,(t+4<NT),(t+2<NT),(t+2<NT));     ENDW(t+1); RESC(); ROT();
  }
  STEP(pB0,pB1,pA0,pA1,NT-1,false,false,false); RESC();
  { float sacc=pB0[0]+pB0[1]; _Pragma("unroll") for(int r=2;r<16;++r)sacc+=pB0[r]; _Pragma("unroll") for(int r=0;r<16;++r)sacc+=pB1[r]; l_reg+=sacc;
    pw0=(u32x4){PKW(pB0,0),PKW(pB0,2),PKW(pB0,4),PKW(pB0,6)};pw1=(u32x4){PKW(pB0,8),PKW(pB0,10),PKW(pB0,12),PKW(pB0,14)};pw2=(u32x4){PKW(pB1,0),PKW(pB1,2),PKW(pB1,4),PKW(pB1,6)};pw3=(u32x4){PKW(pB1,8),PKW(pB1,10),PKW(pB1,12),PKW(pB1,14)};
    SBAR(); pv(o,vb0+sl_cur,PAF(0),PAF(1),PAF(2),PAF(3)); }
  #undef PKW
  #undef PAF
  #undef VFR
  #undef PIN
  #undef MX3
  #undef GAPA
  #undef GAPB
  #undef EX
  #undef VRD
  #undef KRD
  #undef STEP
  #undef ENDW
  {auto rr=__builtin_amdgcn_permlane32_swap(__float_as_uint(l_reg),__float_as_uint(l_reg),false,false);l_reg=__uint_as_float(rr[0])+__uint_as_float(rr[1]);}
  if(hi==0)wsf[32+r32]=l_reg;asm volatile("s_waitcnt lgkmcnt(0)":::"memory");
  float rli[16];
  #pragma unroll
  for(int r=0;r<16;++r)rli[r]=__builtin_amdgcn_rcpf(wsf[32+crow(r,hi)]);
  bf16*Ow=O0+(long)(wid*QBLK)*OP;
  { bf16*stg=(bf16*)(shm+LDS_OST)+wid*2048;
    #pragma unroll
    for(int r=0;r<16;++r){const int orow=crow(r,hi);
      #pragma unroll
      for(int d0=0;d0<2;++d0)stg[orow*64+d0*32+r32]=__float2bfloat16(o[d0][r]*rli[r]);}
    asm volatile("s_waitcnt lgkmcnt(0)":::"memory");
    #pragma unroll
    for(int i=0;i<4;++i){const int row=i*8+(lane>>3),ch=lane&7; const u32x4 v=*(const u32x4*)(stg+row*64+ch*8); ATTN_STORE16(Ow+(long)row*OP+ch*8,v);} }
  asm volatile("s_waitcnt lgkmcnt(0)\n\ts_barrier":::"memory");
  #undef DMA_K
  #undef DMA_V
  #undef CMASK
  #undef START
  #undef RESC
  #undef ROT
}
constexpr int ATTN_LDS_BYTES=LDS_BYTES;
#undef SBAR
#undef WAIT_BAR
}

__device__ __forceinline__ void attn_phase_run(const P& p, unsigned char* lds_generic, int layer) {
    typedef attn_body::bf16 abf;
    const int G = gridDim.x, bx = blockIdx.x, vcu = (G % 8 == 0) ? (bx % 8) * (G / 8) + bx / 8 : bx;
    const abf* Q = (const abf*)(p.ws + WS_ATTQ); const abf* K = (const abf*)(p.ws + WS_ATTK); const abf* V = (const abf*)(p.ws + WS_ATTV); abf* X = (abf*)(p.ws + WS_X);
    if (G == 256) {
        const int x = vcu >> 5, qb = vcu & 31, b = x >> 2, kvh = (x >> 1) & 1;
#pragma unroll 1
        for (int i = 0; i < 2; ++i) { const int h = kvh * 4 + 2 * (x & 1) + i; const long r0 = (long)b * SEQ + qb * 256;
            attn_body::attn_unit<8>(Q + r0 * 512 + h * 64, K + (long)b * KEYS * 128 + kvh * 64, V + (long)b * KEYS * 128 + kvh * 64, X + r0 * 1536 + 768 + h * 64, KEYS / 64, (char*)lds_generic); }
    } else {
#pragma unroll 1
        for (int u = vcu; u < 512; u += G) { const int qb = u & 31, h = (u >> 5) & 7, b = u >> 8, kvh = h >> 2; const long r0 = (long)b * SEQ + qb * 256;
            attn_body::attn_unit<8>(Q + r0 * 512 + h * 64, K + (long)b * KEYS * 128 + kvh * 64, V + (long)b * KEYS * 128 + kvh * 64, X + r0 * 1536 + 768 + h * 64, KEYS / 64, (char*)lds_generic); }
    }
    if (layer == 0) {
#pragma unroll 1
        for (int u = vcu; u < 16; u += G) { const int b = u >> 3, h = u & 7, kvh = h >> 2; const long r0 = NLAT + (long)b * CTX;
            attn_body::attn_unit<8>(Q + r0 * 512 + h * 64, K + (long)b * KEYS * 128 + kvh * 64, V + (long)b * KEYS * 128 + kvh * 64, X + r0 * 1536 + 768 + h * 64, CTX / 64, (char*)lds_generic); }
    }
}

__device__ __forceinline__ void ph_fft1(const P& p, LAS unsigned char* lds, int layer) {
    int nt2 = 2; asm volatile("" : "+s"(nt2));
    { fg::PlainSched S{(const char*)(p.ws + WS_F1), (const char*)(p.ws + WS_UT), 256, 256, 1, 128, (int)gridDim.x, (int)blockIdx.x, nt2};
      fg::EpiFft1 E{p.ws}; fg::gemm_phase(lds, 256, 256, S, E); }
    if (layer == 0) { fg::PlainSched S{(const char*)(p.ws + WS_FC), (const char*)(p.ws + WS_UTC), 256, 256, 2, 2, (int)gridDim.x, (int)((blockIdx.x + 128) % gridDim.x), 4};
      fg::EpiFftC E{p.ws}; fg::gemm_phase(lds, 256, 256, S, E); }
}
__device__ __forceinline__ void ph_fft3(const P& p, LAS unsigned char* lds) {
    int nt2 = 2; asm volatile("" : "+s"(nt2));
    fg::PlainSched S{(const char*)(p.ws + WS_F2), (const char*)(p.ws + WS_Z), 256, 256, 1, 256, (int)gridDim.x, (int)blockIdx.x, nt2};
    fg::EpiFft3 E{p.ws}; fg::gemm_phase(lds, 256, 256, S, E);
}
__device__ __forceinline__ void ph_mix1(const P& p, LAS unsigned char* lds, int layer) {
    ph_fft1(p, lds, layer);
    const int nconv = layer == 0 ? 264 : 256;
    const int n0 = nconv, n1 = n0 + NB * NCHUNK * 4;
    for (int it = gridDim.x - 1 - blockIdx.x; it < n1; it += gridDim.x) {
        if (it < n0) { if (it < 256) conv_item(p, lds, layer, it >> 7, (it & 127) * 64); else conv_item(p, lds, layer, 2 + ((it - 256) >> 2), ((it - 256) & 3) * 64); }
        else ret_kv_item(p, lds, layer, it - n0);
    }
    __syncthreads();
}
__device__ __forceinline__ void ph_mix2(const P& p, LAS unsigned char* lds, unsigned char* lds_generic, int layer) {
    for (int it = blockIdx.x; it < 128; it += gridDim.x) ret_scan_item(p, layer, it);
    __syncthreads();
    ph_fft3(p, lds);
    attn_phase_run(p, lds_generic, layer);
    __syncthreads();
}
__device__ __forceinline__ void ph_mix3(const P& p, LAS unsigned char* lds, int layer, bool ctxlater) {
    for (int it = blockIdx.x; it < NB * NCHUNK * 4; it += gridDim.x) {
        const int n = (it >> 2) % NCHUNK; if ((layer == 1 || ctxlater) && n < 2) continue;
        ret_out_item(p, lds, layer, it);
    }
    __syncthreads();
}
__device__ __forceinline__ void ctx_ret_items(const P& p, LAS unsigned char* lds) {
    const int u = blockIdx.x;
    if (u < 16) { const int b = u >> 3, n = (u >> 2) & 1, h = u & 3;
        ret_out_item(p, lds, 0, (b * NCHUNK + n) * 4 + h);
        asm volatile("s_waitcnt vmcnt(0)" ::: "memory"); __syncthreads();
        if (threadIdx.x == 0) { __builtin_amdgcn_fence(__ATOMIC_RELEASE, "agent");
            __hip_atomic_fetch_add((unsigned*)(p.ws + WS_CTL) + CW_CCNT + (8 * 3) * 16, 1u, __ATOMIC_RELAXED, __HIP_MEMORY_SCOPE_AGENT); }
        __syncthreads(); }
}
__device__ __forceinline__ void ctx_ret_wait(const P& p) {
    if (threadIdx.x == 0) { unsigned* c = (unsigned*)(p.ws + WS_CTL) + CW_CCNT + (8 * 3) * 16; unsigned* tmo = (unsigned*)(p.ws + WS_CTL) + CW_TMO; unsigned sp = 0u;
        while (__hip_atomic_load(c, __ATOMIC_RELAXED, __HIP_MEMORY_SCOPE_AGENT) < 16u) { __builtin_amdgcn_s_sleep(1);
            if ((++sp & 255u) == 0u) { if (__hip_atomic_load(tmo, __ATOMIC_RELAXED, __HIP_MEMORY_SCOPE_AGENT)) break; if (sp > (1u << 22)) { atomicAdd(tmo, 1u); break; } } }
        __builtin_amdgcn_fence(__ATOMIC_ACQUIRE, "agent"); }
    __syncthreads();
}

namespace sk {
typedef short bf16x8 __attribute__((ext_vector_type(8)));
__device__ __forceinline__ void tile64(LAS unsigned char* lds, const bf16* A, int lda, const bf16* Bt, int ldb, int K, float (&out)[8]) {
    const int tid = threadIdx.x, lane = tid & 63, w = tid >> 6, kc = K >> 3;
    const bf16* ap = A + (size_t)(lane & 15) * lda + w * kc + 8 * (lane >> 4); const bf16* bp = Bt + (size_t)(lane & 15) * ldb + w * kc + 8 * (lane >> 4);
    f32x4 acc[4][4];
#pragma unroll
    for (int i = 0; i < 4; ++i)
#pragma unroll
        for (int j = 0; j < 4; ++j) acc[i][j] = (f32x4){0.f, 0.f, 0.f, 0.f};
#pragma unroll 2
    for (int k0 = 0; k0 < kc; k0 += 32) {
        bf16x8 af[4], bfr[4];
#pragma unroll
        for (int i = 0; i < 4; ++i) { af[i] = *(const bf16x8*)(ap + (size_t)(16 * i) * lda + k0); bfr[i] = *(const bf16x8*)(bp + (size_t)(16 * i) * ldb + k0); }
#pragma unroll
        for (int i = 0; i < 4; ++i)
#pragma unroll
            for (int j = 0; j < 4; ++j) acc[i][j] = __builtin_amdgcn_mfma_f32_16x16x32_bf16(af[i], bfr[j], acc[i][j], 0, 0, 0);
    }
    LAS float* part = (LAS float*)lds;
    __syncthreads();
#pragma unroll
    for (int i = 0; i < 4; ++i)
#pragma unroll
        for (int j = 0; j < 4; ++j)
#pragma unroll
            for (int r = 0; r < 4; ++r) part[((w * 16 + i * 4 + j) * 4 + r) * 64 + lane] = acc[i][j][r];
    __syncthreads();
#pragma unroll
    for (int q = 0; q < 8; ++q) { float sacc = 0.f;
#pragma unroll
        for (int ww = 0; ww < 8; ++ww) sacc += part[ww * 4096 + tid + 512 * q];
        out[q] = sacc; }
}
__device__ __forceinline__ void tile64_f8(LAS unsigned char* lds, const unsigned char* A, int lda, const unsigned char* Bt, int ldb, int K, float (&out)[8]) {
    const int tid = threadIdx.x, lane = tid & 63, w = tid >> 6;
    const unsigned char* ap = A + (size_t)(lane & 15) * lda + 32 * (lane >> 4); const unsigned char* bp = Bt + (size_t)(lane & 15) * ldb + 32 * (lane >> 4);
    f32x4 acc[4][4];
#pragma unroll
    for (int i = 0; i < 4; ++i)
#pragma unroll
        for (int j = 0; j < 4; ++j) acc[i][j] = (f32x4){0.f, 0.f, 0.f, 0.f};
    for (int ks = w; ks * 128 < K; ks += 8) {
        fg::i32x8 af[4], bfr[4];
#pragma unroll
        for (int i = 0; i < 4; ++i) { af[i] = *(const fg::i32x8*)(ap + (size_t)(16 * i) * lda + ks * 128); bfr[i] = *(const fg::i32x8*)(bp + (size_t)(16 * i) * ldb + ks * 128); }
#pragma unroll
        for (int i = 0; i < 4; ++i)
#pragma unroll
            for (int j = 0; j < 4; ++j) acc[i][j] = __builtin_amdgcn_mfma_scale_f32_16x16x128_f8f6f4(af[i], bfr[j], acc[i][j], 0, 0, 0, 0x7f7f7f7f, 0, 0x7a7a7a7a);
    }
    LAS float* part = (LAS float*)lds;
    __syncthreads();
#pragma unroll
    for (int i = 0; i < 4; ++i)
#pragma unroll
        for (int j = 0; j < 4; ++j)
#pragma unroll
            for (int r = 0; r < 4; ++r) part[((w * 16 + i * 4 + j) * 4 + r) * 64 + lane] = acc[i][j][r];
    __syncthreads();
#pragma unroll
    for (int q = 0; q < 8; ++q) { float sacc = 0.f;
#pragma unroll
        for (int ww = 0; ww < 8; ++ww) sacc += part[ww * 4096 + tid + 512 * q];
        out[q] = sacc; }
}
__device__ __forceinline__ void elem_rc(int tid, int q, int& row, int& col) { const int e = tid + 512 * q, t16 = e >> 8, reg = (e >> 6) & 3, lane = e & 63; row = 16 * (t16 >> 2) + 4 * (lane >> 4) + reg; col = 16 * (t16 & 3) + (lane & 15); }
}
__device__ __forceinline__ void mini_merge_ctx(const P& p, LAS unsigned char* lds, int layer) {
    const bf16* X = (const bf16*)(p.ws + WS_X); const bf16* WB = (const bf16*)(p.ws + WS_WB) + (size_t)layer * 1024 * 1536; const unsigned char* G = (const unsigned char*)(p.ws + WS_G); bf16* Mg = (bf16*)(p.ws + WS_MERGED);
    for (int it = gridDim.x - 1 - blockIdx.x; it < (NCTX / 64) * 16; it += gridDim.x) { const int r0 = NLAT + (it >> 4) * 64, c0 = (it & 15) * 64;
        float tot[8];
#pragma unroll
        for (int q = 0; q < 8; ++q) tot[q] = 0.f;
#pragma unroll 1
        for (int br = 0; br < 4; ++br) { const int koff = br == 0 ? 0 : (br == 1 ? 512 : (br == 2 ? 768 : 1280)), klen = (br & 1) ? 256 : 512;
            float o[8]; sk::tile64(lds, X + (size_t)r0 * 1536 + koff, 1536, WB + (size_t)c0 * 1536 + koff, 1536, klen, o);
#pragma unroll
            for (int q = 0; q < 8; ++q) { int rr, cc; sk::elem_rc(threadIdx.x, q, rr, cc); tot[q] += o[q] * ((float)G[(size_t)(r0 + rr) * 4096 + br * 1024 + c0 + cc] * (1.f / 255.f)); } }
#pragma unroll
        for (int q = 0; q < 8; ++q) { int rr, cc; sk::elem_rc(threadIdx.x, q, rr, cc); Mg[(size_t)(r0 + rr) * 1024 + c0 + cc] = f2bf(tot[q]); } }
    __syncthreads();
}
__device__ __forceinline__ void mini_resid_ctx(const P& p, LAS unsigned char* lds, int layer, const bf16* A, int lda, const bf16* Bt, int K, int chunk, int xnorm = -1, int nlayer = 0, int nwhich = 0, const float* hsrc = nullptr) {
    const float* g = mods(p, layer, 2, chunk); float* hc = (float*)(p.ws + WS_HCTX); if (hsrc == nullptr) hsrc = hc;
    for (int it = gridDim.x - 1 - blockIdx.x; it < (NCTX / 64) * 16; it += gridDim.x) { const int rl = (it >> 4) * 64, c0 = (it & 15) * 64;
        float o[8]; sk::tile64(lds, A + (size_t)(NLAT + rl) * lda, lda, Bt + (size_t)c0 * K, K, K, o);
        if (xnorm < 0) {
#pragma unroll
            for (int q = 0; q < 8; ++q) { int rr, cc; sk::elem_rc(threadIdx.x, q, rr, cc); float* h = hc + (size_t)(rl + rr) * D + c0 + cc; *h = *h + g[c0 + cc] * o[q]; }
        } else {
#pragma unroll
            for (int q = 0; q < 8; ++q) { int rr, cc; sk::elem_rc(threadIdx.x, q, rr, cc); float* h = hc + (size_t)(rl + rr) * D + c0 + cc;
                __hip_atomic_store(h, hsrc[(size_t)(rl + rr) * D + c0 + cc] + g[c0 + cc] * o[q], __ATOMIC_RELAXED, __HIP_MEMORY_SCOPE_AGENT); }
            asm volatile("s_waitcnt vmcnt(0)" ::: "memory"); __syncthreads();
            if (threadIdx.x == 0) { unsigned* c = (unsigned*)(p.ws + WS_CTL) + CW_CCNT + (8 * xnorm + (it >> 4)) * 16; unsigned* tmo = (unsigned*)(p.ws + WS_CTL) + CW_TMO;
                __hip_atomic_fetch_add(c, 1u, __ATOMIC_RELAXED, __HIP_MEMORY_SCOPE_AGENT);
                unsigned sp = 0u;
                while (__hip_atomic_load(c, __ATOMIC_RELAXED, __HIP_MEMORY_SCOPE_AGENT) < 16u) { __builtin_amdgcn_s_sleep(1);
                    if ((++sp & 255u) == 0u) { if (__hip_atomic_load(tmo, __ATOMIC_RELAXED, __HIP_MEMORY_SCOPE_AGENT)) break; if (sp > (1u << 22)) { atomicAdd(tmo, 1u); break; } } }
                __builtin_amdgcn_fence(__ATOMIC_ACQUIRE, "agent"); }
            __syncthreads();
            { const int w = threadIdx.x >> 6, lane = threadIdx.x & 63;
              if (w < 4) norm_row(p, nlayer, nwhich, NLAT + rl + (it & 15) * 4 + w, lane); }
            __syncthreads();
        } }
    __syncthreads();
}
__device__ __forceinline__ void ph_merge(const P& p, LAS unsigned char* lds, int layer, int nrows) {
    fg::MergeSched S{(const char*)(p.ws + WS_X), (const char*)(p.ws + WS_WB) + (size_t)layer * 1024 * 1536 * 2, nrows / 256, (int)gridDim.x, (int)blockIdx.x};
    fg::EpiMerge E{(const unsigned char*)(p.ws + WS_G), (bf16*)(p.ws + WS_MERGED)};
    fg::gemm_phase(lds, 1536, 1536, S, E);
}
__device__ __forceinline__ void ph_gemm_resid(const P& p, LAS unsigned char* lds, int layer, const bf16* A, int lda, const bf16* Bt, int K, int chunk, int nrows) {
    fg::PlainSched S{(const char*)A, (const char*)Bt, lda, K, nrows / 256, 4, (int)gridDim.x, (int)blockIdx.x, K / 64};
    fg::EpiResid E{p.out, (float*)(p.ws + WS_HCTX), (const float*)(p.ws + WS_MODS) + (size_t)layer * 3 * 6144, chunk};
    fg::gemm_phase(lds, lda, K, S, E);
}
__device__ __forceinline__ void ph_gemm_resid_norm(const P& p, LAS unsigned char* lds, int layer, const bf16* A, int lda, const bf16* Bt, int K, int chunk, int x, int nlayer, int nwhich, const float* hin) {
    fg::PlainSched S{(const char*)A, (const char*)Bt, lda, K, NLAT / 256, 4, (int)gridDim.x, (int)blockIdx.x, K / 64};
    unsigned* ctl = (unsigned*)(p.ws + WS_CTL);
    fg::EpiResidNorm E{hin, p.out, (const float*)(p.ws + WS_MODS) + (size_t)layer * 3 * 6144, chunk,
        p.in[nwhich == 0 ? 6 : 7] + nlayer * D, (const float*)(p.ws + WS_MODS) + (size_t)nlayer * 3 * 6144, nwhich == 0 ? 0 : 3, nwhich == 0 ? 1 : 4, (bf16*)(p.ws + WS_A), nwhich == 0 ? p.ws + WS_A8 : (unsigned char*)nullptr,
        (float*)(p.ws + WS_CTL + CTL_XBUF) + (size_t)x * 65536, ctl + CW_PCNT + 64 * 16 * x, ctl + CW_TMO, lds};
    fg::gemm_phase(lds, lda, K, S, E);
}
__device__ __forceinline__ void ph_ffn1(const P& p, LAS unsigned char* lds) {
    fg::PlainSched S{(const char*)(p.ws + WS_A), (const char*)(p.ws + WS_FFN1), D, D, MROWS / 256, 22, (int)gridDim.x, (int)blockIdx.x, D / 64};
    fg::EpiSwiglu E{(bf16*)(p.ws + WS_HMID)};
    fg::gemm_phase(lds, D, D, S, E);
}
__device__ __forceinline__ int moe_tiles(const P& p, LAS int* tile_e) {
    const unsigned* ctl = (const unsigned*)(p.ws + WS_CTL); int t = 0;
    for (int e = 0; e < NEXP; ++e) { const int c = (int)ctl[CW_CNT + e], nt = (c + 255) >> 8; for (int q = 0; q < nt; ++q) { if (threadIdx.x == 0) tile_e[t + q] = e; } t += nt; }
    __syncthreads();
    return t;
}
__device__ __forceinline__ void ph_assign_gather(const P& p, LAS unsigned char* lds) {
    const int tid = threadIdx.x, bid = blockIdx.x, G = gridDim.x;
    LAS int* sbase = (LAS int*)lds;
    LAS int* stot = sbase + 8;
    LAS int* spst = stot + 8;
    LAS int* sexp = spst + 16;
    LAS int* sslot = sexp + 128;
    const unsigned* cntb = (const unsigned*)(p.ws + WS_ROUTE) + 16384 * 6;
    const int* tok_e = (const int*)(p.ws + WS_ROUTE); int* tok_slot = (int*)(p.ws + WS_ROUTE) + 16384 * 4;
    __syncthreads();
    { const int e = tid >> 6, l = tid & 63; int tot = 0, below = 0;
      for (int b = l; b < G; b += 64) { const int c = (int)cntb[b * NEXP + e]; tot += c; if (b < bid) below += c; }
#pragma unroll
      for (int o = 1; o < 64; o <<= 1) { tot += __shfl_xor(tot, o); below += __shfl_xor(below, o); }
      if (l == 0) { sbase[e] = below; stot[e] = tot; } }
    if (tid < 128) { const int li = tid >> 1, w = li & 7, k = li >> 3, tok = (bid * 8 + w) + k * (G * 8); sexp[tid] = tok < NLAT ? tok_e[tok * 2 + (tid & 1)] : -1; }
    __syncthreads();
    if (tid == 0) { int t = 0; for (int e = 0; e < NEXP; ++e) { spst[e] = t * 256; t += (stot[e] + 255) >> 8; } spst[NEXP] = t * 256;
        if (bid == 0) { unsigned* ctl = (unsigned*)(p.ws + WS_CTL); for (int e = 0; e < NEXP; ++e) ctl[CW_CNT + e] = (unsigned)stot[e]; } }
    __syncthreads();
    if (tid < 128) { const int e = sexp[tid]; int slot = -1;
        if (e >= 0) { int rank = 0; for (int a = 0; a < tid; ++a) rank += (sexp[a] == e) ? 1 : 0; slot = spst[e] + sbase[e] + rank;
            const int li = tid >> 1, w = li & 7, k = li >> 3, tok = (bid * 8 + w) + k * (G * 8); tok_slot[tok * 2 + (tid & 1)] = slot; }
        sslot[tid] = slot; }
    __syncthreads();
    const int lane = tid & 63, wv = tid >> 6; const unsigned char* A8 = p.ws + WS_A8; unsigned char* FS8 = p.ws + WS_FS;
    for (int a = wv; a < 128; a += 8) { const int slot = sslot[a]; if (slot < 0) continue; const int li = a >> 1, w = li & 7, k = li >> 3, tok = (bid * 8 + w) + k * (G * 8);
        *(u32x4*)(FS8 + (size_t)slot * D + lane * 16) = *(const u32x4*)(A8 + (size_t)tok * D + lane * 16); }
    { int idx = 0;
      for (int e = 0; e < NEXP; ++e) { const int lo_ = spst[e] + stot[e], hi_ = spst[e + 1];
          for (int r = lo_ + ((bid * 8 + wv - idx) % (G * 8) + (G * 8)) % (G * 8); r < hi_; r += G * 8) {
              *(u32x4*)(FS8 + (size_t)r * D + lane * 16) = (u32x4){0u, 0u, 0u, 0u}; }
          idx += hi_ - lo_; } }
    __syncthreads();
}
__device__ __forceinline__ void ph_moe1(const P& p, LAS unsigned char* lds) {
    LAS int* tile_e = (LAS int*)(lds + fg::STAGE_BYTES); const int nt = moe_tiles(p, tile_e);
    fg::ExpertSched S{(const char*)(p.ws + WS_FS), (const char*)(p.ws + WS_MOE1), D / 2, D / 2, nt, 22, (int)gridDim.x, (int)blockIdx.x, D / 128, tile_e, (size_t)5632 * D};
    fg::EpiSwiglu8 E{p.ws + WS_HMOE};
    fg::gemm_phase<fg::EpiSwiglu8, fg::ExpertSched, true>(lds, D / 2, D / 2, S, E);
}
__device__ __forceinline__ void ph_moe2(const P& p, LAS unsigned char* lds) {
    LAS int* tile_e = (LAS int*)(lds + fg::STAGE_BYTES); const int nt = moe_tiles(p, tile_e);
    const int nbig = nt < 128 ? nt : 128;
    fg::ExpertSched S{(const char*)(p.ws + WS_HMOE), (const char*)(p.ws + WS_MOE2), FFN / 2, FFN / 2, nbig, 4, (int)gridDim.x, (int)blockIdx.x, FFN / 128, tile_e, (size_t)D * FFN};
    fg::EpiStore E{(bf16*)(p.ws + WS_Y2), D};
    fg::gemm_phase<fg::EpiStore, fg::ExpertSched, true>(lds, FFN / 2, FFN / 2, S, E);
    const unsigned char* A = p.ws + WS_HMOE; bf16* Y = (bf16*)(p.ws + WS_Y2);
    for (int it = blockIdx.x; it < (nt - nbig) * 64; it += gridDim.x) {
        const int rt = nbig + (it >> 6), r0 = rt * 256 + ((it >> 4) & 3) * 64, c0 = (it & 15) * 64;
        const unsigned char* B = p.ws + WS_MOE2 + (size_t)tile_e[rt] * D * FFN;
        float o[8]; sk::tile64_f8(lds, A + (size_t)r0 * FFN, FFN, B + (size_t)c0 * FFN, FFN, FFN, o);
#pragma unroll
        for (int q = 0; q < 8; ++q) { int rr, cc; sk::elem_rc(threadIdx.x, q, rr, cc); Y[(size_t)(r0 + rr) * D + c0 + cc] = f2bf(o[q]); } }
    __syncthreads();
}
__device__ __forceinline__ void ph_combine(const P& p, int layer) {
    const int lane = threadIdx.x & 63, gw = blockIdx.x * 8 + (threadIdx.x >> 6), ngw = gridDim.x * 8;
    const float* tok_w = (const float*)(p.ws + WS_ROUTE) + 16384 * 2; const int* tok_slot = (const int*)(p.ws + WS_ROUTE) + 16384 * 4; const bf16* Y = (const bf16*)(p.ws + WS_Y2);
    for (int r = gw; r < NLAT; r += ngw) {
        const int s0 = tok_slot[r * 2], s1 = tok_slot[r * 2 + 1]; const float w0 = tok_w[r * 2], w1 = tok_w[r * 2 + 1];
        const float* g = mods(p, layer, row_mi(r), 5); float* h = p.out + (size_t)r * D;
#pragma unroll
        for (int j = 0; j < 4; ++j) { const int c = 4 * lane + 256 * j;
            const u32x2 a = *(const u32x2*)(Y + (size_t)s0 * D + c), bq = *(const u32x2*)(Y + (size_t)s1 * D + c); const f32x4 gg = *(const f32x4*)(g + c); f32x4 hv = *(f32x4*)(h + c);
            hv.x += gg.x * (w0 * __uint_as_float(a.x << 16) + w1 * __uint_as_float(bq.x << 16)); hv.y += gg.y * (w0 * __uint_as_float(a.x & 0xffff0000u) + w1 * __uint_as_float(bq.x & 0xffff0000u));
            hv.z += gg.z * (w0 * __uint_as_float(a.y << 16) + w1 * __uint_as_float(bq.y << 16)); hv.w += gg.w * (w0 * __uint_as_float(a.y & 0xffff0000u) + w1 * __uint_as_float(bq.y & 0xffff0000u));
            *(f32x4*)(h + c) = hv; }
    }
}

#define XB_TMO      128
static_assert(CW_TMO == CW_BAR + XB_TMO, "tmo word");
static_assert(CW_CCNT + 4 * 8 * 16 <= 16384, "all zero-initialised control words lie in the first 64 KiB");
#define XB_XCNT(j)  (256  + 64 * (j))
#define XB_XSUB(j)  (1280 + 64 * (j))
#define XB_XGEN(j)  (2304 + 64 * (j))
#define XB_TOP      3328
#define XB_TOPGEN   3392
#define XCD_BAR_WORDS 3456
#define XB_SPIN_CAP (1u << 22)
__device__ __forceinline__ unsigned xb_ld(unsigned* p)              { return __hip_atomic_load(p, __ATOMIC_RELAXED, __HIP_MEMORY_SCOPE_AGENT); }
__device__ __forceinline__ unsigned xb_add(unsigned* p, unsigned v) { return __hip_atomic_fetch_add(p, v, __ATOMIC_RELAXED, __HIP_MEMORY_SCOPE_AGENT); }
__device__ __forceinline__ unsigned xb_xcc_id() { return (unsigned)__builtin_amdgcn_s_getreg((3 << 11) | 20) & 0xFu; }
#define XB_SPIN(cond, bar) do { unsigned _sp = 0; while (cond) { __builtin_amdgcn_s_sleep(1); \
    if ((++_sp & 255u) == 0u) { if (xb_ld(&(bar)[XB_TMO])) break; if (_sp > XB_SPIN_CAP) { atomicAdd(&(bar)[XB_TMO], 1u); break; } } } } while (0)
struct XcdBarrier { unsigned* bar; unsigned x; volatile LAS unsigned* st; };
__device__ __forceinline__ XcdBarrier xcd_barrier_post(unsigned* bar, volatile LAS unsigned* st) {
    XcdBarrier b; b.bar = bar; b.x = xb_xcc_id(); b.st = st;
    if (threadIdx.x == 0) (void)xb_add(&bar[XB_XCNT(b.x)], 1u);
    return b;
}
__device__ __forceinline__ void xcd_barrier_complete(unsigned* bar, unsigned x, unsigned& nloc, unsigned& nx) {
    const unsigned G = gridDim.x * gridDim.y * gridDim.z;
    unsigned sum, cnt, mine, sp = 0u;
    for (;;) {
        sum = 0u; cnt = 0u; mine = 0u;
#pragma unroll
        for (unsigned j = 0; j < 16; ++j) { const unsigned c = xb_ld(&bar[XB_XCNT(j)]); sum += c; cnt += (c > 0u) ? 1u : 0u; mine = (j == x) ? c : mine; }
        if (sum == G) break;
        __builtin_amdgcn_s_sleep(1);
        if ((++sp & 255u) == 0u) { if (xb_ld(&bar[XB_TMO])) break; if (sp > XB_SPIN_CAP) { atomicAdd(&bar[XB_TMO], 1u); break; } }
    }
    nloc = mine > 0u ? mine : 1u; nx = cnt > 0u ? cnt : 1u;
}
__device__ __forceinline__ void xcd_barrier(const XcdBarrier& b) {
    asm volatile("s_waitcnt vmcnt(0)" ::: "memory");
    __syncthreads();
    if (threadIdx.x == 0) {
        unsigned* bar = b.bar;
        __builtin_amdgcn_s_waitcnt(0);
        unsigned nloc = b.st[0], nx = b.st[1];
        if (nloc == 0u) { xcd_barrier_complete(bar, b.x, nloc, nx); b.st[0] = nloc; b.st[1] = nx; }
        const unsigned old = xb_add(&bar[XB_XSUB(b.x)], 1u);
        const unsigned gen = old / nloc;
        if (old + 1u == (gen + 1u) * nloc) {
            __builtin_amdgcn_fence(__ATOMIC_RELEASE, "agent");
            asm volatile("s_waitcnt vmcnt(0)" ::: "memory");
            const unsigned og = xb_add(&bar[XB_TOP], 1u);
            const unsigned tg = og / nx;
            if (og + 1u == (tg + 1u) * nx) xb_add(&bar[XB_TOPGEN], 1u);
            else XB_SPIN(xb_ld(&bar[XB_TOPGEN]) == tg, bar);
            __builtin_amdgcn_fence(__ATOMIC_ACQUIRE, "agent");
            xb_add(&bar[XB_XGEN(b.x)], 1u);
            asm volatile("s_waitcnt vmcnt(0)" ::: "memory");
        } else {
            XB_SPIN(xb_ld(&bar[XB_XGEN(b.x)]) == gen, bar);
            asm volatile("buffer_inv sc0" ::: "memory");
            asm volatile("s_waitcnt vmcnt(0)" ::: "memory");
        }
    }
    __syncthreads();
}

constexpr int NPHASE = 23;
constexpr int LDS_BYTES = 150 * 1024;
__global__ void __launch_bounds__(NTHREADS, 2) mk(P p, int lo, int hi, int fuse) {
    extern __shared__ __attribute__((aligned(16))) unsigned char lds_raw[];
    LAS unsigned char* lds = (LAS unsigned char*)lds_raw;
    volatile LAS unsigned* misc = (volatile LAS unsigned*)(lds + LDS_BYTES - 64);
    if (threadIdx.x < 16) misc[threadIdx.x] = 0u;
    __syncthreads();
    XcdBarrier bar; bar.bar = (unsigned*)(p.ws + WS_CTL) + CW_BAR; bar.x = 0; bar.st = misc;
    if (hi - lo > 1) bar = xcd_barrier_post((unsigned*)(p.ws + WS_CTL) + CW_BAR, misc);
#if MK_SINGLE
    cg::this_grid().sync();
#endif
#ifndef PROBE_MASK
#define PROBE_MASK 0u
#endif
#ifndef AMP_A
#define AMP_A (-1)
#define AMP_B (-1)
#define AMP_MUL 15
#endif
#define AMP(k) do { if ((k) == AMP_A && blockIdx.x == 0 && threadIdx.x == 0) { const unsigned long long t = __builtin_amdgcn_s_memrealtime(); misc[8] = (unsigned)t; } \
    if ((k) == AMP_B && blockIdx.x == 0 && threadIdx.x == 0) { const unsigned t1 = (unsigned)__builtin_amdgcn_s_memrealtime(), dt = (t1 - misc[8]) * AMP_MUL; while ((unsigned)__builtin_amdgcn_s_memrealtime() - t1 < dt) __builtin_amdgcn_s_sleep(8); } } while (0)
#define PH(k, body) do { if (lo <= (k) && (k) < hi) { if ((k) > lo) { xcd_barrier(bar); } AMP(k); body; \
    if ((PROBE_MASK >> (k)) & 1u) { xcd_barrier(bar); body; } } } while (0)
#define LAYER_PHASES(L, base) \
    PH(base + 0, ph_win(p, lds, L)); \
    PH(base + 1, ph_mix1(p, lds, L)); \
    PH(base + 2, ph_mix2(p, lds, lds_raw, L)); \
    PH(base + 3, ph_mix3(p, lds, L, fuse != 0)); \
    PH(base + 4, { if (L == 0 && fuse) ctx_ret_items(p, lds); ph_merge(p, lds, L, NLAT); if (L == 0) { if (fuse && (int)(gridDim.x - 1 - blockIdx.x) < (NCTX / 64) * 16) ctx_ret_wait(p); mini_merge_ctx(p, lds, L); } }); \
    PH(base + 5, { if (L == 0 && fuse) { ph_gemm_resid_norm(p, lds, 0, (const bf16*)(p.ws + WS_MERGED), 1024, (const bf16*)(p.ws + WS_WOUT), D, 2, 0, 0, 1, p.in[0]); mini_resid_ctx(p, lds, 0, (const bf16*)(p.ws + WS_MERGED), 1024, (const bf16*)(p.ws + WS_WOUT), D, 2, 0, 0, 1, p.in[2]); } \
        else { ph_gemm_resid(p, lds, L, (const bf16*)(p.ws + WS_MERGED), 1024, (const bf16*)(p.ws + WS_WOUT) + (size_t)L * D * D, D, 2, NLAT); if (L == 0) mini_resid_ctx(p, lds, L, (const bf16*)(p.ws + WS_MERGED), 1024, (const bf16*)(p.ws + WS_WOUT), D, 2); } });
    PH(0, ph_prologue(p, lds));
    PH(1, ph_norm(p, lds, 0, 0, true, false, MROWS, !fuse));
    LAYER_PHASES(0, 2)
    if (!fuse) PH(8, ph_norm(p, lds, 0, 1, false, false, MROWS));
    PH(9, ph_ffn1(p, lds));
    PH(10, { if (fuse) { ph_gemm_resid_norm(p, lds, 0, (const bf16*)(p.ws + WS_HMID), FFN, (const bf16*)(p.ws + WS_FFN2), FFN, 5, 1, 1, 0, p.out); mini_resid_ctx(p, lds, 0, (const bf16*)(p.ws + WS_HMID), FFN, (const bf16*)(p.ws + WS_FFN2), FFN, 5, 1, 1, 0); }
        else { ph_gemm_resid(p, lds, 0, (const bf16*)(p.ws + WS_HMID), FFN, (const bf16*)(p.ws + WS_FFN2), FFN, 5, NLAT); mini_resid_ctx(p, lds, 0, (const bf16*)(p.ws + WS_HMID), FFN, (const bf16*)(p.ws + WS_FFN2), FFN, 5); } });
    if (!fuse) PH(11, ph_norm(p, lds, 1, 0, false, false, MROWS));
    LAYER_PHASES(1, 12)
    PH(18, ph_norm(p, lds, 1, 1, false, true, NLAT));
    PH(19, { ph_assign_gather(p, lds); ph_moe_convert(p, lds); });
    PH(20, ph_moe1(p, lds));
    PH(21, ph_moe2(p, lds));
    PH(22, ph_combine(p, 1));
#undef PH
#undef LAYER_PHASES
}

extern "C" void kernel_launch(void* const* d_in, const int* in_sizes, int n_in, void* d_out, int out_size, void* d_ws, size_t ws_size, hipStream_t stream) {
    static int grid = 0;
    if (grid == 0) {
        if (n_in != 30 || out_size != NLAT * D || ws_size < WS_END) { fprintf(stderr, "kernel_launch: unexpected shapes (n_in %d out %d ws %zu)\n", n_in, out_size, ws_size); grid = -1; return; }
        int dev = 0, cus = 0, per_cu = 0;
        hipGetDevice(&dev); hipDeviceGetAttribute(&cus, hipDeviceAttributeMultiprocessorCount, dev);
        hipFuncSetAttribute((const void*)mk, hipFuncAttributeMaxDynamicSharedMemorySize, LDS_BYTES);
        hipOccupancyMaxActiveBlocksPerMultiprocessor(&per_cu, (const void*)mk, NTHREADS, LDS_BYTES);
        if (per_cu < 1) { fprintf(stderr, "kernel_launch: occupancy query says %d blocks per CU\n", per_cu); grid = -1; return; }
        grid = cus;
    }
    if (grid < 0) return;
    hipMemsetAsync((char*)d_ws + WS_CTL, 0, 64 * 1024, stream);
    P p{};
    for (int i = 0; i < 30; ++i) p.in[i] = (const float*)d_in[i];
    p.out = (float*)d_out; p.ws = (unsigned char*)d_ws;
#if MK_SINGLE
    int lo = 0, hi = NPHASE, fuse = grid == 256 ? 1 : 0; void* args[] = {&p, &lo, &hi, &fuse};
    hipLaunchCooperativeKernel((const void*)mk, dim3(grid), dim3(NTHREADS), args, LDS_BYTES, stream);
#else
    for (int ph = 0; ph < NPHASE; ++ph) hipLaunchKernelGGL(mk, dim3(grid), dim3(NTHREADS), LDS_BYTES, stream, p, ph, ph + 1, 0);
#endif
}
```

```cpp
#include <hip/hip_runtime.h>
#include <hip/hip_cooperative_groups.h>
#include <cstdio>
#include <cstdint>
namespace cg = cooperative_groups;

#ifndef MK_SINGLE
#define MK_SINGLE 1
#endif

typedef unsigned short bf16;
typedef float f32x4 __attribute__((ext_vector_type(4)));
typedef unsigned u32x4 __attribute__((ext_vector_type(4)));
typedef unsigned u32x2 __attribute__((ext_vector_type(2)));
#define LAS __attribute__((address_space(3)))

constexpr int D = 1024, NB = 2, SEQ = 8192, CTX = 256, NLAT = NB * SEQ, NCTX = NB * CTX, MROWS = NLAT + NCTX;
constexpr int INC = 6656, FFN = 2816, NEXP = 8, KEYS = CTX + SEQ;
constexpr int NCHUNK = 66;
constexpr float EPS = 1e-6f;
constexpr float QSCALE = 0.125f * 1.4426950408889634f;
constexpr int MOE_ROWS = 34816;
constexpr int NTHREADS = 512;

constexpr size_t MiB = 1u << 20;
constexpr size_t WS_CTL = 0, CTL_BYTES = 1 * MiB;
constexpr size_t WS_MODS = 1 * MiB;
constexpr size_t WS_ROPE = 2 * MiB;
constexpr size_t WS_F1 = 4 * MiB;
constexpr size_t WS_F2 = WS_F1 + 131072;
constexpr size_t WS_FC = WS_F2 + 131072;
constexpr size_t WS_TW = WS_FC + 262144;
constexpr size_t WS_ROUTE = 5 * MiB;
constexpr size_t WS_HCTX = 6 * MiB;
constexpr size_t WS_WIN = 8 * MiB;
constexpr size_t WS_WB = 34 * MiB;
constexpr size_t WS_WOUT = 40 * MiB;
constexpr size_t WS_FFN1 = 44 * MiB;
constexpr size_t WS_FFN2 = 55 * MiB;
constexpr size_t WS_A = 61 * MiB;
constexpr size_t WS_X = 94 * MiB;
constexpr size_t WS_Y = 144 * MiB;
constexpr size_t WS_RETQ = WS_Y;
constexpr size_t WS_RETK = WS_RETQ + (size_t)MROWS * 256 * 2;
constexpr size_t WS_RETV = WS_RETK + (size_t)MROWS * 256 * 2;
constexpr size_t WS_RETG = WS_RETV + (size_t)MROWS * 256 * 2;
constexpr size_t WS_ATTQ = WS_Y + 33 * MiB;
constexpr size_t WS_ATTK = WS_Y + 50 * MiB;
constexpr size_t WS_ATTV = WS_Y + 55 * MiB;
constexpr size_t WS_CONV = WS_Y + 60 * MiB;
constexpr size_t WS_UT = WS_Y + 77 * MiB;
constexpr size_t WS_UTC = WS_Y + 93 * MiB;
constexpr size_t WS_Z = WS_Y + 94 * MiB;
constexpr size_t WS_RETS = WS_Y + 126 * MiB;
constexpr size_t WS_MERGED = WS_Y + 143 * MiB;
constexpr size_t WS_G = 320 * MiB;
constexpr size_t WS_MOE1 = WS_G;
constexpr size_t WS_MOE2 = WS_G + (size_t)NEXP * 5632 * 1024 * 2;
constexpr size_t WS_HMID = WS_Y;
constexpr size_t WS_HMOE = 61 * MiB;
constexpr size_t WS_FS = 252 * MiB;
constexpr size_t WS_A8 = 386 * MiB;
constexpr size_t WS_WIN8 = 430 * MiB;
constexpr size_t WS_RETS2 = 452 * MiB;
constexpr size_t WS_Y2 = 160 * MiB;
constexpr size_t WS_END = 469 * MiB;
static_assert(WS_MERGED + (size_t)MROWS * 1024 * 2 <= WS_G, "map");
static_assert(WS_HMOE + (size_t)MOE_ROWS * FFN * 2 <= WS_FS && WS_FS + (size_t)MOE_ROWS * 1024 * 2 <= WS_G, "map moe");
static_assert(WS_MOE2 + (size_t)NEXP * 1024 * FFN * 2 <= WS_END, "map moe w");
static_assert(WS_G + (size_t)MROWS * 4096 <= WS_A8 && WS_A8 + (size_t)NLAT * 1024 <= WS_MOE2 && WS_MOE2 + (size_t)NEXP * 1024 * FFN <= WS_WIN8 && WS_WIN8 + (size_t)2 * 4096 * 1024 <= WS_RETS2, "map fp8 w_in");
constexpr int CW_CNT = 64;
constexpr int CW_CUR = 128;
constexpr int CW_BAR = 4096;
constexpr int CW_TMO = CW_BAR + 128;
constexpr int CW_PCNT = 8192;
constexpr int CW_CCNT = 8192 + 4 * 64 * 16;
constexpr size_t CTL_XBUF = 128 * 1024;

struct P {
    const float* in[30];
    float* out;
    unsigned char* ws;
};

__device__ __forceinline__ float bf2f(bf16 v) { return __uint_as_float((unsigned)v << 16); }
__device__ __forceinline__ bf16 f2bf(float f) { unsigned u = __float_as_uint(f); return (bf16)((u + 0x7fffu + ((u >> 16) & 1u)) >> 16); }
__device__ __forceinline__ unsigned pk2(float lo, float hi) { return (unsigned)f2bf(lo) | ((unsigned)f2bf(hi) << 16); }
__device__ __forceinline__ float sigmoidf_(float x) { return 1.f / (1.f + __expf(-x)); }
__device__ __forceinline__ float siluf_(float x) { return x / (1.f + __expf(-x)); }
__device__ __forceinline__ float sigmoid_fast(float x) { return __builtin_amdgcn_rcpf(1.f + __builtin_amdgcn_exp2f(-1.4426950408889634f * x)); }
__device__ __forceinline__ float silu_fast(float x) { return x * __builtin_amdgcn_rcpf(1.f + __builtin_amdgcn_exp2f(-1.4426950408889634f * x)); }
__device__ __forceinline__ float wave_sum(float v) {
#pragma unroll
    for (int o = 1; o < 64; o <<= 1) v += __shfl_xor(v, o);
    return v;
}
__device__ __forceinline__ int row_mi(int r) { return r < NLAT ? (r >> 13) : 2; }
__device__ __forceinline__ float* hrow(const P& p, int r) { return r < NLAT ? p.out + (size_t)r * D : (float*)(p.ws + WS_HCTX) + (size_t)(r - NLAT) * D; }
__device__ __forceinline__ const float* mods(const P& p, int layer, int mi, int chunk) { return (const float*)(p.ws + WS_MODS) + ((size_t)(layer * 3 + mi) * 6 + chunk) * D; }

__device__ __forceinline__ int rowmap(int mode, int n) {
    if (mode == 0) return n;
    if (mode == 1 || mode == 2) return 8 * (n >> 2) + (n & 3) + (mode == 2 ? 4 : 0);
    const int tile = n >> 8, l = n & 255, head = l >> 6, d = l & 63;
    const bool ropet = tile == 1 || tile == 2 || tile == 5 || tile == 6 || (tile == 7 && head < 2);
    if (ropet) { const int i = d & 31, nn = d >> 5; return tile * 256 + 128 * (i >> 4) + 32 * head + 8 * ((i >> 2) & 3) + 4 * nn + (i & 3); }
    if (tile == 7) return tile * 256 + 128 * (d >> 5) + 32 * head + 8 * ((d >> 3) & 3) + (d & 7);
    return n;
}
__device__ __forceinline__ void conv_tile(LAS float* scr, const float* src, int ldn, int k0, int n0, bf16* dst, int ldd, int koff, int mode) {
    const int tid = threadIdx.x;
    __syncthreads();
#pragma unroll
    for (int i = 0; i < 8; ++i) { const int e = tid + i * NTHREADS, kk = e >> 6, nn = e & 63; scr[kk * 65 + nn] = src[(size_t)(k0 + kk) * ldn + n0 + nn]; }
    __syncthreads();
    const int nn = tid >> 3, kc = (tid & 7) * 8;
    u32x4 o; o.x = pk2(scr[(kc + 0) * 65 + nn], scr[(kc + 1) * 65 + nn]); o.y = pk2(scr[(kc + 2) * 65 + nn], scr[(kc + 3) * 65 + nn]);
    o.z = pk2(scr[(kc + 4) * 65 + nn], scr[(kc + 5) * 65 + nn]); o.w = pk2(scr[(kc + 6) * 65 + nn], scr[(kc + 7) * 65 + nn]);
    *(u32x4*)(dst + (size_t)rowmap(mode, n0 + nn) * ldd + koff + k0 + kc) = o;
}
constexpr float F8_WSCALE = 32.f;
__device__ __forceinline__ unsigned pk4_fp8(float a, float b, float c, float d) { int w = 0; w = __builtin_amdgcn_cvt_pk_fp8_f32(a, b, w, false); w = __builtin_amdgcn_cvt_pk_fp8_f32(c, d, w, true); return (unsigned)w; }
__device__ __forceinline__ void conv_tile2_f8(LAS float* scr, const float* src, int ldn, unsigned char* dst8, int ldd, int mode, int k0a, int n0a, int k0b, int n0b, bool two) {
    const int tid = threadIdx.x;
    f32x4 va[2], vb[2];
#pragma unroll
    for (int i = 0; i < 2; ++i) { const int e = tid + i * NTHREADS, kk = e >> 4, n4 = (e & 15) * 4;
        va[i] = *(const f32x4*)(src + (size_t)(k0a + kk) * ldn + n0a + n4);
        if (two) vb[i] = *(const f32x4*)(src + (size_t)(k0b + kk) * ldn + n0b + n4); }
    __syncthreads();
#pragma unroll
    for (int i = 0; i < 2; ++i) { const int e = tid + i * NTHREADS, kk = e >> 4, n4 = (e & 15) * 4;
#pragma unroll
        for (int q = 0; q < 4; ++q) { scr[kk * 65 + n4 + q] = va[i][q]; if (two) scr[64 * 65 + kk * 65 + n4 + q] = vb[i][q]; } }
    __syncthreads();
    const int nn = tid >> 3, kc = (tid & 7) * 8;
#pragma unroll
    for (int t = 0; t < 2; ++t) { if (t == 1 && !two) break; const LAS float* sp = scr + t * 64 * 65; const int k0 = t ? k0b : k0a, n0 = t ? n0b : n0a;
        u32x2 o; o.x = pk4_fp8(sp[(kc + 0) * 65 + nn] * F8_WSCALE, sp[(kc + 1) * 65 + nn] * F8_WSCALE, sp[(kc + 2) * 65 + nn] * F8_WSCALE, sp[(kc + 3) * 65 + nn] * F8_WSCALE);
        o.y = pk4_fp8(sp[(kc + 4) * 65 + nn] * F8_WSCALE, sp[(kc + 5) * 65 + nn] * F8_WSCALE, sp[(kc + 6) * 65 + nn] * F8_WSCALE, sp[(kc + 7) * 65 + nn] * F8_WSCALE);
        *(u32x2*)(dst8 + (size_t)rowmap(mode, n0 + nn) * ldd + k0 + kc) = o; }
}
__device__ __forceinline__ void conv_tile128_f8(LAS float* scr, const float* src, int ldn, unsigned char* dst8, int ldd, int mode, int k0, int n0) {
    const int tid = threadIdx.x;
    f32x4 v[8];
#pragma unroll
    for (int i = 0; i < 8; ++i) { const int e = tid + i * NTHREADS, kk = e >> 5, n4 = (e & 31) * 4; v[i] = *(const f32x4*)(src + (size_t)(k0 + kk) * ldn + n0 + n4); }
    __syncthreads();
#pragma unroll
    for (int i = 0; i < 8; ++i) { const int e = tid + i * NTHREADS, kk = e >> 5, n4 = (e & 31) * 4;
#pragma unroll
        for (int q = 0; q < 4; ++q) scr[kk * 129 + n4 + q] = v[i][q]; }
    __syncthreads();
    const int nn = tid >> 2, kc = (tid & 3) * 32;
    u32x4 o[2];
#pragma unroll
    for (int h = 0; h < 2; ++h) { const LAS float* sp = scr + (kc + h * 16) * 129 + nn;
        o[h].x = pk4_fp8(sp[0] * F8_WSCALE, sp[129] * F8_WSCALE, sp[2 * 129] * F8_WSCALE, sp[3 * 129] * F8_WSCALE);
        o[h].y = pk4_fp8(sp[4 * 129] * F8_WSCALE, sp[5 * 129] * F8_WSCALE, sp[6 * 129] * F8_WSCALE, sp[7 * 129] * F8_WSCALE);
        o[h].z = pk4_fp8(sp[8 * 129] * F8_WSCALE, sp[9 * 129] * F8_WSCALE, sp[10 * 129] * F8_WSCALE, sp[11 * 129] * F8_WSCALE);
        o[h].w = pk4_fp8(sp[12 * 129] * F8_WSCALE, sp[13 * 129] * F8_WSCALE, sp[14 * 129] * F8_WSCALE, sp[15 * 129] * F8_WSCALE); }
    unsigned char* d = dst8 + (size_t)rowmap(mode, n0 + nn) * ldd + k0 + kc;
    *(u32x4*)d = o[0]; *(u32x4*)(d + 16) = o[1];
}
__device__ __forceinline__ void conv_tile4(LAS float* scr, const float* src, int ldn, int nn, int cnt, int i, int st, bf16* dst, int ldd, int koff, int mode) {
    const int tid = threadIdx.x, kk = tid >> 4, n4 = (tid & 15) * 4;
    f32x4 v[4][2];
#pragma unroll
    for (int t = 0; t < 4; ++t) { const int it = i + t * st; if (it < cnt) { const int k0 = (it / nn) * 64, n0 = (it % nn) * 64;
#pragma unroll
        for (int h = 0; h < 2; ++h) v[t][h] = *(const f32x4*)(src + (size_t)(k0 + kk + 32 * h) * ldn + n0 + n4); } }
    __syncthreads();
#pragma unroll
    for (int t = 0; t < 4; ++t) if (i + t * st < cnt) {
#pragma unroll
        for (int h = 0; h < 2; ++h)
#pragma unroll
            for (int q = 0; q < 4; ++q) scr[t * 64 * 65 + (kk + 32 * h) * 65 + n4 + q] = v[t][h][q]; }
    __syncthreads();
    const int nr = tid >> 3, kc = (tid & 7) * 8;
#pragma unroll
    for (int t = 0; t < 4; ++t) { const int it = i + t * st; if (it < cnt) { const int k0 = (it / nn) * 64, n0 = (it % nn) * 64; const LAS float* sp = scr + t * 64 * 65;
        u32x4 o; o.x = pk2(sp[(kc + 0) * 65 + nr], sp[(kc + 1) * 65 + nr]); o.y = pk2(sp[(kc + 2) * 65 + nr], sp[(kc + 3) * 65 + nr]);
        o.z = pk2(sp[(kc + 4) * 65 + nr], sp[(kc + 5) * 65 + nr]); o.w = pk2(sp[(kc + 6) * 65 + nr], sp[(kc + 7) * 65 + nr]);
        *(u32x4*)(dst + (size_t)rowmap(mode, n0 + nr) * ldd + koff + k0 + kc) = o; } }
}
struct CJob { const float* src; int K, N; bf16* dst; int ldd, koff, mode, ldn; };
__device__ __forceinline__ CJob get_job(const P& p, int j) {
    CJob c;
    if (j < 10) { const int l = j / 5, t = j % 5; bf16* wb = (bf16*)(p.ws + WS_WB) + (size_t)l * 1024 * 1536;
        if (t == 0) c = CJob{p.in[8] + (size_t)l * D * INC, D, l == 0 ? INC : 2560, (bf16*)(p.ws + WS_WIN) + (size_t)l * INC * D, D, 0, 3, INC};
        else if (t == 1) c = CJob{p.in[13] + (size_t)l * 256 * D, 256, D, wb, 1536, 512, 0};
        else if (t == 2) c = CJob{p.in[16] + (size_t)l * 512 * D, 512, D, wb, 1536, 768, 0};
        else if (t == 3) c = CJob{p.in[21] + (size_t)l * 256 * D, 256, D, wb, 1536, 1280, 0};
        else c = CJob{p.in[22] + (size_t)l * D * D, D, D, (bf16*)(p.ws + WS_WOUT) + (size_t)l * D * D, D, 0, 0}; }
    else if (j == 10) c = CJob{p.in[23], D, FFN, (bf16*)(p.ws + WS_FFN1), D, 0, 1};
    else if (j == 11) c = CJob{p.in[24], D, FFN, (bf16*)(p.ws + WS_FFN1), D, 0, 2};
    else c = CJob{p.in[25], FFN, D, (bf16*)(p.ws + WS_FFN2), FFN, 0, 0};
    return c;
}
__device__ __forceinline__ CJob get_moe_job(const P& p, int j) {
    const int e = j / 3, t = j % 3; CJob c;
    const float* sg = p.in[27]; const float* su = p.in[28]; const float* sd = p.in[29];
    asm volatile("" : "+s"(sg), "+s"(su), "+s"(sd));
    if (t == 0) c = CJob{sg + (size_t)e * D * FFN, D, FFN, (bf16*)(p.ws + WS_MOE1 + (size_t)e * 5632 * D), D, 0, 1};
    else if (t == 1) c = CJob{su + (size_t)e * D * FFN, D, FFN, (bf16*)(p.ws + WS_MOE1 + (size_t)e * 5632 * D), D, 0, 2};
    else c = CJob{sd + (size_t)e * FFN * D, FFN, D, (bf16*)(p.ws + WS_MOE2 + (size_t)e * D * FFN), FFN, 0, 0};
    return c;
}
template <bool MOE> __device__ __forceinline__ void run_conv_jobs(const P& p, LAS float* scr, int njobs, int bid, int nb) {
    int base = 0, base2 = 0;
    for (int j = 0; j < njobs; ++j) {
        const CJob jb = MOE ? get_moe_job(p, j) : get_job(p, j); const int nn = jb.N / 64, cnt = (jb.K / 64) * nn, ldn = jb.ldn ? jb.ldn : jb.N;
        const int first = ((bid - base) % nb + nb) % nb;
        if (MOE) { const int nn2 = jb.N / 128, cnt2 = (jb.K / 128) * nn2; const int first2 = ((bid - base2) % nb + nb) % nb;
            for (int i = first2; i < cnt2; i += nb) conv_tile128_f8(scr, jb.src, jb.N, (unsigned char*)jb.dst, jb.ldd, jb.mode, (i / nn2) * 128, (i % nn2) * 128);
            base2 += cnt2; }
        else for (int i = first; i < cnt; i += 4 * nb) conv_tile4(scr, jb.src, ldn, nn, cnt, i, nb, jb.dst, jb.ldd, jb.koff, jb.mode);
        base += cnt;
    }
}
__device__ __forceinline__ void ph_prologue(const P& p, LAS unsigned char* lds) {
    const int tid = threadIdx.x, bid = blockIdx.x, nb = gridDim.x;
    const int gt = bid * NTHREADS + tid, ngt = nb * NTHREADS;
    LAS float* scr = (LAS float*)lds;
    run_conv_jobs<false>(p, scr, 13, bid, nb);
    __syncthreads();
    for (int i = bid; i < 512; i += nb) { const int l = i >> 8, t = i & 255;
        conv_tile128_f8(scr, p.in[8] + (size_t)l * D * INC + 2560, INC, p.ws + WS_WIN8 + (size_t)l * 4096 * 1024, 1024, 0, (t >> 5) * 128, (t & 31) * 128); }
    __syncthreads();
    {
        LAS float* tc = (LAS float*)lds; LAS float* tsn = tc + 64;
        __syncthreads();
        if (tid < 64) { tc[tid] = cospif(tid * (2.f / 64.f)); tsn[tid] = sinpif(tid * (2.f / 64.f)); }
        __syncthreads();
        const float s = 1.0f / sqrtf(64.f * 8192.f);
        for (int e = gt; e < 2 * 4 * 16 * 1024; e += ngt) {
            const int n = e & 1023, cq = (e >> 10) & 15, g = (e >> 14) & 3, l = e >> 16;
            const float* W = p.in[9] + (size_t)l * 256 * D + (size_t)(g * 64) * D + n;
            float w[64];
#pragma unroll
            for (int c2 = 0; c2 < 64; ++c2) w[c2] = W[(size_t)c2 * D];
            bf16* o = (bf16*)(p.ws + WS_WB) + (size_t)l * 1024 * 1536 + (size_t)n * 1536 + g * 64;
#pragma unroll
            for (int ci = 0; ci < 4; ++ci) { const int c = cq * 4 + ci; float re = 0.f, im = 0.f;
#pragma unroll
                for (int c2 = 0; c2 < 64; ++c2) { const int m = (c * c2) & 63; re += tc[m] * w[c2]; im -= tsn[m] * w[c2]; }
                o[c] = f2bf(re * s); o[256 + c] = f2bf(im * s); }
        }
        __syncthreads();
    }
    {
        float* rc = (float*)(p.ws + WS_ROPE); float* rs = rc + SEQ * 32;
        for (int e = gt; e < SEQ * 32; e += ngt) {
            const int s = e >> 5, i = e & 31; const float inv = powf(10000.f, -(float)(i & 15) / 16.f);
            const float pos = (float)(i < 16 ? (s >> 6) : (s & 63)); const float ang = pos * inv;
            rc[e] = cosf(ang); rs[e] = sinf(ang);
        }
    }
    {
        bf16* F1 = (bf16*)(p.ws + WS_F1); bf16* F2 = (bf16*)(p.ws + WS_F2); bf16* FC = (bf16*)(p.ws + WS_FC);
        for (int e = gt; e < 256 * 256; e += ngt) {
            const int rho = e >> 8, n1 = e & 255; float v = 0.f;
            if (n1 < 128) { const int k1 = (rho >> 5) * 16 + (rho & 15), c = (rho >> 4) & 1, m = (k1 * n1) & 127; v = c == 0 ? cospif(m * (2.f / 128.f)) : -sinpif(m * (2.f / 128.f)); }
            F1[e] = f2bf(v);
            float w = 0.f;
            if (rho < 128 && n1 < 128) { const int c2 = rho >> 6, k2 = rho & 63, c = n1 >> 6, n2 = n1 & 63, m = (k2 * n2) & 63; const float cs = cospif(m * (2.f / 64.f)), sn = sinpif(m * (2.f / 64.f));
                w = c2 == 0 ? (c == 0 ? cs : sn) : (c == 0 ? sn : -cs); }
            F2[e] = f2bf(w);
        }
        float* TW = (float*)(p.ws + WS_TW);
        for (int e = gt; e < 128 * 64; e += ngt) { const int k1 = e >> 6, n2 = e & 63; TW[2 * e] = cospif((k1 * n2) * (2.f / 8192.f)); TW[2 * e + 1] = sinpif((k1 * n2) * (2.f / 8192.f)); }
        const float sc = sqrtf(32.f);
        for (int e = gt; e < 512 * 256; e += ngt) { const int rho = e >> 8, n = e & 255, c2 = rho >> 8, k = rho & 255, m = (k * n) & 255; FC[e] = f2bf(sc * (c2 == 0 ? cospif(m * (2.f / 256.f)) : sinpif(m * (2.f / 256.f)))); }
    }
    {
        LAS float* sv = (LAS float*)lds;
        LAS float* red = sv + 3 * 1024;
        __syncthreads();
        for (int e = tid; e < 3 * 1024; e += NTHREADS) { const int j = e >> 10, k = e & 1023; const float v = j < 2 ? p.in[1][j * D + k] : p.in[3][k]; sv[e] = siluf_(v); }
        __syncthreads();
        const int kq = tid >> 6, cl = tid & 63;
        for (int it = bid; it < 2 * 96; it += nb) {
            const int l = it / 96, n = (it % 96) * 64 + cl;
            const float* W = p.in[4] + (size_t)l * D * 6144 + n;
            float a0 = 0.f, a1 = 0.f, a2 = 0.f;
#pragma unroll 32
            for (int k = kq; k < D; k += 8) { const float w = W[(size_t)k * 6144]; a0 += sv[k] * w; a1 += sv[1024 + k] * w; a2 += sv[2048 + k] * w; }
            red[(kq * 3 + 0) * 64 + cl] = a0; red[(kq * 3 + 1) * 64 + cl] = a1; red[(kq * 3 + 2) * 64 + cl] = a2;
            __syncthreads();
            if (tid < 192) { const int j = tid >> 6; float s = 0.f;
#pragma unroll
                for (int q = 0; q < 8; ++q) s += red[(q * 3 + j) * 64 + cl];
                ((float*)(p.ws + WS_MODS))[(size_t)(l * 3 + j) * 6144 + n] = s + p.in[5][l * 6144 + n]; }
            __syncthreads();
        }
    }
}
__device__ __forceinline__ void ph_moe_convert(const P& p, LAS unsigned char* lds) {
    LAS float* scr = (LAS float*)lds;
    const int bid = blockIdx.x, nb = gridDim.x;
    run_conv_jobs<true>(p, scr, 24, bid, nb);
    __syncthreads();
}

__device__ __forceinline__ void ph_norm(const P& p, LAS unsigned char* lds, int layer, int which, bool first, bool route, int nrows, bool copy = true) {
    LAS unsigned* cnt_lds = (LAS unsigned*)lds;
    LAS float* Wl = (LAS float*)(lds + 1024);
    if (route) { __syncthreads(); if (threadIdx.x < NEXP) cnt_lds[threadIdx.x] = 0u;
        for (int i = threadIdx.x; i < D * NEXP; i += NTHREADS) Wl[(i & 7) * D + (i >> 3)] = p.in[26][i];
        __syncthreads(); }
    const int lane = threadIdx.x & 63, gw = blockIdx.x * 8 + (threadIdx.x >> 6), ngw = gridDim.x * 8;
    const float* gain = p.in[which == 0 ? 6 : 7] + layer * D;
    bf16* A = (bf16*)(p.ws + WS_A);
    for (int r = gw; r < nrows; r += ngw) {
        const int mi = row_mi(r);
        const float* src = first ? (r < NLAT ? p.in[0] + (size_t)r * D : p.in[2] + (size_t)(r - NLAT) * D) : hrow(p, r);
        const float* shift = mods(p, layer, mi, which == 0 ? 0 : 3); const float* scale = mods(p, layer, mi, which == 0 ? 1 : 4);
        f32x4 v[4]; float ss = 0.f;
#pragma unroll
        for (int j = 0; j < 4; ++j) { v[j] = *(const f32x4*)(src + 4 * lane + 256 * j); ss += v[j].x * v[j].x + v[j].y * v[j].y + v[j].z * v[j].z + v[j].w * v[j].w; }
        if (first && copy) { float* h = hrow(p, r);
#pragma unroll
            for (int j = 0; j < 4; ++j) *(f32x4*)(h + 4 * lane + 256 * j) = v[j]; }
        const float rstd = rsqrtf(wave_sum(ss) * (1.f / D) + EPS);
        float lg[8];
#pragma unroll
        for (int e = 0; e < 8; ++e) lg[e] = 0.f;
#pragma unroll
        for (int j = 0; j < 4; ++j) {
            const int c = 4 * lane + 256 * j;
            const f32x4 g = *(const f32x4*)(gain + c), sc = *(const f32x4*)(scale + c), sh = *(const f32x4*)(shift + c);
            f32x4 y = v[j] * rstd * g * (sc + 1.f) + sh;
            u32x2 o; o.x = pk2(y.x, y.y); o.y = pk2(y.z, y.w);
            if (!route) *(u32x2*)(A + (size_t)r * D + c) = o;
            if ((which == 0 || route) && r < NLAT) *(unsigned*)(p.ws + WS_A8 + (size_t)r * D + c) = pk4_fp8(y.x, y.y, y.z, y.w);
            if (route) {
#pragma unroll
                for (int e = 0; e < 8; ++e) { const f32x4 w = *(const LAS f32x4*)(Wl + e * D + c); lg[e] += (y[0] * w[0] + y[1] * w[1]) + (y[2] * w[2] + y[3] * w[3]); }
            }
        }
        if (route) {
#pragma unroll
            for (int e = 0; e < 8; ++e) lg[e] = wave_sum(lg[e]);
            if (lane == 0) {
                int e0 = 0; float v0 = lg[0];
#pragma unroll
                for (int e = 1; e < 8; ++e) if (lg[e] > v0) { v0 = lg[e]; e0 = e; }
                int e1 = -1; float v1 = -INFINITY;
#pragma unroll
                for (int e = 0; e < 8; ++e) if (e != e0 && lg[e] > v1) { v1 = lg[e]; e1 = e; }
                const float w0 = 1.f / (1.f + expf(v1 - v0));
                int* tok_e = (int*)(p.ws + WS_ROUTE); float* tok_w = (float*)(p.ws + WS_ROUTE) + 16384 * 2;
                tok_e[r * 2] = e0; tok_e[r * 2 + 1] = e1; tok_w[r * 2] = w0; tok_w[r * 2 + 1] = 1.f - w0;
                __hip_atomic_fetch_add(cnt_lds + e0, 1u, __ATOMIC_RELAXED, __HIP_MEMORY_SCOPE_WORKGROUP); __hip_atomic_fetch_add(cnt_lds + e1, 1u, __ATOMIC_RELAXED, __HIP_MEMORY_SCOPE_WORKGROUP);
            }
        }
    }
    if (route) { __syncthreads(); if (threadIdx.x < NEXP) ((unsigned*)(p.ws + WS_ROUTE) + 16384 * 6)[blockIdx.x * NEXP + threadIdx.x] = cnt_lds[threadIdx.x]; __syncthreads(); }
}

__device__ __forceinline__ void norm_row(const P& p, int layer, int which, int r, int lane) {
    const float* gain = p.in[which == 0 ? 6 : 7] + layer * D; bf16* A = (bf16*)(p.ws + WS_A);
    const int mi = row_mi(r); const float* src = hrow(p, r);
    const float* shift = mods(p, layer, mi, which == 0 ? 0 : 3); const float* scale = mods(p, layer, mi, which == 0 ? 1 : 4);
    f32x4 v[4]; float ss = 0.f;
#pragma unroll
    for (int j = 0; j < 4; ++j) { v[j] = *(const f32x4*)(src + 4 * lane + 256 * j); ss += v[j].x * v[j].x + v[j].y * v[j].y + v[j].z * v[j].z + v[j].w * v[j].w; }
    const float rstd = rsqrtf(wave_sum(ss) * (1.f / D) + EPS);
#pragma unroll
    for (int j = 0; j < 4; ++j) { const int c = 4 * lane + 256 * j;
        const f32x4 g = *(const f32x4*)(gain + c), sc = *(const f32x4*)(scale + c), sh = *(const f32x4*)(shift + c);
        const f32x4 y = v[j] * rstd * g * (sc + 1.f) + sh;
        u32x2 o; o.x = pk2(y.x, y.y); o.y = pk2(y.z, y.w);
        *(u32x2*)(A + (size_t)r * D + c) = o; }
}

namespace fg {
typedef short bf16x8 __attribute__((ext_vector_type(8)));
constexpr int BM = 256, BK = 64, HALF = 128, HTB = HALF * BK * 2, STAGE_BYTES = 8 * HTB, NXCD = 8, WGM = 8;
__device__ __forceinline__ int lds_byte(int r, int c) { const int st = (r >> 4) * 2 + (c >> 5), rr = r & 15, cc = c & 31, ob = rr * 64 + cc * 2; return st * 1024 + (ob ^ (((ob >> 9) & 1) << 5)); }
__device__ __forceinline__ void stage_rc(int b, int& R, int& C) { const int st = b / 1024, sb = b % 1024, swz = sb ^ (((sb >> 9) & 1) << 5); R = (st >> 1) * 16 + swz / 64; C = (st & 1) * 32 + (swz % 64) / 2; }
__device__ __forceinline__ int perm32(int rho) { const int n = rho >> 4, i = rho & 15; return 8 * (i >> 2) + 4 * n + (i & 3); }
struct Unit { int pm, pn; const char* A; const char* B; int nt, aux; };
__device__ __forceinline__ bool tile_order(int i, int nM, int nN, int G, int c, int& pm, int& pn) {
    const int nwg = nM * nN; const long L = (long)i * G + c; if (L >= nwg) return false;
    int wgid = (int)L; { const int q = nwg / NXCD, r = nwg % NXCD, xcd = wgid % NXCD, off = wgid / NXCD; wgid = (xcd < r ? xcd * (q + 1) : r * (q + 1) + (xcd - r) * q) + off; }
    const int nig = WGM * nN, gid = wgid / nig, fm = gid * WGM, gsz = (nM - fm) < WGM ? (nM - fm) : WGM;
    pm = fm + ((wgid % nig) % gsz); pn = (wgid % nig) / gsz; return true;
}
struct PlainSched {
    const char* Abase; const char* Bbase; int lda, ldb, nM, nN, G, c, nt;
    __device__ __forceinline__ int arow(int R) const { return R; }
    __device__ __forceinline__ int ahalf() const { return HALF; }
    __device__ __forceinline__ bool next(int i, Unit& u) const { if (!tile_order(i, nM, nN, G, c, u.pm, u.pn)) return false;
        u.A = Abase + (size_t)u.pm * BM * lda * 2; u.B = Bbase + (size_t)u.pn * BM * ldb * 2; u.nt = nt; u.aux = 0; return true; }
};
struct ExpertSched {
    const char* Abase; const char* Bbase; int lda, ldb, nM, nN, G, c, nt; const LAS int* tile_e; size_t estride;
    __device__ __forceinline__ int arow(int R) const { return R; }
    __device__ __forceinline__ int ahalf() const { return HALF; }
    __device__ __forceinline__ bool next(int i, Unit& u) const { if (!tile_order(i, nM, nN, G, c, u.pm, u.pn)) return false;
        u.A = Abase + (size_t)u.pm * BM * lda * 2; u.B = Bbase + (size_t)tile_e[u.pm] * estride + (size_t)u.pn * BM * ldb * 2; u.nt = nt; u.aux = 0; return true; }
};
struct WinSched {
    const char* Abase; const char* Bbase; int G, c, mode, nN;
    __device__ __forceinline__ int arow(int R) const { return mode == 0 ? 256 * (R & 15) + 64 * ((R >> 4) & 3) + (R >> 6) : R; }
    __device__ __forceinline__ int ahalf() const { return mode == 0 ? 4096 : HALF; }
    __device__ __forceinline__ bool next(int i, Unit& u) const { if (!tile_order(i, mode == 0 ? 64 : 2, nN, G, c, u.pm, u.pn)) return false;
        const size_t row0 = mode == 0 ? (size_t)((u.pm >> 5) * SEQ + 2 * (u.pm & 31)) : (size_t)(NLAT + u.pm * CTX);
        u.A = Abase + row0 * D * 2; u.B = Bbase + (size_t)u.pn * BM * D * 2; u.nt = D / 64; u.aux = mode; return true; }
};
struct MergeSched {
    const char* Xbase; const char* Wbase; int nM, G, c;
    __device__ __forceinline__ int arow(int R) const { return R; }
    __device__ __forceinline__ int ahalf() const { return HALF; }
    __device__ __forceinline__ bool next(int i, Unit& u) const { if (!tile_order(i >> 2, nM, 4, G, c, u.pm, u.pn)) return false;
        const int br = i & 3, koff = br == 0 ? 0 : (br == 1 ? 512 : (br == 2 ? 768 : 1280));
        u.A = Xbase + ((size_t)u.pm * BM * 1536 + koff) * 2; u.B = Wbase + ((size_t)u.pn * BM * 1536 + koff) * 2; u.nt = (br & 1) ? 4 : 8; u.aux = br; return true; }
};
template <class E, class = void> struct is_chain { static constexpr bool v = false; };
template <class E> struct is_chain<E, decltype((void)E::CHAIN)> { static constexpr bool v = E::CHAIN; };
typedef f32x4 Acc[2][2][4][2];
typedef int i32x4 __attribute__((ext_vector_type(4))); typedef int i32x8 __attribute__((ext_vector_type(8)));
__device__ __forceinline__ i32x8 ld32(const LAS unsigned char* p) { const i32x4 a = *(const LAS i32x4*)p, b = *(const LAS i32x4*)(p + 16); return __builtin_shufflevector(a, b, 0, 1, 2, 3, 4, 5, 6, 7); }
template <class Epi, class Sched, bool F8 = false>
__device__ __forceinline__ void gemm_phase(LAS unsigned char* lds, int lda, int ldb, const Sched& S, const Epi& E) {
    int tid_ = threadIdx.x; asm volatile("" : "+v"(tid_));
    const int tid = tid_, wid = __builtin_amdgcn_readfirstlane(tid >> 6), lane = tid & 63, wr = wid >> 2, wc = wid & 3, fr = lane & 15, fq = lane >> 4;
    unsigned voffA[2], voffB[2];
#pragma unroll
    for (int i = 0; i < 2; ++i) { int R, C; stage_rc(tid * 16 + i * 8192, R, C); const int Rb = Epi::PERM ? ((R & ~31) + perm32(R & 31)) : R;
        voffA[i] = (unsigned)(S.arow(R) * lda + C) * 2u; voffB[i] = (unsigned)(Rb * ldb + C) * 2u; }
    const size_t kstep = (size_t)(BK * 2);
    const size_t hstepA = (size_t)S.ahalf() * lda * 2, hstepB = (size_t)HALF * ldb * 2;
    const unsigned ldsw = (unsigned)wid * 1024u;
    const int aoff = lds_byte(wr * 64 + fr, F8 ? fq * 16 : fq * 8), boff = lds_byte(wc * 32 + fr, F8 ? fq * 16 : fq * 8);
#define FG_SA(b, h) (((b) * 2 + (h)) * HTB)
#define FG_SB(b, h) ((4 + (b) * 2 + (h)) * HTB)
#define FG_STAGE(bufoff, gbase, voff) do { _Pragma("unroll") for (int _i = 0; _i < 2; ++_i) \
        __builtin_amdgcn_global_load_lds((const unsigned*)((const char*)(gbase) + (voff)[_i]), (LAS unsigned*)(lds + (bufoff) + ldsw + _i * 8192), 16, 0, 0); } while (0)
#define FG_LDA(dst, b, h) do { if constexpr (F8) { _Pragma("unroll") for (int m = 0; m < 4; ++m) dst##8[m] = ld32(lds + FG_SA(b, h) + aoff + m * 2048); } \
        else { _Pragma("unroll") for (int m = 0; m < 4; ++m) _Pragma("unroll") for (int k = 0; k < 2; ++k) dst[m][k] = *(const LAS bf16x8*)(lds + FG_SA(b, h) + aoff + m * 2048 + k * 1024); } } while (0)
#define FG_LDB(dst, b, h) do { if constexpr (F8) { _Pragma("unroll") for (int n = 0; n < 2; ++n) dst##8[n] = ld32(lds + FG_SB(b, h) + boff + n * 2048); } \
        else { _Pragma("unroll") for (int n = 0; n < 2; ++n) _Pragma("unroll") for (int k = 0; k < 2; ++k) dst[n][k] = *(const LAS bf16x8*)(lds + FG_SB(b, h) + boff + n * 2048 + k * 1024); } } while (0)
#define FG_MMA(ai, bj, At, Bt) do { __builtin_amdgcn_s_setprio(1); _Pragma("unroll") for (int m = 0; m < 4; ++m) _Pragma("unroll") for (int n = 0; n < 2; ++n) { \
        if constexpr (F8) asm volatile("v_mfma_scale_f32_16x16x128_f8f6f4 %0, %1, %2, %0, %3, %4 op_sel_hi:[0,0,0]" : "+v"(acc[ai][bj][m][n]) : "v"(Bt##8[n]), "v"(At##8[m]), "v"(scw), "v"(sca)); \
        else { _Pragma("unroll") for (int k = 0; k < 2; ++k) acc[ai][bj][m][n] = __builtin_amdgcn_mfma_f32_16x16x32_bf16(Bt[n][k], At[m][k], acc[ai][bj][m][n], 0, 0, 0); } } \
        __builtin_amdgcn_s_setprio(0); } while (0)
#define FG_WAIT_V(n) asm volatile("s_waitcnt vmcnt(" #n ")" ::: "memory")
#define FG_WAIT_L(n) asm volatile("s_waitcnt lgkmcnt(" #n ")" ::: "memory")
#define FG_BAR __builtin_amdgcn_s_barrier()
#define FG_SCHED __builtin_amdgcn_sched_barrier(0)
    Unit cur, nxt; int ui = 0;
    if (!S.next(0, cur)) return;
    Acc acc;
#pragma unroll
    for (int a = 0; a < 2; ++a)
#pragma unroll
        for (int b = 0; b < 2; ++b)
#pragma unroll
            for (int m = 0; m < 4; ++m)
#pragma unroll
                for (int n = 0; n < 2; ++n) acc[a][b][m][n] = (f32x4){0.f, 0.f, 0.f, 0.f};
    bf16x8 At[4][2], B0[2][2], B1[2][2]; i32x8 At8[4], B08[2], B18[2];
    const int scw = 0x7a7a7a7a, sca = 0x7f7f7f7f;
    const char* cA = cur.A; const char* cB = cur.B;
    FG_STAGE(FG_SB(0, 0), cB, voffB); FG_STAGE(FG_SB(0, 1), cB + hstepB, voffB); FG_STAGE(FG_SA(0, 0), cA, voffA); FG_STAGE(FG_SA(0, 1), cA + hstepA, voffA);
    if (wr == 1) FG_BAR;
    FG_WAIT_V(2); FG_BAR;
    FG_STAGE(FG_SB(1, 0), cB + kstep, voffB); FG_STAGE(FG_SA(1, 0), cA + kstep, voffA); FG_STAGE(FG_SB(1, 1), cB + hstepB + kstep, voffB);
    FG_WAIT_V(6); FG_BAR;
    for (;;) {
        const bool has_next = S.next(ui + 1, nxt);
        const char* nA = has_next ? nxt.A : cA; const char* nB = has_next ? nxt.B : cB;
        const int nt = cur.nt;
#pragma unroll 1
        for (int t = 0; t < nt; t += 2) {
            const bool last = (t == nt - 2);
            const char* a1 = cA + (size_t)(t + 1) * kstep;
            const char* a2 = last ? nA : cA + (size_t)(t + 2) * kstep; const char* b2 = last ? nB : cB + (size_t)(t + 2) * kstep;
            const char* a3 = a2 + kstep; const char* b3 = b2 + kstep;
            FG_LDB(B0, 0, 0); FG_LDB(B1, 0, 1); FG_SCHED; FG_LDA(At, 0, 0); FG_STAGE(FG_SA(1, 1), a1 + hstepA, voffA);
            FG_WAIT_V(8); FG_WAIT_L(0); FG_BAR; FG_MMA(0, 0, At, B0); FG_MMA(0, 1, At, B1); FG_BAR; FG_SCHED;
            FG_LDA(At, 0, 1); FG_STAGE(FG_SB(0, 0), b2, voffB); FG_STAGE(FG_SB(0, 1), b2 + hstepB, voffB); FG_STAGE(FG_SA(0, 0), a2, voffA);
            FG_WAIT_V(8); FG_WAIT_L(0); FG_BAR; FG_MMA(1, 0, At, B0); FG_MMA(1, 1, At, B1); FG_BAR; FG_SCHED;
            FG_LDB(B0, 1, 0); FG_LDB(B1, 1, 1); FG_SCHED; FG_LDA(At, 1, 0); FG_STAGE(FG_SA(0, 1), a2 + hstepA, voffA);
            FG_WAIT_V(8); FG_WAIT_L(0); FG_BAR; FG_MMA(0, 0, At, B0); FG_MMA(0, 1, At, B1); FG_BAR; FG_SCHED;
            FG_LDA(At, 1, 1); FG_STAGE(FG_SB(1, 0), b3, voffB); FG_STAGE(FG_SB(1, 1), b3 + hstepB, voffB); FG_STAGE(FG_SA(1, 0), a3, voffA);
            FG_WAIT_V(8); FG_WAIT_L(0); FG_BAR; FG_MMA(1, 0, At, B0); FG_MMA(1, 1, At, B1); FG_BAR; FG_SCHED;
        }
        if (wr == 0) FG_BAR;
        E(acc, cur, wr, wc, fr, fq);
        if (!has_next) break;
        if (!(is_chain<Epi>::v && cur.aux != 3)) {
#pragma unroll
        for (int a = 0; a < 2; ++a)
#pragma unroll
            for (int b = 0; b < 2; ++b)
#pragma unroll
                for (int m = 0; m < 4; ++m)
#pragma unroll
                    for (int n = 0; n < 2; ++n) acc[a][b][m][n] = (f32x4){0.f, 0.f, 0.f, 0.f};
        }
        cur = nxt; cA = nA; cB = nB; ++ui;
        if (wr == 1) FG_BAR;
    }
    FG_WAIT_V(0);
    FG_BAR;
#undef FG_SA
#undef FG_SB
#undef FG_STAGE
#undef FG_LDA
#undef FG_LDB
#undef FG_MMA
#undef FG_WAIT_V
#undef FG_WAIT_L
#undef FG_BAR
#undef FG_SCHED
}
__device__ __forceinline__ unsigned cvt_pk(float lo, float hi) { unsigned r; asm volatile("v_cvt_pk_bf16_f32 %0, %1, %2" : "=v"(r) : "v"(lo), "v"(hi)); return r; }
__device__ __forceinline__ u32x4 pack8(const f32x4 a, const f32x4 b) { u32x4 w; w.x = cvt_pk(a[0], a[1]); w.y = cvt_pk(a[2], a[3]); w.z = cvt_pk(b[0], b[1]); w.w = cvt_pk(b[2], b[3]); return w; }
__device__ __forceinline__ f32x4 unpk_u8(unsigned x) { const float k = 1.f / 255.f; return (f32x4){(float)(x & 0xffu) * k, (float)((x >> 8) & 0xffu) * k, (float)((x >> 16) & 0xffu) * k, (float)(x >> 24) * k}; }
__device__ __forceinline__ f32x4 unpk_u8r(unsigned x) { return (f32x4){(float)(x & 0xffu), (float)((x >> 8) & 0xffu), (float)((x >> 16) & 0xffu), (float)(x >> 24)}; }
__device__ __forceinline__ f32x4 unpk_lo(unsigned x, unsigned y) { return (f32x4){__uint_as_float(x << 16), __uint_as_float(x & 0xffff0000u), __uint_as_float(y << 16), __uint_as_float(y & 0xffff0000u)}; }

struct EpiWin {
    static constexpr bool PERM = true;
    unsigned char* ws; const float* qg; const float* kg;
    __device__ __forceinline__ void operator()(const Acc& acc, const Unit& u, int wr, int wc, int fr_, int fq_) const {
        int fr = fr_, fq = fq_; asm volatile("" : "+v"(fr), "+v"(fq));
        const int tile = u.pn; const bool LAT = u.aux == 0;
        if (tile == 0) {
            if (LAT) {
                const int b = u.pm >> 5, n2 = 2 * (u.pm & 31) + wr;
#pragma unroll
                for (int ai = 0; ai < 2; ++ai)
#pragma unroll
                    for (int bj = 0; bj < 2; ++bj) {
#pragma unroll
                        for (int n = 0; n < 2; ++n)
#pragma unroll
                            for (int e = 0; e < 4; ++e) { const int ch = bj * HALF + wc * 32 + 8 * fq + 4 * n + e;
                                u32x2 o; o.x = cvt_pk(acc[ai][bj][0][n][e], acc[ai][bj][1][n][e]); o.y = cvt_pk(acc[ai][bj][2][n][e], acc[ai][bj][3][n][e]);
                                *(u32x2*)((bf16*)(ws + WS_UT) + ((size_t)(b * 256 + ch) * 64 + n2) * 256 + 64 * ai + 4 * fr) = o; }
                        asm volatile("" ::: "memory"); }
            } else {
#pragma unroll
                for (int ai = 0; ai < 2; ++ai)
#pragma unroll
                    for (int m = 0; m < 4; ++m) { const int sx = ai * HALF + wr * 64 + m * 16 + fr;
#pragma unroll
                        for (int bj = 0; bj < 2; ++bj)
#pragma unroll
                            for (int n = 0; n < 2; ++n)
#pragma unroll
                                for (int e = 0; e < 4; ++e) { const int ch = bj * HALF + wc * 32 + 8 * fq + 4 * n + e;
                                    ((bf16*)(ws + WS_UTC))[(size_t)(u.pm * 256 + ch) * 256 + sx] = f2bf(acc[ai][bj][m][n][e]); }
                        asm volatile("" ::: "memory"); }
            }
            return;
        }
        const bool ropek = tile == 1 || tile == 2 || tile == 5 || tile == 6 || (tile == 7 && wc < 2);
        const bool keyrow = tile == 7;
        size_t boff; int pitch, col0;
        if (tile <= 4) { boff = WS_RETQ + (size_t)(tile - 1) * MROWS * 256 * 2; pitch = 256; col0 = ropek ? wc * 64 : wc * 32; }
        else if (tile <= 6) { boff = WS_ATTQ; pitch = 512; col0 = (tile - 5) * 256 + wc * 64; }
        else if (tile == 7) { boff = wc < 2 ? WS_ATTK : WS_ATTV; pitch = 128; col0 = (wc & 1) * 64; }
        else if (tile < 10) { boff = WS_CONV; pitch = 512; col0 = (tile - 8) * 256 + wc * 32; }
        else { boff = WS_G; pitch = 4096; col0 = (tile - 10) * 256 + wc * 32; }
        const bool head = ropek || tile == 7;
        bf16* const dbase = (bf16*)(ws + boff);
        const bool norm = tile >= 5 && ropek;
        const float* gp = tile == 7 ? kg : qg;
        const float osc = tile == 2 ? 0.125f : (tile == 5 || tile == 6 ? QSCALE : 1.f);
        const float* rc = (const float*)(ws + WS_ROPE);
#pragma unroll
        for (int ai = 0; ai < 2; ++ai) {
            f32x4 rcs[4][2], rsn[4][2];
            if (ropek && LAT) {
#pragma unroll
                for (int m = 0; m < 4; ++m)
#pragma unroll
                    for (int bj = 0; bj < 2; ++bj) { const int sx = 4096 * ai + 256 * fr + 64 * m + 2 * (u.pm & 31) + wr, i0 = 16 * bj + 4 * fq;
                        rcs[m][bj] = *(const f32x4*)(rc + sx * 32 + i0); rsn[m][bj] = *(const f32x4*)(rc + SEQ * 32 + sx * 32 + i0); } }
#pragma unroll
            for (int m = 0; m < 4; ++m) {
                const int b = LAT ? (u.pm >> 5) : u.pm, s = LAT ? (4096 * ai + 256 * fr + 64 * m + 2 * (u.pm & 31) + wr) : (ai * HALF + wr * 64 + m * 16 + fr);
                const int rr = keyrow ? b * KEYS + (LAT ? CTX + s : s) : (LAT ? b * SEQ + s : NLAT + b * CTX + s);
                bf16* const drow = dbase + ((size_t)rr * pitch + col0 + 8 * fq);
                if (ropek) {
                    float rstd = 1.f;
                    if (norm) { float ss = 0.f;
#pragma unroll
                        for (int bj = 0; bj < 2; ++bj)
#pragma unroll
                            for (int n = 0; n < 2; ++n) { const f32x4 x = acc[ai][bj][m][n]; ss += (x[0] * x[0] + x[1] * x[1]) + (x[2] * x[2] + x[3] * x[3]); }
                        ss += __shfl_xor(ss, 16); ss += __shfl_xor(ss, 32);
                        rstd = rsqrtf(ss * (1.f / 64.f) + EPS); }
#pragma unroll
                    for (int bj = 0; bj < 2; ++bj) {
                        const int i0 = 16 * bj + 4 * fq;
                        f32x4 x1 = acc[ai][bj][m][0], x2 = acc[ai][bj][m][1];
                        if (norm) { const f32x4 g1 = *(const f32x4*)(gp + i0), g2 = *(const f32x4*)(gp + 32 + i0); x1 = x1 * rstd * g1; x2 = x2 * rstd * g2; }
                        f32x4 o1 = x1, o2 = x2;
                        if (LAT) { const f32x4 cs = rcs[m][bj], sn = rsn[m][bj]; o1 = x1 * cs - x2 * sn; o2 = x1 * sn + x2 * cs; }
                        *(u32x4*)(drow + 32 * bj) = pack8(o1 * osc, o2 * osc);
                    }
                } else {
#pragma unroll
                    for (int bj = 0; bj < 2; ++bj) {
                        f32x4 a0 = acc[ai][bj][m][0], a1 = acc[ai][bj][m][1];
                        if (tile >= 10) {
                            u32x2 o; o.x = 0u; o.y = 0u;
#pragma unroll
                            for (int e = 0; e < 4; ++e) { o.x = __builtin_amdgcn_cvt_pk_u8_f32(__builtin_fmaxf(__builtin_floorf(sigmoid_fast(a0[e]) * 255.f + 0.5f), 1.f), e, o.x);
                                o.y = __builtin_amdgcn_cvt_pk_u8_f32(__builtin_fmaxf(__builtin_floorf(sigmoid_fast(a1[e]) * 255.f + 0.5f), 1.f), e, o.y); }
                            *(u32x2*)(ws + WS_G + (size_t)rr * 4096 + (tile - 10) * 256 + wc * 32 + 8 * fq + HALF * bj) = o;
                        } else *(u32x4*)(drow + (head ? 32 : HALF) * bj) = pack8(a0, a1);
                    }
                }
            }
        }
    }
};
struct EpiGate8 {
    static constexpr bool PERM = true;
    unsigned char* G;
    __device__ __forceinline__ void operator()(const Acc& acc, const Unit& u, int wr, int wc, int fr_, int fq_) const {
        int fr = fr_, fq = fq_; asm volatile("" : "+v"(fr), "+v"(fq));
#pragma unroll
        for (int ai = 0; ai < 2; ++ai)
#pragma unroll
            for (int m = 0; m < 4; ++m) { const int r = u.pm * BM + ai * HALF + wr * 64 + m * 16 + fr;
#pragma unroll
                for (int bj = 0; bj < 2; ++bj) { const f32x4 a0 = acc[ai][bj][m][0], a1 = acc[ai][bj][m][1]; u32x2 o; o.x = 0u; o.y = 0u;
#pragma unroll
                    for (int e = 0; e < 4; ++e) { o.x = __builtin_amdgcn_cvt_pk_u8_f32(__builtin_fmaxf(__builtin_floorf(sigmoid_fast(a0[e]) * 255.f + 0.5f), 1.f), e, o.x);
                        o.y = __builtin_amdgcn_cvt_pk_u8_f32(__builtin_fmaxf(__builtin_floorf(sigmoid_fast(a1[e]) * 255.f + 0.5f), 1.f), e, o.y); }
                    *(u32x2*)(G + (size_t)r * 4096 + u.pn * BM + bj * HALF + wc * 32 + 8 * fq) = o; } }
    }
};
struct EpiMerge {
    static constexpr bool PERM = true, CHAIN = true;
    const unsigned char* G; bf16* Mg;
    __device__ __forceinline__ void operator()(Acc& acc, const Unit& u, int wr, int wc, int fr_, int fq_) const {
        int fr = fr_, fq = fq_; asm volatile("" : "+v"(fr), "+v"(fq));
        const int br = u.aux; const bool lastb = br == 3;
#pragma unroll
        for (int ai = 0; ai < 2; ++ai) {
            u32x2 g[4][2], gn[4][2];
#pragma unroll
            for (int m = 0; m < 4; ++m)
#pragma unroll
                for (int bj = 0; bj < 2; ++bj) { const int r = u.pm * BM + ai * HALF + wr * 64 + m * 16 + fr, c = u.pn * BM + bj * HALF + wc * 32 + 8 * fq;
                    g[m][bj] = *(const u32x2*)(G + (size_t)r * 4096 + br * 1024 + c);
                    if (!lastb) gn[m][bj] = *(const u32x2*)(G + (size_t)r * 4096 + (br + 1) * 1024 + c); }
#pragma unroll
            for (int m = 0; m < 4; ++m)
#pragma unroll
                for (int bj = 0; bj < 2; ++bj) {
                    if (!lastb) {
                        const f32x4 n0 = unpk_u8r(g[m][bj].x), n1 = unpk_u8r(g[m][bj].y), d0 = unpk_u8r(gn[m][bj].x), d1 = unpk_u8r(gn[m][bj].y);
#pragma unroll
                        for (int e = 0; e < 4; ++e) { acc[ai][bj][m][0][e] *= n0[e] * __builtin_amdgcn_rcpf(d0[e]); acc[ai][bj][m][1][e] *= n1[e] * __builtin_amdgcn_rcpf(d1[e]); }
                    } else { const int r = u.pm * BM + ai * HALF + wr * 64 + m * 16 + fr, c = u.pn * BM + bj * HALF + wc * 32 + 8 * fq;
                        *(u32x4*)(Mg + (size_t)r * 1024 + c) = pack8(acc[ai][bj][m][0] * unpk_u8(g[m][bj].x), acc[ai][bj][m][1] * unpk_u8(g[m][bj].y)); } }
        }
    }
};
struct EpiResid {
    static constexpr bool PERM = false;
    float* out; float* hctx; const float* modbase; int chunk;
    __device__ __forceinline__ void operator()(const Acc& acc, const Unit& u, int wr, int wc, int fr_, int fq_) const {
        int fr = fr_, fq = fq_; asm volatile("" : "+v"(fr), "+v"(fq));
        const int rt = u.pm * BM;
        const float* g = modbase + ((size_t)row_mi(rt) * 6 + chunk) * D;
        f32x4 gg[2][2];
#pragma unroll
        for (int bj = 0; bj < 2; ++bj)
#pragma unroll
            for (int n = 0; n < 2; ++n) gg[bj][n] = *(const f32x4*)(g + u.pn * BM + bj * HALF + wc * 32 + 16 * n + 4 * fq);
#pragma unroll
        for (int ai = 0; ai < 2; ++ai) {
            f32x4 hv[4][2][2];
#pragma unroll
            for (int m = 0; m < 4; ++m) { const int r = rt + ai * HALF + wr * 64 + m * 16 + fr; const float* h = r < NLAT ? out + (size_t)r * D : hctx + (size_t)(r - NLAT) * D;
#pragma unroll
                for (int bj = 0; bj < 2; ++bj)
#pragma unroll
                    for (int n = 0; n < 2; ++n) hv[m][bj][n] = *(const f32x4*)(h + u.pn * BM + bj * HALF + wc * 32 + 16 * n + 4 * fq); }
#pragma unroll
            for (int m = 0; m < 4; ++m) { const int r = rt + ai * HALF + wr * 64 + m * 16 + fr; float* h = r < NLAT ? out + (size_t)r * D : hctx + (size_t)(r - NLAT) * D;
#pragma unroll
                for (int bj = 0; bj < 2; ++bj)
#pragma unroll
                    for (int n = 0; n < 2; ++n) *(f32x4*)(h + u.pn * BM + bj * HALF + wc * 32 + 16 * n + 4 * fq) = hv[m][bj][n] + gg[bj][n] * acc[ai][bj][m][n]; }
        }
    }
};
struct EpiResidNorm {
    static constexpr bool PERM = false;
    const float* hin; float* out; const float* modbase; int chunk;
    const float* gain; const float* nmods; int csh, csc; bf16* A; unsigned char* A8;
    float* xbuf; unsigned* cnt; unsigned* tmo; LAS unsigned char* lds;
    __device__ __forceinline__ void operator()(Acc& acc, const Unit& u, int wr, int wc, int fr_, int fq_) const {
        int fr = fr_, fq = fq_; asm volatile("" : "+v"(fr), "+v"(fq));
        const int wid = __builtin_amdgcn_readfirstlane((int)threadIdx.x >> 6), lane = threadIdx.x & 63;
        const int rt = u.pm * BM, mi = row_mi(rt);
        LAS float* Pt = (LAS float*)(lds + STAGE_BYTES);
        LAS float* St = (LAS float*)(lds + STAGE_BYTES + 4096);
        LAS unsigned* flag = (LAS unsigned*)(lds + STAGE_BYTES + 5120);
        { const float* g = modbase + ((size_t)mi * 6 + chunk) * D;
          f32x4 gg[2][2];
#pragma unroll
          for (int bj = 0; bj < 2; ++bj)
#pragma unroll
              for (int n = 0; n < 2; ++n) gg[bj][n] = *(const f32x4*)(g + u.pn * BM + bj * HALF + wc * 32 + 16 * n + 4 * fq);
#pragma unroll
          for (int am = 0; am < 4; ++am) { const int ai = am >> 1, m0 = (am & 1) * 2;
              f32x4 hv[2][2][2];
#pragma unroll
              for (int mm = 0; mm < 2; ++mm) { const float* h = hin + (size_t)(rt + ai * HALF + wr * 64 + (m0 + mm) * 16 + fr) * D;
#pragma unroll
                  for (int bj = 0; bj < 2; ++bj)
#pragma unroll
                      for (int n = 0; n < 2; ++n) hv[mm][bj][n] = *(const f32x4*)(h + u.pn * BM + bj * HALF + wc * 32 + 16 * n + 4 * fq); }
#pragma unroll
              for (int mm = 0; mm < 2; ++mm) { const int m = m0 + mm; float* h = out + (size_t)(rt + ai * HALF + wr * 64 + m * 16 + fr) * D; float ss = 0.f;
#pragma unroll
                  for (int bj = 0; bj < 2; ++bj)
#pragma unroll
                      for (int n = 0; n < 2; ++n) { const f32x4 x = hv[mm][bj][n] + gg[bj][n] * acc[ai][bj][m][n]; acc[ai][bj][m][n] = x;
                          *(f32x4*)(h + u.pn * BM + bj * HALF + wc * 32 + 16 * n + 4 * fq) = x; ss += (x[0] * x[0] + x[1] * x[1]) + (x[2] * x[2] + x[3] * x[3]); }
                  ss += __shfl_xor(ss, 16); ss += __shfl_xor(ss, 32);
                  if (fq == 0) Pt[(ai * HALF + wr * 64 + m * 16 + fr) * 4 + wc] = ss; }
              asm volatile("" ::: "memory");
          } }
        asm volatile("s_waitcnt lgkmcnt(0)" ::: "memory"); __builtin_amdgcn_s_barrier(); asm volatile("" ::: "memory");
        const int row = wid * 32 + (lane & 31);
        if (lane < 32) { const f32x4 q = *(const LAS f32x4*)(Pt + row * 4);
            __hip_atomic_store(xbuf + ((size_t)(rt + row) * 4 + u.pn), (q[0] + q[1]) + (q[2] + q[3]), __ATOMIC_RELAXED, __HIP_MEMORY_SCOPE_AGENT); }
        asm volatile("s_waitcnt vmcnt(0)" ::: "memory");
        if (lane == 0) __hip_atomic_fetch_add(cnt + 16 * u.pm, 1u, __ATOMIC_RELAXED, __HIP_MEMORY_SCOPE_AGENT);
        if (wid == 0) { unsigned sp = 0u, dead = 0u;
            while ((unsigned)__builtin_amdgcn_readfirstlane(__hip_atomic_load(cnt + 16 * u.pm, __ATOMIC_RELAXED, __HIP_MEMORY_SCOPE_AGENT)) < 32u) {
                __builtin_amdgcn_s_sleep(1);
                if ((++sp & 255u) == 0u) { if (__hip_atomic_load(tmo, __ATOMIC_RELAXED, __HIP_MEMORY_SCOPE_AGENT)) { dead = 1u; break; } if (sp > (1u << 22)) { if (lane == 0) atomicAdd(tmo, 1u); dead = 1u; break; } } }
            __builtin_amdgcn_fence(__ATOMIC_ACQUIRE, "agent");
            if (lane == 0) flag[0] = dead; }
        asm volatile("s_waitcnt vmcnt(0) lgkmcnt(0)" ::: "memory"); __builtin_amdgcn_s_barrier(); asm volatile("" ::: "memory");
        if (lane < 32) { const float* sl = xbuf + (size_t)(rt + row) * 4; float t = 0.f;
#pragma unroll
            for (int q = 0; q < 4; ++q) t += __hip_atomic_load(sl + q, __ATOMIC_RELAXED, __HIP_MEMORY_SCOPE_AGENT);
            St[row] = rsqrtf(t * (1.f / D) + EPS); }
        asm volatile("s_waitcnt lgkmcnt(0)" ::: "memory"); __builtin_amdgcn_s_barrier(); asm volatile("" ::: "memory");
        const float* shp = nmods + ((size_t)mi * 6 + csh) * D; const float* scp = nmods + ((size_t)mi * 6 + csc) * D;
        float rs[2][4];
#pragma unroll
        for (int ai = 0; ai < 2; ++ai)
#pragma unroll
            for (int m = 0; m < 4; ++m) rs[ai][m] = St[ai * HALF + wr * 64 + m * 16 + fr];
#pragma unroll
        for (int bj = 0; bj < 2; ++bj)
#pragma unroll
            for (int n = 0; n < 2; ++n) { const int c = u.pn * BM + bj * HALF + wc * 32 + 16 * n + 4 * fq;
                const f32x4 g4 = *(const f32x4*)(gain + c), sc4 = *(const f32x4*)(scp + c) + 1.f, sh4 = *(const f32x4*)(shp + c);
#pragma unroll
                for (int ai = 0; ai < 2; ++ai)
#pragma unroll
                    for (int m = 0; m < 4; ++m) { const f32x4 y = acc[ai][bj][m][n] * rs[ai][m] * g4 * sc4 + sh4;
                        u32x2 o; o.x = cvt_pk(y[0], y[1]); o.y = cvt_pk(y[2], y[3]);
                        *(u32x2*)(A + (size_t)(rt + ai * HALF + wr * 64 + m * 16 + fr) * D + c) = o;
                        if (A8) *(unsigned*)(A8 + (size_t)(rt + ai * HALF + wr * 64 + m * 16 + fr) * D + c) = pk4_fp8(y[0], y[1], y[2], y[3]); } }
    }
};
struct EpiSwiglu {
    static constexpr bool PERM = true;
    bf16* Hm;
    __device__ __forceinline__ void operator()(const Acc& acc, const Unit& u, int wr, int wc, int fr, int fq) const {
#pragma unroll
        for (int ai = 0; ai < 2; ++ai)
#pragma unroll
            for (int m = 0; m < 4; ++m) { const int r = u.pm * BM + ai * HALF + wr * 64 + m * 16 + fr;
#pragma unroll
                for (int bj = 0; bj < 2; ++bj) { const int c = u.pn * BM + bj * HALF + wc * 32 + 8 * fq; const f32x4 g = acc[ai][bj][m][0], up = acc[ai][bj][m][1];
                    u32x2 o; o.x = cvt_pk(silu_fast(g[0]) * up[0], silu_fast(g[1]) * up[1]); o.y = cvt_pk(silu_fast(g[2]) * up[2], silu_fast(g[3]) * up[3]);
                    *(u32x2*)(Hm + (size_t)r * FFN + (c >> 1)) = o; } }
    }
};
struct EpiSwiglu8 {
    static constexpr bool PERM = true;
    unsigned char* Hm;
    __device__ __forceinline__ void operator()(const Acc& acc, const Unit& u, int wr, int wc, int fr_, int fq_) const {
        int fr = fr_, fq = fq_; asm volatile("" : "+v"(fr), "+v"(fq));
#pragma unroll
        for (int ai = 0; ai < 2; ++ai)
#pragma unroll
            for (int m = 0; m < 4; ++m) { const int r = u.pm * BM + ai * HALF + wr * 64 + m * 16 + fr;
#pragma unroll
                for (int bj = 0; bj < 2; ++bj) { const int c = u.pn * BM + bj * HALF + wc * 32 + 8 * fq; const f32x4 g = acc[ai][bj][m][0], up = acc[ai][bj][m][1];
                    *(unsigned*)(Hm + (size_t)r * FFN + (c >> 1)) = pk4_fp8(silu_fast(g[0]) * up[0], silu_fast(g[1]) * up[1], silu_fast(g[2]) * up[2], silu_fast(g[3]) * up[3]); } }
    }
};
struct EpiStore {
    static constexpr bool PERM = true;
    bf16* O; int ldc;
    __device__ __forceinline__ void operator()(const Acc& acc, const Unit& u, int wr, int wc, int fr_, int fq_) const {
        int fr = fr_, fq = fq_; asm volatile("" : "+v"(fr), "+v"(fq));
#pragma unroll
        for (int ai = 0; ai < 2; ++ai)
#pragma unroll
            for (int m = 0; m < 4; ++m) { const int r = u.pm * BM + ai * HALF + wr * 64 + m * 16 + fr;
#pragma unroll
                for (int bj = 0; bj < 2; ++bj) { const int c = u.pn * BM + bj * HALF + wc * 32 + 8 * fq; *(u32x4*)(O + (size_t)r * ldc + c) = pack8(acc[ai][bj][m][0], acc[ai][bj][m][1]); } }
    }
};
struct EpiFft1 {
    static constexpr bool PERM = true;
    unsigned char* ws;
    __device__ __forceinline__ void operator()(const Acc& acc, const Unit& u, int wr, int wc, int fr, int fq) const {
        const float* TW = (const float*)(ws + WS_TW); bf16* Z = (bf16*)(ws + WS_Z);
#pragma unroll
        for (int ai = 0; ai < 2; ++ai)
#pragma unroll
            for (int mm = 0; mm < 2; ++mm) { const int k1 = (4 * ai + 2 * wr + mm) * 16 + fr;
#pragma unroll
                for (int bj = 0; bj < 2; ++bj) { const int c = u.pn * BM + bj * HALF + wc * 32 + 8 * fq, n2 = c & 63, ch = (c >> 6) & 255, b = c >> 14;
                    f32x4 zr[2], zi[2];
#pragma unroll
                    for (int n = 0; n < 2; ++n) { const f32x4 yr = acc[ai][bj][2 * mm][n], yi = acc[ai][bj][2 * mm + 1][n];
                        const f32x4 t0 = *(const f32x4*)(TW + (size_t)(k1 * 64 + n2 + 4 * n) * 2), t1 = *(const f32x4*)(TW + (size_t)(k1 * 64 + n2 + 4 * n) * 2 + 4);
                        const f32x4 ct = {t0[0], t0[2], t1[0], t1[2]}, st = {t0[1], t0[3], t1[1], t1[3]};
                        zr[n] = yr * ct + yi * st; zi[n] = yi * ct - yr * st; }
                    bf16* dst = Z + ((size_t)b * 32768 + k1 * 256 + ch) * 256 + n2;
                    *(u32x4*)dst = pack8(zr[0], zr[1]); *(u32x4*)(dst + 64) = pack8(zi[0], zi[1]);
                    asm volatile("" ::: "memory"); } }
    }
};
struct EpiFft3 {
    static constexpr bool PERM = true;
    unsigned char* ws;
    __device__ __forceinline__ void operator()(const Acc& acc, const Unit& u, int wr, int wc, int fr, int fq) const {
        bf16* X = (bf16*)(ws + WS_X);
#pragma unroll
        for (int m = 0; m < 4; ++m) { const int k2 = 16 * m + fr;
#pragma unroll
            for (int bj = 0; bj < 2; ++bj) { const int c = u.pn * BM + bj * HALF + wc * 32 + 8 * fq, ch = c & 255, k1 = (c >> 8) & 127, b = c >> 15;
                *(u32x4*)(X + (size_t)(b * SEQ + k1 + 128 * k2) * 1536 + wr * 256 + ch) = pack8(acc[0][bj][m][0], acc[0][bj][m][1]); } }
    }
};
struct EpiFftC {
    static constexpr bool PERM = true;
    unsigned char* ws;
    __device__ __forceinline__ void operator()(const Acc& acc, const Unit& u, int wr, int wc, int fr, int fq) const {
        bf16* X = (bf16*)(ws + WS_X);
#pragma unroll
        for (int ai = 0; ai < 2; ++ai)
#pragma unroll
            for (int m = 0; m < 4; ++m) { const int k = ai * HALF + wr * 64 + m * 16 + fr;
#pragma unroll
                for (int bj = 0; bj < 2; ++bj) { const int ch = bj * HALF + wc * 32 + 8 * fq;
                    *(u32x4*)(X + (size_t)(NLAT + u.pn * CTX + k) * 1536 + u.pm * 256 + ch) = pack8(acc[ai][bj][m][0], acc[ai][bj][m][1]); } }
    }
};
}

__device__ __forceinline__ void ph_win(const P& p, LAS unsigned char* lds, int layer) {
    const char* W = (const char*)(p.ws + WS_WIN) + (size_t)layer * INC * D * 2;
#pragma unroll 1
    for (int mode = 0; mode < 2; ++mode) {
        fg::WinSched S{(const char*)(p.ws + WS_A), W, (int)gridDim.x, (int)((blockIdx.x + mode * 128) % gridDim.x), mode, mode == 0 ? 10 : (layer == 0 ? 26 : 10)};
        fg::EpiWin E{p.ws, p.in[14] + layer * 64, p.in[15] + layer * 64};
        fg::gemm_phase(lds, D, D, S, E);
    }
    {
        fg::PlainSched S{(const char*)(p.ws + WS_A8), (const char*)(p.ws + WS_WIN8) + (size_t)layer * 4096 * 1024, D / 2, D / 2, NLAT / 256, 16, (int)gridDim.x, (int)blockIdx.x, D / 128};
        fg::EpiGate8 E{p.ws + WS_G};
        fg::gemm_phase<fg::EpiGate8, fg::PlainSched, true>(lds, D / 2, D / 2, S, E);
    }
}

__device__ __forceinline__ void conv_item(const P& p, LAS unsigned char* lds, int layer, int seqid, int t0) {
    const int tid = threadIdx.x; LAS float* y = (LAS float*)lds;
    const int L = seqid < 2 ? SEQ : CTX; const int rbase = seqid < 2 ? seqid * SEQ : NLAT + (seqid - 2) * CTX;
    const bf16* cv = (const bf16*)(p.ws + WS_CONV);
    __syncthreads();
    u32x4 pa[6], pg[6];
#pragma unroll
    for (int i = 0; i < 6; ++i) { const int e = tid + i * NTHREADS, tt = e >> 5, c8 = (e & 31) * 8, t = t0 - 15 + tt;
        if (e < 94 * 32 && t >= 0 && t < L) { const bf16* rowp = cv + (size_t)(rbase + t) * 512 + c8; pa[i] = *(const u32x4*)rowp; pg[i] = *(const u32x4*)(rowp + 256); } }
#pragma unroll
    for (int i = 0; i < 6; ++i) { const int e = tid + i * NTHREADS; if (e >= 94 * 32) break; const int tt = e >> 5, c8 = (e & 31) * 8, t = t0 - 15 + tt;
        f32x4 lo = {0.f, 0.f, 0.f, 0.f}, hi = lo;
        if (t >= 0 && t < L) { const u32x4 a = pa[i], g = pg[i];
            lo = (f32x4){__uint_as_float(a.x << 16) * sigmoidf_(__uint_as_float(g.x << 16)), __uint_as_float(a.x & 0xffff0000u) * sigmoidf_(__uint_as_float(g.x & 0xffff0000u)),
                         __uint_as_float(a.y << 16) * sigmoidf_(__uint_as_float(g.y << 16)), __uint_as_float(a.y & 0xffff0000u) * sigmoidf_(__uint_as_float(g.y & 0xffff0000u))};
            hi = (f32x4){__uint_as_float(a.z << 16) * sigmoidf_(__uint_as_float(g.z << 16)), __uint_as_float(a.z & 0xffff0000u) * sigmoidf_(__uint_as_float(g.z & 0xffff0000u)),
                         __uint_as_float(a.w << 16) * sigmoidf_(__uint_as_float(g.w << 16)), __uint_as_float(a.w & 0xffff0000u) * sigmoidf_(__uint_as_float(g.w & 0xffff0000u))}; }
        *(LAS f32x4*)(y + tt * 256 + c8) = lo; *(LAS f32x4*)(y + tt * 256 + c8 + 4) = hi; }
    __syncthreads();
    {
        const int ch = tid & 255, half = tid >> 8;
        float w[31];
#pragma unroll
        for (int k = 0; k < 31; ++k) w[k] = p.in[17][(size_t)layer * 31 * 256 + k * 256 + ch];
        const float bias = p.in[18][layer * 256 + ch];
        float o[4][8];
#pragma unroll
        for (int u = 0; u < 4; ++u) { const int tb = (half * 4 + u) * 8;
            float in[38];
#pragma unroll
            for (int q = 0; q < 38; ++q) in[q] = y[(tb + q) * 256 + ch];
#pragma unroll
            for (int q = 0; q < 8; ++q) { float a = bias;
#pragma unroll
                for (int k = 0; k < 31; ++k) a += in[q + k] * w[k];
                o[u][q] = a; } }
        __syncthreads();
#pragma unroll
        for (int u = 0; u < 4; ++u)
#pragma unroll
            for (int q = 0; q < 8; ++q) y[((half * 4 + u) * 8 + q) * 256 + ch] = o[u][q];
    }
    __syncthreads();
    const int wv = tid >> 6, lane = tid & 63;
    const f32x4 g = *(const f32x4*)(p.in[19] + layer * 256 + lane * 4), bb = *(const f32x4*)(p.in[20] + layer * 256 + lane * 4);
    for (int q = 0; q < 8; ++q) { const int t = wv * 8 + q;
        const f32x4 v = *(const LAS f32x4*)(y + t * 256 + lane * 4);
        const float mu = wave_sum(v.x + v.y + v.z + v.w) * (1.f / 256.f);
        const f32x4 dv = v - mu; const float var = wave_sum(dv.x * dv.x + dv.y * dv.y + dv.z * dv.z + dv.w * dv.w) * (1.f / 256.f);
        const float rstd = rsqrtf(var + EPS);
        f32x4 z = dv * rstd * g + bb;
        u32x2 ov; ov.x = pk2(siluf_(z.x), siluf_(z.y)); ov.y = pk2(siluf_(z.z), siluf_(z.w));
        *(u32x2*)((bf16*)(p.ws + WS_X) + (size_t)(rbase + t0 + t) * 1536 + 1280 + lane * 4) = ov; }
}

__device__ __forceinline__ int chunk_row0(int b, int n) { return n < 2 ? NLAT + b * CTX + n * 128 : b * SEQ + (n - 2) * 128; }
__device__ __forceinline__ float log_sigmoid(float x) { return x >= 0.f ? -log1pf(expf(-x)) : x - log1pf(expf(x)); }
namespace rt {
typedef short bf16x8 __attribute__((ext_vector_type(8)));
constexpr int PQ = 72, PJ = 136;
__device__ __forceinline__ f32x4 mma(bf16x8 a, bf16x8 b, f32x4 c) { return __builtin_amdgcn_mfma_f32_16x16x32_bf16(a, b, c, 0, 0, 0); }
__device__ __forceinline__ bf16x8 frag(const LAS bf16* base, int row, int pitch, int k0, int lane) { return *(const LAS bf16x8*)(base + (row + (lane & 15)) * pitch + k0 + 8 * (lane >> 4)); }
}
__device__ __forceinline__ void ret_kv_item(const P& p, LAS unsigned char* lds, int layer, int it) {
    using namespace rt;
    const int tid = threadIdx.x, lane = tid & 63, w = tid >> 6; const int h = it & 3, n = (it >> 2) % NCHUNK, b = (it >> 2) / NCHUNK;
    LAS bf16* KTf = (LAS bf16*)lds; LAS bf16* KTb = KTf + 64 * PJ; LAS bf16* VT = KTb + 64 * PJ;
    const int r0 = chunk_row0(b, n);
    const float lgf = log_sigmoid(p.in[10][layer * 4 + h]), lgb = log_sigmoid(p.in[11][layer * 4 + h]);
    __syncthreads();
    { const int j = tid & 127, dq = (tid >> 7) * 16;
      const bf16* K = (const bf16*)(p.ws + WS_RETK) + (size_t)(r0 + j) * 256 + h * 64 + dq; const bf16* V = (const bf16*)(p.ws + WS_RETV) + (size_t)(r0 + j) * 256 + h * 64 + dq;
      const float zf = expf((127.f - j) * lgf), zb = expf((float)j * lgb);
#pragma unroll
      for (int q8 = 0; q8 < 2; ++q8) { const u32x4 kw = *(const u32x4*)(K + q8 * 8), vw = *(const u32x4*)(V + q8 * 8);
          const unsigned kk[4] = {kw.x, kw.y, kw.z, kw.w}, vv[4] = {vw.x, vw.y, vw.z, vw.w};
#pragma unroll
          for (int q = 0; q < 4; ++q) { const int d = dq + q8 * 8 + 2 * q; const float k0 = __uint_as_float(kk[q] << 16), k1 = __uint_as_float(kk[q] & 0xffff0000u);
              KTf[d * PJ + j] = f2bf(k0 * zf); KTf[(d + 1) * PJ + j] = f2bf(k1 * zf); KTb[d * PJ + j] = f2bf(k0 * zb); KTb[(d + 1) * PJ + j] = f2bf(k1 * zb);
              VT[d * PJ + j] = (bf16)(vv[q] & 0xffffu); VT[(d + 1) * PJ + j] = (bf16)(vv[q] >> 16); } } }
    __syncthreads();
    const int fb = w >> 2, dt = w & 3; const LAS bf16* Am = fb == 0 ? KTf : KTb;
    f32x4 acc[4];
#pragma unroll
    for (int et = 0; et < 4; ++et) acc[et] = (f32x4){0.f, 0.f, 0.f, 0.f};
#pragma unroll
    for (int ks = 0; ks < 4; ++ks) { const bf16x8 af = frag(Am, dt * 16, PJ, ks * 32, lane);
#pragma unroll
        for (int et = 0; et < 4; ++et) acc[et] = mma(af, frag(VT, et * 16, PJ, ks * 32, lane), acc[et]); }
    float* S = (float*)(p.ws + WS_RETS) + ((size_t)((fb * 2 + b) * NCHUNK + n) * 4 + h) * 4096;
#pragma unroll
    for (int et = 0; et < 4; ++et)
#pragma unroll
        for (int r = 0; r < 4; ++r) S[(dt * 16 + 4 * (lane >> 4) + r) * 64 + et * 16 + (lane & 15)] = acc[et][r];
}
__device__ __forceinline__ void ret_scan_item(const P& p, int layer, int it) {
    const int e = it * NTHREADS + threadIdx.x;
    const int de = e & 4095, h = (e >> 12) & 3, b = (e >> 14) & 1, dir = e >> 15;
    const float lg = log_sigmoid(p.in[dir == 0 ? 10 : 11][layer * 4 + h]); const float g = expf(128.f * lg);
    float* S = (float*)(p.ws + WS_RETS) + (size_t)((dir * 2 + b) * NCHUNK) * 4 * 4096 + (size_t)h * 4096 + de;
    float kv[NCHUNK];
#pragma unroll
    for (int n = 0; n < NCHUNK; ++n) kv[n] = S[(size_t)n * 4 * 4096];
    float st = 0.f;
    if (dir == 0) {
#pragma unroll
        for (int n = 0; n < NCHUNK; ++n) { const float t = kv[n]; kv[n] = st; st = st * g + t; }
    } else {
#pragma unroll
        for (int i = 0; i < NCHUNK; ++i) { const int n = i < 2 ? 1 - i : NCHUNK + 1 - i; const float t = kv[n]; kv[n] = st; st = st * g + t; }
    }
    float* S2 = (float*)(p.ws + WS_RETS2) + (size_t)((dir * 2 + b) * NCHUNK) * 4 * 4096 + (size_t)h * 4096 + de;
#pragma unroll
    for (int n = 0; n < NCHUNK; ++n) S2[(size_t)n * 4 * 4096] = kv[n];
}
__device__ __forceinline__ void ret_out_item(const P& p, LAS unsigned char* lds, int layer, int it) {
    using namespace rt;
    const int tid = threadIdx.x, lane = tid & 63, w = tid >> 6; const int h = it & 3, n = (it >> 2) % NCHUNK, b = (it >> 2) / NCHUNK;
    LAS bf16* Qs = (LAS bf16*)lds; LAS bf16* Ks = Qs + 128 * PQ; LAS bf16* VT = Ks + 128 * PQ; LAS bf16* Ps = VT + 64 * PJ; LAS bf16* SfT = Ps + 128 * PJ; LAS bf16* SbT = SfT + 64 * PQ;
    LAS float* pf = (LAS float*)(SbT + 64 * PQ); LAS float* pb = pf + 132;
    const int r0 = chunk_row0(b, n);
    const float lgf = log_sigmoid(p.in[10][layer * 4 + h]), lgb = log_sigmoid(p.in[11][layer * 4 + h]);
    const float* S = (const float*)(p.ws + WS_RETS2);
    const float* sfp = S + ((size_t)((0 * 2 + b) * NCHUNK + n) * 4 + h) * 4096; const float* sbp = S + ((size_t)((1 * 2 + b) * NCHUNK + n) * 4 + h) * 4096;
    __syncthreads();
    { const int j = tid >> 2, dq = (tid & 3) * 16;
      const bf16* Q = (const bf16*)(p.ws + WS_RETQ) + (size_t)(r0 + j) * 256 + h * 64 + dq; const bf16* K = (const bf16*)(p.ws + WS_RETK) + (size_t)(r0 + j) * 256 + h * 64 + dq;
      *(LAS u32x4*)(Qs + j * PQ + dq) = *(const u32x4*)Q; *(LAS u32x4*)(Qs + j * PQ + dq + 8) = *(const u32x4*)(Q + 8);
      *(LAS u32x4*)(Ks + j * PQ + dq) = *(const u32x4*)K; *(LAS u32x4*)(Ks + j * PQ + dq + 8) = *(const u32x4*)(K + 8); }
    { const int j = tid & 127, dq = (tid >> 7) * 16;
      const bf16* V = (const bf16*)(p.ws + WS_RETV) + (size_t)(r0 + j) * 256 + h * 64 + dq;
#pragma unroll
      for (int q8 = 0; q8 < 2; ++q8) { const u32x4 vw = *(const u32x4*)(V + q8 * 8); const unsigned vv[4] = {vw.x, vw.y, vw.z, vw.w};
#pragma unroll
          for (int q = 0; q < 4; ++q) { const int d = dq + q8 * 8 + 2 * q; VT[d * PJ + j] = (bf16)(vv[q] & 0xffffu); VT[(d + 1) * PJ + j] = (bf16)(vv[q] >> 16); } } }
    { const int d = tid & 63, e0 = (tid >> 6) * 8;
#pragma unroll
      for (int q4 = 0; q4 < 2; ++q4) { const f32x4 a = *(const f32x4*)(sfp + d * 64 + e0 + q4 * 4), c = *(const f32x4*)(sbp + d * 64 + e0 + q4 * 4);
#pragma unroll
          for (int q = 0; q < 4; ++q) { SfT[(e0 + q4 * 4 + q) * PQ + d] = f2bf(a[q]); SbT[(e0 + q4 * 4 + q) * PQ + d] = f2bf(c[q]); } } }
    if (tid <= 128) { pf[tid] = expf((float)tid * lgf); pb[tid] = expf((float)tid * lgb); }
    __syncthreads();
    { const bf16x8 a0 = frag(Qs, 16 * w, PQ, 0, lane), a1 = frag(Qs, 16 * w, PQ, 32, lane);
#pragma unroll
      for (int jt = 0; jt < 8; ++jt) { f32x4 c = (f32x4){0.f, 0.f, 0.f, 0.f};
          c = mma(a0, frag(Ks, jt * 16, PQ, 0, lane), c); c = mma(a1, frag(Ks, jt * 16, PQ, 32, lane), c);
          const int j = jt * 16 + (lane & 15);
#pragma unroll
          for (int r = 0; r < 4; ++r) { const int i = 16 * w + 4 * (lane >> 4) + r; const float dm = i > j ? pf[i - j] : (i < j ? pb[j - i] : 2.f); Ps[i * PJ + j] = f2bf(c[r] * dm); } } }
    __syncthreads();
    f32x4 aP[4], aF[4], aB[4];
#pragma unroll
    for (int et = 0; et < 4; ++et) { aP[et] = (f32x4){0.f, 0.f, 0.f, 0.f}; aF[et] = aP[et]; aB[et] = aP[et]; }
#pragma unroll
    for (int ks = 0; ks < 4; ++ks) { const bf16x8 af = frag(Ps, 16 * w, PJ, ks * 32, lane);
#pragma unroll
        for (int et = 0; et < 4; ++et) aP[et] = mma(af, frag(VT, et * 16, PJ, ks * 32, lane), aP[et]); }
#pragma unroll
    for (int ks = 0; ks < 2; ++ks) { const bf16x8 af = frag(Qs, 16 * w, PQ, ks * 32, lane);
#pragma unroll
        for (int et = 0; et < 4; ++et) { aF[et] = mma(af, frag(SfT, et * 16, PQ, ks * 32, lane), aF[et]); aB[et] = mma(af, frag(SbT, et * 16, PQ, ks * 32, lane), aB[et]); } }
    const float* rg = p.in[12] + layer * 256 + h * 64;
    const bf16* G = (const bf16*)(p.ws + WS_RETG) + (size_t)r0 * 256 + h * 64; bf16* X = (bf16*)(p.ws + WS_X) + (size_t)r0 * 1536 + 512 + h * 64;
    float gt[4][4];
#pragma unroll
    for (int r = 0; r < 4; ++r)
#pragma unroll
        for (int et = 0; et < 4; ++et) gt[r][et] = bf2f(G[(size_t)(16 * w + 4 * (lane >> 4) + r) * 256 + et * 16 + (lane & 15)]);
#pragma unroll
    for (int r = 0; r < 4; ++r) { const int i = 16 * w + 4 * (lane >> 4) + r; const float xf = pf[i + 1], xb = pb[128 - i];
        float o[4]; float ss = 0.f;
#pragma unroll
        for (int et = 0; et < 4; ++et) { o[et] = aP[et][r] + xf * aF[et][r] + xb * aB[et][r]; ss += o[et] * o[et]; }
        ss += __shfl_xor(ss, 1); ss += __shfl_xor(ss, 2); ss += __shfl_xor(ss, 4); ss += __shfl_xor(ss, 8);
        const float rstd = rsqrtf(ss * (1.f / 64.f) + EPS);
#pragma unroll
        for (int et = 0; et < 4; ++et) { const int e = et * 16 + (lane & 15); Ps[i * PJ + e] = f2bf(o[et] * rstd * rg[e] * siluf_(gt[r][et])); } }
    asm volatile("s_waitcnt lgkmcnt(0)" ::: "memory");
#pragma unroll
    for (int q = 0; q < 2; ++q) { const int c = lane + 64 * q, i = 16 * w + (c >> 3), e8 = (c & 7) * 8;
        *(u32x4*)(X + (size_t)i * 1536 + e8) = *(const LAS u32x4*)(Ps + i * PJ + e8); }
    __syncthreads();
}

#include <hip/hip_bf16.h>
#include <cmath>
namespace attn_body {
using bf16=__hip_bfloat16;
using bf16x8=__attribute__((ext_vector_type(8)))short;
using s16x4=__attribute__((ext_vector_type(4)))short;
using f32x16=__attribute__((ext_vector_type(16)))float;
using u32x4=__attribute__((ext_vector_type(4)))unsigned;
constexpr int D=64, QP=512, KP=128, OP=1536;
constexpr int NW=8,QBLK=32,QB=QBLK*NW,KVBLK=64;
__device__ __forceinline__ int crow(int r,int hi){return (r&3)+8*(r>>2)+4*hi;}
#define SBAR() __builtin_amdgcn_sched_barrier(0)
__device__ __forceinline__ void cmask(f32x16&p0,f32x16&p1,int jb,int qrel,int hi){
  const float NEG=-INFINITY; int kb=64*jb+4*hi;
  #pragma unroll
  for(int r=0;r<16;++r){int kv=kb+(r&3)+8*(r>>2); if(kv>qrel)p0[r]=NEG; if(kv+32>qrel)p1[r]=NEG;}
}

constexpr int NSLOT=3, SLOTB=8192;
constexpr int LDS_K=0, LDS_V=NSLOT*SLOTB, LDS_WS=2*NSLOT*SLOTB, LDS_OST=LDS_WS+NW*64*4, LDS_BYTES=LDS_OST+NW*4096;
constexpr float C2=0.125f*1.4426950408889634f;
__device__ __forceinline__ void glds16(const void*gsrc,unsigned lds_dst){unsigned keep;
  asm volatile("s_mov_b32 %0, m0\n\ts_mov_b32 m0, %2\n\ts_nop 0\n\tglobal_load_lds_dwordx4 %1, off\n\ts_mov_b32 m0, %0":"=&s"(keep):"v"(gsrc),"s"(lds_dst):"memory");}
__device__ __forceinline__ float max3f(float a,float b,float c){float r;asm("v_max3_f32 %0, %1, %2, %3":"=v"(r):"v"(a),"v"(b),"v"(c));return r;}
__device__ __forceinline__ float max2f(float a,float b){float r;asm("v_max_f32_e32 %0, %1, %2":"=v"(r):"v"(a),"v"(b));return r;}
__device__ __forceinline__ float fadd_s(float a,float b){float r;asm("v_add_f32_e32 %0, %1, %2":"=v"(r):"v"(a),"v"(b));return r;}
__device__ __forceinline__ float fsub_s(float a,float b){float r;asm("v_sub_f32_e32 %0, %1, %2":"=v"(r):"v"(a),"v"(b));return r;}
typedef float f32x2_t __attribute__((ext_vector_type(2))); typedef __bf16 bf16x2_t __attribute__((ext_vector_type(2)));
__device__ __forceinline__ unsigned cvtpk_s(float lo,float hi){f32x2_t v={lo,hi};bf16x2_t b=__builtin_convertvector(v,bf16x2_t);return __builtin_bit_cast(unsigned,b);}
#define WAIT_BAR(N) asm volatile("s_waitcnt vmcnt(" #N ") lgkmcnt(0)\n\ts_barrier":::"memory")

__device__ __forceinline__ void qkt(f32x16&p0,f32x16&p1,const char*Kslot,const bf16x8*qr,const f32x16&negm,int r32,int hi){
  const char*kb=Kslot+hi*1024+r32*16;
  #pragma unroll
  for(int d0=0;d0<4;++d0){
    const bf16x8 b0=*reinterpret_cast<const bf16x8*>(kb+d0*2048);
    const bf16x8 b1=*reinterpret_cast<const bf16x8*>(kb+d0*2048+512);
    if(d0==0){p0=__builtin_amdgcn_mfma_f32_32x32x16_bf16(b0,qr[0],negm,0,0,0);p1=__builtin_amdgcn_mfma_f32_32x32x16_bf16(b1,qr[0],negm,0,0,0);}
    else{p0=__builtin_amdgcn_mfma_f32_32x32x16_bf16(b0,qr[d0],p0,0,0,0);p1=__builtin_amdgcn_mfma_f32_32x32x16_bf16(b1,qr[d0],p1,0,0,0);}}
}
typedef __attribute__((address_space(3))) const char* lds_cptr;
typedef short v4i16_t __attribute__((ext_vector_type(4)));
__device__ __forceinline__ void kload8(bf16x8*kf,lds_cptr kp){
  kf[0]=*(const __attribute__((address_space(3))) bf16x8*)(kp);      kf[1]=*(const __attribute__((address_space(3))) bf16x8*)(kp+512);
  kf[2]=*(const __attribute__((address_space(3))) bf16x8*)(kp+2048); kf[3]=*(const __attribute__((address_space(3))) bf16x8*)(kp+2560);
  kf[4]=*(const __attribute__((address_space(3))) bf16x8*)(kp+4096); kf[5]=*(const __attribute__((address_space(3))) bf16x8*)(kp+4608);
  kf[6]=*(const __attribute__((address_space(3))) bf16x8*)(kp+6144); kf[7]=*(const __attribute__((address_space(3))) bf16x8*)(kp+6656);
}
__device__ __forceinline__ void kload2(bf16x8*kf,lds_cptr kp,int j){ kf[2*j]=*(const __attribute__((address_space(3))) bf16x8*)(kp+j*2048); kf[2*j+1]=*(const __attribute__((address_space(3))) bf16x8*)(kp+j*2048+512); }
__device__ __forceinline__ s16x4 vtr(lds_cptr p){ return __builtin_bit_cast(s16x4,__builtin_amdgcn_ds_read_tr16_b64_v4i16((__attribute__((address_space(3))) v4i16_t*)p)); }
__device__ __forceinline__ float rowmax(const f32x16&p0,const f32x16&p1){
  float a=max3f(p0[0],p0[1],p1[0]),b=max3f(p0[2],p0[3],p1[1]);a=max3f(a,p1[2],p1[3]);
  #pragma unroll
  for(int r=4;r<16;r+=4){a=max3f(a,p0[r],p0[r+1]);b=max3f(b,p0[r+2],p0[r+3]);a=max3f(a,p1[r],p1[r+1]);b=max3f(b,p1[r+2],p1[r+3]);}
  const float m=max2f(a,b);
  auto rr=__builtin_amdgcn_permlane32_swap(__float_as_uint(m),__float_as_uint(m),false,false);
  return max2f(__uint_as_float(rr[0]),__uint_as_float(rr[1]));
}
__device__ __forceinline__ void pv(f32x16*o,int vb,bf16x8 pa0,bf16x8 pa1,bf16x8 pa2,bf16x8 pa3){
  #pragma unroll
  for(int d0=0;d0<2;++d0){s16x4 lo[4],hi[4];
    #pragma unroll
    for(int ks=0;ks<4;++ks){
      asm volatile("ds_read_b64_tr_b16 %0,%1 offset:%c2":"=&v"(lo[ks]):"v"(vb),"i"(d0*4096+ks*1024):"memory");
      asm volatile("ds_read_b64_tr_b16 %0,%1 offset:%c2":"=&v"(hi[ks]):"v"(vb),"i"(d0*4096+ks*1024+512):"memory");}
    asm volatile("s_waitcnt lgkmcnt(0)":::"memory");SBAR();
    #define PK(k) (bf16x8){lo[k][0],lo[k][1],lo[k][2],lo[k][3],hi[k][0],hi[k][1],hi[k][2],hi[k][3]}
    o[d0]=__builtin_amdgcn_mfma_f32_32x32x16_bf16(pa0,PK(0),o[d0],0,0,0);
    o[d0]=__builtin_amdgcn_mfma_f32_32x32x16_bf16(pa1,PK(1),o[d0],0,0,0);
    o[d0]=__builtin_amdgcn_mfma_f32_32x32x16_bf16(pa2,PK(2),o[d0],0,0,0);
    o[d0]=__builtin_amdgcn_mfma_f32_32x32x16_bf16(pa3,PK(3),o[d0],0,0,0);
    #undef PK
  }
}

#ifndef ATTN_STORE16
#define ATTN_STORE16(p,v) (*(u32x4*)(p)=(v))
#endif
template<int THRL> __device__ __forceinline__ void attn_unit(const bf16*Q0,const bf16*__restrict__ Kh,const bf16*__restrict__ Vh,bf16*O0,const int NT,char*shm){
  const int tid=threadIdx.x,lane=tid&63,r32=lane&31,hi=lane>>5; const int wid=__builtin_amdgcn_readfirstlane(tid>>6);
  const bf16*Qw=Q0+(long)(wid*QBLK)*QP;
  const unsigned lds0=(unsigned)(uintptr_t)shm;
  float*wsf=(float*)(shm+LDS_WS)+wid*64;
  const bf16*ksrc=Kh+(long)lane*KP+wid*8;
  const bf16*vsrc=Vh+(long)(16*(wid&3)+(lane>>2))*KP+(wid>>2)*32+(lane&3)*8;
  const unsigned kdst=lds0+LDS_K+wid*1024, vdst=lds0+LDS_V+wid*1024;
  #define DMA_K(t,slot) glds16(ksrc+(long)(t)*KVBLK*KP,(unsigned)__builtin_amdgcn_readfirstlane(kdst+(slot)))
  #define DMA_V(t,slot) glds16(vsrc+(long)(t)*KVBLK*KP,(unsigned)__builtin_amdgcn_readfirstlane(vdst+(slot)))
  const int vb0=(int)(lds0+LDS_V)+((lane>>4)&1)*32+(lane&3)*8+(4*hi+((lane&15)>>2))*64;
  const char*Kbase=shm+LDS_K; bf16x8 kf[8];
  const lds_cptr shm3=(lds_cptr)shm; const lds_cptr kp0=shm3+LDS_K+hi*1024+r32*16; const lds_cptr vp0=shm3+LDS_V+((lane>>4)&1)*32+(lane&3)*8+(4*hi+((lane&15)>>2))*64;
  DMA_K(0,0);DMA_V(0,0);DMA_K(1,SLOTB);
  bf16x8 qr[4];
  #pragma unroll
  for(int d0=0;d0<4;++d0)qr[d0]=*reinterpret_cast<const bf16x8*>(&Qw[(long)r32*QP+d0*16+hi*8]);
  float mhat=0.f,l_reg=0.f;f32x16 o[2];o[0]=f32x16{};o[1]=f32x16{};f32x16 negm=f32x16{};asm volatile("":"+v"(negm));
  #define CMASK(P0,P1,t) do{}while(0)
  bool resc=false;
  #define START(P0,P1) do{ const float rm=rowmax(P0,P1); resc=false; \
    { const float dl=rm; mhat=fadd_s(mhat,dl); \
      _Pragma("unroll") for(int r=0;r<16;++r){P0[r]=fsub_s(P0[r],dl);P1[r]=fsub_s(P1[r],dl);} \
      _Pragma("unroll") for(int r=0;r<16;++r)negm[r]=-mhat; asm volatile("":"+v"(negm)); } \
    _Pragma("unroll") for(int r=0;r<16;++r)P0[r]=__builtin_amdgcn_exp2f(P0[r]); }while(0)
  #define RESC() do{ if(resc){ asm volatile("s_waitcnt lgkmcnt(0)":::"memory"); \
      _Pragma("unroll") for(int d_=0;d_<2;++d_) _Pragma("unroll") for(int r=0;r<16;++r)o[d_][r]*=wsf[crow(r,hi)]; } }while(0)
  f32x16 pA0,pA1,pB0,pB1;
  int sl_prev=0,sl_cur=0,sl_next=SLOTB;
  #define ROT() do{sl_prev=sl_cur;sl_cur=sl_next;sl_next=(sl_next==(NSLOT-1)*SLOTB)?0:sl_next+SLOTB;}while(0)
  DMA_K(2,2*SLOTB);
  WAIT_BAR(3);
  qkt(pA0,pA1,Kbase,qr,negm,r32,hi);asm volatile("s_nop 15\n\ts_nop 7":"+v"(pA0),"+v"(pA1));CMASK(pA0,pA1,0);
  START(pA0,pA1);
  _Pragma("unroll") for(int r=0;r<16;++r)pA1[r]=__builtin_amdgcn_exp2f(pA1[r]);
  WAIT_BAR(0);
  DMA_K(3,0);DMA_V(1,SLOTB);
  ROT();
  kload8(kf,kp0+sl_cur);
  WAIT_BAR(2);
  s16x4 vlo[8],vhi[8]; u32x4 pw0,pw1,pw2,pw3;
  #define PKW(P,B) cvtpk_s(P[B],P[B+1])
  #define PAF(k) __builtin_bit_cast(bf16x8,pw##k)
  #define VFR(i) (bf16x8){vlo[i][0],vlo[i][1],vlo[i][2],vlo[i][3],vhi[i][0],vhi[i][1],vhi[i][2],vhi[i][3]}
  #define PIN(x) asm volatile("":"+v"(x))
  #define MX3(a,b,c) __builtin_fmaxf(__builtin_fmaxf((a),(b)),(c))
  #define GAPA(MF,A0,A1,A2,A3,W0,W1,PW) do{ MF; sacc+=A0; sacc+=A1; sacc+=A2; sacc+=A3; PIN(sacc); W0; W1; PIN(PW); SBAR(); }while(0)
  #define EX(v) __builtin_amdgcn_exp2f(v)
  #define GAPB(MF,X,B) do{ MF; X[B]=EX(X[B]); X[B+1]=EX(X[B+1]); X[B+2]=EX(X[B+2]); X[B+3]=EX(X[B+3]); PIN(X); SBAR(); }while(0)
  #define VRD(i) do{ vlo[i]=vtr(vp_+(((i)>>2)*4096+((i)&3)*1024)); vhi[i]=vtr(vp_+(((i)>>2)*4096+((i)&3)*1024+512)); }while(0)
  #define KRD(G,j) do{ if(G){ kload2(kf,kp0+sl_next,j); SBAR(); } }while(0)
  #define STEP(C0,C1,P0,P1,t,GK,GV,GL) do{ SBAR(); \
    const lds_cptr vp_=vp0+sl_prev; \
    VRD(0); SBAR(); float sacc=(P0[0]+P0[1]); \
    GAPA(C0=__builtin_amdgcn_mfma_f32_32x32x16_bf16(kf[0],qr[0],negm,0,0,0), P0[2],P0[3],P0[4],P0[5],     pw0[0]=PKW(P0,0), pw0[1]=PKW(P0,2), pw0); \
    VRD(4); SBAR(); GAPA(C1=__builtin_amdgcn_mfma_f32_32x32x16_bf16(kf[1],qr[0],negm,0,0,0), P0[6],P0[7],P0[8],P0[9],     pw0[2]=PKW(P0,4), pw0[3]=PKW(P0,6), pw0); \
    VRD(1); SBAR(); GAPA(C0=__builtin_amdgcn_mfma_f32_32x32x16_bf16(kf[2],qr[1],C0,0,0,0),   P0[10],P0[11],P0[12],P0[13], pw1[0]=PKW(P0,8), pw1[1]=PKW(P0,10), pw1); \
    VRD(5); SBAR(); GAPA(C1=__builtin_amdgcn_mfma_f32_32x32x16_bf16(kf[3],qr[1],C1,0,0,0),   P0[14],P0[15],P1[0],P1[1],   pw1[2]=PKW(P0,12),pw1[3]=PKW(P0,14), pw1); \
    VRD(2); SBAR(); GAPA(C0=__builtin_amdgcn_mfma_f32_32x32x16_bf16(kf[4],qr[2],C0,0,0,0),   P1[2],P1[3],P1[4],P1[5],     pw2[0]=PKW(P1,0), pw2[1]=PKW(P1,2), pw2); \
    VRD(6); SBAR(); GAPA(C1=__builtin_amdgcn_mfma_f32_32x32x16_bf16(kf[5],qr[2],C1,0,0,0),   P1[6],P1[7],P1[8],P1[9],     pw2[2]=PKW(P1,4), pw2[3]=PKW(P1,6), pw2); \
    VRD(3); SBAR(); GAPA(C0=__builtin_amdgcn_mfma_f32_32x32x16_bf16(kf[6],qr[3],C0,0,0,0),   P1[10],P1[11],P1[12],P1[13], pw3[0]=PKW(P1,8), pw3[1]=PKW(P1,10), pw3); \
    VRD(7); SBAR(); GAPA(C1=__builtin_amdgcn_mfma_f32_32x32x16_bf16(kf[7],qr[3],C1,0,0,0),   P1[14],P1[15],0.f,0.f,       pw3[2]=PKW(P1,12),pw3[3]=PKW(P1,14), pw3); \
    l_reg+=sacc; \
    if(GK){DMA_K((t)+3,sl_cur);} if(GV){DMA_V((t)+1,sl_next);} \
    CMASK(C0,C1,t); \
    { float a=MX3(C0[0],C0[1],C1[0]),b=MX3(C0[2],C0[3],C1[1]); a=MX3(a,C1[2],C1[3]); \
      _Pragma("unroll") for(int r=4;r<16;r+=4){a=MX3(a,C0[r],C0[r+1]);b=MX3(b,C0[r+2],C0[r+3]);a=MX3(a,C1[r],C1[r+1]);b=MX3(b,C1[r+2],C1[r+3]);} \
      float rm=__builtin_fmaxf(a,b); { auto rr=__builtin_amdgcn_permlane32_swap(__float_as_uint(rm),__float_as_uint(rm),false,false); rm=__builtin_fmaxf(__uint_as_float(rr[0]),__uint_as_float(rr[1])); } \
      resc=false; \
      if(__builtin_expect(__any(rm>(float)THRL),0)){ const float dl=__builtin_fmaxf(rm,0.f); mhat+=dl; \
        _Pragma("unroll") for(int r=0;r<16;++r){C0[r]-=dl;C1[r]-=dl;} \
        _Pragma("unroll") for(int r=0;r<16;++r)negm[r]=-mhat; asm volatile("":"+v"(negm)); \
        const float f=__builtin_amdgcn_exp2f(-dl); l_reg*=f; if(hi==0)wsf[r32]=f; resc=true; } } \
    SBAR(); \
    GAPB(o[0]=__builtin_amdgcn_mfma_f32_32x32x16_bf16(PAF(0),VFR(0),o[0],0,0,0), C0,0); \
    GAPB(o[1]=__builtin_amdgcn_mfma_f32_32x32x16_bf16(PAF(0),VFR(4),o[1],0,0,0), C0,4); \
    KRD(GL,0); GAPB(o[0]=__builtin_amdgcn_mfma_f32_32x32x16_bf16(PAF(1),VFR(1),o[0],0,0,0), C0,8); \
    KRD(GL,1); GAPB(o[1]=__builtin_amdgcn_mfma_f32_32x32x16_bf16(PAF(1),VFR(5),o[1],0,0,0), C0,12); \
    KRD(GL,2); GAPB(o[0]=__builtin_amdgcn_mfma_f32_32x32x16_bf16(PAF(2),VFR(2),o[0],0,0,0), C1,0); \
    KRD(GL,3); GAPB(o[1]=__builtin_amdgcn_mfma_f32_32x32x16_bf16(PAF(2),VFR(6),o[1],0,0,0), C1,4); \
    GAPB(o[0]=__builtin_amdgcn_mfma_f32_32x32x16_bf16(PAF(3),VFR(3),o[0],0,0,0), C1,8); \
    GAPB(o[1]=__builtin_amdgcn_mfma_f32_32x32x16_bf16(PAF(3),VFR(7),o[1],0,0,0), C1,12); \
    }while(0)
  int t=1;
  #undef CMASK
  #define CMASK(P0,P1,t) do{}while(0)
  for(;t+5<NT;t+=2){
    STEP(pB0,pB1,pA0,pA1,t,true,true,true);     WAIT_BAR(2); RESC(); ROT();
    STEP(pA0,pA1,pB0,pB1,t+1,true,true,true);   WAIT_BAR(2); RESC(); ROT();
  }
  #undef CMASK
  #define CMASK(P0,P1,t) do{}while(0)
  #define ENDW(tt) do{ if((tt)+3<NT){WAIT_BAR(2);} else if((tt)+2<NT){WAIT_BAR(1);} else {WAIT_BAR(0);} }while(0)
  for(;t+1<NT;t+=2){
    STEP(pB0,pB1,pA0,pA1,t,(t+3<NT),(t+1<NT),(t+1<NT));       ENDW(t);   RESC(); ROT();
    STEP(pA0,pA1,pB0,pB1,t+1,(t+4<NT),(t+2<NT),(t+2<NT));     ENDW(t+1); RESC(); ROT();
  }
  STEP(pB0,pB1,pA0,pA1,NT-1,false,false,false); RESC();
  { float sacc=pB0[0]+pB0[1]; _Pragma("unroll") for(int r=2;r<16;++r)sacc+=pB0[r]; _Pragma("unroll") for(int r=0;r<16;++r)sacc+=pB1[r]; l_reg+=sacc;
    pw0=(u32x4){PKW(pB0,0),PKW(pB0,2),PKW(pB0,4),PKW(pB0,6)};pw1=(u32x4){PKW(pB0,8),PKW(pB0,10),PKW(pB0,12),PKW(pB0,14)};pw2=(u32x4){PKW(pB1,0),PKW(pB1,2),PKW(pB1,4),PKW(pB1,6)};pw3=(u32x4){PKW(pB1,8),PKW(pB1,10),PKW(pB1,12),PKW(pB1,14)};
    SBAR(); pv(o,vb0+sl_cur,PAF(0),PAF(1),PAF(2),PAF(3)); }
  #undef PKW
  #undef PAF
  #undef VFR
  #undef PIN
  #undef MX3
  #undef GAPA
  #undef GAPB
  #undef EX
  #undef VRD
  #undef KRD
  #undef STEP
  #undef ENDW
  {auto rr=__builtin_amdgcn_permlane32_swap(__float_as_uint(l_reg),__float_as_uint(l_reg),false,false);l_reg=__uint_as_float(rr[0])+__uint_as_float(rr[1]);}
  if(hi==0)wsf[32+r32]=l_reg;asm volatile("s_waitcnt lgkmcnt(0)":::"memory");
  float rli[16];
  #pragma unroll
  for(int r=0;r<16;++r)rli[r]=__builtin_amdgcn_rcpf(wsf[32+crow(r,hi)]);
  bf16*Ow=O0+(long)(wid*QBLK)*OP;
  { bf16*stg=(bf16*)(shm+LDS_OST)+wid*2048;
    #pragma unroll
    for(int r=0;r<16;++r){const int orow=crow(r,hi);
      #pragma unroll
      for(int d0=0;d0<2;++d0)stg[orow*64+d0*32+r32]=__float2bfloat16(o[d0][r]*rli[r]);}
    asm volatile("s_waitcnt lgkmcnt(0)":::"memory");
    #pragma unroll
    for(int i=0;i<4;++i){const int row=i*8+(lane>>3),ch=lane&7; const u32x4 v=*(const u32x4*)(stg+row*64+ch*8); ATTN_STORE16(Ow+(long)row*OP+ch*8,v);} }
  asm volatile("s_waitcnt lgkmcnt(0)\n\ts_barrier":::"memory");
  #undef DMA_K
  #undef DMA_V
  #undef CMASK
  #undef START
  #undef RESC
  #undef ROT
}
constexpr int ATTN_LDS_BYTES=LDS_BYTES;
#undef SBAR
#undef WAIT_BAR
}

__device__ __forceinline__ void attn_phase_run(const P& p, unsigned char* lds_generic, int layer) {
    typedef attn_body::bf16 abf;
    const int G = gridDim.x, bx = blockIdx.x, vcu = (G % 8 == 0) ? (bx % 8) * (G / 8) + bx / 8 : bx;
    const abf* Q = (const abf*)(p.ws + WS_ATTQ); const abf* K = (const abf*)(p.ws + WS_ATTK); const abf* V = (const abf*)(p.ws + WS_ATTV); abf* X = (abf*)(p.ws + WS_X);
    if (G == 256) {
        const int x = vcu >> 5, qb = vcu & 31, b = x >> 2, kvh = (x >> 1) & 1;
#pragma unroll 1
        for (int i = 0; i < 2; ++i) { const int h = kvh * 4 + 2 * (x & 1) + i; const long r0 = (long)b * SEQ + qb * 256;
            attn_body::attn_unit<8>(Q + r0 * 512 + h * 64, K + (long)b * KEYS * 128 + kvh * 64, V + (long)b * KEYS * 128 + kvh * 64, X + r0 * 1536 + 768 + h * 64, KEYS / 64, (char*)lds_generic); }
    } else {
#pragma unroll 1
        for (int u = vcu; u < 512; u += G) { const int qb = u & 31, h = (u >> 5) & 7, b = u >> 8, kvh = h >> 2; const long r0 = (long)b * SEQ + qb * 256;
            attn_body::attn_unit<8>(Q + r0 * 512 + h * 64, K + (long)b * KEYS * 128 + kvh * 64, V + (long)b * KEYS * 128 + kvh * 64, X + r0 * 1536 + 768 + h * 64, KEYS / 64, (char*)lds_generic); }
    }
    if (layer == 0) {
#pragma unroll 1
        for (int u = vcu; u < 16; u += G) { const int b = u >> 3, h = u & 7, kvh = h >> 2; const long r0 = NLAT + (long)b * CTX;
            attn_body::attn_unit<8>(Q + r0 * 512 + h * 64, K + (long)b * KEYS * 128 + kvh * 64, V + (long)b * KEYS * 128 + kvh * 64, X + r0 * 1536 + 768 + h * 64, CTX / 64, (char*)lds_generic); }
    }
}

__device__ __forceinline__ void ph_fft1(const P& p, LAS unsigned char* lds, int layer) {
    int nt2 = 2; asm volatile("" : "+s"(nt2));
    { fg::PlainSched S{(const char*)(p.ws + WS_F1), (const char*)(p.ws + WS_UT), 256, 256, 1, 128, (int)gridDim.x, (int)blockIdx.x, nt2};
      fg::EpiFft1 E{p.ws}; fg::gemm_phase(lds, 256, 256, S, E); }
    if (layer == 0) { fg::PlainSched S{(const char*)(p.ws + WS_FC), (const char*)(p.ws + WS_UTC), 256, 256, 2, 2, (int)gridDim.x, (int)((blockIdx.x + 128) % gridDim.x), 4};
      fg::EpiFftC E{p.ws}; fg::gemm_phase(lds, 256, 256, S, E); }
}
__device__ __forceinline__ void ph_fft3(const P& p, LAS unsigned char* lds) {
    int nt2 = 2; asm volatile("" : "+s"(nt2));
    fg::PlainSched S{(const char*)(p.ws + WS_F2), (const char*)(p.ws + WS_Z), 256, 256, 1, 256, (int)gridDim.x, (int)blockIdx.x, nt2};
    fg::EpiFft3 E{p.ws}; fg::gemm_phase(lds, 256, 256, S, E);
}
__device__ __forceinline__ void ph_mix1(const P& p, LAS unsigned char* lds, int layer) {
    ph_fft1(p, lds, layer);
    const int nconv = layer == 0 ? 264 : 256;
    const int n0 = nconv, n1 = n0 + NB * NCHUNK * 4;
    for (int it = gridDim.x - 1 - blockIdx.x; it < n1; it += gridDim.x) {
        if (it < n0) { if (it < 256) conv_item(p, lds, layer, it >> 7, (it & 127) * 64); else conv_item(p, lds, layer, 2 + ((it - 256) >> 2), ((it - 256) & 3) * 64); }
        else ret_kv_item(p, lds, layer, it - n0);
    }
    __syncthreads();
}
__device__ __forceinline__ void ph_mix2(const P& p, LAS unsigned char* lds, unsigned char* lds_generic, int layer) {
    for (int it = blockIdx.x; it < 128; it += gridDim.x) ret_scan_item(p, layer, it);
    __syncthreads();
    ph_fft3(p, lds);
    attn_phase_run(p, lds_generic, layer);
    __syncthreads();
}
__device__ __forceinline__ void ph_mix3(const P& p, LAS unsigned char* lds, int layer, bool ctxlater) {
    for (int it = blockIdx.x; it < NB * NCHUNK * 4; it += gridDim.x) {
        const int n = (it >> 2) % NCHUNK; if ((layer == 1 || ctxlater) && n < 2) continue;
        ret_out_item(p, lds, layer, it);
    }
    __syncthreads();
}
__device__ __forceinline__ void ctx_ret_items(const P& p, LAS unsigned char* lds) {
    const int u = blockIdx.x;
    if (u < 16) { const int b = u >> 3, n = (u >> 2) & 1, h = u & 3;
        ret_out_item(p, lds, 0, (b * NCHUNK + n) * 4 + h);
        asm volatile("s_waitcnt vmcnt(0)" ::: "memory"); __syncthreads();
        if (threadIdx.x == 0) { __builtin_amdgcn_fence(__ATOMIC_RELEASE, "agent");
            __hip_atomic_fetch_add((unsigned*)(p.ws + WS_CTL) + CW_CCNT + (8 * 3) * 16, 1u, __ATOMIC_RELAXED, __HIP_MEMORY_SCOPE_AGENT); }
        __syncthreads(); }
}
__device__ __forceinline__ void ctx_ret_wait(const P& p) {
    if (threadIdx.x == 0) { unsigned* c = (unsigned*)(p.ws + WS_CTL) + CW_CCNT + (8 * 3) * 16; unsigned* tmo = (unsigned*)(p.ws + WS_CTL) + CW_TMO; unsigned sp = 0u;
        while (__hip_atomic_load(c, __ATOMIC_RELAXED, __HIP_MEMORY_SCOPE_AGENT) < 16u) { __builtin_amdgcn_s_sleep(1);
            if ((++sp & 255u) == 0u) { if (__hip_atomic_load(tmo, __ATOMIC_RELAXED, __HIP_MEMORY_SCOPE_AGENT)) break; if (sp > (1u << 22)) { atomicAdd(tmo, 1u); break; } } }
        __builtin_amdgcn_fence(__ATOMIC_ACQUIRE, "agent"); }
    __syncthreads();
}

namespace sk {
typedef short bf16x8 __attribute__((ext_vector_type(8)));
__device__ __forceinline__ void tile64(LAS unsigned char* lds, const bf16* A, int lda, const bf16* Bt, int ldb, int K, float (&out)[8]) {
    const int tid = threadIdx.x, lane = tid & 63, w = tid >> 6, kc = K >> 3;
    const bf16* ap = A + (size_t)(lane & 15) * lda + w * kc + 8 * (lane >> 4); const bf16* bp = Bt + (size_t)(lane & 15) * ldb + w * kc + 8 * (lane >> 4);
    f32x4 acc[4][4];
#pragma unroll
    for (int i = 0; i < 4; ++i)
#pragma unroll
        for (int j = 0; j < 4; ++j) acc[i][j] = (f32x4){0.f, 0.f, 0.f, 0.f};
#pragma unroll 2
    for (int k0 = 0; k0 < kc; k0 += 32) {
        bf16x8 af[4], bfr[4];
#pragma unroll
        for (int i = 0; i < 4; ++i) { af[i] = *(const bf16x8*)(ap + (size_t)(16 * i) * lda + k0); bfr[i] = *(const bf16x8*)(bp + (size_t)(16 * i) * ldb + k0); }
#pragma unroll
        for (int i = 0; i < 4; ++i)
#pragma unroll
            for (int j = 0; j < 4; ++j) acc[i][j] = __builtin_amdgcn_mfma_f32_16x16x32_bf16(af[i], bfr[j], acc[i][j], 0, 0, 0);
    }
    LAS float* part = (LAS float*)lds;
    __syncthreads();
#pragma unroll
    for (int i = 0; i < 4; ++i)
#pragma unroll
        for (int j = 0; j < 4; ++j)
#pragma unroll
            for (int r = 0; r < 4; ++r) part[((w * 16 + i * 4 + j) * 4 + r) * 64 + lane] = acc[i][j][r];
    __syncthreads();
#pragma unroll
    for (int q = 0; q < 8; ++q) { float sacc = 0.f;
#pragma unroll
        for (int ww = 0; ww < 8; ++ww) sacc += part[ww * 4096 + tid + 512 * q];
        out[q] = sacc; }
}
__device__ __forceinline__ void tile64_f8(LAS unsigned char* lds, const unsigned char* A, int lda, const unsigned char* Bt, int ldb, int K, float (&out)[8]) {
    const int tid = threadIdx.x, lane = tid & 63, w = tid >> 6;
    const unsigned char* ap = A + (size_t)(lane & 15) * lda + 32 * (lane >> 4); const unsigned char* bp = Bt + (size_t)(lane & 15) * ldb + 32 * (lane >> 4);
    f32x4 acc[4][4];
#pragma unroll
    for (int i = 0; i < 4; ++i)
#pragma unroll
        for (int j = 0; j < 4; ++j) acc[i][j] = (f32x4){0.f, 0.f, 0.f, 0.f};
    for (int ks = w; ks * 128 < K; ks += 8) {
        fg::i32x8 af[4], bfr[4];
#pragma unroll
        for (int i = 0; i < 4; ++i) { af[i] = *(const fg::i32x8*)(ap + (size_t)(16 * i) * lda + ks * 128); bfr[i] = *(const fg::i32x8*)(bp + (size_t)(16 * i) * ldb + ks * 128); }
#pragma unroll
        for (int i = 0; i < 4; ++i)
#pragma unroll
            for (int j = 0; j < 4; ++j) acc[i][j] = __builtin_amdgcn_mfma_scale_f32_16x16x128_f8f6f4(af[i], bfr[j], acc[i][j], 0, 0, 0, 0x7f7f7f7f, 0, 0x7a7a7a7a);
    }
    LAS float* part = (LAS float*)lds;
    __syncthreads();
#pragma unroll
    for (int i = 0; i < 4; ++i)
#pragma unroll
        for (int j = 0; j < 4; ++j)
#pragma unroll
            for (int r = 0; r < 4; ++r) part[((w * 16 + i * 4 + j) * 4 + r) * 64 + lane] = acc[i][j][r];
    __syncthreads();
#pragma unroll
    for (int q = 0; q < 8; ++q) { float sacc = 0.f;
#pragma unroll
        for (int ww = 0; ww < 8; ++ww) sacc += part[ww * 4096 + tid + 512 * q];
        out[q] = sacc; }
}
__device__ __forceinline__ void elem_rc(int tid, int q, int& row, int& col) { const int e = tid + 512 * q, t16 = e >> 8, reg = (e >> 6) & 3, lane = e & 63; row = 16 * (t16 >> 2) + 4 * (lane >> 4) + reg; col = 16 * (t16 & 3) + (lane & 15); }
}
__device__ __forceinline__ void mini_merge_ctx(const P& p, LAS unsigned char* lds, int layer) {
    const bf16* X = (const bf16*)(p.ws + WS_X); const bf16* WB = (const bf16*)(p.ws + WS_WB) + (size_t)layer * 1024 * 1536; const unsigned char* G = (const unsigned char*)(p.ws + WS_G); bf16* Mg = (bf16*)(p.ws + WS_MERGED);
    for (int it = gridDim.x - 1 - blockIdx.x; it < (NCTX / 64) * 16; it += gridDim.x) { const int r0 = NLAT + (it >> 4) * 64, c0 = (it & 15) * 64;
        float tot[8];
#pragma unroll
        for (int q = 0; q < 8; ++q) tot[q] = 0.f;
#pragma unroll 1
        for (int br = 0; br < 4; ++br) { const int koff = br == 0 ? 0 : (br == 1 ? 512 : (br == 2 ? 768 : 1280)), klen = (br & 1) ? 256 : 512;
            float o[8]; sk::tile64(lds, X + (size_t)r0 * 1536 + koff, 1536, WB + (size_t)c0 * 1536 + koff, 1536, klen, o);
#pragma unroll
            for (int q = 0; q < 8; ++q) { int rr, cc; sk::elem_rc(threadIdx.x, q, rr, cc); tot[q] += o[q] * ((float)G[(size_t)(r0 + rr) * 4096 + br * 1024 + c0 + cc] * (1.f / 255.f)); } }
#pragma unroll
        for (int q = 0; q < 8; ++q) { int rr, cc; sk::elem_rc(threadIdx.x, q, rr, cc); Mg[(size_t)(r0 + rr) * 1024 + c0 + cc] = f2bf(tot[q]); } }
    __syncthreads();
}
__device__ __forceinline__ void mini_resid_ctx(const P& p, LAS unsigned char* lds, int layer, const bf16* A, int lda, const bf16* Bt, int K, int chunk, int xnorm = -1, int nlayer = 0, int nwhich = 0, const float* hsrc = nullptr) {
    const float* g = mods(p, layer, 2, chunk); float* hc = (float*)(p.ws + WS_HCTX); if (hsrc == nullptr) hsrc = hc;
    for (int it = gridDim.x - 1 - blockIdx.x; it < (NCTX / 64) * 16; it += gridDim.x) { const int rl = (it >> 4) * 64, c0 = (it & 15) * 64;
        float o[8]; sk::tile64(lds, A + (size_t)(NLAT + rl) * lda, lda, Bt + (size_t)c0 * K, K, K, o);
        if (xnorm < 0) {
#pragma unroll
            for (int q = 0; q < 8; ++q) { int rr, cc; sk::elem_rc(threadIdx.x, q, rr, cc); float* h = hc + (size_t)(rl + rr) * D + c0 + cc; *h = *h + g[c0 + cc] * o[q]; }
        } else {
#pragma unroll
            for (int q = 0; q < 8; ++q) { int rr, cc; sk::elem_rc(threadIdx.x, q, rr, cc); float* h = hc + (size_t)(rl + rr) * D + c0 + cc;
                __hip_atomic_store(h, hsrc[(size_t)(rl + rr) * D + c0 + cc] + g[c0 + cc] * o[q], __ATOMIC_RELAXED, __HIP_MEMORY_SCOPE_AGENT); }
            asm volatile("s_waitcnt vmcnt(0)" ::: "memory"); __syncthreads();
            if (threadIdx.x == 0) { unsigned* c = (unsigned*)(p.ws + WS_CTL) + CW_CCNT + (8 * xnorm + (it >> 4)) * 16; unsigned* tmo = (unsigned*)(p.ws + WS_CTL) + CW_TMO;
                __hip_atomic_fetch_add(c, 1u, __ATOMIC_RELAXED, __HIP_MEMORY_SCOPE_AGENT);
                unsigned sp = 0u;
                while (__hip_atomic_load(c, __ATOMIC_RELAXED, __HIP_MEMORY_SCOPE_AGENT) < 16u) { __builtin_amdgcn_s_sleep(1);
                    if ((++sp & 255u) == 0u) { if (__hip_atomic_load(tmo, __ATOMIC_RELAXED, __HIP_MEMORY_SCOPE_AGENT)) break; if (sp > (1u << 22)) { atomicAdd(tmo, 1u); break; } } }
                __builtin_amdgcn_fence(__ATOMIC_ACQUIRE, "agent"); }
            __syncthreads();
            { const int w = threadIdx.x >> 6, lane = threadIdx.x & 63;
              if (w < 4) norm_row(p, nlayer, nwhich, NLAT + rl + (it & 15) * 4 + w, lane); }
            __syncthreads();
        } }
    __syncthreads();
}
__device__ __forceinline__ void ph_merge(const P& p, LAS unsigned char* lds, int layer, int nrows) {
    fg::MergeSched S{(const char*)(p.ws + WS_X), (const char*)(p.ws + WS_WB) + (size_t)layer * 1024 * 1536 * 2, nrows / 256, (int)gridDim.x, (int)blockIdx.x};
    fg::EpiMerge E{(const unsigned char*)(p.ws + WS_G), (bf16*)(p.ws + WS_MERGED)};
    fg::gemm_phase(lds, 1536, 1536, S, E);
}
__device__ __forceinline__ void ph_gemm_resid(const P& p, LAS unsigned char* lds, int layer, const bf16* A, int lda, const bf16* Bt, int K, int chunk, int nrows) {
    fg::PlainSched S{(const char*)A, (const char*)Bt, lda, K, nrows / 256, 4, (int)gridDim.x, (int)blockIdx.x, K / 64};
    fg::EpiResid E{p.out, (float*)(p.ws + WS_HCTX), (const float*)(p.ws + WS_MODS) + (size_t)layer * 3 * 6144, chunk};
    fg::gemm_phase(lds, lda, K, S, E);
}
__device__ __forceinline__ void ph_gemm_resid_norm(const P& p, LAS unsigned char* lds, int layer, const bf16* A, int lda, const bf16* Bt, int K, int chunk, int x, int nlayer, int nwhich, const float* hin) {
    fg::PlainSched S{(const char*)A, (const char*)Bt, lda, K, NLAT / 256, 4, (int)gridDim.x, (int)blockIdx.x, K / 64};
    unsigned* ctl = (unsigned*)(p.ws + WS_CTL);
    fg::EpiResidNorm E{hin, p.out, (const float*)(p.ws + WS_MODS) + (size_t)layer * 3 * 6144, chunk,
        p.in[nwhich == 0 ? 6 : 7] + nlayer * D, (const float*)(p.ws + WS_MODS) + (size_t)nlayer * 3 * 6144, nwhich == 0 ? 0 : 3, nwhich == 0 ? 1 : 4, (bf16*)(p.ws + WS_A), nwhich == 0 ? p.ws + WS_A8 : (unsigned char*)nullptr,
        (float*)(p.ws + WS_CTL + CTL_XBUF) + (size_t)x * 65536, ctl + CW_PCNT + 64 * 16 * x, ctl + CW_TMO, lds};
    fg::gemm_phase(lds, lda, K, S, E);
}
__device__ __forceinline__ void ph_ffn1(const P& p, LAS unsigned char* lds) {
    fg::PlainSched S{(const char*)(p.ws + WS_A), (const char*)(p.ws + WS_FFN1), D, D, MROWS / 256, 22, (int)gridDim.x, (int)blockIdx.x, D / 64};
    fg::EpiSwiglu E{(bf16*)(p.ws + WS_HMID)};
    fg::gemm_phase(lds, D, D, S, E);
}
__device__ __forceinline__ int moe_tiles(const P& p, LAS int* tile_e) {
    const unsigned* ctl = (const unsigned*)(p.ws + WS_CTL); int t = 0;
    for (int e = 0; e < NEXP; ++e) { const int c = (int)ctl[CW_CNT + e], nt = (c + 255) >> 8; for (int q = 0; q < nt; ++q) { if (threadIdx.x == 0) tile_e[t + q] = e; } t += nt; }
    __syncthreads();
    return t;
}
__device__ __forceinline__ void ph_assign_gather(const P& p, LAS unsigned char* lds) {
    const int tid = threadIdx.x, bid = blockIdx.x, G = gridDim.x;
    LAS int* sbase = (LAS int*)lds;
    LAS int* stot = sbase + 8;
    LAS int* spst = stot + 8;
    LAS int* sexp = spst + 16;
    LAS int* sslot = sexp + 128;
    const unsigned* cntb = (const unsigned*)(p.ws + WS_ROUTE) + 16384 * 6;
    const int* tok_e = (const int*)(p.ws + WS_ROUTE); int* tok_slot = (int*)(p.ws + WS_ROUTE) + 16384 * 4;
    __syncthreads();
    { const int e = tid >> 6, l = tid & 63; int tot = 0, below = 0;
      for (int b = l; b < G; b += 64) { const int c = (int)cntb[b * NEXP + e]; tot += c; if (b < bid) below += c; }
#pragma unroll
      for (int o = 1; o < 64; o <<= 1) { tot += __shfl_xor(tot, o); below += __shfl_xor(below, o); }
      if (l == 0) { sbase[e] = below; stot[e] = tot; } }
    if (tid < 128) { const int li = tid >> 1, w = li & 7, k = li >> 3, tok = (bid * 8 + w) + k * (G * 8); sexp[tid] = tok < NLAT ? tok_e[tok * 2 + (tid & 1)] : -1; }
    __syncthreads();
    if (tid == 0) { int t = 0; for (int e = 0; e < NEXP; ++e) { spst[e] = t * 256; t += (stot[e] + 255) >> 8; } spst[NEXP] = t * 256;
        if (bid == 0) { unsigned* ctl = (unsigned*)(p.ws + WS_CTL); for (int e = 0; e < NEXP; ++e) ctl[CW_CNT + e] = (unsigned)stot[e]; } }
    __syncthreads();
    if (tid < 128) { const int e = sexp[tid]; int slot = -1;
        if (e >= 0) { int rank = 0; for (int a = 0; a < tid; ++a) rank += (sexp[a] == e) ? 1 : 0; slot = spst[e] + sbase[e] + rank;
            const int li = tid >> 1, w = li & 7, k = li >> 3, tok = (bid * 8 + w) + k * (G * 8); tok_slot[tok * 2 + (tid & 1)] = slot; }
        sslot[tid] = slot; }
    __syncthreads();
    const int lane = tid & 63, wv = tid >> 6; const unsigned char* A8 = p.ws + WS_A8; unsigned char* FS8 = p.ws + WS_FS;
    for (int a = wv; a < 128; a += 8) { const int slot = sslot[a]; if (slot < 0) continue; const int li = a >> 1, w = li & 7, k = li >> 3, tok = (bid * 8 + w) + k * (G * 8);
        *(u32x4*)(FS8 + (size_t)slot * D + lane * 16) = *(const u32x4*)(A8 + (size_t)tok * D + lane * 16); }
    { int idx = 0;
      for (int e = 0; e < NEXP; ++e) { const int lo_ = spst[e] + stot[e], hi_ = spst[e + 1];
          for (int r = lo_ + ((bid * 8 + wv - idx) % (G * 8) + (G * 8)) % (G * 8); r < hi_; r += G * 8) {
              *(u32x4*)(FS8 + (size_t)r * D + lane * 16) = (u32x4){0u, 0u, 0u, 0u}; }
          idx += hi_ - lo_; } }
    __syncthreads();
}
__device__ __forceinline__ void ph_moe1(const P& p, LAS unsigned char* lds) {
    LAS int* tile_e = (LAS int*)(lds + fg::STAGE_BYTES); const int nt = moe_tiles(p, tile_e);
    fg::ExpertSched S{(const char*)(p.ws + WS_FS), (const char*)(p.ws + WS_MOE1), D / 2, D / 2, nt, 22, (int)gridDim.x, (int)blockIdx.x, D / 128, tile_e, (size_t)5632 * D};
    fg::EpiSwiglu8 E{p.ws + WS_HMOE};
    fg::gemm_phase<fg::EpiSwiglu8, fg::ExpertSched, true>(lds, D / 2, D / 2, S, E);
}
__device__ __forceinline__ void ph_moe2(const P& p, LAS unsigned char* lds) {
    LAS int* tile_e = (LAS int*)(lds + fg::STAGE_BYTES); const int nt = moe_tiles(p, tile_e);
    const int nbig = nt < 128 ? nt : 128;
    fg::ExpertSched S{(const char*)(p.ws + WS_HMOE), (const char*)(p.ws + WS_MOE2), FFN / 2, FFN / 2, nbig, 4, (int)gridDim.x, (int)blockIdx.x, FFN / 128, tile_e, (size_t)D * FFN};
    fg::EpiStore E{(bf16*)(p.ws + WS_Y2), D};
    fg::gemm_phase<fg::EpiStore, fg::ExpertSched, true>(lds, FFN / 2, FFN / 2, S, E);
    const unsigned char* A = p.ws + WS_HMOE; bf16* Y = (bf16*)(p.ws + WS_Y2);
    for (int it = blockIdx.x; it < (nt - nbig) * 64; it += gridDim.x) {
        const int rt = nbig + (it >> 6), r0 = rt * 256 + ((it >> 4) & 3) * 64, c0 = (it & 15) * 64;
        const unsigned char* B = p.ws + WS_MOE2 + (size_t)tile_e[rt] * D * FFN;
        float o[8]; sk::tile64_f8(lds, A + (size_t)r0 * FFN, FFN, B + (size_t)c0 * FFN, FFN, FFN, o);
#pragma unroll
        for (int q = 0; q < 8; ++q) { int rr, cc; sk::elem_rc(threadIdx.x, q, rr, cc); Y[(size_t)(r0 + rr) * D + c0 + cc] = f2bf(o[q]); } }
    __syncthreads();
}
__device__ __forceinline__ void ph_combine(const P& p, int layer) {
    const int lane = threadIdx.x & 63, gw = blockIdx.x * 8 + (threadIdx.x >> 6), ngw = gridDim.x * 8;
    const float* tok_w = (const float*)(p.ws + WS_ROUTE) + 16384 * 2; const int* tok_slot = (const int*)(p.ws + WS_ROUTE) + 16384 * 4; const bf16* Y = (const bf16*)(p.ws + WS_Y2);
    for (int r = gw; r < NLAT; r += ngw) {
        const int s0 = tok_slot[r * 2], s1 = tok_slot[r * 2 + 1]; const float w0 = tok_w[r * 2], w1 = tok_w[r * 2 + 1];
        const float* g = mods(p, layer, row_mi(r), 5); float* h = p.out + (size_t)r * D;
#pragma unroll
        for (int j = 0; j < 4; ++j) { const int c = 4 * lane + 256 * j;
            const u32x2 a = *(const u32x2*)(Y + (size_t)s0 * D + c), bq = *(const u32x2*)(Y + (size_t)s1 * D + c); const f32x4 gg = *(const f32x4*)(g + c); f32x4 hv = *(f32x4*)(h + c);
            hv.x += gg.x * (w0 * __uint_as_float(a.x << 16) + w1 * __uint_as_float(bq.x << 16)); hv.y += gg.y * (w0 * __uint_as_float(a.x & 0xffff0000u) + w1 * __uint_as_float(bq.x & 0xffff0000u));
            hv.z += gg.z * (w0 * __uint_as_float(a.y << 16) + w1 * __uint_as_float(bq.y << 16)); hv.w += gg.w * (w0 * __uint_as_float(a.y & 0xffff0000u) + w1 * __uint_as_float(bq.y & 0xffff0000u));
            *(f32x4*)(h + c) = hv; }
    }
}

#define XB_TMO      128
static_assert(CW_TMO == CW_BAR + XB_TMO, "tmo word");
static_assert(CW_CCNT + 4 * 8 * 16 <= 16384, "all zero-initialised control words lie in the first 64 KiB");
#define XB_XCNT(j)  (256  + 64 * (j))
#define XB_XSUB(j)  (1280 + 64 * (j))
#define XB_XGEN(j)  (2304 + 64 * (j))
#define XB_TOP      3328
#define XB_TOPGEN   3392
#define XCD_BAR_WORDS 3456
#define XB_SPIN_CAP (1u << 22)
__device__ __forceinline__ unsigned xb_ld(unsigned* p)              { return __hip_atomic_load(p, __ATOMIC_RELAXED, __HIP_MEMORY_SCOPE_AGENT); }
__device__ __forceinline__ unsigned xb_add(unsigned* p, unsigned v) { return __hip_atomic_fetch_add(p, v, __ATOMIC_RELAXED, __HIP_MEMORY_SCOPE_AGENT); }
__device__ __forceinline__ unsigned xb_xcc_id() { return (unsigned)__builtin_amdgcn_s_getreg((3 << 11) | 20) & 0xFu; }
#define XB_SPIN(cond, bar) do { unsigned _sp = 0; while (cond) { __builtin_amdgcn_s_sleep(1); \
    if ((++_sp & 255u) == 0u) { if (xb_ld(&(bar)[XB_TMO])) break; if (_sp > XB_SPIN_CAP) { atomicAdd(&(bar)[XB_TMO], 1u); break; } } } } while (0)
struct XcdBarrier { unsigned* bar; unsigned x; volatile LAS unsigned* st; };
__device__ __forceinline__ XcdBarrier xcd_barrier_post(unsigned* bar, volatile LAS unsigned* st) {
    XcdBarrier b; b.bar = bar; b.x = xb_xcc_id(); b.st = st;
    if (threadIdx.x == 0) (void)xb_add(&bar[XB_XCNT(b.x)], 1u);
    return b;
}
__device__ __forceinline__ void xcd_barrier_complete(unsigned* bar, unsigned x, unsigned& nloc, unsigned& nx) {
    const unsigned G = gridDim.x * gridDim.y * gridDim.z;
    unsigned sum, cnt, mine, sp = 0u;
    for (;;) {
        sum = 0u; cnt = 0u; mine = 0u;
#pragma unroll
        for (unsigned j = 0; j < 16; ++j) { const unsigned c = xb_ld(&bar[XB_XCNT(j)]); sum += c; cnt += (c > 0u) ? 1u : 0u; mine = (j == x) ? c : mine; }
        if (sum == G) break;
        __builtin_amdgcn_s_sleep(1);
        if ((++sp & 255u) == 0u) { if (xb_ld(&bar[XB_TMO])) break; if (sp > XB_SPIN_CAP) { atomicAdd(&bar[XB_TMO], 1u); break; } }
    }
    nloc = mine > 0u ? mine : 1u; nx = cnt > 0u ? cnt : 1u;
}
__device__ __forceinline__ void xcd_barrier(const XcdBarrier& b) {
    asm volatile("s_waitcnt vmcnt(0)" ::: "memory");
    __syncthreads();
    if (threadIdx.x == 0) {
        unsigned* bar = b.bar;
        __builtin_amdgcn_s_waitcnt(0);
        unsigned nloc = b.st[0], nx = b.st[1];
        if (nloc == 0u) { xcd_barrier_complete(bar, b.x, nloc, nx); b.st[0] = nloc; b.st[1] = nx; }
        const unsigned old = xb_add(&bar[XB_XSUB(b.x)], 1u);
        const unsigned gen = old / nloc;
        if (old + 1u == (gen + 1u) * nloc) {
            __builtin_amdgcn_fence(__ATOMIC_RELEASE, "agent");
            asm volatile("s_waitcnt vmcnt(0)" ::: "memory");
            const unsigned og = xb_add(&bar[XB_TOP], 1u);
            const unsigned tg = og / nx;
            if (og + 1u == (tg + 1u) * nx) xb_add(&bar[XB_TOPGEN], 1u);
            else XB_SPIN(xb_ld(&bar[XB_TOPGEN]) == tg, bar);
            __builtin_amdgcn_fence(__ATOMIC_ACQUIRE, "agent");
            xb_add(&bar[XB_XGEN(b.x)], 1u);
            asm volatile("s_waitcnt vmcnt(0)" ::: "memory");
        } else {
            XB_SPIN(xb_ld(&bar[XB_XGEN(b.x)]) == gen, bar);
            asm volatile("buffer_inv sc0" ::: "memory");
            asm volatile("s_waitcnt vmcnt(0)" ::: "memory");
        }
    }
    __syncthreads();
}

constexpr int NPHASE = 23;
constexpr int LDS_BYTES = 150 * 1024;
__global__ void __launch_bounds__(NTHREADS, 2) mk(P p, int lo, int hi, int fuse) {
    extern __shared__ __attribute__((aligned(16))) unsigned char lds_raw[];
    LAS unsigned char* lds = (LAS unsigned char*)lds_raw;
    volatile LAS unsigned* misc = (volatile LAS unsigned*)(lds + LDS_BYTES - 64);
    if (threadIdx.x < 16) misc[threadIdx.x] = 0u;
    __syncthreads();
    XcdBarrier bar; bar.bar = (unsigned*)(p.ws + WS_CTL) + CW_BAR; bar.x = 0; bar.st = misc;
    if (hi - lo > 1) bar = xcd_barrier_post((unsigned*)(p.ws + WS_CTL) + CW_BAR, misc);
#if MK_SINGLE
    cg::this_grid().sync();
#endif
#ifndef PROBE_MASK
#define PROBE_MASK 0u
#endif
#ifndef AMP_A
#define AMP_A (-1)
#define AMP_B (-1)
#define AMP_MUL 15
#endif
#define AMP(k) do { if ((k) == AMP_A && blockIdx.x == 0 && threadIdx.x == 0) { const unsigned long long t = __builtin_amdgcn_s_memrealtime(); misc[8] = (unsigned)t; } \
    if ((k) == AMP_B && blockIdx.x == 0 && threadIdx.x == 0) { const unsigned t1 = (unsigned)__builtin_amdgcn_s_memrealtime(), dt = (t1 - misc[8]) * AMP_MUL; while ((unsigned)__builtin_amdgcn_s_memrealtime() - t1 < dt) __builtin_amdgcn_s_sleep(8); } } while (0)
#define PH(k, body) do { if (lo <= (k) && (k) < hi) { if ((k) > lo) { xcd_barrier(bar); } AMP(k); body; \
    if ((PROBE_MASK >> (k)) & 1u) { xcd_barrier(bar); body; } } } while (0)
#define LAYER_PHASES(L, base) \
    PH(base + 0, ph_win(p, lds, L)); \
    PH(base + 1, ph_mix1(p, lds, L)); \
    PH(base + 2, ph_mix2(p, lds, lds_raw, L)); \
    PH(base + 3, ph_mix3(p, lds, L, fuse != 0)); \
    PH(base + 4, { if (L == 0 && fuse) ctx_ret_items(p, lds); ph_merge(p, lds, L, NLAT); if (L == 0) { if (fuse && (int)(gridDim.x - 1 - blockIdx.x) < (NCTX / 64) * 16) ctx_ret_wait(p); mini_merge_ctx(p, lds, L); } }); \
    PH(base + 5, { if (L == 0 && fuse) { ph_gemm_resid_norm(p, lds, 0, (const bf16*)(p.ws + WS_MERGED), 1024, (const bf16*)(p.ws + WS_WOUT), D, 2, 0, 0, 1, p.in[0]); mini_resid_ctx(p, lds, 0, (const bf16*)(p.ws + WS_MERGED), 1024, (const bf16*)(p.ws + WS_WOUT), D, 2, 0, 0, 1, p.in[2]); } \
        else { ph_gemm_resid(p, lds, L, (const bf16*)(p.ws + WS_MERGED), 1024, (const bf16*)(p.ws + WS_WOUT) + (size_t)L * D * D, D, 2, NLAT); if (L == 0) mini_resid_ctx(p, lds, L, (const bf16*)(p.ws + WS_MERGED), 1024, (const bf16*)(p.ws + WS_WOUT), D, 2); } });
    PH(0, ph_prologue(p, lds));
    PH(1, ph_norm(p, lds, 0, 0, true, false, MROWS, !fuse));
    LAYER_PHASES(0, 2)
    if (!fuse) PH(8, ph_norm(p, lds, 0, 1, false, false, MROWS));
    PH(9, ph_ffn1(p, lds));
    PH(10, { if (fuse) { ph_gemm_resid_norm(p, lds, 0, (const bf16*)(p.ws + WS_HMID), FFN, (const bf16*)(p.ws + WS_FFN2), FFN, 5, 1, 1, 0, p.out); mini_resid_ctx(p, lds, 0, (const bf16*)(p.ws + WS_HMID), FFN, (const bf16*)(p.ws + WS_FFN2), FFN, 5, 1, 1, 0); }
        else { ph_gemm_resid(p, lds, 0, (const bf16*)(p.ws + WS_HMID), FFN, (const bf16*)(p.ws + WS_FFN2), FFN, 5, NLAT); mini_resid_ctx(p, lds, 0, (const bf16*)(p.ws + WS_HMID), FFN, (const bf16*)(p.ws + WS_FFN2), FFN, 5); } });
    if (!fuse) PH(11, ph_norm(p, lds, 1, 0, false, false, MROWS));
    LAYER_PHASES(1, 12)
    PH(18, ph_norm(p, lds, 1, 1, false, true, NLAT));
    PH(19, { ph_assign_gather(p, lds); ph_moe_convert(p, lds); });
    PH(20, ph_moe1(p, lds));
    PH(21, ph_moe2(p, lds));
    PH(22, ph_combine(p, 1));
#undef PH
#undef LAYER_PHASES
}

extern "C" void kernel_launch(void* const* d_in, const int* in_sizes, int n_in, void* d_out, int out_size, void* d_ws, size_t ws_size, hipStream_t stream) {
    static int grid = 0;
    if (grid == 0) {
        if (n_in != 30 || out_size != NLAT * D || ws_size < WS_END) { fprintf(stderr, "kernel_launch: unexpected shapes (n_in %d out %d ws %zu)\n", n_in, out_size, ws_size); grid = -1; return; }
        int dev = 0, cus = 0, per_cu = 0;
        hipGetDevice(&dev); hipDeviceGetAttribute(&cus, hipDeviceAttributeMultiprocessorCount, dev);
        hipFuncSetAttribute((const void*)mk, hipFuncAttributeMaxDynamicSharedMemorySize, LDS_BYTES);
        hipOccupancyMaxActiveBlocksPerMultiprocessor(&per_cu, (const void*)mk, NTHREADS, LDS_BYTES);
        if (per_cu < 1) { fprintf(stderr, "kernel_launch: occupancy query says %d blocks per CU\n", per_cu); grid = -1; return; }
        grid = cus;
    }
    if (grid < 0) return;
    hipMemsetAsync((char*)d_ws + WS_CTL, 0, 64 * 1024, stream);
    P p{};
    for (int i = 0; i < 30; ++i) p.in[i] = (const float*)d_in[i];
    p.out = (float*)d_out; p.ws = (unsigned char*)d_ws;
#if MK_SINGLE
    int lo = 0, hi = NPHASE, fuse = grid == 256 ? 1 : 0; void* args[] = {&p, &lo, &hi, &fuse};
    hipLaunchCooperativeKernel((const void*)mk, dim3(grid), dim3(NTHREADS), args, LDS_BYTES, stream);
#else
    for (int ph = 0; ph < NPHASE; ++ph) hipLaunchKernelGGL(mk, dim3(grid), dim3(NTHREADS), LDS_BYTES, stream, p, ph, ph + 1, 0);
#endif
}
```

```cpp
#include <hip/hip_runtime.h>
#include <hip/hip_cooperative_groups.h>
#include <cstdio>
#include <cstdint>
namespace cg = cooperative_groups;

#ifndef MK_SINGLE
#define MK_SINGLE 1
#endif

typedef unsigned short bf16;
typedef float f32x4 __attribute__((ext_vector_type(4)));
typedef unsigned u32x4 __attribute__((ext_vector_type(4)));
typedef unsigned u32x2 __attribute__((ext_vector_type(2)));
#define LAS __attribute__((address_space(3)))

constexpr int D = 1024, NB = 2, SEQ = 8192, CTX = 256, NLAT = NB * SEQ, NCTX = NB * CTX, MROWS = NLAT + NCTX;
constexpr int INC = 6656, FFN = 2816, NEXP = 8, KEYS = CTX + SEQ;
constexpr int NCHUNK = 66;
constexpr float EPS = 1e-6f;
constexpr float QSCALE = 0.125f * 1.4426950408889634f;
constexpr int MOE_ROWS = 34816;
constexpr int NTHREADS = 512;

constexpr size_t MiB = 1u << 20;
constexpr size_t WS_CTL = 0, CTL_BYTES = 1 * MiB;
constexpr size_t WS_MODS = 1 * MiB;
constexpr size_t WS_ROPE = 2 * MiB;
constexpr size_t WS_F1 = 4 * MiB;
constexpr size_t WS_F2 = WS_F1 + 131072;
constexpr size_t WS_FC = WS_F2 + 131072;
constexpr size_t WS_TW = WS_FC + 262144;
constexpr size_t WS_ROUTE = 5 * MiB;
constexpr size_t WS_HCTX = 6 * MiB;
constexpr size_t WS_WIN = 8 * MiB;
constexpr size_t WS_WB = 34 * MiB;
constexpr size_t WS_WOUT = 40 * MiB;
constexpr size_t WS_FFN1 = 44 * MiB;
constexpr size_t WS_FFN2 = 55 * MiB;
constexpr size_t WS_A = 61 * MiB;
constexpr size_t WS_X = 94 * MiB;
constexpr size_t WS_Y = 144 * MiB;
constexpr size_t WS_RETQ = WS_Y;
constexpr size_t WS_RETK = WS_RETQ + (size_t)MROWS * 256 * 2;
constexpr size_t WS_RETV = WS_RETK + (size_t)MROWS * 256 * 2;
constexpr size_t WS_RETG = WS_RETV + (size_t)MROWS * 256 * 2;
constexpr size_t WS_ATTQ = WS_Y + 33 * MiB;
constexpr size_t WS_ATTK = WS_Y + 50 * MiB;
constexpr size_t WS_ATTV = WS_Y + 55 * MiB;
constexpr size_t WS_CONV = WS_Y + 60 * MiB;
constexpr size_t WS_UT = WS_Y + 77 * MiB;
constexpr size_t WS_UTC = WS_Y + 93 * MiB;
constexpr size_t WS_Z = WS_Y + 94 * MiB;
constexpr size_t WS_RETS = WS_Y + 126 * MiB;
constexpr size_t WS_MERGED = WS_Y + 143 * MiB;
constexpr size_t WS_G = 320 * MiB;
constexpr size_t WS_MOE1 = WS_G;
constexpr size_t WS_MOE2 = WS_G + (size_t)NEXP * 5632 * 1024 * 2;
constexpr size_t WS_HMID = WS_Y;
constexpr size_t WS_HMOE = 61 * MiB;
constexpr size_t WS_FS = 252 * MiB;
constexpr size_t WS_A8 = 386 * MiB;
constexpr size_t WS_WIN8 = 430 * MiB;
constexpr size_t WS_RETS2 = 452 * MiB;
constexpr size_t WS_Y2 = 160 * MiB;
constexpr size_t WS_END = 469 * MiB;
static_assert(WS_MERGED + (size_t)MROWS * 1024 * 2 <= WS_G, "map");
static_assert(WS_HMOE + (size_t)MOE_ROWS * FFN * 2 <= WS_FS && WS_FS + (size_t)MOE_ROWS * 1024 * 2 <= WS_G, "map moe");
static_assert(WS_MOE2 + (size_t)NEXP * 1024 * FFN * 2 <= WS_END, "map moe w");
static_assert(WS_G + (size_t)MROWS * 4096 <= WS_A8 && WS_A8 + (size_t)NLAT * 1024 <= WS_MOE2 && WS_MOE2 + (size_t)NEXP * 1024 * FFN <= WS_WIN8 && WS_WIN8 + (size_t)2 * 4096 * 1024 <= WS_RETS2, "map fp8 w_in");
constexpr int CW_CNT = 64;
constexpr int CW_CUR = 128;
constexpr int CW_BAR = 4096;
constexpr int CW_TMO = CW_BAR + 128;
constexpr int CW_PCNT = 8192;
constexpr int CW_CCNT = 8192 + 4 * 64 * 16;
constexpr size_t CTL_XBUF = 128 * 1024;

struct P {
    const float* in[30];
    float* out;
    unsigned char* ws;
};

__device__ __forceinline__ float bf2f(bf16 v) { return __uint_as_float((unsigned)v << 16); }
__device__ __forceinline__ bf16 f2bf(float f) { unsigned u = __float_as_uint(f); return (bf16)((u + 0x7fffu + ((u >> 16) & 1u)) >> 16); }
__device__ __forceinline__ unsigned pk2(float lo, float hi) { return (unsigned)f2bf(lo) | ((unsigned)f2bf(hi) << 16); }
__device__ __forceinline__ float sigmoidf_(float x) { return 1.f / (1.f + __expf(-x)); }
__device__ __forceinline__ float siluf_(float x) { return x / (1.f + __expf(-x)); }
__device__ __forceinline__ float sigmoid_fast(float x) { return __builtin_amdgcn_rcpf(1.f + __builtin_amdgcn_exp2f(-1.4426950408889634f * x)); }
__device__ __forceinline__ float silu_fast(float x) { return x * __builtin_amdgcn_rcpf(1.f + __builtin_amdgcn_exp2f(-1.4426950408889634f * x)); }
__device__ __forceinline__ float wave_sum(float v) {
#pragma unroll
    for (int o = 1; o < 64; o <<= 1) v += __shfl_xor(v, o);
    return v;
}
__device__ __forceinline__ int row_mi(int r) { return r < NLAT ? (r >> 13) : 2; }
__device__ __forceinline__ float* hrow(const P& p, int r) { return r < NLAT ? p.out + (size_t)r * D : (float*)(p.ws + WS_HCTX) + (size_t)(r - NLAT) * D; }
__device__ __forceinline__ const float* mods(const P& p, int layer, int mi, int chunk) { return (const float*)(p.ws + WS_MODS) + ((size_t)(layer * 3 + mi) * 6 + chunk) * D; }

__device__ __forceinline__ int rowmap(int mode, int n) {
    if (mode == 0) return n;
    if (mode == 1 || mode == 2) return 8 * (n >> 2) + (n & 3) + (mode == 2 ? 4 : 0);
    const int tile = n >> 8, l = n & 255, head = l >> 6, d = l & 63;
    const bool ropet = tile == 1 || tile == 2 || tile == 5 || tile == 6 || (tile == 7 && head < 2);
    if (ropet) { const int i = d & 31, nn = d >> 5; return tile * 256 + 128 * (i >> 4) + 32 * head + 8 * ((i >> 2) & 3) + 4 * nn + (i & 3); }
    if (tile == 7) return tile * 256 + 128 * (d >> 5) + 32 * head + 8 * ((d >> 3) & 3) + (d & 7);
    return n;
}
__device__ __forceinline__ void conv_tile(LAS float* scr, const float* src, int ldn, int k0, int n0, bf16* dst, int ldd, int koff, int mode) {
    const int tid = threadIdx.x;
    __syncthreads();
#pragma unroll
    for (int i = 0; i < 8; ++i) { const int e = tid + i * NTHREADS, kk = e >> 6, nn = e & 63; scr[kk * 65 + nn] = src[(size_t)(k0 + kk) * ldn + n0 + nn]; }
    __syncthreads();
    const int nn = tid >> 3, kc = (tid & 7) * 8;
    u32x4 o; o.x = pk2(scr[(kc + 0) * 65 + nn], scr[(kc + 1) * 65 + nn]); o.y = pk2(scr[(kc + 2) * 65 + nn], scr[(kc + 3) * 65 + nn]);
    o.z = pk2(scr[(kc + 4) * 65 + nn], scr[(kc + 5) * 65 + nn]); o.w = pk2(scr[(kc + 6) * 65 + nn], scr[(kc + 7) * 65 + nn]);
    *(u32x4*)(dst + (size_t)rowmap(mode, n0 + nn) * ldd + koff + k0 + kc) = o;
}
constexpr float F8_WSCALE = 32.f;
__device__ __forceinline__ unsigned pk4_fp8(float a, float b, float c, float d) { int w = 0; w = __builtin_amdgcn_cvt_pk_fp8_f32(a, b, w, false); w = __builtin_amdgcn_cvt_pk_fp8_f32(c, d, w, true); return (unsigned)w; }
__device__ __forceinline__ void conv_tile2_f8(LAS float* scr, const float* src, int ldn, unsigned char* dst8, int ldd, int mode, int k0a, int n0a, int k0b, int n0b, bool two) {
    const int tid = threadIdx.x;
    f32x4 va[2], vb[2];
#pragma unroll
    for (int i = 0; i < 2; ++i) { const int e = tid + i * NTHREADS, kk = e >> 4, n4 = (e & 15) * 4;
        va[i] = *(const f32x4*)(src + (size_t)(k0a + kk) * ldn + n0a + n4);
        if (two) vb[i] = *(const f32x4*)(src + (size_t)(k0b + kk) * ldn + n0b + n4); }
    __syncthreads();
#pragma unroll
    for (int i = 0; i < 2; ++i) { const int e = tid + i * NTHREADS, kk = e >> 4, n4 = (e & 15) * 4;
#pragma unroll
        for (int q = 0; q < 4; ++q) { scr[kk * 65 + n4 + q] = va[i][q]; if (two) scr[64 * 65 + kk * 65 + n4 + q] = vb[i][q]; } }
    __syncthreads();
    const int nn = tid >> 3, kc = (tid & 7) * 8;
#pragma unroll
    for (int t = 0; t < 2; ++t) { if (t == 1 && !two) break; const LAS float* sp = scr + t * 64 * 65; const int k0 = t ? k0b : k0a, n0 = t ? n0b : n0a;
        u32x2 o; o.x = pk4_fp8(sp[(kc + 0) * 65 + nn] * F8_WSCALE, sp[(kc + 1) * 65 + nn] * F8_WSCALE, sp[(kc + 2) * 65 + nn] * F8_WSCALE, sp[(kc + 3) * 65 + nn] * F8_WSCALE);
        o.y = pk4_fp8(sp[(kc + 4) * 65 + nn] * F8_WSCALE, sp[(kc + 5) * 65 + nn] * F8_WSCALE, sp[(kc + 6) * 65 + nn] * F8_WSCALE, sp[(kc + 7) * 65 + nn] * F8_WSCALE);
        *(u32x2*)(dst8 + (size_t)rowmap(mode, n0 + nn) * ldd + k0 + kc) = o; }
}
__device__ __forceinline__ void conv_tile128_f8(LAS float* scr, const float* src, int ldn, unsigned char* dst8, int ldd, int mode, int k0, int n0) {
    const int tid = threadIdx.x;
    f32x4 v[8];
#pragma unroll
    for (int i = 0; i < 8; ++i) { const int e = tid + i * NTHREADS, kk = e >> 5, n4 = (e & 31) * 4; v[i] = *(const f32x4*)(src + (size_t)(k0 + kk) * ldn + n0 + n4); }
    __syncthreads();
#pragma unroll
    for (int i = 0; i < 8; ++i) { const int e = tid + i * NTHREADS, kk = e >> 5, n4 = (e & 31) * 4;
#pragma unroll
        for (int q = 0; q < 4; ++q) scr[kk * 129 + n4 + q] = v[i][q]; }
    __syncthreads();
    const int nn = tid >> 2, kc = (tid & 3) * 32;
    u32x4 o[2];
#pragma unroll
    for (int h = 0; h < 2; ++h) { const LAS float* sp = scr + (kc + h * 16) * 129 + nn;
        o[h].x = pk4_fp8(sp[0] * F8_WSCALE, sp[129] * F8_WSCALE, sp[2 * 129] * F8_WSCALE, sp[3 * 129] * F8_WSCALE);
        o[h].y = pk4_fp8(sp[4 * 129] * F8_WSCALE, sp[5 * 129] * F8_WSCALE, sp[6 * 129] * F8_WSCALE, sp[7 * 129] * F8_WSCALE);
        o[h].z = pk4_fp8(sp[8 * 129] * F8_WSCALE, sp[9 * 129] * F8_WSCALE, sp[10 * 129] * F8_WSCALE, sp[11 * 129] * F8_WSCALE);
        o[h].w = pk4_fp8(sp[12 * 129] * F8_WSCALE, sp[13 * 129] * F8_WSCALE, sp[14 * 129] * F8_WSCALE, sp[15 * 129] * F8_WSCALE); }
    unsigned char* d = dst8 + (size_t)rowmap(mode, n0 + nn) * ldd + k0 + kc;
    *(u32x4*)d = o[0]; *(u32x4*)(d + 16) = o[1];
}
__device__ __forceinline__ void conv_tile4(LAS float* scr, const float* src, int ldn, int nn, int cnt, int i, int st, bf16* dst, int ldd, int koff, int mode) {
    const int tid = threadIdx.x, kk = tid >> 4, n4 = (tid & 15) * 4;
    f32x4 v[4][2];
#pragma unroll
    for (int t = 0; t < 4; ++t) { const int it = i + t * st; if (it < cnt) { const int k0 = (it / nn) * 64, n0 = (it % nn) * 64;
#pragma unroll
        for (int h = 0; h < 2; ++h) v[t][h] = *(const f32x4*)(src + (size_t)(k0 + kk + 32 * h) * ldn + n0 + n4); } }
    __syncthreads();
#pragma unroll
    for (int t = 0; t < 4; ++t) if (i + t * st < cnt) {
#pragma unroll
        for (int h = 0; h < 2; ++h)
#pragma unroll
            for (int q = 0; q < 4; ++q) scr[t * 64 * 65 + (kk + 32 * h) * 65 + n4 + q] = v[t][h][q]; }
    __syncthreads();
    const int nr = tid >> 3, kc = (tid & 7) * 8;
#pragma unroll
    for (int t = 0; t < 4; ++t) { const int it = i + t * st; if (it < cnt) { const int k0 = (it / nn) * 64, n0 = (it % nn) * 64; const LAS float* sp = scr + t * 64 * 65;
        u32x4 o; o.x = pk2(sp[(kc + 0) * 65 + nr], sp[(kc + 1) * 65 + nr]); o.y = pk2(sp[(kc + 2) * 65 + nr], sp[(kc + 3) * 65 + nr]);
        o.z = pk2(sp[(kc + 4) * 65 + nr], sp[(kc + 5) * 65 + nr]); o.w = pk2(sp[(kc + 6) * 65 + nr], sp[(kc + 7) * 65 + nr]);
        *(u32x4*)(dst + (size_t)rowmap(mode, n0 + nr) * ldd + koff + k0 + kc) = o; } }
}
struct CJob { const float* src; int K, N; bf16* dst; int ldd, koff, mode, ldn; };
__device__ __forceinline__ CJob get_job(const P& p, int j) {
    CJob c;
    if (j < 10) { const int l = j / 5, t = j % 5; bf16* wb = (bf16*)(p.ws + WS_WB) + (size_t)l * 1024 * 1536;
        if (t == 0) c = CJob{p.in[8] + (size_t)l * D * INC, D, l == 0 ? INC : 2560, (bf16*)(p.ws + WS_WIN) + (size_t)l * INC * D, D, 0, 3, INC};
        else if (t == 1) c = CJob{p.in[13] + (size_t)l * 256 * D, 256, D, wb, 1536, 512, 0};
        else if (t == 2) c = CJob{p.in[16] + (size_t)l * 512 * D, 512, D, wb, 1536, 768, 0};
        else if (t == 3) c = CJob{p.in[21] + (size_t)l * 256 * D, 256, D, wb, 1536, 1280, 0};
        else c = CJob{p.in[22] + (size_t)l * D * D, D, D, (bf16*)(p.ws + WS_WOUT) + (size_t)l * D * D, D, 0, 0}; }
    else if (j == 10) c = CJob{p.in[23], D, FFN, (bf16*)(p.ws + WS_FFN1), D, 0, 1};
    else if (j == 11) c = CJob{p.in[24], D, FFN, (bf16*)(p.ws + WS_FFN1), D, 0, 2};
    else c = CJob{p.in[25], FFN, D, (bf16*)(p.ws + WS_FFN2), FFN, 0, 0};
    return c;
}
__device__ __forceinline__ CJob get_moe_job(const P& p, int j) {
    const int e = j / 3, t = j % 3; CJob c;
    const float* sg = p.in[27]; const float* su = p.in[28]; const float* sd = p.in[29];
    asm volatile("" : "+s"(sg), "+s"(su), "+s"(sd));
    if (t == 0) c = CJob{sg + (size_t)e * D * FFN, D, FFN, (bf16*)(p.ws + WS_MOE1 + (size_t)e * 5632 * D), D, 0, 1};
    else if (t == 1) c = CJob{su + (size_t)e * D * FFN, D, FFN, (bf16*)(p.ws + WS_MOE1 + (size_t)e * 5632 * D), D, 0, 2};
    else c = CJob{sd + (size_t)e * FFN * D, FFN, D, (bf16*)(p.ws + WS_MOE2 + (size_t)e * D * FFN), FFN, 0, 0};
    return c;
}
template <bool MOE> __device__ __forceinline__ void run_conv_jobs(const P& p, LAS float* scr, int njobs, int bid, int nb) {
    int base = 0, base2 = 0;
    for (int j = 0; j < njobs; ++j) {
        const CJob jb = MOE ? get_moe_job(p, j) : get_job(p, j); const int nn = jb.N / 64, cnt = (jb.K / 64) * nn, ldn = jb.ldn ? jb.ldn : jb.N;
        const int first = ((bid - base) % nb + nb) % nb;
        if (MOE) { const int nn2 = jb.N / 128, cnt2 = (jb.K / 128) * nn2; const int first2 = ((bid - base2) % nb + nb) % nb;
            for (int i = first2; i < cnt2; i += nb) conv_tile128_f8(scr, jb.src, jb.N, (unsigned char*)jb.dst, jb.ldd, jb.mode, (i / nn2) * 128, (i % nn2) * 128);
            base2 += cnt2; }
        else for (int i = first; i < cnt; i += 4 * nb) conv_tile4(scr, jb.src, ldn, nn, cnt, i, nb, jb.dst, jb.ldd, jb.koff, jb.mode);
        base += cnt;
    }
}
__device__ __forceinline__ void ph_prologue(const P& p, LAS unsigned char* lds) {
    const int tid = threadIdx.x, bid = blockIdx.x, nb = gridDim.x;
    const int gt = bid * NTHREADS + tid, ngt = nb * NTHREADS;
    LAS float* scr = (LAS float*)lds;
    run_conv_jobs<false>(p, scr, 13, bid, nb);
    __syncthreads();
    for (int i = bid; i < 512; i += nb) { const int l = i >> 8, t = i & 255;
        conv_tile128_f8(scr, p.in[8] + (size_t)l * D * INC + 2560, INC, p.ws + WS_WIN8 + (size_t)l * 4096 * 1024, 1024, 0, (t >> 5) * 128, (t & 31) * 128); }
    __syncthreads();
    {
        LAS float* tc = (LAS float*)lds; LAS float* tsn = tc + 64;
        __syncthreads();
        if (tid < 64) { tc[tid] = cospif(tid * (2.f / 64.f)); tsn[tid] = sinpif(tid * (2.f / 64.f)); }
        __syncthreads();
        const float s = 1.0f / sqrtf(64.f * 8192.f);
        for (int e = gt; e < 2 * 4 * 16 * 1024; e += ngt) {
            const int n = e & 1023, cq = (e >> 10) & 15, g = (e >> 14) & 3, l = e >> 16;
            const float* W = p.in[9] + (size_t)l * 256 * D + (size_t)(g * 64) * D + n;
            float w[64];
#pragma unroll
            for (int c2 = 0; c2 < 64; ++c2) w[c2] = W[(size_t)c2 * D];
            bf16* o = (bf16*)(p.ws + WS_WB) + (size_t)l * 1024 * 1536 + (size_t)n * 1536 + g * 64;
#pragma unroll
            for (int ci = 0; ci < 4; ++ci) { const int c = cq * 4 + ci; float re = 0.f, im = 0.f;
                const float cr = tc[c], sr = tsn[c]; float tr = 1.f, ti = 0.f;
#pragma unroll
                for (int c2 = 0; c2 < 64; ++c2) { re += tr * w[c2]; im -= ti * w[c2]; const float nr = tr * cr - ti * sr; ti = tr * sr + ti * cr; tr = nr; }
                o[c] = f2bf(re * s); o[256 + c] = f2bf(im * s); }
        }
        __syncthreads();
    }
    {
        float* rc = (float*)(p.ws + WS_ROPE); float* rs = rc + SEQ * 32;
        for (int e = gt; e < SEQ * 32; e += ngt) {
            const int s = e >> 5, i = e & 31; const float inv = powf(10000.f, -(float)(i & 15) / 16.f);
            const float pos = (float)(i < 16 ? (s >> 6) : (s & 63)); const float ang = pos * inv;
            rc[e] = cosf(ang); rs[e] = sinf(ang);
        }
    }
    {
        bf16* F1 = (bf16*)(p.ws + WS_F1); bf16* F2 = (bf16*)(p.ws + WS_F2); bf16* FC = (bf16*)(p.ws + WS_FC);
        for (int e = gt; e < 256 * 256; e += ngt) {
            const int rho = e >> 8, n1 = e & 255; float v = 0.f;
            if (n1 < 128) { const int k1 = (rho >> 5) * 16 + (rho & 15), c = (rho >> 4) & 1, m = (k1 * n1) & 127; v = c == 0 ? cospif(m * (2.f / 128.f)) : -sinpif(m * (2.f / 128.f)); }
            F1[e] = f2bf(v);
            float w = 0.f;
            if (rho < 128 && n1 < 128) { const int c2 = rho >> 6, k2 = rho & 63, c = n1 >> 6, n2 = n1 & 63, m = (k2 * n2) & 63; const float cs = cospif(m * (2.f / 64.f)), sn = sinpif(m * (2.f / 64.f));
                w = c2 == 0 ? (c == 0 ? cs : sn) : (c == 0 ? sn : -cs); }
            F2[e] = f2bf(w);
        }
        float* TW = (float*)(p.ws + WS_TW);
        for (int e = gt; e < 128 * 64; e += ngt) { const int k1 = e >> 6, n2 = e & 63; TW[2 * e] = cospif((k1 * n2) * (2.f / 8192.f)); TW[2 * e + 1] = sinpif((k1 * n2) * (2.f / 8192.f)); }
        const float sc = sqrtf(32.f);
        for (int e = gt; e < 512 * 256; e += ngt) { const int rho = e >> 8, n = e & 255, c2 = rho >> 8, k = rho & 255, m = (k * n) & 255; FC[e] = f2bf(sc * (c2 == 0 ? cospif(m * (2.f / 256.f)) : sinpif(m * (2.f / 256.f)))); }
    }
    {
        LAS float* sv = (LAS float*)lds;
        LAS float* red = sv + 3 * 1024;
        __syncthreads();
        for (int e = tid; e < 3 * 1024; e += NTHREADS) { const int j = e >> 10, k = e & 1023; const float v = j < 2 ? p.in[1][j * D + k] : p.in[3][k]; sv[e] = siluf_(v); }
        __syncthreads();
        const int kq = tid >> 6, cl = tid & 63;
        for (int it = bid; it < 2 * 96; it += nb) {
            const int l = it / 96, n = (it % 96) * 64 + cl;
            const float* W = p.in[4] + (size_t)l * D * 6144 + n;
            float a0 = 0.f, a1 = 0.f, a2 = 0.f;
#pragma unroll 32
            for (int k = kq; k < D; k += 8) { const float w = W[(size_t)k * 6144]; a0 += sv[k] * w; a1 += sv[1024 + k] * w; a2 += sv[2048 + k] * w; }
            red[(kq * 3 + 0) * 64 + cl] = a0; red[(kq * 3 + 1) * 64 + cl] = a1; red[(kq * 3 + 2) * 64 + cl] = a2;
            __syncthreads();
            if (tid < 192) { const int j = tid >> 6; float s = 0.f;
#pragma unroll
                for (int q = 0; q < 8; ++q) s += red[(q * 3 + j) * 64 + cl];
                ((float*)(p.ws + WS_MODS))[(size_t)(l * 3 + j) * 6144 + n] = s + p.in[5][l * 6144 + n]; }
            __syncthreads();
        }
    }
}
__device__ __forceinline__ void ph_moe_convert(const P& p, LAS unsigned char* lds) {
    LAS float* scr = (LAS float*)lds;
    const int bid = blockIdx.x, nb = gridDim.x;
    run_conv_jobs<true>(p, scr, 24, bid, nb);
    __syncthreads();
}

__device__ __forceinline__ void ph_norm(const P& p, LAS unsigned char* lds, int layer, int which, bool first, bool route, int nrows, bool copy = true) {
    LAS unsigned* cnt_lds = (LAS unsigned*)lds;
    LAS float* Wl = (LAS float*)(lds + 1024);
    if (route) { __syncthreads(); if (threadIdx.x < NEXP) cnt_lds[threadIdx.x] = 0u;
        for (int i = threadIdx.x; i < D * NEXP; i += NTHREADS) Wl[(i & 7) * D + (i >> 3)] = p.in[26][i];
        __syncthreads(); }
    const int lane = threadIdx.x & 63, gw = blockIdx.x * 8 + (threadIdx.x >> 6), ngw = gridDim.x * 8;
    const float* gain = p.in[which == 0 ? 6 : 7] + layer * D;
    bf16* A = (bf16*)(p.ws + WS_A);
    for (int r = gw; r < nrows; r += ngw) {
        const int mi = row_mi(r);
        const float* src = first ? (r < NLAT ? p.in[0] + (size_t)r * D : p.in[2] + (size_t)(r - NLAT) * D) : hrow(p, r);
        const float* shift = mods(p, layer, mi, which == 0 ? 0 : 3); const float* scale = mods(p, layer, mi, which == 0 ? 1 : 4);
        f32x4 v[4]; float ss = 0.f;
#pragma unroll
        for (int j = 0; j < 4; ++j) { v[j] = *(const f32x4*)(src + 4 * lane + 256 * j); ss += v[j].x * v[j].x + v[j].y * v[j].y + v[j].z * v[j].z + v[j].w * v[j].w; }
        if (first && copy) { float* h = hrow(p, r);
#pragma unroll
            for (int j = 0; j < 4; ++j) *(f32x4*)(h + 4 * lane + 256 * j) = v[j]; }
        const float rstd = rsqrtf(wave_sum(ss) * (1.f / D) + EPS);
        float lg[8];
#pragma unroll
        for (int e = 0; e < 8; ++e) lg[e] = 0.f;
#pragma unroll
        for (int j = 0; j < 4; ++j) {
            const int c = 4 * lane + 256 * j;
            const f32x4 g = *(const f32x4*)(gain + c), sc = *(const f32x4*)(scale + c), sh = *(const f32x4*)(shift + c);
            f32x4 y = v[j] * rstd * g * (sc + 1.f) + sh;
            u32x2 o; o.x = pk2(y.x, y.y); o.y = pk2(y.z, y.w);
            if (!route) *(u32x2*)(A + (size_t)r * D + c) = o;
            if ((which == 0 || route) && r < NLAT) *(unsigned*)(p.ws + WS_A8 + (size_t)r * D + c) = pk4_fp8(y.x, y.y, y.z, y.w);
            if (route) {
#pragma unroll
                for (int e = 0; e < 8; ++e) { const f32x4 w = *(const LAS f32x4*)(Wl + e * D + c); lg[e] += (y[0] * w[0] + y[1] * w[1]) + (y[2] * w[2] + y[3] * w[3]); }
            }
        }
        if (route) {
#pragma unroll
            for (int e = 0; e < 8; ++e) lg[e] = wave_sum(lg[e]);
            if (lane == 0) {
                int e0 = 0; float v0 = lg[0];
#pragma unroll
                for (int e = 1; e < 8; ++e) if (lg[e] > v0) { v0 = lg[e]; e0 = e; }
                int e1 = -1; float v1 = -INFINITY;
#pragma unroll
                for (int e = 0; e < 8; ++e) if (e != e0 && lg[e] > v1) { v1 = lg[e]; e1 = e; }
                const float w0 = 1.f / (1.f + expf(v1 - v0));
                int* tok_e = (int*)(p.ws + WS_ROUTE); float* tok_w = (float*)(p.ws + WS_ROUTE) + 16384 * 2;
                tok_e[r * 2] = e0; tok_e[r * 2 + 1] = e1; tok_w[r * 2] = w0; tok_w[r * 2 + 1] = 1.f - w0;
                __hip_atomic_fetch_add(cnt_lds + e0, 1u, __ATOMIC_RELAXED, __HIP_MEMORY_SCOPE_WORKGROUP); __hip_atomic_fetch_add(cnt_lds + e1, 1u, __ATOMIC_RELAXED, __HIP_MEMORY_SCOPE_WORKGROUP);
            }
        }
    }
    if (route) { __syncthreads(); if (threadIdx.x < NEXP) ((unsigned*)(p.ws + WS_ROUTE) + 16384 * 6)[blockIdx.x * NEXP + threadIdx.x] = cnt_lds[threadIdx.x]; __syncthreads(); }
}

__device__ __forceinline__ void norm_row(const P& p, int layer, int which, int r, int lane) {
    const float* gain = p.in[which == 0 ? 6 : 7] + layer * D; bf16* A = (bf16*)(p.ws + WS_A);
    const int mi = row_mi(r); const float* src = hrow(p, r);
    const float* shift = mods(p, layer, mi, which == 0 ? 0 : 3); const float* scale = mods(p, layer, mi, which == 0 ? 1 : 4);
    f32x4 v[4]; float ss = 0.f;
#pragma unroll
    for (int j = 0; j < 4; ++j) { v[j] = *(const f32x4*)(src + 4 * lane + 256 * j); ss += v[j].x * v[j].x + v[j].y * v[j].y + v[j].z * v[j].z + v[j].w * v[j].w; }
    const float rstd = rsqrtf(wave_sum(ss) * (1.f / D) + EPS);
#pragma unroll
    for (int j = 0; j < 4; ++j) { const int c = 4 * lane + 256 * j;
        const f32x4 g = *(const f32x4*)(gain + c), sc = *(const f32x4*)(scale + c), sh = *(const f32x4*)(shift + c);
        const f32x4 y = v[j] * rstd * g * (sc + 1.f) + sh;
        u32x2 o; o.x = pk2(y.x, y.y); o.y = pk2(y.z, y.w);
        *(u32x2*)(A + (size_t)r * D + c) = o; }
}

namespace fg {
typedef short bf16x8 __attribute__((ext_vector_type(8)));
constexpr int BM = 256, BK = 64, HALF = 128, HTB = HALF * BK * 2, STAGE_BYTES = 8 * HTB, NXCD = 8, WGM = 8;
__device__ __forceinline__ int lds_byte(int r, int c) { const int st = (r >> 4) * 2 + (c >> 5), rr = r & 15, cc = c & 31, ob = rr * 64 + cc * 2; return st * 1024 + (ob ^ (((ob >> 9) & 1) << 5)); }
__device__ __forceinline__ void stage_rc(int b, int& R, int& C) { const int st = b / 1024, sb = b % 1024, swz = sb ^ (((sb >> 9) & 1) << 5); R = (st >> 1) * 16 + swz / 64; C = (st & 1) * 32 + (swz % 64) / 2; }
__device__ __forceinline__ int perm32(int rho) { const int n = rho >> 4, i = rho & 15; return 8 * (i >> 2) + 4 * n + (i & 3); }
struct Unit { int pm, pn; const char* A; const char* B; int nt, aux; };
__device__ __forceinline__ bool tile_order(int i, int nM, int nN, int G, int c, int& pm, int& pn) {
    const int nwg = nM * nN; const long L = (long)i * G + c; if (L >= nwg) return false;
    int wgid = (int)L; { const int q = nwg / NXCD, r = nwg % NXCD, xcd = wgid % NXCD, off = wgid / NXCD; wgid = (xcd < r ? xcd * (q + 1) : r * (q + 1) + (xcd - r) * q) + off; }
    const int nig = WGM * nN, gid = wgid / nig, fm = gid * WGM, gsz = (nM - fm) < WGM ? (nM - fm) : WGM;
    pm = fm + ((wgid % nig) % gsz); pn = (wgid % nig) / gsz; return true;
}
struct PlainSched {
    const char* Abase; const char* Bbase; int lda, ldb, nM, nN, G, c, nt;
    __device__ __forceinline__ int arow(int R) const { return R; }
    __device__ __forceinline__ int ahalf() const { return HALF; }
    __device__ __forceinline__ bool next(int i, Unit& u) const { if (!tile_order(i, nM, nN, G, c, u.pm, u.pn)) return false;
        u.A = Abase + (size_t)u.pm * BM * lda * 2; u.B = Bbase + (size_t)u.pn * BM * ldb * 2; u.nt = nt; u.aux = 0; return true; }
};
struct ExpertSched {
    const char* Abase; const char* Bbase; int lda, ldb, nM, nN, G, c, nt; const LAS int* tile_e; size_t estride;
    __device__ __forceinline__ int arow(int R) const { return R; }
    __device__ __forceinline__ int ahalf() const { return HALF; }
    __device__ __forceinline__ bool next(int i, Unit& u) const { if (!tile_order(i, nM, nN, G, c, u.pm, u.pn)) return false;
        u.A = Abase + (size_t)u.pm * BM * lda * 2; u.B = Bbase + (size_t)tile_e[u.pm] * estride + (size_t)u.pn * BM * ldb * 2; u.nt = nt; u.aux = 0; return true; }
};
struct WinSched {
    const char* Abase; const char* Bbase; int G, c, mode, nN;
    __device__ __forceinline__ int arow(int R) const { return mode == 0 ? 256 * (R & 15) + 64 * ((R >> 4) & 3) + (R >> 6) : R; }
    __device__ __forceinline__ int ahalf() const { return mode == 0 ? 4096 : HALF; }
    __device__ __forceinline__ bool next(int i, Unit& u) const { if (!tile_order(i, mode == 0 ? 64 : 2, nN, G, c, u.pm, u.pn)) return false;
        const size_t row0 = mode == 0 ? (size_t)((u.pm >> 5) * SEQ + 2 * (u.pm & 31)) : (size_t)(NLAT + u.pm * CTX);
        u.A = Abase + row0 * D * 2; u.B = Bbase + (size_t)u.pn * BM * D * 2; u.nt = D / 64; u.aux = mode; return true; }
};
struct MergeSched {
    const char* Xbase; const char* Wbase; int nM, G, c;
    __device__ __forceinline__ int arow(int R) const { return R; }
    __device__ __forceinline__ int ahalf() const { return HALF; }
    __device__ __forceinline__ bool next(int i, Unit& u) const { if (!tile_order(i >> 2, nM, 4, G, c, u.pm, u.pn)) return false;
        const int br = i & 3, koff = br == 0 ? 0 : (br == 1 ? 512 : (br == 2 ? 768 : 1280));
        u.A = Xbase + ((size_t)u.pm * BM * 1536 + koff) * 2; u.B = Wbase + ((size_t)u.pn * BM * 1536 + koff) * 2; u.nt = (br & 1) ? 4 : 8; u.aux = br; return true; }
};
template <class E, class = void> struct is_chain { static constexpr bool v = false; };
template <class E> struct is_chain<E, decltype((void)E::CHAIN)> { static constexpr bool v = E::CHAIN; };
typedef f32x4 Acc[2][2][4][2];
typedef int i32x4 __attribute__((ext_vector_type(4))); typedef int i32x8 __attribute__((ext_vector_type(8)));
__device__ __forceinline__ i32x8 ld32(const LAS unsigned char* p) { const i32x4 a = *(const LAS i32x4*)p, b = *(const LAS i32x4*)(p + 16); return __builtin_shufflevector(a, b, 0, 1, 2, 3, 4, 5, 6, 7); }
template <class Epi, class Sched, bool F8 = false>
__device__ __forceinline__ void gemm_phase(LAS unsigned char* lds, int lda, int ldb, const Sched& S, const Epi& E) {
    int tid_ = threadIdx.x; asm volatile("" : "+v"(tid_));
    const int tid = tid_, wid = __builtin_amdgcn_readfirstlane(tid >> 6), lane = tid & 63, wr = wid >> 2, wc = wid & 3, fr = lane & 15, fq = lane >> 4;
    unsigned voffA[2], voffB[2];
#pragma unroll
    for (int i = 0; i < 2; ++i) { int R, C; stage_rc(tid * 16 + i * 8192, R, C); const int Rb = Epi::PERM ? ((R & ~31) + perm32(R & 31)) : R;
        voffA[i] = (unsigned)(S.arow(R) * lda + C) * 2u; voffB[i] = (unsigned)(Rb * ldb + C) * 2u; }
    const size_t kstep = (size_t)(BK * 2);
    const size_t hstepA = (size_t)S.ahalf() * lda * 2, hstepB = (size_t)HALF * ldb * 2;
    const unsigned ldsw = (unsigned)wid * 1024u;
    const int aoff = lds_byte(wr * 64 + fr, F8 ? fq * 16 : fq * 8), boff = lds_byte(wc * 32 + fr, F8 ? fq * 16 : fq * 8);
#define FG_SA(b, h) (((b) * 2 + (h)) * HTB)
#define FG_SB(b, h) ((4 + (b) * 2 + (h)) * HTB)
#define FG_STAGE(bufoff, gbase, voff) do { _Pragma("unroll") for (int _i = 0; _i < 2; ++_i) \
        __builtin_amdgcn_global_load_lds((const unsigned*)((const char*)(gbase) + (voff)[_i]), (LAS unsigned*)(lds + (bufoff) + ldsw + _i * 8192), 16, 0, 0); } while (0)
#define FG_LDA(dst, b, h) do { if constexpr (F8) { _Pragma("unroll") for (int m = 0; m < 4; ++m) dst##8[m] = ld32(lds + FG_SA(b, h) + aoff + m * 2048); } \
        else { _Pragma("unroll") for (int m = 0; m < 4; ++m) _Pragma("unroll") for (int k = 0; k < 2; ++k) dst[m][k] = *(const LAS bf16x8*)(lds + FG_SA(b, h) + aoff + m * 2048 + k * 1024); } } while (0)
#define FG_LDB(dst, b, h) do { if constexpr (F8) { _Pragma("unroll") for (int n = 0; n < 2; ++n) dst##8[n] = ld32(lds + FG_SB(b, h) + boff + n * 2048); } \
        else { _Pragma("unroll") for (int n = 0; n < 2; ++n) _Pragma("unroll") for (int k = 0; k < 2; ++k) dst[n][k] = *(const LAS bf16x8*)(lds + FG_SB(b, h) + boff + n * 2048 + k * 1024); } } while (0)
#define FG_MMA(ai, bj, At, Bt) do { __builtin_amdgcn_s_setprio(1); _Pragma("unroll") for (int m = 0; m < 4; ++m) _Pragma("unroll") for (int n = 0; n < 2; ++n) { \
        if constexpr (F8) asm volatile("v_mfma_scale_f32_16x16x128_f8f6f4 %0, %1, %2, %0, %3, %4 op_sel_hi:[0,0,0]" : "+v"(acc[ai][bj][m][n]) : "v"(Bt##8[n]), "v"(At##8[m]), "v"(scw), "v"(sca)); \
        else { _Pragma("unroll") for (int k = 0; k < 2; ++k) acc[ai][bj][m][n] = __builtin_amdgcn_mfma_f32_16x16x32_bf16(Bt[n][k], At[m][k], acc[ai][bj][m][n], 0, 0, 0); } } \
        __builtin_amdgcn_s_setprio(0); } while (0)
#define FG_WAIT_V(n) asm volatile("s_waitcnt vmcnt(" #n ")" ::: "memory")
#define FG_WAIT_L(n) asm volatile("s_waitcnt lgkmcnt(" #n ")" ::: "memory")
#define FG_BAR __builtin_amdgcn_s_barrier()
#define FG_SCHED __builtin_amdgcn_sched_barrier(0)
    Unit cur, nxt; int ui = 0;
    if (!S.next(0, cur)) return;
    Acc acc;
#pragma unroll
    for (int a = 0; a < 2; ++a)
#pragma unroll
        for (int b = 0; b < 2; ++b)
#pragma unroll
            for (int m = 0; m < 4; ++m)
#pragma unroll
                for (int n = 0; n < 2; ++n) acc[a][b][m][n] = (f32x4){0.f, 0.f, 0.f, 0.f};
    bf16x8 At[4][2], B0[2][2], B1[2][2]; i32x8 At8[4], B08[2], B18[2];
    const int scw = 0x7a7a7a7a, sca = 0x7f7f7f7f;
    const char* cA = cur.A; const char* cB = cur.B;
    FG_STAGE(FG_SB(0, 0), cB, voffB); FG_STAGE(FG_SB(0, 1), cB + hstepB, voffB); FG_STAGE(FG_SA(0, 0), cA, voffA); FG_STAGE(FG_SA(0, 1), cA + hstepA, voffA);
    if (wr == 1) FG_BAR;
    FG_WAIT_V(2); FG_BAR;
    FG_STAGE(FG_SB(1, 0), cB + kstep, voffB); FG_STAGE(FG_SA(1, 0), cA + kstep, voffA); FG_STAGE(FG_SB(1, 1), cB + hstepB + kstep, voffB);
    FG_WAIT_V(6); FG_BAR;
    for (;;) {
        const bool has_next = S.next(ui + 1, nxt);
        const char* nA = has_next ? nxt.A : cA; const char* nB = has_next ? nxt.B : cB;
        const int nt = cur.nt;
#pragma unroll 1
        for (int t = 0; t < nt; t += 2) {
            const bool last = (t == nt - 2);
            const char* a1 = cA + (size_t)(t + 1) * kstep;
            const char* a2 = last ? nA : cA + (size_t)(t + 2) * kstep; const char* b2 = last ? nB : cB + (size_t)(t + 2) * kstep;
            const char* a3 = a2 + kstep; const char* b3 = b2 + kstep;
            FG_LDB(B0, 0, 0); FG_LDB(B1, 0, 1); FG_SCHED; FG_LDA(At, 0, 0); FG_STAGE(FG_SA(1, 1), a1 + hstepA, voffA);
            FG_WAIT_V(8); FG_WAIT_L(0); FG_BAR; FG_MMA(0, 0, At, B0); FG_MMA(0, 1, At, B1); FG_BAR; FG_SCHED;
            FG_LDA(At, 0, 1); FG_STAGE(FG_SB(0, 0), b2, voffB); FG_STAGE(FG_SB(0, 1), b2 + hstepB, voffB); FG_STAGE(FG_SA(0, 0), a2, voffA);
            FG_WAIT_V(8); FG_WAIT_L(0); FG_BAR; FG_MMA(1, 0, At, B0); FG_MMA(1, 1, At, B1); FG_BAR; FG_SCHED;
            FG_LDB(B0, 1, 0); FG_LDB(B1, 1, 1); FG_SCHED; FG_LDA(At, 1, 0); FG_STAGE(FG_SA(0, 1), a2 + hstepA, voffA);
            FG_WAIT_V(8); FG_WAIT_L(0); FG_BAR; FG_MMA(0, 0, At, B0); FG_MMA(0, 1, At, B1); FG_BAR; FG_SCHED;
            FG_LDA(At, 1, 1); FG_STAGE(FG_SB(1, 0), b3, voffB); FG_STAGE(FG_SB(1, 1), b3 + hstepB, voffB); FG_STAGE(FG_SA(1, 0), a3, voffA);
            FG_WAIT_V(8); FG_WAIT_L(0); FG_BAR; FG_MMA(1, 0, At, B0); FG_MMA(1, 1, At, B1); FG_BAR; FG_SCHED;
        }
        if (wr == 0) FG_BAR;
        E(acc, cur, wr, wc, fr, fq);
        if (!has_next) break;
        if (!(is_chain<Epi>::v && cur.aux != 3)) {
#pragma unroll
        for (int a = 0; a < 2; ++a)
#pragma unroll
            for (int b = 0; b < 2; ++b)
#pragma unroll
                for (int m = 0; m < 4; ++m)
#pragma unroll
                    for (int n = 0; n < 2; ++n) acc[a][b][m][n] = (f32x4){0.f, 0.f, 0.f, 0.f};
        }
        cur = nxt; cA = nA; cB = nB; ++ui;
        if (wr == 1) FG_BAR;
    }
    FG_WAIT_V(0);
    FG_BAR;
#undef FG_SA
#undef FG_SB
#undef FG_STAGE
#undef FG_LDA
#undef FG_LDB
#undef FG_MMA
#undef FG_WAIT_V
#undef FG_WAIT_L
#undef FG_BAR
#undef FG_SCHED
}
__device__ __forceinline__ unsigned cvt_pk(float lo, float hi) { unsigned r; asm volatile("v_cvt_pk_bf16_f32 %0, %1, %2" : "=v"(r) : "v"(lo), "v"(hi)); return r; }
__device__ __forceinline__ u32x4 pack8(const f32x4 a, const f32x4 b) { u32x4 w; w.x = cvt_pk(a[0], a[1]); w.y = cvt_pk(a[2], a[3]); w.z = cvt_pk(b[0], b[1]); w.w = cvt_pk(b[2], b[3]); return w; }
__device__ __forceinline__ f32x4 unpk_u8(unsigned x) { const float k = 1.f / 255.f; return (f32x4){(float)(x & 0xffu) * k, (float)((x >> 8) & 0xffu) * k, (float)((x >> 16) & 0xffu) * k, (float)(x >> 24) * k}; }
__device__ __forceinline__ f32x4 unpk_u8r(unsigned x) { return (f32x4){(float)(x & 0xffu), (float)((x >> 8) & 0xffu), (float)((x >> 16) & 0xffu), (float)(x >> 24)}; }
__device__ __forceinline__ f32x4 unpk_lo(unsigned x, unsigned y) { return (f32x4){__uint_as_float(x << 16), __uint_as_float(x & 0xffff0000u), __uint_as_float(y << 16), __uint_as_float(y & 0xffff0000u)}; }

struct EpiWin {
    static constexpr bool PERM = true;
    unsigned char* ws; const float* qg; const float* kg;
    __device__ __forceinline__ void operator()(const Acc& acc, const Unit& u, int wr, int wc, int fr_, int fq_) const {
        int fr = fr_, fq = fq_; asm volatile("" : "+v"(fr), "+v"(fq));
        const int tile = u.pn; const bool LAT = u.aux == 0;
        if (tile == 0) {
            if (LAT) {
                const int b = u.pm >> 5, n2 = 2 * (u.pm & 31) + wr;
#pragma unroll
                for (int ai = 0; ai < 2; ++ai)
#pragma unroll
                    for (int bj = 0; bj < 2; ++bj) {
#pragma unroll
                        for (int n = 0; n < 2; ++n)
#pragma unroll
                            for (int e = 0; e < 4; ++e) { const int ch = bj * HALF + wc * 32 + 8 * fq + 4 * n + e;
                                u32x2 o; o.x = cvt_pk(acc[ai][bj][0][n][e], acc[ai][bj][1][n][e]); o.y = cvt_pk(acc[ai][bj][2][n][e], acc[ai][bj][3][n][e]);
                                *(u32x2*)((bf16*)(ws + WS_UT) + ((size_t)(b * 256 + ch) * 64 + n2) * 256 + 64 * ai + 4 * fr) = o; }
                        asm volatile("" ::: "memory"); }
            } else {
#pragma unroll
                for (int ai = 0; ai < 2; ++ai)
#pragma unroll
                    for (int m = 0; m < 4; ++m) { const int sx = ai * HALF + wr * 64 + m * 16 + fr;
#pragma unroll
                        for (int bj = 0; bj < 2; ++bj)
#pragma unroll
                            for (int n = 0; n < 2; ++n)
#pragma unroll
                                for (int e = 0; e < 4; ++e) { const int ch = bj * HALF + wc * 32 + 8 * fq + 4 * n + e;
                                    ((bf16*)(ws + WS_UTC))[(size_t)(u.pm * 256 + ch) * 256 + sx] = f2bf(acc[ai][bj][m][n][e]); }
                        asm volatile("" ::: "memory"); }
            }
            return;
        }
        const bool ropek = tile == 1 || tile == 2 || tile == 5 || tile == 6 || (tile == 7 && wc < 2);
        const bool keyrow = tile == 7;
        size_t boff; int pitch, col0;
        if (tile <= 4) { boff = WS_RETQ + (size_t)(tile - 1) * MROWS * 256 * 2; pitch = 256; col0 = ropek ? wc * 64 : wc * 32; }
        else if (tile <= 6) { boff = WS_ATTQ; pitch = 512; col0 = (tile - 5) * 256 + wc * 64; }
        else if (tile == 7) { boff = wc < 2 ? WS_ATTK : WS_ATTV; pitch = 128; col0 = (wc & 1) * 64; }
        else if (tile < 10) { boff = WS_CONV; pitch = 512; col0 = (tile - 8) * 256 + wc * 32; }
        else { boff = WS_G; pitch = 4096; col0 = (tile - 10) * 256 + wc * 32; }
        const bool head = ropek || tile == 7;
        bf16* const dbase = (bf16*)(ws + boff);
        const bool norm = tile >= 5 && ropek;
        const float* gp = tile == 7 ? kg : qg;
        const float osc = tile == 2 ? 0.125f : (tile == 5 || tile == 6 ? QSCALE : 1.f);
        const float* rc = (const float*)(ws + WS_ROPE);
#pragma unroll
        for (int ai = 0; ai < 2; ++ai) {
            f32x4 rcs[4][2], rsn[4][2];
            if (ropek && LAT) {
#pragma unroll
                for (int m = 0; m < 4; ++m)
#pragma unroll
                    for (int bj = 0; bj < 2; ++bj) { const int sx = 4096 * ai + 256 * fr + 64 * m + 2 * (u.pm & 31) + wr, i0 = 16 * bj + 4 * fq;
                        rcs[m][bj] = *(const f32x4*)(rc + sx * 32 + i0); rsn[m][bj] = *(const f32x4*)(rc + SEQ * 32 + sx * 32 + i0); } }
#pragma unroll
            for (int m = 0; m < 4; ++m) {
                const int b = LAT ? (u.pm >> 5) : u.pm, s = LAT ? (4096 * ai + 256 * fr + 64 * m + 2 * (u.pm & 31) + wr) : (ai * HALF + wr * 64 + m * 16 + fr);
                const int rr = keyrow ? b * KEYS + (LAT ? CTX + s : s) : (LAT ? b * SEQ + s : NLAT + b * CTX + s);
                bf16* const drow = dbase + ((size_t)rr * pitch + col0 + 8 * fq);
                if (ropek) {
                    float rstd = 1.f;
                    if (norm) { float ss = 0.f;
#pragma unroll
                        for (int bj = 0; bj < 2; ++bj)
#pragma unroll
                            for (int n = 0; n < 2; ++n) { const f32x4 x = acc[ai][bj][m][n]; ss += (x[0] * x[0] + x[1] * x[1]) + (x[2] * x[2] + x[3] * x[3]); }
                        ss += __shfl_xor(ss, 16); ss += __shfl_xor(ss, 32);
                        rstd = rsqrtf(ss * (1.f / 64.f) + EPS); }
#pragma unroll
                    for (int bj = 0; bj < 2; ++bj) {
                        const int i0 = 16 * bj + 4 * fq;
                        f32x4 x1 = acc[ai][bj][m][0], x2 = acc[ai][bj][m][1];
                        if (norm) { const f32x4 g1 = *(const f32x4*)(gp + i0), g2 = *(const f32x4*)(gp + 32 + i0); x1 = x1 * rstd * g1; x2 = x2 * rstd * g2; }
                        f32x4 o1 = x1, o2 = x2;
                        if (LAT) { const f32x4 cs = rcs[m][bj], sn = rsn[m][bj]; o1 = x1 * cs - x2 * sn; o2 = x1 * sn + x2 * cs; }
                        *(u32x4*)(drow + 32 * bj) = pack8(o1 * osc, o2 * osc);
                    }
                } else {
#pragma unroll
                    for (int bj = 0; bj < 2; ++bj) {
                        f32x4 a0 = acc[ai][bj][m][0], a1 = acc[ai][bj][m][1];
                        if (tile >= 10) {
                            u32x2 o; o.x = 0u; o.y = 0u;
#pragma unroll
                            for (int e = 0; e < 4; ++e) { o.x = __builtin_amdgcn_cvt_pk_u8_f32(__builtin_fmaxf(__builtin_floorf(sigmoid_fast(a0[e]) * 255.f + 0.5f), 1.f), e, o.x);
                                o.y = __builtin_amdgcn_cvt_pk_u8_f32(__builtin_fmaxf(__builtin_floorf(sigmoid_fast(a1[e]) * 255.f + 0.5f), 1.f), e, o.y); }
                            *(u32x2*)(ws + WS_G + (size_t)rr * 4096 + (tile - 10) * 256 + wc * 32 + 8 * fq + HALF * bj) = o;
                        } else *(u32x4*)(drow + (head ? 32 : HALF) * bj) = pack8(a0, a1);
                    }
                }
            }
        }
    }
};
struct EpiGate8 {
    static constexpr bool PERM = true;
    unsigned char* G;
    __device__ __forceinline__ void operator()(const Acc& acc, const Unit& u, int wr, int wc, int fr_, int fq_) const {
        int fr = fr_, fq = fq_; asm volatile("" : "+v"(fr), "+v"(fq));
#pragma unroll
        for (int ai = 0; ai < 2; ++ai)
#pragma unroll
            for (int m = 0; m < 4; ++m) { const int r = u.pm * BM + ai * HALF + wr * 64 + m * 16 + fr;
#pragma unroll
                for (int bj = 0; bj < 2; ++bj) { const f32x4 a0 = acc[ai][bj][m][0], a1 = acc[ai][bj][m][1]; u32x2 o; o.x = 0u; o.y = 0u;
#pragma unroll
                    for (int e = 0; e < 4; ++e) { o.x = __builtin_amdgcn_cvt_pk_u8_f32(__builtin_fmaxf(__builtin_floorf(sigmoid_fast(a0[e]) * 255.f + 0.5f), 1.f), e, o.x);
                        o.y = __builtin_amdgcn_cvt_pk_u8_f32(__builtin_fmaxf(__builtin_floorf(sigmoid_fast(a1[e]) * 255.f + 0.5f), 1.f), e, o.y); }
                    *(u32x2*)(G + (size_t)r * 4096 + u.pn * BM + bj * HALF + wc * 32 + 8 * fq) = o; } }
    }
};
struct EpiMerge {
    static constexpr bool PERM = true, CHAIN = true;
    const unsigned char* G; bf16* Mg;
    __device__ __forceinline__ void operator()(Acc& acc, const Unit& u, int wr, int wc, int fr_, int fq_) const {
        int fr = fr_, fq = fq_; asm volatile("" : "+v"(fr), "+v"(fq));
        const int br = u.aux; const bool lastb = br == 3;
#pragma unroll
        for (int ai = 0; ai < 2; ++ai) {
            u32x2 g[4][2], gn[4][2];
#pragma unroll
            for (int m = 0; m < 4; ++m)
#pragma unroll
                for (int bj = 0; bj < 2; ++bj) { const int r = u.pm * BM + ai * HALF + wr * 64 + m * 16 + fr, c = u.pn * BM + bj * HALF + wc * 32 + 8 * fq;
                    g[m][bj] = *(const u32x2*)(G + (size_t)r * 4096 + br * 1024 + c);
                    if (!lastb) gn[m][bj] = *(const u32x2*)(G + (size_t)r * 4096 + (br + 1) * 1024 + c); }
#pragma unroll
            for (int m = 0; m < 4; ++m)
#pragma unroll
                for (int bj = 0; bj < 2; ++bj) {
                    if (!lastb) {
                        const f32x4 n0 = unpk_u8r(g[m][bj].x), n1 = unpk_u8r(g[m][bj].y), d0 = unpk_u8r(gn[m][bj].x), d1 = unpk_u8r(gn[m][bj].y);
#pragma unroll
                        for (int e = 0; e < 4; ++e) { acc[ai][bj][m][0][e] *= n0[e] * __builtin_amdgcn_rcpf(d0[e]); acc[ai][bj][m][1][e] *= n1[e] * __builtin_amdgcn_rcpf(d1[e]); }
                    } else { const int r = u.pm * BM + ai * HALF + wr * 64 + m * 16 + fr, c = u.pn * BM + bj * HALF + wc * 32 + 8 * fq;
                        *(u32x4*)(Mg + (size_t)r * 1024 + c) = pack8(acc[ai][bj][m][0] * unpk_u8(g[m][bj].x), acc[ai][bj][m][1] * unpk_u8(g[m][bj].y)); } }
        }
    }
};
struct EpiResid {
    static constexpr bool PERM = false;
    float* out; float* hctx; const float* modbase; int chunk;
    __device__ __forceinline__ void operator()(const Acc& acc, const Unit& u, int wr, int wc, int fr_, int fq_) const {
        int fr = fr_, fq = fq_; asm volatile("" : "+v"(fr), "+v"(fq));
        const int rt = u.pm * BM;
        const float* g = modbase + ((size_t)row_mi(rt) * 6 + chunk) * D;
        f32x4 gg[2][2];
#pragma unroll
        for (int bj = 0; bj < 2; ++bj)
#pragma unroll
            for (int n = 0; n < 2; ++n) gg[bj][n] = *(const f32x4*)(g + u.pn * BM + bj * HALF + wc * 32 + 16 * n + 4 * fq);
#pragma unroll
        for (int ai = 0; ai < 2; ++ai) {
            f32x4 hv[4][2][2];
#pragma unroll
            for (int m = 0; m < 4; ++m) { const int r = rt + ai * HALF + wr * 64 + m * 16 + fr; const float* h = r < NLAT ? out + (size_t)r * D : hctx + (size_t)(r - NLAT) * D;
#pragma unroll
                for (int bj = 0; bj < 2; ++bj)
#pragma unroll
                    for (int n = 0; n < 2; ++n) hv[m][bj][n] = *(const f32x4*)(h + u.pn * BM + bj * HALF + wc * 32 + 16 * n + 4 * fq); }
#pragma unroll
            for (int m = 0; m < 4; ++m) { const int r = rt + ai * HALF + wr * 64 + m * 16 + fr; float* h = r < NLAT ? out + (size_t)r * D : hctx + (size_t)(r - NLAT) * D;
#pragma unroll
                for (int bj = 0; bj < 2; ++bj)
#pragma unroll
                    for (int n = 0; n < 2; ++n) *(f32x4*)(h + u.pn * BM + bj * HALF + wc * 32 + 16 * n + 4 * fq) = hv[m][bj][n] + gg[bj][n] * acc[ai][bj][m][n]; }
        }
    }
};
struct EpiResidNorm {
    static constexpr bool PERM = false;
    const float* hin; float* out; const float* modbase; int chunk;
    const float* gain; const float* nmods; int csh, csc; bf16* A; unsigned char* A8;
    float* xbuf; unsigned* cnt; unsigned* tmo; LAS unsigned char* lds;
    __device__ __forceinline__ void operator()(Acc& acc, const Unit& u, int wr, int wc, int fr_, int fq_) const {
        int fr = fr_, fq = fq_; asm volatile("" : "+v"(fr), "+v"(fq));
        const int wid = __builtin_amdgcn_readfirstlane((int)threadIdx.x >> 6), lane = threadIdx.x & 63;
        const int rt = u.pm * BM, mi = row_mi(rt);
        LAS float* Pt = (LAS float*)(lds + STAGE_BYTES);
        LAS float* St = (LAS float*)(lds + STAGE_BYTES + 4096);
        LAS unsigned* flag = (LAS unsigned*)(lds + STAGE_BYTES + 5120);
        { const float* g = modbase + ((size_t)mi * 6 + chunk) * D;
          f32x4 gg[2][2];
#pragma unroll
          for (int bj = 0; bj < 2; ++bj)
#pragma unroll
              for (int n = 0; n < 2; ++n) gg[bj][n] = *(const f32x4*)(g + u.pn * BM + bj * HALF + wc * 32 + 16 * n + 4 * fq);
#pragma unroll
          for (int am = 0; am < 4; ++am) { const int ai = am >> 1, m0 = (am & 1) * 2;
              f32x4 hv[2][2][2];
#pragma unroll
              for (int mm = 0; mm < 2; ++mm) { const float* h = hin + (size_t)(rt + ai * HALF + wr * 64 + (m0 + mm) * 16 + fr) * D;
#pragma unroll
                  for (int bj = 0; bj < 2; ++bj)
#pragma unroll
                      for (int n = 0; n < 2; ++n) hv[mm][bj][n] = *(const f32x4*)(h + u.pn * BM + bj * HALF + wc * 32 + 16 * n + 4 * fq); }
#pragma unroll
              for (int mm = 0; mm < 2; ++mm) { const int m = m0 + mm; float* h = out + (size_t)(rt + ai * HALF + wr * 64 + m * 16 + fr) * D; float ss = 0.f;
#pragma unroll
                  for (int bj = 0; bj < 2; ++bj)
#pragma unroll
                      for (int n = 0; n < 2; ++n) { const f32x4 x = hv[mm][bj][n] + gg[bj][n] * acc[ai][bj][m][n]; acc[ai][bj][m][n] = x;
                          *(f32x4*)(h + u.pn * BM + bj * HALF + wc * 32 + 16 * n + 4 * fq) = x; ss += (x[0] * x[0] + x[1] * x[1]) + (x[2] * x[2] + x[3] * x[3]); }
                  ss += __shfl_xor(ss, 16); ss += __shfl_xor(ss, 32);
                  if (fq == 0) Pt[(ai * HALF + wr * 64 + m * 16 + fr) * 4 + wc] = ss; }
              asm volatile("" ::: "memory");
          } }
        asm volatile("s_waitcnt lgkmcnt(0)" ::: "memory"); __builtin_amdgcn_s_barrier(); asm volatile("" ::: "memory");
        const int row = wid * 32 + (lane & 31);
        if (lane < 32) { const f32x4 q = *(const LAS f32x4*)(Pt + row * 4);
            __hip_atomic_store(xbuf + ((size_t)(rt + row) * 4 + u.pn), (q[0] + q[1]) + (q[2] + q[3]), __ATOMIC_RELAXED, __HIP_MEMORY_SCOPE_AGENT); }
        asm volatile("s_waitcnt vmcnt(0)" ::: "memory");
        if (lane == 0) __hip_atomic_fetch_add(cnt + 16 * u.pm, 1u, __ATOMIC_RELAXED, __HIP_MEMORY_SCOPE_AGENT);
        if (wid == 0) { unsigned sp = 0u, dead = 0u;
            while ((unsigned)__builtin_amdgcn_readfirstlane(__hip_atomic_load(cnt + 16 * u.pm, __ATOMIC_RELAXED, __HIP_MEMORY_SCOPE_AGENT)) < 32u) {
                __builtin_amdgcn_s_sleep(1);
                if ((++sp & 255u) == 0u) { if (__hip_atomic_load(tmo, __ATOMIC_RELAXED, __HIP_MEMORY_SCOPE_AGENT)) { dead = 1u; break; } if (sp > (1u << 22)) { if (lane == 0) atomicAdd(tmo, 1u); dead = 1u; break; } } }
            __builtin_amdgcn_fence(__ATOMIC_ACQUIRE, "agent");
            if (lane == 0) flag[0] = dead; }
        asm volatile("s_waitcnt vmcnt(0) lgkmcnt(0)" ::: "memory"); __builtin_amdgcn_s_barrier(); asm volatile("" ::: "memory");
        if (lane < 32) { const float* sl = xbuf + (size_t)(rt + row) * 4; float t = 0.f;
#pragma unroll
            for (int q = 0; q < 4; ++q) t += __hip_atomic_load(sl + q, __ATOMIC_RELAXED, __HIP_MEMORY_SCOPE_AGENT);
            St[row] = rsqrtf(t * (1.f / D) + EPS); }
        asm volatile("s_waitcnt lgkmcnt(0)" ::: "memory"); __builtin_amdgcn_s_barrier(); asm volatile("" ::: "memory");
        const float* shp = nmods + ((size_t)mi * 6 + csh) * D; const float* scp = nmods + ((size_t)mi * 6 + csc) * D;
        float rs[2][4];
#pragma unroll
        for (int ai = 0; ai < 2; ++ai)
#pragma unroll
            for (int m = 0; m < 4; ++m) rs[ai][m] = St[ai * HALF + wr * 64 + m * 16 + fr];
#pragma unroll
        for (int bj = 0; bj < 2; ++bj)
#pragma unroll
            for (int n = 0; n < 2; ++n) { const int c = u.pn * BM + bj * HALF + wc * 32 + 16 * n + 4 * fq;
                const f32x4 g4 = *(const f32x4*)(gain + c), sc4 = *(const f32x4*)(scp + c) + 1.f, sh4 = *(const f32x4*)(shp + c);
#pragma unroll
                for (int ai = 0; ai < 2; ++ai)
#pragma unroll
                    for (int m = 0; m < 4; ++m) { const f32x4 y = acc[ai][bj][m][n] * rs[ai][m] * g4 * sc4 + sh4;
                        u32x2 o; o.x = cvt_pk(y[0], y[1]); o.y = cvt_pk(y[2], y[3]);
                        *(u32x2*)(A + (size_t)(rt + ai * HALF + wr * 64 + m * 16 + fr) * D + c) = o;
                        if (A8) *(unsigned*)(A8 + (size_t)(rt + ai * HALF + wr * 64 + m * 16 + fr) * D + c) = pk4_fp8(y[0], y[1], y[2], y[3]); } }
    }
};
struct EpiSwiglu {
    static constexpr bool PERM = true;
    bf16* Hm;
    __device__ __forceinline__ void operator()(const Acc& acc, const Unit& u, int wr, int wc, int fr, int fq) const {
#pragma unroll
        for (int ai = 0; ai < 2; ++ai)
#pragma unroll
            for (int m = 0; m < 4; ++m) { const int r = u.pm * BM + ai * HALF + wr * 64 + m * 16 + fr;
#pragma unroll
                for (int bj = 0; bj < 2; ++bj) { const int c = u.pn * BM + bj * HALF + wc * 32 + 8 * fq; const f32x4 g = acc[ai][bj][m][0], up = acc[ai][bj][m][1];
                    u32x2 o; o.x = cvt_pk(silu_fast(g[0]) * up[0], silu_fast(g[1]) * up[1]); o.y = cvt_pk(silu_fast(g[2]) * up[2], silu_fast(g[3]) * up[3]);
                    *(u32x2*)(Hm + (size_t)r * FFN + (c >> 1)) = o; } }
    }
};
struct EpiSwiglu8 {
    static constexpr bool PERM = true;
    unsigned char* Hm;
    __device__ __forceinline__ void operator()(const Acc& acc, const Unit& u, int wr, int wc, int fr_, int fq_) const {
        int fr = fr_, fq = fq_; asm volatile("" : "+v"(fr), "+v"(fq));
#pragma unroll
        for (int ai = 0; ai < 2; ++ai)
#pragma unroll
            for (int m = 0; m < 4; ++m) { const int r = u.pm * BM + ai * HALF + wr * 64 + m * 16 + fr;
#pragma unroll
                for (int bj = 0; bj < 2; ++bj) { const int c = u.pn * BM + bj * HALF + wc * 32 + 8 * fq; const f32x4 g = acc[ai][bj][m][0], up = acc[ai][bj][m][1];
                    *(unsigned*)(Hm + (size_t)r * FFN + (c >> 1)) = pk4_fp8(silu_fast(g[0]) * up[0], silu_fast(g[1]) * up[1], silu_fast(g[2]) * up[2], silu_fast(g[3]) * up[3]); } }
    }
};
struct EpiStore {
    static constexpr bool PERM = true;
    bf16* O; int ldc;
    __device__ __forceinline__ void operator()(const Acc& acc, const Unit& u, int wr, int wc, int fr_, int fq_) const {
        int fr = fr_, fq = fq_; asm volatile("" : "+v"(fr), "+v"(fq));
#pragma unroll
        for (int ai = 0; ai < 2; ++ai)
#pragma unroll
            for (int m = 0; m < 4; ++m) { const int r = u.pm * BM + ai * HALF + wr * 64 + m * 16 + fr;
#pragma unroll
                for (int bj = 0; bj < 2; ++bj) { const int c = u.pn * BM + bj * HALF + wc * 32 + 8 * fq; *(u32x4*)(O + (size_t)r * ldc + c) = pack8(acc[ai][bj][m][0], acc[ai][bj][m][1]); } }
    }
};
struct EpiFft1 {
    static constexpr bool PERM = true;
    unsigned char* ws;
    __device__ __forceinline__ void operator()(const Acc& acc, const Unit& u, int wr, int wc, int fr, int fq) const {
        const float* TW = (const float*)(ws + WS_TW); bf16* Z = (bf16*)(ws + WS_Z);
#pragma unroll
        for (int ai = 0; ai < 2; ++ai)
#pragma unroll
            for (int mm = 0; mm < 2; ++mm) { const int k1 = (4 * ai + 2 * wr + mm) * 16 + fr;
#pragma unroll
                for (int bj = 0; bj < 2; ++bj) { const int c = u.pn * BM + bj * HALF + wc * 32 + 8 * fq, n2 = c & 63, ch = (c >> 6) & 255, b = c >> 14;
                    f32x4 zr[2], zi[2];
#pragma unroll
                    for (int n = 0; n < 2; ++n) { const f32x4 yr = acc[ai][bj][2 * mm][n], yi = acc[ai][bj][2 * mm + 1][n];
                        const f32x4 t0 = *(const f32x4*)(TW + (size_t)(k1 * 64 + n2 + 4 * n) * 2), t1 = *(const f32x4*)(TW + (size_t)(k1 * 64 + n2 + 4 * n) * 2 + 4);
                        const f32x4 ct = {t0[0], t0[2], t1[0], t1[2]}, st = {t0[1], t0[3], t1[1], t1[3]};
                        zr[n] = yr * ct + yi * st; zi[n] = yi * ct - yr * st; }
                    bf16* dst = Z + ((size_t)b * 32768 + k1 * 256 + ch) * 256 + n2;
                    *(u32x4*)dst = pack8(zr[0], zr[1]); *(u32x4*)(dst + 64) = pack8(zi[0], zi[1]);
                    asm volatile("" ::: "memory"); } }
    }
};
struct EpiFft3 {
    static constexpr bool PERM = true;
    unsigned char* ws;
    __device__ __forceinline__ void operator()(const Acc& acc, const Unit& u, int wr, int wc, int fr, int fq) const {
        bf16* X = (bf16*)(ws + WS_X);
#pragma unroll
        for (int m = 0; m < 4; ++m) { const int k2 = 16 * m + fr;
#pragma unroll
            for (int bj = 0; bj < 2; ++bj) { const int c = u.pn * BM + bj * HALF + wc * 32 + 8 * fq, ch = c & 255, k1 = (c >> 8) & 127, b = c >> 15;
                *(u32x4*)(X + (size_t)(b * SEQ + k1 + 128 * k2) * 1536 + wr * 256 + ch) = pack8(acc[0][bj][m][0], acc[0][bj][m][1]); } }
    }
};
struct EpiFftC {
    static constexpr bool PERM = true;
    unsigned char* ws;
    __device__ __forceinline__ void operator()(const Acc& acc, const Unit& u, int wr, int wc, int fr, int fq) const {
        bf16* X = (bf16*)(ws + WS_X);
#pragma unroll
        for (int ai = 0; ai < 2; ++ai)
#pragma unroll
            for (int m = 0; m < 4; ++m) { const int k = ai * HALF + wr * 64 + m * 16 + fr;
#pragma unroll
                for (int bj = 0; bj < 2; ++bj) { const int ch = bj * HALF + wc * 32 + 8 * fq;
                    *(u32x4*)(X + (size_t)(NLAT + u.pn * CTX + k) * 1536 + u.pm * 256 + ch) = pack8(acc[ai][bj][m][0], acc[ai][bj][m][1]); } }
    }
};
}

__device__ __forceinline__ void ph_win(const P& p, LAS unsigned char* lds, int layer) {
    const char* W = (const char*)(p.ws + WS_WIN) + (size_t)layer * INC * D * 2;
#pragma unroll 1
    for (int mode = 0; mode < 2; ++mode) {
        fg::WinSched S{(const char*)(p.ws + WS_A), W, (int)gridDim.x, (int)((blockIdx.x + mode * 128) % gridDim.x), mode, mode == 0 ? 10 : (layer == 0 ? 26 : 10)};
        fg::EpiWin E{p.ws, p.in[14] + layer * 64, p.in[15] + layer * 64};
        fg::gemm_phase(lds, D, D, S, E);
    }
    {
        fg::PlainSched S{(const char*)(p.ws + WS_A8), (const char*)(p.ws + WS_WIN8) + (size_t)layer * 4096 * 1024, D / 2, D / 2, NLAT / 256, 16, (int)gridDim.x, (int)blockIdx.x, D / 128};
        fg::EpiGate8 E{p.ws + WS_G};
        fg::gemm_phase<fg::EpiGate8, fg::PlainSched, true>(lds, D / 2, D / 2, S, E);
    }
}

__device__ __forceinline__ void conv_item(const P& p, LAS unsigned char* lds, int layer, int seqid, int t0) {
    const int tid = threadIdx.x; LAS float* y = (LAS float*)lds;
    const int L = seqid < 2 ? SEQ : CTX; const int rbase = seqid < 2 ? seqid * SEQ : NLAT + (seqid - 2) * CTX;
    const bf16* cv = (const bf16*)(p.ws + WS_CONV);
    __syncthreads();
    u32x4 pa[6], pg[6];
#pragma unroll
    for (int i = 0; i < 6; ++i) { const int e = tid + i * NTHREADS, tt = e >> 5, c8 = (e & 31) * 8, t = t0 - 15 + tt;
        if (e < 94 * 32 && t >= 0 && t < L) { const bf16* rowp = cv + (size_t)(rbase + t) * 512 + c8; pa[i] = *(const u32x4*)rowp; pg[i] = *(const u32x4*)(rowp + 256); } }
#pragma unroll
    for (int i = 0; i < 6; ++i) { const int e = tid + i * NTHREADS; if (e >= 94 * 32) break; const int tt = e >> 5, c8 = (e & 31) * 8, t = t0 - 15 + tt;
        f32x4 lo = {0.f, 0.f, 0.f, 0.f}, hi = lo;
        if (t >= 0 && t < L) { const u32x4 a = pa[i], g = pg[i];
            lo = (f32x4){__uint_as_float(a.x << 16) * sigmoidf_(__uint_as_float(g.x << 16)), __uint_as_float(a.x & 0xffff0000u) * sigmoidf_(__uint_as_float(g.x & 0xffff0000u)),
                         __uint_as_float(a.y << 16) * sigmoidf_(__uint_as_float(g.y << 16)), __uint_as_float(a.y & 0xffff0000u) * sigmoidf_(__uint_as_float(g.y & 0xffff0000u))};
            hi = (f32x4){__uint_as_float(a.z << 16) * sigmoidf_(__uint_as_float(g.z << 16)), __uint_as_float(a.z & 0xffff0000u) * sigmoidf_(__uint_as_float(g.z & 0xffff0000u)),
                         __uint_as_float(a.w << 16) * sigmoidf_(__uint_as_float(g.w << 16)), __uint_as_float(a.w & 0xffff0000u) * sigmoidf_(__uint_as_float(g.w & 0xffff0000u))}; }
        *(LAS f32x4*)(y + tt * 256 + c8) = lo; *(LAS f32x4*)(y + tt * 256 + c8 + 4) = hi; }
    __syncthreads();
    {
        const int ch = tid & 255, half = tid >> 8;
        float w[31];
#pragma unroll
        for (int k = 0; k < 31; ++k) w[k] = p.in[17][(size_t)layer * 31 * 256 + k * 256 + ch];
        const float bias = p.in[18][layer * 256 + ch];
        float o[4][8];
#pragma unroll
        for (int u = 0; u < 4; ++u) { const int tb = (half * 4 + u) * 8;
            float in[38];
#pragma unroll
            for (int q = 0; q < 38; ++q) in[q] = y[(tb + q) * 256 + ch];
#pragma unroll
            for (int q = 0; q < 8; ++q) { float a = bias;
#pragma unroll
                for (int k = 0; k < 31; ++k) a += in[q + k] * w[k];
                o[u][q] = a; } }
        __syncthreads();
#pragma unroll
        for (int u = 0; u < 4; ++u)
#pragma unroll
            for (int q = 0; q < 8; ++q) y[((half * 4 + u) * 8 + q) * 256 + ch] = o[u][q];
    }
    __syncthreads();
    const int wv = tid >> 6, lane = tid & 63;
    const f32x4 g = *(const f32x4*)(p.in[19] + layer * 256 + lane * 4), bb = *(const f32x4*)(p.in[20] + layer * 256 + lane * 4);
    for (int q = 0; q < 8; ++q) { const int t = wv * 8 + q;
        const f32x4 v = *(const LAS f32x4*)(y + t * 256 + lane * 4);
        const float mu = wave_sum(v.x + v.y + v.z + v.w) * (1.f / 256.f);
        const f32x4 dv = v - mu; const float var = wave_sum(dv.x * dv.x + dv.y * dv.y + dv.z * dv.z + dv.w * dv.w) * (1.f / 256.f);
        const float rstd = rsqrtf(var + EPS);
        f32x4 z = dv * rstd * g + bb;
        u32x2 ov; ov.x = pk2(siluf_(z.x), siluf_(z.y)); ov.y = pk2(siluf_(z.z), siluf_(z.w));
        *(u32x2*)((bf16*)(p.ws + WS_X) + (size_t)(rbase + t0 + t) * 1536 + 1280 + lane * 4) = ov; }
}

__device__ __forceinline__ int chunk_row0(int b, int n) { return n < 2 ? NLAT + b * CTX + n * 128 : b * SEQ + (n - 2) * 128; }
__device__ __forceinline__ float log_sigmoid(float x) { return x >= 0.f ? -log1pf(expf(-x)) : x - log1pf(expf(x)); }
namespace rt {
typedef short bf16x8 __attribute__((ext_vector_type(8)));
constexpr int PQ = 72, PJ = 136;
__device__ __forceinline__ f32x4 mma(bf16x8 a, bf16x8 b, f32x4 c) { return __builtin_amdgcn_mfma_f32_16x16x32_bf16(a, b, c, 0, 0, 0); }
__device__ __forceinline__ bf16x8 frag(const LAS bf16* base, int row, int pitch, int k0, int lane) { return *(const LAS bf16x8*)(base + (row + (lane & 15)) * pitch + k0 + 8 * (lane >> 4)); }
}
__device__ __forceinline__ void ret_kv_item(const P& p, LAS unsigned char* lds, int layer, int it) {
    using namespace rt;
    const int tid = threadIdx.x, lane = tid & 63, w = tid >> 6; const int h = it & 3, n = (it >> 2) % NCHUNK, b = (it >> 2) / NCHUNK;
    LAS bf16* KTf = (LAS bf16*)lds; LAS bf16* KTb = KTf + 64 * PJ; LAS bf16* VT = KTb + 64 * PJ;
    const int r0 = chunk_row0(b, n);
    const float lgf = log_sigmoid(p.in[10][layer * 4 + h]), lgb = log_sigmoid(p.in[11][layer * 4 + h]);
    __syncthreads();
    { const int j = tid & 127, dq = (tid >> 7) * 16;
      const bf16* K = (const bf16*)(p.ws + WS_RETK) + (size_t)(r0 + j) * 256 + h * 64 + dq; const bf16* V = (const bf16*)(p.ws + WS_RETV) + (size_t)(r0 + j) * 256 + h * 64 + dq;
      const float zf = expf((127.f - j) * lgf), zb = expf((float)j * lgb);
#pragma unroll
      for (int q8 = 0; q8 < 2; ++q8) { const u32x4 kw = *(const u32x4*)(K + q8 * 8), vw = *(const u32x4*)(V + q8 * 8);
          const unsigned kk[4] = {kw.x, kw.y, kw.z, kw.w}, vv[4] = {vw.x, vw.y, vw.z, vw.w};
#pragma unroll
          for (int q = 0; q < 4; ++q) { const int d = dq + q8 * 8 + 2 * q; const float k0 = __uint_as_float(kk[q] << 16), k1 = __uint_as_float(kk[q] & 0xffff0000u);
              KTf[d * PJ + j] = f2bf(k0 * zf); KTf[(d + 1) * PJ + j] = f2bf(k1 * zf); KTb[d * PJ + j] = f2bf(k0 * zb); KTb[(d + 1) * PJ + j] = f2bf(k1 * zb);
              VT[d * PJ + j] = (bf16)(vv[q] & 0xffffu); VT[(d + 1) * PJ + j] = (bf16)(vv[q] >> 16); } } }
    __syncthreads();
    const int fb = w >> 2, dt = w & 3; const LAS bf16* Am = fb == 0 ? KTf : KTb;
    f32x4 acc[4];
#pragma unroll
    for (int et = 0; et < 4; ++et) acc[et] = (f32x4){0.f, 0.f, 0.f, 0.f};
#pragma unroll
    for (int ks = 0; ks < 4; ++ks) { const bf16x8 af = frag(Am, dt * 16, PJ, ks * 32, lane);
#pragma unroll
        for (int et = 0; et < 4; ++et) acc[et] = mma(af, frag(VT, et * 16, PJ, ks * 32, lane), acc[et]); }
    float* S = (float*)(p.ws + WS_RETS) + ((size_t)((fb * 2 + b) * NCHUNK + n) * 4 + h) * 4096;
#pragma unroll
    for (int et = 0; et < 4; ++et)
#pragma unroll
        for (int r = 0; r < 4; ++r) S[(dt * 16 + 4 * (lane >> 4) + r) * 64 + et * 16 + (lane & 15)] = acc[et][r];
}
__device__ __forceinline__ void ret_scan_item(const P& p, int layer, int it) {
    const int e = it * NTHREADS + threadIdx.x;
    const int de = e & 4095, h = (e >> 12) & 3, b = (e >> 14) & 1, dir = e >> 15;
    const float lg = log_sigmoid(p.in[dir == 0 ? 10 : 11][layer * 4 + h]); const float g = expf(128.f * lg);
    float* S = (float*)(p.ws + WS_RETS) + (size_t)((dir * 2 + b) * NCHUNK) * 4 * 4096 + (size_t)h * 4096 + de;
    float kv[NCHUNK];
#pragma unroll
    for (int n = 0; n < NCHUNK; ++n) kv[n] = S[(size_t)n * 4 * 4096];
    float st = 0.f;
    if (dir == 0) {
#pragma unroll
        for (int n = 0; n < NCHUNK; ++n) { const float t = kv[n]; kv[n] = st; st = st * g + t; }
    } else {
#pragma unroll
        for (int i = 0; i < NCHUNK; ++i) { const int n = i < 2 ? 1 - i : NCHUNK + 1 - i; const float t = kv[n]; kv[n] = st; st = st * g + t; }
    }
    float* S2 = (float*)(p.ws + WS_RETS2) + (size_t)((dir * 2 + b) * NCHUNK) * 4 * 4096 + (size_t)h * 4096 + de;
#pragma unroll
    for (int n = 0; n < NCHUNK; ++n) S2[(size_t)n * 4 * 4096] = kv[n];
}
__device__ __forceinline__ void ret_out_item(const P& p, LAS unsigned char* lds, int layer, int it) {
    using namespace rt;
    const int tid = threadIdx.x, lane = tid & 63, w = tid >> 6; const int h = it & 3, n = (it >> 2) % NCHUNK, b = (it >> 2) / NCHUNK;
    LAS bf16* Qs = (LAS bf16*)lds; LAS bf16* Ks = Qs + 128 * PQ; LAS bf16* VT = Ks + 128 * PQ; LAS bf16* Ps = VT + 64 * PJ; LAS bf16* SfT = Ps + 128 * PJ; LAS bf16* SbT = SfT + 64 * PQ;
    LAS float* pf = (LAS float*)(SbT + 64 * PQ); LAS float* pb = pf + 132;
    const int r0 = chunk_row0(b, n);
    const float lgf = log_sigmoid(p.in[10][layer * 4 + h]), lgb = log_sigmoid(p.in[11][layer * 4 + h]);
    const float* S = (const float*)(p.ws + WS_RETS2);
    const float* sfp = S + ((size_t)((0 * 2 + b) * NCHUNK + n) * 4 + h) * 4096; const float* sbp = S + ((size_t)((1 * 2 + b) * NCHUNK + n) * 4 + h) * 4096;
    __syncthreads();
    { const int j = tid >> 2, dq = (tid & 3) * 16;
      const bf16* Q = (const bf16*)(p.ws + WS_RETQ) + (size_t)(r0 + j) * 256 + h * 64 + dq; const bf16* K = (const bf16*)(p.ws + WS_RETK) + (size_t)(r0 + j) * 256 + h * 64 + dq;
      *(LAS u32x4*)(Qs + j * PQ + dq) = *(const u32x4*)Q; *(LAS u32x4*)(Qs + j * PQ + dq + 8) = *(const u32x4*)(Q + 8);
      *(LAS u32x4*)(Ks + j * PQ + dq) = *(const u32x4*)K; *(LAS u32x4*)(Ks + j * PQ + dq + 8) = *(const u32x4*)(K + 8); }
    { const int j = tid & 127, dq = (tid >> 7) * 16;
      const bf16* V = (const bf16*)(p.ws + WS_RETV) + (size_t)(r0 + j) * 256 + h * 64 + dq;
#pragma unroll
      for (int q8 = 0; q8 < 2; ++q8) { const u32x4 vw = *(const u32x4*)(V + q8 * 8); const unsigned vv[4] = {vw.x, vw.y, vw.z, vw.w};
#pragma unroll
          for (int q = 0; q < 4; ++q) { const int d = dq + q8 * 8 + 2 * q; VT[d * PJ + j] = (bf16)(vv[q] & 0xffffu); VT[(d + 1) * PJ + j] = (bf16)(vv[q] >> 16); } } }
    { const int d = tid & 63, e0 = (tid >> 6) * 8;
#pragma unroll
      for (int q4 = 0; q4 < 2; ++q4) { const f32x4 a = *(const f32x4*)(sfp + d * 64 + e0 + q4 * 4), c = *(const f32x4*)(sbp + d * 64 + e0 + q4 * 4);
#pragma unroll
          for (int q = 0; q < 4; ++q) { SfT[(e0 + q4 * 4 + q) * PQ + d] = f2bf(a[q]); SbT[(e0 + q4 * 4 + q) * PQ + d] = f2bf(c[q]); } } }
    if (tid <= 128) { pf[tid] = expf((float)tid * lgf); pb[tid] = expf((float)tid * lgb); }
    __syncthreads();
    { const bf16x8 a0 = frag(Qs, 16 * w, PQ, 0, lane), a1 = frag(Qs, 16 * w, PQ, 32, lane);
#pragma unroll
      for (int jt = 0; jt < 8; ++jt) { f32x4 c = (f32x4){0.f, 0.f, 0.f, 0.f};
          c = mma(a0, frag(Ks, jt * 16, PQ, 0, lane), c); c = mma(a1, frag(Ks, jt * 16, PQ, 32, lane), c);
          const int j = jt * 16 + (lane & 15);
#pragma unroll
          for (int r = 0; r < 4; ++r) { const int i = 16 * w + 4 * (lane >> 4) + r; const float dm = i > j ? pf[i - j] : (i < j ? pb[j - i] : 2.f); Ps[i * PJ + j] = f2bf(c[r] * dm); } } }
    __syncthreads();
    f32x4 aP[4], aF[4], aB[4];
#pragma unroll
    for (int et = 0; et < 4; ++et) { aP[et] = (f32x4){0.f, 0.f, 0.f, 0.f}; aF[et] = aP[et]; aB[et] = aP[et]; }
#pragma unroll
    for (int ks = 0; ks < 4; ++ks) { const bf16x8 af = frag(Ps, 16 * w, PJ, ks * 32, lane);
#pragma unroll
        for (int et = 0; et < 4; ++et) aP[et] = mma(af, frag(VT, et * 16, PJ, ks * 32, lane), aP[et]); }
#pragma unroll
    for (int ks = 0; ks < 2; ++ks) { const bf16x8 af = frag(Qs, 16 * w, PQ, ks * 32, lane);
#pragma unroll
        for (int et = 0; et < 4; ++et) { aF[et] = mma(af, frag(SfT, et * 16, PQ, ks * 32, lane), aF[et]); aB[et] = mma(af, frag(SbT, et * 16, PQ, ks * 32, lane), aB[et]); } }
    const float* rg = p.in[12] + layer * 256 + h * 64;
    const bf16* G = (const bf16*)(p.ws + WS_RETG) + (size_t)r0 * 256 + h * 64; bf16* X = (bf16*)(p.ws + WS_X) + (size_t)r0 * 1536 + 512 + h * 64;
    float gt[4][4];
#pragma unroll
    for (int r = 0; r < 4; ++r)
#pragma unroll
        for (int et = 0; et < 4; ++et) gt[r][et] = bf2f(G[(size_t)(16 * w + 4 * (lane >> 4) + r) * 256 + et * 16 + (lane & 15)]);
#pragma unroll
    for (int r = 0; r < 4; ++r) { const int i = 16 * w + 4 * (lane >> 4) + r; const float xf = pf[i + 1], xb = pb[128 - i];
        float o[4]; float ss = 0.f;
#pragma unroll
        for (int et = 0; et < 4; ++et) { o[et] = aP[et][r] + xf * aF[et][r] + xb * aB[et][r]; ss += o[et] * o[et]; }
        ss += __shfl_xor(ss, 1); ss += __shfl_xor(ss, 2); ss += __shfl_xor(ss, 4); ss += __shfl_xor(ss, 8);
        const float rstd = rsqrtf(ss * (1.f / 64.f) + EPS);
#pragma unroll
        for (int et = 0; et < 4; ++et) { const int e = et * 16 + (lane & 15); Ps[i * PJ + e] = f2bf(o[et] * rstd * rg[e] * siluf_(gt[r][et])); } }
    asm volatile("s_waitcnt lgkmcnt(0)" ::: "memory");
#pragma unroll
    for (int q = 0; q < 2; ++q) { const int c = lane + 64 * q, i = 16 * w + (c >> 3), e8 = (c & 7) * 8;
        *(u32x4*)(X + (size_t)i * 1536 + e8) = *(const LAS u32x4*)(Ps + i * PJ + e8); }
    __syncthreads();
}

#include <hip/hip_bf16.h>
#include <cmath>
namespace attn_body {
using bf16=__hip_bfloat16;
using bf16x8=__attribute__((ext_vector_type(8)))short;
using s16x4=__attribute__((ext_vector_type(4)))short;
using f32x16=__attribute__((ext_vector_type(16)))float;
using u32x4=__attribute__((ext_vector_type(4)))unsigned;
constexpr int D=64, QP=512, KP=128, OP=1536;
constexpr int NW=8,QBLK=32,QB=QBLK*NW,KVBLK=64;
__device__ __forceinline__ int crow(int r,int hi){return (r&3)+8*(r>>2)+4*hi;}
#define SBAR() __builtin_amdgcn_sched_barrier(0)
__device__ __forceinline__ void cmask(f32x16&p0,f32x16&p1,int jb,int qrel,int hi){
  const float NEG=-INFINITY; int kb=64*jb+4*hi;
  #pragma unroll
  for(int r=0;r<16;++r){int kv=kb+(r&3)+8*(r>>2); if(kv>qrel)p0[r]=NEG; if(kv+32>qrel)p1[r]=NEG;}
}

constexpr int NSLOT=3, SLOTB=8192;
constexpr int LDS_K=0, LDS_V=NSLOT*SLOTB, LDS_WS=2*NSLOT*SLOTB, LDS_OST=LDS_WS+NW*64*4, LDS_BYTES=LDS_OST+NW*4096;
constexpr float C2=0.125f*1.4426950408889634f;
__device__ __forceinline__ void glds16(const void*gsrc,unsigned lds_dst){unsigned keep;
  asm volatile("s_mov_b32 %0, m0\n\ts_mov_b32 m0, %2\n\ts_nop 0\n\tglobal_load_lds_dwordx4 %1, off\n\ts_mov_b32 m0, %0":"=&s"(keep):"v"(gsrc),"s"(lds_dst):"memory");}
__device__ __forceinline__ float max3f(float a,float b,float c){float r;asm("v_max3_f32 %0, %1, %2, %3":"=v"(r):"v"(a),"v"(b),"v"(c));return r;}
__device__ __forceinline__ float max2f(float a,float b){float r;asm("v_max_f32_e32 %0, %1, %2":"=v"(r):"v"(a),"v"(b));return r;}
__device__ __forceinline__ float fadd_s(float a,float b){float r;asm("v_add_f32_e32 %0, %1, %2":"=v"(r):"v"(a),"v"(b));return r;}
__device__ __forceinline__ float fsub_s(float a,float b){float r;asm("v_sub_f32_e32 %0, %1, %2":"=v"(r):"v"(a),"v"(b));return r;}
typedef float f32x2_t __attribute__((ext_vector_type(2))); typedef __bf16 bf16x2_t __attribute__((ext_vector_type(2)));
__device__ __forceinline__ unsigned cvtpk_s(float lo,float hi){f32x2_t v={lo,hi};bf16x2_t b=__builtin_convertvector(v,bf16x2_t);return __builtin_bit_cast(unsigned,b);}
#define WAIT_BAR(N) asm volatile("s_waitcnt vmcnt(" #N ") lgkmcnt(0)\n\ts_barrier":::"memory")

__device__ __forceinline__ void qkt(f32x16&p0,f32x16&p1,const char*Kslot,const bf16x8*qr,const f32x16&negm,int r32,int hi){
  const char*kb=Kslot+hi*1024+r32*16;
  #pragma unroll
  for(int d0=0;d0<4;++d0){
    const bf16x8 b0=*reinterpret_cast<const bf16x8*>(kb+d0*2048);
    const bf16x8 b1=*reinterpret_cast<const bf16x8*>(kb+d0*2048+512);
    if(d0==0){p0=__builtin_amdgcn_mfma_f32_32x32x16_bf16(b0,qr[0],negm,0,0,0);p1=__builtin_amdgcn_mfma_f32_32x32x16_bf16(b1,qr[0],negm,0,0,0);}
    else{p0=__builtin_amdgcn_mfma_f32_32x32x16_bf16(b0,qr[d0],p0,0,0,0);p1=__builtin_amdgcn_mfma_f32_32x32x16_bf16(b1,qr[d0],p1,0,0,0);}}
}
typedef __attribute__((address_space(3))) const char* lds_cptr;
typedef short v4i16_t __attribute__((ext_vector_type(4)));
__device__ __forceinline__ void kload8(bf16x8*kf,lds_cptr kp){
  kf[0]=*(const __attribute__((address_space(3))) bf16x8*)(kp);      kf[1]=*(const __attribute__((address_space(3))) bf16x8*)(kp+512);
  kf[2]=*(const __attribute__((address_space(3))) bf16x8*)(kp+2048); kf[3]=*(const __attribute__((address_space(3))) bf16x8*)(kp+2560);
  kf[4]=*(const __attribute__((address_space(3))) bf16x8*)(kp+4096); kf[5]=*(const __attribute__((address_space(3))) bf16x8*)(kp+4608);
  kf[6]=*(const __attribute__((address_space(3))) bf16x8*)(kp+6144); kf[7]=*(const __attribute__((address_space(3))) bf16x8*)(kp+6656);
}
__device__ __forceinline__ void kload2(bf16x8*kf,lds_cptr kp,int j){ kf[2*j]=*(const __attribute__((address_space(3))) bf16x8*)(kp+j*2048); kf[2*j+1]=*(const __attribute__((address_space(3))) bf16x8*)(kp+j*2048+512); }
__device__ __forceinline__ s16x4 vtr(lds_cptr p){ return __builtin_bit_cast(s16x4,__builtin_amdgcn_ds_read_tr16_b64_v4i16((__attribute__((address_space(3))) v4i16_t*)p)); }
__device__ __forceinline__ float rowmax(const f32x16&p0,const f32x16&p1){
  float a=max3f(p0[0],p0[1],p1[0]),b=max3f(p0[2],p0[3],p1[1]);a=max3f(a,p1[2],p1[3]);
  #pragma unroll
  for(int r=4;r<16;r+=4){a=max3f(a,p0[r],p0[r+1]);b=max3f(b,p0[r+2],p0[r+3]);a=max3f(a,p1[r],p1[r+1]);b=max3f(b,p1[r+2],p1[r+3]);}
  const float m=max2f(a,b);
  auto rr=__builtin_amdgcn_permlane32_swap(__float_as_uint(m),__float_as_uint(m),false,false);
  return max2f(__uint_as_float(rr[0]),__uint_as_float(rr[1]));
}
__device__ __forceinline__ void pv(f32x16*o,int vb,bf16x8 pa0,bf16x8 pa1,bf16x8 pa2,bf16x8 pa3){
  #pragma unroll
  for(int d0=0;d0<2;++d0){s16x4 lo[4],hi[4];
    #pragma unroll
    for(int ks=0;ks<4;++ks){
      asm volatile("ds_read_b64_tr_b16 %0,%1 offset:%c2":"=&v"(lo[ks]):"v"(vb),"i"(d0*4096+ks*1024):"memory");
      asm volatile("ds_read_b64_tr_b16 %0,%1 offset:%c2":"=&v"(hi[ks]):"v"(vb),"i"(d0*4096+ks*1024+512):"memory");}
    asm volatile("s_waitcnt lgkmcnt(0)":::"memory");SBAR();
    #define PK(k) (bf16x8){lo[k][0],lo[k][1],lo[k][2],lo[k][3],hi[k][0],hi[k][1],hi[k][2],hi[k][3]}
    o[d0]=__builtin_amdgcn_mfma_f32_32x32x16_bf16(pa0,PK(0),o[d0],0,0,0);
    o[d0]=__builtin_amdgcn_mfma_f32_32x32x16_bf16(pa1,PK(1),o[d0],0,0,0);
    o[d0]=__builtin_amdgcn_mfma_f32_32x32x16_bf16(pa2,PK(2),o[d0],0,0,0);
    o[d0]=__builtin_amdgcn_mfma_f32_32x32x16_bf16(pa3,PK(3),o[d0],0,0,0);
    #undef PK
  }
}

#ifndef ATTN_STORE16
#define ATTN_STORE16(p,v) (*(u32x4*)(p)=(v))
#endif
template<int THRL> __device__ __forceinline__ void attn_unit(const bf16*Q0,const bf16*__restrict__ Kh,const bf16*__restrict__ Vh,bf16*O0,const int NT,char*shm){
  const int tid=threadIdx.x,lane=tid&63,r32=lane&31,hi=lane>>5; const int wid=__builtin_amdgcn_readfirstlane(tid>>6);
  const bf16*Qw=Q0+(long)(wid*QBLK)*QP;
  const unsigned lds0=(unsigned)(uintptr_t)shm;
  float*wsf=(float*)(shm+LDS_WS)+wid*64;
  const bf16*ksrc=Kh+(long)lane*KP+wid*8;
  const bf16*vsrc=Vh+(long)(16*(wid&3)+(lane>>2))*KP+(wid>>2)*32+(lane&3)*8;
  const unsigned kdst=lds0+LDS_K+wid*1024, vdst=lds0+LDS_V+wid*1024;
  #define DMA_K(t,slot) glds16(ksrc+(long)(t)*KVBLK*KP,(unsigned)__builtin_amdgcn_readfirstlane(kdst+(slot)))
  #define DMA_V(t,slot) glds16(vsrc+(long)(t)*KVBLK*KP,(unsigned)__builtin_amdgcn_readfirstlane(vdst+(slot)))
  const int vb0=(int)(lds0+LDS_V)+((lane>>4)&1)*32+(lane&3)*8+(4*hi+((lane&15)>>2))*64;
  const char*Kbase=shm+LDS_K; bf16x8 kf[8];
  const lds_cptr shm3=(lds_cptr)shm; const lds_cptr kp0=shm3+LDS_K+hi*1024+r32*16; const lds_cptr vp0=shm3+LDS_V+((lane>>4)&1)*32+(lane&3)*8+(4*hi+((lane&15)>>2))*64;
  DMA_K(0,0);DMA_V(0,0);DMA_K(1,SLOTB);
  bf16x8 qr[4];
  #pragma unroll
  for(int d0=0;d0<4;++d0)qr[d0]=*reinterpret_cast<const bf16x8*>(&Qw[(long)r32*QP+d0*16+hi*8]);
  float mhat=0.f,l_reg=0.f;f32x16 o[2];o[0]=f32x16{};o[1]=f32x16{};f32x16 negm=f32x16{};asm volatile("":"+v"(negm));
  #define CMASK(P0,P1,t) do{}while(0)
  bool resc=false;
  #define START(P0,P1) do{ const float rm=rowmax(P0,P1); resc=false; \
    { const float dl=rm; mhat=fadd_s(mhat,dl); \
      _Pragma("unroll") for(int r=0;r<16;++r){P0[r]=fsub_s(P0[r],dl);P1[r]=fsub_s(P1[r],dl);} \
      _Pragma("unroll") for(int r=0;r<16;++r)negm[r]=-mhat; asm volatile("":"+v"(negm)); } \
    _Pragma("unroll") for(int r=0;r<16;++r)P0[r]=__builtin_amdgcn_exp2f(P0[r]); }while(0)
  #define RESC() do{ if(resc){ asm volatile("s_waitcnt lgkmcnt(0)":::"memory"); \
      _Pragma("unroll") for(int d_=0;d_<2;++d_) _Pragma("unroll") for(int r=0;r<16;++r)o[d_][r]*=wsf[crow(r,hi)]; } }while(0)
  f32x16 pA0,pA1,pB0,pB1;
  int sl_prev=0,sl_cur=0,sl_next=SLOTB;
  #define ROT() do{sl_prev=sl_cur;sl_cur=sl_next;sl_next=(sl_next==(NSLOT-1)*SLOTB)?0:sl_next+SLOTB;}while(0)
  DMA_K(2,2*SLOTB);
  WAIT_BAR(3);
  qkt(pA0,pA1,Kbase,qr,negm,r32,hi);asm volatile("s_nop 15\n\ts_nop 7":"+v"(pA0),"+v"(pA1));CMASK(pA0,pA1,0);
  START(pA0,pA1);
  _Pragma("unroll") for(int r=0;r<16;++r)pA1[r]=__builtin_amdgcn_exp2f(pA1[r]);
  WAIT_BAR(0);
  DMA_K(3,0);DMA_V(1,SLOTB);
  ROT();
  kload8(kf,kp0+sl_cur);
  WAIT_BAR(2);
  s16x4 vlo[8],vhi[8]; u32x4 pw0,pw1,pw2,pw3;
  #define PKW(P,B) cvtpk_s(P[B],P[B+1])
  #define PAF(k) __builtin_bit_cast(bf16x8,pw##k)
  #define VFR(i) (bf16x8){vlo[i][0],vlo[i][1],vlo[i][2],vlo[i][3],vhi[i][0],vhi[i][1],vhi[i][2],vhi[i][3]}
  #define PIN(x) asm volatile("":"+v"(x))
  #define MX3(a,b,c) __builtin_fmaxf(__builtin_fmaxf((a),(b)),(c))
  #define GAPA(MF,A0,A1,A2,A3,W0,W1,PW) do{ MF; sacc+=A0; sacc+=A1; sacc+=A2; sacc+=A3; PIN(sacc); W0; W1; PIN(PW); SBAR(); }while(0)
  #define EX(v) __builtin_amdgcn_exp2f(v)
  #define GAPB(MF,X,B) do{ MF; X[B]=EX(X[B]); X[B+1]=EX(X[B+1]); X[B+2]=EX(X[B+2]); X[B+3]=EX(X[B+3]); PIN(X); SBAR(); }while(0)
  #define VRD(i) do{ vlo[i]=vtr(vp_+(((i)>>2)*4096+((i)&3)*1024)); vhi[i]=vtr(vp_+(((i)>>2)*4096+((i)&3)*1024+512)); }while(0)
  #define KRD(G,j) do{ if(G){ kload2(kf,kp0+sl_next,j); SBAR(); } }while(0)
  #define STEP(C0,C1,P0,P1,t,GK,GV,GL) do{ SBAR(); \
    const lds_cptr vp_=vp0+sl_prev; \
    VRD(0); SBAR(); float sacc=(P0[0]+P0[1]); \
    GAPA(C0=__builtin_amdgcn_mfma_f32_32x32x16_bf16(kf[0],qr[0],negm,0,0,0), P0[2],P0[3],P0[4],P0[5],     pw0[0]=PKW(P0,0), pw0[1]=PKW(P0,2), pw0); \
    VRD(4); SBAR(); GAPA(C1=__builtin_amdgcn_mfma_f32_32x32x16_bf16(kf[1],qr[0],negm,0,0,0), P0[6],P0[7],P0[8],P0[9],     pw0[2]=PKW(P0,4), pw0[3]=PKW(P0,6), pw0); \
    VRD(1); SBAR(); GAPA(C0=__builtin_amdgcn_mfma_f32_32x32x16_bf16(kf[2],qr[1],C0,0,0,0),   P0[10],P0[11],P0[12],P0[13], pw1[0]=PKW(P0,8), pw1[1]=PKW(P0,10), pw1); \
    VRD(5); SBAR(); GAPA(C1=__builtin_amdgcn_mfma_f32_32x32x16_bf16(kf[3],qr[1],C1,0,0,0),   P0[14],P0[15],P1[0],P1[1],   pw1[2]=PKW(P0,12),pw1[3]=PKW(P0,14), pw1); \
    VRD(2); SBAR(); GAPA(C0=__builtin_amdgcn_mfma_f32_32x32x16_bf16(kf[4],qr[2],C0,0,0,0),   P1[2],P1[3],P1[4],P1[5],     pw2[0]=PKW(P1,0), pw2[1]=PKW(P1,2), pw2); \
    VRD(6); SBAR(); GAPA(C1=__builtin_amdgcn_mfma_f32_32x32x16_bf16(kf[5],qr[2],C1,0,0,0),   P1[6],P1[7],P1[8],P1[9],     pw2[2]=PKW(P1,4), pw2[3]=PKW(P1,6), pw2); \
    VRD(3); SBAR(); GAPA(C0=__builtin_amdgcn_mfma_f32_32x32x16_bf16(kf[6],qr[3],C0,0,0,0),   P1[10],P1[11],P1[12],P1[13], pw3[0]=PKW(P1,8), pw3[1]=PKW(P1,10), pw3); \
    VRD(7); SBAR(); GAPA(C1=__builtin_amdgcn_mfma_f32_32x32x16_bf16(kf[7],qr[3],C1,0,0,0),   P1[14],P1[15],0.f,0.f,       pw3[2]=PKW(P1,12),pw3[3]=PKW(P1,14), pw3); \
    l_reg+=sacc; \
    if(GK){DMA_K((t)+3,sl_cur);} if(GV){DMA_V((t)+1,sl_next);} \
    CMASK(C0,C1,t); \
    { float a=MX3(C0[0],C0[1],C1[0]),b=MX3(C0[2],C0[3],C1[1]); a=MX3(a,C1[2],C1[3]); \
      _Pragma("unroll") for(int r=4;r<16;r+=4){a=MX3(a,C0[r],C0[r+1]);b=MX3(b,C0[r+2],C0[r+3]);a=MX3(a,C1[r],C1[r+1]);b=MX3(b,C1[r+2],C1[r+3]);} \
      float rm=__builtin_fmaxf(a,b); { auto rr=__builtin_amdgcn_permlane32_swap(__float_as_uint(rm),__float_as_uint(rm),false,false); rm=__builtin_fmaxf(__uint_as_float(rr[0]),__uint_as_float(rr[1])); } \
      resc=false; \
      if(__builtin_expect(__any(rm>(float)THRL),0)){ const float dl=__builtin_fmaxf(rm,0.f); mhat+=dl; \
        _Pragma("unroll") for(int r=0;r<16;++r){C0[r]-=dl;C1[r]-=dl;} \
        _Pragma("unroll") for(int r=0;r<16;++r)negm[r]=-mhat; asm volatile("":"+v"(negm)); \
        const float f=__builtin_amdgcn_exp2f(-dl); l_reg*=f; if(hi==0)wsf[r32]=f; resc=true; } } \
    SBAR(); \
    GAPB(o[0]=__builtin_amdgcn_mfma_f32_32x32x16_bf16(PAF(0),VFR(0),o[0],0,0,0), C0,0); \
    GAPB(o[1]=__builtin_amdgcn_mfma_f32_32x32x16_bf16(PAF(0),VFR(4),o[1],0,0,0), C0,4); \
    KRD(GL,0); GAPB(o[0]=__builtin_amdgcn_mfma_f32_32x32x16_bf16(PAF(1),VFR(1),o[0],0,0,0), C0,8); \
    KRD(GL,1); GAPB(o[1]=__builtin_amdgcn_mfma_f32_32x32x16_bf16(PAF(1),VFR(5),o[1],0,0,0), C0,12); \
    KRD(GL,2); GAPB(o[0]=__builtin_amdgcn_mfma_f32_32x32x16_bf16(PAF(2),VFR(2),o[0],0,0,0), C1,0); \
    KRD(GL,3); GAPB(o[1]=__builtin_amdgcn_mfma_f32_32x32x16_bf16(PAF(2),VFR(6),o[1],0,0,0), C1,4); \
    GAPB(o[0]=__builtin_amdgcn_mfma_f32_32x32x16_bf16(PAF(3),VFR(3),o[0],0,0,0), C1,8); \
    GAPB(o[1]=__builtin_amdgcn_mfma_f32_32x32x16_bf16(PAF(3),VFR(7),o[1],0,0,0), C1,12); \
    }while(0)
  int t=1;
  #undef CMASK
  #define CMASK(P0,P1,t) do{}while(0)
  for(;t+5<NT;t+=2){
    STEP(pB0,pB1,pA0,pA1,t,true,true,true);     WAIT_BAR(2); RESC(); ROT();
    STEP(pA0,pA1,pB0,pB1,t+1,true,true,true);   WAIT_BAR(2); RESC(); ROT();
  }
  #undef CMASK
  #define CMASK(P0,P1,t) do{}while(0)
  #define ENDW(tt) do{ if((tt)+3<NT){WAIT_BAR(2);} else if((tt)+2<NT){WAIT_BAR(1);} else {WAIT_BAR(0);} }while(0)
  for(;t+1<NT;t+=2){
    STEP(pB0,pB1,pA0,pA1,t,(t+3<NT),(t+1<NT),(t+1<NT));       ENDW(t);   RESC(); ROT();
    STEP(pA0,pA1,pB0,pB1,t+1,(t+4<NT),(t+2<NT),(t+2<NT));     ENDW(t+1); RESC(); ROT();
  }
  STEP(pB0,pB1,pA0,pA1,NT-1,false,false,false); RESC();
  { float sacc=pB0[0]+pB0[1]; _Pragma("unroll") for(int r=2;r<16;++r)sacc+=pB0[r]; _Pragma("unroll") for(int r=0;r<16;++r)sacc+=pB1[r]; l_reg+=sacc;
    pw0=(u32x4){PKW(pB0,0),PKW(pB0,2),PKW(pB0,4),PKW(pB0,6)};pw1=(u32x4){PKW(pB0,8),PKW(pB0,10),PKW(pB0,12),PKW(pB0,14)};pw2=(u32x4){PKW(pB1,0),PKW(pB1,2),PKW(pB1,4),PKW(pB1,6)};pw3=(u32x4){PKW(pB1,8),PKW(pB1,10),PKW(pB1,12),PKW(pB1,14)};
    SBAR(); pv(o,vb0+sl_cur,PAF(0),PAF(1),PAF(2),PAF(3)); }
  #undef PKW
  #undef PAF
  #undef VFR
  #undef PIN
  #undef MX3
  #undef GAPA
  #undef GAPB
  #undef EX
  #undef VRD
  #undef KRD
  #undef STEP
  #undef ENDW
  {auto rr=__builtin_amdgcn_permlane32_swap(__float_as_uint(l_reg),__float_as_uint(l_reg),false,false);l_reg=__uint_as_float(rr[0])+__uint_as_float(rr[1]);}
  if(hi==0)wsf[32+r32]=l_reg;asm volatile("s_waitcnt lgkmcnt(0)":::"memory");
  float rli[16];
  #pragma unroll
  for(int r=0;r<16;++r)rli[r]=__builtin_amdgcn_rcpf(wsf[32+crow(r,hi)]);
  bf16*Ow=O0+(long)(wid*QBLK)*OP;
  { bf16*stg=(bf16*)(shm+LDS_OST)+wid*2048;
    #pragma unroll
    for(int r=0;r<16;++r){const int orow=crow(r,hi);
      #pragma unroll
      for(int d0=0;d0<2;++d0)stg[orow*64+d0*32+r32]=__float2bfloat16(o[d0][r]*rli[r]);}
    asm volatile("s_waitcnt lgkmcnt(0)":::"memory");
    #pragma unroll
    for(int i=0;i<4;++i){const int row=i*8+(lane>>3),ch=lane&7; const u32x4 v=*(const u32x4*)(stg+row*64+ch*8); ATTN_STORE16(Ow+(long)row*OP+ch*8,v);} }
  asm volatile("s_waitcnt lgkmcnt(0)\n\ts_barrier":::"memory");
  #undef DMA_K
  #undef DMA_V
  #undef CMASK
  #undef START
  #undef RESC
  #undef ROT
}
constexpr int ATTN_LDS_BYTES=LDS_BYTES;
#undef SBAR
#undef WAIT_BAR
}

__device__ __forceinline__ void attn_phase_run(const P& p, unsigned char* lds_generic, int layer) {
    typedef attn_body::bf16 abf;
    const int G = gridDim.x, bx = blockIdx.x, vcu = (G % 8 == 0) ? (bx % 8) * (G / 8) + bx / 8 : bx;
    const abf* Q = (const abf*)(p.ws + WS_ATTQ); const abf* K = (const abf*)(p.ws + WS_ATTK); const abf* V = (const abf*)(p.ws + WS_ATTV); abf* X = (abf*)(p.ws + WS_X);
    if (G == 256) {
        const int x = vcu >> 5, qb = vcu & 31, b = x >> 2, kvh = (x >> 1) & 1;
#pragma unroll 1
        for (int i = 0; i < 2; ++i) { const int h = kvh * 4 + 2 * (x & 1) + i; const long r0 = (long)b * SEQ + qb * 256;
            attn_body::attn_unit<8>(Q + r0 * 512 + h * 64, K + (long)b * KEYS * 128 + kvh * 64, V + (long)b * KEYS * 128 + kvh * 64, X + r0 * 1536 + 768 + h * 64, KEYS / 64, (char*)lds_generic); }
    } else {
#pragma unroll 1
        for (int u = vcu; u < 512; u += G) { const int qb = u & 31, h = (u >> 5) & 7, b = u >> 8, kvh = h >> 2; const long r0 = (long)b * SEQ + qb * 256;
            attn_body::attn_unit<8>(Q + r0 * 512 + h * 64, K + (long)b * KEYS * 128 + kvh * 64, V + (long)b * KEYS * 128 + kvh * 64, X + r0 * 1536 + 768 + h * 64, KEYS / 64, (char*)lds_generic); }
    }
    if (layer == 0) {
#pragma unroll 1
        for (int u = vcu; u < 16; u += G) { const int b = u >> 3, h = u & 7, kvh = h >> 2; const long r0 = NLAT + (long)b * CTX;
            attn_body::attn_unit<8>(Q + r0 * 512 + h * 64, K + (long)b * KEYS * 128 + kvh * 64, V + (long)b * KEYS * 128 + kvh * 64, X + r0 * 1536 + 768 + h * 64, CTX / 64, (char*)lds_generic); }
    }
}

__device__ __forceinline__ void ph_fft1(const P& p, LAS unsigned char* lds, int layer) {
    int nt2 = 2; asm volatile("" : "+s"(nt2));
    { fg::PlainSched S{(const char*)(p.ws + WS_F1), (const char*)(p.ws + WS_UT), 256, 256, 1, 128, (int)gridDim.x, (int)blockIdx.x, nt2};
      fg::EpiFft1 E{p.ws}; fg::gemm_phase(lds, 256, 256, S, E); }
    if (layer == 0) { fg::PlainSched S{(const char*)(p.ws + WS_FC), (const char*)(p.ws + WS_UTC), 256, 256, 2, 2, (int)gridDim.x, (int)((blockIdx.x + 128) % gridDim.x), 4};
      fg::EpiFftC E{p.ws}; fg::gemm_phase(lds, 256, 256, S, E); }
}
__device__ __forceinline__ void ph_fft3(const P& p, LAS unsigned char* lds) {
    int nt2 = 2; asm volatile("" : "+s"(nt2));
    fg::PlainSched S{(const char*)(p.ws + WS_F2), (const char*)(p.ws + WS_Z), 256, 256, 1, 256, (int)gridDim.x, (int)blockIdx.x, nt2};
    fg::EpiFft3 E{p.ws}; fg::gemm_phase(lds, 256, 256, S, E);
}
__device__ __forceinline__ void ph_mix1(const P& p, LAS unsigned char* lds, int layer) {
    ph_fft1(p, lds, layer);
    const int nconv = layer == 0 ? 264 : 256;
    const int n0 = nconv, n1 = n0 + NB * NCHUNK * 4;
    for (int it = gridDim.x - 1 - blockIdx.x; it < n1; it += gridDim.x) {
        if (it < n0) { if (it < 256) conv_item(p, lds, layer, it >> 7, (it & 127) * 64); else conv_item(p, lds, layer, 2 + ((it - 256) >> 2), ((it - 256) & 3) * 64); }
        else ret_kv_item(p, lds, layer, it - n0);
    }
    __syncthreads();
}
__device__ __forceinline__ void ph_mix2(const P& p, LAS unsigned char* lds, unsigned char* lds_generic, int layer) {
    for (int it = blockIdx.x; it < 128; it += gridDim.x) ret_scan_item(p, layer, it);
    __syncthreads();
    ph_fft3(p, lds);
    attn_phase_run(p, lds_generic, layer);
    __syncthreads();
}
__device__ __forceinline__ void ph_mix3(const P& p, LAS unsigned char* lds, int layer, bool ctxlater) {
    for (int it = blockIdx.x; it < NB * NCHUNK * 4; it += gridDim.x) {
        const int n = (it >> 2) % NCHUNK; if ((layer == 1 || ctxlater) && n < 2) continue;
        ret_out_item(p, lds, layer, it);
    }
    __syncthreads();
}
__device__ __forceinline__ void ctx_ret_items(const P& p, LAS unsigned char* lds) {
    const int u = blockIdx.x;
    if (u < 16) { const int b = u >> 3, n = (u >> 2) & 1, h = u & 3;
        ret_out_item(p, lds, 0, (b * NCHUNK + n) * 4 + h);
        asm volatile("s_waitcnt vmcnt(0)" ::: "memory"); __syncthreads();
        if (threadIdx.x == 0) { __builtin_amdgcn_fence(__ATOMIC_RELEASE, "agent");
            __hip_atomic_fetch_add((unsigned*)(p.ws + WS_CTL) + CW_CCNT + (8 * 3) * 16, 1u, __ATOMIC_RELAXED, __HIP_MEMORY_SCOPE_AGENT); }
        __syncthreads(); }
}
__device__ __forceinline__ void ctx_ret_wait(const P& p) {
    if (threadIdx.x == 0) { unsigned* c = (unsigned*)(p.ws + WS_CTL) + CW_CCNT + (8 * 3) * 16; unsigned* tmo = (unsigned*)(p.ws + WS_CTL) + CW_TMO; unsigned sp = 0u;
        while (__hip_atomic_load(c, __ATOMIC_RELAXED, __HIP_MEMORY_SCOPE_AGENT) < 16u) { __builtin_amdgcn_s_sleep(1);
            if ((++sp & 255u) == 0u) { if (__hip_atomic_load(tmo, __ATOMIC_RELAXED, __HIP_MEMORY_SCOPE_AGENT)) break; if (sp > (1u << 22)) { atomicAdd(tmo, 1u); break; } } }
        __builtin_amdgcn_fence(__ATOMIC_ACQUIRE, "agent"); }
    __syncthreads();
}

namespace sk {
typedef short bf16x8 __attribute__((ext_vector_type(8)));
__device__ __forceinline__ void tile64(LAS unsigned char* lds, const bf16* A, int lda, const bf16* Bt, int ldb, int K, float (&out)[8]) {
    const int tid = threadIdx.x, lane = tid & 63, w = tid >> 6, kc = K >> 3;
    const bf16* ap = A + (size_t)(lane & 15) * lda + w * kc + 8 * (lane >> 4); const bf16* bp = Bt + (size_t)(lane & 15) * ldb + w * kc + 8 * (lane >> 4);
    f32x4 acc[4][4];
#pragma unroll
    for (int i = 0; i < 4; ++i)
#pragma unroll
        for (int j = 0; j < 4; ++j) acc[i][j] = (f32x4){0.f, 0.f, 0.f, 0.f};
#pragma unroll 2
    for (int k0 = 0; k0 < kc; k0 += 32) {
        bf16x8 af[4], bfr[4];
#pragma unroll
        for (int i = 0; i < 4; ++i) { af[i] = *(const bf16x8*)(ap + (size_t)(16 * i) * lda + k0); bfr[i] = *(const bf16x8*)(bp + (size_t)(16 * i) * ldb + k0); }
#pragma unroll
        for (int i = 0; i < 4; ++i)
#pragma unroll
            for (int j = 0; j < 4; ++j) acc[i][j] = __builtin_amdgcn_mfma_f32_16x16x32_bf16(af[i], bfr[j], acc[i][j], 0, 0, 0);
    }
    LAS float* part = (LAS float*)lds;
    __syncthreads();
#pragma unroll
    for (int i = 0; i < 4; ++i)
#pragma unroll
        for (int j = 0; j < 4; ++j)
#pragma unroll
            for (int r = 0; r < 4; ++r) part[((w * 16 + i * 4 + j) * 4 + r) * 64 + lane] = acc[i][j][r];
    __syncthreads();
#pragma unroll
    for (int q = 0; q < 8; ++q) { float sacc = 0.f;
#pragma unroll
        for (int ww = 0; ww < 8; ++ww) sacc += part[ww * 4096 + tid + 512 * q];
        out[q] = sacc; }
}
__device__ __forceinline__ void tile64_f8(LAS unsigned char* lds, const unsigned char* A, int lda, const unsigned char* Bt, int ldb, int K, float (&out)[8]) {
    const int tid = threadIdx.x, lane = tid & 63, w = tid >> 6;
    const unsigned char* ap = A + (size_t)(lane & 15) * lda + 32 * (lane >> 4); const unsigned char* bp = Bt + (size_t)(lane & 15) * ldb + 32 * (lane >> 4);
    f32x4 acc[4][4];
#pragma unroll
    for (int i = 0; i < 4; ++i)
#pragma unroll
        for (int j = 0; j < 4; ++j) acc[i][j] = (f32x4){0.f, 0.f, 0.f, 0.f};
    for (int ks = w; ks * 128 < K; ks += 8) {
        fg::i32x8 af[4], bfr[4];
#pragma unroll
        for (int i = 0; i < 4; ++i) { af[i] = *(const fg::i32x8*)(ap + (size_t)(16 * i) * lda + ks * 128); bfr[i] = *(const fg::i32x8*)(bp + (size_t)(16 * i) * ldb + ks * 128); }
#pragma unroll
        for (int i = 0; i < 4; ++i)
#pragma unroll
            for (int j = 0; j < 4; ++j) acc[i][j] = __builtin_amdgcn_mfma_scale_f32_16x16x128_f8f6f4(af[i], bfr[j], acc[i][j], 0, 0, 0, 0x7f7f7f7f, 0, 0x7a7a7a7a);
    }
    LAS float* part = (LAS float*)lds;
    __syncthreads();
#pragma unroll
    for (int i = 0; i < 4; ++i)
#pragma unroll
        for (int j = 0; j < 4; ++j)
#pragma unroll
            for (int r = 0; r < 4; ++r) part[((w * 16 + i * 4 + j) * 4 + r) * 64 + lane] = acc[i][j][r];
    __syncthreads();
#pragma unroll
    for (int q = 0; q < 8; ++q) { float sacc = 0.f;
#pragma unroll
        for (int ww = 0; ww < 8; ++ww) sacc += part[ww * 4096 + tid + 512 * q];
        out[q] = sacc; }
}
__device__ __forceinline__ void elem_rc(int tid, int q, int& row, int& col) { const int e = tid + 512 * q, t16 = e >> 8, reg = (e >> 6) & 3, lane = e & 63; row = 16 * (t16 >> 2) + 4 * (lane >> 4) + reg; col = 16 * (t16 & 3) + (lane & 15); }
}
__device__ __forceinline__ void mini_merge_ctx(const P& p, LAS unsigned char* lds, int layer) {
    const bf16* X = (const bf16*)(p.ws + WS_X); const bf16* WB = (const bf16*)(p.ws + WS_WB) + (size_t)layer * 1024 * 1536; const unsigned char* G = (const unsigned char*)(p.ws + WS_G); bf16* Mg = (bf16*)(p.ws + WS_MERGED);
    for (int it = gridDim.x - 1 - blockIdx.x; it < (NCTX / 64) * 16; it += gridDim.x) { const int r0 = NLAT + (it >> 4) * 64, c0 = (it & 15) * 64;
        float tot[8];
#pragma unroll
        for (int q = 0; q < 8; ++q) tot[q] = 0.f;
#pragma unroll 1
        for (int br = 0; br < 4; ++br) { const int koff = br == 0 ? 0 : (br == 1 ? 512 : (br == 2 ? 768 : 1280)), klen = (br & 1) ? 256 : 512;
            float o[8]; sk::tile64(lds, X + (size_t)r0 * 1536 + koff, 1536, WB + (size_t)c0 * 1536 + koff, 1536, klen, o);
#pragma unroll
            for (int q = 0; q < 8; ++q) { int rr, cc; sk::elem_rc(threadIdx.x, q, rr, cc); tot[q] += o[q] * ((float)G[(size_t)(r0 + rr) * 4096 + br * 1024 + c0 + cc] * (1.f / 255.f)); } }
#pragma unroll
        for (int q = 0; q < 8; ++q) { int rr, cc; sk::elem_rc(threadIdx.x, q, rr, cc); Mg[(size_t)(r0 + rr) * 1024 + c0 + cc] = f2bf(tot[q]); } }
    __syncthreads();
}
__device__ __forceinline__ void mini_resid_ctx(const P& p, LAS unsigned char* lds, int layer, const bf16* A, int lda, const bf16* Bt, int K, int chunk, int xnorm = -1, int nlayer = 0, int nwhich = 0, const float* hsrc = nullptr) {
    const float* g = mods(p, layer, 2, chunk); float* hc = (float*)(p.ws + WS_HCTX); if (hsrc == nullptr) hsrc = hc;
    for (int it = gridDim.x - 1 - blockIdx.x; it < (NCTX / 64) * 16; it += gridDim.x) { const int rl = (it >> 4) * 64, c0 = (it & 15) * 64;
        float o[8]; sk::tile64(lds, A + (size_t)(NLAT + rl) * lda, lda, Bt + (size_t)c0 * K, K, K, o);
        if (xnorm < 0) {
#pragma unroll
            for (int q = 0; q < 8; ++q) { int rr, cc; sk::elem_rc(threadIdx.x, q, rr, cc); float* h = hc + (size_t)(rl + rr) * D + c0 + cc; *h = *h + g[c0 + cc] * o[q]; }
        } else {
#pragma unroll
            for (int q = 0; q < 8; ++q) { int rr, cc; sk::elem_rc(threadIdx.x, q, rr, cc); float* h = hc + (size_t)(rl + rr) * D + c0 + cc;
                __hip_atomic_store(h, hsrc[(size_t)(rl + rr) * D + c0 + cc] + g[c0 + cc] * o[q], __ATOMIC_RELAXED, __HIP_MEMORY_SCOPE_AGENT); }
            asm volatile("s_waitcnt vmcnt(0)" ::: "memory"); __syncthreads();
            if (threadIdx.x == 0) { unsigned* c = (unsigned*)(p.ws + WS_CTL) + CW_CCNT + (8 * xnorm + (it >> 4)) * 16; unsigned* tmo = (unsigned*)(p.ws + WS_CTL) + CW_TMO;
                __hip_atomic_fetch_add(c, 1u, __ATOMIC_RELAXED, __HIP_MEMORY_SCOPE_AGENT);
                unsigned sp = 0u;
                while (__hip_atomic_load(c, __ATOMIC_RELAXED, __HIP_MEMORY_SCOPE_AGENT) < 16u) { __builtin_amdgcn_s_sleep(1);
                    if ((++sp & 255u) == 0u) { if (__hip_atomic_load(tmo, __ATOMIC_RELAXED, __HIP_MEMORY_SCOPE_AGENT)) break; if (sp > (1u << 22)) { atomicAdd(tmo, 1u); break; } } }
                __builtin_amdgcn_fence(__ATOMIC_ACQUIRE, "agent"); }
            __syncthreads();
            { const int w = threadIdx.x >> 6, lane = threadIdx.x & 63;
              if (w < 4) norm_row(p, nlayer, nwhich, NLAT + rl + (it & 15) * 4 + w, lane); }
            __syncthreads();
        } }
    __syncthreads();
}
__device__ __forceinline__ void ph_merge(const P& p, LAS unsigned char* lds, int layer, int nrows) {
    fg::MergeSched S{(const char*)(p.ws + WS_X), (const char*)(p.ws + WS_WB) + (size_t)layer * 1024 * 1536 * 2, nrows / 256, (int)gridDim.x, (int)blockIdx.x};
    fg::EpiMerge E{(const unsigned char*)(p.ws + WS_G), (bf16*)(p.ws + WS_MERGED)};
    fg::gemm_phase(lds, 1536, 1536, S, E);
}
__device__ __forceinline__ void ph_gemm_resid(const P& p, LAS unsigned char* lds, int layer, const bf16* A, int lda, const bf16* Bt, int K, int chunk, int nrows) {
    fg::PlainSched S{(const char*)A, (const char*)Bt, lda, K, nrows / 256, 4, (int)gridDim.x, (int)blockIdx.x, K / 64};
    fg::EpiResid E{p.out, (float*)(p.ws + WS_HCTX), (const float*)(p.ws + WS_MODS) + (size_t)layer * 3 * 6144, chunk};
    fg::gemm_phase(lds, lda, K, S, E);
}
__device__ __forceinline__ void ph_gemm_resid_norm(const P& p, LAS unsigned char* lds, int layer, const bf16* A, int lda, const bf16* Bt, int K, int chunk, int x, int nlayer, int nwhich, const float* hin) {
    fg::PlainSched S{(const char*)A, (const char*)Bt, lda, K, NLAT / 256, 4, (int)gridDim.x, (int)blockIdx.x, K / 64};
    unsigned* ctl = (unsigned*)(p.ws + WS_CTL);
    fg::EpiResidNorm E{hin, p.out, (const float*)(p.ws + WS_MODS) + (size_t)layer * 3 * 6144, chunk,
        p.in[nwhich == 0 ? 6 : 7] + nlayer * D, (const float*)(p.ws + WS_MODS) + (size_t)nlayer * 3 * 6144, nwhich == 0 ? 0 : 3, nwhich == 0 ? 1 : 4, (bf16*)(p.ws + WS_A), nwhich == 0 ? p.ws + WS_A8 : (unsigned char*)nullptr,
        (float*)(p.ws + WS_CTL + CTL_XBUF) + (size_t)x * 65536, ctl + CW_PCNT + 64 * 16 * x, ctl + CW_TMO, lds};
    fg::gemm_phase(lds, lda, K, S, E);
}
__device__ __forceinline__ void ph_ffn1(const P& p, LAS unsigned char* lds) {
    fg::PlainSched S{(const char*)(p.ws + WS_A), (const char*)(p.ws + WS_FFN1), D, D, MROWS / 256, 22, (int)gridDim.x, (int)blockIdx.x, D / 64};
    fg::EpiSwiglu E{(bf16*)(p.ws + WS_HMID)};
    fg::gemm_phase(lds, D, D, S, E);
}
__device__ __forceinline__ int moe_tiles(const P& p, LAS int* tile_e) {
    const unsigned* ctl = (const unsigned*)(p.ws + WS_CTL); int t = 0;
    for (int e = 0; e < NEXP; ++e) { const int c = (int)ctl[CW_CNT + e], nt = (c + 255) >> 8; for (int q = 0; q < nt; ++q) { if (threadIdx.x == 0) tile_e[t + q] = e; } t += nt; }
    __syncthreads();
    return t;
}
__device__ __forceinline__ void ph_assign_gather(const P& p, LAS unsigned char* lds) {
    const int tid = threadIdx.x, bid = blockIdx.x, G = gridDim.x;
    LAS int* sbase = (LAS int*)lds;
    LAS int* stot = sbase + 8;
    LAS int* spst = stot + 8;
    LAS int* sexp = spst + 16;
    LAS int* sslot = sexp + 128;
    const unsigned* cntb = (const unsigned*)(p.ws + WS_ROUTE) + 16384 * 6;
    const int* tok_e = (const int*)(p.ws + WS_ROUTE); int* tok_slot = (int*)(p.ws + WS_ROUTE) + 16384 * 4;
    __syncthreads();
    { const int e = tid >> 6, l = tid & 63; int tot = 0, below = 0;
      for (int b = l; b < G; b += 64) { const int c = (int)cntb[b * NEXP + e]; tot += c; if (b < bid) below += c; }
#pragma unroll
      for (int o = 1; o < 64; o <<= 1) { tot += __shfl_xor(tot, o); below += __shfl_xor(below, o); }
      if (l == 0) { sbase[e] = below; stot[e] = tot; } }
    if (tid < 128) { const int li = tid >> 1, w = li & 7, k = li >> 3, tok = (bid * 8 + w) + k * (G * 8); sexp[tid] = tok < NLAT ? tok_e[tok * 2 + (tid & 1)] : -1; }
    __syncthreads();
    if (tid == 0) { int t = 0; for (int e = 0; e < NEXP; ++e) { spst[e] = t * 256; t += (stot[e] + 255) >> 8; } spst[NEXP] = t * 256;
        if (bid == 0) { unsigned* ctl = (unsigned*)(p.ws + WS_CTL); for (int e = 0; e < NEXP; ++e) ctl[CW_CNT + e] = (unsigned)stot[e]; } }
    __syncthreads();
    if (tid < 128) { const int e = sexp[tid]; int slot = -1;
        if (e >= 0) { int rank = 0; for (int a = 0; a < tid; ++a) rank += (sexp[a] == e) ? 1 : 0; slot = spst[e] + sbase[e] + rank;
            const int li = tid >> 1, w = li & 7, k = li >> 3, tok = (bid * 8 + w) + k * (G * 8); tok_slot[tok * 2 + (tid & 1)] = slot; }
        sslot[tid] = slot; }
    __syncthreads();
    const int lane = tid & 63, wv = tid >> 6; const unsigned char* A8 = p.ws + WS_A8; unsigned char* FS8 = p.ws + WS_FS;
    for (int a = wv; a < 128; a += 8) { const int slot = sslot[a]; if (slot < 0) continue; const int li = a >> 1, w = li & 7, k = li >> 3, tok = (bid * 8 + w) + k * (G * 8);
        *(u32x4*)(FS8 + (size_t)slot * D + lane * 16) = *(const u32x4*)(A8 + (size_t)tok * D + lane * 16); }
    { int idx = 0;
      for (int e = 0; e < NEXP; ++e) { const int lo_ = spst[e] + stot[e], hi_ = spst[e + 1];
          for (int r = lo_ + ((bid * 8 + wv - idx) % (G * 8) + (G * 8)) % (G * 8); r < hi_; r += G * 8) {
              *(u32x4*)(FS8 + (size_t)r * D + lane * 16) = (u32x4){0u, 0u, 0u, 0u}; }
          idx += hi_ - lo_; } }
    __syncthreads();
}
__device__ __forceinline__ void ph_moe1(const P& p, LAS unsigned char* lds) {
    LAS int* tile_e = (LAS int*)(lds + fg::STAGE_BYTES); const int nt = moe_tiles(p, tile_e);
    fg::ExpertSched S{(const char*)(p.ws + WS_FS), (const char*)(p.ws + WS_MOE1), D / 2, D / 2, nt, 22, (int)gridDim.x, (int)blockIdx.x, D / 128, tile_e, (size_t)5632 * D};
    fg::EpiSwiglu8 E{p.ws + WS_HMOE};
    fg::gemm_phase<fg::EpiSwiglu8, fg::ExpertSched, true>(lds, D / 2, D / 2, S, E);
}
__device__ __forceinline__ void ph_moe2(const P& p, LAS unsigned char* lds) {
    LAS int* tile_e = (LAS int*)(lds + fg::STAGE_BYTES); const int nt = moe_tiles(p, tile_e);
    const int nbig = nt < 128 ? nt : 128;
    fg::ExpertSched S{(const char*)(p.ws + WS_HMOE), (const char*)(p.ws + WS_MOE2), FFN / 2, FFN / 2, nbig, 4, (int)gridDim.x, (int)blockIdx.x, FFN / 128, tile_e, (size_t)D * FFN};
    fg::EpiStore E{(bf16*)(p.ws + WS_Y2), D};
    fg::gemm_phase<fg::EpiStore, fg::ExpertSched, true>(lds, FFN / 2, FFN / 2, S, E);
    const unsigned char* A = p.ws + WS_HMOE; bf16* Y = (bf16*)(p.ws + WS_Y2);
    for (int it = blockIdx.x; it < (nt - nbig) * 64; it += gridDim.x) {
        const int rt = nbig + (it >> 6), r0 = rt * 256 + ((it >> 4) & 3) * 64, c0 = (it & 15) * 64;
        const unsigned char* B = p.ws + WS_MOE2 + (size_t)tile_e[rt] * D * FFN;
        float o[8]; sk::tile64_f8(lds, A + (size_t)r0 * FFN, FFN, B + (size_t)c0 * FFN, FFN, FFN, o);
#pragma unroll
        for (int q = 0; q < 8; ++q) { int rr, cc; sk::elem_rc(threadIdx.x, q, rr, cc); Y[(size_t)(r0 + rr) * D + c0 + cc] = f2bf(o[q]); } }
    __syncthreads();
}
__device__ __forceinline__ void ph_combine(const P& p, int layer) {
    const int lane = threadIdx.x & 63, gw = blockIdx.x * 8 + (threadIdx.x >> 6), ngw = gridDim.x * 8;
    const float* tok_w = (const float*)(p.ws + WS_ROUTE) + 16384 * 2; const int* tok_slot = (const int*)(p.ws + WS_ROUTE) + 16384 * 4; const bf16* Y = (const bf16*)(p.ws + WS_Y2);
    for (int r = gw; r < NLAT; r += ngw) {
        const int s0 = tok_slot[r * 2], s1 = tok_slot[r * 2 + 1]; const float w0 = tok_w[r * 2], w1 = tok_w[r * 2 + 1];
        const float* g = mods(p, layer, row_mi(r), 5); float* h = p.out + (size_t)r * D;
#pragma unroll
        for (int j = 0; j < 4; ++j) { const int c = 4 * lane + 256 * j;
            const u32x2 a = *(const u32x2*)(Y + (size_t)s0 * D + c), bq = *(const u32x2*)(Y + (size_t)s1 * D + c); const f32x4 gg = *(const f32x4*)(g + c); f32x4 hv = *(f32x4*)(h + c);
            hv.x += gg.x * (w0 * __uint_as_float(a.x << 16) + w1 * __uint_as_float(bq.x << 16)); hv.y += gg.y * (w0 * __uint_as_float(a.x & 0xffff0000u) + w1 * __uint_as_float(bq.x & 0xffff0000u));
            hv.z += gg.z * (w0 * __uint_as_float(a.y << 16) + w1 * __uint_as_float(bq.y << 16)); hv.w += gg.w * (w0 * __uint_as_float(a.y & 0xffff0000u) + w1 * __uint_as_float(bq.y & 0xffff0000u));
            *(f32x4*)(h + c) = hv; }
    }
}

#define XB_TMO      128
static_assert(CW_TMO == CW_BAR + XB_TMO, "tmo word");
static_assert(CW_CCNT + 4 * 8 * 16 <= 16384, "all zero-initialised control words lie in the first 64 KiB");
#define XB_XCNT(j)  (256  + 64 * (j))
#define XB_XSUB(j)  (1280 + 64 * (j))
#define XB_XGEN(j)  (2304 + 64 * (j))
#define XB_TOP      3328
#define XB_TOPGEN   3392
#define XCD_BAR_WORDS 3456
#define XB_SPIN_CAP (1u << 22)
__device__ __forceinline__ unsigned xb_ld(unsigned* p)              { return __hip_atomic_load(p, __ATOMIC_RELAXED, __HIP_MEMORY_SCOPE_AGENT); }
__device__ __forceinline__ unsigned xb_add(unsigned* p, unsigned v) { return __hip_atomic_fetch_add(p, v, __ATOMIC_RELAXED, __HIP_MEMORY_SCOPE_AGENT); }
__device__ __forceinline__ unsigned xb_xcc_id() { return (unsigned)__builtin_amdgcn_s_getreg((3 << 11) | 20) & 0xFu; }
#define XB_SPIN(cond, bar) do { unsigned _sp = 0; while (cond) { __builtin_amdgcn_s_sleep(1); \
    if ((++_sp & 255u) == 0u) { if (xb_ld(&(bar)[XB_TMO])) break; if (_sp > XB_SPIN_CAP) { atomicAdd(&(bar)[XB_TMO], 1u); break; } } } } while (0)
struct XcdBarrier { unsigned* bar; unsigned x; volatile LAS unsigned* st; };
__device__ __forceinline__ XcdBarrier xcd_barrier_post(unsigned* bar, volatile LAS unsigned* st) {
    XcdBarrier b; b.bar = bar; b.x = xb_xcc_id(); b.st = st;
    if (threadIdx.x == 0) (void)xb_add(&bar[XB_XCNT(b.x)], 1u);
    return b;
}
__device__ __forceinline__ void xcd_barrier_complete(unsigned* bar, unsigned x, unsigned& nloc, unsigned& nx) {
    const unsigned G = gridDim.x * gridDim.y * gridDim.z;
    unsigned sum, cnt, mine, sp = 0u;
    for (;;) {
        sum = 0u; cnt = 0u; mine = 0u;
#pragma unroll
        for (unsigned j = 0; j < 16; ++j) { const unsigned c = xb_ld(&bar[XB_XCNT(j)]); sum += c; cnt += (c > 0u) ? 1u : 0u; mine = (j == x) ? c : mine; }
        if (sum == G) break;
        __builtin_amdgcn_s_sleep(1);
        if ((++sp & 255u) == 0u) { if (xb_ld(&bar[XB_TMO])) break; if (sp > XB_SPIN_CAP) { atomicAdd(&bar[XB_TMO], 1u); break; } }
    }
    nloc = mine > 0u ? mine : 1u; nx = cnt > 0u ? cnt : 1u;
}
__device__ __forceinline__ void xcd_barrier(const XcdBarrier& b) {
    asm volatile("s_waitcnt vmcnt(0)" ::: "memory");
    __syncthreads();
    if (threadIdx.x == 0) {
        unsigned* bar = b.bar;
        __builtin_amdgcn_s_waitcnt(0);
        unsigned nloc = b.st[0], nx = b.st[1];
        if (nloc == 0u) { xcd_barrier_complete(bar, b.x, nloc, nx); b.st[0] = nloc; b.st[1] = nx; }
        const unsigned old = xb_add(&bar[XB_XSUB(b.x)], 1u);
        const unsigned gen = old / nloc;
        if (old + 1u == (gen + 1u) * nloc) {
            __builtin_amdgcn_fence(__ATOMIC_RELEASE, "agent");
            asm volatile("s_waitcnt vmcnt(0)" ::: "memory");
            const unsigned og = xb_add(&bar[XB_TOP], 1u);
            const unsigned tg = og / nx;
            if (og + 1u == (tg + 1u) * nx) xb_add(&bar[XB_TOPGEN], 1u);
            else XB_SPIN(xb_ld(&bar[XB_TOPGEN]) == tg, bar);
            __builtin_amdgcn_fence(__ATOMIC_ACQUIRE, "agent");
            xb_add(&bar[XB_XGEN(b.x)], 1u);
            asm volatile("s_waitcnt vmcnt(0)" ::: "memory");
        } else {
            XB_SPIN(xb_ld(&bar[XB_XGEN(b.x)]) == gen, bar);
            asm volatile("buffer_inv sc0" ::: "memory");
            asm volatile("s_waitcnt vmcnt(0)" ::: "memory");
        }
    }
    __syncthreads();
}

constexpr int NPHASE = 23;
constexpr int LDS_BYTES = 150 * 1024;
__global__ void __launch_bounds__(NTHREADS, 2) mk(P p, int lo, int hi, int fuse) {
    extern __shared__ __attribute__((aligned(16))) unsigned char lds_raw[];
    LAS unsigned char* lds = (LAS unsigned char*)lds_raw;
    volatile LAS unsigned* misc = (volatile LAS unsigned*)(lds + LDS_BYTES - 64);
    if (threadIdx.x < 16) misc[threadIdx.x] = 0u;
    __syncthreads();
    XcdBarrier bar; bar.bar = (unsigned*)(p.ws + WS_CTL) + CW_BAR; bar.x = 0; bar.st = misc;
    if (hi - lo > 1) bar = xcd_barrier_post((unsigned*)(p.ws + WS_CTL) + CW_BAR, misc);
#if MK_SINGLE
    cg::this_grid().sync();
#endif
#ifndef PROBE_MASK
#define PROBE_MASK 0u
#endif
#ifndef AMP_A
#define AMP_A (-1)
#define AMP_B (-1)
#define AMP_MUL 15
#endif
#define AMP(k) do { if ((k) == AMP_A && blockIdx.x == 0 && threadIdx.x == 0) { const unsigned long long t = __builtin_amdgcn_s_memrealtime(); misc[8] = (unsigned)t; } \
    if ((k) == AMP_B && blockIdx.x == 0 && threadIdx.x == 0) { const unsigned t1 = (unsigned)__builtin_amdgcn_s_memrealtime(), dt = (t1 - misc[8]) * AMP_MUL; while ((unsigned)__builtin_amdgcn_s_memrealtime() - t1 < dt) __builtin_amdgcn_s_sleep(8); } } while (0)
#define PH(k, body) do { if (lo <= (k) && (k) < hi) { if ((k) > lo) { xcd_barrier(bar); } AMP(k); body; \
    if ((PROBE_MASK >> (k)) & 1u) { xcd_barrier(bar); body; } } } while (0)
#define LAYER_PHASES(L, base) \
    PH(base + 0, ph_win(p, lds, L)); \
    PH(base + 1, ph_mix1(p, lds, L)); \
    PH(base + 2, ph_mix2(p, lds, lds_raw, L)); \
    PH(base + 3, ph_mix3(p, lds, L, fuse != 0)); \
    PH(base + 4, { if (L == 0 && fuse) ctx_ret_items(p, lds); ph_merge(p, lds, L, NLAT); if (L == 0) { if (fuse && (int)(gridDim.x - 1 - blockIdx.x) < (NCTX / 64) * 16) ctx_ret_wait(p); mini_merge_ctx(p, lds, L); } }); \
    PH(base + 5, { if (L == 0 && fuse) { ph_gemm_resid_norm(p, lds, 0, (const bf16*)(p.ws + WS_MERGED), 1024, (const bf16*)(p.ws + WS_WOUT), D, 2, 0, 0, 1, p.in[0]); mini_resid_ctx(p, lds, 0, (const bf16*)(p.ws + WS_MERGED), 1024, (const bf16*)(p.ws + WS_WOUT), D, 2, 0, 0, 1, p.in[2]); } \
        else { ph_gemm_resid(p, lds, L, (const bf16*)(p.ws + WS_MERGED), 1024, (const bf16*)(p.ws + WS_WOUT) + (size_t)L * D * D, D, 2, NLAT); if (L == 0) mini_resid_ctx(p, lds, L, (const bf16*)(p.ws + WS_MERGED), 1024, (const bf16*)(p.ws + WS_WOUT), D, 2); } });
    PH(0, ph_prologue(p, lds));
    PH(1, ph_norm(p, lds, 0, 0, true, false, MROWS, !fuse));
    LAYER_PHASES(0, 2)
    if (!fuse) PH(8, ph_norm(p, lds, 0, 1, false, false, MROWS));
    PH(9, ph_ffn1(p, lds));
    PH(10, { if (fuse) { ph_gemm_resid_norm(p, lds, 0, (const bf16*)(p.ws + WS_HMID), FFN, (const bf16*)(p.ws + WS_FFN2), FFN, 5, 1, 1, 0, p.out); mini_resid_ctx(p, lds, 0, (const bf16*)(p.ws + WS_HMID), FFN, (const bf16*)(p.ws + WS_FFN2), FFN, 5, 1, 1, 0); }
        else { ph_gemm_resid(p, lds, 0, (const bf16*)(p.ws + WS_HMID), FFN, (const bf16*)(p.ws + WS_FFN2), FFN, 5, NLAT); mini_resid_ctx(p, lds, 0, (const bf16*)(p.ws + WS_HMID), FFN, (const bf16*)(p.ws + WS_FFN2), FFN, 5); } });
    if (!fuse) PH(11, ph_norm(p, lds, 1, 0, false, false, MROWS));
    LAYER_PHASES(1, 12)
    PH(18, ph_norm(p, lds, 1, 1, false, true, NLAT));
    PH(19, { ph_assign_gather(p, lds); ph_moe_convert(p, lds); });
    PH(20, ph_moe1(p, lds));
    PH(21, ph_moe2(p, lds));
    PH(22, ph_combine(p, 1));
#undef PH
#undef LAYER_PHASES
}

extern "C" void kernel_launch(void* const* d_in, const int* in_sizes, int n_in, void* d_out, int out_size, void* d_ws, size_t ws_size, hipStream_t stream) {
    static int grid = 0;
    if (grid == 0) {
        if (n_in != 30 || out_size != NLAT * D || ws_size < WS_END) { fprintf(stderr, "kernel_launch: unexpected shapes (n_in %d out %d ws %zu)\n", n_in, out_size, ws_size); grid = -1; return; }
        int dev = 0, cus = 0, per_cu = 0;
        hipGetDevice(&dev); hipDeviceGetAttribute(&cus, hipDeviceAttributeMultiprocessorCount, dev);
        hipFuncSetAttribute((const void*)mk, hipFuncAttributeMaxDynamicSharedMemorySize, LDS_BYTES);
        hipOccupancyMaxActiveBlocksPerMultiprocessor(&per_cu, (const void*)mk, NTHREADS, LDS_BYTES);
        if (per_cu < 1) { fprintf(stderr, "kernel_launch: occupancy query says %d blocks per CU\n", per_cu); grid = -1; return; }
        grid = cus;
    }
    if (grid < 0) return;
    hipMemsetAsync((char*)d_ws + WS_CTL, 0, 64 * 1024, stream);
    P p{};
    for (int i = 0; i < 30; ++i) p.in[i] = (const float*)d_in[i];
    p.out = (float*)d_out; p.ws = (unsigned char*)d_ws;
#if MK_SINGLE
    int lo = 0, hi = NPHASE, fuse = grid == 256 ? 1 : 0; void* args[] = {&p, &lo, &hi, &fuse};
    hipLaunchCooperativeKernel((const void*)mk, dim3(grid), dim3(NTHREADS), args, LDS_BYTES, stream);
#else
    for (int ph = 0; ph < NPHASE; ++ph) hipLaunchKernelGGL(mk, dim3(grid), dim3(NTHREADS), LDS_BYTES, stream, p, ph, ph + 1, 0);
#endif
}
```

```cpp
#include <hip/hip_runtime.h>
#include <hip/hip_cooperative_groups.h>
#include <cstdio>
#include <cstdint>
namespace cg = cooperative_groups;

#ifndef MK_SINGLE
#define MK_SINGLE 1
#endif

typedef unsigned short bf16;
typedef float f32x4 __attribute__((ext_vector_type(4)));
typedef unsigned u32x4 __attribute__((ext_vector_type(4)));
typedef unsigned u32x2 __attribute__((ext_vector_type(2)));
#define LAS __attribute__((address_space(3)))

constexpr int D = 1024, NB = 2, SEQ = 8192, CTX = 256, NLAT = NB * SEQ, NCTX = NB * CTX, MROWS = NLAT + NCTX;
constexpr int INC = 6656, FFN = 2816, NEXP = 8, KEYS = CTX + SEQ;
constexpr int NCHUNK = 66;
constexpr float EPS = 1e-6f;
constexpr float QSCALE = 0.125f * 1.4426950408889634f;
constexpr int MOE_ROWS = 34816;
constexpr int NTHREADS = 512;

constexpr size_t MiB = 1u << 20;
constexpr size_t WS_CTL = 0, CTL_BYTES = 1 * MiB;
constexpr size_t WS_MODS = 1 * MiB;
constexpr size_t WS_ROPE = 2 * MiB;
constexpr size_t WS_F1 = 4 * MiB;
constexpr size_t WS_F2 = WS_F1 + 131072;
constexpr size_t WS_FC = WS_F2 + 131072;
constexpr size_t WS_TW = WS_FC + 262144;
constexpr size_t WS_ROUTE = 5 * MiB;
constexpr size_t WS_HCTX = 6 * MiB;
constexpr size_t WS_WIN = 8 * MiB;
constexpr size_t WS_WB = 34 * MiB;
constexpr size_t WS_WOUT = 40 * MiB;
constexpr size_t WS_FFN1 = 44 * MiB;
constexpr size_t WS_FFN2 = 55 * MiB;
constexpr size_t WS_A = 61 * MiB;
constexpr size_t WS_X = 94 * MiB;
constexpr size_t WS_Y = 144 * MiB;
constexpr size_t WS_RETQ = WS_Y;
constexpr size_t WS_RETK = WS_RETQ + (size_t)MROWS * 256 * 2;
constexpr size_t WS_RETV = WS_RETK + (size_t)MROWS * 256 * 2;
constexpr size_t WS_RETG = WS_RETV + (size_t)MROWS * 256 * 2;
constexpr size_t WS_ATTQ = WS_Y + 33 * MiB;
constexpr size_t WS_ATTK = WS_Y + 50 * MiB;
constexpr size_t WS_ATTV = WS_Y + 55 * MiB;
constexpr size_t WS_CONV = WS_Y + 60 * MiB;
constexpr size_t WS_UT = WS_Y + 77 * MiB;
constexpr size_t WS_UTC = WS_Y + 93 * MiB;
constexpr size_t WS_Z = WS_Y + 94 * MiB;
constexpr size_t WS_RETS = WS_Y + 126 * MiB;
constexpr size_t WS_MERGED = WS_Y + 143 * MiB;
constexpr size_t WS_G = 320 * MiB;
constexpr size_t WS_MOE1 = WS_G;
constexpr size_t WS_MOE2 = WS_G + (size_t)NEXP * 5632 * 1024 * 2;
constexpr size_t WS_HMID = WS_Y;
constexpr size_t WS_HMOE = 61 * MiB;
constexpr size_t WS_FS = 252 * MiB;
constexpr size_t WS_A8 = 386 * MiB;
constexpr size_t WS_WIN8 = 430 * MiB;
constexpr size_t WS_RETS2 = 452 * MiB;
constexpr size_t WS_Y2 = 160 * MiB;
constexpr size_t WS_END = 469 * MiB;
static_assert(WS_MERGED + (size_t)MROWS * 1024 * 2 <= WS_G, "map");
static_assert(WS_HMOE + (size_t)MOE_ROWS * FFN * 2 <= WS_FS && WS_FS + (size_t)MOE_ROWS * 1024 * 2 <= WS_G, "map moe");
static_assert(WS_MOE2 + (size_t)NEXP * 1024 * FFN * 2 <= WS_END, "map moe w");
static_assert(WS_G + (size_t)MROWS * 4096 <= WS_A8 && WS_A8 + (size_t)NLAT * 1024 <= WS_MOE2 && WS_MOE2 + (size_t)NEXP * 1024 * FFN <= WS_WIN8 && WS_WIN8 + (size_t)2 * 4096 * 1024 <= WS_RETS2, "map fp8 w_in");
constexpr int CW_CNT = 64;
constexpr int CW_CUR = 128;
constexpr int CW_BAR = 4096;
constexpr int CW_TMO = CW_BAR + 128;
constexpr int CW_PCNT = 8192;
constexpr int CW_CCNT = 8192 + 4 * 64 * 16;
constexpr size_t CTL_XBUF = 128 * 1024;

struct P {
    const float* in[30];
    float* out;
    unsigned char* ws;
};

__device__ __forceinline__ float bf2f(bf16 v) { return __uint_as_float((unsigned)v << 16); }
__device__ __forceinline__ bf16 f2bf(float f) { unsigned u = __float_as_uint(f); return (bf16)((u + 0x7fffu + ((u >> 16) & 1u)) >> 16); }
__device__ __forceinline__ unsigned pk2(float lo, float hi) { return (unsigned)f2bf(lo) | ((unsigned)f2bf(hi) << 16); }
__device__ __forceinline__ float sigmoidf_(float x) { return 1.f / (1.f + __expf(-x)); }
__device__ __forceinline__ float siluf_(float x) { return x / (1.f + __expf(-x)); }
__device__ __forceinline__ float sigmoid_fast(float x) { return __builtin_amdgcn_rcpf(1.f + __builtin_amdgcn_exp2f(-1.4426950408889634f * x)); }
__device__ __forceinline__ float silu_fast(float x) { return x * __builtin_amdgcn_rcpf(1.f + __builtin_amdgcn_exp2f(-1.4426950408889634f * x)); }
__device__ __forceinline__ float wave_sum(float v) {
#pragma unroll
    for (int o = 1; o < 64; o <<= 1) v += __shfl_xor(v, o);
    return v;
}
__device__ __forceinline__ int row_mi(int r) { return r < NLAT ? (r >> 13) : 2; }
__device__ __forceinline__ float* hrow(const P& p, int r) { return r < NLAT ? p.out + (size_t)r * D : (float*)(p.ws + WS_HCTX) + (size_t)(r - NLAT) * D; }
__device__ __forceinline__ const float* mods(const P& p, int layer, int mi, int chunk) { return (const float*)(p.ws + WS_MODS) + ((size_t)(layer * 3 + mi) * 6 + chunk) * D; }

__device__ __forceinline__ int rowmap(int mode, int n) {
    if (mode == 0) return n;
    if (mode == 1 || mode == 2) return 8 * (n >> 2) + (n & 3) + (mode == 2 ? 4 : 0);
    const int tile = n >> 8, l = n & 255, head = l >> 6, d = l & 63;
    const bool ropet = tile == 1 || tile == 2 || tile == 5 || tile == 6 || (tile == 7 && head < 2);
    if (ropet) { const int i = d & 31, nn = d >> 5; return tile * 256 + 128 * (i >> 4) + 32 * head + 8 * ((i >> 2) & 3) + 4 * nn + (i & 3); }
    if (tile == 7) return tile * 256 + 128 * (d >> 5) + 32 * head + 8 * ((d >> 3) & 3) + (d & 7);
    return n;
}
__device__ __forceinline__ void conv_tile(LAS float* scr, const float* src, int ldn, int k0, int n0, bf16* dst, int ldd, int koff, int mode) {
    const int tid = threadIdx.x;
    __syncthreads();
#pragma unroll
    for (int i = 0; i < 8; ++i) { const int e = tid + i * NTHREADS, kk = e >> 6, nn = e & 63; scr[kk * 65 + nn] = src[(size_t)(k0 + kk) * ldn + n0 + nn]; }
    __syncthreads();
    const int nn = tid >> 3, kc = (tid & 7) * 8;
    u32x4 o; o.x = pk2(scr[(kc + 0) * 65 + nn], scr[(kc + 1) * 65 + nn]); o.y = pk2(scr[(kc + 2) * 65 + nn], scr[(kc + 3) * 65 + nn]);
    o.z = pk2(scr[(kc + 4) * 65 + nn], scr[(kc + 5) * 65 + nn]); o.w = pk2(scr[(kc + 6) * 65 + nn], scr[(kc + 7) * 65 + nn]);
    *(u32x4*)(dst + (size_t)rowmap(mode, n0 + nn) * ldd + koff + k0 + kc) = o;
}
constexpr float F8_WSCALE = 32.f;
__device__ __forceinline__ unsigned pk4_fp8(float a, float b, float c, float d) { int w = 0; w = __builtin_amdgcn_cvt_pk_fp8_f32(a, b, w, false); w = __builtin_amdgcn_cvt_pk_fp8_f32(c, d, w, true); return (unsigned)w; }
__device__ __forceinline__ void conv_tile2_f8(LAS float* scr, const float* src, int ldn, unsigned char* dst8, int ldd, int mode, int k0a, int n0a, int k0b, int n0b, bool two) {
    const int tid = threadIdx.x;
    f32x4 va[2], vb[2];
#pragma unroll
    for (int i = 0; i < 2; ++i) { const int e = tid + i * NTHREADS, kk = e >> 4, n4 = (e & 15) * 4;
        va[i] = *(const f32x4*)(src + (size_t)(k0a + kk) * ldn + n0a + n4);
        if (two) vb[i] = *(const f32x4*)(src + (size_t)(k0b + kk) * ldn + n0b + n4); }
    __syncthreads();
#pragma unroll
    for (int i = 0; i < 2; ++i) { const int e = tid + i * NTHREADS, kk = e >> 4, n4 = (e & 15) * 4;
#pragma unroll
        for (int q = 0; q < 4; ++q) { scr[kk * 65 + n4 + q] = va[i][q]; if (two) scr[64 * 65 + kk * 65 + n4 + q] = vb[i][q]; } }
    __syncthreads();
    const int nn = tid >> 3, kc = (tid & 7) * 8;
#pragma unroll
    for (int t = 0; t < 2; ++t) { if (t == 1 && !two) break; const LAS float* sp = scr + t * 64 * 65; const int k0 = t ? k0b : k0a, n0 = t ? n0b : n0a;
        u32x2 o; o.x = pk4_fp8(sp[(kc + 0) * 65 + nn] * F8_WSCALE, sp[(kc + 1) * 65 + nn] * F8_WSCALE, sp[(kc + 2) * 65 + nn] * F8_WSCALE, sp[(kc + 3) * 65 + nn] * F8_WSCALE);
        o.y = pk4_fp8(sp[(kc + 4) * 65 + nn] * F8_WSCALE, sp[(kc + 5) * 65 + nn] * F8_WSCALE, sp[(kc + 6) * 65 + nn] * F8_WSCALE, sp[(kc + 7) * 65 + nn] * F8_WSCALE);
        *(u32x2*)(dst8 + (size_t)rowmap(mode, n0 + nn) * ldd + k0 + kc) = o; }
}
__device__ __forceinline__ void conv_tile128_f8(LAS float* scr, const float* src, int ldn, unsigned char* dst8, int ldd, int mode, int k0, int n0) {
    const int tid = threadIdx.x;
    f32x4 v[8];
#pragma unroll
    for (int i = 0; i < 8; ++i) { const int e = tid + i * NTHREADS, kk = e >> 5, n4 = (e & 31) * 4; v[i] = *(const f32x4*)(src + (size_t)(k0 + kk) * ldn + n0 + n4); }
    __syncthreads();
#pragma unroll
    for (int i = 0; i < 8; ++i) { const int e = tid + i * NTHREADS, kk = e >> 5, n4 = (e & 31) * 4;
#pragma unroll
        for (int q = 0; q < 4; ++q) scr[kk * 129 + n4 + q] = v[i][q]; }
    __syncthreads();
    const int nn = tid >> 2, kc = (tid & 3) * 32;
    u32x4 o[2];
#pragma unroll
    for (int h = 0; h < 2; ++h) { const LAS float* sp = scr + (kc + h * 16) * 129 + nn;
        o[h].x = pk4_fp8(sp[0] * F8_WSCALE, sp[129] * F8_WSCALE, sp[2 * 129] * F8_WSCALE, sp[3 * 129] * F8_WSCALE);
        o[h].y = pk4_fp8(sp[4 * 129] * F8_WSCALE, sp[5 * 129] * F8_WSCALE, sp[6 * 129] * F8_WSCALE, sp[7 * 129] * F8_WSCALE);
        o[h].z = pk4_fp8(sp[8 * 129] * F8_WSCALE, sp[9 * 129] * F8_WSCALE, sp[10 * 129] * F8_WSCALE, sp[11 * 129] * F8_WSCALE);
        o[h].w = pk4_fp8(sp[12 * 129] * F8_WSCALE, sp[13 * 129] * F8_WSCALE, sp[14 * 129] * F8_WSCALE, sp[15 * 129] * F8_WSCALE); }
    unsigned char* d = dst8 + (size_t)rowmap(mode, n0 + nn) * ldd + k0 + kc;
    *(u32x4*)d = o[0]; *(u32x4*)(d + 16) = o[1];
}
__device__ __forceinline__ void conv_tile4(LAS float* scr, const float* src, int ldn, int nn, int cnt, int i, int st, bf16* dst, int ldd, int koff, int mode) {
    const int tid = threadIdx.x, kk = tid >> 4, n4 = (tid & 15) * 4;
    f32x4 v[4][2];
#pragma unroll
    for (int t = 0; t < 4; ++t) { const int it = i + t * st; if (it < cnt) { const int k0 = (it / nn) * 64, n0 = (it % nn) * 64;
#pragma unroll
        for (int h = 0; h < 2; ++h) v[t][h] = *(const f32x4*)(src + (size_t)(k0 + kk + 32 * h) * ldn + n0 + n4); } }
    __syncthreads();
#pragma unroll
    for (int t = 0; t < 4; ++t) if (i + t * st < cnt) {
#pragma unroll
        for (int h = 0; h < 2; ++h)
#pragma unroll
            for (int q = 0; q < 4; ++q) scr[t * 64 * 65 + (kk + 32 * h) * 65 + n4 + q] = v[t][h][q]; }
    __syncthreads();
    const int nr = tid >> 3, kc = (tid & 7) * 8;
#pragma unroll
    for (int t = 0; t < 4; ++t) { const int it = i + t * st; if (it < cnt) { const int k0 = (it / nn) * 64, n0 = (it % nn) * 64; const LAS float* sp = scr + t * 64 * 65;
        u32x4 o; o.x = pk2(sp[(kc + 0) * 65 + nr], sp[(kc + 1) * 65 + nr]); o.y = pk2(sp[(kc + 2) * 65 + nr], sp[(kc + 3) * 65 + nr]);
        o.z = pk2(sp[(kc + 4) * 65 + nr], sp[(kc + 5) * 65 + nr]); o.w = pk2(sp[(kc + 6) * 65 + nr], sp[(kc + 7) * 65 + nr]);
        *(u32x4*)(dst + (size_t)rowmap(mode, n0 + nr) * ldd + koff + k0 + kc) = o; } }
}
struct CJob { const float* src; int K, N; bf16* dst; int ldd, koff, mode, ldn; };
__device__ __forceinline__ CJob get_job(const P& p, int j) {
    CJob c;
    if (j < 10) { const int l = j / 5, t = j % 5; bf16* wb = (bf16*)(p.ws + WS_WB) + (size_t)l * 1024 * 1536;
        if (t == 0) c = CJob{p.in[8] + (size_t)l * D * INC, D, l == 0 ? INC : 2560, (bf16*)(p.ws + WS_WIN) + (size_t)l * INC * D, D, 0, 3, INC};
        else if (t == 1) c = CJob{p.in[13] + (size_t)l * 256 * D, 256, D, wb, 1536, 512, 0};
        else if (t == 2) c = CJob{p.in[16] + (size_t)l * 512 * D, 512, D, wb, 1536, 768, 0};
        else if (t == 3) c = CJob{p.in[21] + (size_t)l * 256 * D, 256, D, wb, 1536, 1280, 0};
        else c = CJob{p.in[22] + (size_t)l * D * D, D, D, (bf16*)(p.ws + WS_WOUT) + (size_t)l * D * D, D, 0, 0}; }
    else if (j == 10) c = CJob{p.in[23], D, FFN, (bf16*)(p.ws + WS_FFN1), D, 0, 1};
    else if (j == 11) c = CJob{p.in[24], D, FFN, (bf16*)(p.ws + WS_FFN1), D, 0, 2};
    else c = CJob{p.in[25], FFN, D, (bf16*)(p.ws + WS_FFN2), FFN, 0, 0};
    return c;
}
__device__ __forceinline__ CJob get_moe_job(const P& p, int j) {
    const int e = j / 3, t = j % 3; CJob c;
    const float* sg = p.in[27]; const float* su = p.in[28]; const float* sd = p.in[29];
    asm volatile("" : "+s"(sg), "+s"(su), "+s"(sd));
    if (t == 0) c = CJob{sg + (size_t)e * D * FFN, D, FFN, (bf16*)(p.ws + WS_MOE1 + (size_t)e * 5632 * D), D, 0, 1};
    else if (t == 1) c = CJob{su + (size_t)e * D * FFN, D, FFN, (bf16*)(p.ws + WS_MOE1 + (size_t)e * 5632 * D), D, 0, 2};
    else c = CJob{sd + (size_t)e * FFN * D, FFN, D, (bf16*)(p.ws + WS_MOE2 + (size_t)e * D * FFN), FFN, 0, 0};
    return c;
}
template <bool MOE> __device__ __forceinline__ void run_conv_jobs(const P& p, LAS float* scr, int njobs, int bid, int nb) {
    int base = 0, base2 = 0;
    for (int j = 0; j < njobs; ++j) {
        const CJob jb = MOE ? get_moe_job(p, j) : get_job(p, j); const int nn = jb.N / 64, cnt = (jb.K / 64) * nn, ldn = jb.ldn ? jb.ldn : jb.N;
        const int first = ((bid - base) % nb + nb) % nb;
        if (MOE) { const int nn2 = jb.N / 128, cnt2 = (jb.K / 128) * nn2; const int first2 = ((bid - base2) % nb + nb) % nb;
            for (int i = first2; i < cnt2; i += nb) conv_tile128_f8(scr, jb.src, jb.N, (unsigned char*)jb.dst, jb.ldd, jb.mode, (i / nn2) * 128, (i % nn2) * 128);
            base2 += cnt2; }
        else for (int i = first; i < cnt; i += 4 * nb) conv_tile4(scr, jb.src, ldn, nn, cnt, i, nb, jb.dst, jb.ldd, jb.koff, jb.mode);
        base += cnt;
    }
}
__device__ __forceinline__ void ph_prologue(const P& p, LAS unsigned char* lds) {
    const int tid = threadIdx.x, bid = blockIdx.x, nb = gridDim.x;
    const int gt = bid * NTHREADS + tid, ngt = nb * NTHREADS;
    LAS float* scr = (LAS float*)lds;
    run_conv_jobs<false>(p, scr, 13, bid, nb);
    __syncthreads();
    for (int i = bid; i < 512; i += nb) { const int l = i >> 8, t = i & 255;
        conv_tile128_f8(scr, p.in[8] + (size_t)l * D * INC + 2560, INC, p.ws + WS_WIN8 + (size_t)l * 4096 * 1024, 1024, 0, (t >> 5) * 128, (t & 31) * 128); }
    __syncthreads();
    {
        LAS float* tc = (LAS float*)lds; LAS float* tsn = tc + 64;
        __syncthreads();
        if (tid < 64) { tc[tid] = cospif(tid * (2.f / 64.f)); tsn[tid] = sinpif(tid * (2.f / 64.f)); }
        __syncthreads();
        const float s = 1.0f / sqrtf(64.f * 8192.f);
        for (int e = gt; e < 2 * 4 * 16 * 1024; e += ngt) {
            const int n = e & 1023, cq = (e >> 10) & 15, g = (e >> 14) & 3, l = e >> 16;
            const float* W = p.in[9] + (size_t)l * 256 * D + (size_t)(g * 64) * D + n;
            float w[64];
#pragma unroll
            for (int c2 = 0; c2 < 64; ++c2) w[c2] = W[(size_t)c2 * D];
            bf16* o = (bf16*)(p.ws + WS_WB) + (size_t)l * 1024 * 1536 + (size_t)n * 1536 + g * 64;
#pragma unroll
            for (int ci = 0; ci < 4; ++ci) { const int c = cq * 4 + ci; float re = 0.f, im = 0.f;
                const float cr = tc[c], sr = tsn[c]; float tr = 1.f, ti = 0.f;
#pragma unroll
                for (int c2 = 0; c2 < 64; ++c2) { re += tr * w[c2]; im -= ti * w[c2]; const float nr = tr * cr - ti * sr; ti = tr * sr + ti * cr; tr = nr; }
                o[c] = f2bf(re * s); o[256 + c] = f2bf(im * s); }
        }
        __syncthreads();
    }
    {
        float* rc = (float*)(p.ws + WS_ROPE); float* rs = rc + SEQ * 32;
        for (int e = gt; e < SEQ * 32; e += ngt) {
            const int s = e >> 5, i = e & 31; const float inv = powf(10000.f, -(float)(i & 15) / 16.f);
            const float pos = (float)(i < 16 ? (s >> 6) : (s & 63)); const float ang = pos * inv;
            rc[e] = cosf(ang); rs[e] = sinf(ang);
        }
    }
    {
        bf16* F1 = (bf16*)(p.ws + WS_F1); bf16* F2 = (bf16*)(p.ws + WS_F2); bf16* FC = (bf16*)(p.ws + WS_FC);
        for (int e = gt; e < 256 * 256; e += ngt) {
            const int rho = e >> 8, n1 = e & 255; float v = 0.f;
            if (n1 < 128) { const int k1 = (rho >> 5) * 16 + (rho & 15), c = (rho >> 4) & 1, m = (k1 * n1) & 127; v = c == 0 ? cospif(m * (2.f / 128.f)) : -sinpif(m * (2.f / 128.f)); }
            F1[e] = f2bf(v);
            float w = 0.f;
            if (rho < 128 && n1 < 128) { const int c2 = rho >> 6, k2 = rho & 63, c = n1 >> 6, n2 = n1 & 63, m = (k2 * n2) & 63; const float cs = cospif(m * (2.f / 64.f)), sn = sinpif(m * (2.f / 64.f));
                w = c2 == 0 ? (c == 0 ? cs : sn) : (c == 0 ? sn : -cs); }
            F2[e] = f2bf(w);
        }
        const float sc = sqrtf(32.f);
        for (int e = gt; e < 512 * 256; e += ngt) { const int rho = e >> 8, n = e & 255, c2 = rho >> 8, k = rho & 255, m = (k * n) & 255; FC[e] = f2bf(sc * (c2 == 0 ? cospif(m * (2.f / 256.f)) : sinpif(m * (2.f / 256.f)))); }
    }
    {
        LAS float* sv = (LAS float*)lds;
        LAS float* red = sv + 3 * 1024;
        __syncthreads();
        for (int e = tid; e < 3 * 1024; e += NTHREADS) { const int j = e >> 10, k = e & 1023; const float v = j < 2 ? p.in[1][j * D + k] : p.in[3][k]; sv[e] = siluf_(v); }
        __syncthreads();
        const int kq = tid >> 6, cl = tid & 63;
        for (int it = bid; it < 2 * 96; it += nb) {
            const int l = it / 96, n = (it % 96) * 64 + cl;
            const float* W = p.in[4] + (size_t)l * D * 6144 + n;
            float a0 = 0.f, a1 = 0.f, a2 = 0.f;
#pragma unroll 32
            for (int k = kq; k < D; k += 8) { const float w = W[(size_t)k * 6144]; a0 += sv[k] * w; a1 += sv[1024 + k] * w; a2 += sv[2048 + k] * w; }
            red[(kq * 3 + 0) * 64 + cl] = a0; red[(kq * 3 + 1) * 64 + cl] = a1; red[(kq * 3 + 2) * 64 + cl] = a2;
            __syncthreads();
            if (tid < 192) { const int j = tid >> 6; float s = 0.f;
#pragma unroll
                for (int q = 0; q < 8; ++q) s += red[(q * 3 + j) * 64 + cl];
                ((float*)(p.ws + WS_MODS))[(size_t)(l * 3 + j) * 6144 + n] = s + p.in[5][l * 6144 + n]; }
            __syncthreads();
        }
    }
}
struct MoeTile { const float* src; unsigned char* dst; int N, K, mode, k0, n0; };
__device__ __forceinline__ MoeTile moe_tile(const P& p, const float* sg, const float* su, const float* sd, int f) {
    const int j = f / 176, i = f - j * 176, e = j / 3, t = j - 3 * e; MoeTile m;
    m.src = (t == 0 ? sg : (t == 1 ? su : sd)) + (size_t)e * D * FFN; m.N = t < 2 ? FFN : D; m.K = t < 2 ? D : FFN;
    m.dst = p.ws + (t < 2 ? WS_MOE1 + (size_t)e * 5632 * D : WS_MOE2 + (size_t)e * D * FFN); m.mode = t < 2 ? t + 1 : 0;
    const int nn = m.N / 128; m.k0 = (i / nn) * 128; m.n0 = (i % nn) * 128; return m;
}
__device__ __forceinline__ void moe_tile_load(const MoeTile& m, f32x4 (&v)[8]) {
    const int tid = threadIdx.x;
#pragma unroll
    for (int i = 0; i < 8; ++i) { const int e = tid + i * NTHREADS, kk = e >> 5, n4 = (e & 31) * 4; v[i] = *(const f32x4*)(m.src + (size_t)(m.k0 + kk) * m.N + m.n0 + n4); }
}
__device__ __forceinline__ void ph_moe_convert(const P& p, LAS unsigned char* lds) {
    LAS float* scr = (LAS float*)lds;
    const float* sg = p.in[27]; const float* su = p.in[28]; const float* sd = p.in[29];
    asm volatile("" : "+s"(sg), "+s"(su), "+s"(sd));
    const int tid = threadIdx.x, nb = gridDim.x, NT = 24 * 176;
    int f = blockIdx.x; f32x4 va[8], vb[8]; MoeTile cur, nxt;
    if (f < NT) { cur = moe_tile(p, sg, su, sd, f); moe_tile_load(cur, va); }
    __syncthreads();
    while (f < NT) {
        const int fn = f + nb;
        if (fn < NT) { nxt = moe_tile(p, sg, su, sd, fn); moe_tile_load(nxt, vb); }
        asm volatile("s_waitcnt lgkmcnt(0)\n\ts_barrier" ::: "memory");
#pragma unroll
        for (int i = 0; i < 8; ++i) { const int e = tid + i * NTHREADS, kk = e >> 5, n4 = (e & 31) * 4;
            *(LAS f32x4*)(scr + kk * 132 + ((kk >> 5) << 3) + n4) = va[i]; }
        asm volatile("s_waitcnt lgkmcnt(0)\n\ts_barrier" ::: "memory");
        { const int nn = tid >> 2, kc = (tid & 3) * 32; u32x4 o[2];
#pragma unroll
          for (int h = 0; h < 2; ++h) { const LAS float* sp = scr + (kc + h * 16) * 132 + ((kc >> 5) << 3) + nn;
              o[h].x = pk4_fp8(sp[0] * F8_WSCALE, sp[132] * F8_WSCALE, sp[2 * 132] * F8_WSCALE, sp[3 * 132] * F8_WSCALE);
              o[h].y = pk4_fp8(sp[4 * 132] * F8_WSCALE, sp[5 * 132] * F8_WSCALE, sp[6 * 132] * F8_WSCALE, sp[7 * 132] * F8_WSCALE);
              o[h].z = pk4_fp8(sp[8 * 132] * F8_WSCALE, sp[9 * 132] * F8_WSCALE, sp[10 * 132] * F8_WSCALE, sp[11 * 132] * F8_WSCALE);
              o[h].w = pk4_fp8(sp[12 * 132] * F8_WSCALE, sp[13 * 132] * F8_WSCALE, sp[14 * 132] * F8_WSCALE, sp[15 * 132] * F8_WSCALE); }
          unsigned char* d = cur.dst + (size_t)rowmap(cur.mode, cur.n0 + nn) * cur.K + cur.k0 + kc;
          *(u32x4*)d = o[0]; *(u32x4*)(d + 16) = o[1]; }
        f = fn; cur = nxt;
#pragma unroll
        for (int i = 0; i < 8; ++i) va[i] = vb[i];
    }
    __syncthreads();
}

__device__ __forceinline__ void ph_norm(const P& p, LAS unsigned char* lds, int layer, int which, bool first, bool route, int nrows, bool copy = true) {
    LAS unsigned* cnt_lds = (LAS unsigned*)lds;
    LAS float* Wl = (LAS float*)(lds + 1024);
    if (route) { __syncthreads(); if (threadIdx.x < NEXP) cnt_lds[threadIdx.x] = 0u;
        for (int i = threadIdx.x; i < D * NEXP; i += NTHREADS) Wl[(i & 7) * D + (i >> 3)] = p.in[26][i];
        __syncthreads(); }
    const int lane = threadIdx.x & 63, gw = blockIdx.x * 8 + (threadIdx.x >> 6), ngw = gridDim.x * 8;
    const float* gain = p.in[which == 0 ? 6 : 7] + layer * D;
    bf16* A = (bf16*)(p.ws + WS_A);
    for (int r = gw; r < nrows; r += ngw) {
        const int mi = row_mi(r);
        const float* src = first ? (r < NLAT ? p.in[0] + (size_t)r * D : p.in[2] + (size_t)(r - NLAT) * D) : hrow(p, r);
        const float* shift = mods(p, layer, mi, which == 0 ? 0 : 3); const float* scale = mods(p, layer, mi, which == 0 ? 1 : 4);
        f32x4 v[4]; float ss = 0.f;
#pragma unroll
        for (int j = 0; j < 4; ++j) { v[j] = *(const f32x4*)(src + 4 * lane + 256 * j); ss += v[j].x * v[j].x + v[j].y * v[j].y + v[j].z * v[j].z + v[j].w * v[j].w; }
        if (first && copy) { float* h = hrow(p, r);
#pragma unroll
            for (int j = 0; j < 4; ++j) *(f32x4*)(h + 4 * lane + 256 * j) = v[j]; }
        const float rstd = rsqrtf(wave_sum(ss) * (1.f / D) + EPS);
        float lg[8];
#pragma unroll
        for (int e = 0; e < 8; ++e) lg[e] = 0.f;
#pragma unroll
        for (int j = 0; j < 4; ++j) {
            const int c = 4 * lane + 256 * j;
            const f32x4 g = *(const f32x4*)(gain + c), sc = *(const f32x4*)(scale + c), sh = *(const f32x4*)(shift + c);
            f32x4 y = v[j] * rstd * g * (sc + 1.f) + sh;
            u32x2 o; o.x = pk2(y.x, y.y); o.y = pk2(y.z, y.w);
            if (!route) *(u32x2*)(A + (size_t)r * D + c) = o;
            if ((which == 0 || route) && r < NLAT) *(unsigned*)(p.ws + WS_A8 + (size_t)r * D + c) = pk4_fp8(y.x, y.y, y.z, y.w);
            if (route) {
#pragma unroll
                for (int e = 0; e < 8; ++e) { const f32x4 w = *(const LAS f32x4*)(Wl + e * D + c); lg[e] += (y[0] * w[0] + y[1] * w[1]) + (y[2] * w[2] + y[3] * w[3]); }
            }
        }
        if (route) {
            {
                const bool b5 = (lane & 32) != 0, b4 = (lane & 16) != 0, b3 = (lane & 8) != 0; float v4[4], v2[2];
#pragma unroll
                for (int i = 0; i < 4; ++i) { const float keep = b5 ? lg[4 + i] : lg[i], send = b5 ? lg[i] : lg[4 + i]; v4[i] = keep + __shfl_xor(send, 32); }
#pragma unroll
                for (int i = 0; i < 2; ++i) { const float keep = b4 ? v4[2 + i] : v4[i], send = b4 ? v4[i] : v4[2 + i]; v2[i] = keep + __shfl_xor(send, 16); }
                float v1 = (b3 ? v2[1] : v2[0]) + __shfl_xor(b3 ? v2[0] : v2[1], 8);
                v1 += __shfl_xor(v1, 4); v1 += __shfl_xor(v1, 2); v1 += __shfl_xor(v1, 1);
#pragma unroll
                for (int e = 0; e < 8; ++e) lg[e] = __builtin_bit_cast(float, __builtin_amdgcn_readlane(__builtin_bit_cast(int, v1), 8 * e)); }
            if (lane == 0) {
                int e0 = 0; float v0 = lg[0];
#pragma unroll
                for (int e = 1; e < 8; ++e) if (lg[e] > v0) { v0 = lg[e]; e0 = e; }
                int e1 = -1; float v1 = -INFINITY;
#pragma unroll
                for (int e = 0; e < 8; ++e) if (e != e0 && lg[e] > v1) { v1 = lg[e]; e1 = e; }
                const float w0 = 1.f / (1.f + expf(v1 - v0));
                int* tok_e = (int*)(p.ws + WS_ROUTE); float* tok_w = (float*)(p.ws + WS_ROUTE) + 16384 * 2;
                tok_e[r * 2] = e0; tok_e[r * 2 + 1] = e1; tok_w[r * 2] = w0; tok_w[r * 2 + 1] = 1.f - w0;
                __hip_atomic_fetch_add(cnt_lds + e0, 1u, __ATOMIC_RELAXED, __HIP_MEMORY_SCOPE_WORKGROUP); __hip_atomic_fetch_add(cnt_lds + e1, 1u, __ATOMIC_RELAXED, __HIP_MEMORY_SCOPE_WORKGROUP);
            }
        }
    }
    if (route) { __syncthreads(); if (threadIdx.x < NEXP) ((unsigned*)(p.ws + WS_ROUTE) + 16384 * 6)[blockIdx.x * NEXP + threadIdx.x] = cnt_lds[threadIdx.x]; __syncthreads(); }
}

__device__ __forceinline__ void norm_row(const P& p, int layer, int which, int r, int lane) {
    const float* gain = p.in[which == 0 ? 6 : 7] + layer * D; bf16* A = (bf16*)(p.ws + WS_A);
    const int mi = row_mi(r); const float* src = hrow(p, r);
    const float* shift = mods(p, layer, mi, which == 0 ? 0 : 3); const float* scale = mods(p, layer, mi, which == 0 ? 1 : 4);
    f32x4 v[4]; float ss = 0.f;
#pragma unroll
    for (int j = 0; j < 4; ++j) { v[j] = *(const f32x4*)(src + 4 * lane + 256 * j); ss += v[j].x * v[j].x + v[j].y * v[j].y + v[j].z * v[j].z + v[j].w * v[j].w; }
    const float rstd = rsqrtf(wave_sum(ss) * (1.f / D) + EPS);
#pragma unroll
    for (int j = 0; j < 4; ++j) { const int c = 4 * lane + 256 * j;
        const f32x4 g = *(const f32x4*)(gain + c), sc = *(const f32x4*)(scale + c), sh = *(const f32x4*)(shift + c);
        const f32x4 y = v[j] * rstd * g * (sc + 1.f) + sh;
        u32x2 o; o.x = pk2(y.x, y.y); o.y = pk2(y.z, y.w);
        *(u32x2*)(A + (size_t)r * D + c) = o; }
}

namespace fg {
typedef short bf16x8 __attribute__((ext_vector_type(8)));
constexpr int BM = 256, BK = 64, HALF = 128, HTB = HALF * BK * 2, STAGE_BYTES = 8 * HTB, NXCD = 8, WGM = 8;
__device__ __forceinline__ int lds_byte(int r, int c) { const int st = (r >> 4) * 2 + (c >> 5), rr = r & 15, cc = c & 31, ob = rr * 64 + cc * 2; return st * 1024 + (ob ^ (((ob >> 9) & 1) << 5)); }
__device__ __forceinline__ void stage_rc(int b, int& R, int& C) { const int st = b / 1024, sb = b % 1024, swz = sb ^ (((sb >> 9) & 1) << 5); R = (st >> 1) * 16 + swz / 64; C = (st & 1) * 32 + (swz % 64) / 2; }
__device__ __forceinline__ int perm32(int rho) { const int n = rho >> 4, i = rho & 15; return 8 * (i >> 2) + 4 * n + (i & 3); }
struct Unit { int pm, pn; const char* A; const char* B; int nt, aux; };
__device__ __forceinline__ bool tile_order(int i, int nM, int nN, int G, int c, int& pm, int& pn) {
    const int nwg = nM * nN; const long L = (long)i * G + c; if (L >= nwg) return false;
    int wgid = (int)L; { const int q = nwg / NXCD, r = nwg % NXCD, xcd = wgid % NXCD, off = wgid / NXCD; wgid = (xcd < r ? xcd * (q + 1) : r * (q + 1) + (xcd - r) * q) + off; }
    const int nig = WGM * nN, gid = wgid / nig, fm = gid * WGM, gsz = (nM - fm) < WGM ? (nM - fm) : WGM;
    pm = fm + ((wgid % nig) % gsz); pn = (wgid % nig) / gsz; return true;
}
struct PlainSched {
    const char* Abase; const char* Bbase; int lda, ldb, nM, nN, G, c, nt;
    __device__ __forceinline__ int arow(int R) const { return R; }
    __device__ __forceinline__ int ahalf() const { return HALF; }
    __device__ __forceinline__ bool next(int i, Unit& u) const { if (!tile_order(i, nM, nN, G, c, u.pm, u.pn)) return false;
        u.A = Abase + (size_t)u.pm * BM * lda * 2; u.B = Bbase + (size_t)u.pn * BM * ldb * 2; u.nt = nt; u.aux = 0; return true; }
};
struct ExpertSched {
    const char* Abase; const char* Bbase; int lda, ldb, nM, nN, G, c, nt; const LAS int* tile_e; size_t estride;
    __device__ __forceinline__ int arow(int R) const { return R; }
    __device__ __forceinline__ int ahalf() const { return HALF; }
    __device__ __forceinline__ bool next(int i, Unit& u) const { if (!tile_order(i, nM, nN, G, c, u.pm, u.pn)) return false;
        u.A = Abase + (size_t)u.pm * BM * lda * 2; u.B = Bbase + (size_t)tile_e[u.pm] * estride + (size_t)u.pn * BM * ldb * 2; u.nt = nt; u.aux = 0; return true; }
};
struct WinSched {
    const char* Abase; const char* Bbase; int G, c, mode, nN;
    __device__ __forceinline__ int arow(int R) const { return mode == 0 ? 256 * (R & 15) + 64 * ((R >> 4) & 3) + (R >> 6) : R; }
    __device__ __forceinline__ int ahalf() const { return mode == 0 ? 4096 : HALF; }
    __device__ __forceinline__ bool next(int i, Unit& u) const { if (!tile_order(i, mode == 0 ? 64 : 2, nN, G, c, u.pm, u.pn)) return false;
        const size_t row0 = mode == 0 ? (size_t)((u.pm >> 5) * SEQ + 2 * (u.pm & 31)) : (size_t)(NLAT + u.pm * CTX);
        u.A = Abase + row0 * D * 2; u.B = Bbase + (size_t)u.pn * BM * D * 2; u.nt = D / 64; u.aux = mode; return true; }
};
struct MergeSched {
    const char* Xbase; const char* Wbase; int nM, G, c;
    __device__ __forceinline__ int arow(int R) const { return R; }
    __device__ __forceinline__ int ahalf() const { return HALF; }
    __device__ __forceinline__ bool next(int i, Unit& u) const { if (!tile_order(i >> 2, nM, 4, G, c, u.pm, u.pn)) return false;
        const int br = i & 3, koff = br == 0 ? 0 : (br == 1 ? 512 : (br == 2 ? 768 : 1280));
        u.A = Xbase + ((size_t)u.pm * BM * 1536 + koff) * 2; u.B = Wbase + ((size_t)u.pn * BM * 1536 + koff) * 2; u.nt = (br & 1) ? 4 : 8; u.aux = br; return true; }
};
template <class E, class = void> struct is_chain { static constexpr bool v = false; };
template <class E> struct is_chain<E, decltype((void)E::CHAIN)> { static constexpr bool v = E::CHAIN; };
typedef f32x4 Acc[2][2][4][2];
typedef int i32x4 __attribute__((ext_vector_type(4))); typedef int i32x8 __attribute__((ext_vector_type(8)));
__device__ __forceinline__ i32x8 ld32(const LAS unsigned char* p) { const i32x4 a = *(const LAS i32x4*)p, b = *(const LAS i32x4*)(p + 16); return __builtin_shufflevector(a, b, 0, 1, 2, 3, 4, 5, 6, 7); }
template <class Epi, class Sched, bool F8 = false>
__device__ __forceinline__ void gemm_phase(LAS unsigned char* lds, int lda, int ldb, const Sched& S, const Epi& E) {
    int tid_ = threadIdx.x; asm volatile("" : "+v"(tid_));
    const int tid = tid_, wid = __builtin_amdgcn_readfirstlane(tid >> 6), lane = tid & 63, wr = wid >> 2, wc = wid & 3, fr = lane & 15, fq = lane >> 4;
    unsigned voffA[2], voffB[2];
#pragma unroll
    for (int i = 0; i < 2; ++i) { int R, C; stage_rc(tid * 16 + i * 8192, R, C); const int Rb = Epi::PERM ? ((R & ~31) + perm32(R & 31)) : R;
        voffA[i] = (unsigned)(S.arow(R) * lda + C) * 2u; voffB[i] = (unsigned)(Rb * ldb + C) * 2u; }
    const size_t kstep = (size_t)(BK * 2);
    const size_t hstepA = (size_t)S.ahalf() * lda * 2, hstepB = (size_t)HALF * ldb * 2;
    const unsigned ldsw = (unsigned)wid * 1024u;
    const int aoff = lds_byte(wr * 64 + fr, F8 ? fq * 16 : fq * 8), boff = lds_byte(wc * 32 + fr, F8 ? fq * 16 : fq * 8);
#define FG_SA(b, h) (((b) * 2 + (h)) * HTB)
#define FG_SB(b, h) ((4 + (b) * 2 + (h)) * HTB)
#define FG_STAGE(bufoff, gbase, voff) do { _Pragma("unroll") for (int _i = 0; _i < 2; ++_i) \
        __builtin_amdgcn_global_load_lds((const unsigned*)((const char*)(gbase) + (voff)[_i]), (LAS unsigned*)(lds + (bufoff) + ldsw + _i * 8192), 16, 0, 0); } while (0)
#define FG_LDA(dst, b, h) do { if constexpr (F8) { _Pragma("unroll") for (int m = 0; m < 4; ++m) dst##8[m] = ld32(lds + FG_SA(b, h) + aoff + m * 2048); } \
        else { _Pragma("unroll") for (int m = 0; m < 4; ++m) _Pragma("unroll") for (int k = 0; k < 2; ++k) dst[m][k] = *(const LAS bf16x8*)(lds + FG_SA(b, h) + aoff + m * 2048 + k * 1024); } } while (0)
#define FG_LDB(dst, b, h) do { if constexpr (F8) { _Pragma("unroll") for (int n = 0; n < 2; ++n) dst##8[n] = ld32(lds + FG_SB(b, h) + boff + n * 2048); } \
        else { _Pragma("unroll") for (int n = 0; n < 2; ++n) _Pragma("unroll") for (int k = 0; k < 2; ++k) dst[n][k] = *(const LAS bf16x8*)(lds + FG_SB(b, h) + boff + n * 2048 + k * 1024); } } while (0)
#define FG_MMA(ai, bj, At, Bt) do { __builtin_amdgcn_s_setprio(1); _Pragma("unroll") for (int m = 0; m < 4; ++m) _Pragma("unroll") for (int n = 0; n < 2; ++n) { \
        if constexpr (F8) asm volatile("v_mfma_scale_f32_16x16x128_f8f6f4 %0, %1, %2, %0, %3, %4 op_sel_hi:[0,0,0]" : "+v"(acc[ai][bj][m][n]) : "v"(Bt##8[n]), "v"(At##8[m]), "v"(scw), "v"(sca)); \
        else { _Pragma("unroll") for (int k = 0; k < 2; ++k) acc[ai][bj][m][n] = __builtin_amdgcn_mfma_f32_16x16x32_bf16(Bt[n][k], At[m][k], acc[ai][bj][m][n], 0, 0, 0); } } \
        __builtin_amdgcn_s_setprio(0); } while (0)
#define FG_WAIT_V(n) asm volatile("s_waitcnt vmcnt(" #n ")" ::: "memory")
#define FG_WAIT_L(n) asm volatile("s_waitcnt lgkmcnt(" #n ")" ::: "memory")
#define FG_BAR __builtin_amdgcn_s_barrier()
#define FG_SCHED __builtin_amdgcn_sched_barrier(0)
    Unit cur, nxt; int ui = 0;
    if (!S.next(0, cur)) return;
    Acc acc;
#pragma unroll
    for (int a = 0; a < 2; ++a)
#pragma unroll
        for (int b = 0; b < 2; ++b)
#pragma unroll
            for (int m = 0; m < 4; ++m)
#pragma unroll
                for (int n = 0; n < 2; ++n) acc[a][b][m][n] = (f32x4){0.f, 0.f, 0.f, 0.f};
    bf16x8 At[4][2], B0[2][2], B1[2][2]; i32x8 At8[4], B08[2], B18[2];
    const int scw = 0x7a7a7a7a, sca = 0x7f7f7f7f;
    const char* cA = cur.A; const char* cB = cur.B;
    FG_STAGE(FG_SB(0, 0), cB, voffB); FG_STAGE(FG_SB(0, 1), cB + hstepB, voffB); FG_STAGE(FG_SA(0, 0), cA, voffA); FG_STAGE(FG_SA(0, 1), cA + hstepA, voffA);
    if (wr == 1) FG_BAR;
    FG_WAIT_V(2); FG_BAR;
    FG_STAGE(FG_SB(1, 0), cB + kstep, voffB); FG_STAGE(FG_SA(1, 0), cA + kstep, voffA); FG_STAGE(FG_SB(1, 1), cB + hstepB + kstep, voffB);
    FG_WAIT_V(6); FG_BAR;
    for (;;) {
        const bool has_next = S.next(ui + 1, nxt);
        const char* nA = has_next ? nxt.A : cA; const char* nB = has_next ? nxt.B : cB;
        const int nt = cur.nt;
#pragma unroll 1
        for (int t = 0; t < nt; t += 2) {
            const bool last = (t == nt - 2);
            const char* a1 = cA + (size_t)(t + 1) * kstep;
            const char* a2 = last ? nA : cA + (size_t)(t + 2) * kstep; const char* b2 = last ? nB : cB + (size_t)(t + 2) * kstep;
            const char* a3 = a2 + kstep; const char* b3 = b2 + kstep;
            FG_LDB(B0, 0, 0); FG_LDB(B1, 0, 1); FG_SCHED; FG_LDA(At, 0, 0); FG_STAGE(FG_SA(1, 1), a1 + hstepA, voffA);
            FG_WAIT_V(8); FG_WAIT_L(0); FG_BAR; FG_MMA(0, 0, At, B0); FG_MMA(0, 1, At, B1); FG_BAR; FG_SCHED;
            FG_LDA(At, 0, 1); FG_STAGE(FG_SB(0, 0), b2, voffB); FG_STAGE(FG_SB(0, 1), b2 + hstepB, voffB); FG_STAGE(FG_SA(0, 0), a2, voffA);
            FG_WAIT_V(8); FG_WAIT_L(0); FG_BAR; FG_MMA(1, 0, At, B0); FG_MMA(1, 1, At, B1); FG_BAR; FG_SCHED;
            FG_LDB(B0, 1, 0); FG_LDB(B1, 1, 1); FG_SCHED; FG_LDA(At, 1, 0); FG_STAGE(FG_SA(0, 1), a2 + hstepA, voffA);
            FG_WAIT_V(8); FG_WAIT_L(0); FG_BAR; FG_MMA(0, 0, At, B0); FG_MMA(0, 1, At, B1); FG_BAR; FG_SCHED;
            FG_LDA(At, 1, 1); FG_STAGE(FG_SB(1, 0), b3, voffB); FG_STAGE(FG_SB(1, 1), b3 + hstepB, voffB); FG_STAGE(FG_SA(1, 0), a3, voffA);
            FG_WAIT_V(8); FG_WAIT_L(0); FG_BAR; FG_MMA(1, 0, At, B0); FG_MMA(1, 1, At, B1); FG_BAR; FG_SCHED;
        }
        if (wr == 0) FG_BAR;
        E(acc, cur, wr, wc, fr, fq);
        if (!has_next) break;
        if (!(is_chain<Epi>::v && cur.aux != 3)) {
#pragma unroll
        for (int a = 0; a < 2; ++a)
#pragma unroll
            for (int b = 0; b < 2; ++b)
#pragma unroll
                for (int m = 0; m < 4; ++m)
#pragma unroll
                    for (int n = 0; n < 2; ++n) acc[a][b][m][n] = (f32x4){0.f, 0.f, 0.f, 0.f};
        }
        cur = nxt; cA = nA; cB = nB; ++ui;
        if (wr == 1) FG_BAR;
    }
    FG_WAIT_V(0);
    FG_BAR;
#undef FG_SA
#undef FG_SB
#undef FG_STAGE
#undef FG_LDA
#undef FG_LDB
#undef FG_MMA
#undef FG_WAIT_V
#undef FG_WAIT_L
#undef FG_BAR
#undef FG_SCHED
}
__device__ __forceinline__ unsigned cvt_pk(float lo, float hi) { unsigned r; asm volatile("v_cvt_pk_bf16_f32 %0, %1, %2" : "=v"(r) : "v"(lo), "v"(hi)); return r; }
__device__ __forceinline__ u32x4 pack8(const f32x4 a, const f32x4 b) { u32x4 w; w.x = cvt_pk(a[0], a[1]); w.y = cvt_pk(a[2], a[3]); w.z = cvt_pk(b[0], b[1]); w.w = cvt_pk(b[2], b[3]); return w; }
__device__ __forceinline__ f32x4 unpk_u8(unsigned x) { const float k = 1.f / 255.f; return (f32x4){(float)(x & 0xffu) * k, (float)((x >> 8) & 0xffu) * k, (float)((x >> 16) & 0xffu) * k, (float)(x >> 24) * k}; }
__device__ __forceinline__ f32x4 unpk_u8r(unsigned x) { return (f32x4){(float)(x & 0xffu), (float)((x >> 8) & 0xffu), (float)((x >> 16) & 0xffu), (float)(x >> 24)}; }
__device__ __forceinline__ f32x4 unpk_lo(unsigned x, unsigned y) { return (f32x4){__uint_as_float(x << 16), __uint_as_float(x & 0xffff0000u), __uint_as_float(y << 16), __uint_as_float(y & 0xffff0000u)}; }

struct EpiWin {
    static constexpr bool PERM = true;
    unsigned char* ws; const float* qg; const float* kg;
    __device__ __forceinline__ void operator()(const Acc& acc, const Unit& u, int wr, int wc, int fr_, int fq_) const {
        int fr = fr_, fq = fq_; asm volatile("" : "+v"(fr), "+v"(fq));
        const int tile = u.pn; const bool LAT = u.aux == 0;
        if (tile == 0) {
            if (LAT) {
                const int b = u.pm >> 5, n2 = 2 * (u.pm & 31) + wr;
#pragma unroll
                for (int ai = 0; ai < 2; ++ai)
#pragma unroll
                    for (int bj = 0; bj < 2; ++bj) {
#pragma unroll
                        for (int n = 0; n < 2; ++n)
#pragma unroll
                            for (int e = 0; e < 4; ++e) { const int ch = bj * HALF + wc * 32 + 8 * fq + 4 * n + e;
                                u32x2 o; o.x = cvt_pk(acc[ai][bj][0][n][e], acc[ai][bj][1][n][e]); o.y = cvt_pk(acc[ai][bj][2][n][e], acc[ai][bj][3][n][e]);
                                *(u32x2*)((bf16*)(ws + WS_UT) + ((size_t)(b * 256 + ch) * 64 + n2) * 256 + 64 * ai + 4 * fr) = o; }
                        asm volatile("" ::: "memory"); }
            } else {
#pragma unroll
                for (int ai = 0; ai < 2; ++ai)
#pragma unroll
                    for (int m = 0; m < 4; ++m) { const int sx = ai * HALF + wr * 64 + m * 16 + fr;
#pragma unroll
                        for (int bj = 0; bj < 2; ++bj)
#pragma unroll
                            for (int n = 0; n < 2; ++n)
#pragma unroll
                                for (int e = 0; e < 4; ++e) { const int ch = bj * HALF + wc * 32 + 8 * fq + 4 * n + e;
                                    ((bf16*)(ws + WS_UTC))[(size_t)(u.pm * 256 + ch) * 256 + sx] = f2bf(acc[ai][bj][m][n][e]); }
                        asm volatile("" ::: "memory"); }
            }
            return;
        }
        const bool ropek = tile == 1 || tile == 2 || tile == 5 || tile == 6 || (tile == 7 && wc < 2);
        const bool keyrow = tile == 7;
        size_t boff; int pitch, col0;
        if (tile <= 4) { boff = WS_RETQ + (size_t)(tile - 1) * MROWS * 256 * 2; pitch = 256; col0 = ropek ? wc * 64 : wc * 32; }
        else if (tile <= 6) { boff = WS_ATTQ; pitch = 512; col0 = (tile - 5) * 256 + wc * 64; }
        else if (tile == 7) { boff = wc < 2 ? WS_ATTK : WS_ATTV; pitch = 128; col0 = (wc & 1) * 64; }
        else if (tile < 10) { boff = WS_CONV; pitch = 512; col0 = (tile - 8) * 256 + wc * 32; }
        else { boff = WS_G; pitch = 4096; col0 = (tile - 10) * 256 + wc * 32; }
        const bool head = ropek || tile == 7;
        bf16* const dbase = (bf16*)(ws + boff);
        const bool norm = tile >= 5 && ropek;
        const float* gp = tile == 7 ? kg : qg;
        const float osc = tile == 2 ? 0.125f : (tile == 5 || tile == 6 ? QSCALE : 1.f);
        const float* rc = (const float*)(ws + WS_ROPE);
#pragma unroll
        for (int ai = 0; ai < 2; ++ai) {
            f32x4 rcs[4][2], rsn[4][2];
            if (ropek && LAT) {
#pragma unroll
                for (int m = 0; m < 4; ++m)
#pragma unroll
                    for (int bj = 0; bj < 2; ++bj) { const int sx = 4096 * ai + 256 * fr + 64 * m + 2 * (u.pm & 31) + wr, i0 = 16 * bj + 4 * fq;
                        rcs[m][bj] = *(const f32x4*)(rc + sx * 32 + i0); rsn[m][bj] = *(const f32x4*)(rc + SEQ * 32 + sx * 32 + i0); } }
#pragma unroll
            for (int m = 0; m < 4; ++m) {
                const int b = LAT ? (u.pm >> 5) : u.pm, s = LAT ? (4096 * ai + 256 * fr + 64 * m + 2 * (u.pm & 31) + wr) : (ai * HALF + wr * 64 + m * 16 + fr);
                const int rr = keyrow ? b * KEYS + (LAT ? CTX + s : s) : (LAT ? b * SEQ + s : NLAT + b * CTX + s);
                bf16* const drow = dbase + ((size_t)rr * pitch + col0 + 8 * fq);
                if (ropek) {
                    float rstd = 1.f;
                    if (norm) { float ss = 0.f;
#pragma unroll
                        for (int bj = 0; bj < 2; ++bj)
#pragma unroll
                            for (int n = 0; n < 2; ++n) { const f32x4 x = acc[ai][bj][m][n]; ss += (x[0] * x[0] + x[1] * x[1]) + (x[2] * x[2] + x[3] * x[3]); }
                        ss += __shfl_xor(ss, 16); ss += __shfl_xor(ss, 32);
                        rstd = rsqrtf(ss * (1.f / 64.f) + EPS); }
#pragma unroll
                    for (int bj = 0; bj < 2; ++bj) {
                        const int i0 = 16 * bj + 4 * fq;
                        f32x4 x1 = acc[ai][bj][m][0], x2 = acc[ai][bj][m][1];
                        if (norm) { const f32x4 g1 = *(const f32x4*)(gp + i0), g2 = *(const f32x4*)(gp + 32 + i0); x1 = x1 * rstd * g1; x2 = x2 * rstd * g2; }
                        f32x4 o1 = x1, o2 = x2;
                        if (LAT) { const f32x4 cs = rcs[m][bj], sn = rsn[m][bj]; o1 = x1 * cs - x2 * sn; o2 = x1 * sn + x2 * cs; }
                        *(u32x4*)(drow + 32 * bj) = pack8(o1 * osc, o2 * osc);
                    }
                } else {
#pragma unroll
                    for (int bj = 0; bj < 2; ++bj) {
                        f32x4 a0 = acc[ai][bj][m][0], a1 = acc[ai][bj][m][1];
                        if (tile >= 10) {
                            u32x2 o; o.x = 0u; o.y = 0u;
#pragma unroll
                            for (int e = 0; e < 4; ++e) { o.x = __builtin_amdgcn_cvt_pk_u8_f32(__builtin_fmaxf(__builtin_floorf(sigmoid_fast(a0[e]) * 255.f + 0.5f), 1.f), e, o.x);
                                o.y = __builtin_amdgcn_cvt_pk_u8_f32(__builtin_fmaxf(__builtin_floorf(sigmoid_fast(a1[e]) * 255.f + 0.5f), 1.f), e, o.y); }
                            *(u32x2*)(ws + WS_G + (size_t)rr * 4096 + (tile - 10) * 256 + wc * 32 + 8 * fq + HALF * bj) = o;
                        } else *(u32x4*)(drow + (head ? 32 : HALF) * bj) = pack8(a0, a1);
                    }
                }
            }
        }
    }
};
struct EpiGate8 {
    static constexpr bool PERM = true;
    unsigned char* G;
    __device__ __forceinline__ void operator()(const Acc& acc, const Unit& u, int wr, int wc, int fr_, int fq_) const {
        int fr = fr_, fq = fq_; asm volatile("" : "+v"(fr), "+v"(fq));
#pragma unroll
        for (int ai = 0; ai < 2; ++ai)
#pragma unroll
            for (int m = 0; m < 4; ++m) { const int r = u.pm * BM + ai * HALF + wr * 64 + m * 16 + fr;
#pragma unroll
                for (int bj = 0; bj < 2; ++bj) { const f32x4 a0 = acc[ai][bj][m][0], a1 = acc[ai][bj][m][1]; u32x2 o; o.x = 0u; o.y = 0u;
#pragma unroll
                    for (int e = 0; e < 4; ++e) { o.x = __builtin_amdgcn_cvt_pk_u8_f32(__builtin_fmaxf(__builtin_floorf(sigmoid_fast(a0[e]) * 255.f + 0.5f), 1.f), e, o.x);
                        o.y = __builtin_amdgcn_cvt_pk_u8_f32(__builtin_fmaxf(__builtin_floorf(sigmoid_fast(a1[e]) * 255.f + 0.5f), 1.f), e, o.y); }
                    *(u32x2*)(G + (size_t)r * 4096 + u.pn * BM + bj * HALF + wc * 32 + 8 * fq) = o; } }
    }
};
struct EpiMerge {
    static constexpr bool PERM = true, CHAIN = true;
    const unsigned char* G; bf16* Mg;
    __device__ __forceinline__ void operator()(Acc& acc, const Unit& u, int wr, int wc, int fr_, int fq_) const {
        int fr = fr_, fq = fq_; asm volatile("" : "+v"(fr), "+v"(fq));
        const int br = u.aux; const bool lastb = br == 3;
#pragma unroll
        for (int ai = 0; ai < 2; ++ai) {
            u32x2 g[4][2], gn[4][2];
#pragma unroll
            for (int m = 0; m < 4; ++m)
#pragma unroll
                for (int bj = 0; bj < 2; ++bj) { const int r = u.pm * BM + ai * HALF + wr * 64 + m * 16 + fr, c = u.pn * BM + bj * HALF + wc * 32 + 8 * fq;
                    g[m][bj] = *(const u32x2*)(G + (size_t)r * 4096 + br * 1024 + c);
                    if (!lastb) gn[m][bj] = *(const u32x2*)(G + (size_t)r * 4096 + (br + 1) * 1024 + c); }
#pragma unroll
            for (int m = 0; m < 4; ++m)
#pragma unroll
                for (int bj = 0; bj < 2; ++bj) {
                    if (!lastb) {
                        const f32x4 n0 = unpk_u8r(g[m][bj].x), n1 = unpk_u8r(g[m][bj].y), d0 = unpk_u8r(gn[m][bj].x), d1 = unpk_u8r(gn[m][bj].y);
#pragma unroll
                        for (int e = 0; e < 4; ++e) { acc[ai][bj][m][0][e] *= n0[e] * __builtin_amdgcn_rcpf(d0[e]); acc[ai][bj][m][1][e] *= n1[e] * __builtin_amdgcn_rcpf(d1[e]); }
                    } else { const int r = u.pm * BM + ai * HALF + wr * 64 + m * 16 + fr, c = u.pn * BM + bj * HALF + wc * 32 + 8 * fq;
                        *(u32x4*)(Mg + (size_t)r * 1024 + c) = pack8(acc[ai][bj][m][0] * unpk_u8(g[m][bj].x), acc[ai][bj][m][1] * unpk_u8(g[m][bj].y)); } }
        }
    }
};
struct EpiResid {
    static constexpr bool PERM = false;
    float* out; float* hctx; const float* modbase; int chunk;
    __device__ __forceinline__ void operator()(const Acc& acc, const Unit& u, int wr, int wc, int fr_, int fq_) const {
        int fr = fr_, fq = fq_; asm volatile("" : "+v"(fr), "+v"(fq));
        const int rt = u.pm * BM;
        const float* g = modbase + ((size_t)row_mi(rt) * 6 + chunk) * D;
        f32x4 gg[2][2];
#pragma unroll
        for (int bj = 0; bj < 2; ++bj)
#pragma unroll
            for (int n = 0; n < 2; ++n) gg[bj][n] = *(const f32x4*)(g + u.pn * BM + bj * HALF + wc * 32 + 16 * n + 4 * fq);
#pragma unroll
        for (int ai = 0; ai < 2; ++ai) {
            f32x4 hv[4][2][2];
#pragma unroll
            for (int m = 0; m < 4; ++m) { const int r = rt + ai * HALF + wr * 64 + m * 16 + fr; const float* h = r < NLAT ? out + (size_t)r * D : hctx + (size_t)(r - NLAT) * D;
#pragma unroll
                for (int bj = 0; bj < 2; ++bj)
#pragma unroll
                    for (int n = 0; n < 2; ++n) hv[m][bj][n] = *(const f32x4*)(h + u.pn * BM + bj * HALF + wc * 32 + 16 * n + 4 * fq); }
#pragma unroll
            for (int m = 0; m < 4; ++m) { const int r = rt + ai * HALF + wr * 64 + m * 16 + fr; float* h = r < NLAT ? out + (size_t)r * D : hctx + (size_t)(r - NLAT) * D;
#pragma unroll
                for (int bj = 0; bj < 2; ++bj)
#pragma unroll
                    for (int n = 0; n < 2; ++n) *(f32x4*)(h + u.pn * BM + bj * HALF + wc * 32 + 16 * n + 4 * fq) = hv[m][bj][n] + gg[bj][n] * acc[ai][bj][m][n]; }
        }
    }
};
struct EpiResidNorm {
    static constexpr bool PERM = false;
    const float* hin; float* out; const float* modbase; int chunk;
    const float* gain; const float* nmods; int csh, csc; bf16* A; unsigned char* A8;
    float* xbuf; unsigned* cnt; unsigned* tmo; LAS unsigned char* lds;
    __device__ __forceinline__ void operator()(Acc& acc, const Unit& u, int wr, int wc, int fr_, int fq_) const {
        int fr = fr_, fq = fq_; asm volatile("" : "+v"(fr), "+v"(fq));
        const int wid = __builtin_amdgcn_readfirstlane((int)threadIdx.x >> 6), lane = threadIdx.x & 63;
        const int rt = u.pm * BM, mi = row_mi(rt);
        LAS float* Pt = (LAS float*)(lds + STAGE_BYTES);
        LAS float* St = (LAS float*)(lds + STAGE_BYTES + 4096);
        LAS unsigned* flag = (LAS unsigned*)(lds + STAGE_BYTES + 5120);
        { const float* g = modbase + ((size_t)mi * 6 + chunk) * D;
          f32x4 gg[2][2];
#pragma unroll
          for (int bj = 0; bj < 2; ++bj)
#pragma unroll
              for (int n = 0; n < 2; ++n) gg[bj][n] = *(const f32x4*)(g + u.pn * BM + bj * HALF + wc * 32 + 16 * n + 4 * fq);
#pragma unroll
          for (int am = 0; am < 4; ++am) { const int ai = am >> 1, m0 = (am & 1) * 2;
              f32x4 hv[2][2][2];
#pragma unroll
              for (int mm = 0; mm < 2; ++mm) { const float* h = hin + (size_t)(rt + ai * HALF + wr * 64 + (m0 + mm) * 16 + fr) * D;
#pragma unroll
                  for (int bj = 0; bj < 2; ++bj)
#pragma unroll
                      for (int n = 0; n < 2; ++n) hv[mm][bj][n] = *(const f32x4*)(h + u.pn * BM + bj * HALF + wc * 32 + 16 * n + 4 * fq); }
#pragma unroll
              for (int mm = 0; mm < 2; ++mm) { const int m = m0 + mm; float* h = out + (size_t)(rt + ai * HALF + wr * 64 + m * 16 + fr) * D; float ss = 0.f;
#pragma unroll
                  for (int bj = 0; bj < 2; ++bj)
#pragma unroll
                      for (int n = 0; n < 2; ++n) { const f32x4 x = hv[mm][bj][n] + gg[bj][n] * acc[ai][bj][m][n]; acc[ai][bj][m][n] = x;
                          *(f32x4*)(h + u.pn * BM + bj * HALF + wc * 32 + 16 * n + 4 * fq) = x; ss += (x[0] * x[0] + x[1] * x[1]) + (x[2] * x[2] + x[3] * x[3]); }
                  ss += __shfl_xor(ss, 16); ss += __shfl_xor(ss, 32);
                  if (fq == 0) Pt[(ai * HALF + wr * 64 + m * 16 + fr) * 4 + wc] = ss; }
              asm volatile("" ::: "memory");
          } }
        asm volatile("s_waitcnt lgkmcnt(0)" ::: "memory"); __builtin_amdgcn_s_barrier(); asm volatile("" ::: "memory");
        const int row = wid * 32 + (lane & 31);
        if (lane < 32) { const f32x4 q = *(const LAS f32x4*)(Pt + row * 4);
            __hip_atomic_store(xbuf + ((size_t)(rt + row) * 4 + u.pn), (q[0] + q[1]) + (q[2] + q[3]), __ATOMIC_RELAXED, __HIP_MEMORY_SCOPE_AGENT); }
        asm volatile("s_waitcnt vmcnt(0)" ::: "memory");
        if (lane == 0) __hip_atomic_fetch_add(cnt + 16 * u.pm, 1u, __ATOMIC_RELAXED, __HIP_MEMORY_SCOPE_AGENT);
        if (wid == 0) { unsigned sp = 0u, dead = 0u;
            while ((unsigned)__builtin_amdgcn_readfirstlane(__hip_atomic_load(cnt + 16 * u.pm, __ATOMIC_RELAXED, __HIP_MEMORY_SCOPE_AGENT)) < 32u) {
                __builtin_amdgcn_s_sleep(1);
                if ((++sp & 255u) == 0u) { if (__hip_atomic_load(tmo, __ATOMIC_RELAXED, __HIP_MEMORY_SCOPE_AGENT)) { dead = 1u; break; } if (sp > (1u << 22)) { if (lane == 0) atomicAdd(tmo, 1u); dead = 1u; break; } } }
            __builtin_amdgcn_fence(__ATOMIC_ACQUIRE, "agent");
            if (lane == 0) flag[0] = dead; }
        asm volatile("s_waitcnt vmcnt(0) lgkmcnt(0)" ::: "memory"); __builtin_amdgcn_s_barrier(); asm volatile("" ::: "memory");
        if (lane < 32) { const float* sl = xbuf + (size_t)(rt + row) * 4; float t = 0.f;
#pragma unroll
            for (int q = 0; q < 4; ++q) t += __hip_atomic_load(sl + q, __ATOMIC_RELAXED, __HIP_MEMORY_SCOPE_AGENT);
            St[row] = rsqrtf(t * (1.f / D) + EPS); }
        asm volatile("s_waitcnt lgkmcnt(0)" ::: "memory"); __builtin_amdgcn_s_barrier(); asm volatile("" ::: "memory");
        const float* shp = nmods + ((size_t)mi * 6 + csh) * D; const float* scp = nmods + ((size_t)mi * 6 + csc) * D;
        float rs[2][4];
#pragma unroll
        for (int ai = 0; ai < 2; ++ai)
#pragma unroll
            for (int m = 0; m < 4; ++m) rs[ai][m] = St[ai * HALF + wr * 64 + m * 16 + fr];
#pragma unroll
        for (int bj = 0; bj < 2; ++bj)
#pragma unroll
            for (int n = 0; n < 2; ++n) { const int c = u.pn * BM + bj * HALF + wc * 32 + 16 * n + 4 * fq;
                const f32x4 g4 = *(const f32x4*)(gain + c), sc4 = *(const f32x4*)(scp + c) + 1.f, sh4 = *(const f32x4*)(shp + c);
#pragma unroll
                for (int ai = 0; ai < 2; ++ai)
#pragma unroll
                    for (int m = 0; m < 4; ++m) { const f32x4 y = acc[ai][bj][m][n] * rs[ai][m] * g4 * sc4 + sh4;
                        u32x2 o; o.x = cvt_pk(y[0], y[1]); o.y = cvt_pk(y[2], y[3]);
                        *(u32x2*)(A + (size_t)(rt + ai * HALF + wr * 64 + m * 16 + fr) * D + c) = o;
                        if (A8) *(unsigned*)(A8 + (size_t)(rt + ai * HALF + wr * 64 + m * 16 + fr) * D + c) = pk4_fp8(y[0], y[1], y[2], y[3]); } }
    }
};
struct EpiSwiglu {
    static constexpr bool PERM = true;
    bf16* Hm;
    __device__ __forceinline__ void operator()(const Acc& acc, const Unit& u, int wr, int wc, int fr, int fq) const {
#pragma unroll
        for (int ai = 0; ai < 2; ++ai)
#pragma unroll
            for (int m = 0; m < 4; ++m) { const int r = u.pm * BM + ai * HALF + wr * 64 + m * 16 + fr;
#pragma unroll
                for (int bj = 0; bj < 2; ++bj) { const int c = u.pn * BM + bj * HALF + wc * 32 + 8 * fq; const f32x4 g = acc[ai][bj][m][0], up = acc[ai][bj][m][1];
                    u32x2 o; o.x = cvt_pk(silu_fast(g[0]) * up[0], silu_fast(g[1]) * up[1]); o.y = cvt_pk(silu_fast(g[2]) * up[2], silu_fast(g[3]) * up[3]);
                    *(u32x2*)(Hm + (size_t)r * FFN + (c >> 1)) = o; } }
    }
};
struct EpiSwiglu8 {
    static constexpr bool PERM = true;
    unsigned char* Hm;
    __device__ __forceinline__ void operator()(const Acc& acc, const Unit& u, int wr, int wc, int fr_, int fq_) const {
        int fr = fr_, fq = fq_; asm volatile("" : "+v"(fr), "+v"(fq));
#pragma unroll
        for (int ai = 0; ai < 2; ++ai)
#pragma unroll
            for (int m = 0; m < 4; ++m) { const int r = u.pm * BM + ai * HALF + wr * 64 + m * 16 + fr;
#pragma unroll
                for (int bj = 0; bj < 2; ++bj) { const int c = u.pn * BM + bj * HALF + wc * 32 + 8 * fq; const f32x4 g = acc[ai][bj][m][0], up = acc[ai][bj][m][1];
                    *(unsigned*)(Hm + (size_t)r * FFN + (c >> 1)) = pk4_fp8(silu_fast(g[0]) * up[0], silu_fast(g[1]) * up[1], silu_fast(g[2]) * up[2], silu_fast(g[3]) * up[3]); } }
    }
};
struct EpiStore {
    static constexpr bool PERM = true;
    bf16* O; int ldc;
    __device__ __forceinline__ void operator()(const Acc& acc, const Unit& u, int wr, int wc, int fr_, int fq_) const {
        int fr = fr_, fq = fq_; asm volatile("" : "+v"(fr), "+v"(fq));
#pragma unroll
        for (int ai = 0; ai < 2; ++ai)
#pragma unroll
            for (int m = 0; m < 4; ++m) { const int r = u.pm * BM + ai * HALF + wr * 64 + m * 16 + fr;
#pragma unroll
                for (int bj = 0; bj < 2; ++bj) { const int c = u.pn * BM + bj * HALF + wc * 32 + 8 * fq; *(u32x4*)(O + (size_t)r * ldc + c) = pack8(acc[ai][bj][m][0], acc[ai][bj][m][1]); } }
    }
};
struct EpiFft1 {
    static constexpr bool PERM = true;
    unsigned char* ws;
    __device__ __forceinline__ void operator()(const Acc& acc, const Unit& u, int wr, int wc, int fr_, int fq_) const {
        int fr = fr_, fq = fq_; asm volatile("" : "+v"(fr), "+v"(fq));
        bf16* Z = (bf16*)(ws + WS_Z);
#pragma unroll
        for (int ai = 0; ai < 2; ++ai)
#pragma unroll
            for (int mm = 0; mm < 2; ++mm) { const int k1 = (4 * ai + 2 * wr + mm) * 16 + fr;
                const float as = (float)k1 * (1.f / 8192.f); const float cs = __builtin_amdgcn_cosf(as), ss = __builtin_amdgcn_sinf(as);
#pragma unroll
                for (int bj = 0; bj < 2; ++bj) { const int c = u.pn * BM + bj * HALF + wc * 32 + 8 * fq, n2 = c & 63, ch = (c >> 6) & 255, b = c >> 14;
                    const float a0 = (float)(k1 * n2) * (1.f / 8192.f); float tc_ = __builtin_amdgcn_cosf(a0), ts_ = __builtin_amdgcn_sinf(a0);
                    f32x4 zr[2], zi[2];
#pragma unroll
                    for (int n = 0; n < 2; ++n) { const f32x4 yr = acc[ai][bj][2 * mm][n], yi = acc[ai][bj][2 * mm + 1][n]; f32x4 ct, st;
#pragma unroll
                        for (int e = 0; e < 4; ++e) { ct[e] = tc_; st[e] = ts_; const float nc = tc_ * cs - ts_ * ss; ts_ = ts_ * cs + tc_ * ss; tc_ = nc; }
                        zr[n] = yr * ct + yi * st; zi[n] = yi * ct - yr * st; }
                    bf16* dst = Z + ((size_t)b * 32768 + k1 * 256 + ch) * 256 + n2;
                    *(u32x4*)dst = pack8(zr[0], zr[1]); *(u32x4*)(dst + 64) = pack8(zi[0], zi[1]);
                    asm volatile("" ::: "memory"); } }
    }
};
struct EpiFft3 {
    static constexpr bool PERM = true;
    unsigned char* ws;
    __device__ __forceinline__ void operator()(const Acc& acc, const Unit& u, int wr, int wc, int fr, int fq) const {
        bf16* X = (bf16*)(ws + WS_X);
#pragma unroll
        for (int m = 0; m < 4; ++m) { const int k2 = 16 * m + fr;
#pragma unroll
            for (int bj = 0; bj < 2; ++bj) { const int c = u.pn * BM + bj * HALF + wc * 32 + 8 * fq, ch = c & 255, k1 = (c >> 8) & 127, b = c >> 15;
                *(u32x4*)(X + (size_t)(b * SEQ + k1 + 128 * k2) * 1536 + wr * 256 + ch) = pack8(acc[0][bj][m][0], acc[0][bj][m][1]); } }
    }
};
struct EpiFftC {
    static constexpr bool PERM = true;
    unsigned char* ws;
    __device__ __forceinline__ void operator()(const Acc& acc, const Unit& u, int wr, int wc, int fr, int fq) const {
        bf16* X = (bf16*)(ws + WS_X);
#pragma unroll
        for (int ai = 0; ai < 2; ++ai)
#pragma unroll
            for (int m = 0; m < 4; ++m) { const int k = ai * HALF + wr * 64 + m * 16 + fr;
#pragma unroll
                for (int bj = 0; bj < 2; ++bj) { const int ch = bj * HALF + wc * 32 + 8 * fq;
                    *(u32x4*)(X + (size_t)(NLAT + u.pn * CTX + k) * 1536 + u.pm * 256 + ch) = pack8(acc[ai][bj][m][0], acc[ai][bj][m][1]); } }
    }
};
}

__device__ __forceinline__ void ph_win(const P& p, LAS unsigned char* lds, int layer) {
    const char* W = (const char*)(p.ws + WS_WIN) + (size_t)layer * INC * D * 2;
#pragma unroll 1
    for (int mode = 0; mode < 2; ++mode) {
        fg::WinSched S{(const char*)(p.ws + WS_A), W, (int)gridDim.x, (int)((blockIdx.x + mode * 128) % gridDim.x), mode, mode == 0 ? 10 : (layer == 0 ? 26 : 10)};
        fg::EpiWin E{p.ws, p.in[14] + layer * 64, p.in[15] + layer * 64};
        fg::gemm_phase(lds, D, D, S, E);
    }
    {
        fg::PlainSched S{(const char*)(p.ws + WS_A8), (const char*)(p.ws + WS_WIN8) + (size_t)layer * 4096 * 1024, D / 2, D / 2, NLAT / 256, 16, (int)gridDim.x, (int)blockIdx.x, D / 128};
        fg::EpiGate8 E{p.ws + WS_G};
        fg::gemm_phase<fg::EpiGate8, fg::PlainSched, true>(lds, D / 2, D / 2, S, E);
    }
}

__device__ __forceinline__ void conv_item(const P& p, LAS unsigned char* lds, int layer, int seqid, int t0) {
    const int tid = threadIdx.x; LAS float* y = (LAS float*)lds;
    const int L = seqid < 2 ? SEQ : CTX; const int rbase = seqid < 2 ? seqid * SEQ : NLAT + (seqid - 2) * CTX;
    const bf16* cv = (const bf16*)(p.ws + WS_CONV);
    __syncthreads();
    u32x4 pa[6], pg[6];
#pragma unroll
    for (int i = 0; i < 6; ++i) { const int e = tid + i * NTHREADS, tt = e >> 5, c8 = (e & 31) * 8, t = t0 - 15 + tt;
        if (e < 94 * 32 && t >= 0 && t < L) { const bf16* rowp = cv + (size_t)(rbase + t) * 512 + c8; pa[i] = *(const u32x4*)rowp; pg[i] = *(const u32x4*)(rowp + 256); } }
#pragma unroll
    for (int i = 0; i < 6; ++i) { const int e = tid + i * NTHREADS; if (e >= 94 * 32) break; const int tt = e >> 5, c8 = (e & 31) * 8, t = t0 - 15 + tt;
        f32x4 lo = {0.f, 0.f, 0.f, 0.f}, hi = lo;
        if (t >= 0 && t < L) { const u32x4 a = pa[i], g = pg[i];
            lo = (f32x4){__uint_as_float(a.x << 16) * sigmoidf_(__uint_as_float(g.x << 16)), __uint_as_float(a.x & 0xffff0000u) * sigmoidf_(__uint_as_float(g.x & 0xffff0000u)),
                         __uint_as_float(a.y << 16) * sigmoidf_(__uint_as_float(g.y << 16)), __uint_as_float(a.y & 0xffff0000u) * sigmoidf_(__uint_as_float(g.y & 0xffff0000u))};
            hi = (f32x4){__uint_as_float(a.z << 16) * sigmoidf_(__uint_as_float(g.z << 16)), __uint_as_float(a.z & 0xffff0000u) * sigmoidf_(__uint_as_float(g.z & 0xffff0000u)),
                         __uint_as_float(a.w << 16) * sigmoidf_(__uint_as_float(g.w << 16)), __uint_as_float(a.w & 0xffff0000u) * sigmoidf_(__uint_as_float(g.w & 0xffff0000u))}; }
        *(LAS f32x4*)(y + tt * 256 + c8) = lo; *(LAS f32x4*)(y + tt * 256 + c8 + 4) = hi; }
    __syncthreads();
    {
        const int ch = tid & 255, half = tid >> 8;
        float w[31];
#pragma unroll
        for (int k = 0; k < 31; ++k) w[k] = p.in[17][(size_t)layer * 31 * 256 + k * 256 + ch];
        const float bias = p.in[18][layer * 256 + ch];
        float o[4][8];
#pragma unroll
        for (int u = 0; u < 4; ++u) { const int tb = (half * 4 + u) * 8;
            float in[38];
#pragma unroll
            for (int q = 0; q < 38; ++q) in[q] = y[(tb + q) * 256 + ch];
#pragma unroll
            for (int q = 0; q < 8; ++q) { float a = bias;
#pragma unroll
                for (int k = 0; k < 31; ++k) a += in[q + k] * w[k];
                o[u][q] = a; } }
        __syncthreads();
#pragma unroll
        for (int u = 0; u < 4; ++u)
#pragma unroll
            for (int q = 0; q < 8; ++q) y[((half * 4 + u) * 8 + q) * 256 + ch] = o[u][q];
    }
    __syncthreads();
    const int wv = tid >> 6, lane = tid & 63;
    const f32x4 g = *(const f32x4*)(p.in[19] + layer * 256 + lane * 4), bb = *(const f32x4*)(p.in[20] + layer * 256 + lane * 4);
    for (int q = 0; q < 8; ++q) { const int t = wv * 8 + q;
        const f32x4 v = *(const LAS f32x4*)(y + t * 256 + lane * 4);
        const float mu = wave_sum(v.x + v.y + v.z + v.w) * (1.f / 256.f);
        const f32x4 dv = v - mu; const float var = wave_sum(dv.x * dv.x + dv.y * dv.y + dv.z * dv.z + dv.w * dv.w) * (1.f / 256.f);
        const float rstd = rsqrtf(var + EPS);
        f32x4 z = dv * rstd * g + bb;
        u32x2 ov; ov.x = pk2(siluf_(z.x), siluf_(z.y)); ov.y = pk2(siluf_(z.z), siluf_(z.w));
        *(u32x2*)((bf16*)(p.ws + WS_X) + (size_t)(rbase + t0 + t) * 1536 + 1280 + lane * 4) = ov; }
}

__device__ __forceinline__ int chunk_row0(int b, int n) { return n < 2 ? NLAT + b * CTX + n * 128 : b * SEQ + (n - 2) * 128; }
__device__ __forceinline__ float log_sigmoid(float x) { return x >= 0.f ? -log1pf(expf(-x)) : x - log1pf(expf(x)); }
namespace rt {
typedef short bf16x8 __attribute__((ext_vector_type(8)));
constexpr int PQ = 72, PJ = 136;
__device__ __forceinline__ f32x4 mma(bf16x8 a, bf16x8 b, f32x4 c) { return __builtin_amdgcn_mfma_f32_16x16x32_bf16(a, b, c, 0, 0, 0); }
__device__ __forceinline__ bf16x8 frag(const LAS bf16* base, int row, int pitch, int k0, int lane) { return *(const LAS bf16x8*)(base + (row + (lane & 15)) * pitch + k0 + 8 * (lane >> 4)); }
}
__device__ __forceinline__ void ret_kv_item(const P& p, LAS unsigned char* lds, int layer, int it) {
    using namespace rt;
    const int tid = threadIdx.x, lane = tid & 63, w = tid >> 6; const int h = it & 3, n = (it >> 2) % NCHUNK, b = (it >> 2) / NCHUNK;
    LAS bf16* KTf = (LAS bf16*)lds; LAS bf16* KTb = KTf + 64 * PJ; LAS bf16* VT = KTb + 64 * PJ;
    const int r0 = chunk_row0(b, n);
    const float lgf = log_sigmoid(p.in[10][layer * 4 + h]), lgb = log_sigmoid(p.in[11][layer * 4 + h]);
    __syncthreads();
    { const int j = tid & 127, dq = (tid >> 7) * 16;
      const bf16* K = (const bf16*)(p.ws + WS_RETK) + (size_t)(r0 + j) * 256 + h * 64 + dq; const bf16* V = (const bf16*)(p.ws + WS_RETV) + (size_t)(r0 + j) * 256 + h * 64 + dq;
      const float zf = expf((127.f - j) * lgf), zb = expf((float)j * lgb);
#pragma unroll
      for (int q8 = 0; q8 < 2; ++q8) { const u32x4 kw = *(const u32x4*)(K + q8 * 8), vw = *(const u32x4*)(V + q8 * 8);
          const unsigned kk[4] = {kw.x, kw.y, kw.z, kw.w}, vv[4] = {vw.x, vw.y, vw.z, vw.w};
#pragma unroll
          for (int q = 0; q < 4; ++q) { const int d = dq + q8 * 8 + 2 * q; const float k0 = __uint_as_float(kk[q] << 16), k1 = __uint_as_float(kk[q] & 0xffff0000u);
              KTf[d * PJ + j] = f2bf(k0 * zf); KTf[(d + 1) * PJ + j] = f2bf(k1 * zf); KTb[d * PJ + j] = f2bf(k0 * zb); KTb[(d + 1) * PJ + j] = f2bf(k1 * zb);
              VT[d * PJ + j] = (bf16)(vv[q] & 0xffffu); VT[(d + 1) * PJ + j] = (bf16)(vv[q] >> 16); } } }
    __syncthreads();
    const int fb = w >> 2, dt = w & 3; const LAS bf16* Am = fb == 0 ? KTf : KTb;
    f32x4 acc[4];
#pragma unroll
    for (int et = 0; et < 4; ++et) acc[et] = (f32x4){0.f, 0.f, 0.f, 0.f};
#pragma unroll
    for (int ks = 0; ks < 4; ++ks) { const bf16x8 af = frag(Am, dt * 16, PJ, ks * 32, lane);
#pragma unroll
        for (int et = 0; et < 4; ++et) acc[et] = mma(af, frag(VT, et * 16, PJ, ks * 32, lane), acc[et]); }
    float* S = (float*)(p.ws + WS_RETS) + ((size_t)((fb * 2 + b) * NCHUNK + n) * 4 + h) * 4096;
#pragma unroll
    for (int et = 0; et < 4; ++et)
#pragma unroll
        for (int r = 0; r < 4; ++r) S[(dt * 16 + 4 * (lane >> 4) + r) * 64 + et * 16 + (lane & 15)] = acc[et][r];
}
__device__ __forceinline__ void ret_scan_item(const P& p, int layer, int it) {
    const int e = it * NTHREADS + threadIdx.x;
    const int de = e & 4095, h = (e >> 12) & 3, b = (e >> 14) & 1, dir = e >> 15;
    const float lg = log_sigmoid(p.in[dir == 0 ? 10 : 11][layer * 4 + h]); const float g = expf(128.f * lg);
    float* S = (float*)(p.ws + WS_RETS) + (size_t)((dir * 2 + b) * NCHUNK) * 4 * 4096 + (size_t)h * 4096 + de;
    float kv[NCHUNK];
#pragma unroll
    for (int n = 0; n < NCHUNK; ++n) kv[n] = S[(size_t)n * 4 * 4096];
    float st = 0.f;
    if (dir == 0) {
#pragma unroll
        for (int n = 0; n < NCHUNK; ++n) { const float t = kv[n]; kv[n] = st; st = st * g + t; }
    } else {
#pragma unroll
        for (int i = 0; i < NCHUNK; ++i) { const int n = i < 2 ? 1 - i : NCHUNK + 1 - i; const float t = kv[n]; kv[n] = st; st = st * g + t; }
    }
    float* S2 = (float*)(p.ws + WS_RETS2) + (size_t)((dir * 2 + b) * NCHUNK) * 4 * 4096 + (size_t)h * 4096 + de;
#pragma unroll
    for (int n = 0; n < NCHUNK; ++n) S2[(size_t)n * 4 * 4096] = kv[n];
}
__device__ __forceinline__ void ret_out_item(const P& p, LAS unsigned char* lds, int layer, int it) {
    using namespace rt;
    const int tid = threadIdx.x, lane = tid & 63, w = tid >> 6; const int h = it & 3, n = (it >> 2) % NCHUNK, b = (it >> 2) / NCHUNK;
    LAS bf16* Qs = (LAS bf16*)lds; LAS bf16* Ks = Qs + 128 * PQ; LAS bf16* VT = Ks + 128 * PQ; LAS bf16* Ps = VT + 64 * PJ; LAS bf16* SfT = Ps + 128 * PJ; LAS bf16* SbT = SfT + 64 * PQ;
    LAS float* pf = (LAS float*)(SbT + 64 * PQ); LAS float* pb = pf + 132;
    const int r0 = chunk_row0(b, n);
    const float lgf = log_sigmoid(p.in[10][layer * 4 + h]), lgb = log_sigmoid(p.in[11][layer * 4 + h]);
    const float* S = (const float*)(p.ws + WS_RETS2);
    const float* sfp = S + ((size_t)((0 * 2 + b) * NCHUNK + n) * 4 + h) * 4096; const float* sbp = S + ((size_t)((1 * 2 + b) * NCHUNK + n) * 4 + h) * 4096;
    __syncthreads();
    { const int j = tid >> 2, dq = (tid & 3) * 16;
      const bf16* Q = (const bf16*)(p.ws + WS_RETQ) + (size_t)(r0 + j) * 256 + h * 64 + dq; const bf16* K = (const bf16*)(p.ws + WS_RETK) + (size_t)(r0 + j) * 256 + h * 64 + dq;
      *(LAS u32x4*)(Qs + j * PQ + dq) = *(const u32x4*)Q; *(LAS u32x4*)(Qs + j * PQ + dq + 8) = *(const u32x4*)(Q + 8);
      *(LAS u32x4*)(Ks + j * PQ + dq) = *(const u32x4*)K; *(LAS u32x4*)(Ks + j * PQ + dq + 8) = *(const u32x4*)(K + 8); }
    { const int j = tid & 127, dq = (tid >> 7) * 16;
      const bf16* V = (const bf16*)(p.ws + WS_RETV) + (size_t)(r0 + j) * 256 + h * 64 + dq;
#pragma unroll
      for (int q8 = 0; q8 < 2; ++q8) { const u32x4 vw = *(const u32x4*)(V + q8 * 8); const unsigned vv[4] = {vw.x, vw.y, vw.z, vw.w};
#pragma unroll
          for (int q = 0; q < 4; ++q) { const int d = dq + q8 * 8 + 2 * q; VT[d * PJ + j] = (bf16)(vv[q] & 0xffffu); VT[(d + 1) * PJ + j] = (bf16)(vv[q] >> 16); } } }
    { const int d = tid & 63, e0 = (tid >> 6) * 8;
#pragma unroll
      for (int q4 = 0; q4 < 2; ++q4) { const f32x4 a = *(const f32x4*)(sfp + d * 64 + e0 + q4 * 4), c = *(const f32x4*)(sbp + d * 64 + e0 + q4 * 4);
#pragma unroll
          for (int q = 0; q < 4; ++q) { SfT[(e0 + q4 * 4 + q) * PQ + d] = f2bf(a[q]); SbT[(e0 + q4 * 4 + q) * PQ + d] = f2bf(c[q]); } } }
    if (tid <= 128) { pf[tid] = expf((float)tid * lgf); pb[tid] = expf((float)tid * lgb); }
    __syncthreads();
    { const bf16x8 a0 = frag(Qs, 16 * w, PQ, 0, lane), a1 = frag(Qs, 16 * w, PQ, 32, lane);
#pragma unroll
      for (int jt = 0; jt < 8; ++jt) { f32x4 c = (f32x4){0.f, 0.f, 0.f, 0.f};
          c = mma(a0, frag(Ks, jt * 16, PQ, 0, lane), c); c = mma(a1, frag(Ks, jt * 16, PQ, 32, lane), c);
          const int j = jt * 16 + (lane & 15);
#pragma unroll
          for (int r = 0; r < 4; ++r) { const int i = 16 * w + 4 * (lane >> 4) + r; const float dm = i > j ? pf[i - j] : (i < j ? pb[j - i] : 2.f); Ps[i * PJ + j] = f2bf(c[r] * dm); } } }
    __syncthreads();
    f32x4 aP[4], aF[4], aB[4];
#pragma unroll
    for (int et = 0; et < 4; ++et) { aP[et] = (f32x4){0.f, 0.f, 0.f, 0.f}; aF[et] = aP[et]; aB[et] = aP[et]; }
#pragma unroll
    for (int ks = 0; ks < 4; ++ks) { const bf16x8 af = frag(Ps, 16 * w, PJ, ks * 32, lane);
#pragma unroll
        for (int et = 0; et < 4; ++et) aP[et] = mma(af, frag(VT, et * 16, PJ, ks * 32, lane), aP[et]); }
#pragma unroll
    for (int ks = 0; ks < 2; ++ks) { const bf16x8 af = frag(Qs, 16 * w, PQ, ks * 32, lane);
#pragma unroll
        for (int et = 0; et < 4; ++et) { aF[et] = mma(af, frag(SfT, et * 16, PQ, ks * 32, lane), aF[et]); aB[et] = mma(af, frag(SbT, et * 16, PQ, ks * 32, lane), aB[et]); } }
    const float* rg = p.in[12] + layer * 256 + h * 64;
    const bf16* G = (const bf16*)(p.ws + WS_RETG) + (size_t)r0 * 256 + h * 64; bf16* X = (bf16*)(p.ws + WS_X) + (size_t)r0 * 1536 + 512 + h * 64;
    float gt[4][4];
#pragma unroll
    for (int r = 0; r < 4; ++r)
#pragma unroll
        for (int et = 0; et < 4; ++et) gt[r][et] = bf2f(G[(size_t)(16 * w + 4 * (lane >> 4) + r) * 256 + et * 16 + (lane & 15)]);
#pragma unroll
    for (int r = 0; r < 4; ++r) { const int i = 16 * w + 4 * (lane >> 4) + r; const float xf = pf[i + 1], xb = pb[128 - i];
        float o[4]; float ss = 0.f;
#pragma unroll
        for (int et = 0; et < 4; ++et) { o[et] = aP[et][r] + xf * aF[et][r] + xb * aB[et][r]; ss += o[et] * o[et]; }
        ss += __shfl_xor(ss, 1); ss += __shfl_xor(ss, 2); ss += __shfl_xor(ss, 4); ss += __shfl_xor(ss, 8);
        const float rstd = rsqrtf(ss * (1.f / 64.f) + EPS);
#pragma unroll
        for (int et = 0; et < 4; ++et) { const int e = et * 16 + (lane & 15); Ps[i * PJ + e] = f2bf(o[et] * rstd * rg[e] * siluf_(gt[r][et])); } }
    asm volatile("s_waitcnt lgkmcnt(0)" ::: "memory");
#pragma unroll
    for (int q = 0; q < 2; ++q) { const int c = lane + 64 * q, i = 16 * w + (c >> 3), e8 = (c & 7) * 8;
        *(u32x4*)(X + (size_t)i * 1536 + e8) = *(const LAS u32x4*)(Ps + i * PJ + e8); }
    __syncthreads();
}

#include <hip/hip_bf16.h>
#include <cmath>
namespace attn_body {
using bf16=__hip_bfloat16;
using bf16x8=__attribute__((ext_vector_type(8)))short;
using s16x4=__attribute__((ext_vector_type(4)))short;
using f32x16=__attribute__((ext_vector_type(16)))float;
using u32x4=__attribute__((ext_vector_type(4)))unsigned;
constexpr int D=64, QP=512, KP=128, OP=1536;
constexpr int NW=8,QBLK=32,QB=QBLK*NW,KVBLK=64;
__device__ __forceinline__ int crow(int r,int hi){return (r&3)+8*(r>>2)+4*hi;}
#define SBAR() __builtin_amdgcn_sched_barrier(0)
__device__ __forceinline__ void cmask(f32x16&p0,f32x16&p1,int jb,int qrel,int hi){
  const float NEG=-INFINITY; int kb=64*jb+4*hi;
  #pragma unroll
  for(int r=0;r<16;++r){int kv=kb+(r&3)+8*(r>>2); if(kv>qrel)p0[r]=NEG; if(kv+32>qrel)p1[r]=NEG;}
}

constexpr int NSLOT=3, SLOTB=8192;
constexpr int LDS_K=0, LDS_V=NSLOT*SLOTB, LDS_WS=2*NSLOT*SLOTB, LDS_OST=LDS_WS+NW*64*4, LDS_BYTES=LDS_OST+NW*4096;
constexpr float C2=0.125f*1.4426950408889634f;
__device__ __forceinline__ void glds16(const void*gsrc,unsigned lds_dst){unsigned keep;
  asm volatile("s_mov_b32 %0, m0\n\ts_mov_b32 m0, %2\n\ts_nop 0\n\tglobal_load_lds_dwordx4 %1, off\n\ts_mov_b32 m0, %0":"=&s"(keep):"v"(gsrc),"s"(lds_dst):"memory");}
__device__ __forceinline__ float max3f(float a,float b,float c){float r;asm("v_max3_f32 %0, %1, %2, %3":"=v"(r):"v"(a),"v"(b),"v"(c));return r;}
__device__ __forceinline__ float max2f(float a,float b){float r;asm("v_max_f32_e32 %0, %1, %2":"=v"(r):"v"(a),"v"(b));return r;}
__device__ __forceinline__ float fadd_s(float a,float b){float r;asm("v_add_f32_e32 %0, %1, %2":"=v"(r):"v"(a),"v"(b));return r;}
__device__ __forceinline__ float fsub_s(float a,float b){float r;asm("v_sub_f32_e32 %0, %1, %2":"=v"(r):"v"(a),"v"(b));return r;}
typedef float f32x2_t __attribute__((ext_vector_type(2))); typedef __bf16 bf16x2_t __attribute__((ext_vector_type(2)));
__device__ __forceinline__ unsigned cvtpk_s(float lo,float hi){f32x2_t v={lo,hi};bf16x2_t b=__builtin_convertvector(v,bf16x2_t);return __builtin_bit_cast(unsigned,b);}
#define WAIT_BAR(N) asm volatile("s_waitcnt vmcnt(" #N ") lgkmcnt(0)\n\ts_barrier":::"memory")

__device__ __forceinline__ void qkt(f32x16&p0,f32x16&p1,const char*Kslot,const bf16x8*qr,const f32x16&negm,int r32,int hi){
  const char*kb=Kslot+hi*1024+r32*16;
  #pragma unroll
  for(int d0=0;d0<4;++d0){
    const bf16x8 b0=*reinterpret_cast<const bf16x8*>(kb+d0*2048);
    const bf16x8 b1=*reinterpret_cast<const bf16x8*>(kb+d0*2048+512);
    if(d0==0){p0=__builtin_amdgcn_mfma_f32_32x32x16_bf16(b0,qr[0],negm,0,0,0);p1=__builtin_amdgcn_mfma_f32_32x32x16_bf16(b1,qr[0],negm,0,0,0);}
    else{p0=__builtin_amdgcn_mfma_f32_32x32x16_bf16(b0,qr[d0],p0,0,0,0);p1=__builtin_amdgcn_mfma_f32_32x32x16_bf16(b1,qr[d0],p1,0,0,0);}}
}
typedef __attribute__((address_space(3))) const char* lds_cptr;
typedef short v4i16_t __attribute__((ext_vector_type(4)));
__device__ __forceinline__ void kload8(bf16x8*kf,lds_cptr kp){
  kf[0]=*(const __attribute__((address_space(3))) bf16x8*)(kp);      kf[1]=*(const __attribute__((address_space(3))) bf16x8*)(kp+512);
  kf[2]=*(const __attribute__((address_space(3))) bf16x8*)(kp+2048); kf[3]=*(const __attribute__((address_space(3))) bf16x8*)(kp+2560);
  kf[4]=*(const __attribute__((address_space(3))) bf16x8*)(kp+4096); kf[5]=*(const __attribute__((address_space(3))) bf16x8*)(kp+4608);
  kf[6]=*(const __attribute__((address_space(3))) bf16x8*)(kp+6144); kf[7]=*(const __attribute__((address_space(3))) bf16x8*)(kp+6656);
}
__device__ __forceinline__ void kload2(bf16x8*kf,lds_cptr kp,int j){ kf[2*j]=*(const __attribute__((address_space(3))) bf16x8*)(kp+j*2048); kf[2*j+1]=*(const __attribute__((address_space(3))) bf16x8*)(kp+j*2048+512); }
__device__ __forceinline__ s16x4 vtr(lds_cptr p){ return __builtin_bit_cast(s16x4,__builtin_amdgcn_ds_read_tr16_b64_v4i16((__attribute__((address_space(3))) v4i16_t*)p)); }
__device__ __forceinline__ float rowmax(const f32x16&p0,const f32x16&p1){
  float a=max3f(p0[0],p0[1],p1[0]),b=max3f(p0[2],p0[3],p1[1]);a=max3f(a,p1[2],p1[3]);
  #pragma unroll
  for(int r=4;r<16;r+=4){a=max3f(a,p0[r],p0[r+1]);b=max3f(b,p0[r+2],p0[r+3]);a=max3f(a,p1[r],p1[r+1]);b=max3f(b,p1[r+2],p1[r+3]);}
  const float m=max2f(a,b);
  auto rr=__builtin_amdgcn_permlane32_swap(__float_as_uint(m),__float_as_uint(m),false,false);
  return max2f(__uint_as_float(rr[0]),__uint_as_float(rr[1]));
}
__device__ __forceinline__ void pv(f32x16*o,int vb,bf16x8 pa0,bf16x8 pa1,bf16x8 pa2,bf16x8 pa3){
  #pragma unroll
  for(int d0=0;d0<2;++d0){s16x4 lo[4],hi[4];
    #pragma unroll
    for(int ks=0;ks<4;++ks){
      asm volatile("ds_read_b64_tr_b16 %0,%1 offset:%c2":"=&v"(lo[ks]):"v"(vb),"i"(d0*4096+ks*1024):"memory");
      asm volatile("ds_read_b64_tr_b16 %0,%1 offset:%c2":"=&v"(hi[ks]):"v"(vb),"i"(d0*4096+ks*1024+512):"memory");}
    asm volatile("s_waitcnt lgkmcnt(0)":::"memory");SBAR();
    #define PK(k) (bf16x8){lo[k][0],lo[k][1],lo[k][2],lo[k][3],hi[k][0],hi[k][1],hi[k][2],hi[k][3]}
    o[d0]=__builtin_amdgcn_mfma_f32_32x32x16_bf16(pa0,PK(0),o[d0],0,0,0);
    o[d0]=__builtin_amdgcn_mfma_f32_32x32x16_bf16(pa1,PK(1),o[d0],0,0,0);
    o[d0]=__builtin_amdgcn_mfma_f32_32x32x16_bf16(pa2,PK(2),o[d0],0,0,0);
    o[d0]=__builtin_amdgcn_mfma_f32_32x32x16_bf16(pa3,PK(3),o[d0],0,0,0);
    #undef PK
  }
}

#ifndef ATTN_STORE16
#define ATTN_STORE16(p,v) (*(u32x4*)(p)=(v))
#endif
template<int THRL> __device__ __forceinline__ void attn_unit(const bf16*Q0,const bf16*__restrict__ Kh,const bf16*__restrict__ Vh,bf16*O0,const int NT,char*shm){
  const int tid=threadIdx.x,lane=tid&63,r32=lane&31,hi=lane>>5; const int wid=__builtin_amdgcn_readfirstlane(tid>>6);
  const bf16*Qw=Q0+(long)(wid*QBLK)*QP;
  const unsigned lds0=(unsigned)(uintptr_t)shm;
  float*wsf=(float*)(shm+LDS_WS)+wid*64;
  const bf16*ksrc=Kh+(long)lane*KP+wid*8;
  const bf16*vsrc=Vh+(long)(16*(wid&3)+(lane>>2))*KP+(wid>>2)*32+(lane&3)*8;
  const unsigned kdst=lds0+LDS_K+wid*1024, vdst=lds0+LDS_V+wid*1024;
  #define DMA_K(t,slot) glds16(ksrc+(long)(t)*KVBLK*KP,(unsigned)__builtin_amdgcn_readfirstlane(kdst+(slot)))
  #define DMA_V(t,slot) glds16(vsrc+(long)(t)*KVBLK*KP,(unsigned)__builtin_amdgcn_readfirstlane(vdst+(slot)))
  const int vb0=(int)(lds0+LDS_V)+((lane>>4)&1)*32+(lane&3)*8+(4*hi+((lane&15)>>2))*64;
  const char*Kbase=shm+LDS_K; bf16x8 kf[8];
  const lds_cptr shm3=(lds_cptr)shm; const lds_cptr kp0=shm3+LDS_K+hi*1024+r32*16; const lds_cptr vp0=shm3+LDS_V+((lane>>4)&1)*32+(lane&3)*8+(4*hi+((lane&15)>>2))*64;
  DMA_K(0,0);DMA_V(0,0);DMA_K(1,SLOTB);
  bf16x8 qr[4];
  #pragma unroll
  for(int d0=0;d0<4;++d0)qr[d0]=*reinterpret_cast<const bf16x8*>(&Qw[(long)r32*QP+d0*16+hi*8]);
  float mhat=0.f,l_reg=0.f;f32x16 o[2];o[0]=f32x16{};o[1]=f32x16{};f32x16 negm=f32x16{};asm volatile("":"+v"(negm));
  #define CMASK(P0,P1,t) do{}while(0)
  bool resc=false;
  #define START(P0,P1) do{ const float rm=rowmax(P0,P1); resc=false; \
    { const float dl=rm; mhat=fadd_s(mhat,dl); \
      _Pragma("unroll") for(int r=0;r<16;++r){P0[r]=fsub_s(P0[r],dl);P1[r]=fsub_s(P1[r],dl);} \
      _Pragma("unroll") for(int r=0;r<16;++r)negm[r]=-mhat; asm volatile("":"+v"(negm)); } \
    _Pragma("unroll") for(int r=0;r<16;++r)P0[r]=__builtin_amdgcn_exp2f(P0[r]); }while(0)
  #define RESC() do{ if(resc){ asm volatile("s_waitcnt lgkmcnt(0)":::"memory"); \
      _Pragma("unroll") for(int d_=0;d_<2;++d_) _Pragma("unroll") for(int r=0;r<16;++r)o[d_][r]*=wsf[crow(r,hi)]; } }while(0)
  f32x16 pA0,pA1,pB0,pB1;
  int sl_prev=0,sl_cur=0,sl_next=SLOTB;
  #define ROT() do{sl_prev=sl_cur;sl_cur=sl_next;sl_next=(sl_next==(NSLOT-1)*SLOTB)?0:sl_next+SLOTB;}while(0)
  DMA_K(2,2*SLOTB);
  WAIT_BAR(3);
  qkt(pA0,pA1,Kbase,qr,negm,r32,hi);asm volatile("s_nop 15\n\ts_nop 7":"+v"(pA0),"+v"(pA1));CMASK(pA0,pA1,0);
  START(pA0,pA1);
  _Pragma("unroll") for(int r=0;r<16;++r)pA1[r]=__builtin_amdgcn_exp2f(pA1[r]);
  WAIT_BAR(0);
  DMA_K(3,0);DMA_V(1,SLOTB);
  ROT();
  kload8(kf,kp0+sl_cur);
  WAIT_BAR(2);
  s16x4 vlo[8],vhi[8]; u32x4 pw0,pw1,pw2,pw3;
  #define PKW(P,B) cvtpk_s(P[B],P[B+1])
  #define PAF(k) __builtin_bit_cast(bf16x8,pw##k)
  #define VFR(i) (bf16x8){vlo[i][0],vlo[i][1],vlo[i][2],vlo[i][3],vhi[i][0],vhi[i][1],vhi[i][2],vhi[i][3]}
  #define PIN(x) asm volatile("":"+v"(x))
  #define MX3(a,b,c) __builtin_fmaxf(__builtin_fmaxf((a),(b)),(c))
  #define GAPA(MF,A0,A1,A2,A3,W0,W1,PW) do{ MF; sacc+=A0; sacc+=A1; sacc+=A2; sacc+=A3; PIN(sacc); W0; W1; PIN(PW); SBAR(); }while(0)
  #define EX(v) __builtin_amdgcn_exp2f(v)
  #define GAPB(MF,X,B) do{ MF; X[B]=EX(X[B]); X[B+1]=EX(X[B+1]); X[B+2]=EX(X[B+2]); X[B+3]=EX(X[B+3]); PIN(X); SBAR(); }while(0)
  #define VRD(i) do{ vlo[i]=vtr(vp_+(((i)>>2)*4096+((i)&3)*1024)); vhi[i]=vtr(vp_+(((i)>>2)*4096+((i)&3)*1024+512)); }while(0)
  #define KRD(G,j) do{ if(G){ kload2(kf,kp0+sl_next,j); SBAR(); } }while(0)
  #define STEP(C0,C1,P0,P1,t,GK,GV,GL) do{ SBAR(); \
    const lds_cptr vp_=vp0+sl_prev; \
    VRD(0); SBAR(); float sacc=(P0[0]+P0[1]); \
    GAPA(C0=__builtin_amdgcn_mfma_f32_32x32x16_bf16(kf[0],qr[0],negm,0,0,0), P0[2],P0[3],P0[4],P0[5],     pw0[0]=PKW(P0,0), pw0[1]=PKW(P0,2), pw0); \
    VRD(4); SBAR(); GAPA(C1=__builtin_amdgcn_mfma_f32_32x32x16_bf16(kf[1],qr[0],negm,0,0,0), P0[6],P0[7],P0[8],P0[9],     pw0[2]=PKW(P0,4), pw0[3]=PKW(P0,6), pw0); \
    VRD(1); SBAR(); GAPA(C0=__builtin_amdgcn_mfma_f32_32x32x16_bf16(kf[2],qr[1],C0,0,0,0),   P0[10],P0[11],P0[12],P0[13], pw1[0]=PKW(P0,8), pw1[1]=PKW(P0,10), pw1); \
    VRD(5); SBAR(); GAPA(C1=__builtin_amdgcn_mfma_f32_32x32x16_bf16(kf[3],qr[1],C1,0,0,0),   P0[14],P0[15],P1[0],P1[1],   pw1[2]=PKW(P0,12),pw1[3]=PKW(P0,14), pw1); \
    VRD(2); SBAR(); GAPA(C0=__builtin_amdgcn_mfma_f32_32x32x16_bf16(kf[4],qr[2],C0,0,0,0),   P1[2],P1[3],P1[4],P1[5],     pw2[0]=PKW(P1,0), pw2[1]=PKW(P1,2), pw2); \
    VRD(6); SBAR(); GAPA(C1=__builtin_amdgcn_mfma_f32_32x32x16_bf16(kf[5],qr[2],C1,0,0,0),   P1[6],P1[7],P1[8],P1[9],     pw2[2]=PKW(P1,4), pw2[3]=PKW(P1,6), pw2); \
    VRD(3); SBAR(); GAPA(C0=__builtin_amdgcn_mfma_f32_32x32x16_bf16(kf[6],qr[3],C0,0,0,0),   P1[10],P1[11],P1[12],P1[13], pw3[0]=PKW(P1,8), pw3[1]=PKW(P1,10), pw3); \
    VRD(7); SBAR(); GAPA(C1=__builtin_amdgcn_mfma_f32_32x32x16_bf16(kf[7],qr[3],C1,0,0,0),   P1[14],P1[15],0.f,0.f,       pw3[2]=PKW(P1,12),pw3[3]=PKW(P1,14), pw3); \
    l_reg+=sacc; \
    if(GK){DMA_K((t)+3,sl_cur);} if(GV){DMA_V((t)+1,sl_next);} \
    CMASK(C0,C1,t); \
    { float a=MX3(C0[0],C0[1],C1[0]),b=MX3(C0[2],C0[3],C1[1]); a=MX3(a,C1[2],C1[3]); \
      _Pragma("unroll") for(int r=4;r<16;r+=4){a=MX3(a,C0[r],C0[r+1]);b=MX3(b,C0[r+2],C0[r+3]);a=MX3(a,C1[r],C1[r+1]);b=MX3(b,C1[r+2],C1[r+3]);} \
      float rm=__builtin_fmaxf(a,b); { auto rr=__builtin_amdgcn_permlane32_swap(__float_as_uint(rm),__float_as_uint(rm),false,false); rm=__builtin_fmaxf(__uint_as_float(rr[0]),__uint_as_float(rr[1])); } \
      resc=false; \
      if(__builtin_expect(__any(rm>(float)THRL),0)){ const float dl=__builtin_fmaxf(rm,0.f); mhat+=dl; \
        _Pragma("unroll") for(int r=0;r<16;++r){C0[r]-=dl;C1[r]-=dl;} \
        _Pragma("unroll") for(int r=0;r<16;++r)negm[r]=-mhat; asm volatile("":"+v"(negm)); \
        const float f=__builtin_amdgcn_exp2f(-dl); l_reg*=f; if(hi==0)wsf[r32]=f; resc=true; } } \
    SBAR(); \
    GAPB(o[0]=__builtin_amdgcn_mfma_f32_32x32x16_bf16(PAF(0),VFR(0),o[0],0,0,0), C0,0); \
    GAPB(o[1]=__builtin_amdgcn_mfma_f32_32x32x16_bf16(PAF(0),VFR(4),o[1],0,0,0), C0,4); \
    KRD(GL,0); GAPB(o[0]=__builtin_amdgcn_mfma_f32_32x32x16_bf16(PAF(1),VFR(1),o[0],0,0,0), C0,8); \
    KRD(GL,1); GAPB(o[1]=__builtin_amdgcn_mfma_f32_32x32x16_bf16(PAF(1),VFR(5),o[1],0,0,0), C0,12); \
    KRD(GL,2); GAPB(o[0]=__builtin_amdgcn_mfma_f32_32x32x16_bf16(PAF(2),VFR(2),o[0],0,0,0), C1,0); \
    KRD(GL,3); GAPB(o[1]=__builtin_amdgcn_mfma_f32_32x32x16_bf16(PAF(2),VFR(6),o[1],0,0,0), C1,4); \
    GAPB(o[0]=__builtin_amdgcn_mfma_f32_32x32x16_bf16(PAF(3),VFR(3),o[0],0,0,0), C1,8); \
    GAPB(o[1]=__builtin_amdgcn_mfma_f32_32x32x16_bf16(PAF(3),VFR(7),o[1],0,0,0), C1,12); \
    }while(0)
  int t=1;
  #undef CMASK
  #define CMASK(P0,P1,t) do{}while(0)
  for(;t+5<NT;t+=2){
    STEP(pB0,pB1,pA0,pA1,t,true,true,true);     WAIT_BAR(2); RESC(); ROT();
    STEP(pA0,pA1,pB0,pB1,t+1,true,true,true);   WAIT_BAR(2); RESC(); ROT();
  }
  #undef CMASK
  #define CMASK(P0,P1,t) do{}while(0)
  #define ENDW(tt) do{ if((tt)+3<NT){WAIT_BAR(2);} else if((tt)+2<NT){WAIT_BAR(1);} else {WAIT_BAR(0);} }while(0)
  for(;t+1<NT;t+=2){
    STEP(pB0,pB1,pA0,pA1,t,(t+3<NT),(t+1<NT),(t+1<NT));       ENDW(t);   RESC(); ROT();
    STEP(pA0,pA1,pB0,pB1,t+1,(t+4<NT),(t+2<NT),(t+2<NT));     ENDW(t+1); RESC(); ROT();
  }
  STEP(pB0,pB1,pA0,pA1,NT-1,false,false,false); RESC();
  { float sacc=pB0[0]+pB0[1]; _Pragma("unroll") for(int r=2;r<16;++r)sacc+=pB0[r]; _Pragma("unroll") for(int r=0;r<16;++r)sacc+=pB1[r]; l_reg+=sacc;
    pw0=(u32x4){PKW(pB0,0),PKW(pB0,2),PKW(pB0,4),PKW(pB0,6)};pw1=(u32x4){PKW(pB0,8),PKW(pB0,10),PKW(pB0,12),PKW(pB0,14)};pw2=(u32x4){PKW(pB1,0),PKW(pB1,2),PKW(pB1,4),PKW(pB1,6)};pw3=(u32x4){PKW(pB1,8),PKW(pB1,10),PKW(pB1,12),PKW(pB1,14)};
    SBAR(); pv(o,vb0+sl_cur,PAF(0),PAF(1),PAF(2),PAF(3)); }
  #undef PKW
  #undef PAF
  #undef VFR
  #undef PIN
  #undef MX3
  #undef GAPA
  #undef GAPB
  #undef EX
  #undef VRD
  #undef KRD
  #undef STEP
  #undef ENDW
  {auto rr=__builtin_amdgcn_permlane32_swap(__float_as_uint(l_reg),__float_as_uint(l_reg),false,false);l_reg=__uint_as_float(rr[0])+__uint_as_float(rr[1]);}
  if(hi==0)wsf[32+r32]=l_reg;asm volatile("s_waitcnt lgkmcnt(0)":::"memory");
  float rli[16];
  #pragma unroll
  for(int r=0;r<16;++r)rli[r]=__builtin_amdgcn_rcpf(wsf[32+crow(r,hi)]);
  bf16*Ow=O0+(long)(wid*QBLK)*OP;
  { bf16*stg=(bf16*)(shm+LDS_OST)+wid*2048;
    #pragma unroll
    for(int r=0;r<16;++r){const int orow=crow(r,hi);
      #pragma unroll
      for(int d0=0;d0<2;++d0)stg[orow*64+d0*32+r32]=__float2bfloat16(o[d0][r]*rli[r]);}
    asm volatile("s_waitcnt lgkmcnt(0)":::"memory");
    #pragma unroll
    for(int i=0;i<4;++i){const int row=i*8+(lane>>3),ch=lane&7; const u32x4 v=*(const u32x4*)(stg+row*64+ch*8); ATTN_STORE16(Ow+(long)row*OP+ch*8,v);} }
  asm volatile("s_waitcnt lgkmcnt(0)\n\ts_barrier":::"memory");
  #undef DMA_K
  #undef DMA_V
  #undef CMASK
  #undef START
  #undef RESC
  #undef ROT
}
constexpr int ATTN_LDS_BYTES=LDS_BYTES;
#undef SBAR
#undef WAIT_BAR
}

__device__ __forceinline__ void attn_phase_run(const P& p, unsigned char* lds_generic, int layer) {
    typedef attn_body::bf16 abf;
    const int G = gridDim.x, bx = blockIdx.x, vcu = (G % 8 == 0) ? (bx % 8) * (G / 8) + bx / 8 : bx;
    const abf* Q = (const abf*)(p.ws + WS_ATTQ); const abf* K = (const abf*)(p.ws + WS_ATTK); const abf* V = (const abf*)(p.ws + WS_ATTV); abf* X = (abf*)(p.ws + WS_X);
    if (G == 256) {
        const int x = vcu >> 5, qb = vcu & 31, b = x >> 2, kvh = (x >> 1) & 1;
#pragma unroll 1
        for (int i = 0; i < 2; ++i) { const int h = kvh * 4 + 2 * (x & 1) + i; const long r0 = (long)b * SEQ + qb * 256;
            attn_body::attn_unit<8>(Q + r0 * 512 + h * 64, K + (long)b * KEYS * 128 + kvh * 64, V + (long)b * KEYS * 128 + kvh * 64, X + r0 * 1536 + 768 + h * 64, KEYS / 64, (char*)lds_generic); }
    } else {
#pragma unroll 1
        for (int u = vcu; u < 512; u += G) { const int qb = u & 31, h = (u >> 5) & 7, b = u >> 8, kvh = h >> 2; const long r0 = (long)b * SEQ + qb * 256;
            attn_body::attn_unit<8>(Q + r0 * 512 + h * 64, K + (long)b * KEYS * 128 + kvh * 64, V + (long)b * KEYS * 128 + kvh * 64, X + r0 * 1536 + 768 + h * 64, KEYS / 64, (char*)lds_generic); }
    }
    if (layer == 0) {
#pragma unroll 1
        for (int u = vcu; u < 16; u += G) { const int b = u >> 3, h = u & 7, kvh = h >> 2; const long r0 = NLAT + (long)b * CTX;
            attn_body::attn_unit<8>(Q + r0 * 512 + h * 64, K + (long)b * KEYS * 128 + kvh * 64, V + (long)b * KEYS * 128 + kvh * 64, X + r0 * 1536 + 768 + h * 64, CTX / 64, (char*)lds_generic); }
    }
}

__device__ __forceinline__ void ph_fft1(const P& p, LAS unsigned char* lds, int layer) {
    int nt2 = 2; asm volatile("" : "+s"(nt2));
    { fg::PlainSched S{(const char*)(p.ws + WS_F1), (const char*)(p.ws + WS_UT), 256, 256, 1, 128, (int)gridDim.x, (int)blockIdx.x, nt2};
      fg::EpiFft1 E{p.ws}; fg::gemm_phase(lds, 256, 256, S, E); }
    if (layer == 0) { fg::PlainSched S{(const char*)(p.ws + WS_FC), (const char*)(p.ws + WS_UTC), 256, 256, 2, 2, (int)gridDim.x, (int)((blockIdx.x + 128) % gridDim.x), 4};
      fg::EpiFftC E{p.ws}; fg::gemm_phase(lds, 256, 256, S, E); }
}
__device__ __forceinline__ void ph_fft3(const P& p, LAS unsigned char* lds) {
    int nt2 = 2; asm volatile("" : "+s"(nt2));
    fg::PlainSched S{(const char*)(p.ws + WS_F2), (const char*)(p.ws + WS_Z), 256, 256, 1, 256, (int)gridDim.x, (int)blockIdx.x, nt2};
    fg::EpiFft3 E{p.ws}; fg::gemm_phase(lds, 256, 256, S, E);
}
__device__ __forceinline__ void ph_mix1(const P& p, LAS unsigned char* lds, int layer) {
    ph_fft1(p, lds, layer);
    const int nconv = layer == 0 ? 264 : 256;
    const int n0 = nconv, n1 = n0 + NB * NCHUNK * 4;
    for (int it = gridDim.x - 1 - blockIdx.x; it < n1; it += gridDim.x) {
        if (it < n0) { if (it < 256) conv_item(p, lds, layer, it >> 7, (it & 127) * 64); else conv_item(p, lds, layer, 2 + ((it - 256) >> 2), ((it - 256) & 3) * 64); }
        else ret_kv_item(p, lds, layer, it - n0);
    }
    __syncthreads();
}
__device__ __forceinline__ void ph_mix2(const P& p, LAS unsigned char* lds, unsigned char* lds_generic, int layer) {
    for (int it = blockIdx.x; it < 128; it += gridDim.x) ret_scan_item(p, layer, it);
    __syncthreads();
    ph_fft3(p, lds);
    attn_phase_run(p, lds_generic, layer);
    __syncthreads();
}
__device__ __forceinline__ void ph_mix3(const P& p, LAS unsigned char* lds, int layer, bool ctxlater) {
    for (int it = blockIdx.x; it < NB * NCHUNK * 4; it += gridDim.x) {
        const int n = (it >> 2) % NCHUNK; if ((layer == 1 || ctxlater) && n < 2) continue;
        ret_out_item(p, lds, layer, it);
    }
    __syncthreads();
}
__device__ __forceinline__ void ctx_ret_items(const P& p, LAS unsigned char* lds) {
    const int u = blockIdx.x;
    if (u < 16) { const int b = u >> 3, n = (u >> 2) & 1, h = u & 3;
        ret_out_item(p, lds, 0, (b * NCHUNK + n) * 4 + h);
        asm volatile("s_waitcnt vmcnt(0)" ::: "memory"); __syncthreads();
        if (threadIdx.x == 0) { __builtin_amdgcn_fence(__ATOMIC_RELEASE, "agent");
            __hip_atomic_fetch_add((unsigned*)(p.ws + WS_CTL) + CW_CCNT + (8 * 3) * 16, 1u, __ATOMIC_RELAXED, __HIP_MEMORY_SCOPE_AGENT); }
        __syncthreads(); }
}
__device__ __forceinline__ void ctx_ret_wait(const P& p) {
    if (threadIdx.x == 0) { unsigned* c = (unsigned*)(p.ws + WS_CTL) + CW_CCNT + (8 * 3) * 16; unsigned* tmo = (unsigned*)(p.ws + WS_CTL) + CW_TMO; unsigned sp = 0u;
        while (__hip_atomic_load(c, __ATOMIC_RELAXED, __HIP_MEMORY_SCOPE_AGENT) < 16u) { __builtin_amdgcn_s_sleep(1);
            if ((++sp & 255u) == 0u) { if (__hip_atomic_load(tmo, __ATOMIC_RELAXED, __HIP_MEMORY_SCOPE_AGENT)) break; if (sp > (1u << 22)) { atomicAdd(tmo, 1u); break; } } }
        __builtin_amdgcn_fence(__ATOMIC_ACQUIRE, "agent"); }
    __syncthreads();
}

namespace sk {
typedef short bf16x8 __attribute__((ext_vector_type(8)));
__device__ __forceinline__ void tile64(LAS unsigned char* lds, const bf16* A, int lda, const bf16* Bt, int ldb, int K, float (&out)[8]) {
    const int tid = threadIdx.x, lane = tid & 63, w = tid >> 6, kc = K >> 3;
    const bf16* ap = A + (size_t)(lane & 15) * lda + w * kc + 8 * (lane >> 4); const bf16* bp = Bt + (size_t)(lane & 15) * ldb + w * kc + 8 * (lane >> 4);
    f32x4 acc[4][4];
#pragma unroll
    for (int i = 0; i < 4; ++i)
#pragma unroll
        for (int j = 0; j < 4; ++j) acc[i][j] = (f32x4){0.f, 0.f, 0.f, 0.f};
#pragma unroll 4
    for (int k0 = 0; k0 < kc; k0 += 32) {
        bf16x8 af[4], bfr[4];
#pragma unroll
        for (int i = 0; i < 4; ++i) { af[i] = *(const bf16x8*)(ap + (size_t)(16 * i) * lda + k0); bfr[i] = *(const bf16x8*)(bp + (size_t)(16 * i) * ldb + k0); }
#pragma unroll
        for (int i = 0; i < 4; ++i)
#pragma unroll
            for (int j = 0; j < 4; ++j) acc[i][j] = __builtin_amdgcn_mfma_f32_16x16x32_bf16(af[i], bfr[j], acc[i][j], 0, 0, 0);
    }
    LAS float* part = (LAS float*)lds;
    __syncthreads();
#pragma unroll
    for (int i = 0; i < 4; ++i)
#pragma unroll
        for (int j = 0; j < 4; ++j)
#pragma unroll
            for (int r = 0; r < 4; ++r) part[((w * 16 + i * 4 + j) * 4 + r) * 64 + lane] = acc[i][j][r];
    __syncthreads();
#pragma unroll
    for (int q = 0; q < 8; ++q) { float sacc = 0.f;
#pragma unroll
        for (int ww = 0; ww < 8; ++ww) sacc += part[ww * 4096 + tid + 512 * q];
        out[q] = sacc; }
}
__device__ __forceinline__ void tile64_f8(LAS unsigned char* lds, const unsigned char* A, int lda, const unsigned char* Bt, int ldb, int K, float (&out)[8]) {
    const int tid = threadIdx.x, lane = tid & 63, w = tid >> 6;
    const unsigned char* ap = A + (size_t)(lane & 15) * lda + 32 * (lane >> 4); const unsigned char* bp = Bt + (size_t)(lane & 15) * ldb + 32 * (lane >> 4);
    f32x4 acc[4][4];
#pragma unroll
    for (int i = 0; i < 4; ++i)
#pragma unroll
        for (int j = 0; j < 4; ++j) acc[i][j] = (f32x4){0.f, 0.f, 0.f, 0.f};
#pragma unroll 2
    for (int ks = w; ks * 128 < K; ks += 8) {
        fg::i32x8 af[4], bfr[4];
#pragma unroll
        for (int i = 0; i < 4; ++i) { af[i] = *(const fg::i32x8*)(ap + (size_t)(16 * i) * lda + ks * 128); bfr[i] = *(const fg::i32x8*)(bp + (size_t)(16 * i) * ldb + ks * 128); }
#pragma unroll
        for (int i = 0; i < 4; ++i)
#pragma unroll
            for (int j = 0; j < 4; ++j) acc[i][j] = __builtin_amdgcn_mfma_scale_f32_16x16x128_f8f6f4(af[i], bfr[j], acc[i][j], 0, 0, 0, 0x7f7f7f7f, 0, 0x7a7a7a7a);
    }
    LAS float* part = (LAS float*)lds;
    __syncthreads();
#pragma unroll
    for (int i = 0; i < 4; ++i)
#pragma unroll
        for (int j = 0; j < 4; ++j)
#pragma unroll
            for (int r = 0; r < 4; ++r) part[((w * 16 + i * 4 + j) * 4 + r) * 64 + lane] = acc[i][j][r];
    __syncthreads();
#pragma unroll
    for (int q = 0; q < 8; ++q) { float sacc = 0.f;
#pragma unroll
        for (int ww = 0; ww < 8; ++ww) sacc += part[ww * 4096 + tid + 512 * q];
        out[q] = sacc; }
}
__device__ __forceinline__ void elem_rc(int tid, int q, int& row, int& col) { const int e = tid + 512 * q, t16 = e >> 8, reg = (e >> 6) & 3, lane = e & 63; row = 16 * (t16 >> 2) + 4 * (lane >> 4) + reg; col = 16 * (t16 & 3) + (lane & 15); }
}
__device__ __forceinline__ void mini_merge_ctx(const P& p, LAS unsigned char* lds, int layer) {
    const bf16* X = (const bf16*)(p.ws + WS_X); const bf16* WB = (const bf16*)(p.ws + WS_WB) + (size_t)layer * 1024 * 1536; const unsigned char* G = (const unsigned char*)(p.ws + WS_G); bf16* Mg = (bf16*)(p.ws + WS_MERGED);
    for (int it = gridDim.x - 1 - blockIdx.x; it < (NCTX / 64) * 16; it += gridDim.x) { const int r0 = NLAT + (it >> 4) * 64, c0 = (it & 15) * 64;
        float tot[8];
#pragma unroll
        for (int q = 0; q < 8; ++q) tot[q] = 0.f;
#pragma unroll 1
        for (int br = 0; br < 4; ++br) { const int koff = br == 0 ? 0 : (br == 1 ? 512 : (br == 2 ? 768 : 1280)), klen = (br & 1) ? 256 : 512;
            float o[8]; sk::tile64(lds, X + (size_t)r0 * 1536 + koff, 1536, WB + (size_t)c0 * 1536 + koff, 1536, klen, o);
#pragma unroll
            for (int q = 0; q < 8; ++q) { int rr, cc; sk::elem_rc(threadIdx.x, q, rr, cc); tot[q] += o[q] * ((float)G[(size_t)(r0 + rr) * 4096 + br * 1024 + c0 + cc] * (1.f / 255.f)); } }
#pragma unroll
        for (int q = 0; q < 8; ++q) { int rr, cc; sk::elem_rc(threadIdx.x, q, rr, cc); Mg[(size_t)(r0 + rr) * 1024 + c0 + cc] = f2bf(tot[q]); } }
    __syncthreads();
}
__device__ __forceinline__ void mini_resid_ctx(const P& p, LAS unsigned char* lds, int layer, const bf16* A, int lda, const bf16* Bt, int K, int chunk, int xnorm = -1, int nlayer = 0, int nwhich = 0, const float* hsrc = nullptr) {
    const float* g = mods(p, layer, 2, chunk); float* hc = (float*)(p.ws + WS_HCTX); if (hsrc == nullptr) hsrc = hc;
    for (int it = gridDim.x - 1 - blockIdx.x; it < (NCTX / 64) * 16; it += gridDim.x) { const int rl = (it >> 4) * 64, c0 = (it & 15) * 64;
        float o[8]; sk::tile64(lds, A + (size_t)(NLAT + rl) * lda, lda, Bt + (size_t)c0 * K, K, K, o);
        if (xnorm < 0) {
#pragma unroll
            for (int q = 0; q < 8; ++q) { int rr, cc; sk::elem_rc(threadIdx.x, q, rr, cc); float* h = hc + (size_t)(rl + rr) * D + c0 + cc; *h = *h + g[c0 + cc] * o[q]; }
        } else {
#pragma unroll
            for (int q = 0; q < 8; ++q) { int rr, cc; sk::elem_rc(threadIdx.x, q, rr, cc); float* h = hc + (size_t)(rl + rr) * D + c0 + cc;
                __hip_atomic_store(h, hsrc[(size_t)(rl + rr) * D + c0 + cc] + g[c0 + cc] * o[q], __ATOMIC_RELAXED, __HIP_MEMORY_SCOPE_AGENT); }
            asm volatile("s_waitcnt vmcnt(0)" ::: "memory"); __syncthreads();
            if (threadIdx.x == 0) { unsigned* c = (unsigned*)(p.ws + WS_CTL) + CW_CCNT + (8 * xnorm + (it >> 4)) * 16; unsigned* tmo = (unsigned*)(p.ws + WS_CTL) + CW_TMO;
                __hip_atomic_fetch_add(c, 1u, __ATOMIC_RELAXED, __HIP_MEMORY_SCOPE_AGENT);
                unsigned sp = 0u;
                while (__hip_atomic_load(c, __ATOMIC_RELAXED, __HIP_MEMORY_SCOPE_AGENT) < 16u) { __builtin_amdgcn_s_sleep(1);
                    if ((++sp & 255u) == 0u) { if (__hip_atomic_load(tmo, __ATOMIC_RELAXED, __HIP_MEMORY_SCOPE_AGENT)) break; if (sp > (1u << 22)) { atomicAdd(tmo, 1u); break; } } }
                __builtin_amdgcn_fence(__ATOMIC_ACQUIRE, "agent"); }
            __syncthreads();
            { const int w = threadIdx.x >> 6, lane = threadIdx.x & 63;
              if (w < 4) norm_row(p, nlayer, nwhich, NLAT + rl + (it & 15) * 4 + w, lane); }
            __syncthreads();
        } }
    __syncthreads();
}
__device__ __forceinline__ void ph_merge(const P& p, LAS unsigned char* lds, int layer, int nrows) {
    fg::MergeSched S{(const char*)(p.ws + WS_X), (const char*)(p.ws + WS_WB) + (size_t)layer * 1024 * 1536 * 2, nrows / 256, (int)gridDim.x, (int)blockIdx.x};
    fg::EpiMerge E{(const unsigned char*)(p.ws + WS_G), (bf16*)(p.ws + WS_MERGED)};
    fg::gemm_phase(lds, 1536, 1536, S, E);
}
__device__ __forceinline__ void ph_gemm_resid(const P& p, LAS unsigned char* lds, int layer, const bf16* A, int lda, const bf16* Bt, int K, int chunk, int nrows) {
    fg::PlainSched S{(const char*)A, (const char*)Bt, lda, K, nrows / 256, 4, (int)gridDim.x, (int)blockIdx.x, K / 64};
    fg::EpiResid E{p.out, (float*)(p.ws + WS_HCTX), (const float*)(p.ws + WS_MODS) + (size_t)layer * 3 * 6144, chunk};
    fg::gemm_phase(lds, lda, K, S, E);
}
__device__ __forceinline__ void ph_gemm_resid_norm(const P& p, LAS unsigned char* lds, int layer, const bf16* A, int lda, const bf16* Bt, int K, int chunk, int x, int nlayer, int nwhich, const float* hin) {
    fg::PlainSched S{(const char*)A, (const char*)Bt, lda, K, NLAT / 256, 4, (int)gridDim.x, (int)blockIdx.x, K / 64};
    unsigned* ctl = (unsigned*)(p.ws + WS_CTL);
    fg::EpiResidNorm E{hin, p.out, (const float*)(p.ws + WS_MODS) + (size_t)layer * 3 * 6144, chunk,
        p.in[nwhich == 0 ? 6 : 7] + nlayer * D, (const float*)(p.ws + WS_MODS) + (size_t)nlayer * 3 * 6144, nwhich == 0 ? 0 : 3, nwhich == 0 ? 1 : 4, (bf16*)(p.ws + WS_A), nwhich == 0 ? p.ws + WS_A8 : (unsigned char*)nullptr,
        (float*)(p.ws + WS_CTL + CTL_XBUF) + (size_t)x * 65536, ctl + CW_PCNT + 64 * 16 * x, ctl + CW_TMO, lds};
    fg::gemm_phase(lds, lda, K, S, E);
}
__device__ __forceinline__ void ph_ffn1(const P& p, LAS unsigned char* lds) {
    fg::PlainSched S{(const char*)(p.ws + WS_A), (const char*)(p.ws + WS_FFN1), D, D, MROWS / 256, 22, (int)gridDim.x, (int)blockIdx.x, D / 64};
    fg::EpiSwiglu E{(bf16*)(p.ws + WS_HMID)};
    fg::gemm_phase(lds, D, D, S, E);
}
__device__ __forceinline__ int moe_tiles(const P& p, LAS int* tile_e) {
    const unsigned* ctl = (const unsigned*)(p.ws + WS_CTL); int t = 0;
    for (int e = 0; e < NEXP; ++e) { const int c = (int)ctl[CW_CNT + e], nt = (c + 255) >> 8; for (int q = 0; q < nt; ++q) { if (threadIdx.x == 0) tile_e[t + q] = e; } t += nt; }
    __syncthreads();
    return t;
}
__device__ __forceinline__ void ph_assign_gather(const P& p, LAS unsigned char* lds) {
    const int tid = threadIdx.x, bid = blockIdx.x, G = gridDim.x;
    LAS int* sbase = (LAS int*)lds;
    LAS int* stot = sbase + 8;
    LAS int* spst = stot + 8;
    LAS int* sexp = spst + 16;
    LAS int* sslot = sexp + 128;
    const unsigned* cntb = (const unsigned*)(p.ws + WS_ROUTE) + 16384 * 6;
    const int* tok_e = (const int*)(p.ws + WS_ROUTE); int* tok_slot = (int*)(p.ws + WS_ROUTE) + 16384 * 4;
    __syncthreads();
    { const int e = tid >> 6, l = tid & 63; int tot = 0, below = 0;
      for (int b = l; b < G; b += 64) { const int c = (int)cntb[b * NEXP + e]; tot += c; if (b < bid) below += c; }
#pragma unroll
      for (int o = 1; o < 64; o <<= 1) { tot += __shfl_xor(tot, o); below += __shfl_xor(below, o); }
      if (l == 0) { sbase[e] = below; stot[e] = tot; } }
    if (tid < 128) { const int li = tid >> 1, w = li & 7, k = li >> 3, tok = (bid * 8 + w) + k * (G * 8); sexp[tid] = tok < NLAT ? tok_e[tok * 2 + (tid & 1)] : -1; }
    __syncthreads();
    if (tid == 0) { int t = 0; for (int e = 0; e < NEXP; ++e) { spst[e] = t * 256; t += (stot[e] + 255) >> 8; } spst[NEXP] = t * 256;
        if (bid == 0) { unsigned* ctl = (unsigned*)(p.ws + WS_CTL); for (int e = 0; e < NEXP; ++e) ctl[CW_CNT + e] = (unsigned)stot[e]; } }
    __syncthreads();
    if (tid < 128) { const int e = sexp[tid]; int slot = -1;
        if (e >= 0) { int rank = 0; for (int a = 0; a < tid; ++a) rank += (sexp[a] == e) ? 1 : 0; slot = spst[e] + sbase[e] + rank;
            const int li = tid >> 1, w = li & 7, k = li >> 3, tok = (bid * 8 + w) + k * (G * 8); tok_slot[tok * 2 + (tid & 1)] = slot; }
        sslot[tid] = slot; }
    __syncthreads();
    const int lane = tid & 63, wv = tid >> 6; const unsigned char* A8 = p.ws + WS_A8; unsigned char* FS8 = p.ws + WS_FS;
    for (int a = wv; a < 128; a += 8) { const int slot = sslot[a]; if (slot < 0) continue; const int li = a >> 1, w = li & 7, k = li >> 3, tok = (bid * 8 + w) + k * (G * 8);
        *(u32x4*)(FS8 + (size_t)slot * D + lane * 16) = *(const u32x4*)(A8 + (size_t)tok * D + lane * 16); }
    { int idx = 0;
      for (int e = 0; e < NEXP; ++e) { const int lo_ = spst[e] + stot[e], hi_ = spst[e + 1];
          for (int r = lo_ + ((bid * 8 + wv - idx) % (G * 8) + (G * 8)) % (G * 8); r < hi_; r += G * 8) {
              *(u32x4*)(FS8 + (size_t)r * D + lane * 16) = (u32x4){0u, 0u, 0u, 0u}; }
          idx += hi_ - lo_; } }
    __syncthreads();
}
__device__ __forceinline__ void ph_moe1(const P& p, LAS unsigned char* lds) {
    LAS int* tile_e = (LAS int*)(lds + fg::STAGE_BYTES); const int nt = moe_tiles(p, tile_e);
    fg::ExpertSched S{(const char*)(p.ws + WS_FS), (const char*)(p.ws + WS_MOE1), D / 2, D / 2, nt, 22, (int)gridDim.x, (int)blockIdx.x, D / 128, tile_e, (size_t)5632 * D};
    fg::EpiSwiglu8 E{p.ws + WS_HMOE};
    fg::gemm_phase<fg::EpiSwiglu8, fg::ExpertSched, true>(lds, D / 2, D / 2, S, E);
}
__device__ __forceinline__ void ph_moe2(const P& p, LAS unsigned char* lds) {
    LAS int* tile_e = (LAS int*)(lds + fg::STAGE_BYTES); const int nt = moe_tiles(p, tile_e);
    const int nbig = nt < 128 ? nt : 128;
    fg::ExpertSched S{(const char*)(p.ws + WS_HMOE), (const char*)(p.ws + WS_MOE2), FFN / 2, FFN / 2, nbig, 4, (int)gridDim.x, (int)blockIdx.x, FFN / 128, tile_e, (size_t)D * FFN};
    fg::EpiStore E{(bf16*)(p.ws + WS_Y2), D};
    fg::gemm_phase<fg::EpiStore, fg::ExpertSched, true>(lds, FFN / 2, FFN / 2, S, E);
    const unsigned char* A = p.ws + WS_HMOE; bf16* Y = (bf16*)(p.ws + WS_Y2);
    for (int it = blockIdx.x; it < (nt - nbig) * 64; it += gridDim.x) {
        const int rt = nbig + (it >> 6), r0 = rt * 256 + ((it >> 4) & 3) * 64, c0 = (it & 15) * 64;
        const unsigned char* B = p.ws + WS_MOE2 + (size_t)tile_e[rt] * D * FFN;
        float o[8]; sk::tile64_f8(lds, A + (size_t)r0 * FFN, FFN, B + (size_t)c0 * FFN, FFN, FFN, o);
#pragma unroll
        for (int q = 0; q < 8; ++q) { int rr, cc; sk::elem_rc(threadIdx.x, q, rr, cc); Y[(size_t)(r0 + rr) * D + c0 + cc] = f2bf(o[q]); } }
    __syncthreads();
}
__device__ __forceinline__ void ph_combine(const P& p, int layer) {
    const int lane = threadIdx.x & 63, gw = blockIdx.x * 8 + (threadIdx.x >> 6), ngw = gridDim.x * 8;
    const float* tok_w = (const float*)(p.ws + WS_ROUTE) + 16384 * 2; const int* tok_slot = (const int*)(p.ws + WS_ROUTE) + 16384 * 4; const bf16* Y = (const bf16*)(p.ws + WS_Y2);
    for (int r = gw; r < NLAT; r += ngw) {
        const int s0 = tok_slot[r * 2], s1 = tok_slot[r * 2 + 1]; const float w0 = tok_w[r * 2], w1 = tok_w[r * 2 + 1];
        const float* g = mods(p, layer, row_mi(r), 5); float* h = p.out + (size_t)r * D;
#pragma unroll
        for (int j = 0; j < 4; ++j) { const int c = 4 * lane + 256 * j;
            const u32x2 a = *(const u32x2*)(Y + (size_t)s0 * D + c), bq = *(const u32x2*)(Y + (size_t)s1 * D + c); const f32x4 gg = *(const f32x4*)(g + c); f32x4 hv = *(f32x4*)(h + c);
            hv.x += gg.x * (w0 * __uint_as_float(a.x << 16) + w1 * __uint_as_float(bq.x << 16)); hv.y += gg.y * (w0 * __uint_as_float(a.x & 0xffff0000u) + w1 * __uint_as_float(bq.x & 0xffff0000u));
            hv.z += gg.z * (w0 * __uint_as_float(a.y << 16) + w1 * __uint_as_float(bq.y << 16)); hv.w += gg.w * (w0 * __uint_as_float(a.y & 0xffff0000u) + w1 * __uint_as_float(bq.y & 0xffff0000u));
            *(f32x4*)(h + c) = hv; }
    }
}

#define XB_TMO      128
static_assert(CW_TMO == CW_BAR + XB_TMO, "tmo word");
static_assert(CW_CCNT + 4 * 8 * 16 <= 16384, "all zero-initialised control words lie in the first 64 KiB");
#define XB_XCNT(j)  (256  + 64 * (j))
#define XB_XSUB(j)  (1280 + 64 * (j))
#define XB_XGEN(j)  (2304 + 64 * (j))
#define XB_TOP      3328
#define XB_TOPGEN   3392
#define XCD_BAR_WORDS 3456
#define XB_SPIN_CAP (1u << 22)
__device__ __forceinline__ unsigned xb_ld(unsigned* p)              { return __hip_atomic_load(p, __ATOMIC_RELAXED, __HIP_MEMORY_SCOPE_AGENT); }
__device__ __forceinline__ unsigned xb_add(unsigned* p, unsigned v) { return __hip_atomic_fetch_add(p, v, __ATOMIC_RELAXED, __HIP_MEMORY_SCOPE_AGENT); }
__device__ __forceinline__ unsigned xb_xcc_id() { return (unsigned)__builtin_amdgcn_s_getreg((3 << 11) | 20) & 0xFu; }
#define XB_SPIN(cond, bar) do { unsigned _sp = 0; while (cond) { __builtin_amdgcn_s_sleep(1); \
    if ((++_sp & 255u) == 0u) { if (xb_ld(&(bar)[XB_TMO])) break; if (_sp > XB_SPIN_CAP) { atomicAdd(&(bar)[XB_TMO], 1u); break; } } } } while (0)
struct XcdBarrier { unsigned* bar; unsigned x; volatile LAS unsigned* st; };
__device__ __forceinline__ XcdBarrier xcd_barrier_post(unsigned* bar, volatile LAS unsigned* st) {
    XcdBarrier b; b.bar = bar; b.x = xb_xcc_id(); b.st = st;
    if (threadIdx.x == 0) (void)xb_add(&bar[XB_XCNT(b.x)], 1u);
    return b;
}
__device__ __forceinline__ void xcd_barrier_complete(unsigned* bar, unsigned x, unsigned& nloc, unsigned& nx) {
    const unsigned G = gridDim.x * gridDim.y * gridDim.z;
    unsigned sum, cnt, mine, sp = 0u;
    for (;;) {
        sum = 0u; cnt = 0u; mine = 0u;
#pragma unroll
        for (unsigned j = 0; j < 16; ++j) { const unsigned c = xb_ld(&bar[XB_XCNT(j)]); sum += c; cnt += (c > 0u) ? 1u : 0u; mine = (j == x) ? c : mine; }
        if (sum == G) break;
        __builtin_amdgcn_s_sleep(1);
        if ((++sp & 255u) == 0u) { if (xb_ld(&bar[XB_TMO])) break; if (sp > XB_SPIN_CAP) { atomicAdd(&bar[XB_TMO], 1u); break; } }
    }
    nloc = mine > 0u ? mine : 1u; nx = cnt > 0u ? cnt : 1u;
}
__device__ __forceinline__ void xcd_barrier(const XcdBarrier& b) {
    asm volatile("s_waitcnt vmcnt(0)" ::: "memory");
    __syncthreads();
    if (threadIdx.x == 0) {
        unsigned* bar = b.bar;
        __builtin_amdgcn_s_waitcnt(0);
        unsigned nloc = b.st[0], nx = b.st[1];
        if (nloc == 0u) { xcd_barrier_complete(bar, b.x, nloc, nx); b.st[0] = nloc; b.st[1] = nx; }
        const unsigned old = xb_add(&bar[XB_XSUB(b.x)], 1u);
        const unsigned gen = old / nloc;
        if (old + 1u == (gen + 1u) * nloc) {
            __builtin_amdgcn_fence(__ATOMIC_RELEASE, "agent");
            asm volatile("s_waitcnt vmcnt(0)" ::: "memory");
            const unsigned og = xb_add(&bar[XB_TOP], 1u);
            const unsigned tg = og / nx;
            if (og + 1u == (tg + 1u) * nx) xb_add(&bar[XB_TOPGEN], 1u);
            else XB_SPIN(xb_ld(&bar[XB_TOPGEN]) == tg, bar);
            __builtin_amdgcn_fence(__ATOMIC_ACQUIRE, "agent");
            xb_add(&bar[XB_XGEN(b.x)], 1u);
            asm volatile("s_waitcnt vmcnt(0)" ::: "memory");
        } else {
            XB_SPIN(xb_ld(&bar[XB_XGEN(b.x)]) == gen, bar);
            asm volatile("buffer_inv sc0" ::: "memory");
            asm volatile("s_waitcnt vmcnt(0)" ::: "memory");
        }
    }
    __syncthreads();
}

constexpr int NPHASE = 23;
constexpr int LDS_BYTES = 150 * 1024;
__global__ void __launch_bounds__(NTHREADS, 2) mk(P p, int lo, int hi, int fuse) {
    extern __shared__ __attribute__((aligned(16))) unsigned char lds_raw[];
    LAS unsigned char* lds = (LAS unsigned char*)lds_raw;
    volatile LAS unsigned* misc = (volatile LAS unsigned*)(lds + LDS_BYTES - 64);
    if (threadIdx.x < 16) misc[threadIdx.x] = 0u;
    __syncthreads();
    XcdBarrier bar; bar.bar = (unsigned*)(p.ws + WS_CTL) + CW_BAR; bar.x = 0; bar.st = misc;
    if (hi - lo > 1) bar = xcd_barrier_post((unsigned*)(p.ws + WS_CTL) + CW_BAR, misc);
#if MK_SINGLE
    cg::this_grid().sync();
#endif
#ifndef PROBE_MASK
#define PROBE_MASK 0u
#endif
#ifndef AMP_A
#define AMP_A (-1)
#define AMP_B (-1)
#define AMP_MUL 15
#endif
#define AMP(k) do { if ((k) == AMP_A && blockIdx.x == 0 && threadIdx.x == 0) { const unsigned long long t = __builtin_amdgcn_s_memrealtime(); misc[8] = (unsigned)t; } \
    if ((k) == AMP_B && blockIdx.x == 0 && threadIdx.x == 0) { const unsigned t1 = (unsigned)__builtin_amdgcn_s_memrealtime(), dt = (t1 - misc[8]) * AMP_MUL; while ((unsigned)__builtin_amdgcn_s_memrealtime() - t1 < dt) __builtin_amdgcn_s_sleep(8); } } while (0)
#define PH(k, body) do { if (lo <= (k) && (k) < hi) { if ((k) > lo) { xcd_barrier(bar); } AMP(k); body; \
    if ((PROBE_MASK >> (k)) & 1u) { xcd_barrier(bar); body; } } } while (0)
#define LAYER_PHASES(L, base) \
    PH(base + 0, ph_win(p, lds, L)); \
    PH(base + 1, ph_mix1(p, lds, L)); \
    PH(base + 2, ph_mix2(p, lds, lds_raw, L)); \
    PH(base + 3, ph_mix3(p, lds, L, fuse != 0)); \
    PH(base + 4, { if (L == 0 && fuse) ctx_ret_items(p, lds); ph_merge(p, lds, L, NLAT); if (L == 0) { if (fuse && (int)(gridDim.x - 1 - blockIdx.x) < (NCTX / 64) * 16) ctx_ret_wait(p); mini_merge_ctx(p, lds, L); } }); \
    PH(base + 5, { if (L == 0 && fuse) { ph_gemm_resid_norm(p, lds, 0, (const bf16*)(p.ws + WS_MERGED), 1024, (const bf16*)(p.ws + WS_WOUT), D, 2, 0, 0, 1, p.in[0]); mini_resid_ctx(p, lds, 0, (const bf16*)(p.ws + WS_MERGED), 1024, (const bf16*)(p.ws + WS_WOUT), D, 2, 0, 0, 1, p.in[2]); } \
        else { ph_gemm_resid(p, lds, L, (const bf16*)(p.ws + WS_MERGED), 1024, (const bf16*)(p.ws + WS_WOUT) + (size_t)L * D * D, D, 2, NLAT); if (L == 0) mini_resid_ctx(p, lds, L, (const bf16*)(p.ws + WS_MERGED), 1024, (const bf16*)(p.ws + WS_WOUT), D, 2); } });
    PH(0, ph_prologue(p, lds));
    PH(1, ph_norm(p, lds, 0, 0, true, false, MROWS, !fuse));
    LAYER_PHASES(0, 2)
    if (!fuse) PH(8, ph_norm(p, lds, 0, 1, false, false, MROWS));
    PH(9, ph_ffn1(p, lds));
    PH(10, { if (fuse) { ph_gemm_resid_norm(p, lds, 0, (const bf16*)(p.ws + WS_HMID), FFN, (const bf16*)(p.ws + WS_FFN2), FFN, 5, 1, 1, 0, p.out); mini_resid_ctx(p, lds, 0, (const bf16*)(p.ws + WS_HMID), FFN, (const bf16*)(p.ws + WS_FFN2), FFN, 5, 1, 1, 0); }
        else { ph_gemm_resid(p, lds, 0, (const bf16*)(p.ws + WS_HMID), FFN, (const bf16*)(p.ws + WS_FFN2), FFN, 5, NLAT); mini_resid_ctx(p, lds, 0, (const bf16*)(p.ws + WS_HMID), FFN, (const bf16*)(p.ws + WS_FFN2), FFN, 5); } });
    if (!fuse) PH(11, ph_norm(p, lds, 1, 0, false, false, MROWS));
    LAYER_PHASES(1, 12)
    PH(18, ph_norm(p, lds, 1, 1, false, true, NLAT));
    PH(19, { ph_assign_gather(p, lds); ph_moe_convert(p, lds); });
    PH(20, ph_moe1(p, lds));
    PH(21, ph_moe2(p, lds));
    PH(22, ph_combine(p, 1));
#undef PH
#undef LAYER_PHASES
}

extern "C" void kernel_launch(void* const* d_in, const int* in_sizes, int n_in, void* d_out, int out_size, void* d_ws, size_t ws_size, hipStream_t stream) {
    static int grid = 0;
    if (grid == 0) {
        if (n_in != 30 || out_size != NLAT * D || ws_size < WS_END) { fprintf(stderr, "kernel_launch: unexpected shapes (n_in %d out %d ws %zu)\n", n_in, out_size, ws_size); grid = -1; return; }
        int dev = 0, cus = 0, per_cu = 0;
        hipGetDevice(&dev); hipDeviceGetAttribute(&cus, hipDeviceAttributeMultiprocessorCount, dev);
        hipFuncSetAttribute((const void*)mk, hipFuncAttributeMaxDynamicSharedMemorySize, LDS_BYTES);
        hipOccupancyMaxActiveBlocksPerMultiprocessor(&per_cu, (const void*)mk, NTHREADS, LDS_BYTES);
        if (per_cu < 1) { fprintf(stderr, "kernel_launch: occupancy query says %d blocks per CU\n", per_cu); grid = -1; return; }
        grid = cus;
    }
    if (grid < 0) return;
    hipMemsetAsync((char*)d_ws + WS_CTL, 0, 64 * 1024, stream);
    P p{};
    for (int i = 0; i < 30; ++i) p.in[i] = (const float*)d_in[i];
    p.out = (float*)d_out; p.ws = (unsigned char*)d_ws;
#if MK_SINGLE
    int lo = 0, hi = NPHASE, fuse = grid == 256 ? 1 : 0; void* args[] = {&p, &lo, &hi, &fuse};
    hipLaunchCooperativeKernel((const void*)mk, dim3(grid), dim3(NTHREADS), args, LDS_BYTES, stream);
#else
    for (int ph = 0; ph < NPHASE; ++ph) hipLaunchKernelGGL(mk, dim3(grid), dim3(NTHREADS), LDS_BYTES, stream, p, ph, ph + 1, 0);
#endif
}
```
